# Optimizing an MI355X kernel written in HIP

```python
import math
import jax, jax.numpy as jnp
from jax import lax
import numpy as np

D_MODEL = 1024
BATCH = 4
SEQ = 8192
DEPTH = 1

CHUNK = 64
QBLOCK = 128
ROPE_THETA = 10000.0
EPS = 1e-6
N_ATTN_HEADS = 8
HEAD_DIM = D_MODEL // 16
D_ATTN = N_ATTN_HEADS * HEAD_DIM
N_IDX_HEADS = 8
IDX_DIM = 64
TOPK_MAX = 256
D_RNN = D_MODEL // 2
N_RNN_BLOCKS = 8
RNN_BLOCK = D_RNN // N_RNN_BLOCKS
CONV_WIDTH = 4
RG_C = 8.0
D_MIX = D_ATTN + D_RNN
IN_SPLITS = [D_ATTN, D_ATTN, D_ATTN, N_IDX_HEADS * IDX_DIM, IDX_DIM, N_IDX_HEADS, D_RNN, D_RNN]
D_IN = sum(IN_SPLITS)
IN_OFFSETS = [int(o) for o in np.cumsum(IN_SPLITS)[:-1]]
N_GROUPS = 4
EXP_PER_GROUP = 8
TOP_E = 2
D_EXPERT = D_MODEL // 4
N_MOD = 6

kernel_name = "hybrid_dsa_rglru_hmoe_block"


def rms_norm(x, g):
    xf = x.astype(jnp.float32)
    y = xf * lax.rsqrt(jnp.mean(xf * xf, axis=-1, keepdims=True) + EPS)
    return (y * g.astype(jnp.float32)).astype(x.dtype)


def rope_tables(seq_len, dim):
    pos = jnp.arange(seq_len, dtype=jnp.float32)
    inv = ROPE_THETA ** (-jnp.arange(0, dim, 2, dtype=jnp.float32) / dim)
    ang = pos[:, None] * inv[None, :]
    return jnp.cos(ang), jnp.sin(ang)


def apply_rope(x, cos, sin):
    xf = x.astype(jnp.float32)
    x1, x2 = jnp.split(xf, 2, axis=-1)
    c, s = cos[None, :, None, :], sin[None, :, None, :]
    return jnp.concatenate([x1 * c - x2 * s, x2 * c + x1 * s], axis=-1).astype(x.dtype)


def sparse_indexed_attention(q, k, v, q_idx, k_idx, w_idx):
    B, S, H, Dh = q.shape
    n_sel = min(TOPK_MAX, S // 4)
    key_pos = jnp.arange(S)
    qi_f = q_idx.astype(jnp.float32)
    ki_f = k_idx.astype(jnp.float32)
    wi_f = w_idx.astype(jnp.float32) * (N_IDX_HEADS ** -0.5)
    gather = jax.vmap(lambda t, i: t[i])

    def one_block(start):
        sl = lambda a: lax.dynamic_slice_in_dim(a, start, QBLOCK, axis=1)
        q_b, qi_b, wi_b = sl(q), sl(qi_f), sl(wi_f)
        q_pos = start + jnp.arange(QBLOCK)
        limit = (q_pos // CHUNK + 1) * CHUNK
        dots = jnp.einsum('bqhd,bsd->bqhs', qi_b, ki_f) * (IDX_DIM ** -0.5)
        score = jnp.einsum('bqh,bqhs->bqs', wi_b, jax.nn.relu(dots))
        score = jnp.where(key_pos[None, None, :] < limit[None, :, None], score, -jnp.inf)
        _, idx = lax.top_k(score, n_sel)
        valid = idx < limit[None, :, None]
        k_sel = gather(k, idx)
        v_sel = gather(v, idx)
        logits = jnp.einsum('bqhd,bqkhd->bhqk', q_b, k_sel).astype(jnp.float32) * (Dh ** -0.5)
        logits = jnp.where(valid[:, None], logits, -jnp.inf)
        p = jax.nn.softmax(logits, axis=-1).astype(v.dtype)
        return jnp.einsum('bhqk,bqkhd->bqhd', p, v_sel)

    starts = jnp.arange(S // QBLOCK) * QBLOCK
    out = lax.map(one_block, starts)
    return out.transpose(1, 0, 2, 3, 4).reshape(B, S, H * Dh)


def rglru_branch(xr, conv_w, conv_b, w_a, b_a, w_x, b_x, lam):
    B, S, R = xr.shape
    conv = lax.conv_general_dilated(
        xr, conv_w[:, None, :].astype(xr.dtype), window_strides=(1,),
        padding=[(CONV_WIDTH - 1, 0)], dimension_numbers=('NWC', 'WIO', 'NWC'),
        feature_group_count=R) + conv_b.astype(xr.dtype)
    xf = conv.astype(jnp.float32)
    xb = xf.reshape(B, S, N_RNN_BLOCKS, RNN_BLOCK)
    r = jax.nn.sigmoid(jnp.einsum('bsnc,ncd->bsnd', xb, w_a.astype(jnp.float32)).reshape(B, S, R) + b_a.astype(jnp.float32))
    i = jax.nn.sigmoid(jnp.einsum('bsnc,ncd->bsnd', xb, w_x.astype(jnp.float32)).reshape(B, S, R) + b_x.astype(jnp.float32))
    log_a = -RG_C * r * jax.nn.softplus(-lam.astype(jnp.float32))
    a = jnp.exp(log_a)
    b = jnp.sqrt(-jnp.expm1(2.0 * log_a)) * (i * xf)

    def combine(left, right):
        a_l, b_l = left
        a_r, b_r = right
        return a_l * a_r, a_r * b_l + b_r

    _, h = lax.associative_scan(combine, (a, b), axis=1)
    return h.astype(xr.dtype)


def hierarchical_moe(h, w_rg, b_rg, w_re, b_re, w_gate, w_up, w_down):
    B, S, D = h.shape
    hf = h.reshape(B * S, D)
    h32 = hf.astype(jnp.float32)
    p_groups = jax.nn.softmax(h32 @ w_rg.astype(jnp.float32) + b_rg.astype(jnp.float32), axis=-1)
    g_idx = jnp.argmax(p_groups, axis=-1)
    p_g = jnp.max(p_groups, axis=-1)
    e_logits = (h32 @ w_re.astype(jnp.float32) + b_re.astype(jnp.float32)).reshape(-1, N_GROUPS, EXP_PER_GROUP)
    e_chosen = jnp.take_along_axis(e_logits, g_idx[:, None, None], axis=1)[:, 0]
    e_val, e_idx = lax.top_k(jax.nn.softmax(e_chosen, axis=-1), TOP_E)
    e_val = e_val / jnp.sum(e_val, axis=-1, keepdims=True)
    e_w = jnp.sum(jax.nn.one_hot(e_idx, EXP_PER_GROUP, dtype=jnp.float32) * e_val[..., None], axis=1)
    comb = (jax.nn.one_hot(g_idx, N_GROUPS, dtype=jnp.float32)[:, :, None]
            * (p_g[:, None] * e_w)[:, None, :]).astype(h.dtype)
    out = jnp.zeros_like(hf)
    for g in range(N_GROUPS):
        gate = jnp.einsum('td,edf->tef', hf, w_gate[g])
        up = jnp.einsum('td,edf->tef', hf, w_up[g])
        act = jax.nn.silu(gate) * up * comb[:, g, :, None]
        out = out + jnp.einsum('tef,efd->td', act, w_down[g])
    return out.reshape(B, S, D)


def setup_inputs(seed: int = 0) -> dict:
    key = jax.random.key(seed)
    ks = jax.random.split(key, 24)
    f32 = jnp.float32
    nrm = lambda k, shape, fan_in, s=1.0: jax.random.normal(k, shape, f32) * (s * fan_in ** -0.5)
    small = lambda k, shape: 0.01 * jax.random.normal(k, shape, f32)
    gain = lambda k: 1.0 + 0.05 * jax.random.normal(k, (DEPTH, D_MODEL), f32)
    u = jax.random.uniform(ks[15], (DEPTH, D_RNN), f32, 0.9, 0.999)
    a0 = u ** (1.0 / RG_C)
    return {
        "x": jax.random.normal(ks[0], (BATCH, SEQ, D_MODEL), f32),
        "c": jax.random.normal(ks[1], (BATCH, D_MODEL), f32),
        "w_ada": nrm(ks[2], (DEPTH, D_MODEL, N_MOD * D_MODEL), D_MODEL, 0.5),
        "b_ada": small(ks[3], (DEPTH, N_MOD * D_MODEL)),
        "g_pre_mix": gain(ks[4]),
        "g_post_mix": gain(ks[5]),
        "g_pre_ffn": gain(ks[6]),
        "g_post_ffn": gain(ks[7]),
        "w_in": nrm(ks[8], (DEPTH, D_MODEL, D_IN), D_MODEL),
        "conv_w": nrm(ks[9], (DEPTH, CONV_WIDTH, D_RNN), CONV_WIDTH),
        "conv_b": small(ks[10], (DEPTH, D_RNN)),
        "w_rg_a": nrm(ks[11], (DEPTH, N_RNN_BLOCKS, RNN_BLOCK, RNN_BLOCK), RNN_BLOCK),
        "b_rg_a": small(ks[12], (DEPTH, D_RNN)),
        "w_rg_x": nrm(ks[13], (DEPTH, N_RNN_BLOCKS, RNN_BLOCK, RNN_BLOCK), RNN_BLOCK),
        "b_rg_x": small(ks[14], (DEPTH, D_RNN)),
        "lru_lambda": jnp.log(a0) - jnp.log1p(-a0),
        "w_out": nrm(ks[16], (DEPTH, D_MIX, D_MODEL), D_MIX),
        "w_router_group": nrm(ks[17], (DEPTH, D_MODEL, N_GROUPS), D_MODEL),
        "b_router_group": small(ks[18], (DEPTH, N_GROUPS)),
        "w_router_expert": nrm(ks[19], (DEPTH, D_MODEL, N_GROUPS * EXP_PER_GROUP), D_MODEL),
        "b_router_expert": small(ks[20], (DEPTH, N_GROUPS * EXP_PER_GROUP)),
        "w_gate": nrm(ks[21], (DEPTH, N_GROUPS, EXP_PER_GROUP, D_MODEL, D_EXPERT), D_MODEL),
        "w_up": nrm(ks[22], (DEPTH, N_GROUPS, EXP_PER_GROUP, D_MODEL, D_EXPERT), D_MODEL),
        "w_down": nrm(ks[23], (DEPTH, N_GROUPS, EXP_PER_GROUP, D_EXPERT, D_MODEL), D_EXPERT),
    }


def reference(x, c, w_ada, b_ada, g_pre_mix, g_post_mix, g_pre_ffn, g_post_ffn, w_in,
              conv_w, conv_b, w_rg_a, b_rg_a, w_rg_x, b_rg_x, lru_lambda, w_out,
              w_router_group, b_router_group, w_router_expert, b_router_expert,
              w_gate, w_up, w_down):
    B, S, D = x.shape
    cos, sin = rope_tables(S, HEAD_DIM)
    cos_i, sin_i = rope_tables(S, IDX_DIM)
    for l in range(DEPTH):
        mod = jax.nn.silu(c) @ w_ada[l] + b_ada[l]
        shift1, scale1, gate1, shift2, scale2, gate2 = [m[:, None, :] for m in jnp.split(mod, N_MOD, axis=-1)]

        h = rms_norm(x, g_pre_mix[l]) * (1 + scale1) + shift1
        proj = h @ w_in[l]
        q, k, v, qi, ki, wi, xr, xg = jnp.split(proj, IN_OFFSETS, axis=-1)
        q = apply_rope(q.reshape(B, S, N_ATTN_HEADS, HEAD_DIM), cos, sin)
        k = apply_rope(k.reshape(B, S, N_ATTN_HEADS, HEAD_DIM), cos, sin)
        v = v.reshape(B, S, N_ATTN_HEADS, HEAD_DIM)
        qi = apply_rope(qi.reshape(B, S, N_IDX_HEADS, IDX_DIM), cos_i, sin_i)
        ki = apply_rope(ki.reshape(B, S, 1, IDX_DIM), cos_i, sin_i)[:, :, 0]
        y_attn = sparse_indexed_attention(q, k, v, qi, ki, wi)
        y_rnn = rglru_branch(xr, conv_w[l], conv_b[l], w_rg_a[l], b_rg_a[l],
                             w_rg_x[l], b_rg_x[l], lru_lambda[l]) * jax.nn.gelu(xg)
        mix = jnp.concatenate([y_attn, y_rnn], axis=-1) @ w_out[l]
        x = x + gate1 * rms_norm(mix, g_post_mix[l])

        h2 = rms_norm(x, g_pre_ffn[l]) * (1 + scale2) + shift2
        y = hierarchical_moe(h2, w_router_group[l], b_router_group[l], w_router_expert[l],
                             b_router_expert[l], w_gate[l], w_up[l], w_down[l])
        x = x + gate2 * rms_norm(y, g_post_ffn[l])
    return x
```

```cpp
#include <hip/hip_runtime.h>
#include <hip/hip_cooperative_groups.h>
#include <cstdio>
#include <cstdint>
namespace cg = cooperative_groups;

#ifndef N_LAUNCH_MODE
#define N_LAUNCH_MODE 0
#endif

#define DEVI __device__ __forceinline__
#define LDS __attribute__((address_space(3)))

typedef _Float16 h16;
typedef _Float16 h16x4 __attribute__((ext_vector_type(4)));
typedef _Float16 h16x8 __attribute__((ext_vector_type(8)));
typedef float f32x4 __attribute__((ext_vector_type(4)));
typedef float f32x16 __attribute__((ext_vector_type(16)));
typedef unsigned u32x2 __attribute__((ext_vector_type(2)));
typedef unsigned u32x4 __attribute__((ext_vector_type(4)));

constexpr int NBATCH = 4, SEQ = 8192, NTOK = NBATCH * SEQ, DM = 1024;
constexpr int NTHR = 512;
constexpr int NPHASE = 10;
constexpr int LDS_BYTES = 163840;

constexpr size_t MiB = 1ull << 20;
constexpr size_t WS_CNT = 0;
constexpr size_t CTL_ZERO_BYTES = 4096;
constexpr size_t WS_MODP = 64 * 1024;
constexpr size_t WS_ROPE = 1 * MiB;
constexpr size_t WS_WIN = 3 * MiB;
constexpr size_t WS_WOUT = 10 * MiB;
constexpr size_t WS_WGU = 12 * MiB;
constexpr size_t WS_WDN = 44 * MiB;
constexpr size_t WS_WRG = 60 * MiB;
constexpr size_t WS_WRT = 60 * MiB + 256 * 1024;
constexpr size_t WS_AGG = 61 * MiB;
constexpr size_t WS_ROUTE = 63 * MiB;
constexpr size_t WS_LIST = 64 * MiB;
constexpr size_t WS_LISTW = 68 * MiB;
constexpr size_t WS_WI = 72 * MiB;
constexpr size_t WS_KI = 73 * MiB;
constexpr size_t WS_MASK = 77 * MiB;
constexpr size_t WS_H = 109 * MiB;
constexpr size_t WS_Q = 173 * MiB;
constexpr size_t WS_K = 205 * MiB;
constexpr size_t WS_VT = 237 * MiB;
constexpr size_t WS_QI = 269 * MiB;
constexpr size_t WS_XR = 301 * MiB;
constexpr size_t WS_XG = 333 * MiB;
constexpr size_t WS_MIX = 365 * MiB;
constexpr size_t WS_ACT = 429 * MiB;
constexpr size_t WS_YP = 173 * MiB;
constexpr size_t WS_END = 462 * MiB;

struct Params { const float* in[24]; float* out; unsigned char* ws; int ph_lo, ph_hi; };
typedef const __attribute__((address_space(4))) Params& PRef;
typedef const __attribute__((address_space(4))) Params* PPtr;

__device__ const double ROPE_REV[32] = {
  1.59154943091895345608e-01, 1.19349370211248861917e-01, 8.94994016088910132600e-02, 6.71150830052272551196e-02,
  5.03292121044870352509e-02, 3.77415847174197710556e-02, 2.83021958306233986646e-02, 2.12236527647776604399e-02,
  1.59154943091895338669e-02, 1.19349370211248861917e-02, 8.94994016088910236684e-03, 6.71150830052272533849e-03,
  5.03292121044870369856e-03, 3.77415847174197719230e-03, 2.83021958306233986646e-03, 2.12236527647776621747e-03,
  1.59154943091895356017e-03, 1.19349370211248848907e-03, 8.94994016088910236684e-04, 6.71150830052272598901e-04,
  5.03292121044870326488e-04, 3.77415847174197740914e-04, 2.83021958306233954120e-04, 2.12236527647776605484e-04,
  1.59154943091895350596e-04, 1.19349370211248862459e-04, 8.94994016088910182474e-05, 6.71150830052272544691e-05,
  5.03292121044870353593e-05, 3.77415847174197768019e-05, 2.83021958306233960897e-05, 2.12236527647776591931e-05};

DEVI int launder(int x) { asm volatile("" : "+v"(x)); return x; }
DEVI PPtr get_params() { PPtr k = (PPtr)__builtin_amdgcn_kernarg_segment_ptr(); asm volatile("" : "+s"(k)); return k; }
DEVI int wave_id(int tid) { return __builtin_amdgcn_readfirstlane(tid >> 6); }
DEVI f32x16 mfma16(h16x8 a, h16x8 b, f32x16 c) { return __builtin_amdgcn_mfma_f32_32x32x16_f16(a, b, c, 0, 0, 0); }
DEVI float wave_sum(float v) {
#pragma unroll
  for (int o = 1; o < 64; o <<= 1) v += __shfl_xor(v, o);
  return v;
}
DEVI float sigmoid_f(float x) { return 1.f / (1.f + __expf(-x)); }
DEVI float silu_f(float x) { return x / (1.f + __expf(-x)); }
DEVI float gelu_tanh_f(float x) {
  const float u = 0.7978845608028654f * (x + 0.044715f * x * x * x);
  const float t = 1.f - 2.f / (1.f + __expf(2.f * u));
  return 0.5f * x * (1.f + t);
}
DEVI unsigned fkey(float f) { unsigned u = __float_as_uint(f); return (u & 0x80000000u) ? ~u : (u | 0x80000000u); }
DEVI float fkey_inv(unsigned k) { unsigned u = (k & 0x80000000u) ? (k & 0x7fffffffu) : ~k; return __uint_as_float(u); }
DEVI int vt_perm(int pos) { return (pos & ~12) | ((pos & 4) << 1) | ((pos & 8) >> 1); }

DEVI void mod_to_lds(PRef p, int b, int chunk, LDS float* dst) {
  const float* mp = (const float*)(p.ws + WS_MODP);
  for (int k = threadIdx.x; k < 1024; k += NTHR) {
    const int j = chunk * 1024 + k;
    float s = p.in[3][j];
#pragma unroll 1
    for (int ks = 0; ks < 8; ++ks) s += mp[(size_t)(ks * 4 + b) * 6144 + j];
    dst[k] = s;
  }
}

constexpr int LROW = 144;
constexpr int GA_BYTES = 256 * LROW, GB_BYTES = 128 * LROW, GSTAGE = GA_BYTES + GB_BYTES;

template <class AR, class EPI>
DEVI void gemm_tile(LDS unsigned char* lds, const AR& arow, const h16* Bt, int ldb, int K, EPI& epi) {
  const int tid = launder((int)threadIdx.x), lane = tid & 63, wave = wave_id(tid), wm = wave >> 1, wn = wave & 1;
  const int lr = tid >> 3, lc = tid & 7, l31 = lane & 31, half = lane >> 5;
  const h16* pa[4]; const h16* pb[2];
#pragma unroll
  for (int j = 0; j < 4; ++j) pa[j] = arow(lr + 64 * j) + lc * 8;
#pragma unroll
  for (int j = 0; j < 2; ++j) pb[j] = Bt + (size_t)(lr + 64 * j) * ldb + lc * 8;
  h16x8 ra[4], rb[2];
#pragma unroll
  for (int j = 0; j < 4; ++j) ra[j] = *(const h16x8*)pa[j];
#pragma unroll
  for (int j = 0; j < 2; ++j) rb[j] = *(const h16x8*)pb[j];
#pragma unroll
  for (int j = 0; j < 4; ++j) *(LDS h16x8*)(lds + (lr + 64 * j) * LROW + lc * 16) = ra[j];
#pragma unroll
  for (int j = 0; j < 2; ++j) *(LDS h16x8*)(lds + GA_BYTES + (lr + 64 * j) * LROW + lc * 16) = rb[j];
  __syncthreads();
  f32x16 acc[2][2];
#pragma unroll
  for (int a = 0; a < 2; ++a)
#pragma unroll
    for (int b = 0; b < 2; ++b)
#pragma unroll
      for (int r = 0; r < 16; ++r) acc[a][b][r] = 0.f;
  const int KT = K >> 6;
  for (int kt = 0; kt < KT; ++kt) {
    const int cur = kt & 1;
    if (kt + 1 < KT) {
#pragma unroll
      for (int j = 0; j < 4; ++j) ra[j] = *(const h16x8*)(pa[j] + (kt + 1) * 64);
#pragma unroll
      for (int j = 0; j < 2; ++j) rb[j] = *(const h16x8*)(pb[j] + (kt + 1) * 64);
    }
    LDS unsigned char* A = lds + cur * GSTAGE;
    LDS unsigned char* B = A + GA_BYTES;
#pragma unroll
    for (int kk = 0; kk < 4; ++kk) {
      h16x8 af[2], bf[2];
#pragma unroll
      for (int mi = 0; mi < 2; ++mi) af[mi] = *(LDS h16x8*)(A + (64 * wm + 32 * mi + l31) * LROW + (2 * kk + half) * 16);
#pragma unroll
      for (int ni = 0; ni < 2; ++ni) bf[ni] = *(LDS h16x8*)(B + (64 * wn + 32 * ni + l31) * LROW + (2 * kk + half) * 16);
#pragma unroll
      for (int mi = 0; mi < 2; ++mi)
#pragma unroll
        for (int ni = 0; ni < 2; ++ni) acc[mi][ni] = mfma16(bf[ni], af[mi], acc[mi][ni]);
    }
    if (kt + 1 < KT) {
      LDS unsigned char* A2 = lds + (cur ^ 1) * GSTAGE;
#pragma unroll
      for (int j = 0; j < 4; ++j) *(LDS h16x8*)(A2 + (lr + 64 * j) * LROW + lc * 16) = ra[j];
#pragma unroll
      for (int j = 0; j < 2; ++j) *(LDS h16x8*)(A2 + GA_BYTES + (lr + 64 * j) * LROW + lc * 16) = rb[j];
    }
    __syncthreads();
  }
  epi(acc, wm, wn, lane);
}

struct ARowPlain { const h16* base; size_t ld; DEVI const h16* operator()(int r) const { return base + (size_t)r * ld; } };
struct ARowGather { const h16* base; const unsigned* list; int n; int row0; DEVI const h16* operator()(int r) const { const int i = row0 + r; const unsigned t = (i < n) ? list[i] : 0u; return base + (size_t)t * DM; } };

DEVI h16x4 pack4(float a, float b, float c, float d) { h16x4 v; v[0] = (h16)a; v[1] = (h16)b; v[2] = (h16)c; v[3] = (h16)d; return v; }

template <class F>
DEVI void transpose_tile(const float* src, int N, int kb, int nb, h16* dst, int ldd, F drow, LDS float* tile) {
  const int tid = launder((int)threadIdx.x);
#pragma unroll
  for (int j = 0; j < 8; ++j) {
    const int kl = (tid >> 6) + 8 * j, nl = tid & 63, n = nb * 64 + nl;
    tile[kl * 65 + nl] = (n < N) ? src[(size_t)(kb * 64 + kl) * N + n] : 0.f;
  }
  __syncthreads();
  const int nl = tid >> 3, ch = tid & 7, n = nb * 64 + nl;
  if (n < N) {
    h16x8 v;
#pragma unroll
    for (int e = 0; e < 8; ++e) v[e] = (h16)tile[(ch * 8 + e) * 65 + nl];
    *(h16x8*)(dst + (size_t)drow(n) * ldd + kb * 64 + ch * 8) = v;
  }
  __syncthreads();
}

DEVI void phase0(PRef p, LDS unsigned char* lds) {
  const int tid = launder((int)threadIdx.x), lane = tid & 63, wave = wave_id(tid), G = gridDim.x;
  const int gw = blockIdx.x * 8 + wave, NW = G * 8;
  {
    const float* c = p.in[1]; const float* wada = p.in[2]; float* mp = (float*)(p.ws + WS_MODP);
    for (int u = gw; u < 96 * 8; u += NW) {
      const int cgp = u % 96, ks = u / 96, j = cgp * 64 + lane;
      float a0 = 0.f, a1 = 0.f, a2 = 0.f, a3 = 0.f;
      for (int k = ks * 128; k < ks * 128 + 128; ++k) {
        const float w = wada[(size_t)k * 6144 + j];
        a0 = fmaf(silu_f(c[k]), w, a0); a1 = fmaf(silu_f(c[1024 + k]), w, a1);
        a2 = fmaf(silu_f(c[2048 + k]), w, a2); a3 = fmaf(silu_f(c[3072 + k]), w, a3);
      }
      mp[(size_t)(ks * 4 + 0) * 6144 + j] = a0; mp[(size_t)(ks * 4 + 1) * 6144 + j] = a1;
      mp[(size_t)(ks * 4 + 2) * 6144 + j] = a2; mp[(size_t)(ks * 4 + 3) * 6144 + j] = a3;
    }
  }
  {
    LDS float* tile = (LDS float*)lds;
    constexpr int I_IN = 16 * 50, I_OUT = 16 * 16, I_G = 32 * 64, I_U = 32 * 64, I_D = 32 * 64, I_RG = 16;
    constexpr int NIT = I_IN + I_OUT + I_G + I_U + I_D + I_RG;
    for (int it = blockIdx.x; it < NIT; it += G) {
      int r = it;
      if (r < I_IN) {
        transpose_tile(p.in[8], 3144, r / 50, r % 50, (h16*)(p.ws + WS_WIN), 1024,
                       [](int n) { return n < 2112 ? n : (n < 2120 ? 3136 + (n - 2112) : (n < 2632 ? 2112 + (n - 2120) : 2624 + (n - 2632))); }, tile);
        continue;
      }
      r -= I_IN;
      if (r < I_OUT) { transpose_tile(p.in[16], 1024, r / 16, r % 16, (h16*)(p.ws + WS_WOUT), 1024, [](int n) { return n; }, tile); continue; }
      r -= I_OUT;
      if (r < I_G) { const int e = r >> 6, q = r & 63;
        transpose_tile(p.in[21] + (size_t)e * 1024 * 256, 256, q >> 2, q & 3, (h16*)(p.ws + WS_WGU) + (size_t)e * 512 * 1024, 1024, [](int f) { return (f >> 5) * 64 + (f & 31); }, tile); continue; }
      r -= I_G;
      if (r < I_U) { const int e = r >> 6, q = r & 63;
        transpose_tile(p.in[22] + (size_t)e * 1024 * 256, 256, q >> 2, q & 3, (h16*)(p.ws + WS_WGU) + (size_t)e * 512 * 1024, 1024, [](int f) { return (f >> 5) * 64 + 32 + (f & 31); }, tile); continue; }
      r -= I_U;
      if (r < I_D) { const int e = r >> 6, q = r & 63;
        transpose_tile(p.in[23] + (size_t)e * 256 * 1024, 1024, q >> 4, q & 15, (h16*)(p.ws + WS_WDN) + (size_t)e * 1024 * 256, 256, [](int n) { return n; }, tile); continue; }
      r -= I_D;
      if (r < 8) transpose_tile(p.in[11] + (size_t)r * 4096, 64, 0, 0, (h16*)(p.ws + WS_WRG) + (size_t)r * 128 * 64, 64, [](int n) { return n; }, tile);
      else transpose_tile(p.in[13] + (size_t)(r - 8) * 4096, 64, 0, 0, (h16*)(p.ws + WS_WRG) + (size_t)(r - 8) * 128 * 64, 64, [](int n) { return 64 + n; }, tile);
    }
  }
  {
    float* wrt = (float*)(p.ws + WS_WRT);
    for (int i = blockIdx.x * NTHR + tid; i < 36 * 1024; i += G * NTHR) {
      const int col = i >> 10, k = i & 1023;
      wrt[i] = (col < 4) ? p.in[17][k * 4 + col] : p.in[19][k * 32 + (col - 4)];
    }
    float* ct = (float*)(p.ws + WS_ROPE); float* st = ct + 8192 * 32;
    for (int i = blockIdx.x * NTHR + tid; i < 8192 * 32; i += G * NTHR) {
      const int pos = i >> 5, f = i & 31;
      const double rev = (double)pos * ROPE_REV[f];
      const float fr = (float)(rev - __builtin_rint(rev));
      ct[i] = __builtin_amdgcn_cosf(fr); st[i] = __builtin_amdgcn_sinf(fr);
    }
  }
}

DEVI void phase1(PRef p, LDS unsigned char* lds) {
  const int tid = launder((int)threadIdx.x), lane = tid & 63, wave = wave_id(tid), G = gridDim.x;
  const int b = blockIdx.x & 3, bi = blockIdx.x >> 2, nbk = G >> 2;
  LDS float* mv = (LDS float*)lds;
  mod_to_lds(p, b, 0, mv); mod_to_lds(p, b, 1, mv + 1024);
  __syncthreads();
  f32x4 A[4], SH[4];
#pragma unroll
  for (int j = 0; j < 4; ++j) {
    const int k = 256 * j + 4 * lane;
    const f32x4 g = *(const f32x4*)(p.in[4] + k);
    A[j] = g * (*(LDS f32x4*)(mv + 1024 + k) + 1.f);
    SH[j] = *(LDS f32x4*)(mv + k);
  }
  const float* x = p.in[0]; h16* H = (h16*)(p.ws + WS_H);
  for (int r = bi * 8 + wave; r < SEQ; r += nbk * 8) {
    const size_t tok = (size_t)b * SEQ + r;
    f32x4 v[4]; float ss = 0.f;
#pragma unroll
    for (int j = 0; j < 4; ++j) { v[j] = *(const f32x4*)(x + tok * DM + 256 * j + 4 * lane); ss += v[j][0] * v[j][0] + v[j][1] * v[j][1] + v[j][2] * v[j][2] + v[j][3] * v[j][3]; }
    const float rstd = 1.0f / sqrtf(wave_sum(ss) * (1.f / 1024.f) + 1e-6f);
#pragma unroll
    for (int j = 0; j < 4; ++j) {
      const f32x4 y = v[j] * rstd * A[j] + SH[j];
      *(h16x4*)(H + tok * DM + 256 * j + 4 * lane) = pack4(y[0], y[1], y[2], y[3]);
    }
  }
}

struct EpiInProj {
  unsigned char* ws; int mt, nt;
  DEVI void operator()(const f32x16 (&acc)[2][2], int wm, int wn, int lane) const {
    const int l31 = lane & 31, half = lane >> 5;
    const int g = 2 * nt + wn;
    const float* cosT = (const float*)(ws + WS_ROPE); const float* sinT = cosT + 8192 * 32;
#pragma unroll
    for (int mi = 0; mi < 2; ++mi) {
      const int tok = mt * 256 + 64 * wm + 32 * mi + l31;
      const int b = tok >> 13, pos = tok & 8191;
      if (g < 16 || (g >= 24 && g <= 32)) {
        float scl; h16* dst;
        if (g < 8) { scl = 0.125f * 1.4426950408889634f; dst = (h16*)(ws + WS_Q) + (size_t)tok * 512 + g * 64; }
        else if (g < 16) { scl = 1.f; dst = (h16*)(ws + WS_K) + (size_t)tok * 512 + (g - 8) * 64; }
        else if (g < 32) { scl = 0.125f; dst = (h16*)(ws + WS_QI) + (size_t)tok * 512 + (g - 24) * 64; }
        else { scl = 1.f; dst = (h16*)(ws + WS_KI) + (size_t)tok * 64; }
#pragma unroll
        for (int q = 0; q < 4; ++q) {
          const int d0 = 8 * q + 4 * half;
          const f32x4 c = *(const f32x4*)(cosT + pos * 32 + d0), s = *(const f32x4*)(sinT + pos * 32 + d0);
          float o1[4], o2[4];
#pragma unroll
          for (int e = 0; e < 4; ++e) {
            const float x1 = acc[mi][0][4 * q + e], x2 = acc[mi][1][4 * q + e];
            o1[e] = (x1 * c[e] - x2 * s[e]) * scl; o2[e] = (x2 * c[e] + x1 * s[e]) * scl;
          }
          *(h16x4*)(dst + d0) = pack4(o1[0], o1[1], o1[2], o1[3]);
          *(h16x4*)(dst + 32 + d0) = pack4(o2[0], o2[1], o2[2], o2[3]);
        }
      } else if (g < 24) {
        h16* vt = (h16*)(ws + WS_VT) + (size_t)(b * 8 + (g - 16)) * 64 * 8192 + vt_perm(pos);
#pragma unroll
        for (int ni = 0; ni < 2; ++ni)
#pragma unroll
          for (int r = 0; r < 16; ++r) { const int d = 32 * ni + 8 * (r >> 2) + 4 * half + (r & 3); vt[(size_t)d * 8192] = (h16)acc[mi][ni][r]; }
      } else if (g < 49) {
        h16* dst = (g < 41) ? (h16*)(ws + WS_XR) + (size_t)tok * 512 + (g - 33) * 64 : (h16*)(ws + WS_XG) + (size_t)tok * 512 + (g - 41) * 64;
#pragma unroll
        for (int ni = 0; ni < 2; ++ni)
#pragma unroll
          for (int q = 0; q < 4; ++q)
            *(h16x4*)(dst + 32 * ni + 8 * q + 4 * half) = pack4(acc[mi][ni][4 * q], acc[mi][ni][4 * q + 1], acc[mi][ni][4 * q + 2], acc[mi][ni][4 * q + 3]);
      } else {
        const float sc = 0.35355339059327373f;
        f32x4 v; v[0] = acc[mi][0][0] * sc; v[1] = acc[mi][0][1] * sc; v[2] = acc[mi][0][2] * sc; v[3] = acc[mi][0][3] * sc;
        *(f32x4*)((float*)(ws + WS_WI) + (size_t)tok * 8 + 4 * half) = v;
      }
    }
  }
};

DEVI void phase2(PRef p, LDS unsigned char* lds) {
  const int G = gridDim.x;
  const h16* H = (const h16*)(p.ws + WS_H); const h16* W = (const h16*)(p.ws + WS_WIN);
  for (int it = blockIdx.x; it < 128 * 25; it += G) {
    const int mt = it / 25, nt = it % 25;
    ARowPlain ar{H + (size_t)mt * 256 * DM, (size_t)DM};
    EpiInProj epi{p.ws, mt, nt};
    gemm_tile(lds, ar, W + (size_t)nt * 128 * DM, DM, DM, epi);
  }
}

constexpr int CROW = 1040;
constexpr int RNN_XG = 64 * CROW;
template <int MODE>
DEVI void rnn_item(PRef p, LDS unsigned char* lds, int b, int cr) {
  const int tid = launder((int)threadIdx.x), lane = tid & 63, wave = wave_id(tid), l31 = lane & 31, half = lane >> 5;
  const h16* XR = (const h16*)(p.ws + WS_XR);
  {
    const int chg = tid & 63, tg = tid >> 6, pos0 = cr * 64 + 8 * tg;
    h16x8 xin[11];
#pragma unroll
    for (int i = 0; i < 11; ++i) {
      const int pos = pos0 + i - 3;
      if (pos >= 0) xin[i] = *(const h16x8*)(XR + ((size_t)b * SEQ + pos) * 512 + chg * 8);
      else {
#pragma unroll
        for (int e = 0; e < 8; ++e) xin[i][e] = (h16)0.f;
      }
    }
    float cw[4][8], cb[8];
#pragma unroll
    for (int e = 0; e < 8; ++e) {
      cb[e] = p.in[10][chg * 8 + e];
#pragma unroll
      for (int j = 0; j < 4; ++j) cw[j][e] = p.in[9][j * 512 + chg * 8 + e];
    }
#pragma unroll
    for (int tt = 0; tt < 8; ++tt) {
      h16x8 o;
#pragma unroll
      for (int e = 0; e < 8; ++e) {
        float v = cb[e];
#pragma unroll
        for (int j = 0; j < 4; ++j) v = fmaf(cw[j][e], (float)xin[tt + j][e], v);
        o[e] = (h16)v;
      }
      *(LDS h16x8*)(lds + (8 * tg + tt) * CROW + chg * 16) = o;
    }
  }
  if (MODE == 1) {
    const h16* XG = (const h16*)(p.ws + WS_XG) + ((size_t)b * SEQ + cr * 64) * 512;
#pragma unroll
    for (int i = 0; i < 8; ++i) { const int c = tid + NTHR * i, row = c >> 6, cc = c & 63; *(LDS h16x8*)(lds + RNN_XG + row * CROW + cc * 16) = *(const h16x8*)(XG + (size_t)row * 512 + cc * 8); }
  }
  __syncthreads();
  const int n = wave;
  const h16* WRG = (const h16*)(p.ws + WS_WRG) + (size_t)n * 128 * 64;
  float* AGG = (float*)(p.ws + WS_AGG);
#pragma unroll 1
  for (int dt = 0; dt < 2; ++dt) {
    h16x8 wa[4], wx[4];
#pragma unroll
    for (int kk = 0; kk < 4; ++kk) {
      wa[kk] = *(const h16x8*)(WRG + (size_t)(32 * dt + l31) * 64 + 16 * kk + 8 * half);
      wx[kk] = *(const h16x8*)(WRG + (size_t)(64 + 32 * dt + l31) * 64 + 16 * kk + 8 * half);
    }
    f32x16 ra[2], rx[2];
#pragma unroll
    for (int ti = 0; ti < 2; ++ti) {
#pragma unroll
      for (int r = 0; r < 16; ++r) { ra[ti][r] = 0.f; rx[ti][r] = 0.f; }
#pragma unroll
      for (int kk = 0; kk < 4; ++kk) {
        const h16x8 af = *(LDS h16x8*)(lds + (32 * ti + l31) * CROW + (n * 64 + 16 * kk + 8 * half) * 2);
        ra[ti] = mfma16(af, wa[kk], ra[ti]);
        rx[ti] = mfma16(af, wx[kk], rx[ti]);
      }
    }
    const int ch = n * 64 + 32 * dt + l31;
    const float ba = p.in[12][ch], bx = p.in[14][ch], lam = p.in[15][ch];
    const float c8 = -8.f * log1pf(__expf(-lam));
#pragma unroll
    for (int ti = 0; ti < 2; ++ti)
#pragma unroll
      for (int r = 0; r < 16; ++r) {
        const int tk = 32 * ti + (r & 3) + 8 * (r >> 2) + 4 * half;
        const float cv = (float)*(LDS h16*)(lds + tk * CROW + ch * 2);
        const float rr = sigmoid_f(ra[ti][r] + ba), ii = sigmoid_f(rx[ti][r] + bx);
        const float la = c8 * rr;
        ra[ti][r] = __expf(la);
        rx[ti][r] = sqrtf(-expm1f(2.f * la)) * (ii * cv);
      }
    float P[8], Hs[8];
#pragma unroll
    for (int sg = 0; sg < 8; ++sg) {
      const int ti = sg >> 2, q = sg & 3;
      float pp = 1.f, hh = 0.f;
#pragma unroll
      for (int i = 0; i < 4; ++i) { const float a = ra[ti][4 * q + i], bb = rx[ti][4 * q + i]; hh = fmaf(a, hh, bb); pp *= a; }
      P[sg] = pp; Hs[sg] = hh;
    }
    float carry = 0.f, prod = 1.f;
    if (MODE == 1) {
      for (int c2 = 0; c2 < cr; ++c2) {
        const float* ag = AGG + ((size_t)(b * 128 + c2) * 512 + ch) * 2;
        carry = fmaf(ag[0], carry, ag[1]);
      }
    }
    float cin[8];
#pragma unroll
    for (int sg = 0; sg < 8; ++sg)
#pragma unroll
      for (int ow = 0; ow < 2; ++ow) {
        const float tmp = fmaf(P[sg], carry, Hs[sg]);
        const float tp = P[sg] * prod;
        if (half == ow) cin[sg] = carry;
        const float oth = __shfl_xor(tmp, 32), otp = __shfl_xor(tp, 32);
        carry = (half == ow) ? tmp : oth;
        prod = (half == ow) ? tp : otp;
      }
    if (MODE == 0) {
      if (half == 0) { float* ag = AGG + ((size_t)(b * 128 + cr) * 512 + ch) * 2; ag[0] = prod; ag[1] = carry; }
    } else {
#pragma unroll
      for (int sg = 0; sg < 8; ++sg) {
        const int ti = sg >> 2, q = sg & 3;
        float hh = cin[sg];
#pragma unroll
        for (int i = 0; i < 4; ++i) {
          hh = fmaf(ra[ti][4 * q + i], hh, rx[ti][4 * q + i]);
          LDS h16* xp = (LDS h16*)(lds + RNN_XG + (32 * ti + 8 * q + 4 * half + i) * CROW + ch * 2);
          *xp = (h16)(hh * gelu_tanh_f((float)*xp));
        }
      }
    }
  }
  __syncthreads();
  if (MODE == 1) {
    h16* Y = (h16*)(p.ws + WS_H) + ((size_t)b * SEQ + cr * 64) * DM + 512;
#pragma unroll
    for (int i = 0; i < 8; ++i) { const int c = tid + NTHR * i, row = c >> 6, cc = c & 63; *(h16x8*)(Y + (size_t)row * DM + cc * 8) = *(LDS h16x8*)(lds + RNN_XG + row * CROW + cc * 16); }
    __syncthreads();
  }
}

constexpr int IDX_NB = 256, IDX_CAP = 128;
constexpr int IL_HIST = 0, IL_CS = 65536, IL_CK = IL_CS + 64 * IDX_CAP * 4, IL_KI = IL_CK + 64 * IDX_CAP * 2, IL_KISZ = 128 * LROW, IL_ST = IL_KI + 2 * IL_KISZ;
static_assert(IL_ST + 4096 <= LDS_BYTES, "indexer LDS map");

DEVI f32x4 mfma16s(h16x8 a, h16x8 b, f32x4 c) { return __builtin_amdgcn_mfma_f32_16x16x32_f16(a, b, c, 0, 0, 0); }
DEVI void idx_score(LDS unsigned char* kit, int kh, int l15, int g4, const h16x8 (&qf)[8][2], const float (&wq)[8], f32x4 (&sc)[4]) {
  h16x8 kf[4][2];
#pragma unroll
  for (int kt = 0; kt < 4; ++kt)
#pragma unroll
    for (int ks = 0; ks < 2; ++ks) kf[kt][ks] = *(LDS h16x8*)(kit + (64 * kh + 16 * kt + l15) * LROW + (4 * ks + g4) * 16);
#pragma unroll
  for (int kt = 0; kt < 4; ++kt) sc[kt] = (f32x4){0.f, 0.f, 0.f, 0.f};
#pragma unroll
  for (int h = 0; h < 8; ++h) {
#pragma unroll
    for (int kt = 0; kt < 4; ++kt) {
      f32x4 acc = (f32x4){0.f, 0.f, 0.f, 0.f};
      acc = mfma16s(kf[kt][0], qf[h][0], acc);
      acc = mfma16s(kf[kt][1], qf[h][1], acc);
#pragma unroll
      for (int r = 0; r < 4; ++r) sc[kt][r] = __builtin_fmaf(wq[h], __builtin_fmaxf(acc[r], 0.f), sc[kt][r]);
    }
    if (h & 1) __builtin_amdgcn_sched_barrier(0);
  }
}

template <int MODE>
DEVI void idx_pass(LDS unsigned char* lds, const h16* KIb, int N, int stride, int qg, int kh,
                   const h16* QIrow0, const float* WIrow0, float qinv, float qoff, int bstar) {
  const int tid = launder((int)threadIdx.x), lane = tid & 63, l15 = lane & 15, g4 = lane >> 4;
  const int q = 16 * qg + l15;
  h16x8 qf[8][2]; float wq[8];
  {
    const h16* QI = QIrow0 + (size_t)q * 512;
#pragma unroll
    for (int h = 0; h < 8; ++h)
#pragma unroll
      for (int ks = 0; ks < 2; ++ks) qf[h][ks] = *(const h16x8*)(QI + h * 64 + 32 * ks + 8 * g4);
    const float* WI = WIrow0 + (size_t)q * 8;
#pragma unroll
    for (int h = 0; h < 8; ++h) wq[h] = WI[h];
  }
  LDS unsigned* hist = (LDS unsigned*)(lds + IL_HIST);
  LDS unsigned* st = (LDS unsigned*)(lds + IL_ST);
  const int nst = (N + 127) >> 7;
  const int lr = tid >> 3, lc = tid & 7;
  h16x8 r0, r1;
  r0 = *(const h16x8*)(KIb + (size_t)lr * 64 + lc * 8); r1 = *(const h16x8*)(KIb + (size_t)(lr + 64) * 64 + lc * 8);
  *(LDS h16x8*)(lds + IL_KI + lr * LROW + lc * 16) = r0; *(LDS h16x8*)(lds + IL_KI + (lr + 64) * LROW + lc * 16) = r1;
  __syncthreads();
  float vmin = INFINITY, vmax = -INFINITY;
  int cur = 0;
  for (int s = 0; s < nst; s += stride) {
    const int nx = s + stride;
    if (nx < nst) { r0 = *(const h16x8*)(KIb + (size_t)(128 * nx + lr) * 64 + lc * 8); r1 = *(const h16x8*)(KIb + (size_t)(128 * nx + lr + 64) * 64 + lc * 8); }
    if (128 * s + 64 * kh < N) {
      f32x4 sc[4];
      idx_score(lds + IL_KI + cur * IL_KISZ, kh, l15, g4, qf, wq, sc);
      if (MODE == 0) {
#pragma unroll
        for (int kt = 0; kt < 4; ++kt)
#pragma unroll
          for (int r = 0; r < 4; ++r) { vmin = fminf(vmin, sc[kt][r]); vmax = fmaxf(vmax, sc[kt][r]); }
      } else if (MODE == 1) {
#pragma unroll
        for (int kt = 0; kt < 4; ++kt)
#pragma unroll
          for (int r = 0; r < 4; ++r) {
            const float xb = fminf(fmaxf(__builtin_fmaf(sc[kt][r], qinv, qoff), 0.f), (float)(IDX_NB - 1));
            const int bin = (int)xb;
            __hip_atomic_fetch_add(&hist[bin * 64 + q], 1u, __ATOMIC_RELAXED, __HIP_MEMORY_SCOPE_WORKGROUP);
          }
      } else {
        unsigned nib = 0u;
#pragma unroll
        for (int kt = 0; kt < 4; ++kt)
#pragma unroll
          for (int r = 0; r < 4; ++r) {
            const float xb = fminf(fmaxf(__builtin_fmaf(sc[kt][r], qinv, qoff), 0.f), (float)(IDX_NB - 1));
            const int bin = (int)xb;
            if (bin > bstar) nib |= (1u << (4 * kt + r));
            else if (bin == bstar) {
              const unsigned pos = __hip_atomic_fetch_add(&st[128 + q], 1u, __ATOMIC_RELAXED, __HIP_MEMORY_SCOPE_WORKGROUP);
              if (pos < (unsigned)IDX_CAP) {
                ((LDS float*)(lds + IL_CS))[q * IDX_CAP + pos] = sc[kt][r];
                ((LDS unsigned short*)(lds + IL_CK))[q * IDX_CAP + pos] = (unsigned short)(128 * s + 64 * kh + 16 * kt + 4 * g4 + r);
              }
            }
          }
        const unsigned oth = (unsigned)__shfl_xor((int)nib, 32);
        if (lane < 32) {
#pragma unroll
          for (int T = 0; T < 2; ++T) {
            const unsigned b0 = ((nib >> (8 * T)) & 15u) | (((oth >> (8 * T)) & 15u) << 4);
            const unsigned b1 = ((nib >> (8 * T + 4)) & 15u) | (((oth >> (8 * T + 4)) & 15u) << 4);
            ((LDS unsigned short*)(lds + IL_HIST))[q * 512 + (4 * s + 2 * kh + T) * 2 + (g4 & 1)] = (unsigned short)(b0 | (b1 << 8));
          }
        }
      }
    }
    if (nx < nst) {
      *(LDS h16x8*)(lds + IL_KI + (cur ^ 1) * IL_KISZ + lr * LROW + lc * 16) = r0;
      *(LDS h16x8*)(lds + IL_KI + (cur ^ 1) * IL_KISZ + (lr + 64) * LROW + lc * 16) = r1;
    }
    __syncthreads();
    cur ^= 1;
  }
  if (MODE == 0) {
    __hip_atomic_fetch_min(&st[q], fkey(vmin), __ATOMIC_RELAXED, __HIP_MEMORY_SCOPE_WORKGROUP);
    __hip_atomic_fetch_max(&st[64 + q], fkey(vmax), __ATOMIC_RELAXED, __HIP_MEMORY_SCOPE_WORKGROUP);
  }
}

DEVI void idx_item(PRef p, LDS unsigned char* lds, int b, int c) {
  const int tid = launder((int)threadIdx.x), lane = tid & 63, wave = wave_id(tid), l31 = lane & 31, half = lane >> 5;
  const int N = 64 * (c + 1);
  unsigned* MASK = (unsigned*)(p.ws + WS_MASK) + ((size_t)b * SEQ + 64 * c) * 256;
  if (N <= 256) {
    const int wpr = N >> 5;
    for (int i = tid; i < 64 * wpr; i += NTHR) MASK[(size_t)(i / wpr) * 256 + (i % wpr)] = 0xFFFFFFFFu;
    return;
  }
  const int qg = wave & 3, kh = wave >> 2, l15 = lane & 15, q = 16 * qg + l15;
  const h16* QIrow0 = (const h16*)(p.ws + WS_QI) + ((size_t)b * SEQ + 64 * c) * 512;
  const float* WIrow0 = (const float*)(p.ws + WS_WI) + ((size_t)b * SEQ + 64 * c) * 8;
  const h16* KIb = (const h16*)(p.ws + WS_KI) + (size_t)b * SEQ * 64;
  LDS unsigned* st = (LDS unsigned*)(lds + IL_ST);
  LDS float* stf = (LDS float*)(lds + IL_ST);
  if (tid < 64) { st[tid] = 0xFFFFFFFFu; st[64 + tid] = 0u; st[128 + tid] = 0u; }
  __syncthreads();
  const int nst = (N + 127) >> 7;
  const int stride = nst >= 16 ? 8 : (nst >= 8 ? 4 : (nst >= 4 ? 2 : 1));
  idx_pass<0>(lds, KIb, N, stride, qg, kh, QIrow0, WIrow0, 0.f, 0.f, 0);
  __syncthreads();
  if (tid < 64) {
    const float lo = fkey_inv(st[tid]), hi = fkey_inv(st[64 + tid]);
    float d = hi - lo; if (!(d > 1e-20f)) d = 1.f;
    const float inv = (float)IDX_NB / (1.5f * d);
    stf[192 + tid] = inv; stf[256 + tid] = -(lo - 0.25f * d) * inv;
  }
  for (int i = tid; i < 16384; i += NTHR) ((LDS unsigned*)(lds + IL_HIST))[i] = 0u;
  __syncthreads();
  const float qinv = stf[192 + q], qoff = stf[256 + q];
  idx_pass<1>(lds, KIb, N, 1, qg, kh, QIrow0, WIrow0, qinv, qoff, 0);
  if (tid < 64) {
    LDS unsigned* hist = (LDS unsigned*)(lds + IL_HIST);
    unsigned cum = 0u; int bs = 0; unsigned need = 256u;
    for (int bb = IDX_NB - 1; bb >= 0; --bb) {
      const unsigned hcount = hist[bb * 64 + tid];
      if (cum + hcount >= 256u) { bs = bb; need = 256u - cum; break; }
      cum += hcount;
    }
    st[320 + tid] = (unsigned)bs; st[384 + tid] = need;
  }
  __syncthreads();
  const int bstar = (int)st[320 + q];
  __syncthreads();
  idx_pass<2>(lds, KIb, N, 1, qg, kh, QIrow0, WIrow0, qinv, qoff, bstar);
  for (int qq = wave; qq < 64; qq += 8) {
    const int nc = min((int)st[128 + qq], IDX_CAP); const unsigned need = st[384 + qq];
    LDS float* cs = (LDS float*)(lds + IL_CS) + qq * IDX_CAP; LDS unsigned short* ck = (LDS unsigned short*)(lds + IL_CK) + qq * IDX_CAP;
    for (int i = lane; i < nc; i += 64) {
      const float sv = cs[i]; const unsigned kv = ck[i];
      unsigned rank = 0u;
      for (int j = 0; j < nc; ++j) { const float sj = cs[j]; const unsigned kj = ck[j]; rank += (sj > sv || (sj == sv && kj < kv)) ? 1u : 0u; }
      if (rank < need) {
        const unsigned kl = kv & 31u;
        const unsigned bit = 16u * ((kl >> 2) & 1u) + (kl & 3u) + 4u * (kl >> 3);
        __hip_atomic_fetch_or((LDS unsigned*)(lds + IL_HIST) + qq * 256 + (kv >> 5), 1u << bit, __ATOMIC_RELAXED, __HIP_MEMORY_SCOPE_WORKGROUP);
      }
    }
  }
  __syncthreads();
  {
    const int cpr = N >> 6;
    for (int i = tid; i < 64 * cpr; i += NTHR) {
      const int row = i / cpr, cc = i % cpr;
      *(u32x2*)(MASK + (size_t)row * 256 + 2 * cc) = *(LDS u32x2*)(lds + IL_HIST + row * 1024 + cc * 8);
    }
  }
  __syncthreads();
}

DEVI void phase3(PRef p, LDS unsigned char* lds) {
  const int G = gridDim.x;
  for (int it = blockIdx.x; it < 512; it += G) rnn_item<0>(p, lds, it >> 7, it & 127);
  for (int it = blockIdx.x; it < 256; it += G) {
    const int b = it >> 6, j = it & 63;
#pragma unroll 1
    for (int w2 = 0; w2 < 2; ++w2) idx_item(p, lds, b, w2 ? j : 127 - j);
  }
}

constexpr int AT_BUF = 2 * 64 * LROW;
DEVI void attn_unit(PRef p, LDS unsigned char* lds, int b, int head, int qb) {
  const int tid = launder((int)threadIdx.x), lane = tid & 63, wave = wave_id(tid), l31 = lane & 31, half = lane >> 5;
  const int q0 = qb * 256 + wave * 32, cw = q0 >> 6, NT = 4 * (qb + 1);
  const size_t tok = (size_t)b * SEQ + q0 + l31;
  h16x8 qf[4];
  {
    const h16* Q = (const h16*)(p.ws + WS_Q) + tok * 512 + head * 64;
#pragma unroll
    for (int kk = 0; kk < 4; ++kk) qf[kk] = *(const h16x8*)(Q + 16 * kk + 8 * half);
  }
  const unsigned* mrow = (const unsigned*)(p.ws + WS_MASK) + tok * 256;
  const int lr = tid >> 3, lc = tid & 7;
  const h16* kp = (const h16*)(p.ws + WS_K) + ((size_t)b * SEQ + lr) * 512 + head * 64 + lc * 8;
  const h16* vp = (const h16*)(p.ws + WS_VT) + ((size_t)(b * 8 + head) * 64 + lr) * 8192 + lc * 8;
  h16x8 rk = *(const h16x8*)kp, rv = *(const h16x8*)vp;
  *(LDS h16x8*)(lds + lr * LROW + lc * 16) = rk; *(LDS h16x8*)(lds + 64 * LROW + lr * LROW + lc * 16) = rv;
  __syncthreads();
  f32x16 o[2];
#pragma unroll
  for (int r = 0; r < 16; ++r) { o[0][r] = 0.f; o[1][r] = 0.f; }
  float m = -INFINITY, l = 0.f;
  for (int jt = 0; jt < NT; ++jt) {
    const int cur = jt & 1;
    if (jt + 1 < NT) { rk = *(const h16x8*)(kp + (size_t)(jt + 1) * 64 * 512); rv = *(const h16x8*)(vp + (jt + 1) * 64); }
    if (jt <= cw) {
      LDS unsigned char* Kt = lds + cur * AT_BUF; LDS unsigned char* Vt = Kt + 64 * LROW;
      const u32x2 mw = *(const u32x2*)(mrow + 2 * jt);
      f32x16 s[2];
#pragma unroll
      for (int ri = 0; ri < 2; ++ri) {
#pragma unroll
        for (int r = 0; r < 16; ++r) s[ri][r] = 0.f;
#pragma unroll
        for (int kk = 0; kk < 4; ++kk) {
          const h16x8 kf = *(LDS h16x8*)(Kt + (32 * ri + l31) * LROW + (2 * kk + half) * 16);
          s[ri] = mfma16(kf, qf[kk], s[ri]);
        }
      }
      const unsigned m0 = (mw[0] >> (16 * half)) & 0xFFFFu, m1 = (mw[1] >> (16 * half)) & 0xFFFFu;
      float mx = -INFINITY;
#pragma unroll
      for (int r = 0; r < 16; ++r) {
        s[0][r] = ((m0 >> r) & 1u) ? s[0][r] : -INFINITY;
        s[1][r] = ((m1 >> r) & 1u) ? s[1][r] : -INFINITY;
        mx = fmaxf(mx, fmaxf(s[0][r], s[1][r]));
      }
      mx = fmaxf(mx, __shfl_xor(mx, 32));
      const float mnew = fmaxf(m, mx);
      const float muse = (mnew == -INFINITY) ? 0.f : mnew;
      const float alpha = __builtin_amdgcn_exp2f(m - muse);
      float ls = 0.f;
#pragma unroll
      for (int r = 0; r < 16; ++r) {
        s[0][r] = __builtin_amdgcn_exp2f(s[0][r] - muse); s[1][r] = __builtin_amdgcn_exp2f(s[1][r] - muse);
        ls += s[0][r] + s[1][r];
      }
      l = l * alpha + ls; m = mnew;
#pragma unroll
      for (int r = 0; r < 16; ++r) { o[0][r] *= alpha; o[1][r] *= alpha; }
      h16x8 pf[4];
#pragma unroll
      for (int s4 = 0; s4 < 4; ++s4)
#pragma unroll
        for (int e = 0; e < 8; ++e) pf[s4][e] = (h16)s[s4 >> 1][8 * (s4 & 1) + e];
#pragma unroll
      for (int di = 0; di < 2; ++di)
#pragma unroll
        for (int s4 = 0; s4 < 4; ++s4) {
          const h16x8 vf = *(LDS h16x8*)(Vt + (32 * di + l31) * LROW + (2 * s4 + half) * 16);
          o[di] = mfma16(vf, pf[s4], o[di]);
        }
    }
    if (jt + 1 < NT) {
      *(LDS h16x8*)(lds + (cur ^ 1) * AT_BUF + lr * LROW + lc * 16) = rk;
      *(LDS h16x8*)(lds + (cur ^ 1) * AT_BUF + 64 * LROW + lr * LROW + lc * 16) = rv;
    }
    __syncthreads();
  }
  const float inv = 1.f / (l + __shfl_xor(l, 32));
  h16* Y = (h16*)(p.ws + WS_H) + tok * DM + head * 64;
#pragma unroll
  for (int di = 0; di < 2; ++di)
#pragma unroll
    for (int q = 0; q < 4; ++q)
      *(h16x4*)(Y + 32 * di + 8 * q + 4 * half) = pack4(o[di][4 * q] * inv, o[di][4 * q + 1] * inv, o[di][4 * q + 2] * inv, o[di][4 * q + 3] * inv);
}

DEVI void phase4(PRef p, LDS unsigned char* lds) {
  const int G = gridDim.x;
  for (int it = blockIdx.x; it < 512; it += G) rnn_item<1>(p, lds, it >> 7, it & 127);
  for (int it = blockIdx.x; it < 512; it += G) {
    const int bh = it >> 4, j = it & 15;
#pragma unroll 1
    for (int w2 = 0; w2 < 2; ++w2) attn_unit(p, lds, bh >> 3, bh & 7, w2 ? j : 31 - j);
  }
}

struct EpiPlain {
  h16* dst; int ld; int row0, col0, nvalid;
  DEVI void operator()(const f32x16 (&acc)[2][2], int wm, int wn, int lane) const {
    const int l31 = lane & 31, half = lane >> 5;
#pragma unroll
    for (int mi = 0; mi < 2; ++mi) {
      const int r = 64 * wm + 32 * mi + l31;
      if (r < nvalid) {
        h16* d = dst + (size_t)(row0 + r) * ld + col0 + 64 * wn;
#pragma unroll
        for (int ni = 0; ni < 2; ++ni)
#pragma unroll
          for (int q = 0; q < 4; ++q)
            *(h16x4*)(d + 32 * ni + 8 * q + 4 * half) = pack4(acc[mi][ni][4 * q], acc[mi][ni][4 * q + 1], acc[mi][ni][4 * q + 2], acc[mi][ni][4 * q + 3]);
      }
    }
  }
};
DEVI void phase5(PRef p, LDS unsigned char* lds) {
  const int G = gridDim.x;
  const h16* Y = (const h16*)(p.ws + WS_H); const h16* W = (const h16*)(p.ws + WS_WOUT);
  for (int it = blockIdx.x; it < 128 * 8; it += G) {
    const int mt = it >> 3, nt = it & 7;
    ARowPlain ar{Y + (size_t)mt * 256 * DM, (size_t)DM};
    EpiPlain epi{(h16*)(p.ws + WS_MIX), DM, mt * 256, nt * 128, 256};
    gemm_tile(lds, ar, W + (size_t)nt * 128 * DM, DM, DM, epi);
  }
}

constexpr int P6_WRT = 0, P6_MOD = 36 * 1024 * 4, P6_LG = P6_MOD + 3 * 4096;
static_assert(P6_LG + 8 * 72 * 4 <= LDS_BYTES, "phase 6 LDS map");
DEVI void phase6(PRef p, LDS unsigned char* lds) {
  const int tid = launder((int)threadIdx.x), lane = tid & 63, wave = wave_id(tid), G = gridDim.x;
  const int b = blockIdx.x & 3, bi = blockIdx.x >> 2, nbk = G >> 2;
  LDS float* wrt = (LDS float*)(lds + P6_WRT);
  LDS float* mv = (LDS float*)(lds + P6_MOD);
  LDS float* lgw = (LDS float*)(lds + P6_LG) + wave * 72;
  {
    const f32x4* src = (const f32x4*)(p.ws + WS_WRT);
    for (int i = tid; i < 36 * 256; i += NTHR) ((LDS f32x4*)wrt)[i] = src[i];
  }
  mod_to_lds(p, b, 2, mv); mod_to_lds(p, b, 3, mv + 1024); mod_to_lds(p, b, 4, mv + 2048);
  __syncthreads();
  f32x4 A1[4], A2[4], SH2[4];
#pragma unroll
  for (int j = 0; j < 4; ++j) {
    const int k = 256 * j + 4 * lane;
    A1[j] = *(LDS f32x4*)(mv + k) * *(const f32x4*)(p.in[5] + k);
    A2[j] = *(const f32x4*)(p.in[6] + k) * (*(LDS f32x4*)(mv + 2048 + k) + 1.f);
    SH2[j] = *(LDS f32x4*)(mv + 1024 + k);
  }
  const float* x = p.in[0]; const h16* MIX = (const h16*)(p.ws + WS_MIX); float* X1 = p.out; h16* H2 = (h16*)(p.ws + WS_H);
  unsigned* cnt = (unsigned*)(p.ws + WS_CNT); unsigned* LIST = (unsigned*)(p.ws + WS_LIST); float* LISTW = (float*)(p.ws + WS_LISTW);
  u32x4* ROUTE = (u32x4*)(p.ws + WS_ROUTE);
  for (int pr = bi * 8 + wave; pr < SEQ / 2; pr += nbk * 8) {
    f32x4 h2[2][4];
#pragma unroll
    for (int tt = 0; tt < 2; ++tt) {
      const size_t tok = (size_t)b * SEQ + 2 * pr + tt;
      f32x4 xv[4], mx[4]; float ssm = 0.f;
#pragma unroll
      for (int j = 0; j < 4; ++j) {
        xv[j] = *(const f32x4*)(x + tok * DM + 256 * j + 4 * lane);
        const h16x4 mh = *(const h16x4*)(MIX + tok * DM + 256 * j + 4 * lane);
#pragma unroll
        for (int e = 0; e < 4; ++e) { mx[j][e] = (float)mh[e]; ssm += mx[j][e] * mx[j][e]; }
      }
      const float rsm = 1.0f / sqrtf(wave_sum(ssm) * (1.f / 1024.f) + 1e-6f);
      float ss1 = 0.f;
#pragma unroll
      for (int j = 0; j < 4; ++j) {
        xv[j] = xv[j] + A1[j] * (mx[j] * rsm);
        *(f32x4*)(X1 + tok * DM + 256 * j + 4 * lane) = xv[j];
        ss1 += xv[j][0] * xv[j][0] + xv[j][1] * xv[j][1] + xv[j][2] * xv[j][2] + xv[j][3] * xv[j][3];
      }
      const float rs1 = 1.0f / sqrtf(wave_sum(ss1) * (1.f / 1024.f) + 1e-6f);
#pragma unroll
      for (int j = 0; j < 4; ++j) {
        h2[tt][j] = xv[j] * rs1 * A2[j] + SH2[j];
        *(h16x4*)(H2 + tok * DM + 256 * j + 4 * lane) = pack4(h2[tt][j][0], h2[tt][j][1], h2[tt][j][2], h2[tt][j][3]);
      }
    }
#pragma unroll 1
    for (int col = 0; col < 36; ++col) {
      float a0 = 0.f, a1 = 0.f;
#pragma unroll
      for (int j = 0; j < 4; ++j) {
        const f32x4 w = *(LDS f32x4*)(wrt + col * 1024 + 256 * j + 4 * lane);
#pragma unroll
        for (int e = 0; e < 4; ++e) { a0 = fmaf(h2[0][j][e], w[e], a0); a1 = fmaf(h2[1][j][e], w[e], a1); }
      }
      a0 = wave_sum(a0); a1 = wave_sum(a1);
      if (lane == 0) { lgw[col] = a0; lgw[36 + col] = a1; }
    }
    if (lane < 2) {
      const int tt = lane;
      const unsigned tok = (unsigned)(b * SEQ + 2 * pr + tt);
      LDS float* lg = lgw + 36 * tt;
      int gi = 0; float gm = lg[0] + p.in[18][0];
      float gl[4];
#pragma unroll
      for (int g = 0; g < 4; ++g) gl[g] = lg[g] + p.in[18][g];
#pragma unroll
      for (int g = 1; g < 4; ++g) if (gl[g] > gm) { gm = gl[g]; gi = g; }
      float gs = 0.f;
#pragma unroll
      for (int g = 0; g < 4; ++g) gs += __expf(gl[g] - gm);
      const float pg = 1.f / gs;
      int e1 = 0, e2 = 0; float l1 = -INFINITY, l2 = -INFINITY;
#pragma unroll 1
      for (int e = 0; e < 8; ++e) {
        const float v = lg[4 + 8 * gi + e] + p.in[20][8 * gi + e];
        if (v > l1) { l2 = l1; e2 = e1; l1 = v; e1 = e; }
        else if (v > l2) { l2 = v; e2 = e; }
      }
      const float x2 = __expf(l2 - l1);
      const float w1 = pg / (1.f + x2), w2 = pg * x2 / (1.f + x2);
      const unsigned E1 = (unsigned)(gi * 8 + e1), E2 = (unsigned)(gi * 8 + e2);
      const unsigned p1 = atomicAdd(&cnt[E1], 1u), p2 = atomicAdd(&cnt[E2], 1u);
      LIST[(size_t)E1 * 32768 + p1] = tok; LISTW[(size_t)E1 * 32768 + p1] = w1;
      LIST[(size_t)E2 * 32768 + p2] = tok; LISTW[(size_t)E2 * 32768 + p2] = w2;
      u32x4 rt; rt[0] = E1; rt[1] = p1; rt[2] = E2; rt[3] = p2;
      ROUTE[tok] = rt;
    }
  }
}

struct MoeItem { int e, mt, nt, cnt, off; };
DEVI bool moe_decode(const unsigned* cnt, int it, int ntn, MoeItem& m) {
  int off = 0;
  for (int e = 0; e < 32; ++e) {
    const int c = (int)cnt[e]; const int nti = ((c + 255) >> 8) * ntn;
    if (it < nti) { m.e = e; m.mt = it / ntn; m.nt = it % ntn; m.cnt = c; m.off = off; return true; }
    it -= nti; off += c;
  }
  return false;
}
struct EpiAct {
  h16* act; const float* lw; int row0, nvalid, nt; size_t orow;
  DEVI void operator()(const f32x16 (&acc)[2][2], int wm, int wn, int lane) const {
    const int l31 = lane & 31, half = lane >> 5;
#pragma unroll
    for (int mi = 0; mi < 2; ++mi) {
      const int r = row0 + 64 * wm + 32 * mi + l31;
      if (r < nvalid) {
        const float w = lw[r];
        h16* d = act + (orow + r) * 256 + 32 * (2 * nt + wn);
#pragma unroll
        for (int q = 0; q < 4; ++q) {
          float v[4];
#pragma unroll
          for (int e = 0; e < 4; ++e) { const float g = acc[mi][0][4 * q + e], u = acc[mi][1][4 * q + e]; v[e] = silu_f(g) * u * w; }
          *(h16x4*)(d + 8 * q + 4 * half) = pack4(v[0], v[1], v[2], v[3]);
        }
      }
    }
  }
};
DEVI void phase7(PRef p, LDS unsigned char* lds) {
  const int G = gridDim.x;
  const unsigned* cnt = (const unsigned*)(p.ws + WS_CNT);
  for (int it = blockIdx.x;; it += G) {
    MoeItem m; if (!moe_decode(cnt, it, 4, m)) break;
    ARowGather ar{(const h16*)(p.ws + WS_H), (const unsigned*)(p.ws + WS_LIST) + (size_t)m.e * 32768, m.cnt, m.mt * 256};
    EpiAct epi{(h16*)(p.ws + WS_ACT), (const float*)(p.ws + WS_LISTW) + (size_t)m.e * 32768, m.mt * 256, m.cnt, m.nt, (size_t)m.off};
    gemm_tile(lds, ar, (const h16*)(p.ws + WS_WGU) + ((size_t)m.e * 512 + m.nt * 128) * DM, DM, DM, epi);
  }
}
DEVI void phase8(PRef p, LDS unsigned char* lds) {
  const int G = gridDim.x;
  const unsigned* cnt = (const unsigned*)(p.ws + WS_CNT);
  for (int it = blockIdx.x;; it += G) {
    MoeItem m; if (!moe_decode(cnt, it, 8, m)) break;
    ARowPlain ar{(const h16*)(p.ws + WS_ACT) + ((size_t)m.off + m.mt * 256) * 256, (size_t)256};
    EpiPlain epi{(h16*)(p.ws + WS_YP), DM, m.off + m.mt * 256, m.nt * 128, m.cnt - m.mt * 256};
    gemm_tile(lds, ar, (const h16*)(p.ws + WS_WDN) + ((size_t)m.e * 1024 + m.nt * 128) * 256, 256, 256, epi);
  }
}

DEVI void phase9(PRef p, LDS unsigned char* lds) {
  const int tid = launder((int)threadIdx.x), lane = tid & 63, wave = wave_id(tid), G = gridDim.x;
  const int b = blockIdx.x & 3, bi = blockIdx.x >> 2, nbk = G >> 2;
  LDS unsigned* offs = (LDS unsigned*)lds;
  if (tid == 0) { const unsigned* cnt = (const unsigned*)(p.ws + WS_CNT); unsigned o = 0; for (int e = 0; e < 32; ++e) { offs[e] = o; o += cnt[e]; } }
  __syncthreads();
  LDS float* mv = (LDS float*)(lds + 256);
  mod_to_lds(p, b, 5, mv);
  __syncthreads();
  f32x4 A3[4];
#pragma unroll
  for (int j = 0; j < 4; ++j) { const int k = 256 * j + 4 * lane; A3[j] = *(LDS f32x4*)(mv + k) * *(const f32x4*)(p.in[7] + k); }
  const h16* YP = (const h16*)(p.ws + WS_YP); const u32x4* ROUTE = (const u32x4*)(p.ws + WS_ROUTE); float* out = p.out;
  for (int r = bi * 8 + wave; r < SEQ; r += nbk * 8) {
    const size_t tok = (size_t)b * SEQ + r;
    const u32x4 rt = ROUTE[tok];
    const size_t r0 = (size_t)offs[rt[0]] + rt[1], r1 = (size_t)offs[rt[2]] + rt[3];
    f32x4 y[4]; float ss = 0.f;
#pragma unroll
    for (int j = 0; j < 4; ++j) {
      const h16x4 a = *(const h16x4*)(YP + r0 * DM + 256 * j + 4 * lane), c = *(const h16x4*)(YP + r1 * DM + 256 * j + 4 * lane);
#pragma unroll
      for (int e = 0; e < 4; ++e) { y[j][e] = (float)a[e] + (float)c[e]; ss += y[j][e] * y[j][e]; }
    }
    const float rs = 1.0f / sqrtf(wave_sum(ss) * (1.f / 1024.f) + 1e-6f);
#pragma unroll
    for (int j = 0; j < 4; ++j) {
      float* o = out + tok * DM + 256 * j + 4 * lane;
      const f32x4 x1 = *(const f32x4*)o;
      *(f32x4*)o = x1 + A3[j] * (y[j] * rs);
    }
  }
}

__global__ void __launch_bounds__(NTHR) fwd_kernel(Params p) {
  extern __shared__ __attribute__((aligned(16))) unsigned char smem[];
  LDS unsigned char* lds = (LDS unsigned char*)smem;
  const int lo = p.ph_lo, hi = p.ph_hi;
#define RUN_PHASE(k, fn) if (lo <= (k) && (k) < hi) { fn(*get_params(), lds); if ((k) + 1 < hi) cg::this_grid().sync(); }
  RUN_PHASE(0, phase0)
  RUN_PHASE(1, phase1)
  RUN_PHASE(2, phase2)
  RUN_PHASE(3, phase3)
  RUN_PHASE(4, phase4)
  RUN_PHASE(5, phase5)
  RUN_PHASE(6, phase6)
  RUN_PHASE(7, phase7)
  RUN_PHASE(8, phase8)
  RUN_PHASE(9, phase9)
#undef RUN_PHASE
}

extern "C" void kernel_launch(void* const* d_in, const int* in_sizes, int n_in, void* d_out, int out_size, void* d_ws, size_t ws_size, hipStream_t stream) {
  static int grid = 0;
  if (grid == 0) {
    if (n_in != 24 || out_size != NTOK * DM || ws_size < WS_END) { fprintf(stderr, "kernel_launch: unexpected problem (n_in %d out %d ws %zu)\n", n_in, out_size, ws_size); grid = -1; return; }
    (void)hipFuncSetAttribute((const void*)fwd_kernel, hipFuncAttributeMaxDynamicSharedMemorySize, LDS_BYTES);
    int dev = 0, cus = 0, per_cu = 0;
    (void)hipGetDevice(&dev);
    (void)hipDeviceGetAttribute(&cus, hipDeviceAttributeMultiprocessorCount, dev);
    (void)hipOccupancyMaxActiveBlocksPerMultiprocessor(&per_cu, (const void*)fwd_kernel, NTHR, LDS_BYTES);
    if (per_cu < 1 || cus < 256) fprintf(stderr, "kernel_launch: occupancy %d blocks/CU on %d CUs\n", per_cu, cus);
    grid = 256;
  }
  if (grid < 0) return;
  (void)hipMemsetAsync((char*)d_ws + WS_CNT, 0, CTL_ZERO_BYTES, stream);
  Params p{};
  for (int i = 0; i < 24; ++i) p.in[i] = (const float*)d_in[i];
  p.out = (float*)d_out; p.ws = (unsigned char*)d_ws;
#if N_LAUNCH_MODE == 1
  p.ph_lo = 0; p.ph_hi = NPHASE;
  void* args[] = {&p};
  hipError_t e = hipLaunchCooperativeKernel((const void*)fwd_kernel, dim3(grid), dim3(NTHR), args, LDS_BYTES, stream);
  if (e != hipSuccess) fprintf(stderr, "cooperative launch failed: %s\n", hipGetErrorString(e));
#else
  for (int ph = 0; ph < NPHASE; ++ph) {
    p.ph_lo = ph; p.ph_hi = ph + 1;
    hipLaunchKernelGGL(fwd_kernel, dim3(grid), dim3(NTHR), LDS_BYTES, stream, p);
  }
#endif
}
```

```cpp
#include <hip/hip_runtime.h>
#include <hip/hip_cooperative_groups.h>
#include <cstdio>
#include <cstdint>
namespace cg = cooperative_groups;

#ifndef N_LAUNCH_MODE
#define N_LAUNCH_MODE 1
#endif

#define DEVI __device__ __forceinline__
#define LDS __attribute__((address_space(3)))

typedef _Float16 h16;
typedef _Float16 h16x4 __attribute__((ext_vector_type(4)));
typedef _Float16 h16x8 __attribute__((ext_vector_type(8)));
typedef float f32x4 __attribute__((ext_vector_type(4)));
typedef float f32x16 __attribute__((ext_vector_type(16)));
typedef unsigned u32x2 __attribute__((ext_vector_type(2)));
typedef unsigned u32x4 __attribute__((ext_vector_type(4)));

constexpr int NBATCH = 4, SEQ = 8192, NTOK = NBATCH * SEQ, DM = 1024;
constexpr int NTHR = 512;
constexpr int NPHASE = 10;
constexpr int LDS_BYTES = 163840;

constexpr size_t MiB = 1ull << 20;
constexpr size_t WS_CNT = 0;
constexpr size_t CTL_ZERO_BYTES = 4096;
constexpr size_t WS_MODP = 64 * 1024;
constexpr size_t WS_ROPE = 1 * MiB;
constexpr size_t WS_WIN = 3 * MiB;
constexpr size_t WS_WOUT = 10 * MiB;
constexpr size_t WS_WGU = 12 * MiB;
constexpr size_t WS_WDN = 44 * MiB;
constexpr size_t WS_WRG = 60 * MiB;
constexpr size_t WS_WRT = 60 * MiB + 256 * 1024;
constexpr size_t WS_AGG = 61 * MiB;
constexpr size_t WS_ROUTE = 63 * MiB;
constexpr size_t WS_LIST = 64 * MiB;
constexpr size_t WS_LISTW = 68 * MiB;
constexpr size_t WS_WI = 72 * MiB;
constexpr size_t WS_KI = 73 * MiB;
constexpr size_t WS_MASK = 77 * MiB;
constexpr size_t WS_H = 109 * MiB;
constexpr size_t WS_Q = 173 * MiB;
constexpr size_t WS_K = 205 * MiB;
constexpr size_t WS_VT = 237 * MiB;
constexpr size_t WS_QI = 269 * MiB;
constexpr size_t WS_XR = 301 * MiB;
constexpr size_t WS_XG = 333 * MiB;
constexpr size_t WS_MIX = 365 * MiB;
constexpr size_t WS_ACT = 429 * MiB;
constexpr size_t WS_YP = 173 * MiB;
constexpr size_t WS_END = 462 * MiB;

struct Params { const float* in[24]; float* out; unsigned char* ws; int ph_lo, ph_hi; };
typedef const __attribute__((address_space(4))) Params& PRef;
typedef const __attribute__((address_space(4))) Params* PPtr;

__device__ const double ROPE_REV[32] = {
  1.59154943091895345608e-01, 1.19349370211248861917e-01, 8.94994016088910132600e-02, 6.71150830052272551196e-02,
  5.03292121044870352509e-02, 3.77415847174197710556e-02, 2.83021958306233986646e-02, 2.12236527647776604399e-02,
  1.59154943091895338669e-02, 1.19349370211248861917e-02, 8.94994016088910236684e-03, 6.71150830052272533849e-03,
  5.03292121044870369856e-03, 3.77415847174197719230e-03, 2.83021958306233986646e-03, 2.12236527647776621747e-03,
  1.59154943091895356017e-03, 1.19349370211248848907e-03, 8.94994016088910236684e-04, 6.71150830052272598901e-04,
  5.03292121044870326488e-04, 3.77415847174197740914e-04, 2.83021958306233954120e-04, 2.12236527647776605484e-04,
  1.59154943091895350596e-04, 1.19349370211248862459e-04, 8.94994016088910182474e-05, 6.71150830052272544691e-05,
  5.03292121044870353593e-05, 3.77415847174197768019e-05, 2.83021958306233960897e-05, 2.12236527647776591931e-05};

DEVI int launder(int x) { asm volatile("" : "+v"(x)); return x; }
DEVI PPtr get_params() { PPtr k = (PPtr)__builtin_amdgcn_kernarg_segment_ptr(); asm volatile("" : "+s"(k)); return k; }
DEVI int wave_id(int tid) { return __builtin_amdgcn_readfirstlane(tid >> 6); }
DEVI f32x16 mfma16(h16x8 a, h16x8 b, f32x16 c) { return __builtin_amdgcn_mfma_f32_32x32x16_f16(a, b, c, 0, 0, 0); }
DEVI float wave_sum(float v) {
#pragma unroll
  for (int o = 1; o < 64; o <<= 1) v += __shfl_xor(v, o);
  return v;
}
DEVI float sigmoid_f(float x) { return 1.f / (1.f + __expf(-x)); }
DEVI float silu_f(float x) { return x / (1.f + __expf(-x)); }
DEVI float gelu_tanh_f(float x) {
  const float u = 0.7978845608028654f * (x + 0.044715f * x * x * x);
  const float t = 1.f - 2.f / (1.f + __expf(2.f * u));
  return 0.5f * x * (1.f + t);
}
DEVI unsigned fkey(float f) { unsigned u = __float_as_uint(f); return (u & 0x80000000u) ? ~u : (u | 0x80000000u); }
DEVI float fkey_inv(unsigned k) { unsigned u = (k & 0x80000000u) ? (k & 0x7fffffffu) : ~k; return __uint_as_float(u); }
DEVI int vt_perm(int pos) { return (pos & ~12) | ((pos & 4) << 1) | ((pos & 8) >> 1); }

DEVI void mod_to_lds(PRef p, int b, int chunk, LDS float* dst) {
  const float* mp = (const float*)(p.ws + WS_MODP);
  for (int k = threadIdx.x; k < 1024; k += NTHR) {
    const int j = chunk * 1024 + k;
    float s = p.in[3][j];
#pragma unroll 1
    for (int ks = 0; ks < 8; ++ks) s += mp[(size_t)(ks * 4 + b) * 6144 + j];
    dst[k] = s;
  }
}

constexpr int LROW = 144;
constexpr int GA_BYTES = 256 * LROW, GB_BYTES = 128 * LROW, GSTAGE = GA_BYTES + GB_BYTES;

template <class AR, class EPI>
DEVI void gemm_tile(LDS unsigned char* lds, const AR& arow, const h16* Bt, int ldb, int K, EPI& epi) {
  const int tid = launder((int)threadIdx.x), lane = tid & 63, wave = wave_id(tid), wm = wave >> 1, wn = wave & 1;
  const int lr = tid >> 3, lc = tid & 7, l31 = lane & 31, half = lane >> 5;
  const h16* pa[4]; const h16* pb[2];
#pragma unroll
  for (int j = 0; j < 4; ++j) pa[j] = arow(lr + 64 * j) + lc * 8;
#pragma unroll
  for (int j = 0; j < 2; ++j) pb[j] = Bt + (size_t)(lr + 64 * j) * ldb + lc * 8;
  h16x8 ra[4], rb[2];
#pragma unroll
  for (int j = 0; j < 4; ++j) ra[j] = *(const h16x8*)pa[j];
#pragma unroll
  for (int j = 0; j < 2; ++j) rb[j] = *(const h16x8*)pb[j];
#pragma unroll
  for (int j = 0; j < 4; ++j) *(LDS h16x8*)(lds + (lr + 64 * j) * LROW + lc * 16) = ra[j];
#pragma unroll
  for (int j = 0; j < 2; ++j) *(LDS h16x8*)(lds + GA_BYTES + (lr + 64 * j) * LROW + lc * 16) = rb[j];
  __syncthreads();
  f32x16 acc[2][2];
#pragma unroll
  for (int a = 0; a < 2; ++a)
#pragma unroll
    for (int b = 0; b < 2; ++b)
#pragma unroll
      for (int r = 0; r < 16; ++r) acc[a][b][r] = 0.f;
  const int KT = K >> 6;
  for (int kt = 0; kt < KT; ++kt) {
    const int cur = kt & 1;
    if (kt + 1 < KT) {
#pragma unroll
      for (int j = 0; j < 4; ++j) ra[j] = *(const h16x8*)(pa[j] + (kt + 1) * 64);
#pragma unroll
      for (int j = 0; j < 2; ++j) rb[j] = *(const h16x8*)(pb[j] + (kt + 1) * 64);
    }
    LDS unsigned char* A = lds + cur * GSTAGE;
    LDS unsigned char* B = A + GA_BYTES;
#pragma unroll
    for (int kk = 0; kk < 4; ++kk) {
      h16x8 af[2], bf[2];
#pragma unroll
      for (int mi = 0; mi < 2; ++mi) af[mi] = *(LDS h16x8*)(A + (64 * wm + 32 * mi + l31) * LROW + (2 * kk + half) * 16);
#pragma unroll
      for (int ni = 0; ni < 2; ++ni) bf[ni] = *(LDS h16x8*)(B + (64 * wn + 32 * ni + l31) * LROW + (2 * kk + half) * 16);
#pragma unroll
      for (int mi = 0; mi < 2; ++mi)
#pragma unroll
        for (int ni = 0; ni < 2; ++ni) acc[mi][ni] = mfma16(bf[ni], af[mi], acc[mi][ni]);
    }
    if (kt + 1 < KT) {
      LDS unsigned char* A2 = lds + (cur ^ 1) * GSTAGE;
#pragma unroll
      for (int j = 0; j < 4; ++j) *(LDS h16x8*)(A2 + (lr + 64 * j) * LROW + lc * 16) = ra[j];
#pragma unroll
      for (int j = 0; j < 2; ++j) *(LDS h16x8*)(A2 + GA_BYTES + (lr + 64 * j) * LROW + lc * 16) = rb[j];
    }
    __syncthreads();
  }
  epi(acc, wm, wn, lane);
}

struct ARowPlain { const h16* base; size_t ld; DEVI const h16* operator()(int r) const { return base + (size_t)r * ld; } };
struct ARowGather { const h16* base; const unsigned* list; int n; int row0; DEVI const h16* operator()(int r) const { const int i = row0 + r; const unsigned t = (i < n) ? list[i] : 0u; return base + (size_t)t * DM; } };

DEVI h16x4 pack4(float a, float b, float c, float d) { h16x4 v; v[0] = (h16)a; v[1] = (h16)b; v[2] = (h16)c; v[3] = (h16)d; return v; }

template <class F>
DEVI void transpose_tile(const float* src, int N, int kb, int nb, h16* dst, int ldd, F drow, LDS float* tile) {
  const int tid = launder((int)threadIdx.x);
#pragma unroll
  for (int j = 0; j < 8; ++j) {
    const int kl = (tid >> 6) + 8 * j, nl = tid & 63, n = nb * 64 + nl;
    tile[kl * 65 + nl] = (n < N) ? src[(size_t)(kb * 64 + kl) * N + n] : 0.f;
  }
  __syncthreads();
  const int nl = tid >> 3, ch = tid & 7, n = nb * 64 + nl;
  if (n < N) {
    h16x8 v;
#pragma unroll
    for (int e = 0; e < 8; ++e) v[e] = (h16)tile[(ch * 8 + e) * 65 + nl];
    *(h16x8*)(dst + (size_t)drow(n) * ldd + kb * 64 + ch * 8) = v;
  }
  __syncthreads();
}

DEVI void phase0(PRef p, LDS unsigned char* lds) {
  const int tid = launder((int)threadIdx.x), lane = tid & 63, wave = wave_id(tid), G = gridDim.x;
  const int gw = blockIdx.x * 8 + wave, NW = G * 8;
  {
    const float* c = p.in[1]; const float* wada = p.in[2]; float* mp = (float*)(p.ws + WS_MODP);
    for (int u = gw; u < 96 * 8; u += NW) {
      const int cgp = u % 96, ks = u / 96, j = cgp * 64 + lane;
      float a0 = 0.f, a1 = 0.f, a2 = 0.f, a3 = 0.f;
      for (int k = ks * 128; k < ks * 128 + 128; ++k) {
        const float w = wada[(size_t)k * 6144 + j];
        a0 = fmaf(silu_f(c[k]), w, a0); a1 = fmaf(silu_f(c[1024 + k]), w, a1);
        a2 = fmaf(silu_f(c[2048 + k]), w, a2); a3 = fmaf(silu_f(c[3072 + k]), w, a3);
      }
      mp[(size_t)(ks * 4 + 0) * 6144 + j] = a0; mp[(size_t)(ks * 4 + 1) * 6144 + j] = a1;
      mp[(size_t)(ks * 4 + 2) * 6144 + j] = a2; mp[(size_t)(ks * 4 + 3) * 6144 + j] = a3;
    }
  }
  {
    LDS float* tile = (LDS float*)lds;
    constexpr int I_IN = 16 * 50, I_OUT = 16 * 16, I_G = 32 * 64, I_U = 32 * 64, I_D = 32 * 64, I_RG = 16;
    constexpr int NIT = I_IN + I_OUT + I_G + I_U + I_D + I_RG;
    for (int it = blockIdx.x; it < NIT; it += G) {
      int r = it;
      if (r < I_IN) {
        transpose_tile(p.in[8], 3144, r / 50, r % 50, (h16*)(p.ws + WS_WIN), 1024,
                       [](int n) { return n < 2112 ? n : (n < 2120 ? 3136 + (n - 2112) : (n < 2632 ? 2112 + (n - 2120) : 2624 + (n - 2632))); }, tile);
        continue;
      }
      r -= I_IN;
      if (r < I_OUT) { transpose_tile(p.in[16], 1024, r / 16, r % 16, (h16*)(p.ws + WS_WOUT), 1024, [](int n) { return n; }, tile); continue; }
      r -= I_OUT;
      if (r < I_G) { const int e = r >> 6, q = r & 63;
        transpose_tile(p.in[21] + (size_t)e * 1024 * 256, 256, q >> 2, q & 3, (h16*)(p.ws + WS_WGU) + (size_t)e * 512 * 1024, 1024, [](int f) { return (f >> 5) * 64 + (f & 31); }, tile); continue; }
      r -= I_G;
      if (r < I_U) { const int e = r >> 6, q = r & 63;
        transpose_tile(p.in[22] + (size_t)e * 1024 * 256, 256, q >> 2, q & 3, (h16*)(p.ws + WS_WGU) + (size_t)e * 512 * 1024, 1024, [](int f) { return (f >> 5) * 64 + 32 + (f & 31); }, tile); continue; }
      r -= I_U;
      if (r < I_D) { const int e = r >> 6, q = r & 63;
        transpose_tile(p.in[23] + (size_t)e * 256 * 1024, 1024, q >> 4, q & 15, (h16*)(p.ws + WS_WDN) + (size_t)e * 1024 * 256, 256, [](int n) { return n; }, tile); continue; }
      r -= I_D;
      if (r < 8) transpose_tile(p.in[11] + (size_t)r * 4096, 64, 0, 0, (h16*)(p.ws + WS_WRG) + (size_t)r * 128 * 64, 64, [](int n) { return n; }, tile);
      else transpose_tile(p.in[13] + (size_t)(r - 8) * 4096, 64, 0, 0, (h16*)(p.ws + WS_WRG) + (size_t)(r - 8) * 128 * 64, 64, [](int n) { return 64 + n; }, tile);
    }
  }
  {
    float* wrt = (float*)(p.ws + WS_WRT);
    for (int i = blockIdx.x * NTHR + tid; i < 36 * 1024; i += G * NTHR) {
      const int col = i >> 10, k = i & 1023;
      wrt[i] = (col < 4) ? p.in[17][k * 4 + col] : p.in[19][k * 32 + (col - 4)];
    }
    float* ct = (float*)(p.ws + WS_ROPE); float* st = ct + 8192 * 32;
    for (int i = blockIdx.x * NTHR + tid; i < 8192 * 32; i += G * NTHR) {
      const int pos = i >> 5, f = i & 31;
      const double rev = (double)pos * ROPE_REV[f];
      const float fr = (float)(rev - __builtin_rint(rev));
      ct[i] = __builtin_amdgcn_cosf(fr); st[i] = __builtin_amdgcn_sinf(fr);
    }
  }
}

DEVI void phase1(PRef p, LDS unsigned char* lds) {
  const int tid = launder((int)threadIdx.x), lane = tid & 63, wave = wave_id(tid), G = gridDim.x;
  const int b = blockIdx.x & 3, bi = blockIdx.x >> 2, nbk = G >> 2;
  LDS float* mv = (LDS float*)lds;
  mod_to_lds(p, b, 0, mv); mod_to_lds(p, b, 1, mv + 1024);
  __syncthreads();
  f32x4 A[4], SH[4];
#pragma unroll
  for (int j = 0; j < 4; ++j) {
    const int k = 256 * j + 4 * lane;
    const f32x4 g = *(const f32x4*)(p.in[4] + k);
    A[j] = g * (*(LDS f32x4*)(mv + 1024 + k) + 1.f);
    SH[j] = *(LDS f32x4*)(mv + k);
  }
  const float* x = p.in[0]; h16* H = (h16*)(p.ws + WS_H);
  for (int r = bi * 8 + wave; r < SEQ; r += nbk * 8) {
    const size_t tok = (size_t)b * SEQ + r;
    f32x4 v[4]; float ss = 0.f;
#pragma unroll
    for (int j = 0; j < 4; ++j) { v[j] = *(const f32x4*)(x + tok * DM + 256 * j + 4 * lane); ss += v[j][0] * v[j][0] + v[j][1] * v[j][1] + v[j][2] * v[j][2] + v[j][3] * v[j][3]; }
    const float rstd = 1.0f / sqrtf(wave_sum(ss) * (1.f / 1024.f) + 1e-6f);
#pragma unroll
    for (int j = 0; j < 4; ++j) {
      const f32x4 y = v[j] * rstd * A[j] + SH[j];
      *(h16x4*)(H + tok * DM + 256 * j + 4 * lane) = pack4(y[0], y[1], y[2], y[3]);
    }
  }
}

struct EpiInProj {
  unsigned char* ws; int mt, nt;
  DEVI void operator()(const f32x16 (&acc)[2][2], int wm, int wn, int lane) const {
    const int l31 = lane & 31, half = lane >> 5;
    const int g = 2 * nt + wn;
    const float* cosT = (const float*)(ws + WS_ROPE); const float* sinT = cosT + 8192 * 32;
#pragma unroll
    for (int mi = 0; mi < 2; ++mi) {
      const int tok = mt * 256 + 64 * wm + 32 * mi + l31;
      const int b = tok >> 13, pos = tok & 8191;
      if (g < 16 || (g >= 24 && g <= 32)) {
        float scl; h16* dst;
        if (g < 8) { scl = 0.125f * 1.4426950408889634f; dst = (h16*)(ws + WS_Q) + (size_t)tok * 512 + g * 64; }
        else if (g < 16) { scl = 1.f; dst = (h16*)(ws + WS_K) + (size_t)tok * 512 + (g - 8) * 64; }
        else if (g < 32) { scl = 0.125f; dst = (h16*)(ws + WS_QI) + (size_t)tok * 512 + (g - 24) * 64; }
        else { scl = 1.f; dst = (h16*)(ws + WS_KI) + (size_t)tok * 64; }
#pragma unroll
        for (int q = 0; q < 4; ++q) {
          const int d0 = 8 * q + 4 * half;
          const f32x4 c = *(const f32x4*)(cosT + pos * 32 + d0), s = *(const f32x4*)(sinT + pos * 32 + d0);
          float o1[4], o2[4];
#pragma unroll
          for (int e = 0; e < 4; ++e) {
            const float x1 = acc[mi][0][4 * q + e], x2 = acc[mi][1][4 * q + e];
            o1[e] = (x1 * c[e] - x2 * s[e]) * scl; o2[e] = (x2 * c[e] + x1 * s[e]) * scl;
          }
          *(h16x4*)(dst + d0) = pack4(o1[0], o1[1], o1[2], o1[3]);
          *(h16x4*)(dst + 32 + d0) = pack4(o2[0], o2[1], o2[2], o2[3]);
        }
      } else if (g < 24) {
        h16* vt = (h16*)(ws + WS_VT) + (size_t)(b * 8 + (g - 16)) * 64 * 8192 + vt_perm(pos);
#pragma unroll
        for (int ni = 0; ni < 2; ++ni)
#pragma unroll
          for (int r = 0; r < 16; ++r) { const int d = 32 * ni + 8 * (r >> 2) + 4 * half + (r & 3); vt[(size_t)d * 8192] = (h16)acc[mi][ni][r]; }
      } else if (g < 49) {
        h16* dst = (g < 41) ? (h16*)(ws + WS_XR) + (size_t)tok * 512 + (g - 33) * 64 : (h16*)(ws + WS_XG) + (size_t)tok * 512 + (g - 41) * 64;
#pragma unroll
        for (int ni = 0; ni < 2; ++ni)
#pragma unroll
          for (int q = 0; q < 4; ++q)
            *(h16x4*)(dst + 32 * ni + 8 * q + 4 * half) = pack4(acc[mi][ni][4 * q], acc[mi][ni][4 * q + 1], acc[mi][ni][4 * q + 2], acc[mi][ni][4 * q + 3]);
      } else {
        const float sc = 0.35355339059327373f;
        f32x4 v; v[0] = acc[mi][0][0] * sc; v[1] = acc[mi][0][1] * sc; v[2] = acc[mi][0][2] * sc; v[3] = acc[mi][0][3] * sc;
        *(f32x4*)((float*)(ws + WS_WI) + (size_t)tok * 8 + 4 * half) = v;
      }
    }
  }
};

DEVI void phase2(PRef p, LDS unsigned char* lds) {
  const int G = gridDim.x;
  const h16* H = (const h16*)(p.ws + WS_H); const h16* W = (const h16*)(p.ws + WS_WIN);
  for (int it = blockIdx.x; it < 128 * 25; it += G) {
    const int mt = it / 25, nt = it % 25;
    ARowPlain ar{H + (size_t)mt * 256 * DM, (size_t)DM};
    EpiInProj epi{p.ws, mt, nt};
    gemm_tile(lds, ar, W + (size_t)nt * 128 * DM, DM, DM, epi);
  }
}

constexpr int CROW = 1040;
constexpr int RNN_XG = 64 * CROW;
template <int MODE>
DEVI void rnn_item(PRef p, LDS unsigned char* lds, int b, int cr) {
  const int tid = launder((int)threadIdx.x), lane = tid & 63, wave = wave_id(tid), l31 = lane & 31, half = lane >> 5;
  const h16* XR = (const h16*)(p.ws + WS_XR);
  {
    const int chg = tid & 63, tg = tid >> 6, pos0 = cr * 64 + 8 * tg;
    h16x8 xin[11];
#pragma unroll
    for (int i = 0; i < 11; ++i) {
      const int pos = pos0 + i - 3;
      if (pos >= 0) xin[i] = *(const h16x8*)(XR + ((size_t)b * SEQ + pos) * 512 + chg * 8);
      else {
#pragma unroll
        for (int e = 0; e < 8; ++e) xin[i][e] = (h16)0.f;
      }
    }
    float cw[4][8], cb[8];
#pragma unroll
    for (int e = 0; e < 8; ++e) {
      cb[e] = p.in[10][chg * 8 + e];
#pragma unroll
      for (int j = 0; j < 4; ++j) cw[j][e] = p.in[9][j * 512 + chg * 8 + e];
    }
#pragma unroll
    for (int tt = 0; tt < 8; ++tt) {
      h16x8 o;
#pragma unroll
      for (int e = 0; e < 8; ++e) {
        float v = cb[e];
#pragma unroll
        for (int j = 0; j < 4; ++j) v = fmaf(cw[j][e], (float)xin[tt + j][e], v);
        o[e] = (h16)v;
      }
      *(LDS h16x8*)(lds + (8 * tg + tt) * CROW + chg * 16) = o;
    }
  }
  if (MODE == 1) {
    const h16* XG = (const h16*)(p.ws + WS_XG) + ((size_t)b * SEQ + cr * 64) * 512;
#pragma unroll
    for (int i = 0; i < 8; ++i) { const int c = tid + NTHR * i, row = c >> 6, cc = c & 63; *(LDS h16x8*)(lds + RNN_XG + row * CROW + cc * 16) = *(const h16x8*)(XG + (size_t)row * 512 + cc * 8); }
  }
  __syncthreads();
  const int n = wave;
  const h16* WRG = (const h16*)(p.ws + WS_WRG) + (size_t)n * 128 * 64;
  float* AGG = (float*)(p.ws + WS_AGG);
#pragma unroll 1
  for (int dt = 0; dt < 2; ++dt) {
    h16x8 wa[4], wx[4];
#pragma unroll
    for (int kk = 0; kk < 4; ++kk) {
      wa[kk] = *(const h16x8*)(WRG + (size_t)(32 * dt + l31) * 64 + 16 * kk + 8 * half);
      wx[kk] = *(const h16x8*)(WRG + (size_t)(64 + 32 * dt + l31) * 64 + 16 * kk + 8 * half);
    }
    f32x16 ra[2], rx[2];
#pragma unroll
    for (int ti = 0; ti < 2; ++ti) {
#pragma unroll
      for (int r = 0; r < 16; ++r) { ra[ti][r] = 0.f; rx[ti][r] = 0.f; }
#pragma unroll
      for (int kk = 0; kk < 4; ++kk) {
        const h16x8 af = *(LDS h16x8*)(lds + (32 * ti + l31) * CROW + (n * 64 + 16 * kk + 8 * half) * 2);
        ra[ti] = mfma16(af, wa[kk], ra[ti]);
        rx[ti] = mfma16(af, wx[kk], rx[ti]);
      }
    }
    const int ch = n * 64 + 32 * dt + l31;
    const float ba = p.in[12][ch], bx = p.in[14][ch], lam = p.in[15][ch];
    const float c8 = -8.f * log1pf(__expf(-lam));
#pragma unroll
    for (int ti = 0; ti < 2; ++ti)
#pragma unroll
      for (int r = 0; r < 16; ++r) {
        const int tk = 32 * ti + (r & 3) + 8 * (r >> 2) + 4 * half;
        const float cv = (float)*(LDS h16*)(lds + tk * CROW + ch * 2);
        const float rr = sigmoid_f(ra[ti][r] + ba), ii = sigmoid_f(rx[ti][r] + bx);
        const float la = c8 * rr;
        ra[ti][r] = __expf(la);
        rx[ti][r] = sqrtf(-expm1f(2.f * la)) * (ii * cv);
      }
    float P[8], Hs[8];
#pragma unroll
    for (int sg = 0; sg < 8; ++sg) {
      const int ti = sg >> 2, q = sg & 3;
      float pp = 1.f, hh = 0.f;
#pragma unroll
      for (int i = 0; i < 4; ++i) { const float a = ra[ti][4 * q + i], bb = rx[ti][4 * q + i]; hh = fmaf(a, hh, bb); pp *= a; }
      P[sg] = pp; Hs[sg] = hh;
    }
    float carry = 0.f, prod = 1.f;
    if (MODE == 1) {
      for (int c2 = 0; c2 < cr; ++c2) {
        const float* ag = AGG + ((size_t)(b * 128 + c2) * 512 + ch) * 2;
        carry = fmaf(ag[0], carry, ag[1]);
      }
    }
    float cin[8];
#pragma unroll
    for (int sg = 0; sg < 8; ++sg)
#pragma unroll
      for (int ow = 0; ow < 2; ++ow) {
        const float tmp = fmaf(P[sg], carry, Hs[sg]);
        const float tp = P[sg] * prod;
        if (half == ow) cin[sg] = carry;
        const float oth = __shfl_xor(tmp, 32), otp = __shfl_xor(tp, 32);
        carry = (half == ow) ? tmp : oth;
        prod = (half == ow) ? tp : otp;
      }
    if (MODE == 0) {
      if (half == 0) { float* ag = AGG + ((size_t)(b * 128 + cr) * 512 + ch) * 2; ag[0] = prod; ag[1] = carry; }
    } else {
#pragma unroll
      for (int sg = 0; sg < 8; ++sg) {
        const int ti = sg >> 2, q = sg & 3;
        float hh = cin[sg];
#pragma unroll
        for (int i = 0; i < 4; ++i) {
          hh = fmaf(ra[ti][4 * q + i], hh, rx[ti][4 * q + i]);
          LDS h16* xp = (LDS h16*)(lds + RNN_XG + (32 * ti + 8 * q + 4 * half + i) * CROW + ch * 2);
          *xp = (h16)(hh * gelu_tanh_f((float)*xp));
        }
      }
    }
  }
  __syncthreads();
  if (MODE == 1) {
    h16* Y = (h16*)(p.ws + WS_H) + ((size_t)b * SEQ + cr * 64) * DM + 512;
#pragma unroll
    for (int i = 0; i < 8; ++i) { const int c = tid + NTHR * i, row = c >> 6, cc = c & 63; *(h16x8*)(Y + (size_t)row * DM + cc * 8) = *(LDS h16x8*)(lds + RNN_XG + row * CROW + cc * 16); }
    __syncthreads();
  }
}

constexpr int IDX_NB = 256, IDX_CAP = 128;
constexpr int IL_HIST = 0, IL_CS = 65536, IL_CK = IL_CS + 64 * IDX_CAP * 4, IL_KI = IL_CK + 64 * IDX_CAP * 2, IL_KISZ = 128 * LROW, IL_ST = IL_KI + 2 * IL_KISZ;
static_assert(IL_ST + 4096 <= LDS_BYTES, "indexer LDS map");

DEVI f32x4 mfma16s(h16x8 a, h16x8 b, f32x4 c) { return __builtin_amdgcn_mfma_f32_16x16x32_f16(a, b, c, 0, 0, 0); }
DEVI void idx_score(LDS unsigned char* kit, int kh, int l15, int g4, const h16x8 (&qf)[8][2], const float (&wq)[8], f32x4 (&sc)[4]) {
  h16x8 kf[4][2];
#pragma unroll
  for (int kt = 0; kt < 4; ++kt)
#pragma unroll
    for (int ks = 0; ks < 2; ++ks) kf[kt][ks] = *(LDS h16x8*)(kit + (64 * kh + 16 * kt + l15) * LROW + (4 * ks + g4) * 16);
#pragma unroll
  for (int kt = 0; kt < 4; ++kt) sc[kt] = (f32x4){0.f, 0.f, 0.f, 0.f};
#pragma unroll
  for (int h = 0; h < 8; ++h) {
#pragma unroll
    for (int kt = 0; kt < 4; ++kt) {
      f32x4 acc = (f32x4){0.f, 0.f, 0.f, 0.f};
      acc = mfma16s(kf[kt][0], qf[h][0], acc);
      acc = mfma16s(kf[kt][1], qf[h][1], acc);
#pragma unroll
      for (int r = 0; r < 4; ++r) sc[kt][r] = __builtin_fmaf(wq[h], __builtin_fmaxf(acc[r], 0.f), sc[kt][r]);
    }
    if (h & 1) __builtin_amdgcn_sched_barrier(0);
  }
}

template <int MODE>
DEVI void idx_pass(LDS unsigned char* lds, const h16* KIb, int N, int stride, int qg, int kh,
                   const h16* QIrow0, const float* WIrow0, float qinv, float qoff, int bstar) {
  const int tid = launder((int)threadIdx.x), lane = tid & 63, l15 = lane & 15, g4 = lane >> 4;
  const int q = 16 * qg + l15;
  h16x8 qf[8][2]; float wq[8];
  {
    const h16* QI = QIrow0 + (size_t)q * 512;
#pragma unroll
    for (int h = 0; h < 8; ++h)
#pragma unroll
      for (int ks = 0; ks < 2; ++ks) qf[h][ks] = *(const h16x8*)(QI + h * 64 + 32 * ks + 8 * g4);
    const float* WI = WIrow0 + (size_t)q * 8;
#pragma unroll
    for (int h = 0; h < 8; ++h) wq[h] = WI[h];
  }
  LDS unsigned* hist = (LDS unsigned*)(lds + IL_HIST);
  LDS unsigned* st = (LDS unsigned*)(lds + IL_ST);
  const int nst = (N + 127) >> 7;
  const int lr = tid >> 3, lc = tid & 7;
  h16x8 r0, r1;
  r0 = *(const h16x8*)(KIb + (size_t)lr * 64 + lc * 8); r1 = *(const h16x8*)(KIb + (size_t)(lr + 64) * 64 + lc * 8);
  *(LDS h16x8*)(lds + IL_KI + lr * LROW + lc * 16) = r0; *(LDS h16x8*)(lds + IL_KI + (lr + 64) * LROW + lc * 16) = r1;
  __syncthreads();
  float vmin = INFINITY, vmax = -INFINITY;
  int cur = 0;
  for (int s = 0; s < nst; s += stride) {
    const int nx = s + stride;
    if (nx < nst) { r0 = *(const h16x8*)(KIb + (size_t)(128 * nx + lr) * 64 + lc * 8); r1 = *(const h16x8*)(KIb + (size_t)(128 * nx + lr + 64) * 64 + lc * 8); }
    if (128 * s + 64 * kh < N) {
      f32x4 sc[4];
      idx_score(lds + IL_KI + cur * IL_KISZ, kh, l15, g4, qf, wq, sc);
      if (MODE == 0) {
#pragma unroll
        for (int kt = 0; kt < 4; ++kt)
#pragma unroll
          for (int r = 0; r < 4; ++r) { vmin = fminf(vmin, sc[kt][r]); vmax = fmaxf(vmax, sc[kt][r]); }
      } else if (MODE == 1) {
#pragma unroll
        for (int kt = 0; kt < 4; ++kt)
#pragma unroll
          for (int r = 0; r < 4; ++r) {
            const float xb = fminf(fmaxf(__builtin_fmaf(sc[kt][r], qinv, qoff), 0.f), (float)(IDX_NB - 1));
            const int bin = (int)xb;
            __hip_atomic_fetch_add(&hist[bin * 64 + q], 1u, __ATOMIC_RELAXED, __HIP_MEMORY_SCOPE_WORKGROUP);
          }
      } else {
        unsigned nib = 0u;
#pragma unroll
        for (int kt = 0; kt < 4; ++kt)
#pragma unroll
          for (int r = 0; r < 4; ++r) {
            const float xb = fminf(fmaxf(__builtin_fmaf(sc[kt][r], qinv, qoff), 0.f), (float)(IDX_NB - 1));
            const int bin = (int)xb;
            if (bin > bstar) nib |= (1u << (4 * kt + r));
            else if (bin == bstar) {
              const unsigned pos = __hip_atomic_fetch_add(&st[128 + q], 1u, __ATOMIC_RELAXED, __HIP_MEMORY_SCOPE_WORKGROUP);
              if (pos < (unsigned)IDX_CAP) {
                ((LDS float*)(lds + IL_CS))[q * IDX_CAP + pos] = sc[kt][r];
                ((LDS unsigned short*)(lds + IL_CK))[q * IDX_CAP + pos] = (unsigned short)(128 * s + 64 * kh + 16 * kt + 4 * g4 + r);
              }
            }
          }
        const unsigned oth = (unsigned)__shfl_xor((int)nib, 32);
        if (lane < 32) {
#pragma unroll
          for (int T = 0; T < 2; ++T) {
            const unsigned b0 = ((nib >> (8 * T)) & 15u) | (((oth >> (8 * T)) & 15u) << 4);
            const unsigned b1 = ((nib >> (8 * T + 4)) & 15u) | (((oth >> (8 * T + 4)) & 15u) << 4);
            ((LDS unsigned short*)(lds + IL_HIST))[q * 512 + (4 * s + 2 * kh + T) * 2 + (g4 & 1)] = (unsigned short)(b0 | (b1 << 8));
          }
        }
      }
    }
    if (nx < nst) {
      *(LDS h16x8*)(lds + IL_KI + (cur ^ 1) * IL_KISZ + lr * LROW + lc * 16) = r0;
      *(LDS h16x8*)(lds + IL_KI + (cur ^ 1) * IL_KISZ + (lr + 64) * LROW + lc * 16) = r1;
    }
    __syncthreads();
    cur ^= 1;
  }
  if (MODE == 0) {
    __hip_atomic_fetch_min(&st[q], fkey(vmin), __ATOMIC_RELAXED, __HIP_MEMORY_SCOPE_WORKGROUP);
    __hip_atomic_fetch_max(&st[64 + q], fkey(vmax), __ATOMIC_RELAXED, __HIP_MEMORY_SCOPE_WORKGROUP);
  }
}

DEVI void idx_item(PRef p, LDS unsigned char* lds, int b, int c) {
  const int tid = launder((int)threadIdx.x), lane = tid & 63, wave = wave_id(tid), l31 = lane & 31, half = lane >> 5;
  const int N = 64 * (c + 1);
  unsigned* MASK = (unsigned*)(p.ws + WS_MASK) + ((size_t)b * SEQ + 64 * c) * 256;
  if (N <= 256) {
    const int wpr = N >> 5;
    for (int i = tid; i < 64 * wpr; i += NTHR) MASK[(size_t)(i / wpr) * 256 + (i % wpr)] = 0xFFFFFFFFu;
    return;
  }
  const int qg = wave & 3, kh = wave >> 2, l15 = lane & 15, q = 16 * qg + l15;
  const h16* QIrow0 = (const h16*)(p.ws + WS_QI) + ((size_t)b * SEQ + 64 * c) * 512;
  const float* WIrow0 = (const float*)(p.ws + WS_WI) + ((size_t)b * SEQ + 64 * c) * 8;
  const h16* KIb = (const h16*)(p.ws + WS_KI) + (size_t)b * SEQ * 64;
  LDS unsigned* st = (LDS unsigned*)(lds + IL_ST);
  LDS float* stf = (LDS float*)(lds + IL_ST);
  if (tid < 64) { st[tid] = 0xFFFFFFFFu; st[64 + tid] = 0u; st[128 + tid] = 0u; }
  __syncthreads();
  const int nst = (N + 127) >> 7;
  const int stride = nst >= 16 ? 8 : (nst >= 8 ? 4 : (nst >= 4 ? 2 : 1));
  idx_pass<0>(lds, KIb, N, stride, qg, kh, QIrow0, WIrow0, 0.f, 0.f, 0);
  __syncthreads();
  if (tid < 64) {
    const float lo = fkey_inv(st[tid]), hi = fkey_inv(st[64 + tid]);
    float d = hi - lo; if (!(d > 1e-20f)) d = 1.f;
    const float inv = (float)IDX_NB / (1.5f * d);
    stf[192 + tid] = inv; stf[256 + tid] = -(lo - 0.25f * d) * inv;
  }
  for (int i = tid; i < 16384; i += NTHR) ((LDS unsigned*)(lds + IL_HIST))[i] = 0u;
  __syncthreads();
  const float qinv = stf[192 + q], qoff = stf[256 + q];
  idx_pass<1>(lds, KIb, N, 1, qg, kh, QIrow0, WIrow0, qinv, qoff, 0);
  if (tid < 64) {
    LDS unsigned* hist = (LDS unsigned*)(lds + IL_HIST);
    unsigned cum = 0u; int bs = 0; unsigned need = 256u;
    for (int bb = IDX_NB - 1; bb >= 0; --bb) {
      const unsigned hcount = hist[bb * 64 + tid];
      if (cum + hcount >= 256u) { bs = bb; need = 256u - cum; break; }
      cum += hcount;
    }
    st[320 + tid] = (unsigned)bs; st[384 + tid] = need;
  }
  __syncthreads();
  const int bstar = (int)st[320 + q];
  __syncthreads();
  idx_pass<2>(lds, KIb, N, 1, qg, kh, QIrow0, WIrow0, qinv, qoff, bstar);
  for (int qq = wave; qq < 64; qq += 8) {
    const int nc = min((int)st[128 + qq], IDX_CAP); const unsigned need = st[384 + qq];
    LDS float* cs = (LDS float*)(lds + IL_CS) + qq * IDX_CAP; LDS unsigned short* ck = (LDS unsigned short*)(lds + IL_CK) + qq * IDX_CAP;
    for (int i = lane; i < nc; i += 64) {
      const float sv = cs[i]; const unsigned kv = ck[i];
      unsigned rank = 0u;
      for (int j = 0; j < nc; ++j) { const float sj = cs[j]; const unsigned kj = ck[j]; rank += (sj > sv || (sj == sv && kj < kv)) ? 1u : 0u; }
      if (rank < need) {
        const unsigned kl = kv & 31u;
        const unsigned bit = 16u * ((kl >> 2) & 1u) + (kl & 3u) + 4u * (kl >> 3);
        __hip_atomic_fetch_or((LDS unsigned*)(lds + IL_HIST) + qq * 256 + (kv >> 5), 1u << bit, __ATOMIC_RELAXED, __HIP_MEMORY_SCOPE_WORKGROUP);
      }
    }
  }
  __syncthreads();
  {
    const int cpr = N >> 6;
    for (int i = tid; i < 64 * cpr; i += NTHR) {
      const int row = i / cpr, cc = i % cpr;
      *(u32x2*)(MASK + (size_t)row * 256 + 2 * cc) = *(LDS u32x2*)(lds + IL_HIST + row * 1024 + cc * 8);
    }
  }
  __syncthreads();
}

DEVI void phase3(PRef p, LDS unsigned char* lds) {
  const int G = gridDim.x;
  for (int it = blockIdx.x; it < 512; it += G) rnn_item<0>(p, lds, it >> 7, it & 127);
  for (int it = blockIdx.x; it < 256; it += G) {
    const int b = it >> 6, j = it & 63;
#pragma unroll 1
    for (int w2 = 0; w2 < 2; ++w2) idx_item(p, lds, b, w2 ? j : 127 - j);
  }
}

constexpr int AT_BUF = 2 * 64 * LROW;
DEVI void attn_unit(PRef p, LDS unsigned char* lds, int b, int head, int qb) {
  const int tid = launder((int)threadIdx.x), lane = tid & 63, wave = wave_id(tid), l31 = lane & 31, half = lane >> 5;
  const int q0 = qb * 256 + wave * 32, cw = q0 >> 6, NT = 4 * (qb + 1);
  const size_t tok = (size_t)b * SEQ + q0 + l31;
  h16x8 qf[4];
  {
    const h16* Q = (const h16*)(p.ws + WS_Q) + tok * 512 + head * 64;
#pragma unroll
    for (int kk = 0; kk < 4; ++kk) qf[kk] = *(const h16x8*)(Q + 16 * kk + 8 * half);
  }
  const unsigned* mrow = (const unsigned*)(p.ws + WS_MASK) + tok * 256;
  const int lr = tid >> 3, lc = tid & 7;
  const h16* kp = (const h16*)(p.ws + WS_K) + ((size_t)b * SEQ + lr) * 512 + head * 64 + lc * 8;
  const h16* vp = (const h16*)(p.ws + WS_VT) + ((size_t)(b * 8 + head) * 64 + lr) * 8192 + lc * 8;
  h16x8 rk = *(const h16x8*)kp, rv = *(const h16x8*)vp;
  *(LDS h16x8*)(lds + lr * LROW + lc * 16) = rk; *(LDS h16x8*)(lds + 64 * LROW + lr * LROW + lc * 16) = rv;
  __syncthreads();
  f32x16 o[2];
#pragma unroll
  for (int r = 0; r < 16; ++r) { o[0][r] = 0.f; o[1][r] = 0.f; }
  float m = -INFINITY, l = 0.f;
  for (int jt = 0; jt < NT; ++jt) {
    const int cur = jt & 1;
    if (jt + 1 < NT) { rk = *(const h16x8*)(kp + (size_t)(jt + 1) * 64 * 512); rv = *(const h16x8*)(vp + (jt + 1) * 64); }
    if (jt <= cw) {
      LDS unsigned char* Kt = lds + cur * AT_BUF; LDS unsigned char* Vt = Kt + 64 * LROW;
      const u32x2 mw = *(const u32x2*)(mrow + 2 * jt);
      f32x16 s[2];
#pragma unroll
      for (int ri = 0; ri < 2; ++ri) {
#pragma unroll
        for (int r = 0; r < 16; ++r) s[ri][r] = 0.f;
#pragma unroll
        for (int kk = 0; kk < 4; ++kk) {
          const h16x8 kf = *(LDS h16x8*)(Kt + (32 * ri + l31) * LROW + (2 * kk + half) * 16);
          s[ri] = mfma16(kf, qf[kk], s[ri]);
        }
      }
      const unsigned m0 = (mw[0] >> (16 * half)) & 0xFFFFu, m1 = (mw[1] >> (16 * half)) & 0xFFFFu;
      float mx = -INFINITY;
#pragma unroll
      for (int r = 0; r < 16; ++r) {
        s[0][r] = ((m0 >> r) & 1u) ? s[0][r] : -INFINITY;
        s[1][r] = ((m1 >> r) & 1u) ? s[1][r] : -INFINITY;
        mx = fmaxf(mx, fmaxf(s[0][r], s[1][r]));
      }
      mx = fmaxf(mx, __shfl_xor(mx, 32));
      const float mnew = fmaxf(m, mx);
      const float muse = (mnew == -INFINITY) ? 0.f : mnew;
      const float alpha = __builtin_amdgcn_exp2f(m - muse);
      float ls = 0.f;
#pragma unroll
      for (int r = 0; r < 16; ++r) {
        s[0][r] = __builtin_amdgcn_exp2f(s[0][r] - muse); s[1][r] = __builtin_amdgcn_exp2f(s[1][r] - muse);
        ls += s[0][r] + s[1][r];
      }
      l = l * alpha + ls; m = mnew;
#pragma unroll
      for (int r = 0; r < 16; ++r) { o[0][r] *= alpha; o[1][r] *= alpha; }
      h16x8 pf[4];
#pragma unroll
      for (int s4 = 0; s4 < 4; ++s4)
#pragma unroll
        for (int e = 0; e < 8; ++e) pf[s4][e] = (h16)s[s4 >> 1][8 * (s4 & 1) + e];
#pragma unroll
      for (int di = 0; di < 2; ++di)
#pragma unroll
        for (int s4 = 0; s4 < 4; ++s4) {
          const h16x8 vf = *(LDS h16x8*)(Vt + (32 * di + l31) * LROW + (2 * s4 + half) * 16);
          o[di] = mfma16(vf, pf[s4], o[di]);
        }
    }
    if (jt + 1 < NT) {
      *(LDS h16x8*)(lds + (cur ^ 1) * AT_BUF + lr * LROW + lc * 16) = rk;
      *(LDS h16x8*)(lds + (cur ^ 1) * AT_BUF + 64 * LROW + lr * LROW + lc * 16) = rv;
    }
    __syncthreads();
  }
  const float inv = 1.f / (l + __shfl_xor(l, 32));
  h16* Y = (h16*)(p.ws + WS_H) + tok * DM + head * 64;
#pragma unroll
  for (int di = 0; di < 2; ++di)
#pragma unroll
    for (int q = 0; q < 4; ++q)
      *(h16x4*)(Y + 32 * di + 8 * q + 4 * half) = pack4(o[di][4 * q] * inv, o[di][4 * q + 1] * inv, o[di][4 * q + 2] * inv, o[di][4 * q + 3] * inv);
}

DEVI void phase4(PRef p, LDS unsigned char* lds) {
  const int G = gridDim.x;
  for (int it = blockIdx.x; it < 512; it += G) rnn_item<1>(p, lds, it >> 7, it & 127);
  for (int it = blockIdx.x; it < 512; it += G) {
    const int bh = it >> 4, j = it & 15;
#pragma unroll 1
    for (int w2 = 0; w2 < 2; ++w2) attn_unit(p, lds, bh >> 3, bh & 7, w2 ? j : 31 - j);
  }
}

struct EpiPlain {
  h16* dst; int ld; int row0, col0, nvalid;
  DEVI void operator()(const f32x16 (&acc)[2][2], int wm, int wn, int lane) const {
    const int l31 = lane & 31, half = lane >> 5;
#pragma unroll
    for (int mi = 0; mi < 2; ++mi) {
      const int r = 64 * wm + 32 * mi + l31;
      if (r < nvalid) {
        h16* d = dst + (size_t)(row0 + r) * ld + col0 + 64 * wn;
#pragma unroll
        for (int ni = 0; ni < 2; ++ni)
#pragma unroll
          for (int q = 0; q < 4; ++q)
            *(h16x4*)(d + 32 * ni + 8 * q + 4 * half) = pack4(acc[mi][ni][4 * q], acc[mi][ni][4 * q + 1], acc[mi][ni][4 * q + 2], acc[mi][ni][4 * q + 3]);
      }
    }
  }
};
DEVI void phase5(PRef p, LDS unsigned char* lds) {
  const int G = gridDim.x;
  const h16* Y = (const h16*)(p.ws + WS_H); const h16* W = (const h16*)(p.ws + WS_WOUT);
  for (int it = blockIdx.x; it < 128 * 8; it += G) {
    const int mt = it >> 3, nt = it & 7;
    ARowPlain ar{Y + (size_t)mt * 256 * DM, (size_t)DM};
    EpiPlain epi{(h16*)(p.ws + WS_MIX), DM, mt * 256, nt * 128, 256};
    gemm_tile(lds, ar, W + (size_t)nt * 128 * DM, DM, DM, epi);
  }
}

constexpr int P6_WRT = 0, P6_MOD = 36 * 1024 * 4, P6_LG = P6_MOD + 3 * 4096;
static_assert(P6_LG + 8 * 72 * 4 <= LDS_BYTES, "phase 6 LDS map");
DEVI void phase6(PRef p, LDS unsigned char* lds) {
  const int tid = launder((int)threadIdx.x), lane = tid & 63, wave = wave_id(tid), G = gridDim.x;
  const int b = blockIdx.x & 3, bi = blockIdx.x >> 2, nbk = G >> 2;
  LDS float* wrt = (LDS float*)(lds + P6_WRT);
  LDS float* mv = (LDS float*)(lds + P6_MOD);
  LDS float* lgw = (LDS float*)(lds + P6_LG) + wave * 72;
  {
    const f32x4* src = (const f32x4*)(p.ws + WS_WRT);
    for (int i = tid; i < 36 * 256; i += NTHR) ((LDS f32x4*)wrt)[i] = src[i];
  }
  mod_to_lds(p, b, 2, mv); mod_to_lds(p, b, 3, mv + 1024); mod_to_lds(p, b, 4, mv + 2048);
  __syncthreads();
  f32x4 A1[4], A2[4], SH2[4];
#pragma unroll
  for (int j = 0; j < 4; ++j) {
    const int k = 256 * j + 4 * lane;
    A1[j] = *(LDS f32x4*)(mv + k) * *(const f32x4*)(p.in[5] + k);
    A2[j] = *(const f32x4*)(p.in[6] + k) * (*(LDS f32x4*)(mv + 2048 + k) + 1.f);
    SH2[j] = *(LDS f32x4*)(mv + 1024 + k);
  }
  const float* x = p.in[0]; const h16* MIX = (const h16*)(p.ws + WS_MIX); float* X1 = p.out; h16* H2 = (h16*)(p.ws + WS_H);
  unsigned* cnt = (unsigned*)(p.ws + WS_CNT); unsigned* LIST = (unsigned*)(p.ws + WS_LIST); float* LISTW = (float*)(p.ws + WS_LISTW);
  u32x4* ROUTE = (u32x4*)(p.ws + WS_ROUTE);
  for (int pr = bi * 8 + wave; pr < SEQ / 2; pr += nbk * 8) {
    f32x4 h2[2][4];
#pragma unroll
    for (int tt = 0; tt < 2; ++tt) {
      const size_t tok = (size_t)b * SEQ + 2 * pr + tt;
      f32x4 xv[4], mx[4]; float ssm = 0.f;
#pragma unroll
      for (int j = 0; j < 4; ++j) {
        xv[j] = *(const f32x4*)(x + tok * DM + 256 * j + 4 * lane);
        const h16x4 mh = *(const h16x4*)(MIX + tok * DM + 256 * j + 4 * lane);
#pragma unroll
        for (int e = 0; e < 4; ++e) { mx[j][e] = (float)mh[e]; ssm += mx[j][e] * mx[j][e]; }
      }
      const float rsm = 1.0f / sqrtf(wave_sum(ssm) * (1.f / 1024.f) + 1e-6f);
      float ss1 = 0.f;
#pragma unroll
      for (int j = 0; j < 4; ++j) {
        xv[j] = xv[j] + A1[j] * (mx[j] * rsm);
        *(f32x4*)(X1 + tok * DM + 256 * j + 4 * lane) = xv[j];
        ss1 += xv[j][0] * xv[j][0] + xv[j][1] * xv[j][1] + xv[j][2] * xv[j][2] + xv[j][3] * xv[j][3];
      }
      const float rs1 = 1.0f / sqrtf(wave_sum(ss1) * (1.f / 1024.f) + 1e-6f);
#pragma unroll
      for (int j = 0; j < 4; ++j) {
        h2[tt][j] = xv[j] * rs1 * A2[j] + SH2[j];
        *(h16x4*)(H2 + tok * DM + 256 * j + 4 * lane) = pack4(h2[tt][j][0], h2[tt][j][1], h2[tt][j][2], h2[tt][j][3]);
      }
    }
#pragma unroll 1
    for (int col = 0; col < 36; ++col) {
      float a0 = 0.f, a1 = 0.f;
#pragma unroll
      for (int j = 0; j < 4; ++j) {
        const f32x4 w = *(LDS f32x4*)(wrt + col * 1024 + 256 * j + 4 * lane);
#pragma unroll
        for (int e = 0; e < 4; ++e) { a0 = fmaf(h2[0][j][e], w[e], a0); a1 = fmaf(h2[1][j][e], w[e], a1); }
      }
      a0 = wave_sum(a0); a1 = wave_sum(a1);
      if (lane == 0) { lgw[col] = a0; lgw[36 + col] = a1; }
    }
    if (lane < 2) {
      const int tt = lane;
      const unsigned tok = (unsigned)(b * SEQ + 2 * pr + tt);
      LDS float* lg = lgw + 36 * tt;
      int gi = 0; float gm = lg[0] + p.in[18][0];
      float gl[4];
#pragma unroll
      for (int g = 0; g < 4; ++g) gl[g] = lg[g] + p.in[18][g];
#pragma unroll
      for (int g = 1; g < 4; ++g) if (gl[g] > gm) { gm = gl[g]; gi = g; }
      float gs = 0.f;
#pragma unroll
      for (int g = 0; g < 4; ++g) gs += __expf(gl[g] - gm);
      const float pg = 1.f / gs;
      int e1 = 0, e2 = 0; float l1 = -INFINITY, l2 = -INFINITY;
#pragma unroll 1
      for (int e = 0; e < 8; ++e) {
        const float v = lg[4 + 8 * gi + e] + p.in[20][8 * gi + e];
        if (v > l1) { l2 = l1; e2 = e1; l1 = v; e1 = e; }
        else if (v > l2) { l2 = v; e2 = e; }
      }
      const float x2 = __expf(l2 - l1);
      const float w1 = pg / (1.f + x2), w2 = pg * x2 / (1.f + x2);
      const unsigned E1 = (unsigned)(gi * 8 + e1), E2 = (unsigned)(gi * 8 + e2);
      const unsigned p1 = atomicAdd(&cnt[E1], 1u), p2 = atomicAdd(&cnt[E2], 1u);
      LIST[(size_t)E1 * 32768 + p1] = tok; LISTW[(size_t)E1 * 32768 + p1] = w1;
      LIST[(size_t)E2 * 32768 + p2] = tok; LISTW[(size_t)E2 * 32768 + p2] = w2;
      u32x4 rt; rt[0] = E1; rt[1] = p1; rt[2] = E2; rt[3] = p2;
      ROUTE[tok] = rt;
    }
  }
}

struct MoeItem { int e, mt, nt, cnt, off; };
DEVI bool moe_decode(const unsigned* cnt, int it, int ntn, MoeItem& m) {
  int off = 0;
  for (int e = 0; e < 32; ++e) {
    const int c = (int)cnt[e]; const int nti = ((c + 255) >> 8) * ntn;
    if (it < nti) { m.e = e; m.mt = it / ntn; m.nt = it % ntn; m.cnt = c; m.off = off; return true; }
    it -= nti; off += c;
  }
  return false;
}
struct EpiAct {
  h16* act; const float* lw; int row0, nvalid, nt; size_t orow;
  DEVI void operator()(const f32x16 (&acc)[2][2], int wm, int wn, int lane) const {
    const int l31 = lane & 31, half = lane >> 5;
#pragma unroll
    for (int mi = 0; mi < 2; ++mi) {
      const int r = row0 + 64 * wm + 32 * mi + l31;
      if (r < nvalid) {
        const float w = lw[r];
        h16* d = act + (orow + r) * 256 + 32 * (2 * nt + wn);
#pragma unroll
        for (int q = 0; q < 4; ++q) {
          float v[4];
#pragma unroll
          for (int e = 0; e < 4; ++e) { const float g = acc[mi][0][4 * q + e], u = acc[mi][1][4 * q + e]; v[e] = silu_f(g) * u * w; }
          *(h16x4*)(d + 8 * q + 4 * half) = pack4(v[0], v[1], v[2], v[3]);
        }
      }
    }
  }
};
DEVI void phase7(PRef p, LDS unsigned char* lds) {
  const int G = gridDim.x;
  const unsigned* cnt = (const unsigned*)(p.ws + WS_CNT);
  for (int it = blockIdx.x;; it += G) {
    MoeItem m; if (!moe_decode(cnt, it, 4, m)) break;
    ARowGather ar{(const h16*)(p.ws + WS_H), (const unsigned*)(p.ws + WS_LIST) + (size_t)m.e * 32768, m.cnt, m.mt * 256};
    EpiAct epi{(h16*)(p.ws + WS_ACT), (const float*)(p.ws + WS_LISTW) + (size_t)m.e * 32768, m.mt * 256, m.cnt, m.nt, (size_t)m.off};
    gemm_tile(lds, ar, (const h16*)(p.ws + WS_WGU) + ((size_t)m.e * 512 + m.nt * 128) * DM, DM, DM, epi);
  }
}
DEVI void phase8(PRef p, LDS unsigned char* lds) {
  const int G = gridDim.x;
  const unsigned* cnt = (const unsigned*)(p.ws + WS_CNT);
  for (int it = blockIdx.x;; it += G) {
    MoeItem m; if (!moe_decode(cnt, it, 8, m)) break;
    ARowPlain ar{(const h16*)(p.ws + WS_ACT) + ((size_t)m.off + m.mt * 256) * 256, (size_t)256};
    EpiPlain epi{(h16*)(p.ws + WS_YP), DM, m.off + m.mt * 256, m.nt * 128, m.cnt - m.mt * 256};
    gemm_tile(lds, ar, (const h16*)(p.ws + WS_WDN) + ((size_t)m.e * 1024 + m.nt * 128) * 256, 256, 256, epi);
  }
}

DEVI void phase9(PRef p, LDS unsigned char* lds) {
  const int tid = launder((int)threadIdx.x), lane = tid & 63, wave = wave_id(tid), G = gridDim.x;
  const int b = blockIdx.x & 3, bi = blockIdx.x >> 2, nbk = G >> 2;
  LDS unsigned* offs = (LDS unsigned*)lds;
  if (tid == 0) { const unsigned* cnt = (const unsigned*)(p.ws + WS_CNT); unsigned o = 0; for (int e = 0; e < 32; ++e) { offs[e] = o; o += cnt[e]; } }
  __syncthreads();
  LDS float* mv = (LDS float*)(lds + 256);
  mod_to_lds(p, b, 5, mv);
  __syncthreads();
  f32x4 A3[4];
#pragma unroll
  for (int j = 0; j < 4; ++j) { const int k = 256 * j + 4 * lane; A3[j] = *(LDS f32x4*)(mv + k) * *(const f32x4*)(p.in[7] + k); }
  const h16* YP = (const h16*)(p.ws + WS_YP); const u32x4* ROUTE = (const u32x4*)(p.ws + WS_ROUTE); float* out = p.out;
  for (int r = bi * 8 + wave; r < SEQ; r += nbk * 8) {
    const size_t tok = (size_t)b * SEQ + r;
    const u32x4 rt = ROUTE[tok];
    const size_t r0 = (size_t)offs[rt[0]] + rt[1], r1 = (size_t)offs[rt[2]] + rt[3];
    f32x4 y[4]; float ss = 0.f;
#pragma unroll
    for (int j = 0; j < 4; ++j) {
      const h16x4 a = *(const h16x4*)(YP + r0 * DM + 256 * j + 4 * lane), c = *(const h16x4*)(YP + r1 * DM + 256 * j + 4 * lane);
#pragma unroll
      for (int e = 0; e < 4; ++e) { y[j][e] = (float)a[e] + (float)c[e]; ss += y[j][e] * y[j][e]; }
    }
    const float rs = 1.0f / sqrtf(wave_sum(ss) * (1.f / 1024.f) + 1e-6f);
#pragma unroll
    for (int j = 0; j < 4; ++j) {
      float* o = out + tok * DM + 256 * j + 4 * lane;
      const f32x4 x1 = *(const f32x4*)o;
      *(f32x4*)o = x1 + A3[j] * (y[j] * rs);
    }
  }
}

__global__ void __launch_bounds__(NTHR) fwd_kernel(Params p) {
  extern __shared__ __attribute__((aligned(16))) unsigned char smem[];
  LDS unsigned char* lds = (LDS unsigned char*)smem;
  const int lo = p.ph_lo, hi = p.ph_hi;
#define RUN_PHASE(k, fn) if (lo <= (k) && (k) < hi) { fn(*get_params(), lds); if ((k) + 1 < hi) cg::this_grid().sync(); }
  RUN_PHASE(0, phase0)
  RUN_PHASE(1, phase1)
  RUN_PHASE(2, phase2)
  RUN_PHASE(3, phase3)
  RUN_PHASE(4, phase4)
  RUN_PHASE(5, phase5)
  RUN_PHASE(6, phase6)
  RUN_PHASE(7, phase7)
  RUN_PHASE(8, phase8)
  RUN_PHASE(9, phase9)
#undef RUN_PHASE
}

extern "C" void kernel_launch(void* const* d_in, const int* in_sizes, int n_in, void* d_out, int out_size, void* d_ws, size_t ws_size, hipStream_t stream) {
  static int grid = 0;
  if (grid == 0) {
    if (n_in != 24 || out_size != NTOK * DM || ws_size < WS_END) { fprintf(stderr, "kernel_launch: unexpected problem (n_in %d out %d ws %zu)\n", n_in, out_size, ws_size); grid = -1; return; }
    (void)hipFuncSetAttribute((const void*)fwd_kernel, hipFuncAttributeMaxDynamicSharedMemorySize, LDS_BYTES);
    int dev = 0, cus = 0, per_cu = 0;
    (void)hipGetDevice(&dev);
    (void)hipDeviceGetAttribute(&cus, hipDeviceAttributeMultiprocessorCount, dev);
    (void)hipOccupancyMaxActiveBlocksPerMultiprocessor(&per_cu, (const void*)fwd_kernel, NTHR, LDS_BYTES);
    if (per_cu < 1 || cus < 256) fprintf(stderr, "kernel_launch: occupancy %d blocks/CU on %d CUs\n", per_cu, cus);
    grid = 256;
  }
  if (grid < 0) return;
  (void)hipMemsetAsync((char*)d_ws + WS_CNT, 0, CTL_ZERO_BYTES, stream);
  Params p{};
  for (int i = 0; i < 24; ++i) p.in[i] = (const float*)d_in[i];
  p.out = (float*)d_out; p.ws = (unsigned char*)d_ws;
#if N_LAUNCH_MODE == 1
  p.ph_lo = 0; p.ph_hi = NPHASE;
  void* args[] = {&p};
  hipError_t e = hipLaunchCooperativeKernel((const void*)fwd_kernel, dim3(grid), dim3(NTHR), args, LDS_BYTES, stream);
  if (e != hipSuccess) fprintf(stderr, "cooperative launch failed: %s\n", hipGetErrorString(e));
#else
  for (int ph = 0; ph < NPHASE; ++ph) {
    p.ph_lo = ph; p.ph_hi = ph + 1;
    hipLaunchKernelGGL(fwd_kernel, dim3(grid), dim3(NTHR), LDS_BYTES, stream, p);
  }
#endif
}
```

```cpp
#include <hip/hip_runtime.h>
#include <hip/hip_cooperative_groups.h>
#include <cstdio>
#include <cstdint>
namespace cg = cooperative_groups;

#ifndef N_LAUNCH_MODE
#define N_LAUNCH_MODE 1
#endif

#define DEVI __device__ __forceinline__
#define LDS __attribute__((address_space(3)))

typedef _Float16 h16;
typedef _Float16 h16x4 __attribute__((ext_vector_type(4)));
typedef _Float16 h16x8 __attribute__((ext_vector_type(8)));
typedef float f32x4 __attribute__((ext_vector_type(4)));
typedef float f32x16 __attribute__((ext_vector_type(16)));
typedef unsigned u32x2 __attribute__((ext_vector_type(2)));
typedef unsigned u32x4 __attribute__((ext_vector_type(4)));

constexpr int NBATCH = 4, SEQ = 8192, NTOK = NBATCH * SEQ, DM = 1024;
constexpr int NTHR = 512;
constexpr int NPHASE = 10;
constexpr int LDS_BYTES = 163840;

constexpr size_t MiB = 1ull << 20;
constexpr size_t WS_CNT = 0;
constexpr size_t CTL_ZERO_BYTES = 20480;
constexpr size_t WS_BAR = 4096;
constexpr size_t WS_MODP = 64 * 1024;
constexpr size_t WS_ROPE = 1 * MiB;
constexpr size_t WS_WIN = 3 * MiB;
constexpr size_t WS_WOUT = 10 * MiB;
constexpr size_t WS_WGU = 12 * MiB;
constexpr size_t WS_WDN = 44 * MiB;
constexpr size_t WS_WRG = 60 * MiB;
constexpr size_t WS_WRT = 60 * MiB + 256 * 1024;
constexpr size_t WS_AGG = 61 * MiB;
constexpr size_t WS_ROUTE = 63 * MiB;
constexpr size_t WS_LIST = 64 * MiB;
constexpr size_t WS_LISTW = 68 * MiB;
constexpr size_t WS_WI = 72 * MiB;
constexpr size_t WS_KI = 73 * MiB;
constexpr size_t WS_MASK = 77 * MiB;
constexpr size_t WS_H = 109 * MiB;
constexpr size_t WS_Q = 173 * MiB;
constexpr size_t WS_K = 205 * MiB;
constexpr size_t WS_VT = 237 * MiB;
constexpr size_t WS_QI = 269 * MiB;
constexpr size_t WS_XR = 301 * MiB;
constexpr size_t WS_XG = 333 * MiB;
constexpr size_t WS_MIX = 365 * MiB;
constexpr size_t WS_ACT = 429 * MiB;
constexpr size_t WS_YP = 173 * MiB;
constexpr size_t WS_END = 462 * MiB;

struct Params { const float* in[24]; float* out; unsigned char* ws; int ph_lo, ph_hi; };
typedef const __attribute__((address_space(4))) Params& PRef;
typedef const __attribute__((address_space(4))) Params* PPtr;

__device__ const double ROPE_REV[32] = {
  1.59154943091895345608e-01, 1.19349370211248861917e-01, 8.94994016088910132600e-02, 6.71150830052272551196e-02,
  5.03292121044870352509e-02, 3.77415847174197710556e-02, 2.83021958306233986646e-02, 2.12236527647776604399e-02,
  1.59154943091895338669e-02, 1.19349370211248861917e-02, 8.94994016088910236684e-03, 6.71150830052272533849e-03,
  5.03292121044870369856e-03, 3.77415847174197719230e-03, 2.83021958306233986646e-03, 2.12236527647776621747e-03,
  1.59154943091895356017e-03, 1.19349370211248848907e-03, 8.94994016088910236684e-04, 6.71150830052272598901e-04,
  5.03292121044870326488e-04, 3.77415847174197740914e-04, 2.83021958306233954120e-04, 2.12236527647776605484e-04,
  1.59154943091895350596e-04, 1.19349370211248862459e-04, 8.94994016088910182474e-05, 6.71150830052272544691e-05,
  5.03292121044870353593e-05, 3.77415847174197768019e-05, 2.83021958306233960897e-05, 2.12236527647776591931e-05};

DEVI int launder(int x) { asm volatile("" : "+v"(x)); return x; }
DEVI PPtr get_params() { PPtr k = (PPtr)__builtin_amdgcn_kernarg_segment_ptr(); asm volatile("" : "+s"(k)); return k; }
DEVI int wave_id(int tid) { return __builtin_amdgcn_readfirstlane(tid >> 6); }
DEVI f32x16 mfma16(h16x8 a, h16x8 b, f32x16 c) { return __builtin_amdgcn_mfma_f32_32x32x16_f16(a, b, c, 0, 0, 0); }
DEVI float wave_sum(float v) {
#pragma unroll
  for (int o = 1; o < 64; o <<= 1) v += __shfl_xor(v, o);
  return v;
}
DEVI float sigmoid_f(float x) { return 1.f / (1.f + __expf(-x)); }
DEVI float silu_f(float x) { return x / (1.f + __expf(-x)); }
DEVI float gelu_tanh_f(float x) {
  const float u = 0.7978845608028654f * (x + 0.044715f * x * x * x);
  const float t = 1.f - 2.f / (1.f + __expf(2.f * u));
  return 0.5f * x * (1.f + t);
}
DEVI unsigned fkey(float f) { unsigned u = __float_as_uint(f); return (u & 0x80000000u) ? ~u : (u | 0x80000000u); }
DEVI float fkey_inv(unsigned k) { unsigned u = (k & 0x80000000u) ? (k & 0x7fffffffu) : ~k; return __uint_as_float(u); }
DEVI int vt_perm(int pos) { return (pos & ~12) | ((pos & 4) << 1) | ((pos & 8) >> 1); }

DEVI void mod_to_lds(PRef p, int b, int chunk, LDS float* dst) {
  const float* mp = (const float*)(p.ws + WS_MODP);
  for (int k = threadIdx.x; k < 1024; k += NTHR) {
    const int j = chunk * 1024 + k;
    float s = p.in[3][j];
#pragma unroll 1
    for (int ks = 0; ks < 8; ++ks) s += mp[(size_t)(ks * 4 + b) * 6144 + j];
    dst[k] = s;
  }
}

constexpr int LROW = 144;
constexpr int GA_BYTES = 256 * LROW, GB_BYTES = 128 * LROW, GSTAGE = GA_BYTES + GB_BYTES;

template <class AR, class EPI>
DEVI void gemm_tile(LDS unsigned char* lds, const AR& arow, const h16* Bt, int ldb, int K, EPI& epi) {
  const int tid = launder((int)threadIdx.x), lane = tid & 63, wave = wave_id(tid), wm = wave >> 1, wn = wave & 1;
  const int lr = tid >> 3, lc = tid & 7, l31 = lane & 31, half = lane >> 5;
  const h16* pa[4]; const h16* pb[2];
#pragma unroll
  for (int j = 0; j < 4; ++j) pa[j] = arow(lr + 64 * j) + lc * 8;
#pragma unroll
  for (int j = 0; j < 2; ++j) pb[j] = Bt + (size_t)(lr + 64 * j) * ldb + lc * 8;
  h16x8 ra[4], rb[2];
#pragma unroll
  for (int j = 0; j < 4; ++j) ra[j] = *(const h16x8*)pa[j];
#pragma unroll
  for (int j = 0; j < 2; ++j) rb[j] = *(const h16x8*)pb[j];
#pragma unroll
  for (int j = 0; j < 4; ++j) *(LDS h16x8*)(lds + (lr + 64 * j) * LROW + lc * 16) = ra[j];
#pragma unroll
  for (int j = 0; j < 2; ++j) *(LDS h16x8*)(lds + GA_BYTES + (lr + 64 * j) * LROW + lc * 16) = rb[j];
  __syncthreads();
  f32x16 acc[2][2];
#pragma unroll
  for (int a = 0; a < 2; ++a)
#pragma unroll
    for (int b = 0; b < 2; ++b)
#pragma unroll
      for (int r = 0; r < 16; ++r) acc[a][b][r] = 0.f;
  const int KT = K >> 6;
  for (int kt = 0; kt < KT; ++kt) {
    const int cur = kt & 1;
    if (kt + 1 < KT) {
#pragma unroll
      for (int j = 0; j < 4; ++j) ra[j] = *(const h16x8*)(pa[j] + (kt + 1) * 64);
#pragma unroll
      for (int j = 0; j < 2; ++j) rb[j] = *(const h16x8*)(pb[j] + (kt + 1) * 64);
    }
    LDS unsigned char* A = lds + cur * GSTAGE;
    LDS unsigned char* B = A + GA_BYTES;
#pragma unroll
    for (int kk = 0; kk < 4; ++kk) {
      h16x8 af[2], bf[2];
#pragma unroll
      for (int mi = 0; mi < 2; ++mi) af[mi] = *(LDS h16x8*)(A + (64 * wm + 32 * mi + l31) * LROW + (2 * kk + half) * 16);
#pragma unroll
      for (int ni = 0; ni < 2; ++ni) bf[ni] = *(LDS h16x8*)(B + (64 * wn + 32 * ni + l31) * LROW + (2 * kk + half) * 16);
#pragma unroll
      for (int mi = 0; mi < 2; ++mi)
#pragma unroll
        for (int ni = 0; ni < 2; ++ni) acc[mi][ni] = mfma16(bf[ni], af[mi], acc[mi][ni]);
    }
    if (kt + 1 < KT) {
      LDS unsigned char* A2 = lds + (cur ^ 1) * GSTAGE;
#pragma unroll
      for (int j = 0; j < 4; ++j) *(LDS h16x8*)(A2 + (lr + 64 * j) * LROW + lc * 16) = ra[j];
#pragma unroll
      for (int j = 0; j < 2; ++j) *(LDS h16x8*)(A2 + GA_BYTES + (lr + 64 * j) * LROW + lc * 16) = rb[j];
    }
    __syncthreads();
  }
  epi(acc, wm, wn, lane);
}

struct ARowPlain { const h16* base; size_t ld; DEVI const h16* operator()(int r) const { return base + (size_t)r * ld; } };
struct ARowGather { const h16* base; const unsigned* list; int n; int row0; DEVI const h16* operator()(int r) const { const int i = row0 + r; const unsigned t = (i < n) ? list[i] : 0u; return base + (size_t)t * DM; } };

DEVI h16x4 pack4(float a, float b, float c, float d) { h16x4 v; v[0] = (h16)a; v[1] = (h16)b; v[2] = (h16)c; v[3] = (h16)d; return v; }

template <class F>
DEVI void transpose_tile(const float* src, int N, int kb, int nb, h16* dst, int ldd, F drow, LDS float* tile) {
  const int tid = launder((int)threadIdx.x);
#pragma unroll
  for (int j = 0; j < 8; ++j) {
    const int kl = (tid >> 6) + 8 * j, nl = tid & 63, n = nb * 64 + nl;
    tile[kl * 65 + nl] = (n < N) ? src[(size_t)(kb * 64 + kl) * N + n] : 0.f;
  }
  __syncthreads();
  const int nl = tid >> 3, ch = tid & 7, n = nb * 64 + nl;
  if (n < N) {
    h16x8 v;
#pragma unroll
    for (int e = 0; e < 8; ++e) v[e] = (h16)tile[(ch * 8 + e) * 65 + nl];
    *(h16x8*)(dst + (size_t)drow(n) * ldd + kb * 64 + ch * 8) = v;
  }
  __syncthreads();
}

DEVI void phase0(PRef p, LDS unsigned char* lds) {
  const int tid = launder((int)threadIdx.x), lane = tid & 63, wave = wave_id(tid), G = gridDim.x;
  const int gw = blockIdx.x * 8 + wave, NW = G * 8;
  {
    const float* c = p.in[1]; const float* wada = p.in[2]; float* mp = (float*)(p.ws + WS_MODP);
    for (int u = gw; u < 96 * 8; u += NW) {
      const int cgp = u % 96, ks = u / 96, j = cgp * 64 + lane;
      float a0 = 0.f, a1 = 0.f, a2 = 0.f, a3 = 0.f;
      for (int k = ks * 128; k < ks * 128 + 128; ++k) {
        const float w = wada[(size_t)k * 6144 + j];
        a0 = fmaf(silu_f(c[k]), w, a0); a1 = fmaf(silu_f(c[1024 + k]), w, a1);
        a2 = fmaf(silu_f(c[2048 + k]), w, a2); a3 = fmaf(silu_f(c[3072 + k]), w, a3);
      }
      mp[(size_t)(ks * 4 + 0) * 6144 + j] = a0; mp[(size_t)(ks * 4 + 1) * 6144 + j] = a1;
      mp[(size_t)(ks * 4 + 2) * 6144 + j] = a2; mp[(size_t)(ks * 4 + 3) * 6144 + j] = a3;
    }
  }
  {
    LDS float* tile = (LDS float*)lds;
    constexpr int I_IN = 16 * 50, I_OUT = 16 * 16, I_G = 32 * 64, I_U = 32 * 64, I_D = 32 * 64, I_RG = 16;
    constexpr int NIT = I_IN + I_OUT + I_G + I_U + I_D + I_RG;
    for (int it = blockIdx.x; it < NIT; it += G) {
      int r = it;
      if (r < I_IN) {
        transpose_tile(p.in[8], 3144, r / 50, r % 50, (h16*)(p.ws + WS_WIN), 1024,
                       [](int n) { return n < 2112 ? n : (n < 2120 ? 3136 + (n - 2112) : (n < 2632 ? 2112 + (n - 2120) : 2624 + (n - 2632))); }, tile);
        continue;
      }
      r -= I_IN;
      if (r < I_OUT) { transpose_tile(p.in[16], 1024, r / 16, r % 16, (h16*)(p.ws + WS_WOUT), 1024, [](int n) { return n; }, tile); continue; }
      r -= I_OUT;
      if (r < I_G) { const int e = r >> 6, q = r & 63;
        transpose_tile(p.in[21] + (size_t)e * 1024 * 256, 256, q >> 2, q & 3, (h16*)(p.ws + WS_WGU) + (size_t)e * 512 * 1024, 1024, [](int f) { return (f >> 5) * 64 + (f & 31); }, tile); continue; }
      r -= I_G;
      if (r < I_U) { const int e = r >> 6, q = r & 63;
        transpose_tile(p.in[22] + (size_t)e * 1024 * 256, 256, q >> 2, q & 3, (h16*)(p.ws + WS_WGU) + (size_t)e * 512 * 1024, 1024, [](int f) { return (f >> 5) * 64 + 32 + (f & 31); }, tile); continue; }
      r -= I_U;
      if (r < I_D) { const int e = r >> 6, q = r & 63;
        transpose_tile(p.in[23] + (size_t)e * 256 * 1024, 1024, q >> 4, q & 15, (h16*)(p.ws + WS_WDN) + (size_t)e * 1024 * 256, 256, [](int n) { return n; }, tile); continue; }
      r -= I_D;
      if (r < 8) transpose_tile(p.in[11] + (size_t)r * 4096, 64, 0, 0, (h16*)(p.ws + WS_WRG) + (size_t)r * 128 * 64, 64, [](int n) { return n; }, tile);
      else transpose_tile(p.in[13] + (size_t)(r - 8) * 4096, 64, 0, 0, (h16*)(p.ws + WS_WRG) + (size_t)(r - 8) * 128 * 64, 64, [](int n) { return 64 + n; }, tile);
    }
  }
  {
    float* wrt = (float*)(p.ws + WS_WRT);
    for (int i = blockIdx.x * NTHR + tid; i < 36 * 1024; i += G * NTHR) {
      const int col = i >> 10, k = i & 1023;
      wrt[i] = (col < 4) ? p.in[17][k * 4 + col] : p.in[19][k * 32 + (col - 4)];
    }
    float* ct = (float*)(p.ws + WS_ROPE); float* st = ct + 8192 * 32;
    for (int i = blockIdx.x * NTHR + tid; i < 8192 * 32; i += G * NTHR) {
      const int pos = i >> 5, f = i & 31;
      const double rev = (double)pos * ROPE_REV[f];
      const float fr = (float)(rev - __builtin_rint(rev));
      ct[i] = __builtin_amdgcn_cosf(fr); st[i] = __builtin_amdgcn_sinf(fr);
    }
  }
}

DEVI void phase1(PRef p, LDS unsigned char* lds) {
  const int tid = launder((int)threadIdx.x), lane = tid & 63, wave = wave_id(tid), G = gridDim.x;
  const int b = blockIdx.x & 3, bi = blockIdx.x >> 2, nbk = G >> 2;
  LDS float* mv = (LDS float*)lds;
  mod_to_lds(p, b, 0, mv); mod_to_lds(p, b, 1, mv + 1024);
  __syncthreads();
  f32x4 A[4], SH[4];
#pragma unroll
  for (int j = 0; j < 4; ++j) {
    const int k = 256 * j + 4 * lane;
    const f32x4 g = *(const f32x4*)(p.in[4] + k);
    A[j] = g * (*(LDS f32x4*)(mv + 1024 + k) + 1.f);
    SH[j] = *(LDS f32x4*)(mv + k);
  }
  const float* x = p.in[0]; h16* H = (h16*)(p.ws + WS_H);
  for (int r = bi * 8 + wave; r < SEQ; r += nbk * 8) {
    const size_t tok = (size_t)b * SEQ + r;
    f32x4 v[4]; float ss = 0.f;
#pragma unroll
    for (int j = 0; j < 4; ++j) { v[j] = *(const f32x4*)(x + tok * DM + 256 * j + 4 * lane); ss += v[j][0] * v[j][0] + v[j][1] * v[j][1] + v[j][2] * v[j][2] + v[j][3] * v[j][3]; }
    const float rstd = 1.0f / sqrtf(wave_sum(ss) * (1.f / 1024.f) + 1e-6f);
#pragma unroll
    for (int j = 0; j < 4; ++j) {
      const f32x4 y = v[j] * rstd * A[j] + SH[j];
      *(h16x4*)(H + tok * DM + 256 * j + 4 * lane) = pack4(y[0], y[1], y[2], y[3]);
    }
  }
}

struct EpiInProj {
  unsigned char* ws; int mt, nt;
  DEVI void operator()(const f32x16 (&acc)[2][2], int wm, int wn, int lane) const {
    const int l31 = lane & 31, half = lane >> 5;
    const int g = 2 * nt + wn;
    const float* cosT = (const float*)(ws + WS_ROPE); const float* sinT = cosT + 8192 * 32;
#pragma unroll
    for (int mi = 0; mi < 2; ++mi) {
      const int tok = mt * 256 + 64 * wm + 32 * mi + l31;
      const int b = tok >> 13, pos = tok & 8191;
      if (g < 16 || (g >= 24 && g <= 32)) {
        float scl; h16* dst;
        if (g < 8) { scl = 0.125f * 1.4426950408889634f; dst = (h16*)(ws + WS_Q) + (size_t)tok * 512 + g * 64; }
        else if (g < 16) { scl = 1.f; dst = (h16*)(ws + WS_K) + (size_t)tok * 512 + (g - 8) * 64; }
        else if (g < 32) { scl = 0.125f; dst = (h16*)(ws + WS_QI) + (size_t)tok * 512 + (g - 24) * 64; }
        else { scl = 1.f; dst = (h16*)(ws + WS_KI) + (size_t)tok * 64; }
#pragma unroll
        for (int q = 0; q < 4; ++q) {
          const int d0 = 8 * q + 4 * half;
          const f32x4 c = *(const f32x4*)(cosT + pos * 32 + d0), s = *(const f32x4*)(sinT + pos * 32 + d0);
          float o1[4], o2[4];
#pragma unroll
          for (int e = 0; e < 4; ++e) {
            const float x1 = acc[mi][0][4 * q + e], x2 = acc[mi][1][4 * q + e];
            o1[e] = (x1 * c[e] - x2 * s[e]) * scl; o2[e] = (x2 * c[e] + x1 * s[e]) * scl;
          }
          *(h16x4*)(dst + d0) = pack4(o1[0], o1[1], o1[2], o1[3]);
          *(h16x4*)(dst + 32 + d0) = pack4(o2[0], o2[1], o2[2], o2[3]);
        }
      } else if (g < 24) {
        h16* vt = (h16*)(ws + WS_VT) + (size_t)(b * 8 + (g - 16)) * 64 * 8192 + vt_perm(pos);
#pragma unroll
        for (int ni = 0; ni < 2; ++ni)
#pragma unroll
          for (int r = 0; r < 16; ++r) { const int d = 32 * ni + 8 * (r >> 2) + 4 * half + (r & 3); vt[(size_t)d * 8192] = (h16)acc[mi][ni][r]; }
      } else if (g < 49) {
        h16* dst = (g < 41) ? (h16*)(ws + WS_XR) + (size_t)tok * 512 + (g - 33) * 64 : (h16*)(ws + WS_XG) + (size_t)tok * 512 + (g - 41) * 64;
#pragma unroll
        for (int ni = 0; ni < 2; ++ni)
#pragma unroll
          for (int q = 0; q < 4; ++q)
            *(h16x4*)(dst + 32 * ni + 8 * q + 4 * half) = pack4(acc[mi][ni][4 * q], acc[mi][ni][4 * q + 1], acc[mi][ni][4 * q + 2], acc[mi][ni][4 * q + 3]);
      } else {
        const float sc = 0.35355339059327373f;
        f32x4 v; v[0] = acc[mi][0][0] * sc; v[1] = acc[mi][0][1] * sc; v[2] = acc[mi][0][2] * sc; v[3] = acc[mi][0][3] * sc;
        *(f32x4*)((float*)(ws + WS_WI) + (size_t)tok * 8 + 4 * half) = v;
      }
    }
  }
};

DEVI void phase2(PRef p, LDS unsigned char* lds) {
  const int G = gridDim.x;
  const h16* H = (const h16*)(p.ws + WS_H); const h16* W = (const h16*)(p.ws + WS_WIN);
  for (int it = blockIdx.x; it < 128 * 25; it += G) {
    const int mt = it / 25, nt = it % 25;
    ARowPlain ar{H + (size_t)mt * 256 * DM, (size_t)DM};
    EpiInProj epi{p.ws, mt, nt};
    gemm_tile(lds, ar, W + (size_t)nt * 128 * DM, DM, DM, epi);
  }
}

constexpr int CROW = 1040;
constexpr int RNN_XG = 64 * CROW;
template <int MODE>
DEVI void rnn_item(PRef p, LDS unsigned char* lds, int b, int cr) {
  const int tid = launder((int)threadIdx.x), lane = tid & 63, wave = wave_id(tid), l31 = lane & 31, half = lane >> 5;
  const h16* XR = (const h16*)(p.ws + WS_XR);
  {
    const int chg = tid & 63, tg = tid >> 6, pos0 = cr * 64 + 8 * tg;
    h16x8 xin[11];
#pragma unroll
    for (int i = 0; i < 11; ++i) {
      const int pos = pos0 + i - 3;
      if (pos >= 0) xin[i] = *(const h16x8*)(XR + ((size_t)b * SEQ + pos) * 512 + chg * 8);
      else {
#pragma unroll
        for (int e = 0; e < 8; ++e) xin[i][e] = (h16)0.f;
      }
    }
    float cw[4][8], cb[8];
#pragma unroll
    for (int e = 0; e < 8; ++e) {
      cb[e] = p.in[10][chg * 8 + e];
#pragma unroll
      for (int j = 0; j < 4; ++j) cw[j][e] = p.in[9][j * 512 + chg * 8 + e];
    }
#pragma unroll
    for (int tt = 0; tt < 8; ++tt) {
      h16x8 o;
#pragma unroll
      for (int e = 0; e < 8; ++e) {
        float v = cb[e];
#pragma unroll
        for (int j = 0; j < 4; ++j) v = fmaf(cw[j][e], (float)xin[tt + j][e], v);
        o[e] = (h16)v;
      }
      *(LDS h16x8*)(lds + (8 * tg + tt) * CROW + chg * 16) = o;
    }
  }
  if (MODE == 1) {
    const h16* XG = (const h16*)(p.ws + WS_XG) + ((size_t)b * SEQ + cr * 64) * 512;
#pragma unroll
    for (int i = 0; i < 8; ++i) { const int c = tid + NTHR * i, row = c >> 6, cc = c & 63; *(LDS h16x8*)(lds + RNN_XG + row * CROW + cc * 16) = *(const h16x8*)(XG + (size_t)row * 512 + cc * 8); }
  }
  __syncthreads();
  const int n = wave;
  const h16* WRG = (const h16*)(p.ws + WS_WRG) + (size_t)n * 128 * 64;
  float* AGG = (float*)(p.ws + WS_AGG);
#pragma unroll 1
  for (int dt = 0; dt < 2; ++dt) {
    h16x8 wa[4], wx[4];
#pragma unroll
    for (int kk = 0; kk < 4; ++kk) {
      wa[kk] = *(const h16x8*)(WRG + (size_t)(32 * dt + l31) * 64 + 16 * kk + 8 * half);
      wx[kk] = *(const h16x8*)(WRG + (size_t)(64 + 32 * dt + l31) * 64 + 16 * kk + 8 * half);
    }
    f32x16 ra[2], rx[2];
#pragma unroll
    for (int ti = 0; ti < 2; ++ti) {
#pragma unroll
      for (int r = 0; r < 16; ++r) { ra[ti][r] = 0.f; rx[ti][r] = 0.f; }
#pragma unroll
      for (int kk = 0; kk < 4; ++kk) {
        const h16x8 af = *(LDS h16x8*)(lds + (32 * ti + l31) * CROW + (n * 64 + 16 * kk + 8 * half) * 2);
        ra[ti] = mfma16(af, wa[kk], ra[ti]);
        rx[ti] = mfma16(af, wx[kk], rx[ti]);
      }
    }
    const int ch = n * 64 + 32 * dt + l31;
    const float ba = p.in[12][ch], bx = p.in[14][ch], lam = p.in[15][ch];
    const float c8 = -8.f * log1pf(__expf(-lam));
#pragma unroll
    for (int ti = 0; ti < 2; ++ti)
#pragma unroll
      for (int r = 0; r < 16; ++r) {
        const int tk = 32 * ti + (r & 3) + 8 * (r >> 2) + 4 * half;
        const float cv = (float)*(LDS h16*)(lds + tk * CROW + ch * 2);
        const float rr = sigmoid_f(ra[ti][r] + ba), ii = sigmoid_f(rx[ti][r] + bx);
        const float la = c8 * rr;
        ra[ti][r] = __expf(la);
        rx[ti][r] = sqrtf(-expm1f(2.f * la)) * (ii * cv);
      }
    float P[8], Hs[8];
#pragma unroll
    for (int sg = 0; sg < 8; ++sg) {
      const int ti = sg >> 2, q = sg & 3;
      float pp = 1.f, hh = 0.f;
#pragma unroll
      for (int i = 0; i < 4; ++i) { const float a = ra[ti][4 * q + i], bb = rx[ti][4 * q + i]; hh = fmaf(a, hh, bb); pp *= a; }
      P[sg] = pp; Hs[sg] = hh;
    }
    float carry = 0.f, prod = 1.f;
    if (MODE == 1) {
      for (int c2 = 0; c2 < cr; ++c2) {
        const float* ag = AGG + ((size_t)(b * 128 + c2) * 512 + ch) * 2;
        carry = fmaf(ag[0], carry, ag[1]);
      }
    }
    float cin[8];
#pragma unroll
    for (int sg = 0; sg < 8; ++sg)
#pragma unroll
      for (int ow = 0; ow < 2; ++ow) {
        const float tmp = fmaf(P[sg], carry, Hs[sg]);
        const float tp = P[sg] * prod;
        if (half == ow) cin[sg] = carry;
        const float oth = __shfl_xor(tmp, 32), otp = __shfl_xor(tp, 32);
        carry = (half == ow) ? tmp : oth;
        prod = (half == ow) ? tp : otp;
      }
    if (MODE == 0) {
      if (half == 0) { float* ag = AGG + ((size_t)(b * 128 + cr) * 512 + ch) * 2; ag[0] = prod; ag[1] = carry; }
    } else {
#pragma unroll
      for (int sg = 0; sg < 8; ++sg) {
        const int ti = sg >> 2, q = sg & 3;
        float hh = cin[sg];
#pragma unroll
        for (int i = 0; i < 4; ++i) {
          hh = fmaf(ra[ti][4 * q + i], hh, rx[ti][4 * q + i]);
          LDS h16* xp = (LDS h16*)(lds + RNN_XG + (32 * ti + 8 * q + 4 * half + i) * CROW + ch * 2);
          *xp = (h16)(hh * gelu_tanh_f((float)*xp));
        }
      }
    }
  }
  __syncthreads();
  if (MODE == 1) {
    h16* Y = (h16*)(p.ws + WS_H) + ((size_t)b * SEQ + cr * 64) * DM + 512;
#pragma unroll
    for (int i = 0; i < 8; ++i) { const int c = tid + NTHR * i, row = c >> 6, cc = c & 63; *(h16x8*)(Y + (size_t)row * DM + cc * 8) = *(LDS h16x8*)(lds + RNN_XG + row * CROW + cc * 16); }
    __syncthreads();
  }
}

constexpr int IDX_NB = 256, IDX_CAP = 128;
constexpr int IL_HIST = 0, IL_CS = 65536, IL_CK = IL_CS + 64 * IDX_CAP * 4, IL_KI = IL_CK + 64 * IDX_CAP * 2, IL_KISZ = 128 * LROW, IL_ST = IL_KI + 2 * IL_KISZ;
static_assert(IL_ST + 4096 <= LDS_BYTES, "indexer LDS map");

DEVI f32x4 mfma16s(h16x8 a, h16x8 b, f32x4 c) { return __builtin_amdgcn_mfma_f32_16x16x32_f16(a, b, c, 0, 0, 0); }
DEVI void idx_score(LDS unsigned char* kit, int kh, int l15, int g4, const h16x8 (&qf)[8][2], const float (&wq)[8], f32x4 (&sc)[4]) {
  h16x8 kf[4][2];
#pragma unroll
  for (int kt = 0; kt < 4; ++kt)
#pragma unroll
    for (int ks = 0; ks < 2; ++ks) kf[kt][ks] = *(LDS h16x8*)(kit + (64 * kh + 16 * kt + l15) * LROW + (4 * ks + g4) * 16);
#pragma unroll
  for (int kt = 0; kt < 4; ++kt) sc[kt] = (f32x4){0.f, 0.f, 0.f, 0.f};
#pragma unroll
  for (int h = 0; h < 8; ++h) {
#pragma unroll
    for (int kt = 0; kt < 4; ++kt) {
      f32x4 acc = (f32x4){0.f, 0.f, 0.f, 0.f};
      acc = mfma16s(kf[kt][0], qf[h][0], acc);
      acc = mfma16s(kf[kt][1], qf[h][1], acc);
#pragma unroll
      for (int r = 0; r < 4; ++r) sc[kt][r] = __builtin_fmaf(wq[h], __builtin_fmaxf(acc[r], 0.f), sc[kt][r]);
    }
    if (h & 1) __builtin_amdgcn_sched_barrier(0);
  }
}

template <int MODE>
DEVI void idx_pass(LDS unsigned char* lds, const h16* KIb, int N, int stride, int qg, int kh,
                   const h16* QIrow0, const float* WIrow0, float qinv, float qoff, int bstar) {
  const int tid = launder((int)threadIdx.x), lane = tid & 63, l15 = lane & 15, g4 = lane >> 4;
  const int q = 16 * qg + l15;
  h16x8 qf[8][2]; float wq[8];
  {
    const h16* QI = QIrow0 + (size_t)q * 512;
#pragma unroll
    for (int h = 0; h < 8; ++h)
#pragma unroll
      for (int ks = 0; ks < 2; ++ks) qf[h][ks] = *(const h16x8*)(QI + h * 64 + 32 * ks + 8 * g4);
    const float* WI = WIrow0 + (size_t)q * 8;
#pragma unroll
    for (int h = 0; h < 8; ++h) wq[h] = WI[h];
  }
  LDS unsigned* hist = (LDS unsigned*)(lds + IL_HIST);
  LDS unsigned* st = (LDS unsigned*)(lds + IL_ST);
  const int nst = (N + 127) >> 7;
  const int lr = tid >> 3, lc = tid & 7;
  h16x8 r0, r1;
  r0 = *(const h16x8*)(KIb + (size_t)lr * 64 + lc * 8); r1 = *(const h16x8*)(KIb + (size_t)(lr + 64) * 64 + lc * 8);
  *(LDS h16x8*)(lds + IL_KI + lr * LROW + lc * 16) = r0; *(LDS h16x8*)(lds + IL_KI + (lr + 64) * LROW + lc * 16) = r1;
  __syncthreads();
  float vmin = INFINITY, vmax = -INFINITY;
  int cur = 0;
  for (int s = 0; s < nst; s += stride) {
    const int nx = s + stride;
    if (nx < nst) { r0 = *(const h16x8*)(KIb + (size_t)(128 * nx + lr) * 64 + lc * 8); r1 = *(const h16x8*)(KIb + (size_t)(128 * nx + lr + 64) * 64 + lc * 8); }
    if (128 * s + 64 * kh < N) {
      f32x4 sc[4];
      idx_score(lds + IL_KI + cur * IL_KISZ, kh, l15, g4, qf, wq, sc);
      if (MODE == 0) {
#pragma unroll
        for (int kt = 0; kt < 4; ++kt)
#pragma unroll
          for (int r = 0; r < 4; ++r) { vmin = fminf(vmin, sc[kt][r]); vmax = fmaxf(vmax, sc[kt][r]); }
      } else if (MODE == 1) {
#pragma unroll
        for (int kt = 0; kt < 4; ++kt)
#pragma unroll
          for (int r = 0; r < 4; ++r) {
            const float xb = fminf(fmaxf(__builtin_fmaf(sc[kt][r], qinv, qoff), 0.f), (float)(IDX_NB - 1));
            const int bin = (int)xb;
            __hip_atomic_fetch_add(&hist[bin * 64 + q], 1u, __ATOMIC_RELAXED, __HIP_MEMORY_SCOPE_WORKGROUP);
          }
      } else {
        unsigned nib = 0u;
#pragma unroll
        for (int kt = 0; kt < 4; ++kt)
#pragma unroll
          for (int r = 0; r < 4; ++r) {
            const float xb = fminf(fmaxf(__builtin_fmaf(sc[kt][r], qinv, qoff), 0.f), (float)(IDX_NB - 1));
            const int bin = (int)xb;
            if (bin > bstar) nib |= (1u << (4 * kt + r));
            else if (bin == bstar) {
              const unsigned pos = __hip_atomic_fetch_add(&st[128 + q], 1u, __ATOMIC_RELAXED, __HIP_MEMORY_SCOPE_WORKGROUP);
              if (pos < (unsigned)IDX_CAP) {
                ((LDS float*)(lds + IL_CS))[q * IDX_CAP + pos] = sc[kt][r];
                ((LDS unsigned short*)(lds + IL_CK))[q * IDX_CAP + pos] = (unsigned short)(128 * s + 64 * kh + 16 * kt + 4 * g4 + r);
              }
            }
          }
        const unsigned oth = (unsigned)__shfl_xor((int)nib, 32);
        if (lane < 32) {
#pragma unroll
          for (int T = 0; T < 2; ++T) {
            const unsigned b0 = ((nib >> (8 * T)) & 15u) | (((oth >> (8 * T)) & 15u) << 4);
            const unsigned b1 = ((nib >> (8 * T + 4)) & 15u) | (((oth >> (8 * T + 4)) & 15u) << 4);
            ((LDS unsigned short*)(lds + IL_HIST))[q * 512 + (4 * s + 2 * kh + T) * 2 + (g4 & 1)] = (unsigned short)(b0 | (b1 << 8));
          }
        }
      }
    }
    if (nx < nst) {
      *(LDS h16x8*)(lds + IL_KI + (cur ^ 1) * IL_KISZ + lr * LROW + lc * 16) = r0;
      *(LDS h16x8*)(lds + IL_KI + (cur ^ 1) * IL_KISZ + (lr + 64) * LROW + lc * 16) = r1;
    }
    __syncthreads();
    cur ^= 1;
  }
  if (MODE == 0) {
    __hip_atomic_fetch_min(&st[q], fkey(vmin), __ATOMIC_RELAXED, __HIP_MEMORY_SCOPE_WORKGROUP);
    __hip_atomic_fetch_max(&st[64 + q], fkey(vmax), __ATOMIC_RELAXED, __HIP_MEMORY_SCOPE_WORKGROUP);
  }
}

DEVI void idx_item(PRef p, LDS unsigned char* lds, int b, int c) {
  const int tid = launder((int)threadIdx.x), lane = tid & 63, wave = wave_id(tid), l31 = lane & 31, half = lane >> 5;
  const int N = 64 * (c + 1);
  unsigned* MASK = (unsigned*)(p.ws + WS_MASK) + ((size_t)b * SEQ + 64 * c) * 256;
  if (N <= 256) {
    const int wpr = N >> 5;
    for (int i = tid; i < 64 * wpr; i += NTHR) MASK[(size_t)(i / wpr) * 256 + (i % wpr)] = 0xFFFFFFFFu;
    return;
  }
  const int qg = wave & 3, kh = wave >> 2, l15 = lane & 15, q = 16 * qg + l15;
  const h16* QIrow0 = (const h16*)(p.ws + WS_QI) + ((size_t)b * SEQ + 64 * c) * 512;
  const float* WIrow0 = (const float*)(p.ws + WS_WI) + ((size_t)b * SEQ + 64 * c) * 8;
  const h16* KIb = (const h16*)(p.ws + WS_KI) + (size_t)b * SEQ * 64;
  LDS unsigned* st = (LDS unsigned*)(lds + IL_ST);
  LDS float* stf = (LDS float*)(lds + IL_ST);
  if (tid < 64) { st[tid] = 0xFFFFFFFFu; st[64 + tid] = 0u; st[128 + tid] = 0u; }
  __syncthreads();
  const int nst = (N + 127) >> 7;
  const int stride = nst >= 16 ? 8 : (nst >= 8 ? 4 : (nst >= 4 ? 2 : 1));
  idx_pass<0>(lds, KIb, N, stride, qg, kh, QIrow0, WIrow0, 0.f, 0.f, 0);
  __syncthreads();
  if (tid < 64) {
    const float lo = fkey_inv(st[tid]), hi = fkey_inv(st[64 + tid]);
    float d = hi - lo; if (!(d > 1e-20f)) d = 1.f;
    const float inv = (float)IDX_NB / (1.5f * d);
    stf[192 + tid] = inv; stf[256 + tid] = -(lo - 0.25f * d) * inv;
  }
  for (int i = tid; i < 16384; i += NTHR) ((LDS unsigned*)(lds + IL_HIST))[i] = 0u;
  __syncthreads();
  const float qinv = stf[192 + q], qoff = stf[256 + q];
  idx_pass<1>(lds, KIb, N, 1, qg, kh, QIrow0, WIrow0, qinv, qoff, 0);
#ifdef PROBE_P1X2
  __syncthreads();
  for (int i = tid; i < 16384; i += NTHR) ((LDS unsigned*)(lds + IL_HIST))[i] = 0u;
  __syncthreads();
  idx_pass<1>(lds, KIb, N, 1, qg, kh, QIrow0, WIrow0, qinv, qoff, 0);
#endif
  if (tid < 64) {
    LDS unsigned* hist = (LDS unsigned*)(lds + IL_HIST);
    unsigned cum = 0u; int bs = 0; unsigned need = 256u;
    for (int bb = IDX_NB - 1; bb >= 0; --bb) {
      const unsigned hcount = hist[bb * 64 + tid];
      if (cum + hcount >= 256u) { bs = bb; need = 256u - cum; break; }
      cum += hcount;
    }
    st[320 + tid] = (unsigned)bs; st[384 + tid] = need;
  }
  __syncthreads();
  const int bstar = (int)st[320 + q];
  __syncthreads();
  idx_pass<2>(lds, KIb, N, 1, qg, kh, QIrow0, WIrow0, qinv, qoff, bstar);
#ifdef PROBE_P2X2
  __syncthreads();
  if (tid < 64) st[128 + tid] = 0u;
  __syncthreads();
  idx_pass<2>(lds, KIb, N, 1, qg, kh, QIrow0, WIrow0, qinv, qoff, bstar);
#endif
  for (int qq = wave; qq < 64; qq += 8) {
    const int nc = min((int)st[128 + qq], IDX_CAP); const unsigned need = st[384 + qq];
    LDS float* cs = (LDS float*)(lds + IL_CS) + qq * IDX_CAP; LDS unsigned short* ck = (LDS unsigned short*)(lds + IL_CK) + qq * IDX_CAP;
    for (int i = lane; i < nc; i += 64) {
      const float sv = cs[i]; const unsigned kv = ck[i];
      unsigned rank = 0u;
      for (int j = 0; j < nc; ++j) { const float sj = cs[j]; const unsigned kj = ck[j]; rank += (sj > sv || (sj == sv && kj < kv)) ? 1u : 0u; }
      if (rank < need) {
        const unsigned kl = kv & 31u;
        const unsigned bit = 16u * ((kl >> 2) & 1u) + (kl & 3u) + 4u * (kl >> 3);
        __hip_atomic_fetch_or((LDS unsigned*)(lds + IL_HIST) + qq * 256 + (kv >> 5), 1u << bit, __ATOMIC_RELAXED, __HIP_MEMORY_SCOPE_WORKGROUP);
      }
    }
  }
  __syncthreads();
  {
    const int cpr = N >> 6;
    for (int i = tid; i < 64 * cpr; i += NTHR) {
      const int row = i / cpr, cc = i % cpr;
      *(u32x2*)(MASK + (size_t)row * 256 + 2 * cc) = *(LDS u32x2*)(lds + IL_HIST + row * 1024 + cc * 8);
    }
  }
  __syncthreads();
}

DEVI void phase3(PRef p, LDS unsigned char* lds) {
  const int G = gridDim.x;
  for (int it = blockIdx.x; it < 512; it += G) rnn_item<0>(p, lds, it >> 7, it & 127);
  for (int it = blockIdx.x; it < 256; it += G) {
    const int b = it >> 6, j = it & 63;
#pragma unroll 1
    for (int w2 = 0; w2 < 2; ++w2) idx_item(p, lds, b, w2 ? j : 127 - j);
  }
}

constexpr int AT_BUF = 2 * 64 * LROW;
DEVI void attn_unit(PRef p, LDS unsigned char* lds, int b, int head, int qb) {
  const int tid = launder((int)threadIdx.x), lane = tid & 63, wave = wave_id(tid), l31 = lane & 31, half = lane >> 5;
  const int q0 = qb * 256 + wave * 32, cw = q0 >> 6, NT = 4 * (qb + 1);
  const size_t tok = (size_t)b * SEQ + q0 + l31;
  h16x8 qf[4];
  {
    const h16* Q = (const h16*)(p.ws + WS_Q) + tok * 512 + head * 64;
#pragma unroll
    for (int kk = 0; kk < 4; ++kk) qf[kk] = *(const h16x8*)(Q + 16 * kk + 8 * half);
  }
  const unsigned* mrow = (const unsigned*)(p.ws + WS_MASK) + tok * 256;
  const int lr = tid >> 3, lc = tid & 7;
  const h16* kp = (const h16*)(p.ws + WS_K) + ((size_t)b * SEQ + lr) * 512 + head * 64 + lc * 8;
  const h16* vp = (const h16*)(p.ws + WS_VT) + ((size_t)(b * 8 + head) * 64 + lr) * 8192 + lc * 8;
  h16x8 rk = *(const h16x8*)kp, rv = *(const h16x8*)vp;
  *(LDS h16x8*)(lds + lr * LROW + lc * 16) = rk; *(LDS h16x8*)(lds + 64 * LROW + lr * LROW + lc * 16) = rv;
  __syncthreads();
  f32x16 o[2];
#pragma unroll
  for (int r = 0; r < 16; ++r) { o[0][r] = 0.f; o[1][r] = 0.f; }
  float m = -INFINITY, l = 0.f;
  for (int jt = 0; jt < NT; ++jt) {
    const int cur = jt & 1;
    if (jt + 1 < NT) { rk = *(const h16x8*)(kp + (size_t)(jt + 1) * 64 * 512); rv = *(const h16x8*)(vp + (jt + 1) * 64); }
    if (jt <= cw) {
      LDS unsigned char* Kt = lds + cur * AT_BUF; LDS unsigned char* Vt = Kt + 64 * LROW;
      const u32x2 mw = *(const u32x2*)(mrow + 2 * jt);
      f32x16 s[2];
#pragma unroll
      for (int ri = 0; ri < 2; ++ri) {
#pragma unroll
        for (int r = 0; r < 16; ++r) s[ri][r] = 0.f;
#pragma unroll
        for (int kk = 0; kk < 4; ++kk) {
          const h16x8 kf = *(LDS h16x8*)(Kt + (32 * ri + l31) * LROW + (2 * kk + half) * 16);
          s[ri] = mfma16(kf, qf[kk], s[ri]);
        }
      }
      const unsigned m0 = (mw[0] >> (16 * half)) & 0xFFFFu, m1 = (mw[1] >> (16 * half)) & 0xFFFFu;
      float mx = -INFINITY;
#pragma unroll
      for (int r = 0; r < 16; ++r) {
        s[0][r] = ((m0 >> r) & 1u) ? s[0][r] : -INFINITY;
        s[1][r] = ((m1 >> r) & 1u) ? s[1][r] : -INFINITY;
        mx = fmaxf(mx, fmaxf(s[0][r], s[1][r]));
      }
      mx = fmaxf(mx, __shfl_xor(mx, 32));
      const float mnew = fmaxf(m, mx);
      const float muse = (mnew == -INFINITY) ? 0.f : mnew;
      const float alpha = __builtin_amdgcn_exp2f(m - muse);
      float ls = 0.f;
#pragma unroll
      for (int r = 0; r < 16; ++r) {
        s[0][r] = __builtin_amdgcn_exp2f(s[0][r] - muse); s[1][r] = __builtin_amdgcn_exp2f(s[1][r] - muse);
        ls += s[0][r] + s[1][r];
      }
      l = l * alpha + ls; m = mnew;
#pragma unroll
      for (int r = 0; r < 16; ++r) { o[0][r] *= alpha; o[1][r] *= alpha; }
      h16x8 pf[4];
#pragma unroll
      for (int s4 = 0; s4 < 4; ++s4)
#pragma unroll
        for (int e = 0; e < 8; ++e) pf[s4][e] = (h16)s[s4 >> 1][8 * (s4 & 1) + e];
#pragma unroll
      for (int di = 0; di < 2; ++di)
#pragma unroll
        for (int s4 = 0; s4 < 4; ++s4) {
          const h16x8 vf = *(LDS h16x8*)(Vt + (32 * di + l31) * LROW + (2 * s4 + half) * 16);
          o[di] = mfma16(vf, pf[s4], o[di]);
        }
    }
    if (jt + 1 < NT) {
      *(LDS h16x8*)(lds + (cur ^ 1) * AT_BUF + lr * LROW + lc * 16) = rk;
      *(LDS h16x8*)(lds + (cur ^ 1) * AT_BUF + 64 * LROW + lr * LROW + lc * 16) = rv;
    }
    __syncthreads();
  }
  const float inv = 1.f / (l + __shfl_xor(l, 32));
  h16* Y = (h16*)(p.ws + WS_H) + tok * DM + head * 64;
#pragma unroll
  for (int di = 0; di < 2; ++di)
#pragma unroll
    for (int q = 0; q < 4; ++q)
      *(h16x4*)(Y + 32 * di + 8 * q + 4 * half) = pack4(o[di][4 * q] * inv, o[di][4 * q + 1] * inv, o[di][4 * q + 2] * inv, o[di][4 * q + 3] * inv);
}

DEVI void phase4(PRef p, LDS unsigned char* lds) {
  const int G = gridDim.x;
  for (int it = blockIdx.x; it < 512; it += G) rnn_item<1>(p, lds, it >> 7, it & 127);
  for (int it = blockIdx.x; it < 512; it += G) {
    const int bh = it >> 4, j = it & 15;
#pragma unroll 1
    for (int w2 = 0; w2 < 2; ++w2) attn_unit(p, lds, bh >> 3, bh & 7, w2 ? j : 31 - j);
  }
}

struct EpiPlain {
  h16* dst; int ld; int row0, col0, nvalid;
  DEVI void operator()(const f32x16 (&acc)[2][2], int wm, int wn, int lane) const {
    const int l31 = lane & 31, half = lane >> 5;
#pragma unroll
    for (int mi = 0; mi < 2; ++mi) {
      const int r = 64 * wm + 32 * mi + l31;
      if (r < nvalid) {
        h16* d = dst + (size_t)(row0 + r) * ld + col0 + 64 * wn;
#pragma unroll
        for (int ni = 0; ni < 2; ++ni)
#pragma unroll
          for (int q = 0; q < 4; ++q)
            *(h16x4*)(d + 32 * ni + 8 * q + 4 * half) = pack4(acc[mi][ni][4 * q], acc[mi][ni][4 * q + 1], acc[mi][ni][4 * q + 2], acc[mi][ni][4 * q + 3]);
      }
    }
  }
};
DEVI void phase5(PRef p, LDS unsigned char* lds) {
  const int G = gridDim.x;
  const h16* Y = (const h16*)(p.ws + WS_H); const h16* W = (const h16*)(p.ws + WS_WOUT);
  for (int it = blockIdx.x; it < 128 * 8; it += G) {
    const int mt = it >> 3, nt = it & 7;
    ARowPlain ar{Y + (size_t)mt * 256 * DM, (size_t)DM};
    EpiPlain epi{(h16*)(p.ws + WS_MIX), DM, mt * 256, nt * 128, 256};
    gemm_tile(lds, ar, W + (size_t)nt * 128 * DM, DM, DM, epi);
  }
}

constexpr int P6_WRT = 0, P6_MOD = 36 * 1024 * 4, P6_LG = P6_MOD + 3 * 4096;
static_assert(P6_LG + 8 * 72 * 4 <= LDS_BYTES, "phase 6 LDS map");
DEVI void phase6(PRef p, LDS unsigned char* lds) {
  const int tid = launder((int)threadIdx.x), lane = tid & 63, wave = wave_id(tid), G = gridDim.x;
  const int b = blockIdx.x & 3, bi = blockIdx.x >> 2, nbk = G >> 2;
  LDS float* wrt = (LDS float*)(lds + P6_WRT);
  LDS float* mv = (LDS float*)(lds + P6_MOD);
  LDS float* lgw = (LDS float*)(lds + P6_LG) + wave * 72;
  {
    const f32x4* src = (const f32x4*)(p.ws + WS_WRT);
    for (int i = tid; i < 36 * 256; i += NTHR) ((LDS f32x4*)wrt)[i] = src[i];
  }
  mod_to_lds(p, b, 2, mv); mod_to_lds(p, b, 3, mv + 1024); mod_to_lds(p, b, 4, mv + 2048);
  __syncthreads();
  f32x4 A1[4], A2[4], SH2[4];
#pragma unroll
  for (int j = 0; j < 4; ++j) {
    const int k = 256 * j + 4 * lane;
    A1[j] = *(LDS f32x4*)(mv + k) * *(const f32x4*)(p.in[5] + k);
    A2[j] = *(const f32x4*)(p.in[6] + k) * (*(LDS f32x4*)(mv + 2048 + k) + 1.f);
    SH2[j] = *(LDS f32x4*)(mv + 1024 + k);
  }
  const float* x = p.in[0]; const h16* MIX = (const h16*)(p.ws + WS_MIX); float* X1 = p.out; h16* H2 = (h16*)(p.ws + WS_H);
  unsigned* cnt = (unsigned*)(p.ws + WS_CNT); unsigned* LIST = (unsigned*)(p.ws + WS_LIST); float* LISTW = (float*)(p.ws + WS_LISTW);
  u32x4* ROUTE = (u32x4*)(p.ws + WS_ROUTE);
  for (int pr = bi * 8 + wave; pr < SEQ / 2; pr += nbk * 8) {
    f32x4 h2[2][4];
#pragma unroll
    for (int tt = 0; tt < 2; ++tt) {
      const size_t tok = (size_t)b * SEQ + 2 * pr + tt;
      f32x4 xv[4], mx[4]; float ssm = 0.f;
#pragma unroll
      for (int j = 0; j < 4; ++j) {
        xv[j] = *(const f32x4*)(x + tok * DM + 256 * j + 4 * lane);
        const h16x4 mh = *(const h16x4*)(MIX + tok * DM + 256 * j + 4 * lane);
#pragma unroll
        for (int e = 0; e < 4; ++e) { mx[j][e] = (float)mh[e]; ssm += mx[j][e] * mx[j][e]; }
      }
      const float rsm = 1.0f / sqrtf(wave_sum(ssm) * (1.f / 1024.f) + 1e-6f);
      float ss1 = 0.f;
#pragma unroll
      for (int j = 0; j < 4; ++j) {
        xv[j] = xv[j] + A1[j] * (mx[j] * rsm);
        *(f32x4*)(X1 + tok * DM + 256 * j + 4 * lane) = xv[j];
        ss1 += xv[j][0] * xv[j][0] + xv[j][1] * xv[j][1] + xv[j][2] * xv[j][2] + xv[j][3] * xv[j][3];
      }
      const float rs1 = 1.0f / sqrtf(wave_sum(ss1) * (1.f / 1024.f) + 1e-6f);
#pragma unroll
      for (int j = 0; j < 4; ++j) {
        h2[tt][j] = xv[j] * rs1 * A2[j] + SH2[j];
        *(h16x4*)(H2 + tok * DM + 256 * j + 4 * lane) = pack4(h2[tt][j][0], h2[tt][j][1], h2[tt][j][2], h2[tt][j][3]);
      }
    }
#pragma unroll 1
    for (int col = 0; col < 36; ++col) {
      float a0 = 0.f, a1 = 0.f;
#pragma unroll
      for (int j = 0; j < 4; ++j) {
        const f32x4 w = *(LDS f32x4*)(wrt + col * 1024 + 256 * j + 4 * lane);
#pragma unroll
        for (int e = 0; e < 4; ++e) { a0 = fmaf(h2[0][j][e], w[e], a0); a1 = fmaf(h2[1][j][e], w[e], a1); }
      }
      a0 = wave_sum(a0); a1 = wave_sum(a1);
      if (lane == 0) { lgw[col] = a0; lgw[36 + col] = a1; }
    }
    if (lane < 2) {
      const int tt = lane;
      const unsigned tok = (unsigned)(b * SEQ + 2 * pr + tt);
      LDS float* lg = lgw + 36 * tt;
      int gi = 0; float gm = lg[0] + p.in[18][0];
      float gl[4];
#pragma unroll
      for (int g = 0; g < 4; ++g) gl[g] = lg[g] + p.in[18][g];
#pragma unroll
      for (int g = 1; g < 4; ++g) if (gl[g] > gm) { gm = gl[g]; gi = g; }
      float gs = 0.f;
#pragma unroll
      for (int g = 0; g < 4; ++g) gs += __expf(gl[g] - gm);
      const float pg = 1.f / gs;
      int e1 = 0, e2 = 0; float l1 = -INFINITY, l2 = -INFINITY;
#pragma unroll 1
      for (int e = 0; e < 8; ++e) {
        const float v = lg[4 + 8 * gi + e] + p.in[20][8 * gi + e];
        if (v > l1) { l2 = l1; e2 = e1; l1 = v; e1 = e; }
        else if (v > l2) { l2 = v; e2 = e; }
      }
      const float x2 = __expf(l2 - l1);
      const float w1 = pg / (1.f + x2), w2 = pg * x2 / (1.f + x2);
      const unsigned E1 = (unsigned)(gi * 8 + e1), E2 = (unsigned)(gi * 8 + e2);
      const unsigned p1 = atomicAdd(&cnt[E1], 1u), p2 = atomicAdd(&cnt[E2], 1u);
      LIST[(size_t)E1 * 32768 + p1] = tok; LISTW[(size_t)E1 * 32768 + p1] = w1;
      LIST[(size_t)E2 * 32768 + p2] = tok; LISTW[(size_t)E2 * 32768 + p2] = w2;
      u32x4 rt; rt[0] = E1; rt[1] = p1; rt[2] = E2; rt[3] = p2;
      ROUTE[tok] = rt;
    }
  }
}

struct MoeItem { int e, mt, nt, cnt, off; };
DEVI bool moe_decode(const unsigned* cnt, int it, int ntn, MoeItem& m) {
  int off = 0;
  for (int e = 0; e < 32; ++e) {
    const int c = (int)cnt[e]; const int nti = ((c + 255) >> 8) * ntn;
    if (it < nti) { m.e = e; m.mt = it / ntn; m.nt = it % ntn; m.cnt = c; m.off = off; return true; }
    it -= nti; off += c;
  }
  return false;
}
struct EpiAct {
  h16* act; const float* lw; int row0, nvalid, nt; size_t orow;
  DEVI void operator()(const f32x16 (&acc)[2][2], int wm, int wn, int lane) const {
    const int l31 = lane & 31, half = lane >> 5;
#pragma unroll
    for (int mi = 0; mi < 2; ++mi) {
      const int r = row0 + 64 * wm + 32 * mi + l31;
      if (r < nvalid) {
        const float w = lw[r];
        h16* d = act + (orow + r) * 256 + 32 * (2 * nt + wn);
#pragma unroll
        for (int q = 0; q < 4; ++q) {
          float v[4];
#pragma unroll
          for (int e = 0; e < 4; ++e) { const float g = acc[mi][0][4 * q + e], u = acc[mi][1][4 * q + e]; v[e] = silu_f(g) * u * w; }
          *(h16x4*)(d + 8 * q + 4 * half) = pack4(v[0], v[1], v[2], v[3]);
        }
      }
    }
  }
};
DEVI void phase7(PRef p, LDS unsigned char* lds) {
  const int G = gridDim.x;
  const unsigned* cnt = (const unsigned*)(p.ws + WS_CNT);
  for (int it = blockIdx.x;; it += G) {
    MoeItem m; if (!moe_decode(cnt, it, 4, m)) break;
    ARowGather ar{(const h16*)(p.ws + WS_H), (const unsigned*)(p.ws + WS_LIST) + (size_t)m.e * 32768, m.cnt, m.mt * 256};
    EpiAct epi{(h16*)(p.ws + WS_ACT), (const float*)(p.ws + WS_LISTW) + (size_t)m.e * 32768, m.mt * 256, m.cnt, m.nt, (size_t)m.off};
    gemm_tile(lds, ar, (const h16*)(p.ws + WS_WGU) + ((size_t)m.e * 512 + m.nt * 128) * DM, DM, DM, epi);
  }
}
DEVI void phase8(PRef p, LDS unsigned char* lds) {
  const int G = gridDim.x;
  const unsigned* cnt = (const unsigned*)(p.ws + WS_CNT);
  for (int it = blockIdx.x;; it += G) {
    MoeItem m; if (!moe_decode(cnt, it, 8, m)) break;
    ARowPlain ar{(const h16*)(p.ws + WS_ACT) + ((size_t)m.off + m.mt * 256) * 256, (size_t)256};
    EpiPlain epi{(h16*)(p.ws + WS_YP), DM, m.off + m.mt * 256, m.nt * 128, m.cnt - m.mt * 256};
    gemm_tile(lds, ar, (const h16*)(p.ws + WS_WDN) + ((size_t)m.e * 1024 + m.nt * 128) * 256, 256, 256, epi);
  }
}

DEVI void phase9(PRef p, LDS unsigned char* lds) {
  const int tid = launder((int)threadIdx.x), lane = tid & 63, wave = wave_id(tid), G = gridDim.x;
  const int b = blockIdx.x & 3, bi = blockIdx.x >> 2, nbk = G >> 2;
  LDS unsigned* offs = (LDS unsigned*)lds;
  if (tid == 0) { const unsigned* cnt = (const unsigned*)(p.ws + WS_CNT); unsigned o = 0; for (int e = 0; e < 32; ++e) { offs[e] = o; o += cnt[e]; } }
  __syncthreads();
  LDS float* mv = (LDS float*)(lds + 256);
  mod_to_lds(p, b, 5, mv);
  __syncthreads();
  f32x4 A3[4];
#pragma unroll
  for (int j = 0; j < 4; ++j) { const int k = 256 * j + 4 * lane; A3[j] = *(LDS f32x4*)(mv + k) * *(const f32x4*)(p.in[7] + k); }
  const h16* YP = (const h16*)(p.ws + WS_YP); const u32x4* ROUTE = (const u32x4*)(p.ws + WS_ROUTE); float* out = p.out;
  for (int r = bi * 8 + wave; r < SEQ; r += nbk * 8) {
    const size_t tok = (size_t)b * SEQ + r;
    const u32x4 rt = ROUTE[tok];
    const size_t r0 = (size_t)offs[rt[0]] + rt[1], r1 = (size_t)offs[rt[2]] + rt[3];
    f32x4 y[4]; float ss = 0.f;
#pragma unroll
    for (int j = 0; j < 4; ++j) {
      const h16x4 a = *(const h16x4*)(YP + r0 * DM + 256 * j + 4 * lane), c = *(const h16x4*)(YP + r1 * DM + 256 * j + 4 * lane);
#pragma unroll
      for (int e = 0; e < 4; ++e) { y[j][e] = (float)a[e] + (float)c[e]; ss += y[j][e] * y[j][e]; }
    }
    const float rs = 1.0f / sqrtf(wave_sum(ss) * (1.f / 1024.f) + 1e-6f);
#pragma unroll
    for (int j = 0; j < 4; ++j) {
      float* o = out + tok * DM + 256 * j + 4 * lane;
      const f32x4 x1 = *(const f32x4*)o;
      *(f32x4*)o = x1 + A3[j] * (y[j] * rs);
    }
  }
}


#define XB_TMO      128
#define XB_XCNT(j)  (256  + 64 * (j))
#define XB_XSUB(j)  (1280 + 64 * (j))
#define XB_XGEN(j)  (2304 + 64 * (j))
#define XB_TOP      3328
#define XB_TOPGEN   3392
#define XB_SPIN_CAP (1u << 22)
DEVI unsigned xb_ld(unsigned* p)              { return __hip_atomic_load(p, __ATOMIC_RELAXED, __HIP_MEMORY_SCOPE_AGENT); }
DEVI unsigned xb_add(unsigned* p, unsigned v) { return __hip_atomic_fetch_add(p, v, __ATOMIC_RELAXED, __HIP_MEMORY_SCOPE_AGENT); }
DEVI unsigned xb_xcc_id() { return (unsigned)__builtin_amdgcn_s_getreg((3 << 11) | 20) & 0xFu; }
#define XB_SPIN(cond, bar) do { unsigned _sp = 0; while (cond) { __builtin_amdgcn_s_sleep(1); \
    if ((++_sp & 255u) == 0u) { if (xb_ld(&(bar)[XB_TMO])) break; if (_sp > XB_SPIN_CAP) { atomicAdd(&(bar)[XB_TMO], 1u); break; } } } } while (0)
struct XcdBarrier { unsigned* bar; unsigned x; volatile LDS unsigned* st; };
DEVI XcdBarrier xcd_barrier_post(unsigned* bar, volatile LDS unsigned* st) {
  XcdBarrier b; b.bar = bar; b.x = xb_xcc_id(); b.st = st;
  if (threadIdx.x == 0) (void)xb_add(&bar[XB_XCNT(b.x)], 1u);
  return b;
}
DEVI void xcd_barrier_complete(unsigned* bar, unsigned x, unsigned& nloc, unsigned& nx) {
  const unsigned G = gridDim.x * gridDim.y * gridDim.z;
  unsigned sum, cnt, mine, sp = 0u;
  for (;;) {
    sum = 0u; cnt = 0u; mine = 0u;
#pragma unroll
    for (unsigned j = 0; j < 16; ++j) { const unsigned c = xb_ld(&bar[XB_XCNT(j)]); sum += c; cnt += (c > 0u) ? 1u : 0u; mine = (j == x) ? c : mine; }
    if (sum == G) break;
    __builtin_amdgcn_s_sleep(1);
    if ((++sp & 255u) == 0u) { if (xb_ld(&bar[XB_TMO])) break; if (sp > XB_SPIN_CAP) { atomicAdd(&bar[XB_TMO], 1u); break; } }
  }
  nloc = mine > 0u ? mine : 1u; nx = cnt > 0u ? cnt : 1u;
}
DEVI void xcd_barrier(const XcdBarrier& b) {
  asm volatile("s_waitcnt vmcnt(0)" ::: "memory");
  __syncthreads();
  if (threadIdx.x == 0) {
    unsigned* bar = b.bar;
    __builtin_amdgcn_s_waitcnt(0);
    unsigned nloc = b.st[0], nx = b.st[1];
    if (nloc == 0u) { xcd_barrier_complete(bar, b.x, nloc, nx); b.st[0] = nloc; b.st[1] = nx; }
    const unsigned old = xb_add(&bar[XB_XSUB(b.x)], 1u);
    const unsigned gen = old / nloc;
    if (old + 1u == (gen + 1u) * nloc) {
      __builtin_amdgcn_fence(__ATOMIC_RELEASE, "agent");
      asm volatile("s_waitcnt vmcnt(0)" ::: "memory");
      const unsigned og = xb_add(&bar[XB_TOP], 1u);
      const unsigned tg = og / nx;
      if (og + 1u == (tg + 1u) * nx) xb_add(&bar[XB_TOPGEN], 1u);
      else XB_SPIN(xb_ld(&bar[XB_TOPGEN]) == tg, bar);
      __builtin_amdgcn_fence(__ATOMIC_ACQUIRE, "agent");
      xb_add(&bar[XB_XGEN(b.x)], 1u);
      asm volatile("s_waitcnt vmcnt(0)" ::: "memory");
    } else {
      XB_SPIN(xb_ld(&bar[XB_XGEN(b.x)]) == gen, bar);
      __builtin_amdgcn_fence(__ATOMIC_ACQUIRE, "agent");
      asm volatile("s_waitcnt vmcnt(0)" ::: "memory");
    }
  }
  __syncthreads();
}

__global__ void __launch_bounds__(NTHR) fwd_kernel(Params p) {
  extern __shared__ __attribute__((aligned(16))) unsigned char smem[];
  LDS unsigned char* lds = (LDS unsigned char*)smem;
  const int lo = p.ph_lo, hi = p.ph_hi;
  volatile LDS unsigned* bst = (volatile LDS unsigned*)(lds + LDS_BYTES - 16);
  if (threadIdx.x < 4) bst[threadIdx.x] = 0u;
  __syncthreads();
  XcdBarrier xbar = xcd_barrier_post((unsigned*)(p.ws + WS_BAR), bst);
#ifndef REPEAT_PHASE
#define REPEAT_PHASE -1
#endif
#define GRID_SYNC(k) do { if ((k) == 0) cg::this_grid().sync(); else xcd_barrier(xbar); } while (0)
#define RUN_PHASE(k, fn) if (lo <= (k) && (k) < hi) { fn(*get_params(), lds); if ((k) == REPEAT_PHASE) { GRID_SYNC(k); fn(*get_params(), lds); } if ((k) + 1 < hi) GRID_SYNC(k); }
  RUN_PHASE(0, phase0)
  RUN_PHASE(1, phase1)
  RUN_PHASE(2, phase2)
  RUN_PHASE(3, phase3)
  RUN_PHASE(4, phase4)
  RUN_PHASE(5, phase5)
  RUN_PHASE(6, phase6)
  RUN_PHASE(7, phase7)
  RUN_PHASE(8, phase8)
  RUN_PHASE(9, phase9)
#undef GRID_SYNC
#undef RUN_PHASE
}

extern "C" void kernel_launch(void* const* d_in, const int* in_sizes, int n_in, void* d_out, int out_size, void* d_ws, size_t ws_size, hipStream_t stream) {
  static int grid = 0;
  if (grid == 0) {
    if (n_in != 24 || out_size != NTOK * DM || ws_size < WS_END) { fprintf(stderr, "kernel_launch: unexpected problem (n_in %d out %d ws %zu)\n", n_in, out_size, ws_size); grid = -1; return; }
    (void)hipFuncSetAttribute((const void*)fwd_kernel, hipFuncAttributeMaxDynamicSharedMemorySize, LDS_BYTES);
    int dev = 0, cus = 0, per_cu = 0;
    (void)hipGetDevice(&dev);
    (void)hipDeviceGetAttribute(&cus, hipDeviceAttributeMultiprocessorCount, dev);
    (void)hipOccupancyMaxActiveBlocksPerMultiprocessor(&per_cu, (const void*)fwd_kernel, NTHR, LDS_BYTES);
    if (per_cu < 1 || cus < 256) fprintf(stderr, "kernel_launch: occupancy %d blocks/CU on %d CUs\n", per_cu, cus);
    grid = 256;
  }
  if (grid < 0) return;
  (void)hipMemsetAsync((char*)d_ws + WS_CNT, 0, CTL_ZERO_BYTES, stream);
  Params p{};
  for (int i = 0; i < 24; ++i) p.in[i] = (const float*)d_in[i];
  p.out = (float*)d_out; p.ws = (unsigned char*)d_ws;
#if N_LAUNCH_MODE == 1
  p.ph_lo = 0; p.ph_hi = NPHASE;
  void* args[] = {&p};
  hipError_t e = hipLaunchCooperativeKernel((const void*)fwd_kernel, dim3(grid), dim3(NTHR), args, LDS_BYTES, stream);
  if (e != hipSuccess) fprintf(stderr, "cooperative launch failed: %s\n", hipGetErrorString(e));
#else
  for (int ph = 0; ph < NPHASE; ++ph) {
    p.ph_lo = ph; p.ph_hi = ph + 1;
    hipLaunchKernelGGL(fwd_kernel, dim3(grid), dim3(NTHR), LDS_BYTES, stream, p);
  }
#endif
}
```

```cpp
#include <hip/hip_runtime.h>
#include <hip/hip_cooperative_groups.h>
#include <cstdio>
#include <cstdint>
namespace cg = cooperative_groups;

#ifndef N_LAUNCH_MODE
#define N_LAUNCH_MODE 1
#endif

#define DEVI __device__ __forceinline__
#define LDS __attribute__((address_space(3)))

typedef _Float16 h16;
typedef _Float16 h16x4 __attribute__((ext_vector_type(4)));
typedef _Float16 h16x8 __attribute__((ext_vector_type(8)));
typedef float f32x4 __attribute__((ext_vector_type(4)));
typedef float f32x16 __attribute__((ext_vector_type(16)));
typedef unsigned u32x2 __attribute__((ext_vector_type(2)));
typedef unsigned u32x4 __attribute__((ext_vector_type(4)));

constexpr int NBATCH = 4, SEQ = 8192, NTOK = NBATCH * SEQ, DM = 1024;
constexpr int NTHR = 512;
constexpr int NPHASE = 10;
constexpr int LDS_BYTES = 163840;

constexpr size_t MiB = 1ull << 20;
constexpr size_t WS_CNT = 0;
constexpr size_t CTL_ZERO_BYTES = 20480;
constexpr size_t WS_BAR = 4096;
constexpr size_t WS_MODP = 64 * 1024;
constexpr size_t WS_ROPE = 1 * MiB;
constexpr size_t WS_WIN = 3 * MiB;
constexpr size_t WS_WOUT = 10 * MiB;
constexpr size_t WS_WGU = 12 * MiB;
constexpr size_t WS_WDN = 44 * MiB;
constexpr size_t WS_WRG = 60 * MiB;
constexpr size_t WS_WRT = 60 * MiB + 256 * 1024;
constexpr size_t WS_AGG = 61 * MiB;
constexpr size_t WS_ROUTE = 63 * MiB;
constexpr size_t WS_LIST = 64 * MiB;
constexpr size_t WS_LISTW = 68 * MiB;
constexpr size_t WS_WI = 72 * MiB;
constexpr size_t WS_KI = 73 * MiB;
constexpr size_t WS_MASK = 77 * MiB;
constexpr size_t WS_H = 109 * MiB;
constexpr size_t WS_Q = 173 * MiB;
constexpr size_t WS_K = 205 * MiB;
constexpr size_t WS_VT = 237 * MiB;
constexpr size_t WS_QI = 269 * MiB;
constexpr size_t WS_XR = 301 * MiB;
constexpr size_t WS_XG = 333 * MiB;
constexpr size_t WS_MIX = 365 * MiB;
constexpr size_t WS_ACT = 429 * MiB;
constexpr size_t WS_YP = 173 * MiB;
constexpr size_t WS_END = 462 * MiB;

struct Params { const float* in[24]; float* out; unsigned char* ws; int ph_lo, ph_hi; };
typedef const __attribute__((address_space(4))) Params& PRef;
typedef const __attribute__((address_space(4))) Params* PPtr;

__device__ const double ROPE_REV[32] = {
  1.59154943091895345608e-01, 1.19349370211248861917e-01, 8.94994016088910132600e-02, 6.71150830052272551196e-02,
  5.03292121044870352509e-02, 3.77415847174197710556e-02, 2.83021958306233986646e-02, 2.12236527647776604399e-02,
  1.59154943091895338669e-02, 1.19349370211248861917e-02, 8.94994016088910236684e-03, 6.71150830052272533849e-03,
  5.03292121044870369856e-03, 3.77415847174197719230e-03, 2.83021958306233986646e-03, 2.12236527647776621747e-03,
  1.59154943091895356017e-03, 1.19349370211248848907e-03, 8.94994016088910236684e-04, 6.71150830052272598901e-04,
  5.03292121044870326488e-04, 3.77415847174197740914e-04, 2.83021958306233954120e-04, 2.12236527647776605484e-04,
  1.59154943091895350596e-04, 1.19349370211248862459e-04, 8.94994016088910182474e-05, 6.71150830052272544691e-05,
  5.03292121044870353593e-05, 3.77415847174197768019e-05, 2.83021958306233960897e-05, 2.12236527647776591931e-05};

DEVI int launder(int x) { asm volatile("" : "+v"(x)); return x; }
DEVI PPtr get_params() { PPtr k = (PPtr)__builtin_amdgcn_kernarg_segment_ptr(); asm volatile("" : "+s"(k)); return k; }
DEVI int wave_id(int tid) { return __builtin_amdgcn_readfirstlane(tid >> 6); }
DEVI f32x16 mfma16(h16x8 a, h16x8 b, f32x16 c) { return __builtin_amdgcn_mfma_f32_32x32x16_f16(a, b, c, 0, 0, 0); }
DEVI float wave_sum(float v) {
#pragma unroll
  for (int o = 1; o < 64; o <<= 1) v += __shfl_xor(v, o);
  return v;
}
DEVI float sigmoid_f(float x) { return 1.f / (1.f + __expf(-x)); }
DEVI float silu_f(float x) { return x / (1.f + __expf(-x)); }
DEVI float gelu_tanh_f(float x) {
  const float u = 0.7978845608028654f * (x + 0.044715f * x * x * x);
  const float t = 1.f - 2.f / (1.f + __expf(2.f * u));
  return 0.5f * x * (1.f + t);
}
DEVI unsigned fkey(float f) { unsigned u = __float_as_uint(f); return (u & 0x80000000u) ? ~u : (u | 0x80000000u); }
DEVI float fkey_inv(unsigned k) { unsigned u = (k & 0x80000000u) ? (k & 0x7fffffffu) : ~k; return __uint_as_float(u); }
DEVI int vt_perm(int pos) { return (pos & ~12) | ((pos & 4) << 1) | ((pos & 8) >> 1); }

DEVI void mod_to_lds(PRef p, int b, int chunk, LDS float* dst) {
  const float* mp = (const float*)(p.ws + WS_MODP);
  for (int k = threadIdx.x; k < 1024; k += NTHR) {
    const int j = chunk * 1024 + k;
    float s = p.in[3][j];
#pragma unroll 1
    for (int ks = 0; ks < 8; ++ks) s += mp[(size_t)(ks * 4 + b) * 6144 + j];
    dst[k] = s;
  }
}

constexpr int LROW = 144;
constexpr int GA_BYTES = 256 * LROW, GB_BYTES = 128 * LROW, GSTAGE = GA_BYTES + GB_BYTES;

template <class AR, class EPI>
DEVI void gemm_tile(LDS unsigned char* lds, const AR& arow, const h16* Bt, int ldb, int K, EPI& epi) {
  const int tid = launder((int)threadIdx.x), lane = tid & 63, wave = wave_id(tid), wm = wave >> 1, wn = wave & 1;
  const int lr = tid >> 3, lc = tid & 7, l31 = lane & 31, half = lane >> 5;
  const h16* pa[4]; const h16* pb[2];
#pragma unroll
  for (int j = 0; j < 4; ++j) pa[j] = arow(lr + 64 * j) + lc * 8;
#pragma unroll
  for (int j = 0; j < 2; ++j) pb[j] = Bt + (size_t)(lr + 64 * j) * ldb + lc * 8;
  h16x8 ra[4], rb[2];
#pragma unroll
  for (int j = 0; j < 4; ++j) ra[j] = *(const h16x8*)pa[j];
#pragma unroll
  for (int j = 0; j < 2; ++j) rb[j] = *(const h16x8*)pb[j];
#pragma unroll
  for (int j = 0; j < 4; ++j) *(LDS h16x8*)(lds + (lr + 64 * j) * LROW + lc * 16) = ra[j];
#pragma unroll
  for (int j = 0; j < 2; ++j) *(LDS h16x8*)(lds + GA_BYTES + (lr + 64 * j) * LROW + lc * 16) = rb[j];
  __syncthreads();
  f32x16 acc[2][2];
#pragma unroll
  for (int a = 0; a < 2; ++a)
#pragma unroll
    for (int b = 0; b < 2; ++b)
#pragma unroll
      for (int r = 0; r < 16; ++r) acc[a][b][r] = 0.f;
  const int KT = K >> 6;
  for (int kt = 0; kt < KT; ++kt) {
    const int cur = kt & 1;
    if (kt + 1 < KT) {
#pragma unroll
      for (int j = 0; j < 4; ++j) ra[j] = *(const h16x8*)(pa[j] + (kt + 1) * 64);
#pragma unroll
      for (int j = 0; j < 2; ++j) rb[j] = *(const h16x8*)(pb[j] + (kt + 1) * 64);
    }
    LDS unsigned char* A = lds + cur * GSTAGE;
    LDS unsigned char* B = A + GA_BYTES;
#pragma unroll
    for (int kk = 0; kk < 4; ++kk) {
      h16x8 af[2], bf[2];
#pragma unroll
      for (int mi = 0; mi < 2; ++mi) af[mi] = *(LDS h16x8*)(A + (64 * wm + 32 * mi + l31) * LROW + (2 * kk + half) * 16);
#pragma unroll
      for (int ni = 0; ni < 2; ++ni) bf[ni] = *(LDS h16x8*)(B + (64 * wn + 32 * ni + l31) * LROW + (2 * kk + half) * 16);
#pragma unroll
      for (int mi = 0; mi < 2; ++mi)
#pragma unroll
        for (int ni = 0; ni < 2; ++ni) acc[mi][ni] = mfma16(bf[ni], af[mi], acc[mi][ni]);
    }
    if (kt + 1 < KT) {
      LDS unsigned char* A2 = lds + (cur ^ 1) * GSTAGE;
#pragma unroll
      for (int j = 0; j < 4; ++j) *(LDS h16x8*)(A2 + (lr + 64 * j) * LROW + lc * 16) = ra[j];
#pragma unroll
      for (int j = 0; j < 2; ++j) *(LDS h16x8*)(A2 + GA_BYTES + (lr + 64 * j) * LROW + lc * 16) = rb[j];
    }
    __syncthreads();
  }
  epi(acc, wm, wn, lane);
}

struct ARowPlain { const h16* base; size_t ld; DEVI const h16* operator()(int r) const { return base + (size_t)r * ld; } };
struct ARowGather { const h16* base; const unsigned* list; int n; int row0; DEVI const h16* operator()(int r) const { const int i = row0 + r; const unsigned t = (i < n) ? list[i] : 0u; return base + (size_t)t * DM; } };

DEVI h16x4 pack4(float a, float b, float c, float d) { h16x4 v; v[0] = (h16)a; v[1] = (h16)b; v[2] = (h16)c; v[3] = (h16)d; return v; }

template <class F>
DEVI void transpose_tile(const float* src, int N, int kb, int nb, h16* dst, int ldd, F drow, LDS float* tile) {
  const int tid = launder((int)threadIdx.x);
#pragma unroll
  for (int j = 0; j < 8; ++j) {
    const int kl = (tid >> 6) + 8 * j, nl = tid & 63, n = nb * 64 + nl;
    tile[kl * 65 + nl] = (n < N) ? src[(size_t)(kb * 64 + kl) * N + n] : 0.f;
  }
  __syncthreads();
  const int nl = tid >> 3, ch = tid & 7, n = nb * 64 + nl;
  if (n < N) {
    h16x8 v;
#pragma unroll
    for (int e = 0; e < 8; ++e) v[e] = (h16)tile[(ch * 8 + e) * 65 + nl];
    *(h16x8*)(dst + (size_t)drow(n) * ldd + kb * 64 + ch * 8) = v;
  }
  __syncthreads();
}

DEVI void phase0(PRef p, LDS unsigned char* lds) {
  const int tid = launder((int)threadIdx.x), lane = tid & 63, wave = wave_id(tid), G = gridDim.x;
  const int gw = blockIdx.x * 8 + wave, NW = G * 8;
  {
    const float* c = p.in[1]; const float* wada = p.in[2]; float* mp = (float*)(p.ws + WS_MODP);
    for (int u = gw; u < 96 * 8; u += NW) {
      const int cgp = u % 96, ks = u / 96, j = cgp * 64 + lane;
      float a0 = 0.f, a1 = 0.f, a2 = 0.f, a3 = 0.f;
      for (int k = ks * 128; k < ks * 128 + 128; ++k) {
        const float w = wada[(size_t)k * 6144 + j];
        a0 = fmaf(silu_f(c[k]), w, a0); a1 = fmaf(silu_f(c[1024 + k]), w, a1);
        a2 = fmaf(silu_f(c[2048 + k]), w, a2); a3 = fmaf(silu_f(c[3072 + k]), w, a3);
      }
      mp[(size_t)(ks * 4 + 0) * 6144 + j] = a0; mp[(size_t)(ks * 4 + 1) * 6144 + j] = a1;
      mp[(size_t)(ks * 4 + 2) * 6144 + j] = a2; mp[(size_t)(ks * 4 + 3) * 6144 + j] = a3;
    }
  }
  {
    LDS float* tile = (LDS float*)lds;
    constexpr int I_IN = 16 * 50, I_OUT = 16 * 16, I_G = 32 * 64, I_U = 32 * 64, I_D = 32 * 64, I_RG = 16;
    constexpr int NIT = I_IN + I_OUT + I_G + I_U + I_D + I_RG;
    for (int it = blockIdx.x; it < NIT; it += G) {
      int r = it;
      if (r < I_IN) {
        transpose_tile(p.in[8], 3144, r / 50, r % 50, (h16*)(p.ws + WS_WIN), 1024,
                       [](int n) { return n < 2112 ? n : (n < 2120 ? 3136 + (n - 2112) : (n < 2632 ? 2112 + (n - 2120) : 2624 + (n - 2632))); }, tile);
        continue;
      }
      r -= I_IN;
      if (r < I_OUT) { transpose_tile(p.in[16], 1024, r / 16, r % 16, (h16*)(p.ws + WS_WOUT), 1024, [](int n) { return n; }, tile); continue; }
      r -= I_OUT;
      if (r < I_G) { const int e = r >> 6, q = r & 63;
        transpose_tile(p.in[21] + (size_t)e * 1024 * 256, 256, q >> 2, q & 3, (h16*)(p.ws + WS_WGU) + (size_t)e * 512 * 1024, 1024, [](int f) { return (f >> 5) * 64 + (f & 31); }, tile); continue; }
      r -= I_G;
      if (r < I_U) { const int e = r >> 6, q = r & 63;
        transpose_tile(p.in[22] + (size_t)e * 1024 * 256, 256, q >> 2, q & 3, (h16*)(p.ws + WS_WGU) + (size_t)e * 512 * 1024, 1024, [](int f) { return (f >> 5) * 64 + 32 + (f & 31); }, tile); continue; }
      r -= I_U;
      if (r < I_D) { const int e = r >> 6, q = r & 63;
        transpose_tile(p.in[23] + (size_t)e * 256 * 1024, 1024, q >> 4, q & 15, (h16*)(p.ws + WS_WDN) + (size_t)e * 1024 * 256, 256, [](int n) { return n; }, tile); continue; }
      r -= I_D;
      if (r < 8) transpose_tile(p.in[11] + (size_t)r * 4096, 64, 0, 0, (h16*)(p.ws + WS_WRG) + (size_t)r * 128 * 64, 64, [](int n) { return n; }, tile);
      else transpose_tile(p.in[13] + (size_t)(r - 8) * 4096, 64, 0, 0, (h16*)(p.ws + WS_WRG) + (size_t)(r - 8) * 128 * 64, 64, [](int n) { return 64 + n; }, tile);
    }
  }
  {
    float* wrt = (float*)(p.ws + WS_WRT);
    for (int i = blockIdx.x * NTHR + tid; i < 36 * 1024; i += G * NTHR) {
      const int col = i >> 10, k = i & 1023;
      wrt[i] = (col < 4) ? p.in[17][k * 4 + col] : p.in[19][k * 32 + (col - 4)];
    }
    float* ct = (float*)(p.ws + WS_ROPE); float* st = ct + 8192 * 32;
    for (int i = blockIdx.x * NTHR + tid; i < 8192 * 32; i += G * NTHR) {
      const int pos = i >> 5, f = i & 31;
      const double rev = (double)pos * ROPE_REV[f];
      const float fr = (float)(rev - __builtin_rint(rev));
      ct[i] = __builtin_amdgcn_cosf(fr); st[i] = __builtin_amdgcn_sinf(fr);
    }
  }
}

DEVI void phase1(PRef p, LDS unsigned char* lds) {
  const int tid = launder((int)threadIdx.x), lane = tid & 63, wave = wave_id(tid), G = gridDim.x;
  const int b = blockIdx.x & 3, bi = blockIdx.x >> 2, nbk = G >> 2;
  LDS float* mv = (LDS float*)lds;
  mod_to_lds(p, b, 0, mv); mod_to_lds(p, b, 1, mv + 1024);
  __syncthreads();
  f32x4 A[4], SH[4];
#pragma unroll
  for (int j = 0; j < 4; ++j) {
    const int k = 256 * j + 4 * lane;
    const f32x4 g = *(const f32x4*)(p.in[4] + k);
    A[j] = g * (*(LDS f32x4*)(mv + 1024 + k) + 1.f);
    SH[j] = *(LDS f32x4*)(mv + k);
  }
  const float* x = p.in[0]; h16* H = (h16*)(p.ws + WS_H);
  for (int r = bi * 8 + wave; r < SEQ; r += nbk * 8) {
    const size_t tok = (size_t)b * SEQ + r;
    f32x4 v[4]; float ss = 0.f;
#pragma unroll
    for (int j = 0; j < 4; ++j) { v[j] = *(const f32x4*)(x + tok * DM + 256 * j + 4 * lane); ss += v[j][0] * v[j][0] + v[j][1] * v[j][1] + v[j][2] * v[j][2] + v[j][3] * v[j][3]; }
    const float rstd = 1.0f / sqrtf(wave_sum(ss) * (1.f / 1024.f) + 1e-6f);
#pragma unroll
    for (int j = 0; j < 4; ++j) {
      const f32x4 y = v[j] * rstd * A[j] + SH[j];
      *(h16x4*)(H + tok * DM + 256 * j + 4 * lane) = pack4(y[0], y[1], y[2], y[3]);
    }
  }
}

struct EpiInProj {
  unsigned char* ws; int mt, nt;
  DEVI void operator()(const f32x16 (&acc)[2][2], int wm, int wn, int lane) const {
    const int l31 = lane & 31, half = lane >> 5;
    const int g = 2 * nt + wn;
    const float* cosT = (const float*)(ws + WS_ROPE); const float* sinT = cosT + 8192 * 32;
#pragma unroll
    for (int mi = 0; mi < 2; ++mi) {
      const int tok = mt * 256 + 64 * wm + 32 * mi + l31;
      const int b = tok >> 13, pos = tok & 8191;
      if (g < 16 || (g >= 24 && g <= 32)) {
        float scl; h16* dst;
        if (g < 8) { scl = 0.125f * 1.4426950408889634f; dst = (h16*)(ws + WS_Q) + (size_t)tok * 512 + g * 64; }
        else if (g < 16) { scl = 1.f; dst = (h16*)(ws + WS_K) + (size_t)tok * 512 + (g - 8) * 64; }
        else if (g < 32) { scl = 0.125f; dst = (h16*)(ws + WS_QI) + (size_t)tok * 512 + (g - 24) * 64; }
        else { scl = 1.f; dst = (h16*)(ws + WS_KI) + (size_t)tok * 64; }
#pragma unroll
        for (int q = 0; q < 4; ++q) {
          const int d0 = 8 * q + 4 * half;
          const f32x4 c = *(const f32x4*)(cosT + pos * 32 + d0), s = *(const f32x4*)(sinT + pos * 32 + d0);
          float o1[4], o2[4];
#pragma unroll
          for (int e = 0; e < 4; ++e) {
            const float x1 = acc[mi][0][4 * q + e], x2 = acc[mi][1][4 * q + e];
            o1[e] = (x1 * c[e] - x2 * s[e]) * scl; o2[e] = (x2 * c[e] + x1 * s[e]) * scl;
          }
          *(h16x4*)(dst + d0) = pack4(o1[0], o1[1], o1[2], o1[3]);
          *(h16x4*)(dst + 32 + d0) = pack4(o2[0], o2[1], o2[2], o2[3]);
        }
      } else if (g < 24) {
        h16* vt = (h16*)(ws + WS_VT) + (size_t)(b * 8 + (g - 16)) * 64 * 8192 + vt_perm(pos);
#pragma unroll
        for (int ni = 0; ni < 2; ++ni)
#pragma unroll
          for (int r = 0; r < 16; ++r) { const int d = 32 * ni + 8 * (r >> 2) + 4 * half + (r & 3); vt[(size_t)d * 8192] = (h16)acc[mi][ni][r]; }
      } else if (g < 49) {
        h16* dst = (g < 41) ? (h16*)(ws + WS_XR) + (size_t)tok * 512 + (g - 33) * 64 : (h16*)(ws + WS_XG) + (size_t)tok * 512 + (g - 41) * 64;
#pragma unroll
        for (int ni = 0; ni < 2; ++ni)
#pragma unroll
          for (int q = 0; q < 4; ++q)
            *(h16x4*)(dst + 32 * ni + 8 * q + 4 * half) = pack4(acc[mi][ni][4 * q], acc[mi][ni][4 * q + 1], acc[mi][ni][4 * q + 2], acc[mi][ni][4 * q + 3]);
      } else {
        const float sc = 0.35355339059327373f;
        f32x4 v; v[0] = acc[mi][0][0] * sc; v[1] = acc[mi][0][1] * sc; v[2] = acc[mi][0][2] * sc; v[3] = acc[mi][0][3] * sc;
        *(f32x4*)((float*)(ws + WS_WI) + (size_t)tok * 8 + 4 * half) = v;
      }
    }
  }
};

DEVI void phase2(PRef p, LDS unsigned char* lds) {
  const int G = gridDim.x;
  const h16* H = (const h16*)(p.ws + WS_H); const h16* W = (const h16*)(p.ws + WS_WIN);
  for (int it = blockIdx.x; it < 128 * 25; it += G) {
    const int mt = it / 25, nt = it % 25;
    ARowPlain ar{H + (size_t)mt * 256 * DM, (size_t)DM};
    EpiInProj epi{p.ws, mt, nt};
    gemm_tile(lds, ar, W + (size_t)nt * 128 * DM, DM, DM, epi);
  }
}

constexpr int CROW = 1040;
constexpr int RNN_XG = 64 * CROW;
constexpr int RNN_CARRY = 2 * 64 * CROW;
template <int MODE>
DEVI void rnn_item(PRef p, LDS unsigned char* lds, int b, int cr) {
  const int tid = launder((int)threadIdx.x), lane = tid & 63, wave = wave_id(tid), l31 = lane & 31, half = lane >> 5;
  const h16* XR = (const h16*)(p.ws + WS_XR);
  {
    const int chg = tid & 63, tg = tid >> 6, pos0 = cr * 64 + 8 * tg;
    h16x8 xin[11];
#pragma unroll
    for (int i = 0; i < 11; ++i) {
      const int pos = pos0 + i - 3;
      if (pos >= 0) xin[i] = *(const h16x8*)(XR + ((size_t)b * SEQ + pos) * 512 + chg * 8);
      else {
#pragma unroll
        for (int e = 0; e < 8; ++e) xin[i][e] = (h16)0.f;
      }
    }
    float cw[4][8], cb[8];
#pragma unroll
    for (int e = 0; e < 8; ++e) {
      cb[e] = p.in[10][chg * 8 + e];
#pragma unroll
      for (int j = 0; j < 4; ++j) cw[j][e] = p.in[9][j * 512 + chg * 8 + e];
    }
#pragma unroll
    for (int tt = 0; tt < 8; ++tt) {
      h16x8 o;
#pragma unroll
      for (int e = 0; e < 8; ++e) {
        float v = cb[e];
#pragma unroll
        for (int j = 0; j < 4; ++j) v = fmaf(cw[j][e], (float)xin[tt + j][e], v);
        o[e] = (h16)v;
      }
      *(LDS h16x8*)(lds + (8 * tg + tt) * CROW + chg * 16) = o;
    }
  }
  if (MODE == 1) {
    const float2* ag = (const float2*)(p.ws + WS_AGG) + (size_t)b * 128 * 512 + tid;
    float carry = 0.f; int c2 = 0;
    for (; c2 + 8 <= cr; c2 += 8) {
      float2 v[8];
#pragma unroll
      for (int u = 0; u < 8; ++u) v[u] = ag[(size_t)(c2 + u) * 512];
#pragma unroll
      for (int u = 0; u < 8; ++u) carry = fmaf(v[u].x, carry, v[u].y);
    }
    for (; c2 < cr; ++c2) { const float2 v = ag[(size_t)c2 * 512]; carry = fmaf(v.x, carry, v.y); }
    ((LDS float*)(lds + RNN_CARRY))[tid] = carry;
  }
  if (MODE == 1) {
    const h16* XG = (const h16*)(p.ws + WS_XG) + ((size_t)b * SEQ + cr * 64) * 512;
#pragma unroll
    for (int i = 0; i < 8; ++i) { const int c = tid + NTHR * i, row = c >> 6, cc = c & 63; *(LDS h16x8*)(lds + RNN_XG + row * CROW + cc * 16) = *(const h16x8*)(XG + (size_t)row * 512 + cc * 8); }
  }
  __syncthreads();
  const int n = wave;
  const h16* WRG = (const h16*)(p.ws + WS_WRG) + (size_t)n * 128 * 64;
  float* AGG = (float*)(p.ws + WS_AGG);
#pragma unroll 1
  for (int dt = 0; dt < 2; ++dt) {
    h16x8 wa[4], wx[4];
#pragma unroll
    for (int kk = 0; kk < 4; ++kk) {
      wa[kk] = *(const h16x8*)(WRG + (size_t)(32 * dt + l31) * 64 + 16 * kk + 8 * half);
      wx[kk] = *(const h16x8*)(WRG + (size_t)(64 + 32 * dt + l31) * 64 + 16 * kk + 8 * half);
    }
    f32x16 ra[2], rx[2];
#pragma unroll
    for (int ti = 0; ti < 2; ++ti) {
#pragma unroll
      for (int r = 0; r < 16; ++r) { ra[ti][r] = 0.f; rx[ti][r] = 0.f; }
#pragma unroll
      for (int kk = 0; kk < 4; ++kk) {
        const h16x8 af = *(LDS h16x8*)(lds + (32 * ti + l31) * CROW + (n * 64 + 16 * kk + 8 * half) * 2);
        ra[ti] = mfma16(af, wa[kk], ra[ti]);
        rx[ti] = mfma16(af, wx[kk], rx[ti]);
      }
    }
    const int ch = n * 64 + 32 * dt + l31;
    const float ba = p.in[12][ch], bx = p.in[14][ch], lam = p.in[15][ch];
    const float c8 = -8.f * log1pf(__expf(-lam));
#pragma unroll
    for (int ti = 0; ti < 2; ++ti)
#pragma unroll
      for (int r = 0; r < 16; ++r) {
        const int tk = 32 * ti + (r & 3) + 8 * (r >> 2) + 4 * half;
        const float cv = (float)*(LDS h16*)(lds + tk * CROW + ch * 2);
        const float rr = sigmoid_f(ra[ti][r] + ba), ii = sigmoid_f(rx[ti][r] + bx);
        const float la = c8 * rr;
        ra[ti][r] = __expf(la);
        rx[ti][r] = sqrtf(-expm1f(2.f * la)) * (ii * cv);
      }
    float P[8], Hs[8];
#pragma unroll
    for (int sg = 0; sg < 8; ++sg) {
      const int ti = sg >> 2, q = sg & 3;
      float pp = 1.f, hh = 0.f;
#pragma unroll
      for (int i = 0; i < 4; ++i) { const float a = ra[ti][4 * q + i], bb = rx[ti][4 * q + i]; hh = fmaf(a, hh, bb); pp *= a; }
      P[sg] = pp; Hs[sg] = hh;
    }
    float carry = 0.f, prod = 1.f;
    if (MODE == 1) carry = ((LDS float*)(lds + RNN_CARRY))[ch];
    float cin[8];
#pragma unroll
    for (int sg = 0; sg < 8; ++sg)
#pragma unroll
      for (int ow = 0; ow < 2; ++ow) {
        const float tmp = fmaf(P[sg], carry, Hs[sg]);
        const float tp = P[sg] * prod;
        if (half == ow) cin[sg] = carry;
        const float oth = __shfl_xor(tmp, 32), otp = __shfl_xor(tp, 32);
        carry = (half == ow) ? tmp : oth;
        prod = (half == ow) ? tp : otp;
      }
    if (MODE == 0) {
      if (half == 0) { float* ag = AGG + ((size_t)(b * 128 + cr) * 512 + ch) * 2; ag[0] = prod; ag[1] = carry; }
    } else {
#pragma unroll
      for (int sg = 0; sg < 8; ++sg) {
        const int ti = sg >> 2, q = sg & 3;
        float hh = cin[sg];
#pragma unroll
        for (int i = 0; i < 4; ++i) {
          hh = fmaf(ra[ti][4 * q + i], hh, rx[ti][4 * q + i]);
          LDS h16* xp = (LDS h16*)(lds + RNN_XG + (32 * ti + 8 * q + 4 * half + i) * CROW + ch * 2);
          *xp = (h16)(hh * gelu_tanh_f((float)*xp));
        }
      }
    }
  }
  __syncthreads();
  if (MODE == 1) {
    h16* Y = (h16*)(p.ws + WS_H) + ((size_t)b * SEQ + cr * 64) * DM + 512;
#pragma unroll
    for (int i = 0; i < 8; ++i) { const int c = tid + NTHR * i, row = c >> 6, cc = c & 63; *(h16x8*)(Y + (size_t)row * DM + cc * 8) = *(LDS h16x8*)(lds + RNN_XG + row * CROW + cc * 16); }
    __syncthreads();
  }
}

constexpr int IDX_NB = 256, IDX_CAP = 128;
constexpr int IL_HIST = 0, IL_CS = 65536, IL_CK = IL_CS + 64 * IDX_CAP * 4, IL_KI = IL_CK + 64 * IDX_CAP * 2, IL_KISZ = 128 * LROW, IL_ST = IL_KI + 2 * IL_KISZ;
static_assert(IL_ST + 4096 <= LDS_BYTES, "indexer LDS map");

DEVI f32x4 mfma16s(h16x8 a, h16x8 b, f32x4 c) { return __builtin_amdgcn_mfma_f32_16x16x32_f16(a, b, c, 0, 0, 0); }
DEVI void idx_score(LDS unsigned char* kit, int kh, int l15, int g4, const h16x8 (&qf)[8][2], const float (&wq)[8], f32x4 (&sc)[4]) {
  h16x8 kf[4][2];
#pragma unroll
  for (int kt = 0; kt < 4; ++kt)
#pragma unroll
    for (int ks = 0; ks < 2; ++ks) kf[kt][ks] = *(LDS h16x8*)(kit + (64 * kh + 16 * kt + l15) * LROW + (4 * ks + g4) * 16);
#pragma unroll
  for (int kt = 0; kt < 4; ++kt) sc[kt] = (f32x4){0.f, 0.f, 0.f, 0.f};
#pragma unroll
  for (int h = 0; h < 8; ++h) {
#pragma unroll
    for (int kt = 0; kt < 4; ++kt) {
      f32x4 acc = (f32x4){0.f, 0.f, 0.f, 0.f};
      acc = mfma16s(kf[kt][0], qf[h][0], acc);
      acc = mfma16s(kf[kt][1], qf[h][1], acc);
#pragma unroll
      for (int r = 0; r < 4; ++r) sc[kt][r] = __builtin_fmaf(wq[h], __builtin_fmaxf(acc[r], 0.f), sc[kt][r]);
    }
    if (h & 1) __builtin_amdgcn_sched_barrier(0);
  }
}

template <int MODE>
DEVI void idx_pass(LDS unsigned char* lds, const h16* KIb, int N, int stride, int qg, int kh,
                   const h16* QIrow0, const float* WIrow0, float qinv, float qoff, int bstar) {
  const int tid = launder((int)threadIdx.x), lane = tid & 63, l15 = lane & 15, g4 = lane >> 4;
  const int q = 16 * qg + l15;
  h16x8 qf[8][2]; float wq[8];
  {
    const h16* QI = QIrow0 + (size_t)q * 512;
#pragma unroll
    for (int h = 0; h < 8; ++h)
#pragma unroll
      for (int ks = 0; ks < 2; ++ks) qf[h][ks] = *(const h16x8*)(QI + h * 64 + 32 * ks + 8 * g4);
    const float* WI = WIrow0 + (size_t)q * 8;
#pragma unroll
    for (int h = 0; h < 8; ++h) wq[h] = WI[h];
  }
  LDS unsigned* hist = (LDS unsigned*)(lds + IL_HIST);
  LDS unsigned* st = (LDS unsigned*)(lds + IL_ST);
  const int nst = (N + 127) >> 7;
  const int lr = tid >> 3, lc = tid & 7;
  h16x8 r0, r1;
  r0 = *(const h16x8*)(KIb + (size_t)lr * 64 + lc * 8); r1 = *(const h16x8*)(KIb + (size_t)(lr + 64) * 64 + lc * 8);
  *(LDS h16x8*)(lds + IL_KI + lr * LROW + lc * 16) = r0; *(LDS h16x8*)(lds + IL_KI + (lr + 64) * LROW + lc * 16) = r1;
  __syncthreads();
  float vmin = INFINITY, vmax = -INFINITY;
  int cur = 0;
  for (int s = 0; s < nst; s += stride) {
    const int nx = s + stride;
    if (nx < nst) { r0 = *(const h16x8*)(KIb + (size_t)(128 * nx + lr) * 64 + lc * 8); r1 = *(const h16x8*)(KIb + (size_t)(128 * nx + lr + 64) * 64 + lc * 8); }
    if (128 * s + 64 * kh < N) {
      f32x4 sc[4];
      idx_score(lds + IL_KI + cur * IL_KISZ, kh, l15, g4, qf, wq, sc);
      if (MODE == 0) {
#pragma unroll
        for (int kt = 0; kt < 4; ++kt)
#pragma unroll
          for (int r = 0; r < 4; ++r) { vmin = fminf(vmin, sc[kt][r]); vmax = fmaxf(vmax, sc[kt][r]); }
      } else if (MODE == 1) {
#pragma unroll
        for (int kt = 0; kt < 4; ++kt)
#pragma unroll
          for (int r = 0; r < 4; ++r) {
            const float xb = fminf(fmaxf(__builtin_fmaf(sc[kt][r], qinv, qoff), 0.f), (float)(IDX_NB - 1));
            const int bin = (int)xb;
            __hip_atomic_fetch_add(&hist[bin * 64 + q], 1u, __ATOMIC_RELAXED, __HIP_MEMORY_SCOPE_WORKGROUP);
          }
      } else {
        unsigned nib = 0u;
#pragma unroll
        for (int kt = 0; kt < 4; ++kt)
#pragma unroll
          for (int r = 0; r < 4; ++r) {
            const float xb = fminf(fmaxf(__builtin_fmaf(sc[kt][r], qinv, qoff), 0.f), (float)(IDX_NB - 1));
            const int bin = (int)xb;
            if (bin > bstar) nib |= (1u << (4 * kt + r));
            else if (bin == bstar) {
              const unsigned pos = __hip_atomic_fetch_add(&st[128 + q], 1u, __ATOMIC_RELAXED, __HIP_MEMORY_SCOPE_WORKGROUP);
              if (pos < (unsigned)IDX_CAP) {
                ((LDS float*)(lds + IL_CS))[q * IDX_CAP + pos] = sc[kt][r];
                ((LDS unsigned short*)(lds + IL_CK))[q * IDX_CAP + pos] = (unsigned short)(128 * s + 64 * kh + 16 * kt + 4 * g4 + r);
              }
            }
          }
        const unsigned oth = (unsigned)__shfl_xor((int)nib, 32);
        if (lane < 32) {
#pragma unroll
          for (int T = 0; T < 2; ++T) {
            const unsigned b0 = ((nib >> (8 * T)) & 15u) | (((oth >> (8 * T)) & 15u) << 4);
            const unsigned b1 = ((nib >> (8 * T + 4)) & 15u) | (((oth >> (8 * T + 4)) & 15u) << 4);
            ((LDS unsigned short*)(lds + IL_HIST))[q * 512 + (4 * s + 2 * kh + T) * 2 + (g4 & 1)] = (unsigned short)(b0 | (b1 << 8));
          }
        }
      }
    }
    if (nx < nst) {
      *(LDS h16x8*)(lds + IL_KI + (cur ^ 1) * IL_KISZ + lr * LROW + lc * 16) = r0;
      *(LDS h16x8*)(lds + IL_KI + (cur ^ 1) * IL_KISZ + (lr + 64) * LROW + lc * 16) = r1;
    }
    __syncthreads();
    cur ^= 1;
  }
  if (MODE == 0) {
    __hip_atomic_fetch_min(&st[q], fkey(vmin), __ATOMIC_RELAXED, __HIP_MEMORY_SCOPE_WORKGROUP);
    __hip_atomic_fetch_max(&st[64 + q], fkey(vmax), __ATOMIC_RELAXED, __HIP_MEMORY_SCOPE_WORKGROUP);
  }
}

DEVI void idx_item(PRef p, LDS unsigned char* lds, int b, int c) {
  const int tid = launder((int)threadIdx.x), lane = tid & 63, wave = wave_id(tid), l31 = lane & 31, half = lane >> 5;
  const int N = 64 * (c + 1);
  unsigned* MASK = (unsigned*)(p.ws + WS_MASK) + ((size_t)b * SEQ + 64 * c) * 256;
  if (N <= 256) {
    const int wpr = N >> 5;
    for (int i = tid; i < 64 * wpr; i += NTHR) MASK[(size_t)(i / wpr) * 256 + (i % wpr)] = 0xFFFFFFFFu;
    return;
  }
  const int qg = wave & 3, kh = wave >> 2, l15 = lane & 15, q = 16 * qg + l15;
  const h16* QIrow0 = (const h16*)(p.ws + WS_QI) + ((size_t)b * SEQ + 64 * c) * 512;
  const float* WIrow0 = (const float*)(p.ws + WS_WI) + ((size_t)b * SEQ + 64 * c) * 8;
  const h16* KIb = (const h16*)(p.ws + WS_KI) + (size_t)b * SEQ * 64;
  LDS unsigned* st = (LDS unsigned*)(lds + IL_ST);
  LDS float* stf = (LDS float*)(lds + IL_ST);
  if (tid < 64) { st[tid] = 0xFFFFFFFFu; st[64 + tid] = 0u; st[128 + tid] = 0u; }
  __syncthreads();
  const int nst = (N + 127) >> 7;
  const int stride = nst >= 16 ? 8 : (nst >= 8 ? 4 : (nst >= 4 ? 2 : 1));
  idx_pass<0>(lds, KIb, N, stride, qg, kh, QIrow0, WIrow0, 0.f, 0.f, 0);
  __syncthreads();
  if (tid < 64) {
    const float lo = fkey_inv(st[tid]), hi = fkey_inv(st[64 + tid]);
    float d = hi - lo; if (!(d > 1e-20f)) d = 1.f;
    const float inv = (float)IDX_NB / (1.5f * d);
    stf[192 + tid] = inv; stf[256 + tid] = -(lo - 0.25f * d) * inv;
  }
  for (int i = tid; i < 16384; i += NTHR) ((LDS unsigned*)(lds + IL_HIST))[i] = 0u;
  __syncthreads();
  const float qinv = stf[192 + q], qoff = stf[256 + q];
  idx_pass<1>(lds, KIb, N, 1, qg, kh, QIrow0, WIrow0, qinv, qoff, 0);
#ifdef PROBE_P1X2
  __syncthreads();
  for (int i = tid; i < 16384; i += NTHR) ((LDS unsigned*)(lds + IL_HIST))[i] = 0u;
  __syncthreads();
  idx_pass<1>(lds, KIb, N, 1, qg, kh, QIrow0, WIrow0, qinv, qoff, 0);
#endif
  if (tid < 64) {
    LDS unsigned* hist = (LDS unsigned*)(lds + IL_HIST);
    unsigned cum = 0u; int bs = 0; unsigned need = 256u;
    for (int bb = IDX_NB - 1; bb >= 0; --bb) {
      const unsigned hcount = hist[bb * 64 + tid];
      if (cum + hcount >= 256u) { bs = bb; need = 256u - cum; break; }
      cum += hcount;
    }
    st[320 + tid] = (unsigned)bs; st[384 + tid] = need;
  }
  __syncthreads();
  const int bstar = (int)st[320 + q];
  __syncthreads();
  idx_pass<2>(lds, KIb, N, 1, qg, kh, QIrow0, WIrow0, qinv, qoff, bstar);
#ifdef PROBE_P2X2
  __syncthreads();
  if (tid < 64) st[128 + tid] = 0u;
  __syncthreads();
  idx_pass<2>(lds, KIb, N, 1, qg, kh, QIrow0, WIrow0, qinv, qoff, bstar);
#endif
  for (int qq = wave; qq < 64; qq += 8) {
    const int nc = min((int)st[128 + qq], IDX_CAP); const unsigned need = st[384 + qq];
    LDS float* cs = (LDS float*)(lds + IL_CS) + qq * IDX_CAP; LDS unsigned short* ck = (LDS unsigned short*)(lds + IL_CK) + qq * IDX_CAP;
    for (int i = lane; i < nc; i += 64) {
      const float sv = cs[i]; const unsigned kv = ck[i];
      unsigned rank = 0u;
      for (int j = 0; j < nc; ++j) { const float sj = cs[j]; const unsigned kj = ck[j]; rank += (sj > sv || (sj == sv && kj < kv)) ? 1u : 0u; }
      if (rank < need) {
        const unsigned kl = kv & 31u;
        const unsigned bit = 16u * ((kl >> 2) & 1u) + (kl & 3u) + 4u * (kl >> 3);
        __hip_atomic_fetch_or((LDS unsigned*)(lds + IL_HIST) + qq * 256 + (kv >> 5), 1u << bit, __ATOMIC_RELAXED, __HIP_MEMORY_SCOPE_WORKGROUP);
      }
    }
  }
  __syncthreads();
  {
    const int cpr = N >> 6;
    for (int i = tid; i < 64 * cpr; i += NTHR) {
      const int row = i / cpr, cc = i % cpr;
      *(u32x2*)(MASK + (size_t)row * 256 + 2 * cc) = *(LDS u32x2*)(lds + IL_HIST + row * 1024 + cc * 8);
    }
  }
  __syncthreads();
}

DEVI void phase3(PRef p, LDS unsigned char* lds) {
  const int G = gridDim.x;
  for (int it = blockIdx.x; it < 512; it += G) rnn_item<0>(p, lds, it >> 7, it & 127);
  for (int it = blockIdx.x; it < 256; it += G) {
    const int b = it >> 6, j = it & 63;
#pragma unroll 1
    for (int w2 = 0; w2 < 2; ++w2) idx_item(p, lds, b, w2 ? j : 127 - j);
  }
}

constexpr int AT_BUF = 2 * 64 * LROW;
DEVI float max3f(float a, float b, float c) { float r; asm("v_max3_f32 %0, %1, %2, %3" : "=v"(r) : "v"(a), "v"(b), "v"(c)); return r; }
DEVI unsigned pk_rtz(float a, float b) { return __builtin_bit_cast(unsigned, __builtin_amdgcn_cvt_pkrtz(a, b)); }
DEVI void attn_tile(LDS unsigned char* Kt, LDS unsigned char* Vt, const h16x8 (&qf)[4], u32x2 mw, int l31, int half, f32x16 (&o)[2], float& mref, float& l, bool& init) {
  const unsigned nm0 = ~(mw[0] >> (16 * half)), nm1 = ~(mw[1] >> (16 * half));
  const unsigned negm = __float_as_uint(-mref);
  f32x16 s[2];
#pragma unroll
  for (int r = 0; r < 16; ++r) {
    unsigned e0 = (unsigned)__builtin_amdgcn_sbfe((int)nm0, r, 1), e1 = (unsigned)__builtin_amdgcn_sbfe((int)nm1, r, 1);
    asm volatile("" : "+v"(e0), "+v"(e1));
    s[0][r] = __uint_as_float((e0 & 0xFF800000u) | (~e0 & negm));
    s[1][r] = __uint_as_float((e1 & 0xFF800000u) | (~e1 & negm));
  }
#pragma unroll
  for (int ri = 0; ri < 2; ++ri)
#pragma unroll
    for (int kk = 0; kk < 4; ++kk) {
      const h16x8 kf = *(LDS h16x8*)(Kt + (32 * ri + l31) * LROW + (2 * kk + half) * 16);
      s[ri] = mfma16(kf, qf[kk], s[ri]);
    }
  asm volatile("s_nop 15\n\ts_nop 7" : "+v"(s[0]), "+v"(s[1]));
  float mx = max3f(s[0][0], s[1][0], s[0][1]), mx2 = max3f(s[1][1], s[0][2], s[1][2]);
#pragma unroll
  for (int r = 3; r < 15; r += 2) { mx = max3f(mx, s[0][r], s[1][r]); mx2 = max3f(mx2, s[0][r + 1], s[1][r + 1]); }
  mx = max3f(mx, s[0][15], s[1][15]);
  mx = max3f(mx, mx2, mx2);
  mx = max3f(mx, __shfl_xor(mx, 32), mx);
  const bool first = (!init) && (mx > -INFINITY);
  const bool resc = first || (mx > 8.f);
  if (__any(resc)) {
    init = init || first;
    const float delta = resc ? mx : 0.f;
    const float alpha = __builtin_amdgcn_exp2f(-delta);
#pragma unroll
    for (int r = 0; r < 16; ++r) { s[0][r] -= delta; s[1][r] -= delta; o[0][r] *= alpha; o[1][r] *= alpha; }
    l *= alpha; mref += delta;
  }
  float ls = 0.f;
#pragma unroll
  for (int r = 0; r < 16; ++r) {
    s[0][r] = __builtin_amdgcn_exp2f(s[0][r]); s[1][r] = __builtin_amdgcn_exp2f(s[1][r]);
    ls += s[0][r] + s[1][r];
  }
  l += ls;
  h16x8 pf[4];
#pragma unroll
  for (int s4 = 0; s4 < 4; ++s4) {
    u32x4 w;
#pragma unroll
    for (int e = 0; e < 4; ++e) w[e] = pk_rtz(s[s4 >> 1][8 * (s4 & 1) + 2 * e], s[s4 >> 1][8 * (s4 & 1) + 2 * e + 1]);
    pf[s4] = __builtin_bit_cast(h16x8, w);
  }
#pragma unroll
  for (int di = 0; di < 2; ++di)
#pragma unroll
    for (int s4 = 0; s4 < 4; ++s4) {
      const h16x8 vf = *(LDS h16x8*)(Vt + (32 * di + l31) * LROW + (2 * s4 + half) * 16);
      o[di] = mfma16(vf, pf[s4], o[di]);
    }
}

DEVI void attn_unit(PRef p, LDS unsigned char* lds, int b, int head, int qb) {
  const int tid = launder((int)threadIdx.x), lane = tid & 63, wave = wave_id(tid), l31 = lane & 31, half = lane >> 5;
  const int q0 = qb * 256 + wave * 32, cw = q0 >> 6, NT = 4 * (qb + 1);
  const size_t tok = (size_t)b * SEQ + q0 + l31;
  h16x8 qf[4];
  {
    const h16* Q = (const h16*)(p.ws + WS_Q) + tok * 512 + head * 64;
#pragma unroll
    for (int kk = 0; kk < 4; ++kk) qf[kk] = *(const h16x8*)(Q + 16 * kk + 8 * half);
  }
  const unsigned* mrow = (const unsigned*)(p.ws + WS_MASK) + tok * 256;
  const int lr = tid >> 3, lc = tid & 7;
  const h16* kp = (const h16*)(p.ws + WS_K) + ((size_t)b * SEQ + lr) * 512 + head * 64 + lc * 8;
  const h16* vp = (const h16*)(p.ws + WS_VT) + ((size_t)(b * 8 + head) * 64 + lr) * 8192 + lc * 8;
  LDS unsigned char* wk = lds + lr * LROW + lc * 16;
  h16x8 rkA = *(const h16x8*)kp, rvA = *(const h16x8*)vp, rkB, rvB;
  *(LDS h16x8*)wk = rkA; *(LDS h16x8*)(wk + 64 * LROW) = rvA;
  rkA = *(const h16x8*)(kp + (size_t)64 * 512); rvA = *(const h16x8*)(vp + 64);
  u32x2 mw = *(const u32x2*)mrow, mwn;
  __syncthreads();
  f32x16 o[2];
#pragma unroll
  for (int r = 0; r < 16; ++r) { o[0][r] = 0.f; o[1][r] = 0.f; }
  float mref = 0.f, l = 0.f; bool init = false;
#define ATT_STEP(j, RKC, RVC, RKN, RVN) { \
    if ((j) + 2 < NT) { RKN = *(const h16x8*)(kp + (size_t)((j) + 2) * 64 * 512); RVN = *(const h16x8*)(vp + ((j) + 2) * 64); } \
    if ((j) + 1 < NT) mwn = *(const u32x2*)(mrow + 2 * ((j) + 1)); \
    if ((j) <= cw) attn_tile(lds + ((j) & 1) * AT_BUF, lds + ((j) & 1) * AT_BUF + 64 * LROW, qf, mw, l31, half, o, mref, l, init); \
    if ((j) + 1 < NT) { *(LDS h16x8*)(wk + (((j) + 1) & 1) * AT_BUF) = RKC; *(LDS h16x8*)(wk + (((j) + 1) & 1) * AT_BUF + 64 * LROW) = RVC; } \
    __syncthreads(); mw = mwn; }
  for (int jt = 0; jt < NT; jt += 2) {
    ATT_STEP(jt, rkA, rvA, rkB, rvB)
    ATT_STEP(jt + 1, rkB, rvB, rkA, rvA)
  }
#undef ATT_STEP
  const float inv = 1.f / (l + __shfl_xor(l, 32));
  h16* Y = (h16*)(p.ws + WS_H) + tok * DM + head * 64;
#pragma unroll
  for (int di = 0; di < 2; ++di)
#pragma unroll
    for (int q = 0; q < 4; ++q)
      *(h16x4*)(Y + 32 * di + 8 * q + 4 * half) = pack4(o[di][4 * q] * inv, o[di][4 * q + 1] * inv, o[di][4 * q + 2] * inv, o[di][4 * q + 3] * inv);
}

DEVI void phase4(PRef p, LDS unsigned char* lds) {
  const int G = gridDim.x;
  for (int it = blockIdx.x; it < 512; it += G) rnn_item<1>(p, lds, it >> 7, it & 127);
  for (int it = blockIdx.x; it < 512; it += G) {
    const int bh = it >> 4, j = it & 15;
#pragma unroll 1
    for (int w2 = 0; w2 < 2; ++w2) attn_unit(p, lds, bh >> 3, bh & 7, w2 ? j : 31 - j);
  }
}

struct EpiPlain {
  h16* dst; int ld; int row0, col0, nvalid;
  DEVI void operator()(const f32x16 (&acc)[2][2], int wm, int wn, int lane) const {
    const int l31 = lane & 31, half = lane >> 5;
#pragma unroll
    for (int mi = 0; mi < 2; ++mi) {
      const int r = 64 * wm + 32 * mi + l31;
      if (r < nvalid) {
        h16* d = dst + (size_t)(row0 + r) * ld + col0 + 64 * wn;
#pragma unroll
        for (int ni = 0; ni < 2; ++ni)
#pragma unroll
          for (int q = 0; q < 4; ++q)
            *(h16x4*)(d + 32 * ni + 8 * q + 4 * half) = pack4(acc[mi][ni][4 * q], acc[mi][ni][4 * q + 1], acc[mi][ni][4 * q + 2], acc[mi][ni][4 * q + 3]);
      }
    }
  }
};
DEVI void phase5(PRef p, LDS unsigned char* lds) {
  const int G = gridDim.x;
  const h16* Y = (const h16*)(p.ws + WS_H); const h16* W = (const h16*)(p.ws + WS_WOUT);
  for (int it = blockIdx.x; it < 128 * 8; it += G) {
    const int mt = it >> 3, nt = it & 7;
    ARowPlain ar{Y + (size_t)mt * 256 * DM, (size_t)DM};
    EpiPlain epi{(h16*)(p.ws + WS_MIX), DM, mt * 256, nt * 128, 256};
    gemm_tile(lds, ar, W + (size_t)nt * 128 * DM, DM, DM, epi);
  }
}

constexpr int P6_WRT = 0, P6_MOD = 36 * 1024 * 4, P6_LG = P6_MOD  , P6_BIAS = P6_LG + 8 * 72 * 4, P6_TOK = P6_BIAS + 160, P6_LCNT = P6_TOK + 128 * 6 * 4, P6_LBASE = P6_LCNT + 128;
static_assert(P6_LBASE + 128 <= LDS_BYTES - 16 && P6_MOD + 3 * 4096 <= LDS_BYTES - 16, "phase 6 LDS map");
DEVI void phase6(PRef p, LDS unsigned char* lds) {
  const int tid = launder((int)threadIdx.x), lane = tid & 63, wave = wave_id(tid), G = gridDim.x;
  const int b = blockIdx.x & 3, bi = blockIdx.x >> 2, nbk = G >> 2;
  LDS float* wrt = (LDS float*)(lds + P6_WRT);
  LDS float* mv = (LDS float*)(lds + P6_MOD);
  LDS float* lgw = (LDS float*)(lds + P6_LG) + wave * 72;
  LDS float* rbias = (LDS float*)(lds + P6_BIAS);
  LDS unsigned* tokrec = (LDS unsigned*)(lds + P6_TOK);
  LDS unsigned* lcnt = (LDS unsigned*)(lds + P6_LCNT);
  LDS unsigned* lbase = (LDS unsigned*)(lds + P6_LBASE);
  {
    const f32x4* src = (const f32x4*)(p.ws + WS_WRT);
    for (int i = tid; i < 36 * 256; i += NTHR) ((LDS f32x4*)wrt)[i] = src[i];
  }
  mod_to_lds(p, b, 2, mv); mod_to_lds(p, b, 3, mv + 1024); mod_to_lds(p, b, 4, mv + 2048);
  __syncthreads();
  f32x4 A1[4], A2[4], SH2[4];
#pragma unroll
  for (int j = 0; j < 4; ++j) {
    const int k = 256 * j + 4 * lane;
    A1[j] = *(LDS f32x4*)(mv + k) * *(const f32x4*)(p.in[5] + k);
    A2[j] = *(const f32x4*)(p.in[6] + k) * (*(LDS f32x4*)(mv + 2048 + k) + 1.f);
    SH2[j] = *(LDS f32x4*)(mv + 1024 + k);
  }
  __syncthreads();
  if (tid < 4) rbias[tid] = p.in[18][tid];
  else if (tid < 36) rbias[tid] = p.in[20][tid - 4];
  if (tid < 32) lcnt[tid] = 0u;
  __syncthreads();
  const float* x = p.in[0]; const h16* MIX = (const h16*)(p.ws + WS_MIX); float* X1 = p.out; h16* H2 = (h16*)(p.ws + WS_H);
  const bool lowhalf = lane < 32, lowq = (lane & 16) == 0;
  int it = 0;
  for (int pr = bi * 8 + wave; pr < SEQ / 2; pr += nbk * 8, ++it) {
    f32x4 h2[2][4];
#pragma unroll
    for (int tt = 0; tt < 2; ++tt) {
      const size_t tok = (size_t)b * SEQ + 2 * pr + tt;
      f32x4 xv[4], mx[4]; float ssm = 0.f;
#pragma unroll
      for (int j = 0; j < 4; ++j) {
        xv[j] = *(const f32x4*)(x + tok * DM + 256 * j + 4 * lane);
        const h16x4 mh = *(const h16x4*)(MIX + tok * DM + 256 * j + 4 * lane);
#pragma unroll
        for (int e = 0; e < 4; ++e) { mx[j][e] = (float)mh[e]; ssm += mx[j][e] * mx[j][e]; }
      }
      const float rsm = 1.0f / sqrtf(wave_sum(ssm) * (1.f / 1024.f) + 1e-6f);
      float ss1 = 0.f;
#pragma unroll
      for (int j = 0; j < 4; ++j) {
        xv[j] = xv[j] + A1[j] * (mx[j] * rsm);
        *(f32x4*)(X1 + tok * DM + 256 * j + 4 * lane) = xv[j];
        ss1 += xv[j][0] * xv[j][0] + xv[j][1] * xv[j][1] + xv[j][2] * xv[j][2] + xv[j][3] * xv[j][3];
      }
      const float rs1 = 1.0f / sqrtf(wave_sum(ss1) * (1.f / 1024.f) + 1e-6f);
#pragma unroll
      for (int j = 0; j < 4; ++j) {
        h2[tt][j] = xv[j] * rs1 * A2[j] + SH2[j];
        *(h16x4*)(H2 + tok * DM + 256 * j + 4 * lane) = pack4(h2[tt][j][0], h2[tt][j][1], h2[tt][j][2], h2[tt][j][3]);
      }
    }
    float a0[36], a1[36];
#pragma unroll
    for (int col = 0; col < 36; ++col) {
      float s0 = 0.f, s1 = 0.f;
#pragma unroll
      for (int j = 0; j < 4; ++j) {
        const f32x4 w = *(LDS f32x4*)(wrt + col * 1024 + 256 * j + 4 * lane);
#pragma unroll
        for (int e = 0; e < 4; ++e) { s0 = fmaf(h2[0][j][e], w[e], s0); s1 = fmaf(h2[1][j][e], w[e], s1); }
      }
      a0[col] = s0; a1[col] = s1;
    }
    float b0[18], b1[18];
#pragma unroll
    for (int c = 0; c < 18; ++c) {
      const float snd0 = lowhalf ? a0[c + 18] : a0[c], snd1 = lowhalf ? a1[c + 18] : a1[c];
      b0[c] = (lowhalf ? a0[c] : a0[c + 18]) + __shfl_xor(snd0, 32);
      b1[c] = (lowhalf ? a1[c] : a1[c + 18]) + __shfl_xor(snd1, 32);
    }
    float c0[9], c1[9];
#pragma unroll
    for (int c = 0; c < 9; ++c) {
      const float snd0 = lowq ? b0[c + 9] : b0[c], snd1 = lowq ? b1[c + 9] : b1[c];
      c0[c] = (lowq ? b0[c] : b0[c + 9]) + __shfl_xor(snd0, 16);
      c1[c] = (lowq ? b1[c] : b1[c + 9]) + __shfl_xor(snd1, 16);
    }
#pragma unroll
    for (int c = 0; c < 9; ++c) {
#pragma unroll
      for (int o = 8; o >= 1; o >>= 1) { c0[c] += __shfl_xor(c0[c], o); c1[c] += __shfl_xor(c1[c], o); }
    }
    if ((lane & 15) == 0) {
      const int cb = 18 * (lane >> 5) + 9 * ((lane >> 4) & 1);
#pragma unroll
      for (int c = 0; c < 9; ++c) { lgw[cb + c] = c0[c]; lgw[36 + cb + c] = c1[c]; }
    }
    if (lane < 2) {
      const int tt = lane;
      LDS float* lg = lgw + 36 * tt;
      float gl[4];
#pragma unroll
      for (int g = 0; g < 4; ++g) gl[g] = lg[g] + rbias[g];
      int gi = 0; float gm = gl[0];
#pragma unroll
      for (int g = 1; g < 4; ++g) if (gl[g] > gm) { gm = gl[g]; gi = g; }
      float gs = 0.f;
#pragma unroll
      for (int g = 0; g < 4; ++g) gs += __expf(gl[g] - gm);
      const float pg = 1.f / gs;
      int e1 = 0, e2 = 0; float l1 = -INFINITY, l2 = -INFINITY;
#pragma unroll
      for (int e = 0; e < 8; ++e) {
        const float v = lg[4 + 8 * gi + e] + rbias[4 + 8 * gi + e];
        if (v > l1) { l2 = l1; e2 = e1; l1 = v; e1 = e; }
        else if (v > l2) { l2 = v; e2 = e; }
      }
      const float x2 = __expf(l2 - l1);
      const float w1 = pg / (1.f + x2), w2 = pg * x2 / (1.f + x2);
      const unsigned E1 = (unsigned)(gi * 8 + e1), E2 = (unsigned)(gi * 8 + e2);
      const unsigned lp1 = __hip_atomic_fetch_add(&lcnt[E1], 1u, __ATOMIC_RELAXED, __HIP_MEMORY_SCOPE_WORKGROUP);
      const unsigned lp2 = __hip_atomic_fetch_add(&lcnt[E2], 1u, __ATOMIC_RELAXED, __HIP_MEMORY_SCOPE_WORKGROUP);
      LDS unsigned* tr = tokrec + ((it * 8 + wave) * 2 + tt) * 6;
      tr[0] = E1; tr[1] = lp1; tr[2] = E2; tr[3] = lp2; tr[4] = __float_as_uint(w1); tr[5] = __float_as_uint(w2);
    }
  }
  __syncthreads();
  if (tid < 32) lbase[tid] = atomicAdd((unsigned*)(p.ws + WS_CNT) + tid, lcnt[tid]);
  __syncthreads();
  {
    unsigned* LIST = (unsigned*)(p.ws + WS_LIST); float* LISTW = (float*)(p.ws + WS_LISTW); u32x4* ROUTE = (u32x4*)(p.ws + WS_ROUTE);
    const int npair = (SEQ / 2 - bi * 8 + nbk * 8 - 1) / (nbk * 8);
    for (int s = tid; s < npair * 16; s += NTHR) {
      const int tt = s & 1, w = (s >> 1) & 7, i2 = s >> 4;
      const int pr = bi * 8 + w + nbk * 8 * i2;
      if (pr < SEQ / 2) {
        const unsigned tok = (unsigned)(b * SEQ + 2 * pr + tt);
        LDS unsigned* tr = tokrec + s * 6;
        const unsigned E1 = tr[0], E2 = tr[2], p1 = lbase[E1] + tr[1], p2 = lbase[E2] + tr[3];
        LIST[(size_t)E1 * 32768 + p1] = tok; LISTW[(size_t)E1 * 32768 + p1] = __uint_as_float(tr[4]);
        LIST[(size_t)E2 * 32768 + p2] = tok; LISTW[(size_t)E2 * 32768 + p2] = __uint_as_float(tr[5]);
        u32x4 rt; rt[0] = E1; rt[1] = p1; rt[2] = E2; rt[3] = p2;
        ROUTE[tok] = rt;
      }
    }
  }
}

struct MoeItem { int e, mt, nt, cnt, off; };
DEVI bool moe_decode(const unsigned* cnt, int it, int ntn, MoeItem& m) {
  int off = 0;
  for (int e = 0; e < 32; ++e) {
    const int c = (int)cnt[e]; const int nti = ((c + 255) >> 8) * ntn;
    if (it < nti) { m.e = e; m.mt = it / ntn; m.nt = it % ntn; m.cnt = c; m.off = off; return true; }
    it -= nti; off += c;
  }
  return false;
}
struct EpiAct {
  h16* act; const float* lw; int row0, nvalid, nt; size_t orow;
  DEVI void operator()(const f32x16 (&acc)[2][2], int wm, int wn, int lane) const {
    const int l31 = lane & 31, half = lane >> 5;
#pragma unroll
    for (int mi = 0; mi < 2; ++mi) {
      const int r = row0 + 64 * wm + 32 * mi + l31;
      if (r < nvalid) {
        const float w = lw[r];
        h16* d = act + (orow + r) * 256 + 32 * (2 * nt + wn);
#pragma unroll
        for (int q = 0; q < 4; ++q) {
          float v[4];
#pragma unroll
          for (int e = 0; e < 4; ++e) { const float g = acc[mi][0][4 * q + e], u = acc[mi][1][4 * q + e]; v[e] = silu_f(g) * u * w; }
          *(h16x4*)(d + 8 * q + 4 * half) = pack4(v[0], v[1], v[2], v[3]);
        }
      }
    }
  }
};
DEVI void phase7(PRef p, LDS unsigned char* lds) {
  const int G = gridDim.x;
  const unsigned* cnt = (const unsigned*)(p.ws + WS_CNT);
  for (int it = blockIdx.x;; it += G) {
    MoeItem m; if (!moe_decode(cnt, it, 4, m)) break;
    ARowGather ar{(const h16*)(p.ws + WS_H), (const unsigned*)(p.ws + WS_LIST) + (size_t)m.e * 32768, m.cnt, m.mt * 256};
    EpiAct epi{(h16*)(p.ws + WS_ACT), (const float*)(p.ws + WS_LISTW) + (size_t)m.e * 32768, m.mt * 256, m.cnt, m.nt, (size_t)m.off};
    gemm_tile(lds, ar, (const h16*)(p.ws + WS_WGU) + ((size_t)m.e * 512 + m.nt * 128) * DM, DM, DM, epi);
  }
}
DEVI void phase8(PRef p, LDS unsigned char* lds) {
  const int G = gridDim.x;
  const unsigned* cnt = (const unsigned*)(p.ws + WS_CNT);
  for (int it = blockIdx.x;; it += G) {
    MoeItem m; if (!moe_decode(cnt, it, 8, m)) break;
    ARowPlain ar{(const h16*)(p.ws + WS_ACT) + ((size_t)m.off + m.mt * 256) * 256, (size_t)256};
    EpiPlain epi{(h16*)(p.ws + WS_YP), DM, m.off + m.mt * 256, m.nt * 128, m.cnt - m.mt * 256};
    gemm_tile(lds, ar, (const h16*)(p.ws + WS_WDN) + ((size_t)m.e * 1024 + m.nt * 128) * 256, 256, 256, epi);
  }
}

DEVI void phase9(PRef p, LDS unsigned char* lds) {
  const int tid = launder((int)threadIdx.x), lane = tid & 63, wave = wave_id(tid), G = gridDim.x;
  const int b = blockIdx.x & 3, bi = blockIdx.x >> 2, nbk = G >> 2;
  LDS unsigned* offs = (LDS unsigned*)lds;
  if (tid == 0) { const unsigned* cnt = (const unsigned*)(p.ws + WS_CNT); unsigned o = 0; for (int e = 0; e < 32; ++e) { offs[e] = o; o += cnt[e]; } }
  __syncthreads();
  LDS float* mv = (LDS float*)(lds + 256);
  mod_to_lds(p, b, 5, mv);
  __syncthreads();
  f32x4 A3[4];
#pragma unroll
  for (int j = 0; j < 4; ++j) { const int k = 256 * j + 4 * lane; A3[j] = *(LDS f32x4*)(mv + k) * *(const f32x4*)(p.in[7] + k); }
  const h16* YP = (const h16*)(p.ws + WS_YP); const u32x4* ROUTE = (const u32x4*)(p.ws + WS_ROUTE); float* out = p.out;
  for (int r = bi * 8 + wave; r < SEQ; r += nbk * 8) {
    const size_t tok = (size_t)b * SEQ + r;
    const u32x4 rt = ROUTE[tok];
    const size_t r0 = (size_t)offs[rt[0]] + rt[1], r1 = (size_t)offs[rt[2]] + rt[3];
    f32x4 y[4]; float ss = 0.f;
#pragma unroll
    for (int j = 0; j < 4; ++j) {
      const h16x4 a = *(const h16x4*)(YP + r0 * DM + 256 * j + 4 * lane), c = *(const h16x4*)(YP + r1 * DM + 256 * j + 4 * lane);
#pragma unroll
      for (int e = 0; e < 4; ++e) { y[j][e] = (float)a[e] + (float)c[e]; ss += y[j][e] * y[j][e]; }
    }
    const float rs = 1.0f / sqrtf(wave_sum(ss) * (1.f / 1024.f) + 1e-6f);
#pragma unroll
    for (int j = 0; j < 4; ++j) {
      float* o = out + tok * DM + 256 * j + 4 * lane;
      const f32x4 x1 = *(const f32x4*)o;
      *(f32x4*)o = x1 + A3[j] * (y[j] * rs);
    }
  }
}


#define XB_TMO      128
#define XB_XCNT(j)  (256  + 64 * (j))
#define XB_XSUB(j)  (1280 + 64 * (j))
#define XB_XGEN(j)  (2304 + 64 * (j))
#define XB_TOP      3328
#define XB_TOPGEN   3392
#define XB_SPIN_CAP (1u << 22)
DEVI unsigned xb_ld(unsigned* p)              { return __hip_atomic_load(p, __ATOMIC_RELAXED, __HIP_MEMORY_SCOPE_AGENT); }
DEVI unsigned xb_add(unsigned* p, unsigned v) { return __hip_atomic_fetch_add(p, v, __ATOMIC_RELAXED, __HIP_MEMORY_SCOPE_AGENT); }
DEVI unsigned xb_xcc_id() { return (unsigned)__builtin_amdgcn_s_getreg((3 << 11) | 20) & 0xFu; }
#define XB_SPIN(cond, bar) do { unsigned _sp = 0; while (cond) { __builtin_amdgcn_s_sleep(1); \
    if ((++_sp & 255u) == 0u) { if (xb_ld(&(bar)[XB_TMO])) break; if (_sp > XB_SPIN_CAP) { atomicAdd(&(bar)[XB_TMO], 1u); break; } } } } while (0)
struct XcdBarrier { unsigned* bar; unsigned x; volatile LDS unsigned* st; };
DEVI XcdBarrier xcd_barrier_post(unsigned* bar, volatile LDS unsigned* st) {
  XcdBarrier b; b.bar = bar; b.x = xb_xcc_id(); b.st = st;
  if (threadIdx.x == 0) (void)xb_add(&bar[XB_XCNT(b.x)], 1u);
  return b;
}
DEVI void xcd_barrier_complete(unsigned* bar, unsigned x, unsigned& nloc, unsigned& nx) {
  const unsigned G = gridDim.x * gridDim.y * gridDim.z;
  unsigned sum, cnt, mine, sp = 0u;
  for (;;) {
    sum = 0u; cnt = 0u; mine = 0u;
#pragma unroll
    for (unsigned j = 0; j < 16; ++j) { const unsigned c = xb_ld(&bar[XB_XCNT(j)]); sum += c; cnt += (c > 0u) ? 1u : 0u; mine = (j == x) ? c : mine; }
    if (sum == G) break;
    __builtin_amdgcn_s_sleep(1);
    if ((++sp & 255u) == 0u) { if (xb_ld(&bar[XB_TMO])) break; if (sp > XB_SPIN_CAP) { atomicAdd(&bar[XB_TMO], 1u); break; } }
  }
  nloc = mine > 0u ? mine : 1u; nx = cnt > 0u ? cnt : 1u;
}
DEVI void xcd_barrier(const XcdBarrier& b) {
  asm volatile("s_waitcnt vmcnt(0)" ::: "memory");
  __syncthreads();
  if (threadIdx.x == 0) {
    unsigned* bar = b.bar;
    __builtin_amdgcn_s_waitcnt(0);
    unsigned nloc = b.st[0], nx = b.st[1];
    if (nloc == 0u) { xcd_barrier_complete(bar, b.x, nloc, nx); b.st[0] = nloc; b.st[1] = nx; }
    const unsigned old = xb_add(&bar[XB_XSUB(b.x)], 1u);
    const unsigned gen = old / nloc;
    if (old + 1u == (gen + 1u) * nloc) {
      __builtin_amdgcn_fence(__ATOMIC_RELEASE, "agent");
      asm volatile("s_waitcnt vmcnt(0)" ::: "memory");
      const unsigned og = xb_add(&bar[XB_TOP], 1u);
      const unsigned tg = og / nx;
      if (og + 1u == (tg + 1u) * nx) xb_add(&bar[XB_TOPGEN], 1u);
      else XB_SPIN(xb_ld(&bar[XB_TOPGEN]) == tg, bar);
      __builtin_amdgcn_fence(__ATOMIC_ACQUIRE, "agent");
      xb_add(&bar[XB_XGEN(b.x)], 1u);
      asm volatile("s_waitcnt vmcnt(0)" ::: "memory");
    } else {
      XB_SPIN(xb_ld(&bar[XB_XGEN(b.x)]) == gen, bar);
      __builtin_amdgcn_fence(__ATOMIC_ACQUIRE, "agent");
      asm volatile("s_waitcnt vmcnt(0)" ::: "memory");
    }
  }
  __syncthreads();
}

__global__ void __launch_bounds__(NTHR) fwd_kernel(Params p) {
  extern __shared__ __attribute__((aligned(16))) unsigned char smem[];
  LDS unsigned char* lds = (LDS unsigned char*)smem;
  const int lo = p.ph_lo, hi = p.ph_hi;
  volatile LDS unsigned* bst = (volatile LDS unsigned*)(lds + LDS_BYTES - 16);
  if (threadIdx.x < 4) bst[threadIdx.x] = 0u;
  __syncthreads();
  XcdBarrier xbar = xcd_barrier_post((unsigned*)(p.ws + WS_BAR), bst);
#ifndef REPEAT_PHASE
#define REPEAT_PHASE -1
#endif
#define GRID_SYNC(k) do { if ((k) == 0) cg::this_grid().sync(); else xcd_barrier(xbar); } while (0)
#define RUN_PHASE(k, fn) if (lo <= (k) && (k) < hi) { fn(*get_params(), lds); if ((k) == REPEAT_PHASE) { GRID_SYNC(k); fn(*get_params(), lds); } if ((k) + 1 < hi) GRID_SYNC(k); }
  RUN_PHASE(0, phase0)
  RUN_PHASE(1, phase1)
  RUN_PHASE(2, phase2)
  RUN_PHASE(3, phase3)
  RUN_PHASE(4, phase4)
  RUN_PHASE(5, phase5)
  RUN_PHASE(6, phase6)
  RUN_PHASE(7, phase7)
  RUN_PHASE(8, phase8)
  RUN_PHASE(9, phase9)
#undef GRID_SYNC
#undef RUN_PHASE
}

extern "C" void kernel_launch(void* const* d_in, const int* in_sizes, int n_in, void* d_out, int out_size, void* d_ws, size_t ws_size, hipStream_t stream) {
  static int grid = 0;
  if (grid == 0) {
    if (n_in != 24 || out_size != NTOK * DM || ws_size < WS_END) { fprintf(stderr, "kernel_launch: unexpected problem (n_in %d out %d ws %zu)\n", n_in, out_size, ws_size); grid = -1; return; }
    (void)hipFuncSetAttribute((const void*)fwd_kernel, hipFuncAttributeMaxDynamicSharedMemorySize, LDS_BYTES);
    int dev = 0, cus = 0, per_cu = 0;
    (void)hipGetDevice(&dev);
    (void)hipDeviceGetAttribute(&cus, hipDeviceAttributeMultiprocessorCount, dev);
    (void)hipOccupancyMaxActiveBlocksPerMultiprocessor(&per_cu, (const void*)fwd_kernel, NTHR, LDS_BYTES);
    if (per_cu < 1 || cus < 256) fprintf(stderr, "kernel_launch: occupancy %d blocks/CU on %d CUs\n", per_cu, cus);
    grid = 256;
  }
  if (grid < 0) return;
  (void)hipMemsetAsync((char*)d_ws + WS_CNT, 0, CTL_ZERO_BYTES, stream);
  Params p{};
  for (int i = 0; i < 24; ++i) p.in[i] = (const float*)d_in[i];
  p.out = (float*)d_out; p.ws = (unsigned char*)d_ws;
#if N_LAUNCH_MODE == 1
  p.ph_lo = 0; p.ph_hi = NPHASE;
  void* args[] = {&p};
  hipError_t e = hipLaunchCooperativeKernel((const void*)fwd_kernel, dim3(grid), dim3(NTHR), args, LDS_BYTES, stream);
  if (e != hipSuccess) fprintf(stderr, "cooperative launch failed: %s\n", hipGetErrorString(e));
#else
  for (int ph = 0; ph < NPHASE; ++ph) {
    p.ph_lo = ph; p.ph_hi = ph + 1;
    hipLaunchKernelGGL(fwd_kernel, dim3(grid), dim3(NTHR), LDS_BYTES, stream, p);
  }
#endif
}
```

```cpp
#include <hip/hip_runtime.h>
#include <hip/hip_cooperative_groups.h>
#include <cstdio>
#include <cstdint>
namespace cg = cooperative_groups;

#ifndef N_LAUNCH_MODE
#define N_LAUNCH_MODE 1
#endif

#define DEVI __device__ __forceinline__
#define LDS __attribute__((address_space(3)))

typedef _Float16 h16;
typedef _Float16 h16x4 __attribute__((ext_vector_type(4)));
typedef _Float16 h16x8 __attribute__((ext_vector_type(8)));
typedef float f32x4 __attribute__((ext_vector_type(4)));
typedef float f32x16 __attribute__((ext_vector_type(16)));
typedef unsigned u32x2 __attribute__((ext_vector_type(2)));
typedef unsigned u32x4 __attribute__((ext_vector_type(4)));

constexpr int NBATCH = 4, SEQ = 8192, NTOK = NBATCH * SEQ, DM = 1024;
constexpr int NTHR = 512;
constexpr int NPHASE = 10;
constexpr int LDS_BYTES = 163840;

constexpr size_t MiB = 1ull << 20;
constexpr size_t WS_CNT = 0;
constexpr size_t CTL_ZERO_BYTES = 20480;
constexpr size_t WS_BAR = 4096;
constexpr size_t WS_MODP = 64 * 1024;
constexpr size_t WS_ROPE = 1 * MiB;
constexpr size_t WS_WIN = 3 * MiB;
constexpr size_t WS_WOUT = 10 * MiB;
constexpr size_t WS_WGU = 12 * MiB;
constexpr size_t WS_WDN = 44 * MiB;
constexpr size_t WS_WRG = 60 * MiB;
constexpr size_t WS_WRT = 60 * MiB + 256 * 1024;
constexpr size_t WS_AGG = 61 * MiB;
constexpr size_t WS_ROUTE = 63 * MiB;
constexpr size_t WS_LIST = 64 * MiB;
constexpr size_t WS_LISTW = 68 * MiB;
constexpr size_t WS_WI = 72 * MiB;
constexpr size_t WS_KI = 73 * MiB;
constexpr size_t WS_MASK = 77 * MiB;
constexpr size_t WS_H = 109 * MiB;
constexpr size_t WS_Q = 173 * MiB;
constexpr size_t WS_K = 205 * MiB;
constexpr size_t WS_VT = 237 * MiB;
constexpr size_t WS_QI = 269 * MiB;
constexpr size_t WS_XR = 301 * MiB;
constexpr size_t WS_XG = 333 * MiB;
constexpr size_t WS_MIX = 365 * MiB;
constexpr size_t WS_ACT = 429 * MiB;
constexpr size_t WS_YP = 173 * MiB;
constexpr size_t WS_END = 462 * MiB;

struct Params { const float* in[24]; float* out; unsigned char* ws; int ph_lo, ph_hi; };
typedef const __attribute__((address_space(4))) Params& PRef;
typedef const __attribute__((address_space(4))) Params* PPtr;

__device__ const double ROPE_REV[32] = {
  1.59154943091895345608e-01, 1.19349370211248861917e-01, 8.94994016088910132600e-02, 6.71150830052272551196e-02,
  5.03292121044870352509e-02, 3.77415847174197710556e-02, 2.83021958306233986646e-02, 2.12236527647776604399e-02,
  1.59154943091895338669e-02, 1.19349370211248861917e-02, 8.94994016088910236684e-03, 6.71150830052272533849e-03,
  5.03292121044870369856e-03, 3.77415847174197719230e-03, 2.83021958306233986646e-03, 2.12236527647776621747e-03,
  1.59154943091895356017e-03, 1.19349370211248848907e-03, 8.94994016088910236684e-04, 6.71150830052272598901e-04,
  5.03292121044870326488e-04, 3.77415847174197740914e-04, 2.83021958306233954120e-04, 2.12236527647776605484e-04,
  1.59154943091895350596e-04, 1.19349370211248862459e-04, 8.94994016088910182474e-05, 6.71150830052272544691e-05,
  5.03292121044870353593e-05, 3.77415847174197768019e-05, 2.83021958306233960897e-05, 2.12236527647776591931e-05};

DEVI int launder(int x) { asm volatile("" : "+v"(x)); return x; }
DEVI PPtr get_params() { PPtr k = (PPtr)__builtin_amdgcn_kernarg_segment_ptr(); asm volatile("" : "+s"(k)); return k; }
DEVI int wave_id(int tid) { return __builtin_amdgcn_readfirstlane(tid >> 6); }
DEVI f32x16 mfma16(h16x8 a, h16x8 b, f32x16 c) { return __builtin_amdgcn_mfma_f32_32x32x16_f16(a, b, c, 0, 0, 0); }
DEVI float wave_sum(float v) {
#pragma unroll
  for (int o = 1; o < 64; o <<= 1) v += __shfl_xor(v, o);
  return v;
}
DEVI float sigmoid_f(float x) { return 1.f / (1.f + __expf(-x)); }
DEVI float silu_f(float x) { return x / (1.f + __expf(-x)); }
DEVI float gelu_tanh_f(float x) {
  const float u = 0.7978845608028654f * (x + 0.044715f * x * x * x);
  const float t = 1.f - 2.f / (1.f + __expf(2.f * u));
  return 0.5f * x * (1.f + t);
}
DEVI unsigned fkey(float f) { unsigned u = __float_as_uint(f); return (u & 0x80000000u) ? ~u : (u | 0x80000000u); }
DEVI float fkey_inv(unsigned k) { unsigned u = (k & 0x80000000u) ? (k & 0x7fffffffu) : ~k; return __uint_as_float(u); }
DEVI int vt_perm(int pos) { return (pos & ~12) | ((pos & 4) << 1) | ((pos & 8) >> 1); }

DEVI void mod_to_lds(PRef p, int b, int chunk, LDS float* dst) {
  const float* mp = (const float*)(p.ws + WS_MODP);
  for (int k = threadIdx.x; k < 1024; k += NTHR) {
    const int j = chunk * 1024 + k;
    float s = p.in[3][j];
#pragma unroll 1
    for (int ks = 0; ks < 8; ++ks) s += mp[(size_t)(ks * 4 + b) * 6144 + j];
    dst[k] = s;
  }
}

constexpr int LROW = 144;
constexpr int GA_BYTES = 256 * LROW, GB_BYTES = 128 * LROW, GSTAGE = GA_BYTES + GB_BYTES;

template <class AR, class EPI>
DEVI void gemm_tile(LDS unsigned char* lds, const AR& arow, const h16* Bt, int ldb, int K, EPI& epi) {
  const int tid = launder((int)threadIdx.x), lane = tid & 63, wave = wave_id(tid), wm = wave >> 1, wn = wave & 1;
  const int lr = tid >> 3, lc = tid & 7, l31 = lane & 31, half = lane >> 5;
  const h16* pa[4]; const h16* pb[2];
#pragma unroll
  for (int j = 0; j < 4; ++j) pa[j] = arow(lr + 64 * j) + lc * 8;
#pragma unroll
  for (int j = 0; j < 2; ++j) pb[j] = Bt + (size_t)(lr + 64 * j) * ldb + lc * 8;
  h16x8 ra[4], rb[2];
#pragma unroll
  for (int j = 0; j < 4; ++j) ra[j] = *(const h16x8*)pa[j];
#pragma unroll
  for (int j = 0; j < 2; ++j) rb[j] = *(const h16x8*)pb[j];
#pragma unroll
  for (int j = 0; j < 4; ++j) *(LDS h16x8*)(lds + (lr + 64 * j) * LROW + lc * 16) = ra[j];
#pragma unroll
  for (int j = 0; j < 2; ++j) *(LDS h16x8*)(lds + GA_BYTES + (lr + 64 * j) * LROW + lc * 16) = rb[j];
  __syncthreads();
  f32x16 acc[2][2];
#pragma unroll
  for (int a = 0; a < 2; ++a)
#pragma unroll
    for (int b = 0; b < 2; ++b)
#pragma unroll
      for (int r = 0; r < 16; ++r) acc[a][b][r] = 0.f;
  const int KT = K >> 6;
  for (int kt = 0; kt < KT; ++kt) {
    const int cur = kt & 1;
    if (kt + 1 < KT) {
#pragma unroll
      for (int j = 0; j < 4; ++j) ra[j] = *(const h16x8*)(pa[j] + (kt + 1) * 64);
#pragma unroll
      for (int j = 0; j < 2; ++j) rb[j] = *(const h16x8*)(pb[j] + (kt + 1) * 64);
    }
    LDS unsigned char* A = lds + cur * GSTAGE;
    LDS unsigned char* B = A + GA_BYTES;
#pragma unroll
    for (int kk = 0; kk < 4; ++kk) {
      h16x8 af[2], bf[2];
#pragma unroll
      for (int mi = 0; mi < 2; ++mi) af[mi] = *(LDS h16x8*)(A + (64 * wm + 32 * mi + l31) * LROW + (2 * kk + half) * 16);
#pragma unroll
      for (int ni = 0; ni < 2; ++ni) bf[ni] = *(LDS h16x8*)(B + (64 * wn + 32 * ni + l31) * LROW + (2 * kk + half) * 16);
#pragma unroll
      for (int mi = 0; mi < 2; ++mi)
#pragma unroll
        for (int ni = 0; ni < 2; ++ni) acc[mi][ni] = mfma16(bf[ni], af[mi], acc[mi][ni]);
    }
    if (kt + 1 < KT) {
      LDS unsigned char* A2 = lds + (cur ^ 1) * GSTAGE;
#pragma unroll
      for (int j = 0; j < 4; ++j) *(LDS h16x8*)(A2 + (lr + 64 * j) * LROW + lc * 16) = ra[j];
#pragma unroll
      for (int j = 0; j < 2; ++j) *(LDS h16x8*)(A2 + GA_BYTES + (lr + 64 * j) * LROW + lc * 16) = rb[j];
    }
    __syncthreads();
  }
  epi(acc, wm, wn, lane);
}


namespace g8 {
constexpr int BM = 256, BK = 64, HALF = 128, HTB = HALF * BK * 2, STAGE_BYTES = 8 * HTB;
DEVI int lds_byte(int r, int c) { const int st = (r >> 4) * 2 + (c >> 5), rr = r & 15, cc = c & 31, ob = rr * 64 + cc * 2; return st * 1024 + (ob ^ (((ob >> 9) & 1) << 5)); }
DEVI void stage_rc(int b, int& R, int& C) { const int st = b / 1024, sb = b % 1024, swz = sb ^ (((sb >> 9) & 1) << 5); R = (st >> 1) * 16 + swz / 64; C = (st & 1) * 32 + (swz % 64) / 2; }
struct Unit { const char* A; unsigned va[2][2]; const char* B; int pm, pn, e, cnt, off; };
DEVI void glds16(const char* src, LDS unsigned char* dst) { __builtin_amdgcn_global_load_lds((const unsigned*)src, (LDS unsigned*)dst, 16, 0, 0); }

DEVI void dense_va(unsigned (&va)[2][2], int K) {
  const int tid = threadIdx.x;
#pragma unroll
  for (int h = 0; h < 2; ++h)
#pragma unroll
    for (int i = 0; i < 2; ++i) { int R, C; stage_rc(tid * 16 + i * 8192, R, C); va[h][i] = (unsigned)((128 * h + R) * K + C) * 2u; }
}
template <class Sched, class Epi>
DEVI void gemm_phase(LDS unsigned char* lds, int K, const Sched& S, const Epi& E) {
  const int tid = launder((int)threadIdx.x), wid = wave_id(tid), lane = tid & 63, wr = wid >> 2, wc = wid & 3, fr = lane & 15, fq = lane >> 4;
  const int nt = launder(K) / BK;
  unsigned vb[2];
#pragma unroll
  for (int i = 0; i < 2; ++i) { int R, C; stage_rc(tid * 16 + i * 8192, R, C); vb[i] = (unsigned)(R * K + C) * 2u; }
  const size_t kstep = (size_t)(BK * 2), hstep = (size_t)HALF * K * 2;
  const unsigned ldsw = (unsigned)wid * 1024u;
  const int aoff = lds_byte(wr * 64 + fr, fq * 8), boff = lds_byte(wc * 32 + fr, fq * 8);
#define G8_SA(b, h) (((b) * 2 + (h)) * HTB)
#define G8_SB(b, h) ((4 + (b) * 2 + (h)) * HTB)
#define G8_STAGE(bufoff, gbase, v) do { glds16((gbase) + (v)[0], lds + (bufoff) + ldsw); glds16((gbase) + (v)[1], lds + (bufoff) + ldsw + 8192); } while (0)
#define G8_STAGEA(bufoff, gbase, h) do { glds16((gbase) + G8_VAC(h, 0), lds + (bufoff) + ldsw); glds16((gbase) + G8_VAC(h, 1), lds + (bufoff) + ldsw + 8192); } while (0)
#define G8_LDA(dst, b, h) do { _Pragma("unroll") for (int m = 0; m < 4; ++m) _Pragma("unroll") for (int k = 0; k < 2; ++k) dst[m][k] = *(const LDS h16x8*)(lds + G8_SA(b, h) + aoff + m * 2048 + k * 1024); } while (0)
#define G8_LDB(dst, b, h) do { _Pragma("unroll") for (int n = 0; n < 2; ++n) _Pragma("unroll") for (int k = 0; k < 2; ++k) dst[n][k] = *(const LDS h16x8*)(lds + G8_SB(b, h) + boff + n * 2048 + k * 1024); } while (0)
#define G8_MMA(ai, bj, At, Bt) do { __builtin_amdgcn_s_setprio(1); _Pragma("unroll") for (int m = 0; m < 4; ++m) _Pragma("unroll") for (int n = 0; n < 2; ++n) _Pragma("unroll") for (int k = 0; k < 2; ++k) \
        acc[ai][bj][m][n] = __builtin_amdgcn_mfma_f32_16x16x32_f16(Bt[n][k], At[m][k], acc[ai][bj][m][n], 0, 0, 0); __builtin_amdgcn_s_setprio(0); } while (0)
#define G8_WAIT_V(n) asm volatile("s_waitcnt vmcnt(" #n ")" ::: "memory")
#define G8_WAIT_L(n) asm volatile("s_waitcnt lgkmcnt(" #n ")" ::: "memory")
#define G8_BAR __builtin_amdgcn_s_barrier()
#define G8_SCHED __builtin_amdgcn_sched_barrier(0)
  Unit cur, nxt; int ui = 0;
  if (!S.next(0, cur)) return;
  unsigned vd[2][2];
  if (!Sched::GATHER) dense_va(vd, K);
#define G8_VAC(h, i) (Sched::GATHER ? cur.va[h][i] : vd[h][i])
#define G8_VAN(h, i) (Sched::GATHER ? nxt.va[h][i] : vd[h][i])
  f32x4 acc[2][2][4][2];
#pragma unroll
  for (int a = 0; a < 2; ++a)
#pragma unroll
    for (int b = 0; b < 2; ++b)
#pragma unroll
      for (int m = 0; m < 4; ++m)
#pragma unroll
        for (int n = 0; n < 2; ++n) acc[a][b][m][n] = (f32x4){0.f, 0.f, 0.f, 0.f};
  h16x8 At[4][2], B0[2][2], B1[2][2];
  const char* cA = cur.A; const char* cB = cur.B;
  G8_STAGE(G8_SB(0, 0), cB, vb); G8_STAGE(G8_SB(0, 1), cB + hstep, vb); G8_STAGEA(G8_SA(0, 0), cA, 0); G8_STAGEA(G8_SA(0, 1), cA, 1);
  if (wr == 1) G8_BAR;
  G8_WAIT_V(2); G8_BAR;
  G8_STAGE(G8_SB(1, 0), cB + kstep, vb); G8_STAGEA(G8_SA(1, 0), cA + kstep, 0); G8_STAGE(G8_SB(1, 1), cB + hstep + kstep, vb);
  G8_WAIT_V(6); G8_BAR;
  for (;;) {
    const bool has_next = S.next(ui + 1, nxt);
    if (!has_next) nxt = cur;
    const char* nA = nxt.A; const char* nB = nxt.B;
#pragma unroll 1
    for (int t = 0; t < nt; t += 2) {
      const bool last = (t == nt - 2);
      const char* a1 = cA + (size_t)(t + 1) * kstep;
      const char* a2 = last ? nA : cA + (size_t)(t + 2) * kstep; const char* b2 = last ? nB : cB + (size_t)(t + 2) * kstep;
      const char* a3 = a2 + kstep; const char* b3 = b2 + kstep;
#define G8_STAGE2(bufoff, gbase, h) do { glds16((gbase) + (last ? G8_VAN(h, 0) : G8_VAC(h, 0)), lds + (bufoff) + ldsw); glds16((gbase) + (last ? G8_VAN(h, 1) : G8_VAC(h, 1)), lds + (bufoff) + ldsw + 8192); } while (0)
      G8_LDB(B0, 0, 0); G8_LDB(B1, 0, 1); G8_SCHED; G8_LDA(At, 0, 0); G8_STAGEA(G8_SA(1, 1), a1, 1);
      G8_WAIT_V(8); G8_WAIT_L(0); G8_BAR; G8_MMA(0, 0, At, B0); G8_MMA(0, 1, At, B1); G8_BAR; G8_SCHED;
      G8_LDA(At, 0, 1); G8_STAGE(G8_SB(0, 0), b2, vb); G8_STAGE(G8_SB(0, 1), b2 + hstep, vb); G8_STAGE2(G8_SA(0, 0), a2, 0);
      G8_WAIT_V(8); G8_WAIT_L(0); G8_BAR; G8_MMA(1, 0, At, B0); G8_MMA(1, 1, At, B1); G8_BAR; G8_SCHED;
      G8_LDB(B0, 1, 0); G8_LDB(B1, 1, 1); G8_SCHED; G8_LDA(At, 1, 0); G8_STAGE2(G8_SA(0, 1), a2, 1);
      G8_WAIT_V(8); G8_WAIT_L(0); G8_BAR; G8_MMA(0, 0, At, B0); G8_MMA(0, 1, At, B1); G8_BAR; G8_SCHED;
      G8_LDA(At, 1, 1); G8_STAGE(G8_SB(1, 0), b3, vb); G8_STAGE(G8_SB(1, 1), b3 + hstep, vb); G8_STAGE2(G8_SA(1, 0), a3, 0);
      G8_WAIT_V(8); G8_WAIT_L(0); G8_BAR; G8_MMA(1, 0, At, B0); G8_MMA(1, 1, At, B1); G8_BAR; G8_SCHED;
    }
#undef G8_STAGE2
    if (wr == 0) G8_BAR;
    E(acc, cur, wr, wc, fr, fq);
    if (!has_next) break;
#pragma unroll
    for (int a = 0; a < 2; ++a)
#pragma unroll
      for (int b = 0; b < 2; ++b)
#pragma unroll
        for (int m = 0; m < 4; ++m)
#pragma unroll
          for (int n = 0; n < 2; ++n) acc[a][b][m][n] = (f32x4){0.f, 0.f, 0.f, 0.f};
    cur = nxt; cA = nA; cB = nB; ++ui;
    if (wr == 1) G8_BAR;
  }
  G8_WAIT_V(0);
  G8_BAR;
#undef G8_SA
#undef G8_STAGEA
#undef G8_VAC
#undef G8_VAN
#undef G8_SB
#undef G8_STAGE
#undef G8_LDA
#undef G8_LDB
#undef G8_MMA
#undef G8_WAIT_V
#undef G8_WAIT_L
#undef G8_BAR
#undef G8_SCHED
}
struct DenseOrder {
  static constexpr bool GATHER = false;
  const h16* A; const h16* Bt; int K, nM, nN, G, c;
  DEVI bool next(int i, Unit& u) const {
    const int nwg = nM * nN; const long L = (long)i * G + c; if (L >= nwg) return false;
    int wgid = (int)L; { const int q = nwg / 8, r = nwg % 8, xcd = wgid % 8, off = wgid / 8; wgid = (xcd < r ? xcd * (q + 1) : r * (q + 1) + (xcd - r) * q) + off; }
    const int nig = 8 * nN, gid = wgid / nig, fm = gid * 8, gsz = (nM - fm) < 8 ? (nM - fm) : 8;
    u.pm = fm + ((wgid % nig) % gsz); u.pn = (wgid % nig) / gsz; u.e = 0; u.cnt = 0x7fffffff; u.off = 0;
    u.A = (const char*)(A + (size_t)u.pm * 256 * K); u.B = (const char*)(Bt + (size_t)u.pn * 256 * K);
    u.va[0][0] = u.va[0][1] = u.va[1][0] = u.va[1][1] = 0u;
    return true;
  }
};
}

struct ARowPlain { const h16* base; size_t ld; DEVI const h16* operator()(int r) const { return base + (size_t)r * ld; } };
struct ARowGather { const h16* base; const unsigned* list; int n; int row0; DEVI const h16* operator()(int r) const { const int i = row0 + r; const unsigned t = (i < n) ? list[i] : 0u; return base + (size_t)t * DM; } };

DEVI h16x4 pack4(float a, float b, float c, float d) { h16x4 v; v[0] = (h16)a; v[1] = (h16)b; v[2] = (h16)c; v[3] = (h16)d; return v; }

template <class F>
DEVI void transpose_tile(const float* src, int N, int kb, int nb, h16* dst, int ldd, F drow, LDS float* tile) {
  const int tid = launder((int)threadIdx.x);
#pragma unroll
  for (int j = 0; j < 8; ++j) {
    const int kl = (tid >> 6) + 8 * j, nl = tid & 63, n = nb * 64 + nl;
    tile[kl * 65 + nl] = (n < N) ? src[(size_t)(kb * 64 + kl) * N + n] : 0.f;
  }
  __syncthreads();
  const int nl = tid >> 3, ch = tid & 7, n = nb * 64 + nl;
  if (n < N) {
    h16x8 v;
#pragma unroll
    for (int e = 0; e < 8; ++e) v[e] = (h16)tile[(ch * 8 + e) * 65 + nl];
    *(h16x8*)(dst + (size_t)drow(n) * ldd + kb * 64 + ch * 8) = v;
  }
  __syncthreads();
}

DEVI void phase0(PRef p, LDS unsigned char* lds) {
  const int tid = launder((int)threadIdx.x), lane = tid & 63, wave = wave_id(tid), G = gridDim.x;
  const int gw = blockIdx.x * 8 + wave, NW = G * 8;
  {
    const float* c = p.in[1]; const float* wada = p.in[2]; float* mp = (float*)(p.ws + WS_MODP);
    for (int u = gw; u < 96 * 8; u += NW) {
      const int cgp = u % 96, ks = u / 96, j = cgp * 64 + lane;
      float a0 = 0.f, a1 = 0.f, a2 = 0.f, a3 = 0.f;
      for (int k = ks * 128; k < ks * 128 + 128; ++k) {
        const float w = wada[(size_t)k * 6144 + j];
        a0 = fmaf(silu_f(c[k]), w, a0); a1 = fmaf(silu_f(c[1024 + k]), w, a1);
        a2 = fmaf(silu_f(c[2048 + k]), w, a2); a3 = fmaf(silu_f(c[3072 + k]), w, a3);
      }
      mp[(size_t)(ks * 4 + 0) * 6144 + j] = a0; mp[(size_t)(ks * 4 + 1) * 6144 + j] = a1;
      mp[(size_t)(ks * 4 + 2) * 6144 + j] = a2; mp[(size_t)(ks * 4 + 3) * 6144 + j] = a3;
    }
  }
  {
    LDS float* tile = (LDS float*)lds;
    constexpr int I_IN = 16 * 50, I_OUT = 16 * 16, I_G = 32 * 64, I_U = 32 * 64, I_D = 32 * 64, I_RG = 16;
    constexpr int NIT = I_IN + I_OUT + I_G + I_U + I_D + I_RG;
    for (int it = blockIdx.x; it < NIT; it += G) {
      int r = it;
      if (r < I_IN) {
        transpose_tile(p.in[8], 3144, r / 50, r % 50, (h16*)(p.ws + WS_WIN), 1024,
                       [](int n) { const int dl = n < 2112 ? n : (n < 2120 ? 3136 + (n - 2112) : (n < 2632 ? 2112 + (n - 2120) : 2624 + (n - 2632))); const int d = dl & 63; return (dl & ~63) + 32 * ((d >> 4) & 1) + 16 * (d >> 5) + (d & 15); }, tile);
        continue;
      }
      r -= I_IN;
      if (r < I_OUT) { transpose_tile(p.in[16], 1024, r / 16, r % 16, (h16*)(p.ws + WS_WOUT), 1024, [](int n) { return n; }, tile); continue; }
      r -= I_OUT;
      if (r < I_G) { const int e = r >> 6, q = r & 63;
        transpose_tile(p.in[21] + (size_t)e * 1024 * 256, 256, q >> 2, q & 3, (h16*)(p.ws + WS_WGU) + (size_t)e * 512 * 1024, 1024, [](int f) { return (f >> 4) * 32 + (f & 15); }, tile); continue; }
      r -= I_G;
      if (r < I_U) { const int e = r >> 6, q = r & 63;
        transpose_tile(p.in[22] + (size_t)e * 1024 * 256, 256, q >> 2, q & 3, (h16*)(p.ws + WS_WGU) + (size_t)e * 512 * 1024, 1024, [](int f) { return (f >> 4) * 32 + 16 + (f & 15); }, tile); continue; }
      r -= I_U;
      if (r < I_D) { const int e = r >> 6, q = r & 63;
        transpose_tile(p.in[23] + (size_t)e * 256 * 1024, 1024, q >> 4, q & 15, (h16*)(p.ws + WS_WDN) + (size_t)e * 1024 * 256, 256, [](int n) { return n; }, tile); continue; }
      r -= I_D;
      if (r < 8) transpose_tile(p.in[11] + (size_t)r * 4096, 64, 0, 0, (h16*)(p.ws + WS_WRG) + (size_t)r * 128 * 64, 64, [](int n) { return n; }, tile);
      else transpose_tile(p.in[13] + (size_t)(r - 8) * 4096, 64, 0, 0, (h16*)(p.ws + WS_WRG) + (size_t)(r - 8) * 128 * 64, 64, [](int n) { return 64 + n; }, tile);
    }
  }
  {
    float* wrt = (float*)(p.ws + WS_WRT);
    for (int i = blockIdx.x * NTHR + tid; i < 36 * 1024; i += G * NTHR) {
      const int col = i >> 10, k = i & 1023;
      wrt[i] = (col < 4) ? p.in[17][k * 4 + col] : p.in[19][k * 32 + (col - 4)];
    }
    float* ct = (float*)(p.ws + WS_ROPE); float* st = ct + 8192 * 32;
    for (int i = blockIdx.x * NTHR + tid; i < 8192 * 32; i += G * NTHR) {
      const int pos = i >> 5, f = i & 31;
      const double rev = (double)pos * ROPE_REV[f];
      const float fr = (float)(rev - __builtin_rint(rev));
      ct[i] = __builtin_amdgcn_cosf(fr); st[i] = __builtin_amdgcn_sinf(fr);
    }
  }
}

DEVI void phase1(PRef p, LDS unsigned char* lds) {
  const int tid = launder((int)threadIdx.x), lane = tid & 63, wave = wave_id(tid), G = gridDim.x;
  const int b = blockIdx.x & 3, bi = blockIdx.x >> 2, nbk = G >> 2;
  LDS float* mv = (LDS float*)lds;
  mod_to_lds(p, b, 0, mv); mod_to_lds(p, b, 1, mv + 1024);
  __syncthreads();
  f32x4 A[4], SH[4];
#pragma unroll
  for (int j = 0; j < 4; ++j) {
    const int k = 256 * j + 4 * lane;
    const f32x4 g = *(const f32x4*)(p.in[4] + k);
    A[j] = g * (*(LDS f32x4*)(mv + 1024 + k) + 1.f);
    SH[j] = *(LDS f32x4*)(mv + k);
  }
  const float* x = p.in[0]; h16* H = (h16*)(p.ws + WS_H);
  for (int r = bi * 8 + wave; r < SEQ; r += nbk * 8) {
    const size_t tok = (size_t)b * SEQ + r;
    f32x4 v[4]; float ss = 0.f;
#pragma unroll
    for (int j = 0; j < 4; ++j) { v[j] = *(const f32x4*)(x + tok * DM + 256 * j + 4 * lane); ss += v[j][0] * v[j][0] + v[j][1] * v[j][1] + v[j][2] * v[j][2] + v[j][3] * v[j][3]; }
    const float rstd = 1.0f / sqrtf(wave_sum(ss) * (1.f / 1024.f) + 1e-6f);
#pragma unroll
    for (int j = 0; j < 4; ++j) {
      const f32x4 y = v[j] * rstd * A[j] + SH[j];
      *(h16x4*)(H + tok * DM + 256 * j + 4 * lane) = pack4(y[0], y[1], y[2], y[3]);
    }
  }
}

struct EpiInProj {
  unsigned char* ws;
  DEVI void operator()(const f32x4 (&acc)[2][2][4][2], const g8::Unit& u, int wr, int wc, int fr, int fq) const {
    const float* cosT = (const float*)(ws + WS_ROPE); const float* sinT = cosT + 8192 * 32;
    const int w2 = wc & 1, dlow = 16 * w2 + 4 * fq;
#pragma unroll
    for (int bj = 0; bj < 2; ++bj) {
      const int g = 4 * u.pn + 2 * bj + (wc >> 1);
      if (g > 49) continue;
#pragma unroll
      for (int ai = 0; ai < 2; ++ai)
#pragma unroll
        for (int m = 0; m < 4; ++m) {
          const int tok = u.pm * 256 + 128 * ai + 64 * wr + 16 * m + fr;
          const int b = tok >> 13, pos = tok & 8191;
          const f32x4 x1 = acc[ai][bj][m][0], x2 = acc[ai][bj][m][1];
          if (g < 16 || (g >= 24 && g <= 32)) {
            float scl; h16* dst;
            if (g < 8) { scl = 0.125f * 1.4426950408889634f; dst = (h16*)(ws + WS_Q) + (size_t)tok * 512 + g * 64; }
            else if (g < 16) { scl = 1.f; dst = (h16*)(ws + WS_K) + (size_t)tok * 512 + (g - 8) * 64; }
            else if (g < 32) { scl = 0.125f; dst = (h16*)(ws + WS_QI) + (size_t)tok * 512 + (g - 24) * 64; }
            else { scl = 1.f; dst = (h16*)(ws + WS_KI) + (size_t)tok * 64; }
            const f32x4 c = *(const f32x4*)(cosT + pos * 32 + dlow), s = *(const f32x4*)(sinT + pos * 32 + dlow);
            const f32x4 o1 = (x1 * c - x2 * s) * scl, o2 = (x2 * c + x1 * s) * scl;
            *(h16x4*)(dst + dlow) = pack4(o1[0], o1[1], o1[2], o1[3]);
            *(h16x4*)(dst + 32 + dlow) = pack4(o2[0], o2[1], o2[2], o2[3]);
          } else if (g < 24) {
            h16* vt = (h16*)(ws + WS_VT) + (size_t)(b * 8 + (g - 16)) * 64 * 8192 + vt_perm(pos);
#pragma unroll
            for (int e = 0; e < 4; ++e) { vt[(size_t)(dlow + e) * 8192] = (h16)x1[e]; vt[(size_t)(32 + dlow + e) * 8192] = (h16)x2[e]; }
          } else if (g < 49) {
            h16* dst = (g < 41) ? (h16*)(ws + WS_XR) + (size_t)tok * 512 + (g - 33) * 64 : (h16*)(ws + WS_XG) + (size_t)tok * 512 + (g - 41) * 64;
            *(h16x4*)(dst + dlow) = pack4(x1[0], x1[1], x1[2], x1[3]);
            *(h16x4*)(dst + 32 + dlow) = pack4(x2[0], x2[1], x2[2], x2[3]);
          } else if (w2 == 0 && fq < 2) {
            const float sc = 0.35355339059327373f;
            *(f32x4*)((float*)(ws + WS_WI) + (size_t)tok * 8 + 4 * fq) = x1 * sc;
          }
        }
    }
  }
};

DEVI void phase2(PRef p, LDS unsigned char* lds) {
  g8::DenseOrder S{(const h16*)(p.ws + WS_H), (const h16*)(p.ws + WS_WIN), DM, 128, 13, (int)gridDim.x, (int)blockIdx.x};
  EpiInProj E{p.ws};
  g8::gemm_phase(lds, DM, S, E);
}

constexpr int CROW = 1040;
constexpr int RNN_XG = 64 * CROW;
constexpr int RNN_CARRY = 2 * 64 * CROW;
template <int MODE>
DEVI void rnn_item(PRef p, LDS unsigned char* lds, int b, int cr) {
  const int tid = launder((int)threadIdx.x), lane = tid & 63, wave = wave_id(tid), l31 = lane & 31, half = lane >> 5;
  const h16* XR = (const h16*)(p.ws + WS_XR);
  {
    const int chg = tid & 63, tg = tid >> 6, pos0 = cr * 64 + 8 * tg;
    h16x8 xin[11];
#pragma unroll
    for (int i = 0; i < 11; ++i) {
      const int pos = pos0 + i - 3;
      if (pos >= 0) xin[i] = *(const h16x8*)(XR + ((size_t)b * SEQ + pos) * 512 + chg * 8);
      else {
#pragma unroll
        for (int e = 0; e < 8; ++e) xin[i][e] = (h16)0.f;
      }
    }
    float cw[4][8], cb[8];
#pragma unroll
    for (int e = 0; e < 8; ++e) {
      cb[e] = p.in[10][chg * 8 + e];
#pragma unroll
      for (int j = 0; j < 4; ++j) cw[j][e] = p.in[9][j * 512 + chg * 8 + e];
    }
#pragma unroll
    for (int tt = 0; tt < 8; ++tt) {
      h16x8 o;
#pragma unroll
      for (int e = 0; e < 8; ++e) {
        float v = cb[e];
#pragma unroll
        for (int j = 0; j < 4; ++j) v = fmaf(cw[j][e], (float)xin[tt + j][e], v);
        o[e] = (h16)v;
      }
      *(LDS h16x8*)(lds + (8 * tg + tt) * CROW + chg * 16) = o;
    }
  }
  if (MODE == 1) {
    const float2* ag = (const float2*)(p.ws + WS_AGG) + (size_t)b * 128 * 512 + tid;
    float carry = 0.f; int c2 = 0;
    for (; c2 + 8 <= cr; c2 += 8) {
      float2 v[8];
#pragma unroll
      for (int u = 0; u < 8; ++u) v[u] = ag[(size_t)(c2 + u) * 512];
#pragma unroll
      for (int u = 0; u < 8; ++u) carry = fmaf(v[u].x, carry, v[u].y);
    }
    for (; c2 < cr; ++c2) { const float2 v = ag[(size_t)c2 * 512]; carry = fmaf(v.x, carry, v.y); }
    ((LDS float*)(lds + RNN_CARRY))[tid] = carry;
  }
  if (MODE == 1) {
    const h16* XG = (const h16*)(p.ws + WS_XG) + ((size_t)b * SEQ + cr * 64) * 512;
#pragma unroll
    for (int i = 0; i < 8; ++i) { const int c = tid + NTHR * i, row = c >> 6, cc = c & 63; *(LDS h16x8*)(lds + RNN_XG + row * CROW + cc * 16) = *(const h16x8*)(XG + (size_t)row * 512 + cc * 8); }
  }
  __syncthreads();
  const int n = wave;
  const h16* WRG = (const h16*)(p.ws + WS_WRG) + (size_t)n * 128 * 64;
  float* AGG = (float*)(p.ws + WS_AGG);
#pragma unroll 1
  for (int dt = 0; dt < 2; ++dt) {
    h16x8 wa[4], wx[4];
#pragma unroll
    for (int kk = 0; kk < 4; ++kk) {
      wa[kk] = *(const h16x8*)(WRG + (size_t)(32 * dt + l31) * 64 + 16 * kk + 8 * half);
      wx[kk] = *(const h16x8*)(WRG + (size_t)(64 + 32 * dt + l31) * 64 + 16 * kk + 8 * half);
    }
    f32x16 ra[2], rx[2];
#pragma unroll
    for (int ti = 0; ti < 2; ++ti) {
#pragma unroll
      for (int r = 0; r < 16; ++r) { ra[ti][r] = 0.f; rx[ti][r] = 0.f; }
#pragma unroll
      for (int kk = 0; kk < 4; ++kk) {
        const h16x8 af = *(LDS h16x8*)(lds + (32 * ti + l31) * CROW + (n * 64 + 16 * kk + 8 * half) * 2);
        ra[ti] = mfma16(af, wa[kk], ra[ti]);
        rx[ti] = mfma16(af, wx[kk], rx[ti]);
      }
    }
    const int ch = n * 64 + 32 * dt + l31;
    const float ba = p.in[12][ch], bx = p.in[14][ch], lam = p.in[15][ch];
    const float c8 = -8.f * log1pf(__expf(-lam));
#pragma unroll
    for (int ti = 0; ti < 2; ++ti)
#pragma unroll
      for (int r = 0; r < 16; ++r) {
        const int tk = 32 * ti + (r & 3) + 8 * (r >> 2) + 4 * half;
        const float cv = (float)*(LDS h16*)(lds + tk * CROW + ch * 2);
        const float rr = sigmoid_f(ra[ti][r] + ba), ii = sigmoid_f(rx[ti][r] + bx);
        const float la = c8 * rr;
        ra[ti][r] = __expf(la);
        rx[ti][r] = sqrtf(-expm1f(2.f * la)) * (ii * cv);
      }
    float P[8], Hs[8];
#pragma unroll
    for (int sg = 0; sg < 8; ++sg) {
      const int ti = sg >> 2, q = sg & 3;
      float pp = 1.f, hh = 0.f;
#pragma unroll
      for (int i = 0; i < 4; ++i) { const float a = ra[ti][4 * q + i], bb = rx[ti][4 * q + i]; hh = fmaf(a, hh, bb); pp *= a; }
      P[sg] = pp; Hs[sg] = hh;
    }
    float carry = 0.f, prod = 1.f;
    if (MODE == 1) carry = ((LDS float*)(lds + RNN_CARRY))[ch];
    float cin[8];
#pragma unroll
    for (int sg = 0; sg < 8; ++sg)
#pragma unroll
      for (int ow = 0; ow < 2; ++ow) {
        const float tmp = fmaf(P[sg], carry, Hs[sg]);
        const float tp = P[sg] * prod;
        if (half == ow) cin[sg] = carry;
        const float oth = __shfl_xor(tmp, 32), otp = __shfl_xor(tp, 32);
        carry = (half == ow) ? tmp : oth;
        prod = (half == ow) ? tp : otp;
      }
    if (MODE == 0) {
      if (half == 0) { float* ag = AGG + ((size_t)(b * 128 + cr) * 512 + ch) * 2; ag[0] = prod; ag[1] = carry; }
    } else {
#pragma unroll
      for (int sg = 0; sg < 8; ++sg) {
        const int ti = sg >> 2, q = sg & 3;
        float hh = cin[sg];
#pragma unroll
        for (int i = 0; i < 4; ++i) {
          hh = fmaf(ra[ti][4 * q + i], hh, rx[ti][4 * q + i]);
          LDS h16* xp = (LDS h16*)(lds + RNN_XG + (32 * ti + 8 * q + 4 * half + i) * CROW + ch * 2);
          *xp = (h16)(hh * gelu_tanh_f((float)*xp));
        }
      }
    }
  }
  __syncthreads();
  if (MODE == 1) {
    h16* Y = (h16*)(p.ws + WS_H) + ((size_t)b * SEQ + cr * 64) * DM + 512;
#pragma unroll
    for (int i = 0; i < 8; ++i) { const int c = tid + NTHR * i, row = c >> 6, cc = c & 63; *(h16x8*)(Y + (size_t)row * DM + cc * 8) = *(LDS h16x8*)(lds + RNN_XG + row * CROW + cc * 16); }
    __syncthreads();
  }
}

constexpr int IDX_NB = 256, IDX_CAP = 128;
constexpr int IL_HIST = 0, IL_CS = 65536, IL_CK = IL_CS + 64 * IDX_CAP * 4, IL_KI = IL_CK + 64 * IDX_CAP * 2, IL_KISZ = 128 * LROW, IL_ST = IL_KI + 2 * IL_KISZ;
static_assert(IL_ST + 4096 <= LDS_BYTES, "indexer LDS map");

DEVI f32x4 mfma16s(h16x8 a, h16x8 b, f32x4 c) { return __builtin_amdgcn_mfma_f32_16x16x32_f16(a, b, c, 0, 0, 0); }
DEVI void idx_score(LDS unsigned char* kit, int kh, int l15, int g4, const h16x8 (&qf)[8][2], const float (&wq)[8], f32x4 (&sc)[4]) {
  h16x8 kf[4][2];
#pragma unroll
  for (int kt = 0; kt < 4; ++kt)
#pragma unroll
    for (int ks = 0; ks < 2; ++ks) kf[kt][ks] = *(LDS h16x8*)(kit + (64 * kh + 16 * kt + l15) * LROW + (4 * ks + g4) * 16);
#pragma unroll
  for (int kt = 0; kt < 4; ++kt) sc[kt] = (f32x4){0.f, 0.f, 0.f, 0.f};
#pragma unroll
  for (int h = 0; h < 8; ++h) {
#pragma unroll
    for (int kt = 0; kt < 4; ++kt) {
      f32x4 acc = (f32x4){0.f, 0.f, 0.f, 0.f};
      acc = mfma16s(kf[kt][0], qf[h][0], acc);
      acc = mfma16s(kf[kt][1], qf[h][1], acc);
#pragma unroll
      for (int r = 0; r < 4; ++r) sc[kt][r] = __builtin_fmaf(wq[h], __builtin_fmaxf(acc[r], 0.f), sc[kt][r]);
    }
    if (h & 1) __builtin_amdgcn_sched_barrier(0);
  }
}

template <int MODE>
DEVI void idx_pass(LDS unsigned char* lds, const h16* KIb, int N, int stride, int qg, int kh,
                   const h16* QIrow0, const float* WIrow0, float qinv, float qoff, int bstar) {
  const int tid = launder((int)threadIdx.x), lane = tid & 63, l15 = lane & 15, g4 = lane >> 4;
  const int q = 16 * qg + l15;
  h16x8 qf[8][2]; float wq[8];
  {
    const h16* QI = QIrow0 + (size_t)q * 512;
#pragma unroll
    for (int h = 0; h < 8; ++h)
#pragma unroll
      for (int ks = 0; ks < 2; ++ks) qf[h][ks] = *(const h16x8*)(QI + h * 64 + 32 * ks + 8 * g4);
    const float* WI = WIrow0 + (size_t)q * 8;
#pragma unroll
    for (int h = 0; h < 8; ++h) wq[h] = WI[h];
  }
  LDS unsigned* hist = (LDS unsigned*)(lds + IL_HIST);
  LDS unsigned* st = (LDS unsigned*)(lds + IL_ST);
  const int nst = (N + 127) >> 7;
  const int lr = tid >> 3, lc = tid & 7;
  h16x8 r0, r1;
  r0 = *(const h16x8*)(KIb + (size_t)lr * 64 + lc * 8); r1 = *(const h16x8*)(KIb + (size_t)(lr + 64) * 64 + lc * 8);
  *(LDS h16x8*)(lds + IL_KI + lr * LROW + lc * 16) = r0; *(LDS h16x8*)(lds + IL_KI + (lr + 64) * LROW + lc * 16) = r1;
  __syncthreads();
  float vmin = INFINITY, vmax = -INFINITY;
  int cur = 0;
  for (int s = 0; s < nst; s += stride) {
    const int nx = s + stride;
    if (nx < nst) { r0 = *(const h16x8*)(KIb + (size_t)(128 * nx + lr) * 64 + lc * 8); r1 = *(const h16x8*)(KIb + (size_t)(128 * nx + lr + 64) * 64 + lc * 8); }
    if (128 * s + 64 * kh < N) {
      f32x4 sc[4];
      idx_score(lds + IL_KI + cur * IL_KISZ, kh, l15, g4, qf, wq, sc);
      if (MODE == 0) {
#pragma unroll
        for (int kt = 0; kt < 4; ++kt)
#pragma unroll
          for (int r = 0; r < 4; ++r) { vmin = fminf(vmin, sc[kt][r]); vmax = fmaxf(vmax, sc[kt][r]); }
      } else if (MODE == 1) {
#pragma unroll
        for (int kt = 0; kt < 4; ++kt)
#pragma unroll
          for (int r = 0; r < 4; ++r) {
            const float xb = fminf(fmaxf(__builtin_fmaf(sc[kt][r], qinv, qoff), 0.f), (float)(IDX_NB - 1));
            const int bin = (int)xb;
            __hip_atomic_fetch_add(&hist[bin * 64 + q], 1u, __ATOMIC_RELAXED, __HIP_MEMORY_SCOPE_WORKGROUP);
          }
      } else {
        unsigned nib = 0u;
#pragma unroll
        for (int kt = 0; kt < 4; ++kt)
#pragma unroll
          for (int r = 0; r < 4; ++r) {
            const float xb = fminf(fmaxf(__builtin_fmaf(sc[kt][r], qinv, qoff), 0.f), (float)(IDX_NB - 1));
            const int bin = (int)xb;
            if (bin > bstar) nib |= (1u << (4 * kt + r));
            else if (bin == bstar) {
              const unsigned pos = __hip_atomic_fetch_add(&st[128 + q], 1u, __ATOMIC_RELAXED, __HIP_MEMORY_SCOPE_WORKGROUP);
              if (pos < (unsigned)IDX_CAP) {
                ((LDS float*)(lds + IL_CS))[q * IDX_CAP + pos] = sc[kt][r];
                ((LDS unsigned short*)(lds + IL_CK))[q * IDX_CAP + pos] = (unsigned short)(128 * s + 64 * kh + 16 * kt + 4 * g4 + r);
              }
            }
          }
        const unsigned oth = (unsigned)__shfl_xor((int)nib, 32);
        if (lane < 32) {
#pragma unroll
          for (int T = 0; T < 2; ++T) {
            const unsigned b0 = ((nib >> (8 * T)) & 15u) | (((oth >> (8 * T)) & 15u) << 4);
            const unsigned b1 = ((nib >> (8 * T + 4)) & 15u) | (((oth >> (8 * T + 4)) & 15u) << 4);
            ((LDS unsigned short*)(lds + IL_HIST))[q * 512 + (4 * s + 2 * kh + T) * 2 + (g4 & 1)] = (unsigned short)(b0 | (b1 << 8));
          }
        }
      }
    }
    if (nx < nst) {
      *(LDS h16x8*)(lds + IL_KI + (cur ^ 1) * IL_KISZ + lr * LROW + lc * 16) = r0;
      *(LDS h16x8*)(lds + IL_KI + (cur ^ 1) * IL_KISZ + (lr + 64) * LROW + lc * 16) = r1;
    }
    __syncthreads();
    cur ^= 1;
  }
  if (MODE == 0) {
    __hip_atomic_fetch_min(&st[q], fkey(vmin), __ATOMIC_RELAXED, __HIP_MEMORY_SCOPE_WORKGROUP);
    __hip_atomic_fetch_max(&st[64 + q], fkey(vmax), __ATOMIC_RELAXED, __HIP_MEMORY_SCOPE_WORKGROUP);
  }
}

DEVI void idx_item(PRef p, LDS unsigned char* lds, int b, int c) {
  const int tid = launder((int)threadIdx.x), lane = tid & 63, wave = wave_id(tid), l31 = lane & 31, half = lane >> 5;
  const int N = 64 * (c + 1);
  unsigned* MASK = (unsigned*)(p.ws + WS_MASK) + ((size_t)b * SEQ + 64 * c) * 256;
  if (N <= 256) {
    const int wpr = N >> 5;
    for (int i = tid; i < 64 * wpr; i += NTHR) MASK[(size_t)(i / wpr) * 256 + (i % wpr)] = 0xFFFFFFFFu;
    return;
  }
  const int qg = wave & 3, kh = wave >> 2, l15 = lane & 15, q = 16 * qg + l15;
  const h16* QIrow0 = (const h16*)(p.ws + WS_QI) + ((size_t)b * SEQ + 64 * c) * 512;
  const float* WIrow0 = (const float*)(p.ws + WS_WI) + ((size_t)b * SEQ + 64 * c) * 8;
  const h16* KIb = (const h16*)(p.ws + WS_KI) + (size_t)b * SEQ * 64;
  LDS unsigned* st = (LDS unsigned*)(lds + IL_ST);
  LDS float* stf = (LDS float*)(lds + IL_ST);
  if (tid < 64) { st[tid] = 0xFFFFFFFFu; st[64 + tid] = 0u; st[128 + tid] = 0u; }
  __syncthreads();
  const int nst = (N + 127) >> 7;
  const int stride = nst >= 16 ? 8 : (nst >= 8 ? 4 : (nst >= 4 ? 2 : 1));
  idx_pass<0>(lds, KIb, N, stride, qg, kh, QIrow0, WIrow0, 0.f, 0.f, 0);
  __syncthreads();
  if (tid < 64) {
    const float lo = fkey_inv(st[tid]), hi = fkey_inv(st[64 + tid]);
    float d = hi - lo; if (!(d > 1e-20f)) d = 1.f;
    const float inv = (float)IDX_NB / (1.5f * d);
    stf[192 + tid] = inv; stf[256 + tid] = -(lo - 0.25f * d) * inv;
  }
  for (int i = tid; i < 16384; i += NTHR) ((LDS unsigned*)(lds + IL_HIST))[i] = 0u;
  __syncthreads();
  const float qinv = stf[192 + q], qoff = stf[256 + q];
  idx_pass<1>(lds, KIb, N, 1, qg, kh, QIrow0, WIrow0, qinv, qoff, 0);
#ifdef PROBE_P1X2
  __syncthreads();
  for (int i = tid; i < 16384; i += NTHR) ((LDS unsigned*)(lds + IL_HIST))[i] = 0u;
  __syncthreads();
  idx_pass<1>(lds, KIb, N, 1, qg, kh, QIrow0, WIrow0, qinv, qoff, 0);
#endif
  if (tid < 64) {
    LDS unsigned* hist = (LDS unsigned*)(lds + IL_HIST);
    unsigned cum = 0u; int bs = 0; unsigned need = 256u;
    for (int bb = IDX_NB - 1; bb >= 0; --bb) {
      const unsigned hcount = hist[bb * 64 + tid];
      if (cum + hcount >= 256u) { bs = bb; need = 256u - cum; break; }
      cum += hcount;
    }
    st[320 + tid] = (unsigned)bs; st[384 + tid] = need;
  }
  __syncthreads();
  const int bstar = (int)st[320 + q];
  __syncthreads();
  idx_pass<2>(lds, KIb, N, 1, qg, kh, QIrow0, WIrow0, qinv, qoff, bstar);
#ifdef PROBE_P2X2
  __syncthreads();
  if (tid < 64) st[128 + tid] = 0u;
  __syncthreads();
  idx_pass<2>(lds, KIb, N, 1, qg, kh, QIrow0, WIrow0, qinv, qoff, bstar);
#endif
  for (int qq = wave; qq < 64; qq += 8) {
    const int nc = min((int)st[128 + qq], IDX_CAP); const unsigned need = st[384 + qq];
    LDS float* cs = (LDS float*)(lds + IL_CS) + qq * IDX_CAP; LDS unsigned short* ck = (LDS unsigned short*)(lds + IL_CK) + qq * IDX_CAP;
    for (int i = lane; i < nc; i += 64) {
      const float sv = cs[i]; const unsigned kv = ck[i];
      unsigned rank = 0u;
      for (int j = 0; j < nc; ++j) { const float sj = cs[j]; const unsigned kj = ck[j]; rank += (sj > sv || (sj == sv && kj < kv)) ? 1u : 0u; }
      if (rank < need) {
        const unsigned kl = kv & 31u;
        const unsigned bit = 16u * ((kl >> 2) & 1u) + (kl & 3u) + 4u * (kl >> 3);
        __hip_atomic_fetch_or((LDS unsigned*)(lds + IL_HIST) + qq * 256 + (kv >> 5), 1u << bit, __ATOMIC_RELAXED, __HIP_MEMORY_SCOPE_WORKGROUP);
      }
    }
  }
  __syncthreads();
  {
    const int cpr = N >> 6;
    for (int i = tid; i < 64 * cpr; i += NTHR) {
      const int row = i / cpr, cc = i % cpr;
      *(u32x2*)(MASK + (size_t)row * 256 + 2 * cc) = *(LDS u32x2*)(lds + IL_HIST + row * 1024 + cc * 8);
    }
  }
  __syncthreads();
}

DEVI void phase3(PRef p, LDS unsigned char* lds) {
  const int G = gridDim.x;
  for (int it = blockIdx.x; it < 512; it += G) rnn_item<0>(p, lds, it >> 7, it & 127);
  for (int it = blockIdx.x; it < 256; it += G) {
    const int b = it >> 6, j = it & 63;
#pragma unroll 1
    for (int w2 = 0; w2 < 2; ++w2) idx_item(p, lds, b, w2 ? j : 127 - j);
  }
}

constexpr int AT_BUF = 2 * 64 * LROW;
DEVI float max3f(float a, float b, float c) { float r; asm("v_max3_f32 %0, %1, %2, %3" : "=v"(r) : "v"(a), "v"(b), "v"(c)); return r; }
DEVI unsigned pk_rtz(float a, float b) { return __builtin_bit_cast(unsigned, __builtin_amdgcn_cvt_pkrtz(a, b)); }
DEVI void attn_tile(LDS unsigned char* Kt, LDS unsigned char* Vt, const h16x8 (&qf)[4], u32x2 mw, int l31, int half, f32x16 (&o)[2], float& mref, float& l, bool& init) {
  const unsigned nm0 = ~(mw[0] >> (16 * half)), nm1 = ~(mw[1] >> (16 * half));
  const unsigned negm = __float_as_uint(-mref);
  f32x16 s[2];
#pragma unroll
  for (int r = 0; r < 16; ++r) {
    unsigned e0 = (unsigned)__builtin_amdgcn_sbfe((int)nm0, r, 1), e1 = (unsigned)__builtin_amdgcn_sbfe((int)nm1, r, 1);
    asm volatile("" : "+v"(e0), "+v"(e1));
    s[0][r] = __uint_as_float((e0 & 0xFF800000u) | (~e0 & negm));
    s[1][r] = __uint_as_float((e1 & 0xFF800000u) | (~e1 & negm));
  }
#pragma unroll
  for (int ri = 0; ri < 2; ++ri)
#pragma unroll
    for (int kk = 0; kk < 4; ++kk) {
      const h16x8 kf = *(LDS h16x8*)(Kt + (32 * ri + l31) * LROW + (2 * kk + half) * 16);
      s[ri] = mfma16(kf, qf[kk], s[ri]);
    }
  asm volatile("s_nop 15\n\ts_nop 7" : "+v"(s[0]), "+v"(s[1]));
  float mx = max3f(s[0][0], s[1][0], s[0][1]), mx2 = max3f(s[1][1], s[0][2], s[1][2]);
#pragma unroll
  for (int r = 3; r < 15; r += 2) { mx = max3f(mx, s[0][r], s[1][r]); mx2 = max3f(mx2, s[0][r + 1], s[1][r + 1]); }
  mx = max3f(mx, s[0][15], s[1][15]);
  mx = max3f(mx, mx2, mx2);
  mx = max3f(mx, __shfl_xor(mx, 32), mx);
  const bool first = (!init) && (mx > -INFINITY);
  const bool resc = first || (mx > 8.f);
  if (__any(resc)) {
    init = init || first;
    const float delta = resc ? mx : 0.f;
    const float alpha = __builtin_amdgcn_exp2f(-delta);
#pragma unroll
    for (int r = 0; r < 16; ++r) { s[0][r] -= delta; s[1][r] -= delta; o[0][r] *= alpha; o[1][r] *= alpha; }
    l *= alpha; mref += delta;
  }
  float ls = 0.f;
#pragma unroll
  for (int r = 0; r < 16; ++r) {
    s[0][r] = __builtin_amdgcn_exp2f(s[0][r]); s[1][r] = __builtin_amdgcn_exp2f(s[1][r]);
    ls += s[0][r] + s[1][r];
  }
  l += ls;
  h16x8 pf[4];
#pragma unroll
  for (int s4 = 0; s4 < 4; ++s4) {
    u32x4 w;
#pragma unroll
    for (int e = 0; e < 4; ++e) w[e] = pk_rtz(s[s4 >> 1][8 * (s4 & 1) + 2 * e], s[s4 >> 1][8 * (s4 & 1) + 2 * e + 1]);
    pf[s4] = __builtin_bit_cast(h16x8, w);
  }
#pragma unroll
  for (int di = 0; di < 2; ++di)
#pragma unroll
    for (int s4 = 0; s4 < 4; ++s4) {
      const h16x8 vf = *(LDS h16x8*)(Vt + (32 * di + l31) * LROW + (2 * s4 + half) * 16);
      o[di] = mfma16(vf, pf[s4], o[di]);
    }
}

DEVI void attn_unit(PRef p, LDS unsigned char* lds, int b, int head, int qb) {
  const int tid = launder((int)threadIdx.x), lane = tid & 63, wave = wave_id(tid), l31 = lane & 31, half = lane >> 5;
  const int q0 = qb * 256 + wave * 32, cw = q0 >> 6, NT = 4 * (qb + 1);
  const size_t tok = (size_t)b * SEQ + q0 + l31;
  h16x8 qf[4];
  {
    const h16* Q = (const h16*)(p.ws + WS_Q) + tok * 512 + head * 64;
#pragma unroll
    for (int kk = 0; kk < 4; ++kk) qf[kk] = *(const h16x8*)(Q + 16 * kk + 8 * half);
  }
  const unsigned* mrow = (const unsigned*)(p.ws + WS_MASK) + tok * 256;
  const int lr = tid >> 3, lc = tid & 7;
  const h16* kp = (const h16*)(p.ws + WS_K) + ((size_t)b * SEQ + lr) * 512 + head * 64 + lc * 8;
  const h16* vp = (const h16*)(p.ws + WS_VT) + ((size_t)(b * 8 + head) * 64 + lr) * 8192 + lc * 8;
  LDS unsigned char* wk = lds + lr * LROW + lc * 16;
  h16x8 rkA = *(const h16x8*)kp, rvA = *(const h16x8*)vp, rkB, rvB;
  *(LDS h16x8*)wk = rkA; *(LDS h16x8*)(wk + 64 * LROW) = rvA;
  rkA = *(const h16x8*)(kp + (size_t)64 * 512); rvA = *(const h16x8*)(vp + 64);
  u32x2 mw = *(const u32x2*)mrow, mwn;
  __syncthreads();
  f32x16 o[2];
#pragma unroll
  for (int r = 0; r < 16; ++r) { o[0][r] = 0.f; o[1][r] = 0.f; }
  float mref = 0.f, l = 0.f; bool init = false;
#define ATT_STEP(j, RKC, RVC, RKN, RVN) { \
    if ((j) + 2 < NT) { RKN = *(const h16x8*)(kp + (size_t)((j) + 2) * 64 * 512); RVN = *(const h16x8*)(vp + ((j) + 2) * 64); } \
    if ((j) + 1 < NT) mwn = *(const u32x2*)(mrow + 2 * ((j) + 1)); \
    if ((j) <= cw) attn_tile(lds + ((j) & 1) * AT_BUF, lds + ((j) & 1) * AT_BUF + 64 * LROW, qf, mw, l31, half, o, mref, l, init); \
    if ((j) + 1 < NT) { *(LDS h16x8*)(wk + (((j) + 1) & 1) * AT_BUF) = RKC; *(LDS h16x8*)(wk + (((j) + 1) & 1) * AT_BUF + 64 * LROW) = RVC; } \
    __syncthreads(); mw = mwn; }
  for (int jt = 0; jt < NT; jt += 2) {
    ATT_STEP(jt, rkA, rvA, rkB, rvB)
    ATT_STEP(jt + 1, rkB, rvB, rkA, rvA)
  }
#undef ATT_STEP
  const float inv = 1.f / (l + __shfl_xor(l, 32));
  h16* Y = (h16*)(p.ws + WS_H) + tok * DM + head * 64;
#pragma unroll
  for (int di = 0; di < 2; ++di)
#pragma unroll
    for (int q = 0; q < 4; ++q)
      *(h16x4*)(Y + 32 * di + 8 * q + 4 * half) = pack4(o[di][4 * q] * inv, o[di][4 * q + 1] * inv, o[di][4 * q + 2] * inv, o[di][4 * q + 3] * inv);
}

DEVI void phase4(PRef p, LDS unsigned char* lds) {
  const int G = gridDim.x;
  for (int it = blockIdx.x; it < 512; it += G) rnn_item<1>(p, lds, it >> 7, it & 127);
  for (int it = blockIdx.x; it < 512; it += G) {
    const int bh = it >> 4, j = it & 15;
#pragma unroll 1
    for (int w2 = 0; w2 < 2; ++w2) attn_unit(p, lds, bh >> 3, bh & 7, w2 ? j : 31 - j);
  }
}

struct EpiPlain {
  h16* dst; int ld;
  DEVI void operator()(const f32x4 (&acc)[2][2][4][2], const g8::Unit& u, int wr, int wc, int fr, int fq) const {
#pragma unroll
    for (int ai = 0; ai < 2; ++ai)
#pragma unroll
      for (int m = 0; m < 4; ++m) {
        const int r = u.pm * 256 + 128 * ai + 64 * wr + 16 * m + fr;
        if (r < u.cnt) {
          h16* d = dst + (size_t)(u.off + r) * ld + u.pn * 256 + 32 * wc + 4 * fq;
#pragma unroll
          for (int bj = 0; bj < 2; ++bj)
#pragma unroll
            for (int n = 0; n < 2; ++n) { const f32x4 v = acc[ai][bj][m][n]; *(h16x4*)(d + 128 * bj + 16 * n) = pack4(v[0], v[1], v[2], v[3]); }
        }
      }
  }
};
DEVI void phase5(PRef p, LDS unsigned char* lds) {
  g8::DenseOrder S{(const h16*)(p.ws + WS_H), (const h16*)(p.ws + WS_WOUT), DM, 128, 4, (int)gridDim.x, (int)blockIdx.x};
  EpiPlain E{(h16*)(p.ws + WS_MIX), DM};
  g8::gemm_phase(lds, DM, S, E);
}

constexpr int P6_WRT = 0, P6_MOD = 36 * 1024 * 4, P6_LG = P6_MOD  , P6_BIAS = P6_LG + 8 * 72 * 4, P6_TOK = P6_BIAS + 160, P6_LCNT = P6_TOK + 128 * 6 * 4, P6_LBASE = P6_LCNT + 128;
static_assert(P6_LBASE + 128 <= LDS_BYTES - 16 && P6_MOD + 3 * 4096 <= LDS_BYTES - 16, "phase 6 LDS map");
DEVI void phase6(PRef p, LDS unsigned char* lds) {
  const int tid = launder((int)threadIdx.x), lane = tid & 63, wave = wave_id(tid), G = gridDim.x;
  const int b = blockIdx.x & 3, bi = blockIdx.x >> 2, nbk = G >> 2;
  LDS float* wrt = (LDS float*)(lds + P6_WRT);
  LDS float* mv = (LDS float*)(lds + P6_MOD);
  LDS float* lgw = (LDS float*)(lds + P6_LG) + wave * 72;
  LDS float* rbias = (LDS float*)(lds + P6_BIAS);
  LDS unsigned* tokrec = (LDS unsigned*)(lds + P6_TOK);
  LDS unsigned* lcnt = (LDS unsigned*)(lds + P6_LCNT);
  LDS unsigned* lbase = (LDS unsigned*)(lds + P6_LBASE);
  {
    const f32x4* src = (const f32x4*)(p.ws + WS_WRT);
    for (int i = tid; i < 36 * 256; i += NTHR) ((LDS f32x4*)wrt)[i] = src[i];
  }
  mod_to_lds(p, b, 2, mv); mod_to_lds(p, b, 3, mv + 1024); mod_to_lds(p, b, 4, mv + 2048);
  __syncthreads();
  f32x4 A1[4], A2[4], SH2[4];
#pragma unroll
  for (int j = 0; j < 4; ++j) {
    const int k = 256 * j + 4 * lane;
    A1[j] = *(LDS f32x4*)(mv + k) * *(const f32x4*)(p.in[5] + k);
    A2[j] = *(const f32x4*)(p.in[6] + k) * (*(LDS f32x4*)(mv + 2048 + k) + 1.f);
    SH2[j] = *(LDS f32x4*)(mv + 1024 + k);
  }
  __syncthreads();
  if (tid < 4) rbias[tid] = p.in[18][tid];
  else if (tid < 36) rbias[tid] = p.in[20][tid - 4];
  if (tid < 32) lcnt[tid] = 0u;
  __syncthreads();
  const float* x = p.in[0]; const h16* MIX = (const h16*)(p.ws + WS_MIX); float* X1 = p.out; h16* H2 = (h16*)(p.ws + WS_H);
  const bool lowhalf = lane < 32, lowq = (lane & 16) == 0;
  int it = 0;
  for (int pr = bi * 8 + wave; pr < SEQ / 2; pr += nbk * 8, ++it) {
    f32x4 h2[2][4];
#pragma unroll
    for (int tt = 0; tt < 2; ++tt) {
      const size_t tok = (size_t)b * SEQ + 2 * pr + tt;
      f32x4 xv[4], mx[4]; float ssm = 0.f;
#pragma unroll
      for (int j = 0; j < 4; ++j) {
        xv[j] = *(const f32x4*)(x + tok * DM + 256 * j + 4 * lane);
        const h16x4 mh = *(const h16x4*)(MIX + tok * DM + 256 * j + 4 * lane);
#pragma unroll
        for (int e = 0; e < 4; ++e) { mx[j][e] = (float)mh[e]; ssm += mx[j][e] * mx[j][e]; }
      }
      const float rsm = 1.0f / sqrtf(wave_sum(ssm) * (1.f / 1024.f) + 1e-6f);
      float ss1 = 0.f;
#pragma unroll
      for (int j = 0; j < 4; ++j) {
        xv[j] = xv[j] + A1[j] * (mx[j] * rsm);
        *(f32x4*)(X1 + tok * DM + 256 * j + 4 * lane) = xv[j];
        ss1 += xv[j][0] * xv[j][0] + xv[j][1] * xv[j][1] + xv[j][2] * xv[j][2] + xv[j][3] * xv[j][3];
      }
      const float rs1 = 1.0f / sqrtf(wave_sum(ss1) * (1.f / 1024.f) + 1e-6f);
#pragma unroll
      for (int j = 0; j < 4; ++j) {
        h2[tt][j] = xv[j] * rs1 * A2[j] + SH2[j];
        *(h16x4*)(H2 + tok * DM + 256 * j + 4 * lane) = pack4(h2[tt][j][0], h2[tt][j][1], h2[tt][j][2], h2[tt][j][3]);
      }
    }
    float a0[36], a1[36];
#pragma unroll
    for (int col = 0; col < 36; ++col) {
      float s0 = 0.f, s1 = 0.f;
#pragma unroll
      for (int j = 0; j < 4; ++j) {
        const f32x4 w = *(LDS f32x4*)(wrt + col * 1024 + 256 * j + 4 * lane);
#pragma unroll
        for (int e = 0; e < 4; ++e) { s0 = fmaf(h2[0][j][e], w[e], s0); s1 = fmaf(h2[1][j][e], w[e], s1); }
      }
      a0[col] = s0; a1[col] = s1;
    }
    float b0[18], b1[18];
#pragma unroll
    for (int c = 0; c < 18; ++c) {
      const float snd0 = lowhalf ? a0[c + 18] : a0[c], snd1 = lowhalf ? a1[c + 18] : a1[c];
      b0[c] = (lowhalf ? a0[c] : a0[c + 18]) + __shfl_xor(snd0, 32);
      b1[c] = (lowhalf ? a1[c] : a1[c + 18]) + __shfl_xor(snd1, 32);
    }
    float c0[9], c1[9];
#pragma unroll
    for (int c = 0; c < 9; ++c) {
      const float snd0 = lowq ? b0[c + 9] : b0[c], snd1 = lowq ? b1[c + 9] : b1[c];
      c0[c] = (lowq ? b0[c] : b0[c + 9]) + __shfl_xor(snd0, 16);
      c1[c] = (lowq ? b1[c] : b1[c + 9]) + __shfl_xor(snd1, 16);
    }
#pragma unroll
    for (int c = 0; c < 9; ++c) {
#pragma unroll
      for (int o = 8; o >= 1; o >>= 1) { c0[c] += __shfl_xor(c0[c], o); c1[c] += __shfl_xor(c1[c], o); }
    }
    if ((lane & 15) == 0) {
      const int cb = 18 * (lane >> 5) + 9 * ((lane >> 4) & 1);
#pragma unroll
      for (int c = 0; c < 9; ++c) { lgw[cb + c] = c0[c]; lgw[36 + cb + c] = c1[c]; }
    }
    if (lane < 2) {
      const int tt = lane;
      LDS float* lg = lgw + 36 * tt;
      float gl[4];
#pragma unroll
      for (int g = 0; g < 4; ++g) gl[g] = lg[g] + rbias[g];
      int gi = 0; float gm = gl[0];
#pragma unroll
      for (int g = 1; g < 4; ++g) if (gl[g] > gm) { gm = gl[g]; gi = g; }
      float gs = 0.f;
#pragma unroll
      for (int g = 0; g < 4; ++g) gs += __expf(gl[g] - gm);
      const float pg = 1.f / gs;
      int e1 = 0, e2 = 0; float l1 = -INFINITY, l2 = -INFINITY;
#pragma unroll
      for (int e = 0; e < 8; ++e) {
        const float v = lg[4 + 8 * gi + e] + rbias[4 + 8 * gi + e];
        if (v > l1) { l2 = l1; e2 = e1; l1 = v; e1 = e; }
        else if (v > l2) { l2 = v; e2 = e; }
      }
      const float x2 = __expf(l2 - l1);
      const float w1 = pg / (1.f + x2), w2 = pg * x2 / (1.f + x2);
      const unsigned E1 = (unsigned)(gi * 8 + e1), E2 = (unsigned)(gi * 8 + e2);
      const unsigned lp1 = __hip_atomic_fetch_add(&lcnt[E1], 1u, __ATOMIC_RELAXED, __HIP_MEMORY_SCOPE_WORKGROUP);
      const unsigned lp2 = __hip_atomic_fetch_add(&lcnt[E2], 1u, __ATOMIC_RELAXED, __HIP_MEMORY_SCOPE_WORKGROUP);
      LDS unsigned* tr = tokrec + ((it * 8 + wave) * 2 + tt) * 6;
      tr[0] = E1; tr[1] = lp1; tr[2] = E2; tr[3] = lp2; tr[4] = __float_as_uint(w1); tr[5] = __float_as_uint(w2);
    }
  }
  __syncthreads();
  if (tid < 32) lbase[tid] = atomicAdd((unsigned*)(p.ws + WS_CNT) + tid, lcnt[tid]);
  __syncthreads();
  {
    unsigned* LIST = (unsigned*)(p.ws + WS_LIST); float* LISTW = (float*)(p.ws + WS_LISTW); u32x4* ROUTE = (u32x4*)(p.ws + WS_ROUTE);
    const int npair = (SEQ / 2 - bi * 8 + nbk * 8 - 1) / (nbk * 8);
    for (int s = tid; s < npair * 16; s += NTHR) {
      const int tt = s & 1, w = (s >> 1) & 7, i2 = s >> 4;
      const int pr = bi * 8 + w + nbk * 8 * i2;
      if (pr < SEQ / 2) {
        const unsigned tok = (unsigned)(b * SEQ + 2 * pr + tt);
        LDS unsigned* tr = tokrec + s * 6;
        const unsigned E1 = tr[0], E2 = tr[2], p1 = lbase[E1] + tr[1], p2 = lbase[E2] + tr[3];
        LIST[(size_t)E1 * 32768 + p1] = tok; LISTW[(size_t)E1 * 32768 + p1] = __uint_as_float(tr[4]);
        LIST[(size_t)E2 * 32768 + p2] = tok; LISTW[(size_t)E2 * 32768 + p2] = __uint_as_float(tr[5]);
        u32x4 rt; rt[0] = E1; rt[1] = p1; rt[2] = E2; rt[3] = p2;
        ROUTE[tok] = rt;
      }
    }
  }
}

template <bool GATHER_> struct MoeOrder {
  static constexpr bool GATHER = GATHER_;
  unsigned char* ws; int ntn, K, G, c;
  DEVI bool next(int i, g8::Unit& u) const {
    const unsigned* cnt = (const unsigned*)(ws + WS_CNT);
    int it = i * G + c, off = 0, e = 0, cn = 0; bool found = false;
    for (e = 0; e < 32; ++e) { cn = (int)cnt[e]; const int nti = ((cn + 255) >> 8) * ntn; if (it < nti) { found = true; break; } it -= nti; off += cn; }
    if (!found) return false;
    u.e = e; u.pm = it / ntn; u.pn = it % ntn; u.cnt = cn; u.off = off;
    const int tid = threadIdx.x;
    if (GATHER_) {
      const unsigned* list = (const unsigned*)(ws + WS_LIST) + (size_t)e * 32768;
      u.A = (const char*)(ws + WS_H);
      u.B = (const char*)((const h16*)(ws + WS_WGU) + ((size_t)e * 512 + u.pn * 256) * DM);
#pragma unroll
      for (int h = 0; h < 2; ++h)
#pragma unroll
        for (int i2 = 0; i2 < 2; ++i2) {
          int R, C; g8::stage_rc(tid * 16 + i2 * 8192, R, C);
          const int row = u.pm * 256 + 128 * h + R;
          const unsigned t = (row < cn) ? list[row] : 0u;
          u.va[h][i2] = (t * (unsigned)DM + (unsigned)C) * 2u;
        }
    } else {
      u.A = (const char*)((const h16*)(ws + WS_ACT) + ((size_t)off + u.pm * 256) * 256);
      u.B = (const char*)((const h16*)(ws + WS_WDN) + ((size_t)e * 1024 + u.pn * 256) * 256);
      u.va[0][0] = u.va[0][1] = u.va[1][0] = u.va[1][1] = 0u;
    }
    return true;
  }
};
struct EpiAct {
  unsigned char* ws;
  DEVI void operator()(const f32x4 (&acc)[2][2][4][2], const g8::Unit& u, int wr, int wc, int fr, int fq) const {
    const float* lw = (const float*)(ws + WS_LISTW) + (size_t)u.e * 32768; h16* act = (h16*)(ws + WS_ACT);
#pragma unroll
    for (int ai = 0; ai < 2; ++ai)
#pragma unroll
      for (int m = 0; m < 4; ++m) {
        const int r = u.pm * 256 + 128 * ai + 64 * wr + 16 * m + fr;
        if (r < u.cnt) {
          const float w = lw[r];
#pragma unroll
          for (int bj = 0; bj < 2; ++bj) {
            const f32x4 g = acc[ai][bj][m][0], up = acc[ai][bj][m][1];
            float v[4];
#pragma unroll
            for (int e = 0; e < 4; ++e) v[e] = g[e] * __builtin_amdgcn_rcpf(1.f + __expf(-g[e])) * up[e] * w;
            *(h16x4*)(act + (size_t)(u.off + r) * 256 + 16 * (8 * u.pn + 4 * bj + wc) + 4 * fq) = pack4(v[0], v[1], v[2], v[3]);
          }
        }
      }
  }
};
struct EpiYp {
  h16* dst;
  DEVI void operator()(const f32x4 (&acc)[2][2][4][2], const g8::Unit& u, int wr, int wc, int fr, int fq) const {
#pragma unroll
    for (int ai = 0; ai < 2; ++ai)
#pragma unroll
      for (int m = 0; m < 4; ++m) {
        const int r = u.pm * 256 + 128 * ai + 64 * wr + 16 * m + fr;
        if (r < u.cnt) {
          h16* d = dst + (size_t)(u.off + r) * DM + u.pn * 256 + 32 * wc + 4 * fq;
#pragma unroll
          for (int bj = 0; bj < 2; ++bj)
#pragma unroll
            for (int n = 0; n < 2; ++n) { const f32x4 v = acc[ai][bj][m][n]; *(h16x4*)(d + 128 * bj + 16 * n) = pack4(v[0], v[1], v[2], v[3]); }
        }
      }
  }
};
DEVI void phase7(PRef p, LDS unsigned char* lds) {
  MoeOrder<true> S{p.ws, 2, DM, (int)gridDim.x, (int)blockIdx.x};
  EpiAct E{p.ws};
  g8::gemm_phase(lds, DM, S, E);
}
DEVI void phase8(PRef p, LDS unsigned char* lds) {
  MoeOrder<false> S{p.ws, 4, 256, (int)gridDim.x, (int)blockIdx.x};
  EpiYp E{(h16*)(p.ws + WS_YP)};
  g8::gemm_phase(lds, 256, S, E);
}

DEVI void phase9(PRef p, LDS unsigned char* lds) {
  const int tid = launder((int)threadIdx.x), lane = tid & 63, wave = wave_id(tid), G = gridDim.x;
  const int b = blockIdx.x & 3, bi = blockIdx.x >> 2, nbk = G >> 2;
  LDS unsigned* offs = (LDS unsigned*)lds;
  if (tid == 0) { const unsigned* cnt = (const unsigned*)(p.ws + WS_CNT); unsigned o = 0; for (int e = 0; e < 32; ++e) { offs[e] = o; o += cnt[e]; } }
  __syncthreads();
  LDS float* mv = (LDS float*)(lds + 256);
  mod_to_lds(p, b, 5, mv);
  __syncthreads();
  f32x4 A3[4];
#pragma unroll
  for (int j = 0; j < 4; ++j) { const int k = 256 * j + 4 * lane; A3[j] = *(LDS f32x4*)(mv + k) * *(const f32x4*)(p.in[7] + k); }
  const h16* YP = (const h16*)(p.ws + WS_YP); const u32x4* ROUTE = (const u32x4*)(p.ws + WS_ROUTE); float* out = p.out;
  const int rstep = nbk * 8, r_first = bi * 8 + wave;
  const int nrow = (SEQ - r_first + rstep - 1) / rstep;
  unsigned R0 = 0u, R1 = 0u;
  if (lane < nrow) { const u32x4 rt = ROUTE[(size_t)b * SEQ + r_first + rstep * lane]; R0 = offs[rt[0]] + rt[1]; R1 = offs[rt[2]] + rt[3]; }
  h16x4 ya[4], yc[4]; f32x4 xv[4];
  {
    const size_t tok = (size_t)b * SEQ + r_first; const size_t r0 = __builtin_amdgcn_readlane(R0, 0), r1 = __builtin_amdgcn_readlane(R1, 0);
#pragma unroll
    for (int j = 0; j < 4; ++j) { ya[j] = *(const h16x4*)(YP + r0 * DM + 256 * j + 4 * lane); yc[j] = *(const h16x4*)(YP + r1 * DM + 256 * j + 4 * lane); xv[j] = *(const f32x4*)(out + tok * DM + 256 * j + 4 * lane); }
  }
  for (int i = 0; i < nrow; ++i) {
    const size_t tok = (size_t)b * SEQ + r_first + rstep * i;
    h16x4 na[4], nc[4]; f32x4 nx[4];
    if (i + 1 < nrow) {
      const size_t r0 = __builtin_amdgcn_readlane(R0, i + 1), r1 = __builtin_amdgcn_readlane(R1, i + 1);
#pragma unroll
      for (int j = 0; j < 4; ++j) { na[j] = *(const h16x4*)(YP + r0 * DM + 256 * j + 4 * lane); nc[j] = *(const h16x4*)(YP + r1 * DM + 256 * j + 4 * lane); nx[j] = *(const f32x4*)(out + (tok + rstep) * DM + 256 * j + 4 * lane); }
    }
    f32x4 y[4]; float ss = 0.f;
#pragma unroll
    for (int j = 0; j < 4; ++j)
#pragma unroll
      for (int e = 0; e < 4; ++e) { y[j][e] = (float)ya[j][e] + (float)yc[j][e]; ss += y[j][e] * y[j][e]; }
    const float rs = 1.0f / sqrtf(wave_sum(ss) * (1.f / 1024.f) + 1e-6f);
#pragma unroll
    for (int j = 0; j < 4; ++j) *(f32x4*)(out + tok * DM + 256 * j + 4 * lane) = xv[j] + A3[j] * (y[j] * rs);
    if (i + 1 < nrow) {
#pragma unroll
      for (int j = 0; j < 4; ++j) { ya[j] = na[j]; yc[j] = nc[j]; xv[j] = nx[j]; }
    }
  }
}

#define XB_TMO      128
#define XB_XCNT(j)  (256  + 64 * (j))
#define XB_XSUB(j)  (1280 + 64 * (j))
#define XB_XGEN(j)  (2304 + 64 * (j))
#define XB_TOP      3328
#define XB_TOPGEN   3392
#define XB_SPIN_CAP (1u << 22)
DEVI unsigned xb_ld(unsigned* p)              { return __hip_atomic_load(p, __ATOMIC_RELAXED, __HIP_MEMORY_SCOPE_AGENT); }
DEVI unsigned xb_add(unsigned* p, unsigned v) { return __hip_atomic_fetch_add(p, v, __ATOMIC_RELAXED, __HIP_MEMORY_SCOPE_AGENT); }
DEVI unsigned xb_xcc_id() { return (unsigned)__builtin_amdgcn_s_getreg((3 << 11) | 20) & 0xFu; }
#define XB_SPIN(cond, bar) do { unsigned _sp = 0; while (cond) { __builtin_amdgcn_s_sleep(1); \
    if ((++_sp & 255u) == 0u) { if (xb_ld(&(bar)[XB_TMO])) break; if (_sp > XB_SPIN_CAP) { atomicAdd(&(bar)[XB_TMO], 1u); break; } } } } while (0)
struct XcdBarrier { unsigned* bar; unsigned x; volatile LDS unsigned* st; };
DEVI XcdBarrier xcd_barrier_post(unsigned* bar, volatile LDS unsigned* st) {
  XcdBarrier b; b.bar = bar; b.x = xb_xcc_id(); b.st = st;
  if (threadIdx.x == 0) (void)xb_add(&bar[XB_XCNT(b.x)], 1u);
  return b;
}
DEVI void xcd_barrier_complete(unsigned* bar, unsigned x, unsigned& nloc, unsigned& nx) {
  const unsigned G = gridDim.x * gridDim.y * gridDim.z;
  unsigned sum, cnt, mine, sp = 0u;
  for (;;) {
    sum = 0u; cnt = 0u; mine = 0u;
#pragma unroll
    for (unsigned j = 0; j < 16; ++j) { const unsigned c = xb_ld(&bar[XB_XCNT(j)]); sum += c; cnt += (c > 0u) ? 1u : 0u; mine = (j == x) ? c : mine; }
    if (sum == G) break;
    __builtin_amdgcn_s_sleep(1);
    if ((++sp & 255u) == 0u) { if (xb_ld(&bar[XB_TMO])) break; if (sp > XB_SPIN_CAP) { atomicAdd(&bar[XB_TMO], 1u); break; } }
  }
  nloc = mine > 0u ? mine : 1u; nx = cnt > 0u ? cnt : 1u;
}
DEVI void xcd_barrier(const XcdBarrier& b) {
  asm volatile("s_waitcnt vmcnt(0)" ::: "memory");
  __syncthreads();
  if (threadIdx.x == 0) {
    unsigned* bar = b.bar;
    __builtin_amdgcn_s_waitcnt(0);
    unsigned nloc = b.st[0], nx = b.st[1];
    if (nloc == 0u) { xcd_barrier_complete(bar, b.x, nloc, nx); b.st[0] = nloc; b.st[1] = nx; }
    const unsigned old = xb_add(&bar[XB_XSUB(b.x)], 1u);
    const unsigned gen = old / nloc;
    if (old + 1u == (gen + 1u) * nloc) {
      __builtin_amdgcn_fence(__ATOMIC_RELEASE, "agent");
      asm volatile("s_waitcnt vmcnt(0)" ::: "memory");
      const unsigned og = xb_add(&bar[XB_TOP], 1u);
      const unsigned tg = og / nx;
      if (og + 1u == (tg + 1u) * nx) xb_add(&bar[XB_TOPGEN], 1u);
      else XB_SPIN(xb_ld(&bar[XB_TOPGEN]) == tg, bar);
      __builtin_amdgcn_fence(__ATOMIC_ACQUIRE, "agent");
      xb_add(&bar[XB_XGEN(b.x)], 1u);
      asm volatile("s_waitcnt vmcnt(0)" ::: "memory");
    } else {
      XB_SPIN(xb_ld(&bar[XB_XGEN(b.x)]) == gen, bar);
      __builtin_amdgcn_fence(__ATOMIC_ACQUIRE, "agent");
      asm volatile("s_waitcnt vmcnt(0)" ::: "memory");
    }
  }
  __syncthreads();
}

__global__ void __launch_bounds__(NTHR) fwd_kernel(Params p) {
  extern __shared__ __attribute__((aligned(16))) unsigned char smem[];
  LDS unsigned char* lds = (LDS unsigned char*)smem;
  const int lo = p.ph_lo, hi = p.ph_hi;
  volatile LDS unsigned* bst = (volatile LDS unsigned*)(lds + LDS_BYTES - 16);
  if (threadIdx.x < 4) bst[threadIdx.x] = 0u;
  __syncthreads();
  (void)xcd_barrier_post((unsigned*)(p.ws + WS_BAR), bst);
#ifndef REPEAT_PHASE
#define REPEAT_PHASE -1
#endif
#define GRID_SYNC(k) do { if ((k) == 0) cg::this_grid().sync(); else { XcdBarrier xb_; xb_.bar = (unsigned*)(get_params()->ws + WS_BAR); xb_.x = xb_xcc_id(); xb_.st = (volatile LDS unsigned*)(lds + LDS_BYTES - 16); xcd_barrier(xb_); } } while (0)
#define RUN_PHASE(k, fn) if (lo <= (k) && (k) < hi) { fn(*get_params(), lds); if ((k) == REPEAT_PHASE) { GRID_SYNC(k); fn(*get_params(), lds); } if ((k) + 1 < hi) GRID_SYNC(k); }
  RUN_PHASE(0, phase0)
  RUN_PHASE(1, phase1)
  RUN_PHASE(2, phase2)
  RUN_PHASE(3, phase3)
  RUN_PHASE(4, phase4)
  RUN_PHASE(5, phase5)
  RUN_PHASE(6, phase6)
  RUN_PHASE(7, phase7)
  RUN_PHASE(8, phase8)
  RUN_PHASE(9, phase9)
#undef GRID_SYNC
#undef RUN_PHASE
}

extern "C" void kernel_launch(void* const* d_in, const int* in_sizes, int n_in, void* d_out, int out_size, void* d_ws, size_t ws_size, hipStream_t stream) {
  static int grid = 0;
  if (grid == 0) {
    if (n_in != 24 || out_size != NTOK * DM || ws_size < WS_END) { fprintf(stderr, "kernel_launch: unexpected problem (n_in %d out %d ws %zu)\n", n_in, out_size, ws_size); grid = -1; return; }
    (void)hipFuncSetAttribute((const void*)fwd_kernel, hipFuncAttributeMaxDynamicSharedMemorySize, LDS_BYTES);
    int dev = 0, cus = 0, per_cu = 0;
    (void)hipGetDevice(&dev);
    (void)hipDeviceGetAttribute(&cus, hipDeviceAttributeMultiprocessorCount, dev);
    (void)hipOccupancyMaxActiveBlocksPerMultiprocessor(&per_cu, (const void*)fwd_kernel, NTHR, LDS_BYTES);
    if (per_cu < 1 || cus < 256) fprintf(stderr, "kernel_launch: occupancy %d blocks/CU on %d CUs\n", per_cu, cus);
    grid = 256;
  }
  if (grid < 0) return;
  (void)hipMemsetAsync((char*)d_ws + WS_CNT, 0, CTL_ZERO_BYTES, stream);
  Params p{};
  for (int i = 0; i < 24; ++i) p.in[i] = (const float*)d_in[i];
  p.out = (float*)d_out; p.ws = (unsigned char*)d_ws;
#if N_LAUNCH_MODE == 1
  p.ph_lo = 0; p.ph_hi = NPHASE;
  void* args[] = {&p};
  hipError_t e = hipLaunchCooperativeKernel((const void*)fwd_kernel, dim3(grid), dim3(NTHR), args, LDS_BYTES, stream);
  if (e != hipSuccess) fprintf(stderr, "cooperative launch failed: %s\n", hipGetErrorString(e));
#else
  for (int ph = 0; ph < NPHASE; ++ph) {
    p.ph_lo = ph; p.ph_hi = ph + 1;
    hipLaunchKernelGGL(fwd_kernel, dim3(grid), dim3(NTHR), LDS_BYTES, stream, p);
  }
#endif
}
```

```cpp
#include <hip/hip_runtime.h>
#include <hip/hip_cooperative_groups.h>
#include <cstdio>
#include <cstdint>
namespace cg = cooperative_groups;

#ifndef N_LAUNCH_MODE
#define N_LAUNCH_MODE 1
#endif

#define DEVI __device__ __forceinline__
#define LDS __attribute__((address_space(3)))

typedef _Float16 h16;
typedef _Float16 h16x4 __attribute__((ext_vector_type(4)));
typedef _Float16 h16x8 __attribute__((ext_vector_type(8)));
typedef float f32x4 __attribute__((ext_vector_type(4)));
typedef float f32x16 __attribute__((ext_vector_type(16)));
typedef unsigned u32x2 __attribute__((ext_vector_type(2)));
typedef unsigned u32x4 __attribute__((ext_vector_type(4)));

constexpr int NBATCH = 4, SEQ = 8192, NTOK = NBATCH * SEQ, DM = 1024;
constexpr int NTHR = 512;
constexpr int NPHASE = 10;
constexpr int LDS_BYTES = 163840;

constexpr size_t MiB = 1ull << 20;
constexpr size_t WS_CNT = 0;
constexpr size_t CTL_ZERO_BYTES = 20480;
constexpr size_t WS_BAR = 4096;
constexpr size_t WS_MODP = 64 * 1024;
constexpr size_t WS_ROPE = 1 * MiB;
constexpr size_t WS_WIN = 3 * MiB;
constexpr size_t WS_WOUT = 10 * MiB;
constexpr size_t WS_WGU = 12 * MiB;
constexpr size_t WS_WDN = 44 * MiB;
constexpr size_t WS_WRG = 60 * MiB;
constexpr size_t WS_WRT = 60 * MiB + 256 * 1024;
constexpr size_t WS_AGG = 61 * MiB;
constexpr size_t WS_ROUTE = 63 * MiB;
constexpr size_t WS_LIST = 64 * MiB;
constexpr size_t WS_LISTW = 68 * MiB;
constexpr size_t WS_WI = 72 * MiB;
constexpr size_t WS_KI = 73 * MiB;
constexpr size_t WS_MASK = 77 * MiB;
constexpr size_t WS_H = 109 * MiB;
constexpr size_t WS_Q = 173 * MiB;
constexpr size_t WS_K = 205 * MiB;
constexpr size_t WS_VT = 237 * MiB;
constexpr size_t WS_QI = 269 * MiB;
constexpr size_t WS_XR = 301 * MiB;
constexpr size_t WS_XG = 333 * MiB;
constexpr size_t WS_MIX = 365 * MiB;
constexpr size_t WS_ACT = 429 * MiB;
constexpr size_t WS_YP = 173 * MiB;
constexpr size_t WS_END = 462 * MiB;

struct Params { const float* in[24]; float* out; unsigned char* ws; int ph_lo, ph_hi; };
typedef const __attribute__((address_space(4))) Params& PRef;
typedef const __attribute__((address_space(4))) Params* PPtr;

__device__ const double ROPE_REV[32] = {
  1.59154943091895345608e-01, 1.19349370211248861917e-01, 8.94994016088910132600e-02, 6.71150830052272551196e-02,
  5.03292121044870352509e-02, 3.77415847174197710556e-02, 2.83021958306233986646e-02, 2.12236527647776604399e-02,
  1.59154943091895338669e-02, 1.19349370211248861917e-02, 8.94994016088910236684e-03, 6.71150830052272533849e-03,
  5.03292121044870369856e-03, 3.77415847174197719230e-03, 2.83021958306233986646e-03, 2.12236527647776621747e-03,
  1.59154943091895356017e-03, 1.19349370211248848907e-03, 8.94994016088910236684e-04, 6.71150830052272598901e-04,
  5.03292121044870326488e-04, 3.77415847174197740914e-04, 2.83021958306233954120e-04, 2.12236527647776605484e-04,
  1.59154943091895350596e-04, 1.19349370211248862459e-04, 8.94994016088910182474e-05, 6.71150830052272544691e-05,
  5.03292121044870353593e-05, 3.77415847174197768019e-05, 2.83021958306233960897e-05, 2.12236527647776591931e-05};

DEVI int launder(int x) { asm volatile("" : "+v"(x)); return x; }
DEVI PPtr get_params() { PPtr k = (PPtr)__builtin_amdgcn_kernarg_segment_ptr(); asm volatile("" : "+s"(k)); return k; }
DEVI int wave_id(int tid) { return __builtin_amdgcn_readfirstlane(tid >> 6); }
DEVI f32x16 mfma16(h16x8 a, h16x8 b, f32x16 c) { return __builtin_amdgcn_mfma_f32_32x32x16_f16(a, b, c, 0, 0, 0); }
DEVI float wave_sum(float v) {
#pragma unroll
  for (int o = 1; o < 64; o <<= 1) v += __shfl_xor(v, o);
  return v;
}
DEVI float sigmoid_f(float x) { return __builtin_amdgcn_rcpf(1.f + __expf(-x)); }
DEVI float silu_f(float x) { return x * __builtin_amdgcn_rcpf(1.f + __expf(-x)); }
DEVI float gelu_tanh_f(float x) {
  const float u = 0.7978845608028654f * (x + 0.044715f * x * x * x);
  const float t = 1.f - 2.f * __builtin_amdgcn_rcpf(1.f + __expf(2.f * u));
  return 0.5f * x * (1.f + t);
}
DEVI unsigned fkey(float f) { unsigned u = __float_as_uint(f); return (u & 0x80000000u) ? ~u : (u | 0x80000000u); }
DEVI float fkey_inv(unsigned k) { unsigned u = (k & 0x80000000u) ? (k & 0x7fffffffu) : ~k; return __uint_as_float(u); }
DEVI int vt_perm(int pos) { return (pos & ~12) | ((pos & 4) << 1) | ((pos & 8) >> 1); }

DEVI void mod_to_lds(PRef p, int b, int chunk, LDS float* dst) {
  const float* mp = (const float*)(p.ws + WS_MODP);
  for (int k = threadIdx.x; k < 1024; k += NTHR) {
    const int j = chunk * 1024 + k;
    float s = p.in[3][j];
#pragma unroll 1
    for (int ks = 0; ks < 8; ++ks) s += mp[(size_t)(ks * 4 + b) * 6144 + j];
    dst[k] = s;
  }
}

constexpr int LROW = 144;
constexpr int GA_BYTES = 256 * LROW, GB_BYTES = 128 * LROW, GSTAGE = GA_BYTES + GB_BYTES;

template <class AR, class EPI>
DEVI void gemm_tile(LDS unsigned char* lds, const AR& arow, const h16* Bt, int ldb, int K, EPI& epi) {
  const int tid = launder((int)threadIdx.x), lane = tid & 63, wave = wave_id(tid), wm = wave >> 1, wn = wave & 1;
  const int lr = tid >> 3, lc = tid & 7, l31 = lane & 31, half = lane >> 5;
  const h16* pa[4]; const h16* pb[2];
#pragma unroll
  for (int j = 0; j < 4; ++j) pa[j] = arow(lr + 64 * j) + lc * 8;
#pragma unroll
  for (int j = 0; j < 2; ++j) pb[j] = Bt + (size_t)(lr + 64 * j) * ldb + lc * 8;
  h16x8 ra[4], rb[2];
#pragma unroll
  for (int j = 0; j < 4; ++j) ra[j] = *(const h16x8*)pa[j];
#pragma unroll
  for (int j = 0; j < 2; ++j) rb[j] = *(const h16x8*)pb[j];
#pragma unroll
  for (int j = 0; j < 4; ++j) *(LDS h16x8*)(lds + (lr + 64 * j) * LROW + lc * 16) = ra[j];
#pragma unroll
  for (int j = 0; j < 2; ++j) *(LDS h16x8*)(lds + GA_BYTES + (lr + 64 * j) * LROW + lc * 16) = rb[j];
  __syncthreads();
  f32x16 acc[2][2];
#pragma unroll
  for (int a = 0; a < 2; ++a)
#pragma unroll
    for (int b = 0; b < 2; ++b)
#pragma unroll
      for (int r = 0; r < 16; ++r) acc[a][b][r] = 0.f;
  const int KT = K >> 6;
  for (int kt = 0; kt < KT; ++kt) {
    const int cur = kt & 1;
    if (kt + 1 < KT) {
#pragma unroll
      for (int j = 0; j < 4; ++j) ra[j] = *(const h16x8*)(pa[j] + (kt + 1) * 64);
#pragma unroll
      for (int j = 0; j < 2; ++j) rb[j] = *(const h16x8*)(pb[j] + (kt + 1) * 64);
    }
    LDS unsigned char* A = lds + cur * GSTAGE;
    LDS unsigned char* B = A + GA_BYTES;
#pragma unroll
    for (int kk = 0; kk < 4; ++kk) {
      h16x8 af[2], bf[2];
#pragma unroll
      for (int mi = 0; mi < 2; ++mi) af[mi] = *(LDS h16x8*)(A + (64 * wm + 32 * mi + l31) * LROW + (2 * kk + half) * 16);
#pragma unroll
      for (int ni = 0; ni < 2; ++ni) bf[ni] = *(LDS h16x8*)(B + (64 * wn + 32 * ni + l31) * LROW + (2 * kk + half) * 16);
#pragma unroll
      for (int mi = 0; mi < 2; ++mi)
#pragma unroll
        for (int ni = 0; ni < 2; ++ni) acc[mi][ni] = mfma16(bf[ni], af[mi], acc[mi][ni]);
    }
    if (kt + 1 < KT) {
      LDS unsigned char* A2 = lds + (cur ^ 1) * GSTAGE;
#pragma unroll
      for (int j = 0; j < 4; ++j) *(LDS h16x8*)(A2 + (lr + 64 * j) * LROW + lc * 16) = ra[j];
#pragma unroll
      for (int j = 0; j < 2; ++j) *(LDS h16x8*)(A2 + GA_BYTES + (lr + 64 * j) * LROW + lc * 16) = rb[j];
    }
    __syncthreads();
  }
  epi(acc, wm, wn, lane);
}


namespace g8 {
constexpr int BM = 256, BK = 64, HALF = 128, HTB = HALF * BK * 2, STAGE_BYTES = 8 * HTB;
DEVI int lds_byte(int r, int c) { const int st = (r >> 4) * 2 + (c >> 5), rr = r & 15, cc = c & 31, ob = rr * 64 + cc * 2; return st * 1024 + (ob ^ (((ob >> 9) & 1) << 5)); }
DEVI void stage_rc(int b, int& R, int& C) { const int st = b / 1024, sb = b % 1024, swz = sb ^ (((sb >> 9) & 1) << 5); R = (st >> 1) * 16 + swz / 64; C = (st & 1) * 32 + (swz % 64) / 2; }
struct Unit { const char* A; unsigned va[2][2]; const char* B; int pm, pn, e, cnt, off; };
DEVI void glds16(const char* src, LDS unsigned char* dst) { __builtin_amdgcn_global_load_lds((const unsigned*)src, (LDS unsigned*)dst, 16, 0, 0); }

DEVI void dense_va(unsigned (&va)[2][2], int K) {
  const int tid = threadIdx.x;
#pragma unroll
  for (int h = 0; h < 2; ++h)
#pragma unroll
    for (int i = 0; i < 2; ++i) { int R, C; stage_rc(tid * 16 + i * 8192, R, C); va[h][i] = (unsigned)((128 * h + R) * K + C) * 2u; }
}
template <class Sched, class Epi>
DEVI void gemm_phase(LDS unsigned char* lds, int K, const Sched& S, const Epi& E) {
  const int tid = launder((int)threadIdx.x), wid = wave_id(tid), lane = tid & 63, wr = wid >> 2, wc = wid & 3, fr = lane & 15, fq = lane >> 4;
  const int nt = launder(K) / BK;
  unsigned vb[2];
#pragma unroll
  for (int i = 0; i < 2; ++i) { int R, C; stage_rc(tid * 16 + i * 8192, R, C); vb[i] = (unsigned)(R * K + C) * 2u; }
  const size_t kstep = (size_t)(BK * 2), hstep = (size_t)HALF * K * 2;
  const unsigned ldsw = (unsigned)wid * 1024u;
  const int aoff = lds_byte(wr * 64 + fr, fq * 8), boff = lds_byte(wc * 32 + fr, fq * 8);
#define G8_SA(b, h) (((b) * 2 + (h)) * HTB)
#define G8_SB(b, h) ((4 + (b) * 2 + (h)) * HTB)
#define G8_STAGE(bufoff, gbase, v) do { glds16((gbase) + (v)[0], lds + (bufoff) + ldsw); glds16((gbase) + (v)[1], lds + (bufoff) + ldsw + 8192); } while (0)
#define G8_STAGEA(bufoff, gbase, h) do { glds16((gbase) + G8_VAC(h, 0), lds + (bufoff) + ldsw); glds16((gbase) + G8_VAC(h, 1), lds + (bufoff) + ldsw + 8192); } while (0)
#define G8_LDA(dst, b, h) do { _Pragma("unroll") for (int m = 0; m < 4; ++m) _Pragma("unroll") for (int k = 0; k < 2; ++k) dst[m][k] = *(const LDS h16x8*)(lds + G8_SA(b, h) + aoff + m * 2048 + k * 1024); } while (0)
#define G8_LDB(dst, b, h) do { _Pragma("unroll") for (int n = 0; n < 2; ++n) _Pragma("unroll") for (int k = 0; k < 2; ++k) dst[n][k] = *(const LDS h16x8*)(lds + G8_SB(b, h) + boff + n * 2048 + k * 1024); } while (0)
#define G8_MMA(ai, bj, At, Bt) do { __builtin_amdgcn_s_setprio(1); _Pragma("unroll") for (int m = 0; m < 4; ++m) _Pragma("unroll") for (int n = 0; n < 2; ++n) _Pragma("unroll") for (int k = 0; k < 2; ++k) \
        acc[ai][bj][m][n] = __builtin_amdgcn_mfma_f32_16x16x32_f16(Bt[n][k], At[m][k], acc[ai][bj][m][n], 0, 0, 0); __builtin_amdgcn_s_setprio(0); } while (0)
#define G8_WAIT_V(n) asm volatile("s_waitcnt vmcnt(" #n ")" ::: "memory")
#define G8_WAIT_L(n) asm volatile("s_waitcnt lgkmcnt(" #n ")" ::: "memory")
#define G8_BAR __builtin_amdgcn_s_barrier()
#define G8_SCHED __builtin_amdgcn_sched_barrier(0)
  Unit cur, nxt; int ui = 0;
  if (!S.next(0, cur)) return;
  unsigned vd[2][2];
  if (!Sched::GATHER) dense_va(vd, K);
#define G8_VAC(h, i) (Sched::GATHER ? cur.va[h][i] : vd[h][i])
#define G8_VAN(h, i) (Sched::GATHER ? nxt.va[h][i] : vd[h][i])
  f32x4 acc[2][2][4][2];
#pragma unroll
  for (int a = 0; a < 2; ++a)
#pragma unroll
    for (int b = 0; b < 2; ++b)
#pragma unroll
      for (int m = 0; m < 4; ++m)
#pragma unroll
        for (int n = 0; n < 2; ++n) acc[a][b][m][n] = (f32x4){0.f, 0.f, 0.f, 0.f};
  h16x8 At[4][2], B0[2][2], B1[2][2];
  const char* cA = cur.A; const char* cB = cur.B;
  G8_STAGE(G8_SB(0, 0), cB, vb); G8_STAGE(G8_SB(0, 1), cB + hstep, vb); G8_STAGEA(G8_SA(0, 0), cA, 0); G8_STAGEA(G8_SA(0, 1), cA, 1);
  if (wr == 1) G8_BAR;
  G8_WAIT_V(2); G8_BAR;
  G8_STAGE(G8_SB(1, 0), cB + kstep, vb); G8_STAGEA(G8_SA(1, 0), cA + kstep, 0); G8_STAGE(G8_SB(1, 1), cB + hstep + kstep, vb);
  G8_WAIT_V(6); G8_BAR;
  for (;;) {
    const bool has_next = S.next(ui + 1, nxt);
    if (!has_next) nxt = cur;
    const char* nA = nxt.A; const char* nB = nxt.B;
#pragma unroll 1
    for (int t = 0; t < nt; t += 2) {
      const bool last = (t == nt - 2);
      const char* a1 = cA + (size_t)(t + 1) * kstep;
      const char* a2 = last ? nA : cA + (size_t)(t + 2) * kstep; const char* b2 = last ? nB : cB + (size_t)(t + 2) * kstep;
      const char* a3 = a2 + kstep; const char* b3 = b2 + kstep;
#define G8_STAGE2(bufoff, gbase, h) do { glds16((gbase) + (last ? G8_VAN(h, 0) : G8_VAC(h, 0)), lds + (bufoff) + ldsw); glds16((gbase) + (last ? G8_VAN(h, 1) : G8_VAC(h, 1)), lds + (bufoff) + ldsw + 8192); } while (0)
      G8_LDB(B0, 0, 0); G8_LDB(B1, 0, 1); G8_SCHED; G8_LDA(At, 0, 0); G8_STAGEA(G8_SA(1, 1), a1, 1);
      G8_WAIT_V(8); G8_WAIT_L(0); G8_BAR; G8_MMA(0, 0, At, B0); G8_MMA(0, 1, At, B1); G8_BAR; G8_SCHED;
      G8_LDA(At, 0, 1); G8_STAGE(G8_SB(0, 0), b2, vb); G8_STAGE(G8_SB(0, 1), b2 + hstep, vb); G8_STAGE2(G8_SA(0, 0), a2, 0);
      G8_WAIT_V(8); G8_WAIT_L(0); G8_BAR; G8_MMA(1, 0, At, B0); G8_MMA(1, 1, At, B1); G8_BAR; G8_SCHED;
      G8_LDB(B0, 1, 0); G8_LDB(B1, 1, 1); G8_SCHED; G8_LDA(At, 1, 0); G8_STAGE2(G8_SA(0, 1), a2, 1);
      G8_WAIT_V(8); G8_WAIT_L(0); G8_BAR; G8_MMA(0, 0, At, B0); G8_MMA(0, 1, At, B1); G8_BAR; G8_SCHED;
      G8_LDA(At, 1, 1); G8_STAGE(G8_SB(1, 0), b3, vb); G8_STAGE(G8_SB(1, 1), b3 + hstep, vb); G8_STAGE2(G8_SA(1, 0), a3, 0);
      G8_WAIT_V(8); G8_WAIT_L(0); G8_BAR; G8_MMA(1, 0, At, B0); G8_MMA(1, 1, At, B1); G8_BAR; G8_SCHED;
    }
#undef G8_STAGE2
    if (wr == 0) G8_BAR;
    E(acc, cur, wr, wc, fr, fq);
    if (!has_next) break;
#pragma unroll
    for (int a = 0; a < 2; ++a)
#pragma unroll
      for (int b = 0; b < 2; ++b)
#pragma unroll
        for (int m = 0; m < 4; ++m)
#pragma unroll
          for (int n = 0; n < 2; ++n) acc[a][b][m][n] = (f32x4){0.f, 0.f, 0.f, 0.f};
    cur = nxt; cA = nA; cB = nB; ++ui;
    if (wr == 1) G8_BAR;
  }
  G8_WAIT_V(0);
  G8_BAR;
#undef G8_SA
#undef G8_STAGEA
#undef G8_VAC
#undef G8_VAN
#undef G8_SB
#undef G8_STAGE
#undef G8_LDA
#undef G8_LDB
#undef G8_MMA
#undef G8_WAIT_V
#undef G8_WAIT_L
#undef G8_BAR
#undef G8_SCHED
}
struct DenseOrder {
  static constexpr bool GATHER = false;
  const h16* A; const h16* Bt; int K, nM, nN, G, c;
  DEVI bool next(int i, Unit& u) const {
    const int nwg = nM * nN; const long L = (long)i * G + c; if (L >= nwg) return false;
    int wgid = (int)L; { const int q = nwg / 8, r = nwg % 8, xcd = wgid % 8, off = wgid / 8; wgid = (xcd < r ? xcd * (q + 1) : r * (q + 1) + (xcd - r) * q) + off; }
    const int nig = 8 * nN, gid = wgid / nig, fm = gid * 8, gsz = (nM - fm) < 8 ? (nM - fm) : 8;
    u.pm = fm + ((wgid % nig) % gsz); u.pn = (wgid % nig) / gsz; u.e = 0; u.cnt = 0x7fffffff; u.off = 0;
    u.A = (const char*)(A + (size_t)u.pm * 256 * K); u.B = (const char*)(Bt + (size_t)u.pn * 256 * K);
    u.va[0][0] = u.va[0][1] = u.va[1][0] = u.va[1][1] = 0u;
    return true;
  }
};
}

struct ARowPlain { const h16* base; size_t ld; DEVI const h16* operator()(int r) const { return base + (size_t)r * ld; } };
struct ARowGather { const h16* base; const unsigned* list; int n; int row0; DEVI const h16* operator()(int r) const { const int i = row0 + r; const unsigned t = (i < n) ? list[i] : 0u; return base + (size_t)t * DM; } };

DEVI h16x4 pack4(float a, float b, float c, float d) { h16x4 v; v[0] = (h16)a; v[1] = (h16)b; v[2] = (h16)c; v[3] = (h16)d; return v; }

template <class F>
DEVI void transpose_item(const float* src, int N, int kb, int nb, h16* dst, int ldd, F drow, LDS float* scr, int lane) {
#pragma unroll 8
  for (int i = 0; i < 32; ++i) {
    const int kk = 2 * i + (lane >> 5), n = nb * 32 + (lane & 31);
    scr[kk * 33 + (lane & 31)] = (n < N) ? src[(size_t)(kb * 64 + kk) * N + n] : 0.f;
  }
  asm volatile("s_waitcnt lgkmcnt(0)" ::: "memory");
  const int c = lane & 7;
#pragma unroll
  for (int j = 0; j < 4; ++j) {
    const int nl = (lane >> 3) + 8 * j, n = nb * 32 + nl;
    h16x8 v;
#pragma unroll
    for (int e = 0; e < 8; ++e) v[e] = (h16)scr[(c * 8 + e) * 33 + nl];
    if (n < N) *(h16x8*)(dst + (size_t)drow(n) * ldd + kb * 64 + c * 8) = v;
  }
  asm volatile("s_waitcnt lgkmcnt(0)" ::: "memory");
}

DEVI void phase0(PRef p, LDS unsigned char* lds) {
  const int tid = launder((int)threadIdx.x), lane = tid & 63, wave = wave_id(tid), G = gridDim.x;
  const int gw = blockIdx.x * 8 + wave, NW = G * 8;
  {
    const float* c = p.in[1]; const float* wada = p.in[2]; float* mp = (float*)(p.ws + WS_MODP);
    for (int u = gw; u < 96 * 8; u += NW) {
      const int cgp = u % 96, ks = u / 96, j = cgp * 64 + lane;
      float a0 = 0.f, a1 = 0.f, a2 = 0.f, a3 = 0.f;
      for (int k = ks * 128; k < ks * 128 + 128; ++k) {
        const float w = wada[(size_t)k * 6144 + j];
        a0 = fmaf(silu_f(c[k]), w, a0); a1 = fmaf(silu_f(c[1024 + k]), w, a1);
        a2 = fmaf(silu_f(c[2048 + k]), w, a2); a3 = fmaf(silu_f(c[3072 + k]), w, a3);
      }
      mp[(size_t)(ks * 4 + 0) * 6144 + j] = a0; mp[(size_t)(ks * 4 + 1) * 6144 + j] = a1;
      mp[(size_t)(ks * 4 + 2) * 6144 + j] = a2; mp[(size_t)(ks * 4 + 3) * 6144 + j] = a3;
    }
  }
  {
    LDS float* scr = (LDS float*)lds + wave * (64 * 33);
    constexpr int I_IN = 16 * 99, I_OUT = 16 * 32, I_G = 32 * 128, I_U = 32 * 128, I_D = 32 * 128, I_RG = 32;
    constexpr int NIT = I_IN + I_OUT + I_G + I_U + I_D + I_RG;
    for (int it = gw; it < NIT; it += NW) {
      int r = it;
      if (r < I_IN) {
        transpose_item(p.in[8], 3144, r / 99, r % 99, (h16*)(p.ws + WS_WIN), 1024,
                       [](int n) { const int dl = n < 2112 ? n : (n < 2120 ? 3136 + (n - 2112) : (n < 2632 ? 2112 + (n - 2120) : 2624 + (n - 2632))); const int d = dl & 63; return (dl & ~63) + 32 * ((d >> 4) & 1) + 16 * (d >> 5) + (d & 15); }, scr, lane);
        continue;
      }
      r -= I_IN;
      if (r < I_OUT) { transpose_item(p.in[16], 1024, r / 32, r % 32, (h16*)(p.ws + WS_WOUT), 1024, [](int n) { return n; }, scr, lane); continue; }
      r -= I_OUT;
      if (r < I_G) { const int e = r >> 7, q = r & 127;
        transpose_item(p.in[21] + (size_t)e * 1024 * 256, 256, q >> 3, q & 7, (h16*)(p.ws + WS_WGU) + (size_t)e * 512 * 1024, 1024, [](int f) { return (f >> 4) * 32 + (f & 15); }, scr, lane); continue; }
      r -= I_G;
      if (r < I_U) { const int e = r >> 7, q = r & 127;
        transpose_item(p.in[22] + (size_t)e * 1024 * 256, 256, q >> 3, q & 7, (h16*)(p.ws + WS_WGU) + (size_t)e * 512 * 1024, 1024, [](int f) { return (f >> 4) * 32 + 16 + (f & 15); }, scr, lane); continue; }
      r -= I_U;
      if (r < I_D) { const int e = r >> 7, q = r & 127;
        transpose_item(p.in[23] + (size_t)e * 256 * 1024, 1024, q >> 5, q & 31, (h16*)(p.ws + WS_WDN) + (size_t)e * 1024 * 256, 256, [](int n) { return n; }, scr, lane); continue; }
      r -= I_D;
      if (r < 16) transpose_item(p.in[11] + (size_t)(r >> 1) * 4096, 64, 0, r & 1, (h16*)(p.ws + WS_WRG) + (size_t)(r >> 1) * 128 * 64, 64, [](int n) { return n; }, scr, lane);
      else transpose_item(p.in[13] + (size_t)((r - 16) >> 1) * 4096, 64, 0, r & 1, (h16*)(p.ws + WS_WRG) + (size_t)((r - 16) >> 1) * 128 * 64, 64, [](int n) { return 64 + n; }, scr, lane);
    }
  }
  {
    float* wrt = (float*)(p.ws + WS_WRT);
    for (int i = blockIdx.x * NTHR + tid; i < 36 * 1024; i += G * NTHR) {
      const int col = i >> 10, k = i & 1023;
      wrt[i] = (col < 4) ? p.in[17][k * 4 + col] : p.in[19][k * 32 + (col - 4)];
    }
    float* ct = (float*)(p.ws + WS_ROPE); float* st = ct + 8192 * 32;
    for (int i = blockIdx.x * NTHR + tid; i < 8192 * 32; i += G * NTHR) {
      const int pos = i >> 5, f = i & 31;
      const double rev = (double)pos * ROPE_REV[f];
      const float fr = (float)(rev - __builtin_rint(rev));
      ct[i] = __builtin_amdgcn_cosf(fr); st[i] = __builtin_amdgcn_sinf(fr);
    }
  }
}

DEVI void phase1(PRef p, LDS unsigned char* lds) {
  const int tid = launder((int)threadIdx.x), lane = tid & 63, wave = wave_id(tid), G = gridDim.x;
  const int b = blockIdx.x & 3, bi = blockIdx.x >> 2, nbk = G >> 2;
  LDS float* mv = (LDS float*)lds;
  mod_to_lds(p, b, 0, mv); mod_to_lds(p, b, 1, mv + 1024);
  __syncthreads();
  f32x4 A[4], SH[4];
#pragma unroll
  for (int j = 0; j < 4; ++j) {
    const int k = 256 * j + 4 * lane;
    const f32x4 g = *(const f32x4*)(p.in[4] + k);
    A[j] = g * (*(LDS f32x4*)(mv + 1024 + k) + 1.f);
    SH[j] = *(LDS f32x4*)(mv + k);
  }
  const float* x = p.in[0]; h16* H = (h16*)(p.ws + WS_H);
  for (int r = bi * 8 + wave; r < SEQ; r += nbk * 8) {
    const size_t tok = (size_t)b * SEQ + r;
    f32x4 v[4]; float ss = 0.f;
#pragma unroll
    for (int j = 0; j < 4; ++j) { v[j] = *(const f32x4*)(x + tok * DM + 256 * j + 4 * lane); ss += v[j][0] * v[j][0] + v[j][1] * v[j][1] + v[j][2] * v[j][2] + v[j][3] * v[j][3]; }
    const float rstd = 1.0f / sqrtf(wave_sum(ss) * (1.f / 1024.f) + 1e-6f);
#pragma unroll
    for (int j = 0; j < 4; ++j) {
      const f32x4 y = v[j] * rstd * A[j] + SH[j];
      *(h16x4*)(H + tok * DM + 256 * j + 4 * lane) = pack4(y[0], y[1], y[2], y[3]);
    }
  }
}

struct EpiInProj {
  unsigned char* ws;
  DEVI void operator()(const f32x4 (&acc)[2][2][4][2], const g8::Unit& u, int wr, int wc, int fr, int fq) const {
    const float* cosT = (const float*)(ws + WS_ROPE); const float* sinT = cosT + 8192 * 32;
    const int w2 = wc & 1, dlow = 16 * w2 + 4 * fq;
#pragma unroll
    for (int bj = 0; bj < 2; ++bj) {
      const int g = 4 * u.pn + 2 * bj + (wc >> 1);
      if (g > 49) continue;
#pragma unroll
      for (int ai = 0; ai < 2; ++ai)
#pragma unroll
        for (int m = 0; m < 4; ++m) {
          const int tok = u.pm * 256 + 128 * ai + 64 * wr + 16 * m + fr;
          const int b = tok >> 13, pos = tok & 8191;
          const f32x4 x1 = acc[ai][bj][m][0], x2 = acc[ai][bj][m][1];
          if (g < 16 || (g >= 24 && g <= 32)) {
            float scl; h16* dst;
            if (g < 8) { scl = 0.125f * 1.4426950408889634f; dst = (h16*)(ws + WS_Q) + (size_t)tok * 512 + g * 64; }
            else if (g < 16) { scl = 1.f; dst = (h16*)(ws + WS_K) + (size_t)tok * 512 + (g - 8) * 64; }
            else if (g < 32) { scl = 0.125f; dst = (h16*)(ws + WS_QI) + (size_t)tok * 512 + (g - 24) * 64; }
            else { scl = 1.f; dst = (h16*)(ws + WS_KI) + (size_t)tok * 64; }
            const f32x4 c = *(const f32x4*)(cosT + pos * 32 + dlow), s = *(const f32x4*)(sinT + pos * 32 + dlow);
            const f32x4 o1 = (x1 * c - x2 * s) * scl, o2 = (x2 * c + x1 * s) * scl;
            *(h16x4*)(dst + dlow) = pack4(o1[0], o1[1], o1[2], o1[3]);
            *(h16x4*)(dst + 32 + dlow) = pack4(o2[0], o2[1], o2[2], o2[3]);
          } else if (g < 24) {
            h16* vt = (h16*)(ws + WS_VT) + (size_t)(b * 8 + (g - 16)) * 64 * 8192 + vt_perm(pos);
#pragma unroll
            for (int e = 0; e < 4; ++e) { vt[(size_t)(dlow + e) * 8192] = (h16)x1[e]; vt[(size_t)(32 + dlow + e) * 8192] = (h16)x2[e]; }
          } else if (g < 49) {
            h16* dst = (g < 41) ? (h16*)(ws + WS_XR) + (size_t)tok * 512 + (g - 33) * 64 : (h16*)(ws + WS_XG) + (size_t)tok * 512 + (g - 41) * 64;
            *(h16x4*)(dst + dlow) = pack4(x1[0], x1[1], x1[2], x1[3]);
            *(h16x4*)(dst + 32 + dlow) = pack4(x2[0], x2[1], x2[2], x2[3]);
          } else if (w2 == 0 && fq < 2) {
            const float sc = 0.35355339059327373f;
            *(f32x4*)((float*)(ws + WS_WI) + (size_t)tok * 8 + 4 * fq) = x1 * sc;
          }
        }
    }
  }
};

DEVI void phase2(PRef p, LDS unsigned char* lds) {
  g8::DenseOrder S{(const h16*)(p.ws + WS_H), (const h16*)(p.ws + WS_WIN), DM, 128, 13, (int)gridDim.x, (int)blockIdx.x};
  EpiInProj E{p.ws};
  g8::gemm_phase(lds, DM, S, E);
}

constexpr int CROW = 1040;
constexpr int RNN_XG = 64 * CROW;
constexpr int RNN_CARRY = 2 * 64 * CROW;
template <int MODE>
DEVI void rnn_item(PRef p, LDS unsigned char* lds, int b, int cr) {
  const int tid = launder((int)threadIdx.x), lane = tid & 63, wave = wave_id(tid), l31 = lane & 31, half = lane >> 5;
  const h16* XR = (const h16*)(p.ws + WS_XR);
  {
    const int chg = tid & 63, tg = tid >> 6, pos0 = cr * 64 + 8 * tg;
    h16x8 xin[11];
#pragma unroll
    for (int i = 0; i < 11; ++i) {
      const int pos = pos0 + i - 3;
      if (pos >= 0) xin[i] = *(const h16x8*)(XR + ((size_t)b * SEQ + pos) * 512 + chg * 8);
      else {
#pragma unroll
        for (int e = 0; e < 8; ++e) xin[i][e] = (h16)0.f;
      }
    }
    float cw[4][8], cb[8];
#pragma unroll
    for (int e = 0; e < 8; ++e) {
      cb[e] = p.in[10][chg * 8 + e];
#pragma unroll
      for (int j = 0; j < 4; ++j) cw[j][e] = p.in[9][j * 512 + chg * 8 + e];
    }
#pragma unroll
    for (int tt = 0; tt < 8; ++tt) {
      h16x8 o;
#pragma unroll
      for (int e = 0; e < 8; ++e) {
        float v = cb[e];
#pragma unroll
        for (int j = 0; j < 4; ++j) v = fmaf(cw[j][e], (float)xin[tt + j][e], v);
        o[e] = (h16)v;
      }
      *(LDS h16x8*)(lds + (8 * tg + tt) * CROW + chg * 16) = o;
    }
  }
  if (MODE == 1) {
    const float2* ag = (const float2*)(p.ws + WS_AGG) + (size_t)b * 128 * 512 + tid;
    float carry = 0.f; int c2 = 0;
    for (; c2 + 8 <= cr; c2 += 8) {
      float2 v[8];
#pragma unroll
      for (int u = 0; u < 8; ++u) v[u] = ag[(size_t)(c2 + u) * 512];
#pragma unroll
      for (int u = 0; u < 8; ++u) carry = fmaf(v[u].x, carry, v[u].y);
    }
    for (; c2 < cr; ++c2) { const float2 v = ag[(size_t)c2 * 512]; carry = fmaf(v.x, carry, v.y); }
    ((LDS float*)(lds + RNN_CARRY))[tid] = carry;
  }
  if (MODE == 1) {
    const h16* XG = (const h16*)(p.ws + WS_XG) + ((size_t)b * SEQ + cr * 64) * 512;
#pragma unroll
    for (int i = 0; i < 8; ++i) { const int c = tid + NTHR * i, row = c >> 6, cc = c & 63; *(LDS h16x8*)(lds + RNN_XG + row * CROW + cc * 16) = *(const h16x8*)(XG + (size_t)row * 512 + cc * 8); }
  }
  __syncthreads();
  const int n = wave;
  const h16* WRG = (const h16*)(p.ws + WS_WRG) + (size_t)n * 128 * 64;
  float* AGG = (float*)(p.ws + WS_AGG);
#pragma unroll 1
  for (int dt = 0; dt < 2; ++dt) {
    h16x8 wa[4], wx[4];
#pragma unroll
    for (int kk = 0; kk < 4; ++kk) {
      wa[kk] = *(const h16x8*)(WRG + (size_t)(32 * dt + l31) * 64 + 16 * kk + 8 * half);
      wx[kk] = *(const h16x8*)(WRG + (size_t)(64 + 32 * dt + l31) * 64 + 16 * kk + 8 * half);
    }
    f32x16 ra[2], rx[2];
#pragma unroll
    for (int ti = 0; ti < 2; ++ti) {
#pragma unroll
      for (int r = 0; r < 16; ++r) { ra[ti][r] = 0.f; rx[ti][r] = 0.f; }
#pragma unroll
      for (int kk = 0; kk < 4; ++kk) {
        const h16x8 af = *(LDS h16x8*)(lds + (32 * ti + l31) * CROW + (n * 64 + 16 * kk + 8 * half) * 2);
        ra[ti] = mfma16(af, wa[kk], ra[ti]);
        rx[ti] = mfma16(af, wx[kk], rx[ti]);
      }
    }
    const int ch = n * 64 + 32 * dt + l31;
    const float ba = p.in[12][ch], bx = p.in[14][ch], lam = p.in[15][ch];
    const float c8 = -8.f * log1pf(__expf(-lam));
#pragma unroll
    for (int ti = 0; ti < 2; ++ti)
#pragma unroll
      for (int r = 0; r < 16; ++r) {
        const int tk = 32 * ti + (r & 3) + 8 * (r >> 2) + 4 * half;
        const float cv = (float)*(LDS h16*)(lds + tk * CROW + ch * 2);
        const float rr = sigmoid_f(ra[ti][r] + ba), ii = sigmoid_f(rx[ti][r] + bx);
        const float la = c8 * rr;
        ra[ti][r] = __expf(la);
        const float x2 = 2.f * la;
        const float om = -x2 * fmaf(x2 * 0.5f, fmaf(x2 * (1.f / 3.f), fmaf(x2 * 0.25f, fmaf(x2, 0.2f, 1.f), 1.f), 1.f), 1.f);
        rx[ti][r] = __builtin_amdgcn_sqrtf(om) * (ii * cv);
      }
    float P[8], Hs[8];
#pragma unroll
    for (int sg = 0; sg < 8; ++sg) {
      const int ti = sg >> 2, q = sg & 3;
      float pp = 1.f, hh = 0.f;
#pragma unroll
      for (int i = 0; i < 4; ++i) { const float a = ra[ti][4 * q + i], bb = rx[ti][4 * q + i]; hh = fmaf(a, hh, bb); pp *= a; }
      P[sg] = pp; Hs[sg] = hh;
    }
    float carry = 0.f, prod = 1.f;
    if (MODE == 1) carry = ((LDS float*)(lds + RNN_CARRY))[ch];
    float cin[8];
#pragma unroll
    for (int sg = 0; sg < 8; ++sg)
#pragma unroll
      for (int ow = 0; ow < 2; ++ow) {
        const float tmp = fmaf(P[sg], carry, Hs[sg]);
        const float tp = P[sg] * prod;
        if (half == ow) cin[sg] = carry;
        const float oth = __shfl_xor(tmp, 32), otp = __shfl_xor(tp, 32);
        carry = (half == ow) ? tmp : oth;
        prod = (half == ow) ? tp : otp;
      }
    if (MODE == 0) {
      if (half == 0) { float* ag = AGG + ((size_t)(b * 128 + cr) * 512 + ch) * 2; ag[0] = prod; ag[1] = carry; }
    } else {
#pragma unroll
      for (int sg = 0; sg < 8; ++sg) {
        const int ti = sg >> 2, q = sg & 3;
        float hh = cin[sg];
#pragma unroll
        for (int i = 0; i < 4; ++i) {
          hh = fmaf(ra[ti][4 * q + i], hh, rx[ti][4 * q + i]);
          LDS h16* xp = (LDS h16*)(lds + RNN_XG + (32 * ti + 8 * q + 4 * half + i) * CROW + ch * 2);
          *xp = (h16)(hh * gelu_tanh_f((float)*xp));
        }
      }
    }
  }
  __syncthreads();
  if (MODE == 1) {
    h16* Y = (h16*)(p.ws + WS_H) + ((size_t)b * SEQ + cr * 64) * DM + 512;
#pragma unroll
    for (int i = 0; i < 8; ++i) { const int c = tid + NTHR * i, row = c >> 6, cc = c & 63; *(h16x8*)(Y + (size_t)row * DM + cc * 8) = *(LDS h16x8*)(lds + RNN_XG + row * CROW + cc * 16); }
    __syncthreads();
  }
}

constexpr int IDX_NB = 256, IDX_CAP = 128;
constexpr int IL_HIST = 0, IL_CS = 65536, IL_CK = IL_CS + 64 * IDX_CAP * 4, IL_KI = IL_CK + 64 * IDX_CAP * 2, IL_KISZ = 128 * LROW, IL_ST = IL_KI + 2 * IL_KISZ;
static_assert(IL_ST + 4096 <= LDS_BYTES, "indexer LDS map");

DEVI f32x4 mfma16s(h16x8 a, h16x8 b, f32x4 c) { return __builtin_amdgcn_mfma_f32_16x16x32_f16(a, b, c, 0, 0, 0); }
DEVI void idx_score(LDS unsigned char* kit, int kh, int l15, int g4, const h16x8 (&qf)[8][2], const float (&wq)[8], f32x4 (&sc)[4]) {
  h16x8 kf[4][2];
#pragma unroll
  for (int kt = 0; kt < 4; ++kt)
#pragma unroll
    for (int ks = 0; ks < 2; ++ks) kf[kt][ks] = *(LDS h16x8*)(kit + (64 * kh + 16 * kt + l15) * LROW + (4 * ks + g4) * 16);
#pragma unroll
  for (int kt = 0; kt < 4; ++kt) sc[kt] = (f32x4){0.f, 0.f, 0.f, 0.f};
  f32x4 accA[4], accB[4];
#define IDX_MM(ACC, h) _Pragma("unroll") for (int kt = 0; kt < 4; ++kt) { ACC[kt] = mfma16s(kf[kt][0], qf[h][0], (f32x4){0.f, 0.f, 0.f, 0.f}); ACC[kt] = mfma16s(kf[kt][1], qf[h][1], ACC[kt]); }
#define IDX_RS(ACC, h) _Pragma("unroll") for (int kt = 0; kt < 4; ++kt) _Pragma("unroll") for (int r = 0; r < 4; ++r) sc[kt][r] = __builtin_fmaf(wq[h], __int_as_float(max(__float_as_int(ACC[kt][r]), 0)), sc[kt][r]);
  IDX_MM(accA, 0)
  IDX_MM(accB, 1) IDX_RS(accA, 0)
  IDX_MM(accA, 2) IDX_RS(accB, 1)
  IDX_MM(accB, 3) IDX_RS(accA, 2)
  IDX_MM(accA, 4) IDX_RS(accB, 3)
  IDX_MM(accB, 5) IDX_RS(accA, 4)
  IDX_MM(accA, 6) IDX_RS(accB, 5)
  IDX_MM(accB, 7) IDX_RS(accA, 6)
  IDX_RS(accB, 7)
#undef IDX_MM
#undef IDX_RS
}

template <int MODE>
DEVI void idx_pass(LDS unsigned char* lds, const h16* KIb, int N, int stride, int qg, int kh,
                   const h16* QIrow0, const float* WIrow0, float qinv, float qoff, int bstar) {
  const int tid = launder((int)threadIdx.x), lane = tid & 63, l15 = lane & 15, g4 = lane >> 4;
  const int q = 16 * qg + l15;
  h16x8 qf[8][2]; float wq[8];
  {
    const h16* QI = QIrow0 + (size_t)q * 512;
#pragma unroll
    for (int h = 0; h < 8; ++h)
#pragma unroll
      for (int ks = 0; ks < 2; ++ks) qf[h][ks] = *(const h16x8*)(QI + h * 64 + 32 * ks + 8 * g4);
    const float* WI = WIrow0 + (size_t)q * 8;
#pragma unroll
    for (int h = 0; h < 8; ++h) wq[h] = WI[h];
  }
  LDS unsigned* hist = (LDS unsigned*)(lds + IL_HIST);
  LDS unsigned* st = (LDS unsigned*)(lds + IL_ST);
  const int nst = (N + 127) >> 7;
  const int lr = tid >> 3, lc = tid & 7;
  h16x8 r0, r1;
  r0 = *(const h16x8*)(KIb + (size_t)lr * 64 + lc * 8); r1 = *(const h16x8*)(KIb + (size_t)(lr + 64) * 64 + lc * 8);
  *(LDS h16x8*)(lds + IL_KI + lr * LROW + lc * 16) = r0; *(LDS h16x8*)(lds + IL_KI + (lr + 64) * LROW + lc * 16) = r1;
  __syncthreads();
  float vmin = INFINITY, vmax = -INFINITY;
  int cur = 0;
  for (int s = 0; s < nst; s += stride) {
    const int nx = s + stride;
    if (nx < nst) { r0 = *(const h16x8*)(KIb + (size_t)(128 * nx + lr) * 64 + lc * 8); r1 = *(const h16x8*)(KIb + (size_t)(128 * nx + lr + 64) * 64 + lc * 8); }
    if (128 * s + 64 * kh < N) {
      f32x4 sc[4];
      idx_score(lds + IL_KI + cur * IL_KISZ, kh, l15, g4, qf, wq, sc);
      if (MODE == 0) {
#pragma unroll
        for (int kt = 0; kt < 4; ++kt)
#pragma unroll
          for (int r = 0; r < 4; ++r) { vmin = fminf(vmin, sc[kt][r]); vmax = fmaxf(vmax, sc[kt][r]); }
      } else if (MODE == 1) {
#pragma unroll
        for (int kt = 0; kt < 4; ++kt)
#pragma unroll
          for (int r = 0; r < 4; ++r) {
            const float xb = fminf(fmaxf(__builtin_fmaf(sc[kt][r], qinv, qoff), 0.f), (float)(IDX_NB - 1));
            const int bin = (int)xb;
            __hip_atomic_fetch_add(&hist[bin * 64 + q], 1u, __ATOMIC_RELAXED, __HIP_MEMORY_SCOPE_WORKGROUP);
          }
      } else {
        unsigned nib = 0u;
#pragma unroll
        for (int kt = 0; kt < 4; ++kt)
#pragma unroll
          for (int r = 0; r < 4; ++r) {
            const float xb = fminf(fmaxf(__builtin_fmaf(sc[kt][r], qinv, qoff), 0.f), (float)(IDX_NB - 1));
            const int bin = (int)xb;
            if (bin > bstar) nib |= (1u << (4 * kt + r));
            else if (bin == bstar) {
              const unsigned pos = __hip_atomic_fetch_add(&st[128 + q], 1u, __ATOMIC_RELAXED, __HIP_MEMORY_SCOPE_WORKGROUP);
              if (pos < (unsigned)IDX_CAP) {
                ((LDS float*)(lds + IL_CS))[q * IDX_CAP + pos] = sc[kt][r];
                ((LDS unsigned short*)(lds + IL_CK))[q * IDX_CAP + pos] = (unsigned short)(128 * s + 64 * kh + 16 * kt + 4 * g4 + r);
              }
            }
          }
        const unsigned oth = (unsigned)__shfl_xor((int)nib, 32);
        if (lane < 32) {
#pragma unroll
          for (int T = 0; T < 2; ++T) {
            const unsigned b0 = ((nib >> (8 * T)) & 15u) | (((oth >> (8 * T)) & 15u) << 4);
            const unsigned b1 = ((nib >> (8 * T + 4)) & 15u) | (((oth >> (8 * T + 4)) & 15u) << 4);
            ((LDS unsigned short*)(lds + IL_HIST))[q * 512 + (4 * s + 2 * kh + T) * 2 + (g4 & 1)] = (unsigned short)(b0 | (b1 << 8));
          }
        }
      }
    }
    if (nx < nst) {
      *(LDS h16x8*)(lds + IL_KI + (cur ^ 1) * IL_KISZ + lr * LROW + lc * 16) = r0;
      *(LDS h16x8*)(lds + IL_KI + (cur ^ 1) * IL_KISZ + (lr + 64) * LROW + lc * 16) = r1;
    }
    __syncthreads();
    cur ^= 1;
  }
  if (MODE == 0) {
    __hip_atomic_fetch_min(&st[q], fkey(vmin), __ATOMIC_RELAXED, __HIP_MEMORY_SCOPE_WORKGROUP);
    __hip_atomic_fetch_max(&st[64 + q], fkey(vmax), __ATOMIC_RELAXED, __HIP_MEMORY_SCOPE_WORKGROUP);
  }
}

DEVI void idx_item(PRef p, LDS unsigned char* lds, int b, int c) {
  const int tid = launder((int)threadIdx.x), lane = tid & 63, wave = wave_id(tid), l31 = lane & 31, half = lane >> 5;
  const int N = 64 * (c + 1);
  unsigned* MASK = (unsigned*)(p.ws + WS_MASK) + ((size_t)b * SEQ + 64 * c) * 256;
  if (N <= 256) {
    const int wpr = N >> 5;
    for (int i = tid; i < 64 * wpr; i += NTHR) MASK[(size_t)(i / wpr) * 256 + (i % wpr)] = 0xFFFFFFFFu;
    return;
  }
  const int qg = wave & 3, kh = wave >> 2, l15 = lane & 15, q = 16 * qg + l15;
  const h16* QIrow0 = (const h16*)(p.ws + WS_QI) + ((size_t)b * SEQ + 64 * c) * 512;
  const float* WIrow0 = (const float*)(p.ws + WS_WI) + ((size_t)b * SEQ + 64 * c) * 8;
  const h16* KIb = (const h16*)(p.ws + WS_KI) + (size_t)b * SEQ * 64;
  LDS unsigned* st = (LDS unsigned*)(lds + IL_ST);
  LDS float* stf = (LDS float*)(lds + IL_ST);
  if (tid < 64) { st[tid] = 0xFFFFFFFFu; st[64 + tid] = 0u; st[128 + tid] = 0u; }
  __syncthreads();
  const int nst = (N + 127) >> 7;
  const int stride = nst >= 16 ? 8 : (nst >= 8 ? 4 : (nst >= 4 ? 2 : 1));
  idx_pass<0>(lds, KIb, N, stride, qg, kh, QIrow0, WIrow0, 0.f, 0.f, 0);
  __syncthreads();
  if (tid < 64) {
    const float lo = fkey_inv(st[tid]), hi = fkey_inv(st[64 + tid]);
    float d = hi - lo; if (!(d > 1e-20f)) d = 1.f;
    const float inv = (float)IDX_NB / (1.5f * d);
    stf[192 + tid] = inv; stf[256 + tid] = -(lo - 0.25f * d) * inv;
  }
  for (int i = tid; i < 16384; i += NTHR) ((LDS unsigned*)(lds + IL_HIST))[i] = 0u;
  __syncthreads();
  const float qinv = stf[192 + q], qoff = stf[256 + q];
  idx_pass<1>(lds, KIb, N, 1, qg, kh, QIrow0, WIrow0, qinv, qoff, 0);
#ifdef PROBE_P1X2
  __syncthreads();
  for (int i = tid; i < 16384; i += NTHR) ((LDS unsigned*)(lds + IL_HIST))[i] = 0u;
  __syncthreads();
  idx_pass<1>(lds, KIb, N, 1, qg, kh, QIrow0, WIrow0, qinv, qoff, 0);
#endif
  {
    LDS unsigned* hist = (LDS unsigned*)(lds + IL_HIST);
    for (int qq = wave; qq < 64; qq += 8) {
      unsigned hb[4];
#pragma unroll
      for (int j = 0; j < 4; ++j) hb[j] = hist[(4 * lane + j) * 64 + qq];
      const unsigned mine = hb[0] + hb[1] + hb[2] + hb[3];
      unsigned suf = mine;
#pragma unroll
      for (int o = 1; o < 64; o <<= 1) { const unsigned v = (unsigned)__shfl_down((int)suf, o); if (lane + o < 64) suf += v; }
      unsigned cum = suf - mine;
      if (cum < 256u && suf >= 256u) {
#pragma unroll
        for (int j = 3; j >= 0; --j) {
          if (cum < 256u && cum + hb[j] >= 256u) { st[320 + qq] = (unsigned)(4 * lane + j); st[384 + qq] = 256u - cum; }
          cum += hb[j];
        }
      }
    }
  }
  __syncthreads();
  const int bstar = (int)st[320 + q];
  __syncthreads();
  idx_pass<2>(lds, KIb, N, 1, qg, kh, QIrow0, WIrow0, qinv, qoff, bstar);
#ifdef PROBE_P2X2
  __syncthreads();
  if (tid < 64) st[128 + tid] = 0u;
  __syncthreads();
  idx_pass<2>(lds, KIb, N, 1, qg, kh, QIrow0, WIrow0, qinv, qoff, bstar);
#endif
  for (int qq = wave; qq < 64; qq += 8) {
    const int nc = min((int)st[128 + qq], IDX_CAP); const unsigned need = st[384 + qq];
    LDS float* cs = (LDS float*)(lds + IL_CS) + qq * IDX_CAP; LDS unsigned short* ck = (LDS unsigned short*)(lds + IL_CK) + qq * IDX_CAP;
    for (int i = lane; i < nc; i += 64) {
      const float sv = cs[i]; const unsigned kv = ck[i];
      unsigned rank = 0u;
      for (int j = 0; j < nc; ++j) { const float sj = cs[j]; const unsigned kj = ck[j]; rank += (sj > sv || (sj == sv && kj < kv)) ? 1u : 0u; }
      if (rank < need) {
        const unsigned kl = kv & 31u;
        const unsigned bit = 16u * ((kl >> 2) & 1u) + (kl & 3u) + 4u * (kl >> 3);
        __hip_atomic_fetch_or((LDS unsigned*)(lds + IL_HIST) + qq * 256 + (kv >> 5), 1u << bit, __ATOMIC_RELAXED, __HIP_MEMORY_SCOPE_WORKGROUP);
      }
    }
  }
  __syncthreads();
  {
    const int cpr = N >> 6;
    for (int i = tid; i < 64 * cpr; i += NTHR) {
      const int row = i / cpr, cc = i % cpr;
      *(u32x2*)(MASK + (size_t)row * 256 + 2 * cc) = *(LDS u32x2*)(lds + IL_HIST + row * 1024 + cc * 8);
    }
  }
  __syncthreads();
}

DEVI void phase3(PRef p, LDS unsigned char* lds) {
  const int G = gridDim.x;
  for (int it = blockIdx.x; it < 512; it += G) rnn_item<0>(p, lds, it >> 7, it & 127);
  for (int it = blockIdx.x; it < 256; it += G) {
    const int b = it >> 6, j = it & 63;
#pragma unroll 1
    for (int w2 = 0; w2 < 2; ++w2) idx_item(p, lds, b, w2 ? j : 127 - j);
  }
}

constexpr int AT_BUF = 2 * 64 * LROW;
DEVI float max3f(float a, float b, float c) { float r; asm("v_max3_f32 %0, %1, %2, %3" : "=v"(r) : "v"(a), "v"(b), "v"(c)); return r; }
DEVI unsigned pk_rtz(float a, float b) { return __builtin_bit_cast(unsigned, __builtin_amdgcn_cvt_pkrtz(a, b)); }
DEVI void attn_tile(LDS unsigned char* Kt, LDS unsigned char* Vt, const h16x8 (&qf)[4], u32x2 mw, int l31, int half, f32x16 (&o)[2], float& mref, float& l, bool& init) {
  const unsigned nm0 = ~(mw[0] >> (16 * half)), nm1 = ~(mw[1] >> (16 * half));
  const unsigned negm = __float_as_uint(-mref);
  f32x16 s[2];
#pragma unroll
  for (int r = 0; r < 16; ++r) {
    unsigned e0 = (unsigned)__builtin_amdgcn_sbfe((int)nm0, r, 1), e1 = (unsigned)__builtin_amdgcn_sbfe((int)nm1, r, 1);
    asm volatile("" : "+v"(e0), "+v"(e1));
    s[0][r] = __uint_as_float((e0 & 0xFF800000u) | (~e0 & negm));
    s[1][r] = __uint_as_float((e1 & 0xFF800000u) | (~e1 & negm));
  }
#pragma unroll
  for (int ri = 0; ri < 2; ++ri)
#pragma unroll
    for (int kk = 0; kk < 4; ++kk) {
      const h16x8 kf = *(LDS h16x8*)(Kt + (32 * ri + l31) * LROW + (2 * kk + half) * 16);
      s[ri] = mfma16(kf, qf[kk], s[ri]);
    }
  asm volatile("s_nop 15\n\ts_nop 7" : "+v"(s[0]), "+v"(s[1]));
  float mx = max3f(s[0][0], s[1][0], s[0][1]), mx2 = max3f(s[1][1], s[0][2], s[1][2]);
#pragma unroll
  for (int r = 3; r < 15; r += 2) { mx = max3f(mx, s[0][r], s[1][r]); mx2 = max3f(mx2, s[0][r + 1], s[1][r + 1]); }
  mx = max3f(mx, s[0][15], s[1][15]);
  mx = max3f(mx, mx2, mx2);
  mx = max3f(mx, __shfl_xor(mx, 32), mx);
  const bool first = (!init) && (mx > -INFINITY);
  const bool resc = first || (mx > 8.f);
  if (__any(resc)) {
    init = init || first;
    const float delta = resc ? mx : 0.f;
    const float alpha = __builtin_amdgcn_exp2f(-delta);
#pragma unroll
    for (int r = 0; r < 16; ++r) { s[0][r] -= delta; s[1][r] -= delta; o[0][r] *= alpha; o[1][r] *= alpha; }
    l *= alpha; mref += delta;
  }
  float ls = 0.f;
#pragma unroll
  for (int r = 0; r < 16; ++r) {
    s[0][r] = __builtin_amdgcn_exp2f(s[0][r]); s[1][r] = __builtin_amdgcn_exp2f(s[1][r]);
    ls += s[0][r] + s[1][r];
  }
  l += ls;
  h16x8 pf[4];
#pragma unroll
  for (int s4 = 0; s4 < 4; ++s4) {
    u32x4 w;
#pragma unroll
    for (int e = 0; e < 4; ++e) w[e] = pk_rtz(s[s4 >> 1][8 * (s4 & 1) + 2 * e], s[s4 >> 1][8 * (s4 & 1) + 2 * e + 1]);
    pf[s4] = __builtin_bit_cast(h16x8, w);
  }
#pragma unroll
  for (int di = 0; di < 2; ++di)
#pragma unroll
    for (int s4 = 0; s4 < 4; ++s4) {
      const h16x8 vf = *(LDS h16x8*)(Vt + (32 * di + l31) * LROW + (2 * s4 + half) * 16);
      o[di] = mfma16(vf, pf[s4], o[di]);
    }
}

DEVI void attn_unit(PRef p, LDS unsigned char* lds, int b, int head, int qb) {
  const int tid = launder((int)threadIdx.x), lane = tid & 63, wave = wave_id(tid), l31 = lane & 31, half = lane >> 5;
  const int q0 = qb * 256 + wave * 32, cw = q0 >> 6, NS = 2 * (qb + 1);
  const size_t tok = (size_t)b * SEQ + q0 + l31;
  h16x8 qf[4];
  {
    const h16* Q = (const h16*)(p.ws + WS_Q) + tok * 512 + head * 64;
#pragma unroll
    for (int kk = 0; kk < 4; ++kk) qf[kk] = *(const h16x8*)(Q + 16 * kk + 8 * half);
  }
  const unsigned* mrow = (const unsigned*)(p.ws + WS_MASK) + tok * 256;
  constexpr int TP = 2 * 64 * LROW, ABUF = 2 * TP;
  const h16* ksrc[2]; const h16* vsrc[2]; int kdst[2], vdst[2];
#pragma unroll
  for (int i = 0; i < 2; ++i) {
    const int id = tid + NTHR * i;
    const int row = id >> 3, lc = id & 7;
    ksrc[i] = (const h16*)(p.ws + WS_K) + ((size_t)b * SEQ + row) * 512 + head * 64 + lc * 8;
    kdst[i] = (row >> 6) * TP + (row & 63) * LROW + lc * 16;
    const int d = id >> 4, c = id & 15;
    vsrc[i] = (const h16*)(p.ws + WS_VT) + ((size_t)(b * 8 + head) * 64 + d) * 8192 + c * 8;
    vdst[i] = (c >> 3) * TP + 64 * LROW + d * LROW + (c & 7) * 16;
  }
  h16x8 rkA[2], rvA[2], rkB[2], rvB[2];
#pragma unroll
  for (int i = 0; i < 2; ++i) { rkA[i] = *(const h16x8*)ksrc[i]; rvA[i] = *(const h16x8*)vsrc[i]; }
#pragma unroll
  for (int i = 0; i < 2; ++i) { *(LDS h16x8*)(lds + kdst[i]) = rkA[i]; *(LDS h16x8*)(lds + vdst[i]) = rvA[i]; }
#pragma unroll
  for (int i = 0; i < 2; ++i) { rkA[i] = *(const h16x8*)(ksrc[i] + (size_t)128 * 512); rvA[i] = *(const h16x8*)(vsrc[i] + 128); }
  u32x4 mw = *(const u32x4*)mrow, mwn;
  __syncthreads();
  f32x16 o[2];
#pragma unroll
  for (int r = 0; r < 16; ++r) { o[0][r] = 0.f; o[1][r] = 0.f; }
  float mref = 0.f, l = 0.f; bool init = false;
#define ATT_STEP(s, RKC, RVC, RKN, RVN) { \
    if ((s) + 2 < NS) { _Pragma("unroll") for (int i = 0; i < 2; ++i) { RKN[i] = *(const h16x8*)(ksrc[i] + (size_t)((s) + 2) * 128 * 512); RVN[i] = *(const h16x8*)(vsrc[i] + ((s) + 2) * 128); } } \
    if ((s) + 1 < NS) mwn = *(const u32x4*)(mrow + 4 * ((s) + 1)); \
    { LDS unsigned char* bb = lds + ((s) & 1) * ABUF; \
      if (2 * (s) <= cw) { u32x2 m2; m2[0] = mw[0]; m2[1] = mw[1]; attn_tile(bb, bb + 64 * LROW, qf, m2, l31, half, o, mref, l, init); } \
      if (2 * (s) + 1 <= cw) { u32x2 m2; m2[0] = mw[2]; m2[1] = mw[3]; attn_tile(bb + TP, bb + TP + 64 * LROW, qf, m2, l31, half, o, mref, l, init); } } \
    if ((s) + 1 < NS) { LDS unsigned char* nb = lds + (((s) + 1) & 1) * ABUF; _Pragma("unroll") for (int i = 0; i < 2; ++i) { *(LDS h16x8*)(nb + kdst[i]) = RKC[i]; *(LDS h16x8*)(nb + vdst[i]) = RVC[i]; } } \
    __syncthreads(); mw = mwn; }
  for (int s = 0; s < NS; s += 2) {
    ATT_STEP(s, rkA, rvA, rkB, rvB)
    ATT_STEP(s + 1, rkB, rvB, rkA, rvA)
  }
#undef ATT_STEP
  const float inv = 1.f / (l + __shfl_xor(l, 32));
  h16* Y = (h16*)(p.ws + WS_H) + tok * DM + head * 64;
#pragma unroll
  for (int di = 0; di < 2; ++di)
#pragma unroll
    for (int q = 0; q < 4; ++q)
      *(h16x4*)(Y + 32 * di + 8 * q + 4 * half) = pack4(o[di][4 * q] * inv, o[di][4 * q + 1] * inv, o[di][4 * q + 2] * inv, o[di][4 * q + 3] * inv);
}

DEVI void phase4(PRef p, LDS unsigned char* lds) {
  const int G = gridDim.x;
  for (int it = blockIdx.x; it < 512; it += G) rnn_item<1>(p, lds, it >> 7, it & 127);
  for (int it = blockIdx.x; it < 512; it += G) {
    const int bh = it >> 4, j = it & 15;
#pragma unroll 1
    for (int w2 = 0; w2 < 2; ++w2) attn_unit(p, lds, bh >> 3, bh & 7, w2 ? j : 31 - j);
  }
}

struct EpiPlain {
  h16* dst; int ld;
  DEVI void operator()(const f32x4 (&acc)[2][2][4][2], const g8::Unit& u, int wr, int wc, int fr, int fq) const {
#pragma unroll
    for (int ai = 0; ai < 2; ++ai)
#pragma unroll
      for (int m = 0; m < 4; ++m) {
        const int r = u.pm * 256 + 128 * ai + 64 * wr + 16 * m + fr;
        if (r < u.cnt) {
          h16* d = dst + (size_t)(u.off + r) * ld + u.pn * 256 + 32 * wc + 4 * fq;
#pragma unroll
          for (int bj = 0; bj < 2; ++bj)
#pragma unroll
            for (int n = 0; n < 2; ++n) { const f32x4 v = acc[ai][bj][m][n]; *(h16x4*)(d + 128 * bj + 16 * n) = pack4(v[0], v[1], v[2], v[3]); }
        }
      }
  }
};
DEVI void phase5(PRef p, LDS unsigned char* lds) {
  g8::DenseOrder S{(const h16*)(p.ws + WS_H), (const h16*)(p.ws + WS_WOUT), DM, 128, 4, (int)gridDim.x, (int)blockIdx.x};
  EpiPlain E{(h16*)(p.ws + WS_MIX), DM};
  g8::gemm_phase(lds, DM, S, E);
}

constexpr int P6_WRT = 0, P6_MOD = 36 * 1024 * 4, P6_LG = P6_MOD  , P6_BIAS = P6_LG + 8 * 72 * 4, P6_TOK = P6_BIAS + 160, P6_LCNT = P6_TOK + 128 * 6 * 4, P6_LBASE = P6_LCNT + 128;
static_assert(P6_LBASE + 128 <= LDS_BYTES - 16 && P6_MOD + 3 * 4096 <= LDS_BYTES - 16, "phase 6 LDS map");
DEVI void phase6(PRef p, LDS unsigned char* lds) {
  const int tid = launder((int)threadIdx.x), lane = tid & 63, wave = wave_id(tid), G = gridDim.x;
  const int b = blockIdx.x & 3, bi = blockIdx.x >> 2, nbk = G >> 2;
  LDS float* wrt = (LDS float*)(lds + P6_WRT);
  LDS float* mv = (LDS float*)(lds + P6_MOD);
  LDS float* lgw = (LDS float*)(lds + P6_LG) + wave * 72;
  LDS float* rbias = (LDS float*)(lds + P6_BIAS);
  LDS unsigned* tokrec = (LDS unsigned*)(lds + P6_TOK);
  LDS unsigned* lcnt = (LDS unsigned*)(lds + P6_LCNT);
  LDS unsigned* lbase = (LDS unsigned*)(lds + P6_LBASE);
  {
    const f32x4* src = (const f32x4*)(p.ws + WS_WRT);
    for (int i = tid; i < 36 * 256; i += NTHR) ((LDS f32x4*)wrt)[i] = src[i];
  }
  mod_to_lds(p, b, 2, mv); mod_to_lds(p, b, 3, mv + 1024); mod_to_lds(p, b, 4, mv + 2048);
  __syncthreads();
  f32x4 A1[4], A2[4], SH2[4];
#pragma unroll
  for (int j = 0; j < 4; ++j) {
    const int k = 256 * j + 4 * lane;
    A1[j] = *(LDS f32x4*)(mv + k) * *(const f32x4*)(p.in[5] + k);
    A2[j] = *(const f32x4*)(p.in[6] + k) * (*(LDS f32x4*)(mv + 2048 + k) + 1.f);
    SH2[j] = *(LDS f32x4*)(mv + 1024 + k);
  }
  __syncthreads();
  if (tid < 4) rbias[tid] = p.in[18][tid];
  else if (tid < 36) rbias[tid] = p.in[20][tid - 4];
  if (tid < 32) lcnt[tid] = 0u;
  __syncthreads();
  const float* x = p.in[0]; const h16* MIX = (const h16*)(p.ws + WS_MIX); float* X1 = p.out; h16* H2 = (h16*)(p.ws + WS_H);
  const bool lowhalf = lane < 32, lowq = (lane & 16) == 0;
  int it = 0;
  for (int pr = bi * 8 + wave; pr < SEQ / 2; pr += nbk * 8, ++it) {
    f32x4 h2[2][4];
#pragma unroll
    for (int tt = 0; tt < 2; ++tt) {
      const size_t tok = (size_t)b * SEQ + 2 * pr + tt;
      f32x4 xv[4], mx[4]; float ssm = 0.f;
#pragma unroll
      for (int j = 0; j < 4; ++j) {
        xv[j] = *(const f32x4*)(x + tok * DM + 256 * j + 4 * lane);
        const h16x4 mh = *(const h16x4*)(MIX + tok * DM + 256 * j + 4 * lane);
#pragma unroll
        for (int e = 0; e < 4; ++e) { mx[j][e] = (float)mh[e]; ssm += mx[j][e] * mx[j][e]; }
      }
      const float rsm = 1.0f / sqrtf(wave_sum(ssm) * (1.f / 1024.f) + 1e-6f);
      float ss1 = 0.f;
#pragma unroll
      for (int j = 0; j < 4; ++j) {
        xv[j] = xv[j] + A1[j] * (mx[j] * rsm);
        *(f32x4*)(X1 + tok * DM + 256 * j + 4 * lane) = xv[j];
        ss1 += xv[j][0] * xv[j][0] + xv[j][1] * xv[j][1] + xv[j][2] * xv[j][2] + xv[j][3] * xv[j][3];
      }
      const float rs1 = 1.0f / sqrtf(wave_sum(ss1) * (1.f / 1024.f) + 1e-6f);
#pragma unroll
      for (int j = 0; j < 4; ++j) {
        h2[tt][j] = xv[j] * rs1 * A2[j] + SH2[j];
        *(h16x4*)(H2 + tok * DM + 256 * j + 4 * lane) = pack4(h2[tt][j][0], h2[tt][j][1], h2[tt][j][2], h2[tt][j][3]);
      }
    }
    float a0[36], a1[36];
#pragma unroll
    for (int col = 0; col < 36; ++col) {
      float s0 = 0.f, s1 = 0.f;
#pragma unroll
      for (int j = 0; j < 4; ++j) {
        const f32x4 w = *(LDS f32x4*)(wrt + col * 1024 + 256 * j + 4 * lane);
#pragma unroll
        for (int e = 0; e < 4; ++e) { s0 = fmaf(h2[0][j][e], w[e], s0); s1 = fmaf(h2[1][j][e], w[e], s1); }
      }
      a0[col] = s0; a1[col] = s1;
    }
    float b0[18], b1[18];
#pragma unroll
    for (int c = 0; c < 18; ++c) {
      const float snd0 = lowhalf ? a0[c + 18] : a0[c], snd1 = lowhalf ? a1[c + 18] : a1[c];
      b0[c] = (lowhalf ? a0[c] : a0[c + 18]) + __shfl_xor(snd0, 32);
      b1[c] = (lowhalf ? a1[c] : a1[c + 18]) + __shfl_xor(snd1, 32);
    }
    float c0[9], c1[9];
#pragma unroll
    for (int c = 0; c < 9; ++c) {
      const float snd0 = lowq ? b0[c + 9] : b0[c], snd1 = lowq ? b1[c + 9] : b1[c];
      c0[c] = (lowq ? b0[c] : b0[c + 9]) + __shfl_xor(snd0, 16);
      c1[c] = (lowq ? b1[c] : b1[c + 9]) + __shfl_xor(snd1, 16);
    }
#pragma unroll
    for (int c = 0; c < 9; ++c) {
#pragma unroll
      for (int o = 8; o >= 1; o >>= 1) { c0[c] += __shfl_xor(c0[c], o); c1[c] += __shfl_xor(c1[c], o); }
    }
    if ((lane & 15) == 0) {
      const int cb = 18 * (lane >> 5) + 9 * ((lane >> 4) & 1);
#pragma unroll
      for (int c = 0; c < 9; ++c) { lgw[cb + c] = c0[c]; lgw[36 + cb + c] = c1[c]; }
    }
    if (lane < 2) {
      const int tt = lane;
      LDS float* lg = lgw + 36 * tt;
      float gl[4];
#pragma unroll
      for (int g = 0; g < 4; ++g) gl[g] = lg[g] + rbias[g];
      int gi = 0; float gm = gl[0];
#pragma unroll
      for (int g = 1; g < 4; ++g) if (gl[g] > gm) { gm = gl[g]; gi = g; }
      float gs = 0.f;
#pragma unroll
      for (int g = 0; g < 4; ++g) gs += __expf(gl[g] - gm);
      const float pg = 1.f / gs;
      int e1 = 0, e2 = 0; float l1 = -INFINITY, l2 = -INFINITY;
#pragma unroll
      for (int e = 0; e < 8; ++e) {
        const float v = lg[4 + 8 * gi + e] + rbias[4 + 8 * gi + e];
        if (v > l1) { l2 = l1; e2 = e1; l1 = v; e1 = e; }
        else if (v > l2) { l2 = v; e2 = e; }
      }
      const float x2 = __expf(l2 - l1);
      const float w1 = pg / (1.f + x2), w2 = pg * x2 / (1.f + x2);
      const unsigned E1 = (unsigned)(gi * 8 + e1), E2 = (unsigned)(gi * 8 + e2);
      const unsigned lp1 = __hip_atomic_fetch_add(&lcnt[E1], 1u, __ATOMIC_RELAXED, __HIP_MEMORY_SCOPE_WORKGROUP);
      const unsigned lp2 = __hip_atomic_fetch_add(&lcnt[E2], 1u, __ATOMIC_RELAXED, __HIP_MEMORY_SCOPE_WORKGROUP);
      LDS unsigned* tr = tokrec + ((it * 8 + wave) * 2 + tt) * 6;
      tr[0] = E1; tr[1] = lp1; tr[2] = E2; tr[3] = lp2; tr[4] = __float_as_uint(w1); tr[5] = __float_as_uint(w2);
    }
  }
  __syncthreads();
  if (tid < 32) lbase[tid] = atomicAdd((unsigned*)(p.ws + WS_CNT) + tid, lcnt[tid]);
  __syncthreads();
  {
    unsigned* LIST = (unsigned*)(p.ws + WS_LIST); float* LISTW = (float*)(p.ws + WS_LISTW); u32x4* ROUTE = (u32x4*)(p.ws + WS_ROUTE);
    const int npair = (SEQ / 2 - bi * 8 + nbk * 8 - 1) / (nbk * 8);
    for (int s = tid; s < npair * 16; s += NTHR) {
      const int tt = s & 1, w = (s >> 1) & 7, i2 = s >> 4;
      const int pr = bi * 8 + w + nbk * 8 * i2;
      if (pr < SEQ / 2) {
        const unsigned tok = (unsigned)(b * SEQ + 2 * pr + tt);
        LDS unsigned* tr = tokrec + s * 6;
        const unsigned E1 = tr[0], E2 = tr[2], p1 = lbase[E1] + tr[1], p2 = lbase[E2] + tr[3];
        LIST[(size_t)E1 * 32768 + p1] = tok; LISTW[(size_t)E1 * 32768 + p1] = __uint_as_float(tr[4]);
        LIST[(size_t)E2 * 32768 + p2] = tok; LISTW[(size_t)E2 * 32768 + p2] = __uint_as_float(tr[5]);
        u32x4 rt; rt[0] = E1; rt[1] = p1; rt[2] = E2; rt[3] = p2;
        ROUTE[tok] = rt;
      }
    }
  }
}

template <bool GATHER_> struct MoeOrder {
  static constexpr bool GATHER = GATHER_;
  unsigned char* ws; int ntn, K, G, c;
  DEVI bool next(int i, g8::Unit& u) const {
    const unsigned* cnt = (const unsigned*)(ws + WS_CNT);
    int it = i * G + c, off = 0, e = 0, cn = 0; bool found = false;
    for (e = 0; e < 32; ++e) { cn = (int)cnt[e]; const int nti = ((cn + 255) >> 8) * ntn; if (it < nti) { found = true; break; } it -= nti; off += cn; }
    if (!found) return false;
    u.e = e; u.pm = it / ntn; u.pn = it % ntn; u.cnt = cn; u.off = off;
    const int tid = threadIdx.x;
    if (GATHER_) {
      const unsigned* list = (const unsigned*)(ws + WS_LIST) + (size_t)e * 32768;
      u.A = (const char*)(ws + WS_H);
      u.B = (const char*)((const h16*)(ws + WS_WGU) + ((size_t)e * 512 + u.pn * 256) * DM);
#pragma unroll
      for (int h = 0; h < 2; ++h)
#pragma unroll
        for (int i2 = 0; i2 < 2; ++i2) {
          int R, C; g8::stage_rc(tid * 16 + i2 * 8192, R, C);
          const int row = u.pm * 256 + 128 * h + R;
          const unsigned t = (row < cn) ? list[row] : 0u;
          u.va[h][i2] = (t * (unsigned)DM + (unsigned)C) * 2u;
        }
    } else {
      u.A = (const char*)((const h16*)(ws + WS_ACT) + ((size_t)off + u.pm * 256) * 256);
      u.B = (const char*)((const h16*)(ws + WS_WDN) + ((size_t)e * 1024 + u.pn * 256) * 256);
      u.va[0][0] = u.va[0][1] = u.va[1][0] = u.va[1][1] = 0u;
    }
    return true;
  }
};
struct EpiAct {
  unsigned char* ws;
  DEVI void operator()(const f32x4 (&acc)[2][2][4][2], const g8::Unit& u, int wr, int wc, int fr, int fq) const {
    const float* lw = (const float*)(ws + WS_LISTW) + (size_t)u.e * 32768; h16* act = (h16*)(ws + WS_ACT);
#pragma unroll
    for (int ai = 0; ai < 2; ++ai)
#pragma unroll
      for (int m = 0; m < 4; ++m) {
        const int r = u.pm * 256 + 128 * ai + 64 * wr + 16 * m + fr;
        if (r < u.cnt) {
          const float w = lw[r];
#pragma unroll
          for (int bj = 0; bj < 2; ++bj) {
            const f32x4 g = acc[ai][bj][m][0], up = acc[ai][bj][m][1];
            float v[4];
#pragma unroll
            for (int e = 0; e < 4; ++e) v[e] = g[e] * __builtin_amdgcn_rcpf(1.f + __expf(-g[e])) * up[e] * w;
            *(h16x4*)(act + (size_t)(u.off + r) * 256 + 16 * (8 * u.pn + 4 * bj + wc) + 4 * fq) = pack4(v[0], v[1], v[2], v[3]);
          }
        }
      }
  }
};
struct EpiYp {
  h16* dst;
  DEVI void operator()(const f32x4 (&acc)[2][2][4][2], const g8::Unit& u, int wr, int wc, int fr, int fq) const {
#pragma unroll
    for (int ai = 0; ai < 2; ++ai)
#pragma unroll
      for (int m = 0; m < 4; ++m) {
        const int r = u.pm * 256 + 128 * ai + 64 * wr + 16 * m + fr;
        if (r < u.cnt) {
          h16* d = dst + (size_t)(u.off + r) * DM + u.pn * 256 + 32 * wc + 4 * fq;
#pragma unroll
          for (int bj = 0; bj < 2; ++bj)
#pragma unroll
            for (int n = 0; n < 2; ++n) { const f32x4 v = acc[ai][bj][m][n]; *(h16x4*)(d + 128 * bj + 16 * n) = pack4(v[0], v[1], v[2], v[3]); }
        }
      }
  }
};
DEVI void phase7(PRef p, LDS unsigned char* lds) {
  MoeOrder<true> S{p.ws, 2, DM, (int)gridDim.x, (int)blockIdx.x};
  EpiAct E{p.ws};
  g8::gemm_phase(lds, DM, S, E);
}
DEVI void phase8(PRef p, LDS unsigned char* lds) {
  MoeOrder<false> S{p.ws, 4, 256, (int)gridDim.x, (int)blockIdx.x};
  EpiYp E{(h16*)(p.ws + WS_YP)};
  g8::gemm_phase(lds, 256, S, E);
}

DEVI void phase9(PRef p, LDS unsigned char* lds) {
  const int tid = launder((int)threadIdx.x), lane = tid & 63, wave = wave_id(tid), G = gridDim.x;
  const int b = blockIdx.x & 3, bi = blockIdx.x >> 2, nbk = G >> 2;
  LDS unsigned* offs = (LDS unsigned*)lds;
  if (tid == 0) { const unsigned* cnt = (const unsigned*)(p.ws + WS_CNT); unsigned o = 0; for (int e = 0; e < 32; ++e) { offs[e] = o; o += cnt[e]; } }
  __syncthreads();
  LDS float* mv = (LDS float*)(lds + 256);
  mod_to_lds(p, b, 5, mv);
  __syncthreads();
  f32x4 A3[4];
#pragma unroll
  for (int j = 0; j < 4; ++j) { const int k = 256 * j + 4 * lane; A3[j] = *(LDS f32x4*)(mv + k) * *(const f32x4*)(p.in[7] + k); }
  const h16* YP = (const h16*)(p.ws + WS_YP); const u32x4* ROUTE = (const u32x4*)(p.ws + WS_ROUTE); float* out = p.out;
  const int rstep = nbk * 8, r_first = bi * 8 + wave;
  const int nrow = (SEQ - r_first + rstep - 1) / rstep;
  unsigned R0 = 0u, R1 = 0u;
  if (lane < nrow) { const u32x4 rt = ROUTE[(size_t)b * SEQ + r_first + rstep * lane]; R0 = offs[rt[0]] + rt[1]; R1 = offs[rt[2]] + rt[3]; }
  h16x4 ya[4], yc[4]; f32x4 xv[4];
  {
    const size_t tok = (size_t)b * SEQ + r_first; const size_t r0 = __builtin_amdgcn_readlane(R0, 0), r1 = __builtin_amdgcn_readlane(R1, 0);
#pragma unroll
    for (int j = 0; j < 4; ++j) { ya[j] = *(const h16x4*)(YP + r0 * DM + 256 * j + 4 * lane); yc[j] = *(const h16x4*)(YP + r1 * DM + 256 * j + 4 * lane); xv[j] = *(const f32x4*)(out + tok * DM + 256 * j + 4 * lane); }
  }
  for (int i = 0; i < nrow; ++i) {
    const size_t tok = (size_t)b * SEQ + r_first + rstep * i;
    h16x4 na[4], nc[4]; f32x4 nx[4];
    if (i + 1 < nrow) {
      const size_t r0 = __builtin_amdgcn_readlane(R0, i + 1), r1 = __builtin_amdgcn_readlane(R1, i + 1);
#pragma unroll
      for (int j = 0; j < 4; ++j) { na[j] = *(const h16x4*)(YP + r0 * DM + 256 * j + 4 * lane); nc[j] = *(const h16x4*)(YP + r1 * DM + 256 * j + 4 * lane); nx[j] = *(const f32x4*)(out + (tok + rstep) * DM + 256 * j + 4 * lane); }
    }
    f32x4 y[4]; float ss = 0.f;
#pragma unroll
    for (int j = 0; j < 4; ++j)
#pragma unroll
      for (int e = 0; e < 4; ++e) { y[j][e] = (float)ya[j][e] + (float)yc[j][e]; ss += y[j][e] * y[j][e]; }
    const float rs = 1.0f / sqrtf(wave_sum(ss) * (1.f / 1024.f) + 1e-6f);
#pragma unroll
    for (int j = 0; j < 4; ++j) *(f32x4*)(out + tok * DM + 256 * j + 4 * lane) = xv[j] + A3[j] * (y[j] * rs);
    if (i + 1 < nrow) {
#pragma unroll
      for (int j = 0; j < 4; ++j) { ya[j] = na[j]; yc[j] = nc[j]; xv[j] = nx[j]; }
    }
  }
}

#define XB_TMO      128
#define XB_XCNT(j)  (256  + 64 * (j))
#define XB_XSUB(j)  (1280 + 64 * (j))
#define XB_XGEN(j)  (2304 + 64 * (j))
#define XB_TOP      3328
#define XB_TOPGEN   3392
#define XB_SPIN_CAP (1u << 22)
DEVI unsigned xb_ld(unsigned* p)              { return __hip_atomic_load(p, __ATOMIC_RELAXED, __HIP_MEMORY_SCOPE_AGENT); }
DEVI unsigned xb_add(unsigned* p, unsigned v) { return __hip_atomic_fetch_add(p, v, __ATOMIC_RELAXED, __HIP_MEMORY_SCOPE_AGENT); }
DEVI unsigned xb_xcc_id() { return (unsigned)__builtin_amdgcn_s_getreg((3 << 11) | 20) & 0xFu; }
#define XB_SPIN(cond, bar) do { unsigned _sp = 0; while (cond) { __builtin_amdgcn_s_sleep(1); \
    if ((++_sp & 255u) == 0u) { if (xb_ld(&(bar)[XB_TMO])) break; if (_sp > XB_SPIN_CAP) { atomicAdd(&(bar)[XB_TMO], 1u); break; } } } } while (0)
struct XcdBarrier { unsigned* bar; unsigned x; volatile LDS unsigned* st; };
DEVI XcdBarrier xcd_barrier_post(unsigned* bar, volatile LDS unsigned* st) {
  XcdBarrier b; b.bar = bar; b.x = xb_xcc_id(); b.st = st;
  if (threadIdx.x == 0) (void)xb_add(&bar[XB_XCNT(b.x)], 1u);
  return b;
}
DEVI void xcd_barrier_complete(unsigned* bar, unsigned x, unsigned& nloc, unsigned& nx) {
  const unsigned G = gridDim.x * gridDim.y * gridDim.z;
  unsigned sum, cnt, mine, sp = 0u;
  for (;;) {
    sum = 0u; cnt = 0u; mine = 0u;
#pragma unroll
    for (unsigned j = 0; j < 16; ++j) { const unsigned c = xb_ld(&bar[XB_XCNT(j)]); sum += c; cnt += (c > 0u) ? 1u : 0u; mine = (j == x) ? c : mine; }
    if (sum == G) break;
    __builtin_amdgcn_s_sleep(1);
    if ((++sp & 255u) == 0u) { if (xb_ld(&bar[XB_TMO])) break; if (sp > XB_SPIN_CAP) { atomicAdd(&bar[XB_TMO], 1u); break; } }
  }
  nloc = mine > 0u ? mine : 1u; nx = cnt > 0u ? cnt : 1u;
}
DEVI void xcd_barrier(const XcdBarrier& b) {
  asm volatile("s_waitcnt vmcnt(0)" ::: "memory");
  __syncthreads();
  if (threadIdx.x == 0) {
    unsigned* bar = b.bar;
    __builtin_amdgcn_s_waitcnt(0);
    unsigned nloc = b.st[0], nx = b.st[1];
    if (nloc == 0u) { xcd_barrier_complete(bar, b.x, nloc, nx); b.st[0] = nloc; b.st[1] = nx; }
    const unsigned old = xb_add(&bar[XB_XSUB(b.x)], 1u);
    const unsigned gen = old / nloc;
    if (old + 1u == (gen + 1u) * nloc) {
      __builtin_amdgcn_fence(__ATOMIC_RELEASE, "agent");
      asm volatile("s_waitcnt vmcnt(0)" ::: "memory");
      const unsigned og = xb_add(&bar[XB_TOP], 1u);
      const unsigned tg = og / nx;
      if (og + 1u == (tg + 1u) * nx) xb_add(&bar[XB_TOPGEN], 1u);
      else XB_SPIN(xb_ld(&bar[XB_TOPGEN]) == tg, bar);
      __builtin_amdgcn_fence(__ATOMIC_ACQUIRE, "agent");
      xb_add(&bar[XB_XGEN(b.x)], 1u);
      asm volatile("s_waitcnt vmcnt(0)" ::: "memory");
    } else {
      XB_SPIN(xb_ld(&bar[XB_XGEN(b.x)]) == gen, bar);
      __builtin_amdgcn_fence(__ATOMIC_ACQUIRE, "agent");
      asm volatile("s_waitcnt vmcnt(0)" ::: "memory");
    }
  }
  __syncthreads();
}

__global__ void __launch_bounds__(NTHR) fwd_kernel(Params p) {
  extern __shared__ __attribute__((aligned(16))) unsigned char smem[];
  LDS unsigned char* lds = (LDS unsigned char*)smem;
  const int lo = p.ph_lo, hi = p.ph_hi;
  volatile LDS unsigned* bst = (volatile LDS unsigned*)(lds + LDS_BYTES - 16);
  if (threadIdx.x < 4) bst[threadIdx.x] = 0u;
  __syncthreads();
  (void)xcd_barrier_post((unsigned*)(p.ws + WS_BAR), bst);
#ifndef REPEAT_PHASE
#define REPEAT_PHASE -1
#endif
#define GRID_SYNC(k) do { if ((k) == 0) cg::this_grid().sync(); else { XcdBarrier xb_; xb_.bar = (unsigned*)(get_params()->ws + WS_BAR); xb_.x = xb_xcc_id(); xb_.st = (volatile LDS unsigned*)(lds + LDS_BYTES - 16); xcd_barrier(xb_); } } while (0)
#define RUN_PHASE(k, fn) if (lo <= (k) && (k) < hi) { fn(*get_params(), lds); if ((k) == REPEAT_PHASE) { GRID_SYNC(k); fn(*get_params(), lds); } if ((k) + 1 < hi) GRID_SYNC(k); }
  RUN_PHASE(0, phase0)
  RUN_PHASE(1, phase1)
  RUN_PHASE(2, phase2)
  RUN_PHASE(3, phase3)
  RUN_PHASE(4, phase4)
  RUN_PHASE(5, phase5)
  RUN_PHASE(6, phase6)
  RUN_PHASE(7, phase7)
  RUN_PHASE(8, phase8)
  RUN_PHASE(9, phase9)
#undef GRID_SYNC
#undef RUN_PHASE
}

extern "C" void kernel_launch(void* const* d_in, const int* in_sizes, int n_in, void* d_out, int out_size, void* d_ws, size_t ws_size, hipStream_t stream) {
  static int grid = 0;
  if (grid == 0) {
    if (n_in != 24 || out_size != NTOK * DM || ws_size < WS_END) { fprintf(stderr, "kernel_launch: unexpected problem (n_in %d out %d ws %zu)\n", n_in, out_size, ws_size); grid = -1; return; }
    (void)hipFuncSetAttribute((const void*)fwd_kernel, hipFuncAttributeMaxDynamicSharedMemorySize, LDS_BYTES);
    int dev = 0, cus = 0, per_cu = 0;
    (void)hipGetDevice(&dev);
    (void)hipDeviceGetAttribute(&cus, hipDeviceAttributeMultiprocessorCount, dev);
    (void)hipOccupancyMaxActiveBlocksPerMultiprocessor(&per_cu, (const void*)fwd_kernel, NTHR, LDS_BYTES);
    if (per_cu < 1 || cus < 256) fprintf(stderr, "kernel_launch: occupancy %d blocks/CU on %d CUs\n", per_cu, cus);
    grid = 256;
  }
  if (grid < 0) return;
  (void)hipMemsetAsync((char*)d_ws + WS_CNT, 0, CTL_ZERO_BYTES, stream);
  Params p{};
  for (int i = 0; i < 24; ++i) p.in[i] = (const float*)d_in[i];
  p.out = (float*)d_out; p.ws = (unsigned char*)d_ws;
#if N_LAUNCH_MODE == 1
  p.ph_lo = 0; p.ph_hi = NPHASE;
  void* args[] = {&p};
  hipError_t e = hipLaunchCooperativeKernel((const void*)fwd_kernel, dim3(grid), dim3(NTHR), args, LDS_BYTES, stream);
  if (e != hipSuccess) fprintf(stderr, "cooperative launch failed: %s\n", hipGetErrorString(e));
#else
  for (int ph = 0; ph < NPHASE; ++ph) {
    p.ph_lo = ph; p.ph_hi = ph + 1;
    hipLaunchKernelGGL(fwd_kernel, dim3(grid), dim3(NTHR), LDS_BYTES, stream, p);
  }
#endif
}
```

```cpp
#include <hip/hip_runtime.h>
#include <hip/hip_cooperative_groups.h>
#include <cstdio>
#include <cstdint>
namespace cg = cooperative_groups;

#ifndef N_LAUNCH_MODE
#define N_LAUNCH_MODE 1
#endif

#define DEVI __device__ __forceinline__
#define LDS __attribute__((address_space(3)))

typedef _Float16 h16;
typedef _Float16 h16x4 __attribute__((ext_vector_type(4)));
typedef _Float16 h16x8 __attribute__((ext_vector_type(8)));
typedef float f32x4 __attribute__((ext_vector_type(4)));
typedef float f32x16 __attribute__((ext_vector_type(16)));
typedef unsigned u32x2 __attribute__((ext_vector_type(2)));
typedef unsigned u32x4 __attribute__((ext_vector_type(4)));

constexpr int NBATCH = 4, SEQ = 8192, NTOK = NBATCH * SEQ, DM = 1024;
constexpr int NTHR = 512;
constexpr int NPHASE = 10;
constexpr int LDS_BYTES = 163840;

constexpr size_t MiB = 1ull << 20;
constexpr size_t WS_CNT = 0;
constexpr size_t CTL_ZERO_BYTES = 20480;
constexpr size_t WS_BAR = 4096;
constexpr size_t WS_MODP = 64 * 1024;
constexpr size_t WS_ROPE = 1 * MiB;
constexpr size_t WS_WIN = 3 * MiB;
constexpr size_t WS_WOUT = 10 * MiB;
constexpr size_t WS_WGU = 12 * MiB;
constexpr size_t WS_WDN = 44 * MiB;
constexpr size_t WS_WRG = 60 * MiB;
constexpr size_t WS_WRT = 60 * MiB + 256 * 1024;
constexpr size_t WS_WRH = 60 * MiB + 512 * 1024;
constexpr size_t WS_WRL = 60 * MiB + 640 * 1024;
constexpr size_t WS_AGG = 61 * MiB;
constexpr size_t WS_ROUTE = 63 * MiB;
constexpr size_t WS_LIST = 64 * MiB;
constexpr size_t WS_LISTW = 68 * MiB;
constexpr size_t WS_WI = 72 * MiB;
constexpr size_t WS_KI = 73 * MiB;
constexpr size_t WS_MASK = 77 * MiB;
constexpr size_t WS_H = 109 * MiB;
constexpr size_t WS_Q = 173 * MiB;
constexpr size_t WS_K = 205 * MiB;
constexpr size_t WS_VT = 237 * MiB;
constexpr size_t WS_QI = 269 * MiB;
constexpr size_t WS_XR = 301 * MiB;
constexpr size_t WS_XG = 333 * MiB;
constexpr size_t WS_MIX = 365 * MiB;
constexpr size_t WS_ACT = 429 * MiB;
constexpr size_t WS_YP = 173 * MiB;
constexpr size_t WS_END = 462 * MiB;

struct Params { const float* in[24]; float* out; unsigned char* ws; int ph_lo, ph_hi; };
typedef const __attribute__((address_space(4))) Params& PRef;
typedef const __attribute__((address_space(4))) Params* PPtr;

__device__ const double ROPE_REV[32] = {
  1.59154943091895345608e-01, 1.19349370211248861917e-01, 8.94994016088910132600e-02, 6.71150830052272551196e-02,
  5.03292121044870352509e-02, 3.77415847174197710556e-02, 2.83021958306233986646e-02, 2.12236527647776604399e-02,
  1.59154943091895338669e-02, 1.19349370211248861917e-02, 8.94994016088910236684e-03, 6.71150830052272533849e-03,
  5.03292121044870369856e-03, 3.77415847174197719230e-03, 2.83021958306233986646e-03, 2.12236527647776621747e-03,
  1.59154943091895356017e-03, 1.19349370211248848907e-03, 8.94994016088910236684e-04, 6.71150830052272598901e-04,
  5.03292121044870326488e-04, 3.77415847174197740914e-04, 2.83021958306233954120e-04, 2.12236527647776605484e-04,
  1.59154943091895350596e-04, 1.19349370211248862459e-04, 8.94994016088910182474e-05, 6.71150830052272544691e-05,
  5.03292121044870353593e-05, 3.77415847174197768019e-05, 2.83021958306233960897e-05, 2.12236527647776591931e-05};

DEVI int launder(int x) { asm volatile("" : "+v"(x)); return x; }
DEVI PPtr get_params() { PPtr k = (PPtr)__builtin_amdgcn_kernarg_segment_ptr(); asm volatile("" : "+s"(k)); return k; }
DEVI int wave_id(int tid) { return __builtin_amdgcn_readfirstlane(tid >> 6); }
DEVI f32x16 mfma16(h16x8 a, h16x8 b, f32x16 c) { return __builtin_amdgcn_mfma_f32_32x32x16_f16(a, b, c, 0, 0, 0); }
DEVI float wave_sum(float v) {
#pragma unroll
  for (int o = 1; o < 64; o <<= 1) v += __shfl_xor(v, o);
  return v;
}
DEVI float sigmoid_f(float x) { return __builtin_amdgcn_rcpf(1.f + __expf(-x)); }
DEVI float silu_f(float x) { return x * __builtin_amdgcn_rcpf(1.f + __expf(-x)); }
DEVI float gelu_tanh_f(float x) {
  const float u = 0.7978845608028654f * (x + 0.044715f * x * x * x);
  const float t = 1.f - 2.f * __builtin_amdgcn_rcpf(1.f + __expf(2.f * u));
  return 0.5f * x * (1.f + t);
}
DEVI unsigned fkey(float f) { unsigned u = __float_as_uint(f); return (u & 0x80000000u) ? ~u : (u | 0x80000000u); }
DEVI float fkey_inv(unsigned k) { unsigned u = (k & 0x80000000u) ? (k & 0x7fffffffu) : ~k; return __uint_as_float(u); }
DEVI int vt_perm(int pos) { return (pos & ~12) | ((pos & 4) << 1) | ((pos & 8) >> 1); }

DEVI void mod_to_lds(PRef p, int b, int chunk, LDS float* dst) {
  const float* mp = (const float*)(p.ws + WS_MODP);
  for (int k = threadIdx.x; k < 1024; k += NTHR) {
    const int j = chunk * 1024 + k;
    float s = p.in[3][j];
#pragma unroll 1
    for (int ks = 0; ks < 8; ++ks) s += mp[(size_t)(ks * 4 + b) * 6144 + j];
    dst[k] = s;
  }
}

constexpr int LROW = 144;
constexpr int GA_BYTES = 256 * LROW, GB_BYTES = 128 * LROW, GSTAGE = GA_BYTES + GB_BYTES;

template <class AR, class EPI>
DEVI void gemm_tile(LDS unsigned char* lds, const AR& arow, const h16* Bt, int ldb, int K, EPI& epi) {
  const int tid = launder((int)threadIdx.x), lane = tid & 63, wave = wave_id(tid), wm = wave >> 1, wn = wave & 1;
  const int lr = tid >> 3, lc = tid & 7, l31 = lane & 31, half = lane >> 5;
  const h16* pa[4]; const h16* pb[2];
#pragma unroll
  for (int j = 0; j < 4; ++j) pa[j] = arow(lr + 64 * j) + lc * 8;
#pragma unroll
  for (int j = 0; j < 2; ++j) pb[j] = Bt + (size_t)(lr + 64 * j) * ldb + lc * 8;
  h16x8 ra[4], rb[2];
#pragma unroll
  for (int j = 0; j < 4; ++j) ra[j] = *(const h16x8*)pa[j];
#pragma unroll
  for (int j = 0; j < 2; ++j) rb[j] = *(const h16x8*)pb[j];
#pragma unroll
  for (int j = 0; j < 4; ++j) *(LDS h16x8*)(lds + (lr + 64 * j) * LROW + lc * 16) = ra[j];
#pragma unroll
  for (int j = 0; j < 2; ++j) *(LDS h16x8*)(lds + GA_BYTES + (lr + 64 * j) * LROW + lc * 16) = rb[j];
  __syncthreads();
  f32x16 acc[2][2];
#pragma unroll
  for (int a = 0; a < 2; ++a)
#pragma unroll
    for (int b = 0; b < 2; ++b)
#pragma unroll
      for (int r = 0; r < 16; ++r) acc[a][b][r] = 0.f;
  const int KT = K >> 6;
  for (int kt = 0; kt < KT; ++kt) {
    const int cur = kt & 1;
    if (kt + 1 < KT) {
#pragma unroll
      for (int j = 0; j < 4; ++j) ra[j] = *(const h16x8*)(pa[j] + (kt + 1) * 64);
#pragma unroll
      for (int j = 0; j < 2; ++j) rb[j] = *(const h16x8*)(pb[j] + (kt + 1) * 64);
    }
    LDS unsigned char* A = lds + cur * GSTAGE;
    LDS unsigned char* B = A + GA_BYTES;
#pragma unroll
    for (int kk = 0; kk < 4; ++kk) {
      h16x8 af[2], bf[2];
#pragma unroll
      for (int mi = 0; mi < 2; ++mi) af[mi] = *(LDS h16x8*)(A + (64 * wm + 32 * mi + l31) * LROW + (2 * kk + half) * 16);
#pragma unroll
      for (int ni = 0; ni < 2; ++ni) bf[ni] = *(LDS h16x8*)(B + (64 * wn + 32 * ni + l31) * LROW + (2 * kk + half) * 16);
#pragma unroll
      for (int mi = 0; mi < 2; ++mi)
#pragma unroll
        for (int ni = 0; ni < 2; ++ni) acc[mi][ni] = mfma16(bf[ni], af[mi], acc[mi][ni]);
    }
    if (kt + 1 < KT) {
      LDS unsigned char* A2 = lds + (cur ^ 1) * GSTAGE;
#pragma unroll
      for (int j = 0; j < 4; ++j) *(LDS h16x8*)(A2 + (lr + 64 * j) * LROW + lc * 16) = ra[j];
#pragma unroll
      for (int j = 0; j < 2; ++j) *(LDS h16x8*)(A2 + GA_BYTES + (lr + 64 * j) * LROW + lc * 16) = rb[j];
    }
    __syncthreads();
  }
  epi(acc, wm, wn, lane);
}


namespace g8 {
constexpr int BM = 256, BK = 64, HALF = 128, HTB = HALF * BK * 2, STAGE_BYTES = 8 * HTB;
DEVI int lds_byte(int r, int c) { const int st = (r >> 4) * 2 + (c >> 5), rr = r & 15, cc = c & 31, ob = rr * 64 + cc * 2; return st * 1024 + (ob ^ (((ob >> 9) & 1) << 5)); }
DEVI void stage_rc(int b, int& R, int& C) { const int st = b / 1024, sb = b % 1024, swz = sb ^ (((sb >> 9) & 1) << 5); R = (st >> 1) * 16 + swz / 64; C = (st & 1) * 32 + (swz % 64) / 2; }
struct Unit { const char* A; unsigned va[2][2]; const char* B; int pm, pn, e, cnt, off; };
DEVI void glds16(const char* src, LDS unsigned char* dst) { __builtin_amdgcn_global_load_lds((const unsigned*)src, (LDS unsigned*)dst, 16, 0, 0); }

DEVI void dense_va(unsigned (&va)[2][2], int K) {
  const int tid = threadIdx.x;
#pragma unroll
  for (int h = 0; h < 2; ++h)
#pragma unroll
    for (int i = 0; i < 2; ++i) { int R, C; stage_rc(tid * 16 + i * 8192, R, C); va[h][i] = (unsigned)((128 * h + R) * K + C) * 2u; }
}
template <class Sched, class Epi>
DEVI void gemm_phase(LDS unsigned char* lds, int K, const Sched& S, const Epi& E) {
  const int tid = launder((int)threadIdx.x), wid = wave_id(tid), lane = tid & 63, wr = wid >> 2, wc = wid & 3, fr = lane & 15, fq = lane >> 4;
  const int nt = launder(K) / BK;
  unsigned vb[2];
#pragma unroll
  for (int i = 0; i < 2; ++i) { int R, C; stage_rc(tid * 16 + i * 8192, R, C); vb[i] = (unsigned)(R * K + C) * 2u; }
  const size_t kstep = (size_t)(BK * 2), hstep = (size_t)HALF * K * 2;
  const unsigned ldsw = (unsigned)wid * 1024u;
  const int aoff = lds_byte(wr * 64 + fr, fq * 8), boff = lds_byte(wc * 32 + fr, fq * 8);
#define G8_SA(b, h) (((b) * 2 + (h)) * HTB)
#define G8_SB(b, h) ((4 + (b) * 2 + (h)) * HTB)
#define G8_STAGE(bufoff, gbase, v) do { glds16((gbase) + (v)[0], lds + (bufoff) + ldsw); glds16((gbase) + (v)[1], lds + (bufoff) + ldsw + 8192); } while (0)
#define G8_STAGEA(bufoff, gbase, h) do { glds16((gbase) + G8_VAC(h, 0), lds + (bufoff) + ldsw); glds16((gbase) + G8_VAC(h, 1), lds + (bufoff) + ldsw + 8192); } while (0)
#define G8_LDA(dst, b, h) do { _Pragma("unroll") for (int m = 0; m < 4; ++m) _Pragma("unroll") for (int k = 0; k < 2; ++k) dst[m][k] = *(const LDS h16x8*)(lds + G8_SA(b, h) + aoff + m * 2048 + k * 1024); } while (0)
#define G8_LDB(dst, b, h) do { _Pragma("unroll") for (int n = 0; n < 2; ++n) _Pragma("unroll") for (int k = 0; k < 2; ++k) dst[n][k] = *(const LDS h16x8*)(lds + G8_SB(b, h) + boff + n * 2048 + k * 1024); } while (0)
#define G8_MMA(ai, bj, At, Bt) do { __builtin_amdgcn_s_setprio(1); _Pragma("unroll") for (int m = 0; m < 4; ++m) _Pragma("unroll") for (int n = 0; n < 2; ++n) _Pragma("unroll") for (int k = 0; k < 2; ++k) \
        acc[ai][bj][m][n] = __builtin_amdgcn_mfma_f32_16x16x32_f16(Bt[n][k], At[m][k], acc[ai][bj][m][n], 0, 0, 0); __builtin_amdgcn_s_setprio(0); } while (0)
#define G8_WAIT_V(n) asm volatile("s_waitcnt vmcnt(" #n ")" ::: "memory")
#define G8_WAIT_L(n) asm volatile("s_waitcnt lgkmcnt(" #n ")" ::: "memory")
#define G8_BAR __builtin_amdgcn_s_barrier()
#define G8_SCHED __builtin_amdgcn_sched_barrier(0)
  Unit cur, nxt; int ui = 0;
  if (!S.next(0, cur)) return;
  unsigned vd[2][2];
  if (!Sched::GATHER) dense_va(vd, K);
#define G8_VAC(h, i) (Sched::GATHER ? cur.va[h][i] : vd[h][i])
#define G8_VAN(h, i) (Sched::GATHER ? nxt.va[h][i] : vd[h][i])
  f32x4 acc[2][2][4][2];
#pragma unroll
  for (int a = 0; a < 2; ++a)
#pragma unroll
    for (int b = 0; b < 2; ++b)
#pragma unroll
      for (int m = 0; m < 4; ++m)
#pragma unroll
        for (int n = 0; n < 2; ++n) acc[a][b][m][n] = (f32x4){0.f, 0.f, 0.f, 0.f};
  h16x8 At[4][2], B0[2][2], B1[2][2];
  const char* cA = cur.A; const char* cB = cur.B;
  G8_STAGE(G8_SB(0, 0), cB, vb); G8_STAGE(G8_SB(0, 1), cB + hstep, vb); G8_STAGEA(G8_SA(0, 0), cA, 0); G8_STAGEA(G8_SA(0, 1), cA, 1);
  if (wr == 1) G8_BAR;
  G8_WAIT_V(2); G8_BAR;
  G8_STAGE(G8_SB(1, 0), cB + kstep, vb); G8_STAGEA(G8_SA(1, 0), cA + kstep, 0); G8_STAGE(G8_SB(1, 1), cB + hstep + kstep, vb);
  G8_WAIT_V(6); G8_BAR;
  for (;;) {
    const bool has_next = S.next(ui + 1, nxt);
    if (!has_next) nxt = cur;
    const char* nA = nxt.A; const char* nB = nxt.B;
#pragma unroll 1
    for (int t = 0; t < nt; t += 2) {
      const bool last = (t == nt - 2);
      const char* a1 = cA + (size_t)(t + 1) * kstep;
      const char* a2 = last ? nA : cA + (size_t)(t + 2) * kstep; const char* b2 = last ? nB : cB + (size_t)(t + 2) * kstep;
      const char* a3 = a2 + kstep; const char* b3 = b2 + kstep;
#define G8_STAGE2(bufoff, gbase, h) do { glds16((gbase) + (last ? G8_VAN(h, 0) : G8_VAC(h, 0)), lds + (bufoff) + ldsw); glds16((gbase) + (last ? G8_VAN(h, 1) : G8_VAC(h, 1)), lds + (bufoff) + ldsw + 8192); } while (0)
      G8_LDB(B0, 0, 0); G8_LDB(B1, 0, 1); G8_SCHED; G8_LDA(At, 0, 0); G8_STAGEA(G8_SA(1, 1), a1, 1);
      G8_WAIT_V(8); G8_WAIT_L(0); G8_BAR; G8_MMA(0, 0, At, B0); G8_MMA(0, 1, At, B1); G8_BAR; G8_SCHED;
      G8_LDA(At, 0, 1); G8_STAGE(G8_SB(0, 0), b2, vb); G8_STAGE(G8_SB(0, 1), b2 + hstep, vb); G8_STAGE2(G8_SA(0, 0), a2, 0);
      G8_WAIT_V(8); G8_WAIT_L(0); G8_BAR; G8_MMA(1, 0, At, B0); G8_MMA(1, 1, At, B1); G8_BAR; G8_SCHED;
      G8_LDB(B0, 1, 0); G8_LDB(B1, 1, 1); G8_SCHED; G8_LDA(At, 1, 0); G8_STAGE2(G8_SA(0, 1), a2, 1);
      G8_WAIT_V(8); G8_WAIT_L(0); G8_BAR; G8_MMA(0, 0, At, B0); G8_MMA(0, 1, At, B1); G8_BAR; G8_SCHED;
      G8_LDA(At, 1, 1); G8_STAGE(G8_SB(1, 0), b3, vb); G8_STAGE(G8_SB(1, 1), b3 + hstep, vb); G8_STAGE2(G8_SA(1, 0), a3, 0);
      G8_WAIT_V(8); G8_WAIT_L(0); G8_BAR; G8_MMA(1, 0, At, B0); G8_MMA(1, 1, At, B1); G8_BAR; G8_SCHED;
    }
#undef G8_STAGE2
    if (wr == 0) G8_BAR;
    E(acc, cur, wr, wc, fr, fq);
    if (!has_next) break;
#pragma unroll
    for (int a = 0; a < 2; ++a)
#pragma unroll
      for (int b = 0; b < 2; ++b)
#pragma unroll
        for (int m = 0; m < 4; ++m)
#pragma unroll
          for (int n = 0; n < 2; ++n) acc[a][b][m][n] = (f32x4){0.f, 0.f, 0.f, 0.f};
    cur = nxt; cA = nA; cB = nB; ++ui;
    if (wr == 1) G8_BAR;
  }
  G8_WAIT_V(0);
  G8_BAR;
#undef G8_SA
#undef G8_STAGEA
#undef G8_VAC
#undef G8_VAN
#undef G8_SB
#undef G8_STAGE
#undef G8_LDA
#undef G8_LDB
#undef G8_MMA
#undef G8_WAIT_V
#undef G8_WAIT_L
#undef G8_BAR
#undef G8_SCHED
}
struct DenseOrder {
  static constexpr bool GATHER = false;
  const h16* A; const h16* Bt; int K, nM, nN, G, c;
  DEVI bool next(int i, Unit& u) const {
    const int nwg = nM * nN; const long L = (long)i * G + c; if (L >= nwg) return false;
    int wgid = (int)L; { const int q = nwg / 8, r = nwg % 8, xcd = wgid % 8, off = wgid / 8; wgid = (xcd < r ? xcd * (q + 1) : r * (q + 1) + (xcd - r) * q) + off; }
    const int nig = 8 * nN, gid = wgid / nig, fm = gid * 8, gsz = (nM - fm) < 8 ? (nM - fm) : 8;
    u.pm = fm + ((wgid % nig) % gsz); u.pn = (wgid % nig) / gsz; u.e = 0; u.cnt = 0x7fffffff; u.off = 0;
    u.A = (const char*)(A + (size_t)u.pm * 256 * K); u.B = (const char*)(Bt + (size_t)u.pn * 256 * K);
    u.va[0][0] = u.va[0][1] = u.va[1][0] = u.va[1][1] = 0u;
    return true;
  }
};
}

struct ARowPlain { const h16* base; size_t ld; DEVI const h16* operator()(int r) const { return base + (size_t)r * ld; } };
struct ARowGather { const h16* base; const unsigned* list; int n; int row0; DEVI const h16* operator()(int r) const { const int i = row0 + r; const unsigned t = (i < n) ? list[i] : 0u; return base + (size_t)t * DM; } };

DEVI h16x4 pack4(float a, float b, float c, float d) { h16x4 v; v[0] = (h16)a; v[1] = (h16)b; v[2] = (h16)c; v[3] = (h16)d; return v; }

template <class F>
DEVI void transpose_item(const float* src, int N, int kb, int nb, h16* dst, int ldd, F drow, LDS float* scr, int lane) {
#pragma unroll 8
  for (int i = 0; i < 32; ++i) {
    const int kk = 2 * i + (lane >> 5), n = nb * 32 + (lane & 31);
    scr[kk * 33 + (lane & 31)] = (n < N) ? src[(size_t)(kb * 64 + kk) * N + n] : 0.f;
  }
  asm volatile("s_waitcnt lgkmcnt(0)" ::: "memory");
  const int c = lane & 7;
#pragma unroll
  for (int j = 0; j < 4; ++j) {
    const int nl = (lane >> 3) + 8 * j, n = nb * 32 + nl;
    h16x8 v;
#pragma unroll
    for (int e = 0; e < 8; ++e) v[e] = (h16)scr[(c * 8 + e) * 33 + nl];
    if (n < N) *(h16x8*)(dst + (size_t)drow(n) * ldd + kb * 64 + c * 8) = v;
  }
  asm volatile("s_waitcnt lgkmcnt(0)" ::: "memory");
}

DEVI void phase0(PRef p, LDS unsigned char* lds) {
  const int tid = launder((int)threadIdx.x), lane = tid & 63, wave = wave_id(tid), G = gridDim.x;
  const int gw = blockIdx.x * 8 + wave, NW = G * 8;
  {
    const float* c = p.in[1]; const float* wada = p.in[2]; float* mp = (float*)(p.ws + WS_MODP);
    for (int u = gw; u < 96 * 8; u += NW) {
      const int cgp = u % 96, ks = u / 96, j = cgp * 64 + lane;
      float a0 = 0.f, a1 = 0.f, a2 = 0.f, a3 = 0.f;
      for (int k = ks * 128; k < ks * 128 + 128; ++k) {
        const float w = wada[(size_t)k * 6144 + j];
        a0 = fmaf(silu_f(c[k]), w, a0); a1 = fmaf(silu_f(c[1024 + k]), w, a1);
        a2 = fmaf(silu_f(c[2048 + k]), w, a2); a3 = fmaf(silu_f(c[3072 + k]), w, a3);
      }
      mp[(size_t)(ks * 4 + 0) * 6144 + j] = a0; mp[(size_t)(ks * 4 + 1) * 6144 + j] = a1;
      mp[(size_t)(ks * 4 + 2) * 6144 + j] = a2; mp[(size_t)(ks * 4 + 3) * 6144 + j] = a3;
    }
  }
  {
    LDS float* scr = (LDS float*)lds + wave * (64 * 33);
    constexpr int I_IN = 16 * 99, I_OUT = 16 * 32, I_G = 32 * 128, I_U = 32 * 128, I_D = 32 * 128, I_RG = 32;
    constexpr int NIT = I_IN + I_OUT + I_G + I_U + I_D + I_RG;
    for (int it = gw; it < NIT; it += NW) {
      int r = it;
      if (r < I_IN) {
        transpose_item(p.in[8], 3144, r / 99, r % 99, (h16*)(p.ws + WS_WIN), 1024,
                       [](int n) { const int dl = n < 2112 ? n : (n < 2120 ? 3136 + (n - 2112) : (n < 2632 ? 2112 + (n - 2120) : 2624 + (n - 2632))); const int d = dl & 63; return (dl & ~63) + 32 * ((d >> 4) & 1) + 16 * (d >> 5) + (d & 15); }, scr, lane);
        continue;
      }
      r -= I_IN;
      if (r < I_OUT) { transpose_item(p.in[16], 1024, r / 32, r % 32, (h16*)(p.ws + WS_WOUT), 1024, [](int n) { return n; }, scr, lane); continue; }
      r -= I_OUT;
      if (r < I_G) { const int e = r >> 7, q = r & 127;
        transpose_item(p.in[21] + (size_t)e * 1024 * 256, 256, q >> 3, q & 7, (h16*)(p.ws + WS_WGU) + (size_t)e * 512 * 1024, 1024, [](int f) { return (f >> 4) * 32 + (f & 15); }, scr, lane); continue; }
      r -= I_G;
      if (r < I_U) { const int e = r >> 7, q = r & 127;
        transpose_item(p.in[22] + (size_t)e * 1024 * 256, 256, q >> 3, q & 7, (h16*)(p.ws + WS_WGU) + (size_t)e * 512 * 1024, 1024, [](int f) { return (f >> 4) * 32 + 16 + (f & 15); }, scr, lane); continue; }
      r -= I_U;
      if (r < I_D) { const int e = r >> 7, q = r & 127;
        transpose_item(p.in[23] + (size_t)e * 256 * 1024, 1024, q >> 5, q & 31, (h16*)(p.ws + WS_WDN) + (size_t)e * 1024 * 256, 256, [](int n) { return n; }, scr, lane); continue; }
      r -= I_D;
      if (r < 16) transpose_item(p.in[11] + (size_t)(r >> 1) * 4096, 64, 0, r & 1, (h16*)(p.ws + WS_WRG) + (size_t)(r >> 1) * 128 * 64, 64, [](int n) { return n; }, scr, lane);
      else transpose_item(p.in[13] + (size_t)((r - 16) >> 1) * 4096, 64, 0, r & 1, (h16*)(p.ws + WS_WRG) + (size_t)((r - 16) >> 1) * 128 * 64, 64, [](int n) { return 64 + n; }, scr, lane);
    }
  }
  {
    h16* wrh = (h16*)(p.ws + WS_WRH); h16* wrl = (h16*)(p.ws + WS_WRL);
    for (int i = blockIdx.x * NTHR + tid; i < 48 * 1024; i += G * NTHR) {
      const int col = i >> 10, k = i & 1023;
      const float w = (col < 4) ? p.in[17][k * 4 + col] : (col < 36 ? p.in[19][k * 32 + (col - 4)] : 0.f);
      const h16 hi = (h16)w;
      wrh[i] = hi; wrl[i] = (h16)(w - (float)hi);
    }
    float* ct = (float*)(p.ws + WS_ROPE); float* st = ct + 8192 * 32;
    for (int i = blockIdx.x * NTHR + tid; i < 8192 * 32; i += G * NTHR) {
      const int pos = i >> 5, f = i & 31;
      const double rev = (double)pos * ROPE_REV[f];
      const float fr = (float)(rev - __builtin_rint(rev));
      ct[i] = __builtin_amdgcn_cosf(fr); st[i] = __builtin_amdgcn_sinf(fr);
    }
  }
}

DEVI void phase1(PRef p, LDS unsigned char* lds) {
  const int tid = launder((int)threadIdx.x), lane = tid & 63, wave = wave_id(tid), G = gridDim.x;
  const int b = blockIdx.x & 3, bi = blockIdx.x >> 2, nbk = G >> 2;
  LDS float* mv = (LDS float*)lds;
  mod_to_lds(p, b, 0, mv); mod_to_lds(p, b, 1, mv + 1024);
  __syncthreads();
  f32x4 A[4], SH[4];
#pragma unroll
  for (int j = 0; j < 4; ++j) {
    const int k = 256 * j + 4 * lane;
    const f32x4 g = *(const f32x4*)(p.in[4] + k);
    A[j] = g * (*(LDS f32x4*)(mv + 1024 + k) + 1.f);
    SH[j] = *(LDS f32x4*)(mv + k);
  }
  const float* x = p.in[0]; h16* H = (h16*)(p.ws + WS_H);
  for (int r = bi * 8 + wave; r < SEQ; r += nbk * 8) {
    const size_t tok = (size_t)b * SEQ + r;
    f32x4 v[4]; float ss = 0.f;
#pragma unroll
    for (int j = 0; j < 4; ++j) { v[j] = *(const f32x4*)(x + tok * DM + 256 * j + 4 * lane); ss += v[j][0] * v[j][0] + v[j][1] * v[j][1] + v[j][2] * v[j][2] + v[j][3] * v[j][3]; }
    const float rstd = 1.0f / sqrtf(wave_sum(ss) * (1.f / 1024.f) + 1e-6f);
#pragma unroll
    for (int j = 0; j < 4; ++j) {
      const f32x4 y = v[j] * rstd * A[j] + SH[j];
      *(h16x4*)(H + tok * DM + 256 * j + 4 * lane) = pack4(y[0], y[1], y[2], y[3]);
    }
  }
}

struct EpiInProj {
  unsigned char* ws;
  DEVI void operator()(const f32x4 (&acc)[2][2][4][2], const g8::Unit& u, int wr, int wc, int fr, int fq) const {
    const float* cosT = (const float*)(ws + WS_ROPE); const float* sinT = cosT + 8192 * 32;
    const int w2 = wc & 1, dlow = 16 * w2 + 4 * fq;
#pragma unroll
    for (int bj = 0; bj < 2; ++bj) {
      const int g = 4 * u.pn + 2 * bj + (wc >> 1);
      if (g > 49) continue;
#pragma unroll
      for (int ai = 0; ai < 2; ++ai)
#pragma unroll
        for (int m = 0; m < 4; ++m) {
          const int tok = u.pm * 256 + 128 * ai + 64 * wr + 16 * m + fr;
          const int b = tok >> 13, pos = tok & 8191;
          const f32x4 x1 = acc[ai][bj][m][0], x2 = acc[ai][bj][m][1];
          if (g < 16 || (g >= 24 && g <= 32)) {
            float scl; h16* dst;
            if (g < 8) { scl = 0.125f * 1.4426950408889634f; dst = (h16*)(ws + WS_Q) + (size_t)tok * 512 + g * 64; }
            else if (g < 16) { scl = 1.f; dst = (h16*)(ws + WS_K) + (size_t)tok * 512 + (g - 8) * 64; }
            else if (g < 32) { scl = 0.125f; dst = (h16*)(ws + WS_QI) + (size_t)tok * 512 + (g - 24) * 64; }
            else { scl = 1.f; dst = (h16*)(ws + WS_KI) + (size_t)tok * 64; }
            const f32x4 c = *(const f32x4*)(cosT + pos * 32 + dlow), s = *(const f32x4*)(sinT + pos * 32 + dlow);
            const f32x4 o1 = (x1 * c - x2 * s) * scl, o2 = (x2 * c + x1 * s) * scl;
            *(h16x4*)(dst + dlow) = pack4(o1[0], o1[1], o1[2], o1[3]);
            *(h16x4*)(dst + 32 + dlow) = pack4(o2[0], o2[1], o2[2], o2[3]);
          } else if (g < 24) {
            h16* vt = (h16*)(ws + WS_VT) + (size_t)(b * 8 + (g - 16)) * 64 * 8192 + vt_perm(pos);
#pragma unroll
            for (int e = 0; e < 4; ++e) { vt[(size_t)(dlow + e) * 8192] = (h16)x1[e]; vt[(size_t)(32 + dlow + e) * 8192] = (h16)x2[e]; }
          } else if (g < 49) {
            h16* dst = (g < 41) ? (h16*)(ws + WS_XR) + (size_t)tok * 512 + (g - 33) * 64 : (h16*)(ws + WS_XG) + (size_t)tok * 512 + (g - 41) * 64;
            *(h16x4*)(dst + dlow) = pack4(x1[0], x1[1], x1[2], x1[3]);
            *(h16x4*)(dst + 32 + dlow) = pack4(x2[0], x2[1], x2[2], x2[3]);
          } else if (w2 == 0 && fq < 2) {
            const float sc = 0.35355339059327373f;
            *(f32x4*)((float*)(ws + WS_WI) + (size_t)tok * 8 + 4 * fq) = x1 * sc;
          }
        }
    }
  }
};

DEVI void phase2(PRef p, LDS unsigned char* lds) {
  g8::DenseOrder S{(const h16*)(p.ws + WS_H), (const h16*)(p.ws + WS_WIN), DM, 128, 13, (int)gridDim.x, (int)blockIdx.x};
  EpiInProj E{p.ws};
  g8::gemm_phase(lds, DM, S, E);
}

constexpr int CROW = 1040;
constexpr int RNN_XG = 64 * CROW;
constexpr int RNN_CARRY = 2 * 64 * CROW;
template <int MODE>
DEVI void rnn_item(PRef p, LDS unsigned char* lds, int b, int cr) {
  const int tid = launder((int)threadIdx.x), lane = tid & 63, wave = wave_id(tid), l31 = lane & 31, half = lane >> 5;
  const h16* XR = (const h16*)(p.ws + WS_XR);
  {
    const int chg = tid & 63, tg = tid >> 6, pos0 = cr * 64 + 8 * tg;
    h16x8 xin[11];
#pragma unroll
    for (int i = 0; i < 11; ++i) {
      const int pos = pos0 + i - 3;
      if (pos >= 0) xin[i] = *(const h16x8*)(XR + ((size_t)b * SEQ + pos) * 512 + chg * 8);
      else {
#pragma unroll
        for (int e = 0; e < 8; ++e) xin[i][e] = (h16)0.f;
      }
    }
    float cw[4][8], cb[8];
#pragma unroll
    for (int e = 0; e < 8; ++e) {
      cb[e] = p.in[10][chg * 8 + e];
#pragma unroll
      for (int j = 0; j < 4; ++j) cw[j][e] = p.in[9][j * 512 + chg * 8 + e];
    }
#pragma unroll
    for (int tt = 0; tt < 8; ++tt) {
      h16x8 o;
#pragma unroll
      for (int e = 0; e < 8; ++e) {
        float v = cb[e];
#pragma unroll
        for (int j = 0; j < 4; ++j) v = fmaf(cw[j][e], (float)xin[tt + j][e], v);
        o[e] = (h16)v;
      }
      *(LDS h16x8*)(lds + (8 * tg + tt) * CROW + chg * 16) = o;
    }
  }
  if (MODE == 1) {
    const float2* ag = (const float2*)(p.ws + WS_AGG) + (size_t)b * 128 * 512 + tid;
    float carry = 0.f; int c2 = 0;
    for (; c2 + 8 <= cr; c2 += 8) {
      float2 v[8];
#pragma unroll
      for (int u = 0; u < 8; ++u) v[u] = ag[(size_t)(c2 + u) * 512];
#pragma unroll
      for (int u = 0; u < 8; ++u) carry = fmaf(v[u].x, carry, v[u].y);
    }
    for (; c2 < cr; ++c2) { const float2 v = ag[(size_t)c2 * 512]; carry = fmaf(v.x, carry, v.y); }
    ((LDS float*)(lds + RNN_CARRY))[tid] = carry;
  }
  if (MODE == 1) {
    const h16* XG = (const h16*)(p.ws + WS_XG) + ((size_t)b * SEQ + cr * 64) * 512;
#pragma unroll
    for (int i = 0; i < 8; ++i) { const int c = tid + NTHR * i, row = c >> 6, cc = c & 63; *(LDS h16x8*)(lds + RNN_XG + row * CROW + cc * 16) = *(const h16x8*)(XG + (size_t)row * 512 + cc * 8); }
  }
  __syncthreads();
  const int n = wave;
  const h16* WRG = (const h16*)(p.ws + WS_WRG) + (size_t)n * 128 * 64;
  float* AGG = (float*)(p.ws + WS_AGG);
#pragma unroll 1
  for (int dt = 0; dt < 2; ++dt) {
    h16x8 wa[4], wx[4];
#pragma unroll
    for (int kk = 0; kk < 4; ++kk) {
      wa[kk] = *(const h16x8*)(WRG + (size_t)(32 * dt + l31) * 64 + 16 * kk + 8 * half);
      wx[kk] = *(const h16x8*)(WRG + (size_t)(64 + 32 * dt + l31) * 64 + 16 * kk + 8 * half);
    }
    f32x16 ra[2], rx[2];
#pragma unroll
    for (int ti = 0; ti < 2; ++ti) {
#pragma unroll
      for (int r = 0; r < 16; ++r) { ra[ti][r] = 0.f; rx[ti][r] = 0.f; }
#pragma unroll
      for (int kk = 0; kk < 4; ++kk) {
        const h16x8 af = *(LDS h16x8*)(lds + (32 * ti + l31) * CROW + (n * 64 + 16 * kk + 8 * half) * 2);
        ra[ti] = mfma16(af, wa[kk], ra[ti]);
        rx[ti] = mfma16(af, wx[kk], rx[ti]);
      }
    }
    const int ch = n * 64 + 32 * dt + l31;
    const float ba = p.in[12][ch], bx = p.in[14][ch], lam = p.in[15][ch];
    const float c8 = -8.f * log1pf(__expf(-lam));
#pragma unroll
    for (int ti = 0; ti < 2; ++ti)
#pragma unroll
      for (int r = 0; r < 16; ++r) {
        const int tk = 32 * ti + (r & 3) + 8 * (r >> 2) + 4 * half;
        const float cv = (float)*(LDS h16*)(lds + tk * CROW + ch * 2);
        const float rr = sigmoid_f(ra[ti][r] + ba), ii = sigmoid_f(rx[ti][r] + bx);
        const float la = c8 * rr;
        ra[ti][r] = __expf(la);
        const float x2 = 2.f * la;
        const float om = -x2 * fmaf(x2 * 0.5f, fmaf(x2 * (1.f / 3.f), fmaf(x2 * 0.25f, fmaf(x2, 0.2f, 1.f), 1.f), 1.f), 1.f);
        rx[ti][r] = __builtin_amdgcn_sqrtf(om) * (ii * cv);
      }
    float P[8], Hs[8];
#pragma unroll
    for (int sg = 0; sg < 8; ++sg) {
      const int ti = sg >> 2, q = sg & 3;
      float pp = 1.f, hh = 0.f;
#pragma unroll
      for (int i = 0; i < 4; ++i) { const float a = ra[ti][4 * q + i], bb = rx[ti][4 * q + i]; hh = fmaf(a, hh, bb); pp *= a; }
      P[sg] = pp; Hs[sg] = hh;
    }
    float carry = 0.f, prod = 1.f;
    if (MODE == 1) carry = ((LDS float*)(lds + RNN_CARRY))[ch];
    float cin[8];
#pragma unroll
    for (int sg = 0; sg < 8; ++sg)
#pragma unroll
      for (int ow = 0; ow < 2; ++ow) {
        const float tmp = fmaf(P[sg], carry, Hs[sg]);
        const float tp = P[sg] * prod;
        if (half == ow) cin[sg] = carry;
        const float oth = __shfl_xor(tmp, 32), otp = __shfl_xor(tp, 32);
        carry = (half == ow) ? tmp : oth;
        prod = (half == ow) ? tp : otp;
      }
    if (MODE == 0) {
      if (half == 0) { float* ag = AGG + ((size_t)(b * 128 + cr) * 512 + ch) * 2; ag[0] = prod; ag[1] = carry; }
    } else {
#pragma unroll
      for (int sg = 0; sg < 8; ++sg) {
        const int ti = sg >> 2, q = sg & 3;
        float hh = cin[sg];
#pragma unroll
        for (int i = 0; i < 4; ++i) {
          hh = fmaf(ra[ti][4 * q + i], hh, rx[ti][4 * q + i]);
          LDS h16* xp = (LDS h16*)(lds + RNN_XG + (32 * ti + 8 * q + 4 * half + i) * CROW + ch * 2);
          *xp = (h16)(hh * gelu_tanh_f((float)*xp));
        }
      }
    }
  }
  __syncthreads();
  if (MODE == 1) {
    h16* Y = (h16*)(p.ws + WS_H) + ((size_t)b * SEQ + cr * 64) * DM + 512;
#pragma unroll
    for (int i = 0; i < 8; ++i) { const int c = tid + NTHR * i, row = c >> 6, cc = c & 63; *(h16x8*)(Y + (size_t)row * DM + cc * 8) = *(LDS h16x8*)(lds + RNN_XG + row * CROW + cc * 16); }
    __syncthreads();
  }
}

constexpr int IDX_NB = 256, IDX_CAP = 128;
constexpr int IL_HIST = 0, IL_CS = 65536, IL_CK = IL_CS + 64 * IDX_CAP * 4, IL_KI = IL_CK + 64 * IDX_CAP * 2, IL_KISZ = 128 * LROW, IL_ST = IL_KI + 2 * IL_KISZ;
static_assert(IL_ST + 4096 <= LDS_BYTES, "indexer LDS map");

DEVI f32x4 mfma16s(h16x8 a, h16x8 b, f32x4 c) { return __builtin_amdgcn_mfma_f32_16x16x32_f16(a, b, c, 0, 0, 0); }
DEVI void idx_score(LDS unsigned char* kit, int kh, int l15, int g4, const h16x8 (&qf)[8][2], const float (&wq)[8], f32x4 (&sc)[4]) {
  h16x8 kf[4][2];
#pragma unroll
  for (int kt = 0; kt < 4; ++kt)
#pragma unroll
    for (int ks = 0; ks < 2; ++ks) kf[kt][ks] = *(LDS h16x8*)(kit + (64 * kh + 16 * kt + l15) * LROW + (4 * ks + g4) * 16);
#pragma unroll
  for (int kt = 0; kt < 4; ++kt) sc[kt] = (f32x4){0.f, 0.f, 0.f, 0.f};
  f32x4 accA[4], accB[4];
#define IDX_MM(ACC, h) _Pragma("unroll") for (int kt = 0; kt < 4; ++kt) { ACC[kt] = mfma16s(kf[kt][0], qf[h][0], (f32x4){0.f, 0.f, 0.f, 0.f}); ACC[kt] = mfma16s(kf[kt][1], qf[h][1], ACC[kt]); }
#define IDX_RS(ACC, h) _Pragma("unroll") for (int kt = 0; kt < 4; ++kt) _Pragma("unroll") for (int r = 0; r < 4; ++r) sc[kt][r] = __builtin_fmaf(wq[h], __int_as_float(max(__float_as_int(ACC[kt][r]), 0)), sc[kt][r]);
  IDX_MM(accA, 0)
  IDX_MM(accB, 1) IDX_RS(accA, 0)
  IDX_MM(accA, 2) IDX_RS(accB, 1)
  IDX_MM(accB, 3) IDX_RS(accA, 2)
  IDX_MM(accA, 4) IDX_RS(accB, 3)
  IDX_MM(accB, 5) IDX_RS(accA, 4)
  IDX_MM(accA, 6) IDX_RS(accB, 5)
  IDX_MM(accB, 7) IDX_RS(accA, 6)
  IDX_RS(accB, 7)
#undef IDX_MM
#undef IDX_RS
}

template <int MODE>
DEVI void idx_pass(LDS unsigned char* lds, const h16* KIb, int N, int stride, int qg, int kh,
                   const h16* QIrow0, const float* WIrow0, float qinv, float qoff, int bstar) {
  const int tid = launder((int)threadIdx.x), lane = tid & 63, l15 = lane & 15, g4 = lane >> 4;
  const int q = 16 * qg + l15;
  h16x8 qf[8][2]; float wq[8];
  {
    const h16* QI = QIrow0 + (size_t)q * 512;
#pragma unroll
    for (int h = 0; h < 8; ++h)
#pragma unroll
      for (int ks = 0; ks < 2; ++ks) qf[h][ks] = *(const h16x8*)(QI + h * 64 + 32 * ks + 8 * g4);
    const float* WI = WIrow0 + (size_t)q * 8;
#pragma unroll
    for (int h = 0; h < 8; ++h) wq[h] = WI[h];
  }
  LDS unsigned* hist = (LDS unsigned*)(lds + IL_HIST);
  LDS unsigned* st = (LDS unsigned*)(lds + IL_ST);
  const int nst = (N + 127) >> 7;
  const int lr = tid >> 3, lc = tid & 7;
  h16x8 r0, r1;
  r0 = *(const h16x8*)(KIb + (size_t)lr * 64 + lc * 8); r1 = *(const h16x8*)(KIb + (size_t)(lr + 64) * 64 + lc * 8);
  *(LDS h16x8*)(lds + IL_KI + lr * LROW + lc * 16) = r0; *(LDS h16x8*)(lds + IL_KI + (lr + 64) * LROW + lc * 16) = r1;
  __syncthreads();
  float vmin = INFINITY, vmax = -INFINITY;
  int cur = 0;
  for (int s = 0; s < nst; s += stride) {
    const int nx = s + stride;
    if (nx < nst) { r0 = *(const h16x8*)(KIb + (size_t)(128 * nx + lr) * 64 + lc * 8); r1 = *(const h16x8*)(KIb + (size_t)(128 * nx + lr + 64) * 64 + lc * 8); }
    if (128 * s + 64 * kh < N) {
      f32x4 sc[4];
      idx_score(lds + IL_KI + cur * IL_KISZ, kh, l15, g4, qf, wq, sc);
      if (MODE == 0) {
#pragma unroll
        for (int kt = 0; kt < 4; ++kt)
#pragma unroll
          for (int r = 0; r < 4; ++r) { vmin = fminf(vmin, sc[kt][r]); vmax = fmaxf(vmax, sc[kt][r]); }
      } else if (MODE == 1) {
#pragma unroll
        for (int kt = 0; kt < 4; ++kt)
#pragma unroll
          for (int r = 0; r < 4; ++r) {
            const float xb = fminf(fmaxf(__builtin_fmaf(sc[kt][r], qinv, qoff), 0.f), (float)(IDX_NB - 1));
            const int bin = (int)xb;
            __hip_atomic_fetch_add(&hist[bin * 64 + q], 1u, __ATOMIC_RELAXED, __HIP_MEMORY_SCOPE_WORKGROUP);
          }
      } else {
        unsigned nib = 0u;
#pragma unroll
        for (int kt = 0; kt < 4; ++kt)
#pragma unroll
          for (int r = 0; r < 4; ++r) {
            const float xb = fminf(fmaxf(__builtin_fmaf(sc[kt][r], qinv, qoff), 0.f), (float)(IDX_NB - 1));
            const int bin = (int)xb;
            if (bin > bstar) nib |= (1u << (4 * kt + r));
            else if (bin == bstar) {
              const unsigned pos = __hip_atomic_fetch_add(&st[128 + q], 1u, __ATOMIC_RELAXED, __HIP_MEMORY_SCOPE_WORKGROUP);
              if (pos < (unsigned)IDX_CAP) {
                ((LDS float*)(lds + IL_CS))[q * IDX_CAP + pos] = sc[kt][r];
                ((LDS unsigned short*)(lds + IL_CK))[q * IDX_CAP + pos] = (unsigned short)(128 * s + 64 * kh + 16 * kt + 4 * g4 + r);
              }
            }
          }
        const unsigned oth = (unsigned)__shfl_xor((int)nib, 32);
        if (lane < 32) {
#pragma unroll
          for (int T = 0; T < 2; ++T) {
            const unsigned b0 = ((nib >> (8 * T)) & 15u) | (((oth >> (8 * T)) & 15u) << 4);
            const unsigned b1 = ((nib >> (8 * T + 4)) & 15u) | (((oth >> (8 * T + 4)) & 15u) << 4);
            ((LDS unsigned short*)(lds + IL_HIST))[q * 512 + (4 * s + 2 * kh + T) * 2 + (g4 & 1)] = (unsigned short)(b0 | (b1 << 8));
          }
        }
      }
    }
    if (nx < nst) {
      *(LDS h16x8*)(lds + IL_KI + (cur ^ 1) * IL_KISZ + lr * LROW + lc * 16) = r0;
      *(LDS h16x8*)(lds + IL_KI + (cur ^ 1) * IL_KISZ + (lr + 64) * LROW + lc * 16) = r1;
    }
    __syncthreads();
    cur ^= 1;
  }
  if (MODE == 0) {
    __hip_atomic_fetch_min(&st[q], fkey(vmin), __ATOMIC_RELAXED, __HIP_MEMORY_SCOPE_WORKGROUP);
    __hip_atomic_fetch_max(&st[64 + q], fkey(vmax), __ATOMIC_RELAXED, __HIP_MEMORY_SCOPE_WORKGROUP);
  }
}

DEVI void idx_item(PRef p, LDS unsigned char* lds, int b, int c) {
  const int tid = launder((int)threadIdx.x), lane = tid & 63, wave = wave_id(tid), l31 = lane & 31, half = lane >> 5;
  const int N = 64 * (c + 1);
  unsigned* MASK = (unsigned*)(p.ws + WS_MASK) + ((size_t)b * SEQ + 64 * c) * 256;
  if (N <= 256) {
    const int wpr = N >> 5;
    for (int i = tid; i < 64 * wpr; i += NTHR) MASK[(size_t)(i / wpr) * 256 + (i % wpr)] = 0xFFFFFFFFu;
    return;
  }
  const int qg = wave & 3, kh = wave >> 2, l15 = lane & 15, q = 16 * qg + l15;
  const h16* QIrow0 = (const h16*)(p.ws + WS_QI) + ((size_t)b * SEQ + 64 * c) * 512;
  const float* WIrow0 = (const float*)(p.ws + WS_WI) + ((size_t)b * SEQ + 64 * c) * 8;
  const h16* KIb = (const h16*)(p.ws + WS_KI) + (size_t)b * SEQ * 64;
  LDS unsigned* st = (LDS unsigned*)(lds + IL_ST);
  LDS float* stf = (LDS float*)(lds + IL_ST);
  if (tid < 64) { st[tid] = 0xFFFFFFFFu; st[64 + tid] = 0u; st[128 + tid] = 0u; }
  __syncthreads();
  const int nst = (N + 127) >> 7;
  const int stride = nst >= 16 ? 8 : (nst >= 8 ? 4 : (nst >= 4 ? 2 : 1));
  idx_pass<0>(lds, KIb, N, stride, qg, kh, QIrow0, WIrow0, 0.f, 0.f, 0);
  __syncthreads();
  if (tid < 64) {
    const float lo = fkey_inv(st[tid]), hi = fkey_inv(st[64 + tid]);
    float d = hi - lo; if (!(d > 1e-20f)) d = 1.f;
    const float inv = (float)IDX_NB / (1.5f * d);
    stf[192 + tid] = inv; stf[256 + tid] = -(lo - 0.25f * d) * inv;
  }
  for (int i = tid; i < 16384; i += NTHR) ((LDS unsigned*)(lds + IL_HIST))[i] = 0u;
  __syncthreads();
  const float qinv = stf[192 + q], qoff = stf[256 + q];
  idx_pass<1>(lds, KIb, N, 1, qg, kh, QIrow0, WIrow0, qinv, qoff, 0);
#ifdef PROBE_P1X2
  __syncthreads();
  for (int i = tid; i < 16384; i += NTHR) ((LDS unsigned*)(lds + IL_HIST))[i] = 0u;
  __syncthreads();
  idx_pass<1>(lds, KIb, N, 1, qg, kh, QIrow0, WIrow0, qinv, qoff, 0);
#endif
  {
    LDS unsigned* hist = (LDS unsigned*)(lds + IL_HIST);
    for (int qq = wave; qq < 64; qq += 8) {
      unsigned hb[4];
#pragma unroll
      for (int j = 0; j < 4; ++j) hb[j] = hist[(4 * lane + j) * 64 + qq];
      const unsigned mine = hb[0] + hb[1] + hb[2] + hb[3];
      unsigned suf = mine;
#pragma unroll
      for (int o = 1; o < 64; o <<= 1) { const unsigned v = (unsigned)__shfl_down((int)suf, o); if (lane + o < 64) suf += v; }
      unsigned cum = suf - mine;
      if (cum < 256u && suf >= 256u) {
#pragma unroll
        for (int j = 3; j >= 0; --j) {
          if (cum < 256u && cum + hb[j] >= 256u) { st[320 + qq] = (unsigned)(4 * lane + j); st[384 + qq] = 256u - cum; }
          cum += hb[j];
        }
      }
    }
  }
  __syncthreads();
  const int bstar = (int)st[320 + q];
  __syncthreads();
  idx_pass<2>(lds, KIb, N, 1, qg, kh, QIrow0, WIrow0, qinv, qoff, bstar);
#ifdef PROBE_P2X2
  __syncthreads();
  if (tid < 64) st[128 + tid] = 0u;
  __syncthreads();
  idx_pass<2>(lds, KIb, N, 1, qg, kh, QIrow0, WIrow0, qinv, qoff, bstar);
#endif
  for (int qq = wave; qq < 64; qq += 8) {
    const int nc = min((int)st[128 + qq], IDX_CAP); const unsigned need = st[384 + qq];
    LDS float* cs = (LDS float*)(lds + IL_CS) + qq * IDX_CAP; LDS unsigned short* ck = (LDS unsigned short*)(lds + IL_CK) + qq * IDX_CAP;
    for (int i = lane; i < nc; i += 64) {
      const float sv = cs[i]; const unsigned kv = ck[i];
      unsigned rank = 0u;
      for (int j = 0; j < nc; ++j) { const float sj = cs[j]; const unsigned kj = ck[j]; rank += (sj > sv || (sj == sv && kj < kv)) ? 1u : 0u; }
      if (rank < need) {
        const unsigned kl = kv & 31u;
        const unsigned bit = 16u * ((kl >> 2) & 1u) + (kl & 3u) + 4u * (kl >> 3);
        __hip_atomic_fetch_or((LDS unsigned*)(lds + IL_HIST) + qq * 256 + (kv >> 5), 1u << bit, __ATOMIC_RELAXED, __HIP_MEMORY_SCOPE_WORKGROUP);
      }
    }
  }
  __syncthreads();
  {
    const int cpr = N >> 6;
    for (int i = tid; i < 64 * cpr; i += NTHR) {
      const int row = i / cpr, cc = i % cpr;
      *(u32x2*)(MASK + (size_t)row * 256 + 2 * cc) = *(LDS u32x2*)(lds + IL_HIST + row * 1024 + cc * 8);
    }
  }
  __syncthreads();
}

DEVI void phase3(PRef p, LDS unsigned char* lds) {
  const int G = gridDim.x;
  for (int it = blockIdx.x; it < 512; it += G) rnn_item<0>(p, lds, it >> 7, it & 127);
  for (int it = blockIdx.x; it < 256; it += G) {
    const int b = it >> 6, j = it & 63;
#pragma unroll 1
    for (int w2 = 0; w2 < 2; ++w2) idx_item(p, lds, b, w2 ? j : 127 - j);
  }
}

constexpr int AT_BUF = 2 * 64 * LROW;
DEVI float max3f(float a, float b, float c) { float r; asm("v_max3_f32 %0, %1, %2, %3" : "=v"(r) : "v"(a), "v"(b), "v"(c)); return r; }
DEVI unsigned pk_rtz(float a, float b) { return __builtin_bit_cast(unsigned, __builtin_amdgcn_cvt_pkrtz(a, b)); }
DEVI void attn_tile(LDS unsigned char* Kt, LDS unsigned char* Vt, const h16x8 (&qf)[4], u32x2 mw, int l31, int half, f32x16 (&o)[2], float& mref, float& l, bool& init) {
  const unsigned nm0 = ~(mw[0] >> (16 * half)), nm1 = ~(mw[1] >> (16 * half));
  const unsigned negm = __float_as_uint(-mref);
  f32x16 s[2];
#pragma unroll
  for (int r = 0; r < 16; ++r) {
    unsigned e0 = (unsigned)__builtin_amdgcn_sbfe((int)nm0, r, 1), e1 = (unsigned)__builtin_amdgcn_sbfe((int)nm1, r, 1);
    asm volatile("" : "+v"(e0), "+v"(e1));
    s[0][r] = __uint_as_float((e0 & 0xFF800000u) | (~e0 & negm));
    s[1][r] = __uint_as_float((e1 & 0xFF800000u) | (~e1 & negm));
  }
#pragma unroll
  for (int ri = 0; ri < 2; ++ri)
#pragma unroll
    for (int kk = 0; kk < 4; ++kk) {
      const h16x8 kf = *(LDS h16x8*)(Kt + (32 * ri + l31) * LROW + (2 * kk + half) * 16);
      s[ri] = mfma16(kf, qf[kk], s[ri]);
    }
  asm volatile("s_nop 15\n\ts_nop 7" : "+v"(s[0]), "+v"(s[1]));
  float mx = max3f(s[0][0], s[1][0], s[0][1]), mx2 = max3f(s[1][1], s[0][2], s[1][2]);
#pragma unroll
  for (int r = 3; r < 15; r += 2) { mx = max3f(mx, s[0][r], s[1][r]); mx2 = max3f(mx2, s[0][r + 1], s[1][r + 1]); }
  mx = max3f(mx, s[0][15], s[1][15]);
  mx = max3f(mx, mx2, mx2);
  mx = max3f(mx, __shfl_xor(mx, 32), mx);
  const bool first = (!init) && (mx > -INFINITY);
  const bool resc = first || (mx > 8.f);
  if (__any(resc)) {
    init = init || first;
    const float delta = resc ? mx : 0.f;
    const float alpha = __builtin_amdgcn_exp2f(-delta);
#pragma unroll
    for (int r = 0; r < 16; ++r) { s[0][r] -= delta; s[1][r] -= delta; o[0][r] *= alpha; o[1][r] *= alpha; }
    l *= alpha; mref += delta;
  }
  float ls = 0.f;
#pragma unroll
  for (int r = 0; r < 16; ++r) {
    s[0][r] = __builtin_amdgcn_exp2f(s[0][r]); s[1][r] = __builtin_amdgcn_exp2f(s[1][r]);
    ls += s[0][r] + s[1][r];
  }
  l += ls;
  h16x8 pf[4];
#pragma unroll
  for (int s4 = 0; s4 < 4; ++s4) {
    u32x4 w;
#pragma unroll
    for (int e = 0; e < 4; ++e) w[e] = pk_rtz(s[s4 >> 1][8 * (s4 & 1) + 2 * e], s[s4 >> 1][8 * (s4 & 1) + 2 * e + 1]);
    pf[s4] = __builtin_bit_cast(h16x8, w);
  }
#pragma unroll
  for (int di = 0; di < 2; ++di)
#pragma unroll
    for (int s4 = 0; s4 < 4; ++s4) {
      const h16x8 vf = *(LDS h16x8*)(Vt + (32 * di + l31) * LROW + (2 * s4 + half) * 16);
      o[di] = mfma16(vf, pf[s4], o[di]);
    }
}

DEVI void attn_unit(PRef p, LDS unsigned char* lds, int b, int head, int qb) {
  const int tid = launder((int)threadIdx.x), lane = tid & 63, wave = wave_id(tid), l31 = lane & 31, half = lane >> 5;
  const int q0 = qb * 256 + wave * 32, cw = q0 >> 6, NS = 2 * (qb + 1);
  const size_t tok = (size_t)b * SEQ + q0 + l31;
  h16x8 qf[4];
  {
    const h16* Q = (const h16*)(p.ws + WS_Q) + tok * 512 + head * 64;
#pragma unroll
    for (int kk = 0; kk < 4; ++kk) qf[kk] = *(const h16x8*)(Q + 16 * kk + 8 * half);
  }
  const unsigned* mrow = (const unsigned*)(p.ws + WS_MASK) + tok * 256;
  constexpr int TP = 2 * 64 * LROW, ABUF = 2 * TP;
  const h16* ksrc[2]; const h16* vsrc[2]; int kdst[2], vdst[2];
#pragma unroll
  for (int i = 0; i < 2; ++i) {
    const int id = tid + NTHR * i;
    const int row = id >> 3, lc = id & 7;
    ksrc[i] = (const h16*)(p.ws + WS_K) + ((size_t)b * SEQ + row) * 512 + head * 64 + lc * 8;
    kdst[i] = (row >> 6) * TP + (row & 63) * LROW + lc * 16;
    const int d = id >> 4, c = id & 15;
    vsrc[i] = (const h16*)(p.ws + WS_VT) + ((size_t)(b * 8 + head) * 64 + d) * 8192 + c * 8;
    vdst[i] = (c >> 3) * TP + 64 * LROW + d * LROW + (c & 7) * 16;
  }
  h16x8 rkA[2], rvA[2], rkB[2], rvB[2];
#pragma unroll
  for (int i = 0; i < 2; ++i) { rkA[i] = *(const h16x8*)ksrc[i]; rvA[i] = *(const h16x8*)vsrc[i]; }
#pragma unroll
  for (int i = 0; i < 2; ++i) { *(LDS h16x8*)(lds + kdst[i]) = rkA[i]; *(LDS h16x8*)(lds + vdst[i]) = rvA[i]; }
#pragma unroll
  for (int i = 0; i < 2; ++i) { rkA[i] = *(const h16x8*)(ksrc[i] + (size_t)128 * 512); rvA[i] = *(const h16x8*)(vsrc[i] + 128); }
  u32x4 mw = *(const u32x4*)mrow, mwn;
  __syncthreads();
  f32x16 o[2];
#pragma unroll
  for (int r = 0; r < 16; ++r) { o[0][r] = 0.f; o[1][r] = 0.f; }
  float mref = 0.f, l = 0.f; bool init = false;
#define ATT_STEP(s, RKC, RVC, RKN, RVN) { \
    if ((s) + 2 < NS) { _Pragma("unroll") for (int i = 0; i < 2; ++i) { RKN[i] = *(const h16x8*)(ksrc[i] + (size_t)((s) + 2) * 128 * 512); RVN[i] = *(const h16x8*)(vsrc[i] + ((s) + 2) * 128); } } \
    if ((s) + 1 < NS) mwn = *(const u32x4*)(mrow + 4 * ((s) + 1)); \
    { LDS unsigned char* bb = lds + ((s) & 1) * ABUF; \
      if (2 * (s) <= cw) { u32x2 m2; m2[0] = mw[0]; m2[1] = mw[1]; attn_tile(bb, bb + 64 * LROW, qf, m2, l31, half, o, mref, l, init); } \
      if (2 * (s) + 1 <= cw) { u32x2 m2; m2[0] = mw[2]; m2[1] = mw[3]; attn_tile(bb + TP, bb + TP + 64 * LROW, qf, m2, l31, half, o, mref, l, init); } } \
    if ((s) + 1 < NS) { LDS unsigned char* nb = lds + (((s) + 1) & 1) * ABUF; _Pragma("unroll") for (int i = 0; i < 2; ++i) { *(LDS h16x8*)(nb + kdst[i]) = RKC[i]; *(LDS h16x8*)(nb + vdst[i]) = RVC[i]; } } \
    __syncthreads(); mw = mwn; }
  for (int s = 0; s < NS; s += 2) {
    ATT_STEP(s, rkA, rvA, rkB, rvB)
    ATT_STEP(s + 1, rkB, rvB, rkA, rvA)
  }
#undef ATT_STEP
  const float inv = 1.f / (l + __shfl_xor(l, 32));
  h16* Y = (h16*)(p.ws + WS_H) + tok * DM + head * 64;
#pragma unroll
  for (int di = 0; di < 2; ++di)
#pragma unroll
    for (int q = 0; q < 4; ++q)
      *(h16x4*)(Y + 32 * di + 8 * q + 4 * half) = pack4(o[di][4 * q] * inv, o[di][4 * q + 1] * inv, o[di][4 * q + 2] * inv, o[di][4 * q + 3] * inv);
}

DEVI void phase4(PRef p, LDS unsigned char* lds) {
  const int G = gridDim.x;
  for (int it = blockIdx.x; it < 512; it += G) rnn_item<1>(p, lds, it >> 7, it & 127);
  for (int it = blockIdx.x; it < 512; it += G) {
    const int bh = it >> 4, j = it & 15;
#pragma unroll 1
    for (int w2 = 0; w2 < 2; ++w2) attn_unit(p, lds, bh >> 3, bh & 7, w2 ? j : 31 - j);
  }
}

struct EpiPlain {
  h16* dst; int ld;
  DEVI void operator()(const f32x4 (&acc)[2][2][4][2], const g8::Unit& u, int wr, int wc, int fr, int fq) const {
#pragma unroll
    for (int ai = 0; ai < 2; ++ai)
#pragma unroll
      for (int m = 0; m < 4; ++m) {
        const int r = u.pm * 256 + 128 * ai + 64 * wr + 16 * m + fr;
        if (r < u.cnt) {
          h16* d = dst + (size_t)(u.off + r) * ld + u.pn * 256 + 32 * wc + 4 * fq;
#pragma unroll
          for (int bj = 0; bj < 2; ++bj)
#pragma unroll
            for (int n = 0; n < 2; ++n) { const f32x4 v = acc[ai][bj][m][n]; *(h16x4*)(d + 128 * bj + 16 * n) = pack4(v[0], v[1], v[2], v[3]); }
        }
      }
  }
};
DEVI void phase5(PRef p, LDS unsigned char* lds) {
  g8::DenseOrder S{(const h16*)(p.ws + WS_H), (const h16*)(p.ws + WS_WOUT), DM, 128, 4, (int)gridDim.x, (int)blockIdx.x};
  EpiPlain E{(h16*)(p.ws + WS_MIX), DM};
  g8::gemm_phase(lds, DM, S, E);
}

constexpr int P6_TROW = 2064, P6_THI = 0, P6_TLO = 32 * P6_TROW, P6_PART = 0, P6_LGT = 8 * 48 * 32 * 4, P6_MOD = 2 * 32 * P6_TROW;
constexpr int P6_BIAS = P6_MOD + 3 * 4096, P6_TOK = P6_BIAS + 160, P6_LCNT = P6_TOK + 128 * 6 * 4, P6_LBASE = P6_LCNT + 128;
static_assert(P6_LBASE + 128 <= LDS_BYTES - 16 && P6_LGT + 32 * 36 * 4 <= P6_MOD, "phase 6 LDS map");
DEVI void phase6(PRef p, LDS unsigned char* lds) {
  const int tid = launder((int)threadIdx.x), lane = tid & 63, wave = wave_id(tid), l15 = lane & 15, g4 = lane >> 4;
  const int b = blockIdx.x >> 6;
  LDS float* mv = (LDS float*)(lds + P6_MOD);
  LDS float* rbias = (LDS float*)(lds + P6_BIAS);
  LDS unsigned* tokrec = (LDS unsigned*)(lds + P6_TOK);
  LDS unsigned* lcnt = (LDS unsigned*)(lds + P6_LCNT);
  LDS unsigned* lbase = (LDS unsigned*)(lds + P6_LBASE);
  mod_to_lds(p, b, 2, mv); mod_to_lds(p, b, 3, mv + 1024); mod_to_lds(p, b, 4, mv + 2048);
  if (tid < 4) rbias[tid] = p.in[18][tid];
  else if (tid < 36) rbias[tid] = p.in[20][tid - 4];
  if (tid < 32) lcnt[tid] = 0u;
  __syncthreads();
  f32x4 A1[4], A2[4], SH2[4];
#pragma unroll
  for (int j = 0; j < 4; ++j) {
    const int k = 256 * j + 4 * lane;
    A1[j] = *(LDS f32x4*)(mv + k) * *(const f32x4*)(p.in[5] + k);
    A2[j] = *(const f32x4*)(p.in[6] + k) * (*(LDS f32x4*)(mv + 2048 + k) + 1.f);
    SH2[j] = *(LDS f32x4*)(mv + 1024 + k);
  }
  const float* x = p.in[0]; const h16* MIX = (const h16*)(p.ws + WS_MIX); float* X1 = p.out; h16* H2 = (h16*)(p.ws + WS_H);
  const h16* WRH = (const h16*)(p.ws + WS_WRH); const h16* WRL = (const h16*)(p.ws + WS_WRL);
  const size_t tok0 = (size_t)blockIdx.x * 128;
#pragma unroll 1
  for (int rd = 0; rd < 4; ++rd) {
#pragma unroll 1
    for (int i = 0; i < 4; ++i) {
      const int tr = 4 * wave + i;
      const size_t tok = tok0 + 32 * rd + tr;
      f32x4 xv[4], mx[4]; float ssm = 0.f;
#pragma unroll
      for (int j = 0; j < 4; ++j) {
        xv[j] = *(const f32x4*)(x + tok * DM + 256 * j + 4 * lane);
        const h16x4 mh = *(const h16x4*)(MIX + tok * DM + 256 * j + 4 * lane);
#pragma unroll
        for (int e = 0; e < 4; ++e) { mx[j][e] = (float)mh[e]; ssm += mx[j][e] * mx[j][e]; }
      }
      const float rsm = 1.0f / sqrtf(wave_sum(ssm) * (1.f / 1024.f) + 1e-6f);
      float ss1 = 0.f;
#pragma unroll
      for (int j = 0; j < 4; ++j) {
        xv[j] = xv[j] + A1[j] * (mx[j] * rsm);
        *(f32x4*)(X1 + tok * DM + 256 * j + 4 * lane) = xv[j];
        ss1 += xv[j][0] * xv[j][0] + xv[j][1] * xv[j][1] + xv[j][2] * xv[j][2] + xv[j][3] * xv[j][3];
      }
      const float rs1 = 1.0f / sqrtf(wave_sum(ss1) * (1.f / 1024.f) + 1e-6f);
#pragma unroll
      for (int j = 0; j < 4; ++j) {
        const f32x4 h2 = xv[j] * rs1 * A2[j] + SH2[j];
        const h16x4 hi = pack4(h2[0], h2[1], h2[2], h2[3]);
        const h16x4 lo = pack4(h2[0] - (float)hi[0], h2[1] - (float)hi[1], h2[2] - (float)hi[2], h2[3] - (float)hi[3]);
        *(h16x4*)(H2 + tok * DM + 256 * j + 4 * lane) = hi;
        *(LDS h16x4*)(lds + P6_THI + tr * P6_TROW + (256 * j + 4 * lane) * 2) = hi;
        *(LDS h16x4*)(lds + P6_TLO + tr * P6_TROW + (256 * j + 4 * lane) * 2) = lo;
      }
    }
    __syncthreads();
    f32x4 acc[2][3];
#pragma unroll
    for (int tt = 0; tt < 2; ++tt)
#pragma unroll
      for (int ct = 0; ct < 3; ++ct) acc[tt][ct] = (f32x4){0.f, 0.f, 0.f, 0.f};
#pragma unroll
    for (int kk = 0; kk < 4; ++kk) {
      const int kof = 32 * (4 * wave + kk) + 8 * g4;
      h16x8 ah[2], al[2];
#pragma unroll
      for (int tt = 0; tt < 2; ++tt) {
        ah[tt] = *(LDS h16x8*)(lds + P6_THI + (16 * tt + l15) * P6_TROW + kof * 2);
        al[tt] = *(LDS h16x8*)(lds + P6_TLO + (16 * tt + l15) * P6_TROW + kof * 2);
      }
#pragma unroll
      for (int ct = 0; ct < 3; ++ct) {
        const h16x8 bh = *(const h16x8*)(WRH + (size_t)(16 * ct + l15) * 1024 + kof), bl = *(const h16x8*)(WRL + (size_t)(16 * ct + l15) * 1024 + kof);
#pragma unroll
        for (int tt = 0; tt < 2; ++tt) {
          acc[tt][ct] = mfma16s(ah[tt], bh, acc[tt][ct]);
          acc[tt][ct] = mfma16s(ah[tt], bl, acc[tt][ct]);
          acc[tt][ct] = mfma16s(al[tt], bh, acc[tt][ct]);
        }
      }
    }
    __syncthreads();
#pragma unroll
    for (int tt = 0; tt < 2; ++tt)
#pragma unroll
      for (int ct = 0; ct < 3; ++ct)
        *(LDS f32x4*)(lds + P6_PART + (((wave * 48 + 16 * ct + l15) * 32) + 16 * tt + 4 * g4) * 4) = acc[tt][ct];
    __syncthreads();
    for (int idx = tid; idx < 36 * 32; idx += NTHR) {
      const int col = idx >> 5, tk = idx & 31;
      float s = 0.f;
#pragma unroll
      for (int w = 0; w < 8; ++w) s += *(LDS float*)(lds + P6_PART + ((w * 48 + col) * 32 + tk) * 4);
      *(LDS float*)(lds + P6_LGT + (tk * 36 + col) * 4) = s;
    }
    __syncthreads();
    if (tid < 32) {
      LDS float* lg = (LDS float*)(lds + P6_LGT) + 36 * tid;
      float gl[4];
#pragma unroll
      for (int g = 0; g < 4; ++g) gl[g] = lg[g] + rbias[g];
      int gi = 0; float gm = gl[0];
#pragma unroll
      for (int g = 1; g < 4; ++g) if (gl[g] > gm) { gm = gl[g]; gi = g; }
      float gs = 0.f;
#pragma unroll
      for (int g = 0; g < 4; ++g) gs += __expf(gl[g] - gm);
      const float pg = 1.f / gs;
      int e1 = 0, e2 = 0; float l1 = -INFINITY, l2 = -INFINITY;
#pragma unroll
      for (int e = 0; e < 8; ++e) {
        const float v = lg[4 + 8 * gi + e] + rbias[4 + 8 * gi + e];
        if (v > l1) { l2 = l1; e2 = e1; l1 = v; e1 = e; }
        else if (v > l2) { l2 = v; e2 = e; }
      }
      const float x2 = __expf(l2 - l1);
      const float w1 = pg / (1.f + x2), w2 = pg * x2 / (1.f + x2);
      const unsigned E1 = (unsigned)(gi * 8 + e1), E2 = (unsigned)(gi * 8 + e2);
      const unsigned lp1 = __hip_atomic_fetch_add(&lcnt[E1], 1u, __ATOMIC_RELAXED, __HIP_MEMORY_SCOPE_WORKGROUP);
      const unsigned lp2 = __hip_atomic_fetch_add(&lcnt[E2], 1u, __ATOMIC_RELAXED, __HIP_MEMORY_SCOPE_WORKGROUP);
      LDS unsigned* tr = tokrec + (32 * rd + tid) * 6;
      tr[0] = E1; tr[1] = lp1; tr[2] = E2; tr[3] = lp2; tr[4] = __float_as_uint(w1); tr[5] = __float_as_uint(w2);
    }
    __syncthreads();
  }
  if (tid < 32) lbase[tid] = atomicAdd((unsigned*)(p.ws + WS_CNT) + tid, lcnt[tid]);
  __syncthreads();
  if (tid < 128) {
    unsigned* LIST = (unsigned*)(p.ws + WS_LIST); float* LISTW = (float*)(p.ws + WS_LISTW); u32x4* ROUTE = (u32x4*)(p.ws + WS_ROUTE);
    const unsigned tok = (unsigned)(tok0 + tid);
    LDS unsigned* tr = tokrec + tid * 6;
    const unsigned E1 = tr[0], E2 = tr[2], p1 = lbase[E1] + tr[1], p2 = lbase[E2] + tr[3];
    LIST[(size_t)E1 * 32768 + p1] = tok; LISTW[(size_t)E1 * 32768 + p1] = __uint_as_float(tr[4]);
    LIST[(size_t)E2 * 32768 + p2] = tok; LISTW[(size_t)E2 * 32768 + p2] = __uint_as_float(tr[5]);
    u32x4 rt; rt[0] = E1; rt[1] = p1; rt[2] = E2; rt[3] = p2;
    ROUTE[tok] = rt;
  }
}

template <bool GATHER_> struct MoeOrder {
  static constexpr bool GATHER = GATHER_;
  unsigned char* ws; int ntn, K, G, c;
  DEVI bool next(int i, g8::Unit& u) const {
    const unsigned* cnt = (const unsigned*)(ws + WS_CNT);
    int it = i * G + c, off = 0, e = 0, cn = 0; bool found = false;
    for (e = 0; e < 32; ++e) { cn = (int)cnt[e]; const int nti = ((cn + 255) >> 8) * ntn; if (it < nti) { found = true; break; } it -= nti; off += cn; }
    if (!found) return false;
    u.e = e; u.pm = it / ntn; u.pn = it % ntn; u.cnt = cn; u.off = off;
    const int tid = threadIdx.x;
    if (GATHER_) {
      const unsigned* list = (const unsigned*)(ws + WS_LIST) + (size_t)e * 32768;
      u.A = (const char*)(ws + WS_H);
      u.B = (const char*)((const h16*)(ws + WS_WGU) + ((size_t)e * 512 + u.pn * 256) * DM);
#pragma unroll
      for (int h = 0; h < 2; ++h)
#pragma unroll
        for (int i2 = 0; i2 < 2; ++i2) {
          int R, C; g8::stage_rc(tid * 16 + i2 * 8192, R, C);
          const int row = u.pm * 256 + 128 * h + R;
          const unsigned t = (row < cn) ? list[row] : 0u;
          u.va[h][i2] = (t * (unsigned)DM + (unsigned)C) * 2u;
        }
    } else {
      u.A = (const char*)((const h16*)(ws + WS_ACT) + ((size_t)off + u.pm * 256) * 256);
      u.B = (const char*)((const h16*)(ws + WS_WDN) + ((size_t)e * 1024 + u.pn * 256) * 256);
      u.va[0][0] = u.va[0][1] = u.va[1][0] = u.va[1][1] = 0u;
    }
    return true;
  }
};
struct EpiAct {
  unsigned char* ws;
  DEVI void operator()(const f32x4 (&acc)[2][2][4][2], const g8::Unit& u, int wr, int wc, int fr, int fq) const {
    const float* lw = (const float*)(ws + WS_LISTW) + (size_t)u.e * 32768; h16* act = (h16*)(ws + WS_ACT);
#pragma unroll
    for (int ai = 0; ai < 2; ++ai)
#pragma unroll
      for (int m = 0; m < 4; ++m) {
        const int r = u.pm * 256 + 128 * ai + 64 * wr + 16 * m + fr;
        if (r < u.cnt) {
          const float w = lw[r];
#pragma unroll
          for (int bj = 0; bj < 2; ++bj) {
            const f32x4 g = acc[ai][bj][m][0], up = acc[ai][bj][m][1];
            float v[4];
#pragma unroll
            for (int e = 0; e < 4; ++e) v[e] = g[e] * __builtin_amdgcn_rcpf(1.f + __expf(-g[e])) * up[e] * w;
            *(h16x4*)(act + (size_t)(u.off + r) * 256 + 16 * (8 * u.pn + 4 * bj + wc) + 4 * fq) = pack4(v[0], v[1], v[2], v[3]);
          }
        }
      }
  }
};
struct EpiYp {
  h16* dst;
  DEVI void operator()(const f32x4 (&acc)[2][2][4][2], const g8::Unit& u, int wr, int wc, int fr, int fq) const {
#pragma unroll
    for (int ai = 0; ai < 2; ++ai)
#pragma unroll
      for (int m = 0; m < 4; ++m) {
        const int r = u.pm * 256 + 128 * ai + 64 * wr + 16 * m + fr;
        if (r < u.cnt) {
          h16* d = dst + (size_t)(u.off + r) * DM + u.pn * 256 + 32 * wc + 4 * fq;
#pragma unroll
          for (int bj = 0; bj < 2; ++bj)
#pragma unroll
            for (int n = 0; n < 2; ++n) { const f32x4 v = acc[ai][bj][m][n]; *(h16x4*)(d + 128 * bj + 16 * n) = pack4(v[0], v[1], v[2], v[3]); }
        }
      }
  }
};
DEVI void phase7(PRef p, LDS unsigned char* lds) {
  MoeOrder<true> S{p.ws, 2, DM, (int)gridDim.x, (int)blockIdx.x};
  EpiAct E{p.ws};
  g8::gemm_phase(lds, DM, S, E);
}
DEVI void phase8(PRef p, LDS unsigned char* lds) {
  MoeOrder<false> S{p.ws, 4, 256, (int)gridDim.x, (int)blockIdx.x};
  EpiYp E{(h16*)(p.ws + WS_YP)};
  g8::gemm_phase(lds, 256, S, E);
}

DEVI void phase9(PRef p, LDS unsigned char* lds) {
  const int tid = launder((int)threadIdx.x), lane = tid & 63, wave = wave_id(tid), G = gridDim.x;
  const int b = blockIdx.x & 3, bi = blockIdx.x >> 2, nbk = G >> 2;
  LDS unsigned* offs = (LDS unsigned*)lds;
  if (tid == 0) { const unsigned* cnt = (const unsigned*)(p.ws + WS_CNT); unsigned o = 0; for (int e = 0; e < 32; ++e) { offs[e] = o; o += cnt[e]; } }
  __syncthreads();
  LDS float* mv = (LDS float*)(lds + 256);
  mod_to_lds(p, b, 5, mv);
  __syncthreads();
  f32x4 A3[4];
#pragma unroll
  for (int j = 0; j < 4; ++j) { const int k = 256 * j + 4 * lane; A3[j] = *(LDS f32x4*)(mv + k) * *(const f32x4*)(p.in[7] + k); }
  const h16* YP = (const h16*)(p.ws + WS_YP); const u32x4* ROUTE = (const u32x4*)(p.ws + WS_ROUTE); float* out = p.out;
  const int rstep = nbk * 8, r_first = bi * 8 + wave;
  const int nrow = (SEQ - r_first + rstep - 1) / rstep;
  unsigned R0 = 0u, R1 = 0u;
  if (lane < nrow) { const u32x4 rt = ROUTE[(size_t)b * SEQ + r_first + rstep * lane]; R0 = offs[rt[0]] + rt[1]; R1 = offs[rt[2]] + rt[3]; }
  h16x4 ya[4], yc[4]; f32x4 xv[4];
  {
    const size_t tok = (size_t)b * SEQ + r_first; const size_t r0 = __builtin_amdgcn_readlane(R0, 0), r1 = __builtin_amdgcn_readlane(R1, 0);
#pragma unroll
    for (int j = 0; j < 4; ++j) { ya[j] = *(const h16x4*)(YP + r0 * DM + 256 * j + 4 * lane); yc[j] = *(const h16x4*)(YP + r1 * DM + 256 * j + 4 * lane); xv[j] = *(const f32x4*)(out + tok * DM + 256 * j + 4 * lane); }
  }
  for (int i = 0; i < nrow; ++i) {
    const size_t tok = (size_t)b * SEQ + r_first + rstep * i;
    h16x4 na[4], nc[4]; f32x4 nx[4];
    if (i + 1 < nrow) {
      const size_t r0 = __builtin_amdgcn_readlane(R0, i + 1), r1 = __builtin_amdgcn_readlane(R1, i + 1);
#pragma unroll
      for (int j = 0; j < 4; ++j) { na[j] = *(const h16x4*)(YP + r0 * DM + 256 * j + 4 * lane); nc[j] = *(const h16x4*)(YP + r1 * DM + 256 * j + 4 * lane); nx[j] = *(const f32x4*)(out + (tok + rstep) * DM + 256 * j + 4 * lane); }
    }
    f32x4 y[4]; float ss = 0.f;
#pragma unroll
    for (int j = 0; j < 4; ++j)
#pragma unroll
      for (int e = 0; e < 4; ++e) { y[j][e] = (float)ya[j][e] + (float)yc[j][e]; ss += y[j][e] * y[j][e]; }
    const float rs = 1.0f / sqrtf(wave_sum(ss) * (1.f / 1024.f) + 1e-6f);
#pragma unroll
    for (int j = 0; j < 4; ++j) *(f32x4*)(out + tok * DM + 256 * j + 4 * lane) = xv[j] + A3[j] * (y[j] * rs);
    if (i + 1 < nrow) {
#pragma unroll
      for (int j = 0; j < 4; ++j) { ya[j] = na[j]; yc[j] = nc[j]; xv[j] = nx[j]; }
    }
  }
}

#define XB_TMO      128
#define XB_XCNT(j)  (256  + 64 * (j))
#define XB_XSUB(j)  (1280 + 64 * (j))
#define XB_XGEN(j)  (2304 + 64 * (j))
#define XB_TOP      3328
#define XB_TOPGEN   3392
#define XB_SPIN_CAP (1u << 22)
DEVI unsigned xb_ld(unsigned* p)              { return __hip_atomic_load(p, __ATOMIC_RELAXED, __HIP_MEMORY_SCOPE_AGENT); }
DEVI unsigned xb_add(unsigned* p, unsigned v) { return __hip_atomic_fetch_add(p, v, __ATOMIC_RELAXED, __HIP_MEMORY_SCOPE_AGENT); }
DEVI unsigned xb_xcc_id() { return (unsigned)__builtin_amdgcn_s_getreg((3 << 11) | 20) & 0xFu; }
#define XB_SPIN(cond, bar) do { unsigned _sp = 0; while (cond) { __builtin_amdgcn_s_sleep(1); \
    if ((++_sp & 255u) == 0u) { if (xb_ld(&(bar)[XB_TMO])) break; if (_sp > XB_SPIN_CAP) { atomicAdd(&(bar)[XB_TMO], 1u); break; } } } } while (0)
struct XcdBarrier { unsigned* bar; unsigned x; volatile LDS unsigned* st; };
DEVI XcdBarrier xcd_barrier_post(unsigned* bar, volatile LDS unsigned* st) {
  XcdBarrier b; b.bar = bar; b.x = xb_xcc_id(); b.st = st;
  if (threadIdx.x == 0) (void)xb_add(&bar[XB_XCNT(b.x)], 1u);
  return b;
}
DEVI void xcd_barrier_complete(unsigned* bar, unsigned x, unsigned& nloc, unsigned& nx) {
  const unsigned G = gridDim.x * gridDim.y * gridDim.z;
  unsigned sum, cnt, mine, sp = 0u;
  for (;;) {
    sum = 0u; cnt = 0u; mine = 0u;
#pragma unroll
    for (unsigned j = 0; j < 16; ++j) { const unsigned c = xb_ld(&bar[XB_XCNT(j)]); sum += c; cnt += (c > 0u) ? 1u : 0u; mine = (j == x) ? c : mine; }
    if (sum == G) break;
    __builtin_amdgcn_s_sleep(1);
    if ((++sp & 255u) == 0u) { if (xb_ld(&bar[XB_TMO])) break; if (sp > XB_SPIN_CAP) { atomicAdd(&bar[XB_TMO], 1u); break; } }
  }
  nloc = mine > 0u ? mine : 1u; nx = cnt > 0u ? cnt : 1u;
}
DEVI void xcd_barrier(const XcdBarrier& b) {
  asm volatile("s_waitcnt vmcnt(0)" ::: "memory");
  __syncthreads();
  if (threadIdx.x == 0) {
    unsigned* bar = b.bar;
    __builtin_amdgcn_s_waitcnt(0);
    unsigned nloc = b.st[0], nx = b.st[1];
    if (nloc == 0u) { xcd_barrier_complete(bar, b.x, nloc, nx); b.st[0] = nloc; b.st[1] = nx; }
    const unsigned old = xb_add(&bar[XB_XSUB(b.x)], 1u);
    const unsigned gen = old / nloc;
    if (old + 1u == (gen + 1u) * nloc) {
      __builtin_amdgcn_fence(__ATOMIC_RELEASE, "agent");
      asm volatile("s_waitcnt vmcnt(0)" ::: "memory");
      const unsigned og = xb_add(&bar[XB_TOP], 1u);
      const unsigned tg = og / nx;
      if (og + 1u == (tg + 1u) * nx) xb_add(&bar[XB_TOPGEN], 1u);
      else XB_SPIN(xb_ld(&bar[XB_TOPGEN]) == tg, bar);
      __builtin_amdgcn_fence(__ATOMIC_ACQUIRE, "agent");
      xb_add(&bar[XB_XGEN(b.x)], 1u);
      asm volatile("s_waitcnt vmcnt(0)" ::: "memory");
    } else {
      XB_SPIN(xb_ld(&bar[XB_XGEN(b.x)]) == gen, bar);
      __builtin_amdgcn_fence(__ATOMIC_ACQUIRE, "agent");
      asm volatile("s_waitcnt vmcnt(0)" ::: "memory");
    }
  }
  __syncthreads();
}

__global__ void __launch_bounds__(NTHR) fwd_kernel(Params p) {
  extern __shared__ __attribute__((aligned(16))) unsigned char smem[];
  LDS unsigned char* lds = (LDS unsigned char*)smem;
  const int lo = p.ph_lo, hi = p.ph_hi;
  volatile LDS unsigned* bst = (volatile LDS unsigned*)(lds + LDS_BYTES - 16);
  if (threadIdx.x < 4) bst[threadIdx.x] = 0u;
  __syncthreads();
  (void)xcd_barrier_post((unsigned*)(p.ws + WS_BAR), bst);
#ifndef REPEAT_PHASE
#define REPEAT_PHASE -1
#endif
#define GRID_SYNC(k) do { if ((k) == 0) cg::this_grid().sync(); else { XcdBarrier xb_; xb_.bar = (unsigned*)(get_params()->ws + WS_BAR); xb_.x = xb_xcc_id(); xb_.st = (volatile LDS unsigned*)(lds + LDS_BYTES - 16); xcd_barrier(xb_); } } while (0)
#define RUN_PHASE(k, fn) if (lo <= (k) && (k) < hi) { fn(*get_params(), lds); if ((k) == REPEAT_PHASE) { GRID_SYNC(k); fn(*get_params(), lds); } if ((k) + 1 < hi) GRID_SYNC(k); }
  RUN_PHASE(0, phase0)
  RUN_PHASE(1, phase1)
  RUN_PHASE(2, phase2)
  RUN_PHASE(3, phase3)
  RUN_PHASE(4, phase4)
  RUN_PHASE(5, phase5)
  RUN_PHASE(6, phase6)
  RUN_PHASE(7, phase7)
  RUN_PHASE(8, phase8)
  RUN_PHASE(9, phase9)
#undef GRID_SYNC
#undef RUN_PHASE
}

extern "C" void kernel_launch(void* const* d_in, const int* in_sizes, int n_in, void* d_out, int out_size, void* d_ws, size_t ws_size, hipStream_t stream) {
  static int grid = 0;
  if (grid == 0) {
    if (n_in != 24 || out_size != NTOK * DM || ws_size < WS_END) { fprintf(stderr, "kernel_launch: unexpected problem (n_in %d out %d ws %zu)\n", n_in, out_size, ws_size); grid = -1; return; }
    (void)hipFuncSetAttribute((const void*)fwd_kernel, hipFuncAttributeMaxDynamicSharedMemorySize, LDS_BYTES);
    int dev = 0, cus = 0, per_cu = 0;
    (void)hipGetDevice(&dev);
    (void)hipDeviceGetAttribute(&cus, hipDeviceAttributeMultiprocessorCount, dev);
    (void)hipOccupancyMaxActiveBlocksPerMultiprocessor(&per_cu, (const void*)fwd_kernel, NTHR, LDS_BYTES);
    if (per_cu < 1 || cus < 256) fprintf(stderr, "kernel_launch: occupancy %d blocks/CU on %d CUs\n", per_cu, cus);
    grid = 256;
  }
  if (grid < 0) return;
  (void)hipMemsetAsync((char*)d_ws + WS_CNT, 0, CTL_ZERO_BYTES, stream);
  Params p{};
  for (int i = 0; i < 24; ++i) p.in[i] = (const float*)d_in[i];
  p.out = (float*)d_out; p.ws = (unsigned char*)d_ws;
#if N_LAUNCH_MODE == 1
  p.ph_lo = 0; p.ph_hi = NPHASE;
  void* args[] = {&p};
  hipError_t e = hipLaunchCooperativeKernel((const void*)fwd_kernel, dim3(grid), dim3(NTHR), args, LDS_BYTES, stream);
  if (e != hipSuccess) fprintf(stderr, "cooperative launch failed: %s\n", hipGetErrorString(e));
#else
  for (int ph = 0; ph < NPHASE; ++ph) {
    p.ph_lo = ph; p.ph_hi = ph + 1;
    hipLaunchKernelGGL(fwd_kernel, dim3(grid), dim3(NTHR), LDS_BYTES, stream, p);
  }
#endif
}
```

```cpp
#include <hip/hip_runtime.h>
#include <hip/hip_cooperative_groups.h>
#include <cstdio>
#include <cstdint>
namespace cg = cooperative_groups;

#ifndef N_LAUNCH_MODE
#define N_LAUNCH_MODE 1
#endif

#define DEVI __device__ __forceinline__
#define LDS __attribute__((address_space(3)))

typedef _Float16 h16;
typedef _Float16 h16x4 __attribute__((ext_vector_type(4)));
typedef _Float16 h16x8 __attribute__((ext_vector_type(8)));
typedef float f32x4 __attribute__((ext_vector_type(4)));
typedef float f32x16 __attribute__((ext_vector_type(16)));
typedef unsigned u32x2 __attribute__((ext_vector_type(2)));
typedef unsigned u32x4 __attribute__((ext_vector_type(4)));

constexpr int NBATCH = 4, SEQ = 8192, NTOK = NBATCH * SEQ, DM = 1024;
constexpr int NTHR = 512;
constexpr int NPHASE = 10;
constexpr int LDS_BYTES = 163840;

constexpr size_t MiB = 1ull << 20;
constexpr size_t WS_CNT = 0;
constexpr size_t CTL_ZERO_BYTES = 20480;
constexpr size_t WS_BAR = 4096;
constexpr size_t WS_MODP = 64 * 1024;
constexpr size_t WS_ROPE = 1 * MiB;
constexpr size_t WS_WIN = 3 * MiB;
constexpr size_t WS_WOUT = 10 * MiB;
constexpr size_t WS_WGU = 12 * MiB;
constexpr size_t WS_WDN = 44 * MiB;
constexpr size_t WS_WRG = 60 * MiB;
constexpr size_t WS_WRT = 60 * MiB + 256 * 1024;
constexpr size_t WS_WRH = 60 * MiB + 512 * 1024;
constexpr size_t WS_WRL = 60 * MiB + 640 * 1024;
constexpr size_t WS_AGG = 61 * MiB;
constexpr size_t WS_ROUTE = 63 * MiB;
constexpr size_t WS_LIST = 64 * MiB;
constexpr size_t WS_LISTW = 68 * MiB;
constexpr size_t WS_WI = 72 * MiB;
constexpr size_t WS_KI = 73 * MiB;
constexpr size_t WS_MASK = 77 * MiB;
constexpr size_t WS_H = 109 * MiB;
constexpr size_t WS_Q = 173 * MiB;
constexpr size_t WS_K = 205 * MiB;
constexpr size_t WS_VT = 237 * MiB;
constexpr size_t WS_QI = 269 * MiB;
constexpr size_t WS_XR = 301 * MiB;
constexpr size_t WS_XG = 333 * MiB;
constexpr size_t WS_MIX = 365 * MiB;
constexpr size_t WS_ACT = 429 * MiB;
constexpr size_t WS_YP = 173 * MiB;
constexpr size_t WS_END = 510 * MiB;
constexpr size_t SC_BATCH_BYTES = 8192ull * 6176ull;
static_assert(SC_BATCH_BYTES <= 64 * MiB && WS_MIX + 3 * SC_BATCH_BYTES <= WS_END, "score slots");

struct Params { const float* in[24]; float* out; unsigned char* ws; int ph_lo, ph_hi; };
typedef const __attribute__((address_space(4))) Params& PRef;
typedef const __attribute__((address_space(4))) Params* PPtr;

__device__ const double ROPE_REV[32] = {
  1.59154943091895345608e-01, 1.19349370211248861917e-01, 8.94994016088910132600e-02, 6.71150830052272551196e-02,
  5.03292121044870352509e-02, 3.77415847174197710556e-02, 2.83021958306233986646e-02, 2.12236527647776604399e-02,
  1.59154943091895338669e-02, 1.19349370211248861917e-02, 8.94994016088910236684e-03, 6.71150830052272533849e-03,
  5.03292121044870369856e-03, 3.77415847174197719230e-03, 2.83021958306233986646e-03, 2.12236527647776621747e-03,
  1.59154943091895356017e-03, 1.19349370211248848907e-03, 8.94994016088910236684e-04, 6.71150830052272598901e-04,
  5.03292121044870326488e-04, 3.77415847174197740914e-04, 2.83021958306233954120e-04, 2.12236527647776605484e-04,
  1.59154943091895350596e-04, 1.19349370211248862459e-04, 8.94994016088910182474e-05, 6.71150830052272544691e-05,
  5.03292121044870353593e-05, 3.77415847174197768019e-05, 2.83021958306233960897e-05, 2.12236527647776591931e-05};

DEVI int launder(int x) { asm volatile("" : "+v"(x)); return x; }
DEVI PPtr get_params() { PPtr k = (PPtr)__builtin_amdgcn_kernarg_segment_ptr(); asm volatile("" : "+s"(k)); return k; }
DEVI int wave_id(int tid) { return __builtin_amdgcn_readfirstlane(tid >> 6); }
DEVI f32x16 mfma16(h16x8 a, h16x8 b, f32x16 c) { return __builtin_amdgcn_mfma_f32_32x32x16_f16(a, b, c, 0, 0, 0); }
DEVI float wave_sum(float v) {
#pragma unroll
  for (int o = 1; o < 64; o <<= 1) v += __shfl_xor(v, o);
  return v;
}
DEVI float sigmoid_f(float x) { return __builtin_amdgcn_rcpf(1.f + __expf(-x)); }
DEVI float silu_f(float x) { return x * __builtin_amdgcn_rcpf(1.f + __expf(-x)); }
DEVI float gelu_tanh_f(float x) {
  const float u = 0.7978845608028654f * (x + 0.044715f * x * x * x);
  const float t = 1.f - 2.f * __builtin_amdgcn_rcpf(1.f + __expf(2.f * u));
  return 0.5f * x * (1.f + t);
}
DEVI unsigned fkey(float f) { unsigned u = __float_as_uint(f); return (u & 0x80000000u) ? ~u : (u | 0x80000000u); }
DEVI float fkey_inv(unsigned k) { unsigned u = (k & 0x80000000u) ? (k & 0x7fffffffu) : ~k; return __uint_as_float(u); }
DEVI int vt_perm(int pos) { return (pos & ~12) | ((pos & 4) << 1) | ((pos & 8) >> 1); }

DEVI void mod_to_lds(PRef p, int b, int chunk, LDS float* dst) {
  const float* mp = (const float*)(p.ws + WS_MODP);
  for (int k = threadIdx.x; k < 1024; k += NTHR) {
    const int j = chunk * 1024 + k;
    float s = p.in[3][j];
#pragma unroll 1
    for (int ks = 0; ks < 8; ++ks) s += mp[(size_t)(ks * 4 + b) * 6144 + j];
    dst[k] = s;
  }
}

constexpr int LROW = 144;
constexpr int GA_BYTES = 256 * LROW, GB_BYTES = 128 * LROW, GSTAGE = GA_BYTES + GB_BYTES;

template <class AR, class EPI>
DEVI void gemm_tile(LDS unsigned char* lds, const AR& arow, const h16* Bt, int ldb, int K, EPI& epi) {
  const int tid = launder((int)threadIdx.x), lane = tid & 63, wave = wave_id(tid), wm = wave >> 1, wn = wave & 1;
  const int lr = tid >> 3, lc = tid & 7, l31 = lane & 31, half = lane >> 5;
  const h16* pa[4]; const h16* pb[2];
#pragma unroll
  for (int j = 0; j < 4; ++j) pa[j] = arow(lr + 64 * j) + lc * 8;
#pragma unroll
  for (int j = 0; j < 2; ++j) pb[j] = Bt + (size_t)(lr + 64 * j) * ldb + lc * 8;
  h16x8 ra[4], rb[2];
#pragma unroll
  for (int j = 0; j < 4; ++j) ra[j] = *(const h16x8*)pa[j];
#pragma unroll
  for (int j = 0; j < 2; ++j) rb[j] = *(const h16x8*)pb[j];
#pragma unroll
  for (int j = 0; j < 4; ++j) *(LDS h16x8*)(lds + (lr + 64 * j) * LROW + lc * 16) = ra[j];
#pragma unroll
  for (int j = 0; j < 2; ++j) *(LDS h16x8*)(lds + GA_BYTES + (lr + 64 * j) * LROW + lc * 16) = rb[j];
  __syncthreads();
  f32x16 acc[2][2];
#pragma unroll
  for (int a = 0; a < 2; ++a)
#pragma unroll
    for (int b = 0; b < 2; ++b)
#pragma unroll
      for (int r = 0; r < 16; ++r) acc[a][b][r] = 0.f;
  const int KT = K >> 6;
  for (int kt = 0; kt < KT; ++kt) {
    const int cur = kt & 1;
    if (kt + 1 < KT) {
#pragma unroll
      for (int j = 0; j < 4; ++j) ra[j] = *(const h16x8*)(pa[j] + (kt + 1) * 64);
#pragma unroll
      for (int j = 0; j < 2; ++j) rb[j] = *(const h16x8*)(pb[j] + (kt + 1) * 64);
    }
    LDS unsigned char* A = lds + cur * GSTAGE;
    LDS unsigned char* B = A + GA_BYTES;
#pragma unroll
    for (int kk = 0; kk < 4; ++kk) {
      h16x8 af[2], bf[2];
#pragma unroll
      for (int mi = 0; mi < 2; ++mi) af[mi] = *(LDS h16x8*)(A + (64 * wm + 32 * mi + l31) * LROW + (2 * kk + half) * 16);
#pragma unroll
      for (int ni = 0; ni < 2; ++ni) bf[ni] = *(LDS h16x8*)(B + (64 * wn + 32 * ni + l31) * LROW + (2 * kk + half) * 16);
#pragma unroll
      for (int mi = 0; mi < 2; ++mi)
#pragma unroll
        for (int ni = 0; ni < 2; ++ni) acc[mi][ni] = mfma16(bf[ni], af[mi], acc[mi][ni]);
    }
    if (kt + 1 < KT) {
      LDS unsigned char* A2 = lds + (cur ^ 1) * GSTAGE;
#pragma unroll
      for (int j = 0; j < 4; ++j) *(LDS h16x8*)(A2 + (lr + 64 * j) * LROW + lc * 16) = ra[j];
#pragma unroll
      for (int j = 0; j < 2; ++j) *(LDS h16x8*)(A2 + GA_BYTES + (lr + 64 * j) * LROW + lc * 16) = rb[j];
    }
    __syncthreads();
  }
  epi(acc, wm, wn, lane);
}


namespace g8 {
constexpr int BM = 256, BK = 64, HALF = 128, HTB = HALF * BK * 2, STAGE_BYTES = 8 * HTB;
DEVI int lds_byte(int r, int c) { const int st = (r >> 4) * 2 + (c >> 5), rr = r & 15, cc = c & 31, ob = rr * 64 + cc * 2; return st * 1024 + (ob ^ (((ob >> 9) & 1) << 5)); }
DEVI void stage_rc(int b, int& R, int& C) { const int st = b / 1024, sb = b % 1024, swz = sb ^ (((sb >> 9) & 1) << 5); R = (st >> 1) * 16 + swz / 64; C = (st & 1) * 32 + (swz % 64) / 2; }
struct Unit { const char* A; unsigned va[2][2]; const char* B; int pm, pn, e, cnt, off; };
DEVI void glds16(const char* src, LDS unsigned char* dst) { __builtin_amdgcn_global_load_lds((const unsigned*)src, (LDS unsigned*)dst, 16, 0, 0); }

DEVI void dense_va(unsigned (&va)[2][2], int K) {
  const int tid = threadIdx.x;
#pragma unroll
  for (int h = 0; h < 2; ++h)
#pragma unroll
    for (int i = 0; i < 2; ++i) { int R, C; stage_rc(tid * 16 + i * 8192, R, C); va[h][i] = (unsigned)((128 * h + R) * K + C) * 2u; }
}
template <class Sched, class Epi>
DEVI void gemm_phase(LDS unsigned char* lds, int K, const Sched& S, const Epi& E) {
  const int tid = launder((int)threadIdx.x), wid = wave_id(tid), lane = tid & 63, wr = wid >> 2, wc = wid & 3, fr = lane & 15, fq = lane >> 4;
  const int nt = launder(K) / BK;
  unsigned vb[2];
#pragma unroll
  for (int i = 0; i < 2; ++i) { int R, C; stage_rc(tid * 16 + i * 8192, R, C); vb[i] = (unsigned)(R * K + C) * 2u; }
  const size_t kstep = (size_t)(BK * 2), hstep = (size_t)HALF * K * 2;
  const unsigned ldsw = (unsigned)wid * 1024u;
  const int aoff = lds_byte(wr * 64 + fr, fq * 8), boff = lds_byte(wc * 32 + fr, fq * 8);
#define G8_SA(b, h) (((b) * 2 + (h)) * HTB)
#define G8_SB(b, h) ((4 + (b) * 2 + (h)) * HTB)
#define G8_STAGE(bufoff, gbase, v) do { glds16((gbase) + (v)[0], lds + (bufoff) + ldsw); glds16((gbase) + (v)[1], lds + (bufoff) + ldsw + 8192); } while (0)
#define G8_STAGEA(bufoff, gbase, h) do { glds16((gbase) + G8_VAC(h, 0), lds + (bufoff) + ldsw); glds16((gbase) + G8_VAC(h, 1), lds + (bufoff) + ldsw + 8192); } while (0)
#define G8_LDA(dst, b, h) do { _Pragma("unroll") for (int m = 0; m < 4; ++m) _Pragma("unroll") for (int k = 0; k < 2; ++k) dst[m][k] = *(const LDS h16x8*)(lds + G8_SA(b, h) + aoff + m * 2048 + k * 1024); } while (0)
#define G8_LDB(dst, b, h) do { _Pragma("unroll") for (int n = 0; n < 2; ++n) _Pragma("unroll") for (int k = 0; k < 2; ++k) dst[n][k] = *(const LDS h16x8*)(lds + G8_SB(b, h) + boff + n * 2048 + k * 1024); } while (0)
#define G8_MMA(ai, bj, At, Bt) do { __builtin_amdgcn_s_setprio(1); _Pragma("unroll") for (int m = 0; m < 4; ++m) _Pragma("unroll") for (int n = 0; n < 2; ++n) _Pragma("unroll") for (int k = 0; k < 2; ++k) \
        acc[ai][bj][m][n] = __builtin_amdgcn_mfma_f32_16x16x32_f16(Bt[n][k], At[m][k], acc[ai][bj][m][n], 0, 0, 0); __builtin_amdgcn_s_setprio(0); } while (0)
#define G8_WAIT_V(n) asm volatile("s_waitcnt vmcnt(" #n ")" ::: "memory")
#define G8_WAIT_L(n) asm volatile("s_waitcnt lgkmcnt(" #n ")" ::: "memory")
#define G8_BAR __builtin_amdgcn_s_barrier()
#define G8_SCHED __builtin_amdgcn_sched_barrier(0)
  Unit cur, nxt; int ui = 0;
  if (!S.next(0, cur)) return;
  unsigned vd[2][2];
  if (!Sched::GATHER) dense_va(vd, K);
#define G8_VAC(h, i) (Sched::GATHER ? cur.va[h][i] : vd[h][i])
#define G8_VAN(h, i) (Sched::GATHER ? nxt.va[h][i] : vd[h][i])
  f32x4 acc[2][2][4][2];
#pragma unroll
  for (int a = 0; a < 2; ++a)
#pragma unroll
    for (int b = 0; b < 2; ++b)
#pragma unroll
      for (int m = 0; m < 4; ++m)
#pragma unroll
        for (int n = 0; n < 2; ++n) acc[a][b][m][n] = (f32x4){0.f, 0.f, 0.f, 0.f};
  h16x8 At[4][2], B0[2][2], B1[2][2];
  const char* cA = cur.A; const char* cB = cur.B;
  G8_STAGE(G8_SB(0, 0), cB, vb); G8_STAGE(G8_SB(0, 1), cB + hstep, vb); G8_STAGEA(G8_SA(0, 0), cA, 0); G8_STAGEA(G8_SA(0, 1), cA, 1);
  if (wr == 1) G8_BAR;
  G8_WAIT_V(2); G8_BAR;
  G8_STAGE(G8_SB(1, 0), cB + kstep, vb); G8_STAGEA(G8_SA(1, 0), cA + kstep, 0); G8_STAGE(G8_SB(1, 1), cB + hstep + kstep, vb);
  G8_WAIT_V(6); G8_BAR;
  for (;;) {
    const bool has_next = S.next(ui + 1, nxt);
    if (!has_next) nxt = cur;
    const char* nA = nxt.A; const char* nB = nxt.B;
#pragma unroll 1
    for (int t = 0; t < nt; t += 2) {
      const bool last = (t == nt - 2);
      const char* a1 = cA + (size_t)(t + 1) * kstep;
      const char* a2 = last ? nA : cA + (size_t)(t + 2) * kstep; const char* b2 = last ? nB : cB + (size_t)(t + 2) * kstep;
      const char* a3 = a2 + kstep; const char* b3 = b2 + kstep;
#define G8_STAGE2(bufoff, gbase, h) do { glds16((gbase) + (last ? G8_VAN(h, 0) : G8_VAC(h, 0)), lds + (bufoff) + ldsw); glds16((gbase) + (last ? G8_VAN(h, 1) : G8_VAC(h, 1)), lds + (bufoff) + ldsw + 8192); } while (0)
      G8_LDB(B0, 0, 0); G8_LDB(B1, 0, 1); G8_SCHED; G8_LDA(At, 0, 0); G8_STAGEA(G8_SA(1, 1), a1, 1);
      G8_WAIT_V(8); G8_WAIT_L(0); G8_BAR; G8_MMA(0, 0, At, B0); G8_MMA(0, 1, At, B1); G8_BAR; G8_SCHED;
      G8_LDA(At, 0, 1); G8_STAGE(G8_SB(0, 0), b2, vb); G8_STAGE(G8_SB(0, 1), b2 + hstep, vb); G8_STAGE2(G8_SA(0, 0), a2, 0);
      G8_WAIT_V(8); G8_WAIT_L(0); G8_BAR; G8_MMA(1, 0, At, B0); G8_MMA(1, 1, At, B1); G8_BAR; G8_SCHED;
      G8_LDB(B0, 1, 0); G8_LDB(B1, 1, 1); G8_SCHED; G8_LDA(At, 1, 0); G8_STAGE2(G8_SA(0, 1), a2, 1);
      G8_WAIT_V(8); G8_WAIT_L(0); G8_BAR; G8_MMA(0, 0, At, B0); G8_MMA(0, 1, At, B1); G8_BAR; G8_SCHED;
      G8_LDA(At, 1, 1); G8_STAGE(G8_SB(1, 0), b3, vb); G8_STAGE(G8_SB(1, 1), b3 + hstep, vb); G8_STAGE2(G8_SA(1, 0), a3, 0);
      G8_WAIT_V(8); G8_WAIT_L(0); G8_BAR; G8_MMA(1, 0, At, B0); G8_MMA(1, 1, At, B1); G8_BAR; G8_SCHED;
    }
#undef G8_STAGE2
    if (wr == 0) G8_BAR;
    E(acc, cur, wr, wc, fr, fq);
    if (!has_next) break;
#pragma unroll
    for (int a = 0; a < 2; ++a)
#pragma unroll
      for (int b = 0; b < 2; ++b)
#pragma unroll
        for (int m = 0; m < 4; ++m)
#pragma unroll
          for (int n = 0; n < 2; ++n) acc[a][b][m][n] = (f32x4){0.f, 0.f, 0.f, 0.f};
    cur = nxt; cA = nA; cB = nB; ++ui;
    if (wr == 1) G8_BAR;
  }
  G8_WAIT_V(0);
  G8_BAR;
#undef G8_SA
#undef G8_STAGEA
#undef G8_VAC
#undef G8_VAN
#undef G8_SB
#undef G8_STAGE
#undef G8_LDA
#undef G8_LDB
#undef G8_MMA
#undef G8_WAIT_V
#undef G8_WAIT_L
#undef G8_BAR
#undef G8_SCHED
}
struct DenseOrder {
  static constexpr bool GATHER = false;
  const h16* A; const h16* Bt; int K, nM, nN, G, c;
  DEVI bool next(int i, Unit& u) const {
    const int nwg = nM * nN; const long L = (long)i * G + c; if (L >= nwg) return false;
    int wgid = (int)L; { const int q = nwg / 8, r = nwg % 8, xcd = wgid % 8, off = wgid / 8; wgid = (xcd < r ? xcd * (q + 1) : r * (q + 1) + (xcd - r) * q) + off; }
    const int nig = 8 * nN, gid = wgid / nig, fm = gid * 8, gsz = (nM - fm) < 8 ? (nM - fm) : 8;
    u.pm = fm + ((wgid % nig) % gsz); u.pn = (wgid % nig) / gsz; u.e = 0; u.cnt = 0x7fffffff; u.off = 0;
    u.A = (const char*)(A + (size_t)u.pm * 256 * K); u.B = (const char*)(Bt + (size_t)u.pn * 256 * K);
    u.va[0][0] = u.va[0][1] = u.va[1][0] = u.va[1][1] = 0u;
    return true;
  }
};
}

struct ARowPlain { const h16* base; size_t ld; DEVI const h16* operator()(int r) const { return base + (size_t)r * ld; } };
struct ARowGather { const h16* base; const unsigned* list; int n; int row0; DEVI const h16* operator()(int r) const { const int i = row0 + r; const unsigned t = (i < n) ? list[i] : 0u; return base + (size_t)t * DM; } };

DEVI h16x4 pack4(float a, float b, float c, float d) { h16x4 v; v[0] = (h16)a; v[1] = (h16)b; v[2] = (h16)c; v[3] = (h16)d; return v; }

template <class F>
DEVI void transpose_item(const float* src, int N, int kb, int nb, h16* dst, int ldd, F drow, LDS float* scr, int lane) {
#pragma unroll 8
  for (int i = 0; i < 32; ++i) {
    const int kk = 2 * i + (lane >> 5), n = nb * 32 + (lane & 31);
    scr[kk * 33 + (lane & 31)] = (n < N) ? src[(size_t)(kb * 64 + kk) * N + n] : 0.f;
  }
  asm volatile("s_waitcnt lgkmcnt(0)" ::: "memory");
  const int c = lane & 7;
#pragma unroll
  for (int j = 0; j < 4; ++j) {
    const int nl = (lane >> 3) + 8 * j, n = nb * 32 + nl;
    h16x8 v;
#pragma unroll
    for (int e = 0; e < 8; ++e) v[e] = (h16)scr[(c * 8 + e) * 33 + nl];
    if (n < N) *(h16x8*)(dst + (size_t)drow(n) * ldd + kb * 64 + c * 8) = v;
  }
  asm volatile("s_waitcnt lgkmcnt(0)" ::: "memory");
}

DEVI void phase0(PRef p, LDS unsigned char* lds) {
  const int tid = launder((int)threadIdx.x), lane = tid & 63, wave = wave_id(tid), G = gridDim.x;
  const int gw = blockIdx.x * 8 + wave, NW = G * 8;
  {
    const float* c = p.in[1]; const float* wada = p.in[2]; float* mp = (float*)(p.ws + WS_MODP);
    for (int u = gw; u < 96 * 8; u += NW) {
      const int cgp = u % 96, ks = u / 96, j = cgp * 64 + lane;
      float a0 = 0.f, a1 = 0.f, a2 = 0.f, a3 = 0.f;
      for (int k = ks * 128; k < ks * 128 + 128; ++k) {
        const float w = wada[(size_t)k * 6144 + j];
        a0 = fmaf(silu_f(c[k]), w, a0); a1 = fmaf(silu_f(c[1024 + k]), w, a1);
        a2 = fmaf(silu_f(c[2048 + k]), w, a2); a3 = fmaf(silu_f(c[3072 + k]), w, a3);
      }
      mp[(size_t)(ks * 4 + 0) * 6144 + j] = a0; mp[(size_t)(ks * 4 + 1) * 6144 + j] = a1;
      mp[(size_t)(ks * 4 + 2) * 6144 + j] = a2; mp[(size_t)(ks * 4 + 3) * 6144 + j] = a3;
    }
  }
  {
    LDS float* scr = (LDS float*)lds + wave * (64 * 33);
    constexpr int I_IN = 16 * 99, I_OUT = 16 * 32, I_G = 32 * 128, I_U = 32 * 128, I_D = 32 * 128, I_RG = 32;
    constexpr int NIT = I_IN + I_OUT + I_G + I_U + I_D + I_RG;
    for (int it = gw; it < NIT; it += NW) {
      int r = it;
      if (r < I_IN) {
        transpose_item(p.in[8], 3144, r / 99, r % 99, (h16*)(p.ws + WS_WIN), 1024,
                       [](int n) { const int dl = n < 2112 ? n : (n < 2120 ? 3136 + (n - 2112) : (n < 2632 ? 2112 + (n - 2120) : 2624 + (n - 2632))); const int d = dl & 63; return (dl & ~63) + 32 * ((d >> 4) & 1) + 16 * (d >> 5) + (d & 15); }, scr, lane);
        continue;
      }
      r -= I_IN;
      if (r < I_OUT) { transpose_item(p.in[16], 1024, r / 32, r % 32, (h16*)(p.ws + WS_WOUT), 1024, [](int n) { return n; }, scr, lane); continue; }
      r -= I_OUT;
      if (r < I_G) { const int e = r >> 7, q = r & 127;
        transpose_item(p.in[21] + (size_t)e * 1024 * 256, 256, q >> 3, q & 7, (h16*)(p.ws + WS_WGU) + (size_t)e * 512 * 1024, 1024, [](int f) { return (f >> 4) * 32 + (f & 15); }, scr, lane); continue; }
      r -= I_G;
      if (r < I_U) { const int e = r >> 7, q = r & 127;
        transpose_item(p.in[22] + (size_t)e * 1024 * 256, 256, q >> 3, q & 7, (h16*)(p.ws + WS_WGU) + (size_t)e * 512 * 1024, 1024, [](int f) { return (f >> 4) * 32 + 16 + (f & 15); }, scr, lane); continue; }
      r -= I_U;
      if (r < I_D) { const int e = r >> 7, q = r & 127;
        transpose_item(p.in[23] + (size_t)e * 256 * 1024, 1024, q >> 5, q & 31, (h16*)(p.ws + WS_WDN) + (size_t)e * 1024 * 256, 256, [](int n) { return n; }, scr, lane); continue; }
      r -= I_D;
      if (r < 16) transpose_item(p.in[11] + (size_t)(r >> 1) * 4096, 64, 0, r & 1, (h16*)(p.ws + WS_WRG) + (size_t)(r >> 1) * 128 * 64, 64, [](int n) { return n; }, scr, lane);
      else transpose_item(p.in[13] + (size_t)((r - 16) >> 1) * 4096, 64, 0, r & 1, (h16*)(p.ws + WS_WRG) + (size_t)((r - 16) >> 1) * 128 * 64, 64, [](int n) { return 64 + n; }, scr, lane);
    }
  }
  {
    h16* wrh = (h16*)(p.ws + WS_WRH); h16* wrl = (h16*)(p.ws + WS_WRL);
    for (int i = blockIdx.x * NTHR + tid; i < 48 * 1024; i += G * NTHR) {
      const int col = i >> 10, k = i & 1023;
      const float w = (col < 4) ? p.in[17][k * 4 + col] : (col < 36 ? p.in[19][k * 32 + (col - 4)] : 0.f);
      const h16 hi = (h16)w;
      wrh[i] = hi; wrl[i] = (h16)(w - (float)hi);
    }
    float* ct = (float*)(p.ws + WS_ROPE); float* st = ct + 8192 * 32;
    for (int i = blockIdx.x * NTHR + tid; i < 8192 * 32; i += G * NTHR) {
      const int pos = i >> 5, f = i & 31;
      const double rev = (double)pos * ROPE_REV[f];
      const float fr = (float)(rev - __builtin_rint(rev));
      ct[i] = __builtin_amdgcn_cosf(fr); st[i] = __builtin_amdgcn_sinf(fr);
    }
  }
}

DEVI void phase1(PRef p, LDS unsigned char* lds) {
  const int tid = launder((int)threadIdx.x), lane = tid & 63, wave = wave_id(tid), G = gridDim.x;
  const int b = blockIdx.x & 3, bi = blockIdx.x >> 2, nbk = G >> 2;
  LDS float* mv = (LDS float*)lds;
  mod_to_lds(p, b, 0, mv); mod_to_lds(p, b, 1, mv + 1024);
  __syncthreads();
  f32x4 A[4], SH[4];
#pragma unroll
  for (int j = 0; j < 4; ++j) {
    const int k = 256 * j + 4 * lane;
    const f32x4 g = *(const f32x4*)(p.in[4] + k);
    A[j] = g * (*(LDS f32x4*)(mv + 1024 + k) + 1.f);
    SH[j] = *(LDS f32x4*)(mv + k);
  }
  const float* x = p.in[0]; h16* H = (h16*)(p.ws + WS_H);
  for (int r = bi * 8 + wave; r < SEQ; r += nbk * 8) {
    const size_t tok = (size_t)b * SEQ + r;
    f32x4 v[4]; float ss = 0.f;
#pragma unroll
    for (int j = 0; j < 4; ++j) { v[j] = *(const f32x4*)(x + tok * DM + 256 * j + 4 * lane); ss += v[j][0] * v[j][0] + v[j][1] * v[j][1] + v[j][2] * v[j][2] + v[j][3] * v[j][3]; }
    const float rstd = 1.0f / sqrtf(wave_sum(ss) * (1.f / 1024.f) + 1e-6f);
#pragma unroll
    for (int j = 0; j < 4; ++j) {
      const f32x4 y = v[j] * rstd * A[j] + SH[j];
      *(h16x4*)(H + tok * DM + 256 * j + 4 * lane) = pack4(y[0], y[1], y[2], y[3]);
    }
  }
}

struct EpiInProj {
  unsigned char* ws;
  DEVI void operator()(const f32x4 (&acc)[2][2][4][2], const g8::Unit& u, int wr, int wc, int fr, int fq) const {
    const float* cosT = (const float*)(ws + WS_ROPE); const float* sinT = cosT + 8192 * 32;
    const int w2 = wc & 1, dlow = 16 * w2 + 4 * fq;
#pragma unroll
    for (int bj = 0; bj < 2; ++bj) {
      const int g = 4 * u.pn + 2 * bj + (wc >> 1);
      if (g > 49) continue;
#pragma unroll
      for (int ai = 0; ai < 2; ++ai)
#pragma unroll
        for (int m = 0; m < 4; ++m) {
          const int tok = u.pm * 256 + 128 * ai + 64 * wr + 16 * m + fr;
          const int b = tok >> 13, pos = tok & 8191;
          const f32x4 x1 = acc[ai][bj][m][0], x2 = acc[ai][bj][m][1];
          if (g < 16 || (g >= 24 && g <= 32)) {
            float scl; h16* dst;
            if (g < 8) { scl = 0.125f * 1.4426950408889634f; dst = (h16*)(ws + WS_Q) + (size_t)tok * 512 + g * 64; }
            else if (g < 16) { scl = 1.f; dst = (h16*)(ws + WS_K) + (size_t)tok * 512 + (g - 8) * 64; }
            else if (g < 32) { scl = 0.125f; dst = (h16*)(ws + WS_QI) + (size_t)tok * 512 + (g - 24) * 64; }
            else { scl = 1.f; dst = (h16*)(ws + WS_KI) + (size_t)tok * 64; }
            const f32x4 c = *(const f32x4*)(cosT + pos * 32 + dlow), s = *(const f32x4*)(sinT + pos * 32 + dlow);
            const f32x4 o1 = (x1 * c - x2 * s) * scl, o2 = (x2 * c + x1 * s) * scl;
            *(h16x4*)(dst + dlow) = pack4(o1[0], o1[1], o1[2], o1[3]);
            *(h16x4*)(dst + 32 + dlow) = pack4(o2[0], o2[1], o2[2], o2[3]);
          } else if (g < 24) {
            h16* vt = (h16*)(ws + WS_VT) + (size_t)(b * 8 + (g - 16)) * 64 * 8192 + vt_perm(pos);
#pragma unroll
            for (int e = 0; e < 4; ++e) { vt[(size_t)(dlow + e) * 8192] = (h16)x1[e]; vt[(size_t)(32 + dlow + e) * 8192] = (h16)x2[e]; }
          } else if (g < 49) {
            h16* dst = (g < 41) ? (h16*)(ws + WS_XR) + (size_t)tok * 512 + (g - 33) * 64 : (h16*)(ws + WS_XG) + (size_t)tok * 512 + (g - 41) * 64;
            *(h16x4*)(dst + dlow) = pack4(x1[0], x1[1], x1[2], x1[3]);
            *(h16x4*)(dst + 32 + dlow) = pack4(x2[0], x2[1], x2[2], x2[3]);
          } else if (w2 == 0 && fq < 2) {
            const float sc = 0.35355339059327373f;
            *(f32x4*)((float*)(ws + WS_WI) + (size_t)tok * 8 + 4 * fq) = x1 * sc;
          }
        }
    }
  }
};

DEVI void phase2(PRef p, LDS unsigned char* lds) {
  g8::DenseOrder S{(const h16*)(p.ws + WS_H), (const h16*)(p.ws + WS_WIN), DM, 128, 13, (int)gridDim.x, (int)blockIdx.x};
  EpiInProj E{p.ws};
  g8::gemm_phase(lds, DM, S, E);
}

constexpr int CROW = 1040;
constexpr int RNN_XG = 64 * CROW;
constexpr int RNN_CARRY = 2 * 64 * CROW;
template <int MODE>
DEVI void rnn_item(PRef p, LDS unsigned char* lds, int b, int cr) {
  const int tid = launder((int)threadIdx.x), lane = tid & 63, wave = wave_id(tid), l31 = lane & 31, half = lane >> 5;
  const h16* XR = (const h16*)(p.ws + WS_XR);
  {
    const int chg = tid & 63, tg = tid >> 6, pos0 = cr * 64 + 8 * tg;
    h16x8 xin[11];
#pragma unroll
    for (int i = 0; i < 11; ++i) {
      const int pos = pos0 + i - 3;
      if (pos >= 0) xin[i] = *(const h16x8*)(XR + ((size_t)b * SEQ + pos) * 512 + chg * 8);
      else {
#pragma unroll
        for (int e = 0; e < 8; ++e) xin[i][e] = (h16)0.f;
      }
    }
    float cw[4][8], cb[8];
#pragma unroll
    for (int e = 0; e < 8; ++e) {
      cb[e] = p.in[10][chg * 8 + e];
#pragma unroll
      for (int j = 0; j < 4; ++j) cw[j][e] = p.in[9][j * 512 + chg * 8 + e];
    }
#pragma unroll
    for (int tt = 0; tt < 8; ++tt) {
      h16x8 o;
#pragma unroll
      for (int e = 0; e < 8; ++e) {
        float v = cb[e];
#pragma unroll
        for (int j = 0; j < 4; ++j) v = fmaf(cw[j][e], (float)xin[tt + j][e], v);
        o[e] = (h16)v;
      }
      *(LDS h16x8*)(lds + (8 * tg + tt) * CROW + chg * 16) = o;
    }
  }
  if (MODE == 1) {
    const float2* ag = (const float2*)(p.ws + WS_AGG) + (size_t)b * 128 * 512 + tid;
    float carry = 0.f; int c2 = 0;
    for (; c2 + 8 <= cr; c2 += 8) {
      float2 v[8];
#pragma unroll
      for (int u = 0; u < 8; ++u) v[u] = ag[(size_t)(c2 + u) * 512];
#pragma unroll
      for (int u = 0; u < 8; ++u) carry = fmaf(v[u].x, carry, v[u].y);
    }
    for (; c2 < cr; ++c2) { const float2 v = ag[(size_t)c2 * 512]; carry = fmaf(v.x, carry, v.y); }
    ((LDS float*)(lds + RNN_CARRY))[tid] = carry;
  }
  if (MODE == 1) {
    const h16* XG = (const h16*)(p.ws + WS_XG) + ((size_t)b * SEQ + cr * 64) * 512;
#pragma unroll
    for (int i = 0; i < 8; ++i) { const int c = tid + NTHR * i, row = c >> 6, cc = c & 63; *(LDS h16x8*)(lds + RNN_XG + row * CROW + cc * 16) = *(const h16x8*)(XG + (size_t)row * 512 + cc * 8); }
  }
  __syncthreads();
  const int n = wave;
  const h16* WRG = (const h16*)(p.ws + WS_WRG) + (size_t)n * 128 * 64;
  float* AGG = (float*)(p.ws + WS_AGG);
#pragma unroll 1
  for (int dt = 0; dt < 2; ++dt) {
    h16x8 wa[4], wx[4];
#pragma unroll
    for (int kk = 0; kk < 4; ++kk) {
      wa[kk] = *(const h16x8*)(WRG + (size_t)(32 * dt + l31) * 64 + 16 * kk + 8 * half);
      wx[kk] = *(const h16x8*)(WRG + (size_t)(64 + 32 * dt + l31) * 64 + 16 * kk + 8 * half);
    }
    f32x16 ra[2], rx[2];
#pragma unroll
    for (int ti = 0; ti < 2; ++ti) {
#pragma unroll
      for (int r = 0; r < 16; ++r) { ra[ti][r] = 0.f; rx[ti][r] = 0.f; }
#pragma unroll
      for (int kk = 0; kk < 4; ++kk) {
        const h16x8 af = *(LDS h16x8*)(lds + (32 * ti + l31) * CROW + (n * 64 + 16 * kk + 8 * half) * 2);
        ra[ti] = mfma16(af, wa[kk], ra[ti]);
        rx[ti] = mfma16(af, wx[kk], rx[ti]);
      }
    }
    const int ch = n * 64 + 32 * dt + l31;
    const float ba = p.in[12][ch], bx = p.in[14][ch], lam = p.in[15][ch];
    const float c8 = -8.f * log1pf(__expf(-lam));
#pragma unroll
    for (int ti = 0; ti < 2; ++ti)
#pragma unroll
      for (int r = 0; r < 16; ++r) {
        const int tk = 32 * ti + (r & 3) + 8 * (r >> 2) + 4 * half;
        const float cv = (float)*(LDS h16*)(lds + tk * CROW + ch * 2);
        const float rr = sigmoid_f(ra[ti][r] + ba), ii = sigmoid_f(rx[ti][r] + bx);
        const float la = c8 * rr;
        ra[ti][r] = __expf(la);
        const float x2 = 2.f * la;
        const float om = -x2 * fmaf(x2 * 0.5f, fmaf(x2 * (1.f / 3.f), fmaf(x2 * 0.25f, fmaf(x2, 0.2f, 1.f), 1.f), 1.f), 1.f);
        rx[ti][r] = __builtin_amdgcn_sqrtf(om) * (ii * cv);
      }
    float P[8], Hs[8];
#pragma unroll
    for (int sg = 0; sg < 8; ++sg) {
      const int ti = sg >> 2, q = sg & 3;
      float pp = 1.f, hh = 0.f;
#pragma unroll
      for (int i = 0; i < 4; ++i) { const float a = ra[ti][4 * q + i], bb = rx[ti][4 * q + i]; hh = fmaf(a, hh, bb); pp *= a; }
      P[sg] = pp; Hs[sg] = hh;
    }
    float carry = 0.f, prod = 1.f;
    if (MODE == 1) carry = ((LDS float*)(lds + RNN_CARRY))[ch];
    float cin[8];
#pragma unroll
    for (int sg = 0; sg < 8; ++sg)
#pragma unroll
      for (int ow = 0; ow < 2; ++ow) {
        const float tmp = fmaf(P[sg], carry, Hs[sg]);
        const float tp = P[sg] * prod;
        if (half == ow) cin[sg] = carry;
        const float oth = __shfl_xor(tmp, 32), otp = __shfl_xor(tp, 32);
        carry = (half == ow) ? tmp : oth;
        prod = (half == ow) ? tp : otp;
      }
    if (MODE == 0) {
      if (half == 0) { float* ag = AGG + ((size_t)(b * 128 + cr) * 512 + ch) * 2; ag[0] = prod; ag[1] = carry; }
    } else {
#pragma unroll
      for (int sg = 0; sg < 8; ++sg) {
        const int ti = sg >> 2, q = sg & 3;
        float hh = cin[sg];
#pragma unroll
        for (int i = 0; i < 4; ++i) {
          hh = fmaf(ra[ti][4 * q + i], hh, rx[ti][4 * q + i]);
          LDS h16* xp = (LDS h16*)(lds + RNN_XG + (32 * ti + 8 * q + 4 * half + i) * CROW + ch * 2);
          *xp = (h16)(hh * gelu_tanh_f((float)*xp));
        }
      }
    }
  }
  __syncthreads();
  if (MODE == 1) {
    h16* Y = (h16*)(p.ws + WS_H) + ((size_t)b * SEQ + cr * 64) * DM + 512;
#pragma unroll
    for (int i = 0; i < 8; ++i) { const int c = tid + NTHR * i, row = c >> 6, cc = c & 63; *(h16x8*)(Y + (size_t)row * DM + cc * 8) = *(LDS h16x8*)(lds + RNN_XG + row * CROW + cc * 16); }
    __syncthreads();
  }
}

constexpr int IDX_NB = 256, IDX_CAP = 128;
constexpr int IL_HIST = 0, IL_CS = 65536, IL_CK = IL_CS + 64 * IDX_CAP * 4, IL_KI = IL_CK + 64 * IDX_CAP * 2, IL_KISZ = 128 * LROW, IL_ST = IL_KI + 2 * IL_KISZ;
static_assert(IL_ST + 4096 <= LDS_BYTES, "indexer LDS map");

DEVI f32x4 mfma16s(h16x8 a, h16x8 b, f32x4 c) { return __builtin_amdgcn_mfma_f32_16x16x32_f16(a, b, c, 0, 0, 0); }
DEVI void idx_score(LDS unsigned char* kit, int kh, int l15, int g4, const h16x8 (&qf)[8][2], const float (&wq)[8], f32x4 (&sc)[4]) {
  h16x8 kf[4][2];
#pragma unroll
  for (int kt = 0; kt < 4; ++kt)
#pragma unroll
    for (int ks = 0; ks < 2; ++ks) kf[kt][ks] = *(LDS h16x8*)(kit + (64 * kh + 16 * kt + l15) * LROW + (4 * ks + g4) * 16);
#pragma unroll
  for (int kt = 0; kt < 4; ++kt) sc[kt] = (f32x4){0.f, 0.f, 0.f, 0.f};
  f32x4 accA[4], accB[4];
#define IDX_MM(ACC, h) _Pragma("unroll") for (int kt = 0; kt < 4; ++kt) { ACC[kt] = mfma16s(kf[kt][0], qf[h][0], (f32x4){0.f, 0.f, 0.f, 0.f}); ACC[kt] = mfma16s(kf[kt][1], qf[h][1], ACC[kt]); }
#define IDX_RS(ACC, h) _Pragma("unroll") for (int kt = 0; kt < 4; ++kt) _Pragma("unroll") for (int r = 0; r < 4; ++r) sc[kt][r] = __builtin_fmaf(wq[h], __int_as_float(max(__float_as_int(ACC[kt][r]), 0)), sc[kt][r]);
  IDX_MM(accA, 0)
  IDX_MM(accB, 1) IDX_RS(accA, 0)
  IDX_MM(accA, 2) IDX_RS(accB, 1)
  IDX_MM(accB, 3) IDX_RS(accA, 2)
  IDX_MM(accA, 4) IDX_RS(accB, 3)
  IDX_MM(accB, 5) IDX_RS(accA, 4)
  IDX_MM(accA, 6) IDX_RS(accB, 5)
  IDX_MM(accB, 7) IDX_RS(accA, 6)
  IDX_RS(accB, 7)
#undef IDX_MM
#undef IDX_RS
}

template <int MODE>
DEVI void idx_pass(LDS unsigned char* lds, const h16* KIb, int N, int stride, int qg, int kh,
                   const h16* QIrow0, const float* WIrow0, float qinv, float qoff, int bstar, h16* scbase) {
  const int tid = launder((int)threadIdx.x), lane = tid & 63, l15 = lane & 15, g4 = lane >> 4;
  const int q = 16 * qg + l15;
  h16x8 qf[8][2]; float wq[8];
  {
    const h16* QI = QIrow0 + (size_t)q * 512;
#pragma unroll
    for (int h = 0; h < 8; ++h)
#pragma unroll
      for (int ks = 0; ks < 2; ++ks) qf[h][ks] = *(const h16x8*)(QI + h * 64 + 32 * ks + 8 * g4);
    const float* WI = WIrow0 + (size_t)q * 8;
#pragma unroll
    for (int h = 0; h < 8; ++h) wq[h] = WI[h];
  }
  LDS unsigned* hist = (LDS unsigned*)(lds + IL_HIST);
  LDS unsigned* st = (LDS unsigned*)(lds + IL_ST);
  const int nst = (N + 127) >> 7;
  const int lr = tid >> 3, lc = tid & 7;
  h16x8 r0, r1;
  r0 = *(const h16x8*)(KIb + (size_t)lr * 64 + lc * 8); r1 = *(const h16x8*)(KIb + (size_t)(lr + 64) * 64 + lc * 8);
  *(LDS h16x8*)(lds + IL_KI + lr * LROW + lc * 16) = r0; *(LDS h16x8*)(lds + IL_KI + (lr + 64) * LROW + lc * 16) = r1;
  __syncthreads();
  float vmin = INFINITY, vmax = -INFINITY;
  int cur = 0;
  for (int s = 0; s < nst; s += stride) {
    const int nx = s + stride;
    if (nx < nst) { r0 = *(const h16x8*)(KIb + (size_t)(128 * nx + lr) * 64 + lc * 8); r1 = *(const h16x8*)(KIb + (size_t)(128 * nx + lr + 64) * 64 + lc * 8); }
    if (128 * s + 64 * kh < N) {
      f32x4 sc[4];
      idx_score(lds + IL_KI + cur * IL_KISZ, kh, l15, g4, qf, wq, sc);
      if (MODE == 0) {
#pragma unroll
        for (int kt = 0; kt < 4; ++kt)
#pragma unroll
          for (int r = 0; r < 4; ++r) { vmin = fminf(vmin, sc[kt][r]); vmax = fmaxf(vmax, sc[kt][r]); }
      } else if (MODE == 1) {
        h16* scp = scbase + ((size_t)((s * 2 + kh) * 4) * 1024 + q * 16 + 4 * g4);
#pragma unroll
        for (int kt = 0; kt < 4; ++kt) {
          const h16x4 hv = pack4(sc[kt][0], sc[kt][1], sc[kt][2], sc[kt][3]);
          *(h16x4*)(scp + kt * 1024) = hv;
#pragma unroll
          for (int r = 0; r < 4; ++r) {
            const float xb = fminf(fmaxf(__builtin_fmaf((float)hv[r], qinv, qoff), 0.f), (float)(IDX_NB - 1));
            const int bin = (int)xb;
            __hip_atomic_fetch_add(&hist[bin * 64 + q], 1u, __ATOMIC_RELAXED, __HIP_MEMORY_SCOPE_WORKGROUP);
          }
        }
      } else {
        unsigned nib = 0u;
#pragma unroll
        for (int kt = 0; kt < 4; ++kt)
#pragma unroll
          for (int r = 0; r < 4; ++r) {
            const float xb = fminf(fmaxf(__builtin_fmaf(sc[kt][r], qinv, qoff), 0.f), (float)(IDX_NB - 1));
            const int bin = (int)xb;
            if (bin > bstar) nib |= (1u << (4 * kt + r));
            else if (bin == bstar) {
              const unsigned pos = __hip_atomic_fetch_add(&st[128 + q], 1u, __ATOMIC_RELAXED, __HIP_MEMORY_SCOPE_WORKGROUP);
              if (pos < (unsigned)IDX_CAP) {
                ((LDS float*)(lds + IL_CS))[q * IDX_CAP + pos] = sc[kt][r];
                ((LDS unsigned short*)(lds + IL_CK))[q * IDX_CAP + pos] = (unsigned short)(128 * s + 64 * kh + 16 * kt + 4 * g4 + r);
              }
            }
          }
        const unsigned oth = (unsigned)__shfl_xor((int)nib, 32);
        if (lane < 32) {
#pragma unroll
          for (int T = 0; T < 2; ++T) {
            const unsigned b0 = ((nib >> (8 * T)) & 15u) | (((oth >> (8 * T)) & 15u) << 4);
            const unsigned b1 = ((nib >> (8 * T + 4)) & 15u) | (((oth >> (8 * T + 4)) & 15u) << 4);
            ((LDS unsigned short*)(lds + IL_HIST))[q * 512 + (4 * s + 2 * kh + T) * 2 + (g4 & 1)] = (unsigned short)(b0 | (b1 << 8));
          }
        }
      }
    }
    if (nx < nst) {
      *(LDS h16x8*)(lds + IL_KI + (cur ^ 1) * IL_KISZ + lr * LROW + lc * 16) = r0;
      *(LDS h16x8*)(lds + IL_KI + (cur ^ 1) * IL_KISZ + (lr + 64) * LROW + lc * 16) = r1;
    }
    __syncthreads();
    cur ^= 1;
  }
  if (MODE == 0) {
    __hip_atomic_fetch_min(&st[q], fkey(vmin), __ATOMIC_RELAXED, __HIP_MEMORY_SCOPE_WORKGROUP);
    __hip_atomic_fetch_max(&st[64 + q], fkey(vmax), __ATOMIC_RELAXED, __HIP_MEMORY_SCOPE_WORKGROUP);
  }
}

DEVI void idx_stream_step(LDS unsigned char* lds, LDS unsigned* st, const unsigned long long (&cur)[4], int s, int kh, int q, int lane, int g4, float qinv, float qoff, int bstar) {
  unsigned nib = 0u;
#pragma unroll
  for (int kt = 0; kt < 4; ++kt) {
    const h16x4 hv = __builtin_bit_cast(h16x4, cur[kt]);
#pragma unroll
    for (int r = 0; r < 4; ++r) {
      const float sv = (float)hv[r];
      const float xb = fminf(fmaxf(__builtin_fmaf(sv, qinv, qoff), 0.f), (float)(IDX_NB - 1));
      const int bin = (int)xb;
      if (bin > bstar) nib |= (1u << (4 * kt + r));
      else if (bin == bstar) {
        const unsigned pos = __hip_atomic_fetch_add(&st[128 + q], 1u, __ATOMIC_RELAXED, __HIP_MEMORY_SCOPE_WORKGROUP);
        if (pos < (unsigned)IDX_CAP) {
          ((LDS float*)(lds + IL_CS))[q * IDX_CAP + pos] = sv;
          ((LDS unsigned short*)(lds + IL_CK))[q * IDX_CAP + pos] = (unsigned short)(128 * s + 64 * kh + 16 * kt + 4 * g4 + r);
        }
      }
    }
  }
  const unsigned oth = (unsigned)__shfl_xor((int)nib, 32);
  if (lane < 32) {
#pragma unroll
    for (int T = 0; T < 2; ++T) {
      const unsigned b0 = ((nib >> (8 * T)) & 15u) | (((oth >> (8 * T)) & 15u) << 4);
      const unsigned b1 = ((nib >> (8 * T + 4)) & 15u) | (((oth >> (8 * T + 4)) & 15u) << 4);
      ((LDS unsigned short*)(lds + IL_HIST))[q * 512 + (4 * s + 2 * kh + T) * 2 + (g4 & 1)] = (unsigned short)(b0 | (b1 << 8));
    }
  }
}
DEVI void idx_stream(LDS unsigned char* lds, int N, int qg, int kh, float qinv, float qoff, int bstar, const h16* scbase) {
  const int tid = launder((int)threadIdx.x), lane = tid & 63, l15 = lane & 15, g4 = lane >> 4;
  const int q = 16 * qg + l15;
  LDS unsigned* st = (LDS unsigned*)(lds + IL_ST);
  const int nv = (N - 64 * kh + 127) >> 7;
  const unsigned long long* scp = (const unsigned long long*)(scbase + ((size_t)(kh * 4) * 1024 + q * 16 + 4 * g4));
#define IDX_LD(dst, s_) do { if ((s_) < nv) { _Pragma("unroll") for (int kt = 0; kt < 4; ++kt) dst[kt] = __hip_atomic_load(scp + (size_t)(s_) * 2048 + kt * 256, __ATOMIC_RELAXED, __HIP_MEMORY_SCOPE_AGENT); } } while (0)
  unsigned long long b0[4], b1[4], b2[4], b3[4];
  IDX_LD(b0, 0); IDX_LD(b1, 1); IDX_LD(b2, 2); IDX_LD(b3, 3);
  for (int s = 0; s < nv; s += 4) {
    idx_stream_step(lds, st, b0, s, kh, q, lane, g4, qinv, qoff, bstar); IDX_LD(b0, s + 4);
    if (s + 1 < nv) { idx_stream_step(lds, st, b1, s + 1, kh, q, lane, g4, qinv, qoff, bstar); IDX_LD(b1, s + 5); }
    if (s + 2 < nv) { idx_stream_step(lds, st, b2, s + 2, kh, q, lane, g4, qinv, qoff, bstar); IDX_LD(b2, s + 6); }
    if (s + 3 < nv) { idx_stream_step(lds, st, b3, s + 3, kh, q, lane, g4, qinv, qoff, bstar); IDX_LD(b3, s + 7); }
  }
#undef IDX_LD
}

DEVI void idx_item(PRef p, LDS unsigned char* lds, int b, int c) {
  const int tid = launder((int)threadIdx.x), lane = tid & 63, wave = wave_id(tid), l31 = lane & 31, half = lane >> 5;
  const int N = 64 * (c + 1);
  unsigned* MASK = (unsigned*)(p.ws + WS_MASK) + ((size_t)b * SEQ + 64 * c) * 256;
  if (N <= 256) {
    const int wpr = N >> 5;
    for (int i = tid; i < 64 * wpr; i += NTHR) MASK[(size_t)(i / wpr) * 256 + (i % wpr)] = 0xFFFFFFFFu;
    return;
  }
  const int qg = wave & 3, kh = wave >> 2, l15 = lane & 15, q = 16 * qg + l15;
  const h16* QIrow0 = (const h16*)(p.ws + WS_QI) + ((size_t)b * SEQ + 64 * c) * 512;
  const float* WIrow0 = (const float*)(p.ws + WS_WI) + ((size_t)b * SEQ + 64 * c) * 8;
  const h16* KIb = (const h16*)(p.ws + WS_KI) + (size_t)b * SEQ * 64;
  h16* scbase;
  {
    const int j = (c < 64) ? c : 127 - c;
    const size_t pre = 8192ull * (size_t)(128 * j - (j * (j - 1)) / 2);
    scbase = (h16*)(p.ws + (b == 0 ? WS_H : WS_MIX + (size_t)(b - 1) * SC_BATCH_BYTES) + pre);
  }
  LDS unsigned* st = (LDS unsigned*)(lds + IL_ST);
  LDS float* stf = (LDS float*)(lds + IL_ST);
  if (tid < 64) { st[tid] = 0xFFFFFFFFu; st[64 + tid] = 0u; st[128 + tid] = 0u; }
  __syncthreads();
  const int nst = (N + 127) >> 7;
  const int stride = nst >= 16 ? 8 : (nst >= 8 ? 4 : (nst >= 4 ? 2 : 1));
  idx_pass<0>(lds, KIb, N, stride, qg, kh, QIrow0, WIrow0, 0.f, 0.f, 0, scbase);
  __syncthreads();
  if (tid < 64) {
    const float lo = fkey_inv(st[tid]), hi = fkey_inv(st[64 + tid]);
    float d = hi - lo; if (!(d > 1e-20f)) d = 1.f;
    const float inv = (float)IDX_NB / (1.5f * d);
    stf[192 + tid] = inv; stf[256 + tid] = -(lo - 0.25f * d) * inv;
  }
  for (int i = tid; i < 16384; i += NTHR) ((LDS unsigned*)(lds + IL_HIST))[i] = 0u;
  __syncthreads();
  const float qinv = stf[192 + q], qoff = stf[256 + q];
  idx_pass<1>(lds, KIb, N, 1, qg, kh, QIrow0, WIrow0, qinv, qoff, 0, scbase);
  {
    LDS unsigned* hist = (LDS unsigned*)(lds + IL_HIST);
    for (int qq = wave; qq < 64; qq += 8) {
      unsigned hb[4];
#pragma unroll
      for (int j = 0; j < 4; ++j) hb[j] = hist[(4 * lane + j) * 64 + qq];
      const unsigned mine = hb[0] + hb[1] + hb[2] + hb[3];
      unsigned suf = mine;
#pragma unroll
      for (int o = 1; o < 64; o <<= 1) { const unsigned v = (unsigned)__shfl_down((int)suf, o); if (lane + o < 64) suf += v; }
      unsigned cum = suf - mine;
      if (cum < 256u && suf >= 256u) {
#pragma unroll
        for (int j = 3; j >= 0; --j) {
          if (cum < 256u && cum + hb[j] >= 256u) { st[320 + qq] = (unsigned)(4 * lane + j); st[384 + qq] = 256u - cum; }
          cum += hb[j];
        }
      }
    }
  }
  __syncthreads();
  const int bstar = (int)st[320 + q];
  __syncthreads();
  asm volatile("s_waitcnt vmcnt(0)" ::: "memory");
  idx_stream(lds, N, qg, kh, qinv, qoff, bstar, scbase);
  __syncthreads();
  for (int qq = wave; qq < 64; qq += 8) {
    const int nc = min((int)st[128 + qq], IDX_CAP); const unsigned need = st[384 + qq];
    LDS float* cs = (LDS float*)(lds + IL_CS) + qq * IDX_CAP; LDS unsigned short* ck = (LDS unsigned short*)(lds + IL_CK) + qq * IDX_CAP;
    for (int i = lane; i < nc; i += 64) {
      const float sv = cs[i]; const unsigned kv = ck[i];
      unsigned rank = 0u;
      for (int j = 0; j < nc; ++j) { const float sj = cs[j]; const unsigned kj = ck[j]; rank += (sj > sv || (sj == sv && kj < kv)) ? 1u : 0u; }
      if (rank < need) {
        const unsigned kl = kv & 31u;
        const unsigned bit = 16u * ((kl >> 2) & 1u) + (kl & 3u) + 4u * (kl >> 3);
        __hip_atomic_fetch_or((LDS unsigned*)(lds + IL_HIST) + qq * 256 + (kv >> 5), 1u << bit, __ATOMIC_RELAXED, __HIP_MEMORY_SCOPE_WORKGROUP);
      }
    }
  }
  __syncthreads();
  {
    const int cpr = N >> 6;
    for (int i = tid; i < 64 * cpr; i += NTHR) {
      const int row = i / cpr, cc = i % cpr;
      *(u32x2*)(MASK + (size_t)row * 256 + 2 * cc) = *(LDS u32x2*)(lds + IL_HIST + row * 1024 + cc * 8);
    }
  }
  __syncthreads();
}

DEVI void phase3(PRef p, LDS unsigned char* lds) {
  const int G = gridDim.x;
  for (int it = blockIdx.x; it < 512; it += G) rnn_item<0>(p, lds, it >> 7, it & 127);
  for (int it = blockIdx.x; it < 256; it += G) {
    const int b = it >> 6, j = it & 63;
#pragma unroll 1
    for (int w2 = 0; w2 < 2; ++w2) idx_item(p, lds, b, w2 ? j : 127 - j);
  }
}

constexpr int AT_BUF = 2 * 64 * LROW;
DEVI float max3f(float a, float b, float c) { float r; asm("v_max3_f32 %0, %1, %2, %3" : "=v"(r) : "v"(a), "v"(b), "v"(c)); return r; }
DEVI unsigned pk_rtz(float a, float b) { return __builtin_bit_cast(unsigned, __builtin_amdgcn_cvt_pkrtz(a, b)); }
DEVI void attn_tile(LDS unsigned char* Kt, LDS unsigned char* Vt, const h16x8 (&qf)[4], u32x2 mw, int l31, int half, f32x16 (&o)[2], float& mref, float& l, bool& init) {
  const unsigned nm0 = ~(mw[0] >> (16 * half)), nm1 = ~(mw[1] >> (16 * half));
  const unsigned negm = __float_as_uint(-mref);
  f32x16 s[2];
#pragma unroll
  for (int r = 0; r < 16; ++r) {
    unsigned e0 = (unsigned)__builtin_amdgcn_sbfe((int)nm0, r, 1), e1 = (unsigned)__builtin_amdgcn_sbfe((int)nm1, r, 1);
    asm volatile("" : "+v"(e0), "+v"(e1));
    s[0][r] = __uint_as_float((e0 & 0xFF800000u) | (~e0 & negm));
    s[1][r] = __uint_as_float((e1 & 0xFF800000u) | (~e1 & negm));
  }
#pragma unroll
  for (int ri = 0; ri < 2; ++ri)
#pragma unroll
    for (int kk = 0; kk < 4; ++kk) {
      const h16x8 kf = *(LDS h16x8*)(Kt + (32 * ri + l31) * LROW + (2 * kk + half) * 16);
      s[ri] = mfma16(kf, qf[kk], s[ri]);
    }
  asm volatile("s_nop 15\n\ts_nop 7" : "+v"(s[0]), "+v"(s[1]));
  float mx = max3f(s[0][0], s[1][0], s[0][1]), mx2 = max3f(s[1][1], s[0][2], s[1][2]);
#pragma unroll
  for (int r = 3; r < 15; r += 2) { mx = max3f(mx, s[0][r], s[1][r]); mx2 = max3f(mx2, s[0][r + 1], s[1][r + 1]); }
  mx = max3f(mx, s[0][15], s[1][15]);
  mx = max3f(mx, mx2, mx2);
  mx = max3f(mx, __shfl_xor(mx, 32), mx);
  const bool first = (!init) && (mx > -INFINITY);
  const bool resc = first || (mx > 8.f);
  if (__any(resc)) {
    init = init || first;
    const float delta = resc ? mx : 0.f;
    const float alpha = __builtin_amdgcn_exp2f(-delta);
#pragma unroll
    for (int r = 0; r < 16; ++r) { s[0][r] -= delta; s[1][r] -= delta; o[0][r] *= alpha; o[1][r] *= alpha; }
    l *= alpha; mref += delta;
  }
  float ls = 0.f;
#pragma unroll
  for (int r = 0; r < 16; ++r) {
    s[0][r] = __builtin_amdgcn_exp2f(s[0][r]); s[1][r] = __builtin_amdgcn_exp2f(s[1][r]);
    ls += s[0][r] + s[1][r];
  }
  l += ls;
  h16x8 pf[4];
#pragma unroll
  for (int s4 = 0; s4 < 4; ++s4) {
    u32x4 w;
#pragma unroll
    for (int e = 0; e < 4; ++e) w[e] = pk_rtz(s[s4 >> 1][8 * (s4 & 1) + 2 * e], s[s4 >> 1][8 * (s4 & 1) + 2 * e + 1]);
    pf[s4] = __builtin_bit_cast(h16x8, w);
  }
#pragma unroll
  for (int di = 0; di < 2; ++di)
#pragma unroll
    for (int s4 = 0; s4 < 4; ++s4) {
      const h16x8 vf = *(LDS h16x8*)(Vt + (32 * di + l31) * LROW + (2 * s4 + half) * 16);
      o[di] = mfma16(vf, pf[s4], o[di]);
    }
}

DEVI void attn_unit(PRef p, LDS unsigned char* lds, int b, int head, int qb) {
  const int tid = launder((int)threadIdx.x), lane = tid & 63, wave = wave_id(tid), l31 = lane & 31, half = lane >> 5;
  const int q0 = qb * 256 + wave * 32, cw = q0 >> 6, NS = 2 * (qb + 1);
  const size_t tok = (size_t)b * SEQ + q0 + l31;
  h16x8 qf[4];
  {
    const h16* Q = (const h16*)(p.ws + WS_Q) + tok * 512 + head * 64;
#pragma unroll
    for (int kk = 0; kk < 4; ++kk) qf[kk] = *(const h16x8*)(Q + 16 * kk + 8 * half);
  }
  const unsigned* mrow = (const unsigned*)(p.ws + WS_MASK) + tok * 256;
  constexpr int TP = 2 * 64 * LROW, ABUF = 2 * TP;
  const h16* ksrc[2]; const h16* vsrc[2]; int kdst[2], vdst[2];
#pragma unroll
  for (int i = 0; i < 2; ++i) {
    const int id = tid + NTHR * i;
    const int row = id >> 3, lc = id & 7;
    ksrc[i] = (const h16*)(p.ws + WS_K) + ((size_t)b * SEQ + row) * 512 + head * 64 + lc * 8;
    kdst[i] = (row >> 6) * TP + (row & 63) * LROW + lc * 16;
    const int d = id >> 4, c = id & 15;
    vsrc[i] = (const h16*)(p.ws + WS_VT) + ((size_t)(b * 8 + head) * 64 + d) * 8192 + c * 8;
    vdst[i] = (c >> 3) * TP + 64 * LROW + d * LROW + (c & 7) * 16;
  }
  h16x8 rkA[2], rvA[2], rkB[2], rvB[2];
#pragma unroll
  for (int i = 0; i < 2; ++i) { rkA[i] = *(const h16x8*)ksrc[i]; rvA[i] = *(const h16x8*)vsrc[i]; }
#pragma unroll
  for (int i = 0; i < 2; ++i) { *(LDS h16x8*)(lds + kdst[i]) = rkA[i]; *(LDS h16x8*)(lds + vdst[i]) = rvA[i]; }
#pragma unroll
  for (int i = 0; i < 2; ++i) { rkA[i] = *(const h16x8*)(ksrc[i] + (size_t)128 * 512); rvA[i] = *(const h16x8*)(vsrc[i] + 128); }
  u32x4 mw = *(const u32x4*)mrow, mwn;
  __syncthreads();
  f32x16 o[2];
#pragma unroll
  for (int r = 0; r < 16; ++r) { o[0][r] = 0.f; o[1][r] = 0.f; }
  float mref = 0.f, l = 0.f; bool init = false;
#define ATT_STEP(s, RKC, RVC, RKN, RVN) { \
    if ((s) + 2 < NS) { _Pragma("unroll") for (int i = 0; i < 2; ++i) { RKN[i] = *(const h16x8*)(ksrc[i] + (size_t)((s) + 2) * 128 * 512); RVN[i] = *(const h16x8*)(vsrc[i] + ((s) + 2) * 128); } } \
    if ((s) + 1 < NS) mwn = *(const u32x4*)(mrow + 4 * ((s) + 1)); \
    { LDS unsigned char* bb = lds + ((s) & 1) * ABUF; \
      if (2 * (s) <= cw) { u32x2 m2; m2[0] = mw[0]; m2[1] = mw[1]; attn_tile(bb, bb + 64 * LROW, qf, m2, l31, half, o, mref, l, init); } \
      if (2 * (s) + 1 <= cw) { u32x2 m2; m2[0] = mw[2]; m2[1] = mw[3]; attn_tile(bb + TP, bb + TP + 64 * LROW, qf, m2, l31, half, o, mref, l, init); } } \
    if ((s) + 1 < NS) { LDS unsigned char* nb = lds + (((s) + 1) & 1) * ABUF; _Pragma("unroll") for (int i = 0; i < 2; ++i) { *(LDS h16x8*)(nb + kdst[i]) = RKC[i]; *(LDS h16x8*)(nb + vdst[i]) = RVC[i]; } } \
    __syncthreads(); mw = mwn; }
  for (int s = 0; s < NS; s += 2) {
    ATT_STEP(s, rkA, rvA, rkB, rvB)
    ATT_STEP(s + 1, rkB, rvB, rkA, rvA)
  }
#undef ATT_STEP
  const float inv = 1.f / (l + __shfl_xor(l, 32));
  h16* Y = (h16*)(p.ws + WS_H) + tok * DM + head * 64;
#pragma unroll
  for (int di = 0; di < 2; ++di)
#pragma unroll
    for (int q = 0; q < 4; ++q)
      *(h16x4*)(Y + 32 * di + 8 * q + 4 * half) = pack4(o[di][4 * q] * inv, o[di][4 * q + 1] * inv, o[di][4 * q + 2] * inv, o[di][4 * q + 3] * inv);
}

DEVI void phase4(PRef p, LDS unsigned char* lds) {
  const int G = gridDim.x;
  for (int it = blockIdx.x; it < 512; it += G) rnn_item<1>(p, lds, it >> 7, it & 127);
  for (int it = blockIdx.x; it < 512; it += G) {
    const int bh = it >> 4, j = it & 15;
#pragma unroll 1
    for (int w2 = 0; w2 < 2; ++w2) attn_unit(p, lds, bh >> 3, bh & 7, w2 ? j : 31 - j);
  }
}

struct EpiPlain {
  h16* dst; int ld;
  DEVI void operator()(const f32x4 (&acc)[2][2][4][2], const g8::Unit& u, int wr, int wc, int fr, int fq) const {
#pragma unroll
    for (int ai = 0; ai < 2; ++ai)
#pragma unroll
      for (int m = 0; m < 4; ++m) {
        const int r = u.pm * 256 + 128 * ai + 64 * wr + 16 * m + fr;
        if (r < u.cnt) {
          h16* d = dst + (size_t)(u.off + r) * ld + u.pn * 256 + 32 * wc + 4 * fq;
#pragma unroll
          for (int bj = 0; bj < 2; ++bj)
#pragma unroll
            for (int n = 0; n < 2; ++n) { const f32x4 v = acc[ai][bj][m][n]; *(h16x4*)(d + 128 * bj + 16 * n) = pack4(v[0], v[1], v[2], v[3]); }
        }
      }
  }
};
DEVI void phase5(PRef p, LDS unsigned char* lds) {
  g8::DenseOrder S{(const h16*)(p.ws + WS_H), (const h16*)(p.ws + WS_WOUT), DM, 128, 4, (int)gridDim.x, (int)blockIdx.x};
  EpiPlain E{(h16*)(p.ws + WS_MIX), DM};
  g8::gemm_phase(lds, DM, S, E);
}

constexpr int P6_TROW = 2064, P6_THI = 0, P6_TLO = 32 * P6_TROW, P6_PART = 0, P6_LGT = 8 * 48 * 32 * 4, P6_MOD = 2 * 32 * P6_TROW;
constexpr int P6_BIAS = P6_MOD + 3 * 4096, P6_TOK = P6_BIAS + 160, P6_LCNT = P6_TOK + 128 * 6 * 4, P6_LBASE = P6_LCNT + 128;
static_assert(P6_LBASE + 128 <= LDS_BYTES - 16 && P6_LGT + 32 * 36 * 4 <= P6_MOD, "phase 6 LDS map");
DEVI void phase6(PRef p, LDS unsigned char* lds) {
  const int tid = launder((int)threadIdx.x), lane = tid & 63, wave = wave_id(tid), l15 = lane & 15, g4 = lane >> 4;
  const int b = blockIdx.x >> 6;
  LDS float* mv = (LDS float*)(lds + P6_MOD);
  LDS float* rbias = (LDS float*)(lds + P6_BIAS);
  LDS unsigned* tokrec = (LDS unsigned*)(lds + P6_TOK);
  LDS unsigned* lcnt = (LDS unsigned*)(lds + P6_LCNT);
  LDS unsigned* lbase = (LDS unsigned*)(lds + P6_LBASE);
  mod_to_lds(p, b, 2, mv); mod_to_lds(p, b, 3, mv + 1024); mod_to_lds(p, b, 4, mv + 2048);
  if (tid < 4) rbias[tid] = p.in[18][tid];
  else if (tid < 36) rbias[tid] = p.in[20][tid - 4];
  if (tid < 32) lcnt[tid] = 0u;
  __syncthreads();
  f32x4 A1[4], A2[4], SH2[4];
#pragma unroll
  for (int j = 0; j < 4; ++j) {
    const int k = 256 * j + 4 * lane;
    A1[j] = *(LDS f32x4*)(mv + k) * *(const f32x4*)(p.in[5] + k);
    A2[j] = *(const f32x4*)(p.in[6] + k) * (*(LDS f32x4*)(mv + 2048 + k) + 1.f);
    SH2[j] = *(LDS f32x4*)(mv + 1024 + k);
  }
  const float* x = p.in[0]; const h16* MIX = (const h16*)(p.ws + WS_MIX); float* X1 = p.out; h16* H2 = (h16*)(p.ws + WS_H);
  const h16* WRH = (const h16*)(p.ws + WS_WRH); const h16* WRL = (const h16*)(p.ws + WS_WRL);
  const size_t tok0 = (size_t)blockIdx.x * 128;
#pragma unroll 1
  for (int rd = 0; rd < 4; ++rd) {
#pragma unroll 1
    for (int i = 0; i < 4; ++i) {
      const int tr = 4 * wave + i;
      const size_t tok = tok0 + 32 * rd + tr;
      f32x4 xv[4], mx[4]; float ssm = 0.f;
#pragma unroll
      for (int j = 0; j < 4; ++j) {
        xv[j] = *(const f32x4*)(x + tok * DM + 256 * j + 4 * lane);
        const h16x4 mh = *(const h16x4*)(MIX + tok * DM + 256 * j + 4 * lane);
#pragma unroll
        for (int e = 0; e < 4; ++e) { mx[j][e] = (float)mh[e]; ssm += mx[j][e] * mx[j][e]; }
      }
      const float rsm = 1.0f / sqrtf(wave_sum(ssm) * (1.f / 1024.f) + 1e-6f);
      float ss1 = 0.f;
#pragma unroll
      for (int j = 0; j < 4; ++j) {
        xv[j] = xv[j] + A1[j] * (mx[j] * rsm);
        *(f32x4*)(X1 + tok * DM + 256 * j + 4 * lane) = xv[j];
        ss1 += xv[j][0] * xv[j][0] + xv[j][1] * xv[j][1] + xv[j][2] * xv[j][2] + xv[j][3] * xv[j][3];
      }
      const float rs1 = 1.0f / sqrtf(wave_sum(ss1) * (1.f / 1024.f) + 1e-6f);
#pragma unroll
      for (int j = 0; j < 4; ++j) {
        const f32x4 h2 = xv[j] * rs1 * A2[j] + SH2[j];
        const h16x4 hi = pack4(h2[0], h2[1], h2[2], h2[3]);
        const h16x4 lo = pack4(h2[0] - (float)hi[0], h2[1] - (float)hi[1], h2[2] - (float)hi[2], h2[3] - (float)hi[3]);
        *(h16x4*)(H2 + tok * DM + 256 * j + 4 * lane) = hi;
        *(LDS h16x4*)(lds + P6_THI + tr * P6_TROW + (256 * j + 4 * lane) * 2) = hi;
        *(LDS h16x4*)(lds + P6_TLO + tr * P6_TROW + (256 * j + 4 * lane) * 2) = lo;
      }
    }
    __syncthreads();
    f32x4 acc[2][3];
#pragma unroll
    for (int tt = 0; tt < 2; ++tt)
#pragma unroll
      for (int ct = 0; ct < 3; ++ct) acc[tt][ct] = (f32x4){0.f, 0.f, 0.f, 0.f};
#pragma unroll
    for (int kk = 0; kk < 4; ++kk) {
      const int kof = 32 * (4 * wave + kk) + 8 * g4;
      h16x8 ah[2], al[2];
#pragma unroll
      for (int tt = 0; tt < 2; ++tt) {
        ah[tt] = *(LDS h16x8*)(lds + P6_THI + (16 * tt + l15) * P6_TROW + kof * 2);
        al[tt] = *(LDS h16x8*)(lds + P6_TLO + (16 * tt + l15) * P6_TROW + kof * 2);
      }
#pragma unroll
      for (int ct = 0; ct < 3; ++ct) {
        const h16x8 bh = *(const h16x8*)(WRH + (size_t)(16 * ct + l15) * 1024 + kof), bl = *(const h16x8*)(WRL + (size_t)(16 * ct + l15) * 1024 + kof);
#pragma unroll
        for (int tt = 0; tt < 2; ++tt) {
          acc[tt][ct] = mfma16s(ah[tt], bh, acc[tt][ct]);
          acc[tt][ct] = mfma16s(ah[tt], bl, acc[tt][ct]);
          acc[tt][ct] = mfma16s(al[tt], bh, acc[tt][ct]);
        }
      }
    }
    __syncthreads();
#pragma unroll
    for (int tt = 0; tt < 2; ++tt)
#pragma unroll
      for (int ct = 0; ct < 3; ++ct)
        *(LDS f32x4*)(lds + P6_PART + (((wave * 48 + 16 * ct + l15) * 32) + 16 * tt + 4 * g4) * 4) = acc[tt][ct];
    __syncthreads();
    for (int idx = tid; idx < 36 * 32; idx += NTHR) {
      const int col = idx >> 5, tk = idx & 31;
      float s = 0.f;
#pragma unroll
      for (int w = 0; w < 8; ++w) s += *(LDS float*)(lds + P6_PART + ((w * 48 + col) * 32 + tk) * 4);
      *(LDS float*)(lds + P6_LGT + (tk * 36 + col) * 4) = s;
    }
    __syncthreads();
    if (tid < 32) {
      LDS float* lg = (LDS float*)(lds + P6_LGT) + 36 * tid;
      float gl[4];
#pragma unroll
      for (int g = 0; g < 4; ++g) gl[g] = lg[g] + rbias[g];
      int gi = 0; float gm = gl[0];
#pragma unroll
      for (int g = 1; g < 4; ++g) if (gl[g] > gm) { gm = gl[g]; gi = g; }
      float gs = 0.f;
#pragma unroll
      for (int g = 0; g < 4; ++g) gs += __expf(gl[g] - gm);
      const float pg = 1.f / gs;
      int e1 = 0, e2 = 0; float l1 = -INFINITY, l2 = -INFINITY;
#pragma unroll
      for (int e = 0; e < 8; ++e) {
        const float v = lg[4 + 8 * gi + e] + rbias[4 + 8 * gi + e];
        if (v > l1) { l2 = l1; e2 = e1; l1 = v; e1 = e; }
        else if (v > l2) { l2 = v; e2 = e; }
      }
      const float x2 = __expf(l2 - l1);
      const float w1 = pg / (1.f + x2), w2 = pg * x2 / (1.f + x2);
      const unsigned E1 = (unsigned)(gi * 8 + e1), E2 = (unsigned)(gi * 8 + e2);
      const unsigned lp1 = __hip_atomic_fetch_add(&lcnt[E1], 1u, __ATOMIC_RELAXED, __HIP_MEMORY_SCOPE_WORKGROUP);
      const unsigned lp2 = __hip_atomic_fetch_add(&lcnt[E2], 1u, __ATOMIC_RELAXED, __HIP_MEMORY_SCOPE_WORKGROUP);
      LDS unsigned* tr = tokrec + (32 * rd + tid) * 6;
      tr[0] = E1; tr[1] = lp1; tr[2] = E2; tr[3] = lp2; tr[4] = __float_as_uint(w1); tr[5] = __float_as_uint(w2);
    }
    __syncthreads();
  }
  if (tid < 32) lbase[tid] = atomicAdd((unsigned*)(p.ws + WS_CNT) + tid, lcnt[tid]);
  __syncthreads();
  if (tid < 128) {
    unsigned* LIST = (unsigned*)(p.ws + WS_LIST); float* LISTW = (float*)(p.ws + WS_LISTW); u32x4* ROUTE = (u32x4*)(p.ws + WS_ROUTE);
    const unsigned tok = (unsigned)(tok0 + tid);
    LDS unsigned* tr = tokrec + tid * 6;
    const unsigned E1 = tr[0], E2 = tr[2], p1 = lbase[E1] + tr[1], p2 = lbase[E2] + tr[3];
    LIST[(size_t)E1 * 32768 + p1] = tok; LISTW[(size_t)E1 * 32768 + p1] = __uint_as_float(tr[4]);
    LIST[(size_t)E2 * 32768 + p2] = tok; LISTW[(size_t)E2 * 32768 + p2] = __uint_as_float(tr[5]);
    u32x4 rt; rt[0] = E1; rt[1] = p1; rt[2] = E2; rt[3] = p2;
    ROUTE[tok] = rt;
  }
}

template <bool GATHER_> struct MoeOrder {
  static constexpr bool GATHER = GATHER_;
  unsigned char* ws; int ntn, K, G, c;
  DEVI bool next(int i, g8::Unit& u) const {
    const unsigned* cnt = (const unsigned*)(ws + WS_CNT);
    int it = i * G + c, off = 0, e = 0, cn = 0; bool found = false;
    for (e = 0; e < 32; ++e) { cn = (int)cnt[e]; const int nti = ((cn + 255) >> 8) * ntn; if (it < nti) { found = true; break; } it -= nti; off += cn; }
    if (!found) return false;
    u.e = e; u.pm = it / ntn; u.pn = it % ntn; u.cnt = cn; u.off = off;
    const int tid = threadIdx.x;
    if (GATHER_) {
      const unsigned* list = (const unsigned*)(ws + WS_LIST) + (size_t)e * 32768;
      u.A = (const char*)(ws + WS_H);
      u.B = (const char*)((const h16*)(ws + WS_WGU) + ((size_t)e * 512 + u.pn * 256) * DM);
#pragma unroll
      for (int h = 0; h < 2; ++h)
#pragma unroll
        for (int i2 = 0; i2 < 2; ++i2) {
          int R, C; g8::stage_rc(tid * 16 + i2 * 8192, R, C);
          const int row = u.pm * 256 + 128 * h + R;
          const unsigned t = (row < cn) ? list[row] : 0u;
          u.va[h][i2] = (t * (unsigned)DM + (unsigned)C) * 2u;
        }
    } else {
      u.A = (const char*)((const h16*)(ws + WS_ACT) + ((size_t)off + u.pm * 256) * 256);
      u.B = (const char*)((const h16*)(ws + WS_WDN) + ((size_t)e * 1024 + u.pn * 256) * 256);
      u.va[0][0] = u.va[0][1] = u.va[1][0] = u.va[1][1] = 0u;
    }
    return true;
  }
};
struct EpiAct {
  unsigned char* ws;
  DEVI void operator()(const f32x4 (&acc)[2][2][4][2], const g8::Unit& u, int wr, int wc, int fr, int fq) const {
    const float* lw = (const float*)(ws + WS_LISTW) + (size_t)u.e * 32768; h16* act = (h16*)(ws + WS_ACT);
#pragma unroll
    for (int ai = 0; ai < 2; ++ai)
#pragma unroll
      for (int m = 0; m < 4; ++m) {
        const int r = u.pm * 256 + 128 * ai + 64 * wr + 16 * m + fr;
        if (r < u.cnt) {
          const float w = lw[r];
#pragma unroll
          for (int bj = 0; bj < 2; ++bj) {
            const f32x4 g = acc[ai][bj][m][0], up = acc[ai][bj][m][1];
            float v[4];
#pragma unroll
            for (int e = 0; e < 4; ++e) v[e] = g[e] * __builtin_amdgcn_rcpf(1.f + __expf(-g[e])) * up[e] * w;
            *(h16x4*)(act + (size_t)(u.off + r) * 256 + 16 * (8 * u.pn + 4 * bj + wc) + 4 * fq) = pack4(v[0], v[1], v[2], v[3]);
          }
        }
      }
  }
};
struct EpiYp {
  h16* dst;
  DEVI void operator()(const f32x4 (&acc)[2][2][4][2], const g8::Unit& u, int wr, int wc, int fr, int fq) const {
#pragma unroll
    for (int ai = 0; ai < 2; ++ai)
#pragma unroll
      for (int m = 0; m < 4; ++m) {
        const int r = u.pm * 256 + 128 * ai + 64 * wr + 16 * m + fr;
        if (r < u.cnt) {
          h16* d = dst + (size_t)(u.off + r) * DM + u.pn * 256 + 32 * wc + 4 * fq;
#pragma unroll
          for (int bj = 0; bj < 2; ++bj)
#pragma unroll
            for (int n = 0; n < 2; ++n) { const f32x4 v = acc[ai][bj][m][n]; *(h16x4*)(d + 128 * bj + 16 * n) = pack4(v[0], v[1], v[2], v[3]); }
        }
      }
  }
};
DEVI void phase7(PRef p, LDS unsigned char* lds) {
  MoeOrder<true> S{p.ws, 2, DM, (int)gridDim.x, (int)blockIdx.x};
  EpiAct E{p.ws};
  g8::gemm_phase(lds, DM, S, E);
}
DEVI void phase8(PRef p, LDS unsigned char* lds) {
  MoeOrder<false> S{p.ws, 4, 256, (int)gridDim.x, (int)blockIdx.x};
  EpiYp E{(h16*)(p.ws + WS_YP)};
  g8::gemm_phase(lds, 256, S, E);
}

DEVI void phase9(PRef p, LDS unsigned char* lds) {
  const int tid = launder((int)threadIdx.x), lane = tid & 63, wave = wave_id(tid), G = gridDim.x;
  const int b = blockIdx.x & 3, bi = blockIdx.x >> 2, nbk = G >> 2;
  LDS unsigned* offs = (LDS unsigned*)lds;
  if (tid == 0) { const unsigned* cnt = (const unsigned*)(p.ws + WS_CNT); unsigned o = 0; for (int e = 0; e < 32; ++e) { offs[e] = o; o += cnt[e]; } }
  __syncthreads();
  LDS float* mv = (LDS float*)(lds + 256);
  mod_to_lds(p, b, 5, mv);
  __syncthreads();
  f32x4 A3[4];
#pragma unroll
  for (int j = 0; j < 4; ++j) { const int k = 256 * j + 4 * lane; A3[j] = *(LDS f32x4*)(mv + k) * *(const f32x4*)(p.in[7] + k); }
  const h16* YP = (const h16*)(p.ws + WS_YP); const u32x4* ROUTE = (const u32x4*)(p.ws + WS_ROUTE); float* out = p.out;
  const int rstep = nbk * 8, r_first = bi * 8 + wave;
  const int nrow = (SEQ - r_first + rstep - 1) / rstep;
  unsigned R0 = 0u, R1 = 0u;
  if (lane < nrow) { const u32x4 rt = ROUTE[(size_t)b * SEQ + r_first + rstep * lane]; R0 = offs[rt[0]] + rt[1]; R1 = offs[rt[2]] + rt[3]; }
  h16x4 ya[4], yc[4]; f32x4 xv[4];
  {
    const size_t tok = (size_t)b * SEQ + r_first; const size_t r0 = __builtin_amdgcn_readlane(R0, 0), r1 = __builtin_amdgcn_readlane(R1, 0);
#pragma unroll
    for (int j = 0; j < 4; ++j) { ya[j] = *(const h16x4*)(YP + r0 * DM + 256 * j + 4 * lane); yc[j] = *(const h16x4*)(YP + r1 * DM + 256 * j + 4 * lane); xv[j] = *(const f32x4*)(out + tok * DM + 256 * j + 4 * lane); }
  }
  for (int i = 0; i < nrow; ++i) {
    const size_t tok = (size_t)b * SEQ + r_first + rstep * i;
    h16x4 na[4], nc[4]; f32x4 nx[4];
    if (i + 1 < nrow) {
      const size_t r0 = __builtin_amdgcn_readlane(R0, i + 1), r1 = __builtin_amdgcn_readlane(R1, i + 1);
#pragma unroll
      for (int j = 0; j < 4; ++j) { na[j] = *(const h16x4*)(YP + r0 * DM + 256 * j + 4 * lane); nc[j] = *(const h16x4*)(YP + r1 * DM + 256 * j + 4 * lane); nx[j] = *(const f32x4*)(out + (tok + rstep) * DM + 256 * j + 4 * lane); }
    }
    f32x4 y[4]; float ss = 0.f;
#pragma unroll
    for (int j = 0; j < 4; ++j)
#pragma unroll
      for (int e = 0; e < 4; ++e) { y[j][e] = (float)ya[j][e] + (float)yc[j][e]; ss += y[j][e] * y[j][e]; }
    const float rs = 1.0f / sqrtf(wave_sum(ss) * (1.f / 1024.f) + 1e-6f);
#pragma unroll
    for (int j = 0; j < 4; ++j) *(f32x4*)(out + tok * DM + 256 * j + 4 * lane) = xv[j] + A3[j] * (y[j] * rs);
    if (i + 1 < nrow) {
#pragma unroll
      for (int j = 0; j < 4; ++j) { ya[j] = na[j]; yc[j] = nc[j]; xv[j] = nx[j]; }
    }
  }
}

#define XB_TMO      128
#define XB_XCNT(j)  (256  + 64 * (j))
#define XB_XSUB(j)  (1280 + 64 * (j))
#define XB_XGEN(j)  (2304 + 64 * (j))
#define XB_TOP      3328
#define XB_TOPGEN   3392
#define XB_SPIN_CAP (1u << 22)
DEVI unsigned xb_ld(unsigned* p)              { return __hip_atomic_load(p, __ATOMIC_RELAXED, __HIP_MEMORY_SCOPE_AGENT); }
DEVI unsigned xb_add(unsigned* p, unsigned v) { return __hip_atomic_fetch_add(p, v, __ATOMIC_RELAXED, __HIP_MEMORY_SCOPE_AGENT); }
DEVI unsigned xb_xcc_id() { return (unsigned)__builtin_amdgcn_s_getreg((3 << 11) | 20) & 0xFu; }
#define XB_SPIN(cond, bar) do { unsigned _sp = 0; while (cond) { __builtin_amdgcn_s_sleep(1); \
    if ((++_sp & 255u) == 0u) { if (xb_ld(&(bar)[XB_TMO])) break; if (_sp > XB_SPIN_CAP) { atomicAdd(&(bar)[XB_TMO], 1u); break; } } } } while (0)
struct XcdBarrier { unsigned* bar; unsigned x; volatile LDS unsigned* st; };
DEVI XcdBarrier xcd_barrier_post(unsigned* bar, volatile LDS unsigned* st) {
  XcdBarrier b; b.bar = bar; b.x = xb_xcc_id(); b.st = st;
  if (threadIdx.x == 0) (void)xb_add(&bar[XB_XCNT(b.x)], 1u);
  return b;
}
DEVI void xcd_barrier_complete(unsigned* bar, unsigned x, unsigned& nloc, unsigned& nx) {
  const unsigned G = gridDim.x * gridDim.y * gridDim.z;
  unsigned sum, cnt, mine, sp = 0u;
  for (;;) {
    sum = 0u; cnt = 0u; mine = 0u;
#pragma unroll
    for (unsigned j = 0; j < 16; ++j) { const unsigned c = xb_ld(&bar[XB_XCNT(j)]); sum += c; cnt += (c > 0u) ? 1u : 0u; mine = (j == x) ? c : mine; }
    if (sum == G) break;
    __builtin_amdgcn_s_sleep(1);
    if ((++sp & 255u) == 0u) { if (xb_ld(&bar[XB_TMO])) break; if (sp > XB_SPIN_CAP) { atomicAdd(&bar[XB_TMO], 1u); break; } }
  }
  nloc = mine > 0u ? mine : 1u; nx = cnt > 0u ? cnt : 1u;
}
DEVI void xcd_barrier(const XcdBarrier& b) {
  asm volatile("s_waitcnt vmcnt(0)" ::: "memory");
  __syncthreads();
  if (threadIdx.x == 0) {
    unsigned* bar = b.bar;
    __builtin_amdgcn_s_waitcnt(0);
    unsigned nloc = b.st[0], nx = b.st[1];
    if (nloc == 0u) { xcd_barrier_complete(bar, b.x, nloc, nx); b.st[0] = nloc; b.st[1] = nx; }
    const unsigned old = xb_add(&bar[XB_XSUB(b.x)], 1u);
    const unsigned gen = old / nloc;
    if (old + 1u == (gen + 1u) * nloc) {
      __builtin_amdgcn_fence(__ATOMIC_RELEASE, "agent");
      asm volatile("s_waitcnt vmcnt(0)" ::: "memory");
      const unsigned og = xb_add(&bar[XB_TOP], 1u);
      const unsigned tg = og / nx;
      if (og + 1u == (tg + 1u) * nx) xb_add(&bar[XB_TOPGEN], 1u);
      else XB_SPIN(xb_ld(&bar[XB_TOPGEN]) == tg, bar);
      __builtin_amdgcn_fence(__ATOMIC_ACQUIRE, "agent");
      xb_add(&bar[XB_XGEN(b.x)], 1u);
      asm volatile("s_waitcnt vmcnt(0)" ::: "memory");
    } else {
      XB_SPIN(xb_ld(&bar[XB_XGEN(b.x)]) == gen, bar);
      __builtin_amdgcn_fence(__ATOMIC_ACQUIRE, "agent");
      asm volatile("s_waitcnt vmcnt(0)" ::: "memory");
    }
  }
  __syncthreads();
}

__global__ void __launch_bounds__(NTHR) fwd_kernel(Params p) {
  extern __shared__ __attribute__((aligned(16))) unsigned char smem[];
  LDS unsigned char* lds = (LDS unsigned char*)smem;
  const int lo = p.ph_lo, hi = p.ph_hi;
  volatile LDS unsigned* bst = (volatile LDS unsigned*)(lds + LDS_BYTES - 16);
  if (threadIdx.x < 4) bst[threadIdx.x] = 0u;
  __syncthreads();
  (void)xcd_barrier_post((unsigned*)(p.ws + WS_BAR), bst);
#ifndef REPEAT_PHASE
#define REPEAT_PHASE -1
#endif
#define GRID_SYNC(k) do { if ((k) == 0) cg::this_grid().sync(); else { XcdBarrier xb_; xb_.bar = (unsigned*)(get_params()->ws + WS_BAR); xb_.x = xb_xcc_id(); xb_.st = (volatile LDS unsigned*)(lds + LDS_BYTES - 16); xcd_barrier(xb_); } } while (0)
#define RUN_PHASE(k, fn) if (lo <= (k) && (k) < hi) { fn(*get_params(), lds); if ((k) == REPEAT_PHASE) { GRID_SYNC(k); fn(*get_params(), lds); } if ((k) + 1 < hi) GRID_SYNC(k); }
  RUN_PHASE(0, phase0)
  RUN_PHASE(1, phase1)
  RUN_PHASE(2, phase2)
  RUN_PHASE(3, phase3)
  RUN_PHASE(4, phase4)
  RUN_PHASE(5, phase5)
  RUN_PHASE(6, phase6)
  RUN_PHASE(7, phase7)
  RUN_PHASE(8, phase8)
  RUN_PHASE(9, phase9)
#undef GRID_SYNC
#undef RUN_PHASE
}

extern "C" void kernel_launch(void* const* d_in, const int* in_sizes, int n_in, void* d_out, int out_size, void* d_ws, size_t ws_size, hipStream_t stream) {
  static int grid = 0;
  if (grid == 0) {
    if (n_in != 24 || out_size != NTOK * DM || ws_size < WS_END) { fprintf(stderr, "kernel_launch: unexpected problem (n_in %d out %d ws %zu)\n", n_in, out_size, ws_size); grid = -1; return; }
    (void)hipFuncSetAttribute((const void*)fwd_kernel, hipFuncAttributeMaxDynamicSharedMemorySize, LDS_BYTES);
    int dev = 0, cus = 0, per_cu = 0;
    (void)hipGetDevice(&dev);
    (void)hipDeviceGetAttribute(&cus, hipDeviceAttributeMultiprocessorCount, dev);
    (void)hipOccupancyMaxActiveBlocksPerMultiprocessor(&per_cu, (const void*)fwd_kernel, NTHR, LDS_BYTES);
    if (per_cu < 1 || cus < 256) fprintf(stderr, "kernel_launch: occupancy %d blocks/CU on %d CUs\n", per_cu, cus);
    grid = 256;
  }
  if (grid < 0) return;
  (void)hipMemsetAsync((char*)d_ws + WS_CNT, 0, CTL_ZERO_BYTES, stream);
  Params p{};
  for (int i = 0; i < 24; ++i) p.in[i] = (const float*)d_in[i];
  p.out = (float*)d_out; p.ws = (unsigned char*)d_ws;
#if N_LAUNCH_MODE == 1
  p.ph_lo = 0; p.ph_hi = NPHASE;
  void* args[] = {&p};
  hipError_t e = hipLaunchCooperativeKernel((const void*)fwd_kernel, dim3(grid), dim3(NTHR), args, LDS_BYTES, stream);
  if (e != hipSuccess) fprintf(stderr, "cooperative launch failed: %s\n", hipGetErrorString(e));
#else
  for (int ph = 0; ph < NPHASE; ++ph) {
    p.ph_lo = ph; p.ph_hi = ph + 1;
    hipLaunchKernelGGL(fwd_kernel, dim3(grid), dim3(NTHR), LDS_BYTES, stream, p);
  }
#endif
}
```

```cpp
#include <hip/hip_runtime.h>
#include <hip/hip_cooperative_groups.h>
#include <cstdio>
#include <cstdint>
namespace cg = cooperative_groups;

#ifndef N_LAUNCH_MODE
#define N_LAUNCH_MODE 1
#endif

#define DEVI __device__ __forceinline__
#define LDS __attribute__((address_space(3)))

typedef _Float16 h16;
typedef _Float16 h16x4 __attribute__((ext_vector_type(4)));
typedef _Float16 h16x8 __attribute__((ext_vector_type(8)));
typedef float f32x4 __attribute__((ext_vector_type(4)));
typedef float f32x16 __attribute__((ext_vector_type(16)));
typedef unsigned u32x2 __attribute__((ext_vector_type(2)));
typedef unsigned u32x4 __attribute__((ext_vector_type(4)));

constexpr int NBATCH = 4, SEQ = 8192, NTOK = NBATCH * SEQ, DM = 1024;
constexpr int NTHR = 512;
constexpr int NPHASE = 10;
constexpr int LDS_BYTES = 163840;

constexpr size_t MiB = 1ull << 20;
constexpr size_t WS_CNT = 0;
constexpr size_t CTL_ZERO_BYTES = 20480;
constexpr size_t WS_BAR = 4096;
constexpr size_t WS_MODP = 64 * 1024;
constexpr size_t WS_ROPE = 1 * MiB;
constexpr size_t WS_WIN = 3 * MiB;
constexpr size_t WS_WOUT = 10 * MiB;
constexpr size_t WS_WGU = 12 * MiB;
constexpr size_t WS_WDN = 44 * MiB;
constexpr size_t WS_WRG = 60 * MiB;
constexpr size_t WS_WRT = 60 * MiB + 256 * 1024;
constexpr size_t WS_WRH = 60 * MiB + 512 * 1024;
constexpr size_t WS_WRL = 60 * MiB + 640 * 1024;
constexpr size_t WS_AGG = 61 * MiB;
constexpr size_t WS_ROUTE = 63 * MiB;
constexpr size_t WS_LIST = 64 * MiB;
constexpr size_t WS_LISTW = 68 * MiB;
constexpr size_t WS_WI = 72 * MiB;
constexpr size_t WS_KI = 73 * MiB;
constexpr size_t WS_MASK = 77 * MiB;
constexpr size_t WS_H = 109 * MiB;
constexpr size_t WS_Q = 173 * MiB;
constexpr size_t WS_K = 205 * MiB;
constexpr size_t WS_VT = 237 * MiB;
constexpr size_t WS_QI = 269 * MiB;
constexpr size_t WS_XR = 301 * MiB;
constexpr size_t WS_XG = 333 * MiB;
constexpr size_t WS_MIX = 365 * MiB;
constexpr size_t WS_ACT = 429 * MiB;
constexpr size_t WS_YP = 173 * MiB;
constexpr size_t WS_END = 510 * MiB;
constexpr size_t SC_BATCH_BYTES = 8192ull * 6176ull;
static_assert(SC_BATCH_BYTES <= 64 * MiB && WS_MIX + 3 * SC_BATCH_BYTES <= WS_END, "score slots");

struct Params { const float* in[24]; float* out; unsigned char* ws; int ph_lo, ph_hi; };
typedef const __attribute__((address_space(4))) Params& PRef;
typedef const __attribute__((address_space(4))) Params* PPtr;

__device__ const double ROPE_REV[32] = {
  1.59154943091895345608e-01, 1.19349370211248861917e-01, 8.94994016088910132600e-02, 6.71150830052272551196e-02,
  5.03292121044870352509e-02, 3.77415847174197710556e-02, 2.83021958306233986646e-02, 2.12236527647776604399e-02,
  1.59154943091895338669e-02, 1.19349370211248861917e-02, 8.94994016088910236684e-03, 6.71150830052272533849e-03,
  5.03292121044870369856e-03, 3.77415847174197719230e-03, 2.83021958306233986646e-03, 2.12236527647776621747e-03,
  1.59154943091895356017e-03, 1.19349370211248848907e-03, 8.94994016088910236684e-04, 6.71150830052272598901e-04,
  5.03292121044870326488e-04, 3.77415847174197740914e-04, 2.83021958306233954120e-04, 2.12236527647776605484e-04,
  1.59154943091895350596e-04, 1.19349370211248862459e-04, 8.94994016088910182474e-05, 6.71150830052272544691e-05,
  5.03292121044870353593e-05, 3.77415847174197768019e-05, 2.83021958306233960897e-05, 2.12236527647776591931e-05};

DEVI int launder(int x) { asm volatile("" : "+v"(x)); return x; }
DEVI PPtr get_params() { PPtr k = (PPtr)__builtin_amdgcn_kernarg_segment_ptr(); asm volatile("" : "+s"(k)); return k; }
DEVI int wave_id(int tid) { return __builtin_amdgcn_readfirstlane(tid >> 6); }
DEVI f32x16 mfma16(h16x8 a, h16x8 b, f32x16 c) { return __builtin_amdgcn_mfma_f32_32x32x16_f16(a, b, c, 0, 0, 0); }
DEVI float wave_sum(float v) {
#pragma unroll
  for (int o = 1; o < 64; o <<= 1) v += __shfl_xor(v, o);
  return v;
}
DEVI float sigmoid_f(float x) { return __builtin_amdgcn_rcpf(1.f + __expf(-x)); }
DEVI float silu_f(float x) { return x * __builtin_amdgcn_rcpf(1.f + __expf(-x)); }
DEVI float gelu_tanh_f(float x) {
  const float u = 0.7978845608028654f * (x + 0.044715f * x * x * x);
  const float t = 1.f - 2.f * __builtin_amdgcn_rcpf(1.f + __expf(2.f * u));
  return 0.5f * x * (1.f + t);
}
DEVI unsigned fkey(float f) { unsigned u = __float_as_uint(f); return (u & 0x80000000u) ? ~u : (u | 0x80000000u); }
DEVI float fkey_inv(unsigned k) { unsigned u = (k & 0x80000000u) ? (k & 0x7fffffffu) : ~k; return __uint_as_float(u); }
DEVI int vt_perm(int pos) { return (pos & ~12) | ((pos & 4) << 1) | ((pos & 8) >> 1); }

DEVI void mod_to_lds(PRef p, int b, int chunk, LDS float* dst) {
  const float* mp = (const float*)(p.ws + WS_MODP);
  for (int k = threadIdx.x; k < 1024; k += NTHR) {
    const int j = chunk * 1024 + k;
    float s = p.in[3][j];
#pragma unroll 1
    for (int ks = 0; ks < 8; ++ks) s += mp[(size_t)(ks * 4 + b) * 6144 + j];
    dst[k] = s;
  }
}

constexpr int LROW = 144;
constexpr int GA_BYTES = 256 * LROW, GB_BYTES = 128 * LROW, GSTAGE = GA_BYTES + GB_BYTES;

template <class AR, class EPI>
DEVI void gemm_tile(LDS unsigned char* lds, const AR& arow, const h16* Bt, int ldb, int K, EPI& epi) {
  const int tid = launder((int)threadIdx.x), lane = tid & 63, wave = wave_id(tid), wm = wave >> 1, wn = wave & 1;
  const int lr = tid >> 3, lc = tid & 7, l31 = lane & 31, half = lane >> 5;
  const h16* pa[4]; const h16* pb[2];
#pragma unroll
  for (int j = 0; j < 4; ++j) pa[j] = arow(lr + 64 * j) + lc * 8;
#pragma unroll
  for (int j = 0; j < 2; ++j) pb[j] = Bt + (size_t)(lr + 64 * j) * ldb + lc * 8;
  h16x8 ra[4], rb[2];
#pragma unroll
  for (int j = 0; j < 4; ++j) ra[j] = *(const h16x8*)pa[j];
#pragma unroll
  for (int j = 0; j < 2; ++j) rb[j] = *(const h16x8*)pb[j];
#pragma unroll
  for (int j = 0; j < 4; ++j) *(LDS h16x8*)(lds + (lr + 64 * j) * LROW + lc * 16) = ra[j];
#pragma unroll
  for (int j = 0; j < 2; ++j) *(LDS h16x8*)(lds + GA_BYTES + (lr + 64 * j) * LROW + lc * 16) = rb[j];
  __syncthreads();
  f32x16 acc[2][2];
#pragma unroll
  for (int a = 0; a < 2; ++a)
#pragma unroll
    for (int b = 0; b < 2; ++b)
#pragma unroll
      for (int r = 0; r < 16; ++r) acc[a][b][r] = 0.f;
  const int KT = K >> 6;
  for (int kt = 0; kt < KT; ++kt) {
    const int cur = kt & 1;
    if (kt + 1 < KT) {
#pragma unroll
      for (int j = 0; j < 4; ++j) ra[j] = *(const h16x8*)(pa[j] + (kt + 1) * 64);
#pragma unroll
      for (int j = 0; j < 2; ++j) rb[j] = *(const h16x8*)(pb[j] + (kt + 1) * 64);
    }
    LDS unsigned char* A = lds + cur * GSTAGE;
    LDS unsigned char* B = A + GA_BYTES;
#pragma unroll
    for (int kk = 0; kk < 4; ++kk) {
      h16x8 af[2], bf[2];
#pragma unroll
      for (int mi = 0; mi < 2; ++mi) af[mi] = *(LDS h16x8*)(A + (64 * wm + 32 * mi + l31) * LROW + (2 * kk + half) * 16);
#pragma unroll
      for (int ni = 0; ni < 2; ++ni) bf[ni] = *(LDS h16x8*)(B + (64 * wn + 32 * ni + l31) * LROW + (2 * kk + half) * 16);
#pragma unroll
      for (int mi = 0; mi < 2; ++mi)
#pragma unroll
        for (int ni = 0; ni < 2; ++ni) acc[mi][ni] = mfma16(bf[ni], af[mi], acc[mi][ni]);
    }
    if (kt + 1 < KT) {
      LDS unsigned char* A2 = lds + (cur ^ 1) * GSTAGE;
#pragma unroll
      for (int j = 0; j < 4; ++j) *(LDS h16x8*)(A2 + (lr + 64 * j) * LROW + lc * 16) = ra[j];
#pragma unroll
      for (int j = 0; j < 2; ++j) *(LDS h16x8*)(A2 + GA_BYTES + (lr + 64 * j) * LROW + lc * 16) = rb[j];
    }
    __syncthreads();
  }
  epi(acc, wm, wn, lane);
}


namespace g8 {
constexpr int BM = 256, BK = 64, HALF = 128, HTB = HALF * BK * 2, STAGE_BYTES = 8 * HTB;
DEVI int lds_byte(int r, int c) { const int st = (r >> 4) * 2 + (c >> 5), rr = r & 15, cc = c & 31, ob = rr * 64 + cc * 2; return st * 1024 + (ob ^ (((ob >> 9) & 1) << 5)); }
DEVI void stage_rc(int b, int& R, int& C) { const int st = b / 1024, sb = b % 1024, swz = sb ^ (((sb >> 9) & 1) << 5); R = (st >> 1) * 16 + swz / 64; C = (st & 1) * 32 + (swz % 64) / 2; }
struct Unit { const char* A; unsigned va[2][2]; const char* B; int pm, pn, e, cnt, off; };
DEVI void glds16(const char* src, LDS unsigned char* dst) { __builtin_amdgcn_global_load_lds((const unsigned*)src, (LDS unsigned*)dst, 16, 0, 0); }

DEVI void dense_va(unsigned (&va)[2][2], int K) {
  const int tid = threadIdx.x;
#pragma unroll
  for (int h = 0; h < 2; ++h)
#pragma unroll
    for (int i = 0; i < 2; ++i) { int R, C; stage_rc(tid * 16 + i * 8192, R, C); va[h][i] = (unsigned)((128 * h + R) * K + C) * 2u; }
}
template <class Sched, class Epi>
DEVI void gemm_phase(LDS unsigned char* lds, int K, const Sched& S, const Epi& E) {
  const int tid = launder((int)threadIdx.x), wid = wave_id(tid), lane = tid & 63, wr = wid >> 2, wc = wid & 3, fr = lane & 15, fq = lane >> 4;
  const int nt = launder(K) / BK;
  unsigned vb[2];
#pragma unroll
  for (int i = 0; i < 2; ++i) { int R, C; stage_rc(tid * 16 + i * 8192, R, C); vb[i] = (unsigned)(R * K + C) * 2u; }
  const size_t kstep = (size_t)(BK * 2), hstep = (size_t)HALF * K * 2;
  const unsigned ldsw = (unsigned)wid * 1024u;
  const int aoff = lds_byte(wr * 64 + fr, fq * 8), boff = lds_byte(wc * 32 + fr, fq * 8);
#define G8_SA(b, h) (((b) * 2 + (h)) * HTB)
#define G8_SB(b, h) ((4 + (b) * 2 + (h)) * HTB)
#define G8_STAGE(bufoff, gbase, v) do { glds16((gbase) + (v)[0], lds + (bufoff) + ldsw); glds16((gbase) + (v)[1], lds + (bufoff) + ldsw + 8192); } while (0)
#define G8_STAGEA(bufoff, gbase, h) do { glds16((gbase) + G8_VAC(h, 0), lds + (bufoff) + ldsw); glds16((gbase) + G8_VAC(h, 1), lds + (bufoff) + ldsw + 8192); } while (0)
#define G8_LDA(dst, b, h) do { _Pragma("unroll") for (int m = 0; m < 4; ++m) _Pragma("unroll") for (int k = 0; k < 2; ++k) dst[m][k] = *(const LDS h16x8*)(lds + G8_SA(b, h) + aoff + m * 2048 + k * 1024); } while (0)
#define G8_LDB(dst, b, h) do { _Pragma("unroll") for (int n = 0; n < 2; ++n) _Pragma("unroll") for (int k = 0; k < 2; ++k) dst[n][k] = *(const LDS h16x8*)(lds + G8_SB(b, h) + boff + n * 2048 + k * 1024); } while (0)
#define G8_MMA(ai, bj, At, Bt) do { __builtin_amdgcn_s_setprio(1); _Pragma("unroll") for (int m = 0; m < 4; ++m) _Pragma("unroll") for (int n = 0; n < 2; ++n) _Pragma("unroll") for (int k = 0; k < 2; ++k) \
        acc[ai][bj][m][n] = __builtin_amdgcn_mfma_f32_16x16x32_f16(Bt[n][k], At[m][k], acc[ai][bj][m][n], 0, 0, 0); __builtin_amdgcn_s_setprio(0); } while (0)
#define G8_WAIT_V(n) asm volatile("s_waitcnt vmcnt(" #n ")" ::: "memory")
#define G8_WAIT_L(n) asm volatile("s_waitcnt lgkmcnt(" #n ")" ::: "memory")
#define G8_BAR __builtin_amdgcn_s_barrier()
#define G8_SCHED __builtin_amdgcn_sched_barrier(0)
  Unit cur, nxt; int ui = 0;
  if (!S.next(0, cur)) return;
  unsigned vd[2][2];
  if (!Sched::GATHER) dense_va(vd, K);
#define G8_VAC(h, i) (Sched::GATHER ? cur.va[h][i] : vd[h][i])
#define G8_VAN(h, i) (Sched::GATHER ? nxt.va[h][i] : vd[h][i])
  f32x4 acc[2][2][4][2];
#pragma unroll
  for (int a = 0; a < 2; ++a)
#pragma unroll
    for (int b = 0; b < 2; ++b)
#pragma unroll
      for (int m = 0; m < 4; ++m)
#pragma unroll
        for (int n = 0; n < 2; ++n) acc[a][b][m][n] = (f32x4){0.f, 0.f, 0.f, 0.f};
  h16x8 At[4][2], B0[2][2], B1[2][2];
  const char* cA = cur.A; const char* cB = cur.B;
  G8_STAGE(G8_SB(0, 0), cB, vb); G8_STAGE(G8_SB(0, 1), cB + hstep, vb); G8_STAGEA(G8_SA(0, 0), cA, 0); G8_STAGEA(G8_SA(0, 1), cA, 1);
  if (wr == 1) G8_BAR;
  G8_WAIT_V(2); G8_BAR;
  G8_STAGE(G8_SB(1, 0), cB + kstep, vb); G8_STAGEA(G8_SA(1, 0), cA + kstep, 0); G8_STAGE(G8_SB(1, 1), cB + hstep + kstep, vb);
  G8_WAIT_V(6); G8_BAR;
  for (;;) {
    const bool has_next = S.next(ui + 1, nxt);
    if (!has_next) nxt = cur;
    const char* nA = nxt.A; const char* nB = nxt.B;
#pragma unroll 1
    for (int t = 0; t < nt; t += 2) {
      const bool last = (t == nt - 2);
      const char* a1 = cA + (size_t)(t + 1) * kstep;
      const char* a2 = last ? nA : cA + (size_t)(t + 2) * kstep; const char* b2 = last ? nB : cB + (size_t)(t + 2) * kstep;
      const char* a3 = a2 + kstep; const char* b3 = b2 + kstep;
#define G8_STAGE2(bufoff, gbase, h) do { glds16((gbase) + (last ? G8_VAN(h, 0) : G8_VAC(h, 0)), lds + (bufoff) + ldsw); glds16((gbase) + (last ? G8_VAN(h, 1) : G8_VAC(h, 1)), lds + (bufoff) + ldsw + 8192); } while (0)
      G8_LDB(B0, 0, 0); G8_LDB(B1, 0, 1); G8_SCHED; G8_LDA(At, 0, 0); G8_STAGEA(G8_SA(1, 1), a1, 1);
      G8_WAIT_V(8); G8_WAIT_L(0); G8_BAR; G8_MMA(0, 0, At, B0); G8_MMA(0, 1, At, B1); G8_BAR; G8_SCHED;
      G8_LDA(At, 0, 1); G8_STAGE(G8_SB(0, 0), b2, vb); G8_STAGE(G8_SB(0, 1), b2 + hstep, vb); G8_STAGE2(G8_SA(0, 0), a2, 0);
      G8_WAIT_V(8); G8_WAIT_L(0); G8_BAR; G8_MMA(1, 0, At, B0); G8_MMA(1, 1, At, B1); G8_BAR; G8_SCHED;
      G8_LDB(B0, 1, 0); G8_LDB(B1, 1, 1); G8_SCHED; G8_LDA(At, 1, 0); G8_STAGE2(G8_SA(0, 1), a2, 1);
      G8_WAIT_V(8); G8_WAIT_L(0); G8_BAR; G8_MMA(0, 0, At, B0); G8_MMA(0, 1, At, B1); G8_BAR; G8_SCHED;
      G8_LDA(At, 1, 1); G8_STAGE(G8_SB(1, 0), b3, vb); G8_STAGE(G8_SB(1, 1), b3 + hstep, vb); G8_STAGE2(G8_SA(1, 0), a3, 0);
      G8_WAIT_V(8); G8_WAIT_L(0); G8_BAR; G8_MMA(1, 0, At, B0); G8_MMA(1, 1, At, B1); G8_BAR; G8_SCHED;
    }
#undef G8_STAGE2
    if (wr == 0) G8_BAR;
    E(acc, cur, wr, wc, fr, fq);
    if (!has_next) break;
#pragma unroll
    for (int a = 0; a < 2; ++a)
#pragma unroll
      for (int b = 0; b < 2; ++b)
#pragma unroll
        for (int m = 0; m < 4; ++m)
#pragma unroll
          for (int n = 0; n < 2; ++n) acc[a][b][m][n] = (f32x4){0.f, 0.f, 0.f, 0.f};
    cur = nxt; cA = nA; cB = nB; ++ui;
    if (wr == 1) G8_BAR;
  }
  G8_WAIT_V(0);
  G8_BAR;
#undef G8_SA
#undef G8_STAGEA
#undef G8_VAC
#undef G8_VAN
#undef G8_SB
#undef G8_STAGE
#undef G8_LDA
#undef G8_LDB
#undef G8_MMA
#undef G8_WAIT_V
#undef G8_WAIT_L
#undef G8_BAR
#undef G8_SCHED
}
struct DenseOrder {
  static constexpr bool GATHER = false;
  const h16* A; const h16* Bt; int K, nM, nN, G, c;
  DEVI bool next(int i, Unit& u) const {
    const int nwg = nM * nN; const long L = (long)i * G + c; if (L >= nwg) return false;
    int wgid = (int)L; { const int q = nwg / 8, r = nwg % 8, xcd = wgid % 8, off = wgid / 8; wgid = (xcd < r ? xcd * (q + 1) : r * (q + 1) + (xcd - r) * q) + off; }
    const int nig = 8 * nN, gid = wgid / nig, fm = gid * 8, gsz = (nM - fm) < 8 ? (nM - fm) : 8;
    u.pm = fm + ((wgid % nig) % gsz); u.pn = (wgid % nig) / gsz; u.e = 0; u.cnt = 0x7fffffff; u.off = 0;
    u.A = (const char*)(A + (size_t)u.pm * 256 * K); u.B = (const char*)(Bt + (size_t)u.pn * 256 * K);
    u.va[0][0] = u.va[0][1] = u.va[1][0] = u.va[1][1] = 0u;
    return true;
  }
};
}

struct ARowPlain { const h16* base; size_t ld; DEVI const h16* operator()(int r) const { return base + (size_t)r * ld; } };
struct ARowGather { const h16* base; const unsigned* list; int n; int row0; DEVI const h16* operator()(int r) const { const int i = row0 + r; const unsigned t = (i < n) ? list[i] : 0u; return base + (size_t)t * DM; } };

DEVI h16x4 pack4(float a, float b, float c, float d) { h16x4 v; v[0] = (h16)a; v[1] = (h16)b; v[2] = (h16)c; v[3] = (h16)d; return v; }

template <class F>
DEVI void transpose_item(const float* src, int N, int kb, int nb, h16* dst, int ldd, F drow, LDS float* scr, int lane) {
#pragma unroll 8
  for (int i = 0; i < 32; ++i) {
    const int kk = 2 * i + (lane >> 5), n = nb * 32 + (lane & 31);
    scr[kk * 33 + (lane & 31)] = (n < N) ? src[(size_t)(kb * 64 + kk) * N + n] : 0.f;
  }
  asm volatile("s_waitcnt lgkmcnt(0)" ::: "memory");
  const int c = lane & 7;
#pragma unroll
  for (int j = 0; j < 4; ++j) {
    const int nl = (lane >> 3) + 8 * j, n = nb * 32 + nl;
    h16x8 v;
#pragma unroll
    for (int e = 0; e < 8; ++e) v[e] = (h16)scr[(c * 8 + e) * 33 + nl];
    if (n < N) *(h16x8*)(dst + (size_t)drow(n) * ldd + kb * 64 + c * 8) = v;
  }
  asm volatile("s_waitcnt lgkmcnt(0)" ::: "memory");
}

DEVI void phase0(PRef p, LDS unsigned char* lds) {
  const int tid = launder((int)threadIdx.x), lane = tid & 63, wave = wave_id(tid), G = gridDim.x;
  const int gw = blockIdx.x * 8 + wave, NW = G * 8;
  {
    const float* c = p.in[1]; const float* wada = p.in[2]; float* mp = (float*)(p.ws + WS_MODP);
    for (int u = gw; u < 96 * 8; u += NW) {
      const int cgp = u % 96, ks = u / 96, j = cgp * 64 + lane;
      float a0 = 0.f, a1 = 0.f, a2 = 0.f, a3 = 0.f;
      for (int k = ks * 128; k < ks * 128 + 128; ++k) {
        const float w = wada[(size_t)k * 6144 + j];
        a0 = fmaf(silu_f(c[k]), w, a0); a1 = fmaf(silu_f(c[1024 + k]), w, a1);
        a2 = fmaf(silu_f(c[2048 + k]), w, a2); a3 = fmaf(silu_f(c[3072 + k]), w, a3);
      }
      mp[(size_t)(ks * 4 + 0) * 6144 + j] = a0; mp[(size_t)(ks * 4 + 1) * 6144 + j] = a1;
      mp[(size_t)(ks * 4 + 2) * 6144 + j] = a2; mp[(size_t)(ks * 4 + 3) * 6144 + j] = a3;
    }
  }
  {
    LDS float* scr = (LDS float*)lds + wave * (64 * 33);
    constexpr int I_IN = 16 * 99, I_OUT = 16 * 32, I_G = 32 * 128, I_U = 32 * 128, I_D = 32 * 128, I_RG = 32;
    constexpr int NIT = I_IN + I_OUT + I_G + I_U + I_D + I_RG;
    for (int it = gw; it < NIT; it += NW) {
      int r = it;
      if (r < I_IN) {
        transpose_item(p.in[8], 3144, r / 99, r % 99, (h16*)(p.ws + WS_WIN), 1024,
                       [](int n) { const int dl = n < 2112 ? n : (n < 2120 ? 3136 + (n - 2112) : (n < 2632 ? 2112 + (n - 2120) : 2624 + (n - 2632))); const int d = dl & 63; return (dl & ~63) + 32 * ((d >> 4) & 1) + 16 * (d >> 5) + (d & 15); }, scr, lane);
        continue;
      }
      r -= I_IN;
      if (r < I_OUT) { transpose_item(p.in[16], 1024, r / 32, r % 32, (h16*)(p.ws + WS_WOUT), 1024, [](int n) { return n; }, scr, lane); continue; }
      r -= I_OUT;
      if (r < I_G) { const int e = r >> 7, q = r & 127;
        transpose_item(p.in[21] + (size_t)e * 1024 * 256, 256, q >> 3, q & 7, (h16*)(p.ws + WS_WGU) + (size_t)e * 512 * 1024, 1024, [](int f) { return (f >> 4) * 32 + (f & 15); }, scr, lane); continue; }
      r -= I_G;
      if (r < I_U) { const int e = r >> 7, q = r & 127;
        transpose_item(p.in[22] + (size_t)e * 1024 * 256, 256, q >> 3, q & 7, (h16*)(p.ws + WS_WGU) + (size_t)e * 512 * 1024, 1024, [](int f) { return (f >> 4) * 32 + 16 + (f & 15); }, scr, lane); continue; }
      r -= I_U;
      if (r < I_D) { const int e = r >> 7, q = r & 127;
        transpose_item(p.in[23] + (size_t)e * 256 * 1024, 1024, q >> 5, q & 31, (h16*)(p.ws + WS_WDN) + (size_t)e * 1024 * 256, 256, [](int n) { return n; }, scr, lane); continue; }
      r -= I_D;
      if (r < 16) transpose_item(p.in[11] + (size_t)(r >> 1) * 4096, 64, 0, r & 1, (h16*)(p.ws + WS_WRG) + (size_t)(r >> 1) * 128 * 64, 64, [](int n) { return n; }, scr, lane);
      else transpose_item(p.in[13] + (size_t)((r - 16) >> 1) * 4096, 64, 0, r & 1, (h16*)(p.ws + WS_WRG) + (size_t)((r - 16) >> 1) * 128 * 64, 64, [](int n) { return 64 + n; }, scr, lane);
    }
  }
  {
    h16* wrh = (h16*)(p.ws + WS_WRH); h16* wrl = (h16*)(p.ws + WS_WRL);
    for (int i = blockIdx.x * NTHR + tid; i < 48 * 1024; i += G * NTHR) {
      const int col = i >> 10, k = i & 1023;
      const float w = (col < 4) ? p.in[17][k * 4 + col] : (col < 36 ? p.in[19][k * 32 + (col - 4)] : 0.f);
      const h16 hi = (h16)w;
      wrh[i] = hi; wrl[i] = (h16)(w - (float)hi);
    }
    float* ct = (float*)(p.ws + WS_ROPE); float* st = ct + 8192 * 32;
    for (int i = blockIdx.x * NTHR + tid; i < 8192 * 32; i += G * NTHR) {
      const int pos = i >> 5, f = i & 31;
      const double rev = (double)pos * ROPE_REV[f];
      const float fr = (float)(rev - __builtin_rint(rev));
      ct[i] = __builtin_amdgcn_cosf(fr); st[i] = __builtin_amdgcn_sinf(fr);
    }
  }
}

DEVI void phase1(PRef p, LDS unsigned char* lds) {
  const int tid = launder((int)threadIdx.x), lane = tid & 63, wave = wave_id(tid), G = gridDim.x;
  const int b = blockIdx.x & 3, bi = blockIdx.x >> 2, nbk = G >> 2;
  LDS float* mv = (LDS float*)lds;
  mod_to_lds(p, b, 0, mv); mod_to_lds(p, b, 1, mv + 1024);
  __syncthreads();
  f32x4 A[4], SH[4];
#pragma unroll
  for (int j = 0; j < 4; ++j) {
    const int k = 256 * j + 4 * lane;
    const f32x4 g = *(const f32x4*)(p.in[4] + k);
    A[j] = g * (*(LDS f32x4*)(mv + 1024 + k) + 1.f);
    SH[j] = *(LDS f32x4*)(mv + k);
  }
  const float* x = p.in[0]; h16* H = (h16*)(p.ws + WS_H);
  for (int r = bi * 8 + wave; r < SEQ; r += nbk * 8) {
    const size_t tok = (size_t)b * SEQ + r;
    f32x4 v[4]; float ss = 0.f;
#pragma unroll
    for (int j = 0; j < 4; ++j) { v[j] = *(const f32x4*)(x + tok * DM + 256 * j + 4 * lane); ss += v[j][0] * v[j][0] + v[j][1] * v[j][1] + v[j][2] * v[j][2] + v[j][3] * v[j][3]; }
    const float rstd = 1.0f / sqrtf(wave_sum(ss) * (1.f / 1024.f) + 1e-6f);
#pragma unroll
    for (int j = 0; j < 4; ++j) {
      const f32x4 y = v[j] * rstd * A[j] + SH[j];
      *(h16x4*)(H + tok * DM + 256 * j + 4 * lane) = pack4(y[0], y[1], y[2], y[3]);
    }
  }
}

struct EpiInProj {
  unsigned char* ws;
  DEVI void operator()(const f32x4 (&acc)[2][2][4][2], const g8::Unit& u, int wr, int wc, int fr, int fq) const {
    const float* cosT = (const float*)(ws + WS_ROPE); const float* sinT = cosT + 8192 * 32;
    const int w2 = wc & 1, dlow = 16 * w2 + 4 * fq;
#pragma unroll
    for (int bj = 0; bj < 2; ++bj) {
      const int g = 4 * u.pn + 2 * bj + (wc >> 1);
      if (g > 49) continue;
#pragma unroll
      for (int ai = 0; ai < 2; ++ai)
#pragma unroll
        for (int m = 0; m < 4; ++m) {
          const int tok = u.pm * 256 + 128 * ai + 64 * wr + 16 * m + fr;
          const int b = tok >> 13, pos = tok & 8191;
          const f32x4 x1 = acc[ai][bj][m][0], x2 = acc[ai][bj][m][1];
          if (g < 16 || (g >= 24 && g <= 32)) {
            float scl; h16* dst;
            if (g < 8) { scl = 0.125f * 1.4426950408889634f; dst = (h16*)(ws + WS_Q) + (size_t)tok * 512 + g * 64; }
            else if (g < 16) { scl = 1.f; dst = (h16*)(ws + WS_K) + (size_t)tok * 512 + (g - 8) * 64; }
            else if (g < 32) { scl = 0.125f; dst = (h16*)(ws + WS_QI) + (size_t)tok * 512 + (g - 24) * 64; }
            else { scl = 1.f; dst = (h16*)(ws + WS_KI) + (size_t)tok * 64; }
            const f32x4 c = *(const f32x4*)(cosT + pos * 32 + dlow), s = *(const f32x4*)(sinT + pos * 32 + dlow);
            const f32x4 o1 = (x1 * c - x2 * s) * scl, o2 = (x2 * c + x1 * s) * scl;
            *(h16x4*)(dst + dlow) = pack4(o1[0], o1[1], o1[2], o1[3]);
            *(h16x4*)(dst + 32 + dlow) = pack4(o2[0], o2[1], o2[2], o2[3]);
          } else if (g < 24) {
            h16* vt = (h16*)(ws + WS_VT) + (size_t)(b * 8 + (g - 16)) * 64 * 8192 + vt_perm(pos);
#pragma unroll
            for (int e = 0; e < 4; ++e) { vt[(size_t)(dlow + e) * 8192] = (h16)x1[e]; vt[(size_t)(32 + dlow + e) * 8192] = (h16)x2[e]; }
          } else if (g < 49) {
            h16* dst = (g < 41) ? (h16*)(ws + WS_XR) + (size_t)tok * 512 + (g - 33) * 64 : (h16*)(ws + WS_XG) + (size_t)tok * 512 + (g - 41) * 64;
            *(h16x4*)(dst + dlow) = pack4(x1[0], x1[1], x1[2], x1[3]);
            *(h16x4*)(dst + 32 + dlow) = pack4(x2[0], x2[1], x2[2], x2[3]);
          } else if (w2 == 0 && fq < 2) {
            const float sc = 0.35355339059327373f;
            *(f32x4*)((float*)(ws + WS_WI) + (size_t)tok * 8 + 4 * fq) = x1 * sc;
          }
        }
    }
  }
};

DEVI void phase2(PRef p, LDS unsigned char* lds) {
  g8::DenseOrder S{(const h16*)(p.ws + WS_H), (const h16*)(p.ws + WS_WIN), DM, 128, 13, (int)gridDim.x, (int)blockIdx.x};
  EpiInProj E{p.ws};
  g8::gemm_phase(lds, DM, S, E);
}

constexpr int CROW = 1040;
constexpr int RNN_XG = 64 * CROW;
constexpr int RNN_CARRY = 2 * 64 * CROW;
template <int MODE>
DEVI void rnn_item(PRef p, LDS unsigned char* lds, int b, int cr) {
  const int tid = launder((int)threadIdx.x), lane = tid & 63, wave = wave_id(tid), l31 = lane & 31, half = lane >> 5;
  const h16* XR = (const h16*)(p.ws + WS_XR);
  {
    const int chg = tid & 63, tg = tid >> 6, pos0 = cr * 64 + 8 * tg;
    h16x8 xin[11];
#pragma unroll
    for (int i = 0; i < 11; ++i) {
      const int pos = pos0 + i - 3;
      if (pos >= 0) xin[i] = *(const h16x8*)(XR + ((size_t)b * SEQ + pos) * 512 + chg * 8);
      else {
#pragma unroll
        for (int e = 0; e < 8; ++e) xin[i][e] = (h16)0.f;
      }
    }
    float cw[4][8], cb[8];
#pragma unroll
    for (int e = 0; e < 8; ++e) {
      cb[e] = p.in[10][chg * 8 + e];
#pragma unroll
      for (int j = 0; j < 4; ++j) cw[j][e] = p.in[9][j * 512 + chg * 8 + e];
    }
#pragma unroll
    for (int tt = 0; tt < 8; ++tt) {
      h16x8 o;
#pragma unroll
      for (int e = 0; e < 8; ++e) {
        float v = cb[e];
#pragma unroll
        for (int j = 0; j < 4; ++j) v = fmaf(cw[j][e], (float)xin[tt + j][e], v);
        o[e] = (h16)v;
      }
      *(LDS h16x8*)(lds + (8 * tg + tt) * CROW + chg * 16) = o;
    }
  }
  if (MODE == 1) {
    const float2* ag = (const float2*)(p.ws + WS_AGG) + (size_t)b * 128 * 512 + tid;
    float carry = 0.f; int c2 = 0;
    for (; c2 + 8 <= cr; c2 += 8) {
      float2 v[8];
#pragma unroll
      for (int u = 0; u < 8; ++u) v[u] = ag[(size_t)(c2 + u) * 512];
#pragma unroll
      for (int u = 0; u < 8; ++u) carry = fmaf(v[u].x, carry, v[u].y);
    }
    for (; c2 < cr; ++c2) { const float2 v = ag[(size_t)c2 * 512]; carry = fmaf(v.x, carry, v.y); }
    ((LDS float*)(lds + RNN_CARRY))[tid] = carry;
  }
  if (MODE == 1) {
    const h16* XG = (const h16*)(p.ws + WS_XG) + ((size_t)b * SEQ + cr * 64) * 512;
#pragma unroll
    for (int i = 0; i < 8; ++i) { const int c = tid + NTHR * i, row = c >> 6, cc = c & 63; *(LDS h16x8*)(lds + RNN_XG + row * CROW + cc * 16) = *(const h16x8*)(XG + (size_t)row * 512 + cc * 8); }
  }
  __syncthreads();
  const int n = wave;
  const h16* WRG = (const h16*)(p.ws + WS_WRG) + (size_t)n * 128 * 64;
  float* AGG = (float*)(p.ws + WS_AGG);
#pragma unroll 1
  for (int dt = 0; dt < 2; ++dt) {
    h16x8 wa[4], wx[4];
#pragma unroll
    for (int kk = 0; kk < 4; ++kk) {
      wa[kk] = *(const h16x8*)(WRG + (size_t)(32 * dt + l31) * 64 + 16 * kk + 8 * half);
      wx[kk] = *(const h16x8*)(WRG + (size_t)(64 + 32 * dt + l31) * 64 + 16 * kk + 8 * half);
    }
    f32x16 ra[2], rx[2];
#pragma unroll
    for (int ti = 0; ti < 2; ++ti) {
#pragma unroll
      for (int r = 0; r < 16; ++r) { ra[ti][r] = 0.f; rx[ti][r] = 0.f; }
#pragma unroll
      for (int kk = 0; kk < 4; ++kk) {
        const h16x8 af = *(LDS h16x8*)(lds + (32 * ti + l31) * CROW + (n * 64 + 16 * kk + 8 * half) * 2);
        ra[ti] = mfma16(af, wa[kk], ra[ti]);
        rx[ti] = mfma16(af, wx[kk], rx[ti]);
      }
    }
    const int ch = n * 64 + 32 * dt + l31;
    const float ba = p.in[12][ch], bx = p.in[14][ch], lam = p.in[15][ch];
    const float c8 = -8.f * log1pf(__expf(-lam));
#pragma unroll
    for (int ti = 0; ti < 2; ++ti)
#pragma unroll
      for (int r = 0; r < 16; ++r) {
        const int tk = 32 * ti + (r & 3) + 8 * (r >> 2) + 4 * half;
        const float cv = (float)*(LDS h16*)(lds + tk * CROW + ch * 2);
        const float rr = sigmoid_f(ra[ti][r] + ba), ii = sigmoid_f(rx[ti][r] + bx);
        const float la = c8 * rr;
        ra[ti][r] = __expf(la);
        const float x2 = 2.f * la;
        const float om = -x2 * fmaf(x2 * 0.5f, fmaf(x2 * (1.f / 3.f), fmaf(x2 * 0.25f, fmaf(x2, 0.2f, 1.f), 1.f), 1.f), 1.f);
        rx[ti][r] = __builtin_amdgcn_sqrtf(om) * (ii * cv);
      }
    float P[8], Hs[8];
#pragma unroll
    for (int sg = 0; sg < 8; ++sg) {
      const int ti = sg >> 2, q = sg & 3;
      float pp = 1.f, hh = 0.f;
#pragma unroll
      for (int i = 0; i < 4; ++i) { const float a = ra[ti][4 * q + i], bb = rx[ti][4 * q + i]; hh = fmaf(a, hh, bb); pp *= a; }
      P[sg] = pp; Hs[sg] = hh;
    }
    float carry = 0.f, prod = 1.f;
    if (MODE == 1) carry = ((LDS float*)(lds + RNN_CARRY))[ch];
    float cin[8];
#pragma unroll
    for (int sg = 0; sg < 8; ++sg)
#pragma unroll
      for (int ow = 0; ow < 2; ++ow) {
        const float tmp = fmaf(P[sg], carry, Hs[sg]);
        const float tp = P[sg] * prod;
        if (half == ow) cin[sg] = carry;
        const float oth = __shfl_xor(tmp, 32), otp = __shfl_xor(tp, 32);
        carry = (half == ow) ? tmp : oth;
        prod = (half == ow) ? tp : otp;
      }
    if (MODE == 0) {
      if (half == 0) { float* ag = AGG + ((size_t)(b * 128 + cr) * 512 + ch) * 2; ag[0] = prod; ag[1] = carry; }
    } else {
#pragma unroll
      for (int sg = 0; sg < 8; ++sg) {
        const int ti = sg >> 2, q = sg & 3;
        float hh = cin[sg];
#pragma unroll
        for (int i = 0; i < 4; ++i) {
          hh = fmaf(ra[ti][4 * q + i], hh, rx[ti][4 * q + i]);
          LDS h16* xp = (LDS h16*)(lds + RNN_XG + (32 * ti + 8 * q + 4 * half + i) * CROW + ch * 2);
          *xp = (h16)(hh * gelu_tanh_f((float)*xp));
        }
      }
    }
  }
  __syncthreads();
  if (MODE == 1) {
    h16* Y = (h16*)(p.ws + WS_H) + ((size_t)b * SEQ + cr * 64) * DM + 512;
#pragma unroll
    for (int i = 0; i < 8; ++i) { const int c = tid + NTHR * i, row = c >> 6, cc = c & 63; *(h16x8*)(Y + (size_t)row * DM + cc * 8) = *(LDS h16x8*)(lds + RNN_XG + row * CROW + cc * 16); }
    __syncthreads();
  }
}

constexpr int IDX_NB = 256, IDX_CAP = 128;
constexpr int IL_HIST = 0, IL_CS = 65536, IL_CK = IL_CS + 64 * IDX_CAP * 4, IL_KI = IL_CK + 64 * IDX_CAP * 2, IL_KISZ = 128 * LROW, IL_ST = IL_KI + 2 * IL_KISZ;
static_assert(IL_ST + 4096 <= LDS_BYTES, "indexer LDS map");

DEVI f32x4 mfma16s(h16x8 a, h16x8 b, f32x4 c) { return __builtin_amdgcn_mfma_f32_16x16x32_f16(a, b, c, 0, 0, 0); }
DEVI void idx_score(LDS unsigned char* kit, int kh, int l15, int g4, const h16x8 (&qf)[8][2], const float (&wq)[8], f32x4 (&sc)[4]) {
  h16x8 kf[4][2];
#pragma unroll
  for (int kt = 0; kt < 4; ++kt)
#pragma unroll
    for (int ks = 0; ks < 2; ++ks) kf[kt][ks] = *(LDS h16x8*)(kit + (64 * kh + 16 * kt + l15) * LROW + (4 * ks + g4) * 16);
#pragma unroll
  for (int kt = 0; kt < 4; ++kt) sc[kt] = (f32x4){0.f, 0.f, 0.f, 0.f};
  f32x4 accA[4], accB[4];
#define IDX_MM(ACC, h) _Pragma("unroll") for (int kt = 0; kt < 4; ++kt) { ACC[kt] = mfma16s(kf[kt][0], qf[h][0], (f32x4){0.f, 0.f, 0.f, 0.f}); ACC[kt] = mfma16s(kf[kt][1], qf[h][1], ACC[kt]); }
#define IDX_RS(ACC, h) _Pragma("unroll") for (int kt = 0; kt < 4; ++kt) _Pragma("unroll") for (int r = 0; r < 4; ++r) sc[kt][r] = __builtin_fmaf(wq[h], __int_as_float(max(__float_as_int(ACC[kt][r]), 0)), sc[kt][r]);
  IDX_MM(accA, 0)
  IDX_MM(accB, 1) IDX_RS(accA, 0)
  IDX_MM(accA, 2) IDX_RS(accB, 1)
  IDX_MM(accB, 3) IDX_RS(accA, 2)
  IDX_MM(accA, 4) IDX_RS(accB, 3)
  IDX_MM(accB, 5) IDX_RS(accA, 4)
  IDX_MM(accA, 6) IDX_RS(accB, 5)
  IDX_MM(accB, 7) IDX_RS(accA, 6)
  IDX_RS(accB, 7)
#undef IDX_MM
#undef IDX_RS
}

template <int MODE>
DEVI void idx_pass(LDS unsigned char* lds, const h16* KIb, int N, int stride, int qg, int kh,
                   const h16* QIrow0, const float* WIrow0, float qinv, float qoff, int bstar, h16* scbase) {
  const int tid = launder((int)threadIdx.x), lane = tid & 63, l15 = lane & 15, g4 = lane >> 4;
  const int q = 16 * qg + l15;
  h16x8 qf[8][2]; float wq[8];
  {
    const h16* QI = QIrow0 + (size_t)q * 512;
#pragma unroll
    for (int h = 0; h < 8; ++h)
#pragma unroll
      for (int ks = 0; ks < 2; ++ks) qf[h][ks] = *(const h16x8*)(QI + h * 64 + 32 * ks + 8 * g4);
    const float* WI = WIrow0 + (size_t)q * 8;
#pragma unroll
    for (int h = 0; h < 8; ++h) wq[h] = WI[h];
  }
  LDS unsigned* hist = (LDS unsigned*)(lds + IL_HIST);
  LDS unsigned* st = (LDS unsigned*)(lds + IL_ST);
  const int nst = (N + 127) >> 7;
  const int lr = tid >> 3, lc = tid & 7;
  h16x8 r0, r1;
  r0 = *(const h16x8*)(KIb + (size_t)lr * 64 + lc * 8); r1 = *(const h16x8*)(KIb + (size_t)(lr + 64) * 64 + lc * 8);
  *(LDS h16x8*)(lds + IL_KI + lr * LROW + lc * 16) = r0; *(LDS h16x8*)(lds + IL_KI + (lr + 64) * LROW + lc * 16) = r1;
  __syncthreads();
  float vmin = INFINITY, vmax = -INFINITY;
  int cur = 0;
  for (int s = 0; s < nst; s += stride) {
    const int nx = s + stride;
    if (nx < nst) { r0 = *(const h16x8*)(KIb + (size_t)(128 * nx + lr) * 64 + lc * 8); r1 = *(const h16x8*)(KIb + (size_t)(128 * nx + lr + 64) * 64 + lc * 8); }
    if (128 * s + 64 * kh < N) {
      f32x4 sc[4];
      idx_score(lds + IL_KI + cur * IL_KISZ, kh, l15, g4, qf, wq, sc);
      if (MODE == 0) {
#pragma unroll
        for (int kt = 0; kt < 4; ++kt)
#pragma unroll
          for (int r = 0; r < 4; ++r) { vmin = fminf(vmin, sc[kt][r]); vmax = fmaxf(vmax, sc[kt][r]); }
      } else if (MODE == 1) {
        h16* scp = scbase + ((size_t)((s * 2 + kh) * 4) * 1024 + q * 16 + 4 * g4);
#pragma unroll
        for (int kt = 0; kt < 4; ++kt) {
          const h16x4 hv = pack4(sc[kt][0], sc[kt][1], sc[kt][2], sc[kt][3]);
          *(h16x4*)(scp + kt * 1024) = hv;
#pragma unroll
          for (int r = 0; r < 4; ++r) {
            const float xb = fminf(fmaxf(__builtin_fmaf((float)hv[r], qinv, qoff), 0.f), (float)(IDX_NB - 1));
            const int bin = (int)xb;
            __hip_atomic_fetch_add(&hist[bin * 64 + q], 1u, __ATOMIC_RELAXED, __HIP_MEMORY_SCOPE_WORKGROUP);
          }
        }
      } else {
        unsigned nib = 0u;
#pragma unroll
        for (int kt = 0; kt < 4; ++kt)
#pragma unroll
          for (int r = 0; r < 4; ++r) {
            const float xb = fminf(fmaxf(__builtin_fmaf(sc[kt][r], qinv, qoff), 0.f), (float)(IDX_NB - 1));
            const int bin = (int)xb;
            if (bin > bstar) nib |= (1u << (4 * kt + r));
            else if (bin == bstar) {
              const unsigned pos = __hip_atomic_fetch_add(&st[128 + q], 1u, __ATOMIC_RELAXED, __HIP_MEMORY_SCOPE_WORKGROUP);
              if (pos < (unsigned)IDX_CAP) {
                ((LDS float*)(lds + IL_CS))[q * IDX_CAP + pos] = sc[kt][r];
                ((LDS unsigned short*)(lds + IL_CK))[q * IDX_CAP + pos] = (unsigned short)(128 * s + 64 * kh + 16 * kt + 4 * g4 + r);
              }
            }
          }
        const unsigned oth = (unsigned)__shfl_xor((int)nib, 32);
        if (lane < 32) {
#pragma unroll
          for (int T = 0; T < 2; ++T) {
            const unsigned b0 = ((nib >> (8 * T)) & 15u) | (((oth >> (8 * T)) & 15u) << 4);
            const unsigned b1 = ((nib >> (8 * T + 4)) & 15u) | (((oth >> (8 * T + 4)) & 15u) << 4);
            ((LDS unsigned short*)(lds + IL_HIST))[q * 512 + (4 * s + 2 * kh + T) * 2 + (g4 & 1)] = (unsigned short)(b0 | (b1 << 8));
          }
        }
      }
    }
    if (nx < nst) {
      *(LDS h16x8*)(lds + IL_KI + (cur ^ 1) * IL_KISZ + lr * LROW + lc * 16) = r0;
      *(LDS h16x8*)(lds + IL_KI + (cur ^ 1) * IL_KISZ + (lr + 64) * LROW + lc * 16) = r1;
    }
    __syncthreads();
    cur ^= 1;
  }
  if (MODE == 0) {
    __hip_atomic_fetch_min(&st[q], fkey(vmin), __ATOMIC_RELAXED, __HIP_MEMORY_SCOPE_WORKGROUP);
    __hip_atomic_fetch_max(&st[64 + q], fkey(vmax), __ATOMIC_RELAXED, __HIP_MEMORY_SCOPE_WORKGROUP);
  }
}

DEVI void idx_stream_step(LDS unsigned char* lds, LDS unsigned* st, const unsigned long long (&cur)[4], int s, int kh, int q, int lane, int g4, float qinv, float qoff, int bstar) {
  unsigned nib = 0u;
#pragma unroll
  for (int kt = 0; kt < 4; ++kt) {
    const h16x4 hv = __builtin_bit_cast(h16x4, cur[kt]);
#pragma unroll
    for (int r = 0; r < 4; ++r) {
      const float sv = (float)hv[r];
      const float xb = fminf(fmaxf(__builtin_fmaf(sv, qinv, qoff), 0.f), (float)(IDX_NB - 1));
      const int bin = (int)xb;
      if (bin > bstar) nib |= (1u << (4 * kt + r));
      else if (bin == bstar) {
        const unsigned pos = __hip_atomic_fetch_add(&st[128 + q], 1u, __ATOMIC_RELAXED, __HIP_MEMORY_SCOPE_WORKGROUP);
        if (pos < (unsigned)IDX_CAP) {
          ((LDS float*)(lds + IL_CS))[q * IDX_CAP + pos] = sv;
          ((LDS unsigned short*)(lds + IL_CK))[q * IDX_CAP + pos] = (unsigned short)(128 * s + 64 * kh + 16 * kt + 4 * g4 + r);
        }
      }
    }
  }
  const unsigned oth = (unsigned)__shfl_xor((int)nib, 32);
  if (lane < 32) {
#pragma unroll
    for (int T = 0; T < 2; ++T) {
      const unsigned b0 = ((nib >> (8 * T)) & 15u) | (((oth >> (8 * T)) & 15u) << 4);
      const unsigned b1 = ((nib >> (8 * T + 4)) & 15u) | (((oth >> (8 * T + 4)) & 15u) << 4);
      ((LDS unsigned short*)(lds + IL_HIST))[q * 512 + (4 * s + 2 * kh + T) * 2 + (g4 & 1)] = (unsigned short)(b0 | (b1 << 8));
    }
  }
}
DEVI void idx_stream(LDS unsigned char* lds, int N, int qg, int kh, float qinv, float qoff, int bstar, const h16* scbase) {
  const int tid = launder((int)threadIdx.x), lane = tid & 63, l15 = lane & 15, g4 = lane >> 4;
  const int q = 16 * qg + l15;
  LDS unsigned* st = (LDS unsigned*)(lds + IL_ST);
  const int nv = (N - 64 * kh + 127) >> 7;
  const unsigned long long* scp = (const unsigned long long*)(scbase + ((size_t)(kh * 4) * 1024 + q * 16 + 4 * g4));
#define IDX_LD(dst, s_) do { if ((s_) < nv) { _Pragma("unroll") for (int kt = 0; kt < 4; ++kt) dst[kt] = __hip_atomic_load(scp + (size_t)(s_) * 2048 + kt * 256, __ATOMIC_RELAXED, __HIP_MEMORY_SCOPE_AGENT); } } while (0)
  unsigned long long b0[4], b1[4], b2[4], b3[4];
  IDX_LD(b0, 0); IDX_LD(b1, 1); IDX_LD(b2, 2); IDX_LD(b3, 3);
  for (int s = 0; s < nv; s += 4) {
    idx_stream_step(lds, st, b0, s, kh, q, lane, g4, qinv, qoff, bstar); IDX_LD(b0, s + 4);
    if (s + 1 < nv) { idx_stream_step(lds, st, b1, s + 1, kh, q, lane, g4, qinv, qoff, bstar); IDX_LD(b1, s + 5); }
    if (s + 2 < nv) { idx_stream_step(lds, st, b2, s + 2, kh, q, lane, g4, qinv, qoff, bstar); IDX_LD(b2, s + 6); }
    if (s + 3 < nv) { idx_stream_step(lds, st, b3, s + 3, kh, q, lane, g4, qinv, qoff, bstar); IDX_LD(b3, s + 7); }
  }
#undef IDX_LD
}

DEVI void idx_item(PRef p, LDS unsigned char* lds, int b, int c) {
  const int tid = launder((int)threadIdx.x), lane = tid & 63, wave = wave_id(tid), l31 = lane & 31, half = lane >> 5;
  const int N = 64 * (c + 1);
  unsigned* MASK = (unsigned*)(p.ws + WS_MASK) + ((size_t)b * SEQ + 64 * c) * 256;
  if (N <= 256) {
    const int wpr = N >> 5;
    for (int i = tid; i < 64 * wpr; i += NTHR) MASK[(size_t)(i / wpr) * 256 + (i % wpr)] = 0xFFFFFFFFu;
    return;
  }
  const int qg = wave & 3, kh = wave >> 2, l15 = lane & 15, q = 16 * qg + l15;
  const h16* QIrow0 = (const h16*)(p.ws + WS_QI) + ((size_t)b * SEQ + 64 * c) * 512;
  const float* WIrow0 = (const float*)(p.ws + WS_WI) + ((size_t)b * SEQ + 64 * c) * 8;
  const h16* KIb = (const h16*)(p.ws + WS_KI) + (size_t)b * SEQ * 64;
  h16* scbase;
  {
    const int j = (c < 64) ? c : 127 - c;
    const size_t pre = 8192ull * (size_t)(128 * j - (j * (j - 1)) / 2);
    scbase = (h16*)(p.ws + (b == 0 ? WS_H : WS_MIX + (size_t)(b - 1) * SC_BATCH_BYTES) + pre);
  }
  LDS unsigned* st = (LDS unsigned*)(lds + IL_ST);
  LDS float* stf = (LDS float*)(lds + IL_ST);
  if (tid < 64) { st[tid] = 0xFFFFFFFFu; st[64 + tid] = 0u; st[128 + tid] = 0u; }
  __syncthreads();
  const int nst = (N + 127) >> 7;
  const int stride = nst >= 16 ? 8 : (nst >= 8 ? 4 : (nst >= 4 ? 2 : 1));
  idx_pass<0>(lds, KIb, N, stride, qg, kh, QIrow0, WIrow0, 0.f, 0.f, 0, scbase);
  __syncthreads();
  if (tid < 64) {
    const float lo = fkey_inv(st[tid]), hi = fkey_inv(st[64 + tid]);
    float d = hi - lo; if (!(d > 1e-20f)) d = 1.f;
    const float inv = (float)IDX_NB / (1.5f * d);
    stf[192 + tid] = inv; stf[256 + tid] = -(lo - 0.25f * d) * inv;
  }
  for (int i = tid; i < 16384; i += NTHR) ((LDS unsigned*)(lds + IL_HIST))[i] = 0u;
  __syncthreads();
  const float qinv = stf[192 + q], qoff = stf[256 + q];
  idx_pass<1>(lds, KIb, N, 1, qg, kh, QIrow0, WIrow0, qinv, qoff, 0, scbase);
  {
    LDS unsigned* hist = (LDS unsigned*)(lds + IL_HIST);
    for (int qq = wave; qq < 64; qq += 8) {
      unsigned hb[4];
#pragma unroll
      for (int j = 0; j < 4; ++j) hb[j] = hist[(4 * lane + j) * 64 + qq];
      const unsigned mine = hb[0] + hb[1] + hb[2] + hb[3];
      unsigned suf = mine;
#pragma unroll
      for (int o = 1; o < 64; o <<= 1) { const unsigned v = (unsigned)__shfl_down((int)suf, o); if (lane + o < 64) suf += v; }
      unsigned cum = suf - mine;
      if (cum < 256u && suf >= 256u) {
#pragma unroll
        for (int j = 3; j >= 0; --j) {
          if (cum < 256u && cum + hb[j] >= 256u) { st[320 + qq] = (unsigned)(4 * lane + j); st[384 + qq] = 256u - cum; }
          cum += hb[j];
        }
      }
    }
  }
  __syncthreads();
  const int bstar = (int)st[320 + q];
  __syncthreads();
  asm volatile("s_waitcnt vmcnt(0)" ::: "memory");
  idx_stream(lds, N, qg, kh, qinv, qoff, bstar, scbase);
  __syncthreads();
  for (int qq = wave; qq < 64; qq += 8) {
    const int nc = min((int)st[128 + qq], IDX_CAP); const unsigned need = st[384 + qq];
    LDS float* cs = (LDS float*)(lds + IL_CS) + qq * IDX_CAP; LDS unsigned short* ck = (LDS unsigned short*)(lds + IL_CK) + qq * IDX_CAP;
    for (int i = lane; i < nc; i += 64) {
      const float sv = cs[i]; const unsigned kv = ck[i];
      unsigned rank = 0u;
      for (int j = 0; j < nc; ++j) { const float sj = cs[j]; const unsigned kj = ck[j]; rank += (sj > sv || (sj == sv && kj < kv)) ? 1u : 0u; }
      if (rank < need) {
        const unsigned kl = kv & 31u;
        const unsigned bit = 16u * ((kl >> 2) & 1u) + (kl & 3u) + 4u * (kl >> 3);
        __hip_atomic_fetch_or((LDS unsigned*)(lds + IL_HIST) + qq * 256 + (kv >> 5), 1u << bit, __ATOMIC_RELAXED, __HIP_MEMORY_SCOPE_WORKGROUP);
      }
    }
  }
  __syncthreads();
  {
    const int cpr = N >> 6;
    for (int i = tid; i < 64 * cpr; i += NTHR) {
      const int row = i / cpr, cc = i % cpr;
      *(u32x2*)(MASK + (size_t)row * 256 + 2 * cc) = *(LDS u32x2*)(lds + IL_HIST + row * 1024 + cc * 8);
    }
  }
  __syncthreads();
}

DEVI void phase3(PRef p, LDS unsigned char* lds) {
  const int G = gridDim.x;
  for (int it = blockIdx.x; it < 512; it += G) rnn_item<0>(p, lds, it >> 7, it & 127);
  for (int it = blockIdx.x; it < 256; it += G) {
    const int b = it >> 6, j = it & 63;
#pragma unroll 1
    for (int w2 = 0; w2 < 2; ++w2) idx_item(p, lds, b, w2 ? j : 127 - j);
  }
}

constexpr int AT_BUF = 2 * 64 * LROW;
DEVI float max3f(float a, float b, float c) { float r; asm("v_max3_f32 %0, %1, %2, %3" : "=v"(r) : "v"(a), "v"(b), "v"(c)); return r; }
DEVI unsigned pk_rtz(float a, float b) { return __builtin_bit_cast(unsigned, __builtin_amdgcn_cvt_pkrtz(a, b)); }
DEVI void attn_tile(LDS unsigned char* Kt, LDS unsigned char* Vt, const h16x8 (&qf)[4], u32x2 mw, int l31, int half, f32x16 (&o)[2], float& mref, float& l, bool& init) {
  const unsigned nm0 = ~(mw[0] >> (16 * half)), nm1 = ~(mw[1] >> (16 * half));
  const unsigned negm = __float_as_uint(-mref);
  f32x16 s[2];
#pragma unroll
  for (int r = 0; r < 16; ++r) {
    unsigned e0 = (unsigned)__builtin_amdgcn_sbfe((int)nm0, r, 1), e1 = (unsigned)__builtin_amdgcn_sbfe((int)nm1, r, 1);
    asm volatile("" : "+v"(e0), "+v"(e1));
    s[0][r] = __uint_as_float((e0 & 0xFF800000u) | (~e0 & negm));
    s[1][r] = __uint_as_float((e1 & 0xFF800000u) | (~e1 & negm));
  }
#pragma unroll
  for (int ri = 0; ri < 2; ++ri)
#pragma unroll
    for (int kk = 0; kk < 4; ++kk) {
      const h16x8 kf = *(LDS h16x8*)(Kt + (32 * ri + l31) * LROW + (2 * kk + half) * 16);
      s[ri] = mfma16(kf, qf[kk], s[ri]);
    }
  asm volatile("s_nop 15\n\ts_nop 7" : "+v"(s[0]), "+v"(s[1]));
  float mx = max3f(s[0][0], s[1][0], s[0][1]), mx2 = max3f(s[1][1], s[0][2], s[1][2]);
#pragma unroll
  for (int r = 3; r < 15; r += 2) { mx = max3f(mx, s[0][r], s[1][r]); mx2 = max3f(mx2, s[0][r + 1], s[1][r + 1]); }
  mx = max3f(mx, s[0][15], s[1][15]);
  mx = max3f(mx, mx2, mx2);
  mx = max3f(mx, __shfl_xor(mx, 32), mx);
  const bool first = (!init) && (mx > -INFINITY);
  const bool resc = first || (mx > 8.f);
  if (__any(resc)) {
    init = init || first;
    const float delta = resc ? mx : 0.f;
    const float alpha = __builtin_amdgcn_exp2f(-delta);
#pragma unroll
    for (int r = 0; r < 16; ++r) { s[0][r] -= delta; s[1][r] -= delta; o[0][r] *= alpha; o[1][r] *= alpha; }
    l *= alpha; mref += delta;
  }
  float ls = 0.f;
#pragma unroll
  for (int r = 0; r < 16; ++r) {
    s[0][r] = __builtin_amdgcn_exp2f(s[0][r]); s[1][r] = __builtin_amdgcn_exp2f(s[1][r]);
    ls += s[0][r] + s[1][r];
  }
  l += ls;
  h16x8 pf[4];
#pragma unroll
  for (int s4 = 0; s4 < 4; ++s4) {
    u32x4 w;
#pragma unroll
    for (int e = 0; e < 4; ++e) w[e] = pk_rtz(s[s4 >> 1][8 * (s4 & 1) + 2 * e], s[s4 >> 1][8 * (s4 & 1) + 2 * e + 1]);
    pf[s4] = __builtin_bit_cast(h16x8, w);
  }
#pragma unroll
  for (int di = 0; di < 2; ++di)
#pragma unroll
    for (int s4 = 0; s4 < 4; ++s4) {
      const h16x8 vf = *(LDS h16x8*)(Vt + (32 * di + l31) * LROW + (2 * s4 + half) * 16);
      o[di] = mfma16(vf, pf[s4], o[di]);
    }
}

DEVI void attn_unit(PRef p, LDS unsigned char* lds, int b, int head, int qb) {
  const int tid = launder((int)threadIdx.x), lane = tid & 63, wave = wave_id(tid), l31 = lane & 31, half = lane >> 5;
  const int q0 = qb * 256 + wave * 32, cw = q0 >> 6, NS = qb + 1;
  const size_t tok = (size_t)b * SEQ + q0 + l31;
  h16x8 qf[4];
  {
    const h16* Q = (const h16*)(p.ws + WS_Q) + tok * 512 + head * 64;
#pragma unroll
    for (int kk = 0; kk < 4; ++kk) qf[kk] = *(const h16x8*)(Q + 16 * kk + 8 * half);
  }
  const unsigned* mrow = (const unsigned*)(p.ws + WS_MASK) + tok * 256;
  constexpr int TP = 2 * 64 * LROW, ABUF = 4 * TP;
  static_assert(2 * ABUF <= LDS_BYTES - 16, "attention LDS");
  const h16* ksrc[4]; const h16* vsrc[4]; int kdst[4], vdst[4];
#pragma unroll
  for (int i = 0; i < 4; ++i) {
    const int id = tid + NTHR * i;
    const int row = id >> 3, lc = id & 7;
    ksrc[i] = (const h16*)(p.ws + WS_K) + ((size_t)b * SEQ + row) * 512 + head * 64 + lc * 8;
    kdst[i] = (row >> 6) * TP + (row & 63) * LROW + lc * 16;
    const int d = id >> 5, c = id & 31;
    vsrc[i] = (const h16*)(p.ws + WS_VT) + ((size_t)(b * 8 + head) * 64 + d) * 8192 + c * 8;
    vdst[i] = (c >> 3) * TP + 64 * LROW + d * LROW + (c & 7) * 16;
  }
  h16x8 rkA[4], rvA[4], rkB[4], rvB[4];
#pragma unroll
  for (int i = 0; i < 4; ++i) { rkA[i] = *(const h16x8*)ksrc[i]; rvA[i] = *(const h16x8*)vsrc[i]; }
#pragma unroll
  for (int i = 0; i < 4; ++i) { *(LDS h16x8*)(lds + kdst[i]) = rkA[i]; *(LDS h16x8*)(lds + vdst[i]) = rvA[i]; }
  if (NS > 1) {
#pragma unroll
    for (int i = 0; i < 4; ++i) { rkA[i] = *(const h16x8*)(ksrc[i] + (size_t)256 * 512); rvA[i] = *(const h16x8*)(vsrc[i] + 256); }
  }
  u32x4 mwa = *(const u32x4*)mrow, mwb = *(const u32x4*)(mrow + 4), mna, mnb;
  mna = mwa; mnb = mwb;
  __syncthreads();
  f32x16 o[2];
#pragma unroll
  for (int r = 0; r < 16; ++r) { o[0][r] = 0.f; o[1][r] = 0.f; }
  float mref = 0.f, l = 0.f; bool init = false;
#define ATT_TILE(s, t, W0, W1) if (4 * (s) + (t) <= cw) { u32x2 m2; m2[0] = W0; m2[1] = W1; attn_tile(bb + (t) * TP, bb + (t) * TP + 64 * LROW, qf, m2, l31, half, o, mref, l, init); }
#define ATT_STEP(s, RKC, RVC, RKN, RVN) { \
    if ((s) + 2 < NS) { _Pragma("unroll") for (int i = 0; i < 4; ++i) { RKN[i] = *(const h16x8*)(ksrc[i] + (size_t)((s) + 2) * 256 * 512); RVN[i] = *(const h16x8*)(vsrc[i] + ((s) + 2) * 256); } } \
    if ((s) + 1 < NS) { mna = *(const u32x4*)(mrow + 8 * ((s) + 1)); mnb = *(const u32x4*)(mrow + 8 * ((s) + 1) + 4); } \
    { LDS unsigned char* bb = lds + ((s) & 1) * ABUF; \
      ATT_TILE(s, 0, mwa[0], mwa[1]) ATT_TILE(s, 1, mwa[2], mwa[3]) ATT_TILE(s, 2, mwb[0], mwb[1]) ATT_TILE(s, 3, mwb[2], mwb[3]) } \
    if ((s) + 1 < NS) { LDS unsigned char* nb = lds + (((s) + 1) & 1) * ABUF; _Pragma("unroll") for (int i = 0; i < 4; ++i) { *(LDS h16x8*)(nb + kdst[i]) = RKC[i]; *(LDS h16x8*)(nb + vdst[i]) = RVC[i]; } } \
    __syncthreads(); mwa = mna; mwb = mnb; }
  for (int s = 0; s < NS; s += 2) {
    ATT_STEP(s, rkA, rvA, rkB, rvB)
    if (s + 1 < NS) ATT_STEP(s + 1, rkB, rvB, rkA, rvA)
  }
#undef ATT_STEP
#undef ATT_TILE
  const float inv = 1.f / (l + __shfl_xor(l, 32));
  h16* Y = (h16*)(p.ws + WS_H) + tok * DM + head * 64;
#pragma unroll
  for (int di = 0; di < 2; ++di)
#pragma unroll
    for (int q = 0; q < 4; ++q)
      *(h16x4*)(Y + 32 * di + 8 * q + 4 * half) = pack4(o[di][4 * q] * inv, o[di][4 * q + 1] * inv, o[di][4 * q + 2] * inv, o[di][4 * q + 3] * inv);
}

DEVI void phase4(PRef p, LDS unsigned char* lds) {
  const int G = gridDim.x;
  for (int it = blockIdx.x; it < 512; it += G) rnn_item<1>(p, lds, it >> 7, it & 127);
  for (int it = blockIdx.x; it < 512; it += G) {
    const int bh = it >> 4, j = it & 15;
#pragma unroll 1
    for (int w2 = 0; w2 < 2; ++w2) attn_unit(p, lds, bh >> 3, bh & 7, w2 ? j : 31 - j);
  }
}

struct EpiPlain {
  h16* dst; int ld;
  DEVI void operator()(const f32x4 (&acc)[2][2][4][2], const g8::Unit& u, int wr, int wc, int fr, int fq) const {
#pragma unroll
    for (int ai = 0; ai < 2; ++ai)
#pragma unroll
      for (int m = 0; m < 4; ++m) {
        const int r = u.pm * 256 + 128 * ai + 64 * wr + 16 * m + fr;
        if (r < u.cnt) {
          h16* d = dst + (size_t)(u.off + r) * ld + u.pn * 256 + 32 * wc + 4 * fq;
#pragma unroll
          for (int bj = 0; bj < 2; ++bj)
#pragma unroll
            for (int n = 0; n < 2; ++n) { const f32x4 v = acc[ai][bj][m][n]; *(h16x4*)(d + 128 * bj + 16 * n) = pack4(v[0], v[1], v[2], v[3]); }
        }
      }
  }
};
DEVI void phase5(PRef p, LDS unsigned char* lds) {
  g8::DenseOrder S{(const h16*)(p.ws + WS_H), (const h16*)(p.ws + WS_WOUT), DM, 128, 4, (int)gridDim.x, (int)blockIdx.x};
  EpiPlain E{(h16*)(p.ws + WS_MIX), DM};
  g8::gemm_phase(lds, DM, S, E);
}

constexpr int P6_TROW = 2064, P6_THI = 0, P6_TLO = 32 * P6_TROW, P6_PART = 0, P6_LGT = 8 * 48 * 32 * 4, P6_MOD = 2 * 32 * P6_TROW;
constexpr int P6_BIAS = P6_MOD + 3 * 4096, P6_TOK = P6_BIAS + 160, P6_LCNT = P6_TOK + 128 * 6 * 4, P6_LBASE = P6_LCNT + 128;
static_assert(P6_LBASE + 128 <= LDS_BYTES - 16 && P6_LGT + 32 * 36 * 4 <= P6_MOD, "phase 6 LDS map");
DEVI void phase6(PRef p, LDS unsigned char* lds) {
  const int tid = launder((int)threadIdx.x), lane = tid & 63, wave = wave_id(tid), l15 = lane & 15, g4 = lane >> 4;
  const int b = blockIdx.x >> 6;
  LDS float* mv = (LDS float*)(lds + P6_MOD);
  LDS float* rbias = (LDS float*)(lds + P6_BIAS);
  LDS unsigned* tokrec = (LDS unsigned*)(lds + P6_TOK);
  LDS unsigned* lcnt = (LDS unsigned*)(lds + P6_LCNT);
  LDS unsigned* lbase = (LDS unsigned*)(lds + P6_LBASE);
  mod_to_lds(p, b, 2, mv); mod_to_lds(p, b, 3, mv + 1024); mod_to_lds(p, b, 4, mv + 2048);
  if (tid < 4) rbias[tid] = p.in[18][tid];
  else if (tid < 36) rbias[tid] = p.in[20][tid - 4];
  if (tid < 32) lcnt[tid] = 0u;
  __syncthreads();
  f32x4 A1[4], A2[4], SH2[4];
#pragma unroll
  for (int j = 0; j < 4; ++j) {
    const int k = 256 * j + 4 * lane;
    A1[j] = *(LDS f32x4*)(mv + k) * *(const f32x4*)(p.in[5] + k);
    A2[j] = *(const f32x4*)(p.in[6] + k) * (*(LDS f32x4*)(mv + 2048 + k) + 1.f);
    SH2[j] = *(LDS f32x4*)(mv + 1024 + k);
  }
  const float* x = p.in[0]; const h16* MIX = (const h16*)(p.ws + WS_MIX); float* X1 = p.out; h16* H2 = (h16*)(p.ws + WS_H);
  const h16* WRH = (const h16*)(p.ws + WS_WRH); const h16* WRL = (const h16*)(p.ws + WS_WRL);
  const size_t tok0 = (size_t)blockIdx.x * 128;
#pragma unroll 1
  for (int rd = 0; rd < 4; ++rd) {
#pragma unroll 1
    for (int i = 0; i < 4; ++i) {
      const int tr = 4 * wave + i;
      const size_t tok = tok0 + 32 * rd + tr;
      f32x4 xv[4], mx[4]; float ssm = 0.f;
#pragma unroll
      for (int j = 0; j < 4; ++j) {
        xv[j] = *(const f32x4*)(x + tok * DM + 256 * j + 4 * lane);
        const h16x4 mh = *(const h16x4*)(MIX + tok * DM + 256 * j + 4 * lane);
#pragma unroll
        for (int e = 0; e < 4; ++e) { mx[j][e] = (float)mh[e]; ssm += mx[j][e] * mx[j][e]; }
      }
      const float rsm = 1.0f / sqrtf(wave_sum(ssm) * (1.f / 1024.f) + 1e-6f);
      float ss1 = 0.f;
#pragma unroll
      for (int j = 0; j < 4; ++j) {
        xv[j] = xv[j] + A1[j] * (mx[j] * rsm);
        *(f32x4*)(X1 + tok * DM + 256 * j + 4 * lane) = xv[j];
        ss1 += xv[j][0] * xv[j][0] + xv[j][1] * xv[j][1] + xv[j][2] * xv[j][2] + xv[j][3] * xv[j][3];
      }
      const float rs1 = 1.0f / sqrtf(wave_sum(ss1) * (1.f / 1024.f) + 1e-6f);
#pragma unroll
      for (int j = 0; j < 4; ++j) {
        const f32x4 h2 = xv[j] * rs1 * A2[j] + SH2[j];
        const h16x4 hi = pack4(h2[0], h2[1], h2[2], h2[3]);
        const h16x4 lo = pack4(h2[0] - (float)hi[0], h2[1] - (float)hi[1], h2[2] - (float)hi[2], h2[3] - (float)hi[3]);
        *(h16x4*)(H2 + tok * DM + 256 * j + 4 * lane) = hi;
        *(LDS h16x4*)(lds + P6_THI + tr * P6_TROW + (256 * j + 4 * lane) * 2) = hi;
        *(LDS h16x4*)(lds + P6_TLO + tr * P6_TROW + (256 * j + 4 * lane) * 2) = lo;
      }
    }
    __syncthreads();
    f32x4 acc[2][3];
#pragma unroll
    for (int tt = 0; tt < 2; ++tt)
#pragma unroll
      for (int ct = 0; ct < 3; ++ct) acc[tt][ct] = (f32x4){0.f, 0.f, 0.f, 0.f};
#pragma unroll
    for (int kk = 0; kk < 4; ++kk) {
      const int kof = 32 * (4 * wave + kk) + 8 * g4;
      h16x8 ah[2], al[2];
#pragma unroll
      for (int tt = 0; tt < 2; ++tt) {
        ah[tt] = *(LDS h16x8*)(lds + P6_THI + (16 * tt + l15) * P6_TROW + kof * 2);
        al[tt] = *(LDS h16x8*)(lds + P6_TLO + (16 * tt + l15) * P6_TROW + kof * 2);
      }
#pragma unroll
      for (int ct = 0; ct < 3; ++ct) {
        const h16x8 bh = *(const h16x8*)(WRH + (size_t)(16 * ct + l15) * 1024 + kof), bl = *(const h16x8*)(WRL + (size_t)(16 * ct + l15) * 1024 + kof);
#pragma unroll
        for (int tt = 0; tt < 2; ++tt) {
          acc[tt][ct] = mfma16s(ah[tt], bh, acc[tt][ct]);
          acc[tt][ct] = mfma16s(ah[tt], bl, acc[tt][ct]);
          acc[tt][ct] = mfma16s(al[tt], bh, acc[tt][ct]);
        }
      }
    }
    __syncthreads();
#pragma unroll
    for (int tt = 0; tt < 2; ++tt)
#pragma unroll
      for (int ct = 0; ct < 3; ++ct)
        *(LDS f32x4*)(lds + P6_PART + (((wave * 48 + 16 * ct + l15) * 32) + 16 * tt + 4 * g4) * 4) = acc[tt][ct];
    __syncthreads();
    for (int idx = tid; idx < 36 * 32; idx += NTHR) {
      const int col = idx >> 5, tk = idx & 31;
      float s = 0.f;
#pragma unroll
      for (int w = 0; w < 8; ++w) s += *(LDS float*)(lds + P6_PART + ((w * 48 + col) * 32 + tk) * 4);
      *(LDS float*)(lds + P6_LGT + (tk * 36 + col) * 4) = s;
    }
    __syncthreads();
    if (tid < 32) {
      LDS float* lg = (LDS float*)(lds + P6_LGT) + 36 * tid;
      float gl[4];
#pragma unroll
      for (int g = 0; g < 4; ++g) gl[g] = lg[g] + rbias[g];
      int gi = 0; float gm = gl[0];
#pragma unroll
      for (int g = 1; g < 4; ++g) if (gl[g] > gm) { gm = gl[g]; gi = g; }
      float gs = 0.f;
#pragma unroll
      for (int g = 0; g < 4; ++g) gs += __expf(gl[g] - gm);
      const float pg = 1.f / gs;
      int e1 = 0, e2 = 0; float l1 = -INFINITY, l2 = -INFINITY;
#pragma unroll
      for (int e = 0; e < 8; ++e) {
        const float v = lg[4 + 8 * gi + e] + rbias[4 + 8 * gi + e];
        if (v > l1) { l2 = l1; e2 = e1; l1 = v; e1 = e; }
        else if (v > l2) { l2 = v; e2 = e; }
      }
      const float x2 = __expf(l2 - l1);
      const float w1 = pg / (1.f + x2), w2 = pg * x2 / (1.f + x2);
      const unsigned E1 = (unsigned)(gi * 8 + e1), E2 = (unsigned)(gi * 8 + e2);
      const unsigned lp1 = __hip_atomic_fetch_add(&lcnt[E1], 1u, __ATOMIC_RELAXED, __HIP_MEMORY_SCOPE_WORKGROUP);
      const unsigned lp2 = __hip_atomic_fetch_add(&lcnt[E2], 1u, __ATOMIC_RELAXED, __HIP_MEMORY_SCOPE_WORKGROUP);
      LDS unsigned* tr = tokrec + (32 * rd + tid) * 6;
      tr[0] = E1; tr[1] = lp1; tr[2] = E2; tr[3] = lp2; tr[4] = __float_as_uint(w1); tr[5] = __float_as_uint(w2);
    }
    __syncthreads();
  }
  if (tid < 32) lbase[tid] = atomicAdd((unsigned*)(p.ws + WS_CNT) + tid, lcnt[tid]);
  __syncthreads();
  if (tid < 128) {
    unsigned* LIST = (unsigned*)(p.ws + WS_LIST); float* LISTW = (float*)(p.ws + WS_LISTW); u32x4* ROUTE = (u32x4*)(p.ws + WS_ROUTE);
    const unsigned tok = (unsigned)(tok0 + tid);
    LDS unsigned* tr = tokrec + tid * 6;
    const unsigned E1 = tr[0], E2 = tr[2], p1 = lbase[E1] + tr[1], p2 = lbase[E2] + tr[3];
    LIST[(size_t)E1 * 32768 + p1] = tok; LISTW[(size_t)E1 * 32768 + p1] = __uint_as_float(tr[4]);
    LIST[(size_t)E2 * 32768 + p2] = tok; LISTW[(size_t)E2 * 32768 + p2] = __uint_as_float(tr[5]);
    u32x4 rt; rt[0] = E1; rt[1] = p1; rt[2] = E2; rt[3] = p2;
    ROUTE[tok] = rt;
  }
}

template <bool GATHER_> struct MoeOrder {
  static constexpr bool GATHER = GATHER_;
  unsigned char* ws; int ntn, K, G, c;
  DEVI bool next(int i, g8::Unit& u) const {
    const unsigned* cnt = (const unsigned*)(ws + WS_CNT);
    int it = i * G + c, off = 0, e = 0, cn = 0; bool found = false;
    for (e = 0; e < 32; ++e) { cn = (int)cnt[e]; const int nti = ((cn + 255) >> 8) * ntn; if (it < nti) { found = true; break; } it -= nti; off += cn; }
    if (!found) return false;
    u.e = e; u.pm = it / ntn; u.pn = it % ntn; u.cnt = cn; u.off = off;
    const int tid = threadIdx.x;
    if (GATHER_) {
      const unsigned* list = (const unsigned*)(ws + WS_LIST) + (size_t)e * 32768;
      u.A = (const char*)(ws + WS_H);
      u.B = (const char*)((const h16*)(ws + WS_WGU) + ((size_t)e * 512 + u.pn * 256) * DM);
#pragma unroll
      for (int h = 0; h < 2; ++h)
#pragma unroll
        for (int i2 = 0; i2 < 2; ++i2) {
          int R, C; g8::stage_rc(tid * 16 + i2 * 8192, R, C);
          const int row = u.pm * 256 + 128 * h + R;
          const unsigned t = (row < cn) ? list[row] : 0u;
          u.va[h][i2] = (t * (unsigned)DM + (unsigned)C) * 2u;
        }
    } else {
      u.A = (const char*)((const h16*)(ws + WS_ACT) + ((size_t)off + u.pm * 256) * 256);
      u.B = (const char*)((const h16*)(ws + WS_WDN) + ((size_t)e * 1024 + u.pn * 256) * 256);
      u.va[0][0] = u.va[0][1] = u.va[1][0] = u.va[1][1] = 0u;
    }
    return true;
  }
};
struct EpiAct {
  unsigned char* ws;
  DEVI void operator()(const f32x4 (&acc)[2][2][4][2], const g8::Unit& u, int wr, int wc, int fr, int fq) const {
    const float* lw = (const float*)(ws + WS_LISTW) + (size_t)u.e * 32768; h16* act = (h16*)(ws + WS_ACT);
#pragma unroll
    for (int ai = 0; ai < 2; ++ai)
#pragma unroll
      for (int m = 0; m < 4; ++m) {
        const int r = u.pm * 256 + 128 * ai + 64 * wr + 16 * m + fr;
        if (r < u.cnt) {
          const float w = lw[r];
#pragma unroll
          for (int bj = 0; bj < 2; ++bj) {
            const f32x4 g = acc[ai][bj][m][0], up = acc[ai][bj][m][1];
            float v[4];
#pragma unroll
            for (int e = 0; e < 4; ++e) v[e] = g[e] * __builtin_amdgcn_rcpf(1.f + __expf(-g[e])) * up[e] * w;
            *(h16x4*)(act + (size_t)(u.off + r) * 256 + 16 * (8 * u.pn + 4 * bj + wc) + 4 * fq) = pack4(v[0], v[1], v[2], v[3]);
          }
        }
      }
  }
};
struct EpiYp {
  h16* dst;
  DEVI void operator()(const f32x4 (&acc)[2][2][4][2], const g8::Unit& u, int wr, int wc, int fr, int fq) const {
#pragma unroll
    for (int ai = 0; ai < 2; ++ai)
#pragma unroll
      for (int m = 0; m < 4; ++m) {
        const int r = u.pm * 256 + 128 * ai + 64 * wr + 16 * m + fr;
        if (r < u.cnt) {
          h16* d = dst + (size_t)(u.off + r) * DM + u.pn * 256 + 32 * wc + 4 * fq;
#pragma unroll
          for (int bj = 0; bj < 2; ++bj)
#pragma unroll
            for (int n = 0; n < 2; ++n) { const f32x4 v = acc[ai][bj][m][n]; *(h16x4*)(d + 128 * bj + 16 * n) = pack4(v[0], v[1], v[2], v[3]); }
        }
      }
  }
};
DEVI void phase7(PRef p, LDS unsigned char* lds) {
  MoeOrder<true> S{p.ws, 2, DM, (int)gridDim.x, (int)blockIdx.x};
  EpiAct E{p.ws};
  g8::gemm_phase(lds, DM, S, E);
}
DEVI void phase8(PRef p, LDS unsigned char* lds) {
  MoeOrder<false> S{p.ws, 4, 256, (int)gridDim.x, (int)blockIdx.x};
  EpiYp E{(h16*)(p.ws + WS_YP)};
  g8::gemm_phase(lds, 256, S, E);
}

DEVI void phase9(PRef p, LDS unsigned char* lds) {
  const int tid = launder((int)threadIdx.x), lane = tid & 63, wave = wave_id(tid), G = gridDim.x;
  const int b = blockIdx.x & 3, bi = blockIdx.x >> 2, nbk = G >> 2;
  LDS unsigned* offs = (LDS unsigned*)lds;
  if (tid == 0) { const unsigned* cnt = (const unsigned*)(p.ws + WS_CNT); unsigned o = 0; for (int e = 0; e < 32; ++e) { offs[e] = o; o += cnt[e]; } }
  __syncthreads();
  LDS float* mv = (LDS float*)(lds + 256);
  mod_to_lds(p, b, 5, mv);
  __syncthreads();
  f32x4 A3[4];
#pragma unroll
  for (int j = 0; j < 4; ++j) { const int k = 256 * j + 4 * lane; A3[j] = *(LDS f32x4*)(mv + k) * *(const f32x4*)(p.in[7] + k); }
  const h16* YP = (const h16*)(p.ws + WS_YP); const u32x4* ROUTE = (const u32x4*)(p.ws + WS_ROUTE); float* out = p.out;
  const int rstep = nbk * 8, r_first = bi * 8 + wave;
  const int nrow = (SEQ - r_first + rstep - 1) / rstep;
  unsigned R0 = 0u, R1 = 0u;
  if (lane < nrow) { const u32x4 rt = ROUTE[(size_t)b * SEQ + r_first + rstep * lane]; R0 = offs[rt[0]] + rt[1]; R1 = offs[rt[2]] + rt[3]; }
  h16x4 ya[4], yc[4]; f32x4 xv[4];
  {
    const size_t tok = (size_t)b * SEQ + r_first; const size_t r0 = __builtin_amdgcn_readlane(R0, 0), r1 = __builtin_amdgcn_readlane(R1, 0);
#pragma unroll
    for (int j = 0; j < 4; ++j) { ya[j] = *(const h16x4*)(YP + r0 * DM + 256 * j + 4 * lane); yc[j] = *(const h16x4*)(YP + r1 * DM + 256 * j + 4 * lane); xv[j] = *(const f32x4*)(out + tok * DM + 256 * j + 4 * lane); }
  }
  for (int i = 0; i < nrow; ++i) {
    const size_t tok = (size_t)b * SEQ + r_first + rstep * i;
    h16x4 na[4], nc[4]; f32x4 nx[4];
    if (i + 1 < nrow) {
      const size_t r0 = __builtin_amdgcn_readlane(R0, i + 1), r1 = __builtin_amdgcn_readlane(R1, i + 1);
#pragma unroll
      for (int j = 0; j < 4; ++j) { na[j] = *(const h16x4*)(YP + r0 * DM + 256 * j + 4 * lane); nc[j] = *(const h16x4*)(YP + r1 * DM + 256 * j + 4 * lane); nx[j] = *(const f32x4*)(out + (tok + rstep) * DM + 256 * j + 4 * lane); }
    }
    f32x4 y[4]; float ss = 0.f;
#pragma unroll
    for (int j = 0; j < 4; ++j)
#pragma unroll
      for (int e = 0; e < 4; ++e) { y[j][e] = (float)ya[j][e] + (float)yc[j][e]; ss += y[j][e] * y[j][e]; }
    const float rs = 1.0f / sqrtf(wave_sum(ss) * (1.f / 1024.f) + 1e-6f);
#pragma unroll
    for (int j = 0; j < 4; ++j) *(f32x4*)(out + tok * DM + 256 * j + 4 * lane) = xv[j] + A3[j] * (y[j] * rs);
    if (i + 1 < nrow) {
#pragma unroll
      for (int j = 0; j < 4; ++j) { ya[j] = na[j]; yc[j] = nc[j]; xv[j] = nx[j]; }
    }
  }
}

#define XB_TMO      128
#define XB_XCNT(j)  (256  + 64 * (j))
#define XB_XSUB(j)  (1280 + 64 * (j))
#define XB_XGEN(j)  (2304 + 64 * (j))
#define XB_TOP      3328
#define XB_TOPGEN   3392
#define XB_SPIN_CAP (1u << 22)
DEVI unsigned xb_ld(unsigned* p)              { return __hip_atomic_load(p, __ATOMIC_RELAXED, __HIP_MEMORY_SCOPE_AGENT); }
DEVI unsigned xb_add(unsigned* p, unsigned v) { return __hip_atomic_fetch_add(p, v, __ATOMIC_RELAXED, __HIP_MEMORY_SCOPE_AGENT); }
DEVI unsigned xb_xcc_id() { return (unsigned)__builtin_amdgcn_s_getreg((3 << 11) | 20) & 0xFu; }
#define XB_SPIN(cond, bar) do { unsigned _sp = 0; while (cond) { __builtin_amdgcn_s_sleep(1); \
    if ((++_sp & 255u) == 0u) { if (xb_ld(&(bar)[XB_TMO])) break; if (_sp > XB_SPIN_CAP) { atomicAdd(&(bar)[XB_TMO], 1u); break; } } } } while (0)
struct XcdBarrier { unsigned* bar; unsigned x; volatile LDS unsigned* st; };
DEVI XcdBarrier xcd_barrier_post(unsigned* bar, volatile LDS unsigned* st) {
  XcdBarrier b; b.bar = bar; b.x = xb_xcc_id(); b.st = st;
  if (threadIdx.x == 0) (void)xb_add(&bar[XB_XCNT(b.x)], 1u);
  return b;
}
DEVI void xcd_barrier_complete(unsigned* bar, unsigned x, unsigned& nloc, unsigned& nx) {
  const unsigned G = gridDim.x * gridDim.y * gridDim.z;
  unsigned sum, cnt, mine, sp = 0u;
  for (;;) {
    sum = 0u; cnt = 0u; mine = 0u;
#pragma unroll
    for (unsigned j = 0; j < 16; ++j) { const unsigned c = xb_ld(&bar[XB_XCNT(j)]); sum += c; cnt += (c > 0u) ? 1u : 0u; mine = (j == x) ? c : mine; }
    if (sum == G) break;
    __builtin_amdgcn_s_sleep(1);
    if ((++sp & 255u) == 0u) { if (xb_ld(&bar[XB_TMO])) break; if (sp > XB_SPIN_CAP) { atomicAdd(&bar[XB_TMO], 1u); break; } }
  }
  nloc = mine > 0u ? mine : 1u; nx = cnt > 0u ? cnt : 1u;
}
DEVI void xcd_barrier(const XcdBarrier& b) {
  asm volatile("s_waitcnt vmcnt(0)" ::: "memory");
  __syncthreads();
  if (threadIdx.x == 0) {
    unsigned* bar = b.bar;
    __builtin_amdgcn_s_waitcnt(0);
    unsigned nloc = b.st[0], nx = b.st[1];
    if (nloc == 0u) { xcd_barrier_complete(bar, b.x, nloc, nx); b.st[0] = nloc; b.st[1] = nx; }
    const unsigned old = xb_add(&bar[XB_XSUB(b.x)], 1u);
    const unsigned gen = old / nloc;
    if (old + 1u == (gen + 1u) * nloc) {
      __builtin_amdgcn_fence(__ATOMIC_RELEASE, "agent");
      asm volatile("s_waitcnt vmcnt(0)" ::: "memory");
      const unsigned og = xb_add(&bar[XB_TOP], 1u);
      const unsigned tg = og / nx;
      if (og + 1u == (tg + 1u) * nx) xb_add(&bar[XB_TOPGEN], 1u);
      else XB_SPIN(xb_ld(&bar[XB_TOPGEN]) == tg, bar);
      __builtin_amdgcn_fence(__ATOMIC_ACQUIRE, "agent");
      xb_add(&bar[XB_XGEN(b.x)], 1u);
      asm volatile("s_waitcnt vmcnt(0)" ::: "memory");
    } else {
      XB_SPIN(xb_ld(&bar[XB_XGEN(b.x)]) == gen, bar);
      __builtin_amdgcn_fence(__ATOMIC_ACQUIRE, "agent");
      asm volatile("s_waitcnt vmcnt(0)" ::: "memory");
    }
  }
  __syncthreads();
}

__global__ void __launch_bounds__(NTHR) fwd_kernel(Params p) {
  extern __shared__ __attribute__((aligned(16))) unsigned char smem[];
  LDS unsigned char* lds = (LDS unsigned char*)smem;
  const int lo = p.ph_lo, hi = p.ph_hi;
  volatile LDS unsigned* bst = (volatile LDS unsigned*)(lds + LDS_BYTES - 16);
  if (threadIdx.x < 4) bst[threadIdx.x] = 0u;
  __syncthreads();
  (void)xcd_barrier_post((unsigned*)(p.ws + WS_BAR), bst);
#ifndef REPEAT_PHASE
#define REPEAT_PHASE -1
#endif
#define GRID_SYNC(k) do { { XcdBarrier xb_; xb_.bar = (unsigned*)(get_params()->ws + WS_BAR); xb_.x = xb_xcc_id(); xb_.st = (volatile LDS unsigned*)(lds + LDS_BYTES - 16); xcd_barrier(xb_); } } while (0)
#define RUN_PHASE(k, fn) if (lo <= (k) && (k) < hi) { fn(*get_params(), lds); if ((k) == REPEAT_PHASE) { GRID_SYNC(k); fn(*get_params(), lds); } if ((k) + 1 < hi) GRID_SYNC(k); }
  RUN_PHASE(0, phase0)
  RUN_PHASE(1, phase1)
  RUN_PHASE(2, phase2)
  RUN_PHASE(3, phase3)
  RUN_PHASE(4, phase4)
  RUN_PHASE(5, phase5)
  RUN_PHASE(6, phase6)
  RUN_PHASE(7, phase7)
  RUN_PHASE(8, phase8)
  RUN_PHASE(9, phase9)
#undef GRID_SYNC
#undef RUN_PHASE
}

extern "C" void kernel_launch(void* const* d_in, const int* in_sizes, int n_in, void* d_out, int out_size, void* d_ws, size_t ws_size, hipStream_t stream) {
  static int grid = 0;
  if (grid == 0) {
    if (n_in != 24 || out_size != NTOK * DM || ws_size < WS_END) { fprintf(stderr, "kernel_launch: unexpected problem (n_in %d out %d ws %zu)\n", n_in, out_size, ws_size); grid = -1; return; }
    (void)hipFuncSetAttribute((const void*)fwd_kernel, hipFuncAttributeMaxDynamicSharedMemorySize, LDS_BYTES);
    int dev = 0, cus = 0, per_cu = 0;
    (void)hipGetDevice(&dev);
    (void)hipDeviceGetAttribute(&cus, hipDeviceAttributeMultiprocessorCount, dev);
    (void)hipOccupancyMaxActiveBlocksPerMultiprocessor(&per_cu, (const void*)fwd_kernel, NTHR, LDS_BYTES);
    if (per_cu < 1 || cus < 256) fprintf(stderr, "kernel_launch: occupancy %d blocks/CU on %d CUs\n", per_cu, cus);
    grid = 256;
  }
  if (grid < 0) return;
  (void)hipMemsetAsync((char*)d_ws + WS_CNT, 0, CTL_ZERO_BYTES, stream);
  Params p{};
  for (int i = 0; i < 24; ++i) p.in[i] = (const float*)d_in[i];
  p.out = (float*)d_out; p.ws = (unsigned char*)d_ws;
#if N_LAUNCH_MODE == 1
  p.ph_lo = 0; p.ph_hi = NPHASE;
  void* args[] = {&p};
  hipError_t e = hipLaunchCooperativeKernel((const void*)fwd_kernel, dim3(grid), dim3(NTHR), args, LDS_BYTES, stream);
  if (e != hipSuccess) fprintf(stderr, "cooperative launch failed: %s\n", hipGetErrorString(e));
#else
  for (int ph = 0; ph < NPHASE; ++ph) {
    p.ph_lo = ph; p.ph_hi = ph + 1;
    hipLaunchKernelGGL(fwd_kernel, dim3(grid), dim3(NTHR), LDS_BYTES, stream, p);
  }
#endif
}
```

```cpp
#include <hip/hip_runtime.h>
#include <hip/hip_cooperative_groups.h>
#include <cstdio>
#include <cstdint>
namespace cg = cooperative_groups;

#ifndef N_LAUNCH_MODE
#define N_LAUNCH_MODE 1
#endif

#define DEVI __device__ __forceinline__
#define LDS __attribute__((address_space(3)))

typedef _Float16 h16;
typedef _Float16 h16x4 __attribute__((ext_vector_type(4)));
typedef _Float16 h16x8 __attribute__((ext_vector_type(8)));
typedef float f32x4 __attribute__((ext_vector_type(4)));
typedef float f32x16 __attribute__((ext_vector_type(16)));
typedef unsigned u32x2 __attribute__((ext_vector_type(2)));
typedef unsigned u32x4 __attribute__((ext_vector_type(4)));

constexpr int NBATCH = 4, SEQ = 8192, NTOK = NBATCH * SEQ, DM = 1024;
constexpr int NTHR = 512;
constexpr int NPHASE = 10;
constexpr int LDS_BYTES = 163840;

constexpr size_t MiB = 1ull << 20;
constexpr size_t WS_CNT = 0;
constexpr size_t CTL_ZERO_BYTES = 20480;
constexpr size_t WS_BAR = 4096;
constexpr size_t WS_MODP = 64 * 1024;
constexpr size_t WS_ROPE = 1 * MiB;
constexpr size_t WS_WIN = 3 * MiB;
constexpr size_t WS_WOUT = 10 * MiB;
constexpr size_t WS_WGU = 12 * MiB;
constexpr size_t WS_WDN = 44 * MiB;
constexpr size_t WS_WRG = 60 * MiB;
constexpr size_t WS_WRT = 60 * MiB + 256 * 1024;
constexpr size_t WS_WRH = 60 * MiB + 512 * 1024;
constexpr size_t WS_WRL = 60 * MiB + 640 * 1024;
constexpr size_t WS_AGG = 61 * MiB;
constexpr size_t WS_ROUTE = 63 * MiB;
constexpr size_t WS_LIST = 64 * MiB;
constexpr size_t WS_LISTW = 68 * MiB;
constexpr size_t WS_WI = 72 * MiB;
constexpr size_t WS_KI = 73 * MiB;
constexpr size_t WS_MASK = 77 * MiB;
constexpr size_t WS_H = 109 * MiB;
constexpr size_t WS_Q = 173 * MiB;
constexpr size_t WS_K = 205 * MiB;
constexpr size_t WS_VT = 237 * MiB;
constexpr size_t WS_QI = 269 * MiB;
constexpr size_t WS_XR = 301 * MiB;
constexpr size_t WS_XG = 333 * MiB;
constexpr size_t WS_MIX = 365 * MiB;
constexpr size_t WS_ACT = 429 * MiB;
constexpr size_t WS_YP = 173 * MiB;
constexpr size_t WS_END = 510 * MiB;
constexpr size_t SC_BATCH_BYTES = 8192ull * 6176ull;
static_assert(SC_BATCH_BYTES <= 64 * MiB && WS_MIX + 3 * SC_BATCH_BYTES <= WS_END, "score slots");

struct Params { const float* in[24]; float* out; unsigned char* ws; int ph_lo, ph_hi; };
typedef const __attribute__((address_space(4))) Params& PRef;
typedef const __attribute__((address_space(4))) Params* PPtr;

__device__ const double ROPE_REV[32] = {
  1.59154943091895345608e-01, 1.19349370211248861917e-01, 8.94994016088910132600e-02, 6.71150830052272551196e-02,
  5.03292121044870352509e-02, 3.77415847174197710556e-02, 2.83021958306233986646e-02, 2.12236527647776604399e-02,
  1.59154943091895338669e-02, 1.19349370211248861917e-02, 8.94994016088910236684e-03, 6.71150830052272533849e-03,
  5.03292121044870369856e-03, 3.77415847174197719230e-03, 2.83021958306233986646e-03, 2.12236527647776621747e-03,
  1.59154943091895356017e-03, 1.19349370211248848907e-03, 8.94994016088910236684e-04, 6.71150830052272598901e-04,
  5.03292121044870326488e-04, 3.77415847174197740914e-04, 2.83021958306233954120e-04, 2.12236527647776605484e-04,
  1.59154943091895350596e-04, 1.19349370211248862459e-04, 8.94994016088910182474e-05, 6.71150830052272544691e-05,
  5.03292121044870353593e-05, 3.77415847174197768019e-05, 2.83021958306233960897e-05, 2.12236527647776591931e-05};

DEVI int launder(int x) { asm volatile("" : "+v"(x)); return x; }
DEVI PPtr get_params() { PPtr k = (PPtr)__builtin_amdgcn_kernarg_segment_ptr(); asm volatile("" : "+s"(k)); return k; }
DEVI int wave_id(int tid) { return __builtin_amdgcn_readfirstlane(tid >> 6); }
DEVI f32x16 mfma16(h16x8 a, h16x8 b, f32x16 c) { return __builtin_amdgcn_mfma_f32_32x32x16_f16(a, b, c, 0, 0, 0); }
DEVI float wave_sum(float v) {
#pragma unroll
  for (int o = 1; o < 64; o <<= 1) v += __shfl_xor(v, o);
  return v;
}
DEVI float sigmoid_f(float x) { return __builtin_amdgcn_rcpf(1.f + __expf(-x)); }
DEVI float silu_f(float x) { return x * __builtin_amdgcn_rcpf(1.f + __expf(-x)); }
DEVI float gelu_tanh_f(float x) {
  const float u = 0.7978845608028654f * (x + 0.044715f * x * x * x);
  const float t = 1.f - 2.f * __builtin_amdgcn_rcpf(1.f + __expf(2.f * u));
  return 0.5f * x * (1.f + t);
}
DEVI unsigned fkey(float f) { unsigned u = __float_as_uint(f); return (u & 0x80000000u) ? ~u : (u | 0x80000000u); }
DEVI float fkey_inv(unsigned k) { unsigned u = (k & 0x80000000u) ? (k & 0x7fffffffu) : ~k; return __uint_as_float(u); }
DEVI int vt_perm(int pos) { return (pos & ~12) | ((pos & 4) << 1) | ((pos & 8) >> 1); }

DEVI void mod_to_lds(PRef p, int b, int chunk, LDS float* dst) {
  const float* mp = (const float*)(p.ws + WS_MODP);
  for (int k = threadIdx.x; k < 1024; k += NTHR) {
    const int j = chunk * 1024 + k;
    float v[8];
#pragma unroll
    for (int ks = 0; ks < 8; ++ks) v[ks] = mp[(size_t)(ks * 4 + b) * 6144 + j];
    float s = p.in[3][j];
#pragma unroll
    for (int ks = 0; ks < 8; ++ks) s += v[ks];
    dst[k] = s;
  }
}

constexpr int LROW = 144;
constexpr int GA_BYTES = 256 * LROW, GB_BYTES = 128 * LROW, GSTAGE = GA_BYTES + GB_BYTES;

template <class AR, class EPI>
DEVI void gemm_tile(LDS unsigned char* lds, const AR& arow, const h16* Bt, int ldb, int K, EPI& epi) {
  const int tid = launder((int)threadIdx.x), lane = tid & 63, wave = wave_id(tid), wm = wave >> 1, wn = wave & 1;
  const int lr = tid >> 3, lc = tid & 7, l31 = lane & 31, half = lane >> 5;
  const h16* pa[4]; const h16* pb[2];
#pragma unroll
  for (int j = 0; j < 4; ++j) pa[j] = arow(lr + 64 * j) + lc * 8;
#pragma unroll
  for (int j = 0; j < 2; ++j) pb[j] = Bt + (size_t)(lr + 64 * j) * ldb + lc * 8;
  h16x8 ra[4], rb[2];
#pragma unroll
  for (int j = 0; j < 4; ++j) ra[j] = *(const h16x8*)pa[j];
#pragma unroll
  for (int j = 0; j < 2; ++j) rb[j] = *(const h16x8*)pb[j];
#pragma unroll
  for (int j = 0; j < 4; ++j) *(LDS h16x8*)(lds + (lr + 64 * j) * LROW + lc * 16) = ra[j];
#pragma unroll
  for (int j = 0; j < 2; ++j) *(LDS h16x8*)(lds + GA_BYTES + (lr + 64 * j) * LROW + lc * 16) = rb[j];
  __syncthreads();
  f32x16 acc[2][2];
#pragma unroll
  for (int a = 0; a < 2; ++a)
#pragma unroll
    for (int b = 0; b < 2; ++b)
#pragma unroll
      for (int r = 0; r < 16; ++r) acc[a][b][r] = 0.f;
  const int KT = K >> 6;
  for (int kt = 0; kt < KT; ++kt) {
    const int cur = kt & 1;
    if (kt + 1 < KT) {
#pragma unroll
      for (int j = 0; j < 4; ++j) ra[j] = *(const h16x8*)(pa[j] + (kt + 1) * 64);
#pragma unroll
      for (int j = 0; j < 2; ++j) rb[j] = *(const h16x8*)(pb[j] + (kt + 1) * 64);
    }
    LDS unsigned char* A = lds + cur * GSTAGE;
    LDS unsigned char* B = A + GA_BYTES;
#pragma unroll
    for (int kk = 0; kk < 4; ++kk) {
      h16x8 af[2], bf[2];
#pragma unroll
      for (int mi = 0; mi < 2; ++mi) af[mi] = *(LDS h16x8*)(A + (64 * wm + 32 * mi + l31) * LROW + (2 * kk + half) * 16);
#pragma unroll
      for (int ni = 0; ni < 2; ++ni) bf[ni] = *(LDS h16x8*)(B + (64 * wn + 32 * ni + l31) * LROW + (2 * kk + half) * 16);
#pragma unroll
      for (int mi = 0; mi < 2; ++mi)
#pragma unroll
        for (int ni = 0; ni < 2; ++ni) acc[mi][ni] = mfma16(bf[ni], af[mi], acc[mi][ni]);
    }
    if (kt + 1 < KT) {
      LDS unsigned char* A2 = lds + (cur ^ 1) * GSTAGE;
#pragma unroll
      for (int j = 0; j < 4; ++j) *(LDS h16x8*)(A2 + (lr + 64 * j) * LROW + lc * 16) = ra[j];
#pragma unroll
      for (int j = 0; j < 2; ++j) *(LDS h16x8*)(A2 + GA_BYTES + (lr + 64 * j) * LROW + lc * 16) = rb[j];
    }
    __syncthreads();
  }
  epi(acc, wm, wn, lane);
}


namespace g8 {
constexpr int BM = 256, BK = 64, HALF = 128, HTB = HALF * BK * 2, STAGE_BYTES = 8 * HTB;
DEVI int lds_byte(int r, int c) { const int st = (r >> 4) * 2 + (c >> 5), rr = r & 15, cc = c & 31, ob = rr * 64 + cc * 2; return st * 1024 + (ob ^ (((ob >> 9) & 1) << 5)); }
DEVI void stage_rc(int b, int& R, int& C) { const int st = b / 1024, sb = b % 1024, swz = sb ^ (((sb >> 9) & 1) << 5); R = (st >> 1) * 16 + swz / 64; C = (st & 1) * 32 + (swz % 64) / 2; }
struct Unit { const char* A; unsigned va[2][2]; const char* B; int pm, pn, e, cnt, off; };
DEVI void glds16(const char* src, LDS unsigned char* dst) { __builtin_amdgcn_global_load_lds((const unsigned*)src, (LDS unsigned*)dst, 16, 0, 0); }

DEVI void dense_va(unsigned (&va)[2][2], int K) {
  const int tid = threadIdx.x;
#pragma unroll
  for (int h = 0; h < 2; ++h)
#pragma unroll
    for (int i = 0; i < 2; ++i) { int R, C; stage_rc(tid * 16 + i * 8192, R, C); va[h][i] = (unsigned)((128 * h + R) * K + C) * 2u; }
}
template <class Sched, class Epi>
DEVI void gemm_phase(LDS unsigned char* lds, int K, const Sched& S, const Epi& E) {
  const int tid = launder((int)threadIdx.x), wid = wave_id(tid), lane = tid & 63, wr = wid >> 2, wc = wid & 3, fr = lane & 15, fq = lane >> 4;
  const int nt = launder(K) / BK;
  unsigned vb[2];
#pragma unroll
  for (int i = 0; i < 2; ++i) { int R, C; stage_rc(tid * 16 + i * 8192, R, C); vb[i] = (unsigned)(R * K + C) * 2u; }
  const size_t kstep = (size_t)(BK * 2), hstep = (size_t)HALF * K * 2;
  const unsigned ldsw = (unsigned)wid * 1024u;
  const int aoff = lds_byte(wr * 64 + fr, fq * 8), boff = lds_byte(wc * 32 + fr, fq * 8);
#define G8_SA(b, h) (((b) * 2 + (h)) * HTB)
#define G8_SB(b, h) ((4 + (b) * 2 + (h)) * HTB)
#define G8_STAGE(bufoff, gbase, v) do { glds16((gbase) + (v)[0], lds + (bufoff) + ldsw); glds16((gbase) + (v)[1], lds + (bufoff) + ldsw + 8192); } while (0)
#define G8_STAGEA(bufoff, gbase, h) do { glds16((gbase) + G8_VAC(h, 0), lds + (bufoff) + ldsw); glds16((gbase) + G8_VAC(h, 1), lds + (bufoff) + ldsw + 8192); } while (0)
#define G8_LDA(dst, b, h) do { _Pragma("unroll") for (int m = 0; m < 4; ++m) _Pragma("unroll") for (int k = 0; k < 2; ++k) dst[m][k] = *(const LDS h16x8*)(lds + G8_SA(b, h) + aoff + m * 2048 + k * 1024); } while (0)
#define G8_LDB(dst, b, h) do { _Pragma("unroll") for (int n = 0; n < 2; ++n) _Pragma("unroll") for (int k = 0; k < 2; ++k) dst[n][k] = *(const LDS h16x8*)(lds + G8_SB(b, h) + boff + n * 2048 + k * 1024); } while (0)
#define G8_MMA(ai, bj, At, Bt) do { __builtin_amdgcn_s_setprio(1); _Pragma("unroll") for (int m = 0; m < 4; ++m) _Pragma("unroll") for (int n = 0; n < 2; ++n) _Pragma("unroll") for (int k = 0; k < 2; ++k) \
        acc[ai][bj][m][n] = __builtin_amdgcn_mfma_f32_16x16x32_f16(Bt[n][k], At[m][k], acc[ai][bj][m][n], 0, 0, 0); __builtin_amdgcn_s_setprio(0); } while (0)
#define G8_WAIT_V(n) asm volatile("s_waitcnt vmcnt(" #n ")" ::: "memory")
#define G8_WAIT_L(n) asm volatile("s_waitcnt lgkmcnt(" #n ")" ::: "memory")
#define G8_BAR __builtin_amdgcn_s_barrier()
#define G8_SCHED __builtin_amdgcn_sched_barrier(0)
  Unit cur, nxt; int ui = 0;
  if (!S.next(0, cur)) return;
  unsigned vd[2][2];
  if (!Sched::GATHER) dense_va(vd, K);
#define G8_VAC(h, i) (Sched::GATHER ? cur.va[h][i] : vd[h][i])
#define G8_VAN(h, i) (Sched::GATHER ? nxt.va[h][i] : vd[h][i])
  f32x4 acc[2][2][4][2];
#pragma unroll
  for (int a = 0; a < 2; ++a)
#pragma unroll
    for (int b = 0; b < 2; ++b)
#pragma unroll
      for (int m = 0; m < 4; ++m)
#pragma unroll
        for (int n = 0; n < 2; ++n) acc[a][b][m][n] = (f32x4){0.f, 0.f, 0.f, 0.f};
  h16x8 At[4][2], B0[2][2], B1[2][2];
  const char* cA = cur.A; const char* cB = cur.B;
  G8_STAGE(G8_SB(0, 0), cB, vb); G8_STAGE(G8_SB(0, 1), cB + hstep, vb); G8_STAGEA(G8_SA(0, 0), cA, 0); G8_STAGEA(G8_SA(0, 1), cA, 1);
  if (wr == 1) G8_BAR;
  G8_WAIT_V(2); G8_BAR;
  G8_STAGE(G8_SB(1, 0), cB + kstep, vb); G8_STAGEA(G8_SA(1, 0), cA + kstep, 0); G8_STAGE(G8_SB(1, 1), cB + hstep + kstep, vb);
  G8_WAIT_V(6); G8_BAR;
  for (;;) {
    const bool has_next = S.next(ui + 1, nxt);
    if (!has_next) nxt = cur;
    const char* nA = nxt.A; const char* nB = nxt.B;
#pragma unroll 1
    for (int t = 0; t < nt; t += 2) {
      const bool last = (t == nt - 2);
      const char* a1 = cA + (size_t)(t + 1) * kstep;
      const char* a2 = last ? nA : cA + (size_t)(t + 2) * kstep; const char* b2 = last ? nB : cB + (size_t)(t + 2) * kstep;
      const char* a3 = a2 + kstep; const char* b3 = b2 + kstep;
#define G8_STAGE2(bufoff, gbase, h) do { glds16((gbase) + (last ? G8_VAN(h, 0) : G8_VAC(h, 0)), lds + (bufoff) + ldsw); glds16((gbase) + (last ? G8_VAN(h, 1) : G8_VAC(h, 1)), lds + (bufoff) + ldsw + 8192); } while (0)
      G8_LDB(B0, 0, 0); G8_LDB(B1, 0, 1); G8_SCHED; G8_LDA(At, 0, 0); G8_STAGEA(G8_SA(1, 1), a1, 1);
      G8_WAIT_V(8); G8_WAIT_L(0); G8_BAR; G8_MMA(0, 0, At, B0); G8_MMA(0, 1, At, B1); G8_BAR; G8_SCHED;
      G8_LDA(At, 0, 1); G8_STAGE(G8_SB(0, 0), b2, vb); G8_STAGE(G8_SB(0, 1), b2 + hstep, vb); G8_STAGE2(G8_SA(0, 0), a2, 0);
      G8_WAIT_V(8); G8_WAIT_L(0); G8_BAR; G8_MMA(1, 0, At, B0); G8_MMA(1, 1, At, B1); G8_BAR; G8_SCHED;
      G8_LDB(B0, 1, 0); G8_LDB(B1, 1, 1); G8_SCHED; G8_LDA(At, 1, 0); G8_STAGE2(G8_SA(0, 1), a2, 1);
      G8_WAIT_V(8); G8_WAIT_L(0); G8_BAR; G8_MMA(0, 0, At, B0); G8_MMA(0, 1, At, B1); G8_BAR; G8_SCHED;
      G8_LDA(At, 1, 1); G8_STAGE(G8_SB(1, 0), b3, vb); G8_STAGE(G8_SB(1, 1), b3 + hstep, vb); G8_STAGE2(G8_SA(1, 0), a3, 0);
      G8_WAIT_V(8); G8_WAIT_L(0); G8_BAR; G8_MMA(1, 0, At, B0); G8_MMA(1, 1, At, B1); G8_BAR; G8_SCHED;
    }
#undef G8_STAGE2
    if (wr == 0) G8_BAR;
    E(acc, cur, wr, wc, fr, fq);
    if (!has_next) break;
#pragma unroll
    for (int a = 0; a < 2; ++a)
#pragma unroll
      for (int b = 0; b < 2; ++b)
#pragma unroll
        for (int m = 0; m < 4; ++m)
#pragma unroll
          for (int n = 0; n < 2; ++n) acc[a][b][m][n] = (f32x4){0.f, 0.f, 0.f, 0.f};
    cur = nxt; cA = nA; cB = nB; ++ui;
    if (wr == 1) G8_BAR;
  }
  G8_WAIT_V(0);
  G8_BAR;
#undef G8_SA
#undef G8_STAGEA
#undef G8_VAC
#undef G8_VAN
#undef G8_SB
#undef G8_STAGE
#undef G8_LDA
#undef G8_LDB
#undef G8_MMA
#undef G8_WAIT_V
#undef G8_WAIT_L
#undef G8_BAR
#undef G8_SCHED
}
struct DenseOrder {
  static constexpr bool GATHER = false;
  const h16* A; const h16* Bt; int K, nM, nN, G, c;
  DEVI bool next(int i, Unit& u) const {
    const int nwg = nM * nN; const long L = (long)i * G + c; if (L >= nwg) return false;
    int wgid = (int)L; { const int q = nwg / 8, r = nwg % 8, xcd = wgid % 8, off = wgid / 8; wgid = (xcd < r ? xcd * (q + 1) : r * (q + 1) + (xcd - r) * q) + off; }
    const int nig = 8 * nN, gid = wgid / nig, fm = gid * 8, gsz = (nM - fm) < 8 ? (nM - fm) : 8;
    u.pm = fm + ((wgid % nig) % gsz); u.pn = (wgid % nig) / gsz; u.e = 0; u.cnt = 0x7fffffff; u.off = 0;
    u.A = (const char*)(A + (size_t)u.pm * 256 * K); u.B = (const char*)(Bt + (size_t)u.pn * 256 * K);
    u.va[0][0] = u.va[0][1] = u.va[1][0] = u.va[1][1] = 0u;
    return true;
  }
};
}

struct ARowPlain { const h16* base; size_t ld; DEVI const h16* operator()(int r) const { return base + (size_t)r * ld; } };
struct ARowGather { const h16* base; const unsigned* list; int n; int row0; DEVI const h16* operator()(int r) const { const int i = row0 + r; const unsigned t = (i < n) ? list[i] : 0u; return base + (size_t)t * DM; } };

DEVI h16x4 pack4(float a, float b, float c, float d) { h16x4 v; v[0] = (h16)a; v[1] = (h16)b; v[2] = (h16)c; v[3] = (h16)d; return v; }

template <class F>
DEVI void transpose_item(const float* src, int N, int kb, int nb, h16* dst, int ldd, F drow, LDS float* scr, int lane) {
#pragma unroll 8
  for (int i = 0; i < 32; ++i) {
    const int kk = 2 * i + (lane >> 5), n = nb * 32 + (lane & 31);
    scr[kk * 33 + (lane & 31)] = (n < N) ? src[(size_t)(kb * 64 + kk) * N + n] : 0.f;
  }
  asm volatile("s_waitcnt lgkmcnt(0)" ::: "memory");
  const int c = lane & 7;
#pragma unroll
  for (int j = 0; j < 4; ++j) {
    const int nl = (lane >> 3) + 8 * j, n = nb * 32 + nl;
    h16x8 v;
#pragma unroll
    for (int e = 0; e < 8; ++e) v[e] = (h16)scr[(c * 8 + e) * 33 + nl];
    if (n < N) *(h16x8*)(dst + (size_t)drow(n) * ldd + kb * 64 + c * 8) = v;
  }
  asm volatile("s_waitcnt lgkmcnt(0)" ::: "memory");
}

DEVI void phase0(PRef p, LDS unsigned char* lds) {
  const int tid = launder((int)threadIdx.x), lane = tid & 63, wave = wave_id(tid), G = gridDim.x;
  const int gw = blockIdx.x * 8 + wave, NW = G * 8;
  {
    const float* c = p.in[1]; const float* wada = p.in[2]; float* mp = (float*)(p.ws + WS_MODP);
    for (int u = gw; u < 96 * 8; u += NW) {
      const int cgp = u % 96, ks = u / 96, j = cgp * 64 + lane;
      float a0 = 0.f, a1 = 0.f, a2 = 0.f, a3 = 0.f;
      for (int k = ks * 128; k < ks * 128 + 128; ++k) {
        const float w = wada[(size_t)k * 6144 + j];
        a0 = fmaf(silu_f(c[k]), w, a0); a1 = fmaf(silu_f(c[1024 + k]), w, a1);
        a2 = fmaf(silu_f(c[2048 + k]), w, a2); a3 = fmaf(silu_f(c[3072 + k]), w, a3);
      }
      mp[(size_t)(ks * 4 + 0) * 6144 + j] = a0; mp[(size_t)(ks * 4 + 1) * 6144 + j] = a1;
      mp[(size_t)(ks * 4 + 2) * 6144 + j] = a2; mp[(size_t)(ks * 4 + 3) * 6144 + j] = a3;
    }
  }
  {
    LDS float* scr = (LDS float*)lds + wave * (64 * 33);
    constexpr int I_IN = 16 * 99, I_OUT = 16 * 32, I_G = 32 * 128, I_U = 32 * 128, I_D = 32 * 128, I_RG = 32;
    constexpr int NIT = I_IN + I_OUT + I_G + I_U + I_D + I_RG;
    for (int it = gw; it < NIT; it += NW) {
      int r = it;
      if (r < I_IN) {
        transpose_item(p.in[8], 3144, r / 99, r % 99, (h16*)(p.ws + WS_WIN), 1024,
                       [](int n) { const int dl = n < 2112 ? n : (n < 2120 ? 3136 + (n - 2112) : (n < 2632 ? 2112 + (n - 2120) : 2624 + (n - 2632))); const int d = dl & 63; return (dl & ~63) + 32 * ((d >> 4) & 1) + 16 * (d >> 5) + (d & 15); }, scr, lane);
        continue;
      }
      r -= I_IN;
      if (r < I_OUT) { transpose_item(p.in[16], 1024, r / 32, r % 32, (h16*)(p.ws + WS_WOUT), 1024, [](int n) { return n; }, scr, lane); continue; }
      r -= I_OUT;
      if (r < I_G) { const int e = r >> 7, q = r & 127;
        transpose_item(p.in[21] + (size_t)e * 1024 * 256, 256, q >> 3, q & 7, (h16*)(p.ws + WS_WGU) + (size_t)e * 512 * 1024, 1024, [](int f) { return (f >> 4) * 32 + (f & 15); }, scr, lane); continue; }
      r -= I_G;
      if (r < I_U) { const int e = r >> 7, q = r & 127;
        transpose_item(p.in[22] + (size_t)e * 1024 * 256, 256, q >> 3, q & 7, (h16*)(p.ws + WS_WGU) + (size_t)e * 512 * 1024, 1024, [](int f) { return (f >> 4) * 32 + 16 + (f & 15); }, scr, lane); continue; }
      r -= I_U;
      if (r < I_D) { const int e = r >> 7, q = r & 127;
        transpose_item(p.in[23] + (size_t)e * 256 * 1024, 1024, q >> 5, q & 31, (h16*)(p.ws + WS_WDN) + (size_t)e * 1024 * 256, 256, [](int n) { return n; }, scr, lane); continue; }
      r -= I_D;
      if (r < 16) transpose_item(p.in[11] + (size_t)(r >> 1) * 4096, 64, 0, r & 1, (h16*)(p.ws + WS_WRG) + (size_t)(r >> 1) * 128 * 64, 64, [](int n) { return n; }, scr, lane);
      else transpose_item(p.in[13] + (size_t)((r - 16) >> 1) * 4096, 64, 0, r & 1, (h16*)(p.ws + WS_WRG) + (size_t)((r - 16) >> 1) * 128 * 64, 64, [](int n) { return 64 + n; }, scr, lane);
    }
  }
  {
    h16* wrh = (h16*)(p.ws + WS_WRH); h16* wrl = (h16*)(p.ws + WS_WRL);
    for (int i = blockIdx.x * NTHR + tid; i < 48 * 1024; i += G * NTHR) {
      const int col = i >> 10, k = i & 1023;
      const float w = (col < 4) ? p.in[17][k * 4 + col] : (col < 36 ? p.in[19][k * 32 + (col - 4)] : 0.f);
      const h16 hi = (h16)w;
      wrh[i] = hi; wrl[i] = (h16)(w - (float)hi);
    }
    float* ct = (float*)(p.ws + WS_ROPE); float* st = ct + 8192 * 32;
    for (int i = blockIdx.x * NTHR + tid; i < 8192 * 32; i += G * NTHR) {
      const int pos = i >> 5, f = i & 31;
      const double rev = (double)pos * ROPE_REV[f];
      const float fr = (float)(rev - __builtin_rint(rev));
      ct[i] = __builtin_amdgcn_cosf(fr); st[i] = __builtin_amdgcn_sinf(fr);
    }
  }
}

DEVI void phase1(PRef p, LDS unsigned char* lds) {
  const int tid = launder((int)threadIdx.x), lane = tid & 63, wave = wave_id(tid), G = gridDim.x;
  const int b = blockIdx.x & 3, bi = blockIdx.x >> 2, nbk = G >> 2;
  LDS float* mv = (LDS float*)lds;
  mod_to_lds(p, b, 0, mv); mod_to_lds(p, b, 1, mv + 1024);
  __syncthreads();
  f32x4 A[4], SH[4];
#pragma unroll
  for (int j = 0; j < 4; ++j) {
    const int k = 256 * j + 4 * lane;
    const f32x4 g = *(const f32x4*)(p.in[4] + k);
    A[j] = g * (*(LDS f32x4*)(mv + 1024 + k) + 1.f);
    SH[j] = *(LDS f32x4*)(mv + k);
  }
  const float* x = p.in[0]; h16* H = (h16*)(p.ws + WS_H);
  for (int r = bi * 8 + wave; r < SEQ; r += nbk * 8) {
    const size_t tok = (size_t)b * SEQ + r;
    f32x4 v[4]; float ss = 0.f;
#pragma unroll
    for (int j = 0; j < 4; ++j) { v[j] = *(const f32x4*)(x + tok * DM + 256 * j + 4 * lane); ss += v[j][0] * v[j][0] + v[j][1] * v[j][1] + v[j][2] * v[j][2] + v[j][3] * v[j][3]; }
    const float rstd = 1.0f / sqrtf(wave_sum(ss) * (1.f / 1024.f) + 1e-6f);
#pragma unroll
    for (int j = 0; j < 4; ++j) {
      const f32x4 y = v[j] * rstd * A[j] + SH[j];
      *(h16x4*)(H + tok * DM + 256 * j + 4 * lane) = pack4(y[0], y[1], y[2], y[3]);
    }
  }
}

struct EpiInProj {
  unsigned char* ws;
  DEVI void operator()(const f32x4 (&acc)[2][2][4][2], const g8::Unit& u, int wr, int wc, int fr, int fq) const {
    const float* cosT = (const float*)(ws + WS_ROPE); const float* sinT = cosT + 8192 * 32;
    const int w2 = wc & 1, dlow = 16 * w2 + 4 * fq;
#pragma unroll
    for (int bj = 0; bj < 2; ++bj) {
      const int g = 4 * u.pn + 2 * bj + (wc >> 1);
      if (g > 49) continue;
#pragma unroll
      for (int ai = 0; ai < 2; ++ai)
#pragma unroll
        for (int m = 0; m < 4; ++m) {
          const int tok = u.pm * 256 + 128 * ai + 64 * wr + 16 * m + fr;
          const int b = tok >> 13, pos = tok & 8191;
          const f32x4 x1 = acc[ai][bj][m][0], x2 = acc[ai][bj][m][1];
          if (g < 16 || (g >= 24 && g <= 32)) {
            float scl; h16* dst;
            if (g < 8) { scl = 0.125f * 1.4426950408889634f; dst = (h16*)(ws + WS_Q) + (size_t)tok * 512 + g * 64; }
            else if (g < 16) { scl = 1.f; dst = (h16*)(ws + WS_K) + (size_t)tok * 512 + (g - 8) * 64; }
            else if (g < 32) { scl = 0.125f; dst = (h16*)(ws + WS_QI) + (size_t)tok * 512 + (g - 24) * 64; }
            else { scl = 1.f; dst = (h16*)(ws + WS_KI) + (size_t)tok * 64; }
            const f32x4 c = *(const f32x4*)(cosT + pos * 32 + dlow), s = *(const f32x4*)(sinT + pos * 32 + dlow);
            const f32x4 o1 = (x1 * c - x2 * s) * scl, o2 = (x2 * c + x1 * s) * scl;
            *(h16x4*)(dst + dlow) = pack4(o1[0], o1[1], o1[2], o1[3]);
            *(h16x4*)(dst + 32 + dlow) = pack4(o2[0], o2[1], o2[2], o2[3]);
          } else if (g < 24) {
            h16* vt = (h16*)(ws + WS_VT) + (size_t)(b * 8 + (g - 16)) * 64 * 8192 + vt_perm(pos);
#pragma unroll
            for (int e = 0; e < 4; ++e) { vt[(size_t)(dlow + e) * 8192] = (h16)x1[e]; vt[(size_t)(32 + dlow + e) * 8192] = (h16)x2[e]; }
          } else if (g < 49) {
            h16* dst = (g < 41) ? (h16*)(ws + WS_XR) + (size_t)tok * 512 + (g - 33) * 64 : (h16*)(ws + WS_XG) + (size_t)tok * 512 + (g - 41) * 64;
            *(h16x4*)(dst + dlow) = pack4(x1[0], x1[1], x1[2], x1[3]);
            *(h16x4*)(dst + 32 + dlow) = pack4(x2[0], x2[1], x2[2], x2[3]);
          } else if (w2 == 0 && fq < 2) {
            const float sc = 0.35355339059327373f;
            *(f32x4*)((float*)(ws + WS_WI) + (size_t)tok * 8 + 4 * fq) = x1 * sc;
          }
        }
    }
  }
};

DEVI void phase2(PRef p, LDS unsigned char* lds) {
  g8::DenseOrder S{(const h16*)(p.ws + WS_H), (const h16*)(p.ws + WS_WIN), DM, 128, 13, (int)gridDim.x, (int)blockIdx.x};
  EpiInProj E{p.ws};
  g8::gemm_phase(lds, DM, S, E);
}

constexpr int CROW = 1040;
constexpr int RNN_XG = 64 * CROW;
constexpr int RNN_CARRY = 2 * 64 * CROW;
template <int MODE>
DEVI void rnn_item(PRef p, LDS unsigned char* lds, int b, int cr) {
  const int tid = launder((int)threadIdx.x), lane = tid & 63, wave = wave_id(tid), l31 = lane & 31, half = lane >> 5;
  const h16* XR = (const h16*)(p.ws + WS_XR);
  {
    const int chg = tid & 63, tg = tid >> 6, pos0 = cr * 64 + 8 * tg;
    h16x8 xin[11];
#pragma unroll
    for (int i = 0; i < 11; ++i) {
      const int pos = pos0 + i - 3;
      if (pos >= 0) xin[i] = *(const h16x8*)(XR + ((size_t)b * SEQ + pos) * 512 + chg * 8);
      else {
#pragma unroll
        for (int e = 0; e < 8; ++e) xin[i][e] = (h16)0.f;
      }
    }
    float cw[4][8], cb[8];
#pragma unroll
    for (int e = 0; e < 8; ++e) {
      cb[e] = p.in[10][chg * 8 + e];
#pragma unroll
      for (int j = 0; j < 4; ++j) cw[j][e] = p.in[9][j * 512 + chg * 8 + e];
    }
#pragma unroll
    for (int tt = 0; tt < 8; ++tt) {
      h16x8 o;
#pragma unroll
      for (int e = 0; e < 8; ++e) {
        float v = cb[e];
#pragma unroll
        for (int j = 0; j < 4; ++j) v = fmaf(cw[j][e], (float)xin[tt + j][e], v);
        o[e] = (h16)v;
      }
      *(LDS h16x8*)(lds + (8 * tg + tt) * CROW + chg * 16) = o;
    }
  }
  if (MODE == 1) {
    const float2* ag = (const float2*)(p.ws + WS_AGG) + (size_t)b * 128 * 512 + tid;
    float carry = 0.f; int c2 = 0;
    for (; c2 + 8 <= cr; c2 += 8) {
      float2 v[8];
#pragma unroll
      for (int u = 0; u < 8; ++u) v[u] = ag[(size_t)(c2 + u) * 512];
#pragma unroll
      for (int u = 0; u < 8; ++u) carry = fmaf(v[u].x, carry, v[u].y);
    }
    for (; c2 < cr; ++c2) { const float2 v = ag[(size_t)c2 * 512]; carry = fmaf(v.x, carry, v.y); }
    ((LDS float*)(lds + RNN_CARRY))[tid] = carry;
  }
  if (MODE == 1) {
    const h16* XG = (const h16*)(p.ws + WS_XG) + ((size_t)b * SEQ + cr * 64) * 512;
#pragma unroll
    for (int i = 0; i < 8; ++i) { const int c = tid + NTHR * i, row = c >> 6, cc = c & 63; *(LDS h16x8*)(lds + RNN_XG + row * CROW + cc * 16) = *(const h16x8*)(XG + (size_t)row * 512 + cc * 8); }
  }
  __syncthreads();
  const int n = wave;
  const h16* WRG = (const h16*)(p.ws + WS_WRG) + (size_t)n * 128 * 64;
  float* AGG = (float*)(p.ws + WS_AGG);
#pragma unroll 1
  for (int dt = 0; dt < 2; ++dt) {
    h16x8 wa[4], wx[4];
#pragma unroll
    for (int kk = 0; kk < 4; ++kk) {
      wa[kk] = *(const h16x8*)(WRG + (size_t)(32 * dt + l31) * 64 + 16 * kk + 8 * half);
      wx[kk] = *(const h16x8*)(WRG + (size_t)(64 + 32 * dt + l31) * 64 + 16 * kk + 8 * half);
    }
    f32x16 ra[2], rx[2];
#pragma unroll
    for (int ti = 0; ti < 2; ++ti) {
#pragma unroll
      for (int r = 0; r < 16; ++r) { ra[ti][r] = 0.f; rx[ti][r] = 0.f; }
#pragma unroll
      for (int kk = 0; kk < 4; ++kk) {
        const h16x8 af = *(LDS h16x8*)(lds + (32 * ti + l31) * CROW + (n * 64 + 16 * kk + 8 * half) * 2);
        ra[ti] = mfma16(af, wa[kk], ra[ti]);
        rx[ti] = mfma16(af, wx[kk], rx[ti]);
      }
    }
    const int ch = n * 64 + 32 * dt + l31;
    const float ba = p.in[12][ch], bx = p.in[14][ch], lam = p.in[15][ch];
    const float c8 = -8.f * log1pf(__expf(-lam));
#pragma unroll
    for (int ti = 0; ti < 2; ++ti)
#pragma unroll
      for (int r = 0; r < 16; ++r) {
        const int tk = 32 * ti + (r & 3) + 8 * (r >> 2) + 4 * half;
        const float cv = (float)*(LDS h16*)(lds + tk * CROW + ch * 2);
        const float rr = sigmoid_f(ra[ti][r] + ba), ii = sigmoid_f(rx[ti][r] + bx);
        const float la = c8 * rr;
        ra[ti][r] = __expf(la);
        const float x2 = 2.f * la;
        const float om = -x2 * fmaf(x2 * 0.5f, fmaf(x2 * (1.f / 3.f), fmaf(x2 * 0.25f, fmaf(x2, 0.2f, 1.f), 1.f), 1.f), 1.f);
        rx[ti][r] = __builtin_amdgcn_sqrtf(om) * (ii * cv);
      }
    float P[8], Hs[8];
#pragma unroll
    for (int sg = 0; sg < 8; ++sg) {
      const int ti = sg >> 2, q = sg & 3;
      float pp = 1.f, hh = 0.f;
#pragma unroll
      for (int i = 0; i < 4; ++i) { const float a = ra[ti][4 * q + i], bb = rx[ti][4 * q + i]; hh = fmaf(a, hh, bb); pp *= a; }
      P[sg] = pp; Hs[sg] = hh;
    }
    float carry = 0.f, prod = 1.f;
    if (MODE == 1) carry = ((LDS float*)(lds + RNN_CARRY))[ch];
    float cin[8];
#pragma unroll
    for (int sg = 0; sg < 8; ++sg)
#pragma unroll
      for (int ow = 0; ow < 2; ++ow) {
        const float tmp = fmaf(P[sg], carry, Hs[sg]);
        const float tp = P[sg] * prod;
        if (half == ow) cin[sg] = carry;
        const float oth = __shfl_xor(tmp, 32), otp = __shfl_xor(tp, 32);
        carry = (half == ow) ? tmp : oth;
        prod = (half == ow) ? tp : otp;
      }
    if (MODE == 0) {
      if (half == 0) { float* ag = AGG + ((size_t)(b * 128 + cr) * 512 + ch) * 2; ag[0] = prod; ag[1] = carry; }
    } else {
#pragma unroll
      for (int sg = 0; sg < 8; ++sg) {
        const int ti = sg >> 2, q = sg & 3;
        float hh = cin[sg];
#pragma unroll
        for (int i = 0; i < 4; ++i) {
          hh = fmaf(ra[ti][4 * q + i], hh, rx[ti][4 * q + i]);
          LDS h16* xp = (LDS h16*)(lds + RNN_XG + (32 * ti + 8 * q + 4 * half + i) * CROW + ch * 2);
          *xp = (h16)(hh * gelu_tanh_f((float)*xp));
        }
      }
    }
  }
  __syncthreads();
  if (MODE == 1) {
    h16* Y = (h16*)(p.ws + WS_H) + ((size_t)b * SEQ + cr * 64) * DM + 512;
#pragma unroll
    for (int i = 0; i < 8; ++i) { const int c = tid + NTHR * i, row = c >> 6, cc = c & 63; *(h16x8*)(Y + (size_t)row * DM + cc * 8) = *(LDS h16x8*)(lds + RNN_XG + row * CROW + cc * 16); }
    __syncthreads();
  }
}

constexpr int IDX_NB = 256, IDX_CAP = 128;
constexpr int IL_HIST = 0, IL_CS = 65536, IL_CK = IL_CS + 64 * IDX_CAP * 4, IL_KI = IL_CK + 64 * IDX_CAP * 2, IL_KISZ = 128 * LROW, IL_ST = IL_KI + 2 * IL_KISZ;
static_assert(IL_ST + 4096 <= LDS_BYTES, "indexer LDS map");

DEVI f32x4 mfma16s(h16x8 a, h16x8 b, f32x4 c) { return __builtin_amdgcn_mfma_f32_16x16x32_f16(a, b, c, 0, 0, 0); }
DEVI void idx_score(LDS unsigned char* kit, int kh, int l15, int g4, const h16x8 (&qf)[8][2], const float (&wq)[8], f32x4 (&sc)[4]) {
  h16x8 kf[4][2];
#pragma unroll
  for (int kt = 0; kt < 4; ++kt)
#pragma unroll
    for (int ks = 0; ks < 2; ++ks) kf[kt][ks] = *(LDS h16x8*)(kit + (64 * kh + 16 * kt + l15) * LROW + (4 * ks + g4) * 16);
#pragma unroll
  for (int kt = 0; kt < 4; ++kt) sc[kt] = (f32x4){0.f, 0.f, 0.f, 0.f};
  f32x4 accA[4], accB[4];
#define IDX_MM(ACC, h) _Pragma("unroll") for (int kt = 0; kt < 4; ++kt) { ACC[kt] = mfma16s(kf[kt][0], qf[h][0], (f32x4){0.f, 0.f, 0.f, 0.f}); ACC[kt] = mfma16s(kf[kt][1], qf[h][1], ACC[kt]); }
#define IDX_RS(ACC, h) _Pragma("unroll") for (int kt = 0; kt < 4; ++kt) _Pragma("unroll") for (int r = 0; r < 4; ++r) sc[kt][r] = __builtin_fmaf(wq[h], __int_as_float(max(__float_as_int(ACC[kt][r]), 0)), sc[kt][r]);
  IDX_MM(accA, 0)
  IDX_MM(accB, 1) IDX_RS(accA, 0)
  IDX_MM(accA, 2) IDX_RS(accB, 1)
  IDX_MM(accB, 3) IDX_RS(accA, 2)
  IDX_MM(accA, 4) IDX_RS(accB, 3)
  IDX_MM(accB, 5) IDX_RS(accA, 4)
  IDX_MM(accA, 6) IDX_RS(accB, 5)
  IDX_MM(accB, 7) IDX_RS(accA, 6)
  IDX_RS(accB, 7)
#undef IDX_MM
#undef IDX_RS
}

template <int MODE>
DEVI void idx_pass(LDS unsigned char* lds, const h16* KIb, int N, int stride, int qg, int kh,
                   const h16* QIrow0, const float* WIrow0, float qinv, float qoff, int bstar, h16* scbase) {
  const int tid = launder((int)threadIdx.x), lane = tid & 63, l15 = lane & 15, g4 = lane >> 4;
  const int q = 16 * qg + l15;
  h16x8 qf[8][2]; float wq[8];
  {
    const h16* QI = QIrow0 + (size_t)q * 512;
#pragma unroll
    for (int h = 0; h < 8; ++h)
#pragma unroll
      for (int ks = 0; ks < 2; ++ks) qf[h][ks] = *(const h16x8*)(QI + h * 64 + 32 * ks + 8 * g4);
    const float* WI = WIrow0 + (size_t)q * 8;
#pragma unroll
    for (int h = 0; h < 8; ++h) wq[h] = WI[h];
  }
  LDS unsigned* hist = (LDS unsigned*)(lds + IL_HIST);
  LDS unsigned* st = (LDS unsigned*)(lds + IL_ST);
  const int nst = (N + 127) >> 7;
  const int lr = tid >> 3, lc = tid & 7;
  h16x8 r0, r1;
  r0 = *(const h16x8*)(KIb + (size_t)lr * 64 + lc * 8); r1 = *(const h16x8*)(KIb + (size_t)(lr + 64) * 64 + lc * 8);
  *(LDS h16x8*)(lds + IL_KI + lr * LROW + lc * 16) = r0; *(LDS h16x8*)(lds + IL_KI + (lr + 64) * LROW + lc * 16) = r1;
  __syncthreads();
  float vmin = INFINITY, vmax = -INFINITY;
  int cur = 0;
  for (int s = 0; s < nst; s += stride) {
    const int nx = s + stride;
    if (nx < nst) { r0 = *(const h16x8*)(KIb + (size_t)(128 * nx + lr) * 64 + lc * 8); r1 = *(const h16x8*)(KIb + (size_t)(128 * nx + lr + 64) * 64 + lc * 8); }
    if (128 * s + 64 * kh < N) {
      f32x4 sc[4];
      idx_score(lds + IL_KI + cur * IL_KISZ, kh, l15, g4, qf, wq, sc);
      if (MODE == 0) {
#pragma unroll
        for (int kt = 0; kt < 4; ++kt)
#pragma unroll
          for (int r = 0; r < 4; ++r) { vmin = fminf(vmin, sc[kt][r]); vmax = fmaxf(vmax, sc[kt][r]); }
      } else if (MODE == 1) {
        h16* scp = scbase + ((size_t)((s * 2 + kh) * 4) * 1024 + q * 16 + 4 * g4);
#pragma unroll
        for (int kt = 0; kt < 4; ++kt) {
          const h16x4 hv = pack4(sc[kt][0], sc[kt][1], sc[kt][2], sc[kt][3]);
          *(h16x4*)(scp + kt * 1024) = hv;
#pragma unroll
          for (int r = 0; r < 4; ++r) {
            const float xb = fminf(fmaxf(__builtin_fmaf((float)hv[r], qinv, qoff), 0.f), (float)(IDX_NB - 1));
            const int bin = (int)xb;
            __hip_atomic_fetch_add(&hist[bin * 64 + q], 1u, __ATOMIC_RELAXED, __HIP_MEMORY_SCOPE_WORKGROUP);
          }
        }
      } else {
        unsigned nib = 0u;
#pragma unroll
        for (int kt = 0; kt < 4; ++kt)
#pragma unroll
          for (int r = 0; r < 4; ++r) {
            const float xb = fminf(fmaxf(__builtin_fmaf(sc[kt][r], qinv, qoff), 0.f), (float)(IDX_NB - 1));
            const int bin = (int)xb;
            if (bin > bstar) nib |= (1u << (4 * kt + r));
            else if (bin == bstar) {
              const unsigned pos = __hip_atomic_fetch_add(&st[128 + q], 1u, __ATOMIC_RELAXED, __HIP_MEMORY_SCOPE_WORKGROUP);
              if (pos < (unsigned)IDX_CAP) {
                ((LDS float*)(lds + IL_CS))[q * IDX_CAP + pos] = sc[kt][r];
                ((LDS unsigned short*)(lds + IL_CK))[q * IDX_CAP + pos] = (unsigned short)(128 * s + 64 * kh + 16 * kt + 4 * g4 + r);
              }
            }
          }
        const unsigned oth = (unsigned)__shfl_xor((int)nib, 32);
        if (lane < 32) {
#pragma unroll
          for (int T = 0; T < 2; ++T) {
            const unsigned b0 = ((nib >> (8 * T)) & 15u) | (((oth >> (8 * T)) & 15u) << 4);
            const unsigned b1 = ((nib >> (8 * T + 4)) & 15u) | (((oth >> (8 * T + 4)) & 15u) << 4);
            ((LDS unsigned short*)(lds + IL_HIST))[q * 512 + (4 * s + 2 * kh + T) * 2 + (g4 & 1)] = (unsigned short)(b0 | (b1 << 8));
          }
        }
      }
    }
    if (nx < nst) {
      *(LDS h16x8*)(lds + IL_KI + (cur ^ 1) * IL_KISZ + lr * LROW + lc * 16) = r0;
      *(LDS h16x8*)(lds + IL_KI + (cur ^ 1) * IL_KISZ + (lr + 64) * LROW + lc * 16) = r1;
    }
    __syncthreads();
    cur ^= 1;
  }
  if (MODE == 0) {
    __hip_atomic_fetch_min(&st[q], fkey(vmin), __ATOMIC_RELAXED, __HIP_MEMORY_SCOPE_WORKGROUP);
    __hip_atomic_fetch_max(&st[64 + q], fkey(vmax), __ATOMIC_RELAXED, __HIP_MEMORY_SCOPE_WORKGROUP);
  }
}

DEVI int idx_bin(float sv, float qinv, float qoff) { return (int)fminf(fmaxf(__builtin_fmaf(sv, qinv, qoff), 0.f), (float)(IDX_NB - 1)); }
DEVI float idx_bin_lower_bound(int target, float qinv, float qoff) {
  if (target <= 0) return -INFINITY;
  if (target > IDX_NB - 1) return INFINITY;
  unsigned lo = 0x03FFu, hi = 0xFC00u;
  auto val = [](unsigned k) { const unsigned short hbits = (unsigned short)((k & 0x8000u) ? (k & 0x7FFFu) : (~k & 0xFFFFu)); return (float)__builtin_bit_cast(h16, hbits); };
  if (idx_bin(val(hi), qinv, qoff) < target) return INFINITY;
  while (lo < hi) { const unsigned mid = (lo + hi) >> 1; if (idx_bin(val(mid), qinv, qoff) >= target) hi = mid; else lo = mid + 1; }
  return val(lo);
}
DEVI void idx_stream_step(LDS unsigned char* lds, LDS unsigned* st, const unsigned long long (&cur)[4], int s, int kh, int q, int lane, int g4, float thi, float tlo) {
  unsigned nib = 0u;
#pragma unroll
  for (int kt = 3; kt >= 0; --kt) {
    const h16x4 hv = __builtin_bit_cast(h16x4, cur[kt]);
#pragma unroll
    for (int r = 3; r >= 0; --r) {
      const float sv = (float)hv[r];
      const unsigned long long ms = __builtin_amdgcn_ballot_w64(sv >= thi);
      asm("v_addc_co_u32_e64 %0, vcc, %0, %0, %1" : "+v"(nib) : "s"(ms) : "vcc");
      const bool cand = (sv >= tlo) && !(sv >= thi);
      if (__builtin_amdgcn_ballot_w64(cand) != 0ull) {
        if (cand) {
          const unsigned pos = __hip_atomic_fetch_add(&st[128 + q], 1u, __ATOMIC_RELAXED, __HIP_MEMORY_SCOPE_WORKGROUP);
          if (pos < (unsigned)IDX_CAP) {
            ((LDS float*)(lds + IL_CS))[q * IDX_CAP + pos] = sv;
            ((LDS unsigned short*)(lds + IL_CK))[q * IDX_CAP + pos] = (unsigned short)(128 * s + 64 * kh + 16 * kt + 4 * g4 + r);
          }
        }
      }
    }
  }
  const unsigned oth = (unsigned)__shfl_xor((int)nib, 32);
  if (lane < 32) {
#pragma unroll
    for (int T = 0; T < 2; ++T) {
      const unsigned b0 = ((nib >> (8 * T)) & 15u) | (((oth >> (8 * T)) & 15u) << 4);
      const unsigned b1 = ((nib >> (8 * T + 4)) & 15u) | (((oth >> (8 * T + 4)) & 15u) << 4);
      ((LDS unsigned short*)(lds + IL_HIST))[q * 512 + (4 * s + 2 * kh + T) * 2 + (g4 & 1)] = (unsigned short)(b0 | (b1 << 8));
    }
  }
}
DEVI void idx_stream(LDS unsigned char* lds, int N, int qg, int kh, float thi, float tlo, const h16* scbase) {
  const int tid = launder((int)threadIdx.x), lane = tid & 63, l15 = lane & 15, g4 = lane >> 4;
  const int q = 16 * qg + l15;
  LDS unsigned* st = (LDS unsigned*)(lds + IL_ST);
  const int nv = (N - 64 * kh + 127) >> 7;
  const unsigned long long* scp = (const unsigned long long*)(scbase + ((size_t)(kh * 4) * 1024 + q * 16 + 4 * g4));
#define IDX_LD(dst, s_) do { if ((s_) < nv) { _Pragma("unroll") for (int kt = 0; kt < 4; ++kt) dst[kt] = __hip_atomic_load(scp + (size_t)(s_) * 2048 + kt * 256, __ATOMIC_RELAXED, __HIP_MEMORY_SCOPE_AGENT); } } while (0)
  unsigned long long b0[4], b1[4], b2[4], b3[4];
  IDX_LD(b0, 0); IDX_LD(b1, 1); IDX_LD(b2, 2); IDX_LD(b3, 3);
  for (int s = 0; s < nv; s += 4) {
    idx_stream_step(lds, st, b0, s, kh, q, lane, g4, thi, tlo); IDX_LD(b0, s + 4);
    if (s + 1 < nv) { idx_stream_step(lds, st, b1, s + 1, kh, q, lane, g4, thi, tlo); IDX_LD(b1, s + 5); }
    if (s + 2 < nv) { idx_stream_step(lds, st, b2, s + 2, kh, q, lane, g4, thi, tlo); IDX_LD(b2, s + 6); }
    if (s + 3 < nv) { idx_stream_step(lds, st, b3, s + 3, kh, q, lane, g4, thi, tlo); IDX_LD(b3, s + 7); }
  }
#undef IDX_LD
}

DEVI void idx_item(PRef p, LDS unsigned char* lds, int b, int c) {
  const int tid = launder((int)threadIdx.x), lane = tid & 63, wave = wave_id(tid), l31 = lane & 31, half = lane >> 5;
  const int N = 64 * (c + 1);
  unsigned* MASK = (unsigned*)(p.ws + WS_MASK) + ((size_t)b * SEQ + 64 * c) * 256;
  if (N <= 256) {
    const int wpr = N >> 5;
    for (int i = tid; i < 64 * wpr; i += NTHR) MASK[(size_t)(i / wpr) * 256 + (i % wpr)] = 0xFFFFFFFFu;
    return;
  }
  const int qg = wave & 3, kh = wave >> 2, l15 = lane & 15, q = 16 * qg + l15;
  const h16* QIrow0 = (const h16*)(p.ws + WS_QI) + ((size_t)b * SEQ + 64 * c) * 512;
  const float* WIrow0 = (const float*)(p.ws + WS_WI) + ((size_t)b * SEQ + 64 * c) * 8;
  const h16* KIb = (const h16*)(p.ws + WS_KI) + (size_t)b * SEQ * 64;
  h16* scbase;
  {
    const int j = (c < 64) ? c : 127 - c;
    const size_t pre = 8192ull * (size_t)(128 * j - (j * (j - 1)) / 2);
    scbase = (h16*)(p.ws + (b == 0 ? WS_H : WS_MIX + (size_t)(b - 1) * SC_BATCH_BYTES) + pre);
  }
  LDS unsigned* st = (LDS unsigned*)(lds + IL_ST);
  LDS float* stf = (LDS float*)(lds + IL_ST);
  if (tid < 64) { st[tid] = 0xFFFFFFFFu; st[64 + tid] = 0u; st[128 + tid] = 0u; }
  __syncthreads();
  const int nst = (N + 127) >> 7;
  const int stride = nst >= 16 ? 8 : (nst >= 8 ? 4 : (nst >= 4 ? 2 : 1));
  idx_pass<0>(lds, KIb, N, stride, qg, kh, QIrow0, WIrow0, 0.f, 0.f, 0, scbase);
  __syncthreads();
  if (tid < 64) {
    const float lo = fkey_inv(st[tid]), hi = fkey_inv(st[64 + tid]);
    float d = hi - lo; if (!(d > 1e-20f)) d = 1.f;
    const float inv = (float)IDX_NB / (1.5f * d);
    stf[192 + tid] = inv; stf[256 + tid] = -(lo - 0.25f * d) * inv;
  }
  for (int i = tid; i < 16384; i += NTHR) ((LDS unsigned*)(lds + IL_HIST))[i] = 0u;
  __syncthreads();
  const float qinv = stf[192 + q], qoff = stf[256 + q];
  idx_pass<1>(lds, KIb, N, 1, qg, kh, QIrow0, WIrow0, qinv, qoff, 0, scbase);
  {
    LDS unsigned* hist = (LDS unsigned*)(lds + IL_HIST);
    for (int qq = wave; qq < 64; qq += 8) {
      unsigned hb[4];
#pragma unroll
      for (int j = 0; j < 4; ++j) hb[j] = hist[(4 * lane + j) * 64 + qq];
      const unsigned mine = hb[0] + hb[1] + hb[2] + hb[3];
      unsigned suf = mine;
#pragma unroll
      for (int o = 1; o < 64; o <<= 1) { const unsigned v = (unsigned)__shfl_down((int)suf, o); if (lane + o < 64) suf += v; }
      unsigned cum = suf - mine;
      if (cum < 256u && suf >= 256u) {
#pragma unroll
        for (int j = 3; j >= 0; --j) {
          if (cum < 256u && cum + hb[j] >= 256u) { st[320 + qq] = (unsigned)(4 * lane + j); st[384 + qq] = 256u - cum; }
          cum += hb[j];
        }
      }
    }
  }
  __syncthreads();
  if (tid < 64) {
    const int bs = (int)st[320 + tid]; const float qi_ = stf[192 + tid], qo_ = stf[256 + tid];
    stf[448 + tid] = idx_bin_lower_bound(bs + 1, qi_, qo_);
    stf[512 + tid] = idx_bin_lower_bound(bs, qi_, qo_);
  }
  __syncthreads();
  const float thi = stf[448 + q], tlo = stf[512 + q];
  asm volatile("s_waitcnt vmcnt(0)" ::: "memory");
  idx_stream(lds, N, qg, kh, thi, tlo, scbase);
  __syncthreads();
  for (int qq = wave; qq < 64; qq += 8) {
    const int nc = min((int)st[128 + qq], IDX_CAP); const unsigned need = st[384 + qq];
    LDS float* cs = (LDS float*)(lds + IL_CS) + qq * IDX_CAP; LDS unsigned short* ck = (LDS unsigned short*)(lds + IL_CK) + qq * IDX_CAP;
    for (int i = lane; i < nc; i += 64) {
      const float sv = cs[i]; const unsigned kv = ck[i];
      unsigned rank = 0u;
      for (int j = 0; j < nc; ++j) { const float sj = cs[j]; const unsigned kj = ck[j]; rank += (sj > sv || (sj == sv && kj < kv)) ? 1u : 0u; }
      if (rank < need) {
        const unsigned kl = kv & 31u;
        const unsigned bit = 16u * ((kl >> 2) & 1u) + (kl & 3u) + 4u * (kl >> 3);
        __hip_atomic_fetch_or((LDS unsigned*)(lds + IL_HIST) + qq * 256 + (kv >> 5), 1u << bit, __ATOMIC_RELAXED, __HIP_MEMORY_SCOPE_WORKGROUP);
      }
    }
  }
  __syncthreads();
  {
    const int cpr = N >> 6;
    for (int i = tid; i < 64 * cpr; i += NTHR) {
      const int row = i / cpr, cc = i % cpr;
      *(u32x2*)(MASK + (size_t)row * 256 + 2 * cc) = *(LDS u32x2*)(lds + IL_HIST + row * 1024 + cc * 8);
    }
  }
  __syncthreads();
}

DEVI void phase3(PRef p, LDS unsigned char* lds) {
  const int G = gridDim.x;
  for (int it = blockIdx.x; it < 512; it += G) rnn_item<0>(p, lds, it >> 7, it & 127);
  for (int it = blockIdx.x; it < 256; it += G) {
    const int b = it >> 6, j = it & 63;
#pragma unroll 1
    for (int w2 = 0; w2 < 2; ++w2) idx_item(p, lds, b, w2 ? j : 127 - j);
  }
}

constexpr int AT_BUF = 2 * 64 * LROW;
DEVI float max3f(float a, float b, float c) { float r; asm("v_max3_f32 %0, %1, %2, %3" : "=v"(r) : "v"(a), "v"(b), "v"(c)); return r; }
DEVI unsigned pk_rtz(float a, float b) { return __builtin_bit_cast(unsigned, __builtin_amdgcn_cvt_pkrtz(a, b)); }
DEVI void attn_tile(LDS unsigned char* Kt, LDS unsigned char* Vt, const h16x8 (&qf)[4], u32x2 mw, int l31, int half, f32x16 (&o)[2], float& mref, float& l, bool& init) {
  const unsigned nm0 = ~(mw[0] >> (16 * half)), nm1 = ~(mw[1] >> (16 * half));
  const unsigned negm = __float_as_uint(-mref);
  f32x16 s[2];
#pragma unroll
  for (int r = 0; r < 16; ++r) {
    unsigned e0 = (unsigned)__builtin_amdgcn_sbfe((int)nm0, r, 1), e1 = (unsigned)__builtin_amdgcn_sbfe((int)nm1, r, 1);
    asm volatile("" : "+v"(e0), "+v"(e1));
    s[0][r] = __uint_as_float((e0 & 0xFF800000u) | (~e0 & negm));
    s[1][r] = __uint_as_float((e1 & 0xFF800000u) | (~e1 & negm));
  }
#pragma unroll
  for (int ri = 0; ri < 2; ++ri)
#pragma unroll
    for (int kk = 0; kk < 4; ++kk) {
      const h16x8 kf = *(LDS h16x8*)(Kt + (32 * ri + l31) * LROW + (2 * kk + half) * 16);
      s[ri] = mfma16(kf, qf[kk], s[ri]);
    }
  asm volatile("s_nop 15\n\ts_nop 7" : "+v"(s[0]), "+v"(s[1]));
  float mx = max3f(s[0][0], s[1][0], s[0][1]), mx2 = max3f(s[1][1], s[0][2], s[1][2]);
#pragma unroll
  for (int r = 3; r < 15; r += 2) { mx = max3f(mx, s[0][r], s[1][r]); mx2 = max3f(mx2, s[0][r + 1], s[1][r + 1]); }
  mx = max3f(mx, s[0][15], s[1][15]);
  mx = max3f(mx, mx2, mx2);
  mx = max3f(mx, __shfl_xor(mx, 32), mx);
  const bool first = (!init) && (mx > -INFINITY);
  const bool resc = first || (mx > 8.f);
  if (__any(resc)) {
    init = init || first;
    const float delta = resc ? mx : 0.f;
    const float alpha = __builtin_amdgcn_exp2f(-delta);
#pragma unroll
    for (int r = 0; r < 16; ++r) { s[0][r] -= delta; s[1][r] -= delta; o[0][r] *= alpha; o[1][r] *= alpha; }
    l *= alpha; mref += delta;
  }
  float ls = 0.f;
#pragma unroll
  for (int r = 0; r < 16; ++r) {
    s[0][r] = __builtin_amdgcn_exp2f(s[0][r]); s[1][r] = __builtin_amdgcn_exp2f(s[1][r]);
    ls += s[0][r] + s[1][r];
  }
  l += ls;
  h16x8 pf[4];
#pragma unroll
  for (int s4 = 0; s4 < 4; ++s4) {
    u32x4 w;
#pragma unroll
    for (int e = 0; e < 4; ++e) w[e] = pk_rtz(s[s4 >> 1][8 * (s4 & 1) + 2 * e], s[s4 >> 1][8 * (s4 & 1) + 2 * e + 1]);
    pf[s4] = __builtin_bit_cast(h16x8, w);
  }
#pragma unroll
  for (int di = 0; di < 2; ++di)
#pragma unroll
    for (int s4 = 0; s4 < 4; ++s4) {
      const h16x8 vf = *(LDS h16x8*)(Vt + (32 * di + l31) * LROW + (2 * s4 + half) * 16);
      o[di] = mfma16(vf, pf[s4], o[di]);
    }
}

DEVI void attn_unit(PRef p, LDS unsigned char* lds, int b, int head, int qb) {
  const int tid = launder((int)threadIdx.x), lane = tid & 63, wave = wave_id(tid), l31 = lane & 31, half = lane >> 5;
  const int q0 = qb * 256 + wave * 32, cw = q0 >> 6, NS = qb + 1;
  const size_t tok = (size_t)b * SEQ + q0 + l31;
  h16x8 qf[4];
  {
    const h16* Q = (const h16*)(p.ws + WS_Q) + tok * 512 + head * 64;
#pragma unroll
    for (int kk = 0; kk < 4; ++kk) qf[kk] = *(const h16x8*)(Q + 16 * kk + 8 * half);
  }
  const unsigned* mrow = (const unsigned*)(p.ws + WS_MASK) + tok * 256;
  constexpr int TP = 2 * 64 * LROW, ABUF = 4 * TP;
  static_assert(2 * ABUF <= LDS_BYTES - 16, "attention LDS");
  const h16* ksrc[4]; const h16* vsrc[4]; int kdst[4], vdst[4];
#pragma unroll
  for (int i = 0; i < 4; ++i) {
    const int id = tid + NTHR * i;
    const int row = id >> 3, lc = id & 7;
    ksrc[i] = (const h16*)(p.ws + WS_K) + ((size_t)b * SEQ + row) * 512 + head * 64 + lc * 8;
    kdst[i] = (row >> 6) * TP + (row & 63) * LROW + lc * 16;
    const int d = id >> 5, c = id & 31;
    vsrc[i] = (const h16*)(p.ws + WS_VT) + ((size_t)(b * 8 + head) * 64 + d) * 8192 + c * 8;
    vdst[i] = (c >> 3) * TP + 64 * LROW + d * LROW + (c & 7) * 16;
  }
  h16x8 rkA[4], rvA[4], rkB[4], rvB[4];
#pragma unroll
  for (int i = 0; i < 4; ++i) { rkA[i] = *(const h16x8*)ksrc[i]; rvA[i] = *(const h16x8*)vsrc[i]; }
#pragma unroll
  for (int i = 0; i < 4; ++i) { *(LDS h16x8*)(lds + kdst[i]) = rkA[i]; *(LDS h16x8*)(lds + vdst[i]) = rvA[i]; }
  if (NS > 1) {
#pragma unroll
    for (int i = 0; i < 4; ++i) { rkA[i] = *(const h16x8*)(ksrc[i] + (size_t)256 * 512); rvA[i] = *(const h16x8*)(vsrc[i] + 256); }
  }
  u32x4 mwa = *(const u32x4*)mrow, mwb = *(const u32x4*)(mrow + 4), mna, mnb;
  mna = mwa; mnb = mwb;
  __syncthreads();
  f32x16 o[2];
#pragma unroll
  for (int r = 0; r < 16; ++r) { o[0][r] = 0.f; o[1][r] = 0.f; }
  float mref = 0.f, l = 0.f; bool init = false;
#define ATT_TILE(s, t, W0, W1) if (4 * (s) + (t) <= cw) { u32x2 m2; m2[0] = W0; m2[1] = W1; attn_tile(bb + (t) * TP, bb + (t) * TP + 64 * LROW, qf, m2, l31, half, o, mref, l, init); }
#define ATT_STEP(s, RKC, RVC, RKN, RVN) { \
    if ((s) + 2 < NS) { _Pragma("unroll") for (int i = 0; i < 4; ++i) { RKN[i] = *(const h16x8*)(ksrc[i] + (size_t)((s) + 2) * 256 * 512); RVN[i] = *(const h16x8*)(vsrc[i] + ((s) + 2) * 256); } } \
    if ((s) + 1 < NS) { mna = *(const u32x4*)(mrow + 8 * ((s) + 1)); mnb = *(const u32x4*)(mrow + 8 * ((s) + 1) + 4); } \
    { LDS unsigned char* bb = lds + ((s) & 1) * ABUF; \
      ATT_TILE(s, 0, mwa[0], mwa[1]) ATT_TILE(s, 1, mwa[2], mwa[3]) ATT_TILE(s, 2, mwb[0], mwb[1]) ATT_TILE(s, 3, mwb[2], mwb[3]) } \
    if ((s) + 1 < NS) { LDS unsigned char* nb = lds + (((s) + 1) & 1) * ABUF; _Pragma("unroll") for (int i = 0; i < 4; ++i) { *(LDS h16x8*)(nb + kdst[i]) = RKC[i]; *(LDS h16x8*)(nb + vdst[i]) = RVC[i]; } } \
    __syncthreads(); mwa = mna; mwb = mnb; }
  for (int s = 0; s < NS; s += 2) {
    ATT_STEP(s, rkA, rvA, rkB, rvB)
    if (s + 1 < NS) ATT_STEP(s + 1, rkB, rvB, rkA, rvA)
  }
#undef ATT_STEP
#undef ATT_TILE
  const float inv = 1.f / (l + __shfl_xor(l, 32));
  h16* Y = (h16*)(p.ws + WS_H) + tok * DM + head * 64;
#pragma unroll
  for (int di = 0; di < 2; ++di)
#pragma unroll
    for (int q = 0; q < 4; ++q)
      *(h16x4*)(Y + 32 * di + 8 * q + 4 * half) = pack4(o[di][4 * q] * inv, o[di][4 * q + 1] * inv, o[di][4 * q + 2] * inv, o[di][4 * q + 3] * inv);
}

DEVI void phase4(PRef p, LDS unsigned char* lds) {
  const int G = gridDim.x;
  for (int it = blockIdx.x; it < 512; it += G) rnn_item<1>(p, lds, it >> 7, it & 127);
  for (int it = blockIdx.x; it < 512; it += G) {
    const int bh = it >> 4, j = it & 15;
#pragma unroll 1
    for (int w2 = 0; w2 < 2; ++w2) attn_unit(p, lds, bh >> 3, bh & 7, w2 ? j : 31 - j);
  }
}

struct EpiPlain {
  h16* dst; int ld;
  DEVI void operator()(const f32x4 (&acc)[2][2][4][2], const g8::Unit& u, int wr, int wc, int fr, int fq) const {
#pragma unroll
    for (int ai = 0; ai < 2; ++ai)
#pragma unroll
      for (int m = 0; m < 4; ++m) {
        const int r = u.pm * 256 + 128 * ai + 64 * wr + 16 * m + fr;
        if (r < u.cnt) {
          h16* d = dst + (size_t)(u.off + r) * ld + u.pn * 256 + 32 * wc + 4 * fq;
#pragma unroll
          for (int bj = 0; bj < 2; ++bj)
#pragma unroll
            for (int n = 0; n < 2; ++n) { const f32x4 v = acc[ai][bj][m][n]; *(h16x4*)(d + 128 * bj + 16 * n) = pack4(v[0], v[1], v[2], v[3]); }
        }
      }
  }
};
DEVI void phase5(PRef p, LDS unsigned char* lds) {
  g8::DenseOrder S{(const h16*)(p.ws + WS_H), (const h16*)(p.ws + WS_WOUT), DM, 128, 4, (int)gridDim.x, (int)blockIdx.x};
  EpiPlain E{(h16*)(p.ws + WS_MIX), DM};
  g8::gemm_phase(lds, DM, S, E);
}

constexpr int P6_TROW = 2064, P6_THI = 0, P6_TLO = 32 * P6_TROW, P6_PART = 0, P6_LGT = 8 * 48 * 32 * 4, P6_MOD = 2 * 32 * P6_TROW;
constexpr int P6_BIAS = P6_MOD + 3 * 4096, P6_TOK = P6_BIAS + 160, P6_LCNT = P6_TOK + 128 * 6 * 4, P6_LBASE = P6_LCNT + 128;
static_assert(P6_LBASE + 128 <= LDS_BYTES - 16 && P6_LGT + 32 * 36 * 4 <= P6_MOD, "phase 6 LDS map");
DEVI void phase6(PRef p, LDS unsigned char* lds) {
  const int tid = launder((int)threadIdx.x), lane = tid & 63, wave = wave_id(tid), l15 = lane & 15, g4 = lane >> 4;
  const int b = blockIdx.x >> 6;
  LDS float* mv = (LDS float*)(lds + P6_MOD);
  LDS float* rbias = (LDS float*)(lds + P6_BIAS);
  LDS unsigned* tokrec = (LDS unsigned*)(lds + P6_TOK);
  LDS unsigned* lcnt = (LDS unsigned*)(lds + P6_LCNT);
  LDS unsigned* lbase = (LDS unsigned*)(lds + P6_LBASE);
  mod_to_lds(p, b, 2, mv); mod_to_lds(p, b, 3, mv + 1024); mod_to_lds(p, b, 4, mv + 2048);
  if (tid < 4) rbias[tid] = p.in[18][tid];
  else if (tid < 36) rbias[tid] = p.in[20][tid - 4];
  if (tid < 32) lcnt[tid] = 0u;
  __syncthreads();
  f32x4 A1[4], A2[4], SH2[4];
#pragma unroll
  for (int j = 0; j < 4; ++j) {
    const int k = 256 * j + 4 * lane;
    A1[j] = *(LDS f32x4*)(mv + k) * *(const f32x4*)(p.in[5] + k);
    A2[j] = *(const f32x4*)(p.in[6] + k) * (*(LDS f32x4*)(mv + 2048 + k) + 1.f);
    SH2[j] = *(LDS f32x4*)(mv + 1024 + k);
  }
  const float* x = p.in[0]; const h16* MIX = (const h16*)(p.ws + WS_MIX); h16* X1h = (h16*)(p.ws + WS_MIX); h16* H2 = (h16*)(p.ws + WS_H);
  const h16* WRH = (const h16*)(p.ws + WS_WRH); const h16* WRL = (const h16*)(p.ws + WS_WRL);
  const size_t tok0 = (size_t)blockIdx.x * 128;
  h16x8 bh[3][4], bl[3][4];
#pragma unroll
  for (int ct = 0; ct < 3; ++ct)
#pragma unroll
    for (int kk = 0; kk < 4; ++kk) {
      const int kof = 32 * (4 * wave + kk) + 8 * g4;
      bh[ct][kk] = *(const h16x8*)(WRH + (size_t)(16 * ct + l15) * 1024 + kof); bl[ct][kk] = *(const h16x8*)(WRL + (size_t)(16 * ct + l15) * 1024 + kof);
    }
#pragma unroll 1
  for (int rd = 0; rd < 4; ++rd) {
#pragma unroll 1
    for (int i = 0; i < 4; ++i) {
      const int tr = 4 * wave + i;
      const size_t tok = tok0 + 32 * rd + tr;
      f32x4 xv[4], mx[4]; float ssm = 0.f;
#pragma unroll
      for (int j = 0; j < 4; ++j) {
        xv[j] = *(const f32x4*)(x + tok * DM + 256 * j + 4 * lane);
        const h16x4 mh = *(const h16x4*)(MIX + tok * DM + 256 * j + 4 * lane);
#pragma unroll
        for (int e = 0; e < 4; ++e) { mx[j][e] = (float)mh[e]; ssm += mx[j][e] * mx[j][e]; }
      }
      const float rsm = 1.0f / sqrtf(wave_sum(ssm) * (1.f / 1024.f) + 1e-6f);
      float ss1 = 0.f;
#pragma unroll
      for (int j = 0; j < 4; ++j) {
        xv[j] = xv[j] + A1[j] * (mx[j] * rsm);
        *(h16x4*)(X1h + tok * DM + 256 * j + 4 * lane) = pack4(xv[j][0], xv[j][1], xv[j][2], xv[j][3]);
        ss1 += xv[j][0] * xv[j][0] + xv[j][1] * xv[j][1] + xv[j][2] * xv[j][2] + xv[j][3] * xv[j][3];
      }
      const float rs1 = 1.0f / sqrtf(wave_sum(ss1) * (1.f / 1024.f) + 1e-6f);
#pragma unroll
      for (int j = 0; j < 4; ++j) {
        const f32x4 h2 = xv[j] * rs1 * A2[j] + SH2[j];
        const h16x4 hi = pack4(h2[0], h2[1], h2[2], h2[3]);
        const h16x4 lo = pack4(h2[0] - (float)hi[0], h2[1] - (float)hi[1], h2[2] - (float)hi[2], h2[3] - (float)hi[3]);
        *(h16x4*)(H2 + tok * DM + 256 * j + 4 * lane) = hi;
        *(LDS h16x4*)(lds + P6_THI + tr * P6_TROW + (256 * j + 4 * lane) * 2) = hi;
        *(LDS h16x4*)(lds + P6_TLO + tr * P6_TROW + (256 * j + 4 * lane) * 2) = lo;
      }
    }
    __syncthreads();
    f32x4 acc[2][3];
#pragma unroll
    for (int tt = 0; tt < 2; ++tt)
#pragma unroll
      for (int ct = 0; ct < 3; ++ct) acc[tt][ct] = (f32x4){0.f, 0.f, 0.f, 0.f};
#pragma unroll
    for (int kk = 0; kk < 4; ++kk) {
      const int kof = 32 * (4 * wave + kk) + 8 * g4;
      h16x8 ah[2], al[2];
#pragma unroll
      for (int tt = 0; tt < 2; ++tt) {
        ah[tt] = *(LDS h16x8*)(lds + P6_THI + (16 * tt + l15) * P6_TROW + kof * 2);
        al[tt] = *(LDS h16x8*)(lds + P6_TLO + (16 * tt + l15) * P6_TROW + kof * 2);
      }
#pragma unroll
      for (int ct = 0; ct < 3; ++ct) {
#pragma unroll
        for (int tt = 0; tt < 2; ++tt) {
          acc[tt][ct] = mfma16s(ah[tt], bh[ct][kk], acc[tt][ct]);
          acc[tt][ct] = mfma16s(ah[tt], bl[ct][kk], acc[tt][ct]);
          acc[tt][ct] = mfma16s(al[tt], bh[ct][kk], acc[tt][ct]);
        }
      }
    }
    __syncthreads();
#pragma unroll
    for (int tt = 0; tt < 2; ++tt)
#pragma unroll
      for (int ct = 0; ct < 3; ++ct)
        *(LDS f32x4*)(lds + P6_PART + (((wave * 48 + 16 * ct + l15) * 32) + 16 * tt + 4 * g4) * 4) = acc[tt][ct];
    __syncthreads();
    for (int idx = tid; idx < 36 * 32; idx += NTHR) {
      const int col = idx >> 5, tk = idx & 31;
      float s = 0.f;
#pragma unroll
      for (int w = 0; w < 8; ++w) s += *(LDS float*)(lds + P6_PART + ((w * 48 + col) * 32 + tk) * 4);
      *(LDS float*)(lds + P6_LGT + (tk * 36 + col) * 4) = s;
    }
    __syncthreads();
    if (tid < 32) {
      LDS float* lg = (LDS float*)(lds + P6_LGT) + 36 * tid;
      float gl[4];
#pragma unroll
      for (int g = 0; g < 4; ++g) gl[g] = lg[g] + rbias[g];
      int gi = 0; float gm = gl[0];
#pragma unroll
      for (int g = 1; g < 4; ++g) if (gl[g] > gm) { gm = gl[g]; gi = g; }
      float gs = 0.f;
#pragma unroll
      for (int g = 0; g < 4; ++g) gs += __expf(gl[g] - gm);
      const float pg = 1.f / gs;
      int e1 = 0, e2 = 0; float l1 = -INFINITY, l2 = -INFINITY;
#pragma unroll
      for (int e = 0; e < 8; ++e) {
        const float v = lg[4 + 8 * gi + e] + rbias[4 + 8 * gi + e];
        if (v > l1) { l2 = l1; e2 = e1; l1 = v; e1 = e; }
        else if (v > l2) { l2 = v; e2 = e; }
      }
      const float x2 = __expf(l2 - l1);
      const float w1 = pg / (1.f + x2), w2 = pg * x2 / (1.f + x2);
      const unsigned E1 = (unsigned)(gi * 8 + e1), E2 = (unsigned)(gi * 8 + e2);
      const unsigned lp1 = __hip_atomic_fetch_add(&lcnt[E1], 1u, __ATOMIC_RELAXED, __HIP_MEMORY_SCOPE_WORKGROUP);
      const unsigned lp2 = __hip_atomic_fetch_add(&lcnt[E2], 1u, __ATOMIC_RELAXED, __HIP_MEMORY_SCOPE_WORKGROUP);
      LDS unsigned* tr = tokrec + (32 * rd + tid) * 6;
      tr[0] = E1; tr[1] = lp1; tr[2] = E2; tr[3] = lp2; tr[4] = __float_as_uint(w1); tr[5] = __float_as_uint(w2);
    }
    __syncthreads();
  }
  if (tid < 32) lbase[tid] = atomicAdd((unsigned*)(p.ws + WS_CNT) + tid, lcnt[tid]);
  __syncthreads();
  if (tid < 128) {
    unsigned* LIST = (unsigned*)(p.ws + WS_LIST); float* LISTW = (float*)(p.ws + WS_LISTW); u32x4* ROUTE = (u32x4*)(p.ws + WS_ROUTE);
    const unsigned tok = (unsigned)(tok0 + tid);
    LDS unsigned* tr = tokrec + tid * 6;
    const unsigned E1 = tr[0], E2 = tr[2], p1 = lbase[E1] + tr[1], p2 = lbase[E2] + tr[3];
    LIST[(size_t)E1 * 32768 + p1] = tok; LISTW[(size_t)E1 * 32768 + p1] = __uint_as_float(tr[4]);
    LIST[(size_t)E2 * 32768 + p2] = tok; LISTW[(size_t)E2 * 32768 + p2] = __uint_as_float(tr[5]);
    u32x4 rt; rt[0] = E1; rt[1] = p1; rt[2] = E2; rt[3] = p2;
    ROUTE[tok] = rt;
  }
}

template <bool GATHER_> struct MoeOrder {
  static constexpr bool GATHER = GATHER_;
  unsigned char* ws; int ntn, K, G, c;
  DEVI bool next(int i, g8::Unit& u) const {
    const unsigned* cnt = (const unsigned*)(ws + WS_CNT);
    int it = i * G + c, off = 0, e = 0, cn = 0; bool found = false;
    for (e = 0; e < 32; ++e) { cn = (int)cnt[e]; const int nti = ((cn + 255) >> 8) * ntn; if (it < nti) { found = true; break; } it -= nti; off += cn; }
    if (!found) return false;
    u.e = e; u.pm = it / ntn; u.pn = it % ntn; u.cnt = cn; u.off = off;
    const int tid = threadIdx.x;
    if (GATHER_) {
      const unsigned* list = (const unsigned*)(ws + WS_LIST) + (size_t)e * 32768;
      u.A = (const char*)(ws + WS_H);
      u.B = (const char*)((const h16*)(ws + WS_WGU) + ((size_t)e * 512 + u.pn * 256) * DM);
#pragma unroll
      for (int h = 0; h < 2; ++h)
#pragma unroll
        for (int i2 = 0; i2 < 2; ++i2) {
          int R, C; g8::stage_rc(tid * 16 + i2 * 8192, R, C);
          const int row = u.pm * 256 + 128 * h + R;
          const unsigned t = (row < cn) ? list[row] : 0u;
          u.va[h][i2] = (t * (unsigned)DM + (unsigned)C) * 2u;
        }
    } else {
      u.A = (const char*)((const h16*)(ws + WS_ACT) + ((size_t)off + u.pm * 256) * 256);
      u.B = (const char*)((const h16*)(ws + WS_WDN) + ((size_t)e * 1024 + u.pn * 256) * 256);
      u.va[0][0] = u.va[0][1] = u.va[1][0] = u.va[1][1] = 0u;
    }
    return true;
  }
};
struct EpiAct {
  unsigned char* ws;
  DEVI void operator()(const f32x4 (&acc)[2][2][4][2], const g8::Unit& u, int wr, int wc, int fr, int fq) const {
    const float* lw = (const float*)(ws + WS_LISTW) + (size_t)u.e * 32768; h16* act = (h16*)(ws + WS_ACT);
#pragma unroll
    for (int ai = 0; ai < 2; ++ai)
#pragma unroll
      for (int m = 0; m < 4; ++m) {
        const int r = u.pm * 256 + 128 * ai + 64 * wr + 16 * m + fr;
        if (r < u.cnt) {
          const float w = lw[r];
#pragma unroll
          for (int bj = 0; bj < 2; ++bj) {
            const f32x4 g = acc[ai][bj][m][0], up = acc[ai][bj][m][1];
            float v[4];
#pragma unroll
            for (int e = 0; e < 4; ++e) v[e] = g[e] * __builtin_amdgcn_rcpf(1.f + __expf(-g[e])) * up[e] * w;
            *(h16x4*)(act + (size_t)(u.off + r) * 256 + 16 * (8 * u.pn + 4 * bj + wc) + 4 * fq) = pack4(v[0], v[1], v[2], v[3]);
          }
        }
      }
  }
};
struct EpiYp {
  h16* dst;
  DEVI void operator()(const f32x4 (&acc)[2][2][4][2], const g8::Unit& u, int wr, int wc, int fr, int fq) const {
#pragma unroll
    for (int ai = 0; ai < 2; ++ai)
#pragma unroll
      for (int m = 0; m < 4; ++m) {
        const int r = u.pm * 256 + 128 * ai + 64 * wr + 16 * m + fr;
        if (r < u.cnt) {
          h16* d = dst + (size_t)(u.off + r) * DM + u.pn * 256 + 32 * wc + 4 * fq;
#pragma unroll
          for (int bj = 0; bj < 2; ++bj)
#pragma unroll
            for (int n = 0; n < 2; ++n) { const f32x4 v = acc[ai][bj][m][n]; *(h16x4*)(d + 128 * bj + 16 * n) = pack4(v[0], v[1], v[2], v[3]); }
        }
      }
  }
};
DEVI void phase7(PRef p, LDS unsigned char* lds) {
  MoeOrder<true> S{p.ws, 2, DM, (int)gridDim.x, (int)blockIdx.x};
  EpiAct E{p.ws};
  g8::gemm_phase(lds, DM, S, E);
}
DEVI void phase8(PRef p, LDS unsigned char* lds) {
  MoeOrder<false> S{p.ws, 4, 256, (int)gridDim.x, (int)blockIdx.x};
  EpiYp E{(h16*)(p.ws + WS_YP)};
  g8::gemm_phase(lds, 256, S, E);
}

DEVI void phase9(PRef p, LDS unsigned char* lds) {
  const int tid = launder((int)threadIdx.x), lane = tid & 63, wave = wave_id(tid), G = gridDim.x;
  const int b = blockIdx.x & 3, bi = blockIdx.x >> 2, nbk = G >> 2;
  LDS unsigned* offs = (LDS unsigned*)lds;
  if (tid == 0) { const unsigned* cnt = (const unsigned*)(p.ws + WS_CNT); unsigned o = 0; for (int e = 0; e < 32; ++e) { offs[e] = o; o += cnt[e]; } }
  __syncthreads();
  LDS float* mv = (LDS float*)(lds + 256);
  mod_to_lds(p, b, 5, mv);
  __syncthreads();
  f32x4 A3[4];
#pragma unroll
  for (int j = 0; j < 4; ++j) { const int k = 256 * j + 4 * lane; A3[j] = *(LDS f32x4*)(mv + k) * *(const f32x4*)(p.in[7] + k); }
  const h16* YP = (const h16*)(p.ws + WS_YP); const u32x4* ROUTE = (const u32x4*)(p.ws + WS_ROUTE); float* out = p.out; const h16* X1h = (const h16*)(p.ws + WS_MIX);
  const int rstep = nbk * 8, r_first = bi * 8 + wave;
  const int nrow = (SEQ - r_first + rstep - 1) / rstep;
  unsigned R0 = 0u, R1 = 0u;
  if (lane < nrow) { const u32x4 rt = ROUTE[(size_t)b * SEQ + r_first + rstep * lane]; R0 = offs[rt[0]] + rt[1]; R1 = offs[rt[2]] + rt[3]; }
  h16x4 ya[4], yc[4]; f32x4 xv[4];
  {
    const size_t tok = (size_t)b * SEQ + r_first; const size_t r0 = __builtin_amdgcn_readlane(R0, 0), r1 = __builtin_amdgcn_readlane(R1, 0);
#pragma unroll
    for (int j = 0; j < 4; ++j) { ya[j] = *(const h16x4*)(YP + r0 * DM + 256 * j + 4 * lane); yc[j] = *(const h16x4*)(YP + r1 * DM + 256 * j + 4 * lane); { const h16x4 xh = *(const h16x4*)(X1h + tok * DM + 256 * j + 4 * lane); xv[j] = (f32x4){(float)xh[0], (float)xh[1], (float)xh[2], (float)xh[3]}; } }
  }
  for (int i = 0; i < nrow; ++i) {
    const size_t tok = (size_t)b * SEQ + r_first + rstep * i;
    h16x4 na[4], nc[4]; f32x4 nx[4];
    if (i + 1 < nrow) {
      const size_t r0 = __builtin_amdgcn_readlane(R0, i + 1), r1 = __builtin_amdgcn_readlane(R1, i + 1);
#pragma unroll
      for (int j = 0; j < 4; ++j) { na[j] = *(const h16x4*)(YP + r0 * DM + 256 * j + 4 * lane); nc[j] = *(const h16x4*)(YP + r1 * DM + 256 * j + 4 * lane); { const h16x4 xh = *(const h16x4*)(X1h + (tok + rstep) * DM + 256 * j + 4 * lane); nx[j] = (f32x4){(float)xh[0], (float)xh[1], (float)xh[2], (float)xh[3]}; } }
    }
    f32x4 y[4]; float ss = 0.f;
#pragma unroll
    for (int j = 0; j < 4; ++j)
#pragma unroll
      for (int e = 0; e < 4; ++e) { y[j][e] = (float)ya[j][e] + (float)yc[j][e]; ss += y[j][e] * y[j][e]; }
    const float rs = 1.0f / sqrtf(wave_sum(ss) * (1.f / 1024.f) + 1e-6f);
#pragma unroll
    for (int j = 0; j < 4; ++j) *(f32x4*)(out + tok * DM + 256 * j + 4 * lane) = xv[j] + A3[j] * (y[j] * rs);
    if (i + 1 < nrow) {
#pragma unroll
      for (int j = 0; j < 4; ++j) { ya[j] = na[j]; yc[j] = nc[j]; xv[j] = nx[j]; }
    }
  }
}

#define XB_TMO      128
#define XB_XCNT(j)  (256  + 64 * (j))
#define XB_XSUB(j)  (1280 + 64 * (j))
#define XB_XGEN(j)  (2304 + 64 * (j))
#define XB_TOP      3328
#define XB_TOPGEN   3392
#define XB_SPIN_CAP (1u << 22)
DEVI unsigned xb_ld(unsigned* p)              { return __hip_atomic_load(p, __ATOMIC_RELAXED, __HIP_MEMORY_SCOPE_AGENT); }
DEVI unsigned xb_add(unsigned* p, unsigned v) { return __hip_atomic_fetch_add(p, v, __ATOMIC_RELAXED, __HIP_MEMORY_SCOPE_AGENT); }
DEVI unsigned xb_xcc_id() { return (unsigned)__builtin_amdgcn_s_getreg((3 << 11) | 20) & 0xFu; }
#define XB_SPIN(cond, bar) do { unsigned _sp = 0; while (cond) { __builtin_amdgcn_s_sleep(1); \
    if ((++_sp & 255u) == 0u) { if (xb_ld(&(bar)[XB_TMO])) break; if (_sp > XB_SPIN_CAP) { atomicAdd(&(bar)[XB_TMO], 1u); break; } } } } while (0)
struct XcdBarrier { unsigned* bar; unsigned x; volatile LDS unsigned* st; };
DEVI XcdBarrier xcd_barrier_post(unsigned* bar, volatile LDS unsigned* st) {
  XcdBarrier b; b.bar = bar; b.x = xb_xcc_id(); b.st = st;
  if (threadIdx.x == 0) (void)xb_add(&bar[XB_XCNT(b.x)], 1u);
  return b;
}
DEVI void xcd_barrier_complete(unsigned* bar, unsigned x, unsigned& nloc, unsigned& nx) {
  const unsigned G = gridDim.x * gridDim.y * gridDim.z;
  unsigned sum, cnt, mine, sp = 0u;
  for (;;) {
    sum = 0u; cnt = 0u; mine = 0u;
#pragma unroll
    for (unsigned j = 0; j < 16; ++j) { const unsigned c = xb_ld(&bar[XB_XCNT(j)]); sum += c; cnt += (c > 0u) ? 1u : 0u; mine = (j == x) ? c : mine; }
    if (sum == G) break;
    __builtin_amdgcn_s_sleep(1);
    if ((++sp & 255u) == 0u) { if (xb_ld(&bar[XB_TMO])) break; if (sp > XB_SPIN_CAP) { atomicAdd(&bar[XB_TMO], 1u); break; } }
  }
  nloc = mine > 0u ? mine : 1u; nx = cnt > 0u ? cnt : 1u;
}
DEVI void xcd_barrier(const XcdBarrier& b) {
  asm volatile("s_waitcnt vmcnt(0)" ::: "memory");
  __syncthreads();
  if (threadIdx.x == 0) {
    unsigned* bar = b.bar;
    __builtin_amdgcn_s_waitcnt(0);
    unsigned nloc = b.st[0], nx = b.st[1];
    if (nloc == 0u) { xcd_barrier_complete(bar, b.x, nloc, nx); b.st[0] = nloc; b.st[1] = nx; }
    const unsigned old = xb_add(&bar[XB_XSUB(b.x)], 1u);
    const unsigned gen = old / nloc;
    if (old + 1u == (gen + 1u) * nloc) {
      __builtin_amdgcn_fence(__ATOMIC_RELEASE, "agent");
      asm volatile("s_waitcnt vmcnt(0)" ::: "memory");
      const unsigned og = xb_add(&bar[XB_TOP], 1u);
      const unsigned tg = og / nx;
      if (og + 1u == (tg + 1u) * nx) xb_add(&bar[XB_TOPGEN], 1u);
      else XB_SPIN(xb_ld(&bar[XB_TOPGEN]) == tg, bar);
      __builtin_amdgcn_fence(__ATOMIC_ACQUIRE, "agent");
      xb_add(&bar[XB_XGEN(b.x)], 1u);
      asm volatile("s_waitcnt vmcnt(0)" ::: "memory");
    } else {
      XB_SPIN(xb_ld(&bar[XB_XGEN(b.x)]) == gen, bar);
      __builtin_amdgcn_fence(__ATOMIC_ACQUIRE, "agent");
      asm volatile("s_waitcnt vmcnt(0)" ::: "memory");
    }
  }
  __syncthreads();
}

__global__ void __launch_bounds__(NTHR) fwd_kernel(Params p) {
  extern __shared__ __attribute__((aligned(16))) unsigned char smem[];
  LDS unsigned char* lds = (LDS unsigned char*)smem;
  const int lo = p.ph_lo, hi = p.ph_hi;
  volatile LDS unsigned* bst = (volatile LDS unsigned*)(lds + LDS_BYTES - 16);
  if (threadIdx.x < 4) bst[threadIdx.x] = 0u;
  __syncthreads();
  (void)xcd_barrier_post((unsigned*)(p.ws + WS_BAR), bst);
#ifndef REPEAT_PHASE
#define REPEAT_PHASE -1
#endif
#define GRID_SYNC(k) do { { XcdBarrier xb_; xb_.bar = (unsigned*)(get_params()->ws + WS_BAR); xb_.x = xb_xcc_id(); xb_.st = (volatile LDS unsigned*)(lds + LDS_BYTES - 16); xcd_barrier(xb_); } } while (0)
#define RUN_PHASE(k, fn) if (lo <= (k) && (k) < hi) { fn(*get_params(), lds); if ((k) == REPEAT_PHASE) { GRID_SYNC(k); fn(*get_params(), lds); } if ((k) + 1 < hi) GRID_SYNC(k); }
  RUN_PHASE(0, phase0)
  RUN_PHASE(1, phase1)
  RUN_PHASE(2, phase2)
  RUN_PHASE(3, phase3)
  RUN_PHASE(4, phase4)
  RUN_PHASE(5, phase5)
  RUN_PHASE(6, phase6)
  RUN_PHASE(7, phase7)
  RUN_PHASE(8, phase8)
  RUN_PHASE(9, phase9)
#undef GRID_SYNC
#undef RUN_PHASE
}

extern "C" void kernel_launch(void* const* d_in, const int* in_sizes, int n_in, void* d_out, int out_size, void* d_ws, size_t ws_size, hipStream_t stream) {
  static int grid = 0;
  if (grid == 0) {
    if (n_in != 24 || out_size != NTOK * DM || ws_size < WS_END) { fprintf(stderr, "kernel_launch: unexpected problem (n_in %d out %d ws %zu)\n", n_in, out_size, ws_size); grid = -1; return; }
    (void)hipFuncSetAttribute((const void*)fwd_kernel, hipFuncAttributeMaxDynamicSharedMemorySize, LDS_BYTES);
    int dev = 0, cus = 0, per_cu = 0;
    (void)hipGetDevice(&dev);
    (void)hipDeviceGetAttribute(&cus, hipDeviceAttributeMultiprocessorCount, dev);
    (void)hipOccupancyMaxActiveBlocksPerMultiprocessor(&per_cu, (const void*)fwd_kernel, NTHR, LDS_BYTES);
    if (per_cu < 1 || cus < 256) fprintf(stderr, "kernel_launch: occupancy %d blocks/CU on %d CUs\n", per_cu, cus);
    grid = 256;
  }
  if (grid < 0) return;
  (void)hipMemsetAsync((char*)d_ws + WS_CNT, 0, CTL_ZERO_BYTES, stream);
  Params p{};
  for (int i = 0; i < 24; ++i) p.in[i] = (const float*)d_in[i];
  p.out = (float*)d_out; p.ws = (unsigned char*)d_ws;
#if N_LAUNCH_MODE == 1
  p.ph_lo = 0; p.ph_hi = NPHASE;
  void* args[] = {&p};
  hipError_t e = hipLaunchCooperativeKernel((const void*)fwd_kernel, dim3(grid), dim3(NTHR), args, LDS_BYTES, stream);
  if (e != hipSuccess) fprintf(stderr, "cooperative launch failed: %s\n", hipGetErrorString(e));
#else
  for (int ph = 0; ph < NPHASE; ++ph) {
    p.ph_lo = ph; p.ph_hi = ph + 1;
    hipLaunchKernelGGL(fwd_kernel, dim3(grid), dim3(NTHR), LDS_BYTES, stream, p);
  }
#endif
}
```

```cpp
#include <hip/hip_runtime.h>
#include <cstdio>
#include <cstdint>

#ifndef N_LAUNCH_MODE
#define N_LAUNCH_MODE 1
#endif

#define DEVI __device__ __forceinline__
#define LDS __attribute__((address_space(3)))

typedef _Float16 h16;
typedef _Float16 h16x4 __attribute__((ext_vector_type(4)));
typedef _Float16 h16x8 __attribute__((ext_vector_type(8)));
typedef float f32x4 __attribute__((ext_vector_type(4)));
typedef float f32x16 __attribute__((ext_vector_type(16)));
typedef unsigned u32x2 __attribute__((ext_vector_type(2)));
typedef unsigned u32x4 __attribute__((ext_vector_type(4)));

constexpr int NBATCH = 4, SEQ = 8192, NTOK = NBATCH * SEQ, DM = 1024;
constexpr int NTHR = 512;
constexpr int NPHASE = 10;
constexpr int LDS_BYTES = 163840;

constexpr size_t MiB = 1ull << 20;
constexpr size_t WS_CNT = 0;
constexpr size_t CTL_ZERO_BYTES = 20480;
constexpr size_t WS_BAR = 4096;
constexpr size_t WS_MODP = 64 * 1024;
constexpr size_t WS_ROPE = 1 * MiB;
constexpr size_t WS_WIN = 3 * MiB;
constexpr size_t WS_WOUT = 10 * MiB;
constexpr size_t WS_WGU = 12 * MiB;
constexpr size_t WS_WDN = 44 * MiB;
constexpr size_t WS_WRG = 60 * MiB;
constexpr size_t WS_WRH = 60 * MiB + 512 * 1024;
constexpr size_t WS_WRL = 60 * MiB + 640 * 1024;
constexpr size_t WS_AGG = 61 * MiB;
constexpr size_t WS_ROUTE = 63 * MiB;
constexpr size_t WS_LIST = 64 * MiB;
constexpr size_t WS_LISTW = 68 * MiB;
constexpr size_t WS_WI = 72 * MiB;
constexpr size_t WS_KI = 73 * MiB;
constexpr size_t WS_MASK = 77 * MiB;
constexpr size_t WS_H = 109 * MiB;
constexpr size_t WS_Q = 173 * MiB;
constexpr size_t WS_K = 205 * MiB;
constexpr size_t WS_VT = 237 * MiB;
constexpr size_t WS_QI = 269 * MiB;
constexpr size_t WS_XR = 301 * MiB;
constexpr size_t WS_XG = 333 * MiB;
constexpr size_t WS_MIX = 365 * MiB;
constexpr size_t WS_ACT = 429 * MiB;
constexpr size_t WS_YP = 173 * MiB;
constexpr size_t WS_END = 510 * MiB;
constexpr size_t SC_BATCH_BYTES = 8192ull * 6176ull;
static_assert(SC_BATCH_BYTES <= 64 * MiB && WS_MIX + 3 * SC_BATCH_BYTES <= WS_END, "score slots");

struct Params { const float* in[24]; float* out; unsigned char* ws; int ph_lo, ph_hi; };
typedef const __attribute__((address_space(4))) Params& PRef;
typedef const __attribute__((address_space(4))) Params* PPtr;

__device__ const double ROPE_REV[32] = {
  1.59154943091895345608e-01, 1.19349370211248861917e-01, 8.94994016088910132600e-02, 6.71150830052272551196e-02,
  5.03292121044870352509e-02, 3.77415847174197710556e-02, 2.83021958306233986646e-02, 2.12236527647776604399e-02,
  1.59154943091895338669e-02, 1.19349370211248861917e-02, 8.94994016088910236684e-03, 6.71150830052272533849e-03,
  5.03292121044870369856e-03, 3.77415847174197719230e-03, 2.83021958306233986646e-03, 2.12236527647776621747e-03,
  1.59154943091895356017e-03, 1.19349370211248848907e-03, 8.94994016088910236684e-04, 6.71150830052272598901e-04,
  5.03292121044870326488e-04, 3.77415847174197740914e-04, 2.83021958306233954120e-04, 2.12236527647776605484e-04,
  1.59154943091895350596e-04, 1.19349370211248862459e-04, 8.94994016088910182474e-05, 6.71150830052272544691e-05,
  5.03292121044870353593e-05, 3.77415847174197768019e-05, 2.83021958306233960897e-05, 2.12236527647776591931e-05};

DEVI int launder(int x) { asm volatile("" : "+v"(x)); return x; }
DEVI PPtr get_params() { PPtr k = (PPtr)__builtin_amdgcn_kernarg_segment_ptr(); asm volatile("" : "+s"(k)); return k; }
DEVI int wave_id(int tid) { return __builtin_amdgcn_readfirstlane(tid >> 6); }
DEVI f32x16 mfma16(h16x8 a, h16x8 b, f32x16 c) { return __builtin_amdgcn_mfma_f32_32x32x16_f16(a, b, c, 0, 0, 0); }
DEVI float wave_sum(float v) {
#pragma unroll
  for (int o = 1; o < 64; o <<= 1) v += __shfl_xor(v, o);
  return v;
}
DEVI float sigmoid_f(float x) { return __builtin_amdgcn_rcpf(1.f + __expf(-x)); }
DEVI float silu_f(float x) { return x * __builtin_amdgcn_rcpf(1.f + __expf(-x)); }
DEVI float gelu_tanh_f(float x) {
  const float u = 0.7978845608028654f * (x + 0.044715f * x * x * x);
  const float t = 1.f - 2.f * __builtin_amdgcn_rcpf(1.f + __expf(2.f * u));
  return 0.5f * x * (1.f + t);
}
DEVI unsigned fkey(float f) { unsigned u = __float_as_uint(f); return (u & 0x80000000u) ? ~u : (u | 0x80000000u); }
DEVI float fkey_inv(unsigned k) { unsigned u = (k & 0x80000000u) ? (k & 0x7fffffffu) : ~k; return __uint_as_float(u); }
DEVI int vt_perm(int pos) { return (pos & ~12) | ((pos & 4) << 1) | ((pos & 8) >> 1); }

DEVI void mod_to_lds(PRef p, int b, int chunk, LDS float* dst) {
  const float* mp = (const float*)(p.ws + WS_MODP);
  for (int k = threadIdx.x; k < 1024; k += NTHR) {
    const int j = chunk * 1024 + k;
    float v[8];
#pragma unroll
    for (int ks = 0; ks < 8; ++ks) v[ks] = mp[(size_t)(ks * 4 + b) * 6144 + j];
    float s = p.in[3][j];
#pragma unroll
    for (int ks = 0; ks < 8; ++ks) s += v[ks];
    dst[k] = s;
  }
}

constexpr int LROW = 144;

namespace g8 {
constexpr int BM = 256, BK = 64, HALF = 128, HTB = HALF * BK * 2, STAGE_BYTES = 8 * HTB;
DEVI int lds_byte(int r, int c) { const int st = (r >> 4) * 2 + (c >> 5), rr = r & 15, cc = c & 31, ob = rr * 64 + cc * 2; return st * 1024 + (ob ^ (((ob >> 9) & 1) << 5)); }
DEVI void stage_rc(int b, int& R, int& C) { const int st = b / 1024, sb = b % 1024, swz = sb ^ (((sb >> 9) & 1) << 5); R = (st >> 1) * 16 + swz / 64; C = (st & 1) * 32 + (swz % 64) / 2; }
struct Unit { const char* A; unsigned va[2][2]; const char* B; int pm, pn, e, cnt, off; };
DEVI void glds16(const char* src, LDS unsigned char* dst) { __builtin_amdgcn_global_load_lds((const unsigned*)src, (LDS unsigned*)dst, 16, 0, 0); }

DEVI void dense_va(unsigned (&va)[2][2], int K) {
  const int tid = threadIdx.x;
#pragma unroll
  for (int h = 0; h < 2; ++h)
#pragma unroll
    for (int i = 0; i < 2; ++i) { int R, C; stage_rc(tid * 16 + i * 8192, R, C); va[h][i] = (unsigned)((128 * h + R) * K + C) * 2u; }
}
template <class Sched, class Epi>
DEVI void gemm_phase(LDS unsigned char* lds, int K, const Sched& S, const Epi& E) {
  const int tid = launder((int)threadIdx.x), wid = wave_id(tid), lane = tid & 63, wr = wid >> 2, wc = wid & 3, fr = lane & 15, fq = lane >> 4;
  const int nt = launder(K) / BK;
  unsigned vb[2];
#pragma unroll
  for (int i = 0; i < 2; ++i) { int R, C; stage_rc(tid * 16 + i * 8192, R, C); vb[i] = (unsigned)(R * K + C) * 2u; }
  const size_t kstep = (size_t)(BK * 2), hstep = (size_t)HALF * K * 2;
  const unsigned ldsw = (unsigned)wid * 1024u;
  const int aoff = lds_byte(wr * 64 + fr, fq * 8), boff = lds_byte(wc * 32 + fr, fq * 8);
#define G8_SA(b, h) (((b) * 2 + (h)) * HTB)
#define G8_SB(b, h) ((4 + (b) * 2 + (h)) * HTB)
#define G8_STAGE(bufoff, gbase, v) do { glds16((gbase) + (v)[0], lds + (bufoff) + ldsw); glds16((gbase) + (v)[1], lds + (bufoff) + ldsw + 8192); } while (0)
#define G8_STAGEA(bufoff, gbase, h) do { glds16((gbase) + G8_VAC(h, 0), lds + (bufoff) + ldsw); glds16((gbase) + G8_VAC(h, 1), lds + (bufoff) + ldsw + 8192); } while (0)
#define G8_LDA(dst, b, h) do { _Pragma("unroll") for (int m = 0; m < 4; ++m) _Pragma("unroll") for (int k = 0; k < 2; ++k) dst[m][k] = *(const LDS h16x8*)(lds + G8_SA(b, h) + aoff + m * 2048 + k * 1024); } while (0)
#define G8_LDB(dst, b, h) do { _Pragma("unroll") for (int n = 0; n < 2; ++n) _Pragma("unroll") for (int k = 0; k < 2; ++k) dst[n][k] = *(const LDS h16x8*)(lds + G8_SB(b, h) + boff + n * 2048 + k * 1024); } while (0)
#define G8_MMA(ai, bj, At, Bt) do { __builtin_amdgcn_s_setprio(1); _Pragma("unroll") for (int m = 0; m < 4; ++m) _Pragma("unroll") for (int n = 0; n < 2; ++n) _Pragma("unroll") for (int k = 0; k < 2; ++k) \
        acc[ai][bj][m][n] = __builtin_amdgcn_mfma_f32_16x16x32_f16(Bt[n][k], At[m][k], acc[ai][bj][m][n], 0, 0, 0); __builtin_amdgcn_s_setprio(0); } while (0)
#define G8_WAIT_V(n) asm volatile("s_waitcnt vmcnt(" #n ")" ::: "memory")
#define G8_WAIT_L(n) asm volatile("s_waitcnt lgkmcnt(" #n ")" ::: "memory")
#define G8_BAR __builtin_amdgcn_s_barrier()
#define G8_SCHED __builtin_amdgcn_sched_barrier(0)
  Unit cur, nxt; int ui = 0;
  if (!S.next(0, cur)) return;
  unsigned vd[2][2];
  if (!Sched::GATHER) dense_va(vd, K);
#define G8_VAC(h, i) (Sched::GATHER ? cur.va[h][i] : vd[h][i])
#define G8_VAN(h, i) (Sched::GATHER ? nxt.va[h][i] : vd[h][i])
  f32x4 acc[2][2][4][2];
#pragma unroll
  for (int a = 0; a < 2; ++a)
#pragma unroll
    for (int b = 0; b < 2; ++b)
#pragma unroll
      for (int m = 0; m < 4; ++m)
#pragma unroll
        for (int n = 0; n < 2; ++n) acc[a][b][m][n] = (f32x4){0.f, 0.f, 0.f, 0.f};
  h16x8 At[4][2], B0[2][2], B1[2][2];
  const char* cA = cur.A; const char* cB = cur.B;
  G8_STAGE(G8_SB(0, 0), cB, vb); G8_STAGE(G8_SB(0, 1), cB + hstep, vb); G8_STAGEA(G8_SA(0, 0), cA, 0); G8_STAGEA(G8_SA(0, 1), cA, 1);
  if (wr == 1) G8_BAR;
  G8_WAIT_V(2); G8_BAR;
  G8_STAGE(G8_SB(1, 0), cB + kstep, vb); G8_STAGEA(G8_SA(1, 0), cA + kstep, 0); G8_STAGE(G8_SB(1, 1), cB + hstep + kstep, vb);
  G8_WAIT_V(6); G8_BAR;
  for (;;) {
    const bool has_next = S.next(ui + 1, nxt);
    if (!has_next) nxt = cur;
    const char* nA = nxt.A; const char* nB = nxt.B;
#pragma unroll 1
    for (int t = 0; t < nt; t += 2) {
      const bool last = (t == nt - 2);
      const char* a1 = cA + (size_t)(t + 1) * kstep;
      const char* a2 = last ? nA : cA + (size_t)(t + 2) * kstep; const char* b2 = last ? nB : cB + (size_t)(t + 2) * kstep;
      const char* a3 = a2 + kstep; const char* b3 = b2 + kstep;
#define G8_STAGE2(bufoff, gbase, h) do { glds16((gbase) + (last ? G8_VAN(h, 0) : G8_VAC(h, 0)), lds + (bufoff) + ldsw); glds16((gbase) + (last ? G8_VAN(h, 1) : G8_VAC(h, 1)), lds + (bufoff) + ldsw + 8192); } while (0)
      G8_LDB(B0, 0, 0); G8_LDB(B1, 0, 1); G8_SCHED; G8_LDA(At, 0, 0); G8_STAGEA(G8_SA(1, 1), a1, 1);
      G8_WAIT_V(8); G8_WAIT_L(0); G8_BAR; G8_MMA(0, 0, At, B0); G8_MMA(0, 1, At, B1); G8_BAR; G8_SCHED;
      G8_LDA(At, 0, 1); G8_STAGE(G8_SB(0, 0), b2, vb); G8_STAGE(G8_SB(0, 1), b2 + hstep, vb); G8_STAGE2(G8_SA(0, 0), a2, 0);
      G8_WAIT_V(8); G8_WAIT_L(0); G8_BAR; G8_MMA(1, 0, At, B0); G8_MMA(1, 1, At, B1); G8_BAR; G8_SCHED;
      G8_LDB(B0, 1, 0); G8_LDB(B1, 1, 1); G8_SCHED; G8_LDA(At, 1, 0); G8_STAGE2(G8_SA(0, 1), a2, 1);
      G8_WAIT_V(8); G8_WAIT_L(0); G8_BAR; G8_MMA(0, 0, At, B0); G8_MMA(0, 1, At, B1); G8_BAR; G8_SCHED;
      G8_LDA(At, 1, 1); G8_STAGE(G8_SB(1, 0), b3, vb); G8_STAGE(G8_SB(1, 1), b3 + hstep, vb); G8_STAGE2(G8_SA(1, 0), a3, 0);
      G8_WAIT_V(8); G8_WAIT_L(0); G8_BAR; G8_MMA(1, 0, At, B0); G8_MMA(1, 1, At, B1); G8_BAR; G8_SCHED;
    }
#undef G8_STAGE2
    if (wr == 0) G8_BAR;
    E(acc, cur, wr, wc, fr, fq);
    if (!has_next) break;
#pragma unroll
    for (int a = 0; a < 2; ++a)
#pragma unroll
      for (int b = 0; b < 2; ++b)
#pragma unroll
        for (int m = 0; m < 4; ++m)
#pragma unroll
          for (int n = 0; n < 2; ++n) acc[a][b][m][n] = (f32x4){0.f, 0.f, 0.f, 0.f};
    cur = nxt; cA = nA; cB = nB; ++ui;
    if (wr == 1) G8_BAR;
  }
  G8_WAIT_V(0);
  G8_BAR;
#undef G8_SA
#undef G8_STAGEA
#undef G8_VAC
#undef G8_VAN
#undef G8_SB
#undef G8_STAGE
#undef G8_LDA
#undef G8_LDB
#undef G8_MMA
#undef G8_WAIT_V
#undef G8_WAIT_L
#undef G8_BAR
#undef G8_SCHED
}
struct DenseOrder {
  static constexpr bool GATHER = false;
  const h16* A; const h16* Bt; int K, nM, nN, G, c;
  DEVI bool next(int i, Unit& u) const {
    const int nwg = nM * nN; const long L = (long)i * G + c; if (L >= nwg) return false;
    int wgid = (int)L; { const int q = nwg / 8, r = nwg % 8, xcd = wgid % 8, off = wgid / 8; wgid = (xcd < r ? xcd * (q + 1) : r * (q + 1) + (xcd - r) * q) + off; }
    const int nig = 8 * nN, gid = wgid / nig, fm = gid * 8, gsz = (nM - fm) < 8 ? (nM - fm) : 8;
    u.pm = fm + ((wgid % nig) % gsz); u.pn = (wgid % nig) / gsz; u.e = 0; u.cnt = 0x7fffffff; u.off = 0;
    u.A = (const char*)(A + (size_t)u.pm * 256 * K); u.B = (const char*)(Bt + (size_t)u.pn * 256 * K);
    u.va[0][0] = u.va[0][1] = u.va[1][0] = u.va[1][1] = 0u;
    return true;
  }
};
}


DEVI h16x4 pack4(float a, float b, float c, float d) { h16x4 v; v[0] = (h16)a; v[1] = (h16)b; v[2] = (h16)c; v[3] = (h16)d; return v; }

template <class F>
DEVI void transpose_item(const float* src, int N, int kb, int nb, h16* dst, int ldd, F drow, LDS float* scr, int lane) {
#pragma unroll 8
  for (int i = 0; i < 32; ++i) {
    const int kk = 2 * i + (lane >> 5), n = nb * 32 + (lane & 31);
    scr[kk * 33 + (lane & 31)] = (n < N) ? src[(size_t)(kb * 64 + kk) * N + n] : 0.f;
  }
  asm volatile("s_waitcnt lgkmcnt(0)" ::: "memory");
  const int c = lane & 7;
#pragma unroll
  for (int j = 0; j < 4; ++j) {
    const int nl = (lane >> 3) + 8 * j, n = nb * 32 + nl;
    h16x8 v;
#pragma unroll
    for (int e = 0; e < 8; ++e) v[e] = (h16)scr[(c * 8 + e) * 33 + nl];
    if (n < N) *(h16x8*)(dst + (size_t)drow(n) * ldd + kb * 64 + c * 8) = v;
  }
  asm volatile("s_waitcnt lgkmcnt(0)" ::: "memory");
}

DEVI void phase0(PRef p, LDS unsigned char* lds) {
  const int tid = launder((int)threadIdx.x), lane = tid & 63, wave = wave_id(tid), G = gridDim.x;
  const int gw = blockIdx.x * 8 + wave, NW = G * 8;
  {
    const float* c = p.in[1]; const float* wada = p.in[2]; float* mp = (float*)(p.ws + WS_MODP);
    for (int u = gw; u < 96 * 8; u += NW) {
      const int cgp = u % 96, ks = u / 96, j = cgp * 64 + lane;
      float a0 = 0.f, a1 = 0.f, a2 = 0.f, a3 = 0.f;
      for (int k0 = ks * 128; k0 < ks * 128 + 128; k0 += 16) {
        float w[16];
#pragma unroll
        for (int u = 0; u < 16; ++u) w[u] = wada[(size_t)(k0 + u) * 6144 + j];
#pragma unroll
        for (int u = 0; u < 16; ++u) {
          const int k = k0 + u;
          a0 = fmaf(silu_f(c[k]), w[u], a0); a1 = fmaf(silu_f(c[1024 + k]), w[u], a1);
          a2 = fmaf(silu_f(c[2048 + k]), w[u], a2); a3 = fmaf(silu_f(c[3072 + k]), w[u], a3);
        }
      }
      mp[(size_t)(ks * 4 + 0) * 6144 + j] = a0; mp[(size_t)(ks * 4 + 1) * 6144 + j] = a1;
      mp[(size_t)(ks * 4 + 2) * 6144 + j] = a2; mp[(size_t)(ks * 4 + 3) * 6144 + j] = a3;
    }
  }
  {
    LDS float* scr = (LDS float*)lds + wave * (64 * 33);
    constexpr int I_IN = 16 * 99, I_OUT = 16 * 32, I_G = 32 * 128, I_U = 32 * 128, I_D = 32 * 128, I_RG = 32;
    constexpr int NIT = I_IN + I_OUT + I_G + I_U + I_D + I_RG;
    for (int it = gw; it < NIT; it += NW) {
      int r = it;
      if (r < I_IN) {
        transpose_item(p.in[8], 3144, r / 99, r % 99, (h16*)(p.ws + WS_WIN), 1024,
                       [](int n) { const int dl = n < 2112 ? n : (n < 2120 ? 3136 + (n - 2112) : (n < 2632 ? 2112 + (n - 2120) : 2624 + (n - 2632))); const int d = dl & 63; return (dl & ~63) + 32 * ((d >> 4) & 1) + 16 * (d >> 5) + (d & 15); }, scr, lane);
        continue;
      }
      r -= I_IN;
      if (r < I_OUT) { transpose_item(p.in[16], 1024, r / 32, r % 32, (h16*)(p.ws + WS_WOUT), 1024, [](int n) { return n; }, scr, lane); continue; }
      r -= I_OUT;
      if (r < I_G) { const int e = r >> 7, q = r & 127;
        transpose_item(p.in[21] + (size_t)e * 1024 * 256, 256, q >> 3, q & 7, (h16*)(p.ws + WS_WGU) + (size_t)e * 512 * 1024, 1024, [](int f) { return (f >> 4) * 32 + (f & 15); }, scr, lane); continue; }
      r -= I_G;
      if (r < I_U) { const int e = r >> 7, q = r & 127;
        transpose_item(p.in[22] + (size_t)e * 1024 * 256, 256, q >> 3, q & 7, (h16*)(p.ws + WS_WGU) + (size_t)e * 512 * 1024, 1024, [](int f) { return (f >> 4) * 32 + 16 + (f & 15); }, scr, lane); continue; }
      r -= I_U;
      if (r < I_D) { const int e = r >> 7, q = r & 127;
        transpose_item(p.in[23] + (size_t)e * 256 * 1024, 1024, q >> 5, q & 31, (h16*)(p.ws + WS_WDN) + (size_t)e * 1024 * 256, 256, [](int n) { return n; }, scr, lane); continue; }
      r -= I_D;
      if (r < 16) transpose_item(p.in[11] + (size_t)(r >> 1) * 4096, 64, 0, r & 1, (h16*)(p.ws + WS_WRG) + (size_t)(r >> 1) * 128 * 64, 64, [](int n) { return n; }, scr, lane);
      else transpose_item(p.in[13] + (size_t)((r - 16) >> 1) * 4096, 64, 0, r & 1, (h16*)(p.ws + WS_WRG) + (size_t)((r - 16) >> 1) * 128 * 64, 64, [](int n) { return 64 + n; }, scr, lane);
    }
  }
  {
    h16* wrh = (h16*)(p.ws + WS_WRH); h16* wrl = (h16*)(p.ws + WS_WRL);
    for (int i = blockIdx.x * NTHR + tid; i < 48 * 1024; i += G * NTHR) {
      const int col = i >> 10, k = i & 1023;
      const float w = (col < 4) ? p.in[17][k * 4 + col] : (col < 36 ? p.in[19][k * 32 + (col - 4)] : 0.f);
      const h16 hi = (h16)w;
      wrh[i] = hi; wrl[i] = (h16)(w - (float)hi);
    }
    float* ct = (float*)(p.ws + WS_ROPE); float* st = ct + 8192 * 32;
    for (int i = blockIdx.x * NTHR + tid; i < 8192 * 32; i += G * NTHR) {
      const int pos = i >> 5, f = i & 31;
      const double rev = (double)pos * ROPE_REV[f];
      const float fr = (float)(rev - __builtin_rint(rev));
      ct[i] = __builtin_amdgcn_cosf(fr); st[i] = __builtin_amdgcn_sinf(fr);
    }
  }
}

DEVI void phase1(PRef p, LDS unsigned char* lds) {
  const int tid = launder((int)threadIdx.x), lane = tid & 63, wave = wave_id(tid), G = gridDim.x;
  const int b = blockIdx.x & 3, bi = blockIdx.x >> 2, nbk = G >> 2;
  LDS float* mv = (LDS float*)lds;
  mod_to_lds(p, b, 0, mv); mod_to_lds(p, b, 1, mv + 1024);
  __syncthreads();
  f32x4 A[4], SH[4];
#pragma unroll
  for (int j = 0; j < 4; ++j) {
    const int k = 256 * j + 4 * lane;
    const f32x4 g = *(const f32x4*)(p.in[4] + k);
    A[j] = g * (*(LDS f32x4*)(mv + 1024 + k) + 1.f);
    SH[j] = *(LDS f32x4*)(mv + k);
  }
  const float* x = p.in[0]; h16* H = (h16*)(p.ws + WS_H);
  f32x4 vn[4];
  {
    const size_t tok = (size_t)b * SEQ + bi * 8 + wave;
#pragma unroll
    for (int j = 0; j < 4; ++j) vn[j] = *(const f32x4*)(x + tok * DM + 256 * j + 4 * lane);
  }
  for (int r = bi * 8 + wave; r < SEQ; r += nbk * 8) {
    const size_t tok = (size_t)b * SEQ + r;
    f32x4 v[4]; float ss = 0.f;
#pragma unroll
    for (int j = 0; j < 4; ++j) { v[j] = vn[j]; ss += v[j][0] * v[j][0] + v[j][1] * v[j][1] + v[j][2] * v[j][2] + v[j][3] * v[j][3]; }
    if (r + nbk * 8 < SEQ) {
#pragma unroll
      for (int j = 0; j < 4; ++j) vn[j] = *(const f32x4*)(x + (tok + nbk * 8) * DM + 256 * j + 4 * lane);
    }
    const float rstd = 1.0f / sqrtf(wave_sum(ss) * (1.f / 1024.f) + 1e-6f);
#pragma unroll
    for (int j = 0; j < 4; ++j) {
      const f32x4 y = v[j] * rstd * A[j] + SH[j];
      *(h16x4*)(H + tok * DM + 256 * j + 4 * lane) = pack4(y[0], y[1], y[2], y[3]);
    }
  }
}

struct EpiInProj {
  unsigned char* ws;
  DEVI void operator()(const f32x4 (&acc)[2][2][4][2], const g8::Unit& u, int wr, int wc, int fr, int fq) const {
    const float* cosT = (const float*)(ws + WS_ROPE); const float* sinT = cosT + 8192 * 32;
    const int w2 = wc & 1, dlow = 16 * w2 + 4 * fq;
#pragma unroll
    for (int bj = 0; bj < 2; ++bj) {
      const int g = 4 * u.pn + 2 * bj + (wc >> 1);
      if (g > 49) continue;
#pragma unroll
      for (int ai = 0; ai < 2; ++ai)
#pragma unroll
        for (int m = 0; m < 4; ++m) {
          const int tok = u.pm * 256 + 128 * ai + 64 * wr + 16 * m + fr;
          const int b = tok >> 13, pos = tok & 8191;
          const f32x4 x1 = acc[ai][bj][m][0], x2 = acc[ai][bj][m][1];
          if (g < 16 || (g >= 24 && g <= 32)) {
            float scl; h16* dst;
            if (g < 8) { scl = 0.125f * 1.4426950408889634f; dst = (h16*)(ws + WS_Q) + (size_t)tok * 512 + g * 64; }
            else if (g < 16) { scl = 1.f; dst = (h16*)(ws + WS_K) + (size_t)tok * 512 + (g - 8) * 64; }
            else if (g < 32) { scl = 0.125f; dst = (h16*)(ws + WS_QI) + (size_t)tok * 512 + (g - 24) * 64; }
            else { scl = 1.f; dst = (h16*)(ws + WS_KI) + (size_t)tok * 64; }
            const f32x4 c = *(const f32x4*)(cosT + pos * 32 + dlow), s = *(const f32x4*)(sinT + pos * 32 + dlow);
            const f32x4 o1 = (x1 * c - x2 * s) * scl, o2 = (x2 * c + x1 * s) * scl;
            *(h16x4*)(dst + dlow) = pack4(o1[0], o1[1], o1[2], o1[3]);
            *(h16x4*)(dst + 32 + dlow) = pack4(o2[0], o2[1], o2[2], o2[3]);
          } else if (g < 24) {
            h16* vt = (h16*)(ws + WS_VT) + (size_t)(b * 8 + (g - 16)) * 64 * 8192 + vt_perm(pos);
#pragma unroll
            for (int e = 0; e < 4; ++e) { vt[(size_t)(dlow + e) * 8192] = (h16)x1[e]; vt[(size_t)(32 + dlow + e) * 8192] = (h16)x2[e]; }
          } else if (g < 49) {
            h16* dst = (g < 41) ? (h16*)(ws + WS_XR) + (size_t)tok * 512 + (g - 33) * 64 : (h16*)(ws + WS_XG) + (size_t)tok * 512 + (g - 41) * 64;
            *(h16x4*)(dst + dlow) = pack4(x1[0], x1[1], x1[2], x1[3]);
            *(h16x4*)(dst + 32 + dlow) = pack4(x2[0], x2[1], x2[2], x2[3]);
          } else if (w2 == 0 && fq < 2) {
            const float sc = 0.35355339059327373f;
            *(f32x4*)((float*)(ws + WS_WI) + (size_t)tok * 8 + 4 * fq) = x1 * sc;
          }
        }
    }
  }
};

DEVI void phase2(PRef p, LDS unsigned char* lds) {
  g8::DenseOrder S{(const h16*)(p.ws + WS_H), (const h16*)(p.ws + WS_WIN), DM, 128, 13, (int)gridDim.x, (int)blockIdx.x};
  EpiInProj E{p.ws};
  g8::gemm_phase(lds, DM, S, E);
}

constexpr int CROW = 1040;
constexpr int RNN_XG = 64 * CROW;
constexpr int RNN_CARRY = 2 * 64 * CROW;
template <int MODE>
DEVI void rnn_item(PRef p, LDS unsigned char* lds, int b, int cr) {
  const int tid = launder((int)threadIdx.x), lane = tid & 63, wave = wave_id(tid), l31 = lane & 31, half = lane >> 5;
  const h16* XR = (const h16*)(p.ws + WS_XR);
  {
    const int chg = tid & 63, tg = tid >> 6, pos0 = cr * 64 + 8 * tg;
    h16x8 xin[11];
#pragma unroll
    for (int i = 0; i < 11; ++i) {
      const int pos = pos0 + i - 3;
      if (pos >= 0) xin[i] = *(const h16x8*)(XR + ((size_t)b * SEQ + pos) * 512 + chg * 8);
      else {
#pragma unroll
        for (int e = 0; e < 8; ++e) xin[i][e] = (h16)0.f;
      }
    }
    float cw[4][8], cb[8];
#pragma unroll
    for (int e = 0; e < 8; ++e) {
      cb[e] = p.in[10][chg * 8 + e];
#pragma unroll
      for (int j = 0; j < 4; ++j) cw[j][e] = p.in[9][j * 512 + chg * 8 + e];
    }
#pragma unroll
    for (int tt = 0; tt < 8; ++tt) {
      h16x8 o;
#pragma unroll
      for (int e = 0; e < 8; ++e) {
        float v = cb[e];
#pragma unroll
        for (int j = 0; j < 4; ++j) v = fmaf(cw[j][e], (float)xin[tt + j][e], v);
        o[e] = (h16)v;
      }
      *(LDS h16x8*)(lds + (8 * tg + tt) * CROW + chg * 16) = o;
    }
  }
  if (MODE == 1) {
    const float2* ag = (const float2*)(p.ws + WS_AGG) + (size_t)b * 128 * 512 + tid;
    float carry = 0.f; int c2 = 0;
    for (; c2 + 8 <= cr; c2 += 8) {
      float2 v[8];
#pragma unroll
      for (int u = 0; u < 8; ++u) v[u] = ag[(size_t)(c2 + u) * 512];
#pragma unroll
      for (int u = 0; u < 8; ++u) carry = fmaf(v[u].x, carry, v[u].y);
    }
    for (; c2 < cr; ++c2) { const float2 v = ag[(size_t)c2 * 512]; carry = fmaf(v.x, carry, v.y); }
    ((LDS float*)(lds + RNN_CARRY))[tid] = carry;
  }
  if (MODE == 1) {
    const h16* XG = (const h16*)(p.ws + WS_XG) + ((size_t)b * SEQ + cr * 64) * 512;
#pragma unroll
    for (int i = 0; i < 8; ++i) { const int c = tid + NTHR * i, row = c >> 6, cc = c & 63; *(LDS h16x8*)(lds + RNN_XG + row * CROW + cc * 16) = *(const h16x8*)(XG + (size_t)row * 512 + cc * 8); }
  }
  __syncthreads();
  const int n = wave;
  const h16* WRG = (const h16*)(p.ws + WS_WRG) + (size_t)n * 128 * 64;
  float* AGG = (float*)(p.ws + WS_AGG);
#pragma unroll 1
  for (int dt = 0; dt < 2; ++dt) {
    h16x8 wa[4], wx[4];
#pragma unroll
    for (int kk = 0; kk < 4; ++kk) {
      wa[kk] = *(const h16x8*)(WRG + (size_t)(32 * dt + l31) * 64 + 16 * kk + 8 * half);
      wx[kk] = *(const h16x8*)(WRG + (size_t)(64 + 32 * dt + l31) * 64 + 16 * kk + 8 * half);
    }
    f32x16 ra[2], rx[2];
#pragma unroll
    for (int ti = 0; ti < 2; ++ti) {
#pragma unroll
      for (int r = 0; r < 16; ++r) { ra[ti][r] = 0.f; rx[ti][r] = 0.f; }
#pragma unroll
      for (int kk = 0; kk < 4; ++kk) {
        const h16x8 af = *(LDS h16x8*)(lds + (32 * ti + l31) * CROW + (n * 64 + 16 * kk + 8 * half) * 2);
        ra[ti] = mfma16(af, wa[kk], ra[ti]);
        rx[ti] = mfma16(af, wx[kk], rx[ti]);
      }
    }
    const int ch = n * 64 + 32 * dt + l31;
    const float ba = p.in[12][ch], bx = p.in[14][ch], lam = p.in[15][ch];
    const float c8 = -8.f * log1pf(__expf(-lam));
#pragma unroll
    for (int ti = 0; ti < 2; ++ti)
#pragma unroll
      for (int r = 0; r < 16; ++r) {
        const int tk = 32 * ti + (r & 3) + 8 * (r >> 2) + 4 * half;
        const float cv = (float)*(LDS h16*)(lds + tk * CROW + ch * 2);
        const float rr = sigmoid_f(ra[ti][r] + ba), ii = sigmoid_f(rx[ti][r] + bx);
        const float la = c8 * rr;
        ra[ti][r] = __expf(la);
        const float x2 = 2.f * la;
        const float om = -x2 * fmaf(x2 * 0.5f, fmaf(x2 * (1.f / 3.f), fmaf(x2 * 0.25f, fmaf(x2, 0.2f, 1.f), 1.f), 1.f), 1.f);
        rx[ti][r] = __builtin_amdgcn_sqrtf(om) * (ii * cv);
      }
    float P[8], Hs[8];
#pragma unroll
    for (int sg = 0; sg < 8; ++sg) {
      const int ti = sg >> 2, q = sg & 3;
      float pp = 1.f, hh = 0.f;
#pragma unroll
      for (int i = 0; i < 4; ++i) { const float a = ra[ti][4 * q + i], bb = rx[ti][4 * q + i]; hh = fmaf(a, hh, bb); pp *= a; }
      P[sg] = pp; Hs[sg] = hh;
    }
    float carry = 0.f, prod = 1.f;
    if (MODE == 1) carry = ((LDS float*)(lds + RNN_CARRY))[ch];
    float cin[8];
#pragma unroll
    for (int sg = 0; sg < 8; ++sg)
#pragma unroll
      for (int ow = 0; ow < 2; ++ow) {
        const float tmp = fmaf(P[sg], carry, Hs[sg]);
        const float tp = P[sg] * prod;
        if (half == ow) cin[sg] = carry;
        const float oth = __shfl_xor(tmp, 32), otp = __shfl_xor(tp, 32);
        carry = (half == ow) ? tmp : oth;
        prod = (half == ow) ? tp : otp;
      }
    if (MODE == 0) {
      if (half == 0) { float* ag = AGG + ((size_t)(b * 128 + cr) * 512 + ch) * 2; ag[0] = prod; ag[1] = carry; }
    } else {
#pragma unroll
      for (int sg = 0; sg < 8; ++sg) {
        const int ti = sg >> 2, q = sg & 3;
        float hh = cin[sg];
#pragma unroll
        for (int i = 0; i < 4; ++i) {
          hh = fmaf(ra[ti][4 * q + i], hh, rx[ti][4 * q + i]);
          LDS h16* xp = (LDS h16*)(lds + RNN_XG + (32 * ti + 8 * q + 4 * half + i) * CROW + ch * 2);
          *xp = (h16)(hh * gelu_tanh_f((float)*xp));
        }
      }
    }
  }
  __syncthreads();
  if (MODE == 1) {
    h16* Y = (h16*)(p.ws + WS_H) + ((size_t)b * SEQ + cr * 64) * DM + 512;
#pragma unroll
    for (int i = 0; i < 8; ++i) { const int c = tid + NTHR * i, row = c >> 6, cc = c & 63; *(h16x8*)(Y + (size_t)row * DM + cc * 8) = *(LDS h16x8*)(lds + RNN_XG + row * CROW + cc * 16); }
    __syncthreads();
  }
}

constexpr int IDX_NB = 256, IDX_CAP = 128;
constexpr int IL_HIST = 0, IL_CS = 65536, IL_CK = IL_CS + 64 * IDX_CAP * 4, IL_KI = IL_CK + 64 * IDX_CAP * 2, IL_KISZ = 128 * LROW, IL_ST = IL_KI + 2 * IL_KISZ;
static_assert(IL_ST + 4096 <= LDS_BYTES, "indexer LDS map");

DEVI f32x4 mfma16s(h16x8 a, h16x8 b, f32x4 c) { return __builtin_amdgcn_mfma_f32_16x16x32_f16(a, b, c, 0, 0, 0); }
DEVI void idx_score(LDS unsigned char* kit, int kh, int l15, int g4, const h16x8 (&qf)[8][2], const float (&wq)[8], f32x4 (&sc)[4]) {
  h16x8 kf[4][2];
#pragma unroll
  for (int kt = 0; kt < 4; ++kt)
#pragma unroll
    for (int ks = 0; ks < 2; ++ks) kf[kt][ks] = *(LDS h16x8*)(kit + (64 * kh + 16 * kt + l15) * LROW + (4 * ks + g4) * 16);
#pragma unroll
  for (int kt = 0; kt < 4; ++kt) sc[kt] = (f32x4){0.f, 0.f, 0.f, 0.f};
  f32x4 accA[4], accB[4];
#define IDX_MM(ACC, h) _Pragma("unroll") for (int kt = 0; kt < 4; ++kt) { ACC[kt] = mfma16s(kf[kt][0], qf[h][0], (f32x4){0.f, 0.f, 0.f, 0.f}); ACC[kt] = mfma16s(kf[kt][1], qf[h][1], ACC[kt]); }
#define IDX_RS(ACC, h) _Pragma("unroll") for (int kt = 0; kt < 4; ++kt) _Pragma("unroll") for (int r = 0; r < 4; ++r) sc[kt][r] = __builtin_fmaf(wq[h], __int_as_float(max(__float_as_int(ACC[kt][r]), 0)), sc[kt][r]);
  IDX_MM(accA, 0)
  IDX_MM(accB, 1) IDX_RS(accA, 0)
  IDX_MM(accA, 2) IDX_RS(accB, 1)
  IDX_MM(accB, 3) IDX_RS(accA, 2)
  IDX_MM(accA, 4) IDX_RS(accB, 3)
  IDX_MM(accB, 5) IDX_RS(accA, 4)
  IDX_MM(accA, 6) IDX_RS(accB, 5)
  IDX_MM(accB, 7) IDX_RS(accA, 6)
  IDX_RS(accB, 7)
#undef IDX_MM
#undef IDX_RS
}

template <int MODE>
DEVI void idx_pass(LDS unsigned char* lds, const h16* KIb, int N, int stride, int qg, int kh,
                   const h16* QIrow0, const float* WIrow0, float qinv, float qoff, int bstar, h16* scbase) {
  const int tid = launder((int)threadIdx.x), lane = tid & 63, l15 = lane & 15, g4 = lane >> 4;
  const int q = 16 * qg + l15;
  h16x8 qf[8][2]; float wq[8];
  {
    const h16* QI = QIrow0 + (size_t)q * 512;
#pragma unroll
    for (int h = 0; h < 8; ++h)
#pragma unroll
      for (int ks = 0; ks < 2; ++ks) qf[h][ks] = *(const h16x8*)(QI + h * 64 + 32 * ks + 8 * g4);
    const float* WI = WIrow0 + (size_t)q * 8;
#pragma unroll
    for (int h = 0; h < 8; ++h) wq[h] = WI[h];
  }
  LDS unsigned* hist = (LDS unsigned*)(lds + IL_HIST);
  LDS unsigned* st = (LDS unsigned*)(lds + IL_ST);
  const int nst = (N + 127) >> 7;
  const int lr = tid >> 3, lc = tid & 7;
  h16x8 r0, r1;
  r0 = *(const h16x8*)(KIb + (size_t)lr * 64 + lc * 8); r1 = *(const h16x8*)(KIb + (size_t)(lr + 64) * 64 + lc * 8);
  *(LDS h16x8*)(lds + IL_KI + lr * LROW + lc * 16) = r0; *(LDS h16x8*)(lds + IL_KI + (lr + 64) * LROW + lc * 16) = r1;
  __syncthreads();
  float vmin = INFINITY, vmax = -INFINITY;
  int cur = 0;
  for (int s = 0; s < nst; s += stride) {
    const int nx = s + stride;
    if (nx < nst) { r0 = *(const h16x8*)(KIb + (size_t)(128 * nx + lr) * 64 + lc * 8); r1 = *(const h16x8*)(KIb + (size_t)(128 * nx + lr + 64) * 64 + lc * 8); }
    if (128 * s + 64 * kh < N) {
      f32x4 sc[4];
      idx_score(lds + IL_KI + cur * IL_KISZ, kh, l15, g4, qf, wq, sc);
      if (MODE == 0) {
#pragma unroll
        for (int kt = 0; kt < 4; ++kt)
#pragma unroll
          for (int r = 0; r < 4; ++r) { vmin = fminf(vmin, sc[kt][r]); vmax = fmaxf(vmax, sc[kt][r]); }
      } else if (MODE == 1) {
        h16* scp = scbase + ((size_t)((s * 2 + kh) * 4) * 1024 + q * 16 + 4 * g4);
#pragma unroll
        for (int kt = 0; kt < 4; ++kt) {
          const h16x4 hv = pack4(sc[kt][0], sc[kt][1], sc[kt][2], sc[kt][3]);
          *(h16x4*)(scp + kt * 1024) = hv;
#pragma unroll
          for (int r = 0; r < 4; ++r) {
            const float xb = fminf(fmaxf(__builtin_fmaf((float)hv[r], qinv, qoff), 0.f), (float)(IDX_NB - 1));
            const int bin = (int)xb;
            __hip_atomic_fetch_add(&hist[bin * 64 + q], 1u, __ATOMIC_RELAXED, __HIP_MEMORY_SCOPE_WORKGROUP);
          }
        }
      }
    }
    if (nx < nst) {
      *(LDS h16x8*)(lds + IL_KI + (cur ^ 1) * IL_KISZ + lr * LROW + lc * 16) = r0;
      *(LDS h16x8*)(lds + IL_KI + (cur ^ 1) * IL_KISZ + (lr + 64) * LROW + lc * 16) = r1;
    }
    __syncthreads();
    cur ^= 1;
  }
  if (MODE == 0) {
    __hip_atomic_fetch_min(&st[q], fkey(vmin), __ATOMIC_RELAXED, __HIP_MEMORY_SCOPE_WORKGROUP);
    __hip_atomic_fetch_max(&st[64 + q], fkey(vmax), __ATOMIC_RELAXED, __HIP_MEMORY_SCOPE_WORKGROUP);
  }
}

DEVI int idx_bin(float sv, float qinv, float qoff) { return (int)fminf(fmaxf(__builtin_fmaf(sv, qinv, qoff), 0.f), (float)(IDX_NB - 1)); }
DEVI float idx_bin_lower_bound(int target, float qinv, float qoff) {
  if (target <= 0) return -INFINITY;
  if (target > IDX_NB - 1) return INFINITY;
  unsigned lo = 0x03FFu, hi = 0xFC00u;
  auto val = [](unsigned k) { const unsigned short hbits = (unsigned short)((k & 0x8000u) ? (k & 0x7FFFu) : (~k & 0xFFFFu)); return (float)__builtin_bit_cast(h16, hbits); };
  if (idx_bin(val(hi), qinv, qoff) < target) return INFINITY;
  while (lo < hi) { const unsigned mid = (lo + hi) >> 1; if (idx_bin(val(mid), qinv, qoff) >= target) hi = mid; else lo = mid + 1; }
  return val(lo);
}
DEVI void idx_stream_step(LDS unsigned char* lds, LDS unsigned* st, const unsigned long long (&cur)[4], int s, int kh, int q, int lane, int g4, float thi, float tlo) {
  unsigned nib = 0u;
#pragma unroll
  for (int kt = 3; kt >= 0; --kt) {
    const h16x4 hv = __builtin_bit_cast(h16x4, cur[kt]);
#pragma unroll
    for (int r = 3; r >= 0; --r) {
      const float sv = (float)hv[r];
      const unsigned long long ms = __builtin_amdgcn_ballot_w64(sv >= thi);
      asm("v_addc_co_u32_e64 %0, vcc, %0, %0, %1" : "+v"(nib) : "s"(ms) : "vcc");
      const bool cand = (sv >= tlo) && !(sv >= thi);
      if (__builtin_amdgcn_ballot_w64(cand) != 0ull) {
        if (cand) {
          const unsigned pos = __hip_atomic_fetch_add(&st[128 + q], 1u, __ATOMIC_RELAXED, __HIP_MEMORY_SCOPE_WORKGROUP);
          if (pos < (unsigned)IDX_CAP) {
            ((LDS float*)(lds + IL_CS))[q * IDX_CAP + pos] = sv;
            ((LDS unsigned short*)(lds + IL_CK))[q * IDX_CAP + pos] = (unsigned short)(128 * s + 64 * kh + 16 * kt + 4 * g4 + r);
          }
        }
      }
    }
  }
  const unsigned oth = (unsigned)__shfl_xor((int)nib, 32);
  if (lane < 32) {
#pragma unroll
    for (int T = 0; T < 2; ++T) {
      const unsigned b0 = ((nib >> (8 * T)) & 15u) | (((oth >> (8 * T)) & 15u) << 4);
      const unsigned b1 = ((nib >> (8 * T + 4)) & 15u) | (((oth >> (8 * T + 4)) & 15u) << 4);
      ((LDS unsigned short*)(lds + IL_HIST))[q * 512 + (4 * s + 2 * kh + T) * 2 + (g4 & 1)] = (unsigned short)(b0 | (b1 << 8));
    }
  }
}
DEVI void idx_stream(LDS unsigned char* lds, int N, int qg, int kh, float thi, float tlo, const h16* scbase) {
  const int tid = launder((int)threadIdx.x), lane = tid & 63, l15 = lane & 15, g4 = lane >> 4;
  const int q = 16 * qg + l15;
  LDS unsigned* st = (LDS unsigned*)(lds + IL_ST);
  const int nv = (N - 64 * kh + 127) >> 7;
  const unsigned long long* scp = (const unsigned long long*)(scbase + ((size_t)(kh * 4) * 1024 + q * 16 + 4 * g4));
#define IDX_LD(dst, s_) do { if ((s_) < nv) { _Pragma("unroll") for (int kt = 0; kt < 4; ++kt) dst[kt] = __hip_atomic_load(scp + (size_t)(s_) * 2048 + kt * 256, __ATOMIC_RELAXED, __HIP_MEMORY_SCOPE_AGENT); } } while (0)
  unsigned long long b0[4], b1[4], b2[4], b3[4];
  IDX_LD(b0, 0); IDX_LD(b1, 1); IDX_LD(b2, 2); IDX_LD(b3, 3);
  for (int s = 0; s < nv; s += 4) {
    idx_stream_step(lds, st, b0, s, kh, q, lane, g4, thi, tlo); IDX_LD(b0, s + 4);
    if (s + 1 < nv) { idx_stream_step(lds, st, b1, s + 1, kh, q, lane, g4, thi, tlo); IDX_LD(b1, s + 5); }
    if (s + 2 < nv) { idx_stream_step(lds, st, b2, s + 2, kh, q, lane, g4, thi, tlo); IDX_LD(b2, s + 6); }
    if (s + 3 < nv) { idx_stream_step(lds, st, b3, s + 3, kh, q, lane, g4, thi, tlo); IDX_LD(b3, s + 7); }
  }
#undef IDX_LD
}

DEVI void idx_item(PRef p, LDS unsigned char* lds, int b, int c) {
  const int tid = launder((int)threadIdx.x), lane = tid & 63, wave = wave_id(tid), l31 = lane & 31, half = lane >> 5;
  const int N = 64 * (c + 1);
  unsigned* MASK = (unsigned*)(p.ws + WS_MASK) + ((size_t)b * SEQ + 64 * c) * 256;
  if (N <= 256) {
    const int wpr = N >> 5;
    for (int i = tid; i < 64 * wpr; i += NTHR) MASK[(size_t)(i / wpr) * 256 + (i % wpr)] = 0xFFFFFFFFu;
    return;
  }
  const int qg = wave & 3, kh = wave >> 2, l15 = lane & 15, q = 16 * qg + l15;
  const h16* QIrow0 = (const h16*)(p.ws + WS_QI) + ((size_t)b * SEQ + 64 * c) * 512;
  const float* WIrow0 = (const float*)(p.ws + WS_WI) + ((size_t)b * SEQ + 64 * c) * 8;
  const h16* KIb = (const h16*)(p.ws + WS_KI) + (size_t)b * SEQ * 64;
  h16* scbase;
  {
    const int j = (c < 64) ? c : 127 - c;
    const size_t pre = 8192ull * (size_t)(128 * j - (j * (j - 1)) / 2);
    scbase = (h16*)(p.ws + (b == 0 ? WS_H : WS_MIX + (size_t)(b - 1) * SC_BATCH_BYTES) + pre);
  }
  LDS unsigned* st = (LDS unsigned*)(lds + IL_ST);
  LDS float* stf = (LDS float*)(lds + IL_ST);
  if (tid < 64) { st[tid] = 0xFFFFFFFFu; st[64 + tid] = 0u; st[128 + tid] = 0u; }
  __syncthreads();
  const int nst = (N + 127) >> 7;
  const int stride = nst >= 16 ? 8 : (nst >= 8 ? 4 : (nst >= 4 ? 2 : 1));
  idx_pass<0>(lds, KIb, N, stride, qg, kh, QIrow0, WIrow0, 0.f, 0.f, 0, scbase);
  __syncthreads();
  if (tid < 64) {
    const float lo = fkey_inv(st[tid]), hi = fkey_inv(st[64 + tid]);
    float d = hi - lo; if (!(d > 1e-20f)) d = 1.f;
    const float inv = (float)IDX_NB / (1.5f * d);
    stf[192 + tid] = inv; stf[256 + tid] = -(lo - 0.25f * d) * inv;
  }
  for (int i = tid; i < 16384; i += NTHR) ((LDS unsigned*)(lds + IL_HIST))[i] = 0u;
  __syncthreads();
  const float qinv = stf[192 + q], qoff = stf[256 + q];
  idx_pass<1>(lds, KIb, N, 1, qg, kh, QIrow0, WIrow0, qinv, qoff, 0, scbase);
  {
    LDS unsigned* hist = (LDS unsigned*)(lds + IL_HIST);
    for (int qq = wave; qq < 64; qq += 8) {
      unsigned hb[4];
#pragma unroll
      for (int j = 0; j < 4; ++j) hb[j] = hist[(4 * lane + j) * 64 + qq];
      const unsigned mine = hb[0] + hb[1] + hb[2] + hb[3];
      unsigned suf = mine;
#pragma unroll
      for (int o = 1; o < 64; o <<= 1) { const unsigned v = (unsigned)__shfl_down((int)suf, o); if (lane + o < 64) suf += v; }
      unsigned cum = suf - mine;
      if (cum < 256u && suf >= 256u) {
#pragma unroll
        for (int j = 3; j >= 0; --j) {
          if (cum < 256u && cum + hb[j] >= 256u) { st[320 + qq] = (unsigned)(4 * lane + j); st[384 + qq] = 256u - cum; }
          cum += hb[j];
        }
      }
    }
  }
  __syncthreads();
  if (tid < 64) {
    const int bs = (int)st[320 + tid]; const float qi_ = stf[192 + tid], qo_ = stf[256 + tid];
    stf[448 + tid] = idx_bin_lower_bound(bs + 1, qi_, qo_);
    stf[512 + tid] = idx_bin_lower_bound(bs, qi_, qo_);
  }
  __syncthreads();
  const float thi = stf[448 + q], tlo = stf[512 + q];
  asm volatile("s_waitcnt vmcnt(0)" ::: "memory");
  idx_stream(lds, N, qg, kh, thi, tlo, scbase);
  __syncthreads();
  for (int qq = wave; qq < 64; qq += 8) {
    const int nc = min((int)st[128 + qq], IDX_CAP); const unsigned need = st[384 + qq];
    LDS float* cs = (LDS float*)(lds + IL_CS) + qq * IDX_CAP; LDS unsigned short* ck = (LDS unsigned short*)(lds + IL_CK) + qq * IDX_CAP;
    for (int i = lane; i < nc; i += 64) {
      const float sv = cs[i]; const unsigned kv = ck[i];
      unsigned rank = 0u;
      for (int j = 0; j < nc; ++j) { const float sj = cs[j]; const unsigned kj = ck[j]; rank += (sj > sv || (sj == sv && kj < kv)) ? 1u : 0u; }
      if (rank < need) {
        const unsigned kl = kv & 31u;
        const unsigned bit = 16u * ((kl >> 2) & 1u) + (kl & 3u) + 4u * (kl >> 3);
        __hip_atomic_fetch_or((LDS unsigned*)(lds + IL_HIST) + qq * 256 + (kv >> 5), 1u << bit, __ATOMIC_RELAXED, __HIP_MEMORY_SCOPE_WORKGROUP);
      }
    }
  }
  __syncthreads();
  {
    const int cpr = N >> 6;
    for (int i = tid; i < 64 * cpr; i += NTHR) {
      const int row = i / cpr, cc = i % cpr;
      *(u32x2*)(MASK + (size_t)row * 256 + 2 * cc) = *(LDS u32x2*)(lds + IL_HIST + row * 1024 + cc * 8);
    }
  }
  __syncthreads();
}

DEVI void phase3(PRef p, LDS unsigned char* lds) {
  const int G = gridDim.x;
  for (int it = blockIdx.x; it < 512; it += G) rnn_item<0>(p, lds, it >> 7, it & 127);
  for (int it = blockIdx.x; it < 256; it += G) {
    const int b = it >> 6, j = it & 63;
#pragma unroll 1
    for (int w2 = 0; w2 < 2; ++w2) idx_item(p, lds, b, w2 ? j : 127 - j);
  }
}

DEVI float max3f(float a, float b, float c) { float r; asm("v_max3_f32 %0, %1, %2, %3" : "=v"(r) : "v"(a), "v"(b), "v"(c)); return r; }
DEVI unsigned pk_rtz(float a, float b) { return __builtin_bit_cast(unsigned, __builtin_amdgcn_cvt_pkrtz(a, b)); }
DEVI void attn_tile(LDS unsigned char* Kt, LDS unsigned char* Vt, const h16x8 (&qf)[4], u32x2 mw, int l31, int half, f32x16 (&o)[2], float& mref, float& l, bool& init) {
  const unsigned nm0 = ~(mw[0] >> (16 * half)), nm1 = ~(mw[1] >> (16 * half));
  const unsigned negm = __float_as_uint(-mref);
  f32x16 s[2];
#pragma unroll
  for (int r = 0; r < 16; ++r) {
    unsigned e0 = (unsigned)__builtin_amdgcn_sbfe((int)nm0, r, 1), e1 = (unsigned)__builtin_amdgcn_sbfe((int)nm1, r, 1);
    asm volatile("" : "+v"(e0), "+v"(e1));
    s[0][r] = __uint_as_float((e0 & 0xFF800000u) | (~e0 & negm));
    s[1][r] = __uint_as_float((e1 & 0xFF800000u) | (~e1 & negm));
  }
#pragma unroll
  for (int ri = 0; ri < 2; ++ri)
#pragma unroll
    for (int kk = 0; kk < 4; ++kk) {
      const h16x8 kf = *(LDS h16x8*)(Kt + (32 * ri + l31) * LROW + (2 * kk + half) * 16);
      s[ri] = mfma16(kf, qf[kk], s[ri]);
    }
  asm volatile("s_nop 15\n\ts_nop 7" : "+v"(s[0]), "+v"(s[1]));
  float mx = max3f(s[0][0], s[1][0], s[0][1]), mx2 = max3f(s[1][1], s[0][2], s[1][2]);
#pragma unroll
  for (int r = 3; r < 15; r += 2) { mx = max3f(mx, s[0][r], s[1][r]); mx2 = max3f(mx2, s[0][r + 1], s[1][r + 1]); }
  mx = max3f(mx, s[0][15], s[1][15]);
  mx = max3f(mx, mx2, mx2);
  mx = max3f(mx, __shfl_xor(mx, 32), mx);
  const bool first = (!init) && (mx > -INFINITY);
  const bool resc = first || (mx > 8.f);
  if (__any(resc)) {
    init = init || first;
    const float delta = resc ? mx : 0.f;
    const float alpha = __builtin_amdgcn_exp2f(-delta);
#pragma unroll
    for (int r = 0; r < 16; ++r) { s[0][r] -= delta; s[1][r] -= delta; o[0][r] *= alpha; o[1][r] *= alpha; }
    l *= alpha; mref += delta;
  }
  float ls = 0.f;
#pragma unroll
  for (int r = 0; r < 16; ++r) {
    s[0][r] = __builtin_amdgcn_exp2f(s[0][r]); s[1][r] = __builtin_amdgcn_exp2f(s[1][r]);
    ls += s[0][r] + s[1][r];
  }
  l += ls;
  h16x8 pf[4];
#pragma unroll
  for (int s4 = 0; s4 < 4; ++s4) {
    u32x4 w;
#pragma unroll
    for (int e = 0; e < 4; ++e) w[e] = pk_rtz(s[s4 >> 1][8 * (s4 & 1) + 2 * e], s[s4 >> 1][8 * (s4 & 1) + 2 * e + 1]);
    pf[s4] = __builtin_bit_cast(h16x8, w);
  }
#pragma unroll
  for (int di = 0; di < 2; ++di)
#pragma unroll
    for (int s4 = 0; s4 < 4; ++s4) {
      const h16x8 vf = *(LDS h16x8*)(Vt + (32 * di + l31) * LROW + (2 * s4 + half) * 16);
      o[di] = mfma16(vf, pf[s4], o[di]);
    }
}

DEVI void attn_unit(PRef p, LDS unsigned char* lds, int b, int head, int qb) {
  const int tid = launder((int)threadIdx.x), lane = tid & 63, wave = wave_id(tid), l31 = lane & 31, half = lane >> 5;
  const int q0 = qb * 256 + wave * 32, cw = q0 >> 6, NS = qb + 1;
  const size_t tok = (size_t)b * SEQ + q0 + l31;
  h16x8 qf[4];
  {
    const h16* Q = (const h16*)(p.ws + WS_Q) + tok * 512 + head * 64;
#pragma unroll
    for (int kk = 0; kk < 4; ++kk) qf[kk] = *(const h16x8*)(Q + 16 * kk + 8 * half);
  }
  const unsigned* mrow = (const unsigned*)(p.ws + WS_MASK) + tok * 256;
  constexpr int TP = 2 * 64 * LROW, ABUF = 4 * TP;
  static_assert(2 * ABUF <= LDS_BYTES - 16, "attention LDS");
  const h16* ksrc[4]; const h16* vsrc[4]; int kdst[4], vdst[4];
#pragma unroll
  for (int i = 0; i < 4; ++i) {
    const int id = tid + NTHR * i;
    const int row = id >> 3, lc = id & 7;
    ksrc[i] = (const h16*)(p.ws + WS_K) + ((size_t)b * SEQ + row) * 512 + head * 64 + lc * 8;
    kdst[i] = (row >> 6) * TP + (row & 63) * LROW + lc * 16;
    const int d = id >> 5, c = id & 31;
    vsrc[i] = (const h16*)(p.ws + WS_VT) + ((size_t)(b * 8 + head) * 64 + d) * 8192 + c * 8;
    vdst[i] = (c >> 3) * TP + 64 * LROW + d * LROW + (c & 7) * 16;
  }
  h16x8 rkA[4], rvA[4], rkB[4], rvB[4];
#pragma unroll
  for (int i = 0; i < 4; ++i) { rkA[i] = *(const h16x8*)ksrc[i]; rvA[i] = *(const h16x8*)vsrc[i]; }
#pragma unroll
  for (int i = 0; i < 4; ++i) { *(LDS h16x8*)(lds + kdst[i]) = rkA[i]; *(LDS h16x8*)(lds + vdst[i]) = rvA[i]; }
  if (NS > 1) {
#pragma unroll
    for (int i = 0; i < 4; ++i) { rkA[i] = *(const h16x8*)(ksrc[i] + (size_t)256 * 512); rvA[i] = *(const h16x8*)(vsrc[i] + 256); }
  }
  u32x4 mwa = *(const u32x4*)mrow, mwb = *(const u32x4*)(mrow + 4), mna, mnb;
  mna = mwa; mnb = mwb;
  __syncthreads();
  f32x16 o[2];
#pragma unroll
  for (int r = 0; r < 16; ++r) { o[0][r] = 0.f; o[1][r] = 0.f; }
  float mref = 0.f, l = 0.f; bool init = false;
#define ATT_TILE(s, t, W0, W1) if (4 * (s) + (t) <= cw) { u32x2 m2; m2[0] = W0; m2[1] = W1; attn_tile(bb + (t) * TP, bb + (t) * TP + 64 * LROW, qf, m2, l31, half, o, mref, l, init); }
#define ATT_STEP(s, RKC, RVC, RKN, RVN) { \
    if ((s) + 2 < NS) { _Pragma("unroll") for (int i = 0; i < 4; ++i) { RKN[i] = *(const h16x8*)(ksrc[i] + (size_t)((s) + 2) * 256 * 512); RVN[i] = *(const h16x8*)(vsrc[i] + ((s) + 2) * 256); } } \
    if ((s) + 1 < NS) { mna = *(const u32x4*)(mrow + 8 * ((s) + 1)); mnb = *(const u32x4*)(mrow + 8 * ((s) + 1) + 4); } \
    { LDS unsigned char* bb = lds + ((s) & 1) * ABUF; \
      ATT_TILE(s, 0, mwa[0], mwa[1]) ATT_TILE(s, 1, mwa[2], mwa[3]) ATT_TILE(s, 2, mwb[0], mwb[1]) ATT_TILE(s, 3, mwb[2], mwb[3]) } \
    if ((s) + 1 < NS) { LDS unsigned char* nb = lds + (((s) + 1) & 1) * ABUF; _Pragma("unroll") for (int i = 0; i < 4; ++i) { *(LDS h16x8*)(nb + kdst[i]) = RKC[i]; *(LDS h16x8*)(nb + vdst[i]) = RVC[i]; } } \
    __syncthreads(); mwa = mna; mwb = mnb; }
  for (int s = 0; s < NS; s += 2) {
    ATT_STEP(s, rkA, rvA, rkB, rvB)
    if (s + 1 < NS) ATT_STEP(s + 1, rkB, rvB, rkA, rvA)
  }
#undef ATT_STEP
#undef ATT_TILE
  const float inv = 1.f / (l + __shfl_xor(l, 32));
  h16* Y = (h16*)(p.ws + WS_H) + tok * DM + head * 64;
#pragma unroll
  for (int di = 0; di < 2; ++di)
#pragma unroll
    for (int q = 0; q < 4; ++q)
      *(h16x4*)(Y + 32 * di + 8 * q + 4 * half) = pack4(o[di][4 * q] * inv, o[di][4 * q + 1] * inv, o[di][4 * q + 2] * inv, o[di][4 * q + 3] * inv);
}

DEVI void phase4(PRef p, LDS unsigned char* lds) {
  const int G = gridDim.x;
  for (int it = blockIdx.x; it < 512; it += G) rnn_item<1>(p, lds, it >> 7, it & 127);
  for (int it = blockIdx.x; it < 512; it += G) {
    const int bh = it >> 4, j = it & 15;
#pragma unroll 1
    for (int w2 = 0; w2 < 2; ++w2) attn_unit(p, lds, bh >> 3, bh & 7, w2 ? j : 31 - j);
  }
}

struct EpiPlain {
  h16* dst; int ld;
  DEVI void operator()(const f32x4 (&acc)[2][2][4][2], const g8::Unit& u, int wr, int wc, int fr, int fq) const {
#pragma unroll
    for (int ai = 0; ai < 2; ++ai)
#pragma unroll
      for (int m = 0; m < 4; ++m) {
        const int r = u.pm * 256 + 128 * ai + 64 * wr + 16 * m + fr;
        if (r < u.cnt) {
          h16* d = dst + (size_t)(u.off + r) * ld + u.pn * 256 + 32 * wc + 4 * fq;
#pragma unroll
          for (int bj = 0; bj < 2; ++bj)
#pragma unroll
            for (int n = 0; n < 2; ++n) { const f32x4 v = acc[ai][bj][m][n]; *(h16x4*)(d + 128 * bj + 16 * n) = pack4(v[0], v[1], v[2], v[3]); }
        }
      }
  }
};
DEVI void phase5(PRef p, LDS unsigned char* lds) {
  g8::DenseOrder S{(const h16*)(p.ws + WS_H), (const h16*)(p.ws + WS_WOUT), DM, 128, 4, (int)gridDim.x, (int)blockIdx.x};
  EpiPlain E{(h16*)(p.ws + WS_MIX), DM};
  g8::gemm_phase(lds, DM, S, E);
}

constexpr int P6_TROW = 2064, P6_THI = 0, P6_TLO = 32 * P6_TROW, P6_PART = 0, P6_LGT = 8 * 48 * 32 * 4, P6_MOD = 2 * 32 * P6_TROW;
constexpr int P6_BIAS = P6_MOD + 3 * 4096, P6_TOK = P6_BIAS + 160, P6_LCNT = P6_TOK + 128 * 6 * 4, P6_LBASE = P6_LCNT + 128;
static_assert(P6_LBASE + 128 <= LDS_BYTES - 16 && P6_LGT + 32 * 36 * 4 <= P6_MOD, "phase 6 LDS map");
DEVI void phase6(PRef p, LDS unsigned char* lds) {
  const int tid = launder((int)threadIdx.x), lane = tid & 63, wave = wave_id(tid), l15 = lane & 15, g4 = lane >> 4;
  const int b = blockIdx.x >> 6;
  LDS float* mv = (LDS float*)(lds + P6_MOD);
  LDS float* rbias = (LDS float*)(lds + P6_BIAS);
  LDS unsigned* tokrec = (LDS unsigned*)(lds + P6_TOK);
  LDS unsigned* lcnt = (LDS unsigned*)(lds + P6_LCNT);
  LDS unsigned* lbase = (LDS unsigned*)(lds + P6_LBASE);
  mod_to_lds(p, b, 2, mv); mod_to_lds(p, b, 3, mv + 1024); mod_to_lds(p, b, 4, mv + 2048);
  if (tid < 4) rbias[tid] = p.in[18][tid];
  else if (tid < 36) rbias[tid] = p.in[20][tid - 4];
  if (tid < 32) lcnt[tid] = 0u;
  __syncthreads();
  f32x4 A1[4], A2[4], SH2[4];
#pragma unroll
  for (int j = 0; j < 4; ++j) {
    const int k = 256 * j + 4 * lane;
    A1[j] = *(LDS f32x4*)(mv + k) * *(const f32x4*)(p.in[5] + k);
    A2[j] = *(const f32x4*)(p.in[6] + k) * (*(LDS f32x4*)(mv + 2048 + k) + 1.f);
    SH2[j] = *(LDS f32x4*)(mv + 1024 + k);
  }
  const float* x = p.in[0]; const h16* MIX = (const h16*)(p.ws + WS_MIX); h16* X1h = (h16*)(p.ws + WS_MIX); h16* H2 = (h16*)(p.ws + WS_H);
  const h16* WRH = (const h16*)(p.ws + WS_WRH); const h16* WRL = (const h16*)(p.ws + WS_WRL);
  const size_t tok0 = (size_t)blockIdx.x * 128;
  h16x8 bh[3][4], bl[3][4];
#pragma unroll
  for (int ct = 0; ct < 3; ++ct)
#pragma unroll
    for (int kk = 0; kk < 4; ++kk) {
      const int kof = 32 * (4 * wave + kk) + 8 * g4;
      bh[ct][kk] = *(const h16x8*)(WRH + (size_t)(16 * ct + l15) * 1024 + kof); bl[ct][kk] = *(const h16x8*)(WRL + (size_t)(16 * ct + l15) * 1024 + kof);
    }
#pragma unroll 1
  for (int rd = 0; rd < 4; ++rd) {
#pragma unroll 1
    for (int i = 0; i < 4; ++i) {
      const int tr = 4 * wave + i;
      const size_t tok = tok0 + 32 * rd + tr;
      f32x4 xv[4], mx[4]; float ssm = 0.f;
#pragma unroll
      for (int j = 0; j < 4; ++j) {
        xv[j] = *(const f32x4*)(x + tok * DM + 256 * j + 4 * lane);
        const h16x4 mh = *(const h16x4*)(MIX + tok * DM + 256 * j + 4 * lane);
#pragma unroll
        for (int e = 0; e < 4; ++e) { mx[j][e] = (float)mh[e]; ssm += mx[j][e] * mx[j][e]; }
      }
      const float rsm = 1.0f / sqrtf(wave_sum(ssm) * (1.f / 1024.f) + 1e-6f);
      float ss1 = 0.f;
#pragma unroll
      for (int j = 0; j < 4; ++j) {
        xv[j] = xv[j] + A1[j] * (mx[j] * rsm);
        *(h16x4*)(X1h + tok * DM + 256 * j + 4 * lane) = pack4(xv[j][0], xv[j][1], xv[j][2], xv[j][3]);
        ss1 += xv[j][0] * xv[j][0] + xv[j][1] * xv[j][1] + xv[j][2] * xv[j][2] + xv[j][3] * xv[j][3];
      }
      const float rs1 = 1.0f / sqrtf(wave_sum(ss1) * (1.f / 1024.f) + 1e-6f);
#pragma unroll
      for (int j = 0; j < 4; ++j) {
        const f32x4 h2 = xv[j] * rs1 * A2[j] + SH2[j];
        const h16x4 hi = pack4(h2[0], h2[1], h2[2], h2[3]);
        const h16x4 lo = pack4(h2[0] - (float)hi[0], h2[1] - (float)hi[1], h2[2] - (float)hi[2], h2[3] - (float)hi[3]);
        *(h16x4*)(H2 + tok * DM + 256 * j + 4 * lane) = hi;
        *(LDS h16x4*)(lds + P6_THI + tr * P6_TROW + (256 * j + 4 * lane) * 2) = hi;
        *(LDS h16x4*)(lds + P6_TLO + tr * P6_TROW + (256 * j + 4 * lane) * 2) = lo;
      }
    }
    __syncthreads();
    f32x4 acc[2][3];
#pragma unroll
    for (int tt = 0; tt < 2; ++tt)
#pragma unroll
      for (int ct = 0; ct < 3; ++ct) acc[tt][ct] = (f32x4){0.f, 0.f, 0.f, 0.f};
#pragma unroll
    for (int kk = 0; kk < 4; ++kk) {
      const int kof = 32 * (4 * wave + kk) + 8 * g4;
      h16x8 ah[2], al[2];
#pragma unroll
      for (int tt = 0; tt < 2; ++tt) {
        ah[tt] = *(LDS h16x8*)(lds + P6_THI + (16 * tt + l15) * P6_TROW + kof * 2);
        al[tt] = *(LDS h16x8*)(lds + P6_TLO + (16 * tt + l15) * P6_TROW + kof * 2);
      }
#pragma unroll
      for (int ct = 0; ct < 3; ++ct) {
#pragma unroll
        for (int tt = 0; tt < 2; ++tt) {
          acc[tt][ct] = mfma16s(ah[tt], bh[ct][kk], acc[tt][ct]);
          acc[tt][ct] = mfma16s(ah[tt], bl[ct][kk], acc[tt][ct]);
          acc[tt][ct] = mfma16s(al[tt], bh[ct][kk], acc[tt][ct]);
        }
      }
    }
    __syncthreads();
#pragma unroll
    for (int tt = 0; tt < 2; ++tt)
#pragma unroll
      for (int ct = 0; ct < 3; ++ct)
        *(LDS f32x4*)(lds + P6_PART + (((wave * 48 + 16 * ct + l15) * 32) + 16 * tt + 4 * g4) * 4) = acc[tt][ct];
    __syncthreads();
    for (int idx = tid; idx < 36 * 32; idx += NTHR) {
      const int col = idx >> 5, tk = idx & 31;
      float s = 0.f;
#pragma unroll
      for (int w = 0; w < 8; ++w) s += *(LDS float*)(lds + P6_PART + ((w * 48 + col) * 32 + tk) * 4);
      *(LDS float*)(lds + P6_LGT + (tk * 36 + col) * 4) = s;
    }
    __syncthreads();
    if (tid < 32) {
      LDS float* lg = (LDS float*)(lds + P6_LGT) + 36 * tid;
      float gl[4];
#pragma unroll
      for (int g = 0; g < 4; ++g) gl[g] = lg[g] + rbias[g];
      int gi = 0; float gm = gl[0];
#pragma unroll
      for (int g = 1; g < 4; ++g) if (gl[g] > gm) { gm = gl[g]; gi = g; }
      float gs = 0.f;
#pragma unroll
      for (int g = 0; g < 4; ++g) gs += __expf(gl[g] - gm);
      const float pg = 1.f / gs;
      int e1 = 0, e2 = 0; float l1 = -INFINITY, l2 = -INFINITY;
#pragma unroll
      for (int e = 0; e < 8; ++e) {
        const float v = lg[4 + 8 * gi + e] + rbias[4 + 8 * gi + e];
        if (v > l1) { l2 = l1; e2 = e1; l1 = v; e1 = e; }
        else if (v > l2) { l2 = v; e2 = e; }
      }
      const float x2 = __expf(l2 - l1);
      const float w1 = pg / (1.f + x2), w2 = pg * x2 / (1.f + x2);
      const unsigned E1 = (unsigned)(gi * 8 + e1), E2 = (unsigned)(gi * 8 + e2);
      const unsigned lp1 = __hip_atomic_fetch_add(&lcnt[E1], 1u, __ATOMIC_RELAXED, __HIP_MEMORY_SCOPE_WORKGROUP);
      const unsigned lp2 = __hip_atomic_fetch_add(&lcnt[E2], 1u, __ATOMIC_RELAXED, __HIP_MEMORY_SCOPE_WORKGROUP);
      LDS unsigned* tr = tokrec + (32 * rd + tid) * 6;
      tr[0] = E1; tr[1] = lp1; tr[2] = E2; tr[3] = lp2; tr[4] = __float_as_uint(w1); tr[5] = __float_as_uint(w2);
    }
    __syncthreads();
  }
  if (tid < 32) lbase[tid] = atomicAdd((unsigned*)(p.ws + WS_CNT) + tid, lcnt[tid]);
  __syncthreads();
  if (tid < 128) {
    unsigned* LIST = (unsigned*)(p.ws + WS_LIST); float* LISTW = (float*)(p.ws + WS_LISTW); u32x4* ROUTE = (u32x4*)(p.ws + WS_ROUTE);
    const unsigned tok = (unsigned)(tok0 + tid);
    LDS unsigned* tr = tokrec + tid * 6;
    const unsigned E1 = tr[0], E2 = tr[2], p1 = lbase[E1] + tr[1], p2 = lbase[E2] + tr[3];
    LIST[(size_t)E1 * 32768 + p1] = tok; LISTW[(size_t)E1 * 32768 + p1] = __uint_as_float(tr[4]);
    LIST[(size_t)E2 * 32768 + p2] = tok; LISTW[(size_t)E2 * 32768 + p2] = __uint_as_float(tr[5]);
    u32x4 rt; rt[0] = E1; rt[1] = p1; rt[2] = E2; rt[3] = p2;
    ROUTE[tok] = rt;
  }
}

template <bool GATHER_> struct MoeOrder {
  static constexpr bool GATHER = GATHER_;
  unsigned char* ws; int ntn, K, G, c;
  DEVI bool next(int i, g8::Unit& u) const {
    const unsigned* cnt = (const unsigned*)(ws + WS_CNT);
    int it = i * G + c, off = 0, e = 0, cn = 0; bool found = false;
    for (e = 0; e < 32; ++e) { cn = (int)cnt[e]; const int nti = ((cn + 255) >> 8) * ntn; if (it < nti) { found = true; break; } it -= nti; off += cn; }
    if (!found) return false;
    u.e = e; u.pm = it / ntn; u.pn = it % ntn; u.cnt = cn; u.off = off;
    const int tid = threadIdx.x;
    if (GATHER_) {
      const unsigned* list = (const unsigned*)(ws + WS_LIST) + (size_t)e * 32768;
      u.A = (const char*)(ws + WS_H);
      u.B = (const char*)((const h16*)(ws + WS_WGU) + ((size_t)e * 512 + u.pn * 256) * DM);
#pragma unroll
      for (int h = 0; h < 2; ++h)
#pragma unroll
        for (int i2 = 0; i2 < 2; ++i2) {
          int R, C; g8::stage_rc(tid * 16 + i2 * 8192, R, C);
          const int row = u.pm * 256 + 128 * h + R;
          const unsigned t = (row < cn) ? list[row] : 0u;
          u.va[h][i2] = (t * (unsigned)DM + (unsigned)C) * 2u;
        }
    } else {
      u.A = (const char*)((const h16*)(ws + WS_ACT) + ((size_t)off + u.pm * 256) * 256);
      u.B = (const char*)((const h16*)(ws + WS_WDN) + ((size_t)e * 1024 + u.pn * 256) * 256);
      u.va[0][0] = u.va[0][1] = u.va[1][0] = u.va[1][1] = 0u;
    }
    return true;
  }
};
struct EpiAct {
  unsigned char* ws;
  DEVI void operator()(const f32x4 (&acc)[2][2][4][2], const g8::Unit& u, int wr, int wc, int fr, int fq) const {
    const float* lw = (const float*)(ws + WS_LISTW) + (size_t)u.e * 32768; h16* act = (h16*)(ws + WS_ACT);
#pragma unroll
    for (int ai = 0; ai < 2; ++ai)
#pragma unroll
      for (int m = 0; m < 4; ++m) {
        const int r = u.pm * 256 + 128 * ai + 64 * wr + 16 * m + fr;
        if (r < u.cnt) {
          const float w = lw[r];
#pragma unroll
          for (int bj = 0; bj < 2; ++bj) {
            const f32x4 g = acc[ai][bj][m][0], up = acc[ai][bj][m][1];
            float v[4];
#pragma unroll
            for (int e = 0; e < 4; ++e) v[e] = g[e] * __builtin_amdgcn_rcpf(1.f + __expf(-g[e])) * up[e] * w;
            *(h16x4*)(act + (size_t)(u.off + r) * 256 + 16 * (8 * u.pn + 4 * bj + wc) + 4 * fq) = pack4(v[0], v[1], v[2], v[3]);
          }
        }
      }
  }
};
struct EpiYp {
  h16* dst;
  DEVI void operator()(const f32x4 (&acc)[2][2][4][2], const g8::Unit& u, int wr, int wc, int fr, int fq) const {
#pragma unroll
    for (int ai = 0; ai < 2; ++ai)
#pragma unroll
      for (int m = 0; m < 4; ++m) {
        const int r = u.pm * 256 + 128 * ai + 64 * wr + 16 * m + fr;
        if (r < u.cnt) {
          h16* d = dst + (size_t)(u.off + r) * DM + u.pn * 256 + 32 * wc + 4 * fq;
#pragma unroll
          for (int bj = 0; bj < 2; ++bj)
#pragma unroll
            for (int n = 0; n < 2; ++n) { const f32x4 v = acc[ai][bj][m][n]; *(h16x4*)(d + 128 * bj + 16 * n) = pack4(v[0], v[1], v[2], v[3]); }
        }
      }
  }
};
DEVI void phase7(PRef p, LDS unsigned char* lds) {
  MoeOrder<true> S{p.ws, 2, DM, (int)gridDim.x, (int)blockIdx.x};
  EpiAct E{p.ws};
  g8::gemm_phase(lds, DM, S, E);
}
DEVI void phase8(PRef p, LDS unsigned char* lds) {
  MoeOrder<false> S{p.ws, 4, 256, (int)gridDim.x, (int)blockIdx.x};
  EpiYp E{(h16*)(p.ws + WS_YP)};
  g8::gemm_phase(lds, 256, S, E);
}

DEVI void phase9(PRef p, LDS unsigned char* lds) {
  const int tid = launder((int)threadIdx.x), lane = tid & 63, wave = wave_id(tid), G = gridDim.x;
  const int b = blockIdx.x & 3, bi = blockIdx.x >> 2, nbk = G >> 2;
  LDS unsigned* offs = (LDS unsigned*)lds;
  if (tid == 0) { const unsigned* cnt = (const unsigned*)(p.ws + WS_CNT); unsigned o = 0; for (int e = 0; e < 32; ++e) { offs[e] = o; o += cnt[e]; } }
  __syncthreads();
  LDS float* mv = (LDS float*)(lds + 256);
  mod_to_lds(p, b, 5, mv);
  __syncthreads();
  f32x4 A3[4];
#pragma unroll
  for (int j = 0; j < 4; ++j) { const int k = 256 * j + 4 * lane; A3[j] = *(LDS f32x4*)(mv + k) * *(const f32x4*)(p.in[7] + k); }
  const h16* YP = (const h16*)(p.ws + WS_YP); const u32x4* ROUTE = (const u32x4*)(p.ws + WS_ROUTE); float* out = p.out; const h16* X1h = (const h16*)(p.ws + WS_MIX);
  const int rstep = nbk * 8, r_first = bi * 8 + wave;
  const int nrow = (SEQ - r_first + rstep - 1) / rstep;
  unsigned R0 = 0u, R1 = 0u;
  if (lane < nrow) { const u32x4 rt = ROUTE[(size_t)b * SEQ + r_first + rstep * lane]; R0 = offs[rt[0]] + rt[1]; R1 = offs[rt[2]] + rt[3]; }
  h16x4 ya[4], yc[4]; f32x4 xv[4];
  {
    const size_t tok = (size_t)b * SEQ + r_first; const size_t r0 = __builtin_amdgcn_readlane(R0, 0), r1 = __builtin_amdgcn_readlane(R1, 0);
#pragma unroll
    for (int j = 0; j < 4; ++j) { ya[j] = *(const h16x4*)(YP + r0 * DM + 256 * j + 4 * lane); yc[j] = *(const h16x4*)(YP + r1 * DM + 256 * j + 4 * lane); { const h16x4 xh = *(const h16x4*)(X1h + tok * DM + 256 * j + 4 * lane); xv[j] = (f32x4){(float)xh[0], (float)xh[1], (float)xh[2], (float)xh[3]}; } }
  }
  for (int i = 0; i < nrow; ++i) {
    const size_t tok = (size_t)b * SEQ + r_first + rstep * i;
    h16x4 na[4], nc[4]; f32x4 nx[4];
    if (i + 1 < nrow) {
      const size_t r0 = __builtin_amdgcn_readlane(R0, i + 1), r1 = __builtin_amdgcn_readlane(R1, i + 1);
#pragma unroll
      for (int j = 0; j < 4; ++j) { na[j] = *(const h16x4*)(YP + r0 * DM + 256 * j + 4 * lane); nc[j] = *(const h16x4*)(YP + r1 * DM + 256 * j + 4 * lane); { const h16x4 xh = *(const h16x4*)(X1h + (tok + rstep) * DM + 256 * j + 4 * lane); nx[j] = (f32x4){(float)xh[0], (float)xh[1], (float)xh[2], (float)xh[3]}; } }
    }
    f32x4 y[4]; float ss = 0.f;
#pragma unroll
    for (int j = 0; j < 4; ++j)
#pragma unroll
      for (int e = 0; e < 4; ++e) { y[j][e] = (float)ya[j][e] + (float)yc[j][e]; ss += y[j][e] * y[j][e]; }
    const float rs = 1.0f / sqrtf(wave_sum(ss) * (1.f / 1024.f) + 1e-6f);
#pragma unroll
    for (int j = 0; j < 4; ++j) *(f32x4*)(out + tok * DM + 256 * j + 4 * lane) = xv[j] + A3[j] * (y[j] * rs);
    if (i + 1 < nrow) {
#pragma unroll
      for (int j = 0; j < 4; ++j) { ya[j] = na[j]; yc[j] = nc[j]; xv[j] = nx[j]; }
    }
  }
}

#define XB_TMO      128
#define XB_XCNT(j)  (256  + 64 * (j))
#define XB_XSUB(j)  (1280 + 64 * (j))
#define XB_XGEN(j)  (2304 + 64 * (j))
#define XB_TOP      3328
#define XB_TOPGEN   3392
#define XB_SPIN_CAP (1u << 22)
DEVI unsigned xb_ld(unsigned* p)              { return __hip_atomic_load(p, __ATOMIC_RELAXED, __HIP_MEMORY_SCOPE_AGENT); }
DEVI unsigned xb_add(unsigned* p, unsigned v) { return __hip_atomic_fetch_add(p, v, __ATOMIC_RELAXED, __HIP_MEMORY_SCOPE_AGENT); }
DEVI unsigned xb_xcc_id() { return (unsigned)__builtin_amdgcn_s_getreg((3 << 11) | 20) & 0xFu; }
#define XB_SPIN(cond, bar) do { unsigned _sp = 0; while (cond) { __builtin_amdgcn_s_sleep(1); \
    if ((++_sp & 255u) == 0u) { if (xb_ld(&(bar)[XB_TMO])) break; if (_sp > XB_SPIN_CAP) { atomicAdd(&(bar)[XB_TMO], 1u); break; } } } } while (0)
struct XcdBarrier { unsigned* bar; unsigned x; volatile LDS unsigned* st; };
DEVI XcdBarrier xcd_barrier_post(unsigned* bar, volatile LDS unsigned* st) {
  XcdBarrier b; b.bar = bar; b.x = xb_xcc_id(); b.st = st;
  if (threadIdx.x == 0) (void)xb_add(&bar[XB_XCNT(b.x)], 1u);
  return b;
}
DEVI void xcd_barrier_complete(unsigned* bar, unsigned x, unsigned& nloc, unsigned& nx) {
  const unsigned G = gridDim.x * gridDim.y * gridDim.z;
  unsigned sum, cnt, mine, sp = 0u;
  for (;;) {
    sum = 0u; cnt = 0u; mine = 0u;
#pragma unroll
    for (unsigned j = 0; j < 16; ++j) { const unsigned c = xb_ld(&bar[XB_XCNT(j)]); sum += c; cnt += (c > 0u) ? 1u : 0u; mine = (j == x) ? c : mine; }
    if (sum == G) break;
    __builtin_amdgcn_s_sleep(1);
    if ((++sp & 255u) == 0u) { if (xb_ld(&bar[XB_TMO])) break; if (sp > XB_SPIN_CAP) { atomicAdd(&bar[XB_TMO], 1u); break; } }
  }
  nloc = mine > 0u ? mine : 1u; nx = cnt > 0u ? cnt : 1u;
}
DEVI void xcd_barrier(const XcdBarrier& b) {
  asm volatile("s_waitcnt vmcnt(0)" ::: "memory");
  __syncthreads();
  if (threadIdx.x == 0) {
    unsigned* bar = b.bar;
    __builtin_amdgcn_s_waitcnt(0);
    unsigned nloc = b.st[0], nx = b.st[1];
    if (nloc == 0u) { xcd_barrier_complete(bar, b.x, nloc, nx); b.st[0] = nloc; b.st[1] = nx; }
    const unsigned old = xb_add(&bar[XB_XSUB(b.x)], 1u);
    const unsigned gen = old / nloc;
    if (old + 1u == (gen + 1u) * nloc) {
      __builtin_amdgcn_fence(__ATOMIC_RELEASE, "agent");
      asm volatile("s_waitcnt vmcnt(0)" ::: "memory");
      const unsigned og = xb_add(&bar[XB_TOP], 1u);
      const unsigned tg = og / nx;
      if (og + 1u == (tg + 1u) * nx) xb_add(&bar[XB_TOPGEN], 1u);
      else XB_SPIN(xb_ld(&bar[XB_TOPGEN]) == tg, bar);
      __builtin_amdgcn_fence(__ATOMIC_ACQUIRE, "agent");
      xb_add(&bar[XB_XGEN(b.x)], 1u);
      asm volatile("s_waitcnt vmcnt(0)" ::: "memory");
    } else {
      XB_SPIN(xb_ld(&bar[XB_XGEN(b.x)]) == gen, bar);
      __builtin_amdgcn_fence(__ATOMIC_ACQUIRE, "agent");
      asm volatile("s_waitcnt vmcnt(0)" ::: "memory");
    }
  }
  __syncthreads();
}

__global__ void __launch_bounds__(NTHR) fwd_kernel(Params p) {
  extern __shared__ __attribute__((aligned(16))) unsigned char smem[];
  LDS unsigned char* lds = (LDS unsigned char*)smem;
  const int lo = p.ph_lo, hi = p.ph_hi;
  volatile LDS unsigned* bst = (volatile LDS unsigned*)(lds + LDS_BYTES - 16);
  if (threadIdx.x < 4) bst[threadIdx.x] = 0u;
  __syncthreads();
  (void)xcd_barrier_post((unsigned*)(p.ws + WS_BAR), bst);
#ifndef REPEAT_PHASE
#define REPEAT_PHASE -1
#endif
#define GRID_SYNC(k) do { { XcdBarrier xb_; xb_.bar = (unsigned*)(get_params()->ws + WS_BAR); xb_.x = xb_xcc_id(); xb_.st = (volatile LDS unsigned*)(lds + LDS_BYTES - 16); xcd_barrier(xb_); } } while (0)
#define RUN_PHASE(k, fn) if (lo <= (k) && (k) < hi) { fn(*get_params(), lds); if ((k) == REPEAT_PHASE) { GRID_SYNC(k); fn(*get_params(), lds); } if ((k) + 1 < hi) GRID_SYNC(k); }
  RUN_PHASE(0, phase0)
  RUN_PHASE(1, phase1)
  RUN_PHASE(2, phase2)
  RUN_PHASE(3, phase3)
  RUN_PHASE(4, phase4)
  RUN_PHASE(5, phase5)
  RUN_PHASE(6, phase6)
  RUN_PHASE(7, phase7)
  RUN_PHASE(8, phase8)
  RUN_PHASE(9, phase9)
#undef GRID_SYNC
#undef RUN_PHASE
}

extern "C" void kernel_launch(void* const* d_in, const int* in_sizes, int n_in, void* d_out, int out_size, void* d_ws, size_t ws_size, hipStream_t stream) {
  static int grid = 0;
  if (grid == 0) {
    if (n_in != 24 || out_size != NTOK * DM || ws_size < WS_END) { fprintf(stderr, "kernel_launch: unexpected problem (n_in %d out %d ws %zu)\n", n_in, out_size, ws_size); grid = -1; return; }
    (void)hipFuncSetAttribute((const void*)fwd_kernel, hipFuncAttributeMaxDynamicSharedMemorySize, LDS_BYTES);
    int dev = 0, cus = 0, per_cu = 0;
    (void)hipGetDevice(&dev);
    (void)hipDeviceGetAttribute(&cus, hipDeviceAttributeMultiprocessorCount, dev);
    (void)hipOccupancyMaxActiveBlocksPerMultiprocessor(&per_cu, (const void*)fwd_kernel, NTHR, LDS_BYTES);
    if (per_cu < 1 || cus < 256) fprintf(stderr, "kernel_launch: occupancy %d blocks/CU on %d CUs\n", per_cu, cus);
    grid = 256;
  }
  if (grid < 0) return;
  (void)hipMemsetAsync((char*)d_ws + WS_CNT, 0, CTL_ZERO_BYTES, stream);
  Params p{};
  for (int i = 0; i < 24; ++i) p.in[i] = (const float*)d_in[i];
  p.out = (float*)d_out; p.ws = (unsigned char*)d_ws;
#if N_LAUNCH_MODE == 1
  p.ph_lo = 0; p.ph_hi = NPHASE;
  void* args[] = {&p};
  hipError_t e = hipLaunchCooperativeKernel((const void*)fwd_kernel, dim3(grid), dim3(NTHR), args, LDS_BYTES, stream);
  if (e != hipSuccess) fprintf(stderr, "cooperative launch failed: %s\n", hipGetErrorString(e));
#else
  for (int ph = 0; ph < NPHASE; ++ph) {
    p.ph_lo = ph; p.ph_hi = ph + 1;
    hipLaunchKernelGGL(fwd_kernel, dim3(grid), dim3(NTHR), LDS_BYTES, stream, p);
  }
#endif
}
```

```cpp
#include <hip/hip_runtime.h>
#include <cstdio>
#include <cstdint>

#ifndef N_LAUNCH_MODE
#define N_LAUNCH_MODE 1
#endif

#define DEVI __device__ __forceinline__
#define LDS __attribute__((address_space(3)))

typedef _Float16 h16;
typedef _Float16 h16x4 __attribute__((ext_vector_type(4)));
typedef _Float16 h16x8 __attribute__((ext_vector_type(8)));
typedef float f32x4 __attribute__((ext_vector_type(4)));
typedef float f32x16 __attribute__((ext_vector_type(16)));
typedef unsigned u32x2 __attribute__((ext_vector_type(2)));
typedef unsigned u32x4 __attribute__((ext_vector_type(4)));

constexpr int NBATCH = 4, SEQ = 8192, NTOK = NBATCH * SEQ, DM = 1024;
constexpr int NTHR = 512;
constexpr int NPHASE = 10;
constexpr int LDS_BYTES = 163840;

constexpr size_t MiB = 1ull << 20;
constexpr size_t WS_CNT = 0;
constexpr size_t CTL_ZERO_BYTES = 20480;
constexpr size_t WS_BAR = 4096;
constexpr size_t WS_MODP = 64 * 1024;
constexpr size_t WS_ROPE = 1 * MiB;
constexpr size_t WS_WIN = 3 * MiB;
constexpr size_t WS_WOUT = 10 * MiB;
constexpr size_t WS_WGU = 12 * MiB;
constexpr size_t WS_WDN = 44 * MiB;
constexpr size_t WS_WRG = 60 * MiB;
constexpr size_t WS_WRH = 60 * MiB + 512 * 1024;
constexpr size_t WS_WRL = 60 * MiB + 640 * 1024;
constexpr size_t WS_AGG = 61 * MiB;
constexpr size_t WS_ROUTE = 63 * MiB;
constexpr size_t WS_LIST = 64 * MiB;
constexpr size_t WS_LISTW = 68 * MiB;
constexpr size_t WS_WI = 72 * MiB;
constexpr size_t WS_KI = 73 * MiB;
constexpr size_t WS_MASK = 77 * MiB;
constexpr size_t WS_H = 109 * MiB;
constexpr size_t WS_Q = 173 * MiB;
constexpr size_t WS_K = 205 * MiB;
constexpr size_t WS_VT = 237 * MiB;
constexpr size_t WS_QI = 269 * MiB;
constexpr size_t WS_XR = 301 * MiB;
constexpr size_t WS_XG = 333 * MiB;
constexpr size_t WS_MIX = 365 * MiB;
constexpr size_t WS_ACT = 429 * MiB;
constexpr size_t WS_YP = 173 * MiB;
constexpr size_t WS_END = 510 * MiB;
constexpr size_t SC_BATCH_BYTES = 8192ull * 6176ull;
static_assert(SC_BATCH_BYTES <= 64 * MiB && WS_MIX + 3 * SC_BATCH_BYTES <= WS_END, "score slots");

struct Params { const float* in[24]; float* out; unsigned char* ws; int ph_lo, ph_hi; };
typedef const __attribute__((address_space(4))) Params& PRef;
typedef const __attribute__((address_space(4))) Params* PPtr;

__device__ const double ROPE_REV[32] = {
  1.59154943091895345608e-01, 1.19349370211248861917e-01, 8.94994016088910132600e-02, 6.71150830052272551196e-02,
  5.03292121044870352509e-02, 3.77415847174197710556e-02, 2.83021958306233986646e-02, 2.12236527647776604399e-02,
  1.59154943091895338669e-02, 1.19349370211248861917e-02, 8.94994016088910236684e-03, 6.71150830052272533849e-03,
  5.03292121044870369856e-03, 3.77415847174197719230e-03, 2.83021958306233986646e-03, 2.12236527647776621747e-03,
  1.59154943091895356017e-03, 1.19349370211248848907e-03, 8.94994016088910236684e-04, 6.71150830052272598901e-04,
  5.03292121044870326488e-04, 3.77415847174197740914e-04, 2.83021958306233954120e-04, 2.12236527647776605484e-04,
  1.59154943091895350596e-04, 1.19349370211248862459e-04, 8.94994016088910182474e-05, 6.71150830052272544691e-05,
  5.03292121044870353593e-05, 3.77415847174197768019e-05, 2.83021958306233960897e-05, 2.12236527647776591931e-05};

DEVI int launder(int x) { asm volatile("" : "+v"(x)); return x; }
DEVI PPtr get_params() { PPtr k = (PPtr)__builtin_amdgcn_kernarg_segment_ptr(); asm volatile("" : "+s"(k)); return k; }
DEVI int wave_id(int tid) { return __builtin_amdgcn_readfirstlane(tid >> 6); }
DEVI f32x16 mfma16(h16x8 a, h16x8 b, f32x16 c) { return __builtin_amdgcn_mfma_f32_32x32x16_f16(a, b, c, 0, 0, 0); }
DEVI float wave_sum(float v) {
#pragma unroll
  for (int o = 1; o < 64; o <<= 1) v += __shfl_xor(v, o);
  return v;
}
DEVI float sigmoid_f(float x) { return __builtin_amdgcn_rcpf(1.f + __expf(-x)); }
DEVI float silu_f(float x) { return x * __builtin_amdgcn_rcpf(1.f + __expf(-x)); }
DEVI float gelu_tanh_f(float x) {
  const float u = 0.7978845608028654f * (x + 0.044715f * x * x * x);
  const float t = 1.f - 2.f * __builtin_amdgcn_rcpf(1.f + __expf(2.f * u));
  return 0.5f * x * (1.f + t);
}
DEVI unsigned fkey(float f) { unsigned u = __float_as_uint(f); return (u & 0x80000000u) ? ~u : (u | 0x80000000u); }
DEVI float fkey_inv(unsigned k) { unsigned u = (k & 0x80000000u) ? (k & 0x7fffffffu) : ~k; return __uint_as_float(u); }
DEVI int vt_perm(int pos) { return (pos & ~12) | ((pos & 4) << 1) | ((pos & 8) >> 1); }

DEVI void mod_to_lds(PRef p, int b, int chunk, LDS float* dst) {
  const float* mp = (const float*)(p.ws + WS_MODP);
  for (int k = threadIdx.x; k < 1024; k += NTHR) {
    const int j = chunk * 1024 + k;
    float v[8];
#pragma unroll
    for (int ks = 0; ks < 8; ++ks) v[ks] = mp[(size_t)(ks * 4 + b) * 6144 + j];
    float s = p.in[3][j];
#pragma unroll
    for (int ks = 0; ks < 8; ++ks) s += v[ks];
    dst[k] = s;
  }
}

constexpr int LROW = 144;

namespace g8 {
constexpr int BM = 256, BK = 64, HALF = 128, HTB = HALF * BK * 2, STAGE_BYTES = 8 * HTB;
DEVI int lds_byte(int r, int c) { const int st = (r >> 4) * 2 + (c >> 5), rr = r & 15, cc = c & 31, ob = rr * 64 + cc * 2; return st * 1024 + (ob ^ (((ob >> 9) & 1) << 5)); }
DEVI void stage_rc(int b, int& R, int& C) { const int st = b / 1024, sb = b % 1024, swz = sb ^ (((sb >> 9) & 1) << 5); R = (st >> 1) * 16 + swz / 64; C = (st & 1) * 32 + (swz % 64) / 2; }
struct Unit { const char* A; unsigned va[2][2]; const char* B; int pm, pn, e, cnt, off; };
DEVI void glds16(const char* src, LDS unsigned char* dst) { __builtin_amdgcn_global_load_lds((const unsigned*)src, (LDS unsigned*)dst, 16, 0, 0); }

DEVI void dense_va(unsigned (&va)[2][2], int K) {
  const int tid = threadIdx.x;
#pragma unroll
  for (int h = 0; h < 2; ++h)
#pragma unroll
    for (int i = 0; i < 2; ++i) { int R, C; stage_rc(tid * 16 + i * 8192, R, C); va[h][i] = (unsigned)((128 * h + R) * K + C) * 2u; }
}
template <class Sched, class Epi>
DEVI void gemm_phase(LDS unsigned char* lds, int K, const Sched& S, const Epi& E) {
  const int tid = launder((int)threadIdx.x), wid = wave_id(tid), lane = tid & 63, wr = wid >> 2, wc = wid & 3, fr = lane & 15, fq = lane >> 4;
  const int nt = launder(K) / BK;
  unsigned vb[2];
#pragma unroll
  for (int i = 0; i < 2; ++i) { int R, C; stage_rc(tid * 16 + i * 8192, R, C); vb[i] = (unsigned)(R * K + C) * 2u; }
  const size_t kstep = (size_t)(BK * 2), hstep = (size_t)HALF * K * 2;
  const unsigned ldsw = (unsigned)wid * 1024u;
  const int aoff = lds_byte(wr * 64 + fr, fq * 8), boff = lds_byte(wc * 32 + fr, fq * 8);
#define G8_SA(b, h) (((b) * 2 + (h)) * HTB)
#define G8_SB(b, h) ((4 + (b) * 2 + (h)) * HTB)
#define G8_STAGE(bufoff, gbase, v) do { glds16((gbase) + (v)[0], lds + (bufoff) + ldsw); glds16((gbase) + (v)[1], lds + (bufoff) + ldsw + 8192); } while (0)
#define G8_STAGEA(bufoff, gbase, h) do { glds16((gbase) + G8_VAC(h, 0), lds + (bufoff) + ldsw); glds16((gbase) + G8_VAC(h, 1), lds + (bufoff) + ldsw + 8192); } while (0)
#define G8_LDA(dst, b, h) do { _Pragma("unroll") for (int m = 0; m < 4; ++m) _Pragma("unroll") for (int k = 0; k < 2; ++k) dst[m][k] = *(const LDS h16x8*)(lds + G8_SA(b, h) + aoff + m * 2048 + k * 1024); } while (0)
#define G8_LDB(dst, b, h) do { _Pragma("unroll") for (int n = 0; n < 2; ++n) _Pragma("unroll") for (int k = 0; k < 2; ++k) dst[n][k] = *(const LDS h16x8*)(lds + G8_SB(b, h) + boff + n * 2048 + k * 1024); } while (0)
#define G8_MMA(ai, bj, At, Bt) do { __builtin_amdgcn_s_setprio(1); _Pragma("unroll") for (int m = 0; m < 4; ++m) _Pragma("unroll") for (int n = 0; n < 2; ++n) _Pragma("unroll") for (int k = 0; k < 2; ++k) \
        acc[ai][bj][m][n] = __builtin_amdgcn_mfma_f32_16x16x32_f16(Bt[n][k], At[m][k], acc[ai][bj][m][n], 0, 0, 0); __builtin_amdgcn_s_setprio(0); } while (0)
#define G8_WAIT_V(n) asm volatile("s_waitcnt vmcnt(" #n ")" ::: "memory")
#define G8_WAIT_L(n) asm volatile("s_waitcnt lgkmcnt(" #n ")" ::: "memory")
#define G8_BAR __builtin_amdgcn_s_barrier()
#define G8_SCHED __builtin_amdgcn_sched_barrier(0)
  Unit cur, nxt; int ui = 0;
  if (!S.next(0, cur)) return;
  unsigned vd[2][2];
  if (!Sched::GATHER) dense_va(vd, K);
#define G8_VAC(h, i) (Sched::GATHER ? cur.va[h][i] : vd[h][i])
#define G8_VAN(h, i) (Sched::GATHER ? nxt.va[h][i] : vd[h][i])
  f32x4 acc[2][2][4][2];
#pragma unroll
  for (int a = 0; a < 2; ++a)
#pragma unroll
    for (int b = 0; b < 2; ++b)
#pragma unroll
      for (int m = 0; m < 4; ++m)
#pragma unroll
        for (int n = 0; n < 2; ++n) acc[a][b][m][n] = (f32x4){0.f, 0.f, 0.f, 0.f};
  h16x8 At[4][2], B0[2][2], B1[2][2];
  const char* cA = cur.A; const char* cB = cur.B;
  G8_STAGE(G8_SB(0, 0), cB, vb); G8_STAGE(G8_SB(0, 1), cB + hstep, vb); G8_STAGEA(G8_SA(0, 0), cA, 0); G8_STAGEA(G8_SA(0, 1), cA, 1);
  if (wr == 1) G8_BAR;
  G8_WAIT_V(2); G8_BAR;
  G8_STAGE(G8_SB(1, 0), cB + kstep, vb); G8_STAGEA(G8_SA(1, 0), cA + kstep, 0); G8_STAGE(G8_SB(1, 1), cB + hstep + kstep, vb);
  G8_WAIT_V(6); G8_BAR;
  for (;;) {
    const bool has_next = S.next(ui + 1, nxt);
    if (!has_next) nxt = cur;
    const char* nA = nxt.A; const char* nB = nxt.B;
#pragma unroll 1
    for (int t = 0; t < nt; t += 2) {
      const bool last = (t == nt - 2);
      const char* a1 = cA + (size_t)(t + 1) * kstep;
      const char* a2 = last ? nA : cA + (size_t)(t + 2) * kstep; const char* b2 = last ? nB : cB + (size_t)(t + 2) * kstep;
      const char* a3 = a2 + kstep; const char* b3 = b2 + kstep;
#define G8_STAGE2(bufoff, gbase, h) do { glds16((gbase) + (last ? G8_VAN(h, 0) : G8_VAC(h, 0)), lds + (bufoff) + ldsw); glds16((gbase) + (last ? G8_VAN(h, 1) : G8_VAC(h, 1)), lds + (bufoff) + ldsw + 8192); } while (0)
      G8_LDB(B0, 0, 0); G8_LDB(B1, 0, 1); G8_SCHED; G8_LDA(At, 0, 0); G8_STAGEA(G8_SA(1, 1), a1, 1);
      G8_WAIT_V(8); G8_WAIT_L(0); G8_BAR; G8_MMA(0, 0, At, B0); G8_MMA(0, 1, At, B1); G8_BAR; G8_SCHED;
      G8_LDA(At, 0, 1); G8_STAGE(G8_SB(0, 0), b2, vb); G8_STAGE(G8_SB(0, 1), b2 + hstep, vb); G8_STAGE2(G8_SA(0, 0), a2, 0);
      G8_WAIT_V(8); G8_WAIT_L(0); G8_BAR; G8_MMA(1, 0, At, B0); G8_MMA(1, 1, At, B1); G8_BAR; G8_SCHED;
      G8_LDB(B0, 1, 0); G8_LDB(B1, 1, 1); G8_SCHED; G8_LDA(At, 1, 0); G8_STAGE2(G8_SA(0, 1), a2, 1);
      G8_WAIT_V(8); G8_WAIT_L(0); G8_BAR; G8_MMA(0, 0, At, B0); G8_MMA(0, 1, At, B1); G8_BAR; G8_SCHED;
      G8_LDA(At, 1, 1); G8_STAGE(G8_SB(1, 0), b3, vb); G8_STAGE(G8_SB(1, 1), b3 + hstep, vb); G8_STAGE2(G8_SA(1, 0), a3, 0);
      G8_WAIT_V(8); G8_WAIT_L(0); G8_BAR; G8_MMA(1, 0, At, B0); G8_MMA(1, 1, At, B1); G8_BAR; G8_SCHED;
    }
#undef G8_STAGE2
    if (wr == 0) G8_BAR;
    E(acc, cur, wr, wc, fr, fq);
    if (!has_next) break;
#pragma unroll
    for (int a = 0; a < 2; ++a)
#pragma unroll
      for (int b = 0; b < 2; ++b)
#pragma unroll
        for (int m = 0; m < 4; ++m)
#pragma unroll
          for (int n = 0; n < 2; ++n) acc[a][b][m][n] = (f32x4){0.f, 0.f, 0.f, 0.f};
    cur = nxt; cA = nA; cB = nB; ++ui;
    if (wr == 1) G8_BAR;
  }
  G8_WAIT_V(0);
  G8_BAR;
#undef G8_SA
#undef G8_STAGEA
#undef G8_VAC
#undef G8_VAN
#undef G8_SB
#undef G8_STAGE
#undef G8_LDA
#undef G8_LDB
#undef G8_MMA
#undef G8_WAIT_V
#undef G8_WAIT_L
#undef G8_BAR
#undef G8_SCHED
}
struct DenseOrder {
  static constexpr bool GATHER = false;
  const h16* A; const h16* Bt; int K, nM, nN, G, c;
  DEVI bool next(int i, Unit& u) const {
    const int nwg = nM * nN; const long L = (long)i * G + c; if (L >= nwg) return false;
    int wgid = (int)L; { const int q = nwg / 8, r = nwg % 8, xcd = wgid % 8, off = wgid / 8; wgid = (xcd < r ? xcd * (q + 1) : r * (q + 1) + (xcd - r) * q) + off; }
    const int nig = 8 * nN, gid = wgid / nig, fm = gid * 8, gsz = (nM - fm) < 8 ? (nM - fm) : 8;
    u.pm = fm + ((wgid % nig) % gsz); u.pn = (wgid % nig) / gsz; u.e = 0; u.cnt = 0x7fffffff; u.off = 0;
    u.A = (const char*)(A + (size_t)u.pm * 256 * K); u.B = (const char*)(Bt + (size_t)u.pn * 256 * K);
    u.va[0][0] = u.va[0][1] = u.va[1][0] = u.va[1][1] = 0u;
    return true;
  }
};
}


DEVI h16x4 pack4(float a, float b, float c, float d) { h16x4 v; v[0] = (h16)a; v[1] = (h16)b; v[2] = (h16)c; v[3] = (h16)d; return v; }

template <class F>
DEVI void transpose_item(const float* src, int N, int kb, int nb, h16* dst, int ldd, F drow, LDS float* scr, int lane) {
#pragma unroll 8
  for (int i = 0; i < 32; ++i) {
    const int kk = 2 * i + (lane >> 5), n = nb * 32 + (lane & 31);
    scr[kk * 33 + (lane & 31)] = (n < N) ? src[(size_t)(kb * 64 + kk) * N + n] : 0.f;
  }
  asm volatile("s_waitcnt lgkmcnt(0)" ::: "memory");
  const int c = lane & 7;
#pragma unroll
  for (int j = 0; j < 4; ++j) {
    const int nl = (lane >> 3) + 8 * j, n = nb * 32 + nl;
    h16x8 v;
#pragma unroll
    for (int e = 0; e < 8; ++e) v[e] = (h16)scr[(c * 8 + e) * 33 + nl];
    if (n < N) *(h16x8*)(dst + (size_t)drow(n) * ldd + kb * 64 + c * 8) = v;
  }
  asm volatile("s_waitcnt lgkmcnt(0)" ::: "memory");
}

DEVI void phase0(PRef p, LDS unsigned char* lds) {
  const int tid = launder((int)threadIdx.x), lane = tid & 63, wave = wave_id(tid), G = gridDim.x;
  const int gw = blockIdx.x * 8 + wave, NW = G * 8;
  {
    const float* c = p.in[1]; const float* wada = p.in[2]; float* mp = (float*)(p.ws + WS_MODP);
    for (int u = gw; u < 96 * 8; u += NW) {
      const int cgp = u % 96, ks = u / 96, j = cgp * 64 + lane;
      float a0 = 0.f, a1 = 0.f, a2 = 0.f, a3 = 0.f;
      for (int k0 = ks * 128; k0 < ks * 128 + 128; k0 += 16) {
        float w[16];
#pragma unroll
        for (int u = 0; u < 16; ++u) w[u] = wada[(size_t)(k0 + u) * 6144 + j];
#pragma unroll
        for (int u = 0; u < 16; ++u) {
          const int k = k0 + u;
          a0 = fmaf(silu_f(c[k]), w[u], a0); a1 = fmaf(silu_f(c[1024 + k]), w[u], a1);
          a2 = fmaf(silu_f(c[2048 + k]), w[u], a2); a3 = fmaf(silu_f(c[3072 + k]), w[u], a3);
        }
      }
      mp[(size_t)(ks * 4 + 0) * 6144 + j] = a0; mp[(size_t)(ks * 4 + 1) * 6144 + j] = a1;
      mp[(size_t)(ks * 4 + 2) * 6144 + j] = a2; mp[(size_t)(ks * 4 + 3) * 6144 + j] = a3;
    }
  }
  {
    LDS float* scr = (LDS float*)lds + wave * (64 * 33);
    constexpr int I_IN = 16 * 99, I_OUT = 16 * 32, I_G = 32 * 128, I_U = 32 * 128, I_D = 32 * 128, I_RG = 32;
    constexpr int NIT = I_IN + I_OUT + I_G + I_U + I_D + I_RG;
    for (int it = gw; it < NIT; it += NW) {
      int r = it;
      if (r < I_IN) {
        transpose_item(p.in[8], 3144, r / 99, r % 99, (h16*)(p.ws + WS_WIN), 1024,
                       [](int n) { const int dl = n < 2112 ? n : (n < 2120 ? 3136 + (n - 2112) : (n < 2632 ? 2112 + (n - 2120) : 2624 + (n - 2632)));
                                     const int d = dl & 63, sx = (dl >> 6) & 3;
                                     return (dl & ~255) + 128 * (d >> 5) + 32 * sx + 16 * ((d >> 2) & 1) + 4 * ((d >> 3) & 3) + (d & 3); }, scr, lane);
        continue;
      }
      r -= I_IN;
      if (r < I_OUT) { transpose_item(p.in[16], 1024, r / 32, r % 32, (h16*)(p.ws + WS_WOUT), 1024, [](int n) { return (n & ~31) + 16 * ((n >> 2) & 1) + 4 * ((n >> 3) & 3) + (n & 3); }, scr, lane); continue; }
      r -= I_OUT;
      if (r < I_G) { const int e = r >> 7, q = r & 127;
        transpose_item(p.in[21] + (size_t)e * 1024 * 256, 256, q >> 3, q & 7, (h16*)(p.ws + WS_WGU) + (size_t)e * 512 * 1024, 1024, [](int f) { return (f >> 4) * 32 + (f & 15); }, scr, lane); continue; }
      r -= I_G;
      if (r < I_U) { const int e = r >> 7, q = r & 127;
        transpose_item(p.in[22] + (size_t)e * 1024 * 256, 256, q >> 3, q & 7, (h16*)(p.ws + WS_WGU) + (size_t)e * 512 * 1024, 1024, [](int f) { return (f >> 4) * 32 + 16 + (f & 15); }, scr, lane); continue; }
      r -= I_U;
      if (r < I_D) { const int e = r >> 7, q = r & 127;
        transpose_item(p.in[23] + (size_t)e * 256 * 1024, 1024, q >> 5, q & 31, (h16*)(p.ws + WS_WDN) + (size_t)e * 1024 * 256, 256, [](int n) { return (n & ~31) + 16 * ((n >> 2) & 1) + 4 * ((n >> 3) & 3) + (n & 3); }, scr, lane); continue; }
      r -= I_D;
      if (r < 16) transpose_item(p.in[11] + (size_t)(r >> 1) * 4096, 64, 0, r & 1, (h16*)(p.ws + WS_WRG) + (size_t)(r >> 1) * 128 * 64, 64, [](int n) { return n; }, scr, lane);
      else transpose_item(p.in[13] + (size_t)((r - 16) >> 1) * 4096, 64, 0, r & 1, (h16*)(p.ws + WS_WRG) + (size_t)((r - 16) >> 1) * 128 * 64, 64, [](int n) { return 64 + n; }, scr, lane);
    }
  }
  {
    h16* wrh = (h16*)(p.ws + WS_WRH); h16* wrl = (h16*)(p.ws + WS_WRL);
    for (int i = blockIdx.x * NTHR + tid; i < 48 * 1024; i += G * NTHR) {
      const int col = i >> 10, k = i & 1023;
      const float w = (col < 4) ? p.in[17][k * 4 + col] : (col < 36 ? p.in[19][k * 32 + (col - 4)] : 0.f);
      const h16 hi = (h16)w;
      wrh[i] = hi; wrl[i] = (h16)(w - (float)hi);
    }
    float* ct = (float*)(p.ws + WS_ROPE); float* st = ct + 8192 * 32;
    for (int i = blockIdx.x * NTHR + tid; i < 8192 * 32; i += G * NTHR) {
      const int pos = i >> 5, f = i & 31;
      const double rev = (double)pos * ROPE_REV[f];
      const float fr = (float)(rev - __builtin_rint(rev));
      ct[i] = __builtin_amdgcn_cosf(fr); st[i] = __builtin_amdgcn_sinf(fr);
    }
  }
}

DEVI void phase1(PRef p, LDS unsigned char* lds) {
  const int tid = launder((int)threadIdx.x), lane = tid & 63, wave = wave_id(tid), G = gridDim.x;
  const int b = blockIdx.x & 3, bi = blockIdx.x >> 2, nbk = G >> 2;
  LDS float* mv = (LDS float*)lds;
  mod_to_lds(p, b, 0, mv); mod_to_lds(p, b, 1, mv + 1024);
  __syncthreads();
  f32x4 A[4], SH[4];
#pragma unroll
  for (int j = 0; j < 4; ++j) {
    const int k = 256 * j + 4 * lane;
    const f32x4 g = *(const f32x4*)(p.in[4] + k);
    A[j] = g * (*(LDS f32x4*)(mv + 1024 + k) + 1.f);
    SH[j] = *(LDS f32x4*)(mv + k);
  }
  const float* x = p.in[0]; h16* H = (h16*)(p.ws + WS_H);
  f32x4 vn[4];
  {
    const size_t tok = (size_t)b * SEQ + bi * 8 + wave;
#pragma unroll
    for (int j = 0; j < 4; ++j) vn[j] = *(const f32x4*)(x + tok * DM + 256 * j + 4 * lane);
  }
  for (int r = bi * 8 + wave; r < SEQ; r += nbk * 8) {
    const size_t tok = (size_t)b * SEQ + r;
    f32x4 v[4]; float ss = 0.f;
#pragma unroll
    for (int j = 0; j < 4; ++j) { v[j] = vn[j]; ss += v[j][0] * v[j][0] + v[j][1] * v[j][1] + v[j][2] * v[j][2] + v[j][3] * v[j][3]; }
    if (r + nbk * 8 < SEQ) {
#pragma unroll
      for (int j = 0; j < 4; ++j) vn[j] = *(const f32x4*)(x + (tok + nbk * 8) * DM + 256 * j + 4 * lane);
    }
    const float rstd = 1.0f / sqrtf(wave_sum(ss) * (1.f / 1024.f) + 1e-6f);
#pragma unroll
    for (int j = 0; j < 4; ++j) {
      const f32x4 y = v[j] * rstd * A[j] + SH[j];
      *(h16x4*)(H + tok * DM + 256 * j + 4 * lane) = pack4(y[0], y[1], y[2], y[3]);
    }
  }
}

DEVI h16x8 pack8(const f32x4& a, const f32x4& b) { h16x8 w; w[0] = (h16)a[0]; w[1] = (h16)a[1]; w[2] = (h16)a[2]; w[3] = (h16)a[3]; w[4] = (h16)b[0]; w[5] = (h16)b[1]; w[6] = (h16)b[2]; w[7] = (h16)b[3]; return w; }
struct EpiInProj {
  unsigned char* ws;
  DEVI void operator()(const f32x4 (&acc)[2][2][4][2], const g8::Unit& u, int wr, int wc, int fr, int fq) const {
    const float* cosT = (const float*)(ws + WS_ROPE); const float* sinT = cosT + 8192 * 32;
    const int g = 4 * u.pn + wc;
    if (g > 49) return;
    const int d0 = 8 * fq;
#pragma unroll
    for (int ai = 0; ai < 2; ++ai)
#pragma unroll
      for (int m = 0; m < 4; ++m) {
        const int tok = u.pm * 256 + 128 * ai + 64 * wr + 16 * m + fr;
        const int b = tok >> 13, pos = tok & 8191;
        const f32x4 xa = acc[ai][0][m][0], xb = acc[ai][0][m][1], ya = acc[ai][1][m][0], yb = acc[ai][1][m][1];
        if (g < 16 || (g >= 24 && g <= 32)) {
          float scl; h16* dst;
          if (g < 8) { scl = 0.125f * 1.4426950408889634f; dst = (h16*)(ws + WS_Q) + (size_t)tok * 512 + g * 64; }
          else if (g < 16) { scl = 1.f; dst = (h16*)(ws + WS_K) + (size_t)tok * 512 + (g - 8) * 64; }
          else if (g < 32) { scl = 0.125f; dst = (h16*)(ws + WS_QI) + (size_t)tok * 512 + (g - 24) * 64; }
          else { scl = 1.f; dst = (h16*)(ws + WS_KI) + (size_t)tok * 64; }
          const f32x4 ca = *(const f32x4*)(cosT + pos * 32 + d0), cb = *(const f32x4*)(cosT + pos * 32 + d0 + 4);
          const f32x4 sa = *(const f32x4*)(sinT + pos * 32 + d0), sb = *(const f32x4*)(sinT + pos * 32 + d0 + 4);
          *(h16x8*)(dst + d0) = pack8((xa * ca - ya * sa) * scl, (xb * cb - yb * sb) * scl);
          *(h16x8*)(dst + 32 + d0) = pack8((ya * ca + xa * sa) * scl, (yb * cb + xb * sb) * scl);
        } else if (g < 24) {
          h16* vt = (h16*)(ws + WS_VT) + (size_t)(b * 8 + (g - 16)) * 64 * 8192 + vt_perm(pos);
#pragma unroll
          for (int e = 0; e < 4; ++e) {
            vt[(size_t)(d0 + e) * 8192] = (h16)xa[e]; vt[(size_t)(d0 + 4 + e) * 8192] = (h16)xb[e];
            vt[(size_t)(32 + d0 + e) * 8192] = (h16)ya[e]; vt[(size_t)(36 + d0 + e) * 8192] = (h16)yb[e];
          }
        } else if (g < 49) {
          h16* dst = (g < 41) ? (h16*)(ws + WS_XR) + (size_t)tok * 512 + (g - 33) * 64 : (h16*)(ws + WS_XG) + (size_t)tok * 512 + (g - 41) * 64;
          *(h16x8*)(dst + d0) = pack8(xa, xb);
          *(h16x8*)(dst + 32 + d0) = pack8(ya, yb);
        } else if (fq == 0) {
          const float sc = 0.35355339059327373f;
          float* wi = (float*)(ws + WS_WI) + (size_t)tok * 8;
          *(f32x4*)wi = xa * sc; *(f32x4*)(wi + 4) = xb * sc;
        }
      }
  }
};

DEVI void phase2(PRef p, LDS unsigned char* lds) {
  g8::DenseOrder S{(const h16*)(p.ws + WS_H), (const h16*)(p.ws + WS_WIN), DM, 128, 13, (int)gridDim.x, (int)blockIdx.x};
  EpiInProj E{p.ws};
  g8::gemm_phase(lds, DM, S, E);
}

constexpr int CROW = 1040;
constexpr int RNN_XG = 64 * CROW;
constexpr int RNN_CARRY = 2 * 64 * CROW;
template <int MODE>
DEVI void rnn_item(PRef p, LDS unsigned char* lds, int b, int cr) {
  const int tid = launder((int)threadIdx.x), lane = tid & 63, wave = wave_id(tid), l31 = lane & 31, half = lane >> 5;
  const h16* XR = (const h16*)(p.ws + WS_XR);
  {
    const int chg = tid & 63, tg = tid >> 6, pos0 = cr * 64 + 8 * tg;
    h16x8 xin[11];
#pragma unroll
    for (int i = 0; i < 11; ++i) {
      const int pos = pos0 + i - 3;
      if (pos >= 0) xin[i] = *(const h16x8*)(XR + ((size_t)b * SEQ + pos) * 512 + chg * 8);
      else {
#pragma unroll
        for (int e = 0; e < 8; ++e) xin[i][e] = (h16)0.f;
      }
    }
    float cw[4][8], cb[8];
#pragma unroll
    for (int e = 0; e < 8; ++e) {
      cb[e] = p.in[10][chg * 8 + e];
#pragma unroll
      for (int j = 0; j < 4; ++j) cw[j][e] = p.in[9][j * 512 + chg * 8 + e];
    }
#pragma unroll
    for (int tt = 0; tt < 8; ++tt) {
      h16x8 o;
#pragma unroll
      for (int e = 0; e < 8; ++e) {
        float v = cb[e];
#pragma unroll
        for (int j = 0; j < 4; ++j) v = fmaf(cw[j][e], (float)xin[tt + j][e], v);
        o[e] = (h16)v;
      }
      *(LDS h16x8*)(lds + (8 * tg + tt) * CROW + chg * 16) = o;
    }
  }
  if (MODE == 1) {
    const float2* ag = (const float2*)(p.ws + WS_AGG) + (size_t)b * 128 * 512 + tid;
    float carry = 0.f; int c2 = 0;
    for (; c2 + 8 <= cr; c2 += 8) {
      float2 v[8];
#pragma unroll
      for (int u = 0; u < 8; ++u) v[u] = ag[(size_t)(c2 + u) * 512];
#pragma unroll
      for (int u = 0; u < 8; ++u) carry = fmaf(v[u].x, carry, v[u].y);
    }
    for (; c2 < cr; ++c2) { const float2 v = ag[(size_t)c2 * 512]; carry = fmaf(v.x, carry, v.y); }
    ((LDS float*)(lds + RNN_CARRY))[tid] = carry;
  }
  if (MODE == 1) {
    const h16* XG = (const h16*)(p.ws + WS_XG) + ((size_t)b * SEQ + cr * 64) * 512;
#pragma unroll
    for (int i = 0; i < 8; ++i) { const int c = tid + NTHR * i, row = c >> 6, cc = c & 63; *(LDS h16x8*)(lds + RNN_XG + row * CROW + cc * 16) = *(const h16x8*)(XG + (size_t)row * 512 + cc * 8); }
  }
  __syncthreads();
  const int n = wave;
  const h16* WRG = (const h16*)(p.ws + WS_WRG) + (size_t)n * 128 * 64;
  float* AGG = (float*)(p.ws + WS_AGG);
#pragma unroll 1
  for (int dt = 0; dt < 2; ++dt) {
    h16x8 wa[4], wx[4];
#pragma unroll
    for (int kk = 0; kk < 4; ++kk) {
      wa[kk] = *(const h16x8*)(WRG + (size_t)(32 * dt + l31) * 64 + 16 * kk + 8 * half);
      wx[kk] = *(const h16x8*)(WRG + (size_t)(64 + 32 * dt + l31) * 64 + 16 * kk + 8 * half);
    }
    f32x16 ra[2], rx[2];
#pragma unroll
    for (int ti = 0; ti < 2; ++ti) {
#pragma unroll
      for (int r = 0; r < 16; ++r) { ra[ti][r] = 0.f; rx[ti][r] = 0.f; }
#pragma unroll
      for (int kk = 0; kk < 4; ++kk) {
        const h16x8 af = *(LDS h16x8*)(lds + (32 * ti + l31) * CROW + (n * 64 + 16 * kk + 8 * half) * 2);
        ra[ti] = mfma16(af, wa[kk], ra[ti]);
        rx[ti] = mfma16(af, wx[kk], rx[ti]);
      }
    }
    const int ch = n * 64 + 32 * dt + l31;
    const float ba = p.in[12][ch], bx = p.in[14][ch], lam = p.in[15][ch];
    const float c8 = -8.f * log1pf(__expf(-lam));
#pragma unroll
    for (int ti = 0; ti < 2; ++ti)
#pragma unroll
      for (int r = 0; r < 16; ++r) {
        const int tk = 32 * ti + (r & 3) + 8 * (r >> 2) + 4 * half;
        const float cv = (float)*(LDS h16*)(lds + tk * CROW + ch * 2);
        const float rr = sigmoid_f(ra[ti][r] + ba), ii = sigmoid_f(rx[ti][r] + bx);
        const float la = c8 * rr;
        ra[ti][r] = __expf(la);
        const float x2 = 2.f * la;
        const float om = -x2 * fmaf(x2 * 0.5f, fmaf(x2 * (1.f / 3.f), fmaf(x2 * 0.25f, fmaf(x2, 0.2f, 1.f), 1.f), 1.f), 1.f);
        rx[ti][r] = __builtin_amdgcn_sqrtf(om) * (ii * cv);
      }
    float P[8], Hs[8];
#pragma unroll
    for (int sg = 0; sg < 8; ++sg) {
      const int ti = sg >> 2, q = sg & 3;
      float pp = 1.f, hh = 0.f;
#pragma unroll
      for (int i = 0; i < 4; ++i) { const float a = ra[ti][4 * q + i], bb = rx[ti][4 * q + i]; hh = fmaf(a, hh, bb); pp *= a; }
      P[sg] = pp; Hs[sg] = hh;
    }
    float carry = 0.f, prod = 1.f;
    if (MODE == 1) carry = ((LDS float*)(lds + RNN_CARRY))[ch];
    float cin[8];
#pragma unroll
    for (int sg = 0; sg < 8; ++sg)
#pragma unroll
      for (int ow = 0; ow < 2; ++ow) {
        const float tmp = fmaf(P[sg], carry, Hs[sg]);
        const float tp = P[sg] * prod;
        if (half == ow) cin[sg] = carry;
        const float oth = __shfl_xor(tmp, 32), otp = __shfl_xor(tp, 32);
        carry = (half == ow) ? tmp : oth;
        prod = (half == ow) ? tp : otp;
      }
    if (MODE == 0) {
      if (half == 0) { float* ag = AGG + ((size_t)(b * 128 + cr) * 512 + ch) * 2; ag[0] = prod; ag[1] = carry; }
    } else {
#pragma unroll
      for (int sg = 0; sg < 8; ++sg) {
        const int ti = sg >> 2, q = sg & 3;
        float hh = cin[sg];
#pragma unroll
        for (int i = 0; i < 4; ++i) {
          hh = fmaf(ra[ti][4 * q + i], hh, rx[ti][4 * q + i]);
          LDS h16* xp = (LDS h16*)(lds + RNN_XG + (32 * ti + 8 * q + 4 * half + i) * CROW + ch * 2);
          *xp = (h16)(hh * gelu_tanh_f((float)*xp));
        }
      }
    }
  }
  __syncthreads();
  if (MODE == 1) {
    h16* Y = (h16*)(p.ws + WS_H) + ((size_t)b * SEQ + cr * 64) * DM + 512;
#pragma unroll
    for (int i = 0; i < 8; ++i) { const int c = tid + NTHR * i, row = c >> 6, cc = c & 63; *(h16x8*)(Y + (size_t)row * DM + cc * 8) = *(LDS h16x8*)(lds + RNN_XG + row * CROW + cc * 16); }
    __syncthreads();
  }
}

constexpr int IDX_NB = 256, IDX_CAP = 128;
constexpr int IL_HIST = 0, IL_CS = 65536, IL_CK = IL_CS + 64 * IDX_CAP * 4, IL_KI = IL_CK + 64 * IDX_CAP * 2, IL_KISZ = 128 * LROW, IL_ST = IL_KI + 2 * IL_KISZ;
static_assert(IL_ST + 4096 <= LDS_BYTES, "indexer LDS map");

DEVI f32x4 mfma16s(h16x8 a, h16x8 b, f32x4 c) { return __builtin_amdgcn_mfma_f32_16x16x32_f16(a, b, c, 0, 0, 0); }
DEVI void idx_score(LDS unsigned char* kit, int kh, int l15, int g4, const h16x8 (&qf)[8][2], const float (&wq)[8], f32x4 (&sc)[4]) {
  h16x8 kf[4][2];
#pragma unroll
  for (int kt = 0; kt < 4; ++kt)
#pragma unroll
    for (int ks = 0; ks < 2; ++ks) kf[kt][ks] = *(LDS h16x8*)(kit + (64 * kh + 16 * kt + l15) * LROW + (4 * ks + g4) * 16);
#pragma unroll
  for (int kt = 0; kt < 4; ++kt) sc[kt] = (f32x4){0.f, 0.f, 0.f, 0.f};
  f32x4 accA[4], accB[4];
#define IDX_MM(ACC, h) _Pragma("unroll") for (int kt = 0; kt < 4; ++kt) { ACC[kt] = mfma16s(kf[kt][0], qf[h][0], (f32x4){0.f, 0.f, 0.f, 0.f}); ACC[kt] = mfma16s(kf[kt][1], qf[h][1], ACC[kt]); }
#define IDX_RS(ACC, h) _Pragma("unroll") for (int kt = 0; kt < 4; ++kt) _Pragma("unroll") for (int r = 0; r < 4; ++r) sc[kt][r] = __builtin_fmaf(wq[h], __int_as_float(max(__float_as_int(ACC[kt][r]), 0)), sc[kt][r]);
  IDX_MM(accA, 0)
  IDX_MM(accB, 1) IDX_RS(accA, 0)
  IDX_MM(accA, 2) IDX_RS(accB, 1)
  IDX_MM(accB, 3) IDX_RS(accA, 2)
  IDX_MM(accA, 4) IDX_RS(accB, 3)
  IDX_MM(accB, 5) IDX_RS(accA, 4)
  IDX_MM(accA, 6) IDX_RS(accB, 5)
  IDX_MM(accB, 7) IDX_RS(accA, 6)
  IDX_RS(accB, 7)
#undef IDX_MM
#undef IDX_RS
}

template <int MODE>
DEVI void idx_pass(LDS unsigned char* lds, const h16* KIb, int N, int stride, int qg, int kh,
                   const h16* QIrow0, const float* WIrow0, float qinv, float qoff, int bstar, h16* scbase) {
  const int tid = launder((int)threadIdx.x), lane = tid & 63, l15 = lane & 15, g4 = lane >> 4;
  const int q = 16 * qg + l15;
  h16x8 qf[8][2]; float wq[8];
  {
    const h16* QI = QIrow0 + (size_t)q * 512;
#pragma unroll
    for (int h = 0; h < 8; ++h)
#pragma unroll
      for (int ks = 0; ks < 2; ++ks) qf[h][ks] = *(const h16x8*)(QI + h * 64 + 32 * ks + 8 * g4);
    const float* WI = WIrow0 + (size_t)q * 8;
#pragma unroll
    for (int h = 0; h < 8; ++h) wq[h] = WI[h];
  }
  LDS unsigned* hist = (LDS unsigned*)(lds + IL_HIST);
  LDS unsigned* st = (LDS unsigned*)(lds + IL_ST);
  const int nst = (N + 127) >> 7;
  const int lr = tid >> 3, lc = tid & 7;
  h16x8 r0, r1;
  r0 = *(const h16x8*)(KIb + (size_t)lr * 64 + lc * 8); r1 = *(const h16x8*)(KIb + (size_t)(lr + 64) * 64 + lc * 8);
  *(LDS h16x8*)(lds + IL_KI + lr * LROW + lc * 16) = r0; *(LDS h16x8*)(lds + IL_KI + (lr + 64) * LROW + lc * 16) = r1;
  __syncthreads();
  float vmin = INFINITY, vmax = -INFINITY;
  int cur = 0;
  for (int s = 0; s < nst; s += stride) {
    const int nx = s + stride;
    if (nx < nst) { r0 = *(const h16x8*)(KIb + (size_t)(128 * nx + lr) * 64 + lc * 8); r1 = *(const h16x8*)(KIb + (size_t)(128 * nx + lr + 64) * 64 + lc * 8); }
    if (128 * s + 64 * kh < N) {
      f32x4 sc[4];
      idx_score(lds + IL_KI + cur * IL_KISZ, kh, l15, g4, qf, wq, sc);
      if (MODE == 0) {
#pragma unroll
        for (int kt = 0; kt < 4; ++kt)
#pragma unroll
          for (int r = 0; r < 4; ++r) { vmin = fminf(vmin, sc[kt][r]); vmax = fmaxf(vmax, sc[kt][r]); }
      } else if (MODE == 1) {
        h16* scp = scbase + ((size_t)((s * 2 + kh) * 4) * 1024 + q * 16 + 4 * g4);
#pragma unroll
        for (int kt = 0; kt < 4; ++kt) {
          const h16x4 hv = pack4(sc[kt][0], sc[kt][1], sc[kt][2], sc[kt][3]);
          *(h16x4*)(scp + kt * 1024) = hv;
#pragma unroll
          for (int r = 0; r < 4; ++r) {
            const float xb = fminf(fmaxf(__builtin_fmaf((float)hv[r], qinv, qoff), 0.f), (float)(IDX_NB - 1));
            const int bin = (int)xb;
            __hip_atomic_fetch_add(&hist[bin * 64 + q], 1u, __ATOMIC_RELAXED, __HIP_MEMORY_SCOPE_WORKGROUP);
          }
        }
      }
    }
    if (nx < nst) {
      *(LDS h16x8*)(lds + IL_KI + (cur ^ 1) * IL_KISZ + lr * LROW + lc * 16) = r0;
      *(LDS h16x8*)(lds + IL_KI + (cur ^ 1) * IL_KISZ + (lr + 64) * LROW + lc * 16) = r1;
    }
    __syncthreads();
    cur ^= 1;
  }
  if (MODE == 0) {
    __hip_atomic_fetch_min(&st[q], fkey(vmin), __ATOMIC_RELAXED, __HIP_MEMORY_SCOPE_WORKGROUP);
    __hip_atomic_fetch_max(&st[64 + q], fkey(vmax), __ATOMIC_RELAXED, __HIP_MEMORY_SCOPE_WORKGROUP);
  }
}

DEVI int idx_bin(float sv, float qinv, float qoff) { return (int)fminf(fmaxf(__builtin_fmaf(sv, qinv, qoff), 0.f), (float)(IDX_NB - 1)); }
DEVI float idx_bin_lower_bound(int target, float qinv, float qoff) {
  if (target <= 0) return -INFINITY;
  if (target > IDX_NB - 1) return INFINITY;
  unsigned lo = 0x03FFu, hi = 0xFC00u;
  auto val = [](unsigned k) { const unsigned short hbits = (unsigned short)((k & 0x8000u) ? (k & 0x7FFFu) : (~k & 0xFFFFu)); return (float)__builtin_bit_cast(h16, hbits); };
  if (idx_bin(val(hi), qinv, qoff) < target) return INFINITY;
  while (lo < hi) { const unsigned mid = (lo + hi) >> 1; if (idx_bin(val(mid), qinv, qoff) >= target) hi = mid; else lo = mid + 1; }
  return val(lo);
}
DEVI void idx_stream_step(LDS unsigned char* lds, LDS unsigned* st, const unsigned long long (&cur)[4], int s, int kh, int q, int lane, int g4, float thi, float tlo) {
  unsigned nib = 0u;
#pragma unroll
  for (int kt = 3; kt >= 0; --kt) {
    const h16x4 hv = __builtin_bit_cast(h16x4, cur[kt]);
#pragma unroll
    for (int r = 3; r >= 0; --r) {
      const float sv = (float)hv[r];
      const unsigned long long ms = __builtin_amdgcn_ballot_w64(sv >= thi);
      asm("v_addc_co_u32_e64 %0, vcc, %0, %0, %1" : "+v"(nib) : "s"(ms) : "vcc");
      const bool cand = (sv >= tlo) && !(sv >= thi);
      if (__builtin_amdgcn_ballot_w64(cand) != 0ull) {
        if (cand) {
          const unsigned pos = __hip_atomic_fetch_add(&st[128 + q], 1u, __ATOMIC_RELAXED, __HIP_MEMORY_SCOPE_WORKGROUP);
          if (pos < (unsigned)IDX_CAP) {
            ((LDS float*)(lds + IL_CS))[q * IDX_CAP + pos] = sv;
            ((LDS unsigned short*)(lds + IL_CK))[q * IDX_CAP + pos] = (unsigned short)(128 * s + 64 * kh + 16 * kt + 4 * g4 + r);
          }
        }
      }
    }
  }
  const unsigned oth = (unsigned)__shfl_xor((int)nib, 32);
  if (lane < 32) {
#pragma unroll
    for (int T = 0; T < 2; ++T) {
      const unsigned b0 = ((nib >> (8 * T)) & 15u) | (((oth >> (8 * T)) & 15u) << 4);
      const unsigned b1 = ((nib >> (8 * T + 4)) & 15u) | (((oth >> (8 * T + 4)) & 15u) << 4);
      ((LDS unsigned short*)(lds + IL_HIST))[q * 512 + (4 * s + 2 * kh + T) * 2 + (g4 & 1)] = (unsigned short)(b0 | (b1 << 8));
    }
  }
}
DEVI void idx_stream(LDS unsigned char* lds, int N, int qg, int kh, float thi, float tlo, const h16* scbase) {
  const int tid = launder((int)threadIdx.x), lane = tid & 63, l15 = lane & 15, g4 = lane >> 4;
  const int q = 16 * qg + l15;
  LDS unsigned* st = (LDS unsigned*)(lds + IL_ST);
  const int nv = (N - 64 * kh + 127) >> 7;
  const unsigned long long* scp = (const unsigned long long*)(scbase + ((size_t)(kh * 4) * 1024 + q * 16 + 4 * g4));
#define IDX_LD(dst, s_) do { if ((s_) < nv) { _Pragma("unroll") for (int kt = 0; kt < 4; ++kt) dst[kt] = __hip_atomic_load(scp + (size_t)(s_) * 2048 + kt * 256, __ATOMIC_RELAXED, __HIP_MEMORY_SCOPE_AGENT); } } while (0)
  unsigned long long b0[4], b1[4], b2[4], b3[4];
  IDX_LD(b0, 0); IDX_LD(b1, 1); IDX_LD(b2, 2); IDX_LD(b3, 3);
  for (int s = 0; s < nv; s += 4) {
    idx_stream_step(lds, st, b0, s, kh, q, lane, g4, thi, tlo); IDX_LD(b0, s + 4);
    if (s + 1 < nv) { idx_stream_step(lds, st, b1, s + 1, kh, q, lane, g4, thi, tlo); IDX_LD(b1, s + 5); }
    if (s + 2 < nv) { idx_stream_step(lds, st, b2, s + 2, kh, q, lane, g4, thi, tlo); IDX_LD(b2, s + 6); }
    if (s + 3 < nv) { idx_stream_step(lds, st, b3, s + 3, kh, q, lane, g4, thi, tlo); IDX_LD(b3, s + 7); }
  }
#undef IDX_LD
}

DEVI void idx_item(PRef p, LDS unsigned char* lds, int b, int c) {
  const int tid = launder((int)threadIdx.x), lane = tid & 63, wave = wave_id(tid), l31 = lane & 31, half = lane >> 5;
  const int N = 64 * (c + 1);
  unsigned* MASK = (unsigned*)(p.ws + WS_MASK) + ((size_t)b * SEQ + 64 * c) * 256;
  if (N <= 256) {
    const int wpr = N >> 5;
    for (int i = tid; i < 64 * wpr; i += NTHR) MASK[(size_t)(i / wpr) * 256 + (i % wpr)] = 0xFFFFFFFFu;
    return;
  }
  const int qg = wave & 3, kh = wave >> 2, l15 = lane & 15, q = 16 * qg + l15;
  const h16* QIrow0 = (const h16*)(p.ws + WS_QI) + ((size_t)b * SEQ + 64 * c) * 512;
  const float* WIrow0 = (const float*)(p.ws + WS_WI) + ((size_t)b * SEQ + 64 * c) * 8;
  const h16* KIb = (const h16*)(p.ws + WS_KI) + (size_t)b * SEQ * 64;
  h16* scbase;
  {
    const int j = (c < 64) ? c : 127 - c;
    const size_t pre = 8192ull * (size_t)(128 * j - (j * (j - 1)) / 2);
    scbase = (h16*)(p.ws + (b == 0 ? WS_H : WS_MIX + (size_t)(b - 1) * SC_BATCH_BYTES) + pre);
  }
  LDS unsigned* st = (LDS unsigned*)(lds + IL_ST);
  LDS float* stf = (LDS float*)(lds + IL_ST);
  if (tid < 64) { st[tid] = 0xFFFFFFFFu; st[64 + tid] = 0u; st[128 + tid] = 0u; }
  __syncthreads();
  const int nst = (N + 127) >> 7;
  const int stride = nst >= 16 ? 8 : (nst >= 8 ? 4 : (nst >= 4 ? 2 : 1));
  idx_pass<0>(lds, KIb, N, stride, qg, kh, QIrow0, WIrow0, 0.f, 0.f, 0, scbase);
  __syncthreads();
  if (tid < 64) {
    const float lo = fkey_inv(st[tid]), hi = fkey_inv(st[64 + tid]);
    float d = hi - lo; if (!(d > 1e-20f)) d = 1.f;
    const float inv = (float)IDX_NB / (1.5f * d);
    stf[192 + tid] = inv; stf[256 + tid] = -(lo - 0.25f * d) * inv;
  }
  for (int i = tid; i < 16384; i += NTHR) ((LDS unsigned*)(lds + IL_HIST))[i] = 0u;
  __syncthreads();
  const float qinv = stf[192 + q], qoff = stf[256 + q];
  idx_pass<1>(lds, KIb, N, 1, qg, kh, QIrow0, WIrow0, qinv, qoff, 0, scbase);
  {
    LDS unsigned* hist = (LDS unsigned*)(lds + IL_HIST);
    for (int qq = wave; qq < 64; qq += 8) {
      unsigned hb[4];
#pragma unroll
      for (int j = 0; j < 4; ++j) hb[j] = hist[(4 * lane + j) * 64 + qq];
      const unsigned mine = hb[0] + hb[1] + hb[2] + hb[3];
      unsigned suf = mine;
#pragma unroll
      for (int o = 1; o < 64; o <<= 1) { const unsigned v = (unsigned)__shfl_down((int)suf, o); if (lane + o < 64) suf += v; }
      unsigned cum = suf - mine;
      if (cum < 256u && suf >= 256u) {
#pragma unroll
        for (int j = 3; j >= 0; --j) {
          if (cum < 256u && cum + hb[j] >= 256u) { st[320 + qq] = (unsigned)(4 * lane + j); st[384 + qq] = 256u - cum; }
          cum += hb[j];
        }
      }
    }
  }
  __syncthreads();
  if (tid < 64) {
    const int bs = (int)st[320 + tid]; const float qi_ = stf[192 + tid], qo_ = stf[256 + tid];
    stf[448 + tid] = idx_bin_lower_bound(bs + 1, qi_, qo_);
    stf[512 + tid] = idx_bin_lower_bound(bs, qi_, qo_);
  }
  __syncthreads();
  const float thi = stf[448 + q], tlo = stf[512 + q];
  asm volatile("s_waitcnt vmcnt(0)" ::: "memory");
  idx_stream(lds, N, qg, kh, thi, tlo, scbase);
  __syncthreads();
  for (int qq = wave; qq < 64; qq += 8) {
    const int nc = min((int)st[128 + qq], IDX_CAP); const unsigned need = st[384 + qq];
    LDS float* cs = (LDS float*)(lds + IL_CS) + qq * IDX_CAP; LDS unsigned short* ck = (LDS unsigned short*)(lds + IL_CK) + qq * IDX_CAP;
    for (int i = lane; i < nc; i += 64) {
      const float sv = cs[i]; const unsigned kv = ck[i];
      unsigned rank = 0u;
      for (int j = 0; j < nc; ++j) { const float sj = cs[j]; const unsigned kj = ck[j]; rank += (sj > sv || (sj == sv && kj < kv)) ? 1u : 0u; }
      if (rank < need) {
        const unsigned kl = kv & 31u;
        const unsigned bit = 16u * ((kl >> 2) & 1u) + (kl & 3u) + 4u * (kl >> 3);
        __hip_atomic_fetch_or((LDS unsigned*)(lds + IL_HIST) + qq * 256 + (kv >> 5), 1u << bit, __ATOMIC_RELAXED, __HIP_MEMORY_SCOPE_WORKGROUP);
      }
    }
  }
  __syncthreads();
  {
    const int cpr = N >> 6;
    for (int i = tid; i < 64 * cpr; i += NTHR) {
      const int row = i / cpr, cc = i % cpr;
      *(u32x2*)(MASK + (size_t)row * 256 + 2 * cc) = *(LDS u32x2*)(lds + IL_HIST + row * 1024 + cc * 8);
    }
  }
  __syncthreads();
}

DEVI void phase3(PRef p, LDS unsigned char* lds) {
  const int G = gridDim.x;
  for (int it = blockIdx.x; it < 512; it += G) rnn_item<0>(p, lds, it >> 7, it & 127);
  for (int it = blockIdx.x; it < 256; it += G) {
    const int b = it >> 6, j = it & 63;
#pragma unroll 1
    for (int w2 = 0; w2 < 2; ++w2) idx_item(p, lds, b, w2 ? j : 127 - j);
  }
}

DEVI float max3f(float a, float b, float c) { float r; asm("v_max3_f32 %0, %1, %2, %3" : "=v"(r) : "v"(a), "v"(b), "v"(c)); return r; }
DEVI unsigned pk_rtz(float a, float b) { return __builtin_bit_cast(unsigned, __builtin_amdgcn_cvt_pkrtz(a, b)); }
DEVI void attn_tile(LDS unsigned char* Kt, LDS unsigned char* Vt, const h16x8 (&qf)[4], u32x2 mw, int l31, int half, f32x16 (&o)[2], float& mref, float& l, bool& init) {
  const unsigned nm0 = ~(mw[0] >> (16 * half)), nm1 = ~(mw[1] >> (16 * half));
  const unsigned negm = __float_as_uint(-mref);
  f32x16 s[2];
#pragma unroll
  for (int r = 0; r < 16; ++r) {
    unsigned e0 = (unsigned)__builtin_amdgcn_sbfe((int)nm0, r, 1), e1 = (unsigned)__builtin_amdgcn_sbfe((int)nm1, r, 1);
    asm volatile("" : "+v"(e0), "+v"(e1));
    s[0][r] = __uint_as_float((e0 & 0xFF800000u) | (~e0 & negm));
    s[1][r] = __uint_as_float((e1 & 0xFF800000u) | (~e1 & negm));
  }
#pragma unroll
  for (int ri = 0; ri < 2; ++ri)
#pragma unroll
    for (int kk = 0; kk < 4; ++kk) {
      const h16x8 kf = *(LDS h16x8*)(Kt + (32 * ri + l31) * LROW + (2 * kk + half) * 16);
      s[ri] = mfma16(kf, qf[kk], s[ri]);
    }
  asm volatile("s_nop 15\n\ts_nop 7" : "+v"(s[0]), "+v"(s[1]));
  float mx = max3f(s[0][0], s[1][0], s[0][1]), mx2 = max3f(s[1][1], s[0][2], s[1][2]);
#pragma unroll
  for (int r = 3; r < 15; r += 2) { mx = max3f(mx, s[0][r], s[1][r]); mx2 = max3f(mx2, s[0][r + 1], s[1][r + 1]); }
  mx = max3f(mx, s[0][15], s[1][15]);
  mx = max3f(mx, mx2, mx2);
  mx = max3f(mx, __shfl_xor(mx, 32), mx);
  const bool first = (!init) && (mx > -INFINITY);
  const bool resc = first || (mx > 8.f);
  if (__any(resc)) {
    init = init || first;
    const float delta = resc ? mx : 0.f;
    const float alpha = __builtin_amdgcn_exp2f(-delta);
#pragma unroll
    for (int r = 0; r < 16; ++r) { s[0][r] -= delta; s[1][r] -= delta; o[0][r] *= alpha; o[1][r] *= alpha; }
    l *= alpha; mref += delta;
  }
  float ls = 0.f;
#pragma unroll
  for (int r = 0; r < 16; ++r) {
    s[0][r] = __builtin_amdgcn_exp2f(s[0][r]); s[1][r] = __builtin_amdgcn_exp2f(s[1][r]);
    ls += s[0][r] + s[1][r];
  }
  l += ls;
  h16x8 pf[4];
#pragma unroll
  for (int s4 = 0; s4 < 4; ++s4) {
    u32x4 w;
#pragma unroll
    for (int e = 0; e < 4; ++e) w[e] = pk_rtz(s[s4 >> 1][8 * (s4 & 1) + 2 * e], s[s4 >> 1][8 * (s4 & 1) + 2 * e + 1]);
    pf[s4] = __builtin_bit_cast(h16x8, w);
  }
#pragma unroll
  for (int di = 0; di < 2; ++di)
#pragma unroll
    for (int s4 = 0; s4 < 4; ++s4) {
      const h16x8 vf = *(LDS h16x8*)(Vt + (32 * di + l31) * LROW + (2 * s4 + half) * 16);
      o[di] = mfma16(vf, pf[s4], o[di]);
    }
}

DEVI void attn_unit(PRef p, LDS unsigned char* lds, int b, int head, int qb) {
  const int tid = launder((int)threadIdx.x), lane = tid & 63, wave = wave_id(tid), l31 = lane & 31, half = lane >> 5;
  const int q0 = qb * 256 + wave * 32, cw = q0 >> 6, NS = qb + 1;
  const size_t tok = (size_t)b * SEQ + q0 + l31;
  h16x8 qf[4];
  {
    const h16* Q = (const h16*)(p.ws + WS_Q) + tok * 512 + head * 64;
#pragma unroll
    for (int kk = 0; kk < 4; ++kk) qf[kk] = *(const h16x8*)(Q + 16 * kk + 8 * half);
  }
  const unsigned* mrow = (const unsigned*)(p.ws + WS_MASK) + tok * 256;
  constexpr int TP = 2 * 64 * LROW, ABUF = 4 * TP;
  static_assert(2 * ABUF <= LDS_BYTES - 16, "attention LDS");
  const h16* ksrc[4]; const h16* vsrc[4]; int kdst[4], vdst[4];
#pragma unroll
  for (int i = 0; i < 4; ++i) {
    const int id = tid + NTHR * i;
    const int row = id >> 3, lc = id & 7;
    ksrc[i] = (const h16*)(p.ws + WS_K) + ((size_t)b * SEQ + row) * 512 + head * 64 + lc * 8;
    kdst[i] = (row >> 6) * TP + (row & 63) * LROW + lc * 16;
    const int d = id >> 5, c = id & 31;
    vsrc[i] = (const h16*)(p.ws + WS_VT) + ((size_t)(b * 8 + head) * 64 + d) * 8192 + c * 8;
    vdst[i] = (c >> 3) * TP + 64 * LROW + d * LROW + (c & 7) * 16;
  }
  h16x8 rkA[4], rvA[4], rkB[4], rvB[4];
#pragma unroll
  for (int i = 0; i < 4; ++i) { rkA[i] = *(const h16x8*)ksrc[i]; rvA[i] = *(const h16x8*)vsrc[i]; }
#pragma unroll
  for (int i = 0; i < 4; ++i) { *(LDS h16x8*)(lds + kdst[i]) = rkA[i]; *(LDS h16x8*)(lds + vdst[i]) = rvA[i]; }
  if (NS > 1) {
#pragma unroll
    for (int i = 0; i < 4; ++i) { rkA[i] = *(const h16x8*)(ksrc[i] + (size_t)256 * 512); rvA[i] = *(const h16x8*)(vsrc[i] + 256); }
  }
  u32x4 mwa = *(const u32x4*)mrow, mwb = *(const u32x4*)(mrow + 4), mna, mnb;
  mna = mwa; mnb = mwb;
  __syncthreads();
  f32x16 o[2];
#pragma unroll
  for (int r = 0; r < 16; ++r) { o[0][r] = 0.f; o[1][r] = 0.f; }
  float mref = 0.f, l = 0.f; bool init = false;
#define ATT_TILE(s, t, W0, W1) if (4 * (s) + (t) <= cw) { u32x2 m2; m2[0] = W0; m2[1] = W1; attn_tile(bb + (t) * TP, bb + (t) * TP + 64 * LROW, qf, m2, l31, half, o, mref, l, init); }
#define ATT_STEP(s, RKC, RVC, RKN, RVN) { \
    if ((s) + 2 < NS) { _Pragma("unroll") for (int i = 0; i < 4; ++i) { RKN[i] = *(const h16x8*)(ksrc[i] + (size_t)((s) + 2) * 256 * 512); RVN[i] = *(const h16x8*)(vsrc[i] + ((s) + 2) * 256); } } \
    if ((s) + 1 < NS) { mna = *(const u32x4*)(mrow + 8 * ((s) + 1)); mnb = *(const u32x4*)(mrow + 8 * ((s) + 1) + 4); } \
    { LDS unsigned char* bb = lds + ((s) & 1) * ABUF; \
      ATT_TILE(s, 0, mwa[0], mwa[1]) ATT_TILE(s, 1, mwa[2], mwa[3]) ATT_TILE(s, 2, mwb[0], mwb[1]) ATT_TILE(s, 3, mwb[2], mwb[3]) } \
    if ((s) + 1 < NS) { LDS unsigned char* nb = lds + (((s) + 1) & 1) * ABUF; _Pragma("unroll") for (int i = 0; i < 4; ++i) { *(LDS h16x8*)(nb + kdst[i]) = RKC[i]; *(LDS h16x8*)(nb + vdst[i]) = RVC[i]; } } \
    __syncthreads(); mwa = mna; mwb = mnb; }
  for (int s = 0; s < NS; s += 2) {
    ATT_STEP(s, rkA, rvA, rkB, rvB)
    if (s + 1 < NS) ATT_STEP(s + 1, rkB, rvB, rkA, rvA)
  }
#undef ATT_STEP
#undef ATT_TILE
  const float inv = 1.f / (l + __shfl_xor(l, 32));
  h16* Y = (h16*)(p.ws + WS_H) + tok * DM + head * 64;
#pragma unroll
  for (int di = 0; di < 2; ++di)
#pragma unroll
    for (int q = 0; q < 4; ++q)
      *(h16x4*)(Y + 32 * di + 8 * q + 4 * half) = pack4(o[di][4 * q] * inv, o[di][4 * q + 1] * inv, o[di][4 * q + 2] * inv, o[di][4 * q + 3] * inv);
}

DEVI void phase4(PRef p, LDS unsigned char* lds) {
  const int G = gridDim.x;
  for (int it = blockIdx.x; it < 512; it += G) rnn_item<1>(p, lds, it >> 7, it & 127);
  for (int it = blockIdx.x; it < 512; it += G) {
    const int bh = it >> 4, j = it & 15;
#pragma unroll 1
    for (int w2 = 0; w2 < 2; ++w2) attn_unit(p, lds, bh >> 3, bh & 7, w2 ? j : 31 - j);
  }
}

struct EpiPlain {
  h16* dst; int ld;
  DEVI void operator()(const f32x4 (&acc)[2][2][4][2], const g8::Unit& u, int wr, int wc, int fr, int fq) const {
#pragma unroll
    for (int ai = 0; ai < 2; ++ai)
#pragma unroll
      for (int m = 0; m < 4; ++m) {
        const int r = u.pm * 256 + 128 * ai + 64 * wr + 16 * m + fr;
        if (r < u.cnt) {
          h16* d = dst + (size_t)(u.off + r) * ld + u.pn * 256 + 32 * wc + 8 * fq;
#pragma unroll
          for (int bj = 0; bj < 2; ++bj)
            { const f32x4 v0 = acc[ai][bj][m][0], v1 = acc[ai][bj][m][1]; h16x8 w; w[0] = (h16)v0[0]; w[1] = (h16)v0[1]; w[2] = (h16)v0[2]; w[3] = (h16)v0[3]; w[4] = (h16)v1[0]; w[5] = (h16)v1[1]; w[6] = (h16)v1[2]; w[7] = (h16)v1[3]; *(h16x8*)(d + 128 * bj) = w; }
        }
      }
  }
};
DEVI void phase5(PRef p, LDS unsigned char* lds) {
  g8::DenseOrder S{(const h16*)(p.ws + WS_H), (const h16*)(p.ws + WS_WOUT), DM, 128, 4, (int)gridDim.x, (int)blockIdx.x};
  EpiPlain E{(h16*)(p.ws + WS_MIX), DM};
  g8::gemm_phase(lds, DM, S, E);
}

constexpr int P6_TROW = 2064, P6_THI = 0, P6_TLO = 32 * P6_TROW, P6_PART = 0, P6_LGT = 8 * 48 * 32 * 4, P6_MOD = 2 * 32 * P6_TROW;
constexpr int P6_BIAS = P6_MOD + 3 * 4096, P6_TOK = P6_BIAS + 160, P6_LCNT = P6_TOK + 128 * 6 * 4, P6_LBASE = P6_LCNT + 128;
static_assert(P6_LBASE + 128 <= LDS_BYTES - 16 && P6_LGT + 32 * 36 * 4 <= P6_MOD, "phase 6 LDS map");
DEVI void phase6(PRef p, LDS unsigned char* lds) {
  const int tid = launder((int)threadIdx.x), lane = tid & 63, wave = wave_id(tid), l15 = lane & 15, g4 = lane >> 4;
  const int b = blockIdx.x >> 6;
  LDS float* mv = (LDS float*)(lds + P6_MOD);
  LDS float* rbias = (LDS float*)(lds + P6_BIAS);
  LDS unsigned* tokrec = (LDS unsigned*)(lds + P6_TOK);
  LDS unsigned* lcnt = (LDS unsigned*)(lds + P6_LCNT);
  LDS unsigned* lbase = (LDS unsigned*)(lds + P6_LBASE);
  mod_to_lds(p, b, 2, mv); mod_to_lds(p, b, 3, mv + 1024); mod_to_lds(p, b, 4, mv + 2048);
  if (tid < 4) rbias[tid] = p.in[18][tid];
  else if (tid < 36) rbias[tid] = p.in[20][tid - 4];
  if (tid < 32) lcnt[tid] = 0u;
  __syncthreads();
  f32x4 A1[4], A2[4], SH2[4];
#pragma unroll
  for (int j = 0; j < 4; ++j) {
    const int k = 256 * j + 4 * lane;
    A1[j] = *(LDS f32x4*)(mv + k) * *(const f32x4*)(p.in[5] + k);
    A2[j] = *(const f32x4*)(p.in[6] + k) * (*(LDS f32x4*)(mv + 2048 + k) + 1.f);
    SH2[j] = *(LDS f32x4*)(mv + 1024 + k);
  }
  const float* x = p.in[0]; const h16* MIX = (const h16*)(p.ws + WS_MIX); h16* X1h = (h16*)(p.ws + WS_MIX); h16* H2 = (h16*)(p.ws + WS_H);
  const h16* WRH = (const h16*)(p.ws + WS_WRH); const h16* WRL = (const h16*)(p.ws + WS_WRL);
  const size_t tok0 = (size_t)blockIdx.x * 128;
  h16x8 bh[3][4], bl[3][4];
#pragma unroll
  for (int ct = 0; ct < 3; ++ct)
#pragma unroll
    for (int kk = 0; kk < 4; ++kk) {
      const int kof = 32 * (4 * wave + kk) + 8 * g4;
      bh[ct][kk] = *(const h16x8*)(WRH + (size_t)(16 * ct + l15) * 1024 + kof); bl[ct][kk] = *(const h16x8*)(WRL + (size_t)(16 * ct + l15) * 1024 + kof);
    }
#pragma unroll 1
  for (int rd = 0; rd < 4; ++rd) {
#pragma unroll 1
    for (int i = 0; i < 4; ++i) {
      const int tr = 4 * wave + i;
      const size_t tok = tok0 + 32 * rd + tr;
      f32x4 xv[4], mx[4]; float ssm = 0.f;
#pragma unroll
      for (int j = 0; j < 4; ++j) {
        xv[j] = *(const f32x4*)(x + tok * DM + 256 * j + 4 * lane);
        const h16x4 mh = *(const h16x4*)(MIX + tok * DM + 256 * j + 4 * lane);
#pragma unroll
        for (int e = 0; e < 4; ++e) { mx[j][e] = (float)mh[e]; ssm += mx[j][e] * mx[j][e]; }
      }
      const float rsm = 1.0f / sqrtf(wave_sum(ssm) * (1.f / 1024.f) + 1e-6f);
      float ss1 = 0.f;
#pragma unroll
      for (int j = 0; j < 4; ++j) {
        xv[j] = xv[j] + A1[j] * (mx[j] * rsm);
        *(h16x4*)(X1h + tok * DM + 256 * j + 4 * lane) = pack4(xv[j][0], xv[j][1], xv[j][2], xv[j][3]);
        ss1 += xv[j][0] * xv[j][0] + xv[j][1] * xv[j][1] + xv[j][2] * xv[j][2] + xv[j][3] * xv[j][3];
      }
      const float rs1 = 1.0f / sqrtf(wave_sum(ss1) * (1.f / 1024.f) + 1e-6f);
#pragma unroll
      for (int j = 0; j < 4; ++j) {
        const f32x4 h2 = xv[j] * rs1 * A2[j] + SH2[j];
        const h16x4 hi = pack4(h2[0], h2[1], h2[2], h2[3]);
        const h16x4 lo = pack4(h2[0] - (float)hi[0], h2[1] - (float)hi[1], h2[2] - (float)hi[2], h2[3] - (float)hi[3]);
        *(h16x4*)(H2 + tok * DM + 256 * j + 4 * lane) = hi;
        *(LDS h16x4*)(lds + P6_THI + tr * P6_TROW + (256 * j + 4 * lane) * 2) = hi;
        *(LDS h16x4*)(lds + P6_TLO + tr * P6_TROW + (256 * j + 4 * lane) * 2) = lo;
      }
    }
    __syncthreads();
    f32x4 acc[2][3];
#pragma unroll
    for (int tt = 0; tt < 2; ++tt)
#pragma unroll
      for (int ct = 0; ct < 3; ++ct) acc[tt][ct] = (f32x4){0.f, 0.f, 0.f, 0.f};
#pragma unroll
    for (int kk = 0; kk < 4; ++kk) {
      const int kof = 32 * (4 * wave + kk) + 8 * g4;
      h16x8 ah[2], al[2];
#pragma unroll
      for (int tt = 0; tt < 2; ++tt) {
        ah[tt] = *(LDS h16x8*)(lds + P6_THI + (16 * tt + l15) * P6_TROW + kof * 2);
        al[tt] = *(LDS h16x8*)(lds + P6_TLO + (16 * tt + l15) * P6_TROW + kof * 2);
      }
#pragma unroll
      for (int ct = 0; ct < 3; ++ct) {
#pragma unroll
        for (int tt = 0; tt < 2; ++tt) {
          acc[tt][ct] = mfma16s(ah[tt], bh[ct][kk], acc[tt][ct]);
          acc[tt][ct] = mfma16s(ah[tt], bl[ct][kk], acc[tt][ct]);
          acc[tt][ct] = mfma16s(al[tt], bh[ct][kk], acc[tt][ct]);
        }
      }
    }
    __syncthreads();
#pragma unroll
    for (int tt = 0; tt < 2; ++tt)
#pragma unroll
      for (int ct = 0; ct < 3; ++ct)
        *(LDS f32x4*)(lds + P6_PART + (((wave * 48 + 16 * ct + l15) * 32) + 16 * tt + 4 * g4) * 4) = acc[tt][ct];
    __syncthreads();
    for (int idx = tid; idx < 36 * 32; idx += NTHR) {
      const int col = idx >> 5, tk = idx & 31;
      float s = 0.f;
#pragma unroll
      for (int w = 0; w < 8; ++w) s += *(LDS float*)(lds + P6_PART + ((w * 48 + col) * 32 + tk) * 4);
      *(LDS float*)(lds + P6_LGT + (tk * 36 + col) * 4) = s;
    }
    __syncthreads();
    if (tid < 32) {
      LDS float* lg = (LDS float*)(lds + P6_LGT) + 36 * tid;
      float gl[4];
#pragma unroll
      for (int g = 0; g < 4; ++g) gl[g] = lg[g] + rbias[g];
      int gi = 0; float gm = gl[0];
#pragma unroll
      for (int g = 1; g < 4; ++g) if (gl[g] > gm) { gm = gl[g]; gi = g; }
      float gs = 0.f;
#pragma unroll
      for (int g = 0; g < 4; ++g) gs += __expf(gl[g] - gm);
      const float pg = 1.f / gs;
      int e1 = 0, e2 = 0; float l1 = -INFINITY, l2 = -INFINITY;
#pragma unroll
      for (int e = 0; e < 8; ++e) {
        const float v = lg[4 + 8 * gi + e] + rbias[4 + 8 * gi + e];
        if (v > l1) { l2 = l1; e2 = e1; l1 = v; e1 = e; }
        else if (v > l2) { l2 = v; e2 = e; }
      }
      const float x2 = __expf(l2 - l1);
      const float w1 = pg / (1.f + x2), w2 = pg * x2 / (1.f + x2);
      const unsigned E1 = (unsigned)(gi * 8 + e1), E2 = (unsigned)(gi * 8 + e2);
      const unsigned lp1 = __hip_atomic_fetch_add(&lcnt[E1], 1u, __ATOMIC_RELAXED, __HIP_MEMORY_SCOPE_WORKGROUP);
      const unsigned lp2 = __hip_atomic_fetch_add(&lcnt[E2], 1u, __ATOMIC_RELAXED, __HIP_MEMORY_SCOPE_WORKGROUP);
      LDS unsigned* tr = tokrec + (32 * rd + tid) * 6;
      tr[0] = E1; tr[1] = lp1; tr[2] = E2; tr[3] = lp2; tr[4] = __float_as_uint(w1); tr[5] = __float_as_uint(w2);
    }
    __syncthreads();
  }
  if (tid < 32) lbase[tid] = atomicAdd((unsigned*)(p.ws + WS_CNT) + tid, lcnt[tid]);
  __syncthreads();
  if (tid < 128) {
    unsigned* LIST = (unsigned*)(p.ws + WS_LIST); float* LISTW = (float*)(p.ws + WS_LISTW); u32x4* ROUTE = (u32x4*)(p.ws + WS_ROUTE);
    const unsigned tok = (unsigned)(tok0 + tid);
    LDS unsigned* tr = tokrec + tid * 6;
    const unsigned E1 = tr[0], E2 = tr[2], p1 = lbase[E1] + tr[1], p2 = lbase[E2] + tr[3];
    LIST[(size_t)E1 * 32768 + p1] = tok; LISTW[(size_t)E1 * 32768 + p1] = __uint_as_float(tr[4]);
    LIST[(size_t)E2 * 32768 + p2] = tok; LISTW[(size_t)E2 * 32768 + p2] = __uint_as_float(tr[5]);
    u32x4 rt; rt[0] = E1; rt[1] = p1; rt[2] = E2; rt[3] = p2;
    ROUTE[tok] = rt;
  }
}

template <bool GATHER_> struct MoeOrder {
  static constexpr bool GATHER = GATHER_;
  unsigned char* ws; int ntn, K, G, c;
  DEVI bool next(int i, g8::Unit& u) const {
    const unsigned* cnt = (const unsigned*)(ws + WS_CNT);
    int it = i * G + c, off = 0, e = 0, cn = 0; bool found = false;
    for (e = 0; e < 32; ++e) { cn = (int)cnt[e]; const int nti = ((cn + 255) >> 8) * ntn; if (it < nti) { found = true; break; } it -= nti; off += cn; }
    if (!found) return false;
    u.e = e; u.pm = it / ntn; u.pn = it % ntn; u.cnt = cn; u.off = off;
    const int tid = threadIdx.x;
    if (GATHER_) {
      const unsigned* list = (const unsigned*)(ws + WS_LIST) + (size_t)e * 32768;
      u.A = (const char*)(ws + WS_H);
      u.B = (const char*)((const h16*)(ws + WS_WGU) + ((size_t)e * 512 + u.pn * 256) * DM);
#pragma unroll
      for (int h = 0; h < 2; ++h)
#pragma unroll
        for (int i2 = 0; i2 < 2; ++i2) {
          int R, C; g8::stage_rc(tid * 16 + i2 * 8192, R, C);
          const int row = u.pm * 256 + 128 * h + R;
          const unsigned t = (row < cn) ? list[row] : 0u;
          u.va[h][i2] = (t * (unsigned)DM + (unsigned)C) * 2u;
        }
    } else {
      u.A = (const char*)((const h16*)(ws + WS_ACT) + ((size_t)off + u.pm * 256) * 256);
      u.B = (const char*)((const h16*)(ws + WS_WDN) + ((size_t)e * 1024 + u.pn * 256) * 256);
      u.va[0][0] = u.va[0][1] = u.va[1][0] = u.va[1][1] = 0u;
    }
    return true;
  }
};
struct EpiAct {
  unsigned char* ws;
  DEVI void operator()(const f32x4 (&acc)[2][2][4][2], const g8::Unit& u, int wr, int wc, int fr, int fq) const {
    const float* lw = (const float*)(ws + WS_LISTW) + (size_t)u.e * 32768; h16* act = (h16*)(ws + WS_ACT);
#pragma unroll
    for (int ai = 0; ai < 2; ++ai)
#pragma unroll
      for (int m = 0; m < 4; ++m) {
        const int r = u.pm * 256 + 128 * ai + 64 * wr + 16 * m + fr;
        if (r < u.cnt) {
          const float w = lw[r];
#pragma unroll
          for (int bj = 0; bj < 2; ++bj) {
            const f32x4 g = acc[ai][bj][m][0], up = acc[ai][bj][m][1];
            float v[4];
#pragma unroll
            for (int e = 0; e < 4; ++e) v[e] = g[e] * __builtin_amdgcn_rcpf(1.f + __expf(-g[e])) * up[e] * w;
            *(h16x4*)(act + (size_t)(u.off + r) * 256 + 16 * (8 * u.pn + 4 * bj + wc) + 4 * fq) = pack4(v[0], v[1], v[2], v[3]);
          }
        }
      }
  }
};
struct EpiYp {
  h16* dst;
  DEVI void operator()(const f32x4 (&acc)[2][2][4][2], const g8::Unit& u, int wr, int wc, int fr, int fq) const {
#pragma unroll
    for (int ai = 0; ai < 2; ++ai)
#pragma unroll
      for (int m = 0; m < 4; ++m) {
        const int r = u.pm * 256 + 128 * ai + 64 * wr + 16 * m + fr;
        if (r < u.cnt) {
          h16* d = dst + (size_t)(u.off + r) * DM + u.pn * 256 + 32 * wc + 8 * fq;
#pragma unroll
          for (int bj = 0; bj < 2; ++bj)
            { const f32x4 v0 = acc[ai][bj][m][0], v1 = acc[ai][bj][m][1]; h16x8 w; w[0] = (h16)v0[0]; w[1] = (h16)v0[1]; w[2] = (h16)v0[2]; w[3] = (h16)v0[3]; w[4] = (h16)v1[0]; w[5] = (h16)v1[1]; w[6] = (h16)v1[2]; w[7] = (h16)v1[3]; *(h16x8*)(d + 128 * bj) = w; }
        }
      }
  }
};
DEVI void phase7(PRef p, LDS unsigned char* lds) {
  MoeOrder<true> S{p.ws, 2, DM, (int)gridDim.x, (int)blockIdx.x};
  EpiAct E{p.ws};
  g8::gemm_phase(lds, DM, S, E);
}
DEVI void phase8(PRef p, LDS unsigned char* lds) {
  MoeOrder<false> S{p.ws, 4, 256, (int)gridDim.x, (int)blockIdx.x};
  EpiYp E{(h16*)(p.ws + WS_YP)};
  g8::gemm_phase(lds, 256, S, E);
}

DEVI void phase9(PRef p, LDS unsigned char* lds) {
  const int tid = launder((int)threadIdx.x), lane = tid & 63, wave = wave_id(tid), G = gridDim.x;
  const int b = blockIdx.x & 3, bi = blockIdx.x >> 2, nbk = G >> 2;
  LDS unsigned* offs = (LDS unsigned*)lds;
  if (tid == 0) { const unsigned* cnt = (const unsigned*)(p.ws + WS_CNT); unsigned o = 0; for (int e = 0; e < 32; ++e) { offs[e] = o; o += cnt[e]; } }
  __syncthreads();
  LDS float* mv = (LDS float*)(lds + 256);
  mod_to_lds(p, b, 5, mv);
  __syncthreads();
  f32x4 A3[4];
#pragma unroll
  for (int j = 0; j < 4; ++j) { const int k = 256 * j + 4 * lane; A3[j] = *(LDS f32x4*)(mv + k) * *(const f32x4*)(p.in[7] + k); }
  const h16* YP = (const h16*)(p.ws + WS_YP); const u32x4* ROUTE = (const u32x4*)(p.ws + WS_ROUTE); float* out = p.out; const h16* X1h = (const h16*)(p.ws + WS_MIX);
  const int rstep = nbk * 8, r_first = bi * 8 + wave;
  const int nrow = (SEQ - r_first + rstep - 1) / rstep;
  unsigned R0 = 0u, R1 = 0u;
  if (lane < nrow) { const u32x4 rt = ROUTE[(size_t)b * SEQ + r_first + rstep * lane]; R0 = offs[rt[0]] + rt[1]; R1 = offs[rt[2]] + rt[3]; }
  h16x4 ya[4], yc[4]; f32x4 xv[4];
  {
    const size_t tok = (size_t)b * SEQ + r_first; const size_t r0 = __builtin_amdgcn_readlane(R0, 0), r1 = __builtin_amdgcn_readlane(R1, 0);
#pragma unroll
    for (int j = 0; j < 4; ++j) { ya[j] = *(const h16x4*)(YP + r0 * DM + 256 * j + 4 * lane); yc[j] = *(const h16x4*)(YP + r1 * DM + 256 * j + 4 * lane); { const h16x4 xh = *(const h16x4*)(X1h + tok * DM + 256 * j + 4 * lane); xv[j] = (f32x4){(float)xh[0], (float)xh[1], (float)xh[2], (float)xh[3]}; } }
  }
  for (int i = 0; i < nrow; ++i) {
    const size_t tok = (size_t)b * SEQ + r_first + rstep * i;
    h16x4 na[4], nc[4]; f32x4 nx[4];
    if (i + 1 < nrow) {
      const size_t r0 = __builtin_amdgcn_readlane(R0, i + 1), r1 = __builtin_amdgcn_readlane(R1, i + 1);
#pragma unroll
      for (int j = 0; j < 4; ++j) { na[j] = *(const h16x4*)(YP + r0 * DM + 256 * j + 4 * lane); nc[j] = *(const h16x4*)(YP + r1 * DM + 256 * j + 4 * lane); { const h16x4 xh = *(const h16x4*)(X1h + (tok + rstep) * DM + 256 * j + 4 * lane); nx[j] = (f32x4){(float)xh[0], (float)xh[1], (float)xh[2], (float)xh[3]}; } }
    }
    f32x4 y[4]; float ss = 0.f;
#pragma unroll
    for (int j = 0; j < 4; ++j)
#pragma unroll
      for (int e = 0; e < 4; ++e) { y[j][e] = (float)ya[j][e] + (float)yc[j][e]; ss += y[j][e] * y[j][e]; }
    const float rs = 1.0f / sqrtf(wave_sum(ss) * (1.f / 1024.f) + 1e-6f);
#pragma unroll
    for (int j = 0; j < 4; ++j) *(f32x4*)(out + tok * DM + 256 * j + 4 * lane) = xv[j] + A3[j] * (y[j] * rs);
    if (i + 1 < nrow) {
#pragma unroll
      for (int j = 0; j < 4; ++j) { ya[j] = na[j]; yc[j] = nc[j]; xv[j] = nx[j]; }
    }
  }
}

#define XB_TMO      128
#define XB_XCNT(j)  (256  + 64 * (j))
#define XB_XSUB(j)  (1280 + 64 * (j))
#define XB_XGEN(j)  (2304 + 64 * (j))
#define XB_TOP      3328
#define XB_TOPGEN   3392
#define XB_SPIN_CAP (1u << 22)
DEVI unsigned xb_ld(unsigned* p)              { return __hip_atomic_load(p, __ATOMIC_RELAXED, __HIP_MEMORY_SCOPE_AGENT); }
DEVI unsigned xb_add(unsigned* p, unsigned v) { return __hip_atomic_fetch_add(p, v, __ATOMIC_RELAXED, __HIP_MEMORY_SCOPE_AGENT); }
DEVI unsigned xb_xcc_id() { return (unsigned)__builtin_amdgcn_s_getreg((3 << 11) | 20) & 0xFu; }
#define XB_SPIN(cond, bar) do { unsigned _sp = 0; while (cond) { __builtin_amdgcn_s_sleep(1); \
    if ((++_sp & 255u) == 0u) { if (xb_ld(&(bar)[XB_TMO])) break; if (_sp > XB_SPIN_CAP) { atomicAdd(&(bar)[XB_TMO], 1u); break; } } } } while (0)
struct XcdBarrier { unsigned* bar; unsigned x; volatile LDS unsigned* st; };
DEVI XcdBarrier xcd_barrier_post(unsigned* bar, volatile LDS unsigned* st) {
  XcdBarrier b; b.bar = bar; b.x = xb_xcc_id(); b.st = st;
  if (threadIdx.x == 0) (void)xb_add(&bar[XB_XCNT(b.x)], 1u);
  return b;
}
DEVI void xcd_barrier_complete(unsigned* bar, unsigned x, unsigned& nloc, unsigned& nx) {
  const unsigned G = gridDim.x * gridDim.y * gridDim.z;
  unsigned sum, cnt, mine, sp = 0u;
  for (;;) {
    sum = 0u; cnt = 0u; mine = 0u;
#pragma unroll
    for (unsigned j = 0; j < 16; ++j) { const unsigned c = xb_ld(&bar[XB_XCNT(j)]); sum += c; cnt += (c > 0u) ? 1u : 0u; mine = (j == x) ? c : mine; }
    if (sum == G) break;
    __builtin_amdgcn_s_sleep(1);
    if ((++sp & 255u) == 0u) { if (xb_ld(&bar[XB_TMO])) break; if (sp > XB_SPIN_CAP) { atomicAdd(&bar[XB_TMO], 1u); break; } }
  }
  nloc = mine > 0u ? mine : 1u; nx = cnt > 0u ? cnt : 1u;
}
DEVI void xcd_barrier(const XcdBarrier& b) {
  asm volatile("s_waitcnt vmcnt(0)" ::: "memory");
  __syncthreads();
  if (threadIdx.x == 0) {
    unsigned* bar = b.bar;
    __builtin_amdgcn_s_waitcnt(0);
    unsigned nloc = b.st[0], nx = b.st[1];
    if (nloc == 0u) { xcd_barrier_complete(bar, b.x, nloc, nx); b.st[0] = nloc; b.st[1] = nx; }
    const unsigned old = xb_add(&bar[XB_XSUB(b.x)], 1u);
    const unsigned gen = old / nloc;
    if (old + 1u == (gen + 1u) * nloc) {
      __builtin_amdgcn_fence(__ATOMIC_RELEASE, "agent");
      asm volatile("s_waitcnt vmcnt(0)" ::: "memory");
      const unsigned og = xb_add(&bar[XB_TOP], 1u);
      const unsigned tg = og / nx;
      if (og + 1u == (tg + 1u) * nx) xb_add(&bar[XB_TOPGEN], 1u);
      else XB_SPIN(xb_ld(&bar[XB_TOPGEN]) == tg, bar);
      __builtin_amdgcn_fence(__ATOMIC_ACQUIRE, "agent");
      xb_add(&bar[XB_XGEN(b.x)], 1u);
      asm volatile("s_waitcnt vmcnt(0)" ::: "memory");
    } else {
      XB_SPIN(xb_ld(&bar[XB_XGEN(b.x)]) == gen, bar);
      __builtin_amdgcn_fence(__ATOMIC_ACQUIRE, "agent");
      asm volatile("s_waitcnt vmcnt(0)" ::: "memory");
    }
  }
  __syncthreads();
}

__global__ void __launch_bounds__(NTHR) fwd_kernel(Params p) {
  extern __shared__ __attribute__((aligned(16))) unsigned char smem[];
  LDS unsigned char* lds = (LDS unsigned char*)smem;
  const int lo = p.ph_lo, hi = p.ph_hi;
  volatile LDS unsigned* bst = (volatile LDS unsigned*)(lds + LDS_BYTES - 16);
  if (threadIdx.x < 4) bst[threadIdx.x] = 0u;
  __syncthreads();
  (void)xcd_barrier_post((unsigned*)(p.ws + WS_BAR), bst);
#ifndef REPEAT_PHASE
#define REPEAT_PHASE -1
#endif
#define GRID_SYNC(k) do { { XcdBarrier xb_; xb_.bar = (unsigned*)(get_params()->ws + WS_BAR); xb_.x = xb_xcc_id(); xb_.st = (volatile LDS unsigned*)(lds + LDS_BYTES - 16); xcd_barrier(xb_); } } while (0)
#define RUN_PHASE(k, fn) if (lo <= (k) && (k) < hi) { fn(*get_params(), lds); if ((k) == REPEAT_PHASE) { GRID_SYNC(k); fn(*get_params(), lds); } if ((k) + 1 < hi) GRID_SYNC(k); }
  RUN_PHASE(0, phase0)
  RUN_PHASE(1, phase1)
  RUN_PHASE(2, phase2)
  RUN_PHASE(3, phase3)
  RUN_PHASE(4, phase4)
  RUN_PHASE(5, phase5)
  RUN_PHASE(6, phase6)
  RUN_PHASE(7, phase7)
  RUN_PHASE(8, phase8)
  RUN_PHASE(9, phase9)
#undef GRID_SYNC
#undef RUN_PHASE
}

extern "C" void kernel_launch(void* const* d_in, const int* in_sizes, int n_in, void* d_out, int out_size, void* d_ws, size_t ws_size, hipStream_t stream) {
  static int grid = 0;
  if (grid == 0) {
    if (n_in != 24 || out_size != NTOK * DM || ws_size < WS_END) { fprintf(stderr, "kernel_launch: unexpected problem (n_in %d out %d ws %zu)\n", n_in, out_size, ws_size); grid = -1; return; }
    (void)hipFuncSetAttribute((const void*)fwd_kernel, hipFuncAttributeMaxDynamicSharedMemorySize, LDS_BYTES);
    int dev = 0, cus = 0, per_cu = 0;
    (void)hipGetDevice(&dev);
    (void)hipDeviceGetAttribute(&cus, hipDeviceAttributeMultiprocessorCount, dev);
    (void)hipOccupancyMaxActiveBlocksPerMultiprocessor(&per_cu, (const void*)fwd_kernel, NTHR, LDS_BYTES);
    if (per_cu < 1 || cus < 256) fprintf(stderr, "kernel_launch: occupancy %d blocks/CU on %d CUs\n", per_cu, cus);
    grid = 256;
  }
  if (grid < 0) return;
  (void)hipMemsetAsync((char*)d_ws + WS_CNT, 0, CTL_ZERO_BYTES, stream);
  Params p{};
  for (int i = 0; i < 24; ++i) p.in[i] = (const float*)d_in[i];
  p.out = (float*)d_out; p.ws = (unsigned char*)d_ws;
#if N_LAUNCH_MODE == 1
  p.ph_lo = 0; p.ph_hi = NPHASE;
  void* args[] = {&p};
  hipError_t e = hipLaunchCooperativeKernel((const void*)fwd_kernel, dim3(grid), dim3(NTHR), args, LDS_BYTES, stream);
  if (e != hipSuccess) fprintf(stderr, "cooperative launch failed: %s\n", hipGetErrorString(e));
#else
  for (int ph = 0; ph < NPHASE; ++ph) {
    p.ph_lo = ph; p.ph_hi = ph + 1;
    hipLaunchKernelGGL(fwd_kernel, dim3(grid), dim3(NTHR), LDS_BYTES, stream, p);
  }
#endif
}
```

```cpp
#include <hip/hip_runtime.h>
#include <cstdio>
#include <cstdint>

#ifndef N_LAUNCH_MODE
#define N_LAUNCH_MODE 1
#endif

#define DEVI __device__ __forceinline__
#define LDS __attribute__((address_space(3)))

typedef _Float16 h16;
typedef _Float16 h16x4 __attribute__((ext_vector_type(4)));
typedef _Float16 h16x8 __attribute__((ext_vector_type(8)));
typedef float f32x4 __attribute__((ext_vector_type(4)));
typedef float f32x16 __attribute__((ext_vector_type(16)));
typedef unsigned u32x2 __attribute__((ext_vector_type(2)));
typedef unsigned u32x4 __attribute__((ext_vector_type(4)));

constexpr int NBATCH = 4, SEQ = 8192, NTOK = NBATCH * SEQ, DM = 1024;
constexpr int NTHR = 512;
constexpr int NPHASE = 10;
constexpr int LDS_BYTES = 163840;

constexpr size_t MiB = 1ull << 20;
constexpr size_t WS_CNT = 0;
constexpr size_t CTL_ZERO_BYTES = 20480;
constexpr size_t WS_BAR = 4096;
constexpr size_t WS_MODP = 64 * 1024;
constexpr size_t WS_ROPE = 1 * MiB;
constexpr size_t WS_WIN = 3 * MiB;
constexpr size_t WS_WOUT = 10 * MiB;
constexpr size_t WS_WGU = 12 * MiB;
constexpr size_t WS_WDN = 44 * MiB;
constexpr size_t WS_WRG = 60 * MiB;
constexpr size_t WS_WRH = 60 * MiB + 512 * 1024;
constexpr size_t WS_WRL = 60 * MiB + 640 * 1024;
constexpr size_t WS_AGG = 61 * MiB;
constexpr size_t WS_ROUTE = 63 * MiB;
constexpr size_t WS_LIST = 64 * MiB;
constexpr size_t WS_LISTW = 68 * MiB;
constexpr size_t WS_WI = 72 * MiB;
constexpr size_t WS_KI = 73 * MiB;
constexpr size_t WS_MASK = 77 * MiB;
constexpr size_t WS_H = 109 * MiB;
constexpr size_t WS_Q = 173 * MiB;
constexpr size_t WS_K = 205 * MiB;
constexpr size_t WS_VT = 237 * MiB;
constexpr size_t WS_QI = 269 * MiB;
constexpr size_t WS_XR = 301 * MiB;
constexpr size_t WS_XG = 333 * MiB;
constexpr size_t WS_MIX = 365 * MiB;
constexpr size_t WS_ACT = 429 * MiB;
constexpr size_t WS_YP = 173 * MiB;
constexpr size_t WS_END = 510 * MiB;
constexpr size_t SC_BATCH_BYTES = 8192ull * 6176ull;
static_assert(SC_BATCH_BYTES <= 64 * MiB && WS_MIX + 3 * SC_BATCH_BYTES <= WS_END, "score slots");

struct Params { const float* in[24]; float* out; unsigned char* ws; int ph_lo, ph_hi; };
typedef const __attribute__((address_space(4))) Params& PRef;
typedef const __attribute__((address_space(4))) Params* PPtr;

__device__ const double ROPE_REV[32] = {
  1.59154943091895345608e-01, 1.19349370211248861917e-01, 8.94994016088910132600e-02, 6.71150830052272551196e-02,
  5.03292121044870352509e-02, 3.77415847174197710556e-02, 2.83021958306233986646e-02, 2.12236527647776604399e-02,
  1.59154943091895338669e-02, 1.19349370211248861917e-02, 8.94994016088910236684e-03, 6.71150830052272533849e-03,
  5.03292121044870369856e-03, 3.77415847174197719230e-03, 2.83021958306233986646e-03, 2.12236527647776621747e-03,
  1.59154943091895356017e-03, 1.19349370211248848907e-03, 8.94994016088910236684e-04, 6.71150830052272598901e-04,
  5.03292121044870326488e-04, 3.77415847174197740914e-04, 2.83021958306233954120e-04, 2.12236527647776605484e-04,
  1.59154943091895350596e-04, 1.19349370211248862459e-04, 8.94994016088910182474e-05, 6.71150830052272544691e-05,
  5.03292121044870353593e-05, 3.77415847174197768019e-05, 2.83021958306233960897e-05, 2.12236527647776591931e-05};

DEVI int launder(int x) { asm volatile("" : "+v"(x)); return x; }
DEVI PPtr get_params() { PPtr k = (PPtr)__builtin_amdgcn_kernarg_segment_ptr(); asm volatile("" : "+s"(k)); return k; }
DEVI int wave_id(int tid) { return __builtin_amdgcn_readfirstlane(tid >> 6); }
DEVI f32x16 mfma16(h16x8 a, h16x8 b, f32x16 c) { return __builtin_amdgcn_mfma_f32_32x32x16_f16(a, b, c, 0, 0, 0); }
DEVI float wave_sum(float v) {
#pragma unroll
  for (int o = 1; o < 64; o <<= 1) v += __shfl_xor(v, o);
  return v;
}
DEVI float sigmoid_f(float x) { return __builtin_amdgcn_rcpf(1.f + __expf(-x)); }
DEVI float silu_f(float x) { return x * __builtin_amdgcn_rcpf(1.f + __expf(-x)); }
DEVI float gelu_tanh_f(float x) {
  const float u = 0.7978845608028654f * (x + 0.044715f * x * x * x);
  const float t = 1.f - 2.f * __builtin_amdgcn_rcpf(1.f + __expf(2.f * u));
  return 0.5f * x * (1.f + t);
}
DEVI unsigned fkey(float f) { unsigned u = __float_as_uint(f); return (u & 0x80000000u) ? ~u : (u | 0x80000000u); }
DEVI float fkey_inv(unsigned k) { unsigned u = (k & 0x80000000u) ? (k & 0x7fffffffu) : ~k; return __uint_as_float(u); }
DEVI int vt_perm(int pos) { return (pos & ~12) | ((pos & 4) << 1) | ((pos & 8) >> 1); }

DEVI void mod_to_lds(PRef p, int b, int chunk, LDS float* dst) {
  const float* mp = (const float*)(p.ws + WS_MODP);
  for (int k = threadIdx.x; k < 1024; k += NTHR) {
    const int j = chunk * 1024 + k;
    float v[8];
#pragma unroll
    for (int ks = 0; ks < 8; ++ks) v[ks] = mp[(size_t)(ks * 4 + b) * 6144 + j];
    float s = p.in[3][j];
#pragma unroll
    for (int ks = 0; ks < 8; ++ks) s += v[ks];
    dst[k] = s;
  }
}

constexpr int LROW = 144;

namespace g8 {
constexpr int BM = 256, BK = 64, HALF = 128, HTB = HALF * BK * 2, STAGE_BYTES = 8 * HTB;
DEVI int lds_byte(int r, int c) { const int st = (r >> 4) * 2 + (c >> 5), rr = r & 15, cc = c & 31, ob = rr * 64 + cc * 2; return st * 1024 + (ob ^ (((ob >> 9) & 1) << 5)); }
DEVI void stage_rc(int b, int& R, int& C) { const int st = b / 1024, sb = b % 1024, swz = sb ^ (((sb >> 9) & 1) << 5); R = (st >> 1) * 16 + swz / 64; C = (st & 1) * 32 + (swz % 64) / 2; }
struct Unit { const char* A; unsigned va[2][2]; const char* B; int pm, pn, e, cnt, off; };
DEVI void glds16(const char* src, LDS unsigned char* dst) { __builtin_amdgcn_global_load_lds((const unsigned*)src, (LDS unsigned*)dst, 16, 0, 0); }

DEVI void dense_va(unsigned (&va)[2][2], int K) {
  const int tid = threadIdx.x;
#pragma unroll
  for (int h = 0; h < 2; ++h)
#pragma unroll
    for (int i = 0; i < 2; ++i) { int R, C; stage_rc(tid * 16 + i * 8192, R, C); va[h][i] = (unsigned)((128 * h + R) * K + C) * 2u; }
}
template <class Sched, class Epi>
DEVI void gemm_phase(LDS unsigned char* lds, int K, const Sched& S, const Epi& E) {
  const int tid = launder((int)threadIdx.x), wid = wave_id(tid), lane = tid & 63, wr = wid >> 2, wc = wid & 3, fr = lane & 15, fq = lane >> 4;
  const int nt = launder(K) / BK;
  unsigned vb[2];
#pragma unroll
  for (int i = 0; i < 2; ++i) { int R, C; stage_rc(tid * 16 + i * 8192, R, C); vb[i] = (unsigned)(R * K + C) * 2u; }
  const size_t kstep = (size_t)(BK * 2), hstep = (size_t)HALF * K * 2;
  const unsigned ldsw = (unsigned)wid * 1024u;
  const int aoff = lds_byte(wr * 64 + fr, fq * 8), boff = lds_byte(wc * 32 + fr, fq * 8);
#define G8_SA(b, h) (((b) * 2 + (h)) * HTB)
#define G8_SB(b, h) ((4 + (b) * 2 + (h)) * HTB)
#define G8_STAGE(bufoff, gbase, v) do { glds16((gbase) + (v)[0], lds + (bufoff) + ldsw); glds16((gbase) + (v)[1], lds + (bufoff) + ldsw + 8192); } while (0)
#define G8_STAGEA(bufoff, gbase, h) do { glds16((gbase) + G8_VAC(h, 0), lds + (bufoff) + ldsw); glds16((gbase) + G8_VAC(h, 1), lds + (bufoff) + ldsw + 8192); } while (0)
#define G8_LDA(dst, b, h) do { _Pragma("unroll") for (int m = 0; m < 4; ++m) _Pragma("unroll") for (int k = 0; k < 2; ++k) dst[m][k] = *(const LDS h16x8*)(lds + G8_SA(b, h) + aoff + m * 2048 + k * 1024); } while (0)
#define G8_LDB(dst, b, h) do { _Pragma("unroll") for (int n = 0; n < 2; ++n) _Pragma("unroll") for (int k = 0; k < 2; ++k) dst[n][k] = *(const LDS h16x8*)(lds + G8_SB(b, h) + boff + n * 2048 + k * 1024); } while (0)
#define G8_MMA(ai, bj, At, Bt) do { __builtin_amdgcn_s_setprio(1); _Pragma("unroll") for (int m = 0; m < 4; ++m) _Pragma("unroll") for (int n = 0; n < 2; ++n) _Pragma("unroll") for (int k = 0; k < 2; ++k) \
        acc[ai][bj][m][n] = __builtin_amdgcn_mfma_f32_16x16x32_f16(Bt[n][k], At[m][k], acc[ai][bj][m][n], 0, 0, 0); __builtin_amdgcn_s_setprio(0); } while (0)
#define G8_WAIT_V(n) asm volatile("s_waitcnt vmcnt(" #n ")" ::: "memory")
#define G8_WAIT_L(n) asm volatile("s_waitcnt lgkmcnt(" #n ")" ::: "memory")
#define G8_BAR __builtin_amdgcn_s_barrier()
#define G8_SCHED __builtin_amdgcn_sched_barrier(0)
  Unit cur, nxt; int ui = 0;
  if (!S.next(0, cur)) return;
  unsigned vd[2][2];
  if (!Sched::GATHER) dense_va(vd, K);
#define G8_VAC(h, i) (Sched::GATHER ? cur.va[h][i] : vd[h][i])
#define G8_VAN(h, i) (Sched::GATHER ? nxt.va[h][i] : vd[h][i])
  f32x4 acc[2][2][4][2];
#pragma unroll
  for (int a = 0; a < 2; ++a)
#pragma unroll
    for (int b = 0; b < 2; ++b)
#pragma unroll
      for (int m = 0; m < 4; ++m)
#pragma unroll
        for (int n = 0; n < 2; ++n) acc[a][b][m][n] = (f32x4){0.f, 0.f, 0.f, 0.f};
  h16x8 At[4][2], B0[2][2], B1[2][2];
  const char* cA = cur.A; const char* cB = cur.B;
  G8_STAGE(G8_SB(0, 0), cB, vb); G8_STAGE(G8_SB(0, 1), cB + hstep, vb); G8_STAGEA(G8_SA(0, 0), cA, 0); G8_STAGEA(G8_SA(0, 1), cA, 1);
  if (wr == 1) G8_BAR;
  G8_WAIT_V(2); G8_BAR;
  G8_STAGE(G8_SB(1, 0), cB + kstep, vb); G8_STAGEA(G8_SA(1, 0), cA + kstep, 0); G8_STAGE(G8_SB(1, 1), cB + hstep + kstep, vb);
  G8_WAIT_V(6); G8_BAR;
  for (;;) {
    const bool has_next = S.next(ui + 1, nxt);
    if (!has_next) nxt = cur;
    const char* nA = nxt.A; const char* nB = nxt.B;
#pragma unroll 1
    for (int t = 0; t < nt; t += 2) {
      const bool last = (t == nt - 2);
      const char* a1 = cA + (size_t)(t + 1) * kstep;
      const char* a2 = last ? nA : cA + (size_t)(t + 2) * kstep; const char* b2 = last ? nB : cB + (size_t)(t + 2) * kstep;
      const char* a3 = a2 + kstep; const char* b3 = b2 + kstep;
#define G8_STAGE2(bufoff, gbase, h) do { glds16((gbase) + (last ? G8_VAN(h, 0) : G8_VAC(h, 0)), lds + (bufoff) + ldsw); glds16((gbase) + (last ? G8_VAN(h, 1) : G8_VAC(h, 1)), lds + (bufoff) + ldsw + 8192); } while (0)
      G8_LDB(B0, 0, 0); G8_LDB(B1, 0, 1); G8_SCHED; G8_LDA(At, 0, 0); G8_STAGEA(G8_SA(1, 1), a1, 1);
      G8_WAIT_V(8); G8_WAIT_L(0); G8_BAR; G8_MMA(0, 0, At, B0); G8_MMA(0, 1, At, B1); G8_BAR; G8_SCHED;
      G8_LDA(At, 0, 1); G8_STAGE(G8_SB(0, 0), b2, vb); G8_STAGE(G8_SB(0, 1), b2 + hstep, vb); G8_STAGE2(G8_SA(0, 0), a2, 0);
      G8_WAIT_V(8); G8_WAIT_L(0); G8_BAR; G8_MMA(1, 0, At, B0); G8_MMA(1, 1, At, B1); G8_BAR; G8_SCHED;
      G8_LDB(B0, 1, 0); G8_LDB(B1, 1, 1); G8_SCHED; G8_LDA(At, 1, 0); G8_STAGE2(G8_SA(0, 1), a2, 1);
      G8_WAIT_V(8); G8_WAIT_L(0); G8_BAR; G8_MMA(0, 0, At, B0); G8_MMA(0, 1, At, B1); G8_BAR; G8_SCHED;
      G8_LDA(At, 1, 1); G8_STAGE(G8_SB(1, 0), b3, vb); G8_STAGE(G8_SB(1, 1), b3 + hstep, vb); G8_STAGE2(G8_SA(1, 0), a3, 0);
      G8_WAIT_V(8); G8_WAIT_L(0); G8_BAR; G8_MMA(1, 0, At, B0); G8_MMA(1, 1, At, B1); G8_BAR; G8_SCHED;
    }
#undef G8_STAGE2
    if (wr == 0) G8_BAR;
    E(acc, cur, wr, wc, fr, fq);
    if (!has_next) break;
#pragma unroll
    for (int a = 0; a < 2; ++a)
#pragma unroll
      for (int b = 0; b < 2; ++b)
#pragma unroll
        for (int m = 0; m < 4; ++m)
#pragma unroll
          for (int n = 0; n < 2; ++n) acc[a][b][m][n] = (f32x4){0.f, 0.f, 0.f, 0.f};
    cur = nxt; cA = nA; cB = nB; ++ui;
    if (wr == 1) G8_BAR;
  }
  G8_WAIT_V(0);
  G8_BAR;
#undef G8_SA
#undef G8_STAGEA
#undef G8_VAC
#undef G8_VAN
#undef G8_SB
#undef G8_STAGE
#undef G8_LDA
#undef G8_LDB
#undef G8_MMA
#undef G8_WAIT_V
#undef G8_WAIT_L
#undef G8_BAR
#undef G8_SCHED
}
struct DenseOrder {
  static constexpr bool GATHER = false;
  const h16* A; const h16* Bt; int K, nM, nN, G, c;
  DEVI bool next(int i, Unit& u) const {
    const int nwg = nM * nN; const long L = (long)i * G + c; if (L >= nwg) return false;
    int wgid = (int)L; { const int q = nwg / 8, r = nwg % 8, xcd = wgid % 8, off = wgid / 8; wgid = (xcd < r ? xcd * (q + 1) : r * (q + 1) + (xcd - r) * q) + off; }
    const int nig = 8 * nN, gid = wgid / nig, fm = gid * 8, gsz = (nM - fm) < 8 ? (nM - fm) : 8;
    u.pm = fm + ((wgid % nig) % gsz); u.pn = (wgid % nig) / gsz; u.e = 0; u.cnt = 0x7fffffff; u.off = 0;
    u.A = (const char*)(A + (size_t)u.pm * 256 * K); u.B = (const char*)(Bt + (size_t)u.pn * 256 * K);
    u.va[0][0] = u.va[0][1] = u.va[1][0] = u.va[1][1] = 0u;
    return true;
  }
};
}


DEVI h16x4 pack4(float a, float b, float c, float d) { h16x4 v; v[0] = (h16)a; v[1] = (h16)b; v[2] = (h16)c; v[3] = (h16)d; return v; }

template <class F>
DEVI void transpose_item(const float* src, int N, int kb, int nb, h16* dst, int ldd, F drow, LDS float* scr, int lane) {
#pragma unroll 8
  for (int i = 0; i < 32; ++i) {
    const int kk = 2 * i + (lane >> 5), n = nb * 32 + (lane & 31);
    scr[kk * 33 + (lane & 31)] = (n < N) ? src[(size_t)(kb * 64 + kk) * N + n] : 0.f;
  }
  asm volatile("s_waitcnt lgkmcnt(0)" ::: "memory");
  const int c = lane & 7;
#pragma unroll
  for (int j = 0; j < 4; ++j) {
    const int nl = (lane >> 3) + 8 * j, n = nb * 32 + nl;
    h16x8 v;
#pragma unroll
    for (int e = 0; e < 8; ++e) v[e] = (h16)scr[(c * 8 + e) * 33 + nl];
    if (n < N) *(h16x8*)(dst + (size_t)drow(n) * ldd + kb * 64 + c * 8) = v;
  }
  asm volatile("s_waitcnt lgkmcnt(0)" ::: "memory");
}

DEVI void phase0(PRef p, LDS unsigned char* lds) {
  const int tid = launder((int)threadIdx.x), lane = tid & 63, wave = wave_id(tid), G = gridDim.x;
  const int gw = blockIdx.x * 8 + wave, NW = G * 8;
  {
    const float* c = p.in[1]; const float* wada = p.in[2]; float* mp = (float*)(p.ws + WS_MODP);
    for (int u = gw; u < 96 * 8; u += NW) {
      const int cgp = u % 96, ks = u / 96, j = cgp * 64 + lane;
      float a0 = 0.f, a1 = 0.f, a2 = 0.f, a3 = 0.f;
      for (int k0 = ks * 128; k0 < ks * 128 + 128; k0 += 16) {
        float w[16];
#pragma unroll
        for (int u = 0; u < 16; ++u) w[u] = wada[(size_t)(k0 + u) * 6144 + j];
#pragma unroll
        for (int u = 0; u < 16; ++u) {
          const int k = k0 + u;
          a0 = fmaf(silu_f(c[k]), w[u], a0); a1 = fmaf(silu_f(c[1024 + k]), w[u], a1);
          a2 = fmaf(silu_f(c[2048 + k]), w[u], a2); a3 = fmaf(silu_f(c[3072 + k]), w[u], a3);
        }
      }
      mp[(size_t)(ks * 4 + 0) * 6144 + j] = a0; mp[(size_t)(ks * 4 + 1) * 6144 + j] = a1;
      mp[(size_t)(ks * 4 + 2) * 6144 + j] = a2; mp[(size_t)(ks * 4 + 3) * 6144 + j] = a3;
    }
  }
  {
    LDS float* scr = (LDS float*)lds + wave * (64 * 33);
    constexpr int I_IN = 16 * 99, I_OUT = 16 * 32, I_G = 32 * 128, I_U = 32 * 128, I_D = 32 * 128, I_RG = 32;
    constexpr int NIT = I_IN + I_OUT + I_G + I_U + I_D + I_RG;
    for (int it = gw; it < NIT; it += NW) {
      int r = it;
      if (r < I_IN) {
        transpose_item(p.in[8], 3144, r / 99, r % 99, (h16*)(p.ws + WS_WIN), 1024,
                       [](int n) { const int dl = n < 2112 ? n : (n < 2120 ? 3136 + (n - 2112) : (n < 2632 ? 2112 + (n - 2120) : 2624 + (n - 2632)));
                                     const int d = dl & 63, sx = (dl >> 6) & 3;
                                     return (dl & ~255) + 128 * (d >> 5) + 32 * sx + 16 * ((d >> 2) & 1) + 4 * ((d >> 3) & 3) + (d & 3); }, scr, lane);
        continue;
      }
      r -= I_IN;
      if (r < I_OUT) { transpose_item(p.in[16], 1024, r / 32, r % 32, (h16*)(p.ws + WS_WOUT), 1024, [](int n) { return (n & ~31) + 16 * ((n >> 2) & 1) + 4 * ((n >> 3) & 3) + (n & 3); }, scr, lane); continue; }
      r -= I_OUT;
      if (r < I_G) { const int e = r >> 7, q = r & 127;
        transpose_item(p.in[21] + (size_t)e * 1024 * 256, 256, q >> 3, q & 7, (h16*)(p.ws + WS_WGU) + (size_t)e * 512 * 1024, 1024, [](int f) { return (f >> 4) * 32 + (f & 15); }, scr, lane); continue; }
      r -= I_G;
      if (r < I_U) { const int e = r >> 7, q = r & 127;
        transpose_item(p.in[22] + (size_t)e * 1024 * 256, 256, q >> 3, q & 7, (h16*)(p.ws + WS_WGU) + (size_t)e * 512 * 1024, 1024, [](int f) { return (f >> 4) * 32 + 16 + (f & 15); }, scr, lane); continue; }
      r -= I_U;
      if (r < I_D) { const int e = r >> 7, q = r & 127;
        transpose_item(p.in[23] + (size_t)e * 256 * 1024, 1024, q >> 5, q & 31, (h16*)(p.ws + WS_WDN) + (size_t)e * 1024 * 256, 256, [](int n) { return (n & ~31) + 16 * ((n >> 2) & 1) + 4 * ((n >> 3) & 3) + (n & 3); }, scr, lane); continue; }
      r -= I_D;
      if (r < 16) transpose_item(p.in[11] + (size_t)(r >> 1) * 4096, 64, 0, r & 1, (h16*)(p.ws + WS_WRG) + (size_t)(r >> 1) * 128 * 64, 64, [](int n) { return n; }, scr, lane);
      else transpose_item(p.in[13] + (size_t)((r - 16) >> 1) * 4096, 64, 0, r & 1, (h16*)(p.ws + WS_WRG) + (size_t)((r - 16) >> 1) * 128 * 64, 64, [](int n) { return 64 + n; }, scr, lane);
    }
  }
  {
    h16* wrh = (h16*)(p.ws + WS_WRH); h16* wrl = (h16*)(p.ws + WS_WRL);
    for (int i = blockIdx.x * NTHR + tid; i < 48 * 1024; i += G * NTHR) {
      const int col = i >> 10, k = i & 1023;
      const float w = (col < 4) ? p.in[17][k * 4 + col] : (col < 36 ? p.in[19][k * 32 + (col - 4)] : 0.f);
      const h16 hi = (h16)w;
      wrh[i] = hi; wrl[i] = (h16)(w - (float)hi);
    }
    float* ct = (float*)(p.ws + WS_ROPE); float* st = ct + 8192 * 32;
    for (int i = blockIdx.x * NTHR + tid; i < 8192 * 32; i += G * NTHR) {
      const int pos = i >> 5, f = i & 31;
      const double rev = (double)pos * ROPE_REV[f];
      const float fr = (float)(rev - __builtin_rint(rev));
      ct[i] = __builtin_amdgcn_cosf(fr); st[i] = __builtin_amdgcn_sinf(fr);
    }
  }
}

DEVI void phase1(PRef p, LDS unsigned char* lds) {
  const int tid = launder((int)threadIdx.x), lane = tid & 63, wave = wave_id(tid), G = gridDim.x;
  const int b = blockIdx.x & 3, bi = blockIdx.x >> 2, nbk = G >> 2;
  LDS float* mv = (LDS float*)lds;
  mod_to_lds(p, b, 0, mv); mod_to_lds(p, b, 1, mv + 1024);
  __syncthreads();
  f32x4 A[4], SH[4];
#pragma unroll
  for (int j = 0; j < 4; ++j) {
    const int k = 256 * j + 4 * lane;
    const f32x4 g = *(const f32x4*)(p.in[4] + k);
    A[j] = g * (*(LDS f32x4*)(mv + 1024 + k) + 1.f);
    SH[j] = *(LDS f32x4*)(mv + k);
  }
  const float* x = p.in[0]; h16* H = (h16*)(p.ws + WS_H);
  f32x4 vn[4];
  {
    const size_t tok = (size_t)b * SEQ + bi * 8 + wave;
#pragma unroll
    for (int j = 0; j < 4; ++j) vn[j] = *(const f32x4*)(x + tok * DM + 256 * j + 4 * lane);
  }
  for (int r = bi * 8 + wave; r < SEQ; r += nbk * 8) {
    const size_t tok = (size_t)b * SEQ + r;
    f32x4 v[4]; float ss = 0.f;
#pragma unroll
    for (int j = 0; j < 4; ++j) { v[j] = vn[j]; ss += v[j][0] * v[j][0] + v[j][1] * v[j][1] + v[j][2] * v[j][2] + v[j][3] * v[j][3]; }
    if (r + nbk * 8 < SEQ) {
#pragma unroll
      for (int j = 0; j < 4; ++j) vn[j] = *(const f32x4*)(x + (tok + nbk * 8) * DM + 256 * j + 4 * lane);
    }
    const float rstd = 1.0f / sqrtf(wave_sum(ss) * (1.f / 1024.f) + 1e-6f);
#pragma unroll
    for (int j = 0; j < 4; ++j) {
      const f32x4 y = v[j] * rstd * A[j] + SH[j];
      *(h16x4*)(H + tok * DM + 256 * j + 4 * lane) = pack4(y[0], y[1], y[2], y[3]);
    }
  }
}

DEVI h16x8 pack8(const f32x4& a, const f32x4& b) { h16x8 w; w[0] = (h16)a[0]; w[1] = (h16)a[1]; w[2] = (h16)a[2]; w[3] = (h16)a[3]; w[4] = (h16)b[0]; w[5] = (h16)b[1]; w[6] = (h16)b[2]; w[7] = (h16)b[3]; return w; }
struct EpiInProj {
  unsigned char* ws;
  DEVI void operator()(const f32x4 (&acc)[2][2][4][2], const g8::Unit& u, int wr, int wc, int fr, int fq) const {
    const float* cosT = (const float*)(ws + WS_ROPE); const float* sinT = cosT + 8192 * 32;
    const int g = 4 * u.pn + wc;
    if (g > 49) return;
    const int d0 = 8 * fq;
#pragma unroll
    for (int ai = 0; ai < 2; ++ai)
#pragma unroll
      for (int m = 0; m < 4; ++m) {
        const int tok = u.pm * 256 + 128 * ai + 64 * wr + 16 * m + fr;
        const int b = tok >> 13, pos = tok & 8191;
        const f32x4 xa = acc[ai][0][m][0], xb = acc[ai][0][m][1], ya = acc[ai][1][m][0], yb = acc[ai][1][m][1];
        if (g < 16 || (g >= 24 && g <= 32)) {
          float scl; h16* dst;
          if (g < 8) { scl = 0.125f * 1.4426950408889634f; dst = (h16*)(ws + WS_Q) + (size_t)tok * 512 + g * 64; }
          else if (g < 16) { scl = 1.f; dst = (h16*)(ws + WS_K) + (size_t)tok * 512 + (g - 8) * 64; }
          else if (g < 32) { scl = 0.125f; dst = (h16*)(ws + WS_QI) + (size_t)tok * 512 + (g - 24) * 64; }
          else { scl = 1.f; dst = (h16*)(ws + WS_KI) + (size_t)tok * 64; }
          const f32x4 ca = *(const f32x4*)(cosT + pos * 32 + d0), cb = *(const f32x4*)(cosT + pos * 32 + d0 + 4);
          const f32x4 sa = *(const f32x4*)(sinT + pos * 32 + d0), sb = *(const f32x4*)(sinT + pos * 32 + d0 + 4);
          *(h16x8*)(dst + d0) = pack8((xa * ca - ya * sa) * scl, (xb * cb - yb * sb) * scl);
          *(h16x8*)(dst + 32 + d0) = pack8((ya * ca + xa * sa) * scl, (yb * cb + xb * sb) * scl);
        } else if (g < 24) {
          h16* vt = (h16*)(ws + WS_VT) + (size_t)(b * 8 + (g - 16)) * 64 * 8192 + vt_perm(pos);
#pragma unroll
          for (int e = 0; e < 4; ++e) {
            vt[(size_t)(d0 + e) * 8192] = (h16)xa[e]; vt[(size_t)(d0 + 4 + e) * 8192] = (h16)xb[e];
            vt[(size_t)(32 + d0 + e) * 8192] = (h16)ya[e]; vt[(size_t)(36 + d0 + e) * 8192] = (h16)yb[e];
          }
        } else if (g < 49) {
          h16* dst = (g < 41) ? (h16*)(ws + WS_XR) + (size_t)tok * 512 + (g - 33) * 64 : (h16*)(ws + WS_XG) + (size_t)tok * 512 + (g - 41) * 64;
          *(h16x8*)(dst + d0) = pack8(xa, xb);
          *(h16x8*)(dst + 32 + d0) = pack8(ya, yb);
        } else if (fq == 0) {
          const float sc = 0.35355339059327373f;
          float* wi = (float*)(ws + WS_WI) + (size_t)tok * 8;
          *(f32x4*)wi = xa * sc; *(f32x4*)(wi + 4) = xb * sc;
        }
      }
  }
};

DEVI void phase2(PRef p, LDS unsigned char* lds) {
  g8::DenseOrder S{(const h16*)(p.ws + WS_H), (const h16*)(p.ws + WS_WIN), DM, 128, 13, (int)gridDim.x, (int)blockIdx.x};
  EpiInProj E{p.ws};
  g8::gemm_phase(lds, DM, S, E);
}

constexpr int CROW = 1040;
constexpr int RNN_XG = 64 * CROW;
constexpr int RNN_CARRY = 2 * 64 * CROW;
template <int MODE>
DEVI void rnn_item(PRef p, LDS unsigned char* lds, int b, int cr) {
  const int tid = launder((int)threadIdx.x), lane = tid & 63, wave = wave_id(tid), l31 = lane & 31, half = lane >> 5;
  const h16* XR = (const h16*)(p.ws + WS_XR);
  {
    const int chg = tid & 63, tg = tid >> 6, pos0 = cr * 64 + 8 * tg;
    h16x8 xin[11];
#pragma unroll
    for (int i = 0; i < 11; ++i) {
      const int pos = pos0 + i - 3;
      if (pos >= 0) xin[i] = *(const h16x8*)(XR + ((size_t)b * SEQ + pos) * 512 + chg * 8);
      else {
#pragma unroll
        for (int e = 0; e < 8; ++e) xin[i][e] = (h16)0.f;
      }
    }
    float cw[4][8], cb[8];
#pragma unroll
    for (int e = 0; e < 8; ++e) {
      cb[e] = p.in[10][chg * 8 + e];
#pragma unroll
      for (int j = 0; j < 4; ++j) cw[j][e] = p.in[9][j * 512 + chg * 8 + e];
    }
#pragma unroll
    for (int tt = 0; tt < 8; ++tt) {
      h16x8 o;
#pragma unroll
      for (int e = 0; e < 8; ++e) {
        float v = cb[e];
#pragma unroll
        for (int j = 0; j < 4; ++j) v = fmaf(cw[j][e], (float)xin[tt + j][e], v);
        o[e] = (h16)v;
      }
      *(LDS h16x8*)(lds + (8 * tg + tt) * CROW + chg * 16) = o;
    }
  }
  if (MODE == 1) {
    const float2* ag = (const float2*)(p.ws + WS_AGG) + (size_t)b * 128 * 512 + tid;
    float carry = 0.f; int c2 = 0;
    for (; c2 + 8 <= cr; c2 += 8) {
      float2 v[8];
#pragma unroll
      for (int u = 0; u < 8; ++u) v[u] = ag[(size_t)(c2 + u) * 512];
#pragma unroll
      for (int u = 0; u < 8; ++u) carry = fmaf(v[u].x, carry, v[u].y);
    }
    for (; c2 < cr; ++c2) { const float2 v = ag[(size_t)c2 * 512]; carry = fmaf(v.x, carry, v.y); }
    ((LDS float*)(lds + RNN_CARRY))[tid] = carry;
  }
  if (MODE == 1) {
    const h16* XG = (const h16*)(p.ws + WS_XG) + ((size_t)b * SEQ + cr * 64) * 512;
#pragma unroll
    for (int i = 0; i < 8; ++i) { const int c = tid + NTHR * i, row = c >> 6, cc = c & 63; *(LDS h16x8*)(lds + RNN_XG + row * CROW + cc * 16) = *(const h16x8*)(XG + (size_t)row * 512 + cc * 8); }
  }
  __syncthreads();
  const int n = wave;
  const h16* WRG = (const h16*)(p.ws + WS_WRG) + (size_t)n * 128 * 64;
  float* AGG = (float*)(p.ws + WS_AGG);
#pragma unroll 1
  for (int dt = 0; dt < 2; ++dt) {
    h16x8 wa[4], wx[4];
#pragma unroll
    for (int kk = 0; kk < 4; ++kk) {
      wa[kk] = *(const h16x8*)(WRG + (size_t)(32 * dt + l31) * 64 + 16 * kk + 8 * half);
      wx[kk] = *(const h16x8*)(WRG + (size_t)(64 + 32 * dt + l31) * 64 + 16 * kk + 8 * half);
    }
    f32x16 ra[2], rx[2];
#pragma unroll
    for (int ti = 0; ti < 2; ++ti) {
#pragma unroll
      for (int r = 0; r < 16; ++r) { ra[ti][r] = 0.f; rx[ti][r] = 0.f; }
#pragma unroll
      for (int kk = 0; kk < 4; ++kk) {
        const h16x8 af = *(LDS h16x8*)(lds + (32 * ti + l31) * CROW + (n * 64 + 16 * kk + 8 * half) * 2);
        ra[ti] = mfma16(af, wa[kk], ra[ti]);
        rx[ti] = mfma16(af, wx[kk], rx[ti]);
      }
    }
    const int ch = n * 64 + 32 * dt + l31;
    const float ba = p.in[12][ch], bx = p.in[14][ch], lam = p.in[15][ch];
    const float c8 = -8.f * log1pf(__expf(-lam));
#pragma unroll
    for (int ti = 0; ti < 2; ++ti)
#pragma unroll
      for (int r = 0; r < 16; ++r) {
        const int tk = 32 * ti + (r & 3) + 8 * (r >> 2) + 4 * half;
        const float cv = (float)*(LDS h16*)(lds + tk * CROW + ch * 2);
        const float rr = sigmoid_f(ra[ti][r] + ba), ii = sigmoid_f(rx[ti][r] + bx);
        const float la = c8 * rr;
        ra[ti][r] = __expf(la);
        const float x2 = 2.f * la;
        const float om = -x2 * fmaf(x2 * 0.5f, fmaf(x2 * (1.f / 3.f), fmaf(x2 * 0.25f, fmaf(x2, 0.2f, 1.f), 1.f), 1.f), 1.f);
        rx[ti][r] = __builtin_amdgcn_sqrtf(om) * (ii * cv);
      }
    float P[8], Hs[8];
#pragma unroll
    for (int sg = 0; sg < 8; ++sg) {
      const int ti = sg >> 2, q = sg & 3;
      float pp = 1.f, hh = 0.f;
#pragma unroll
      for (int i = 0; i < 4; ++i) { const float a = ra[ti][4 * q + i], bb = rx[ti][4 * q + i]; hh = fmaf(a, hh, bb); pp *= a; }
      P[sg] = pp; Hs[sg] = hh;
    }
    float carry = 0.f, prod = 1.f;
    if (MODE == 1) carry = ((LDS float*)(lds + RNN_CARRY))[ch];
    float cin[8];
#pragma unroll
    for (int sg = 0; sg < 8; ++sg)
#pragma unroll
      for (int ow = 0; ow < 2; ++ow) {
        const float tmp = fmaf(P[sg], carry, Hs[sg]);
        const float tp = P[sg] * prod;
        if (half == ow) cin[sg] = carry;
        const float oth = __shfl_xor(tmp, 32), otp = __shfl_xor(tp, 32);
        carry = (half == ow) ? tmp : oth;
        prod = (half == ow) ? tp : otp;
      }
    if (MODE == 0) {
      if (half == 0) { float* ag = AGG + ((size_t)(b * 128 + cr) * 512 + ch) * 2; ag[0] = prod; ag[1] = carry; }
    } else {
#pragma unroll
      for (int sg = 0; sg < 8; ++sg) {
        const int ti = sg >> 2, q = sg & 3;
        float hh = cin[sg];
#pragma unroll
        for (int i = 0; i < 4; ++i) {
          hh = fmaf(ra[ti][4 * q + i], hh, rx[ti][4 * q + i]);
          LDS h16* xp = (LDS h16*)(lds + RNN_XG + (32 * ti + 8 * q + 4 * half + i) * CROW + ch * 2);
          *xp = (h16)(hh * gelu_tanh_f((float)*xp));
        }
      }
    }
  }
  __syncthreads();
  if (MODE == 1) {
    h16* Y = (h16*)(p.ws + WS_H) + ((size_t)b * SEQ + cr * 64) * DM + 512;
#pragma unroll
    for (int i = 0; i < 8; ++i) { const int c = tid + NTHR * i, row = c >> 6, cc = c & 63; *(h16x8*)(Y + (size_t)row * DM + cc * 8) = *(LDS h16x8*)(lds + RNN_XG + row * CROW + cc * 16); }
    __syncthreads();
  }
}

constexpr int IDX_NB = 256, IDX_CAP = 128;
constexpr int IL_HIST = 0, IL_CS = 65536, IL_CK = IL_CS + 64 * IDX_CAP * 4, IL_KI = IL_CK + 64 * IDX_CAP * 2, IL_KISZ = 128 * LROW, IL_ST = IL_KI + 2 * IL_KISZ;
static_assert(IL_ST + 4096 <= LDS_BYTES, "indexer LDS map");

DEVI f32x4 mfma16s(h16x8 a, h16x8 b, f32x4 c) { return __builtin_amdgcn_mfma_f32_16x16x32_f16(a, b, c, 0, 0, 0); }
DEVI void idx_score(LDS unsigned char* kit, int kh, int l15, int g4, const h16x8 (&qf)[8][2], const float (&wq)[8], f32x4 (&sc)[4]) {
  h16x8 kf[4][2];
#pragma unroll
  for (int kt = 0; kt < 4; ++kt)
#pragma unroll
    for (int ks = 0; ks < 2; ++ks) kf[kt][ks] = *(LDS h16x8*)(kit + (64 * kh + 16 * kt + l15) * LROW + (4 * ks + g4) * 16);
#pragma unroll
  for (int kt = 0; kt < 4; ++kt) sc[kt] = (f32x4){0.f, 0.f, 0.f, 0.f};
  f32x4 accA[4], accB[4];
#define IDX_MM(ACC, h) _Pragma("unroll") for (int kt = 0; kt < 4; ++kt) { ACC[kt] = mfma16s(kf[kt][0], qf[h][0], (f32x4){0.f, 0.f, 0.f, 0.f}); ACC[kt] = mfma16s(kf[kt][1], qf[h][1], ACC[kt]); }
#define IDX_RS(ACC, h) _Pragma("unroll") for (int kt = 0; kt < 4; ++kt) _Pragma("unroll") for (int r = 0; r < 4; ++r) sc[kt][r] = __builtin_fmaf(wq[h], __int_as_float(max(__float_as_int(ACC[kt][r]), 0)), sc[kt][r]);
  IDX_MM(accA, 0)
  IDX_MM(accB, 1) IDX_RS(accA, 0)
  IDX_MM(accA, 2) IDX_RS(accB, 1)
  IDX_MM(accB, 3) IDX_RS(accA, 2)
  IDX_MM(accA, 4) IDX_RS(accB, 3)
  IDX_MM(accB, 5) IDX_RS(accA, 4)
  IDX_MM(accA, 6) IDX_RS(accB, 5)
  IDX_MM(accB, 7) IDX_RS(accA, 6)
  IDX_RS(accB, 7)
#undef IDX_MM
#undef IDX_RS
}

template <int MODE>
DEVI void idx_pass(LDS unsigned char* lds, const h16* KIb, int N, int stride, int qg, int kh,
                   const h16* QIrow0, const float* WIrow0, float qinv, float qoff, int bstar, h16* scbase) {
  const int tid = launder((int)threadIdx.x), lane = tid & 63, l15 = lane & 15, g4 = lane >> 4;
  const int q = 16 * qg + l15;
  h16x8 qf[8][2]; float wq[8];
  {
    const h16* QI = QIrow0 + (size_t)q * 512;
#pragma unroll
    for (int h = 0; h < 8; ++h)
#pragma unroll
      for (int ks = 0; ks < 2; ++ks) qf[h][ks] = *(const h16x8*)(QI + h * 64 + 32 * ks + 8 * g4);
    const float* WI = WIrow0 + (size_t)q * 8;
#pragma unroll
    for (int h = 0; h < 8; ++h) wq[h] = WI[h];
  }
  LDS unsigned* hist = (LDS unsigned*)(lds + IL_HIST);
  LDS unsigned* st = (LDS unsigned*)(lds + IL_ST);
  const int nst = (N + 127) >> 7;
  const int lr = tid >> 3, lc = tid & 7;
  h16x8 r0, r1;
  r0 = *(const h16x8*)(KIb + (size_t)lr * 64 + lc * 8); r1 = *(const h16x8*)(KIb + (size_t)(lr + 64) * 64 + lc * 8);
  *(LDS h16x8*)(lds + IL_KI + lr * LROW + lc * 16) = r0; *(LDS h16x8*)(lds + IL_KI + (lr + 64) * LROW + lc * 16) = r1;
  __syncthreads();
  float vmin = INFINITY, vmax = -INFINITY;
  int cur = 0;
  for (int s = 0; s < nst; s += stride) {
    const int nx = s + stride;
    if (nx < nst) { r0 = *(const h16x8*)(KIb + (size_t)(128 * nx + lr) * 64 + lc * 8); r1 = *(const h16x8*)(KIb + (size_t)(128 * nx + lr + 64) * 64 + lc * 8); }
    if (128 * s + 64 * kh < N) {
      f32x4 sc[4];
      idx_score(lds + IL_KI + cur * IL_KISZ, kh, l15, g4, qf, wq, sc);
      if (MODE == 0) {
#pragma unroll
        for (int kt = 0; kt < 4; ++kt)
#pragma unroll
          for (int r = 0; r < 4; ++r) { vmin = fminf(vmin, sc[kt][r]); vmax = fmaxf(vmax, sc[kt][r]); }
      } else if (MODE == 1) {
        h16* scp = scbase + ((size_t)((s * 2 + kh) * 4) * 1024 + q * 16 + 4 * g4);
#pragma unroll
        for (int kt = 0; kt < 4; ++kt) {
          const h16x4 hv = pack4(sc[kt][0], sc[kt][1], sc[kt][2], sc[kt][3]);
          *(h16x4*)(scp + kt * 1024) = hv;
#pragma unroll
          for (int r = 0; r < 4; ++r) {
            const float xb = fminf(fmaxf(__builtin_fmaf((float)hv[r], qinv, qoff), 0.f), (float)(IDX_NB - 1));
            const int bin = (int)xb;
            __hip_atomic_fetch_add(&hist[bin * 64 + q], 1u, __ATOMIC_RELAXED, __HIP_MEMORY_SCOPE_WORKGROUP);
          }
        }
      }
    }
    if (nx < nst) {
      *(LDS h16x8*)(lds + IL_KI + (cur ^ 1) * IL_KISZ + lr * LROW + lc * 16) = r0;
      *(LDS h16x8*)(lds + IL_KI + (cur ^ 1) * IL_KISZ + (lr + 64) * LROW + lc * 16) = r1;
    }
    __syncthreads();
    cur ^= 1;
  }
  if (MODE == 0) {
    __hip_atomic_fetch_min(&st[q], fkey(vmin), __ATOMIC_RELAXED, __HIP_MEMORY_SCOPE_WORKGROUP);
    __hip_atomic_fetch_max(&st[64 + q], fkey(vmax), __ATOMIC_RELAXED, __HIP_MEMORY_SCOPE_WORKGROUP);
  }
}

DEVI int idx_bin(float sv, float qinv, float qoff) { return (int)fminf(fmaxf(__builtin_fmaf(sv, qinv, qoff), 0.f), (float)(IDX_NB - 1)); }
DEVI float idx_bin_lower_bound(int target, float qinv, float qoff) {
  if (target <= 0) return -INFINITY;
  if (target > IDX_NB - 1) return INFINITY;
  unsigned lo = 0x03FFu, hi = 0xFC00u;
  auto val = [](unsigned k) { const unsigned short hbits = (unsigned short)((k & 0x8000u) ? (k & 0x7FFFu) : (~k & 0xFFFFu)); return (float)__builtin_bit_cast(h16, hbits); };
  if (idx_bin(val(hi), qinv, qoff) < target) return INFINITY;
  while (lo < hi) { const unsigned mid = (lo + hi) >> 1; if (idx_bin(val(mid), qinv, qoff) >= target) hi = mid; else lo = mid + 1; }
  return val(lo);
}
DEVI void idx_stream_step(LDS unsigned char* lds, LDS unsigned* st, const unsigned long long (&cur)[4], int s, int kh, int q, int lane, int g4, float thi, float tlo) {
  unsigned nib = 0u;
#pragma unroll
  for (int kt = 3; kt >= 0; --kt) {
    const h16x4 hv = __builtin_bit_cast(h16x4, cur[kt]);
#pragma unroll
    for (int r = 3; r >= 0; --r) {
      const float sv = (float)hv[r];
      const unsigned long long ms = __builtin_amdgcn_ballot_w64(sv >= thi);
      asm("v_addc_co_u32_e64 %0, vcc, %0, %0, %1" : "+v"(nib) : "s"(ms) : "vcc");
      const bool cand = (sv >= tlo) && !(sv >= thi);
      if (__builtin_amdgcn_ballot_w64(cand) != 0ull) {
        if (cand) {
          const unsigned pos = __hip_atomic_fetch_add(&st[128 + q], 1u, __ATOMIC_RELAXED, __HIP_MEMORY_SCOPE_WORKGROUP);
          if (pos < (unsigned)IDX_CAP) {
            ((LDS float*)(lds + IL_CS))[q * IDX_CAP + pos] = sv;
            ((LDS unsigned short*)(lds + IL_CK))[q * IDX_CAP + pos] = (unsigned short)(128 * s + 64 * kh + 16 * kt + 4 * g4 + r);
          }
        }
      }
    }
  }
  const unsigned oth = (unsigned)__shfl_xor((int)nib, 32);
  if (lane < 32) {
#pragma unroll
    for (int T = 0; T < 2; ++T) {
      const unsigned b0 = ((nib >> (8 * T)) & 15u) | (((oth >> (8 * T)) & 15u) << 4);
      const unsigned b1 = ((nib >> (8 * T + 4)) & 15u) | (((oth >> (8 * T + 4)) & 15u) << 4);
      ((LDS unsigned short*)(lds + IL_HIST))[q * 512 + (4 * s + 2 * kh + T) * 2 + (g4 & 1)] = (unsigned short)(b0 | (b1 << 8));
    }
  }
}
DEVI void idx_stream(LDS unsigned char* lds, int N, int qg, int kh, float thi, float tlo, const h16* scbase) {
  const int tid = launder((int)threadIdx.x), lane = tid & 63, l15 = lane & 15, g4 = lane >> 4;
  const int q = 16 * qg + l15;
  LDS unsigned* st = (LDS unsigned*)(lds + IL_ST);
  const int nv = (N - 64 * kh + 127) >> 7;
  const unsigned long long* scp = (const unsigned long long*)(scbase + ((size_t)(kh * 4) * 1024 + q * 16 + 4 * g4));
#define IDX_LD(dst, s_) do { if ((s_) < nv) { _Pragma("unroll") for (int kt = 0; kt < 4; ++kt) dst[kt] = __hip_atomic_load(scp + (size_t)(s_) * 2048 + kt * 256, __ATOMIC_RELAXED, __HIP_MEMORY_SCOPE_AGENT); } } while (0)
  unsigned long long b0[4], b1[4], b2[4], b3[4];
  IDX_LD(b0, 0); IDX_LD(b1, 1); IDX_LD(b2, 2); IDX_LD(b3, 3);
  for (int s = 0; s < nv; s += 4) {
    idx_stream_step(lds, st, b0, s, kh, q, lane, g4, thi, tlo); IDX_LD(b0, s + 4);
    if (s + 1 < nv) { idx_stream_step(lds, st, b1, s + 1, kh, q, lane, g4, thi, tlo); IDX_LD(b1, s + 5); }
    if (s + 2 < nv) { idx_stream_step(lds, st, b2, s + 2, kh, q, lane, g4, thi, tlo); IDX_LD(b2, s + 6); }
    if (s + 3 < nv) { idx_stream_step(lds, st, b3, s + 3, kh, q, lane, g4, thi, tlo); IDX_LD(b3, s + 7); }
  }
#undef IDX_LD
}

DEVI void idx_item(PRef p, LDS unsigned char* lds, int b, int c) {
  const int tid = launder((int)threadIdx.x), lane = tid & 63, wave = wave_id(tid), l31 = lane & 31, half = lane >> 5;
  const int N = 64 * (c + 1);
  unsigned* MASK = (unsigned*)(p.ws + WS_MASK) + ((size_t)b * SEQ + 64 * c) * 256;
  if (N <= 256) {
    const int wpr = N >> 5;
    for (int i = tid; i < 64 * wpr; i += NTHR) MASK[(size_t)(i / wpr) * 256 + (i % wpr)] = 0xFFFFFFFFu;
    return;
  }
  const int qg = wave & 3, kh = wave >> 2, l15 = lane & 15, q = 16 * qg + l15;
  const h16* QIrow0 = (const h16*)(p.ws + WS_QI) + ((size_t)b * SEQ + 64 * c) * 512;
  const float* WIrow0 = (const float*)(p.ws + WS_WI) + ((size_t)b * SEQ + 64 * c) * 8;
  const h16* KIb = (const h16*)(p.ws + WS_KI) + (size_t)b * SEQ * 64;
  h16* scbase;
  {
    const int j = (c < 64) ? c : 127 - c;
    const size_t pre = 8192ull * (size_t)(128 * j - (j * (j - 1)) / 2);
    scbase = (h16*)(p.ws + (b == 0 ? WS_H : WS_MIX + (size_t)(b - 1) * SC_BATCH_BYTES) + pre);
  }
  LDS unsigned* st = (LDS unsigned*)(lds + IL_ST);
  LDS float* stf = (LDS float*)(lds + IL_ST);
  if (tid < 64) { st[tid] = 0xFFFFFFFFu; st[64 + tid] = 0u; st[128 + tid] = 0u; }
  __syncthreads();
  const int nst = (N + 127) >> 7;
  const int stride = nst >= 16 ? 8 : (nst >= 8 ? 4 : (nst >= 4 ? 2 : 1));
  idx_pass<0>(lds, KIb, N, stride, qg, kh, QIrow0, WIrow0, 0.f, 0.f, 0, scbase);
  __syncthreads();
  if (tid < 64) {
    const float lo = fkey_inv(st[tid]), hi = fkey_inv(st[64 + tid]);
    float d = hi - lo; if (!(d > 1e-20f)) d = 1.f;
    const float inv = (float)IDX_NB / (1.5f * d);
    stf[192 + tid] = inv; stf[256 + tid] = -(lo - 0.25f * d) * inv;
  }
  for (int i = tid; i < 16384; i += NTHR) ((LDS unsigned*)(lds + IL_HIST))[i] = 0u;
  __syncthreads();
  const float qinv = stf[192 + q], qoff = stf[256 + q];
  idx_pass<1>(lds, KIb, N, 1, qg, kh, QIrow0, WIrow0, qinv, qoff, 0, scbase);
  {
    LDS unsigned* hist = (LDS unsigned*)(lds + IL_HIST);
    for (int qq = wave; qq < 64; qq += 8) {
      unsigned hb[4];
#pragma unroll
      for (int j = 0; j < 4; ++j) hb[j] = hist[(4 * lane + j) * 64 + qq];
      const unsigned mine = hb[0] + hb[1] + hb[2] + hb[3];
      unsigned suf = mine;
#pragma unroll
      for (int o = 1; o < 64; o <<= 1) { const unsigned v = (unsigned)__shfl_down((int)suf, o); if (lane + o < 64) suf += v; }
      unsigned cum = suf - mine;
      if (cum < 256u && suf >= 256u) {
#pragma unroll
        for (int j = 3; j >= 0; --j) {
          if (cum < 256u && cum + hb[j] >= 256u) { st[320 + qq] = (unsigned)(4 * lane + j); st[384 + qq] = 256u - cum; }
          cum += hb[j];
        }
      }
    }
  }
  __syncthreads();
  if (tid < 64) {
    const int bs = (int)st[320 + tid]; const float qi_ = stf[192 + tid], qo_ = stf[256 + tid];
    stf[448 + tid] = idx_bin_lower_bound(bs + 1, qi_, qo_);
    stf[512 + tid] = idx_bin_lower_bound(bs, qi_, qo_);
  }
  __syncthreads();
  const float thi = stf[448 + q], tlo = stf[512 + q];
  asm volatile("s_waitcnt vmcnt(0)" ::: "memory");
  idx_stream(lds, N, qg, kh, thi, tlo, scbase);
  __syncthreads();
  for (int qq = wave; qq < 64; qq += 8) {
    const int nc = min((int)st[128 + qq], IDX_CAP); const unsigned need = st[384 + qq];
    LDS float* cs = (LDS float*)(lds + IL_CS) + qq * IDX_CAP; LDS unsigned short* ck = (LDS unsigned short*)(lds + IL_CK) + qq * IDX_CAP;
    for (int i = lane; i < nc; i += 64) {
      const float sv = cs[i]; const unsigned kv = ck[i];
      unsigned rank = 0u;
      for (int j = 0; j < nc; ++j) { const float sj = cs[j]; const unsigned kj = ck[j]; rank += (sj > sv || (sj == sv && kj < kv)) ? 1u : 0u; }
      if (rank < need) {
        const unsigned kl = kv & 31u;
        const unsigned bit = 16u * ((kl >> 2) & 1u) + (kl & 3u) + 4u * (kl >> 3);
        __hip_atomic_fetch_or((LDS unsigned*)(lds + IL_HIST) + qq * 256 + (kv >> 5), 1u << bit, __ATOMIC_RELAXED, __HIP_MEMORY_SCOPE_WORKGROUP);
      }
    }
  }
  __syncthreads();
  {
    const int cpr = N >> 6;
    for (int i = tid; i < 64 * cpr; i += NTHR) {
      const int row = i / cpr, cc = i % cpr;
      *(u32x2*)(MASK + (size_t)row * 256 + 2 * cc) = *(LDS u32x2*)(lds + IL_HIST + row * 1024 + cc * 8);
    }
  }
  __syncthreads();
}

DEVI void phase3(PRef p, LDS unsigned char* lds) {
  const int G = gridDim.x;
  for (int it = blockIdx.x; it < 512; it += G) rnn_item<0>(p, lds, it >> 7, it & 127);
  for (int it = blockIdx.x; it < 256; it += G) {
    const int b = it >> 6, j = it & 63;
#pragma unroll 1
    for (int w2 = 0; w2 < 2; ++w2) idx_item(p, lds, b, w2 ? j : 127 - j);
  }
}

DEVI float max3f(float a, float b, float c) { float r; asm("v_max3_f32 %0, %1, %2, %3" : "=v"(r) : "v"(a), "v"(b), "v"(c)); return r; }
DEVI unsigned pk_rtz(float a, float b) { return __builtin_bit_cast(unsigned, __builtin_amdgcn_cvt_pkrtz(a, b)); }
DEVI void attn_tile(LDS unsigned char* Kt, LDS unsigned char* Vt, const h16x8 (&qf)[4], u32x2 mw, int l31, int half, f32x16 (&o)[2], float& mref, float& l, bool& init) {
  const unsigned nm0 = ~(mw[0] >> (16 * half)), nm1 = ~(mw[1] >> (16 * half));
  const unsigned negm = __float_as_uint(-mref);
  f32x16 s[2];
#pragma unroll
  for (int r = 0; r < 16; ++r) {
    unsigned e0 = (unsigned)__builtin_amdgcn_sbfe((int)nm0, r, 1), e1 = (unsigned)__builtin_amdgcn_sbfe((int)nm1, r, 1);
    asm volatile("" : "+v"(e0), "+v"(e1));
    s[0][r] = __uint_as_float((e0 & 0xFF800000u) | (~e0 & negm));
    s[1][r] = __uint_as_float((e1 & 0xFF800000u) | (~e1 & negm));
  }
#pragma unroll
  for (int ri = 0; ri < 2; ++ri)
#pragma unroll
    for (int kk = 0; kk < 4; ++kk) {
      const h16x8 kf = *(LDS h16x8*)(Kt + (32 * ri + l31) * LROW + (2 * kk + half) * 16);
      s[ri] = mfma16(kf, qf[kk], s[ri]);
    }
  asm volatile("s_nop 15\n\ts_nop 7" : "+v"(s[0]), "+v"(s[1]));
  float mx = max3f(s[0][0], s[1][0], s[0][1]), mx2 = max3f(s[1][1], s[0][2], s[1][2]);
#pragma unroll
  for (int r = 3; r < 15; r += 2) { mx = max3f(mx, s[0][r], s[1][r]); mx2 = max3f(mx2, s[0][r + 1], s[1][r + 1]); }
  mx = max3f(mx, s[0][15], s[1][15]);
  mx = max3f(mx, mx2, mx2);
  mx = max3f(mx, __shfl_xor(mx, 32), mx);
  const bool first = (!init) && (mx > -INFINITY);
  const bool resc = first || (mx > 8.f);
  if (__any(resc)) {
    init = init || first;
    const float delta = resc ? mx : 0.f;
    const float alpha = __builtin_amdgcn_exp2f(-delta);
#pragma unroll
    for (int r = 0; r < 16; ++r) { s[0][r] -= delta; s[1][r] -= delta; o[0][r] *= alpha; o[1][r] *= alpha; }
    l *= alpha; mref += delta;
  }
  float ls = 0.f;
#pragma unroll
  for (int r = 0; r < 16; ++r) {
    s[0][r] = __builtin_amdgcn_exp2f(s[0][r]); s[1][r] = __builtin_amdgcn_exp2f(s[1][r]);
    ls += s[0][r] + s[1][r];
  }
  l += ls;
  h16x8 pf[4];
#pragma unroll
  for (int s4 = 0; s4 < 4; ++s4) {
    u32x4 w;
#pragma unroll
    for (int e = 0; e < 4; ++e) w[e] = pk_rtz(s[s4 >> 1][8 * (s4 & 1) + 2 * e], s[s4 >> 1][8 * (s4 & 1) + 2 * e + 1]);
    pf[s4] = __builtin_bit_cast(h16x8, w);
  }
#pragma unroll
  for (int di = 0; di < 2; ++di)
#pragma unroll
    for (int s4 = 0; s4 < 4; ++s4) {
      const h16x8 vf = *(LDS h16x8*)(Vt + (32 * di + l31) * LROW + (2 * s4 + half) * 16);
      o[di] = mfma16(vf, pf[s4], o[di]);
    }
}

DEVI void attn_unit(PRef p, LDS unsigned char* lds, int b, int head, int qb) {
  const int tid = launder((int)threadIdx.x), lane = tid & 63, wave = wave_id(tid), l31 = lane & 31, half = lane >> 5;
  const int q0 = qb * 256 + wave * 32, cw = q0 >> 6, NS = qb + 1;
  const size_t tok = (size_t)b * SEQ + q0 + l31;
  h16x8 qf[4];
  {
    const h16* Q = (const h16*)(p.ws + WS_Q) + tok * 512 + head * 64;
#pragma unroll
    for (int kk = 0; kk < 4; ++kk) qf[kk] = *(const h16x8*)(Q + 16 * kk + 8 * half);
  }
  const unsigned* mrow = (const unsigned*)(p.ws + WS_MASK) + tok * 256;
  constexpr int TP = 2 * 64 * LROW, ABUF = 4 * TP;
  static_assert(2 * ABUF <= LDS_BYTES - 16, "attention LDS");
  const h16* ksrc[4]; const h16* vsrc[4]; int kdst[4], vdst[4];
#pragma unroll
  for (int i = 0; i < 4; ++i) {
    const int id = tid + NTHR * i;
    const int row = id >> 3, lc = id & 7;
    ksrc[i] = (const h16*)(p.ws + WS_K) + ((size_t)b * SEQ + row) * 512 + head * 64 + lc * 8;
    kdst[i] = (row >> 6) * TP + (row & 63) * LROW + lc * 16;
    const int d = id >> 5, c = id & 31;
    vsrc[i] = (const h16*)(p.ws + WS_VT) + ((size_t)(b * 8 + head) * 64 + d) * 8192 + c * 8;
    vdst[i] = (c >> 3) * TP + 64 * LROW + d * LROW + (c & 7) * 16;
  }
  h16x8 rkA[4], rvA[4], rkB[4], rvB[4];
#pragma unroll
  for (int i = 0; i < 4; ++i) { rkA[i] = *(const h16x8*)ksrc[i]; rvA[i] = *(const h16x8*)vsrc[i]; }
#pragma unroll
  for (int i = 0; i < 4; ++i) { *(LDS h16x8*)(lds + kdst[i]) = rkA[i]; *(LDS h16x8*)(lds + vdst[i]) = rvA[i]; }
  if (NS > 1) {
#pragma unroll
    for (int i = 0; i < 4; ++i) { rkA[i] = *(const h16x8*)(ksrc[i] + (size_t)256 * 512); rvA[i] = *(const h16x8*)(vsrc[i] + 256); }
  }
  u32x4 mwa = *(const u32x4*)mrow, mwb = *(const u32x4*)(mrow + 4), mna, mnb;
  mna = mwa; mnb = mwb;
  __syncthreads();
  f32x16 o[2];
#pragma unroll
  for (int r = 0; r < 16; ++r) { o[0][r] = 0.f; o[1][r] = 0.f; }
  float mref = 0.f, l = 0.f; bool init = false;
#define ATT_TILE(s, t, W0, W1) if (4 * (s) + (t) <= cw) { u32x2 m2; m2[0] = W0; m2[1] = W1; attn_tile(bb + (t) * TP, bb + (t) * TP + 64 * LROW, qf, m2, l31, half, o, mref, l, init); }
#define ATT_STEP(s, RKC, RVC, RKN, RVN) { \
    if ((s) + 2 < NS) { _Pragma("unroll") for (int i = 0; i < 4; ++i) { RKN[i] = *(const h16x8*)(ksrc[i] + (size_t)((s) + 2) * 256 * 512); RVN[i] = *(const h16x8*)(vsrc[i] + ((s) + 2) * 256); } } \
    if ((s) + 1 < NS) { mna = *(const u32x4*)(mrow + 8 * ((s) + 1)); mnb = *(const u32x4*)(mrow + 8 * ((s) + 1) + 4); } \
    { LDS unsigned char* bb = lds + ((s) & 1) * ABUF; \
      ATT_TILE(s, 0, mwa[0], mwa[1]) ATT_TILE(s, 1, mwa[2], mwa[3]) ATT_TILE(s, 2, mwb[0], mwb[1]) ATT_TILE(s, 3, mwb[2], mwb[3]) } \
    if ((s) + 1 < NS) { LDS unsigned char* nb = lds + (((s) + 1) & 1) * ABUF; _Pragma("unroll") for (int i = 0; i < 4; ++i) { *(LDS h16x8*)(nb + kdst[i]) = RKC[i]; *(LDS h16x8*)(nb + vdst[i]) = RVC[i]; } } \
    __syncthreads(); mwa = mna; mwb = mnb; }
  for (int s = 0; s < NS; s += 2) {
    ATT_STEP(s, rkA, rvA, rkB, rvB)
    if (s + 1 < NS) ATT_STEP(s + 1, rkB, rvB, rkA, rvA)
  }
#undef ATT_STEP
#undef ATT_TILE
  const float inv = 1.f / (l + __shfl_xor(l, 32));
  h16* Y = (h16*)(p.ws + WS_H) + tok * DM + head * 64;
#pragma unroll
  for (int di = 0; di < 2; ++di)
#pragma unroll
    for (int q = 0; q < 4; ++q)
      *(h16x4*)(Y + 32 * di + 8 * q + 4 * half) = pack4(o[di][4 * q] * inv, o[di][4 * q + 1] * inv, o[di][4 * q + 2] * inv, o[di][4 * q + 3] * inv);
}

DEVI void phase4(PRef p, LDS unsigned char* lds) {
  const int G = gridDim.x;
  for (int it = blockIdx.x; it < 512; it += G) rnn_item<1>(p, lds, it >> 7, it & 127);
  for (int it = blockIdx.x; it < 512; it += G) {
    const int bh = it >> 4, j = it & 15;
#pragma unroll 1
    for (int w2 = 0; w2 < 2; ++w2) attn_unit(p, lds, bh >> 3, bh & 7, w2 ? j : 31 - j);
  }
}

struct EpiPlain {
  h16* dst; int ld;
  DEVI void operator()(const f32x4 (&acc)[2][2][4][2], const g8::Unit& u, int wr, int wc, int fr, int fq) const {
#pragma unroll
    for (int ai = 0; ai < 2; ++ai)
#pragma unroll
      for (int m = 0; m < 4; ++m) {
        const int r = u.pm * 256 + 128 * ai + 64 * wr + 16 * m + fr;
        if (r < u.cnt) {
          h16* d = dst + (size_t)(u.off + r) * ld + u.pn * 256 + 32 * wc + 8 * fq;
#pragma unroll
          for (int bj = 0; bj < 2; ++bj)
            { const f32x4 v0 = acc[ai][bj][m][0], v1 = acc[ai][bj][m][1]; h16x8 w; w[0] = (h16)v0[0]; w[1] = (h16)v0[1]; w[2] = (h16)v0[2]; w[3] = (h16)v0[3]; w[4] = (h16)v1[0]; w[5] = (h16)v1[1]; w[6] = (h16)v1[2]; w[7] = (h16)v1[3]; *(h16x8*)(d + 128 * bj) = w; }
        }
      }
  }
};
DEVI void phase5(PRef p, LDS unsigned char* lds) {
  g8::DenseOrder S{(const h16*)(p.ws + WS_H), (const h16*)(p.ws + WS_WOUT), DM, 128, 4, (int)gridDim.x, (int)blockIdx.x};
  EpiPlain E{(h16*)(p.ws + WS_MIX), DM};
  g8::gemm_phase(lds, DM, S, E);
}

constexpr int P6_TROW = 2064, P6_THI = 0, P6_TLO = 32 * P6_TROW, P6_PART = 0, P6_LGT = 8 * 48 * 32 * 4, P6_MOD = 2 * 32 * P6_TROW;
constexpr int P6_BIAS = P6_MOD + 3 * 4096, P6_TOK = P6_BIAS + 160, P6_LCNT = P6_TOK + 128 * 6 * 4, P6_LBASE = P6_LCNT + 128;
static_assert(P6_LBASE + 128 <= LDS_BYTES - 16 && P6_LGT + 32 * 36 * 4 <= P6_MOD, "phase 6 LDS map");
DEVI void phase6(PRef p, LDS unsigned char* lds) {
  const int tid = launder((int)threadIdx.x), lane = tid & 63, wave = wave_id(tid), l15 = lane & 15, g4 = lane >> 4;
  const int b = blockIdx.x >> 6;
  LDS float* mv = (LDS float*)(lds + P6_MOD);
  LDS float* rbias = (LDS float*)(lds + P6_BIAS);
  LDS unsigned* tokrec = (LDS unsigned*)(lds + P6_TOK);
  LDS unsigned* lcnt = (LDS unsigned*)(lds + P6_LCNT);
  LDS unsigned* lbase = (LDS unsigned*)(lds + P6_LBASE);
  mod_to_lds(p, b, 2, mv); mod_to_lds(p, b, 3, mv + 1024); mod_to_lds(p, b, 4, mv + 2048);
  if (tid < 4) rbias[tid] = p.in[18][tid];
  else if (tid < 36) rbias[tid] = p.in[20][tid - 4];
  if (tid < 32) lcnt[tid] = 0u;
  __syncthreads();
  for (int k = tid; k < 1024; k += NTHR) { mv[k] *= p.in[5][k]; mv[2048 + k] = p.in[6][k] * (mv[2048 + k] + 1.f); }
  __syncthreads();
  const float* x = p.in[0]; const h16* MIX = (const h16*)(p.ws + WS_MIX); h16* X1h = (h16*)(p.ws + WS_MIX); h16* H2 = (h16*)(p.ws + WS_H);
  const h16* WRH = (const h16*)(p.ws + WS_WRH); const h16* WRL = (const h16*)(p.ws + WS_WRL);
  const size_t tok0 = (size_t)blockIdx.x * 128;
  h16x8 bh[3][4], bl[3][4];
#pragma unroll
  for (int ct = 0; ct < 3; ++ct)
#pragma unroll
    for (int kk = 0; kk < 4; ++kk) {
      const int kof = 32 * (4 * wave + kk) + 8 * g4;
      bh[ct][kk] = *(const h16x8*)(WRH + (size_t)(16 * ct + l15) * 1024 + kof); bl[ct][kk] = *(const h16x8*)(WRL + (size_t)(16 * ct + l15) * 1024 + kof);
    }
  f32x4 xa[4]; h16x4 ma[4];
#pragma unroll
  for (int j = 0; j < 4; ++j) { xa[j] = *(const f32x4*)(x + (tok0 + 4 * wave) * DM + 256 * j + 4 * lane); ma[j] = *(const h16x4*)(MIX + (tok0 + 4 * wave) * DM + 256 * j + 4 * lane); }
#pragma unroll 1
  for (int rd = 0; rd < 4; ++rd) {
    {
      const size_t tokb = tok0 + 32 * rd + 4 * wave;
#define P6_LOAD(XV, MH, T) do { _Pragma("unroll") for (int j = 0; j < 4; ++j) { XV[j] = *(const f32x4*)(x + (T) * DM + 256 * j + 4 * lane); MH[j] = *(const h16x4*)(MIX + (T) * DM + 256 * j + 4 * lane); } } while (0)
#define P6_ROW(XV, MH, I) do { \
        const int tr = 4 * wave + (I); const size_t tok = tokb + (I); \
        f32x4 mx[4]; float ssm = 0.f; \
        _Pragma("unroll") for (int j = 0; j < 4; ++j) _Pragma("unroll") for (int e = 0; e < 4; ++e) { mx[j][e] = (float)MH[j][e]; ssm += mx[j][e] * mx[j][e]; } \
        const float rsm = 1.0f / sqrtf(wave_sum(ssm) * (1.f / 1024.f) + 1e-6f); \
        float ss1 = 0.f; \
        _Pragma("unroll") for (int j = 0; j < 4; ++j) { \
          const f32x4 v = XV[j] + *(LDS f32x4*)(mv + 256 * j + 4 * lane) * (mx[j] * rsm); \
          XV[j] = v; \
          *(h16x4*)(X1h + tok * DM + 256 * j + 4 * lane) = pack4(v[0], v[1], v[2], v[3]); \
          ss1 += v[0] * v[0] + v[1] * v[1] + v[2] * v[2] + v[3] * v[3]; \
        } \
        const float rs1 = 1.0f / sqrtf(wave_sum(ss1) * (1.f / 1024.f) + 1e-6f); \
        _Pragma("unroll") for (int j = 0; j < 4; ++j) { \
          const f32x4 h2 = XV[j] * rs1 * *(LDS f32x4*)(mv + 2048 + 256 * j + 4 * lane) + *(LDS f32x4*)(mv + 1024 + 256 * j + 4 * lane); \
          const h16x4 hi = pack4(h2[0], h2[1], h2[2], h2[3]); \
          const h16x4 lo = pack4(h2[0] - (float)hi[0], h2[1] - (float)hi[1], h2[2] - (float)hi[2], h2[3] - (float)hi[3]); \
          *(h16x4*)(H2 + tok * DM + 256 * j + 4 * lane) = hi; \
          *(LDS h16x4*)(lds + P6_THI + tr * P6_TROW + (256 * j + 4 * lane) * 2) = hi; \
          *(LDS h16x4*)(lds + P6_TLO + tr * P6_TROW + (256 * j + 4 * lane) * 2) = lo; \
        } } while (0)
      f32x4 xb[4]; h16x4 mb[4];
      P6_LOAD(xb, mb, tokb + 1); __builtin_amdgcn_sched_barrier(0); P6_ROW(xa, ma, 0);
      P6_LOAD(xa, ma, tokb + 2); __builtin_amdgcn_sched_barrier(0); P6_ROW(xb, mb, 1);
      P6_LOAD(xb, mb, tokb + 3); __builtin_amdgcn_sched_barrier(0); P6_ROW(xa, ma, 2);
      { const size_t tn = rd < 3 ? tokb + 32 : tokb; P6_LOAD(xa, ma, tn); } __builtin_amdgcn_sched_barrier(0); P6_ROW(xb, mb, 3);
    }
    __syncthreads();
    f32x4 acc[2][3];
#pragma unroll
    for (int tt = 0; tt < 2; ++tt)
#pragma unroll
      for (int ct = 0; ct < 3; ++ct) acc[tt][ct] = (f32x4){0.f, 0.f, 0.f, 0.f};
#pragma unroll
    for (int kk = 0; kk < 4; ++kk) {
      const int kof = 32 * (4 * wave + kk) + 8 * g4;
      h16x8 ah[2], al[2];
#pragma unroll
      for (int tt = 0; tt < 2; ++tt) {
        ah[tt] = *(LDS h16x8*)(lds + P6_THI + (16 * tt + l15) * P6_TROW + kof * 2);
        al[tt] = *(LDS h16x8*)(lds + P6_TLO + (16 * tt + l15) * P6_TROW + kof * 2);
      }
#pragma unroll
      for (int ct = 0; ct < 3; ++ct) {
#pragma unroll
        for (int tt = 0; tt < 2; ++tt) {
          acc[tt][ct] = mfma16s(ah[tt], bh[ct][kk], acc[tt][ct]);
          acc[tt][ct] = mfma16s(ah[tt], bl[ct][kk], acc[tt][ct]);
          acc[tt][ct] = mfma16s(al[tt], bh[ct][kk], acc[tt][ct]);
        }
      }
    }
    __syncthreads();
#pragma unroll
    for (int tt = 0; tt < 2; ++tt)
#pragma unroll
      for (int ct = 0; ct < 3; ++ct)
        *(LDS f32x4*)(lds + P6_PART + (((wave * 48 + 16 * ct + l15) * 32) + 16 * tt + 4 * g4) * 4) = acc[tt][ct];
    __syncthreads();
    for (int idx = tid; idx < 36 * 32; idx += NTHR) {
      const int col = idx >> 5, tk = idx & 31;
      float s = 0.f;
#pragma unroll
      for (int w = 0; w < 8; ++w) s += *(LDS float*)(lds + P6_PART + ((w * 48 + col) * 32 + tk) * 4);
      *(LDS float*)(lds + P6_LGT + (tk * 36 + col) * 4) = s;
    }
    __syncthreads();
    if (tid < 32) {
      LDS float* lg = (LDS float*)(lds + P6_LGT) + 36 * tid;
      float gl[4];
#pragma unroll
      for (int g = 0; g < 4; ++g) gl[g] = lg[g] + rbias[g];
      int gi = 0; float gm = gl[0];
#pragma unroll
      for (int g = 1; g < 4; ++g) if (gl[g] > gm) { gm = gl[g]; gi = g; }
      float gs = 0.f;
#pragma unroll
      for (int g = 0; g < 4; ++g) gs += __expf(gl[g] - gm);
      const float pg = 1.f / gs;
      int e1 = 0, e2 = 0; float l1 = -INFINITY, l2 = -INFINITY;
#pragma unroll
      for (int e = 0; e < 8; ++e) {
        const float v = lg[4 + 8 * gi + e] + rbias[4 + 8 * gi + e];
        if (v > l1) { l2 = l1; e2 = e1; l1 = v; e1 = e; }
        else if (v > l2) { l2 = v; e2 = e; }
      }
      const float x2 = __expf(l2 - l1);
      const float w1 = pg / (1.f + x2), w2 = pg * x2 / (1.f + x2);
      const unsigned E1 = (unsigned)(gi * 8 + e1), E2 = (unsigned)(gi * 8 + e2);
      const unsigned lp1 = __hip_atomic_fetch_add(&lcnt[E1], 1u, __ATOMIC_RELAXED, __HIP_MEMORY_SCOPE_WORKGROUP);
      const unsigned lp2 = __hip_atomic_fetch_add(&lcnt[E2], 1u, __ATOMIC_RELAXED, __HIP_MEMORY_SCOPE_WORKGROUP);
      LDS unsigned* tr = tokrec + (32 * rd + tid) * 6;
      tr[0] = E1; tr[1] = lp1; tr[2] = E2; tr[3] = lp2; tr[4] = __float_as_uint(w1); tr[5] = __float_as_uint(w2);
    }
    __syncthreads();
  }
  if (tid < 32) lbase[tid] = atomicAdd((unsigned*)(p.ws + WS_CNT) + tid, lcnt[tid]);
  __syncthreads();
  if (tid < 128) {
    unsigned* LIST = (unsigned*)(p.ws + WS_LIST); float* LISTW = (float*)(p.ws + WS_LISTW); u32x4* ROUTE = (u32x4*)(p.ws + WS_ROUTE);
    const unsigned tok = (unsigned)(tok0 + tid);
    LDS unsigned* tr = tokrec + tid * 6;
    const unsigned E1 = tr[0], E2 = tr[2], p1 = lbase[E1] + tr[1], p2 = lbase[E2] + tr[3];
    LIST[(size_t)E1 * 32768 + p1] = tok; LISTW[(size_t)E1 * 32768 + p1] = __uint_as_float(tr[4]);
    LIST[(size_t)E2 * 32768 + p2] = tok; LISTW[(size_t)E2 * 32768 + p2] = __uint_as_float(tr[5]);
    u32x4 rt; rt[0] = E1; rt[1] = p1; rt[2] = E2; rt[3] = p2;
    ROUTE[tok] = rt;
  }
}

template <bool GATHER_> struct MoeOrder {
  static constexpr bool GATHER = GATHER_;
  unsigned char* ws; int ntn, K, G, c;
  DEVI bool next(int i, g8::Unit& u) const {
    const unsigned* cnt = (const unsigned*)(ws + WS_CNT);
    int it = i * G + c, off = 0, e = 0, cn = 0; bool found = false;
    for (e = 0; e < 32; ++e) { cn = (int)cnt[e]; const int nti = ((cn + 255) >> 8) * ntn; if (it < nti) { found = true; break; } it -= nti; off += cn; }
    if (!found) return false;
    u.e = e; u.pm = it / ntn; u.pn = it % ntn; u.cnt = cn; u.off = off;
    const int tid = threadIdx.x;
    if (GATHER_) {
      const unsigned* list = (const unsigned*)(ws + WS_LIST) + (size_t)e * 32768;
      u.A = (const char*)(ws + WS_H);
      u.B = (const char*)((const h16*)(ws + WS_WGU) + ((size_t)e * 512 + u.pn * 256) * DM);
#pragma unroll
      for (int h = 0; h < 2; ++h)
#pragma unroll
        for (int i2 = 0; i2 < 2; ++i2) {
          int R, C; g8::stage_rc(tid * 16 + i2 * 8192, R, C);
          const int row = u.pm * 256 + 128 * h + R;
          const unsigned t = (row < cn) ? list[row] : 0u;
          u.va[h][i2] = (t * (unsigned)DM + (unsigned)C) * 2u;
        }
    } else {
      u.A = (const char*)((const h16*)(ws + WS_ACT) + ((size_t)off + u.pm * 256) * 256);
      u.B = (const char*)((const h16*)(ws + WS_WDN) + ((size_t)e * 1024 + u.pn * 256) * 256);
      u.va[0][0] = u.va[0][1] = u.va[1][0] = u.va[1][1] = 0u;
    }
    return true;
  }
};
struct EpiAct {
  unsigned char* ws;
  DEVI void operator()(const f32x4 (&acc)[2][2][4][2], const g8::Unit& u, int wr, int wc, int fr, int fq) const {
    const float* lw = (const float*)(ws + WS_LISTW) + (size_t)u.e * 32768; h16* act = (h16*)(ws + WS_ACT);
#pragma unroll
    for (int ai = 0; ai < 2; ++ai)
#pragma unroll
      for (int m = 0; m < 4; ++m) {
        const int r = u.pm * 256 + 128 * ai + 64 * wr + 16 * m + fr;
        if (r < u.cnt) {
          const float w = lw[r];
#pragma unroll
          for (int bj = 0; bj < 2; ++bj) {
            const f32x4 g = acc[ai][bj][m][0], up = acc[ai][bj][m][1];
            float v[4];
#pragma unroll
            for (int e = 0; e < 4; ++e) v[e] = g[e] * __builtin_amdgcn_rcpf(1.f + __expf(-g[e])) * up[e] * w;
            *(h16x4*)(act + (size_t)(u.off + r) * 256 + 16 * (8 * u.pn + 4 * bj + wc) + 4 * fq) = pack4(v[0], v[1], v[2], v[3]);
          }
        }
      }
  }
};
struct EpiYp {
  h16* dst;
  DEVI void operator()(const f32x4 (&acc)[2][2][4][2], const g8::Unit& u, int wr, int wc, int fr, int fq) const {
#pragma unroll
    for (int ai = 0; ai < 2; ++ai)
#pragma unroll
      for (int m = 0; m < 4; ++m) {
        const int r = u.pm * 256 + 128 * ai + 64 * wr + 16 * m + fr;
        if (r < u.cnt) {
          h16* d = dst + (size_t)(u.off + r) * DM + u.pn * 256 + 32 * wc + 8 * fq;
#pragma unroll
          for (int bj = 0; bj < 2; ++bj)
            { const f32x4 v0 = acc[ai][bj][m][0], v1 = acc[ai][bj][m][1]; h16x8 w; w[0] = (h16)v0[0]; w[1] = (h16)v0[1]; w[2] = (h16)v0[2]; w[3] = (h16)v0[3]; w[4] = (h16)v1[0]; w[5] = (h16)v1[1]; w[6] = (h16)v1[2]; w[7] = (h16)v1[3]; *(h16x8*)(d + 128 * bj) = w; }
        }
      }
  }
};
DEVI void phase7(PRef p, LDS unsigned char* lds) {
  MoeOrder<true> S{p.ws, 2, DM, (int)gridDim.x, (int)blockIdx.x};
  EpiAct E{p.ws};
  g8::gemm_phase(lds, DM, S, E);
}
DEVI void phase8(PRef p, LDS unsigned char* lds) {
  MoeOrder<false> S{p.ws, 4, 256, (int)gridDim.x, (int)blockIdx.x};
  EpiYp E{(h16*)(p.ws + WS_YP)};
  g8::gemm_phase(lds, 256, S, E);
}

DEVI void phase9(PRef p, LDS unsigned char* lds) {
  const int tid = launder((int)threadIdx.x), lane = tid & 63, wave = wave_id(tid), G = gridDim.x;
  const int b = blockIdx.x & 3, bi = blockIdx.x >> 2, nbk = G >> 2;
  LDS unsigned* offs = (LDS unsigned*)lds;
  if (tid == 0) { const unsigned* cnt = (const unsigned*)(p.ws + WS_CNT); unsigned o = 0; for (int e = 0; e < 32; ++e) { offs[e] = o; o += cnt[e]; } }
  __syncthreads();
  LDS float* mv = (LDS float*)(lds + 256);
  mod_to_lds(p, b, 5, mv);
  __syncthreads();
  f32x4 A3[4];
#pragma unroll
  for (int j = 0; j < 4; ++j) { const int k = 256 * j + 4 * lane; A3[j] = *(LDS f32x4*)(mv + k) * *(const f32x4*)(p.in[7] + k); }
  const h16* YP = (const h16*)(p.ws + WS_YP); const u32x4* ROUTE = (const u32x4*)(p.ws + WS_ROUTE); float* out = p.out; const h16* X1h = (const h16*)(p.ws + WS_MIX);
  const int rstep = nbk * 8, r_first = bi * 8 + wave;
  const int nrow = (SEQ - r_first + rstep - 1) / rstep;
  unsigned R0 = 0u, R1 = 0u;
  if (lane < nrow) { const u32x4 rt = ROUTE[(size_t)b * SEQ + r_first + rstep * lane]; R0 = offs[rt[0]] + rt[1]; R1 = offs[rt[2]] + rt[3]; }
  h16x4 ya[4], yc[4]; f32x4 xv[4];
  {
    const size_t tok = (size_t)b * SEQ + r_first; const size_t r0 = __builtin_amdgcn_readlane(R0, 0), r1 = __builtin_amdgcn_readlane(R1, 0);
#pragma unroll
    for (int j = 0; j < 4; ++j) { ya[j] = *(const h16x4*)(YP + r0 * DM + 256 * j + 4 * lane); yc[j] = *(const h16x4*)(YP + r1 * DM + 256 * j + 4 * lane); { const h16x4 xh = *(const h16x4*)(X1h + tok * DM + 256 * j + 4 * lane); xv[j] = (f32x4){(float)xh[0], (float)xh[1], (float)xh[2], (float)xh[3]}; } }
  }
  for (int i = 0; i < nrow; ++i) {
    const size_t tok = (size_t)b * SEQ + r_first + rstep * i;
    h16x4 na[4], nc[4]; f32x4 nx[4];
    if (i + 1 < nrow) {
      const size_t r0 = __builtin_amdgcn_readlane(R0, i + 1), r1 = __builtin_amdgcn_readlane(R1, i + 1);
#pragma unroll
      for (int j = 0; j < 4; ++j) { na[j] = *(const h16x4*)(YP + r0 * DM + 256 * j + 4 * lane); nc[j] = *(const h16x4*)(YP + r1 * DM + 256 * j + 4 * lane); { const h16x4 xh = *(const h16x4*)(X1h + (tok + rstep) * DM + 256 * j + 4 * lane); nx[j] = (f32x4){(float)xh[0], (float)xh[1], (float)xh[2], (float)xh[3]}; } }
    }
    f32x4 y[4]; float ss = 0.f;
#pragma unroll
    for (int j = 0; j < 4; ++j)
#pragma unroll
      for (int e = 0; e < 4; ++e) { y[j][e] = (float)ya[j][e] + (float)yc[j][e]; ss += y[j][e] * y[j][e]; }
    const float rs = 1.0f / sqrtf(wave_sum(ss) * (1.f / 1024.f) + 1e-6f);
#pragma unroll
    for (int j = 0; j < 4; ++j) *(f32x4*)(out + tok * DM + 256 * j + 4 * lane) = xv[j] + A3[j] * (y[j] * rs);
    if (i + 1 < nrow) {
#pragma unroll
      for (int j = 0; j < 4; ++j) { ya[j] = na[j]; yc[j] = nc[j]; xv[j] = nx[j]; }
    }
  }
}

#define XB_TMO      128
#define XB_XCNT(j)  (256  + 64 * (j))
#define XB_XSUB(j)  (1280 + 64 * (j))
#define XB_XGEN(j)  (2304 + 64 * (j))
#define XB_TOP      3328
#define XB_TOPGEN   3392
#define XB_SPIN_CAP (1u << 22)
DEVI unsigned xb_ld(unsigned* p)              { return __hip_atomic_load(p, __ATOMIC_RELAXED, __HIP_MEMORY_SCOPE_AGENT); }
DEVI unsigned xb_add(unsigned* p, unsigned v) { return __hip_atomic_fetch_add(p, v, __ATOMIC_RELAXED, __HIP_MEMORY_SCOPE_AGENT); }
DEVI unsigned xb_xcc_id() { return (unsigned)__builtin_amdgcn_s_getreg((3 << 11) | 20) & 0xFu; }
#define XB_SPIN(cond, bar) do { unsigned _sp = 0; while (cond) { __builtin_amdgcn_s_sleep(1); \
    if ((++_sp & 255u) == 0u) { if (xb_ld(&(bar)[XB_TMO])) break; if (_sp > XB_SPIN_CAP) { atomicAdd(&(bar)[XB_TMO], 1u); break; } } } } while (0)
struct XcdBarrier { unsigned* bar; unsigned x; volatile LDS unsigned* st; };
DEVI XcdBarrier xcd_barrier_post(unsigned* bar, volatile LDS unsigned* st) {
  XcdBarrier b; b.bar = bar; b.x = xb_xcc_id(); b.st = st;
  if (threadIdx.x == 0) (void)xb_add(&bar[XB_XCNT(b.x)], 1u);
  return b;
}
DEVI void xcd_barrier_complete(unsigned* bar, unsigned x, unsigned& nloc, unsigned& nx) {
  const unsigned G = gridDim.x * gridDim.y * gridDim.z;
  unsigned sum, cnt, mine, sp = 0u;
  for (;;) {
    sum = 0u; cnt = 0u; mine = 0u;
#pragma unroll
    for (unsigned j = 0; j < 16; ++j) { const unsigned c = xb_ld(&bar[XB_XCNT(j)]); sum += c; cnt += (c > 0u) ? 1u : 0u; mine = (j == x) ? c : mine; }
    if (sum == G) break;
    __builtin_amdgcn_s_sleep(1);
    if ((++sp & 255u) == 0u) { if (xb_ld(&bar[XB_TMO])) break; if (sp > XB_SPIN_CAP) { atomicAdd(&bar[XB_TMO], 1u); break; } }
  }
  nloc = mine > 0u ? mine : 1u; nx = cnt > 0u ? cnt : 1u;
}
DEVI void xcd_barrier(const XcdBarrier& b) {
  asm volatile("s_waitcnt vmcnt(0)" ::: "memory");
  __syncthreads();
  if (threadIdx.x == 0) {
    unsigned* bar = b.bar;
    __builtin_amdgcn_s_waitcnt(0);
    unsigned nloc = b.st[0], nx = b.st[1];
    if (nloc == 0u) { xcd_barrier_complete(bar, b.x, nloc, nx); b.st[0] = nloc; b.st[1] = nx; }
    const unsigned old = xb_add(&bar[XB_XSUB(b.x)], 1u);
    const unsigned gen = old / nloc;
    if (old + 1u == (gen + 1u) * nloc) {
      __builtin_amdgcn_fence(__ATOMIC_RELEASE, "agent");
      asm volatile("s_waitcnt vmcnt(0)" ::: "memory");
      const unsigned og = xb_add(&bar[XB_TOP], 1u);
      const unsigned tg = og / nx;
      if (og + 1u == (tg + 1u) * nx) xb_add(&bar[XB_TOPGEN], 1u);
      else XB_SPIN(xb_ld(&bar[XB_TOPGEN]) == tg, bar);
      __builtin_amdgcn_fence(__ATOMIC_ACQUIRE, "agent");
      xb_add(&bar[XB_XGEN(b.x)], 1u);
      asm volatile("s_waitcnt vmcnt(0)" ::: "memory");
    } else {
      XB_SPIN(xb_ld(&bar[XB_XGEN(b.x)]) == gen, bar);
      __builtin_amdgcn_fence(__ATOMIC_ACQUIRE, "agent");
      asm volatile("s_waitcnt vmcnt(0)" ::: "memory");
    }
  }
  __syncthreads();
}

__global__ void __launch_bounds__(NTHR) fwd_kernel(Params p) {
  extern __shared__ __attribute__((aligned(16))) unsigned char smem[];
  LDS unsigned char* lds = (LDS unsigned char*)smem;
  const int lo = p.ph_lo, hi = p.ph_hi;
  volatile LDS unsigned* bst = (volatile LDS unsigned*)(lds + LDS_BYTES - 16);
  if (threadIdx.x < 4) bst[threadIdx.x] = 0u;
  __syncthreads();
  (void)xcd_barrier_post((unsigned*)(p.ws + WS_BAR), bst);
#ifndef REPEAT_PHASE
#define REPEAT_PHASE -1
#endif
#define GRID_SYNC(k) do { { XcdBarrier xb_; xb_.bar = (unsigned*)(get_params()->ws + WS_BAR); xb_.x = xb_xcc_id(); xb_.st = (volatile LDS unsigned*)(lds + LDS_BYTES - 16); xcd_barrier(xb_); } } while (0)
#define RUN_PHASE(k, fn) if (lo <= (k) && (k) < hi) { fn(*get_params(), lds); if ((k) == REPEAT_PHASE) { GRID_SYNC(k); fn(*get_params(), lds); } if ((k) + 1 < hi) GRID_SYNC(k); }
  RUN_PHASE(0, phase0)
  RUN_PHASE(1, phase1)
  RUN_PHASE(2, phase2)
  RUN_PHASE(3, phase3)
  RUN_PHASE(4, phase4)
  RUN_PHASE(5, phase5)
  RUN_PHASE(6, phase6)
  RUN_PHASE(7, phase7)
  RUN_PHASE(8, phase8)
  RUN_PHASE(9, phase9)
#undef GRID_SYNC
#undef RUN_PHASE
}

extern "C" void kernel_launch(void* const* d_in, const int* in_sizes, int n_in, void* d_out, int out_size, void* d_ws, size_t ws_size, hipStream_t stream) {
  static int grid = 0;
  if (grid == 0) {
    if (n_in != 24 || out_size != NTOK * DM || ws_size < WS_END) { fprintf(stderr, "kernel_launch: unexpected problem (n_in %d out %d ws %zu)\n", n_in, out_size, ws_size); grid = -1; return; }
    (void)hipFuncSetAttribute((const void*)fwd_kernel, hipFuncAttributeMaxDynamicSharedMemorySize, LDS_BYTES);
    int dev = 0, cus = 0, per_cu = 0;
    (void)hipGetDevice(&dev);
    (void)hipDeviceGetAttribute(&cus, hipDeviceAttributeMultiprocessorCount, dev);
    (void)hipOccupancyMaxActiveBlocksPerMultiprocessor(&per_cu, (const void*)fwd_kernel, NTHR, LDS_BYTES);
    if (per_cu < 1 || cus < 256) fprintf(stderr, "kernel_launch: occupancy %d blocks/CU on %d CUs\n", per_cu, cus);
    grid = 256;
  }
  if (grid < 0) return;
  (void)hipMemsetAsync((char*)d_ws + WS_CNT, 0, CTL_ZERO_BYTES, stream);
  Params p{};
  for (int i = 0; i < 24; ++i) p.in[i] = (const float*)d_in[i];
  p.out = (float*)d_out; p.ws = (unsigned char*)d_ws;
#if N_LAUNCH_MODE == 1
  p.ph_lo = 0; p.ph_hi = NPHASE;
  void* args[] = {&p};
  hipError_t e = hipLaunchCooperativeKernel((const void*)fwd_kernel, dim3(grid), dim3(NTHR), args, LDS_BYTES, stream);
  if (e != hipSuccess) fprintf(stderr, "cooperative launch failed: %s\n", hipGetErrorString(e));
#else
  for (int ph = 0; ph < NPHASE; ++ph) {
    p.ph_lo = ph; p.ph_hi = ph + 1;
    hipLaunchKernelGGL(fwd_kernel, dim3(grid), dim3(NTHR), LDS_BYTES, stream, p);
  }
#endif
}
```

```cpp
#include <hip/hip_runtime.h>
#include <cstdio>
#include <cstdint>

#ifndef N_LAUNCH_MODE
#define N_LAUNCH_MODE 1
#endif

#define DEVI __device__ __forceinline__
#define LDS __attribute__((address_space(3)))

typedef _Float16 h16;
typedef _Float16 h16x4 __attribute__((ext_vector_type(4)));
typedef _Float16 h16x8 __attribute__((ext_vector_type(8)));
typedef float f32x4 __attribute__((ext_vector_type(4)));
typedef float f32x16 __attribute__((ext_vector_type(16)));
typedef unsigned u32x2 __attribute__((ext_vector_type(2)));
typedef unsigned u32x4 __attribute__((ext_vector_type(4)));

constexpr int NBATCH = 4, SEQ = 8192, NTOK = NBATCH * SEQ, DM = 1024;
constexpr int NTHR = 512;
constexpr int NPHASE = 10;
constexpr int LDS_BYTES = 163840;

constexpr size_t MiB = 1ull << 20;
constexpr size_t WS_CNT = 0;
constexpr size_t CTL_ZERO_BYTES = 20480;
constexpr size_t WS_BAR = 4096;
constexpr size_t WS_MODP = 64 * 1024;
constexpr size_t WS_ROPE = 1 * MiB;
constexpr size_t WS_WIN = 3 * MiB;
constexpr size_t WS_WOUT = 10 * MiB;
constexpr size_t WS_WGU = 12 * MiB;
constexpr size_t WS_WDN = 44 * MiB;
constexpr size_t WS_WRG = 60 * MiB;
constexpr size_t WS_WRH = 60 * MiB + 512 * 1024;
constexpr size_t WS_WRL = 60 * MiB + 640 * 1024;
constexpr size_t WS_AGG = 61 * MiB;
constexpr size_t WS_ROUTE = 63 * MiB;
constexpr size_t WS_LIST = 64 * MiB;
constexpr size_t WS_LISTW = 68 * MiB;
constexpr size_t WS_WI = 72 * MiB;
constexpr size_t WS_KI = 73 * MiB;
constexpr size_t WS_MASK = 77 * MiB;
constexpr size_t WS_H = 109 * MiB;
constexpr size_t WS_Q = 173 * MiB;
constexpr size_t WS_K = 205 * MiB;
constexpr size_t WS_VT = 237 * MiB;
constexpr size_t WS_QI = 269 * MiB;
constexpr size_t WS_XR = 301 * MiB;
constexpr size_t WS_XG = 333 * MiB;
constexpr size_t WS_MIX = 365 * MiB;
constexpr size_t WS_ACT = 429 * MiB;
constexpr size_t WS_YP = 173 * MiB;
constexpr size_t WS_END = 510 * MiB;
constexpr size_t SC_BATCH_BYTES = 8192ull * 6176ull;
static_assert(SC_BATCH_BYTES <= 64 * MiB && WS_MIX + 3 * SC_BATCH_BYTES <= WS_END, "score slots");

struct Params { const float* in[24]; float* out; unsigned char* ws; int ph_lo, ph_hi; };
typedef const __attribute__((address_space(4))) Params& PRef;
typedef const __attribute__((address_space(4))) Params* PPtr;

__device__ const double ROPE_REV[32] = {
  1.59154943091895345608e-01, 1.19349370211248861917e-01, 8.94994016088910132600e-02, 6.71150830052272551196e-02,
  5.03292121044870352509e-02, 3.77415847174197710556e-02, 2.83021958306233986646e-02, 2.12236527647776604399e-02,
  1.59154943091895338669e-02, 1.19349370211248861917e-02, 8.94994016088910236684e-03, 6.71150830052272533849e-03,
  5.03292121044870369856e-03, 3.77415847174197719230e-03, 2.83021958306233986646e-03, 2.12236527647776621747e-03,
  1.59154943091895356017e-03, 1.19349370211248848907e-03, 8.94994016088910236684e-04, 6.71150830052272598901e-04,
  5.03292121044870326488e-04, 3.77415847174197740914e-04, 2.83021958306233954120e-04, 2.12236527647776605484e-04,
  1.59154943091895350596e-04, 1.19349370211248862459e-04, 8.94994016088910182474e-05, 6.71150830052272544691e-05,
  5.03292121044870353593e-05, 3.77415847174197768019e-05, 2.83021958306233960897e-05, 2.12236527647776591931e-05};

DEVI int launder(int x) { asm volatile("" : "+v"(x)); return x; }
DEVI PPtr get_params() { PPtr k = (PPtr)__builtin_amdgcn_kernarg_segment_ptr(); asm volatile("" : "+s"(k)); return k; }
DEVI int wave_id(int tid) { return __builtin_amdgcn_readfirstlane(tid >> 6); }
DEVI f32x16 mfma16(h16x8 a, h16x8 b, f32x16 c) { return __builtin_amdgcn_mfma_f32_32x32x16_f16(a, b, c, 0, 0, 0); }
DEVI float wave_sum(float v) {
#pragma unroll
  for (int o = 1; o < 64; o <<= 1) v += __shfl_xor(v, o);
  return v;
}
DEVI float sigmoid_f(float x) { return __builtin_amdgcn_rcpf(1.f + __expf(-x)); }
DEVI float silu_f(float x) { return x * __builtin_amdgcn_rcpf(1.f + __expf(-x)); }
DEVI float gelu_tanh_f(float x) {
  const float u = 0.7978845608028654f * (x + 0.044715f * x * x * x);
  const float t = 1.f - 2.f * __builtin_amdgcn_rcpf(1.f + __expf(2.f * u));
  return 0.5f * x * (1.f + t);
}
DEVI unsigned fkey(float f) { unsigned u = __float_as_uint(f); return (u & 0x80000000u) ? ~u : (u | 0x80000000u); }
DEVI float fkey_inv(unsigned k) { unsigned u = (k & 0x80000000u) ? (k & 0x7fffffffu) : ~k; return __uint_as_float(u); }
DEVI int vt_perm(int pos) { return (pos & ~12) | ((pos & 4) << 1) | ((pos & 8) >> 1); }

DEVI void mod_to_lds(PRef p, int b, int chunk, LDS float* dst) {
  const float* mp = (const float*)(p.ws + WS_MODP);
  for (int k = threadIdx.x; k < 1024; k += NTHR) {
    const int j = chunk * 1024 + k;
    float v[8];
#pragma unroll
    for (int ks = 0; ks < 8; ++ks) v[ks] = mp[(size_t)(ks * 4 + b) * 6144 + j];
    float s = p.in[3][j];
#pragma unroll
    for (int ks = 0; ks < 8; ++ks) s += v[ks];
    dst[k] = s;
  }
}

constexpr int LROW = 144;

namespace g8 {
constexpr int BM = 256, BK = 64, HALF = 128, HTB = HALF * BK * 2, STAGE_BYTES = 8 * HTB;
DEVI int lds_byte(int r, int c) { const int st = (r >> 4) * 2 + (c >> 5), rr = r & 15, cc = c & 31, ob = rr * 64 + cc * 2; return st * 1024 + (ob ^ (((ob >> 9) & 1) << 5)); }
DEVI void stage_rc(int b, int& R, int& C) { const int st = b / 1024, sb = b % 1024, swz = sb ^ (((sb >> 9) & 1) << 5); R = (st >> 1) * 16 + swz / 64; C = (st & 1) * 32 + (swz % 64) / 2; }
struct Unit { const char* A; unsigned va[2][2]; const char* B; int pm, pn, e, cnt, off; };
DEVI void glds16(const char* src, LDS unsigned char* dst) { __builtin_amdgcn_global_load_lds((const unsigned*)src, (LDS unsigned*)dst, 16, 0, 0); }

DEVI void dense_va(unsigned (&va)[2][2], int K) {
  const int tid = threadIdx.x;
#pragma unroll
  for (int h = 0; h < 2; ++h)
#pragma unroll
    for (int i = 0; i < 2; ++i) { int R, C; stage_rc(tid * 16 + i * 8192, R, C); va[h][i] = (unsigned)((128 * h + R) * K + C) * 2u; }
}
template <class Sched, class Epi>
DEVI void gemm_phase(LDS unsigned char* lds, int K, const Sched& S, const Epi& E) {
  const int tid = launder((int)threadIdx.x), wid = wave_id(tid), lane = tid & 63, wr = wid >> 2, wc = wid & 3, fr = lane & 15, fq = lane >> 4;
  const int nt = launder(K) / BK;
  unsigned vb[2];
#pragma unroll
  for (int i = 0; i < 2; ++i) { int R, C; stage_rc(tid * 16 + i * 8192, R, C); vb[i] = (unsigned)(R * K + C) * 2u; }
  const size_t kstep = (size_t)(BK * 2), hstep = (size_t)HALF * K * 2;
  const unsigned ldsw = (unsigned)wid * 1024u;
  const int aoff = lds_byte(wr * 64 + fr, fq * 8), boff = lds_byte(wc * 32 + fr, fq * 8);
#define G8_SA(b, h) (((b) * 2 + (h)) * HTB)
#define G8_SB(b, h) ((4 + (b) * 2 + (h)) * HTB)
#define G8_STAGE(bufoff, gbase, v) do { glds16((gbase) + (v)[0], lds + (bufoff) + ldsw); glds16((gbase) + (v)[1], lds + (bufoff) + ldsw + 8192); } while (0)
#define G8_STAGEA(bufoff, gbase, h) do { glds16((gbase) + G8_VAC(h, 0), lds + (bufoff) + ldsw); glds16((gbase) + G8_VAC(h, 1), lds + (bufoff) + ldsw + 8192); } while (0)
#define G8_LDA(dst, b, h) do { _Pragma("unroll") for (int m = 0; m < 4; ++m) _Pragma("unroll") for (int k = 0; k < 2; ++k) dst[m][k] = *(const LDS h16x8*)(lds + G8_SA(b, h) + aoff + m * 2048 + k * 1024); } while (0)
#define G8_LDB(dst, b, h) do { _Pragma("unroll") for (int n = 0; n < 2; ++n) _Pragma("unroll") for (int k = 0; k < 2; ++k) dst[n][k] = *(const LDS h16x8*)(lds + G8_SB(b, h) + boff + n * 2048 + k * 1024); } while (0)
#define G8_MMA(ai, bj, At, Bt) do { __builtin_amdgcn_s_setprio(1); _Pragma("unroll") for (int m = 0; m < 4; ++m) _Pragma("unroll") for (int n = 0; n < 2; ++n) _Pragma("unroll") for (int k = 0; k < 2; ++k) \
        acc[ai][bj][m][n] = __builtin_amdgcn_mfma_f32_16x16x32_f16(Bt[n][k], At[m][k], acc[ai][bj][m][n], 0, 0, 0); __builtin_amdgcn_s_setprio(0); } while (0)
#define G8_WAIT_V(n) asm volatile("s_waitcnt vmcnt(" #n ")" ::: "memory")
#define G8_WAIT_L(n) asm volatile("s_waitcnt lgkmcnt(" #n ")" ::: "memory")
#define G8_BAR __builtin_amdgcn_s_barrier()
#define G8_SCHED __builtin_amdgcn_sched_barrier(0)
  Unit cur, nxt; int ui = 0;
  if (!S.next(0, cur)) return;
  unsigned vd[2][2];
  if (!Sched::GATHER) dense_va(vd, K);
#define G8_VAC(h, i) (Sched::GATHER ? cur.va[h][i] : vd[h][i])
#define G8_VAN(h, i) (Sched::GATHER ? nxt.va[h][i] : vd[h][i])
  f32x4 acc[2][2][4][2];
#pragma unroll
  for (int a = 0; a < 2; ++a)
#pragma unroll
    for (int b = 0; b < 2; ++b)
#pragma unroll
      for (int m = 0; m < 4; ++m)
#pragma unroll
        for (int n = 0; n < 2; ++n) acc[a][b][m][n] = (f32x4){0.f, 0.f, 0.f, 0.f};
  h16x8 At[4][2], B0[2][2], B1[2][2];
  const char* cA = cur.A; const char* cB = cur.B;
  G8_STAGE(G8_SB(0, 0), cB, vb); G8_STAGE(G8_SB(0, 1), cB + hstep, vb); G8_STAGEA(G8_SA(0, 0), cA, 0); G8_STAGEA(G8_SA(0, 1), cA, 1);
  if (wr == 1) G8_BAR;
  G8_WAIT_V(2); G8_BAR;
  G8_STAGE(G8_SB(1, 0), cB + kstep, vb); G8_STAGEA(G8_SA(1, 0), cA + kstep, 0); G8_STAGE(G8_SB(1, 1), cB + hstep + kstep, vb);
  G8_WAIT_V(6); G8_BAR;
  for (;;) {
    const bool has_next = S.next(ui + 1, nxt);
    if (!has_next) nxt = cur;
    const char* nA = nxt.A; const char* nB = nxt.B;
#pragma unroll 1
    for (int t = 0; t < nt; t += 2) {
      const bool last = (t == nt - 2);
      const char* a1 = cA + (size_t)(t + 1) * kstep;
      const char* a2 = last ? nA : cA + (size_t)(t + 2) * kstep; const char* b2 = last ? nB : cB + (size_t)(t + 2) * kstep;
      const char* a3 = a2 + kstep; const char* b3 = b2 + kstep;
#define G8_STAGE2(bufoff, gbase, h) do { glds16((gbase) + (last ? G8_VAN(h, 0) : G8_VAC(h, 0)), lds + (bufoff) + ldsw); glds16((gbase) + (last ? G8_VAN(h, 1) : G8_VAC(h, 1)), lds + (bufoff) + ldsw + 8192); } while (0)
      G8_LDB(B0, 0, 0); G8_LDB(B1, 0, 1); G8_SCHED; G8_LDA(At, 0, 0); G8_STAGEA(G8_SA(1, 1), a1, 1);
      G8_WAIT_V(8); G8_WAIT_L(0); G8_BAR; G8_MMA(0, 0, At, B0); G8_MMA(0, 1, At, B1); G8_BAR; G8_SCHED;
      G8_LDA(At, 0, 1); G8_STAGE(G8_SB(0, 0), b2, vb); G8_STAGE(G8_SB(0, 1), b2 + hstep, vb); G8_STAGE2(G8_SA(0, 0), a2, 0);
      G8_WAIT_V(8); G8_WAIT_L(0); G8_BAR; G8_MMA(1, 0, At, B0); G8_MMA(1, 1, At, B1); G8_BAR; G8_SCHED;
      G8_LDB(B0, 1, 0); G8_LDB(B1, 1, 1); G8_SCHED; G8_LDA(At, 1, 0); G8_STAGE2(G8_SA(0, 1), a2, 1);
      G8_WAIT_V(8); G8_WAIT_L(0); G8_BAR; G8_MMA(0, 0, At, B0); G8_MMA(0, 1, At, B1); G8_BAR; G8_SCHED;
      G8_LDA(At, 1, 1); G8_STAGE(G8_SB(1, 0), b3, vb); G8_STAGE(G8_SB(1, 1), b3 + hstep, vb); G8_STAGE2(G8_SA(1, 0), a3, 0);
      G8_WAIT_V(8); G8_WAIT_L(0); G8_BAR; G8_MMA(1, 0, At, B0); G8_MMA(1, 1, At, B1); G8_BAR; G8_SCHED;
    }
#undef G8_STAGE2
    if (wr == 0) G8_BAR;
    E(acc, cur, wr, wc, fr, fq);
    if (!has_next) break;
#pragma unroll
    for (int a = 0; a < 2; ++a)
#pragma unroll
      for (int b = 0; b < 2; ++b)
#pragma unroll
        for (int m = 0; m < 4; ++m)
#pragma unroll
          for (int n = 0; n < 2; ++n) acc[a][b][m][n] = (f32x4){0.f, 0.f, 0.f, 0.f};
    cur = nxt; cA = nA; cB = nB; ++ui;
    if (wr == 1) G8_BAR;
  }
  G8_WAIT_V(0);
  G8_BAR;
#undef G8_SA
#undef G8_STAGEA
#undef G8_VAC
#undef G8_VAN
#undef G8_SB
#undef G8_STAGE
#undef G8_LDA
#undef G8_LDB
#undef G8_MMA
#undef G8_WAIT_V
#undef G8_WAIT_L
#undef G8_BAR
#undef G8_SCHED
}
struct DenseOrder {
  static constexpr bool GATHER = false;
  const h16* A; const h16* Bt; int K, nM, nN, G, c;
  DEVI bool next(int i, Unit& u) const {
    const int nwg = nM * nN; const long L = (long)i * G + c; if (L >= nwg) return false;
    int wgid = (int)L; { const int q = nwg / 8, r = nwg % 8, xcd = wgid % 8, off = wgid / 8; wgid = (xcd < r ? xcd * (q + 1) : r * (q + 1) + (xcd - r) * q) + off; }
    const int nig = 8 * nN, gid = wgid / nig, fm = gid * 8, gsz = (nM - fm) < 8 ? (nM - fm) : 8;
    u.pm = fm + ((wgid % nig) % gsz); u.pn = (wgid % nig) / gsz; u.e = 0; u.cnt = 0x7fffffff; u.off = 0;
    u.A = (const char*)(A + (size_t)u.pm * 256 * K); u.B = (const char*)(Bt + (size_t)u.pn * 256 * K);
    u.va[0][0] = u.va[0][1] = u.va[1][0] = u.va[1][1] = 0u;
    return true;
  }
};
}


DEVI h16x4 pack4(float a, float b, float c, float d) { h16x4 v; v[0] = (h16)a; v[1] = (h16)b; v[2] = (h16)c; v[3] = (h16)d; return v; }

template <class F>
DEVI void transpose_item(const float* src, int N, int kb, int nb, h16* dst, int ldd, F drow, LDS float* scr, int lane) {
#pragma unroll 8
  for (int i = 0; i < 32; ++i) {
    const int kk = 2 * i + (lane >> 5), n = nb * 32 + (lane & 31);
    scr[kk * 33 + (lane & 31)] = (n < N) ? src[(size_t)(kb * 64 + kk) * N + n] : 0.f;
  }
  asm volatile("s_waitcnt lgkmcnt(0)" ::: "memory");
  const int c = lane & 7;
#pragma unroll
  for (int j = 0; j < 4; ++j) {
    const int nl = (lane >> 3) + 8 * j, n = nb * 32 + nl;
    h16x8 v;
#pragma unroll
    for (int e = 0; e < 8; ++e) v[e] = (h16)scr[(c * 8 + e) * 33 + nl];
    if (n < N) *(h16x8*)(dst + (size_t)drow(n) * ldd + kb * 64 + c * 8) = v;
  }
  asm volatile("s_waitcnt lgkmcnt(0)" ::: "memory");
}

DEVI void phase0(PRef p, LDS unsigned char* lds) {
  const int tid = launder((int)threadIdx.x), lane = tid & 63, wave = wave_id(tid), G = gridDim.x;
  const int gw = blockIdx.x * 8 + wave, NW = G * 8;
  {
    const float* c = p.in[1]; const float* wada = p.in[2]; float* mp = (float*)(p.ws + WS_MODP);
    for (int u = gw; u < 96 * 8; u += NW) {
      const int cgp = u % 96, ks = u / 96, j = cgp * 64 + lane;
      float a0 = 0.f, a1 = 0.f, a2 = 0.f, a3 = 0.f;
      for (int k0 = ks * 128; k0 < ks * 128 + 128; k0 += 16) {
        float w[16];
#pragma unroll
        for (int u = 0; u < 16; ++u) w[u] = wada[(size_t)(k0 + u) * 6144 + j];
#pragma unroll
        for (int u = 0; u < 16; ++u) {
          const int k = k0 + u;
          a0 = fmaf(silu_f(c[k]), w[u], a0); a1 = fmaf(silu_f(c[1024 + k]), w[u], a1);
          a2 = fmaf(silu_f(c[2048 + k]), w[u], a2); a3 = fmaf(silu_f(c[3072 + k]), w[u], a3);
        }
      }
      mp[(size_t)(ks * 4 + 0) * 6144 + j] = a0; mp[(size_t)(ks * 4 + 1) * 6144 + j] = a1;
      mp[(size_t)(ks * 4 + 2) * 6144 + j] = a2; mp[(size_t)(ks * 4 + 3) * 6144 + j] = a3;
    }
  }
  {
    LDS float* scr = (LDS float*)lds + wave * (64 * 33);
    constexpr int I_IN = 16 * 99, I_OUT = 16 * 32, I_G = 32 * 128, I_U = 32 * 128, I_D = 32 * 128, I_RG = 32;
    constexpr int NIT = I_IN + I_OUT + I_G + I_U + I_D + I_RG;
    for (int it = gw; it < NIT; it += NW) {
      int r = it;
      if (r < I_IN) {
        transpose_item(p.in[8], 3144, r / 99, r % 99, (h16*)(p.ws + WS_WIN), 1024,
                       [](int n) { const int dl = n < 2112 ? n : (n < 2120 ? 3136 + (n - 2112) : (n < 2632 ? 2112 + (n - 2120) : 2624 + (n - 2632)));
                                     const int d = dl & 63, sx = (dl >> 6) & 3;
                                     return (dl & ~255) + 128 * (d >> 5) + 32 * sx + 16 * ((d >> 2) & 1) + 4 * ((d >> 3) & 3) + (d & 3); }, scr, lane);
        continue;
      }
      r -= I_IN;
      if (r < I_OUT) { transpose_item(p.in[16], 1024, r / 32, r % 32, (h16*)(p.ws + WS_WOUT), 1024, [](int n) { return (n & ~31) + 16 * ((n >> 2) & 1) + 4 * ((n >> 3) & 3) + (n & 3); }, scr, lane); continue; }
      r -= I_OUT;
      if (r < I_G) { const int e = r >> 7, q = r & 127;
        transpose_item(p.in[21] + (size_t)e * 1024 * 256, 256, q >> 3, q & 7, (h16*)(p.ws + WS_WGU) + (size_t)e * 512 * 1024, 1024, [](int f) { return (f >> 4) * 32 + (f & 15); }, scr, lane); continue; }
      r -= I_G;
      if (r < I_U) { const int e = r >> 7, q = r & 127;
        transpose_item(p.in[22] + (size_t)e * 1024 * 256, 256, q >> 3, q & 7, (h16*)(p.ws + WS_WGU) + (size_t)e * 512 * 1024, 1024, [](int f) { return (f >> 4) * 32 + 16 + (f & 15); }, scr, lane); continue; }
      r -= I_U;
      if (r < I_D) { const int e = r >> 7, q = r & 127;
        transpose_item(p.in[23] + (size_t)e * 256 * 1024, 1024, q >> 5, q & 31, (h16*)(p.ws + WS_WDN) + (size_t)e * 1024 * 256, 256, [](int n) { return (n & ~31) + 16 * ((n >> 2) & 1) + 4 * ((n >> 3) & 3) + (n & 3); }, scr, lane); continue; }
      r -= I_D;
      if (r < 16) transpose_item(p.in[11] + (size_t)(r >> 1) * 4096, 64, 0, r & 1, (h16*)(p.ws + WS_WRG) + (size_t)(r >> 1) * 128 * 64, 64, [](int n) { return n; }, scr, lane);
      else transpose_item(p.in[13] + (size_t)((r - 16) >> 1) * 4096, 64, 0, r & 1, (h16*)(p.ws + WS_WRG) + (size_t)((r - 16) >> 1) * 128 * 64, 64, [](int n) { return 64 + n; }, scr, lane);
    }
  }
  {
    h16* wrh = (h16*)(p.ws + WS_WRH); h16* wrl = (h16*)(p.ws + WS_WRL);
    for (int i = blockIdx.x * NTHR + tid; i < 48 * 1024; i += G * NTHR) {
      const int col = i >> 10, k = i & 1023;
      const float w = (col < 4) ? p.in[17][k * 4 + col] : (col < 36 ? p.in[19][k * 32 + (col - 4)] : 0.f);
      const h16 hi = (h16)w;
      wrh[i] = hi; wrl[i] = (h16)(w - (float)hi);
    }
    float* ct = (float*)(p.ws + WS_ROPE); float* st = ct + 8192 * 32;
    for (int i = blockIdx.x * NTHR + tid; i < 8192 * 32; i += G * NTHR) {
      const int pos = i >> 5, f = i & 31;
      const double rev = (double)pos * ROPE_REV[f];
      const float fr = (float)(rev - __builtin_rint(rev));
      ct[i] = __builtin_amdgcn_cosf(fr); st[i] = __builtin_amdgcn_sinf(fr);
    }
  }
}

DEVI void phase1(PRef p, LDS unsigned char* lds) {
  const int tid = launder((int)threadIdx.x), lane = tid & 63, wave = wave_id(tid), G = gridDim.x;
  const int b = blockIdx.x & 3, bi = blockIdx.x >> 2, nbk = G >> 2;
  LDS float* mv = (LDS float*)lds;
  mod_to_lds(p, b, 0, mv); mod_to_lds(p, b, 1, mv + 1024);
  __syncthreads();
  f32x4 A[4], SH[4];
#pragma unroll
  for (int j = 0; j < 4; ++j) {
    const int k = 256 * j + 4 * lane;
    const f32x4 g = *(const f32x4*)(p.in[4] + k);
    A[j] = g * (*(LDS f32x4*)(mv + 1024 + k) + 1.f);
    SH[j] = *(LDS f32x4*)(mv + k);
  }
  const float* x = p.in[0]; h16* H = (h16*)(p.ws + WS_H);
  f32x4 vn[4];
  {
    const size_t tok = (size_t)b * SEQ + bi * 8 + wave;
#pragma unroll
    for (int j = 0; j < 4; ++j) vn[j] = *(const f32x4*)(x + tok * DM + 256 * j + 4 * lane);
  }
  for (int r = bi * 8 + wave; r < SEQ; r += nbk * 8) {
    const size_t tok = (size_t)b * SEQ + r;
    f32x4 v[4]; float ss = 0.f;
#pragma unroll
    for (int j = 0; j < 4; ++j) { v[j] = vn[j]; ss += v[j][0] * v[j][0] + v[j][1] * v[j][1] + v[j][2] * v[j][2] + v[j][3] * v[j][3]; }
    if (r + nbk * 8 < SEQ) {
#pragma unroll
      for (int j = 0; j < 4; ++j) vn[j] = *(const f32x4*)(x + (tok + nbk * 8) * DM + 256 * j + 4 * lane);
    }
    const float rstd = 1.0f / sqrtf(wave_sum(ss) * (1.f / 1024.f) + 1e-6f);
#pragma unroll
    for (int j = 0; j < 4; ++j) {
      const f32x4 y = v[j] * rstd * A[j] + SH[j];
      *(h16x4*)(H + tok * DM + 256 * j + 4 * lane) = pack4(y[0], y[1], y[2], y[3]);
    }
  }
}

DEVI h16x8 pack8(const f32x4& a, const f32x4& b) { h16x8 w; w[0] = (h16)a[0]; w[1] = (h16)a[1]; w[2] = (h16)a[2]; w[3] = (h16)a[3]; w[4] = (h16)b[0]; w[5] = (h16)b[1]; w[6] = (h16)b[2]; w[7] = (h16)b[3]; return w; }
struct EpiInProj {
  unsigned char* ws;
  DEVI void operator()(const f32x4 (&acc)[2][2][4][2], const g8::Unit& u, int wr, int wc, int fr, int fq) const {
    const float* cosT = (const float*)(ws + WS_ROPE); const float* sinT = cosT + 8192 * 32;
    const int g = 4 * u.pn + wc;
    if (g > 49) return;
    const int d0 = 8 * fq;
#pragma unroll
    for (int ai = 0; ai < 2; ++ai)
#pragma unroll
      for (int m = 0; m < 4; ++m) {
        const int tok = u.pm * 256 + 128 * ai + 64 * wr + 16 * m + fr;
        const int b = tok >> 13, pos = tok & 8191;
        const f32x4 xa = acc[ai][0][m][0], xb = acc[ai][0][m][1], ya = acc[ai][1][m][0], yb = acc[ai][1][m][1];
        if (g < 16 || (g >= 24 && g <= 32)) {
          float scl; h16* dst;
          if (g < 8) { scl = 0.125f * 1.4426950408889634f; dst = (h16*)(ws + WS_Q) + (size_t)tok * 512 + g * 64; }
          else if (g < 16) { scl = 1.f; dst = (h16*)(ws + WS_K) + (size_t)tok * 512 + (g - 8) * 64; }
          else if (g < 32) { scl = 0.125f; dst = (h16*)(ws + WS_QI) + (size_t)tok * 512 + (g - 24) * 64; }
          else { scl = 1.f; dst = (h16*)(ws + WS_KI) + (size_t)tok * 64; }
          const f32x4 ca = *(const f32x4*)(cosT + pos * 32 + d0), cb = *(const f32x4*)(cosT + pos * 32 + d0 + 4);
          const f32x4 sa = *(const f32x4*)(sinT + pos * 32 + d0), sb = *(const f32x4*)(sinT + pos * 32 + d0 + 4);
          *(h16x8*)(dst + d0) = pack8((xa * ca - ya * sa) * scl, (xb * cb - yb * sb) * scl);
          *(h16x8*)(dst + 32 + d0) = pack8((ya * ca + xa * sa) * scl, (yb * cb + xb * sb) * scl);
        } else if (g < 24) {
          h16* vt = (h16*)(ws + WS_VT) + (size_t)(b * 8 + (g - 16)) * 64 * 8192 + vt_perm(pos);
#pragma unroll
          for (int e = 0; e < 4; ++e) {
            vt[(size_t)(d0 + e) * 8192] = (h16)xa[e]; vt[(size_t)(d0 + 4 + e) * 8192] = (h16)xb[e];
            vt[(size_t)(32 + d0 + e) * 8192] = (h16)ya[e]; vt[(size_t)(36 + d0 + e) * 8192] = (h16)yb[e];
          }
        } else if (g < 49) {
          h16* dst = (g < 41) ? (h16*)(ws + WS_XR) + (size_t)tok * 512 + (g - 33) * 64 : (h16*)(ws + WS_XG) + (size_t)tok * 512 + (g - 41) * 64;
          *(h16x8*)(dst + d0) = pack8(xa, xb);
          *(h16x8*)(dst + 32 + d0) = pack8(ya, yb);
        } else if (fq == 0) {
          const float sc = 0.35355339059327373f;
          float* wi = (float*)(ws + WS_WI) + (size_t)tok * 8;
          *(f32x4*)wi = xa * sc; *(f32x4*)(wi + 4) = xb * sc;
        }
      }
  }
};

DEVI void phase2(PRef p, LDS unsigned char* lds) {
  g8::DenseOrder S{(const h16*)(p.ws + WS_H), (const h16*)(p.ws + WS_WIN), DM, 128, 13, (int)gridDim.x, (int)blockIdx.x};
  EpiInProj E{p.ws};
  g8::gemm_phase(lds, DM, S, E);
}

constexpr int CROW = 1040;
constexpr int RNN_XG = 64 * CROW;
constexpr int RNN_CARRY = 2 * 64 * CROW;
template <int MODE>
DEVI void rnn_item(PRef p, LDS unsigned char* lds, int b, int cr) {
  const int tid = launder((int)threadIdx.x), lane = tid & 63, wave = wave_id(tid), l31 = lane & 31, half = lane >> 5;
  const h16* XR = (const h16*)(p.ws + WS_XR);
  {
    const int chg = tid & 63, tg = tid >> 6, pos0 = cr * 64 + 8 * tg;
    h16x8 xin[11];
#pragma unroll
    for (int i = 0; i < 11; ++i) {
      const int pos = pos0 + i - 3;
      if (pos >= 0) xin[i] = *(const h16x8*)(XR + ((size_t)b * SEQ + pos) * 512 + chg * 8);
      else {
#pragma unroll
        for (int e = 0; e < 8; ++e) xin[i][e] = (h16)0.f;
      }
    }
    float cw[4][8], cb[8];
#pragma unroll
    for (int e = 0; e < 8; ++e) {
      cb[e] = p.in[10][chg * 8 + e];
#pragma unroll
      for (int j = 0; j < 4; ++j) cw[j][e] = p.in[9][j * 512 + chg * 8 + e];
    }
#pragma unroll
    for (int tt = 0; tt < 8; ++tt) {
      h16x8 o;
#pragma unroll
      for (int e = 0; e < 8; ++e) {
        float v = cb[e];
#pragma unroll
        for (int j = 0; j < 4; ++j) v = fmaf(cw[j][e], (float)xin[tt + j][e], v);
        o[e] = (h16)v;
      }
      *(LDS h16x8*)(lds + (8 * tg + tt) * CROW + chg * 16) = o;
    }
  }
  if (MODE == 1) {
    const float2* ag = (const float2*)(p.ws + WS_AGG) + (size_t)b * 128 * 512 + tid;
    float carry = 0.f; int c2 = 0;
    for (; c2 + 8 <= cr; c2 += 8) {
      float2 v[8];
#pragma unroll
      for (int u = 0; u < 8; ++u) v[u] = ag[(size_t)(c2 + u) * 512];
#pragma unroll
      for (int u = 0; u < 8; ++u) carry = fmaf(v[u].x, carry, v[u].y);
    }
    for (; c2 < cr; ++c2) { const float2 v = ag[(size_t)c2 * 512]; carry = fmaf(v.x, carry, v.y); }
    ((LDS float*)(lds + RNN_CARRY))[tid] = carry;
  }
  if (MODE == 1) {
    const h16* XG = (const h16*)(p.ws + WS_XG) + ((size_t)b * SEQ + cr * 64) * 512;
#pragma unroll
    for (int i = 0; i < 8; ++i) { const int c = tid + NTHR * i, row = c >> 6, cc = c & 63; *(LDS h16x8*)(lds + RNN_XG + row * CROW + cc * 16) = *(const h16x8*)(XG + (size_t)row * 512 + cc * 8); }
  }
  __syncthreads();
  const int n = wave;
  const h16* WRG = (const h16*)(p.ws + WS_WRG) + (size_t)n * 128 * 64;
  float* AGG = (float*)(p.ws + WS_AGG);
#pragma unroll 1
  for (int dt = 0; dt < 2; ++dt) {
    h16x8 wa[4], wx[4];
#pragma unroll
    for (int kk = 0; kk < 4; ++kk) {
      wa[kk] = *(const h16x8*)(WRG + (size_t)(32 * dt + l31) * 64 + 16 * kk + 8 * half);
      wx[kk] = *(const h16x8*)(WRG + (size_t)(64 + 32 * dt + l31) * 64 + 16 * kk + 8 * half);
    }
    f32x16 ra[2], rx[2];
#pragma unroll
    for (int ti = 0; ti < 2; ++ti) {
#pragma unroll
      for (int r = 0; r < 16; ++r) { ra[ti][r] = 0.f; rx[ti][r] = 0.f; }
#pragma unroll
      for (int kk = 0; kk < 4; ++kk) {
        const h16x8 af = *(LDS h16x8*)(lds + (32 * ti + l31) * CROW + (n * 64 + 16 * kk + 8 * half) * 2);
        ra[ti] = mfma16(af, wa[kk], ra[ti]);
        rx[ti] = mfma16(af, wx[kk], rx[ti]);
      }
    }
    const int ch = n * 64 + 32 * dt + l31;
    const float ba = p.in[12][ch], bx = p.in[14][ch], lam = p.in[15][ch];
    const float c8 = -8.f * log1pf(__expf(-lam));
#pragma unroll
    for (int ti = 0; ti < 2; ++ti)
#pragma unroll
      for (int r = 0; r < 16; ++r) {
        const int tk = 32 * ti + (r & 3) + 8 * (r >> 2) + 4 * half;
        const float cv = (float)*(LDS h16*)(lds + tk * CROW + ch * 2);
        const float rr = sigmoid_f(ra[ti][r] + ba), ii = sigmoid_f(rx[ti][r] + bx);
        const float la = c8 * rr;
        ra[ti][r] = __expf(la);
        const float x2 = 2.f * la;
        const float om = -x2 * fmaf(x2 * 0.5f, fmaf(x2 * (1.f / 3.f), fmaf(x2 * 0.25f, fmaf(x2, 0.2f, 1.f), 1.f), 1.f), 1.f);
        rx[ti][r] = __builtin_amdgcn_sqrtf(om) * (ii * cv);
      }
    float P[8], Hs[8];
#pragma unroll
    for (int sg = 0; sg < 8; ++sg) {
      const int ti = sg >> 2, q = sg & 3;
      float pp = 1.f, hh = 0.f;
#pragma unroll
      for (int i = 0; i < 4; ++i) { const float a = ra[ti][4 * q + i], bb = rx[ti][4 * q + i]; hh = fmaf(a, hh, bb); pp *= a; }
      P[sg] = pp; Hs[sg] = hh;
    }
    float carry = 0.f, prod = 1.f;
    if (MODE == 1) carry = ((LDS float*)(lds + RNN_CARRY))[ch];
    float cin[8];
#pragma unroll
    for (int sg = 0; sg < 8; ++sg)
#pragma unroll
      for (int ow = 0; ow < 2; ++ow) {
        const float tmp = fmaf(P[sg], carry, Hs[sg]);
        const float tp = P[sg] * prod;
        if (half == ow) cin[sg] = carry;
        const float oth = __shfl_xor(tmp, 32), otp = __shfl_xor(tp, 32);
        carry = (half == ow) ? tmp : oth;
        prod = (half == ow) ? tp : otp;
      }
    if (MODE == 0) {
      if (half == 0) { float* ag = AGG + ((size_t)(b * 128 + cr) * 512 + ch) * 2; ag[0] = prod; ag[1] = carry; }
    } else {
#pragma unroll
      for (int sg = 0; sg < 8; ++sg) {
        const int ti = sg >> 2, q = sg & 3;
        float hh = cin[sg];
#pragma unroll
        for (int i = 0; i < 4; ++i) {
          hh = fmaf(ra[ti][4 * q + i], hh, rx[ti][4 * q + i]);
          LDS h16* xp = (LDS h16*)(lds + RNN_XG + (32 * ti + 8 * q + 4 * half + i) * CROW + ch * 2);
          *xp = (h16)(hh * gelu_tanh_f((float)*xp));
        }
      }
    }
  }
  __syncthreads();
  if (MODE == 1) {
    h16* Y = (h16*)(p.ws + WS_H) + ((size_t)b * SEQ + cr * 64) * DM + 512;
#pragma unroll
    for (int i = 0; i < 8; ++i) { const int c = tid + NTHR * i, row = c >> 6, cc = c & 63; *(h16x8*)(Y + (size_t)row * DM + cc * 8) = *(LDS h16x8*)(lds + RNN_XG + row * CROW + cc * 16); }
    __syncthreads();
  }
}

constexpr int IDX_NB = 256, IDX_CAP = 128;
constexpr int IL_HIST = 0, IL_CS = 65536, IL_CK = IL_CS + 64 * IDX_CAP * 4, IL_KI = IL_CK + 64 * IDX_CAP * 2, IL_KISZ = 128 * LROW, IL_ST = IL_KI + 2 * IL_KISZ;
static_assert(IL_ST + 4096 <= LDS_BYTES, "indexer LDS map");

DEVI f32x4 mfma16s(h16x8 a, h16x8 b, f32x4 c) { return __builtin_amdgcn_mfma_f32_16x16x32_f16(a, b, c, 0, 0, 0); }
DEVI void idx_score(LDS unsigned char* kit, int kh, int l15, int g4, const h16x8 (&qf)[8][2], const float (&wq)[8], f32x4 (&sc)[4]) {
  h16x8 kf[4][2];
#pragma unroll
  for (int kt = 0; kt < 4; ++kt)
#pragma unroll
    for (int ks = 0; ks < 2; ++ks) kf[kt][ks] = *(LDS h16x8*)(kit + (64 * kh + 16 * kt + l15) * LROW + (4 * ks + g4) * 16);
#pragma unroll
  for (int kt = 0; kt < 4; ++kt) sc[kt] = (f32x4){0.f, 0.f, 0.f, 0.f};
  f32x4 accA[4], accB[4];
#define IDX_MM(ACC, h) _Pragma("unroll") for (int kt = 0; kt < 4; ++kt) { ACC[kt] = mfma16s(kf[kt][0], qf[h][0], (f32x4){0.f, 0.f, 0.f, 0.f}); ACC[kt] = mfma16s(kf[kt][1], qf[h][1], ACC[kt]); }
#define IDX_RS(ACC, h) _Pragma("unroll") for (int kt = 0; kt < 4; ++kt) _Pragma("unroll") for (int r = 0; r < 4; ++r) sc[kt][r] = __builtin_fmaf(wq[h], __int_as_float(max(__float_as_int(ACC[kt][r]), 0)), sc[kt][r]);
  IDX_MM(accA, 0)
  IDX_MM(accB, 1) IDX_RS(accA, 0)
  IDX_MM(accA, 2) IDX_RS(accB, 1)
  IDX_MM(accB, 3) IDX_RS(accA, 2)
  IDX_MM(accA, 4) IDX_RS(accB, 3)
  IDX_MM(accB, 5) IDX_RS(accA, 4)
  IDX_MM(accA, 6) IDX_RS(accB, 5)
  IDX_MM(accB, 7) IDX_RS(accA, 6)
  IDX_RS(accB, 7)
#undef IDX_MM
#undef IDX_RS
}

template <int MODE>
DEVI void idx_pass(LDS unsigned char* lds, const h16* KIb, int N, int stride, int qg, int kh,
                   const h16* QIrow0, const float* WIrow0, float qinv, float qoff, int bstar, h16* scbase) {
  const int tid = launder((int)threadIdx.x), lane = tid & 63, l15 = lane & 15, g4 = lane >> 4;
  const int q = 16 * qg + l15;
  h16x8 qf[8][2]; float wq[8];
  {
    const h16* QI = QIrow0 + (size_t)q * 512;
#pragma unroll
    for (int h = 0; h < 8; ++h)
#pragma unroll
      for (int ks = 0; ks < 2; ++ks) qf[h][ks] = *(const h16x8*)(QI + h * 64 + 32 * ks + 8 * g4);
    const float* WI = WIrow0 + (size_t)q * 8;
#pragma unroll
    for (int h = 0; h < 8; ++h) wq[h] = WI[h];
  }
  LDS unsigned* hist = (LDS unsigned*)(lds + IL_HIST);
  LDS unsigned* st = (LDS unsigned*)(lds + IL_ST);
  const int nst = (N + 127) >> 7;
  const int lr = tid >> 3, lc = tid & 7;
  h16x8 r0, r1;
  r0 = *(const h16x8*)(KIb + (size_t)lr * 64 + lc * 8); r1 = *(const h16x8*)(KIb + (size_t)(lr + 64) * 64 + lc * 8);
  *(LDS h16x8*)(lds + IL_KI + lr * LROW + lc * 16) = r0; *(LDS h16x8*)(lds + IL_KI + (lr + 64) * LROW + lc * 16) = r1;
  __syncthreads();
  float vmin = INFINITY, vmax = -INFINITY;
  int cur = 0;
  for (int s = 0; s < nst; s += stride) {
    const int nx = s + stride;
    if (nx < nst) { r0 = *(const h16x8*)(KIb + (size_t)(128 * nx + lr) * 64 + lc * 8); r1 = *(const h16x8*)(KIb + (size_t)(128 * nx + lr + 64) * 64 + lc * 8); }
    if (128 * s + 64 * kh < N) {
      f32x4 sc[4];
      idx_score(lds + IL_KI + cur * IL_KISZ, kh, l15, g4, qf, wq, sc);
      if (MODE == 0) {
#pragma unroll
        for (int kt = 0; kt < 4; ++kt)
#pragma unroll
          for (int r = 0; r < 4; ++r) { vmin = fminf(vmin, sc[kt][r]); vmax = fmaxf(vmax, sc[kt][r]); }
      } else if (MODE == 1) {
        h16* scp = scbase + ((size_t)((s * 2 + kh) * 4) * 1024 + q * 16 + 4 * g4);
#pragma unroll
        for (int kt = 0; kt < 4; ++kt) {
          const h16x4 hv = pack4(sc[kt][0], sc[kt][1], sc[kt][2], sc[kt][3]);
          *(h16x4*)(scp + kt * 1024) = hv;
#pragma unroll
          for (int r = 0; r < 4; ++r) {
            const float xb = fminf(fmaxf(__builtin_fmaf((float)hv[r], qinv, qoff), 0.f), (float)(IDX_NB - 1));
            const int bin = (int)xb;
            __hip_atomic_fetch_add(&hist[bin * 64 + q], 1u, __ATOMIC_RELAXED, __HIP_MEMORY_SCOPE_WORKGROUP);
          }
        }
      }
    }
    if (nx < nst) {
      *(LDS h16x8*)(lds + IL_KI + (cur ^ 1) * IL_KISZ + lr * LROW + lc * 16) = r0;
      *(LDS h16x8*)(lds + IL_KI + (cur ^ 1) * IL_KISZ + (lr + 64) * LROW + lc * 16) = r1;
    }
    __syncthreads();
    cur ^= 1;
  }
  if (MODE == 0) {
    __hip_atomic_fetch_min(&st[q], fkey(vmin), __ATOMIC_RELAXED, __HIP_MEMORY_SCOPE_WORKGROUP);
    __hip_atomic_fetch_max(&st[64 + q], fkey(vmax), __ATOMIC_RELAXED, __HIP_MEMORY_SCOPE_WORKGROUP);
  }
}

DEVI int idx_bin(float sv, float qinv, float qoff) { return (int)fminf(fmaxf(__builtin_fmaf(sv, qinv, qoff), 0.f), (float)(IDX_NB - 1)); }
DEVI float idx_bin_lower_bound(int target, float qinv, float qoff) {
  if (target <= 0) return -INFINITY;
  if (target > IDX_NB - 1) return INFINITY;
  unsigned lo = 0x03FFu, hi = 0xFC00u;
  auto val = [](unsigned k) { const unsigned short hbits = (unsigned short)((k & 0x8000u) ? (k & 0x7FFFu) : (~k & 0xFFFFu)); return (float)__builtin_bit_cast(h16, hbits); };
  if (idx_bin(val(hi), qinv, qoff) < target) return INFINITY;
  while (lo < hi) { const unsigned mid = (lo + hi) >> 1; if (idx_bin(val(mid), qinv, qoff) >= target) hi = mid; else lo = mid + 1; }
  return val(lo);
}
DEVI void idx_stream_step(LDS unsigned char* lds, LDS unsigned* st, const unsigned long long (&cur)[4], int s, int kh, int q, int lane, int g4, float thi, float tlo) {
  unsigned nib = 0u;
#pragma unroll
  for (int kt = 3; kt >= 0; --kt) {
    const h16x4 hv = __builtin_bit_cast(h16x4, cur[kt]);
#pragma unroll
    for (int r = 3; r >= 0; --r) {
      const float sv = (float)hv[r];
      const unsigned long long ms = __builtin_amdgcn_ballot_w64(sv >= thi);
      asm("v_addc_co_u32_e64 %0, vcc, %0, %0, %1" : "+v"(nib) : "s"(ms) : "vcc");
      const bool cand = (sv >= tlo) && !(sv >= thi);
      if (__builtin_amdgcn_ballot_w64(cand) != 0ull) {
        if (cand) {
          const unsigned pos = __hip_atomic_fetch_add(&st[128 + q], 1u, __ATOMIC_RELAXED, __HIP_MEMORY_SCOPE_WORKGROUP);
          if (pos < (unsigned)IDX_CAP) {
            ((LDS float*)(lds + IL_CS))[q * IDX_CAP + pos] = sv;
            ((LDS unsigned short*)(lds + IL_CK))[q * IDX_CAP + pos] = (unsigned short)(128 * s + 64 * kh + 16 * kt + 4 * g4 + r);
          }
        }
      }
    }
  }
  const unsigned oth = (unsigned)__shfl_xor((int)nib, 32);
  if (lane < 32) {
#pragma unroll
    for (int T = 0; T < 2; ++T) {
      const unsigned b0 = ((nib >> (8 * T)) & 15u) | (((oth >> (8 * T)) & 15u) << 4);
      const unsigned b1 = ((nib >> (8 * T + 4)) & 15u) | (((oth >> (8 * T + 4)) & 15u) << 4);
      ((LDS unsigned short*)(lds + IL_HIST))[q * 512 + (4 * s + 2 * kh + T) * 2 + (g4 & 1)] = (unsigned short)(b0 | (b1 << 8));
    }
  }
}
DEVI void idx_stream(LDS unsigned char* lds, int N, int qg, int kh, float thi, float tlo, const h16* scbase) {
  const int tid = launder((int)threadIdx.x), lane = tid & 63, l15 = lane & 15, g4 = lane >> 4;
  const int q = 16 * qg + l15;
  LDS unsigned* st = (LDS unsigned*)(lds + IL_ST);
  const int nv = (N - 64 * kh + 127) >> 7;
  const unsigned long long* scp = (const unsigned long long*)(scbase + ((size_t)(kh * 4) * 1024 + q * 16 + 4 * g4));
#define IDX_LD(dst, s_) do { if ((s_) < nv) { _Pragma("unroll") for (int kt = 0; kt < 4; ++kt) dst[kt] = __hip_atomic_load(scp + (size_t)(s_) * 2048 + kt * 256, __ATOMIC_RELAXED, __HIP_MEMORY_SCOPE_AGENT); } } while (0)
  unsigned long long b0[4], b1[4], b2[4], b3[4];
  IDX_LD(b0, 0); IDX_LD(b1, 1); IDX_LD(b2, 2); IDX_LD(b3, 3);
  for (int s = 0; s < nv; s += 4) {
    idx_stream_step(lds, st, b0, s, kh, q, lane, g4, thi, tlo); IDX_LD(b0, s + 4);
    if (s + 1 < nv) { idx_stream_step(lds, st, b1, s + 1, kh, q, lane, g4, thi, tlo); IDX_LD(b1, s + 5); }
    if (s + 2 < nv) { idx_stream_step(lds, st, b2, s + 2, kh, q, lane, g4, thi, tlo); IDX_LD(b2, s + 6); }
    if (s + 3 < nv) { idx_stream_step(lds, st, b3, s + 3, kh, q, lane, g4, thi, tlo); IDX_LD(b3, s + 7); }
  }
#undef IDX_LD
}

DEVI void idx_item(PRef p, LDS unsigned char* lds, int b, int c) {
  const int tid = launder((int)threadIdx.x), lane = tid & 63, wave = wave_id(tid), l31 = lane & 31, half = lane >> 5;
  const int N = 64 * (c + 1);
  unsigned* MASK = (unsigned*)(p.ws + WS_MASK) + ((size_t)b * SEQ + 64 * c) * 256;
  if (N <= 256) {
    const int wpr = N >> 5;
    for (int i = tid; i < 64 * wpr; i += NTHR) MASK[(size_t)(i / wpr) * 256 + (i % wpr)] = 0xFFFFFFFFu;
    return;
  }
  const int qg = wave & 3, kh = wave >> 2, l15 = lane & 15, q = 16 * qg + l15;
  const h16* QIrow0 = (const h16*)(p.ws + WS_QI) + ((size_t)b * SEQ + 64 * c) * 512;
  const float* WIrow0 = (const float*)(p.ws + WS_WI) + ((size_t)b * SEQ + 64 * c) * 8;
  const h16* KIb = (const h16*)(p.ws + WS_KI) + (size_t)b * SEQ * 64;
  h16* scbase;
  {
    const int j = (c < 64) ? c : 127 - c;
    const size_t pre = 8192ull * (size_t)(128 * j - (j * (j - 1)) / 2);
    scbase = (h16*)(p.ws + (b == 0 ? WS_H : WS_MIX + (size_t)(b - 1) * SC_BATCH_BYTES) + pre);
  }
  LDS unsigned* st = (LDS unsigned*)(lds + IL_ST);
  LDS float* stf = (LDS float*)(lds + IL_ST);
  if (tid < 64) { st[tid] = 0xFFFFFFFFu; st[64 + tid] = 0u; st[128 + tid] = 0u; }
  __syncthreads();
  const int nst = (N + 127) >> 7;
  const int stride = nst >= 16 ? 8 : (nst >= 8 ? 4 : (nst >= 4 ? 2 : 1));
  idx_pass<0>(lds, KIb, N, stride, qg, kh, QIrow0, WIrow0, 0.f, 0.f, 0, scbase);
  __syncthreads();
  if (tid < 64) {
    const float lo = fkey_inv(st[tid]), hi = fkey_inv(st[64 + tid]);
    float d = hi - lo; if (!(d > 1e-20f)) d = 1.f;
    const float inv = (float)IDX_NB / (1.5f * d);
    stf[192 + tid] = inv; stf[256 + tid] = -(lo - 0.25f * d) * inv;
  }
  for (int i = tid; i < 16384; i += NTHR) ((LDS unsigned*)(lds + IL_HIST))[i] = 0u;
  __syncthreads();
  const float qinv = stf[192 + q], qoff = stf[256 + q];
  idx_pass<1>(lds, KIb, N, 1, qg, kh, QIrow0, WIrow0, qinv, qoff, 0, scbase);
  {
    LDS unsigned* hist = (LDS unsigned*)(lds + IL_HIST);
    for (int qq = wave; qq < 64; qq += 8) {
      unsigned hb[4];
#pragma unroll
      for (int j = 0; j < 4; ++j) hb[j] = hist[(4 * lane + j) * 64 + qq];
      const unsigned mine = hb[0] + hb[1] + hb[2] + hb[3];
      unsigned suf = mine;
#pragma unroll
      for (int o = 1; o < 64; o <<= 1) { const unsigned v = (unsigned)__shfl_down((int)suf, o); if (lane + o < 64) suf += v; }
      unsigned cum = suf - mine;
      if (cum < 256u && suf >= 256u) {
#pragma unroll
        for (int j = 3; j >= 0; --j) {
          if (cum < 256u && cum + hb[j] >= 256u) { st[320 + qq] = (unsigned)(4 * lane + j); st[384 + qq] = 256u - cum; }
          cum += hb[j];
        }
      }
    }
  }
  __syncthreads();
  if (tid < 64) {
    const int bs = (int)st[320 + tid]; const float qi_ = stf[192 + tid], qo_ = stf[256 + tid];
    stf[448 + tid] = idx_bin_lower_bound(bs + 1, qi_, qo_);
    stf[512 + tid] = idx_bin_lower_bound(bs, qi_, qo_);
  }
  __syncthreads();
  const float thi = stf[448 + q], tlo = stf[512 + q];
  asm volatile("s_waitcnt vmcnt(0)" ::: "memory");
  idx_stream(lds, N, qg, kh, thi, tlo, scbase);
  __syncthreads();
  for (int qq = wave; qq < 64; qq += 8) {
    const int nc = min((int)st[128 + qq], IDX_CAP); const unsigned need = st[384 + qq];
    LDS float* cs = (LDS float*)(lds + IL_CS) + qq * IDX_CAP; LDS unsigned short* ck = (LDS unsigned short*)(lds + IL_CK) + qq * IDX_CAP;
    for (int i = lane; i < nc; i += 64) {
      const float sv = cs[i]; const unsigned kv = ck[i];
      unsigned rank = 0u;
      for (int j = 0; j < nc; ++j) { const float sj = cs[j]; const unsigned kj = ck[j]; rank += (sj > sv || (sj == sv && kj < kv)) ? 1u : 0u; }
      if (rank < need) {
        const unsigned kl = kv & 31u;
        const unsigned bit = 16u * ((kl >> 2) & 1u) + (kl & 3u) + 4u * (kl >> 3);
        __hip_atomic_fetch_or((LDS unsigned*)(lds + IL_HIST) + qq * 256 + (kv >> 5), 1u << bit, __ATOMIC_RELAXED, __HIP_MEMORY_SCOPE_WORKGROUP);
      }
    }
  }
  __syncthreads();
  {
    const int cpr = N >> 6;
    for (int i = tid; i < 64 * cpr; i += NTHR) {
      const int row = i / cpr, cc = i % cpr;
      *(u32x2*)(MASK + (size_t)row * 256 + 2 * cc) = *(LDS u32x2*)(lds + IL_HIST + row * 1024 + cc * 8);
    }
  }
  __syncthreads();
}

DEVI void phase3(PRef p, LDS unsigned char* lds) {
  const int G = gridDim.x;
  for (int it = blockIdx.x; it < 512; it += G) rnn_item<0>(p, lds, it >> 7, it & 127);
  for (int it = blockIdx.x; it < 256; it += G) {
    const int b = it >> 6, j = it & 63;
#pragma unroll 1
    for (int w2 = 0; w2 < 2; ++w2) idx_item(p, lds, b, w2 ? j : 127 - j);
  }
}

DEVI float max3f(float a, float b, float c) { float r; asm("v_max3_f32 %0, %1, %2, %3" : "=v"(r) : "v"(a), "v"(b), "v"(c)); return r; }
DEVI unsigned pk_rtz(float a, float b) { return __builtin_bit_cast(unsigned, __builtin_amdgcn_cvt_pkrtz(a, b)); }
DEVI void attn_tile(LDS unsigned char* Kt, LDS unsigned char* Vt, const h16x8 (&qf)[4], u32x2 mw, int l31, int half, f32x16 (&o)[2], float& mref, float& l, bool& init) {
  const unsigned nm0 = ~(mw[0] >> (16 * half)), nm1 = ~(mw[1] >> (16 * half));
  const unsigned negm = __float_as_uint(-mref);
  f32x16 s[2];
#pragma unroll
  for (int r = 0; r < 16; ++r) {
    unsigned e0 = (unsigned)__builtin_amdgcn_sbfe((int)nm0, r, 1), e1 = (unsigned)__builtin_amdgcn_sbfe((int)nm1, r, 1);
    asm volatile("" : "+v"(e0), "+v"(e1));
    s[0][r] = __uint_as_float((e0 & 0xFF800000u) | (~e0 & negm));
    s[1][r] = __uint_as_float((e1 & 0xFF800000u) | (~e1 & negm));
  }
#pragma unroll
  for (int ri = 0; ri < 2; ++ri)
#pragma unroll
    for (int kk = 0; kk < 4; ++kk) {
      const h16x8 kf = *(LDS h16x8*)(Kt + (32 * ri + l31) * LROW + (2 * kk + half) * 16);
      s[ri] = mfma16(kf, qf[kk], s[ri]);
    }
  asm volatile("s_nop 15\n\ts_nop 7" : "+v"(s[0]), "+v"(s[1]));
  float mx = max3f(s[0][0], s[1][0], s[0][1]), mx2 = max3f(s[1][1], s[0][2], s[1][2]);
#pragma unroll
  for (int r = 3; r < 15; r += 2) { mx = max3f(mx, s[0][r], s[1][r]); mx2 = max3f(mx2, s[0][r + 1], s[1][r + 1]); }
  mx = max3f(mx, s[0][15], s[1][15]);
  mx = max3f(mx, mx2, mx2);
  mx = max3f(mx, __shfl_xor(mx, 32), mx);
  const bool first = (!init) && (mx > -INFINITY);
  const bool resc = first || (mx > 8.f);
  if (__any(resc)) {
    init = init || first;
    const float delta = resc ? mx : 0.f;
    const float alpha = __builtin_amdgcn_exp2f(-delta);
#pragma unroll
    for (int r = 0; r < 16; ++r) { s[0][r] -= delta; s[1][r] -= delta; o[0][r] *= alpha; o[1][r] *= alpha; }
    l *= alpha; mref += delta;
  }
  float ls = 0.f;
#pragma unroll
  for (int r = 0; r < 16; ++r) {
    s[0][r] = __builtin_amdgcn_exp2f(s[0][r]); s[1][r] = __builtin_amdgcn_exp2f(s[1][r]);
    ls += s[0][r] + s[1][r];
  }
  l += ls;
  h16x8 pf[4];
#pragma unroll
  for (int s4 = 0; s4 < 4; ++s4) {
    u32x4 w;
#pragma unroll
    for (int e = 0; e < 4; ++e) w[e] = pk_rtz(s[s4 >> 1][8 * (s4 & 1) + 2 * e], s[s4 >> 1][8 * (s4 & 1) + 2 * e + 1]);
    pf[s4] = __builtin_bit_cast(h16x8, w);
  }
#pragma unroll
  for (int di = 0; di < 2; ++di)
#pragma unroll
    for (int s4 = 0; s4 < 4; ++s4) {
      const h16x8 vf = *(LDS h16x8*)(Vt + (32 * di + l31) * LROW + (2 * s4 + half) * 16);
      o[di] = mfma16(vf, pf[s4], o[di]);
    }
}

DEVI void attn_unit(PRef p, LDS unsigned char* lds, int b, int head, int qb) {
  const int tid = launder((int)threadIdx.x), lane = tid & 63, wave = wave_id(tid), l31 = lane & 31, half = lane >> 5;
  const int q0 = qb * 256 + wave * 32, cw = q0 >> 6, NS = qb + 1;
  const size_t tok = (size_t)b * SEQ + q0 + l31;
  h16x8 qf[4];
  {
    const h16* Q = (const h16*)(p.ws + WS_Q) + tok * 512 + head * 64;
#pragma unroll
    for (int kk = 0; kk < 4; ++kk) qf[kk] = *(const h16x8*)(Q + 16 * kk + 8 * half);
  }
  const unsigned* mrow = (const unsigned*)(p.ws + WS_MASK) + tok * 256;
  constexpr int TP = 2 * 64 * LROW, ABUF = 4 * TP;
  static_assert(2 * ABUF <= LDS_BYTES - 16, "attention LDS");
  const h16* ksrc[4]; const h16* vsrc[4]; int kdst[4], vdst[4];
#pragma unroll
  for (int i = 0; i < 4; ++i) {
    const int id = tid + NTHR * i;
    const int row = id >> 3, lc = id & 7;
    ksrc[i] = (const h16*)(p.ws + WS_K) + ((size_t)b * SEQ + row) * 512 + head * 64 + lc * 8;
    kdst[i] = (row >> 6) * TP + (row & 63) * LROW + lc * 16;
    const int d = id >> 5, c = id & 31;
    vsrc[i] = (const h16*)(p.ws + WS_VT) + ((size_t)(b * 8 + head) * 64 + d) * 8192 + c * 8;
    vdst[i] = (c >> 3) * TP + 64 * LROW + d * LROW + (c & 7) * 16;
  }
  h16x8 rkA[4], rvA[4], rkB[4], rvB[4];
#pragma unroll
  for (int i = 0; i < 4; ++i) { rkA[i] = *(const h16x8*)ksrc[i]; rvA[i] = *(const h16x8*)vsrc[i]; }
#pragma unroll
  for (int i = 0; i < 4; ++i) { *(LDS h16x8*)(lds + kdst[i]) = rkA[i]; *(LDS h16x8*)(lds + vdst[i]) = rvA[i]; }
  if (NS > 1) {
#pragma unroll
    for (int i = 0; i < 4; ++i) { rkA[i] = *(const h16x8*)(ksrc[i] + (size_t)256 * 512); rvA[i] = *(const h16x8*)(vsrc[i] + 256); }
  }
  u32x4 mwa = *(const u32x4*)mrow, mwb = *(const u32x4*)(mrow + 4), mna, mnb;
  mna = mwa; mnb = mwb;
  __syncthreads();
  f32x16 o[2];
#pragma unroll
  for (int r = 0; r < 16; ++r) { o[0][r] = 0.f; o[1][r] = 0.f; }
  float mref = 0.f, l = 0.f; bool init = false;
#define ATT_TILE(s, t, W0, W1) if (4 * (s) + (t) <= cw) { u32x2 m2; m2[0] = W0; m2[1] = W1; attn_tile(bb + (t) * TP, bb + (t) * TP + 64 * LROW, qf, m2, l31, half, o, mref, l, init); }
#define ATT_STEP(s, RKC, RVC, RKN, RVN) { \
    if ((s) + 2 < NS) { _Pragma("unroll") for (int i = 0; i < 4; ++i) { RKN[i] = *(const h16x8*)(ksrc[i] + (size_t)((s) + 2) * 256 * 512); RVN[i] = *(const h16x8*)(vsrc[i] + ((s) + 2) * 256); } } \
    if ((s) + 1 < NS) { mna = *(const u32x4*)(mrow + 8 * ((s) + 1)); mnb = *(const u32x4*)(mrow + 8 * ((s) + 1) + 4); } \
    { LDS unsigned char* bb = lds + ((s) & 1) * ABUF; \
      ATT_TILE(s, 0, mwa[0], mwa[1]) ATT_TILE(s, 1, mwa[2], mwa[3]) ATT_TILE(s, 2, mwb[0], mwb[1]) ATT_TILE(s, 3, mwb[2], mwb[3]) } \
    if ((s) + 1 < NS) { LDS unsigned char* nb = lds + (((s) + 1) & 1) * ABUF; _Pragma("unroll") for (int i = 0; i < 4; ++i) { *(LDS h16x8*)(nb + kdst[i]) = RKC[i]; *(LDS h16x8*)(nb + vdst[i]) = RVC[i]; } } \
    __syncthreads(); mwa = mna; mwb = mnb; }
  for (int s = 0; s < NS; s += 2) {
    ATT_STEP(s, rkA, rvA, rkB, rvB)
    if (s + 1 < NS) ATT_STEP(s + 1, rkB, rvB, rkA, rvA)
  }
#undef ATT_STEP
#undef ATT_TILE
  const float inv = 1.f / (l + __shfl_xor(l, 32));
  h16* Y = (h16*)(p.ws + WS_H) + tok * DM + head * 64;
#pragma unroll
  for (int di = 0; di < 2; ++di)
#pragma unroll
    for (int q = 0; q < 4; ++q)
      *(h16x4*)(Y + 32 * di + 8 * q + 4 * half) = pack4(o[di][4 * q] * inv, o[di][4 * q + 1] * inv, o[di][4 * q + 2] * inv, o[di][4 * q + 3] * inv);
}

DEVI void phase4(PRef p, LDS unsigned char* lds) {
  const int G = gridDim.x;
  for (int it = blockIdx.x; it < 512; it += G) rnn_item<1>(p, lds, it >> 7, it & 127);
  for (int it = blockIdx.x; it < 512; it += G) {
    const int bh = it >> 4, j = it & 15;
#pragma unroll 1
    for (int w2 = 0; w2 < 2; ++w2) attn_unit(p, lds, bh >> 3, bh & 7, w2 ? j : 31 - j);
  }
}

struct EpiPlain {
  h16* dst; int ld;
  DEVI void operator()(const f32x4 (&acc)[2][2][4][2], const g8::Unit& u, int wr, int wc, int fr, int fq) const {
#pragma unroll
    for (int ai = 0; ai < 2; ++ai)
#pragma unroll
      for (int m = 0; m < 4; ++m) {
        const int r = u.pm * 256 + 128 * ai + 64 * wr + 16 * m + fr;
        if (r < u.cnt) {
          h16* d = dst + (size_t)(u.off + r) * ld + u.pn * 256 + 32 * wc + 8 * fq;
#pragma unroll
          for (int bj = 0; bj < 2; ++bj)
            { const f32x4 v0 = acc[ai][bj][m][0], v1 = acc[ai][bj][m][1]; h16x8 w; w[0] = (h16)v0[0]; w[1] = (h16)v0[1]; w[2] = (h16)v0[2]; w[3] = (h16)v0[3]; w[4] = (h16)v1[0]; w[5] = (h16)v1[1]; w[6] = (h16)v1[2]; w[7] = (h16)v1[3]; *(h16x8*)(d + 128 * bj) = w; }
        }
      }
  }
};
DEVI void phase5(PRef p, LDS unsigned char* lds) {
  g8::DenseOrder S{(const h16*)(p.ws + WS_H), (const h16*)(p.ws + WS_WOUT), DM, 128, 4, (int)gridDim.x, (int)blockIdx.x};
  EpiPlain E{(h16*)(p.ws + WS_MIX), DM};
  g8::gemm_phase(lds, DM, S, E);
}

constexpr int P6_TROW = 2064, P6_THI = 0, P6_TLO = 32 * P6_TROW, P6_PART = 0, P6_LGT = 8 * 48 * 32 * 4, P6_MOD = 2 * 32 * P6_TROW;
constexpr int P6_BIAS = P6_MOD + 3 * 4096, P6_TOK = P6_BIAS + 160, P6_LCNT = P6_TOK + 128 * 6 * 4, P6_LBASE = P6_LCNT + 128;
static_assert(P6_LBASE + 128 <= LDS_BYTES - 16 && P6_LGT + 32 * 36 * 4 <= P6_MOD, "phase 6 LDS map");
DEVI void phase6(PRef p, LDS unsigned char* lds) {
  const int tid = launder((int)threadIdx.x), lane = tid & 63, wave = wave_id(tid), l15 = lane & 15, g4 = lane >> 4;
  const int b = blockIdx.x >> 6;
  LDS float* mv = (LDS float*)(lds + P6_MOD);
  LDS float* rbias = (LDS float*)(lds + P6_BIAS);
  LDS unsigned* tokrec = (LDS unsigned*)(lds + P6_TOK);
  LDS unsigned* lcnt = (LDS unsigned*)(lds + P6_LCNT);
  LDS unsigned* lbase = (LDS unsigned*)(lds + P6_LBASE);
  mod_to_lds(p, b, 2, mv); mod_to_lds(p, b, 3, mv + 1024); mod_to_lds(p, b, 4, mv + 2048);
  if (tid < 4) rbias[tid] = p.in[18][tid];
  else if (tid < 36) rbias[tid] = p.in[20][tid - 4];
  if (tid < 32) lcnt[tid] = 0u;
  __syncthreads();
  for (int k = tid; k < 1024; k += NTHR) { mv[k] *= p.in[5][k]; mv[2048 + k] = p.in[6][k] * (mv[2048 + k] + 1.f); }
  __syncthreads();
  const float* x = p.in[0]; const h16* MIX = (const h16*)(p.ws + WS_MIX); h16* X1h = (h16*)(p.ws + WS_MIX); h16* H2 = (h16*)(p.ws + WS_H);
  const h16* WRH = (const h16*)(p.ws + WS_WRH); const h16* WRL = (const h16*)(p.ws + WS_WRL);
  const size_t tok0 = (size_t)blockIdx.x * 128;
  h16x8 bh[3][4], bl[3][4];
#pragma unroll
  for (int ct = 0; ct < 3; ++ct)
#pragma unroll
    for (int kk = 0; kk < 4; ++kk) {
      const int kof = 32 * (4 * wave + kk) + 8 * g4;
      bh[ct][kk] = *(const h16x8*)(WRH + (size_t)(16 * ct + l15) * 1024 + kof); bl[ct][kk] = *(const h16x8*)(WRL + (size_t)(16 * ct + l15) * 1024 + kof);
    }
  f32x4 xa[4]; h16x4 ma[4];
#pragma unroll
  for (int j = 0; j < 4; ++j) { xa[j] = *(const f32x4*)(x + (tok0 + 4 * wave) * DM + 256 * j + 4 * lane); ma[j] = *(const h16x4*)(MIX + (tok0 + 4 * wave) * DM + 256 * j + 4 * lane); }
#pragma unroll 1
  for (int rd = 0; rd < 4; ++rd) {
    {
      const size_t tokb = tok0 + 32 * rd + 4 * wave;
#define P6_LOAD(XV, MH, T) do { _Pragma("unroll") for (int j = 0; j < 4; ++j) { XV[j] = *(const f32x4*)(x + (T) * DM + 256 * j + 4 * lane); MH[j] = *(const h16x4*)(MIX + (T) * DM + 256 * j + 4 * lane); } } while (0)
#define P6_ROW(XV, MH, I) do { \
        const int tr = 4 * wave + (I); const size_t tok = tokb + (I); \
        f32x4 mx[4]; float ssm = 0.f; \
        _Pragma("unroll") for (int j = 0; j < 4; ++j) _Pragma("unroll") for (int e = 0; e < 4; ++e) { mx[j][e] = (float)MH[j][e]; ssm += mx[j][e] * mx[j][e]; } \
        const float rsm = 1.0f / sqrtf(wave_sum(ssm) * (1.f / 1024.f) + 1e-6f); \
        float ss1 = 0.f; \
        _Pragma("unroll") for (int j = 0; j < 4; ++j) { \
          const f32x4 v = XV[j] + *(LDS f32x4*)(mv + 256 * j + 4 * lane) * (mx[j] * rsm); \
          XV[j] = v; \
          *(h16x4*)(X1h + tok * DM + 256 * j + 4 * lane) = pack4(v[0], v[1], v[2], v[3]); \
          ss1 += v[0] * v[0] + v[1] * v[1] + v[2] * v[2] + v[3] * v[3]; \
        } \
        const float rs1 = 1.0f / sqrtf(wave_sum(ss1) * (1.f / 1024.f) + 1e-6f); \
        _Pragma("unroll") for (int j = 0; j < 4; ++j) { \
          const f32x4 h2 = XV[j] * rs1 * *(LDS f32x4*)(mv + 2048 + 256 * j + 4 * lane) + *(LDS f32x4*)(mv + 1024 + 256 * j + 4 * lane); \
          const h16x4 hi = pack4(h2[0], h2[1], h2[2], h2[3]); \
          const h16x4 lo = pack4(h2[0] - (float)hi[0], h2[1] - (float)hi[1], h2[2] - (float)hi[2], h2[3] - (float)hi[3]); \
          *(h16x4*)(H2 + tok * DM + 256 * j + 4 * lane) = hi; \
          *(LDS h16x4*)(lds + P6_THI + tr * P6_TROW + (256 * j + 4 * lane) * 2) = hi; \
          *(LDS h16x4*)(lds + P6_TLO + tr * P6_TROW + (256 * j + 4 * lane) * 2) = lo; \
        } } while (0)
      f32x4 xb[4]; h16x4 mb[4];
      P6_LOAD(xb, mb, tokb + 1); __builtin_amdgcn_sched_barrier(0); P6_ROW(xa, ma, 0);
      P6_LOAD(xa, ma, tokb + 2); __builtin_amdgcn_sched_barrier(0); P6_ROW(xb, mb, 1);
      P6_LOAD(xb, mb, tokb + 3); __builtin_amdgcn_sched_barrier(0); P6_ROW(xa, ma, 2);
      { const size_t tn = rd < 3 ? tokb + 32 : tokb; P6_LOAD(xa, ma, tn); } __builtin_amdgcn_sched_barrier(0); P6_ROW(xb, mb, 3);
    }
    __syncthreads();
    f32x4 acc[2][3];
#pragma unroll
    for (int tt = 0; tt < 2; ++tt)
#pragma unroll
      for (int ct = 0; ct < 3; ++ct) acc[tt][ct] = (f32x4){0.f, 0.f, 0.f, 0.f};
#pragma unroll
    for (int kk = 0; kk < 4; ++kk) {
      const int kof = 32 * (4 * wave + kk) + 8 * g4;
      h16x8 ah[2], al[2];
#pragma unroll
      for (int tt = 0; tt < 2; ++tt) {
        ah[tt] = *(LDS h16x8*)(lds + P6_THI + (16 * tt + l15) * P6_TROW + kof * 2);
        al[tt] = *(LDS h16x8*)(lds + P6_TLO + (16 * tt + l15) * P6_TROW + kof * 2);
      }
#pragma unroll
      for (int ct = 0; ct < 3; ++ct) {
#pragma unroll
        for (int tt = 0; tt < 2; ++tt) {
          acc[tt][ct] = mfma16s(ah[tt], bh[ct][kk], acc[tt][ct]);
          acc[tt][ct] = mfma16s(ah[tt], bl[ct][kk], acc[tt][ct]);
          acc[tt][ct] = mfma16s(al[tt], bh[ct][kk], acc[tt][ct]);
        }
      }
    }
    __syncthreads();
#pragma unroll
    for (int tt = 0; tt < 2; ++tt)
#pragma unroll
      for (int ct = 0; ct < 3; ++ct)
        *(LDS f32x4*)(lds + P6_PART + (((wave * 48 + 16 * ct + l15) * 32) + 16 * tt + 4 * g4) * 4) = acc[tt][ct];
    __syncthreads();
    for (int idx = tid; idx < 36 * 32; idx += NTHR) {
      const int col = idx >> 5, tk = idx & 31;
      float s = 0.f;
#pragma unroll
      for (int w = 0; w < 8; ++w) s += *(LDS float*)(lds + P6_PART + ((w * 48 + col) * 32 + tk) * 4);
      *(LDS float*)(lds + P6_LGT + (tk * 36 + col) * 4) = s;
    }
    __syncthreads();
    if (tid < 32) {
      LDS float* lg = (LDS float*)(lds + P6_LGT) + 36 * tid;
      float gl[4];
#pragma unroll
      for (int g = 0; g < 4; ++g) gl[g] = lg[g] + rbias[g];
      int gi = 0; float gm = gl[0];
#pragma unroll
      for (int g = 1; g < 4; ++g) if (gl[g] > gm) { gm = gl[g]; gi = g; }
      float gs = 0.f;
#pragma unroll
      for (int g = 0; g < 4; ++g) gs += __expf(gl[g] - gm);
      const float pg = 1.f / gs;
      int e1 = 0, e2 = 0; float l1 = -INFINITY, l2 = -INFINITY;
#pragma unroll
      for (int e = 0; e < 8; ++e) {
        const float v = lg[4 + 8 * gi + e] + rbias[4 + 8 * gi + e];
        if (v > l1) { l2 = l1; e2 = e1; l1 = v; e1 = e; }
        else if (v > l2) { l2 = v; e2 = e; }
      }
      const float x2 = __expf(l2 - l1);
      const float w1 = pg / (1.f + x2), w2 = pg * x2 / (1.f + x2);
      const unsigned E1 = (unsigned)(gi * 8 + e1), E2 = (unsigned)(gi * 8 + e2);
      const unsigned lp1 = __hip_atomic_fetch_add(&lcnt[E1], 1u, __ATOMIC_RELAXED, __HIP_MEMORY_SCOPE_WORKGROUP);
      const unsigned lp2 = __hip_atomic_fetch_add(&lcnt[E2], 1u, __ATOMIC_RELAXED, __HIP_MEMORY_SCOPE_WORKGROUP);
      LDS unsigned* tr = tokrec + (32 * rd + tid) * 6;
      tr[0] = E1; tr[1] = lp1; tr[2] = E2; tr[3] = lp2; tr[4] = __float_as_uint(w1); tr[5] = __float_as_uint(w2);
    }
    __syncthreads();
  }
  if (tid < 32) lbase[tid] = atomicAdd((unsigned*)(p.ws + WS_CNT) + tid, lcnt[tid]);
  __syncthreads();
  if (tid < 128) {
    unsigned* LIST = (unsigned*)(p.ws + WS_LIST); float* LISTW = (float*)(p.ws + WS_LISTW); u32x4* ROUTE = (u32x4*)(p.ws + WS_ROUTE);
    const unsigned tok = (unsigned)(tok0 + tid);
    LDS unsigned* tr = tokrec + tid * 6;
    const unsigned E1 = tr[0], E2 = tr[2], p1 = lbase[E1] + tr[1], p2 = lbase[E2] + tr[3];
    LIST[(size_t)E1 * 32768 + p1] = tok; LISTW[(size_t)E1 * 32768 + p1] = __uint_as_float(tr[4]);
    LIST[(size_t)E2 * 32768 + p2] = tok; LISTW[(size_t)E2 * 32768 + p2] = __uint_as_float(tr[5]);
    u32x4 rt; rt[0] = E1; rt[1] = p1; rt[2] = E2; rt[3] = p2;
    ROUTE[tok] = rt;
  }
}

template <bool GATHER_> struct MoeOrder {
  static constexpr bool GATHER = GATHER_;
  unsigned char* ws; int ntn, K, G, c;
  int pre, cnl, offx;
  DEVI void init() {
    const int lane = threadIdx.x & 63;
    const int cn0 = lane < 32 ? (int)((const unsigned*)(ws + WS_CNT))[lane] : 0;
    int pt = ((cn0 + 255) >> 8) * ntn, po = cn0;
#pragma unroll
    for (int d = 1; d < 32; d <<= 1) { const int a = __shfl_up(pt, d), b = __shfl_up(po, d); if (lane >= d) { pt += a; po += b; } }
    pre = lane < 32 ? pt : 0x7fffffff; cnl = cn0; offx = po - cn0;
  }
  DEVI bool next(int i, g8::Unit& u) const {
    const int itg = i * G + c;
    const int e = __builtin_popcountll(__builtin_amdgcn_ballot_w64(pre <= itg));
    if (e >= 32) return false;
    const int cn = __builtin_amdgcn_readlane(cnl, e), off = __builtin_amdgcn_readlane(offx, e);
    const int it = itg - (__builtin_amdgcn_readlane(pre, e) - ((cn + 255) >> 8) * ntn);
    u.e = e; u.pm = it / ntn; u.pn = it % ntn; u.cnt = cn; u.off = off;
    const int tid = threadIdx.x;
    if (GATHER_) {
      const unsigned* list = (const unsigned*)(ws + WS_LIST) + (size_t)e * 32768;
      u.A = (const char*)(ws + WS_H);
      u.B = (const char*)((const h16*)(ws + WS_WGU) + ((size_t)e * 512 + u.pn * 256) * DM);
#pragma unroll
      for (int h = 0; h < 2; ++h)
#pragma unroll
        for (int i2 = 0; i2 < 2; ++i2) {
          int R, C; g8::stage_rc(tid * 16 + i2 * 8192, R, C);
          const int row = u.pm * 256 + 128 * h + R;
          const unsigned t = (row < cn) ? list[row] : 0u;
          u.va[h][i2] = (t * (unsigned)DM + (unsigned)C) * 2u;
        }
    } else {
      u.A = (const char*)((const h16*)(ws + WS_ACT) + ((size_t)off + u.pm * 256) * 256);
      u.B = (const char*)((const h16*)(ws + WS_WDN) + ((size_t)e * 1024 + u.pn * 256) * 256);
      u.va[0][0] = u.va[0][1] = u.va[1][0] = u.va[1][1] = 0u;
    }
    return true;
  }
};
struct EpiAct {
  unsigned char* ws;
  DEVI void operator()(const f32x4 (&acc)[2][2][4][2], const g8::Unit& u, int wr, int wc, int fr, int fq) const {
    const float* lw = (const float*)(ws + WS_LISTW) + (size_t)u.e * 32768; h16* act = (h16*)(ws + WS_ACT);
#pragma unroll
    for (int ai = 0; ai < 2; ++ai)
#pragma unroll
      for (int m = 0; m < 4; ++m) {
        const int r = u.pm * 256 + 128 * ai + 64 * wr + 16 * m + fr;
        if (r < u.cnt) {
          const float w = lw[r];
#pragma unroll
          for (int bj = 0; bj < 2; ++bj) {
            const f32x4 g = acc[ai][bj][m][0], up = acc[ai][bj][m][1];
            float v[4];
#pragma unroll
            for (int e = 0; e < 4; ++e) v[e] = g[e] * __builtin_amdgcn_rcpf(1.f + __expf(-g[e])) * up[e] * w;
            *(h16x4*)(act + (size_t)(u.off + r) * 256 + 16 * (8 * u.pn + 4 * bj + wc) + 4 * fq) = pack4(v[0], v[1], v[2], v[3]);
          }
        }
      }
  }
};
struct EpiYp {
  h16* dst;
  DEVI void operator()(const f32x4 (&acc)[2][2][4][2], const g8::Unit& u, int wr, int wc, int fr, int fq) const {
#pragma unroll
    for (int ai = 0; ai < 2; ++ai)
#pragma unroll
      for (int m = 0; m < 4; ++m) {
        const int r = u.pm * 256 + 128 * ai + 64 * wr + 16 * m + fr;
        if (r < u.cnt) {
          h16* d = dst + (size_t)(u.off + r) * DM + u.pn * 256 + 32 * wc + 8 * fq;
#pragma unroll
          for (int bj = 0; bj < 2; ++bj)
            { const f32x4 v0 = acc[ai][bj][m][0], v1 = acc[ai][bj][m][1]; h16x8 w; w[0] = (h16)v0[0]; w[1] = (h16)v0[1]; w[2] = (h16)v0[2]; w[3] = (h16)v0[3]; w[4] = (h16)v1[0]; w[5] = (h16)v1[1]; w[6] = (h16)v1[2]; w[7] = (h16)v1[3]; *(h16x8*)(d + 128 * bj) = w; }
        }
      }
  }
};
DEVI void phase7(PRef p, LDS unsigned char* lds) {
  MoeOrder<true> S{p.ws, 2, DM, (int)gridDim.x, (int)blockIdx.x, 0, 0, 0};
  S.init();
  EpiAct E{p.ws};
  g8::gemm_phase(lds, DM, S, E);
}
DEVI void phase8(PRef p, LDS unsigned char* lds) {
  MoeOrder<false> S{p.ws, 4, 256, (int)gridDim.x, (int)blockIdx.x, 0, 0, 0};
  S.init();
  EpiYp E{(h16*)(p.ws + WS_YP)};
  g8::gemm_phase(lds, 256, S, E);
}

DEVI void phase9(PRef p, LDS unsigned char* lds) {
  const int tid = launder((int)threadIdx.x), lane = tid & 63, wave = wave_id(tid), G = gridDim.x;
  const int b = blockIdx.x & 3, bi = blockIdx.x >> 2, nbk = G >> 2;
  LDS unsigned* offs = (LDS unsigned*)lds;
  if (tid == 0) { const unsigned* cnt = (const unsigned*)(p.ws + WS_CNT); unsigned o = 0; for (int e = 0; e < 32; ++e) { offs[e] = o; o += cnt[e]; } }
  __syncthreads();
  LDS float* mv = (LDS float*)(lds + 256);
  mod_to_lds(p, b, 5, mv);
  __syncthreads();
  f32x4 A3[4];
#pragma unroll
  for (int j = 0; j < 4; ++j) { const int k = 256 * j + 4 * lane; A3[j] = *(LDS f32x4*)(mv + k) * *(const f32x4*)(p.in[7] + k); }
  const h16* YP = (const h16*)(p.ws + WS_YP); const u32x4* ROUTE = (const u32x4*)(p.ws + WS_ROUTE); float* out = p.out; const h16* X1h = (const h16*)(p.ws + WS_MIX);
  const int rstep = nbk * 8, r_first = bi * 8 + wave;
  const int nrow = (SEQ - r_first + rstep - 1) / rstep;
  unsigned R0 = 0u, R1 = 0u;
  if (lane < nrow) { const u32x4 rt = ROUTE[(size_t)b * SEQ + r_first + rstep * lane]; R0 = offs[rt[0]] + rt[1]; R1 = offs[rt[2]] + rt[3]; }
  h16x4 ya[4], yc[4]; f32x4 xv[4];
  {
    const size_t tok = (size_t)b * SEQ + r_first; const size_t r0 = __builtin_amdgcn_readlane(R0, 0), r1 = __builtin_amdgcn_readlane(R1, 0);
#pragma unroll
    for (int j = 0; j < 4; ++j) { ya[j] = *(const h16x4*)(YP + r0 * DM + 256 * j + 4 * lane); yc[j] = *(const h16x4*)(YP + r1 * DM + 256 * j + 4 * lane); { const h16x4 xh = *(const h16x4*)(X1h + tok * DM + 256 * j + 4 * lane); xv[j] = (f32x4){(float)xh[0], (float)xh[1], (float)xh[2], (float)xh[3]}; } }
  }
  for (int i = 0; i < nrow; ++i) {
    const size_t tok = (size_t)b * SEQ + r_first + rstep * i;
    h16x4 na[4], nc[4]; f32x4 nx[4];
    if (i + 1 < nrow) {
      const size_t r0 = __builtin_amdgcn_readlane(R0, i + 1), r1 = __builtin_amdgcn_readlane(R1, i + 1);
#pragma unroll
      for (int j = 0; j < 4; ++j) { na[j] = *(const h16x4*)(YP + r0 * DM + 256 * j + 4 * lane); nc[j] = *(const h16x4*)(YP + r1 * DM + 256 * j + 4 * lane); { const h16x4 xh = *(const h16x4*)(X1h + (tok + rstep) * DM + 256 * j + 4 * lane); nx[j] = (f32x4){(float)xh[0], (float)xh[1], (float)xh[2], (float)xh[3]}; } }
    }
    f32x4 y[4]; float ss = 0.f;
#pragma unroll
    for (int j = 0; j < 4; ++j)
#pragma unroll
      for (int e = 0; e < 4; ++e) { y[j][e] = (float)ya[j][e] + (float)yc[j][e]; ss += y[j][e] * y[j][e]; }
    const float rs = 1.0f / sqrtf(wave_sum(ss) * (1.f / 1024.f) + 1e-6f);
#pragma unroll
    for (int j = 0; j < 4; ++j) *(f32x4*)(out + tok * DM + 256 * j + 4 * lane) = xv[j] + A3[j] * (y[j] * rs);
    if (i + 1 < nrow) {
#pragma unroll
      for (int j = 0; j < 4; ++j) { ya[j] = na[j]; yc[j] = nc[j]; xv[j] = nx[j]; }
    }
  }
}

#define XB_TMO      128
#define XB_XCNT(j)  (256  + 64 * (j))
#define XB_XSUB(j)  (1280 + 64 * (j))
#define XB_XGEN(j)  (2304 + 64 * (j))
#define XB_TOP      3328
#define XB_TOPGEN   3392
#define XB_SPIN_CAP (1u << 22)
DEVI unsigned xb_ld(unsigned* p)              { return __hip_atomic_load(p, __ATOMIC_RELAXED, __HIP_MEMORY_SCOPE_AGENT); }
DEVI unsigned xb_add(unsigned* p, unsigned v) { return __hip_atomic_fetch_add(p, v, __ATOMIC_RELAXED, __HIP_MEMORY_SCOPE_AGENT); }
DEVI unsigned xb_xcc_id() { return (unsigned)__builtin_amdgcn_s_getreg((3 << 11) | 20) & 0xFu; }
#define XB_SPIN(cond, bar) do { unsigned _sp = 0; while (cond) { __builtin_amdgcn_s_sleep(1); \
    if ((++_sp & 255u) == 0u) { if (xb_ld(&(bar)[XB_TMO])) break; if (_sp > XB_SPIN_CAP) { atomicAdd(&(bar)[XB_TMO], 1u); break; } } } } while (0)
struct XcdBarrier { unsigned* bar; unsigned x; volatile LDS unsigned* st; };
DEVI XcdBarrier xcd_barrier_post(unsigned* bar, volatile LDS unsigned* st) {
  XcdBarrier b; b.bar = bar; b.x = xb_xcc_id(); b.st = st;
  if (threadIdx.x == 0) (void)xb_add(&bar[XB_XCNT(b.x)], 1u);
  return b;
}
DEVI void xcd_barrier_complete(unsigned* bar, unsigned x, unsigned& nloc, unsigned& nx) {
  const unsigned G = gridDim.x * gridDim.y * gridDim.z;
  unsigned sum, cnt, mine, sp = 0u;
  for (;;) {
    sum = 0u; cnt = 0u; mine = 0u;
#pragma unroll
    for (unsigned j = 0; j < 16; ++j) { const unsigned c = xb_ld(&bar[XB_XCNT(j)]); sum += c; cnt += (c > 0u) ? 1u : 0u; mine = (j == x) ? c : mine; }
    if (sum == G) break;
    __builtin_amdgcn_s_sleep(1);
    if ((++sp & 255u) == 0u) { if (xb_ld(&bar[XB_TMO])) break; if (sp > XB_SPIN_CAP) { atomicAdd(&bar[XB_TMO], 1u); break; } }
  }
  nloc = mine > 0u ? mine : 1u; nx = cnt > 0u ? cnt : 1u;
}
DEVI void xcd_barrier(const XcdBarrier& b) {
  asm volatile("s_waitcnt vmcnt(0)" ::: "memory");
  __syncthreads();
  if (threadIdx.x == 0) {
    unsigned* bar = b.bar;
    __builtin_amdgcn_s_waitcnt(0);
    unsigned nloc = b.st[0], nx = b.st[1];
    if (nloc == 0u) { xcd_barrier_complete(bar, b.x, nloc, nx); b.st[0] = nloc; b.st[1] = nx; }
    const unsigned old = xb_add(&bar[XB_XSUB(b.x)], 1u);
    const unsigned gen = old / nloc;
    if (old + 1u == (gen + 1u) * nloc) {
      __builtin_amdgcn_fence(__ATOMIC_RELEASE, "agent");
      asm volatile("s_waitcnt vmcnt(0)" ::: "memory");
      const unsigned og = xb_add(&bar[XB_TOP], 1u);
      const unsigned tg = og / nx;
      if (og + 1u == (tg + 1u) * nx) xb_add(&bar[XB_TOPGEN], 1u);
      else XB_SPIN(xb_ld(&bar[XB_TOPGEN]) == tg, bar);
      __builtin_amdgcn_fence(__ATOMIC_ACQUIRE, "agent");
      xb_add(&bar[XB_XGEN(b.x)], 1u);
      asm volatile("s_waitcnt vmcnt(0)" ::: "memory");
    } else {
      XB_SPIN(xb_ld(&bar[XB_XGEN(b.x)]) == gen, bar);
      __builtin_amdgcn_fence(__ATOMIC_ACQUIRE, "agent");
      asm volatile("s_waitcnt vmcnt(0)" ::: "memory");
    }
  }
  __syncthreads();
}

__global__ void __launch_bounds__(NTHR) fwd_kernel(Params p) {
  extern __shared__ __attribute__((aligned(16))) unsigned char smem[];
  LDS unsigned char* lds = (LDS unsigned char*)smem;
  const int lo = p.ph_lo, hi = p.ph_hi;
  volatile LDS unsigned* bst = (volatile LDS unsigned*)(lds + LDS_BYTES - 16);
  if (threadIdx.x < 4) bst[threadIdx.x] = 0u;
  __syncthreads();
  (void)xcd_barrier_post((unsigned*)(p.ws + WS_BAR), bst);
#ifndef REPEAT_PHASE
#define REPEAT_PHASE -1
#endif
#define GRID_SYNC(k) do { { XcdBarrier xb_; xb_.bar = (unsigned*)(get_params()->ws + WS_BAR); xb_.x = xb_xcc_id(); xb_.st = (volatile LDS unsigned*)(lds + LDS_BYTES - 16); xcd_barrier(xb_); } } while (0)
#define RUN_PHASE(k, fn) if (lo <= (k) && (k) < hi) { fn(*get_params(), lds); if ((k) == REPEAT_PHASE) { GRID_SYNC(k); fn(*get_params(), lds); } if ((k) + 1 < hi) GRID_SYNC(k); }
  RUN_PHASE(0, phase0)
  RUN_PHASE(1, phase1)
  RUN_PHASE(2, phase2)
  RUN_PHASE(3, phase3)
  RUN_PHASE(4, phase4)
  RUN_PHASE(5, phase5)
  RUN_PHASE(6, phase6)
  RUN_PHASE(7, phase7)
  RUN_PHASE(8, phase8)
  RUN_PHASE(9, phase9)
#undef GRID_SYNC
#undef RUN_PHASE
}

extern "C" void kernel_launch(void* const* d_in, const int* in_sizes, int n_in, void* d_out, int out_size, void* d_ws, size_t ws_size, hipStream_t stream) {
  static int grid = 0;
  if (grid == 0) {
    if (n_in != 24 || out_size != NTOK * DM || ws_size < WS_END) { fprintf(stderr, "kernel_launch: unexpected problem (n_in %d out %d ws %zu)\n", n_in, out_size, ws_size); grid = -1; return; }
    (void)hipFuncSetAttribute((const void*)fwd_kernel, hipFuncAttributeMaxDynamicSharedMemorySize, LDS_BYTES);
    int dev = 0, cus = 0, per_cu = 0;
    (void)hipGetDevice(&dev);
    (void)hipDeviceGetAttribute(&cus, hipDeviceAttributeMultiprocessorCount, dev);
    (void)hipOccupancyMaxActiveBlocksPerMultiprocessor(&per_cu, (const void*)fwd_kernel, NTHR, LDS_BYTES);
    if (per_cu < 1 || cus < 256) fprintf(stderr, "kernel_launch: occupancy %d blocks/CU on %d CUs\n", per_cu, cus);
    grid = 256;
  }
  if (grid < 0) return;
  (void)hipMemsetAsync((char*)d_ws + WS_CNT, 0, CTL_ZERO_BYTES, stream);
  Params p{};
  for (int i = 0; i < 24; ++i) p.in[i] = (const float*)d_in[i];
  p.out = (float*)d_out; p.ws = (unsigned char*)d_ws;
#if N_LAUNCH_MODE == 1
  p.ph_lo = 0; p.ph_hi = NPHASE;
  void* args[] = {&p};
  hipError_t e = hipLaunchCooperativeKernel((const void*)fwd_kernel, dim3(grid), dim3(NTHR), args, LDS_BYTES, stream);
  if (e != hipSuccess) fprintf(stderr, "cooperative launch failed: %s\n", hipGetErrorString(e));
#else
  for (int ph = 0; ph < NPHASE; ++ph) {
    p.ph_lo = ph; p.ph_hi = ph + 1;
    hipLaunchKernelGGL(fwd_kernel, dim3(grid), dim3(NTHR), LDS_BYTES, stream, p);
  }
#endif
}
```

```cpp
#include <hip/hip_runtime.h>
#include <cstdio>
#include <cstdint>

#ifndef N_LAUNCH_MODE
#define N_LAUNCH_MODE 1
#endif

#define DEVI __device__ __forceinline__
#define LDS __attribute__((address_space(3)))

typedef _Float16 h16;
typedef _Float16 h16x4 __attribute__((ext_vector_type(4)));
typedef _Float16 h16x8 __attribute__((ext_vector_type(8)));
typedef float f32x4 __attribute__((ext_vector_type(4)));
typedef float f32x16 __attribute__((ext_vector_type(16)));
typedef unsigned u32x2 __attribute__((ext_vector_type(2)));
typedef unsigned u32x4 __attribute__((ext_vector_type(4)));

constexpr int NBATCH = 4, SEQ = 8192, NTOK = NBATCH * SEQ, DM = 1024;
constexpr int NTHR = 512;
constexpr int NPHASE = 10;
constexpr int LDS_BYTES = 163840;

constexpr size_t MiB = 1ull << 20;
constexpr size_t WS_CNT = 0;
constexpr size_t CTL_ZERO_BYTES = 20480;
constexpr size_t WS_BAR = 4096;
constexpr size_t WS_MODP = 64 * 1024;
constexpr size_t WS_ROPE = 1 * MiB;
constexpr size_t WS_WIN = 3 * MiB;
constexpr size_t WS_WOUT = 10 * MiB;
constexpr size_t WS_WGU = 12 * MiB;
constexpr size_t WS_WDN = 44 * MiB;
constexpr size_t WS_WRG = 60 * MiB;
constexpr size_t WS_WRH = 60 * MiB + 512 * 1024;
constexpr size_t WS_WRL = 60 * MiB + 640 * 1024;
constexpr size_t WS_AGG = 61 * MiB;
constexpr size_t WS_ROUTE = 63 * MiB;
constexpr size_t WS_LIST = 64 * MiB;
constexpr size_t WS_LISTW = 68 * MiB;
constexpr size_t WS_WI = 72 * MiB;
constexpr size_t WS_KI = 73 * MiB;
constexpr size_t WS_MASK = 77 * MiB;
constexpr size_t WS_H = 109 * MiB;
constexpr size_t WS_Q = 173 * MiB;
constexpr size_t WS_K = 205 * MiB;
constexpr size_t WS_VT = 237 * MiB;
constexpr size_t WS_QI = 269 * MiB;
constexpr size_t WS_XR = 301 * MiB;
constexpr size_t WS_XG = 333 * MiB;
constexpr size_t WS_MIX = 365 * MiB;
constexpr size_t WS_ACT = 429 * MiB;
constexpr size_t WS_YP = 173 * MiB;
constexpr size_t WS_END = 510 * MiB;
constexpr size_t SC_BATCH_BYTES = 8192ull * 6176ull;
static_assert(SC_BATCH_BYTES <= 64 * MiB && WS_MIX + 3 * SC_BATCH_BYTES <= WS_END, "score slots");

struct Params { const float* in[24]; float* out; unsigned char* ws; int ph_lo, ph_hi; };
typedef const __attribute__((address_space(4))) Params& PRef;
typedef const __attribute__((address_space(4))) Params* PPtr;

__device__ const double ROPE_REV[32] = {
  1.59154943091895345608e-01, 1.19349370211248861917e-01, 8.94994016088910132600e-02, 6.71150830052272551196e-02,
  5.03292121044870352509e-02, 3.77415847174197710556e-02, 2.83021958306233986646e-02, 2.12236527647776604399e-02,
  1.59154943091895338669e-02, 1.19349370211248861917e-02, 8.94994016088910236684e-03, 6.71150830052272533849e-03,
  5.03292121044870369856e-03, 3.77415847174197719230e-03, 2.83021958306233986646e-03, 2.12236527647776621747e-03,
  1.59154943091895356017e-03, 1.19349370211248848907e-03, 8.94994016088910236684e-04, 6.71150830052272598901e-04,
  5.03292121044870326488e-04, 3.77415847174197740914e-04, 2.83021958306233954120e-04, 2.12236527647776605484e-04,
  1.59154943091895350596e-04, 1.19349370211248862459e-04, 8.94994016088910182474e-05, 6.71150830052272544691e-05,
  5.03292121044870353593e-05, 3.77415847174197768019e-05, 2.83021958306233960897e-05, 2.12236527647776591931e-05};

DEVI int launder(int x) { asm volatile("" : "+v"(x)); return x; }
DEVI PPtr get_params() { PPtr k = (PPtr)__builtin_amdgcn_kernarg_segment_ptr(); asm volatile("" : "+s"(k)); return k; }
DEVI int wave_id(int tid) { return __builtin_amdgcn_readfirstlane(tid >> 6); }
DEVI f32x16 mfma16(h16x8 a, h16x8 b, f32x16 c) { return __builtin_amdgcn_mfma_f32_32x32x16_f16(a, b, c, 0, 0, 0); }
DEVI float wave_sum(float v) {
#pragma unroll
  for (int o = 1; o < 64; o <<= 1) v += __shfl_xor(v, o);
  return v;
}
DEVI float sigmoid_f(float x) { return __builtin_amdgcn_rcpf(1.f + __expf(-x)); }
DEVI float silu_f(float x) { return x * __builtin_amdgcn_rcpf(1.f + __expf(-x)); }
DEVI float gelu_tanh_f(float x) {
  const float u = 0.7978845608028654f * (x + 0.044715f * x * x * x);
  const float t = 1.f - 2.f * __builtin_amdgcn_rcpf(1.f + __expf(2.f * u));
  return 0.5f * x * (1.f + t);
}
DEVI unsigned fkey(float f) { unsigned u = __float_as_uint(f); return (u & 0x80000000u) ? ~u : (u | 0x80000000u); }
DEVI float fkey_inv(unsigned k) { unsigned u = (k & 0x80000000u) ? (k & 0x7fffffffu) : ~k; return __uint_as_float(u); }
DEVI int vt_perm(int pos) { return (pos & ~12) | ((pos & 4) << 1) | ((pos & 8) >> 1); }

DEVI void mod_to_lds(PRef p, int b, int chunk, LDS float* dst) {
  const float* mp = (const float*)(p.ws + WS_MODP);
  for (int k = threadIdx.x; k < 1024; k += NTHR) {
    const int j = chunk * 1024 + k;
    float v[8];
#pragma unroll
    for (int ks = 0; ks < 8; ++ks) v[ks] = mp[(size_t)(ks * 4 + b) * 6144 + j];
    float s = p.in[3][j];
#pragma unroll
    for (int ks = 0; ks < 8; ++ks) s += v[ks];
    dst[k] = s;
  }
}

constexpr int LROW = 144;

namespace g8 {
constexpr int BM = 256, BK = 64, HALF = 128, HTB = HALF * BK * 2, STAGE_BYTES = 8 * HTB;
DEVI int lds_byte(int r, int c) { const int st = (r >> 4) * 2 + (c >> 5), rr = r & 15, cc = c & 31, ob = rr * 64 + cc * 2; return st * 1024 + (ob ^ (((ob >> 9) & 1) << 5)); }
DEVI void stage_rc(int b, int& R, int& C) { const int st = b / 1024, sb = b % 1024, swz = sb ^ (((sb >> 9) & 1) << 5); R = (st >> 1) * 16 + swz / 64; C = (st & 1) * 32 + (swz % 64) / 2; }
struct Unit { const char* A; unsigned va[2][2]; const char* B; int pm, pn, e, cnt, off; };
DEVI void glds16(const char* src, LDS unsigned char* dst) { __builtin_amdgcn_global_load_lds((const unsigned*)src, (LDS unsigned*)dst, 16, 0, 0); }

DEVI void dense_va(unsigned (&va)[2][2], int K) {
  const int tid = threadIdx.x;
#pragma unroll
  for (int h = 0; h < 2; ++h)
#pragma unroll
    for (int i = 0; i < 2; ++i) { int R, C; stage_rc(tid * 16 + i * 8192, R, C); va[h][i] = (unsigned)((128 * h + R) * K + C) * 2u; }
}
template <class Sched, class Epi>
DEVI void gemm_phase(LDS unsigned char* lds, int K, const Sched& S, const Epi& E) {
  const int tid = launder((int)threadIdx.x), wid = wave_id(tid), lane = tid & 63, wr = wid >> 2, wc = wid & 3, fr = lane & 15, fq = lane >> 4;
  const int nt = launder(K) / BK;
  unsigned vb[2];
#pragma unroll
  for (int i = 0; i < 2; ++i) { int R, C; stage_rc(tid * 16 + i * 8192, R, C); vb[i] = (unsigned)(R * K + C) * 2u; }
  const size_t kstep = (size_t)(BK * 2), hstep = (size_t)HALF * K * 2;
  const unsigned ldsw = (unsigned)wid * 1024u;
  const int aoff = lds_byte(wr * 64 + fr, fq * 8), boff = lds_byte(wc * 32 + fr, fq * 8);
#define G8_SA(b, h) (((b) * 2 + (h)) * HTB)
#define G8_SB(b, h) ((4 + (b) * 2 + (h)) * HTB)
#define G8_STAGE(bufoff, gbase, v) do { glds16((gbase) + (v)[0], lds + (bufoff) + ldsw); glds16((gbase) + (v)[1], lds + (bufoff) + ldsw + 8192); } while (0)
#define G8_STAGEA(bufoff, gbase, h) do { glds16((gbase) + G8_VAC(h, 0), lds + (bufoff) + ldsw); glds16((gbase) + G8_VAC(h, 1), lds + (bufoff) + ldsw + 8192); } while (0)
#define G8_LDA(dst, b, h) do { _Pragma("unroll") for (int m = 0; m < 4; ++m) _Pragma("unroll") for (int k = 0; k < 2; ++k) dst[m][k] = *(const LDS h16x8*)(lds + G8_SA(b, h) + aoff + m * 2048 + k * 1024); } while (0)
#define G8_LDB(dst, b, h) do { _Pragma("unroll") for (int n = 0; n < 2; ++n) _Pragma("unroll") for (int k = 0; k < 2; ++k) dst[n][k] = *(const LDS h16x8*)(lds + G8_SB(b, h) + boff + n * 2048 + k * 1024); } while (0)
#define G8_MMA(ai, bj, At, Bt) do { __builtin_amdgcn_s_setprio(1); _Pragma("unroll") for (int m = 0; m < 4; ++m) _Pragma("unroll") for (int n = 0; n < 2; ++n) _Pragma("unroll") for (int k = 0; k < 2; ++k) \
        acc[ai][bj][m][n] = __builtin_amdgcn_mfma_f32_16x16x32_f16(Bt[n][k], At[m][k], acc[ai][bj][m][n], 0, 0, 0); __builtin_amdgcn_s_setprio(0); } while (0)
#define G8_WAIT_V(n) asm volatile("s_waitcnt vmcnt(" #n ")" ::: "memory")
#define G8_WAIT_L(n) asm volatile("s_waitcnt lgkmcnt(" #n ")" ::: "memory")
#define G8_BAR __builtin_amdgcn_s_barrier()
#define G8_SCHED __builtin_amdgcn_sched_barrier(0)
  Unit cur, nxt; int ui = 0;
  if (!S.next(0, cur)) return;
  unsigned vd[2][2];
  if (!Sched::GATHER) dense_va(vd, K);
#define G8_VAC(h, i) (Sched::GATHER ? cur.va[h][i] : vd[h][i])
#define G8_VAN(h, i) (Sched::GATHER ? nxt.va[h][i] : vd[h][i])
  f32x4 acc[2][2][4][2];
#pragma unroll
  for (int a = 0; a < 2; ++a)
#pragma unroll
    for (int b = 0; b < 2; ++b)
#pragma unroll
      for (int m = 0; m < 4; ++m)
#pragma unroll
        for (int n = 0; n < 2; ++n) acc[a][b][m][n] = (f32x4){0.f, 0.f, 0.f, 0.f};
  h16x8 At[4][2], B0[2][2], B1[2][2];
  const char* cA = cur.A; const char* cB = cur.B;
  G8_STAGE(G8_SB(0, 0), cB, vb); G8_STAGE(G8_SB(0, 1), cB + hstep, vb); G8_STAGEA(G8_SA(0, 0), cA, 0); G8_STAGEA(G8_SA(0, 1), cA, 1);
  if (wr == 1) G8_BAR;
  G8_WAIT_V(2); G8_BAR;
  G8_STAGE(G8_SB(1, 0), cB + kstep, vb); G8_STAGEA(G8_SA(1, 0), cA + kstep, 0); G8_STAGE(G8_SB(1, 1), cB + hstep + kstep, vb);
  G8_WAIT_V(6); G8_BAR;
  for (;;) {
    const bool has_next = S.next(ui + 1, nxt);
    if (!has_next) nxt = cur;
    const char* nA = nxt.A; const char* nB = nxt.B;
#pragma unroll 1
    for (int t = 0; t < nt; t += 2) {
      const bool last = (t == nt - 2);
      const char* a1 = cA + (size_t)(t + 1) * kstep;
      const char* a2 = last ? nA : cA + (size_t)(t + 2) * kstep; const char* b2 = last ? nB : cB + (size_t)(t + 2) * kstep;
      const char* a3 = a2 + kstep; const char* b3 = b2 + kstep;
#define G8_STAGE2(bufoff, gbase, h) do { glds16((gbase) + (last ? G8_VAN(h, 0) : G8_VAC(h, 0)), lds + (bufoff) + ldsw); glds16((gbase) + (last ? G8_VAN(h, 1) : G8_VAC(h, 1)), lds + (bufoff) + ldsw + 8192); } while (0)
      G8_LDB(B0, 0, 0); G8_LDB(B1, 0, 1); G8_SCHED; G8_LDA(At, 0, 0); G8_STAGEA(G8_SA(1, 1), a1, 1);
      G8_WAIT_V(8); G8_WAIT_L(0); G8_BAR; G8_MMA(0, 0, At, B0); G8_MMA(0, 1, At, B1); G8_BAR; G8_SCHED;
      G8_LDA(At, 0, 1); G8_STAGE(G8_SB(0, 0), b2, vb); G8_STAGE(G8_SB(0, 1), b2 + hstep, vb); G8_STAGE2(G8_SA(0, 0), a2, 0);
      G8_WAIT_V(8); G8_WAIT_L(0); G8_BAR; G8_MMA(1, 0, At, B0); G8_MMA(1, 1, At, B1); G8_BAR; G8_SCHED;
      G8_LDB(B0, 1, 0); G8_LDB(B1, 1, 1); G8_SCHED; G8_LDA(At, 1, 0); G8_STAGE2(G8_SA(0, 1), a2, 1);
      G8_WAIT_V(8); G8_WAIT_L(0); G8_BAR; G8_MMA(0, 0, At, B0); G8_MMA(0, 1, At, B1); G8_BAR; G8_SCHED;
      G8_LDA(At, 1, 1); G8_STAGE(G8_SB(1, 0), b3, vb); G8_STAGE(G8_SB(1, 1), b3 + hstep, vb); G8_STAGE2(G8_SA(1, 0), a3, 0);
      G8_WAIT_V(8); G8_WAIT_L(0); G8_BAR; G8_MMA(1, 0, At, B0); G8_MMA(1, 1, At, B1); G8_BAR; G8_SCHED;
    }
#undef G8_STAGE2
    if (wr == 0) G8_BAR;
    E(acc, cur, wr, wc, fr, fq);
    if (!has_next) break;
#pragma unroll
    for (int a = 0; a < 2; ++a)
#pragma unroll
      for (int b = 0; b < 2; ++b)
#pragma unroll
        for (int m = 0; m < 4; ++m)
#pragma unroll
          for (int n = 0; n < 2; ++n) acc[a][b][m][n] = (f32x4){0.f, 0.f, 0.f, 0.f};
    cur = nxt; cA = nA; cB = nB; ++ui;
    if (wr == 1) G8_BAR;
  }
  G8_WAIT_V(0);
  G8_BAR;
#undef G8_SA
#undef G8_STAGEA
#undef G8_VAC
#undef G8_VAN
#undef G8_SB
#undef G8_STAGE
#undef G8_LDA
#undef G8_LDB
#undef G8_MMA
#undef G8_WAIT_V
#undef G8_WAIT_L
#undef G8_BAR
#undef G8_SCHED
}
struct DenseOrder {
  static constexpr bool GATHER = false;
  const h16* A; const h16* Bt; int K, nM, nN, G, c;
  DEVI bool next(int i, Unit& u) const {
    const int nwg = nM * nN; const long L = (long)i * G + c; if (L >= nwg) return false;
    int wgid = (int)L; { const int q = nwg / 8, r = nwg % 8, xcd = wgid % 8, off = wgid / 8; wgid = (xcd < r ? xcd * (q + 1) : r * (q + 1) + (xcd - r) * q) + off; }
    const int nig = 8 * nN, gid = wgid / nig, fm = gid * 8, gsz = (nM - fm) < 8 ? (nM - fm) : 8;
    u.pm = fm + ((wgid % nig) % gsz); u.pn = (wgid % nig) / gsz; u.e = 0; u.cnt = 0x7fffffff; u.off = 0;
    u.A = (const char*)(A + (size_t)u.pm * 256 * K); u.B = (const char*)(Bt + (size_t)u.pn * 256 * K);
    u.va[0][0] = u.va[0][1] = u.va[1][0] = u.va[1][1] = 0u;
    return true;
  }
};
}


DEVI h16x4 pack4(float a, float b, float c, float d) { h16x4 v; v[0] = (h16)a; v[1] = (h16)b; v[2] = (h16)c; v[3] = (h16)d; return v; }

template <class F>
DEVI void transpose_item(const float* src, int N, int kb, int nb, h16* dst, int ldd, F drow, LDS float* scr, int lane) {
#pragma unroll 8
  for (int i = 0; i < 32; ++i) {
    const int kk = 2 * i + (lane >> 5), n = nb * 32 + (lane & 31);
    scr[kk * 33 + (lane & 31)] = (n < N) ? src[(size_t)(kb * 64 + kk) * N + n] : 0.f;
  }
  asm volatile("s_waitcnt lgkmcnt(0)" ::: "memory");
  const int c = lane & 7;
#pragma unroll
  for (int j = 0; j < 4; ++j) {
    const int nl = (lane >> 3) + 8 * j, n = nb * 32 + nl;
    h16x8 v;
#pragma unroll
    for (int e = 0; e < 8; ++e) v[e] = (h16)scr[(c * 8 + e) * 33 + nl];
    if (n < N) *(h16x8*)(dst + (size_t)drow(n) * ldd + kb * 64 + c * 8) = v;
  }
  asm volatile("s_waitcnt lgkmcnt(0)" ::: "memory");
}

DEVI void phase0(PRef p, LDS unsigned char* lds) {
  const int tid = launder((int)threadIdx.x), lane = tid & 63, wave = wave_id(tid), G = gridDim.x;
  const int gw = blockIdx.x * 8 + wave, NW = G * 8;
  {
    const float* c = p.in[1]; const float* wada = p.in[2]; float* mp = (float*)(p.ws + WS_MODP);
    for (int u = gw; u < 96 * 8; u += NW) {
      const int cgp = u % 96, ks = u / 96, j = cgp * 64 + lane;
      float a0 = 0.f, a1 = 0.f, a2 = 0.f, a3 = 0.f;
      for (int k0 = ks * 128; k0 < ks * 128 + 128; k0 += 16) {
        float w[16];
#pragma unroll
        for (int u = 0; u < 16; ++u) w[u] = wada[(size_t)(k0 + u) * 6144 + j];
#pragma unroll
        for (int u = 0; u < 16; ++u) {
          const int k = k0 + u;
          a0 = fmaf(silu_f(c[k]), w[u], a0); a1 = fmaf(silu_f(c[1024 + k]), w[u], a1);
          a2 = fmaf(silu_f(c[2048 + k]), w[u], a2); a3 = fmaf(silu_f(c[3072 + k]), w[u], a3);
        }
      }
      mp[(size_t)(ks * 4 + 0) * 6144 + j] = a0; mp[(size_t)(ks * 4 + 1) * 6144 + j] = a1;
      mp[(size_t)(ks * 4 + 2) * 6144 + j] = a2; mp[(size_t)(ks * 4 + 3) * 6144 + j] = a3;
    }
  }
  {
    LDS float* scr = (LDS float*)lds + wave * (64 * 33);
    constexpr int I_IN = 16 * 99, I_OUT = 16 * 32, I_G = 32 * 128, I_U = 32 * 128, I_D = 32 * 128, I_RG = 32;
    constexpr int NIT = I_IN + I_OUT + I_G + I_U + I_D + I_RG;
    for (int it = gw; it < NIT; it += NW) {
      int r = it;
      if (r < I_IN) {
        transpose_item(p.in[8], 3144, r / 99, r % 99, (h16*)(p.ws + WS_WIN), 1024,
                       [](int n) { const int dl = n < 2112 ? n : (n < 2120 ? 3136 + (n - 2112) : (n < 2632 ? 2112 + (n - 2120) : 2624 + (n - 2632)));
                                     const int d = dl & 63, sx = (dl >> 6) & 3;
                                     return (dl & ~255) + 128 * (d >> 5) + 32 * sx + 16 * ((d >> 2) & 1) + 4 * ((d >> 3) & 3) + (d & 3); }, scr, lane);
        continue;
      }
      r -= I_IN;
      if (r < I_OUT) { transpose_item(p.in[16], 1024, r / 32, r % 32, (h16*)(p.ws + WS_WOUT), 1024, [](int n) { return (n & ~31) + 16 * ((n >> 2) & 1) + 4 * ((n >> 3) & 3) + (n & 3); }, scr, lane); continue; }
      r -= I_OUT;
      if (r < I_G) { const int e = r >> 7, q = r & 127;
        transpose_item(p.in[21] + (size_t)e * 1024 * 256, 256, q >> 3, q & 7, (h16*)(p.ws + WS_WGU) + (size_t)e * 512 * 1024, 1024, [](int f) { return (f >> 4) * 32 + (f & 15); }, scr, lane); continue; }
      r -= I_G;
      if (r < I_U) { const int e = r >> 7, q = r & 127;
        transpose_item(p.in[22] + (size_t)e * 1024 * 256, 256, q >> 3, q & 7, (h16*)(p.ws + WS_WGU) + (size_t)e * 512 * 1024, 1024, [](int f) { return (f >> 4) * 32 + 16 + (f & 15); }, scr, lane); continue; }
      r -= I_U;
      if (r < I_D) { const int e = r >> 7, q = r & 127;
        transpose_item(p.in[23] + (size_t)e * 256 * 1024, 1024, q >> 5, q & 31, (h16*)(p.ws + WS_WDN) + (size_t)e * 1024 * 256, 256, [](int n) { return (n & ~31) + 16 * ((n >> 2) & 1) + 4 * ((n >> 3) & 3) + (n & 3); }, scr, lane); continue; }
      r -= I_D;
      if (r < 16) transpose_item(p.in[11] + (size_t)(r >> 1) * 4096, 64, 0, r & 1, (h16*)(p.ws + WS_WRG) + (size_t)(r >> 1) * 128 * 64, 64, [](int n) { return n; }, scr, lane);
      else transpose_item(p.in[13] + (size_t)((r - 16) >> 1) * 4096, 64, 0, r & 1, (h16*)(p.ws + WS_WRG) + (size_t)((r - 16) >> 1) * 128 * 64, 64, [](int n) { return 64 + n; }, scr, lane);
    }
  }
  {
    h16* wrh = (h16*)(p.ws + WS_WRH); h16* wrl = (h16*)(p.ws + WS_WRL);
    for (int i = blockIdx.x * NTHR + tid; i < 48 * 1024; i += G * NTHR) {
      const int col = i >> 10, k = i & 1023;
      const float w = (col < 4) ? p.in[17][k * 4 + col] : (col < 36 ? p.in[19][k * 32 + (col - 4)] : 0.f);
      const h16 hi = (h16)w;
      wrh[i] = hi; wrl[i] = (h16)(w - (float)hi);
    }
    float* ct = (float*)(p.ws + WS_ROPE); float* st = ct + 8192 * 32;
    for (int i = blockIdx.x * NTHR + tid; i < 8192 * 32; i += G * NTHR) {
      const int pos = i >> 5, f = i & 31;
      const double rev = (double)pos * ROPE_REV[f];
      const float fr = (float)(rev - __builtin_rint(rev));
      ct[i] = __builtin_amdgcn_cosf(fr); st[i] = __builtin_amdgcn_sinf(fr);
    }
  }
}

DEVI void phase1(PRef p, LDS unsigned char* lds) {
  const int tid = launder((int)threadIdx.x), lane = tid & 63, wave = wave_id(tid), G = gridDim.x;
  const int b = blockIdx.x & 3, bi = blockIdx.x >> 2, nbk = G >> 2;
  LDS float* mv = (LDS float*)lds;
  mod_to_lds(p, b, 0, mv); mod_to_lds(p, b, 1, mv + 1024);
  __syncthreads();
  f32x4 A[4], SH[4];
#pragma unroll
  for (int j = 0; j < 4; ++j) {
    const int k = 256 * j + 4 * lane;
    const f32x4 g = *(const f32x4*)(p.in[4] + k);
    A[j] = g * (*(LDS f32x4*)(mv + 1024 + k) + 1.f);
    SH[j] = *(LDS f32x4*)(mv + k);
  }
  const float* x = p.in[0]; h16* H = (h16*)(p.ws + WS_H);
  f32x4 vn[4];
  {
    const size_t tok = (size_t)b * SEQ + bi * 8 + wave;
#pragma unroll
    for (int j = 0; j < 4; ++j) vn[j] = *(const f32x4*)(x + tok * DM + 256 * j + 4 * lane);
  }
  for (int r = bi * 8 + wave; r < SEQ; r += nbk * 8) {
    const size_t tok = (size_t)b * SEQ + r;
    f32x4 v[4]; float ss = 0.f;
#pragma unroll
    for (int j = 0; j < 4; ++j) { v[j] = vn[j]; ss += v[j][0] * v[j][0] + v[j][1] * v[j][1] + v[j][2] * v[j][2] + v[j][3] * v[j][3]; }
    if (r + nbk * 8 < SEQ) {
#pragma unroll
      for (int j = 0; j < 4; ++j) vn[j] = *(const f32x4*)(x + (tok + nbk * 8) * DM + 256 * j + 4 * lane);
    }
    const float rstd = 1.0f / sqrtf(wave_sum(ss) * (1.f / 1024.f) + 1e-6f);
#pragma unroll
    for (int j = 0; j < 4; ++j) {
      const f32x4 y = v[j] * rstd * A[j] + SH[j];
      *(h16x4*)(H + tok * DM + 256 * j + 4 * lane) = pack4(y[0], y[1], y[2], y[3]);
    }
  }
}

DEVI h16x8 pack8(const f32x4& a, const f32x4& b) { h16x8 w; w[0] = (h16)a[0]; w[1] = (h16)a[1]; w[2] = (h16)a[2]; w[3] = (h16)a[3]; w[4] = (h16)b[0]; w[5] = (h16)b[1]; w[6] = (h16)b[2]; w[7] = (h16)b[3]; return w; }
struct EpiInProj {
  unsigned char* ws;
  DEVI void operator()(const f32x4 (&acc)[2][2][4][2], const g8::Unit& u, int wr, int wc, int fr, int fq) const {
    const float* cosT = (const float*)(ws + WS_ROPE); const float* sinT = cosT + 8192 * 32;
    const int g = 4 * u.pn + wc;
    if (g > 49) return;
    const int d0 = 8 * fq;
    const int tok0 = u.pm * 256 + 64 * wr + fr;
    if (g < 16 || (g >= 24 && g <= 32)) {
      float scl; h16* dst; int ld;
      if (g < 8) { scl = 0.125f * 1.4426950408889634f; dst = (h16*)(ws + WS_Q) + g * 64; ld = 512; }
      else if (g < 16) { scl = 1.f; dst = (h16*)(ws + WS_K) + (g - 8) * 64; ld = 512; }
      else if (g < 32) { scl = 0.125f; dst = (h16*)(ws + WS_QI) + (g - 24) * 64; ld = 512; }
      else { scl = 1.f; dst = (h16*)(ws + WS_KI); ld = 64; }
#pragma unroll
      for (int ai = 0; ai < 2; ++ai) {
        f32x4 ca[4], cb[4], sa[4], sb[4];
#pragma unroll
        for (int m = 0; m < 4; ++m) {
          const int pos = (tok0 + 128 * ai + 16 * m) & 8191;
          ca[m] = *(const f32x4*)(cosT + pos * 32 + d0); cb[m] = *(const f32x4*)(cosT + pos * 32 + d0 + 4);
          sa[m] = *(const f32x4*)(sinT + pos * 32 + d0); sb[m] = *(const f32x4*)(sinT + pos * 32 + d0 + 4);
        }
        __builtin_amdgcn_sched_barrier(0);
#pragma unroll
        for (int m = 0; m < 4; ++m) {
          const int tok = tok0 + 128 * ai + 16 * m;
          const f32x4 xa = acc[ai][0][m][0], xb = acc[ai][0][m][1], ya = acc[ai][1][m][0], yb = acc[ai][1][m][1];
          h16* o = dst + (size_t)tok * ld;
          *(h16x8*)(o + d0) = pack8((xa * ca[m] - ya * sa[m]) * scl, (xb * cb[m] - yb * sb[m]) * scl);
          *(h16x8*)(o + 32 + d0) = pack8((ya * ca[m] + xa * sa[m]) * scl, (yb * cb[m] + xb * sb[m]) * scl);
        }
      }
    } else if (g < 24) {
#pragma unroll
      for (int ai = 0; ai < 2; ++ai)
#pragma unroll
        for (int m = 0; m < 4; ++m) {
          const int tok = tok0 + 128 * ai + 16 * m;
          const int b = tok >> 13, pos = tok & 8191;
          const f32x4 xa = acc[ai][0][m][0], xb = acc[ai][0][m][1], ya = acc[ai][1][m][0], yb = acc[ai][1][m][1];
          h16* vt = (h16*)(ws + WS_VT) + (size_t)(b * 8 + (g - 16)) * 64 * 8192 + vt_perm(pos);
#pragma unroll
          for (int e = 0; e < 4; ++e) {
            vt[(size_t)(d0 + e) * 8192] = (h16)xa[e]; vt[(size_t)(d0 + 4 + e) * 8192] = (h16)xb[e];
            vt[(size_t)(32 + d0 + e) * 8192] = (h16)ya[e]; vt[(size_t)(36 + d0 + e) * 8192] = (h16)yb[e];
          }
        }
    } else if (g < 49) {
      h16* dst = (g < 41) ? (h16*)(ws + WS_XR) + (g - 33) * 64 : (h16*)(ws + WS_XG) + (g - 41) * 64;
#pragma unroll
      for (int ai = 0; ai < 2; ++ai)
#pragma unroll
        for (int m = 0; m < 4; ++m) {
          h16* o = dst + (size_t)(tok0 + 128 * ai + 16 * m) * 512;
          *(h16x8*)(o + d0) = pack8(acc[ai][0][m][0], acc[ai][0][m][1]);
          *(h16x8*)(o + 32 + d0) = pack8(acc[ai][1][m][0], acc[ai][1][m][1]);
        }
    } else if (fq == 0) {
      const float sc = 0.35355339059327373f;
#pragma unroll
      for (int ai = 0; ai < 2; ++ai)
#pragma unroll
        for (int m = 0; m < 4; ++m) {
          float* wi = (float*)(ws + WS_WI) + (size_t)(tok0 + 128 * ai + 16 * m) * 8;
          *(f32x4*)wi = acc[ai][0][m][0] * sc; *(f32x4*)(wi + 4) = acc[ai][0][m][1] * sc;
        }
    }
  }
};

DEVI void phase2(PRef p, LDS unsigned char* lds) {
  g8::DenseOrder S{(const h16*)(p.ws + WS_H), (const h16*)(p.ws + WS_WIN), DM, 128, 13, (int)gridDim.x, (int)blockIdx.x};
  EpiInProj E{p.ws};
  g8::gemm_phase(lds, DM, S, E);
}

constexpr int CROW = 1040;
constexpr int RNN_XG = 64 * CROW;
constexpr int RNN_CARRY = 2 * 64 * CROW;
template <int MODE>
DEVI void rnn_item(PRef p, LDS unsigned char* lds, int b, int cr) {
  const int tid = launder((int)threadIdx.x), lane = tid & 63, wave = wave_id(tid), l31 = lane & 31, half = lane >> 5;
  const h16* XR = (const h16*)(p.ws + WS_XR);
  {
    const int chg = tid & 63, tg = tid >> 6, pos0 = cr * 64 + 8 * tg;
    h16x8 xin[11];
#pragma unroll
    for (int i = 0; i < 11; ++i) {
      const int pos = pos0 + i - 3;
      if (pos >= 0) xin[i] = *(const h16x8*)(XR + ((size_t)b * SEQ + pos) * 512 + chg * 8);
      else {
#pragma unroll
        for (int e = 0; e < 8; ++e) xin[i][e] = (h16)0.f;
      }
    }
    float cw[4][8], cb[8];
#pragma unroll
    for (int e = 0; e < 8; ++e) {
      cb[e] = p.in[10][chg * 8 + e];
#pragma unroll
      for (int j = 0; j < 4; ++j) cw[j][e] = p.in[9][j * 512 + chg * 8 + e];
    }
#pragma unroll
    for (int tt = 0; tt < 8; ++tt) {
      h16x8 o;
#pragma unroll
      for (int e = 0; e < 8; ++e) {
        float v = cb[e];
#pragma unroll
        for (int j = 0; j < 4; ++j) v = fmaf(cw[j][e], (float)xin[tt + j][e], v);
        o[e] = (h16)v;
      }
      *(LDS h16x8*)(lds + (8 * tg + tt) * CROW + chg * 16) = o;
    }
  }
  if (MODE == 1) {
    const float2* ag = (const float2*)(p.ws + WS_AGG) + (size_t)b * 128 * 512 + tid;
    float carry = 0.f; int c2 = 0;
    for (; c2 + 8 <= cr; c2 += 8) {
      float2 v[8];
#pragma unroll
      for (int u = 0; u < 8; ++u) v[u] = ag[(size_t)(c2 + u) * 512];
#pragma unroll
      for (int u = 0; u < 8; ++u) carry = fmaf(v[u].x, carry, v[u].y);
    }
    for (; c2 < cr; ++c2) { const float2 v = ag[(size_t)c2 * 512]; carry = fmaf(v.x, carry, v.y); }
    ((LDS float*)(lds + RNN_CARRY))[tid] = carry;
  }
  if (MODE == 1) {
    const h16* XG = (const h16*)(p.ws + WS_XG) + ((size_t)b * SEQ + cr * 64) * 512;
#pragma unroll
    for (int i = 0; i < 8; ++i) { const int c = tid + NTHR * i, row = c >> 6, cc = c & 63; *(LDS h16x8*)(lds + RNN_XG + row * CROW + cc * 16) = *(const h16x8*)(XG + (size_t)row * 512 + cc * 8); }
  }
  __syncthreads();
  const int n = wave;
  const h16* WRG = (const h16*)(p.ws + WS_WRG) + (size_t)n * 128 * 64;
  float* AGG = (float*)(p.ws + WS_AGG);
#pragma unroll 1
  for (int dt = 0; dt < 2; ++dt) {
    h16x8 wa[4], wx[4];
#pragma unroll
    for (int kk = 0; kk < 4; ++kk) {
      wa[kk] = *(const h16x8*)(WRG + (size_t)(32 * dt + l31) * 64 + 16 * kk + 8 * half);
      wx[kk] = *(const h16x8*)(WRG + (size_t)(64 + 32 * dt + l31) * 64 + 16 * kk + 8 * half);
    }
    f32x16 ra[2], rx[2];
#pragma unroll
    for (int ti = 0; ti < 2; ++ti) {
#pragma unroll
      for (int r = 0; r < 16; ++r) { ra[ti][r] = 0.f; rx[ti][r] = 0.f; }
#pragma unroll
      for (int kk = 0; kk < 4; ++kk) {
        const h16x8 af = *(LDS h16x8*)(lds + (32 * ti + l31) * CROW + (n * 64 + 16 * kk + 8 * half) * 2);
        ra[ti] = mfma16(af, wa[kk], ra[ti]);
        rx[ti] = mfma16(af, wx[kk], rx[ti]);
      }
    }
    const int ch = n * 64 + 32 * dt + l31;
    const float ba = p.in[12][ch], bx = p.in[14][ch], lam = p.in[15][ch];
    const float c8 = -8.f * log1pf(__expf(-lam));
#pragma unroll
    for (int ti = 0; ti < 2; ++ti)
#pragma unroll
      for (int r = 0; r < 16; ++r) {
        const int tk = 32 * ti + (r & 3) + 8 * (r >> 2) + 4 * half;
        const float cv = (float)*(LDS h16*)(lds + tk * CROW + ch * 2);
        const float rr = sigmoid_f(ra[ti][r] + ba), ii = sigmoid_f(rx[ti][r] + bx);
        const float la = c8 * rr;
        ra[ti][r] = __expf(la);
        const float x2 = 2.f * la;
        const float om = -x2 * fmaf(x2 * 0.5f, fmaf(x2 * (1.f / 3.f), fmaf(x2 * 0.25f, fmaf(x2, 0.2f, 1.f), 1.f), 1.f), 1.f);
        rx[ti][r] = __builtin_amdgcn_sqrtf(om) * (ii * cv);
      }
    float P[8], Hs[8];
#pragma unroll
    for (int sg = 0; sg < 8; ++sg) {
      const int ti = sg >> 2, q = sg & 3;
      float pp = 1.f, hh = 0.f;
#pragma unroll
      for (int i = 0; i < 4; ++i) { const float a = ra[ti][4 * q + i], bb = rx[ti][4 * q + i]; hh = fmaf(a, hh, bb); pp *= a; }
      P[sg] = pp; Hs[sg] = hh;
    }
    float carry = 0.f, prod = 1.f;
    if (MODE == 1) carry = ((LDS float*)(lds + RNN_CARRY))[ch];
    float cin[8];
#pragma unroll
    for (int sg = 0; sg < 8; ++sg)
#pragma unroll
      for (int ow = 0; ow < 2; ++ow) {
        const float tmp = fmaf(P[sg], carry, Hs[sg]);
        const float tp = P[sg] * prod;
        if (half == ow) cin[sg] = carry;
        const float oth = __shfl_xor(tmp, 32), otp = __shfl_xor(tp, 32);
        carry = (half == ow) ? tmp : oth;
        prod = (half == ow) ? tp : otp;
      }
    if (MODE == 0) {
      if (half == 0) { float* ag = AGG + ((size_t)(b * 128 + cr) * 512 + ch) * 2; ag[0] = prod; ag[1] = carry; }
    } else {
#pragma unroll
      for (int sg = 0; sg < 8; ++sg) {
        const int ti = sg >> 2, q = sg & 3;
        float hh = cin[sg];
#pragma unroll
        for (int i = 0; i < 4; ++i) {
          hh = fmaf(ra[ti][4 * q + i], hh, rx[ti][4 * q + i]);
          LDS h16* xp = (LDS h16*)(lds + RNN_XG + (32 * ti + 8 * q + 4 * half + i) * CROW + ch * 2);
          *xp = (h16)(hh * gelu_tanh_f((float)*xp));
        }
      }
    }
  }
  __syncthreads();
  if (MODE == 1) {
    h16* Y = (h16*)(p.ws + WS_H) + ((size_t)b * SEQ + cr * 64) * DM + 512;
#pragma unroll
    for (int i = 0; i < 8; ++i) { const int c = tid + NTHR * i, row = c >> 6, cc = c & 63; *(h16x8*)(Y + (size_t)row * DM + cc * 8) = *(LDS h16x8*)(lds + RNN_XG + row * CROW + cc * 16); }
    __syncthreads();
  }
}

constexpr int IDX_NB = 256, IDX_CAP = 128;
constexpr int IL_HIST = 0, IL_CS = 65536, IL_CK = IL_CS + 64 * IDX_CAP * 4, IL_KI = IL_CK + 64 * IDX_CAP * 2, IL_KISZ = 128 * LROW, IL_ST = IL_KI + 2 * IL_KISZ;
static_assert(IL_ST + 4096 <= LDS_BYTES, "indexer LDS map");

DEVI f32x4 mfma16s(h16x8 a, h16x8 b, f32x4 c) { return __builtin_amdgcn_mfma_f32_16x16x32_f16(a, b, c, 0, 0, 0); }
DEVI void idx_score(LDS unsigned char* kit, int kh, int l15, int g4, const h16x8 (&qf)[8][2], const float (&wq)[8], f32x4 (&sc)[4]) {
  h16x8 kf[4][2];
#pragma unroll
  for (int kt = 0; kt < 4; ++kt)
#pragma unroll
    for (int ks = 0; ks < 2; ++ks) kf[kt][ks] = *(LDS h16x8*)(kit + (64 * kh + 16 * kt + l15) * LROW + (4 * ks + g4) * 16);
#pragma unroll
  for (int kt = 0; kt < 4; ++kt) sc[kt] = (f32x4){0.f, 0.f, 0.f, 0.f};
  f32x4 accA[4], accB[4];
#define IDX_MM(ACC, h) _Pragma("unroll") for (int kt = 0; kt < 4; ++kt) { ACC[kt] = mfma16s(kf[kt][0], qf[h][0], (f32x4){0.f, 0.f, 0.f, 0.f}); ACC[kt] = mfma16s(kf[kt][1], qf[h][1], ACC[kt]); }
#define IDX_RS(ACC, h) _Pragma("unroll") for (int kt = 0; kt < 4; ++kt) _Pragma("unroll") for (int r = 0; r < 4; ++r) sc[kt][r] = __builtin_fmaf(wq[h], __int_as_float(max(__float_as_int(ACC[kt][r]), 0)), sc[kt][r]);
  IDX_MM(accA, 0)
  IDX_MM(accB, 1) IDX_RS(accA, 0)
  IDX_MM(accA, 2) IDX_RS(accB, 1)
  IDX_MM(accB, 3) IDX_RS(accA, 2)
  IDX_MM(accA, 4) IDX_RS(accB, 3)
  IDX_MM(accB, 5) IDX_RS(accA, 4)
  IDX_MM(accA, 6) IDX_RS(accB, 5)
  IDX_MM(accB, 7) IDX_RS(accA, 6)
  IDX_RS(accB, 7)
#undef IDX_MM
#undef IDX_RS
}

template <int MODE>
DEVI void idx_pass(LDS unsigned char* lds, const h16* KIb, int N, int stride, int qg, int kh,
                   const h16* QIrow0, const float* WIrow0, float qinv, float qoff, int bstar, h16* scbase) {
  const int tid = launder((int)threadIdx.x), lane = tid & 63, l15 = lane & 15, g4 = lane >> 4;
  const int q = 16 * qg + l15;
  h16x8 qf[8][2]; float wq[8];
  {
    const h16* QI = QIrow0 + (size_t)q * 512;
#pragma unroll
    for (int h = 0; h < 8; ++h)
#pragma unroll
      for (int ks = 0; ks < 2; ++ks) qf[h][ks] = *(const h16x8*)(QI + h * 64 + 32 * ks + 8 * g4);
    const float* WI = WIrow0 + (size_t)q * 8;
#pragma unroll
    for (int h = 0; h < 8; ++h) wq[h] = WI[h];
#pragma unroll
    for (int h = 0; h < 8; ++h) { asm volatile("" : "+v"(qf[h][0])); asm volatile("" : "+v"(qf[h][1])); asm volatile("" : "+v"(wq[h])); }
  }
  LDS unsigned* hist = (LDS unsigned*)(lds + IL_HIST);
  LDS unsigned* st = (LDS unsigned*)(lds + IL_ST);
  const int nst = (N + 127) >> 7;
  const int lr = tid >> 3, lc = tid & 7;
  h16x8 r0, r1;
  r0 = *(const h16x8*)(KIb + (size_t)lr * 64 + lc * 8); r1 = *(const h16x8*)(KIb + (size_t)(lr + 64) * 64 + lc * 8);
  *(LDS h16x8*)(lds + IL_KI + lr * LROW + lc * 16) = r0; *(LDS h16x8*)(lds + IL_KI + (lr + 64) * LROW + lc * 16) = r1;
  __syncthreads();
  float vmin = INFINITY, vmax = -INFINITY;
  int cur = 0;
  for (int s = 0; s < nst; s += stride) {
    const int nx = s + stride;
    { const int nxc = nx < nst ? nx : s;
      r0 = *(const h16x8*)(KIb + (size_t)(128 * nxc + lr) * 64 + lc * 8); r1 = *(const h16x8*)(KIb + (size_t)(128 * nxc + lr + 64) * 64 + lc * 8); }
    const bool active = 128 * s + 64 * kh < N;
    f32x4 sc[4];
    if (active) {
      idx_score(lds + IL_KI + cur * IL_KISZ, kh, l15, g4, qf, wq, sc);
#pragma unroll
      for (int kt = 0; kt < 4; ++kt) asm volatile("" : "+v"(sc[kt]));
    }
    {
      *(LDS h16x8*)(lds + IL_KI + (cur ^ 1) * IL_KISZ + lr * LROW + lc * 16) = r0;
      *(LDS h16x8*)(lds + IL_KI + (cur ^ 1) * IL_KISZ + (lr + 64) * LROW + lc * 16) = r1;
    }
    if (active) {
      if (MODE == 0) {
#pragma unroll
        for (int kt = 0; kt < 4; ++kt)
#pragma unroll
          for (int r = 0; r < 4; ++r) { vmin = fminf(vmin, sc[kt][r]); vmax = fmaxf(vmax, sc[kt][r]); }
      } else if (MODE == 1) {
        h16* scp = scbase + ((size_t)((s * 2 + kh) * 4) * 1024 + q * 16 + 4 * g4);
#pragma unroll
        for (int kt = 0; kt < 4; ++kt) {
          const h16x4 hv = pack4(sc[kt][0], sc[kt][1], sc[kt][2], sc[kt][3]);
          *(h16x4*)(scp + kt * 1024) = hv;
#pragma unroll
          for (int r = 0; r < 4; ++r) {
            const float xb = fminf(fmaxf(__builtin_fmaf((float)hv[r], qinv, qoff), 0.f), (float)(IDX_NB - 1));
            const int bin = (int)xb;
            __hip_atomic_fetch_add(&hist[bin * 64 + q], 1u, __ATOMIC_RELAXED, __HIP_MEMORY_SCOPE_WORKGROUP);
          }
        }
      }
    }
    __syncthreads();
    cur ^= 1;
  }
  if (MODE == 0) {
    __hip_atomic_fetch_min(&st[q], fkey(vmin), __ATOMIC_RELAXED, __HIP_MEMORY_SCOPE_WORKGROUP);
    __hip_atomic_fetch_max(&st[64 + q], fkey(vmax), __ATOMIC_RELAXED, __HIP_MEMORY_SCOPE_WORKGROUP);
  }
}

DEVI int idx_bin(float sv, float qinv, float qoff) { return (int)fminf(fmaxf(__builtin_fmaf(sv, qinv, qoff), 0.f), (float)(IDX_NB - 1)); }
DEVI float idx_bin_lower_bound(int target, float qinv, float qoff) {
  if (target <= 0) return -INFINITY;
  if (target > IDX_NB - 1) return INFINITY;
  unsigned lo = 0x03FFu, hi = 0xFC00u;
  auto val = [](unsigned k) { const unsigned short hbits = (unsigned short)((k & 0x8000u) ? (k & 0x7FFFu) : (~k & 0xFFFFu)); return (float)__builtin_bit_cast(h16, hbits); };
  if (idx_bin(val(hi), qinv, qoff) < target) return INFINITY;
  while (lo < hi) { const unsigned mid = (lo + hi) >> 1; if (idx_bin(val(mid), qinv, qoff) >= target) hi = mid; else lo = mid + 1; }
  return val(lo);
}
DEVI void idx_stream_step(LDS unsigned char* lds, LDS unsigned* st, const unsigned long long (&cur)[4], int s, int kh, int q, int lane, int g4, float thi, float tlo) {
  unsigned nib = 0u;
#pragma unroll
  for (int kt = 3; kt >= 0; --kt) {
    const h16x4 hv = __builtin_bit_cast(h16x4, cur[kt]);
#pragma unroll
    for (int r = 3; r >= 0; --r) {
      const float sv = (float)hv[r];
      const unsigned long long ms = __builtin_amdgcn_ballot_w64(sv >= thi);
      asm("v_addc_co_u32_e64 %0, vcc, %0, %0, %1" : "+v"(nib) : "s"(ms) : "vcc");
      const bool cand = (sv >= tlo) && !(sv >= thi);
      if (__builtin_amdgcn_ballot_w64(cand) != 0ull) {
        if (cand) {
          const unsigned pos = __hip_atomic_fetch_add(&st[128 + q], 1u, __ATOMIC_RELAXED, __HIP_MEMORY_SCOPE_WORKGROUP);
          if (pos < (unsigned)IDX_CAP) {
            ((LDS float*)(lds + IL_CS))[q * IDX_CAP + pos] = sv;
            ((LDS unsigned short*)(lds + IL_CK))[q * IDX_CAP + pos] = (unsigned short)(128 * s + 64 * kh + 16 * kt + 4 * g4 + r);
          }
        }
      }
    }
  }
  const unsigned oth = (unsigned)__shfl_xor((int)nib, 32);
  if (lane < 32) {
#pragma unroll
    for (int T = 0; T < 2; ++T) {
      const unsigned b0 = ((nib >> (8 * T)) & 15u) | (((oth >> (8 * T)) & 15u) << 4);
      const unsigned b1 = ((nib >> (8 * T + 4)) & 15u) | (((oth >> (8 * T + 4)) & 15u) << 4);
      ((LDS unsigned short*)(lds + IL_HIST))[q * 512 + (4 * s + 2 * kh + T) * 2 + (g4 & 1)] = (unsigned short)(b0 | (b1 << 8));
    }
  }
}
DEVI void idx_stream(LDS unsigned char* lds, int N, int qg, int kh, float thi, float tlo, const h16* scbase) {
  const int tid = launder((int)threadIdx.x), lane = tid & 63, l15 = lane & 15, g4 = lane >> 4;
  const int q = 16 * qg + l15;
  LDS unsigned* st = (LDS unsigned*)(lds + IL_ST);
  const int nv = (N - 64 * kh + 127) >> 7;
  const unsigned long long* scp = (const unsigned long long*)(scbase + ((size_t)(kh * 4) * 1024 + q * 16 + 4 * g4));
#define IDX_LD(dst, s_) do { const int sc_ = (s_) < nv ? (s_) : nv - 1; _Pragma("unroll") for (int kt = 0; kt < 4; ++kt) dst[kt] = __hip_atomic_load(scp + (size_t)sc_ * 2048 + kt * 256, __ATOMIC_RELAXED, __HIP_MEMORY_SCOPE_AGENT); } while (0)
  unsigned long long b0[4], b1[4], b2[4], b3[4];
  IDX_LD(b0, 0); IDX_LD(b1, 1); IDX_LD(b2, 2); IDX_LD(b3, 3);
  for (int s = 0; s < nv; s += 4) {
    idx_stream_step(lds, st, b0, s, kh, q, lane, g4, thi, tlo); IDX_LD(b0, s + 4);
    if (s + 1 < nv) idx_stream_step(lds, st, b1, s + 1, kh, q, lane, g4, thi, tlo);
    IDX_LD(b1, s + 5);
    if (s + 2 < nv) idx_stream_step(lds, st, b2, s + 2, kh, q, lane, g4, thi, tlo);
    IDX_LD(b2, s + 6);
    if (s + 3 < nv) idx_stream_step(lds, st, b3, s + 3, kh, q, lane, g4, thi, tlo);
    IDX_LD(b3, s + 7);
  }
#undef IDX_LD
}

DEVI void idx_item(PRef p, LDS unsigned char* lds, int b, int c) {
  const int tid = launder((int)threadIdx.x), lane = tid & 63, wave = wave_id(tid), l31 = lane & 31, half = lane >> 5;
  const int N = 64 * (c + 1);
  unsigned* MASK = (unsigned*)(p.ws + WS_MASK) + ((size_t)b * SEQ + 64 * c) * 256;
  if (N <= 256) {
    const int wpr = N >> 5;
    for (int i = tid; i < 64 * wpr; i += NTHR) MASK[(size_t)(i / wpr) * 256 + (i % wpr)] = 0xFFFFFFFFu;
    return;
  }
  const int qg = wave & 3, kh = wave >> 2, l15 = lane & 15, q = 16 * qg + l15;
  const h16* QIrow0 = (const h16*)(p.ws + WS_QI) + ((size_t)b * SEQ + 64 * c) * 512;
  const float* WIrow0 = (const float*)(p.ws + WS_WI) + ((size_t)b * SEQ + 64 * c) * 8;
  const h16* KIb = (const h16*)(p.ws + WS_KI) + (size_t)b * SEQ * 64;
  h16* scbase;
  {
    const int j = (c < 64) ? c : 127 - c;
    const size_t pre = 8192ull * (size_t)(128 * j - (j * (j - 1)) / 2);
    scbase = (h16*)(p.ws + (b == 0 ? WS_H : WS_MIX + (size_t)(b - 1) * SC_BATCH_BYTES) + pre);
  }
  LDS unsigned* st = (LDS unsigned*)(lds + IL_ST);
  LDS float* stf = (LDS float*)(lds + IL_ST);
  if (tid < 64) { st[tid] = 0xFFFFFFFFu; st[64 + tid] = 0u; st[128 + tid] = 0u; }
  __syncthreads();
  const int nst = (N + 127) >> 7;
  const int stride = nst >= 16 ? 8 : (nst >= 8 ? 4 : (nst >= 4 ? 2 : 1));
  idx_pass<0>(lds, KIb, N, stride, qg, kh, QIrow0, WIrow0, 0.f, 0.f, 0, scbase);
  __syncthreads();
  if (tid < 64) {
    const float lo = fkey_inv(st[tid]), hi = fkey_inv(st[64 + tid]);
    float d = hi - lo; if (!(d > 1e-20f)) d = 1.f;
    const float inv = (float)IDX_NB / (1.5f * d);
    stf[192 + tid] = inv; stf[256 + tid] = -(lo - 0.25f * d) * inv;
  }
  for (int i = tid; i < 16384; i += NTHR) ((LDS unsigned*)(lds + IL_HIST))[i] = 0u;
  __syncthreads();
  const float qinv = stf[192 + q], qoff = stf[256 + q];
  idx_pass<1>(lds, KIb, N, 1, qg, kh, QIrow0, WIrow0, qinv, qoff, 0, scbase);
  {
    LDS unsigned* hist = (LDS unsigned*)(lds + IL_HIST);
    for (int qq = wave; qq < 64; qq += 8) {
      unsigned hb[4];
#pragma unroll
      for (int j = 0; j < 4; ++j) hb[j] = hist[(4 * lane + j) * 64 + qq];
      const unsigned mine = hb[0] + hb[1] + hb[2] + hb[3];
      unsigned suf = mine;
#pragma unroll
      for (int o = 1; o < 64; o <<= 1) { const unsigned v = (unsigned)__shfl_down((int)suf, o); if (lane + o < 64) suf += v; }
      unsigned cum = suf - mine;
      if (cum < 256u && suf >= 256u) {
#pragma unroll
        for (int j = 3; j >= 0; --j) {
          if (cum < 256u && cum + hb[j] >= 256u) { st[320 + qq] = (unsigned)(4 * lane + j); st[384 + qq] = 256u - cum; }
          cum += hb[j];
        }
      }
    }
  }
  __syncthreads();
  if (tid < 64) {
    const int bs = (int)st[320 + tid]; const float qi_ = stf[192 + tid], qo_ = stf[256 + tid];
    stf[448 + tid] = idx_bin_lower_bound(bs + 1, qi_, qo_);
    stf[512 + tid] = idx_bin_lower_bound(bs, qi_, qo_);
  }
  __syncthreads();
  const float thi = stf[448 + q], tlo = stf[512 + q];
  asm volatile("s_waitcnt vmcnt(0)" ::: "memory");
  idx_stream(lds, N, qg, kh, thi, tlo, scbase);
  __syncthreads();
  for (int qq = wave; qq < 64; qq += 8) {
    const int nc = min((int)st[128 + qq], IDX_CAP); const unsigned need = st[384 + qq];
    LDS float* cs = (LDS float*)(lds + IL_CS) + qq * IDX_CAP; LDS unsigned short* ck = (LDS unsigned short*)(lds + IL_CK) + qq * IDX_CAP;
    for (int i = lane; i < nc; i += 64) {
      const float sv = cs[i]; const unsigned kv = ck[i];
      unsigned rank = 0u;
      for (int j = 0; j < nc; ++j) { const float sj = cs[j]; const unsigned kj = ck[j]; rank += (sj > sv || (sj == sv && kj < kv)) ? 1u : 0u; }
      if (rank < need) {
        const unsigned kl = kv & 31u;
        const unsigned bit = 16u * ((kl >> 2) & 1u) + (kl & 3u) + 4u * (kl >> 3);
        __hip_atomic_fetch_or((LDS unsigned*)(lds + IL_HIST) + qq * 256 + (kv >> 5), 1u << bit, __ATOMIC_RELAXED, __HIP_MEMORY_SCOPE_WORKGROUP);
      }
    }
  }
  __syncthreads();
  {
    const int cpr = N >> 6;
    for (int i = tid; i < 64 * cpr; i += NTHR) {
      const int row = i / cpr, cc = i % cpr;
      *(u32x2*)(MASK + (size_t)row * 256 + 2 * cc) = *(LDS u32x2*)(lds + IL_HIST + row * 1024 + cc * 8);
    }
  }
  __syncthreads();
}

DEVI void phase3(PRef p, LDS unsigned char* lds) {
  const int G = gridDim.x;
  for (int it = blockIdx.x; it < 512; it += G) rnn_item<0>(p, lds, it >> 7, it & 127);
  for (int it = blockIdx.x; it < 256; it += G) {
    const int b = it >> 6, j = it & 63;
#pragma unroll 1
    for (int w2 = 0; w2 < 2; ++w2) idx_item(p, lds, b, w2 ? j : 127 - j);
  }
}

DEVI float max3f(float a, float b, float c) { float r; asm("v_max3_f32 %0, %1, %2, %3" : "=v"(r) : "v"(a), "v"(b), "v"(c)); return r; }
DEVI unsigned pk_rtz(float a, float b) { return __builtin_bit_cast(unsigned, __builtin_amdgcn_cvt_pkrtz(a, b)); }
DEVI void attn_tile(LDS unsigned char* Kt, LDS unsigned char* Vt, const h16x8 (&qf)[4], u32x2 mw, int l31, int half, f32x16 (&o)[2], float& mref, float& l, bool& init) {
  const unsigned nm0 = ~(mw[0] >> (16 * half)), nm1 = ~(mw[1] >> (16 * half));
  const unsigned negm = __float_as_uint(-mref);
  f32x16 s[2];
#pragma unroll
  for (int r = 0; r < 16; ++r) {
    unsigned e0 = (unsigned)__builtin_amdgcn_sbfe((int)nm0, r, 1), e1 = (unsigned)__builtin_amdgcn_sbfe((int)nm1, r, 1);
    asm volatile("" : "+v"(e0), "+v"(e1));
    s[0][r] = __uint_as_float((e0 & 0xFF800000u) | (~e0 & negm));
    s[1][r] = __uint_as_float((e1 & 0xFF800000u) | (~e1 & negm));
  }
#pragma unroll
  for (int ri = 0; ri < 2; ++ri)
#pragma unroll
    for (int kk = 0; kk < 4; ++kk) {
      const h16x8 kf = *(LDS h16x8*)(Kt + (32 * ri + l31) * LROW + (2 * kk + half) * 16);
      s[ri] = mfma16(kf, qf[kk], s[ri]);
    }
  asm volatile("s_nop 15\n\ts_nop 7" : "+v"(s[0]), "+v"(s[1]));
  float mx = max3f(s[0][0], s[1][0], s[0][1]), mx2 = max3f(s[1][1], s[0][2], s[1][2]);
#pragma unroll
  for (int r = 3; r < 15; r += 2) { mx = max3f(mx, s[0][r], s[1][r]); mx2 = max3f(mx2, s[0][r + 1], s[1][r + 1]); }
  mx = max3f(mx, s[0][15], s[1][15]);
  mx = max3f(mx, mx2, mx2);
  mx = max3f(mx, __shfl_xor(mx, 32), mx);
  const bool first = (!init) && (mx > -INFINITY);
  const bool resc = first || (mx > 8.f);
  if (__any(resc)) {
    init = init || first;
    const float delta = resc ? mx : 0.f;
    const float alpha = __builtin_amdgcn_exp2f(-delta);
#pragma unroll
    for (int r = 0; r < 16; ++r) { s[0][r] -= delta; s[1][r] -= delta; o[0][r] *= alpha; o[1][r] *= alpha; }
    l *= alpha; mref += delta;
  }
  float ls = 0.f;
#pragma unroll
  for (int r = 0; r < 16; ++r) {
    s[0][r] = __builtin_amdgcn_exp2f(s[0][r]); s[1][r] = __builtin_amdgcn_exp2f(s[1][r]);
    ls += s[0][r] + s[1][r];
  }
  l += ls;
  h16x8 pf[4];
#pragma unroll
  for (int s4 = 0; s4 < 4; ++s4) {
    u32x4 w;
#pragma unroll
    for (int e = 0; e < 4; ++e) w[e] = pk_rtz(s[s4 >> 1][8 * (s4 & 1) + 2 * e], s[s4 >> 1][8 * (s4 & 1) + 2 * e + 1]);
    pf[s4] = __builtin_bit_cast(h16x8, w);
  }
#pragma unroll
  for (int di = 0; di < 2; ++di)
#pragma unroll
    for (int s4 = 0; s4 < 4; ++s4) {
      const h16x8 vf = *(LDS h16x8*)(Vt + (32 * di + l31) * LROW + (2 * s4 + half) * 16);
      o[di] = mfma16(vf, pf[s4], o[di]);
    }
}

DEVI void attn_unit(PRef p, LDS unsigned char* lds, int b, int head, int qb) {
  const int tid = launder((int)threadIdx.x), lane = tid & 63, wave = wave_id(tid), l31 = lane & 31, half = lane >> 5;
  const int q0 = qb * 256 + wave * 32, cw = q0 >> 6, NS = qb + 1;
  const size_t tok = (size_t)b * SEQ + q0 + l31;
  h16x8 qf[4];
  {
    const h16* Q = (const h16*)(p.ws + WS_Q) + tok * 512 + head * 64;
#pragma unroll
    for (int kk = 0; kk < 4; ++kk) qf[kk] = *(const h16x8*)(Q + 16 * kk + 8 * half);
  }
  const unsigned* mrow = (const unsigned*)(p.ws + WS_MASK) + tok * 256;
  constexpr int TP = 2 * 64 * LROW, ABUF = 4 * TP;
  static_assert(2 * ABUF <= LDS_BYTES - 16, "attention LDS");
  const h16* ksrc[4]; const h16* vsrc[4]; int kdst[4], vdst[4];
#pragma unroll
  for (int i = 0; i < 4; ++i) {
    const int id = tid + NTHR * i;
    const int row = id >> 3, lc = id & 7;
    ksrc[i] = (const h16*)(p.ws + WS_K) + ((size_t)b * SEQ + row) * 512 + head * 64 + lc * 8;
    kdst[i] = (row >> 6) * TP + (row & 63) * LROW + lc * 16;
    const int d = id >> 5, c = id & 31;
    vsrc[i] = (const h16*)(p.ws + WS_VT) + ((size_t)(b * 8 + head) * 64 + d) * 8192 + c * 8;
    vdst[i] = (c >> 3) * TP + 64 * LROW + d * LROW + (c & 7) * 16;
  }
  h16x8 rkA[4], rvA[4], rkB[4], rvB[4];
#pragma unroll
  for (int i = 0; i < 4; ++i) { rkA[i] = *(const h16x8*)ksrc[i]; rvA[i] = *(const h16x8*)vsrc[i]; }
#pragma unroll
  for (int i = 0; i < 4; ++i) { *(LDS h16x8*)(lds + kdst[i]) = rkA[i]; *(LDS h16x8*)(lds + vdst[i]) = rvA[i]; }
  {
    const int s1 = NS > 1 ? 1 : 0;
#pragma unroll
    for (int i = 0; i < 4; ++i) { rkA[i] = *(const h16x8*)(ksrc[i] + (size_t)s1 * 256 * 512); rvA[i] = *(const h16x8*)(vsrc[i] + s1 * 256); }
  }
  u32x4 mA0 = *(const u32x4*)mrow, mA1 = *(const u32x4*)(mrow + 4), mB0, mB1;
  __syncthreads();
  f32x16 o[2];
#pragma unroll
  for (int r = 0; r < 16; ++r) { o[0][r] = 0.f; o[1][r] = 0.f; }
  float mref = 0.f, l = 0.f; bool init = false;
#define ATT_TILE(s, t, W0, W1) if (4 * (s) + (t) <= cw) { u32x2 m2; m2[0] = W0; m2[1] = W1; attn_tile(bb + (t) * TP, bb + (t) * TP + 64 * LROW, qf, m2, l31, half, o, mref, l, init); }
#define ATT_STEP(s, RKC, RVC, RKN, RVN, MC0, MC1, MN0, MN1) { \
    { const int sp = (s) + 2 < NS ? (s) + 2 : NS - 1; _Pragma("unroll") for (int i = 0; i < 4; ++i) { RKN[i] = *(const h16x8*)(ksrc[i] + (size_t)sp * 256 * 512); RVN[i] = *(const h16x8*)(vsrc[i] + sp * 256); } } \
    { const int sm = (s) + 1 < NS ? (s) + 1 : NS - 1; MN0 = *(const u32x4*)(mrow + 8 * sm); MN1 = *(const u32x4*)(mrow + 8 * sm + 4); } \
    { LDS unsigned char* bb = lds + ((s) & 1) * ABUF; \
      ATT_TILE(s, 0, MC0[0], MC0[1]) ATT_TILE(s, 1, MC0[2], MC0[3]) ATT_TILE(s, 2, MC1[0], MC1[1]) ATT_TILE(s, 3, MC1[2], MC1[3]) } \
    { LDS unsigned char* nb = lds + (((s) + 1) & 1) * ABUF; _Pragma("unroll") for (int i = 0; i < 4; ++i) { *(LDS h16x8*)(nb + kdst[i]) = RKC[i]; *(LDS h16x8*)(nb + vdst[i]) = RVC[i]; } } \
    __syncthreads(); }
  for (int s = 0; s < NS; s += 2) {
    ATT_STEP(s, rkA, rvA, rkB, rvB, mA0, mA1, mB0, mB1)
    if (s + 1 < NS) ATT_STEP(s + 1, rkB, rvB, rkA, rvA, mB0, mB1, mA0, mA1)
  }
#undef ATT_STEP
#undef ATT_TILE
  const float inv = 1.f / (l + __shfl_xor(l, 32));
  h16* Y = (h16*)(p.ws + WS_H) + tok * DM + head * 64;
#pragma unroll
  for (int di = 0; di < 2; ++di)
#pragma unroll
    for (int q = 0; q < 4; ++q)
      *(h16x4*)(Y + 32 * di + 8 * q + 4 * half) = pack4(o[di][4 * q] * inv, o[di][4 * q + 1] * inv, o[di][4 * q + 2] * inv, o[di][4 * q + 3] * inv);
}

DEVI void phase4(PRef p, LDS unsigned char* lds) {
  const int G = gridDim.x;
  for (int it = blockIdx.x; it < 512; it += G) rnn_item<1>(p, lds, it >> 7, it & 127);
  for (int it = blockIdx.x; it < 512; it += G) {
    const int bh = it >> 4, j = it & 15;
#pragma unroll 1
    for (int w2 = 0; w2 < 2; ++w2) attn_unit(p, lds, bh >> 3, bh & 7, w2 ? j : 31 - j);
  }
}

struct EpiPlain {
  h16* dst; int ld;
  DEVI void operator()(const f32x4 (&acc)[2][2][4][2], const g8::Unit& u, int wr, int wc, int fr, int fq) const {
#pragma unroll
    for (int ai = 0; ai < 2; ++ai)
#pragma unroll
      for (int m = 0; m < 4; ++m) {
        const int r = u.pm * 256 + 128 * ai + 64 * wr + 16 * m + fr;
        if (r < u.cnt) {
          h16* d = dst + (size_t)(u.off + r) * ld + u.pn * 256 + 32 * wc + 8 * fq;
#pragma unroll
          for (int bj = 0; bj < 2; ++bj)
            { const f32x4 v0 = acc[ai][bj][m][0], v1 = acc[ai][bj][m][1]; h16x8 w; w[0] = (h16)v0[0]; w[1] = (h16)v0[1]; w[2] = (h16)v0[2]; w[3] = (h16)v0[3]; w[4] = (h16)v1[0]; w[5] = (h16)v1[1]; w[6] = (h16)v1[2]; w[7] = (h16)v1[3]; *(h16x8*)(d + 128 * bj) = w; }
        }
      }
  }
};
DEVI void phase5(PRef p, LDS unsigned char* lds) {
  g8::DenseOrder S{(const h16*)(p.ws + WS_H), (const h16*)(p.ws + WS_WOUT), DM, 128, 4, (int)gridDim.x, (int)blockIdx.x};
  EpiPlain E{(h16*)(p.ws + WS_MIX), DM};
  g8::gemm_phase(lds, DM, S, E);
}

constexpr int P6_TROW = 2064, P6_THI = 0, P6_TLO = 32 * P6_TROW, P6_PART = 0, P6_LGT = 8 * 48 * 32 * 4, P6_MOD = 2 * 32 * P6_TROW;
constexpr int P6_BIAS = P6_MOD + 3 * 4096, P6_TOK = P6_BIAS + 160, P6_LCNT = P6_TOK + 128 * 6 * 4, P6_LBASE = P6_LCNT + 128;
static_assert(P6_LBASE + 128 <= LDS_BYTES - 16 && P6_LGT + 32 * 36 * 4 <= P6_MOD, "phase 6 LDS map");
DEVI void phase6(PRef p, LDS unsigned char* lds) {
  const int tid = launder((int)threadIdx.x), lane = tid & 63, wave = wave_id(tid), l15 = lane & 15, g4 = lane >> 4;
  const int b = blockIdx.x >> 6;
  LDS float* mv = (LDS float*)(lds + P6_MOD);
  LDS float* rbias = (LDS float*)(lds + P6_BIAS);
  LDS unsigned* tokrec = (LDS unsigned*)(lds + P6_TOK);
  LDS unsigned* lcnt = (LDS unsigned*)(lds + P6_LCNT);
  LDS unsigned* lbase = (LDS unsigned*)(lds + P6_LBASE);
  mod_to_lds(p, b, 2, mv); mod_to_lds(p, b, 3, mv + 1024); mod_to_lds(p, b, 4, mv + 2048);
  if (tid < 4) rbias[tid] = p.in[18][tid];
  else if (tid < 36) rbias[tid] = p.in[20][tid - 4];
  if (tid < 32) lcnt[tid] = 0u;
  __syncthreads();
  for (int k = tid; k < 1024; k += NTHR) { mv[k] *= p.in[5][k]; mv[2048 + k] = p.in[6][k] * (mv[2048 + k] + 1.f); }
  __syncthreads();
  const float* x = p.in[0]; const h16* MIX = (const h16*)(p.ws + WS_MIX); h16* X1h = (h16*)(p.ws + WS_MIX); h16* H2 = (h16*)(p.ws + WS_H);
  const h16* WRH = (const h16*)(p.ws + WS_WRH); const h16* WRL = (const h16*)(p.ws + WS_WRL);
  const size_t tok0 = (size_t)blockIdx.x * 128;
  h16x8 bh[3][4], bl[3][4];
#pragma unroll
  for (int ct = 0; ct < 3; ++ct)
#pragma unroll
    for (int kk = 0; kk < 4; ++kk) {
      const int kof = 32 * (4 * wave + kk) + 8 * g4;
      bh[ct][kk] = *(const h16x8*)(WRH + (size_t)(16 * ct + l15) * 1024 + kof); bl[ct][kk] = *(const h16x8*)(WRL + (size_t)(16 * ct + l15) * 1024 + kof);
    }
  f32x4 xa[4]; h16x4 ma[4];
#pragma unroll
  for (int j = 0; j < 4; ++j) { xa[j] = *(const f32x4*)(x + (tok0 + 4 * wave) * DM + 256 * j + 4 * lane); ma[j] = *(const h16x4*)(MIX + (tok0 + 4 * wave) * DM + 256 * j + 4 * lane); }
#pragma unroll 1
  for (int rd = 0; rd < 4; ++rd) {
    {
      const size_t tokb = tok0 + 32 * rd + 4 * wave;
#define P6_LOAD(XV, MH, T) do { _Pragma("unroll") for (int j = 0; j < 4; ++j) { XV[j] = *(const f32x4*)(x + (T) * DM + 256 * j + 4 * lane); MH[j] = *(const h16x4*)(MIX + (T) * DM + 256 * j + 4 * lane); } } while (0)
#define P6_ROW(XV, MH, I) do { \
        const int tr = 4 * wave + (I); const size_t tok = tokb + (I); \
        f32x4 mx[4]; float ssm = 0.f; \
        _Pragma("unroll") for (int j = 0; j < 4; ++j) _Pragma("unroll") for (int e = 0; e < 4; ++e) { mx[j][e] = (float)MH[j][e]; ssm += mx[j][e] * mx[j][e]; } \
        const float rsm = 1.0f / sqrtf(wave_sum(ssm) * (1.f / 1024.f) + 1e-6f); \
        float ss1 = 0.f; \
        _Pragma("unroll") for (int j = 0; j < 4; ++j) { \
          const f32x4 v = XV[j] + *(LDS f32x4*)(mv + 256 * j + 4 * lane) * (mx[j] * rsm); \
          XV[j] = v; \
          *(h16x4*)(X1h + tok * DM + 256 * j + 4 * lane) = pack4(v[0], v[1], v[2], v[3]); \
          ss1 += v[0] * v[0] + v[1] * v[1] + v[2] * v[2] + v[3] * v[3]; \
        } \
        const float rs1 = 1.0f / sqrtf(wave_sum(ss1) * (1.f / 1024.f) + 1e-6f); \
        _Pragma("unroll") for (int j = 0; j < 4; ++j) { \
          const f32x4 h2 = XV[j] * rs1 * *(LDS f32x4*)(mv + 2048 + 256 * j + 4 * lane) + *(LDS f32x4*)(mv + 1024 + 256 * j + 4 * lane); \
          const h16x4 hi = pack4(h2[0], h2[1], h2[2], h2[3]); \
          const h16x4 lo = pack4(h2[0] - (float)hi[0], h2[1] - (float)hi[1], h2[2] - (float)hi[2], h2[3] - (float)hi[3]); \
          *(h16x4*)(H2 + tok * DM + 256 * j + 4 * lane) = hi; \
          *(LDS h16x4*)(lds + P6_THI + tr * P6_TROW + (256 * j + 4 * lane) * 2) = hi; \
          *(LDS h16x4*)(lds + P6_TLO + tr * P6_TROW + (256 * j + 4 * lane) * 2) = lo; \
        } } while (0)
      f32x4 xb[4]; h16x4 mb[4];
      P6_LOAD(xb, mb, tokb + 1); __builtin_amdgcn_sched_barrier(0); P6_ROW(xa, ma, 0);
      P6_LOAD(xa, ma, tokb + 2); __builtin_amdgcn_sched_barrier(0); P6_ROW(xb, mb, 1);
      P6_LOAD(xb, mb, tokb + 3); __builtin_amdgcn_sched_barrier(0); P6_ROW(xa, ma, 2);
      { const size_t tn = rd < 3 ? tokb + 32 : tokb; P6_LOAD(xa, ma, tn); } __builtin_amdgcn_sched_barrier(0); P6_ROW(xb, mb, 3);
    }
    __syncthreads();
    f32x4 acc[2][3];
#pragma unroll
    for (int tt = 0; tt < 2; ++tt)
#pragma unroll
      for (int ct = 0; ct < 3; ++ct) acc[tt][ct] = (f32x4){0.f, 0.f, 0.f, 0.f};
#pragma unroll
    for (int kk = 0; kk < 4; ++kk) {
      const int kof = 32 * (4 * wave + kk) + 8 * g4;
      h16x8 ah[2], al[2];
#pragma unroll
      for (int tt = 0; tt < 2; ++tt) {
        ah[tt] = *(LDS h16x8*)(lds + P6_THI + (16 * tt + l15) * P6_TROW + kof * 2);
        al[tt] = *(LDS h16x8*)(lds + P6_TLO + (16 * tt + l15) * P6_TROW + kof * 2);
      }
#pragma unroll
      for (int ct = 0; ct < 3; ++ct) {
#pragma unroll
        for (int tt = 0; tt < 2; ++tt) {
          acc[tt][ct] = mfma16s(ah[tt], bh[ct][kk], acc[tt][ct]);
          acc[tt][ct] = mfma16s(ah[tt], bl[ct][kk], acc[tt][ct]);
          acc[tt][ct] = mfma16s(al[tt], bh[ct][kk], acc[tt][ct]);
        }
      }
    }
    __syncthreads();
#pragma unroll
    for (int tt = 0; tt < 2; ++tt)
#pragma unroll
      for (int ct = 0; ct < 3; ++ct)
        *(LDS f32x4*)(lds + P6_PART + (((wave * 48 + 16 * ct + l15) * 32) + 16 * tt + 4 * g4) * 4) = acc[tt][ct];
    __syncthreads();
    for (int idx = tid; idx < 36 * 32; idx += NTHR) {
      const int col = idx >> 5, tk = idx & 31;
      float s = 0.f;
#pragma unroll
      for (int w = 0; w < 8; ++w) s += *(LDS float*)(lds + P6_PART + ((w * 48 + col) * 32 + tk) * 4);
      *(LDS float*)(lds + P6_LGT + (tk * 36 + col) * 4) = s;
    }
    __syncthreads();
    if (tid < 32) {
      LDS float* lg = (LDS float*)(lds + P6_LGT) + 36 * tid;
      float gl[4];
#pragma unroll
      for (int g = 0; g < 4; ++g) gl[g] = lg[g] + rbias[g];
      int gi = 0; float gm = gl[0];
#pragma unroll
      for (int g = 1; g < 4; ++g) if (gl[g] > gm) { gm = gl[g]; gi = g; }
      float gs = 0.f;
#pragma unroll
      for (int g = 0; g < 4; ++g) gs += __expf(gl[g] - gm);
      const float pg = 1.f / gs;
      int e1 = 0, e2 = 0; float l1 = -INFINITY, l2 = -INFINITY;
#pragma unroll
      for (int e = 0; e < 8; ++e) {
        const float v = lg[4 + 8 * gi + e] + rbias[4 + 8 * gi + e];
        if (v > l1) { l2 = l1; e2 = e1; l1 = v; e1 = e; }
        else if (v > l2) { l2 = v; e2 = e; }
      }
      const float x2 = __expf(l2 - l1);
      const float w1 = pg / (1.f + x2), w2 = pg * x2 / (1.f + x2);
      const unsigned E1 = (unsigned)(gi * 8 + e1), E2 = (unsigned)(gi * 8 + e2);
      const unsigned lp1 = __hip_atomic_fetch_add(&lcnt[E1], 1u, __ATOMIC_RELAXED, __HIP_MEMORY_SCOPE_WORKGROUP);
      const unsigned lp2 = __hip_atomic_fetch_add(&lcnt[E2], 1u, __ATOMIC_RELAXED, __HIP_MEMORY_SCOPE_WORKGROUP);
      LDS unsigned* tr = tokrec + (32 * rd + tid) * 6;
      tr[0] = E1; tr[1] = lp1; tr[2] = E2; tr[3] = lp2; tr[4] = __float_as_uint(w1); tr[5] = __float_as_uint(w2);
    }
    __syncthreads();
  }
  if (tid < 32) lbase[tid] = atomicAdd((unsigned*)(p.ws + WS_CNT) + tid, lcnt[tid]);
  __syncthreads();
  if (tid < 128) {
    unsigned* LIST = (unsigned*)(p.ws + WS_LIST); float* LISTW = (float*)(p.ws + WS_LISTW); u32x4* ROUTE = (u32x4*)(p.ws + WS_ROUTE);
    const unsigned tok = (unsigned)(tok0 + tid);
    LDS unsigned* tr = tokrec + tid * 6;
    const unsigned E1 = tr[0], E2 = tr[2], p1 = lbase[E1] + tr[1], p2 = lbase[E2] + tr[3];
    LIST[(size_t)E1 * 32768 + p1] = tok; LISTW[(size_t)E1 * 32768 + p1] = __uint_as_float(tr[4]);
    LIST[(size_t)E2 * 32768 + p2] = tok; LISTW[(size_t)E2 * 32768 + p2] = __uint_as_float(tr[5]);
    u32x4 rt; rt[0] = E1; rt[1] = p1; rt[2] = E2; rt[3] = p2;
    ROUTE[tok] = rt;
  }
}

template <bool GATHER_> struct MoeOrder {
  static constexpr bool GATHER = GATHER_;
  unsigned char* ws; int ntn, K, G, c;
  int pre, cnl, offx;
  DEVI void init() {
    const int lane = threadIdx.x & 63;
    const int cn0 = lane < 32 ? (int)((const unsigned*)(ws + WS_CNT))[lane] : 0;
    int pt = ((cn0 + 255) >> 8) * ntn, po = cn0;
#pragma unroll
    for (int d = 1; d < 32; d <<= 1) { const int a = __shfl_up(pt, d), b = __shfl_up(po, d); if (lane >= d) { pt += a; po += b; } }
    pre = lane < 32 ? pt : 0x7fffffff; cnl = cn0; offx = po - cn0;
  }
  DEVI bool next(int i, g8::Unit& u) const {
    const int itg = i * G + c;
    const int e = __builtin_popcountll(__builtin_amdgcn_ballot_w64(pre <= itg));
    if (e >= 32) return false;
    const int cn = __builtin_amdgcn_readlane(cnl, e), off = __builtin_amdgcn_readlane(offx, e);
    const int it = itg - (__builtin_amdgcn_readlane(pre, e) - ((cn + 255) >> 8) * ntn);
    u.e = e; u.pm = it / ntn; u.pn = it % ntn; u.cnt = cn; u.off = off;
    const int tid = threadIdx.x;
    if (GATHER_) {
      const unsigned* list = (const unsigned*)(ws + WS_LIST) + (size_t)e * 32768;
      u.A = (const char*)(ws + WS_H);
      u.B = (const char*)((const h16*)(ws + WS_WGU) + ((size_t)e * 512 + u.pn * 256) * DM);
#pragma unroll
      for (int h = 0; h < 2; ++h)
#pragma unroll
        for (int i2 = 0; i2 < 2; ++i2) {
          int R, C; g8::stage_rc(tid * 16 + i2 * 8192, R, C);
          const int row = u.pm * 256 + 128 * h + R;
          const unsigned t = list[row < cn ? row : cn - 1];
          u.va[h][i2] = (t * (unsigned)DM + (unsigned)C) * 2u;
        }
    } else {
      u.A = (const char*)((const h16*)(ws + WS_ACT) + ((size_t)off + u.pm * 256) * 256);
      u.B = (const char*)((const h16*)(ws + WS_WDN) + ((size_t)e * 1024 + u.pn * 256) * 256);
      u.va[0][0] = u.va[0][1] = u.va[1][0] = u.va[1][1] = 0u;
    }
    return true;
  }
};
struct EpiAct {
  unsigned char* ws;
  DEVI void operator()(const f32x4 (&acc)[2][2][4][2], const g8::Unit& u, int wr, int wc, int fr, int fq) const {
    const float* lw = (const float*)(ws + WS_LISTW) + (size_t)u.e * 32768; h16* act = (h16*)(ws + WS_ACT);
    const int r0 = u.pm * 256 + 64 * wr + fr;
    float w8[2][4];
#pragma unroll
    for (int ai = 0; ai < 2; ++ai)
#pragma unroll
      for (int m = 0; m < 4; ++m) { const int r = r0 + 128 * ai + 16 * m; w8[ai][m] = lw[r < u.cnt ? r : u.cnt - 1]; }
    __builtin_amdgcn_sched_barrier(0);
#pragma unroll
    for (int ai = 0; ai < 2; ++ai)
#pragma unroll
      for (int m = 0; m < 4; ++m) asm volatile("" : "+v"(w8[ai][m]));
#pragma unroll
    for (int ai = 0; ai < 2; ++ai)
#pragma unroll
      for (int m = 0; m < 4; ++m) {
        const int r = r0 + 128 * ai + 16 * m;
        if (r < u.cnt) {
          const float w = w8[ai][m];
#pragma unroll
          for (int bj = 0; bj < 2; ++bj) {
            const f32x4 g = acc[ai][bj][m][0], up = acc[ai][bj][m][1];
            float v[4];
#pragma unroll
            for (int e = 0; e < 4; ++e) v[e] = g[e] * __builtin_amdgcn_rcpf(1.f + __expf(-g[e])) * up[e] * w;
            *(h16x4*)(act + (size_t)(u.off + r) * 256 + 16 * (8 * u.pn + 4 * bj + wc) + 4 * fq) = pack4(v[0], v[1], v[2], v[3]);
          }
        }
      }
  }
};
struct EpiYp {
  h16* dst;
  DEVI void operator()(const f32x4 (&acc)[2][2][4][2], const g8::Unit& u, int wr, int wc, int fr, int fq) const {
#pragma unroll
    for (int ai = 0; ai < 2; ++ai)
#pragma unroll
      for (int m = 0; m < 4; ++m) {
        const int r = u.pm * 256 + 128 * ai + 64 * wr + 16 * m + fr;
        if (r < u.cnt) {
          h16* d = dst + (size_t)(u.off + r) * DM + u.pn * 256 + 32 * wc + 8 * fq;
#pragma unroll
          for (int bj = 0; bj < 2; ++bj)
            { const f32x4 v0 = acc[ai][bj][m][0], v1 = acc[ai][bj][m][1]; h16x8 w; w[0] = (h16)v0[0]; w[1] = (h16)v0[1]; w[2] = (h16)v0[2]; w[3] = (h16)v0[3]; w[4] = (h16)v1[0]; w[5] = (h16)v1[1]; w[6] = (h16)v1[2]; w[7] = (h16)v1[3]; *(h16x8*)(d + 128 * bj) = w; }
        }
      }
  }
};
DEVI void phase7(PRef p, LDS unsigned char* lds) {
  MoeOrder<true> S{p.ws, 2, DM, (int)gridDim.x, (int)blockIdx.x, 0, 0, 0};
  S.init();
  EpiAct E{p.ws};
  g8::gemm_phase(lds, DM, S, E);
}
DEVI void phase8(PRef p, LDS unsigned char* lds) {
  MoeOrder<false> S{p.ws, 4, 256, (int)gridDim.x, (int)blockIdx.x, 0, 0, 0};
  S.init();
  EpiYp E{(h16*)(p.ws + WS_YP)};
  g8::gemm_phase(lds, 256, S, E);
}

DEVI void phase9(PRef p, LDS unsigned char* lds) {
  const int tid = launder((int)threadIdx.x), lane = tid & 63, wave = wave_id(tid), G = gridDim.x;
  const int b = blockIdx.x & 3, bi = blockIdx.x >> 2, nbk = G >> 2;
  LDS unsigned* offs = (LDS unsigned*)lds;
  if (tid == 0) { const unsigned* cnt = (const unsigned*)(p.ws + WS_CNT); unsigned o = 0; for (int e = 0; e < 32; ++e) { offs[e] = o; o += cnt[e]; } }
  __syncthreads();
  LDS float* mv = (LDS float*)(lds + 256);
  mod_to_lds(p, b, 5, mv);
  __syncthreads();
  f32x4 A3[4];
#pragma unroll
  for (int j = 0; j < 4; ++j) { const int k = 256 * j + 4 * lane; A3[j] = *(LDS f32x4*)(mv + k) * *(const f32x4*)(p.in[7] + k); }
  const h16* YP = (const h16*)(p.ws + WS_YP); const u32x4* ROUTE = (const u32x4*)(p.ws + WS_ROUTE); float* out = p.out; const h16* X1h = (const h16*)(p.ws + WS_MIX);
  const int rstep = nbk * 8, r_first = bi * 8 + wave;
  const int nrow = (SEQ - r_first + rstep - 1) / rstep;
  unsigned R0 = 0u, R1 = 0u;
  if (lane < nrow) { const u32x4 rt = ROUTE[(size_t)b * SEQ + r_first + rstep * lane]; R0 = offs[rt[0]] + rt[1]; R1 = offs[rt[2]] + rt[3]; }
  h16x4 ya[4], yc[4]; f32x4 xv[4];
  {
    const size_t tok = (size_t)b * SEQ + r_first; const size_t r0 = __builtin_amdgcn_readlane(R0, 0), r1 = __builtin_amdgcn_readlane(R1, 0);
#pragma unroll
    for (int j = 0; j < 4; ++j) { ya[j] = *(const h16x4*)(YP + r0 * DM + 256 * j + 4 * lane); yc[j] = *(const h16x4*)(YP + r1 * DM + 256 * j + 4 * lane); { const h16x4 xh = *(const h16x4*)(X1h + tok * DM + 256 * j + 4 * lane); xv[j] = (f32x4){(float)xh[0], (float)xh[1], (float)xh[2], (float)xh[3]}; } }
  }
  for (int i = 0; i < nrow; ++i) {
    const size_t tok = (size_t)b * SEQ + r_first + rstep * i;
    h16x4 na[4], nc[4]; f32x4 nx[4];
    if (i + 1 < nrow) {
      const size_t r0 = __builtin_amdgcn_readlane(R0, i + 1), r1 = __builtin_amdgcn_readlane(R1, i + 1);
#pragma unroll
      for (int j = 0; j < 4; ++j) { na[j] = *(const h16x4*)(YP + r0 * DM + 256 * j + 4 * lane); nc[j] = *(const h16x4*)(YP + r1 * DM + 256 * j + 4 * lane); { const h16x4 xh = *(const h16x4*)(X1h + (tok + rstep) * DM + 256 * j + 4 * lane); nx[j] = (f32x4){(float)xh[0], (float)xh[1], (float)xh[2], (float)xh[3]}; } }
    }
    f32x4 y[4]; float ss = 0.f;
#pragma unroll
    for (int j = 0; j < 4; ++j)
#pragma unroll
      for (int e = 0; e < 4; ++e) { y[j][e] = (float)ya[j][e] + (float)yc[j][e]; ss += y[j][e] * y[j][e]; }
    const float rs = 1.0f / sqrtf(wave_sum(ss) * (1.f / 1024.f) + 1e-6f);
#pragma unroll
    for (int j = 0; j < 4; ++j) *(f32x4*)(out + tok * DM + 256 * j + 4 * lane) = xv[j] + A3[j] * (y[j] * rs);
    if (i + 1 < nrow) {
#pragma unroll
      for (int j = 0; j < 4; ++j) { ya[j] = na[j]; yc[j] = nc[j]; xv[j] = nx[j]; }
    }
  }
}

#define XB_TMO      128
#define XB_XCNT(j)  (256  + 64 * (j))
#define XB_XSUB(j)  (1280 + 64 * (j))
#define XB_XGEN(j)  (2304 + 64 * (j))
#define XB_TOP      3328
#define XB_TOPGEN   3392
#define XB_SPIN_CAP (1u << 22)
DEVI unsigned xb_ld(unsigned* p)              { return __hip_atomic_load(p, __ATOMIC_RELAXED, __HIP_MEMORY_SCOPE_AGENT); }
DEVI unsigned xb_add(unsigned* p, unsigned v) { return __hip_atomic_fetch_add(p, v, __ATOMIC_RELAXED, __HIP_MEMORY_SCOPE_AGENT); }
DEVI unsigned xb_xcc_id() { return (unsigned)__builtin_amdgcn_s_getreg((3 << 11) | 20) & 0xFu; }
#define XB_SPIN(cond, bar) do { unsigned _sp = 0; while (cond) { __builtin_amdgcn_s_sleep(1); \
    if ((++_sp & 255u) == 0u) { if (xb_ld(&(bar)[XB_TMO])) break; if (_sp > XB_SPIN_CAP) { atomicAdd(&(bar)[XB_TMO], 1u); break; } } } } while (0)
struct XcdBarrier { unsigned* bar; unsigned x; volatile LDS unsigned* st; };
DEVI XcdBarrier xcd_barrier_post(unsigned* bar, volatile LDS unsigned* st) {
  XcdBarrier b; b.bar = bar; b.x = xb_xcc_id(); b.st = st;
  if (threadIdx.x == 0) (void)xb_add(&bar[XB_XCNT(b.x)], 1u);
  return b;
}
DEVI void xcd_barrier_complete(unsigned* bar, unsigned x, unsigned& nloc, unsigned& nx) {
  const unsigned G = gridDim.x * gridDim.y * gridDim.z;
  unsigned sum, cnt, mine, sp = 0u;
  for (;;) {
    sum = 0u; cnt = 0u; mine = 0u;
#pragma unroll
    for (unsigned j = 0; j < 16; ++j) { const unsigned c = xb_ld(&bar[XB_XCNT(j)]); sum += c; cnt += (c > 0u) ? 1u : 0u; mine = (j == x) ? c : mine; }
    if (sum == G) break;
    __builtin_amdgcn_s_sleep(1);
    if ((++sp & 255u) == 0u) { if (xb_ld(&bar[XB_TMO])) break; if (sp > XB_SPIN_CAP) { atomicAdd(&bar[XB_TMO], 1u); break; } }
  }
  nloc = mine > 0u ? mine : 1u; nx = cnt > 0u ? cnt : 1u;
}
DEVI void xcd_barrier(const XcdBarrier& b) {
  asm volatile("s_waitcnt vmcnt(0)" ::: "memory");
  __syncthreads();
  if (threadIdx.x == 0) {
    unsigned* bar = b.bar;
    __builtin_amdgcn_s_waitcnt(0);
    unsigned nloc = b.st[0], nx = b.st[1];
    if (nloc == 0u) { xcd_barrier_complete(bar, b.x, nloc, nx); b.st[0] = nloc; b.st[1] = nx; }
    const unsigned old = xb_add(&bar[XB_XSUB(b.x)], 1u);
    const unsigned gen = old / nloc;
    if (old + 1u == (gen + 1u) * nloc) {
      __builtin_amdgcn_fence(__ATOMIC_RELEASE, "agent");
      asm volatile("s_waitcnt vmcnt(0)" ::: "memory");
      const unsigned og = xb_add(&bar[XB_TOP], 1u);
      const unsigned tg = og / nx;
      if (og + 1u == (tg + 1u) * nx) xb_add(&bar[XB_TOPGEN], 1u);
      else XB_SPIN(xb_ld(&bar[XB_TOPGEN]) == tg, bar);
      __builtin_amdgcn_fence(__ATOMIC_ACQUIRE, "agent");
      xb_add(&bar[XB_XGEN(b.x)], 1u);
      asm volatile("s_waitcnt vmcnt(0)" ::: "memory");
    } else {
      XB_SPIN(xb_ld(&bar[XB_XGEN(b.x)]) == gen, bar);
      __builtin_amdgcn_fence(__ATOMIC_ACQUIRE, "agent");
      asm volatile("s_waitcnt vmcnt(0)" ::: "memory");
    }
  }
  __syncthreads();
}

__global__ void __launch_bounds__(NTHR) fwd_kernel(Params p) {
  extern __shared__ __attribute__((aligned(16))) unsigned char smem[];
  LDS unsigned char* lds = (LDS unsigned char*)smem;
  const int lo = p.ph_lo, hi = p.ph_hi;
  volatile LDS unsigned* bst = (volatile LDS unsigned*)(lds + LDS_BYTES - 16);
  if (threadIdx.x < 4) bst[threadIdx.x] = 0u;
  __syncthreads();
  (void)xcd_barrier_post((unsigned*)(p.ws + WS_BAR), bst);
#ifndef REPEAT_PHASE
#define REPEAT_PHASE -1
#endif
#define GRID_SYNC(k) do { { XcdBarrier xb_; xb_.bar = (unsigned*)(get_params()->ws + WS_BAR); xb_.x = xb_xcc_id(); xb_.st = (volatile LDS unsigned*)(lds + LDS_BYTES - 16); xcd_barrier(xb_); } } while (0)
#define RUN_PHASE(k, fn) if (lo <= (k) && (k) < hi) { fn(*get_params(), lds); if ((k) == REPEAT_PHASE) { GRID_SYNC(k); fn(*get_params(), lds); } if ((k) + 1 < hi) GRID_SYNC(k); }
  RUN_PHASE(0, phase0)
  RUN_PHASE(1, phase1)
  RUN_PHASE(2, phase2)
  RUN_PHASE(3, phase3)
  RUN_PHASE(4, phase4)
  RUN_PHASE(5, phase5)
  RUN_PHASE(6, phase6)
  RUN_PHASE(7, phase7)
  RUN_PHASE(8, phase8)
  RUN_PHASE(9, phase9)
#undef GRID_SYNC
#undef RUN_PHASE
}

extern "C" void kernel_launch(void* const* d_in, const int* in_sizes, int n_in, void* d_out, int out_size, void* d_ws, size_t ws_size, hipStream_t stream) {
  static int grid = 0;
  if (grid == 0) {
    if (n_in != 24 || out_size != NTOK * DM || ws_size < WS_END) { fprintf(stderr, "kernel_launch: unexpected problem (n_in %d out %d ws %zu)\n", n_in, out_size, ws_size); grid = -1; return; }
    (void)hipFuncSetAttribute((const void*)fwd_kernel, hipFuncAttributeMaxDynamicSharedMemorySize, LDS_BYTES);
    int dev = 0, cus = 0, per_cu = 0;
    (void)hipGetDevice(&dev);
    (void)hipDeviceGetAttribute(&cus, hipDeviceAttributeMultiprocessorCount, dev);
    (void)hipOccupancyMaxActiveBlocksPerMultiprocessor(&per_cu, (const void*)fwd_kernel, NTHR, LDS_BYTES);
    if (per_cu < 1 || cus < 256) fprintf(stderr, "kernel_launch: occupancy %d blocks/CU on %d CUs\n", per_cu, cus);
    grid = 256;
  }
  if (grid < 0) return;
  (void)hipMemsetAsync((char*)d_ws + WS_CNT, 0, CTL_ZERO_BYTES, stream);
  Params p{};
  for (int i = 0; i < 24; ++i) p.in[i] = (const float*)d_in[i];
  p.out = (float*)d_out; p.ws = (unsigned char*)d_ws;
#if N_LAUNCH_MODE == 1
  p.ph_lo = 0; p.ph_hi = NPHASE;
  void* args[] = {&p};
  hipError_t e = hipLaunchCooperativeKernel((const void*)fwd_kernel, dim3(grid), dim3(NTHR), args, LDS_BYTES, stream);
  if (e != hipSuccess) fprintf(stderr, "cooperative launch failed: %s\n", hipGetErrorString(e));
#else
  for (int ph = 0; ph < NPHASE; ++ph) {
    p.ph_lo = ph; p.ph_hi = ph + 1;
    hipLaunchKernelGGL(fwd_kernel, dim3(grid), dim3(NTHR), LDS_BYTES, stream, p);
  }
#endif
}
```

```cpp
#include <hip/hip_runtime.h>
#include <cstdio>
#include <cstdint>

#ifndef N_LAUNCH_MODE
#define N_LAUNCH_MODE 1
#endif

#define DEVI __device__ __forceinline__
#define LDS __attribute__((address_space(3)))

typedef _Float16 h16;
typedef _Float16 h16x4 __attribute__((ext_vector_type(4)));
typedef _Float16 h16x8 __attribute__((ext_vector_type(8)));
typedef float f32x4 __attribute__((ext_vector_type(4)));
typedef float f32x16 __attribute__((ext_vector_type(16)));
typedef unsigned u32x2 __attribute__((ext_vector_type(2)));
typedef unsigned u32x4 __attribute__((ext_vector_type(4)));

constexpr int NBATCH = 4, SEQ = 8192, NTOK = NBATCH * SEQ, DM = 1024;
constexpr int NTHR = 512;
constexpr int NPHASE = 10;
constexpr int LDS_BYTES = 163840;

constexpr size_t MiB = 1ull << 20;
constexpr size_t WS_CNT = 0;
constexpr size_t CTL_ZERO_BYTES = 20480;
constexpr size_t WS_BAR = 4096;
constexpr size_t WS_MODP = 64 * 1024;
constexpr size_t WS_ROPE = 1 * MiB;
constexpr size_t WS_WIN = 3 * MiB;
constexpr size_t WS_WOUT = 10 * MiB;
constexpr size_t WS_WGU = 12 * MiB;
constexpr size_t WS_WDN = 44 * MiB;
constexpr size_t WS_WRG = 60 * MiB;
constexpr size_t WS_WRH = 60 * MiB + 512 * 1024;
constexpr size_t WS_WRL = 60 * MiB + 640 * 1024;
constexpr size_t WS_AGG = 61 * MiB;
constexpr size_t WS_ROUTE = 63 * MiB;
constexpr size_t WS_LIST = 64 * MiB;
constexpr size_t WS_LISTW = 68 * MiB;
constexpr size_t WS_WI = 72 * MiB;
constexpr size_t WS_KI = 73 * MiB;
constexpr size_t WS_MASK = 77 * MiB;
constexpr size_t WS_H = 109 * MiB;
constexpr size_t WS_Q = 173 * MiB;
constexpr size_t WS_K = 205 * MiB;
constexpr size_t WS_VT = 237 * MiB;
constexpr size_t WS_QI = 269 * MiB;
constexpr size_t WS_XR = 301 * MiB;
constexpr size_t WS_XG = 333 * MiB;
constexpr size_t WS_MIX = 365 * MiB;
constexpr size_t WS_ACT = 429 * MiB;
constexpr size_t WS_YP = 173 * MiB;
constexpr size_t WS_END = 510 * MiB;
constexpr size_t SC_BATCH_BYTES = 8192ull * 6176ull;
static_assert(SC_BATCH_BYTES <= 64 * MiB && WS_MIX + 3 * SC_BATCH_BYTES <= WS_END, "score slots");

struct Params { const float* in[24]; float* out; unsigned char* ws; int ph_lo, ph_hi; };
typedef const __attribute__((address_space(4))) Params& PRef;
typedef const __attribute__((address_space(4))) Params* PPtr;

__device__ const double ROPE_REV[32] = {
  1.59154943091895345608e-01, 1.19349370211248861917e-01, 8.94994016088910132600e-02, 6.71150830052272551196e-02,
  5.03292121044870352509e-02, 3.77415847174197710556e-02, 2.83021958306233986646e-02, 2.12236527647776604399e-02,
  1.59154943091895338669e-02, 1.19349370211248861917e-02, 8.94994016088910236684e-03, 6.71150830052272533849e-03,
  5.03292121044870369856e-03, 3.77415847174197719230e-03, 2.83021958306233986646e-03, 2.12236527647776621747e-03,
  1.59154943091895356017e-03, 1.19349370211248848907e-03, 8.94994016088910236684e-04, 6.71150830052272598901e-04,
  5.03292121044870326488e-04, 3.77415847174197740914e-04, 2.83021958306233954120e-04, 2.12236527647776605484e-04,
  1.59154943091895350596e-04, 1.19349370211248862459e-04, 8.94994016088910182474e-05, 6.71150830052272544691e-05,
  5.03292121044870353593e-05, 3.77415847174197768019e-05, 2.83021958306233960897e-05, 2.12236527647776591931e-05};

DEVI int launder(int x) { asm volatile("" : "+v"(x)); return x; }
DEVI PPtr get_params() { PPtr k = (PPtr)__builtin_amdgcn_kernarg_segment_ptr(); asm volatile("" : "+s"(k)); return k; }
DEVI int wave_id(int tid) { return __builtin_amdgcn_readfirstlane(tid >> 6); }
DEVI f32x16 mfma16(h16x8 a, h16x8 b, f32x16 c) { return __builtin_amdgcn_mfma_f32_32x32x16_f16(a, b, c, 0, 0, 0); }
template <int CTRL> DEVI float dpp_add(float v) { return v + __int_as_float(__builtin_amdgcn_update_dpp(0, __float_as_int(v), CTRL, 0xf, 0xf, true)); }
DEVI float wave_sum(float v) {
  v = dpp_add<0xB1>(v); v = dpp_add<0x4E>(v); v = dpp_add<0x141>(v); v = dpp_add<0x140>(v);
  { const auto sw = __builtin_amdgcn_permlane16_swap(__float_as_uint(v), __float_as_uint(v), false, false); v = __uint_as_float(sw[0]) + __uint_as_float(sw[1]); }
  { const auto sw = __builtin_amdgcn_permlane32_swap(__float_as_uint(v), __float_as_uint(v), false, false); v = __uint_as_float(sw[0]) + __uint_as_float(sw[1]); }
  return v;
}
DEVI float sigmoid_f(float x) { return __builtin_amdgcn_rcpf(1.f + __expf(-x)); }
DEVI float silu_f(float x) { return x * __builtin_amdgcn_rcpf(1.f + __expf(-x)); }
DEVI float gelu_tanh_f(float x) {
  const float u = 0.7978845608028654f * (x + 0.044715f * x * x * x);
  const float t = 1.f - 2.f * __builtin_amdgcn_rcpf(1.f + __expf(2.f * u));
  return 0.5f * x * (1.f + t);
}
DEVI unsigned fkey(float f) { unsigned u = __float_as_uint(f); return (u & 0x80000000u) ? ~u : (u | 0x80000000u); }
DEVI float fkey_inv(unsigned k) { unsigned u = (k & 0x80000000u) ? (k & 0x7fffffffu) : ~k; return __uint_as_float(u); }
DEVI int vt_perm(int pos) { return (pos & ~12) | ((pos & 4) << 1) | ((pos & 8) >> 1); }

DEVI void mod_to_lds(PRef p, int b, int chunk, LDS float* dst) {
  const float* mp = (const float*)(p.ws + WS_MODP);
  for (int k = threadIdx.x; k < 1024; k += NTHR) {
    const int j = chunk * 1024 + k;
    float v[8];
#pragma unroll
    for (int ks = 0; ks < 8; ++ks) v[ks] = mp[(size_t)(ks * 4 + b) * 6144 + j];
    float s = p.in[3][j];
#pragma unroll
    for (int ks = 0; ks < 8; ++ks) s += v[ks];
    dst[k] = s;
  }
}

constexpr int LROW = 144;

namespace g8 {
constexpr int BM = 256, BK = 64, HALF = 128, HTB = HALF * BK * 2, STAGE_BYTES = 8 * HTB;
DEVI int lds_byte(int r, int c) { const int st = (r >> 4) * 2 + (c >> 5), rr = r & 15, cc = c & 31, ob = rr * 64 + cc * 2; return st * 1024 + (ob ^ (((ob >> 9) & 1) << 5)); }
DEVI void stage_rc(int b, int& R, int& C) { const int st = b / 1024, sb = b % 1024, swz = sb ^ (((sb >> 9) & 1) << 5); R = (st >> 1) * 16 + swz / 64; C = (st & 1) * 32 + (swz % 64) / 2; }
struct Unit { const char* A; unsigned va[2][2]; const char* B; int pm, pn, e, cnt, off; };
DEVI void glds16(const char* src, LDS unsigned char* dst) { __builtin_amdgcn_global_load_lds((const unsigned*)src, (LDS unsigned*)dst, 16, 0, 0); }

DEVI void dense_va(unsigned (&va)[2][2], int K) {
  const int tid = threadIdx.x;
#pragma unroll
  for (int h = 0; h < 2; ++h)
#pragma unroll
    for (int i = 0; i < 2; ++i) { int R, C; stage_rc(tid * 16 + i * 8192, R, C); va[h][i] = (unsigned)((128 * h + R) * K + C) * 2u; }
}
template <class Sched, class Epi>
DEVI void gemm_phase(LDS unsigned char* lds, int K, const Sched& S, const Epi& E) {
  const int tid = launder((int)threadIdx.x), wid = wave_id(tid), lane = tid & 63, wr = wid >> 2, wc = wid & 3, fr = lane & 15, fq = lane >> 4;
  const int nt = launder(K) / BK;
  unsigned vb[2];
#pragma unroll
  for (int i = 0; i < 2; ++i) { int R, C; stage_rc(tid * 16 + i * 8192, R, C); vb[i] = (unsigned)(R * K + C) * 2u; }
  const size_t kstep = (size_t)(BK * 2), hstep = (size_t)HALF * K * 2;
  const unsigned ldsw = (unsigned)wid * 1024u;
  const int aoff = lds_byte(wr * 64 + fr, fq * 8), boff = lds_byte(wc * 32 + fr, fq * 8);
#define G8_SA(b, h) (((b) * 2 + (h)) * HTB)
#define G8_SB(b, h) ((4 + (b) * 2 + (h)) * HTB)
#define G8_STAGE(bufoff, gbase, v) do { glds16((gbase) + (v)[0], lds + (bufoff) + ldsw); glds16((gbase) + (v)[1], lds + (bufoff) + ldsw + 8192); } while (0)
#define G8_STAGEA(bufoff, gbase, h) do { glds16((gbase) + G8_VAC(h, 0), lds + (bufoff) + ldsw); glds16((gbase) + G8_VAC(h, 1), lds + (bufoff) + ldsw + 8192); } while (0)
#define G8_LDA(dst, b, h) do { _Pragma("unroll") for (int m = 0; m < 4; ++m) _Pragma("unroll") for (int k = 0; k < 2; ++k) dst[m][k] = *(const LDS h16x8*)(lds + G8_SA(b, h) + aoff + m * 2048 + k * 1024); } while (0)
#define G8_LDB(dst, b, h) do { _Pragma("unroll") for (int n = 0; n < 2; ++n) _Pragma("unroll") for (int k = 0; k < 2; ++k) dst[n][k] = *(const LDS h16x8*)(lds + G8_SB(b, h) + boff + n * 2048 + k * 1024); } while (0)
#define G8_MMA(ai, bj, At, Bt) do { __builtin_amdgcn_s_setprio(1); _Pragma("unroll") for (int m = 0; m < 4; ++m) _Pragma("unroll") for (int n = 0; n < 2; ++n) _Pragma("unroll") for (int k = 0; k < 2; ++k) \
        acc[ai][bj][m][n] = __builtin_amdgcn_mfma_f32_16x16x32_f16(Bt[n][k], At[m][k], acc[ai][bj][m][n], 0, 0, 0); __builtin_amdgcn_s_setprio(0); } while (0)
#define G8_WAIT_V(n) asm volatile("s_waitcnt vmcnt(" #n ")" ::: "memory")
#define G8_WAIT_L(n) asm volatile("s_waitcnt lgkmcnt(" #n ")" ::: "memory")
#define G8_BAR __builtin_amdgcn_s_barrier()
#define G8_SCHED __builtin_amdgcn_sched_barrier(0)
  Unit cur, nxt; int ui = 0;
  if (!S.next(0, cur)) return;
  unsigned vd[2][2];
  if (!Sched::GATHER) dense_va(vd, K);
#define G8_VAC(h, i) (Sched::GATHER ? cur.va[h][i] : vd[h][i])
#define G8_VAN(h, i) (Sched::GATHER ? nxt.va[h][i] : vd[h][i])
  f32x4 acc[2][2][4][2];
#pragma unroll
  for (int a = 0; a < 2; ++a)
#pragma unroll
    for (int b = 0; b < 2; ++b)
#pragma unroll
      for (int m = 0; m < 4; ++m)
#pragma unroll
        for (int n = 0; n < 2; ++n) acc[a][b][m][n] = (f32x4){0.f, 0.f, 0.f, 0.f};
  h16x8 At[4][2], B0[2][2], B1[2][2];
  const char* cA = cur.A; const char* cB = cur.B;
  G8_STAGE(G8_SB(0, 0), cB, vb); G8_STAGE(G8_SB(0, 1), cB + hstep, vb); G8_STAGEA(G8_SA(0, 0), cA, 0); G8_STAGEA(G8_SA(0, 1), cA, 1);
  if (wr == 1) G8_BAR;
  G8_WAIT_V(2); G8_BAR;
  G8_STAGE(G8_SB(1, 0), cB + kstep, vb); G8_STAGEA(G8_SA(1, 0), cA + kstep, 0); G8_STAGE(G8_SB(1, 1), cB + hstep + kstep, vb);
  G8_WAIT_V(6); G8_BAR;
  for (;;) {
    const bool has_next = S.next(ui + 1, nxt);
    if (!has_next) nxt = cur;
    const char* nA = nxt.A; const char* nB = nxt.B;
#pragma unroll 1
    for (int t = 0; t < nt; t += 2) {
      const bool last = (t == nt - 2);
      const char* a1 = cA + (size_t)(t + 1) * kstep;
      const char* a2 = last ? nA : cA + (size_t)(t + 2) * kstep; const char* b2 = last ? nB : cB + (size_t)(t + 2) * kstep;
      const char* a3 = a2 + kstep; const char* b3 = b2 + kstep;
#define G8_STAGE2(bufoff, gbase, h) do { glds16((gbase) + (last ? G8_VAN(h, 0) : G8_VAC(h, 0)), lds + (bufoff) + ldsw); glds16((gbase) + (last ? G8_VAN(h, 1) : G8_VAC(h, 1)), lds + (bufoff) + ldsw + 8192); } while (0)
      G8_LDB(B0, 0, 0); G8_LDB(B1, 0, 1); G8_SCHED; G8_LDA(At, 0, 0); G8_STAGEA(G8_SA(1, 1), a1, 1);
      G8_WAIT_V(8); G8_WAIT_L(0); G8_BAR; G8_MMA(0, 0, At, B0); G8_MMA(0, 1, At, B1); G8_BAR; G8_SCHED;
      G8_LDA(At, 0, 1); G8_STAGE(G8_SB(0, 0), b2, vb); G8_STAGE(G8_SB(0, 1), b2 + hstep, vb); G8_STAGE2(G8_SA(0, 0), a2, 0);
      G8_WAIT_V(8); G8_WAIT_L(0); G8_BAR; G8_MMA(1, 0, At, B0); G8_MMA(1, 1, At, B1); G8_BAR; G8_SCHED;
      G8_LDB(B0, 1, 0); G8_LDB(B1, 1, 1); G8_SCHED; G8_LDA(At, 1, 0); G8_STAGE2(G8_SA(0, 1), a2, 1);
      G8_WAIT_V(8); G8_WAIT_L(0); G8_BAR; G8_MMA(0, 0, At, B0); G8_MMA(0, 1, At, B1); G8_BAR; G8_SCHED;
      G8_LDA(At, 1, 1); G8_STAGE(G8_SB(1, 0), b3, vb); G8_STAGE(G8_SB(1, 1), b3 + hstep, vb); G8_STAGE2(G8_SA(1, 0), a3, 0);
      G8_WAIT_V(8); G8_WAIT_L(0); G8_BAR; G8_MMA(1, 0, At, B0); G8_MMA(1, 1, At, B1); G8_BAR; G8_SCHED;
    }
#undef G8_STAGE2
    if (wr == 0) G8_BAR;
    E(acc, cur, wr, wc, fr, fq);
    if (!has_next) break;
#pragma unroll
    for (int a = 0; a < 2; ++a)
#pragma unroll
      for (int b = 0; b < 2; ++b)
#pragma unroll
        for (int m = 0; m < 4; ++m)
#pragma unroll
          for (int n = 0; n < 2; ++n) acc[a][b][m][n] = (f32x4){0.f, 0.f, 0.f, 0.f};
    cur = nxt; cA = nA; cB = nB; ++ui;
    if (wr == 1) G8_BAR;
  }
  G8_WAIT_V(0);
  G8_BAR;
#undef G8_SA
#undef G8_STAGEA
#undef G8_VAC
#undef G8_VAN
#undef G8_SB
#undef G8_STAGE
#undef G8_LDA
#undef G8_LDB
#undef G8_MMA
#undef G8_WAIT_V
#undef G8_WAIT_L
#undef G8_BAR
#undef G8_SCHED
}
struct DenseOrder {
  static constexpr bool GATHER = false;
  const h16* A; const h16* Bt; int K, nM, nN, G, c;
  DEVI bool next(int i, Unit& u) const {
    const int nwg = nM * nN; const long L = (long)i * G + c; if (L >= nwg) return false;
    int wgid = (int)L; { const int q = nwg / 8, r = nwg % 8, xcd = wgid % 8, off = wgid / 8; wgid = (xcd < r ? xcd * (q + 1) : r * (q + 1) + (xcd - r) * q) + off; }
    const int nig = 8 * nN, gid = wgid / nig, fm = gid * 8, gsz = (nM - fm) < 8 ? (nM - fm) : 8;
    u.pm = fm + ((wgid % nig) % gsz); u.pn = (wgid % nig) / gsz; u.e = 0; u.cnt = 0x7fffffff; u.off = 0;
    u.A = (const char*)(A + (size_t)u.pm * 256 * K); u.B = (const char*)(Bt + (size_t)u.pn * 256 * K);
    u.va[0][0] = u.va[0][1] = u.va[1][0] = u.va[1][1] = 0u;
    return true;
  }
};
}


DEVI h16x4 pack4(float a, float b, float c, float d) { h16x4 v; v[0] = (h16)a; v[1] = (h16)b; v[2] = (h16)c; v[3] = (h16)d; return v; }

template <class F>
DEVI void transpose_item(const float* src, int N, int kb, int nb, h16* dst, int ldd, F drow, LDS float* scr, int lane) {
#pragma unroll 8
  for (int i = 0; i < 32; ++i) {
    const int kk = 2 * i + (lane >> 5), n = nb * 32 + (lane & 31);
    scr[kk * 33 + (lane & 31)] = (n < N) ? src[(size_t)(kb * 64 + kk) * N + n] : 0.f;
  }
  asm volatile("s_waitcnt lgkmcnt(0)" ::: "memory");
  const int c = lane & 7;
#pragma unroll
  for (int j = 0; j < 4; ++j) {
    const int nl = (lane >> 3) + 8 * j, n = nb * 32 + nl;
    h16x8 v;
#pragma unroll
    for (int e = 0; e < 8; ++e) v[e] = (h16)scr[(c * 8 + e) * 33 + nl];
    if (n < N) *(h16x8*)(dst + (size_t)drow(n) * ldd + kb * 64 + c * 8) = v;
  }
  asm volatile("s_waitcnt lgkmcnt(0)" ::: "memory");
}

DEVI void phase0(PRef p, LDS unsigned char* lds) {
  const int tid = launder((int)threadIdx.x), lane = tid & 63, wave = wave_id(tid), G = gridDim.x;
  const int gw = blockIdx.x * 8 + wave, NW = G * 8;
  {
    const float* c = p.in[1]; const float* wada = p.in[2]; float* mp = (float*)(p.ws + WS_MODP);
    for (int u = gw; u < 96 * 8; u += NW) {
      const int cgp = u % 96, ks = u / 96, j = cgp * 64 + lane;
      float a0 = 0.f, a1 = 0.f, a2 = 0.f, a3 = 0.f;
      for (int k0 = ks * 128; k0 < ks * 128 + 128; k0 += 16) {
        float w[16];
#pragma unroll
        for (int u = 0; u < 16; ++u) w[u] = wada[(size_t)(k0 + u) * 6144 + j];
#pragma unroll
        for (int u = 0; u < 16; ++u) {
          const int k = k0 + u;
          a0 = fmaf(silu_f(c[k]), w[u], a0); a1 = fmaf(silu_f(c[1024 + k]), w[u], a1);
          a2 = fmaf(silu_f(c[2048 + k]), w[u], a2); a3 = fmaf(silu_f(c[3072 + k]), w[u], a3);
        }
      }
      mp[(size_t)(ks * 4 + 0) * 6144 + j] = a0; mp[(size_t)(ks * 4 + 1) * 6144 + j] = a1;
      mp[(size_t)(ks * 4 + 2) * 6144 + j] = a2; mp[(size_t)(ks * 4 + 3) * 6144 + j] = a3;
    }
  }
  {
    LDS float* scr = (LDS float*)lds + wave * (64 * 33);
    constexpr int I_IN = 16 * 99, I_OUT = 16 * 32, I_G = 32 * 128, I_U = 32 * 128, I_D = 32 * 128, I_RG = 32;
    constexpr int NIT = I_IN + I_OUT + I_G + I_U + I_D + I_RG;
    for (int it = gw; it < NIT; it += NW) {
      int r = it;
      if (r < I_IN) {
        transpose_item(p.in[8], 3144, r / 99, r % 99, (h16*)(p.ws + WS_WIN), 1024,
                       [](int n) { const int dl = n < 2112 ? n : (n < 2120 ? 3136 + (n - 2112) : (n < 2632 ? 2112 + (n - 2120) : 2624 + (n - 2632)));
                                     const int d = dl & 63, sx = (dl >> 6) & 3;
                                     return (dl & ~255) + 128 * (d >> 5) + 32 * sx + 16 * ((d >> 2) & 1) + 4 * ((d >> 3) & 3) + (d & 3); }, scr, lane);
        continue;
      }
      r -= I_IN;
      if (r < I_OUT) { transpose_item(p.in[16], 1024, r / 32, r % 32, (h16*)(p.ws + WS_WOUT), 1024, [](int n) { return (n & ~31) + 16 * ((n >> 2) & 1) + 4 * ((n >> 3) & 3) + (n & 3); }, scr, lane); continue; }
      r -= I_OUT;
      if (r < I_G) { const int e = r >> 7, q = r & 127;
        transpose_item(p.in[21] + (size_t)e * 1024 * 256, 256, q >> 3, q & 7, (h16*)(p.ws + WS_WGU) + (size_t)e * 512 * 1024, 1024, [](int f) { return (f >> 4) * 32 + (f & 15); }, scr, lane); continue; }
      r -= I_G;
      if (r < I_U) { const int e = r >> 7, q = r & 127;
        transpose_item(p.in[22] + (size_t)e * 1024 * 256, 256, q >> 3, q & 7, (h16*)(p.ws + WS_WGU) + (size_t)e * 512 * 1024, 1024, [](int f) { return (f >> 4) * 32 + 16 + (f & 15); }, scr, lane); continue; }
      r -= I_U;
      if (r < I_D) { const int e = r >> 7, q = r & 127;
        transpose_item(p.in[23] + (size_t)e * 256 * 1024, 1024, q >> 5, q & 31, (h16*)(p.ws + WS_WDN) + (size_t)e * 1024 * 256, 256, [](int n) { return (n & ~31) + 16 * ((n >> 2) & 1) + 4 * ((n >> 3) & 3) + (n & 3); }, scr, lane); continue; }
      r -= I_D;
      if (r < 16) transpose_item(p.in[11] + (size_t)(r >> 1) * 4096, 64, 0, r & 1, (h16*)(p.ws + WS_WRG) + (size_t)(r >> 1) * 128 * 64, 64, [](int n) { return n; }, scr, lane);
      else transpose_item(p.in[13] + (size_t)((r - 16) >> 1) * 4096, 64, 0, r & 1, (h16*)(p.ws + WS_WRG) + (size_t)((r - 16) >> 1) * 128 * 64, 64, [](int n) { return 64 + n; }, scr, lane);
    }
  }
  {
    h16* wrh = (h16*)(p.ws + WS_WRH); h16* wrl = (h16*)(p.ws + WS_WRL);
    for (int i = blockIdx.x * NTHR + tid; i < 48 * 1024; i += G * NTHR) {
      const int col = i >> 10, k = i & 1023;
      const float w = (col < 4) ? p.in[17][k * 4 + col] : (col < 36 ? p.in[19][k * 32 + (col - 4)] : 0.f);
      const h16 hi = (h16)w;
      wrh[i] = hi; wrl[i] = (h16)(w - (float)hi);
    }
    float* ct = (float*)(p.ws + WS_ROPE); float* st = ct + 8192 * 32;
    for (int i = blockIdx.x * NTHR + tid; i < 8192 * 32; i += G * NTHR) {
      const int pos = i >> 5, f = i & 31;
      const double rev = (double)pos * ROPE_REV[f];
      const float fr = (float)(rev - __builtin_rint(rev));
      ct[i] = __builtin_amdgcn_cosf(fr); st[i] = __builtin_amdgcn_sinf(fr);
    }
  }
}

DEVI void phase1(PRef p, LDS unsigned char* lds) {
  const int tid = launder((int)threadIdx.x), lane = tid & 63, wave = wave_id(tid), G = gridDim.x;
  const int b = blockIdx.x & 3, bi = blockIdx.x >> 2, nbk = G >> 2;
  LDS float* mv = (LDS float*)lds;
  mod_to_lds(p, b, 0, mv); mod_to_lds(p, b, 1, mv + 1024);
  __syncthreads();
  f32x4 A[4], SH[4];
#pragma unroll
  for (int j = 0; j < 4; ++j) {
    const int k = 256 * j + 4 * lane;
    const f32x4 g = *(const f32x4*)(p.in[4] + k);
    A[j] = g * (*(LDS f32x4*)(mv + 1024 + k) + 1.f);
    SH[j] = *(LDS f32x4*)(mv + k);
  }
  const float* x = p.in[0]; h16* H = (h16*)(p.ws + WS_H);
  f32x4 vn[4];
  {
    const size_t tok = (size_t)b * SEQ + bi * 8 + wave;
#pragma unroll
    for (int j = 0; j < 4; ++j) vn[j] = *(const f32x4*)(x + tok * DM + 256 * j + 4 * lane);
  }
  for (int r = bi * 8 + wave; r < SEQ; r += nbk * 8) {
    const size_t tok = (size_t)b * SEQ + r;
    f32x4 v[4]; float ss = 0.f;
#pragma unroll
    for (int j = 0; j < 4; ++j) { v[j] = vn[j]; ss += v[j][0] * v[j][0] + v[j][1] * v[j][1] + v[j][2] * v[j][2] + v[j][3] * v[j][3]; }
    if (r + nbk * 8 < SEQ) {
#pragma unroll
      for (int j = 0; j < 4; ++j) vn[j] = *(const f32x4*)(x + (tok + nbk * 8) * DM + 256 * j + 4 * lane);
    }
    const float rstd = 1.0f / sqrtf(wave_sum(ss) * (1.f / 1024.f) + 1e-6f);
#pragma unroll
    for (int j = 0; j < 4; ++j) {
      const f32x4 y = v[j] * rstd * A[j] + SH[j];
      *(h16x4*)(H + tok * DM + 256 * j + 4 * lane) = pack4(y[0], y[1], y[2], y[3]);
    }
  }
}

DEVI h16x8 pack8(const f32x4& a, const f32x4& b) { h16x8 w; w[0] = (h16)a[0]; w[1] = (h16)a[1]; w[2] = (h16)a[2]; w[3] = (h16)a[3]; w[4] = (h16)b[0]; w[5] = (h16)b[1]; w[6] = (h16)b[2]; w[7] = (h16)b[3]; return w; }
struct EpiInProj {
  unsigned char* ws;
  DEVI void operator()(const f32x4 (&acc)[2][2][4][2], const g8::Unit& u, int wr, int wc, int fr, int fq) const {
    const float* cosT = (const float*)(ws + WS_ROPE); const float* sinT = cosT + 8192 * 32;
    const int g = 4 * u.pn + wc;
    if (g > 49) return;
    const int d0 = 8 * fq;
    const int tok0 = u.pm * 256 + 64 * wr + fr;
    if (g < 16 || (g >= 24 && g <= 32)) {
      float scl; h16* dst; int ld;
      if (g < 8) { scl = 0.125f * 1.4426950408889634f; dst = (h16*)(ws + WS_Q) + g * 64; ld = 512; }
      else if (g < 16) { scl = 1.f; dst = (h16*)(ws + WS_K) + (g - 8) * 64; ld = 512; }
      else if (g < 32) { scl = 0.125f; dst = (h16*)(ws + WS_QI) + (g - 24) * 64; ld = 512; }
      else { scl = 1.f; dst = (h16*)(ws + WS_KI); ld = 64; }
#pragma unroll
      for (int ai = 0; ai < 2; ++ai) {
        f32x4 ca[4], cb[4], sa[4], sb[4];
#pragma unroll
        for (int m = 0; m < 4; ++m) {
          const int pos = (tok0 + 128 * ai + 16 * m) & 8191;
          ca[m] = *(const f32x4*)(cosT + pos * 32 + d0); cb[m] = *(const f32x4*)(cosT + pos * 32 + d0 + 4);
          sa[m] = *(const f32x4*)(sinT + pos * 32 + d0); sb[m] = *(const f32x4*)(sinT + pos * 32 + d0 + 4);
        }
        __builtin_amdgcn_sched_barrier(0);
#pragma unroll
        for (int m = 0; m < 4; ++m) {
          const int tok = tok0 + 128 * ai + 16 * m;
          const f32x4 xa = acc[ai][0][m][0], xb = acc[ai][0][m][1], ya = acc[ai][1][m][0], yb = acc[ai][1][m][1];
          h16* o = dst + (size_t)tok * ld;
          *(h16x8*)(o + d0) = pack8((xa * ca[m] - ya * sa[m]) * scl, (xb * cb[m] - yb * sb[m]) * scl);
          *(h16x8*)(o + 32 + d0) = pack8((ya * ca[m] + xa * sa[m]) * scl, (yb * cb[m] + xb * sb[m]) * scl);
        }
      }
    } else if (g < 24) {
#pragma unroll
      for (int ai = 0; ai < 2; ++ai)
#pragma unroll
        for (int m = 0; m < 4; ++m) {
          const int tok = tok0 + 128 * ai + 16 * m;
          const int b = tok >> 13, pos = tok & 8191;
          const f32x4 xa = acc[ai][0][m][0], xb = acc[ai][0][m][1], ya = acc[ai][1][m][0], yb = acc[ai][1][m][1];
          h16* vt = (h16*)(ws + WS_VT) + (size_t)(b * 8 + (g - 16)) * 64 * 8192 + vt_perm(pos);
#pragma unroll
          for (int e = 0; e < 4; ++e) {
            vt[(size_t)(d0 + e) * 8192] = (h16)xa[e]; vt[(size_t)(d0 + 4 + e) * 8192] = (h16)xb[e];
            vt[(size_t)(32 + d0 + e) * 8192] = (h16)ya[e]; vt[(size_t)(36 + d0 + e) * 8192] = (h16)yb[e];
          }
        }
    } else if (g < 49) {
      h16* dst = (g < 41) ? (h16*)(ws + WS_XR) + (g - 33) * 64 : (h16*)(ws + WS_XG) + (g - 41) * 64;
#pragma unroll
      for (int ai = 0; ai < 2; ++ai)
#pragma unroll
        for (int m = 0; m < 4; ++m) {
          h16* o = dst + (size_t)(tok0 + 128 * ai + 16 * m) * 512;
          *(h16x8*)(o + d0) = pack8(acc[ai][0][m][0], acc[ai][0][m][1]);
          *(h16x8*)(o + 32 + d0) = pack8(acc[ai][1][m][0], acc[ai][1][m][1]);
        }
    } else if (fq == 0) {
      const float sc = 0.35355339059327373f;
#pragma unroll
      for (int ai = 0; ai < 2; ++ai)
#pragma unroll
        for (int m = 0; m < 4; ++m) {
          float* wi = (float*)(ws + WS_WI) + (size_t)(tok0 + 128 * ai + 16 * m) * 8;
          *(f32x4*)wi = acc[ai][0][m][0] * sc; *(f32x4*)(wi + 4) = acc[ai][0][m][1] * sc;
        }
    }
  }
};

DEVI void phase2(PRef p, LDS unsigned char* lds) {
  g8::DenseOrder S{(const h16*)(p.ws + WS_H), (const h16*)(p.ws + WS_WIN), DM, 128, 13, (int)gridDim.x, (int)blockIdx.x};
  EpiInProj E{p.ws};
  g8::gemm_phase(lds, DM, S, E);
}

constexpr int CROW = 1040;
constexpr int RNN_XG = 64 * CROW;
constexpr int RNN_CARRY = 2 * 64 * CROW;
template <int MODE>
DEVI void rnn_item(PRef p, LDS unsigned char* lds, int b, int cr) {
  const int tid = launder((int)threadIdx.x), lane = tid & 63, wave = wave_id(tid), l31 = lane & 31, half = lane >> 5;
  const h16* XR = (const h16*)(p.ws + WS_XR);
  {
    const int chg = tid & 63, tg = tid >> 6, pos0 = cr * 64 + 8 * tg;
    h16x8 xin[11];
#pragma unroll
    for (int i = 0; i < 11; ++i) {
      const int pos = pos0 + i - 3;
      if (pos >= 0) xin[i] = *(const h16x8*)(XR + ((size_t)b * SEQ + pos) * 512 + chg * 8);
      else {
#pragma unroll
        for (int e = 0; e < 8; ++e) xin[i][e] = (h16)0.f;
      }
    }
    float cw[4][8], cb[8];
#pragma unroll
    for (int e = 0; e < 8; ++e) {
      cb[e] = p.in[10][chg * 8 + e];
#pragma unroll
      for (int j = 0; j < 4; ++j) cw[j][e] = p.in[9][j * 512 + chg * 8 + e];
    }
#pragma unroll
    for (int tt = 0; tt < 8; ++tt) {
      h16x8 o;
#pragma unroll
      for (int e = 0; e < 8; ++e) {
        float v = cb[e];
#pragma unroll
        for (int j = 0; j < 4; ++j) v = fmaf(cw[j][e], (float)xin[tt + j][e], v);
        o[e] = (h16)v;
      }
      *(LDS h16x8*)(lds + (8 * tg + tt) * CROW + chg * 16) = o;
    }
  }
  if (MODE == 1) {
    const float2* ag = (const float2*)(p.ws + WS_AGG) + (size_t)b * 128 * 512 + tid;
    float carry = 0.f; int c2 = 0;
    for (; c2 + 8 <= cr; c2 += 8) {
      float2 v[8];
#pragma unroll
      for (int u = 0; u < 8; ++u) v[u] = ag[(size_t)(c2 + u) * 512];
#pragma unroll
      for (int u = 0; u < 8; ++u) carry = fmaf(v[u].x, carry, v[u].y);
    }
    for (; c2 < cr; ++c2) { const float2 v = ag[(size_t)c2 * 512]; carry = fmaf(v.x, carry, v.y); }
    ((LDS float*)(lds + RNN_CARRY))[tid] = carry;
  }
  if (MODE == 1) {
    const h16* XG = (const h16*)(p.ws + WS_XG) + ((size_t)b * SEQ + cr * 64) * 512;
#pragma unroll
    for (int i = 0; i < 8; ++i) { const int c = tid + NTHR * i, row = c >> 6, cc = c & 63; *(LDS h16x8*)(lds + RNN_XG + row * CROW + cc * 16) = *(const h16x8*)(XG + (size_t)row * 512 + cc * 8); }
  }
  __syncthreads();
  const int n = wave;
  const h16* WRG = (const h16*)(p.ws + WS_WRG) + (size_t)n * 128 * 64;
  float* AGG = (float*)(p.ws + WS_AGG);
#pragma unroll 1
  for (int dt = 0; dt < 2; ++dt) {
    h16x8 wa[4], wx[4];
#pragma unroll
    for (int kk = 0; kk < 4; ++kk) {
      wa[kk] = *(const h16x8*)(WRG + (size_t)(32 * dt + l31) * 64 + 16 * kk + 8 * half);
      wx[kk] = *(const h16x8*)(WRG + (size_t)(64 + 32 * dt + l31) * 64 + 16 * kk + 8 * half);
    }
    f32x16 ra[2], rx[2];
#pragma unroll
    for (int ti = 0; ti < 2; ++ti) {
#pragma unroll
      for (int r = 0; r < 16; ++r) { ra[ti][r] = 0.f; rx[ti][r] = 0.f; }
#pragma unroll
      for (int kk = 0; kk < 4; ++kk) {
        const h16x8 af = *(LDS h16x8*)(lds + (32 * ti + l31) * CROW + (n * 64 + 16 * kk + 8 * half) * 2);
        ra[ti] = mfma16(af, wa[kk], ra[ti]);
        rx[ti] = mfma16(af, wx[kk], rx[ti]);
      }
    }
    const int ch = n * 64 + 32 * dt + l31;
    const float ba = p.in[12][ch], bx = p.in[14][ch], lam = p.in[15][ch];
    const float c8 = -8.f * log1pf(__expf(-lam));
#pragma unroll
    for (int ti = 0; ti < 2; ++ti)
#pragma unroll
      for (int r = 0; r < 16; ++r) {
        const int tk = 32 * ti + (r & 3) + 8 * (r >> 2) + 4 * half;
        const float cv = (float)*(LDS h16*)(lds + tk * CROW + ch * 2);
        const float rr = sigmoid_f(ra[ti][r] + ba), ii = sigmoid_f(rx[ti][r] + bx);
        const float la = c8 * rr;
        ra[ti][r] = __expf(la);
        const float x2 = 2.f * la;
        const float om = -x2 * fmaf(x2 * 0.5f, fmaf(x2 * (1.f / 3.f), fmaf(x2 * 0.25f, fmaf(x2, 0.2f, 1.f), 1.f), 1.f), 1.f);
        rx[ti][r] = __builtin_amdgcn_sqrtf(om) * (ii * cv);
      }
    float P[8], Hs[8];
#pragma unroll
    for (int sg = 0; sg < 8; ++sg) {
      const int ti = sg >> 2, q = sg & 3;
      float pp = 1.f, hh = 0.f;
#pragma unroll
      for (int i = 0; i < 4; ++i) { const float a = ra[ti][4 * q + i], bb = rx[ti][4 * q + i]; hh = fmaf(a, hh, bb); pp *= a; }
      P[sg] = pp; Hs[sg] = hh;
    }
    float carry = 0.f, prod = 1.f;
    if (MODE == 1) carry = ((LDS float*)(lds + RNN_CARRY))[ch];
    float cin[8];
#pragma unroll
    for (int sg = 0; sg < 8; ++sg)
#pragma unroll
      for (int ow = 0; ow < 2; ++ow) {
        const float tmp = fmaf(P[sg], carry, Hs[sg]);
        const float tp = P[sg] * prod;
        if (half == ow) cin[sg] = carry;
        const auto swc = __builtin_amdgcn_permlane32_swap(__float_as_uint(tmp), __float_as_uint(tmp), false, false);
        const auto swp = __builtin_amdgcn_permlane32_swap(__float_as_uint(tp), __float_as_uint(tp), false, false);
        carry = __uint_as_float(swc[ow]); prod = __uint_as_float(swp[ow]);
      }
    if (MODE == 0) {
      if (half == 0) { float* ag = AGG + ((size_t)(b * 128 + cr) * 512 + ch) * 2; ag[0] = prod; ag[1] = carry; }
    } else {
#pragma unroll
      for (int sg = 0; sg < 8; ++sg) {
        const int ti = sg >> 2, q = sg & 3;
        float hh = cin[sg];
#pragma unroll
        for (int i = 0; i < 4; ++i) {
          hh = fmaf(ra[ti][4 * q + i], hh, rx[ti][4 * q + i]);
          LDS h16* xp = (LDS h16*)(lds + RNN_XG + (32 * ti + 8 * q + 4 * half + i) * CROW + ch * 2);
          *xp = (h16)(hh * gelu_tanh_f((float)*xp));
        }
      }
    }
  }
  __syncthreads();
  if (MODE == 1) {
    h16* Y = (h16*)(p.ws + WS_H) + ((size_t)b * SEQ + cr * 64) * DM + 512;
#pragma unroll
    for (int i = 0; i < 8; ++i) { const int c = tid + NTHR * i, row = c >> 6, cc = c & 63; *(h16x8*)(Y + (size_t)row * DM + cc * 8) = *(LDS h16x8*)(lds + RNN_XG + row * CROW + cc * 16); }
    __syncthreads();
  }
}

constexpr int IDX_NB = 256, IDX_CAP = 128;
constexpr int IL_HIST = 0, IL_CS = 65536, IL_CK = IL_CS + 64 * IDX_CAP * 4, IL_KI = IL_CK + 64 * IDX_CAP * 2, IL_KISZ = 128 * LROW, IL_ST = IL_KI + 2 * IL_KISZ;
static_assert(IL_ST + 4096 <= LDS_BYTES, "indexer LDS map");

DEVI f32x4 mfma16s(h16x8 a, h16x8 b, f32x4 c) { return __builtin_amdgcn_mfma_f32_16x16x32_f16(a, b, c, 0, 0, 0); }
DEVI void idx_score(LDS unsigned char* kit, int kh, int l15, int g4, const h16x8 (&qf)[8][2], const float (&wq)[8], f32x4 (&sc)[4]) {
  h16x8 kf[4][2];
#pragma unroll
  for (int kt = 0; kt < 4; ++kt)
#pragma unroll
    for (int ks = 0; ks < 2; ++ks) kf[kt][ks] = *(LDS h16x8*)(kit + (64 * kh + 16 * kt + l15) * LROW + (4 * ks + g4) * 16);
#pragma unroll
  for (int kt = 0; kt < 4; ++kt) sc[kt] = (f32x4){0.f, 0.f, 0.f, 0.f};
  f32x4 accA[4], accB[4];
#define IDX_MM(ACC, h) _Pragma("unroll") for (int kt = 0; kt < 4; ++kt) { ACC[kt] = mfma16s(kf[kt][0], qf[h][0], (f32x4){0.f, 0.f, 0.f, 0.f}); ACC[kt] = mfma16s(kf[kt][1], qf[h][1], ACC[kt]); }
#define IDX_RS(ACC, h) _Pragma("unroll") for (int kt = 0; kt < 4; ++kt) _Pragma("unroll") for (int r = 0; r < 4; ++r) sc[kt][r] = __builtin_fmaf(wq[h], __int_as_float(max(__float_as_int(ACC[kt][r]), 0)), sc[kt][r]);
  IDX_MM(accA, 0)
  IDX_MM(accB, 1) IDX_RS(accA, 0)
  IDX_MM(accA, 2) IDX_RS(accB, 1)
  IDX_MM(accB, 3) IDX_RS(accA, 2)
  IDX_MM(accA, 4) IDX_RS(accB, 3)
  IDX_MM(accB, 5) IDX_RS(accA, 4)
  IDX_MM(accA, 6) IDX_RS(accB, 5)
  IDX_MM(accB, 7) IDX_RS(accA, 6)
  IDX_RS(accB, 7)
#undef IDX_MM
#undef IDX_RS
}

template <int MODE>
DEVI void idx_pass(LDS unsigned char* lds, const h16* KIb, int N, int stride, int qg, int kh,
                   const h16* QIrow0, const float* WIrow0, float qinv, float qoff, int bstar, h16* scbase) {
  const int tid = launder((int)threadIdx.x), lane = tid & 63, l15 = lane & 15, g4 = lane >> 4;
  const int q = 16 * qg + l15;
  h16x8 qf[8][2]; float wq[8];
  {
    const h16* QI = QIrow0 + (size_t)q * 512;
#pragma unroll
    for (int h = 0; h < 8; ++h)
#pragma unroll
      for (int ks = 0; ks < 2; ++ks) qf[h][ks] = *(const h16x8*)(QI + h * 64 + 32 * ks + 8 * g4);
    const float* WI = WIrow0 + (size_t)q * 8;
#pragma unroll
    for (int h = 0; h < 8; ++h) wq[h] = WI[h];
#pragma unroll
    for (int h = 0; h < 8; ++h) { asm volatile("" : "+v"(qf[h][0])); asm volatile("" : "+v"(qf[h][1])); asm volatile("" : "+v"(wq[h])); }
  }
  LDS unsigned* hist = (LDS unsigned*)(lds + IL_HIST);
  LDS unsigned* st = (LDS unsigned*)(lds + IL_ST);
  const int nst = (N + 127) >> 7;
  const int lr = tid >> 3, lc = tid & 7;
  h16x8 r0, r1;
  r0 = *(const h16x8*)(KIb + (size_t)lr * 64 + lc * 8); r1 = *(const h16x8*)(KIb + (size_t)(lr + 64) * 64 + lc * 8);
  *(LDS h16x8*)(lds + IL_KI + lr * LROW + lc * 16) = r0; *(LDS h16x8*)(lds + IL_KI + (lr + 64) * LROW + lc * 16) = r1;
  __syncthreads();
  float vmin = INFINITY, vmax = -INFINITY;
  int cur = 0;
  for (int s = 0; s < nst; s += stride) {
    const int nx = s + stride;
    { const int nxc = nx < nst ? nx : s;
      r0 = *(const h16x8*)(KIb + (size_t)(128 * nxc + lr) * 64 + lc * 8); r1 = *(const h16x8*)(KIb + (size_t)(128 * nxc + lr + 64) * 64 + lc * 8); }
    const bool active = 128 * s + 64 * kh < N;
    f32x4 sc[4];
    if (active) {
      idx_score(lds + IL_KI + cur * IL_KISZ, kh, l15, g4, qf, wq, sc);
#pragma unroll
      for (int kt = 0; kt < 4; ++kt) asm volatile("" : "+v"(sc[kt]));
    }
    {
      *(LDS h16x8*)(lds + IL_KI + (cur ^ 1) * IL_KISZ + lr * LROW + lc * 16) = r0;
      *(LDS h16x8*)(lds + IL_KI + (cur ^ 1) * IL_KISZ + (lr + 64) * LROW + lc * 16) = r1;
    }
    if (active) {
      if (MODE == 0) {
#pragma unroll
        for (int kt = 0; kt < 4; ++kt)
#pragma unroll
          for (int r = 0; r < 4; ++r) { vmin = fminf(vmin, sc[kt][r]); vmax = fmaxf(vmax, sc[kt][r]); }
      } else if (MODE == 1) {
        h16* scp = scbase + ((size_t)((s * 2 + kh) * 4) * 1024 + q * 16 + 4 * g4);
#pragma unroll
        for (int kt = 0; kt < 4; ++kt) {
          const h16x4 hv = pack4(sc[kt][0], sc[kt][1], sc[kt][2], sc[kt][3]);
          *(h16x4*)(scp + kt * 1024) = hv;
#pragma unroll
          for (int r = 0; r < 4; ++r) {
            const float xb = fminf(fmaxf(__builtin_fmaf((float)hv[r], qinv, qoff), 0.f), (float)(IDX_NB - 1));
            const int bin = (int)xb;
            __hip_atomic_fetch_add(&hist[bin * 64 + q], 1u, __ATOMIC_RELAXED, __HIP_MEMORY_SCOPE_WORKGROUP);
          }
        }
      }
    }
    __syncthreads();
    cur ^= 1;
  }
  if (MODE == 0) {
    __hip_atomic_fetch_min(&st[q], fkey(vmin), __ATOMIC_RELAXED, __HIP_MEMORY_SCOPE_WORKGROUP);
    __hip_atomic_fetch_max(&st[64 + q], fkey(vmax), __ATOMIC_RELAXED, __HIP_MEMORY_SCOPE_WORKGROUP);
  }
}

DEVI int idx_bin(float sv, float qinv, float qoff) { return (int)fminf(fmaxf(__builtin_fmaf(sv, qinv, qoff), 0.f), (float)(IDX_NB - 1)); }
DEVI float idx_bin_lower_bound(int target, float qinv, float qoff) {
  if (target <= 0) return -INFINITY;
  if (target > IDX_NB - 1) return INFINITY;
  unsigned lo = 0x03FFu, hi = 0xFC00u;
  auto val = [](unsigned k) { const unsigned short hbits = (unsigned short)((k & 0x8000u) ? (k & 0x7FFFu) : (~k & 0xFFFFu)); return (float)__builtin_bit_cast(h16, hbits); };
  if (idx_bin(val(hi), qinv, qoff) < target) return INFINITY;
  while (lo < hi) { const unsigned mid = (lo + hi) >> 1; if (idx_bin(val(mid), qinv, qoff) >= target) hi = mid; else lo = mid + 1; }
  return val(lo);
}
DEVI void idx_stream_step(LDS unsigned char* lds, LDS unsigned* st, const unsigned long long (&cur)[4], int s, int kh, int q, int lane, int g4, float thi, float tlo) {
  unsigned nib = 0u;
#pragma unroll
  for (int kt = 3; kt >= 0; --kt) {
    const h16x4 hv = __builtin_bit_cast(h16x4, cur[kt]);
#pragma unroll
    for (int r = 3; r >= 0; --r) {
      const float sv = (float)hv[r];
      const unsigned long long ms = __builtin_amdgcn_ballot_w64(sv >= thi);
      asm("v_addc_co_u32_e64 %0, vcc, %0, %0, %1" : "+v"(nib) : "s"(ms) : "vcc");
      const bool cand = (sv >= tlo) && !(sv >= thi);
      if (__builtin_amdgcn_ballot_w64(cand) != 0ull) {
        if (cand) {
          const unsigned pos = __hip_atomic_fetch_add(&st[128 + q], 1u, __ATOMIC_RELAXED, __HIP_MEMORY_SCOPE_WORKGROUP);
          if (pos < (unsigned)IDX_CAP) {
            ((LDS float*)(lds + IL_CS))[q * IDX_CAP + pos] = sv;
            ((LDS unsigned short*)(lds + IL_CK))[q * IDX_CAP + pos] = (unsigned short)(128 * s + 64 * kh + 16 * kt + 4 * g4 + r);
          }
        }
      }
    }
  }
  const unsigned oth = (unsigned)__shfl_xor((int)nib, 32);
  if (lane < 32) {
#pragma unroll
    for (int T = 0; T < 2; ++T) {
      const unsigned b0 = ((nib >> (8 * T)) & 15u) | (((oth >> (8 * T)) & 15u) << 4);
      const unsigned b1 = ((nib >> (8 * T + 4)) & 15u) | (((oth >> (8 * T + 4)) & 15u) << 4);
      ((LDS unsigned short*)(lds + IL_HIST))[q * 512 + (4 * s + 2 * kh + T) * 2 + (g4 & 1)] = (unsigned short)(b0 | (b1 << 8));
    }
  }
}
DEVI void idx_stream(LDS unsigned char* lds, int N, int qg, int kh, float thi, float tlo, const h16* scbase) {
  const int tid = launder((int)threadIdx.x), lane = tid & 63, l15 = lane & 15, g4 = lane >> 4;
  const int q = 16 * qg + l15;
  LDS unsigned* st = (LDS unsigned*)(lds + IL_ST);
  const int nv = (N - 64 * kh + 127) >> 7;
  const unsigned long long* scp = (const unsigned long long*)(scbase + ((size_t)(kh * 4) * 1024 + q * 16 + 4 * g4));
#define IDX_LD(dst, s_) do { const int sc_ = (s_) < nv ? (s_) : nv - 1; _Pragma("unroll") for (int kt = 0; kt < 4; ++kt) dst[kt] = __hip_atomic_load(scp + (size_t)sc_ * 2048 + kt * 256, __ATOMIC_RELAXED, __HIP_MEMORY_SCOPE_AGENT); } while (0)
  unsigned long long b0[4], b1[4], b2[4], b3[4];
  IDX_LD(b0, 0); IDX_LD(b1, 1); IDX_LD(b2, 2); IDX_LD(b3, 3);
  for (int s = 0; s < nv; s += 4) {
    idx_stream_step(lds, st, b0, s, kh, q, lane, g4, thi, tlo); IDX_LD(b0, s + 4);
    if (s + 1 < nv) idx_stream_step(lds, st, b1, s + 1, kh, q, lane, g4, thi, tlo);
    IDX_LD(b1, s + 5);
    if (s + 2 < nv) idx_stream_step(lds, st, b2, s + 2, kh, q, lane, g4, thi, tlo);
    IDX_LD(b2, s + 6);
    if (s + 3 < nv) idx_stream_step(lds, st, b3, s + 3, kh, q, lane, g4, thi, tlo);
    IDX_LD(b3, s + 7);
  }
#undef IDX_LD
}

DEVI void idx_item(PRef p, LDS unsigned char* lds, int b, int c) {
  const int tid = launder((int)threadIdx.x), lane = tid & 63, wave = wave_id(tid), l31 = lane & 31, half = lane >> 5;
  const int N = 64 * (c + 1);
  unsigned* MASK = (unsigned*)(p.ws + WS_MASK) + ((size_t)b * SEQ + 64 * c) * 256;
  if (N <= 256) {
    const int wpr = N >> 5;
    for (int i = tid; i < 64 * wpr; i += NTHR) MASK[(size_t)(i / wpr) * 256 + (i % wpr)] = 0xFFFFFFFFu;
    return;
  }
  const int qg = wave & 3, kh = wave >> 2, l15 = lane & 15, q = 16 * qg + l15;
  const h16* QIrow0 = (const h16*)(p.ws + WS_QI) + ((size_t)b * SEQ + 64 * c) * 512;
  const float* WIrow0 = (const float*)(p.ws + WS_WI) + ((size_t)b * SEQ + 64 * c) * 8;
  const h16* KIb = (const h16*)(p.ws + WS_KI) + (size_t)b * SEQ * 64;
  h16* scbase;
  {
    const int j = (c < 64) ? c : 127 - c;
    const size_t pre = 8192ull * (size_t)(128 * j - (j * (j - 1)) / 2);
    scbase = (h16*)(p.ws + (b == 0 ? WS_H : WS_MIX + (size_t)(b - 1) * SC_BATCH_BYTES) + pre);
  }
  LDS unsigned* st = (LDS unsigned*)(lds + IL_ST);
  LDS float* stf = (LDS float*)(lds + IL_ST);
  if (tid < 64) { st[tid] = 0xFFFFFFFFu; st[64 + tid] = 0u; st[128 + tid] = 0u; }
  __syncthreads();
  const int nst = (N + 127) >> 7;
  const int stride = nst >= 16 ? 8 : (nst >= 8 ? 4 : (nst >= 4 ? 2 : 1));
  idx_pass<0>(lds, KIb, N, stride, qg, kh, QIrow0, WIrow0, 0.f, 0.f, 0, scbase);
  __syncthreads();
  if (tid < 64) {
    const float lo = fkey_inv(st[tid]), hi = fkey_inv(st[64 + tid]);
    float d = hi - lo; if (!(d > 1e-20f)) d = 1.f;
    const float inv = (float)IDX_NB / (1.5f * d);
    stf[192 + tid] = inv; stf[256 + tid] = -(lo - 0.25f * d) * inv;
  }
  for (int i = tid; i < 16384; i += NTHR) ((LDS unsigned*)(lds + IL_HIST))[i] = 0u;
  __syncthreads();
  const float qinv = stf[192 + q], qoff = stf[256 + q];
  idx_pass<1>(lds, KIb, N, 1, qg, kh, QIrow0, WIrow0, qinv, qoff, 0, scbase);
  {
    LDS unsigned* hist = (LDS unsigned*)(lds + IL_HIST);
    for (int qq = wave; qq < 64; qq += 8) {
      unsigned hb[4];
#pragma unroll
      for (int j = 0; j < 4; ++j) hb[j] = hist[(4 * lane + j) * 64 + qq];
      const unsigned mine = hb[0] + hb[1] + hb[2] + hb[3];
      unsigned suf = mine;
#pragma unroll
      for (int o = 1; o < 64; o <<= 1) { const unsigned v = (unsigned)__shfl_down((int)suf, o); if (lane + o < 64) suf += v; }
      unsigned cum = suf - mine;
      if (cum < 256u && suf >= 256u) {
#pragma unroll
        for (int j = 3; j >= 0; --j) {
          if (cum < 256u && cum + hb[j] >= 256u) { st[320 + qq] = (unsigned)(4 * lane + j); st[384 + qq] = 256u - cum; }
          cum += hb[j];
        }
      }
    }
  }
  __syncthreads();
  if (tid < 64) {
    const int bs = (int)st[320 + tid]; const float qi_ = stf[192 + tid], qo_ = stf[256 + tid];
    stf[448 + tid] = idx_bin_lower_bound(bs + 1, qi_, qo_);
    stf[512 + tid] = idx_bin_lower_bound(bs, qi_, qo_);
  }
  __syncthreads();
  const float thi = stf[448 + q], tlo = stf[512 + q];
  asm volatile("s_waitcnt vmcnt(0)" ::: "memory");
  idx_stream(lds, N, qg, kh, thi, tlo, scbase);
  __syncthreads();
  for (int qq = wave; qq < 64; qq += 8) {
    const int nc = min((int)st[128 + qq], IDX_CAP); const unsigned need = st[384 + qq];
    LDS float* cs = (LDS float*)(lds + IL_CS) + qq * IDX_CAP; LDS unsigned short* ck = (LDS unsigned short*)(lds + IL_CK) + qq * IDX_CAP;
    for (int i = lane; i < nc; i += 64) {
      const float sv = cs[i]; const unsigned kv = ck[i];
      unsigned rank = 0u;
      for (int j = 0; j < nc; ++j) { const float sj = cs[j]; const unsigned kj = ck[j]; rank += (sj > sv || (sj == sv && kj < kv)) ? 1u : 0u; }
      if (rank < need) {
        const unsigned kl = kv & 31u;
        const unsigned bit = 16u * ((kl >> 2) & 1u) + (kl & 3u) + 4u * (kl >> 3);
        __hip_atomic_fetch_or((LDS unsigned*)(lds + IL_HIST) + qq * 256 + (kv >> 5), 1u << bit, __ATOMIC_RELAXED, __HIP_MEMORY_SCOPE_WORKGROUP);
      }
    }
  }
  __syncthreads();
  {
    const int cpr = N >> 6;
    for (int i = tid; i < 64 * cpr; i += NTHR) {
      const int row = i / cpr, cc = i % cpr;
      *(u32x2*)(MASK + (size_t)row * 256 + 2 * cc) = *(LDS u32x2*)(lds + IL_HIST + row * 1024 + cc * 8);
    }
  }
  __syncthreads();
}

DEVI void phase3(PRef p, LDS unsigned char* lds) {
  const int G = gridDim.x;
  for (int it = blockIdx.x; it < 512; it += G) rnn_item<0>(p, lds, it >> 7, it & 127);
  for (int it = blockIdx.x; it < 256; it += G) {
    const int b = it >> 6, j = it & 63;
#pragma unroll 1
    for (int w2 = 0; w2 < 2; ++w2) idx_item(p, lds, b, w2 ? j : 127 - j);
  }
}

DEVI float max3f(float a, float b, float c) { float r; asm("v_max3_f32 %0, %1, %2, %3" : "=v"(r) : "v"(a), "v"(b), "v"(c)); return r; }
DEVI unsigned pk_rtz(float a, float b) { return __builtin_bit_cast(unsigned, __builtin_amdgcn_cvt_pkrtz(a, b)); }
DEVI void attn_seed(f32x16 (&s)[2], u32x2 mw, int half, float mref) {
  const unsigned nm0 = ~(mw[0] >> (16 * half)), nm1 = ~(mw[1] >> (16 * half));
  const unsigned negm = __float_as_uint(-mref);
#pragma unroll
  for (int r = 0; r < 16; ++r) {
    unsigned e0 = (unsigned)__builtin_amdgcn_sbfe((int)nm0, r, 1), e1 = (unsigned)__builtin_amdgcn_sbfe((int)nm1, r, 1);
    asm volatile("" : "+v"(e0), "+v"(e1));
    s[0][r] = __uint_as_float((e0 & 0xFF800000u) | (~e0 & negm));
    s[1][r] = __uint_as_float((e1 & 0xFF800000u) | (~e1 & negm));
  }
}
DEVI void attn_tile(LDS unsigned char* Kt, LDS unsigned char* Vt, const h16x8 (&qf)[4], f32x16 (&s)[2], u32x2 mwn, int l31, int half, f32x16 (&o)[2], float& mref, float& l, bool& init) {
  h16x8 kf[2][4];
#pragma unroll
  for (int ri = 0; ri < 2; ++ri)
#pragma unroll
    for (int kk = 0; kk < 4; ++kk) kf[ri][kk] = *(LDS h16x8*)(Kt + (32 * ri + l31) * LROW + (2 * kk + half) * 16);
  __builtin_amdgcn_sched_barrier(0);
#pragma unroll
  for (int kk = 0; kk < 4; ++kk)
#pragma unroll
    for (int ri = 0; ri < 2; ++ri) s[ri] = mfma16(kf[ri][kk], qf[kk], s[ri]);
  h16x8 vf[2][4];
#pragma unroll
  for (int di = 0; di < 2; ++di)
#pragma unroll
    for (int s4 = 0; s4 < 4; ++s4) vf[di][s4] = *(LDS h16x8*)(Vt + (32 * di + l31) * LROW + (2 * s4 + half) * 16);
  __builtin_amdgcn_sched_barrier(0);
  asm volatile("s_nop 15\n\ts_nop 7" : "+v"(s[0]), "+v"(s[1]));
  float mx = max3f(s[0][0], s[1][0], s[0][1]), mx2 = max3f(s[1][1], s[0][2], s[1][2]);
#pragma unroll
  for (int r = 3; r < 15; r += 2) { mx = max3f(mx, s[0][r], s[1][r]); mx2 = max3f(mx2, s[0][r + 1], s[1][r + 1]); }
  mx = max3f(mx, s[0][15], s[1][15]);
  mx = max3f(mx, mx2, mx2);
  { const auto sw = __builtin_amdgcn_permlane32_swap(__float_as_uint(mx), __float_as_uint(mx), false, false);
    mx = fmaxf(__uint_as_float(sw[0]), __uint_as_float(sw[1])); }
  const bool first = (!init) && (mx > -INFINITY);
  const bool resc = first || (mx > 8.f);
  if (__any(resc)) {
    init = init || first;
    const float delta = resc ? mx : 0.f;
    const float alpha = __builtin_amdgcn_exp2f(-delta);
#pragma unroll
    for (int r = 0; r < 16; ++r) { s[0][r] -= delta; s[1][r] -= delta; o[0][r] *= alpha; o[1][r] *= alpha; }
    l *= alpha; mref += delta;
  }
  float ls = 0.f;
#pragma unroll
  for (int r = 0; r < 16; ++r) {
    s[0][r] = __builtin_amdgcn_exp2f(s[0][r]); s[1][r] = __builtin_amdgcn_exp2f(s[1][r]);
    ls += s[0][r] + s[1][r];
  }
  l += ls;
  h16x8 pf[4];
#pragma unroll
  for (int s4 = 0; s4 < 4; ++s4) {
    u32x4 w;
#pragma unroll
    for (int e = 0; e < 4; ++e) w[e] = pk_rtz(s[s4 >> 1][8 * (s4 & 1) + 2 * e], s[s4 >> 1][8 * (s4 & 1) + 2 * e + 1]);
    pf[s4] = __builtin_bit_cast(h16x8, w);
  }
  __builtin_amdgcn_sched_barrier(0);
  {
    const unsigned nm0 = ~(mwn[0] >> (16 * half)), nm1 = ~(mwn[1] >> (16 * half));
    const unsigned negm = __float_as_uint(-mref);
#pragma unroll
    for (int i = 0; i < 8; ++i) {
      const int di = i >> 2, s4 = i & 3;
      o[di] = mfma16(vf[di][s4], pf[s4], o[di]);
#pragma unroll
      for (int r = 2 * i; r < 2 * i + 2; ++r) {
        unsigned e0 = (unsigned)__builtin_amdgcn_sbfe((int)nm0, r, 1), e1 = (unsigned)__builtin_amdgcn_sbfe((int)nm1, r, 1);
        asm volatile("" : "+v"(e0), "+v"(e1));
        s[0][r] = __uint_as_float((e0 & 0xFF800000u) | (~e0 & negm));
        s[1][r] = __uint_as_float((e1 & 0xFF800000u) | (~e1 & negm));
      }
    }
#pragma unroll
    for (int i = 0; i < 8; ++i) { __builtin_amdgcn_sched_group_barrier(0x008, 1, 0); __builtin_amdgcn_sched_group_barrier(0x002, 8, 0); }
  }
}

DEVI void attn_unit(PRef p, LDS unsigned char* lds, int b, int head, int qb) {
  const int tid = launder((int)threadIdx.x), lane = tid & 63, wave = wave_id(tid), l31 = lane & 31, half = lane >> 5;
  const int q0 = qb * 256 + wave * 32, cw = q0 >> 6, NS = qb + 1;
  const size_t tok = (size_t)b * SEQ + q0 + l31;
  h16x8 qf[4];
  {
    const h16* Q = (const h16*)(p.ws + WS_Q) + tok * 512 + head * 64;
#pragma unroll
    for (int kk = 0; kk < 4; ++kk) qf[kk] = *(const h16x8*)(Q + 16 * kk + 8 * half);
  }
  const unsigned* mrow = (const unsigned*)(p.ws + WS_MASK) + tok * 256;
  constexpr int TP = 2 * 64 * LROW, ABUF = 4 * TP;
  static_assert(2 * ABUF <= LDS_BYTES - 16, "attention LDS");
  const h16* ksrc[4]; const h16* vsrc[4]; int kdst[4], vdst[4];
#pragma unroll
  for (int i = 0; i < 4; ++i) {
    const int id = tid + NTHR * i;
    const int row = id >> 3, lc = id & 7;
    ksrc[i] = (const h16*)(p.ws + WS_K) + ((size_t)b * SEQ + row) * 512 + head * 64 + lc * 8;
    kdst[i] = (row >> 6) * TP + (row & 63) * LROW + lc * 16;
    const int d = id >> 5, c = id & 31;
    vsrc[i] = (const h16*)(p.ws + WS_VT) + ((size_t)(b * 8 + head) * 64 + d) * 8192 + c * 8;
    vdst[i] = (c >> 3) * TP + 64 * LROW + d * LROW + (c & 7) * 16;
  }
  h16x8 rkA[4], rvA[4], rkB[4], rvB[4];
#pragma unroll
  for (int i = 0; i < 4; ++i) { rkA[i] = *(const h16x8*)ksrc[i]; rvA[i] = *(const h16x8*)vsrc[i]; }
#pragma unroll
  for (int i = 0; i < 4; ++i) { *(LDS h16x8*)(lds + kdst[i]) = rkA[i]; *(LDS h16x8*)(lds + vdst[i]) = rvA[i]; }
  {
    const int s1 = NS > 1 ? 1 : 0;
#pragma unroll
    for (int i = 0; i < 4; ++i) { rkA[i] = *(const h16x8*)(ksrc[i] + (size_t)s1 * 256 * 512); rvA[i] = *(const h16x8*)(vsrc[i] + s1 * 256); }
  }
  u32x4 mA0 = *(const u32x4*)mrow, mA1 = *(const u32x4*)(mrow + 4), mB0, mB1;
  __syncthreads();
  f32x16 o[2];
#pragma unroll
  for (int r = 0; r < 16; ++r) { o[0][r] = 0.f; o[1][r] = 0.f; }
  float mref = 0.f, l = 0.f; bool init = false;
  f32x16 sd[2];
  { u32x2 m2; m2[0] = mA0[0]; m2[1] = mA0[1]; attn_seed(sd, m2, half, mref); }
#define ATT_TILE(s, t, W0, W1) if (4 * (s) + (t) <= cw) { u32x2 m2; m2[0] = W0; m2[1] = W1; attn_tile(bb + (t) * TP, bb + (t) * TP + 64 * LROW, qf, sd, m2, l31, half, o, mref, l, init); }
#define ATT_STEP(s, RKC, RVC, RKN, RVN, MC0, MC1, MN0, MN1) { \
    { const int sp = (s) + 2 < NS ? (s) + 2 : NS - 1; _Pragma("unroll") for (int i = 0; i < 4; ++i) { RKN[i] = *(const h16x8*)(ksrc[i] + (size_t)sp * 256 * 512); RVN[i] = *(const h16x8*)(vsrc[i] + sp * 256); } } \
    { const int sm = (s) + 1 < NS ? (s) + 1 : NS - 1; MN0 = *(const u32x4*)(mrow + 8 * sm); MN1 = *(const u32x4*)(mrow + 8 * sm + 4); } \
    { LDS unsigned char* bb = lds + ((s) & 1) * ABUF; \
      ATT_TILE(s, 0, MC0[2], MC0[3]) ATT_TILE(s, 1, MC1[0], MC1[1]) ATT_TILE(s, 2, MC1[2], MC1[3]) ATT_TILE(s, 3, MN0[0], MN0[1]) } \
    { LDS unsigned char* nb = lds + (((s) + 1) & 1) * ABUF; _Pragma("unroll") for (int i = 0; i < 4; ++i) { *(LDS h16x8*)(nb + kdst[i]) = RKC[i]; *(LDS h16x8*)(nb + vdst[i]) = RVC[i]; } } \
    __syncthreads(); }
  for (int s = 0; s < NS; s += 2) {
    ATT_STEP(s, rkA, rvA, rkB, rvB, mA0, mA1, mB0, mB1)
    if (s + 1 < NS) ATT_STEP(s + 1, rkB, rvB, rkA, rvA, mB0, mB1, mA0, mA1)
  }
#undef ATT_STEP
#undef ATT_TILE
  const float inv = 1.f / (l + __shfl_xor(l, 32));
  h16* Y = (h16*)(p.ws + WS_H) + tok * DM + head * 64;
#pragma unroll
  for (int di = 0; di < 2; ++di)
#pragma unroll
    for (int q = 0; q < 4; ++q)
      *(h16x4*)(Y + 32 * di + 8 * q + 4 * half) = pack4(o[di][4 * q] * inv, o[di][4 * q + 1] * inv, o[di][4 * q + 2] * inv, o[di][4 * q + 3] * inv);
}

DEVI void phase4(PRef p, LDS unsigned char* lds) {
  const int G = gridDim.x;
  for (int it = blockIdx.x; it < 512; it += G) rnn_item<1>(p, lds, it >> 7, it & 127);
  for (int it = blockIdx.x; it < 512; it += G) {
    const int bh = it >> 4, j = it & 15;
#pragma unroll 1
    for (int w2 = 0; w2 < 2; ++w2) attn_unit(p, lds, bh >> 3, bh & 7, w2 ? j : 31 - j);
  }
}

struct EpiPlain {
  h16* dst; int ld;
  DEVI void operator()(const f32x4 (&acc)[2][2][4][2], const g8::Unit& u, int wr, int wc, int fr, int fq) const {
#pragma unroll
    for (int ai = 0; ai < 2; ++ai)
#pragma unroll
      for (int m = 0; m < 4; ++m) {
        const int r = u.pm * 256 + 128 * ai + 64 * wr + 16 * m + fr;
        if (r < u.cnt) {
          h16* d = dst + (size_t)(u.off + r) * ld + u.pn * 256 + 32 * wc + 8 * fq;
#pragma unroll
          for (int bj = 0; bj < 2; ++bj)
            { const f32x4 v0 = acc[ai][bj][m][0], v1 = acc[ai][bj][m][1]; h16x8 w; w[0] = (h16)v0[0]; w[1] = (h16)v0[1]; w[2] = (h16)v0[2]; w[3] = (h16)v0[3]; w[4] = (h16)v1[0]; w[5] = (h16)v1[1]; w[6] = (h16)v1[2]; w[7] = (h16)v1[3]; *(h16x8*)(d + 128 * bj) = w; }
        }
      }
  }
};
DEVI void phase5(PRef p, LDS unsigned char* lds) {
  g8::DenseOrder S{(const h16*)(p.ws + WS_H), (const h16*)(p.ws + WS_WOUT), DM, 128, 4, (int)gridDim.x, (int)blockIdx.x};
  EpiPlain E{(h16*)(p.ws + WS_MIX), DM};
  g8::gemm_phase(lds, DM, S, E);
}

constexpr int P6_TROW = 2064, P6_THI = 0, P6_TLO = 32 * P6_TROW, P6_PART = 0, P6_LGT = 8 * 48 * 32 * 4, P6_MOD = 2 * 32 * P6_TROW;
constexpr int P6_BIAS = P6_MOD + 3 * 4096, P6_TOK = P6_BIAS + 160, P6_LCNT = P6_TOK + 128 * 6 * 4, P6_LBASE = P6_LCNT + 128;
static_assert(P6_LBASE + 128 <= LDS_BYTES - 16 && P6_LGT + 32 * 36 * 4 <= P6_MOD, "phase 6 LDS map");
DEVI void phase6(PRef p, LDS unsigned char* lds) {
  const int tid = launder((int)threadIdx.x), lane = tid & 63, wave = wave_id(tid), l15 = lane & 15, g4 = lane >> 4;
  const int b = blockIdx.x >> 6;
  LDS float* mv = (LDS float*)(lds + P6_MOD);
  LDS float* rbias = (LDS float*)(lds + P6_BIAS);
  LDS unsigned* tokrec = (LDS unsigned*)(lds + P6_TOK);
  LDS unsigned* lcnt = (LDS unsigned*)(lds + P6_LCNT);
  LDS unsigned* lbase = (LDS unsigned*)(lds + P6_LBASE);
  mod_to_lds(p, b, 2, mv); mod_to_lds(p, b, 3, mv + 1024); mod_to_lds(p, b, 4, mv + 2048);
  if (tid < 4) rbias[tid] = p.in[18][tid];
  else if (tid < 36) rbias[tid] = p.in[20][tid - 4];
  if (tid < 32) lcnt[tid] = 0u;
  __syncthreads();
  for (int k = tid; k < 1024; k += NTHR) { mv[k] *= p.in[5][k]; mv[2048 + k] = p.in[6][k] * (mv[2048 + k] + 1.f); }
  __syncthreads();
  const float* x = p.in[0]; const h16* MIX = (const h16*)(p.ws + WS_MIX); h16* X1h = (h16*)(p.ws + WS_MIX); h16* H2 = (h16*)(p.ws + WS_H);
  const h16* WRH = (const h16*)(p.ws + WS_WRH); const h16* WRL = (const h16*)(p.ws + WS_WRL);
  const size_t tok0 = (size_t)blockIdx.x * 128;
  h16x8 bh[3][4], bl[3][4];
#pragma unroll
  for (int ct = 0; ct < 3; ++ct)
#pragma unroll
    for (int kk = 0; kk < 4; ++kk) {
      const int kof = 32 * (4 * wave + kk) + 8 * g4;
      bh[ct][kk] = *(const h16x8*)(WRH + (size_t)(16 * ct + l15) * 1024 + kof); bl[ct][kk] = *(const h16x8*)(WRL + (size_t)(16 * ct + l15) * 1024 + kof);
    }
  f32x4 xa[4]; h16x4 ma[4];
#pragma unroll
  for (int j = 0; j < 4; ++j) { xa[j] = *(const f32x4*)(x + (tok0 + 4 * wave) * DM + 256 * j + 4 * lane); ma[j] = *(const h16x4*)(MIX + (tok0 + 4 * wave) * DM + 256 * j + 4 * lane); }
#pragma unroll 1
  for (int rd = 0; rd < 4; ++rd) {
    {
      const size_t tokb = tok0 + 32 * rd + 4 * wave;
#define P6_LOAD(XV, MH, T) do { _Pragma("unroll") for (int j = 0; j < 4; ++j) { XV[j] = *(const f32x4*)(x + (T) * DM + 256 * j + 4 * lane); MH[j] = *(const h16x4*)(MIX + (T) * DM + 256 * j + 4 * lane); } } while (0)
#define P6_ROW(XV, MH, I) do { \
        const int tr = 4 * wave + (I); const size_t tok = tokb + (I); \
        f32x4 mx[4]; float ssm = 0.f; \
        _Pragma("unroll") for (int j = 0; j < 4; ++j) _Pragma("unroll") for (int e = 0; e < 4; ++e) { mx[j][e] = (float)MH[j][e]; ssm += mx[j][e] * mx[j][e]; } \
        const float rsm = 1.0f / sqrtf(wave_sum(ssm) * (1.f / 1024.f) + 1e-6f); \
        float ss1 = 0.f; \
        _Pragma("unroll") for (int j = 0; j < 4; ++j) { \
          const f32x4 v = XV[j] + *(LDS f32x4*)(mv + 256 * j + 4 * lane) * (mx[j] * rsm); \
          XV[j] = v; \
          *(h16x4*)(X1h + tok * DM + 256 * j + 4 * lane) = pack4(v[0], v[1], v[2], v[3]); \
          ss1 += v[0] * v[0] + v[1] * v[1] + v[2] * v[2] + v[3] * v[3]; \
        } \
        const float rs1 = 1.0f / sqrtf(wave_sum(ss1) * (1.f / 1024.f) + 1e-6f); \
        _Pragma("unroll") for (int j = 0; j < 4; ++j) { \
          const f32x4 h2 = XV[j] * rs1 * *(LDS f32x4*)(mv + 2048 + 256 * j + 4 * lane) + *(LDS f32x4*)(mv + 1024 + 256 * j + 4 * lane); \
          const h16x4 hi = pack4(h2[0], h2[1], h2[2], h2[3]); \
          const h16x4 lo = pack4(h2[0] - (float)hi[0], h2[1] - (float)hi[1], h2[2] - (float)hi[2], h2[3] - (float)hi[3]); \
          *(h16x4*)(H2 + tok * DM + 256 * j + 4 * lane) = hi; \
          *(LDS h16x4*)(lds + P6_THI + tr * P6_TROW + (256 * j + 4 * lane) * 2) = hi; \
          *(LDS h16x4*)(lds + P6_TLO + tr * P6_TROW + (256 * j + 4 * lane) * 2) = lo; \
        } } while (0)
      f32x4 xb[4]; h16x4 mb[4];
      P6_LOAD(xb, mb, tokb + 1); __builtin_amdgcn_sched_barrier(0); P6_ROW(xa, ma, 0);
      P6_LOAD(xa, ma, tokb + 2); __builtin_amdgcn_sched_barrier(0); P6_ROW(xb, mb, 1);
      P6_LOAD(xb, mb, tokb + 3); __builtin_amdgcn_sched_barrier(0); P6_ROW(xa, ma, 2);
      { const size_t tn = rd < 3 ? tokb + 32 : tokb; P6_LOAD(xa, ma, tn); } __builtin_amdgcn_sched_barrier(0); P6_ROW(xb, mb, 3);
    }
    __syncthreads();
    f32x4 acc[2][3];
#pragma unroll
    for (int tt = 0; tt < 2; ++tt)
#pragma unroll
      for (int ct = 0; ct < 3; ++ct) acc[tt][ct] = (f32x4){0.f, 0.f, 0.f, 0.f};
#pragma unroll
    for (int kk = 0; kk < 4; ++kk) {
      const int kof = 32 * (4 * wave + kk) + 8 * g4;
      h16x8 ah[2], al[2];
#pragma unroll
      for (int tt = 0; tt < 2; ++tt) {
        ah[tt] = *(LDS h16x8*)(lds + P6_THI + (16 * tt + l15) * P6_TROW + kof * 2);
        al[tt] = *(LDS h16x8*)(lds + P6_TLO + (16 * tt + l15) * P6_TROW + kof * 2);
      }
#pragma unroll
      for (int ct = 0; ct < 3; ++ct) {
#pragma unroll
        for (int tt = 0; tt < 2; ++tt) {
          acc[tt][ct] = mfma16s(ah[tt], bh[ct][kk], acc[tt][ct]);
          acc[tt][ct] = mfma16s(ah[tt], bl[ct][kk], acc[tt][ct]);
          acc[tt][ct] = mfma16s(al[tt], bh[ct][kk], acc[tt][ct]);
        }
      }
    }
    __syncthreads();
#pragma unroll
    for (int tt = 0; tt < 2; ++tt)
#pragma unroll
      for (int ct = 0; ct < 3; ++ct)
        *(LDS f32x4*)(lds + P6_PART + (((wave * 48 + 16 * ct + l15) * 32) + 16 * tt + 4 * g4) * 4) = acc[tt][ct];
    __syncthreads();
    for (int idx = tid; idx < 36 * 32; idx += NTHR) {
      const int col = idx >> 5, tk = idx & 31;
      float s = 0.f;
#pragma unroll
      for (int w = 0; w < 8; ++w) s += *(LDS float*)(lds + P6_PART + ((w * 48 + col) * 32 + tk) * 4);
      *(LDS float*)(lds + P6_LGT + (tk * 36 + col) * 4) = s;
    }
    __syncthreads();
    if (tid < 32) {
      LDS float* lg = (LDS float*)(lds + P6_LGT) + 36 * tid;
      float gl[4];
#pragma unroll
      for (int g = 0; g < 4; ++g) gl[g] = lg[g] + rbias[g];
      int gi = 0; float gm = gl[0];
#pragma unroll
      for (int g = 1; g < 4; ++g) if (gl[g] > gm) { gm = gl[g]; gi = g; }
      float gs = 0.f;
#pragma unroll
      for (int g = 0; g < 4; ++g) gs += __expf(gl[g] - gm);
      const float pg = 1.f / gs;
      int e1 = 0, e2 = 0; float l1 = -INFINITY, l2 = -INFINITY;
#pragma unroll
      for (int e = 0; e < 8; ++e) {
        const float v = lg[4 + 8 * gi + e] + rbias[4 + 8 * gi + e];
        if (v > l1) { l2 = l1; e2 = e1; l1 = v; e1 = e; }
        else if (v > l2) { l2 = v; e2 = e; }
      }
      const float x2 = __expf(l2 - l1);
      const float w1 = pg / (1.f + x2), w2 = pg * x2 / (1.f + x2);
      const unsigned E1 = (unsigned)(gi * 8 + e1), E2 = (unsigned)(gi * 8 + e2);
      const unsigned lp1 = __hip_atomic_fetch_add(&lcnt[E1], 1u, __ATOMIC_RELAXED, __HIP_MEMORY_SCOPE_WORKGROUP);
      const unsigned lp2 = __hip_atomic_fetch_add(&lcnt[E2], 1u, __ATOMIC_RELAXED, __HIP_MEMORY_SCOPE_WORKGROUP);
      LDS unsigned* tr = tokrec + (32 * rd + tid) * 6;
      tr[0] = E1; tr[1] = lp1; tr[2] = E2; tr[3] = lp2; tr[4] = __float_as_uint(w1); tr[5] = __float_as_uint(w2);
    }
    __syncthreads();
  }
  if (tid < 32) lbase[tid] = atomicAdd((unsigned*)(p.ws + WS_CNT) + tid, lcnt[tid]);
  __syncthreads();
  if (tid < 128) {
    unsigned* LIST = (unsigned*)(p.ws + WS_LIST); float* LISTW = (float*)(p.ws + WS_LISTW); u32x4* ROUTE = (u32x4*)(p.ws + WS_ROUTE);
    const unsigned tok = (unsigned)(tok0 + tid);
    LDS unsigned* tr = tokrec + tid * 6;
    const unsigned E1 = tr[0], E2 = tr[2], p1 = lbase[E1] + tr[1], p2 = lbase[E2] + tr[3];
    LIST[(size_t)E1 * 32768 + p1] = tok; LISTW[(size_t)E1 * 32768 + p1] = __uint_as_float(tr[4]);
    LIST[(size_t)E2 * 32768 + p2] = tok; LISTW[(size_t)E2 * 32768 + p2] = __uint_as_float(tr[5]);
    u32x4 rt; rt[0] = E1; rt[1] = p1; rt[2] = E2; rt[3] = p2;
    ROUTE[tok] = rt;
  }
}

template <bool GATHER_> struct MoeOrder {
  static constexpr bool GATHER = GATHER_;
  unsigned char* ws; int ntn, K, G, c;
  int pre, cnl, offx;
  DEVI void init() {
    const int lane = threadIdx.x & 63;
    const int cn0 = lane < 32 ? (int)((const unsigned*)(ws + WS_CNT))[lane] : 0;
    int pt = ((cn0 + 255) >> 8) * ntn, po = cn0;
#pragma unroll
    for (int d = 1; d < 32; d <<= 1) { const int a = __shfl_up(pt, d), b = __shfl_up(po, d); if (lane >= d) { pt += a; po += b; } }
    pre = lane < 32 ? pt : 0x7fffffff; cnl = cn0; offx = po - cn0;
  }
  DEVI bool next(int i, g8::Unit& u) const {
    const int itg = i * G + c;
    const int e = __builtin_popcountll(__builtin_amdgcn_ballot_w64(pre <= itg));
    if (e >= 32) return false;
    const int cn = __builtin_amdgcn_readlane(cnl, e), off = __builtin_amdgcn_readlane(offx, e);
    const int it = itg - (__builtin_amdgcn_readlane(pre, e) - ((cn + 255) >> 8) * ntn);
    u.e = e; u.pm = it / ntn; u.pn = it % ntn; u.cnt = cn; u.off = off;
    const int tid = threadIdx.x;
    if (GATHER_) {
      const unsigned* list = (const unsigned*)(ws + WS_LIST) + (size_t)e * 32768;
      u.A = (const char*)(ws + WS_H);
      u.B = (const char*)((const h16*)(ws + WS_WGU) + ((size_t)e * 512 + u.pn * 256) * DM);
#pragma unroll
      for (int h = 0; h < 2; ++h)
#pragma unroll
        for (int i2 = 0; i2 < 2; ++i2) {
          int R, C; g8::stage_rc(tid * 16 + i2 * 8192, R, C);
          const int row = u.pm * 256 + 128 * h + R;
          const unsigned t = list[row < cn ? row : cn - 1];
          u.va[h][i2] = (t * (unsigned)DM + (unsigned)C) * 2u;
        }
    } else {
      u.A = (const char*)((const h16*)(ws + WS_ACT) + ((size_t)off + u.pm * 256) * 256);
      u.B = (const char*)((const h16*)(ws + WS_WDN) + ((size_t)e * 1024 + u.pn * 256) * 256);
      u.va[0][0] = u.va[0][1] = u.va[1][0] = u.va[1][1] = 0u;
    }
    return true;
  }
};
struct EpiAct {
  unsigned char* ws;
  DEVI void operator()(const f32x4 (&acc)[2][2][4][2], const g8::Unit& u, int wr, int wc, int fr, int fq) const {
    const float* lw = (const float*)(ws + WS_LISTW) + (size_t)u.e * 32768; h16* act = (h16*)(ws + WS_ACT);
    const int r0 = u.pm * 256 + 64 * wr + fr;
    float w8[2][4];
#pragma unroll
    for (int ai = 0; ai < 2; ++ai)
#pragma unroll
      for (int m = 0; m < 4; ++m) { const int r = r0 + 128 * ai + 16 * m; w8[ai][m] = lw[r < u.cnt ? r : u.cnt - 1]; }
    __builtin_amdgcn_sched_barrier(0);
#pragma unroll
    for (int ai = 0; ai < 2; ++ai)
#pragma unroll
      for (int m = 0; m < 4; ++m) asm volatile("" : "+v"(w8[ai][m]));
#pragma unroll
    for (int ai = 0; ai < 2; ++ai)
#pragma unroll
      for (int m = 0; m < 4; ++m) {
        const int r = r0 + 128 * ai + 16 * m;
        if (r < u.cnt) {
          const float w = w8[ai][m];
#pragma unroll
          for (int bj = 0; bj < 2; ++bj) {
            const f32x4 g = acc[ai][bj][m][0], up = acc[ai][bj][m][1];
            float v[4];
#pragma unroll
            for (int e = 0; e < 4; ++e) v[e] = g[e] * __builtin_amdgcn_rcpf(1.f + __expf(-g[e])) * up[e] * w;
            *(h16x4*)(act + (size_t)(u.off + r) * 256 + 16 * (8 * u.pn + 4 * bj + wc) + 4 * fq) = pack4(v[0], v[1], v[2], v[3]);
          }
        }
      }
  }
};
struct EpiYp {
  h16* dst;
  DEVI void operator()(const f32x4 (&acc)[2][2][4][2], const g8::Unit& u, int wr, int wc, int fr, int fq) const {
#pragma unroll
    for (int ai = 0; ai < 2; ++ai)
#pragma unroll
      for (int m = 0; m < 4; ++m) {
        const int r = u.pm * 256 + 128 * ai + 64 * wr + 16 * m + fr;
        if (r < u.cnt) {
          h16* d = dst + (size_t)(u.off + r) * DM + u.pn * 256 + 32 * wc + 8 * fq;
#pragma unroll
          for (int bj = 0; bj < 2; ++bj)
            { const f32x4 v0 = acc[ai][bj][m][0], v1 = acc[ai][bj][m][1]; h16x8 w; w[0] = (h16)v0[0]; w[1] = (h16)v0[1]; w[2] = (h16)v0[2]; w[3] = (h16)v0[3]; w[4] = (h16)v1[0]; w[5] = (h16)v1[1]; w[6] = (h16)v1[2]; w[7] = (h16)v1[3]; *(h16x8*)(d + 128 * bj) = w; }
        }
      }
  }
};
DEVI void phase7(PRef p, LDS unsigned char* lds) {
  MoeOrder<true> S{p.ws, 2, DM, (int)gridDim.x, (int)blockIdx.x, 0, 0, 0};
  S.init();
  EpiAct E{p.ws};
  g8::gemm_phase(lds, DM, S, E);
}
DEVI void phase8(PRef p, LDS unsigned char* lds) {
  MoeOrder<false> S{p.ws, 4, 256, (int)gridDim.x, (int)blockIdx.x, 0, 0, 0};
  S.init();
  EpiYp E{(h16*)(p.ws + WS_YP)};
  g8::gemm_phase(lds, 256, S, E);
}

DEVI void phase9(PRef p, LDS unsigned char* lds) {
  const int tid = launder((int)threadIdx.x), lane = tid & 63, wave = wave_id(tid), G = gridDim.x;
  const int b = blockIdx.x & 3, bi = blockIdx.x >> 2, nbk = G >> 2;
  LDS unsigned* offs = (LDS unsigned*)lds;
  if (tid == 0) { const unsigned* cnt = (const unsigned*)(p.ws + WS_CNT); unsigned o = 0; for (int e = 0; e < 32; ++e) { offs[e] = o; o += cnt[e]; } }
  __syncthreads();
  LDS float* mv = (LDS float*)(lds + 256);
  mod_to_lds(p, b, 5, mv);
  __syncthreads();
  f32x4 A3[4];
#pragma unroll
  for (int j = 0; j < 4; ++j) { const int k = 256 * j + 4 * lane; A3[j] = *(LDS f32x4*)(mv + k) * *(const f32x4*)(p.in[7] + k); }
  const h16* YP = (const h16*)(p.ws + WS_YP); const u32x4* ROUTE = (const u32x4*)(p.ws + WS_ROUTE); float* out = p.out; const h16* X1h = (const h16*)(p.ws + WS_MIX);
  const int rstep = nbk * 8, r_first = bi * 8 + wave;
  const int nrow = (SEQ - r_first + rstep - 1) / rstep;
  unsigned R0 = 0u, R1 = 0u;
  if (lane < nrow) { const u32x4 rt = ROUTE[(size_t)b * SEQ + r_first + rstep * lane]; R0 = offs[rt[0]] + rt[1]; R1 = offs[rt[2]] + rt[3]; }
  h16x4 ya[4], yc[4]; f32x4 xv[4];
  {
    const size_t tok = (size_t)b * SEQ + r_first; const size_t r0 = __builtin_amdgcn_readlane(R0, 0), r1 = __builtin_amdgcn_readlane(R1, 0);
#pragma unroll
    for (int j = 0; j < 4; ++j) { ya[j] = *(const h16x4*)(YP + r0 * DM + 256 * j + 4 * lane); yc[j] = *(const h16x4*)(YP + r1 * DM + 256 * j + 4 * lane); { const h16x4 xh = *(const h16x4*)(X1h + tok * DM + 256 * j + 4 * lane); xv[j] = (f32x4){(float)xh[0], (float)xh[1], (float)xh[2], (float)xh[3]}; } }
  }
  for (int i = 0; i < nrow; ++i) {
    const size_t tok = (size_t)b * SEQ + r_first + rstep * i;
    h16x4 na[4], nc[4]; f32x4 nx[4];
    if (i + 1 < nrow) {
      const size_t r0 = __builtin_amdgcn_readlane(R0, i + 1), r1 = __builtin_amdgcn_readlane(R1, i + 1);
#pragma unroll
      for (int j = 0; j < 4; ++j) { na[j] = *(const h16x4*)(YP + r0 * DM + 256 * j + 4 * lane); nc[j] = *(const h16x4*)(YP + r1 * DM + 256 * j + 4 * lane); { const h16x4 xh = *(const h16x4*)(X1h + (tok + rstep) * DM + 256 * j + 4 * lane); nx[j] = (f32x4){(float)xh[0], (float)xh[1], (float)xh[2], (float)xh[3]}; } }
    }
    f32x4 y[4]; float ss = 0.f;
#pragma unroll
    for (int j = 0; j < 4; ++j)
#pragma unroll
      for (int e = 0; e < 4; ++e) { y[j][e] = (float)ya[j][e] + (float)yc[j][e]; ss += y[j][e] * y[j][e]; }
    const float rs = 1.0f / sqrtf(wave_sum(ss) * (1.f / 1024.f) + 1e-6f);
#pragma unroll
    for (int j = 0; j < 4; ++j) *(f32x4*)(out + tok * DM + 256 * j + 4 * lane) = xv[j] + A3[j] * (y[j] * rs);
    if (i + 1 < nrow) {
#pragma unroll
      for (int j = 0; j < 4; ++j) { ya[j] = na[j]; yc[j] = nc[j]; xv[j] = nx[j]; }
    }
  }
}

#define XB_TMO      128
#define XB_XCNT(j)  (256  + 64 * (j))
#define XB_XSUB(j)  (1280 + 64 * (j))
#define XB_XGEN(j)  (2304 + 64 * (j))
#define XB_TOP      3328
#define XB_TOPGEN   3392
#define XB_SPIN_CAP (1u << 22)
DEVI unsigned xb_ld(unsigned* p)              { return __hip_atomic_load(p, __ATOMIC_RELAXED, __HIP_MEMORY_SCOPE_AGENT); }
DEVI unsigned xb_add(unsigned* p, unsigned v) { return __hip_atomic_fetch_add(p, v, __ATOMIC_RELAXED, __HIP_MEMORY_SCOPE_AGENT); }
DEVI unsigned xb_xcc_id() { return (unsigned)__builtin_amdgcn_s_getreg((3 << 11) | 20) & 0xFu; }
#define XB_SPIN(cond, bar) do { unsigned _sp = 0; while (cond) { __builtin_amdgcn_s_sleep(1); \
    if ((++_sp & 255u) == 0u) { if (xb_ld(&(bar)[XB_TMO])) break; if (_sp > XB_SPIN_CAP) { atomicAdd(&(bar)[XB_TMO], 1u); break; } } } } while (0)
struct XcdBarrier { unsigned* bar; unsigned x; volatile LDS unsigned* st; };
DEVI XcdBarrier xcd_barrier_post(unsigned* bar, volatile LDS unsigned* st) {
  XcdBarrier b; b.bar = bar; b.x = xb_xcc_id(); b.st = st;
  if (threadIdx.x == 0) (void)xb_add(&bar[XB_XCNT(b.x)], 1u);
  return b;
}
DEVI void xcd_barrier_complete(unsigned* bar, unsigned x, unsigned& nloc, unsigned& nx) {
  const unsigned G = gridDim.x * gridDim.y * gridDim.z;
  unsigned sum, cnt, mine, sp = 0u;
  for (;;) {
    sum = 0u; cnt = 0u; mine = 0u;
#pragma unroll
    for (unsigned j = 0; j < 16; ++j) { const unsigned c = xb_ld(&bar[XB_XCNT(j)]); sum += c; cnt += (c > 0u) ? 1u : 0u; mine = (j == x) ? c : mine; }
    if (sum == G) break;
    __builtin_amdgcn_s_sleep(1);
    if ((++sp & 255u) == 0u) { if (xb_ld(&bar[XB_TMO])) break; if (sp > XB_SPIN_CAP) { atomicAdd(&bar[XB_TMO], 1u); break; } }
  }
  nloc = mine > 0u ? mine : 1u; nx = cnt > 0u ? cnt : 1u;
}
DEVI void xcd_barrier(const XcdBarrier& b) {
  asm volatile("s_waitcnt vmcnt(0)" ::: "memory");
  __syncthreads();
  if (threadIdx.x == 0) {
    unsigned* bar = b.bar;
    __builtin_amdgcn_s_waitcnt(0);
    unsigned nloc = b.st[0], nx = b.st[1];
    if (nloc == 0u) { xcd_barrier_complete(bar, b.x, nloc, nx); b.st[0] = nloc; b.st[1] = nx; }
    const unsigned old = xb_add(&bar[XB_XSUB(b.x)], 1u);
    const unsigned gen = old / nloc;
    if (old + 1u == (gen + 1u) * nloc) {
      __builtin_amdgcn_fence(__ATOMIC_RELEASE, "agent");
      asm volatile("s_waitcnt vmcnt(0)" ::: "memory");
      const unsigned og = xb_add(&bar[XB_TOP], 1u);
      const unsigned tg = og / nx;
      if (og + 1u == (tg + 1u) * nx) xb_add(&bar[XB_TOPGEN], 1u);
      else XB_SPIN(xb_ld(&bar[XB_TOPGEN]) == tg, bar);
      __builtin_amdgcn_fence(__ATOMIC_ACQUIRE, "agent");
      xb_add(&bar[XB_XGEN(b.x)], 1u);
      asm volatile("s_waitcnt vmcnt(0)" ::: "memory");
    } else {
      XB_SPIN(xb_ld(&bar[XB_XGEN(b.x)]) == gen, bar);
      __builtin_amdgcn_fence(__ATOMIC_ACQUIRE, "agent");
      asm volatile("s_waitcnt vmcnt(0)" ::: "memory");
    }
  }
  __syncthreads();
}

__global__ void __launch_bounds__(NTHR) fwd_kernel(Params p) {
  extern __shared__ __attribute__((aligned(16))) unsigned char smem[];
  LDS unsigned char* lds = (LDS unsigned char*)smem;
  const int lo = p.ph_lo, hi = p.ph_hi;
  volatile LDS unsigned* bst = (volatile LDS unsigned*)(lds + LDS_BYTES - 16);
  if (threadIdx.x < 4) bst[threadIdx.x] = 0u;
  __syncthreads();
  (void)xcd_barrier_post((unsigned*)(p.ws + WS_BAR), bst);
#ifndef REPEAT_PHASE
#define REPEAT_PHASE -1
#endif
#define GRID_SYNC(k) do { { XcdBarrier xb_; xb_.bar = (unsigned*)(get_params()->ws + WS_BAR); xb_.x = xb_xcc_id(); xb_.st = (volatile LDS unsigned*)(lds + LDS_BYTES - 16); xcd_barrier(xb_); } } while (0)
#define RUN_PHASE(k, fn) if (lo <= (k) && (k) < hi) { fn(*get_params(), lds); if ((k) == REPEAT_PHASE) { GRID_SYNC(k); fn(*get_params(), lds); } if ((k) + 1 < hi) GRID_SYNC(k); }
  RUN_PHASE(0, phase0)
  RUN_PHASE(1, phase1)
  RUN_PHASE(2, phase2)
  RUN_PHASE(3, phase3)
  RUN_PHASE(4, phase4)
  RUN_PHASE(5, phase5)
  RUN_PHASE(6, phase6)
  RUN_PHASE(7, phase7)
  RUN_PHASE(8, phase8)
  RUN_PHASE(9, phase9)
#undef GRID_SYNC
#undef RUN_PHASE
}

extern "C" void kernel_launch(void* const* d_in, const int* in_sizes, int n_in, void* d_out, int out_size, void* d_ws, size_t ws_size, hipStream_t stream) {
  static int grid = 0;
  if (grid == 0) {
    if (n_in != 24 || out_size != NTOK * DM || ws_size < WS_END) { fprintf(stderr, "kernel_launch: unexpected problem (n_in %d out %d ws %zu)\n", n_in, out_size, ws_size); grid = -1; return; }
    (void)hipFuncSetAttribute((const void*)fwd_kernel, hipFuncAttributeMaxDynamicSharedMemorySize, LDS_BYTES);
    int dev = 0, cus = 0, per_cu = 0;
    (void)hipGetDevice(&dev);
    (void)hipDeviceGetAttribute(&cus, hipDeviceAttributeMultiprocessorCount, dev);
    (void)hipOccupancyMaxActiveBlocksPerMultiprocessor(&per_cu, (const void*)fwd_kernel, NTHR, LDS_BYTES);
    if (per_cu < 1 || cus < 256) fprintf(stderr, "kernel_launch: occupancy %d blocks/CU on %d CUs\n", per_cu, cus);
    grid = 256;
  }
  if (grid < 0) return;
  (void)hipMemsetAsync((char*)d_ws + WS_CNT, 0, CTL_ZERO_BYTES, stream);
  Params p{};
  for (int i = 0; i < 24; ++i) p.in[i] = (const float*)d_in[i];
  p.out = (float*)d_out; p.ws = (unsigned char*)d_ws;
#if N_LAUNCH_MODE == 1
  p.ph_lo = 0; p.ph_hi = NPHASE;
  void* args[] = {&p};
  hipError_t e = hipLaunchCooperativeKernel((const void*)fwd_kernel, dim3(grid), dim3(NTHR), args, LDS_BYTES, stream);
  if (e != hipSuccess) fprintf(stderr, "cooperative launch failed: %s\n", hipGetErrorString(e));
#else
  for (int ph = 0; ph < NPHASE; ++ph) {
    p.ph_lo = ph; p.ph_hi = ph + 1;
    hipLaunchKernelGGL(fwd_kernel, dim3(grid), dim3(NTHR), LDS_BYTES, stream, p);
  }
#endif
}
```

```cpp
#include <hip/hip_runtime.h>
#include <cstdio>
#include <cstdint>

#ifndef N_LAUNCH_MODE
#define N_LAUNCH_MODE 1
#endif

#define DEVI __device__ __forceinline__
#define LDS __attribute__((address_space(3)))

typedef _Float16 h16;
typedef _Float16 h16x4 __attribute__((ext_vector_type(4)));
typedef _Float16 h16x8 __attribute__((ext_vector_type(8)));
typedef float f32x4 __attribute__((ext_vector_type(4)));
typedef float f32x16 __attribute__((ext_vector_type(16)));
typedef unsigned u32x2 __attribute__((ext_vector_type(2)));
typedef unsigned u32x4 __attribute__((ext_vector_type(4)));

constexpr int NBATCH = 4, SEQ = 8192, NTOK = NBATCH * SEQ, DM = 1024;
constexpr int NTHR = 512;
constexpr int NPHASE = 10;
constexpr int LDS_BYTES = 163840;

constexpr size_t MiB = 1ull << 20;
constexpr size_t WS_CNT = 0;
constexpr size_t CTL_ZERO_BYTES = 20480;
constexpr size_t WS_BAR = 4096;
constexpr size_t WS_MODP = 64 * 1024;
constexpr size_t WS_ROPE = 1 * MiB;
constexpr size_t WS_WIN = 3 * MiB;
constexpr size_t WS_WOUT = 10 * MiB;
constexpr size_t WS_WGU = 12 * MiB;
constexpr size_t WS_WDN = 44 * MiB;
constexpr size_t WS_WRG = 60 * MiB;
constexpr size_t WS_WRH = 60 * MiB + 512 * 1024;
constexpr size_t WS_WRL = 60 * MiB + 640 * 1024;
constexpr size_t WS_AGG = 61 * MiB;
constexpr size_t WS_ROUTE = 63 * MiB;
constexpr size_t WS_LIST = 64 * MiB;
constexpr size_t WS_LISTW = 68 * MiB;
constexpr size_t WS_WI = 72 * MiB;
constexpr size_t WS_KI = 73 * MiB;
constexpr size_t WS_MASK = 77 * MiB;
constexpr size_t WS_H = 109 * MiB;
constexpr size_t WS_Q = 173 * MiB;
constexpr size_t WS_K = 205 * MiB;
constexpr size_t WS_VT = 237 * MiB;
constexpr size_t WS_QI = 269 * MiB;
constexpr size_t WS_XR = 301 * MiB;
constexpr size_t WS_XG = 333 * MiB;
constexpr size_t WS_MIX = 365 * MiB;
constexpr size_t WS_ACT = 429 * MiB;
constexpr size_t WS_YP = 173 * MiB;
constexpr size_t WS_END = 510 * MiB;
constexpr size_t SC_BATCH_BYTES = 8192ull * 6176ull;
static_assert(SC_BATCH_BYTES <= 64 * MiB && WS_MIX + 3 * SC_BATCH_BYTES <= WS_END, "score slots");

struct Params { const float* in[24]; float* out; unsigned char* ws; int ph_lo, ph_hi; };
typedef const __attribute__((address_space(4))) Params& PRef;
typedef const __attribute__((address_space(4))) Params* PPtr;

__device__ const double ROPE_REV[32] = {
  1.59154943091895345608e-01, 1.19349370211248861917e-01, 8.94994016088910132600e-02, 6.71150830052272551196e-02,
  5.03292121044870352509e-02, 3.77415847174197710556e-02, 2.83021958306233986646e-02, 2.12236527647776604399e-02,
  1.59154943091895338669e-02, 1.19349370211248861917e-02, 8.94994016088910236684e-03, 6.71150830052272533849e-03,
  5.03292121044870369856e-03, 3.77415847174197719230e-03, 2.83021958306233986646e-03, 2.12236527647776621747e-03,
  1.59154943091895356017e-03, 1.19349370211248848907e-03, 8.94994016088910236684e-04, 6.71150830052272598901e-04,
  5.03292121044870326488e-04, 3.77415847174197740914e-04, 2.83021958306233954120e-04, 2.12236527647776605484e-04,
  1.59154943091895350596e-04, 1.19349370211248862459e-04, 8.94994016088910182474e-05, 6.71150830052272544691e-05,
  5.03292121044870353593e-05, 3.77415847174197768019e-05, 2.83021958306233960897e-05, 2.12236527647776591931e-05};

DEVI int launder(int x) { asm volatile("" : "+v"(x)); return x; }
DEVI PPtr get_params() { PPtr k = (PPtr)__builtin_amdgcn_kernarg_segment_ptr(); asm volatile("" : "+s"(k)); return k; }
DEVI int wave_id(int tid) { return __builtin_amdgcn_readfirstlane(tid >> 6); }
DEVI f32x16 mfma16(h16x8 a, h16x8 b, f32x16 c) { return __builtin_amdgcn_mfma_f32_32x32x16_f16(a, b, c, 0, 0, 0); }
template <int CTRL> DEVI float dpp_add(float v) { return v + __int_as_float(__builtin_amdgcn_update_dpp(0, __float_as_int(v), CTRL, 0xf, 0xf, true)); }
DEVI float wave_sum(float v) {
  v = dpp_add<0xB1>(v); v = dpp_add<0x4E>(v); v = dpp_add<0x141>(v); v = dpp_add<0x140>(v);
  { const auto sw = __builtin_amdgcn_permlane16_swap(__float_as_uint(v), __float_as_uint(v), false, false); v = __uint_as_float(sw[0]) + __uint_as_float(sw[1]); }
  { const auto sw = __builtin_amdgcn_permlane32_swap(__float_as_uint(v), __float_as_uint(v), false, false); v = __uint_as_float(sw[0]) + __uint_as_float(sw[1]); }
  return v;
}
DEVI float sigmoid_f(float x) { return __builtin_amdgcn_rcpf(1.f + __expf(-x)); }
DEVI float silu_f(float x) { return x * __builtin_amdgcn_rcpf(1.f + __expf(-x)); }
DEVI float gelu_tanh_f(float x) {
  const float u = 0.7978845608028654f * (x + 0.044715f * x * x * x);
  const float t = 1.f - 2.f * __builtin_amdgcn_rcpf(1.f + __expf(2.f * u));
  return 0.5f * x * (1.f + t);
}
DEVI unsigned fkey(float f) { unsigned u = __float_as_uint(f); return (u & 0x80000000u) ? ~u : (u | 0x80000000u); }
DEVI float fkey_inv(unsigned k) { unsigned u = (k & 0x80000000u) ? (k & 0x7fffffffu) : ~k; return __uint_as_float(u); }
DEVI int vt_perm(int pos) { return (pos & ~12) | ((pos & 4) << 1) | ((pos & 8) >> 1); }

DEVI void mod_to_lds(PRef p, int b, int chunk, LDS float* dst) {
  const float* mp = (const float*)(p.ws + WS_MODP);
  for (int k = threadIdx.x; k < 1024; k += NTHR) {
    const int j = chunk * 1024 + k;
    float v[8];
#pragma unroll
    for (int ks = 0; ks < 8; ++ks) v[ks] = mp[(size_t)(ks * 4 + b) * 6144 + j];
    float s = p.in[3][j];
#pragma unroll
    for (int ks = 0; ks < 8; ++ks) s += v[ks];
    dst[k] = s;
  }
}

constexpr int LROW = 144;

namespace g8 {
constexpr int BM = 256, BK = 64, HALF = 128, HTB = HALF * BK * 2, STAGE_BYTES = 8 * HTB;
DEVI int lds_byte(int r, int c) { const int st = (r >> 4) * 2 + (c >> 5), rr = r & 15, cc = c & 31, ob = rr * 64 + cc * 2; return st * 1024 + (ob ^ (((ob >> 9) & 1) << 5)); }
DEVI void stage_rc(int b, int& R, int& C) { const int st = b / 1024, sb = b % 1024, swz = sb ^ (((sb >> 9) & 1) << 5); R = (st >> 1) * 16 + swz / 64; C = (st & 1) * 32 + (swz % 64) / 2; }
struct Unit { const char* A; unsigned va[2][2]; const char* B; int pm, pn, e, cnt, off; };
DEVI void glds16(const char* src, LDS unsigned char* dst) { __builtin_amdgcn_global_load_lds((const unsigned*)src, (LDS unsigned*)dst, 16, 0, 0); }

DEVI void dense_va(unsigned (&va)[2][2], int K) {
  const int tid = threadIdx.x;
#pragma unroll
  for (int h = 0; h < 2; ++h)
#pragma unroll
    for (int i = 0; i < 2; ++i) { int R, C; stage_rc(tid * 16 + i * 8192, R, C); va[h][i] = (unsigned)((128 * h + R) * K + C) * 2u; }
}
template <class Sched, class Epi>
DEVI void gemm_phase(LDS unsigned char* lds, int K, const Sched& S, const Epi& E) {
  const int tid = launder((int)threadIdx.x), wid = wave_id(tid), lane = tid & 63, wr = wid >> 2, wc = wid & 3, fr = lane & 15, fq = lane >> 4;
  const int nt = launder(K) / BK;
  unsigned vb[2];
#pragma unroll
  for (int i = 0; i < 2; ++i) { int R, C; stage_rc(tid * 16 + i * 8192, R, C); vb[i] = (unsigned)(R * K + C) * 2u; }
  const size_t kstep = (size_t)(BK * 2), hstep = (size_t)HALF * K * 2;
  const unsigned ldsw = (unsigned)wid * 1024u;
  const int aoff = lds_byte(wr * 64 + fr, fq * 8), boff = lds_byte(wc * 32 + fr, fq * 8);
#define G8_SA(b, h) (((b) * 2 + (h)) * HTB)
#define G8_SB(b, h) ((4 + (b) * 2 + (h)) * HTB)
#define G8_STAGE(bufoff, gbase, v) do { glds16((gbase) + (v)[0], lds + (bufoff) + ldsw); glds16((gbase) + (v)[1], lds + (bufoff) + ldsw + 8192); } while (0)
#define G8_STAGEA(bufoff, gbase, h) do { glds16((gbase) + G8_VAC(h, 0), lds + (bufoff) + ldsw); glds16((gbase) + G8_VAC(h, 1), lds + (bufoff) + ldsw + 8192); } while (0)
#define G8_LDA(dst, b, h) do { _Pragma("unroll") for (int m = 0; m < 4; ++m) _Pragma("unroll") for (int k = 0; k < 2; ++k) dst[m][k] = *(const LDS h16x8*)(lds + G8_SA(b, h) + aoff + m * 2048 + k * 1024); } while (0)
#define G8_LDB(dst, b, h) do { _Pragma("unroll") for (int n = 0; n < 2; ++n) _Pragma("unroll") for (int k = 0; k < 2; ++k) dst[n][k] = *(const LDS h16x8*)(lds + G8_SB(b, h) + boff + n * 2048 + k * 1024); } while (0)
#define G8_MMA(ai, bj, At, Bt) do { __builtin_amdgcn_s_setprio(1); _Pragma("unroll") for (int m = 0; m < 4; ++m) _Pragma("unroll") for (int n = 0; n < 2; ++n) _Pragma("unroll") for (int k = 0; k < 2; ++k) \
        acc[ai][bj][m][n] = __builtin_amdgcn_mfma_f32_16x16x32_f16(Bt[n][k], At[m][k], acc[ai][bj][m][n], 0, 0, 0); __builtin_amdgcn_s_setprio(0); } while (0)
#define G8_WAIT_V(n) asm volatile("s_waitcnt vmcnt(" #n ")" ::: "memory")
#define G8_WAIT_L(n) asm volatile("s_waitcnt lgkmcnt(" #n ")" ::: "memory")
#define G8_BAR __builtin_amdgcn_s_barrier()
#define G8_SCHED __builtin_amdgcn_sched_barrier(0)
  Unit cur, nxt; int ui = 0;
  if (!S.next(0, cur)) return;
  unsigned vd[2][2];
  if (!Sched::GATHER) dense_va(vd, K);
#define G8_VAC(h, i) (Sched::GATHER ? cur.va[h][i] : vd[h][i])
#define G8_VAN(h, i) (Sched::GATHER ? nxt.va[h][i] : vd[h][i])
  f32x4 acc[2][2][4][2];
#pragma unroll
  for (int a = 0; a < 2; ++a)
#pragma unroll
    for (int b = 0; b < 2; ++b)
#pragma unroll
      for (int m = 0; m < 4; ++m)
#pragma unroll
        for (int n = 0; n < 2; ++n) acc[a][b][m][n] = (f32x4){0.f, 0.f, 0.f, 0.f};
  h16x8 At[4][2], B0[2][2], B1[2][2];
  const char* cA = cur.A; const char* cB = cur.B;
  G8_STAGE(G8_SB(0, 0), cB, vb); G8_STAGE(G8_SB(0, 1), cB + hstep, vb); G8_STAGEA(G8_SA(0, 0), cA, 0); G8_STAGEA(G8_SA(0, 1), cA, 1);
  if (wr == 1) G8_BAR;
  G8_WAIT_V(2); G8_BAR;
  G8_STAGE(G8_SB(1, 0), cB + kstep, vb); G8_STAGEA(G8_SA(1, 0), cA + kstep, 0); G8_STAGE(G8_SB(1, 1), cB + hstep + kstep, vb);
  G8_WAIT_V(6); G8_BAR;
  for (;;) {
    const bool has_next = S.next(ui + 1, nxt);
    if (!has_next) nxt = cur;
    const char* nA = nxt.A; const char* nB = nxt.B;
#pragma unroll 1
    for (int t = 0; t < nt; t += 2) {
      const bool last = (t == nt - 2);
      const char* a1 = cA + (size_t)(t + 1) * kstep;
      const char* a2 = last ? nA : cA + (size_t)(t + 2) * kstep; const char* b2 = last ? nB : cB + (size_t)(t + 2) * kstep;
      const char* a3 = a2 + kstep; const char* b3 = b2 + kstep;
#define G8_STAGE2(bufoff, gbase, h) do { glds16((gbase) + (last ? G8_VAN(h, 0) : G8_VAC(h, 0)), lds + (bufoff) + ldsw); glds16((gbase) + (last ? G8_VAN(h, 1) : G8_VAC(h, 1)), lds + (bufoff) + ldsw + 8192); } while (0)
      G8_LDB(B0, 0, 0); G8_LDB(B1, 0, 1); G8_SCHED; G8_LDA(At, 0, 0); G8_STAGEA(G8_SA(1, 1), a1, 1);
      G8_WAIT_V(8); G8_WAIT_L(0); G8_BAR; G8_MMA(0, 0, At, B0); G8_MMA(0, 1, At, B1); G8_BAR; G8_SCHED;
      G8_LDA(At, 0, 1); G8_STAGE(G8_SB(0, 0), b2, vb); G8_STAGE(G8_SB(0, 1), b2 + hstep, vb); G8_STAGE2(G8_SA(0, 0), a2, 0);
      G8_WAIT_V(8); G8_WAIT_L(0); G8_BAR; G8_MMA(1, 0, At, B0); G8_MMA(1, 1, At, B1); G8_BAR; G8_SCHED;
      G8_LDB(B0, 1, 0); G8_LDB(B1, 1, 1); G8_SCHED; G8_LDA(At, 1, 0); G8_STAGE2(G8_SA(0, 1), a2, 1);
      G8_WAIT_V(8); G8_WAIT_L(0); G8_BAR; G8_MMA(0, 0, At, B0); G8_MMA(0, 1, At, B1); G8_BAR; G8_SCHED;
      G8_LDA(At, 1, 1); G8_STAGE(G8_SB(1, 0), b3, vb); G8_STAGE(G8_SB(1, 1), b3 + hstep, vb); G8_STAGE2(G8_SA(1, 0), a3, 0);
      G8_WAIT_V(8); G8_WAIT_L(0); G8_BAR; G8_MMA(1, 0, At, B0); G8_MMA(1, 1, At, B1); G8_BAR; G8_SCHED;
    }
#undef G8_STAGE2
    if (wr == 0) G8_BAR;
    E(acc, cur, wr, wc, fr, fq);
    if (!has_next) break;
#pragma unroll
    for (int a = 0; a < 2; ++a)
#pragma unroll
      for (int b = 0; b < 2; ++b)
#pragma unroll
        for (int m = 0; m < 4; ++m)
#pragma unroll
          for (int n = 0; n < 2; ++n) acc[a][b][m][n] = (f32x4){0.f, 0.f, 0.f, 0.f};
    cur = nxt; cA = nA; cB = nB; ++ui;
    if (wr == 1) G8_BAR;
  }
  G8_WAIT_V(0);
  G8_BAR;
#undef G8_SA
#undef G8_STAGEA
#undef G8_VAC
#undef G8_VAN
#undef G8_SB
#undef G8_STAGE
#undef G8_LDA
#undef G8_LDB
#undef G8_MMA
#undef G8_WAIT_V
#undef G8_WAIT_L
#undef G8_BAR
#undef G8_SCHED
}
struct DenseOrder {
  static constexpr bool GATHER = false;
  const h16* A; const h16* Bt; int K, nM, nN, G, c;
  DEVI bool next(int i, Unit& u) const {
    const int nwg = nM * nN; const long L = (long)i * G + c; if (L >= nwg) return false;
    int wgid = (int)L; { const int q = nwg / 8, r = nwg % 8, xcd = wgid % 8, off = wgid / 8; wgid = (xcd < r ? xcd * (q + 1) : r * (q + 1) + (xcd - r) * q) + off; }
    const int nig = 8 * nN, gid = wgid / nig, fm = gid * 8, gsz = (nM - fm) < 8 ? (nM - fm) : 8;
    u.pm = fm + ((wgid % nig) % gsz); u.pn = (wgid % nig) / gsz; u.e = 0; u.cnt = 0x7fffffff; u.off = 0;
    u.A = (const char*)(A + (size_t)u.pm * 256 * K); u.B = (const char*)(Bt + (size_t)u.pn * 256 * K);
    u.va[0][0] = u.va[0][1] = u.va[1][0] = u.va[1][1] = 0u;
    return true;
  }
};
}


DEVI h16x4 pack4(float a, float b, float c, float d) { h16x4 v; v[0] = (h16)a; v[1] = (h16)b; v[2] = (h16)c; v[3] = (h16)d; return v; }

template <class F>
DEVI void transpose_item(const float* src, int N, int kb, int nb, h16* dst, int ldd, F drow, LDS float* scr, int lane) {
#pragma unroll 8
  for (int i = 0; i < 32; ++i) {
    const int kk = 2 * i + (lane >> 5), n = nb * 32 + (lane & 31);
    scr[kk * 33 + (lane & 31)] = (n < N) ? src[(size_t)(kb * 64 + kk) * N + n] : 0.f;
  }
  asm volatile("s_waitcnt lgkmcnt(0)" ::: "memory");
  const int c = lane & 7;
#pragma unroll
  for (int j = 0; j < 4; ++j) {
    const int nl = (lane >> 3) + 8 * j, n = nb * 32 + nl;
    h16x8 v;
#pragma unroll
    for (int e = 0; e < 8; ++e) v[e] = (h16)scr[(c * 8 + e) * 33 + nl];
    if (n < N) *(h16x8*)(dst + (size_t)drow(n) * ldd + kb * 64 + c * 8) = v;
  }
  asm volatile("s_waitcnt lgkmcnt(0)" ::: "memory");
}

DEVI void phase0(PRef p, LDS unsigned char* lds) {
  const int tid = launder((int)threadIdx.x), lane = tid & 63, wave = wave_id(tid), G = gridDim.x;
  const int gw = blockIdx.x * 8 + wave, NW = G * 8;
  {
    const float* c = p.in[1]; const float* wada = p.in[2]; float* mp = (float*)(p.ws + WS_MODP);
    for (int u = gw; u < 96 * 8; u += NW) {
      const int cgp = u % 96, ks = u / 96, j = cgp * 64 + lane;
      float a0 = 0.f, a1 = 0.f, a2 = 0.f, a3 = 0.f;
      for (int k0 = ks * 128; k0 < ks * 128 + 128; k0 += 16) {
        float w[16];
#pragma unroll
        for (int u = 0; u < 16; ++u) w[u] = wada[(size_t)(k0 + u) * 6144 + j];
#pragma unroll
        for (int u = 0; u < 16; ++u) {
          const int k = k0 + u;
          a0 = fmaf(silu_f(c[k]), w[u], a0); a1 = fmaf(silu_f(c[1024 + k]), w[u], a1);
          a2 = fmaf(silu_f(c[2048 + k]), w[u], a2); a3 = fmaf(silu_f(c[3072 + k]), w[u], a3);
        }
      }
      mp[(size_t)(ks * 4 + 0) * 6144 + j] = a0; mp[(size_t)(ks * 4 + 1) * 6144 + j] = a1;
      mp[(size_t)(ks * 4 + 2) * 6144 + j] = a2; mp[(size_t)(ks * 4 + 3) * 6144 + j] = a3;
    }
  }
  {
    LDS float* scr = (LDS float*)lds + wave * (64 * 33);
    constexpr int I_IN = 16 * 99, I_OUT = 16 * 32, I_G = 32 * 128, I_U = 32 * 128, I_D = 32 * 128, I_RG = 32;
    constexpr int NIT = I_IN + I_OUT + I_G + I_U + I_D + I_RG;
    for (int it = gw; it < NIT; it += NW) {
      int r = it;
      if (r < I_IN) {
        transpose_item(p.in[8], 3144, r / 99, r % 99, (h16*)(p.ws + WS_WIN), 1024,
                       [](int n) { const int dl = n < 2112 ? n : (n < 2120 ? 3136 + (n - 2112) : (n < 2632 ? 2112 + (n - 2120) : 2624 + (n - 2632)));
                                     const int d = dl & 63, sx = (dl >> 6) & 3;
                                     return (dl & ~255) + 128 * (d >> 5) + 32 * sx + 16 * ((d >> 2) & 1) + 4 * ((d >> 3) & 3) + (d & 3); }, scr, lane);
        continue;
      }
      r -= I_IN;
      if (r < I_OUT) { transpose_item(p.in[16], 1024, r / 32, r % 32, (h16*)(p.ws + WS_WOUT), 1024, [](int n) { return (n & ~31) + 16 * ((n >> 2) & 1) + 4 * ((n >> 3) & 3) + (n & 3); }, scr, lane); continue; }
      r -= I_OUT;
      if (r < I_G) { const int e = r >> 7, q = r & 127;
        transpose_item(p.in[21] + (size_t)e * 1024 * 256, 256, q >> 3, q & 7, (h16*)(p.ws + WS_WGU) + (size_t)e * 512 * 1024, 1024, [](int f) { return (f >> 4) * 32 + (f & 15); }, scr, lane); continue; }
      r -= I_G;
      if (r < I_U) { const int e = r >> 7, q = r & 127;
        transpose_item(p.in[22] + (size_t)e * 1024 * 256, 256, q >> 3, q & 7, (h16*)(p.ws + WS_WGU) + (size_t)e * 512 * 1024, 1024, [](int f) { return (f >> 4) * 32 + 16 + (f & 15); }, scr, lane); continue; }
      r -= I_U;
      if (r < I_D) { const int e = r >> 7, q = r & 127;
        transpose_item(p.in[23] + (size_t)e * 256 * 1024, 1024, q >> 5, q & 31, (h16*)(p.ws + WS_WDN) + (size_t)e * 1024 * 256, 256, [](int n) { return (n & ~31) + 16 * ((n >> 2) & 1) + 4 * ((n >> 3) & 3) + (n & 3); }, scr, lane); continue; }
      r -= I_D;
      if (r < 16) transpose_item(p.in[11] + (size_t)(r >> 1) * 4096, 64, 0, r & 1, (h16*)(p.ws + WS_WRG) + (size_t)(r >> 1) * 128 * 64, 64, [](int n) { return n; }, scr, lane);
      else transpose_item(p.in[13] + (size_t)((r - 16) >> 1) * 4096, 64, 0, r & 1, (h16*)(p.ws + WS_WRG) + (size_t)((r - 16) >> 1) * 128 * 64, 64, [](int n) { return 64 + n; }, scr, lane);
    }
  }
  {
    h16* wrh = (h16*)(p.ws + WS_WRH); h16* wrl = (h16*)(p.ws + WS_WRL);
    for (int i = blockIdx.x * NTHR + tid; i < 48 * 1024; i += G * NTHR) {
      const int col = i >> 10, k = i & 1023;
      const float w = (col < 4) ? p.in[17][k * 4 + col] : (col < 36 ? p.in[19][k * 32 + (col - 4)] : 0.f);
      const h16 hi = (h16)w;
      wrh[i] = hi; wrl[i] = (h16)(w - (float)hi);
    }
    float* ct = (float*)(p.ws + WS_ROPE); float* st = ct + 8192 * 32;
    for (int i = blockIdx.x * NTHR + tid; i < 8192 * 32; i += G * NTHR) {
      const int pos = i >> 5, f = i & 31;
      const double rev = (double)pos * ROPE_REV[f];
      const float fr = (float)(rev - __builtin_rint(rev));
      ct[i] = __builtin_amdgcn_cosf(fr); st[i] = __builtin_amdgcn_sinf(fr);
    }
  }
}

DEVI void phase1(PRef p, LDS unsigned char* lds) {
  const int tid = launder((int)threadIdx.x), lane = tid & 63, wave = wave_id(tid), G = gridDim.x;
  const int b = blockIdx.x & 3, bi = blockIdx.x >> 2, nbk = G >> 2;
  LDS float* mv = (LDS float*)lds;
  mod_to_lds(p, b, 0, mv); mod_to_lds(p, b, 1, mv + 1024);
  __syncthreads();
  f32x4 A[4], SH[4];
#pragma unroll
  for (int j = 0; j < 4; ++j) {
    const int k = 256 * j + 4 * lane;
    const f32x4 g = *(const f32x4*)(p.in[4] + k);
    A[j] = g * (*(LDS f32x4*)(mv + 1024 + k) + 1.f);
    SH[j] = *(LDS f32x4*)(mv + k);
  }
  const float* x = p.in[0]; h16* H = (h16*)(p.ws + WS_H);
  f32x4 vn[4];
  {
    const size_t tok = (size_t)b * SEQ + bi * 8 + wave;
#pragma unroll
    for (int j = 0; j < 4; ++j) vn[j] = *(const f32x4*)(x + tok * DM + 256 * j + 4 * lane);
  }
  for (int r = bi * 8 + wave; r < SEQ; r += nbk * 8) {
    const size_t tok = (size_t)b * SEQ + r;
    f32x4 v[4]; float ss = 0.f;
#pragma unroll
    for (int j = 0; j < 4; ++j) { v[j] = vn[j]; ss += v[j][0] * v[j][0] + v[j][1] * v[j][1] + v[j][2] * v[j][2] + v[j][3] * v[j][3]; }
    if (r + nbk * 8 < SEQ) {
#pragma unroll
      for (int j = 0; j < 4; ++j) vn[j] = *(const f32x4*)(x + (tok + nbk * 8) * DM + 256 * j + 4 * lane);
    }
    const float rstd = 1.0f / sqrtf(wave_sum(ss) * (1.f / 1024.f) + 1e-6f);
#pragma unroll
    for (int j = 0; j < 4; ++j) {
      const f32x4 y = v[j] * rstd * A[j] + SH[j];
      *(h16x4*)(H + tok * DM + 256 * j + 4 * lane) = pack4(y[0], y[1], y[2], y[3]);
    }
  }
}

DEVI h16x8 pack8(const f32x4& a, const f32x4& b) { h16x8 w; w[0] = (h16)a[0]; w[1] = (h16)a[1]; w[2] = (h16)a[2]; w[3] = (h16)a[3]; w[4] = (h16)b[0]; w[5] = (h16)b[1]; w[6] = (h16)b[2]; w[7] = (h16)b[3]; return w; }
struct EpiInProj {
  unsigned char* ws;
  DEVI void operator()(const f32x4 (&acc)[2][2][4][2], const g8::Unit& u, int wr, int wc, int fr, int fq) const {
    const float* cosT = (const float*)(ws + WS_ROPE); const float* sinT = cosT + 8192 * 32;
    const int g = 4 * u.pn + wc;
    if (g > 49) return;
    const int d0 = 8 * fq;
    const int tok0 = u.pm * 256 + 64 * wr + fr;
    if (g < 16 || (g >= 24 && g <= 32)) {
      float scl; h16* dst; int ld;
      if (g < 8) { scl = 0.125f * 1.4426950408889634f; dst = (h16*)(ws + WS_Q) + g * 64; ld = 512; }
      else if (g < 16) { scl = 1.f; dst = (h16*)(ws + WS_K) + (g - 8) * 64; ld = 512; }
      else if (g < 32) { scl = 0.125f; dst = (h16*)(ws + WS_QI) + (g - 24) * 64; ld = 512; }
      else { scl = 1.f; dst = (h16*)(ws + WS_KI); ld = 64; }
#pragma unroll
      for (int ai = 0; ai < 2; ++ai) {
        f32x4 ca[4], cb[4], sa[4], sb[4];
#pragma unroll
        for (int m = 0; m < 4; ++m) {
          const int pos = (tok0 + 128 * ai + 16 * m) & 8191;
          ca[m] = *(const f32x4*)(cosT + pos * 32 + d0); cb[m] = *(const f32x4*)(cosT + pos * 32 + d0 + 4);
          sa[m] = *(const f32x4*)(sinT + pos * 32 + d0); sb[m] = *(const f32x4*)(sinT + pos * 32 + d0 + 4);
        }
        __builtin_amdgcn_sched_barrier(0);
#pragma unroll
        for (int m = 0; m < 4; ++m) {
          const int tok = tok0 + 128 * ai + 16 * m;
          const f32x4 xa = acc[ai][0][m][0], xb = acc[ai][0][m][1], ya = acc[ai][1][m][0], yb = acc[ai][1][m][1];
          h16* o = dst + (size_t)tok * ld;
          *(h16x8*)(o + d0) = pack8((xa * ca[m] - ya * sa[m]) * scl, (xb * cb[m] - yb * sb[m]) * scl);
          *(h16x8*)(o + 32 + d0) = pack8((ya * ca[m] + xa * sa[m]) * scl, (yb * cb[m] + xb * sb[m]) * scl);
        }
      }
    } else if (g < 24) {
#pragma unroll
      for (int ai = 0; ai < 2; ++ai)
#pragma unroll
        for (int m = 0; m < 4; ++m) {
          const int tok = tok0 + 128 * ai + 16 * m;
          const int b = tok >> 13, pos = tok & 8191;
          const f32x4 xa = acc[ai][0][m][0], xb = acc[ai][0][m][1], ya = acc[ai][1][m][0], yb = acc[ai][1][m][1];
          h16* vt = (h16*)(ws + WS_VT) + (size_t)(b * 8 + (g - 16)) * 64 * 8192 + vt_perm(pos);
#pragma unroll
          for (int e = 0; e < 4; ++e) {
            vt[(size_t)(d0 + e) * 8192] = (h16)xa[e]; vt[(size_t)(d0 + 4 + e) * 8192] = (h16)xb[e];
            vt[(size_t)(32 + d0 + e) * 8192] = (h16)ya[e]; vt[(size_t)(36 + d0 + e) * 8192] = (h16)yb[e];
          }
        }
    } else if (g < 49) {
      h16* dst = (g < 41) ? (h16*)(ws + WS_XR) + (g - 33) * 64 : (h16*)(ws + WS_XG) + (g - 41) * 64;
#pragma unroll
      for (int ai = 0; ai < 2; ++ai)
#pragma unroll
        for (int m = 0; m < 4; ++m) {
          h16* o = dst + (size_t)(tok0 + 128 * ai + 16 * m) * 512;
          *(h16x8*)(o + d0) = pack8(acc[ai][0][m][0], acc[ai][0][m][1]);
          *(h16x8*)(o + 32 + d0) = pack8(acc[ai][1][m][0], acc[ai][1][m][1]);
        }
    } else if (fq == 0) {
      const float sc = 0.35355339059327373f;
#pragma unroll
      for (int ai = 0; ai < 2; ++ai)
#pragma unroll
        for (int m = 0; m < 4; ++m) {
          float* wi = (float*)(ws + WS_WI) + (size_t)(tok0 + 128 * ai + 16 * m) * 8;
          *(f32x4*)wi = acc[ai][0][m][0] * sc; *(f32x4*)(wi + 4) = acc[ai][0][m][1] * sc;
        }
    }
  }
};

DEVI void phase2(PRef p, LDS unsigned char* lds) {
  g8::DenseOrder S{(const h16*)(p.ws + WS_H), (const h16*)(p.ws + WS_WIN), DM, 128, 13, (int)gridDim.x, (int)blockIdx.x};
  EpiInProj E{p.ws};
  g8::gemm_phase(lds, DM, S, E);
}

constexpr int CROW = 1040;
constexpr int RNN_XG = 64 * CROW;
constexpr int RNN_CARRY = 2 * 64 * CROW;
template <int MODE>
DEVI void rnn_item(PRef p, LDS unsigned char* lds, int b, int cr) {
  const int tid = launder((int)threadIdx.x), lane = tid & 63, wave = wave_id(tid), l31 = lane & 31, half = lane >> 5;
  const h16* XR = (const h16*)(p.ws + WS_XR);
  {
    const int chg = tid & 63, tg = tid >> 6, pos0 = cr * 64 + 8 * tg;
    h16x8 xin[11];
#pragma unroll
    for (int i = 0; i < 11; ++i) {
      const int pos = pos0 + i - 3;
      if (pos >= 0) xin[i] = *(const h16x8*)(XR + ((size_t)b * SEQ + pos) * 512 + chg * 8);
      else {
#pragma unroll
        for (int e = 0; e < 8; ++e) xin[i][e] = (h16)0.f;
      }
    }
    float cw[4][8], cb[8];
#pragma unroll
    for (int e = 0; e < 8; ++e) {
      cb[e] = p.in[10][chg * 8 + e];
#pragma unroll
      for (int j = 0; j < 4; ++j) cw[j][e] = p.in[9][j * 512 + chg * 8 + e];
    }
#pragma unroll
    for (int tt = 0; tt < 8; ++tt) {
      h16x8 o;
#pragma unroll
      for (int e = 0; e < 8; ++e) {
        float v = cb[e];
#pragma unroll
        for (int j = 0; j < 4; ++j) v = fmaf(cw[j][e], (float)xin[tt + j][e], v);
        o[e] = (h16)v;
      }
      *(LDS h16x8*)(lds + (8 * tg + tt) * CROW + chg * 16) = o;
    }
  }
  if (MODE == 1) {
    const float2* ag = (const float2*)(p.ws + WS_AGG) + (size_t)b * 128 * 512 + tid;
    float carry = 0.f; int c2 = 0;
    for (; c2 + 8 <= cr; c2 += 8) {
      float2 v[8];
#pragma unroll
      for (int u = 0; u < 8; ++u) v[u] = ag[(size_t)(c2 + u) * 512];
#pragma unroll
      for (int u = 0; u < 8; ++u) carry = fmaf(v[u].x, carry, v[u].y);
    }
    for (; c2 < cr; ++c2) { const float2 v = ag[(size_t)c2 * 512]; carry = fmaf(v.x, carry, v.y); }
    ((LDS float*)(lds + RNN_CARRY))[tid] = carry;
  }
  if (MODE == 1) {
    const h16* XG = (const h16*)(p.ws + WS_XG) + ((size_t)b * SEQ + cr * 64) * 512;
#pragma unroll
    for (int i = 0; i < 8; ++i) { const int c = tid + NTHR * i, row = c >> 6, cc = c & 63; *(LDS h16x8*)(lds + RNN_XG + row * CROW + cc * 16) = *(const h16x8*)(XG + (size_t)row * 512 + cc * 8); }
  }
  __syncthreads();
  const int n = wave;
  const h16* WRG = (const h16*)(p.ws + WS_WRG) + (size_t)n * 128 * 64;
  float* AGG = (float*)(p.ws + WS_AGG);
#pragma unroll 1
  for (int dt = 0; dt < 2; ++dt) {
    h16x8 wa[4], wx[4];
#pragma unroll
    for (int kk = 0; kk < 4; ++kk) {
      wa[kk] = *(const h16x8*)(WRG + (size_t)(32 * dt + l31) * 64 + 16 * kk + 8 * half);
      wx[kk] = *(const h16x8*)(WRG + (size_t)(64 + 32 * dt + l31) * 64 + 16 * kk + 8 * half);
    }
    f32x16 ra[2], rx[2];
#pragma unroll
    for (int ti = 0; ti < 2; ++ti) {
#pragma unroll
      for (int r = 0; r < 16; ++r) { ra[ti][r] = 0.f; rx[ti][r] = 0.f; }
#pragma unroll
      for (int kk = 0; kk < 4; ++kk) {
        const h16x8 af = *(LDS h16x8*)(lds + (32 * ti + l31) * CROW + (n * 64 + 16 * kk + 8 * half) * 2);
        ra[ti] = mfma16(af, wa[kk], ra[ti]);
        rx[ti] = mfma16(af, wx[kk], rx[ti]);
      }
    }
    const int ch = n * 64 + 32 * dt + l31;
    const float ba = p.in[12][ch], bx = p.in[14][ch], lam = p.in[15][ch];
    const float c8 = -8.f * log1pf(__expf(-lam));
#pragma unroll
    for (int ti = 0; ti < 2; ++ti)
#pragma unroll
      for (int r = 0; r < 16; ++r) {
        const int tk = 32 * ti + (r & 3) + 8 * (r >> 2) + 4 * half;
        const float cv = (float)*(LDS h16*)(lds + tk * CROW + ch * 2);
        const float rr = sigmoid_f(ra[ti][r] + ba), ii = sigmoid_f(rx[ti][r] + bx);
        const float la = c8 * rr;
        ra[ti][r] = __expf(la);
        const float x2 = 2.f * la;
        const float om = -x2 * fmaf(x2 * 0.5f, fmaf(x2 * (1.f / 3.f), fmaf(x2 * 0.25f, fmaf(x2, 0.2f, 1.f), 1.f), 1.f), 1.f);
        rx[ti][r] = __builtin_amdgcn_sqrtf(om) * (ii * cv);
      }
    float P[8], Hs[8];
#pragma unroll
    for (int sg = 0; sg < 8; ++sg) {
      const int ti = sg >> 2, q = sg & 3;
      float pp = 1.f, hh = 0.f;
#pragma unroll
      for (int i = 0; i < 4; ++i) { const float a = ra[ti][4 * q + i], bb = rx[ti][4 * q + i]; hh = fmaf(a, hh, bb); pp *= a; }
      P[sg] = pp; Hs[sg] = hh;
    }
    float carry = 0.f, prod = 1.f;
    if (MODE == 1) carry = ((LDS float*)(lds + RNN_CARRY))[ch];
    float cin[8];
#pragma unroll
    for (int sg = 0; sg < 8; ++sg)
#pragma unroll
      for (int ow = 0; ow < 2; ++ow) {
        const float tmp = fmaf(P[sg], carry, Hs[sg]);
        const float tp = P[sg] * prod;
        if (half == ow) cin[sg] = carry;
        const auto swc = __builtin_amdgcn_permlane32_swap(__float_as_uint(tmp), __float_as_uint(tmp), false, false);
        const auto swp = __builtin_amdgcn_permlane32_swap(__float_as_uint(tp), __float_as_uint(tp), false, false);
        carry = __uint_as_float(swc[ow]); prod = __uint_as_float(swp[ow]);
      }
    if (MODE == 0) {
      if (half == 0) { float* ag = AGG + ((size_t)(b * 128 + cr) * 512 + ch) * 2; ag[0] = prod; ag[1] = carry; }
    } else {
#pragma unroll
      for (int sg = 0; sg < 8; ++sg) {
        const int ti = sg >> 2, q = sg & 3;
        float hh = cin[sg];
#pragma unroll
        for (int i = 0; i < 4; ++i) {
          hh = fmaf(ra[ti][4 * q + i], hh, rx[ti][4 * q + i]);
          LDS h16* xp = (LDS h16*)(lds + RNN_XG + (32 * ti + 8 * q + 4 * half + i) * CROW + ch * 2);
          *xp = (h16)(hh * gelu_tanh_f((float)*xp));
        }
      }
    }
  }
  __syncthreads();
  if (MODE == 1) {
    h16* Y = (h16*)(p.ws + WS_H) + ((size_t)b * SEQ + cr * 64) * DM + 512;
#pragma unroll
    for (int i = 0; i < 8; ++i) { const int c = tid + NTHR * i, row = c >> 6, cc = c & 63; *(h16x8*)(Y + (size_t)row * DM + cc * 8) = *(LDS h16x8*)(lds + RNN_XG + row * CROW + cc * 16); }
    __syncthreads();
  }
}

constexpr int IDX_NB = 256, IDX_CAP = 128;
constexpr int IL_HIST = 0, IL_CS = 65536, IL_CK = IL_CS + 64 * IDX_CAP * 4, IL_KI = IL_CK + 64 * IDX_CAP * 2, IL_KISZ = 128 * LROW, IL_ST = IL_KI + 2 * IL_KISZ;
static_assert(IL_ST + 4096 <= LDS_BYTES, "indexer LDS map");

DEVI f32x4 mfma16s(h16x8 a, h16x8 b, f32x4 c) { return __builtin_amdgcn_mfma_f32_16x16x32_f16(a, b, c, 0, 0, 0); }
DEVI void idx_score(LDS unsigned char* kit, int kh, int l15, int g4, const h16x8 (&qf)[8][2], const float (&wq)[8], f32x4 (&sc)[4]) {
  h16x8 kf[4][2];
#pragma unroll
  for (int kt = 0; kt < 4; ++kt)
#pragma unroll
    for (int ks = 0; ks < 2; ++ks) kf[kt][ks] = *(LDS h16x8*)(kit + (64 * kh + 16 * kt + l15) * LROW + (4 * ks + g4) * 16);
#pragma unroll
  for (int kt = 0; kt < 4; ++kt) sc[kt] = (f32x4){0.f, 0.f, 0.f, 0.f};
  f32x4 accA[4], accB[4];
#define IDX_MM(ACC, h) _Pragma("unroll") for (int kt = 0; kt < 4; ++kt) { ACC[kt] = mfma16s(kf[kt][0], qf[h][0], (f32x4){0.f, 0.f, 0.f, 0.f}); ACC[kt] = mfma16s(kf[kt][1], qf[h][1], ACC[kt]); }
#define IDX_RS(ACC, h) _Pragma("unroll") for (int kt = 0; kt < 4; ++kt) _Pragma("unroll") for (int r = 0; r < 4; ++r) sc[kt][r] = __builtin_fmaf(wq[h], __int_as_float(max(__float_as_int(ACC[kt][r]), 0)), sc[kt][r]);
  IDX_MM(accA, 0)
  IDX_MM(accB, 1) IDX_RS(accA, 0)
  IDX_MM(accA, 2) IDX_RS(accB, 1)
  IDX_MM(accB, 3) IDX_RS(accA, 2)
  IDX_MM(accA, 4) IDX_RS(accB, 3)
  IDX_MM(accB, 5) IDX_RS(accA, 4)
  IDX_MM(accA, 6) IDX_RS(accB, 5)
  IDX_MM(accB, 7) IDX_RS(accA, 6)
  IDX_RS(accB, 7)
#undef IDX_MM
#undef IDX_RS
}

template <int MODE>
DEVI void idx_pass(LDS unsigned char* lds, const h16* KIb, int N, int stride, int qg, int kh,
                   const h16* QIrow0, const float* WIrow0, float qinv, float qoff, int bstar, h16* scbase) {
  const int tid = launder((int)threadIdx.x), lane = tid & 63, l15 = lane & 15, g4 = lane >> 4;
  const int q = 16 * qg + l15;
  h16x8 qf[8][2]; float wq[8];
  {
    const h16* QI = QIrow0 + (size_t)q * 512;
#pragma unroll
    for (int h = 0; h < 8; ++h)
#pragma unroll
      for (int ks = 0; ks < 2; ++ks) qf[h][ks] = *(const h16x8*)(QI + h * 64 + 32 * ks + 8 * g4);
    const float* WI = WIrow0 + (size_t)q * 8;
#pragma unroll
    for (int h = 0; h < 8; ++h) wq[h] = WI[h];
#pragma unroll
    for (int h = 0; h < 8; ++h) { asm volatile("" : "+v"(qf[h][0])); asm volatile("" : "+v"(qf[h][1])); asm volatile("" : "+v"(wq[h])); }
  }
  LDS unsigned* hist = (LDS unsigned*)(lds + IL_HIST);
  LDS unsigned* st = (LDS unsigned*)(lds + IL_ST);
  const int nst = (N + 127) >> 7;
  const int lr = tid >> 3, lc = tid & 7;
  h16x8 r0, r1;
  r0 = *(const h16x8*)(KIb + (size_t)lr * 64 + lc * 8); r1 = *(const h16x8*)(KIb + (size_t)(lr + 64) * 64 + lc * 8);
  *(LDS h16x8*)(lds + IL_KI + lr * LROW + lc * 16) = r0; *(LDS h16x8*)(lds + IL_KI + (lr + 64) * LROW + lc * 16) = r1;
  __syncthreads();
  float vmin = INFINITY, vmax = -INFINITY;
  int cur = 0;
  for (int s = 0; s < nst; s += stride) {
    const int nx = s + stride;
    { const int nxc = nx < nst ? nx : s;
      r0 = *(const h16x8*)(KIb + (size_t)(128 * nxc + lr) * 64 + lc * 8); r1 = *(const h16x8*)(KIb + (size_t)(128 * nxc + lr + 64) * 64 + lc * 8); }
    const bool active = 128 * s + 64 * kh < N;
    f32x4 sc[4];
    if (active) {
      idx_score(lds + IL_KI + cur * IL_KISZ, kh, l15, g4, qf, wq, sc);
#pragma unroll
      for (int kt = 0; kt < 4; ++kt) asm volatile("" : "+v"(sc[kt]));
    }
    {
      *(LDS h16x8*)(lds + IL_KI + (cur ^ 1) * IL_KISZ + lr * LROW + lc * 16) = r0;
      *(LDS h16x8*)(lds + IL_KI + (cur ^ 1) * IL_KISZ + (lr + 64) * LROW + lc * 16) = r1;
    }
    if (active) {
      if (MODE == 0) {
#pragma unroll
        for (int kt = 0; kt < 4; ++kt)
#pragma unroll
          for (int r = 0; r < 4; ++r) { vmin = fminf(vmin, sc[kt][r]); vmax = fmaxf(vmax, sc[kt][r]); }
      } else if (MODE == 1) {
        h16* scp = scbase + ((size_t)((s * 2 + kh) * 4) * 1024 + q * 16 + 4 * g4);
#pragma unroll
        for (int kt = 0; kt < 4; ++kt) {
          const h16x4 hv = pack4(sc[kt][0], sc[kt][1], sc[kt][2], sc[kt][3]);
          *(h16x4*)(scp + kt * 1024) = hv;
#pragma unroll
          for (int r = 0; r < 4; ++r) {
            const float xb = fminf(fmaxf(__builtin_fmaf((float)hv[r], qinv, qoff), 0.f), (float)(IDX_NB - 1));
            const int bin = (int)xb;
            __hip_atomic_fetch_add(&hist[bin * 64 + q], 1u, __ATOMIC_RELAXED, __HIP_MEMORY_SCOPE_WORKGROUP);
          }
        }
      }
    }
    __syncthreads();
    cur ^= 1;
  }
  if (MODE == 0) {
    __hip_atomic_fetch_min(&st[q], fkey(vmin), __ATOMIC_RELAXED, __HIP_MEMORY_SCOPE_WORKGROUP);
    __hip_atomic_fetch_max(&st[64 + q], fkey(vmax), __ATOMIC_RELAXED, __HIP_MEMORY_SCOPE_WORKGROUP);
  }
}

DEVI int idx_bin(float sv, float qinv, float qoff) { return (int)fminf(fmaxf(__builtin_fmaf(sv, qinv, qoff), 0.f), (float)(IDX_NB - 1)); }
DEVI float idx_bin_lower_bound(int target, float qinv, float qoff) {
  if (target <= 0) return -INFINITY;
  if (target > IDX_NB - 1) return INFINITY;
  unsigned lo = 0x03FFu, hi = 0xFC00u;
  auto val = [](unsigned k) { const unsigned short hbits = (unsigned short)((k & 0x8000u) ? (k & 0x7FFFu) : (~k & 0xFFFFu)); return (float)__builtin_bit_cast(h16, hbits); };
  if (idx_bin(val(hi), qinv, qoff) < target) return INFINITY;
  while (lo < hi) { const unsigned mid = (lo + hi) >> 1; if (idx_bin(val(mid), qinv, qoff) >= target) hi = mid; else lo = mid + 1; }
  return val(lo);
}
DEVI void idx_stream_step(LDS unsigned char* lds, LDS unsigned* st, const unsigned long long (&cur)[4], int s, int kh, int q, int lane, int g4, h16 thi, h16 tlo) {
  unsigned nib = 0u, cnb = 0u;
#pragma unroll
  for (int kt = 3; kt >= 0; --kt) {
    const h16x4 hv = __builtin_bit_cast(h16x4, cur[kt]);
#pragma unroll
    for (int r = 3; r >= 0; --r) {
      const unsigned long long ms = __builtin_amdgcn_ballot_w64(hv[r] >= thi);
      asm("v_addc_co_u32_e64 %0, vcc, %0, %0, %1" : "+v"(nib) : "s"(ms) : "vcc");
      const unsigned long long mc = __builtin_amdgcn_ballot_w64(hv[r] >= tlo);
      asm("v_addc_co_u32_e64 %0, vcc, %0, %0, %1" : "+v"(cnb) : "s"(mc) : "vcc");
    }
  }
  unsigned cm = cnb & ~nib;
  if (__builtin_amdgcn_ballot_w64(cm != 0u) != 0ull) {
    while (cm != 0u) {
      const int e = __builtin_ctz(cm); cm &= cm - 1u;
      const int kt = e >> 2, r = e & 3;
      const unsigned long long w = kt == 0 ? cur[0] : (kt == 1 ? cur[1] : (kt == 2 ? cur[2] : cur[3]));
      const unsigned hb = (unsigned)(w >> (16 * r)) & 0xFFFFu;
      const unsigned sk = (hb & 0x8000u) ? (~hb & 0xFFFFu) : (hb | 0x8000u);
      const unsigned key = (unsigned)(128 * s + 64 * kh + 16 * kt + 4 * g4 + r);
      const unsigned pos = __hip_atomic_fetch_add(&st[128 + q], 1u, __ATOMIC_RELAXED, __HIP_MEMORY_SCOPE_WORKGROUP);
      if (pos < (unsigned)IDX_CAP) ((LDS unsigned*)(lds + IL_CS))[q * IDX_CAP + pos] = (sk << 16) | (0xFFFFu - key);
    }
  }
  const auto sw = __builtin_amdgcn_permlane32_swap(nib, nib, false, false);
  const unsigned oth = sw[1];
  if (lane < 32) {
#pragma unroll
    for (int T = 0; T < 2; ++T) {
      const unsigned b0 = ((nib >> (8 * T)) & 15u) | (((oth >> (8 * T)) & 15u) << 4);
      const unsigned b1 = ((nib >> (8 * T + 4)) & 15u) | (((oth >> (8 * T + 4)) & 15u) << 4);
      ((LDS unsigned short*)(lds + IL_HIST))[q * 512 + (4 * s + 2 * kh + T) * 2 + (g4 & 1)] = (unsigned short)(b0 | (b1 << 8));
    }
  }
}
DEVI void idx_stream(LDS unsigned char* lds, int N, int qg, int kh, float thi_f, float tlo_f, const h16* scbase) {
  const int tid = launder((int)threadIdx.x), lane = tid & 63, l15 = lane & 15, g4 = lane >> 4;
  const int q = 16 * qg + l15;
  const h16 thi = (h16)thi_f, tlo = (h16)tlo_f;
  LDS unsigned* st = (LDS unsigned*)(lds + IL_ST);
  const int nv = (N - 64 * kh + 127) >> 7;
  const unsigned long long* scp = (const unsigned long long*)(scbase + ((size_t)(kh * 4) * 1024 + q * 16 + 4 * g4));
#define IDX_LD(dst, s_) do { const int sc_ = (s_) < nv ? (s_) : nv - 1; _Pragma("unroll") for (int kt = 0; kt < 4; ++kt) dst[kt] = __hip_atomic_load(scp + (size_t)sc_ * 2048 + kt * 256, __ATOMIC_RELAXED, __HIP_MEMORY_SCOPE_AGENT); } while (0)
  unsigned long long b0[4], b1[4], b2[4], b3[4];
  IDX_LD(b0, 0); IDX_LD(b1, 1); IDX_LD(b2, 2); IDX_LD(b3, 3);
  for (int s = 0; s < nv; s += 4) {
    idx_stream_step(lds, st, b0, s, kh, q, lane, g4, thi, tlo); IDX_LD(b0, s + 4);
    if (s + 1 < nv) idx_stream_step(lds, st, b1, s + 1, kh, q, lane, g4, thi, tlo);
    IDX_LD(b1, s + 5);
    if (s + 2 < nv) idx_stream_step(lds, st, b2, s + 2, kh, q, lane, g4, thi, tlo);
    IDX_LD(b2, s + 6);
    if (s + 3 < nv) idx_stream_step(lds, st, b3, s + 3, kh, q, lane, g4, thi, tlo);
    IDX_LD(b3, s + 7);
  }
#undef IDX_LD
}

DEVI void idx_item(PRef p, LDS unsigned char* lds, int b, int c) {
  const int tid = launder((int)threadIdx.x), lane = tid & 63, wave = wave_id(tid), l31 = lane & 31, half = lane >> 5;
  const int N = 64 * (c + 1);
  unsigned* MASK = (unsigned*)(p.ws + WS_MASK) + ((size_t)b * SEQ + 64 * c) * 256;
  if (N <= 256) {
    const int wpr = N >> 5;
    for (int i = tid; i < 64 * wpr; i += NTHR) MASK[(size_t)(i / wpr) * 256 + (i % wpr)] = 0xFFFFFFFFu;
    return;
  }
  const int qg = wave & 3, kh = wave >> 2, l15 = lane & 15, q = 16 * qg + l15;
  const h16* QIrow0 = (const h16*)(p.ws + WS_QI) + ((size_t)b * SEQ + 64 * c) * 512;
  const float* WIrow0 = (const float*)(p.ws + WS_WI) + ((size_t)b * SEQ + 64 * c) * 8;
  const h16* KIb = (const h16*)(p.ws + WS_KI) + (size_t)b * SEQ * 64;
  h16* scbase;
  {
    const int j = (c < 64) ? c : 127 - c;
    const size_t pre = 8192ull * (size_t)(128 * j - (j * (j - 1)) / 2);
    scbase = (h16*)(p.ws + (b == 0 ? WS_H : WS_MIX + (size_t)(b - 1) * SC_BATCH_BYTES) + pre);
  }
  LDS unsigned* st = (LDS unsigned*)(lds + IL_ST);
  LDS float* stf = (LDS float*)(lds + IL_ST);
  if (tid < 64) { st[tid] = 0xFFFFFFFFu; st[64 + tid] = 0u; st[128 + tid] = 0u; }
  __syncthreads();
  const int nst = (N + 127) >> 7;
  const int stride = nst >= 16 ? 8 : (nst >= 8 ? 4 : (nst >= 4 ? 2 : 1));
  idx_pass<0>(lds, KIb, N, stride, qg, kh, QIrow0, WIrow0, 0.f, 0.f, 0, scbase);
  __syncthreads();
  if (tid < 64) {
    const float lo = fkey_inv(st[tid]), hi = fkey_inv(st[64 + tid]);
    float d = hi - lo; if (!(d > 1e-20f)) d = 1.f;
    const float inv = (float)IDX_NB / (1.5f * d);
    stf[192 + tid] = inv; stf[256 + tid] = -(lo - 0.25f * d) * inv;
  }
  for (int i = tid; i < 16384; i += NTHR) ((LDS unsigned*)(lds + IL_HIST))[i] = 0u;
  __syncthreads();
  const float qinv = stf[192 + q], qoff = stf[256 + q];
  idx_pass<1>(lds, KIb, N, 1, qg, kh, QIrow0, WIrow0, qinv, qoff, 0, scbase);
  {
    LDS unsigned* hist = (LDS unsigned*)(lds + IL_HIST);
    for (int qq = wave; qq < 64; qq += 8) {
      unsigned hb[4];
#pragma unroll
      for (int j = 0; j < 4; ++j) hb[j] = hist[(4 * lane + j) * 64 + qq];
      const unsigned mine = hb[0] + hb[1] + hb[2] + hb[3];
      unsigned suf = mine;
#pragma unroll
      for (int o = 1; o < 64; o <<= 1) { const unsigned v = (unsigned)__shfl_down((int)suf, o); if (lane + o < 64) suf += v; }
      unsigned cum = suf - mine;
      if (cum < 256u && suf >= 256u) {
#pragma unroll
        for (int j = 3; j >= 0; --j) {
          if (cum < 256u && cum + hb[j] >= 256u) { st[320 + qq] = (unsigned)(4 * lane + j); st[384 + qq] = 256u - cum; }
          cum += hb[j];
        }
      }
    }
  }
  __syncthreads();
  if (tid < 64) {
    const int bs = (int)st[320 + tid]; const float qi_ = stf[192 + tid], qo_ = stf[256 + tid];
    stf[448 + tid] = idx_bin_lower_bound(bs + 1, qi_, qo_);
    stf[512 + tid] = idx_bin_lower_bound(bs, qi_, qo_);
  }
  __syncthreads();
  const float thi = stf[448 + q], tlo = stf[512 + q];
  asm volatile("s_waitcnt vmcnt(0)" ::: "memory");
  idx_stream(lds, N, qg, kh, thi, tlo, scbase);
  __syncthreads();
  for (int qq = wave; qq < 64; qq += 8) {
    const int nc = min((int)st[128 + qq], IDX_CAP); const unsigned need = st[384 + qq];
    LDS unsigned* cs = (LDS unsigned*)(lds + IL_CS) + qq * IDX_CAP;
    const unsigned c1 = lane < nc ? cs[lane] : 0u, c2 = 64 + lane < nc ? cs[64 + lane] : 0u;
    unsigned r1 = 0u, r2 = 0u;
    const int n1 = nc < 64 ? nc : 64;
    for (int j = 0; j < n1; ++j) { const unsigned cj = (unsigned)__builtin_amdgcn_readlane((int)c1, j); r1 += cj > c1 ? 1u : 0u; r2 += cj > c2 ? 1u : 0u; }
    for (int j = 64; j < nc; ++j) { const unsigned cj = (unsigned)__builtin_amdgcn_readlane((int)c2, j - 64); r1 += cj > c1 ? 1u : 0u; r2 += cj > c2 ? 1u : 0u; }
#pragma unroll
    for (int h2 = 0; h2 < 2; ++h2) {
      const unsigned cv = h2 ? c2 : c1, rk = h2 ? r2 : r1;
      if (64 * h2 + lane < nc && rk < need) {
        const unsigned kv = 0xFFFFu - (cv & 0xFFFFu), kl = kv & 31u;
        const unsigned bit = 16u * ((kl >> 2) & 1u) + (kl & 3u) + 4u * (kl >> 3);
        __hip_atomic_fetch_or((LDS unsigned*)(lds + IL_HIST) + qq * 256 + (kv >> 5), 1u << bit, __ATOMIC_RELAXED, __HIP_MEMORY_SCOPE_WORKGROUP);
      }
    }
  }
  __syncthreads();
  {
    const int cpr = N >> 6;
    for (int i = tid; i < 64 * cpr; i += NTHR) {
      const int row = i / cpr, cc = i % cpr;
      *(u32x2*)(MASK + (size_t)row * 256 + 2 * cc) = *(LDS u32x2*)(lds + IL_HIST + row * 1024 + cc * 8);
    }
  }
  __syncthreads();
}

DEVI void phase3(PRef p, LDS unsigned char* lds) {
  const int G = gridDim.x;
  for (int it = blockIdx.x; it < 512; it += G) rnn_item<0>(p, lds, it >> 7, it & 127);
  for (int it = blockIdx.x; it < 256; it += G) {
    const int b = it >> 6, j = it & 63;
#pragma unroll 1
    for (int w2 = 0; w2 < 2; ++w2) idx_item(p, lds, b, w2 ? j : 127 - j);
  }
}

DEVI float max3f(float a, float b, float c) { float r; asm("v_max3_f32 %0, %1, %2, %3" : "=v"(r) : "v"(a), "v"(b), "v"(c)); return r; }
DEVI unsigned pk_rtz(float a, float b) { return __builtin_bit_cast(unsigned, __builtin_amdgcn_cvt_pkrtz(a, b)); }
DEVI void attn_seed(f32x16 (&s)[2], u32x2 mw, int half, float mref) {
  const unsigned nm0 = ~(mw[0] >> (16 * half)), nm1 = ~(mw[1] >> (16 * half));
  const unsigned negm = __float_as_uint(-mref);
#pragma unroll
  for (int r = 0; r < 16; ++r) {
    unsigned e0 = (unsigned)__builtin_amdgcn_sbfe((int)nm0, r, 1), e1 = (unsigned)__builtin_amdgcn_sbfe((int)nm1, r, 1);
    asm volatile("" : "+v"(e0), "+v"(e1));
    s[0][r] = __uint_as_float((e0 & 0xFF800000u) | (~e0 & negm));
    s[1][r] = __uint_as_float((e1 & 0xFF800000u) | (~e1 & negm));
  }
}
DEVI void attn_tile(LDS unsigned char* Kt, LDS unsigned char* Vt, const h16x8 (&qf)[4], f32x16 (&s)[2], u32x2 mwn, int l31, int half, f32x16 (&o)[2], float& mref, float& l, bool& init) {
  h16x8 kf[2][4];
#pragma unroll
  for (int ri = 0; ri < 2; ++ri)
#pragma unroll
    for (int kk = 0; kk < 4; ++kk) kf[ri][kk] = *(LDS h16x8*)(Kt + (32 * ri + l31) * LROW + (2 * kk + half) * 16);
  __builtin_amdgcn_sched_barrier(0);
#pragma unroll
  for (int kk = 0; kk < 4; ++kk)
#pragma unroll
    for (int ri = 0; ri < 2; ++ri) s[ri] = mfma16(kf[ri][kk], qf[kk], s[ri]);
  h16x8 vf[2][4];
#pragma unroll
  for (int di = 0; di < 2; ++di)
#pragma unroll
    for (int s4 = 0; s4 < 4; ++s4) vf[di][s4] = *(LDS h16x8*)(Vt + (32 * di + l31) * LROW + (2 * s4 + half) * 16);
  __builtin_amdgcn_sched_barrier(0);
  asm volatile("s_nop 15\n\ts_nop 7" : "+v"(s[0]), "+v"(s[1]));
  float mx = max3f(s[0][0], s[1][0], s[0][1]), mx2 = max3f(s[1][1], s[0][2], s[1][2]);
#pragma unroll
  for (int r = 3; r < 15; r += 2) { mx = max3f(mx, s[0][r], s[1][r]); mx2 = max3f(mx2, s[0][r + 1], s[1][r + 1]); }
  mx = max3f(mx, s[0][15], s[1][15]);
  mx = max3f(mx, mx2, mx2);
  { const auto sw = __builtin_amdgcn_permlane32_swap(__float_as_uint(mx), __float_as_uint(mx), false, false);
    mx = fmaxf(__uint_as_float(sw[0]), __uint_as_float(sw[1])); }
  const bool first = (!init) && (mx > -INFINITY);
  const bool resc = first || (mx > 8.f);
  if (__any(resc)) {
    init = init || first;
    const float delta = resc ? mx : 0.f;
    const float alpha = __builtin_amdgcn_exp2f(-delta);
#pragma unroll
    for (int r = 0; r < 16; ++r) { s[0][r] -= delta; s[1][r] -= delta; o[0][r] *= alpha; o[1][r] *= alpha; }
    l *= alpha; mref += delta;
  }
  float ls = 0.f;
#pragma unroll
  for (int r = 0; r < 16; ++r) {
    s[0][r] = __builtin_amdgcn_exp2f(s[0][r]); s[1][r] = __builtin_amdgcn_exp2f(s[1][r]);
    ls += s[0][r] + s[1][r];
  }
  l += ls;
  h16x8 pf[4];
#pragma unroll
  for (int s4 = 0; s4 < 4; ++s4) {
    u32x4 w;
#pragma unroll
    for (int e = 0; e < 4; ++e) w[e] = pk_rtz(s[s4 >> 1][8 * (s4 & 1) + 2 * e], s[s4 >> 1][8 * (s4 & 1) + 2 * e + 1]);
    pf[s4] = __builtin_bit_cast(h16x8, w);
  }
  __builtin_amdgcn_sched_barrier(0);
  {
    const unsigned nm0 = ~(mwn[0] >> (16 * half)), nm1 = ~(mwn[1] >> (16 * half));
    const unsigned negm = __float_as_uint(-mref);
#pragma unroll
    for (int i = 0; i < 8; ++i) {
      const int di = i >> 2, s4 = i & 3;
      o[di] = mfma16(vf[di][s4], pf[s4], o[di]);
#pragma unroll
      for (int r = 2 * i; r < 2 * i + 2; ++r) {
        unsigned e0 = (unsigned)__builtin_amdgcn_sbfe((int)nm0, r, 1), e1 = (unsigned)__builtin_amdgcn_sbfe((int)nm1, r, 1);
        asm volatile("" : "+v"(e0), "+v"(e1));
        s[0][r] = __uint_as_float((e0 & 0xFF800000u) | (~e0 & negm));
        s[1][r] = __uint_as_float((e1 & 0xFF800000u) | (~e1 & negm));
      }
    }
#pragma unroll
    for (int i = 0; i < 8; ++i) { __builtin_amdgcn_sched_group_barrier(0x008, 1, 0); __builtin_amdgcn_sched_group_barrier(0x002, 8, 0); }
  }
}

DEVI void attn_unit(PRef p, LDS unsigned char* lds, int b, int head, int qb) {
  const int tid = launder((int)threadIdx.x), lane = tid & 63, wave = wave_id(tid), l31 = lane & 31, half = lane >> 5;
  const int q0 = qb * 256 + wave * 32, cw = q0 >> 6, NS = qb + 1;
  const size_t tok = (size_t)b * SEQ + q0 + l31;
  h16x8 qf[4];
  {
    const h16* Q = (const h16*)(p.ws + WS_Q) + tok * 512 + head * 64;
#pragma unroll
    for (int kk = 0; kk < 4; ++kk) qf[kk] = *(const h16x8*)(Q + 16 * kk + 8 * half);
  }
  const unsigned* mrow = (const unsigned*)(p.ws + WS_MASK) + tok * 256;
  constexpr int TP = 2 * 64 * LROW, ABUF = 4 * TP;
  static_assert(2 * ABUF <= LDS_BYTES - 16, "attention LDS");
  const h16* ksrc[4]; const h16* vsrc[4]; int kdst[4], vdst[4];
#pragma unroll
  for (int i = 0; i < 4; ++i) {
    const int id = tid + NTHR * i;
    const int row = id >> 3, lc = id & 7;
    ksrc[i] = (const h16*)(p.ws + WS_K) + ((size_t)b * SEQ + row) * 512 + head * 64 + lc * 8;
    kdst[i] = (row >> 6) * TP + (row & 63) * LROW + lc * 16;
    const int d = id >> 5, c = id & 31;
    vsrc[i] = (const h16*)(p.ws + WS_VT) + ((size_t)(b * 8 + head) * 64 + d) * 8192 + c * 8;
    vdst[i] = (c >> 3) * TP + 64 * LROW + d * LROW + (c & 7) * 16;
  }
  h16x8 rkA[4], rvA[4], rkB[4], rvB[4];
#pragma unroll
  for (int i = 0; i < 4; ++i) { rkA[i] = *(const h16x8*)ksrc[i]; rvA[i] = *(const h16x8*)vsrc[i]; }
#pragma unroll
  for (int i = 0; i < 4; ++i) { *(LDS h16x8*)(lds + kdst[i]) = rkA[i]; *(LDS h16x8*)(lds + vdst[i]) = rvA[i]; }
  {
    const int s1 = NS > 1 ? 1 : 0;
#pragma unroll
    for (int i = 0; i < 4; ++i) { rkA[i] = *(const h16x8*)(ksrc[i] + (size_t)s1 * 256 * 512); rvA[i] = *(const h16x8*)(vsrc[i] + s1 * 256); }
  }
  u32x4 mA0 = *(const u32x4*)mrow, mA1 = *(const u32x4*)(mrow + 4), mB0, mB1;
  __syncthreads();
  f32x16 o[2];
#pragma unroll
  for (int r = 0; r < 16; ++r) { o[0][r] = 0.f; o[1][r] = 0.f; }
  float mref = 0.f, l = 0.f; bool init = false;
  f32x16 sd[2];
  { u32x2 m2; m2[0] = mA0[0]; m2[1] = mA0[1]; attn_seed(sd, m2, half, mref); }
#define ATT_TILE(s, t, W0, W1) if (4 * (s) + (t) <= cw) { u32x2 m2; m2[0] = W0; m2[1] = W1; attn_tile(bb + (t) * TP, bb + (t) * TP + 64 * LROW, qf, sd, m2, l31, half, o, mref, l, init); }
#define ATT_STEP(s, RKC, RVC, RKN, RVN, MC0, MC1, MN0, MN1) { \
    { const int sp = (s) + 2 < NS ? (s) + 2 : NS - 1; _Pragma("unroll") for (int i = 0; i < 4; ++i) { RKN[i] = *(const h16x8*)(ksrc[i] + (size_t)sp * 256 * 512); RVN[i] = *(const h16x8*)(vsrc[i] + sp * 256); } } \
    { const int sm = (s) + 1 < NS ? (s) + 1 : NS - 1; MN0 = *(const u32x4*)(mrow + 8 * sm); MN1 = *(const u32x4*)(mrow + 8 * sm + 4); } \
    { LDS unsigned char* bb = lds + ((s) & 1) * ABUF; \
      ATT_TILE(s, 0, MC0[2], MC0[3]) ATT_TILE(s, 1, MC1[0], MC1[1]) ATT_TILE(s, 2, MC1[2], MC1[3]) ATT_TILE(s, 3, MN0[0], MN0[1]) } \
    { LDS unsigned char* nb = lds + (((s) + 1) & 1) * ABUF; _Pragma("unroll") for (int i = 0; i < 4; ++i) { *(LDS h16x8*)(nb + kdst[i]) = RKC[i]; *(LDS h16x8*)(nb + vdst[i]) = RVC[i]; } } \
    __syncthreads(); }
  for (int s = 0; s < NS; s += 2) {
    ATT_STEP(s, rkA, rvA, rkB, rvB, mA0, mA1, mB0, mB1)
    if (s + 1 < NS) ATT_STEP(s + 1, rkB, rvB, rkA, rvA, mB0, mB1, mA0, mA1)
  }
#undef ATT_STEP
#undef ATT_TILE
  const float inv = 1.f / (l + __shfl_xor(l, 32));
  h16* Y = (h16*)(p.ws + WS_H) + tok * DM + head * 64;
#pragma unroll
  for (int di = 0; di < 2; ++di)
#pragma unroll
    for (int q = 0; q < 4; ++q)
      *(h16x4*)(Y + 32 * di + 8 * q + 4 * half) = pack4(o[di][4 * q] * inv, o[di][4 * q + 1] * inv, o[di][4 * q + 2] * inv, o[di][4 * q + 3] * inv);
}

DEVI void phase4(PRef p, LDS unsigned char* lds) {
  const int G = gridDim.x;
  for (int it = blockIdx.x; it < 512; it += G) rnn_item<1>(p, lds, it >> 7, it & 127);
  for (int it = blockIdx.x; it < 512; it += G) {
    const int bh = it >> 4, j = it & 15;
#pragma unroll 1
    for (int w2 = 0; w2 < 2; ++w2) attn_unit(p, lds, bh >> 3, bh & 7, w2 ? j : 31 - j);
  }
}

struct EpiPlain {
  h16* dst; int ld;
  DEVI void operator()(const f32x4 (&acc)[2][2][4][2], const g8::Unit& u, int wr, int wc, int fr, int fq) const {
#pragma unroll
    for (int ai = 0; ai < 2; ++ai)
#pragma unroll
      for (int m = 0; m < 4; ++m) {
        const int r = u.pm * 256 + 128 * ai + 64 * wr + 16 * m + fr;
        if (r < u.cnt) {
          h16* d = dst + (size_t)(u.off + r) * ld + u.pn * 256 + 32 * wc + 8 * fq;
#pragma unroll
          for (int bj = 0; bj < 2; ++bj)
            { const f32x4 v0 = acc[ai][bj][m][0], v1 = acc[ai][bj][m][1]; h16x8 w; w[0] = (h16)v0[0]; w[1] = (h16)v0[1]; w[2] = (h16)v0[2]; w[3] = (h16)v0[3]; w[4] = (h16)v1[0]; w[5] = (h16)v1[1]; w[6] = (h16)v1[2]; w[7] = (h16)v1[3]; *(h16x8*)(d + 128 * bj) = w; }
        }
      }
  }
};
DEVI void phase5(PRef p, LDS unsigned char* lds) {
  g8::DenseOrder S{(const h16*)(p.ws + WS_H), (const h16*)(p.ws + WS_WOUT), DM, 128, 4, (int)gridDim.x, (int)blockIdx.x};
  EpiPlain E{(h16*)(p.ws + WS_MIX), DM};
  g8::gemm_phase(lds, DM, S, E);
}

constexpr int P6_TROW = 2064, P6_THI = 0, P6_TLO = 32 * P6_TROW, P6_PART = 0, P6_LGT = 8 * 48 * 32 * 4, P6_MOD = 2 * 32 * P6_TROW;
constexpr int P6_BIAS = P6_MOD + 3 * 4096, P6_TOK = P6_BIAS + 160, P6_LCNT = P6_TOK + 128 * 6 * 4, P6_LBASE = P6_LCNT + 128;
static_assert(P6_LBASE + 128 <= LDS_BYTES - 16 && P6_LGT + 32 * 36 * 4 <= P6_MOD, "phase 6 LDS map");
DEVI void phase6(PRef p, LDS unsigned char* lds) {
  const int tid = launder((int)threadIdx.x), lane = tid & 63, wave = wave_id(tid), l15 = lane & 15, g4 = lane >> 4;
  const int b = blockIdx.x >> 6;
  LDS float* mv = (LDS float*)(lds + P6_MOD);
  LDS float* rbias = (LDS float*)(lds + P6_BIAS);
  LDS unsigned* tokrec = (LDS unsigned*)(lds + P6_TOK);
  LDS unsigned* lcnt = (LDS unsigned*)(lds + P6_LCNT);
  LDS unsigned* lbase = (LDS unsigned*)(lds + P6_LBASE);
  mod_to_lds(p, b, 2, mv); mod_to_lds(p, b, 3, mv + 1024); mod_to_lds(p, b, 4, mv + 2048);
  if (tid < 4) rbias[tid] = p.in[18][tid];
  else if (tid < 36) rbias[tid] = p.in[20][tid - 4];
  if (tid < 32) lcnt[tid] = 0u;
  __syncthreads();
  for (int k = tid; k < 1024; k += NTHR) { mv[k] *= p.in[5][k]; mv[2048 + k] = p.in[6][k] * (mv[2048 + k] + 1.f); }
  __syncthreads();
  const float* x = p.in[0]; const h16* MIX = (const h16*)(p.ws + WS_MIX); h16* X1h = (h16*)(p.ws + WS_MIX); h16* H2 = (h16*)(p.ws + WS_H);
  const h16* WRH = (const h16*)(p.ws + WS_WRH); const h16* WRL = (const h16*)(p.ws + WS_WRL);
  const size_t tok0 = (size_t)blockIdx.x * 128;
  h16x8 bh[3][4], bl[3][4];
#pragma unroll
  for (int ct = 0; ct < 3; ++ct)
#pragma unroll
    for (int kk = 0; kk < 4; ++kk) {
      const int kof = 32 * (4 * wave + kk) + 8 * g4;
      bh[ct][kk] = *(const h16x8*)(WRH + (size_t)(16 * ct + l15) * 1024 + kof); bl[ct][kk] = *(const h16x8*)(WRL + (size_t)(16 * ct + l15) * 1024 + kof);
    }
  f32x4 xa[4]; h16x4 ma[4];
#pragma unroll
  for (int j = 0; j < 4; ++j) { xa[j] = *(const f32x4*)(x + (tok0 + 4 * wave) * DM + 256 * j + 4 * lane); ma[j] = *(const h16x4*)(MIX + (tok0 + 4 * wave) * DM + 256 * j + 4 * lane); }
#pragma unroll 1
  for (int rd = 0; rd < 4; ++rd) {
    {
      const size_t tokb = tok0 + 32 * rd + 4 * wave;
#define P6_LOAD(XV, MH, T) do { _Pragma("unroll") for (int j = 0; j < 4; ++j) { XV[j] = *(const f32x4*)(x + (T) * DM + 256 * j + 4 * lane); MH[j] = *(const h16x4*)(MIX + (T) * DM + 256 * j + 4 * lane); } } while (0)
#define P6_ROW(XV, MH, I) do { \
        const int tr = 4 * wave + (I); const size_t tok = tokb + (I); \
        f32x4 mx[4]; float ssm = 0.f; \
        _Pragma("unroll") for (int j = 0; j < 4; ++j) _Pragma("unroll") for (int e = 0; e < 4; ++e) { mx[j][e] = (float)MH[j][e]; ssm += mx[j][e] * mx[j][e]; } \
        const float rsm = 1.0f / sqrtf(wave_sum(ssm) * (1.f / 1024.f) + 1e-6f); \
        float ss1 = 0.f; \
        _Pragma("unroll") for (int j = 0; j < 4; ++j) { \
          const f32x4 v = XV[j] + *(LDS f32x4*)(mv + 256 * j + 4 * lane) * (mx[j] * rsm); \
          XV[j] = v; \
          *(h16x4*)(X1h + tok * DM + 256 * j + 4 * lane) = pack4(v[0], v[1], v[2], v[3]); \
          ss1 += v[0] * v[0] + v[1] * v[1] + v[2] * v[2] + v[3] * v[3]; \
        } \
        const float rs1 = 1.0f / sqrtf(wave_sum(ss1) * (1.f / 1024.f) + 1e-6f); \
        _Pragma("unroll") for (int j = 0; j < 4; ++j) { \
          const f32x4 h2 = XV[j] * rs1 * *(LDS f32x4*)(mv + 2048 + 256 * j + 4 * lane) + *(LDS f32x4*)(mv + 1024 + 256 * j + 4 * lane); \
          const h16x4 hi = pack4(h2[0], h2[1], h2[2], h2[3]); \
          const h16x4 lo = pack4(h2[0] - (float)hi[0], h2[1] - (float)hi[1], h2[2] - (float)hi[2], h2[3] - (float)hi[3]); \
          *(h16x4*)(H2 + tok * DM + 256 * j + 4 * lane) = hi; \
          *(LDS h16x4*)(lds + P6_THI + tr * P6_TROW + (256 * j + 4 * lane) * 2) = hi; \
          *(LDS h16x4*)(lds + P6_TLO + tr * P6_TROW + (256 * j + 4 * lane) * 2) = lo; \
        } } while (0)
      f32x4 xb[4]; h16x4 mb[4];
      P6_LOAD(xb, mb, tokb + 1); __builtin_amdgcn_sched_barrier(0); P6_ROW(xa, ma, 0);
      P6_LOAD(xa, ma, tokb + 2); __builtin_amdgcn_sched_barrier(0); P6_ROW(xb, mb, 1);
      P6_LOAD(xb, mb, tokb + 3); __builtin_amdgcn_sched_barrier(0); P6_ROW(xa, ma, 2);
      { const size_t tn = rd < 3 ? tokb + 32 : tokb; P6_LOAD(xa, ma, tn); } __builtin_amdgcn_sched_barrier(0); P6_ROW(xb, mb, 3);
    }
    __syncthreads();
    f32x4 acc[2][3];
#pragma unroll
    for (int tt = 0; tt < 2; ++tt)
#pragma unroll
      for (int ct = 0; ct < 3; ++ct) acc[tt][ct] = (f32x4){0.f, 0.f, 0.f, 0.f};
#pragma unroll
    for (int kk = 0; kk < 4; ++kk) {
      const int kof = 32 * (4 * wave + kk) + 8 * g4;
      h16x8 ah[2], al[2];
#pragma unroll
      for (int tt = 0; tt < 2; ++tt) {
        ah[tt] = *(LDS h16x8*)(lds + P6_THI + (16 * tt + l15) * P6_TROW + kof * 2);
        al[tt] = *(LDS h16x8*)(lds + P6_TLO + (16 * tt + l15) * P6_TROW + kof * 2);
      }
#pragma unroll
      for (int ct = 0; ct < 3; ++ct) {
#pragma unroll
        for (int tt = 0; tt < 2; ++tt) {
          acc[tt][ct] = mfma16s(ah[tt], bh[ct][kk], acc[tt][ct]);
          acc[tt][ct] = mfma16s(ah[tt], bl[ct][kk], acc[tt][ct]);
          acc[tt][ct] = mfma16s(al[tt], bh[ct][kk], acc[tt][ct]);
        }
      }
    }
    __syncthreads();
#pragma unroll
    for (int tt = 0; tt < 2; ++tt)
#pragma unroll
      for (int ct = 0; ct < 3; ++ct)
        *(LDS f32x4*)(lds + P6_PART + (((wave * 48 + 16 * ct + l15) * 32) + 16 * tt + 4 * g4) * 4) = acc[tt][ct];
    __syncthreads();
    for (int idx = tid; idx < 36 * 32; idx += NTHR) {
      const int col = idx >> 5, tk = idx & 31;
      float s = 0.f;
#pragma unroll
      for (int w = 0; w < 8; ++w) s += *(LDS float*)(lds + P6_PART + ((w * 48 + col) * 32 + tk) * 4);
      *(LDS float*)(lds + P6_LGT + (tk * 36 + col) * 4) = s;
    }
    __syncthreads();
    if (tid < 32) {
      LDS float* lg = (LDS float*)(lds + P6_LGT) + 36 * tid;
      float gl[4];
#pragma unroll
      for (int g = 0; g < 4; ++g) gl[g] = lg[g] + rbias[g];
      int gi = 0; float gm = gl[0];
#pragma unroll
      for (int g = 1; g < 4; ++g) if (gl[g] > gm) { gm = gl[g]; gi = g; }
      float gs = 0.f;
#pragma unroll
      for (int g = 0; g < 4; ++g) gs += __expf(gl[g] - gm);
      const float pg = 1.f / gs;
      int e1 = 0, e2 = 0; float l1 = -INFINITY, l2 = -INFINITY;
#pragma unroll
      for (int e = 0; e < 8; ++e) {
        const float v = lg[4 + 8 * gi + e] + rbias[4 + 8 * gi + e];
        if (v > l1) { l2 = l1; e2 = e1; l1 = v; e1 = e; }
        else if (v > l2) { l2 = v; e2 = e; }
      }
      const float x2 = __expf(l2 - l1);
      const float w1 = pg / (1.f + x2), w2 = pg * x2 / (1.f + x2);
      const unsigned E1 = (unsigned)(gi * 8 + e1), E2 = (unsigned)(gi * 8 + e2);
      const unsigned lp1 = __hip_atomic_fetch_add(&lcnt[E1], 1u, __ATOMIC_RELAXED, __HIP_MEMORY_SCOPE_WORKGROUP);
      const unsigned lp2 = __hip_atomic_fetch_add(&lcnt[E2], 1u, __ATOMIC_RELAXED, __HIP_MEMORY_SCOPE_WORKGROUP);
      LDS unsigned* tr = tokrec + (32 * rd + tid) * 6;
      tr[0] = E1; tr[1] = lp1; tr[2] = E2; tr[3] = lp2; tr[4] = __float_as_uint(w1); tr[5] = __float_as_uint(w2);
    }
    __syncthreads();
  }
  if (tid < 32) lbase[tid] = atomicAdd((unsigned*)(p.ws + WS_CNT) + tid, lcnt[tid]);
  __syncthreads();
  if (tid < 128) {
    unsigned* LIST = (unsigned*)(p.ws + WS_LIST); float* LISTW = (float*)(p.ws + WS_LISTW); u32x4* ROUTE = (u32x4*)(p.ws + WS_ROUTE);
    const unsigned tok = (unsigned)(tok0 + tid);
    LDS unsigned* tr = tokrec + tid * 6;
    const unsigned E1 = tr[0], E2 = tr[2], p1 = lbase[E1] + tr[1], p2 = lbase[E2] + tr[3];
    LIST[(size_t)E1 * 32768 + p1] = tok; LISTW[(size_t)E1 * 32768 + p1] = __uint_as_float(tr[4]);
    LIST[(size_t)E2 * 32768 + p2] = tok; LISTW[(size_t)E2 * 32768 + p2] = __uint_as_float(tr[5]);
    u32x4 rt; rt[0] = E1; rt[1] = p1; rt[2] = E2; rt[3] = p2;
    ROUTE[tok] = rt;
  }
}

template <bool GATHER_> struct MoeOrder {
  static constexpr bool GATHER = GATHER_;
  unsigned char* ws; int ntn, K, G, c;
  int pre, cnl, offx;
  DEVI void init() {
    const int lane = threadIdx.x & 63;
    const int cn0 = lane < 32 ? (int)((const unsigned*)(ws + WS_CNT))[lane] : 0;
    int pt = ((cn0 + 255) >> 8) * ntn, po = cn0;
#pragma unroll
    for (int d = 1; d < 32; d <<= 1) { const int a = __shfl_up(pt, d), b = __shfl_up(po, d); if (lane >= d) { pt += a; po += b; } }
    pre = lane < 32 ? pt : 0x7fffffff; cnl = cn0; offx = po - cn0;
  }
  DEVI bool next(int i, g8::Unit& u) const {
    const int itg = i * G + c;
    const int e = __builtin_popcountll(__builtin_amdgcn_ballot_w64(pre <= itg));
    if (e >= 32) return false;
    const int cn = __builtin_amdgcn_readlane(cnl, e), off = __builtin_amdgcn_readlane(offx, e);
    const int it = itg - (__builtin_amdgcn_readlane(pre, e) - ((cn + 255) >> 8) * ntn);
    u.e = e; u.pm = it / ntn; u.pn = it % ntn; u.cnt = cn; u.off = off;
    const int tid = threadIdx.x;
    if (GATHER_) {
      const unsigned* list = (const unsigned*)(ws + WS_LIST) + (size_t)e * 32768;
      u.A = (const char*)(ws + WS_H);
      u.B = (const char*)((const h16*)(ws + WS_WGU) + ((size_t)e * 512 + u.pn * 256) * DM);
#pragma unroll
      for (int h = 0; h < 2; ++h)
#pragma unroll
        for (int i2 = 0; i2 < 2; ++i2) {
          int R, C; g8::stage_rc(tid * 16 + i2 * 8192, R, C);
          const int row = u.pm * 256 + 128 * h + R;
          const unsigned t = list[row < cn ? row : cn - 1];
          u.va[h][i2] = (t * (unsigned)DM + (unsigned)C) * 2u;
        }
    } else {
      u.A = (const char*)((const h16*)(ws + WS_ACT) + ((size_t)off + u.pm * 256) * 256);
      u.B = (const char*)((const h16*)(ws + WS_WDN) + ((size_t)e * 1024 + u.pn * 256) * 256);
      u.va[0][0] = u.va[0][1] = u.va[1][0] = u.va[1][1] = 0u;
    }
    return true;
  }
};
struct EpiAct {
  unsigned char* ws;
  DEVI void operator()(const f32x4 (&acc)[2][2][4][2], const g8::Unit& u, int wr, int wc, int fr, int fq) const {
    const float* lw = (const float*)(ws + WS_LISTW) + (size_t)u.e * 32768; h16* act = (h16*)(ws + WS_ACT);
    const int r0 = u.pm * 256 + 64 * wr + fr;
    float w8[2][4];
#pragma unroll
    for (int ai = 0; ai < 2; ++ai)
#pragma unroll
      for (int m = 0; m < 4; ++m) { const int r = r0 + 128 * ai + 16 * m; w8[ai][m] = lw[r < u.cnt ? r : u.cnt - 1]; }
    __builtin_amdgcn_sched_barrier(0);
#pragma unroll
    for (int ai = 0; ai < 2; ++ai)
#pragma unroll
      for (int m = 0; m < 4; ++m) asm volatile("" : "+v"(w8[ai][m]));
#pragma unroll
    for (int ai = 0; ai < 2; ++ai)
#pragma unroll
      for (int m = 0; m < 4; ++m) {
        const int r = r0 + 128 * ai + 16 * m;
        if (r < u.cnt) {
          const float w = w8[ai][m];
#pragma unroll
          for (int bj = 0; bj < 2; ++bj) {
            const f32x4 g = acc[ai][bj][m][0], up = acc[ai][bj][m][1];
            float v[4];
#pragma unroll
            for (int e = 0; e < 4; ++e) v[e] = g[e] * __builtin_amdgcn_rcpf(1.f + __expf(-g[e])) * up[e] * w;
            *(h16x4*)(act + (size_t)(u.off + r) * 256 + 16 * (8 * u.pn + 4 * bj + wc) + 4 * fq) = pack4(v[0], v[1], v[2], v[3]);
          }
        }
      }
  }
};
struct EpiYp {
  h16* dst;
  DEVI void operator()(const f32x4 (&acc)[2][2][4][2], const g8::Unit& u, int wr, int wc, int fr, int fq) const {
#pragma unroll
    for (int ai = 0; ai < 2; ++ai)
#pragma unroll
      for (int m = 0; m < 4; ++m) {
        const int r = u.pm * 256 + 128 * ai + 64 * wr + 16 * m + fr;
        if (r < u.cnt) {
          h16* d = dst + (size_t)(u.off + r) * DM + u.pn * 256 + 32 * wc + 8 * fq;
#pragma unroll
          for (int bj = 0; bj < 2; ++bj)
            { const f32x4 v0 = acc[ai][bj][m][0], v1 = acc[ai][bj][m][1]; h16x8 w; w[0] = (h16)v0[0]; w[1] = (h16)v0[1]; w[2] = (h16)v0[2]; w[3] = (h16)v0[3]; w[4] = (h16)v1[0]; w[5] = (h16)v1[1]; w[6] = (h16)v1[2]; w[7] = (h16)v1[3]; *(h16x8*)(d + 128 * bj) = w; }
        }
      }
  }
};
DEVI void phase7(PRef p, LDS unsigned char* lds) {
  MoeOrder<true> S{p.ws, 2, DM, (int)gridDim.x, (int)blockIdx.x, 0, 0, 0};
  S.init();
  EpiAct E{p.ws};
  g8::gemm_phase(lds, DM, S, E);
}
DEVI void phase8(PRef p, LDS unsigned char* lds) {
  MoeOrder<false> S{p.ws, 4, 256, (int)gridDim.x, (int)blockIdx.x, 0, 0, 0};
  S.init();
  EpiYp E{(h16*)(p.ws + WS_YP)};
  g8::gemm_phase(lds, 256, S, E);
}

DEVI void phase9(PRef p, LDS unsigned char* lds) {
  const int tid = launder((int)threadIdx.x), lane = tid & 63, wave = wave_id(tid), G = gridDim.x;
  const int b = blockIdx.x & 3, bi = blockIdx.x >> 2, nbk = G >> 2;
  LDS unsigned* offs = (LDS unsigned*)lds;
  if (tid == 0) { const unsigned* cnt = (const unsigned*)(p.ws + WS_CNT); unsigned o = 0; for (int e = 0; e < 32; ++e) { offs[e] = o; o += cnt[e]; } }
  __syncthreads();
  LDS float* mv = (LDS float*)(lds + 256);
  mod_to_lds(p, b, 5, mv);
  __syncthreads();
  f32x4 A3[4];
#pragma unroll
  for (int j = 0; j < 4; ++j) { const int k = 256 * j + 4 * lane; A3[j] = *(LDS f32x4*)(mv + k) * *(const f32x4*)(p.in[7] + k); }
  const h16* YP = (const h16*)(p.ws + WS_YP); const u32x4* ROUTE = (const u32x4*)(p.ws + WS_ROUTE); float* out = p.out; const h16* X1h = (const h16*)(p.ws + WS_MIX);
  const int rstep = nbk * 8, r_first = bi * 8 + wave;
  const int nrow = (SEQ - r_first + rstep - 1) / rstep;
  unsigned R0 = 0u, R1 = 0u;
  if (lane < nrow) { const u32x4 rt = ROUTE[(size_t)b * SEQ + r_first + rstep * lane]; R0 = offs[rt[0]] + rt[1]; R1 = offs[rt[2]] + rt[3]; }
  h16x4 ya[4], yc[4]; f32x4 xv[4];
  {
    const size_t tok = (size_t)b * SEQ + r_first; const size_t r0 = __builtin_amdgcn_readlane(R0, 0), r1 = __builtin_amdgcn_readlane(R1, 0);
#pragma unroll
    for (int j = 0; j < 4; ++j) { ya[j] = *(const h16x4*)(YP + r0 * DM + 256 * j + 4 * lane); yc[j] = *(const h16x4*)(YP + r1 * DM + 256 * j + 4 * lane); { const h16x4 xh = *(const h16x4*)(X1h + tok * DM + 256 * j + 4 * lane); xv[j] = (f32x4){(float)xh[0], (float)xh[1], (float)xh[2], (float)xh[3]}; } }
  }
  for (int i = 0; i < nrow; ++i) {
    const size_t tok = (size_t)b * SEQ + r_first + rstep * i;
    h16x4 na[4], nc[4]; f32x4 nx[4];
    if (i + 1 < nrow) {
      const size_t r0 = __builtin_amdgcn_readlane(R0, i + 1), r1 = __builtin_amdgcn_readlane(R1, i + 1);
#pragma unroll
      for (int j = 0; j < 4; ++j) { na[j] = *(const h16x4*)(YP + r0 * DM + 256 * j + 4 * lane); nc[j] = *(const h16x4*)(YP + r1 * DM + 256 * j + 4 * lane); { const h16x4 xh = *(const h16x4*)(X1h + (tok + rstep) * DM + 256 * j + 4 * lane); nx[j] = (f32x4){(float)xh[0], (float)xh[1], (float)xh[2], (float)xh[3]}; } }
    }
    f32x4 y[4]; float ss = 0.f;
#pragma unroll
    for (int j = 0; j < 4; ++j)
#pragma unroll
      for (int e = 0; e < 4; ++e) { y[j][e] = (float)ya[j][e] + (float)yc[j][e]; ss += y[j][e] * y[j][e]; }
    const float rs = 1.0f / sqrtf(wave_sum(ss) * (1.f / 1024.f) + 1e-6f);
#pragma unroll
    for (int j = 0; j < 4; ++j) *(f32x4*)(out + tok * DM + 256 * j + 4 * lane) = xv[j] + A3[j] * (y[j] * rs);
    if (i + 1 < nrow) {
#pragma unroll
      for (int j = 0; j < 4; ++j) { ya[j] = na[j]; yc[j] = nc[j]; xv[j] = nx[j]; }
    }
  }
}

#define XB_TMO      128
#define XB_XCNT(j)  (256  + 64 * (j))
#define XB_XSUB(j)  (1280 + 64 * (j))
#define XB_XGEN(j)  (2304 + 64 * (j))
#define XB_TOP      3328
#define XB_TOPGEN   3392
#define XB_SPIN_CAP (1u << 22)
DEVI unsigned xb_ld(unsigned* p)              { return __hip_atomic_load(p, __ATOMIC_RELAXED, __HIP_MEMORY_SCOPE_AGENT); }
DEVI unsigned xb_add(unsigned* p, unsigned v) { return __hip_atomic_fetch_add(p, v, __ATOMIC_RELAXED, __HIP_MEMORY_SCOPE_AGENT); }
DEVI unsigned xb_xcc_id() { return (unsigned)__builtin_amdgcn_s_getreg((3 << 11) | 20) & 0xFu; }
#define XB_SPIN(cond, bar) do { unsigned _sp = 0; while (cond) { __builtin_amdgcn_s_sleep(1); \
    if ((++_sp & 255u) == 0u) { if (xb_ld(&(bar)[XB_TMO])) break; if (_sp > XB_SPIN_CAP) { atomicAdd(&(bar)[XB_TMO], 1u); break; } } } } while (0)
struct XcdBarrier { unsigned* bar; unsigned x; volatile LDS unsigned* st; };
DEVI XcdBarrier xcd_barrier_post(unsigned* bar, volatile LDS unsigned* st) {
  XcdBarrier b; b.bar = bar; b.x = xb_xcc_id(); b.st = st;
  if (threadIdx.x == 0) (void)xb_add(&bar[XB_XCNT(b.x)], 1u);
  return b;
}
DEVI void xcd_barrier_complete(unsigned* bar, unsigned x, unsigned& nloc, unsigned& nx) {
  const unsigned G = gridDim.x * gridDim.y * gridDim.z;
  unsigned sum, cnt, mine, sp = 0u;
  for (;;) {
    sum = 0u; cnt = 0u; mine = 0u;
#pragma unroll
    for (unsigned j = 0; j < 16; ++j) { const unsigned c = xb_ld(&bar[XB_XCNT(j)]); sum += c; cnt += (c > 0u) ? 1u : 0u; mine = (j == x) ? c : mine; }
    if (sum == G) break;
    __builtin_amdgcn_s_sleep(1);
    if ((++sp & 255u) == 0u) { if (xb_ld(&bar[XB_TMO])) break; if (sp > XB_SPIN_CAP) { atomicAdd(&bar[XB_TMO], 1u); break; } }
  }
  nloc = mine > 0u ? mine : 1u; nx = cnt > 0u ? cnt : 1u;
}
DEVI void xcd_barrier(const XcdBarrier& b) {
  asm volatile("s_waitcnt vmcnt(0)" ::: "memory");
  __syncthreads();
  if (threadIdx.x == 0) {
    unsigned* bar = b.bar;
    __builtin_amdgcn_s_waitcnt(0);
    unsigned nloc = b.st[0], nx = b.st[1];
    if (nloc == 0u) { xcd_barrier_complete(bar, b.x, nloc, nx); b.st[0] = nloc; b.st[1] = nx; }
    const unsigned old = xb_add(&bar[XB_XSUB(b.x)], 1u);
    const unsigned gen = old / nloc;
    if (old + 1u == (gen + 1u) * nloc) {
      __builtin_amdgcn_fence(__ATOMIC_RELEASE, "agent");
      asm volatile("s_waitcnt vmcnt(0)" ::: "memory");
      const unsigned og = xb_add(&bar[XB_TOP], 1u);
      const unsigned tg = og / nx;
      if (og + 1u == (tg + 1u) * nx) xb_add(&bar[XB_TOPGEN], 1u);
      else XB_SPIN(xb_ld(&bar[XB_TOPGEN]) == tg, bar);
      __builtin_amdgcn_fence(__ATOMIC_ACQUIRE, "agent");
      xb_add(&bar[XB_XGEN(b.x)], 1u);
      asm volatile("s_waitcnt vmcnt(0)" ::: "memory");
    } else {
      XB_SPIN(xb_ld(&bar[XB_XGEN(b.x)]) == gen, bar);
      __builtin_amdgcn_fence(__ATOMIC_ACQUIRE, "agent");
      asm volatile("s_waitcnt vmcnt(0)" ::: "memory");
    }
  }
  __syncthreads();
}

__global__ void __launch_bounds__(NTHR) fwd_kernel(Params p) {
  extern __shared__ __attribute__((aligned(16))) unsigned char smem[];
  LDS unsigned char* lds = (LDS unsigned char*)smem;
  const int lo = p.ph_lo, hi = p.ph_hi;
  volatile LDS unsigned* bst = (volatile LDS unsigned*)(lds + LDS_BYTES - 16);
  if (threadIdx.x < 4) bst[threadIdx.x] = 0u;
  __syncthreads();
  (void)xcd_barrier_post((unsigned*)(p.ws + WS_BAR), bst);
#ifndef REPEAT_PHASE
#define REPEAT_PHASE -1
#endif
#define GRID_SYNC(k) do { { XcdBarrier xb_; xb_.bar = (unsigned*)(get_params()->ws + WS_BAR); xb_.x = xb_xcc_id(); xb_.st = (volatile LDS unsigned*)(lds + LDS_BYTES - 16); xcd_barrier(xb_); } } while (0)
#define RUN_PHASE(k, fn) if (lo <= (k) && (k) < hi) { fn(*get_params(), lds); if ((k) == REPEAT_PHASE) { GRID_SYNC(k); fn(*get_params(), lds); } if ((k) + 1 < hi) GRID_SYNC(k); }
  RUN_PHASE(0, phase0)
  RUN_PHASE(1, phase1)
  RUN_PHASE(2, phase2)
  RUN_PHASE(3, phase3)
  RUN_PHASE(4, phase4)
  RUN_PHASE(5, phase5)
  RUN_PHASE(6, phase6)
  RUN_PHASE(7, phase7)
  RUN_PHASE(8, phase8)
  RUN_PHASE(9, phase9)
#undef GRID_SYNC
#undef RUN_PHASE
}

extern "C" void kernel_launch(void* const* d_in, const int* in_sizes, int n_in, void* d_out, int out_size, void* d_ws, size_t ws_size, hipStream_t stream) {
  static int grid = 0;
  if (grid == 0) {
    if (n_in != 24 || out_size != NTOK * DM || ws_size < WS_END) { fprintf(stderr, "kernel_launch: unexpected problem (n_in %d out %d ws %zu)\n", n_in, out_size, ws_size); grid = -1; return; }
    (void)hipFuncSetAttribute((const void*)fwd_kernel, hipFuncAttributeMaxDynamicSharedMemorySize, LDS_BYTES);
    int dev = 0, cus = 0, per_cu = 0;
    (void)hipGetDevice(&dev);
    (void)hipDeviceGetAttribute(&cus, hipDeviceAttributeMultiprocessorCount, dev);
    (void)hipOccupancyMaxActiveBlocksPerMultiprocessor(&per_cu, (const void*)fwd_kernel, NTHR, LDS_BYTES);
    if (per_cu < 1 || cus < 256) fprintf(stderr, "kernel_launch: occupancy %d blocks/CU on %d CUs\n", per_cu, cus);
    grid = 256;
  }
  if (grid < 0) return;
  (void)hipMemsetAsync((char*)d_ws + WS_CNT, 0, CTL_ZERO_BYTES, stream);
  Params p{};
  for (int i = 0; i < 24; ++i) p.in[i] = (const float*)d_in[i];
  p.out = (float*)d_out; p.ws = (unsigned char*)d_ws;
#if N_LAUNCH_MODE == 1
  p.ph_lo = 0; p.ph_hi = NPHASE;
  void* args[] = {&p};
  hipError_t e = hipLaunchCooperativeKernel((const void*)fwd_kernel, dim3(grid), dim3(NTHR), args, LDS_BYTES, stream);
  if (e != hipSuccess) fprintf(stderr, "cooperative launch failed: %s\n", hipGetErrorString(e));
#else
  for (int ph = 0; ph < NPHASE; ++ph) {
    p.ph_lo = ph; p.ph_hi = ph + 1;
    hipLaunchKernelGGL(fwd_kernel, dim3(grid), dim3(NTHR), LDS_BYTES, stream, p);
  }
#endif
}
```

```cpp
#include <hip/hip_runtime.h>
#include <cstdio>
#include <cstdint>

#ifndef N_LAUNCH_MODE
#define N_LAUNCH_MODE 1
#endif

#define DEVI __device__ __forceinline__
#define LDS __attribute__((address_space(3)))

typedef _Float16 h16;
typedef _Float16 h16x4 __attribute__((ext_vector_type(4)));
typedef _Float16 h16x8 __attribute__((ext_vector_type(8)));
typedef float f32x4 __attribute__((ext_vector_type(4)));
typedef float f32x16 __attribute__((ext_vector_type(16)));
typedef unsigned u32x2 __attribute__((ext_vector_type(2)));
typedef unsigned u32x4 __attribute__((ext_vector_type(4)));

constexpr int NBATCH = 4, SEQ = 8192, NTOK = NBATCH * SEQ, DM = 1024;
constexpr int NTHR = 512;
constexpr int NPHASE = 10;
constexpr int LDS_BYTES = 163840;

constexpr size_t MiB = 1ull << 20;
constexpr size_t WS_CNT = 0;
constexpr size_t CTL_ZERO_BYTES = 20480;
constexpr size_t WS_BAR = 4096;
constexpr size_t WS_MODP = 64 * 1024;
constexpr size_t WS_ROPE = 1 * MiB;
constexpr size_t WS_WIN = 3 * MiB;
constexpr size_t WS_WOUT = 10 * MiB;
constexpr size_t WS_WGU = 12 * MiB;
constexpr size_t WS_WDN = 44 * MiB;
constexpr size_t WS_WRG = 60 * MiB;
constexpr size_t WS_WRH = 60 * MiB + 512 * 1024;
constexpr size_t WS_WRL = 60 * MiB + 640 * 1024;
constexpr size_t WS_AGG = 61 * MiB;
constexpr size_t WS_ROUTE = 63 * MiB;
constexpr size_t WS_LIST = 64 * MiB;
constexpr size_t WS_LISTW = 68 * MiB;
constexpr size_t WS_WI = 72 * MiB;
constexpr size_t WS_KI = 73 * MiB;
constexpr size_t WS_MASK = 77 * MiB;
constexpr size_t WS_H = 109 * MiB;
constexpr size_t WS_Q = 173 * MiB;
constexpr size_t WS_K = 205 * MiB;
constexpr size_t WS_VT = 237 * MiB;
constexpr size_t WS_QI = 269 * MiB;
constexpr size_t WS_XR = 301 * MiB;
constexpr size_t WS_XG = 333 * MiB;
constexpr size_t WS_MIX = 365 * MiB;
constexpr size_t WS_ACT = 429 * MiB;
constexpr size_t WS_YP = 173 * MiB;
constexpr size_t WS_END = 510 * MiB;
constexpr size_t SC_BATCH_BYTES = 8192ull * 6176ull;
static_assert(SC_BATCH_BYTES <= 64 * MiB && WS_MIX + 3 * SC_BATCH_BYTES <= WS_END, "score slots");

struct Params { const float* in[24]; float* out; unsigned char* ws; int ph_lo, ph_hi; };
typedef const __attribute__((address_space(4))) Params& PRef;
typedef const __attribute__((address_space(4))) Params* PPtr;

__device__ const double ROPE_REV[32] = {
  1.59154943091895345608e-01, 1.19349370211248861917e-01, 8.94994016088910132600e-02, 6.71150830052272551196e-02,
  5.03292121044870352509e-02, 3.77415847174197710556e-02, 2.83021958306233986646e-02, 2.12236527647776604399e-02,
  1.59154943091895338669e-02, 1.19349370211248861917e-02, 8.94994016088910236684e-03, 6.71150830052272533849e-03,
  5.03292121044870369856e-03, 3.77415847174197719230e-03, 2.83021958306233986646e-03, 2.12236527647776621747e-03,
  1.59154943091895356017e-03, 1.19349370211248848907e-03, 8.94994016088910236684e-04, 6.71150830052272598901e-04,
  5.03292121044870326488e-04, 3.77415847174197740914e-04, 2.83021958306233954120e-04, 2.12236527647776605484e-04,
  1.59154943091895350596e-04, 1.19349370211248862459e-04, 8.94994016088910182474e-05, 6.71150830052272544691e-05,
  5.03292121044870353593e-05, 3.77415847174197768019e-05, 2.83021958306233960897e-05, 2.12236527647776591931e-05};

DEVI int launder(int x) { asm volatile("" : "+v"(x)); return x; }
DEVI PPtr get_params() { PPtr k = (PPtr)__builtin_amdgcn_kernarg_segment_ptr(); asm volatile("" : "+s"(k)); return k; }
DEVI int wave_id(int tid) { return __builtin_amdgcn_readfirstlane(tid >> 6); }
DEVI f32x16 mfma16(h16x8 a, h16x8 b, f32x16 c) { return __builtin_amdgcn_mfma_f32_32x32x16_f16(a, b, c, 0, 0, 0); }
template <int CTRL> DEVI float dpp_add(float v) { return v + __int_as_float(__builtin_amdgcn_update_dpp(0, __float_as_int(v), CTRL, 0xf, 0xf, true)); }
DEVI float wave_sum(float v) {
  v = dpp_add<0xB1>(v); v = dpp_add<0x4E>(v); v = dpp_add<0x141>(v); v = dpp_add<0x140>(v);
  { const auto sw = __builtin_amdgcn_permlane16_swap(__float_as_uint(v), __float_as_uint(v), false, false); v = __uint_as_float(sw[0]) + __uint_as_float(sw[1]); }
  { const auto sw = __builtin_amdgcn_permlane32_swap(__float_as_uint(v), __float_as_uint(v), false, false); v = __uint_as_float(sw[0]) + __uint_as_float(sw[1]); }
  return v;
}
DEVI float sigmoid_f(float x) { return __builtin_amdgcn_rcpf(1.f + __expf(-x)); }
DEVI float silu_f(float x) { return x * __builtin_amdgcn_rcpf(1.f + __expf(-x)); }
DEVI float gelu_tanh_f(float x) {
  const float u = 0.7978845608028654f * (x + 0.044715f * x * x * x);
  const float t = 1.f - 2.f * __builtin_amdgcn_rcpf(1.f + __expf(2.f * u));
  return 0.5f * x * (1.f + t);
}
DEVI unsigned fkey(float f) { unsigned u = __float_as_uint(f); return (u & 0x80000000u) ? ~u : (u | 0x80000000u); }
DEVI float fkey_inv(unsigned k) { unsigned u = (k & 0x80000000u) ? (k & 0x7fffffffu) : ~k; return __uint_as_float(u); }
DEVI int vt_perm(int pos) { return (pos & ~12) | ((pos & 4) << 1) | ((pos & 8) >> 1); }

DEVI void mod_to_lds(PRef p, int b, int chunk, LDS float* dst) {
  const float* mp = (const float*)(p.ws + WS_MODP);
  for (int k = threadIdx.x; k < 1024; k += NTHR) {
    const int j = chunk * 1024 + k;
    float v[8];
#pragma unroll
    for (int ks = 0; ks < 8; ++ks) v[ks] = mp[(size_t)(ks * 4 + b) * 6144 + j];
    float s = p.in[3][j];
#pragma unroll
    for (int ks = 0; ks < 8; ++ks) s += v[ks];
    dst[k] = s;
  }
}

constexpr int LROW = 144;

namespace g8 {
constexpr int BM = 256, BK = 64, HALF = 128, HTB = HALF * BK * 2, STAGE_BYTES = 8 * HTB;
DEVI int lds_byte(int r, int c) { const int st = (r >> 4) * 2 + (c >> 5), rr = r & 15, cc = c & 31, ob = rr * 64 + cc * 2; return st * 1024 + (ob ^ (((ob >> 9) & 1) << 5)); }
DEVI void stage_rc(int b, int& R, int& C) { const int st = b / 1024, sb = b % 1024, swz = sb ^ (((sb >> 9) & 1) << 5); R = (st >> 1) * 16 + swz / 64; C = (st & 1) * 32 + (swz % 64) / 2; }
struct Unit { const char* A; unsigned va[2][2]; const char* B; int pm, pn, e, cnt, off; };
DEVI void glds16(const char* src, LDS unsigned char* dst) { __builtin_amdgcn_global_load_lds((const unsigned*)src, (LDS unsigned*)dst, 16, 0, 0); }

DEVI void dense_va(unsigned (&va)[2][2], int K) {
  const int tid = threadIdx.x;
#pragma unroll
  for (int h = 0; h < 2; ++h)
#pragma unroll
    for (int i = 0; i < 2; ++i) { int R, C; stage_rc(tid * 16 + i * 8192, R, C); va[h][i] = (unsigned)((128 * h + R) * K + C) * 2u; }
}
template <class Sched, class Epi>
DEVI void gemm_phase(LDS unsigned char* lds, int K, const Sched& S, const Epi& E) {
  const int tid = launder((int)threadIdx.x), wid = wave_id(tid), lane = tid & 63, wr = wid >> 2, wc = wid & 3, fr = lane & 15, fq = lane >> 4;
  const int nt = launder(K) / BK;
  unsigned vb[2];
#pragma unroll
  for (int i = 0; i < 2; ++i) { int R, C; stage_rc(tid * 16 + i * 8192, R, C); vb[i] = (unsigned)(R * K + C) * 2u; }
  const size_t kstep = (size_t)(BK * 2), hstep = (size_t)HALF * K * 2;
  const unsigned ldsw = (unsigned)wid * 1024u;
  const int aoff = lds_byte(wr * 64 + fr, fq * 8), boff = lds_byte(wc * 32 + fr, fq * 8);
#define G8_SA(b, h) (((b) * 2 + (h)) * HTB)
#define G8_SB(b, h) ((4 + (b) * 2 + (h)) * HTB)
#define G8_STAGE(bufoff, gbase, v) do { glds16((gbase) + (v)[0], lds + (bufoff) + ldsw); glds16((gbase) + (v)[1], lds + (bufoff) + ldsw + 8192); } while (0)
#define G8_STAGEA(bufoff, gbase, h) do { glds16((gbase) + G8_VAC(h, 0), lds + (bufoff) + ldsw); glds16((gbase) + G8_VAC(h, 1), lds + (bufoff) + ldsw + 8192); } while (0)
#define G8_LDA(dst, b, h) do { _Pragma("unroll") for (int m = 0; m < 4; ++m) _Pragma("unroll") for (int k = 0; k < 2; ++k) dst[m][k] = *(const LDS h16x8*)(lds + G8_SA(b, h) + aoff + m * 2048 + k * 1024); } while (0)
#define G8_LDB(dst, b, h) do { _Pragma("unroll") for (int n = 0; n < 2; ++n) _Pragma("unroll") for (int k = 0; k < 2; ++k) dst[n][k] = *(const LDS h16x8*)(lds + G8_SB(b, h) + boff + n * 2048 + k * 1024); } while (0)
#define G8_MMA(ai, bj, At, Bt) do { __builtin_amdgcn_s_setprio(1); _Pragma("unroll") for (int m = 0; m < 4; ++m) _Pragma("unroll") for (int n = 0; n < 2; ++n) _Pragma("unroll") for (int k = 0; k < 2; ++k) \
        acc[ai][bj][m][n] = __builtin_amdgcn_mfma_f32_16x16x32_f16(Bt[n][k], At[m][k], acc[ai][bj][m][n], 0, 0, 0); __builtin_amdgcn_s_setprio(0); } while (0)
#define G8_WAIT_V(n) asm volatile("s_waitcnt vmcnt(" #n ")" ::: "memory")
#define G8_WAIT_L(n) asm volatile("s_waitcnt lgkmcnt(" #n ")" ::: "memory")
#define G8_BAR __builtin_amdgcn_s_barrier()
#define G8_SCHED __builtin_amdgcn_sched_barrier(0)
  Unit cur, nxt; int ui = 0;
  if (!S.next(0, cur)) return;
  unsigned vd[2][2];
  if (!Sched::GATHER) dense_va(vd, K);
#define G8_VAC(h, i) (Sched::GATHER ? cur.va[h][i] : vd[h][i])
#define G8_VAN(h, i) (Sched::GATHER ? nxt.va[h][i] : vd[h][i])
  f32x4 acc[2][2][4][2];
#pragma unroll
  for (int a = 0; a < 2; ++a)
#pragma unroll
    for (int b = 0; b < 2; ++b)
#pragma unroll
      for (int m = 0; m < 4; ++m)
#pragma unroll
        for (int n = 0; n < 2; ++n) acc[a][b][m][n] = (f32x4){0.f, 0.f, 0.f, 0.f};
  h16x8 At[4][2], B0[2][2], B1[2][2];
  const char* cA = cur.A; const char* cB = cur.B;
  G8_STAGE(G8_SB(0, 0), cB, vb); G8_STAGE(G8_SB(0, 1), cB + hstep, vb); G8_STAGEA(G8_SA(0, 0), cA, 0); G8_STAGEA(G8_SA(0, 1), cA, 1);
  if (wr == 1) G8_BAR;
  G8_WAIT_V(2); G8_BAR;
  G8_STAGE(G8_SB(1, 0), cB + kstep, vb); G8_STAGEA(G8_SA(1, 0), cA + kstep, 0); G8_STAGE(G8_SB(1, 1), cB + hstep + kstep, vb);
  G8_WAIT_V(6); G8_BAR;
  for (;;) {
    const bool has_next = S.next(ui + 1, nxt);
    if (!has_next) nxt = cur;
    const char* nA = nxt.A; const char* nB = nxt.B;
#pragma unroll 1
    for (int t = 0; t < nt; t += 2) {
      const bool last = (t == nt - 2);
      const char* a1 = cA + (size_t)(t + 1) * kstep;
      const char* a2 = last ? nA : cA + (size_t)(t + 2) * kstep; const char* b2 = last ? nB : cB + (size_t)(t + 2) * kstep;
      const char* a3 = a2 + kstep; const char* b3 = b2 + kstep;
#define G8_STAGE2(bufoff, gbase, h) do { glds16((gbase) + (last ? G8_VAN(h, 0) : G8_VAC(h, 0)), lds + (bufoff) + ldsw); glds16((gbase) + (last ? G8_VAN(h, 1) : G8_VAC(h, 1)), lds + (bufoff) + ldsw + 8192); } while (0)
      G8_LDB(B0, 0, 0); G8_LDB(B1, 0, 1); G8_SCHED; G8_LDA(At, 0, 0); G8_STAGEA(G8_SA(1, 1), a1, 1);
      G8_WAIT_V(8); G8_WAIT_L(0); G8_BAR; G8_MMA(0, 0, At, B0); G8_MMA(0, 1, At, B1); G8_BAR; G8_SCHED;
      G8_LDA(At, 0, 1); G8_STAGE(G8_SB(0, 0), b2, vb); G8_STAGE(G8_SB(0, 1), b2 + hstep, vb); G8_STAGE2(G8_SA(0, 0), a2, 0);
      G8_WAIT_V(8); G8_WAIT_L(0); G8_BAR; G8_MMA(1, 0, At, B0); G8_MMA(1, 1, At, B1); G8_BAR; G8_SCHED;
      G8_LDB(B0, 1, 0); G8_LDB(B1, 1, 1); G8_SCHED; G8_LDA(At, 1, 0); G8_STAGE2(G8_SA(0, 1), a2, 1);
      G8_WAIT_V(8); G8_WAIT_L(0); G8_BAR; G8_MMA(0, 0, At, B0); G8_MMA(0, 1, At, B1); G8_BAR; G8_SCHED;
      G8_LDA(At, 1, 1); G8_STAGE(G8_SB(1, 0), b3, vb); G8_STAGE(G8_SB(1, 1), b3 + hstep, vb); G8_STAGE2(G8_SA(1, 0), a3, 0);
      G8_WAIT_V(8); G8_WAIT_L(0); G8_BAR; G8_MMA(1, 0, At, B0); G8_MMA(1, 1, At, B1); G8_BAR; G8_SCHED;
    }
#undef G8_STAGE2
    if (wr == 0) G8_BAR;
    E(acc, cur, wr, wc, fr, fq);
    if (!has_next) break;
#pragma unroll
    for (int a = 0; a < 2; ++a)
#pragma unroll
      for (int b = 0; b < 2; ++b)
#pragma unroll
        for (int m = 0; m < 4; ++m)
#pragma unroll
          for (int n = 0; n < 2; ++n) acc[a][b][m][n] = (f32x4){0.f, 0.f, 0.f, 0.f};
    cur = nxt; cA = nA; cB = nB; ++ui;
    if (wr == 1) G8_BAR;
  }
  G8_WAIT_V(0);
  G8_BAR;
#undef G8_SA
#undef G8_STAGEA
#undef G8_VAC
#undef G8_VAN
#undef G8_SB
#undef G8_STAGE
#undef G8_LDA
#undef G8_LDB
#undef G8_MMA
#undef G8_WAIT_V
#undef G8_WAIT_L
#undef G8_BAR
#undef G8_SCHED
}
struct DenseOrder {
  static constexpr bool GATHER = false;
  const h16* A; const h16* Bt; int K, nM, nN, G, c;
  DEVI bool next(int i, Unit& u) const {
    const int nwg = nM * nN; const long L = (long)i * G + c; if (L >= nwg) return false;
    int wgid = (int)L; { const int q = nwg / 8, r = nwg % 8, xcd = wgid % 8, off = wgid / 8; wgid = (xcd < r ? xcd * (q + 1) : r * (q + 1) + (xcd - r) * q) + off; }
    const int nig = 8 * nN, gid = wgid / nig, fm = gid * 8, gsz = (nM - fm) < 8 ? (nM - fm) : 8;
    u.pm = fm + ((wgid % nig) % gsz); u.pn = (wgid % nig) / gsz; u.e = 0; u.cnt = 0x7fffffff; u.off = 0;
    u.A = (const char*)(A + (size_t)u.pm * 256 * K); u.B = (const char*)(Bt + (size_t)u.pn * 256 * K);
    u.va[0][0] = u.va[0][1] = u.va[1][0] = u.va[1][1] = 0u;
    return true;
  }
};
}


DEVI h16x4 pack4(float a, float b, float c, float d) { h16x4 v; v[0] = (h16)a; v[1] = (h16)b; v[2] = (h16)c; v[3] = (h16)d; return v; }

template <class F>
DEVI void transpose_item(const float* src, int N, int kb, int nb, h16* dst, int ldd, F drow, LDS float* scr, int lane) {
#pragma unroll 8
  for (int i = 0; i < 32; ++i) {
    const int kk = 2 * i + (lane >> 5), n = nb * 32 + (lane & 31);
    scr[kk * 33 + (lane & 31)] = (n < N) ? src[(size_t)(kb * 64 + kk) * N + n] : 0.f;
  }
  asm volatile("s_waitcnt lgkmcnt(0)" ::: "memory");
  const int c = lane & 7;
#pragma unroll
  for (int j = 0; j < 4; ++j) {
    const int nl = (lane >> 3) + 8 * j, n = nb * 32 + nl;
    h16x8 v;
#pragma unroll
    for (int e = 0; e < 8; ++e) v[e] = (h16)scr[(c * 8 + e) * 33 + nl];
    if (n < N) *(h16x8*)(dst + (size_t)drow(n) * ldd + kb * 64 + c * 8) = v;
  }
  asm volatile("s_waitcnt lgkmcnt(0)" ::: "memory");
}

DEVI void phase0(PRef p, LDS unsigned char* lds) {
  const int tid = launder((int)threadIdx.x), lane = tid & 63, wave = wave_id(tid), G = gridDim.x;
  const int gw = blockIdx.x * 8 + wave, NW = G * 8;
  {
    const float* c = p.in[1]; const float* wada = p.in[2]; float* mp = (float*)(p.ws + WS_MODP);
    for (int u = gw; u < 96 * 8; u += NW) {
      const int cgp = u % 96, ks = u / 96, j = cgp * 64 + lane;
      float a0 = 0.f, a1 = 0.f, a2 = 0.f, a3 = 0.f;
      for (int k0 = ks * 128; k0 < ks * 128 + 128; k0 += 16) {
        float w[16];
#pragma unroll
        for (int u = 0; u < 16; ++u) w[u] = wada[(size_t)(k0 + u) * 6144 + j];
#pragma unroll
        for (int u = 0; u < 16; ++u) {
          const int k = k0 + u;
          a0 = fmaf(silu_f(c[k]), w[u], a0); a1 = fmaf(silu_f(c[1024 + k]), w[u], a1);
          a2 = fmaf(silu_f(c[2048 + k]), w[u], a2); a3 = fmaf(silu_f(c[3072 + k]), w[u], a3);
        }
      }
      mp[(size_t)(ks * 4 + 0) * 6144 + j] = a0; mp[(size_t)(ks * 4 + 1) * 6144 + j] = a1;
      mp[(size_t)(ks * 4 + 2) * 6144 + j] = a2; mp[(size_t)(ks * 4 + 3) * 6144 + j] = a3;
    }
  }
  {
    LDS float* scr = (LDS float*)lds + wave * (64 * 33);
    constexpr int I_IN = 16 * 99, I_OUT = 16 * 32, I_G = 32 * 128, I_U = 32 * 128, I_D = 32 * 128, I_RG = 32;
    constexpr int NIT = I_IN + I_OUT + I_G + I_U + I_D + I_RG;
    for (int it = gw; it < NIT; it += NW) {
      int r = it;
      if (r < I_IN) {
        transpose_item(p.in[8], 3144, r / 99, r % 99, (h16*)(p.ws + WS_WIN), 1024,
                       [](int n) { const int dl = n < 2112 ? n : (n < 2120 ? 3136 + (n - 2112) : (n < 2632 ? 2112 + (n - 2120) : 2624 + (n - 2632)));
                                     const int d = dl & 63, sx = (dl >> 6) & 3;
                                     return (dl & ~255) + 128 * (d >> 5) + 32 * sx + 16 * ((d >> 2) & 1) + 4 * ((d >> 3) & 3) + (d & 3); }, scr, lane);
        continue;
      }
      r -= I_IN;
      if (r < I_OUT) { transpose_item(p.in[16], 1024, r / 32, r % 32, (h16*)(p.ws + WS_WOUT), 1024, [](int n) { return (n & ~31) + 16 * ((n >> 2) & 1) + 4 * ((n >> 3) & 3) + (n & 3); }, scr, lane); continue; }
      r -= I_OUT;
      if (r < I_G) { const int e = r >> 7, q = r & 127;
        transpose_item(p.in[21] + (size_t)e * 1024 * 256, 256, q >> 3, q & 7, (h16*)(p.ws + WS_WGU) + (size_t)e * 512 * 1024, 1024, [](int f) { return (f >> 4) * 32 + (f & 15); }, scr, lane); continue; }
      r -= I_G;
      if (r < I_U) { const int e = r >> 7, q = r & 127;
        transpose_item(p.in[22] + (size_t)e * 1024 * 256, 256, q >> 3, q & 7, (h16*)(p.ws + WS_WGU) + (size_t)e * 512 * 1024, 1024, [](int f) { return (f >> 4) * 32 + 16 + (f & 15); }, scr, lane); continue; }
      r -= I_U;
      if (r < I_D) { const int e = r >> 7, q = r & 127;
        transpose_item(p.in[23] + (size_t)e * 256 * 1024, 1024, q >> 5, q & 31, (h16*)(p.ws + WS_WDN) + (size_t)e * 1024 * 256, 256, [](int n) { return (n & ~31) + 16 * ((n >> 2) & 1) + 4 * ((n >> 3) & 3) + (n & 3); }, scr, lane); continue; }
      r -= I_D;
      if (r < 16) transpose_item(p.in[11] + (size_t)(r >> 1) * 4096, 64, 0, r & 1, (h16*)(p.ws + WS_WRG) + (size_t)(r >> 1) * 128 * 64, 64, [](int n) { return n; }, scr, lane);
      else transpose_item(p.in[13] + (size_t)((r - 16) >> 1) * 4096, 64, 0, r & 1, (h16*)(p.ws + WS_WRG) + (size_t)((r - 16) >> 1) * 128 * 64, 64, [](int n) { return 64 + n; }, scr, lane);
    }
  }
  {
    h16* wrh = (h16*)(p.ws + WS_WRH); h16* wrl = (h16*)(p.ws + WS_WRL);
    for (int i = blockIdx.x * NTHR + tid; i < 48 * 1024; i += G * NTHR) {
      const int col = i >> 10, k = i & 1023;
      const float w = (col < 4) ? p.in[17][k * 4 + col] : (col < 36 ? p.in[19][k * 32 + (col - 4)] : 0.f);
      const h16 hi = (h16)w;
      wrh[i] = hi; wrl[i] = (h16)(w - (float)hi);
    }
    float* ct = (float*)(p.ws + WS_ROPE); float* st = ct + 8192 * 32;
    for (int i = blockIdx.x * NTHR + tid; i < 8192 * 32; i += G * NTHR) {
      const int pos = i >> 5, f = i & 31;
      const double rev = (double)pos * ROPE_REV[f];
      const float fr = (float)(rev - __builtin_rint(rev));
      ct[i] = __builtin_amdgcn_cosf(fr); st[i] = __builtin_amdgcn_sinf(fr);
    }
  }
}

DEVI void phase1(PRef p, LDS unsigned char* lds) {
  const int tid = launder((int)threadIdx.x), lane = tid & 63, wave = wave_id(tid), G = gridDim.x;
  const int b = blockIdx.x & 3, bi = blockIdx.x >> 2, nbk = G >> 2;
  LDS float* mv = (LDS float*)lds;
  mod_to_lds(p, b, 0, mv); mod_to_lds(p, b, 1, mv + 1024);
  __syncthreads();
  f32x4 A[4], SH[4];
#pragma unroll
  for (int j = 0; j < 4; ++j) {
    const int k = 256 * j + 4 * lane;
    const f32x4 g = *(const f32x4*)(p.in[4] + k);
    A[j] = g * (*(LDS f32x4*)(mv + 1024 + k) + 1.f);
    SH[j] = *(LDS f32x4*)(mv + k);
  }
  const float* x = p.in[0]; h16* H = (h16*)(p.ws + WS_H);
  f32x4 vn[4];
  {
    const size_t tok = (size_t)b * SEQ + bi * 8 + wave;
#pragma unroll
    for (int j = 0; j < 4; ++j) vn[j] = *(const f32x4*)(x + tok * DM + 256 * j + 4 * lane);
  }
  for (int r = bi * 8 + wave; r < SEQ; r += nbk * 8) {
    const size_t tok = (size_t)b * SEQ + r;
    f32x4 v[4]; float ss = 0.f;
#pragma unroll
    for (int j = 0; j < 4; ++j) { v[j] = vn[j]; ss += v[j][0] * v[j][0] + v[j][1] * v[j][1] + v[j][2] * v[j][2] + v[j][3] * v[j][3]; }
    if (r + nbk * 8 < SEQ) {
#pragma unroll
      for (int j = 0; j < 4; ++j) vn[j] = *(const f32x4*)(x + (tok + nbk * 8) * DM + 256 * j + 4 * lane);
    }
    const float rstd = 1.0f / sqrtf(wave_sum(ss) * (1.f / 1024.f) + 1e-6f);
#pragma unroll
    for (int j = 0; j < 4; ++j) {
      const f32x4 y = v[j] * rstd * A[j] + SH[j];
      *(h16x4*)(H + tok * DM + 256 * j + 4 * lane) = pack4(y[0], y[1], y[2], y[3]);
    }
  }
}

DEVI h16x8 pack8(const f32x4& a, const f32x4& b) { h16x8 w; w[0] = (h16)a[0]; w[1] = (h16)a[1]; w[2] = (h16)a[2]; w[3] = (h16)a[3]; w[4] = (h16)b[0]; w[5] = (h16)b[1]; w[6] = (h16)b[2]; w[7] = (h16)b[3]; return w; }
struct EpiInProj {
  unsigned char* ws;
  DEVI void operator()(const f32x4 (&acc)[2][2][4][2], const g8::Unit& u, int wr, int wc, int fr, int fq) const {
    const float* cosT = (const float*)(ws + WS_ROPE); const float* sinT = cosT + 8192 * 32;
    const int g = 4 * u.pn + wc;
    if (g > 49) return;
    const int d0 = 8 * fq;
    const int tok0 = u.pm * 256 + 64 * wr + fr;
    if (g < 16 || (g >= 24 && g <= 32)) {
      float scl; h16* dst; int ld;
      if (g < 8) { scl = 0.125f * 1.4426950408889634f; dst = (h16*)(ws + WS_Q) + g * 64; ld = 512; }
      else if (g < 16) { scl = 1.f; dst = (h16*)(ws + WS_K) + (g - 8) * 64; ld = 512; }
      else if (g < 32) { scl = 0.125f; dst = (h16*)(ws + WS_QI) + (g - 24) * 64; ld = 512; }
      else { scl = 1.f; dst = (h16*)(ws + WS_KI); ld = 64; }
#pragma unroll
      for (int ai = 0; ai < 2; ++ai) {
        f32x4 ca[4], cb[4], sa[4], sb[4];
#pragma unroll
        for (int m = 0; m < 4; ++m) {
          const int pos = (tok0 + 128 * ai + 16 * m) & 8191;
          ca[m] = *(const f32x4*)(cosT + pos * 32 + d0); cb[m] = *(const f32x4*)(cosT + pos * 32 + d0 + 4);
          sa[m] = *(const f32x4*)(sinT + pos * 32 + d0); sb[m] = *(const f32x4*)(sinT + pos * 32 + d0 + 4);
        }
        __builtin_amdgcn_sched_barrier(0);
#pragma unroll
        for (int m = 0; m < 4; ++m) {
          const int tok = tok0 + 128 * ai + 16 * m;
          const f32x4 xa = acc[ai][0][m][0], xb = acc[ai][0][m][1], ya = acc[ai][1][m][0], yb = acc[ai][1][m][1];
          h16* o = dst + (size_t)tok * ld;
          *(h16x8*)(o + d0) = pack8((xa * ca[m] - ya * sa[m]) * scl, (xb * cb[m] - yb * sb[m]) * scl);
          *(h16x8*)(o + 32 + d0) = pack8((ya * ca[m] + xa * sa[m]) * scl, (yb * cb[m] + xb * sb[m]) * scl);
        }
      }
    } else if (g < 24) {
#pragma unroll
      for (int ai = 0; ai < 2; ++ai)
#pragma unroll
        for (int m = 0; m < 4; ++m) {
          const int tok = tok0 + 128 * ai + 16 * m;
          const int b = tok >> 13, pos = tok & 8191;
          const f32x4 xa = acc[ai][0][m][0], xb = acc[ai][0][m][1], ya = acc[ai][1][m][0], yb = acc[ai][1][m][1];
          h16* vt = (h16*)(ws + WS_VT) + (size_t)(b * 8 + (g - 16)) * 64 * 8192 + vt_perm(pos);
#pragma unroll
          for (int e = 0; e < 4; ++e) {
            vt[(size_t)(d0 + e) * 8192] = (h16)xa[e]; vt[(size_t)(d0 + 4 + e) * 8192] = (h16)xb[e];
            vt[(size_t)(32 + d0 + e) * 8192] = (h16)ya[e]; vt[(size_t)(36 + d0 + e) * 8192] = (h16)yb[e];
          }
        }
    } else if (g < 49) {
      h16* dst = (g < 41) ? (h16*)(ws + WS_XR) + (g - 33) * 64 : (h16*)(ws + WS_XG) + (g - 41) * 64;
#pragma unroll
      for (int ai = 0; ai < 2; ++ai)
#pragma unroll
        for (int m = 0; m < 4; ++m) {
          h16* o = dst + (size_t)(tok0 + 128 * ai + 16 * m) * 512;
          *(h16x8*)(o + d0) = pack8(acc[ai][0][m][0], acc[ai][0][m][1]);
          *(h16x8*)(o + 32 + d0) = pack8(acc[ai][1][m][0], acc[ai][1][m][1]);
        }
    } else if (fq == 0) {
      const float sc = 0.35355339059327373f;
#pragma unroll
      for (int ai = 0; ai < 2; ++ai)
#pragma unroll
        for (int m = 0; m < 4; ++m) {
          float* wi = (float*)(ws + WS_WI) + (size_t)(tok0 + 128 * ai + 16 * m) * 8;
          *(f32x4*)wi = acc[ai][0][m][0] * sc; *(f32x4*)(wi + 4) = acc[ai][0][m][1] * sc;
        }
    }
  }
};

DEVI void phase2(PRef p, LDS unsigned char* lds) {
  g8::DenseOrder S{(const h16*)(p.ws + WS_H), (const h16*)(p.ws + WS_WIN), DM, 128, 13, (int)gridDim.x, (int)blockIdx.x};
  EpiInProj E{p.ws};
  g8::gemm_phase(lds, DM, S, E);
}

constexpr int CROW = 1040;
constexpr int RNN_XG = 64 * CROW;
constexpr int RNN_CARRY = 2 * 64 * CROW;
template <int MODE>
DEVI void rnn_item(PRef p, LDS unsigned char* lds, int b, int cr) {
  const int tid = launder((int)threadIdx.x), lane = tid & 63, wave = wave_id(tid), l31 = lane & 31, half = lane >> 5;
  const h16* XR = (const h16*)(p.ws + WS_XR);
  {
    const int chg = tid & 63, tg = tid >> 6, pos0 = cr * 64 + 8 * tg;
    h16x8 xin[11];
#pragma unroll
    for (int i = 0; i < 11; ++i) {
      const int pos = pos0 + i - 3;
      if (pos >= 0) xin[i] = *(const h16x8*)(XR + ((size_t)b * SEQ + pos) * 512 + chg * 8);
      else {
#pragma unroll
        for (int e = 0; e < 8; ++e) xin[i][e] = (h16)0.f;
      }
    }
    float cw[4][8], cb[8];
#pragma unroll
    for (int e = 0; e < 8; ++e) {
      cb[e] = p.in[10][chg * 8 + e];
#pragma unroll
      for (int j = 0; j < 4; ++j) cw[j][e] = p.in[9][j * 512 + chg * 8 + e];
    }
#pragma unroll
    for (int tt = 0; tt < 8; ++tt) {
      h16x8 o;
#pragma unroll
      for (int e = 0; e < 8; ++e) {
        float v = cb[e];
#pragma unroll
        for (int j = 0; j < 4; ++j) v = fmaf(cw[j][e], (float)xin[tt + j][e], v);
        o[e] = (h16)v;
      }
      *(LDS h16x8*)(lds + (8 * tg + tt) * CROW + chg * 16) = o;
    }
  }
  if (MODE == 1) {
    const float2* ag = (const float2*)(p.ws + WS_AGG) + (size_t)b * 128 * 512 + tid;
    float carry = 0.f; int c2 = 0;
    for (; c2 + 8 <= cr; c2 += 8) {
      float2 v[8];
#pragma unroll
      for (int u = 0; u < 8; ++u) v[u] = ag[(size_t)(c2 + u) * 512];
#pragma unroll
      for (int u = 0; u < 8; ++u) carry = fmaf(v[u].x, carry, v[u].y);
    }
    for (; c2 < cr; ++c2) { const float2 v = ag[(size_t)c2 * 512]; carry = fmaf(v.x, carry, v.y); }
    ((LDS float*)(lds + RNN_CARRY))[tid] = carry;
  }
  if (MODE == 1) {
    const h16* XG = (const h16*)(p.ws + WS_XG) + ((size_t)b * SEQ + cr * 64) * 512;
#pragma unroll
    for (int i = 0; i < 8; ++i) { const int c = tid + NTHR * i, row = c >> 6, cc = c & 63; *(LDS h16x8*)(lds + RNN_XG + row * CROW + cc * 16) = *(const h16x8*)(XG + (size_t)row * 512 + cc * 8); }
  }
  __syncthreads();
  const int n = wave;
  const h16* WRG = (const h16*)(p.ws + WS_WRG) + (size_t)n * 128 * 64;
  float* AGG = (float*)(p.ws + WS_AGG);
#pragma unroll 1
  for (int dt = 0; dt < 2; ++dt) {
    h16x8 wa[4], wx[4];
#pragma unroll
    for (int kk = 0; kk < 4; ++kk) {
      wa[kk] = *(const h16x8*)(WRG + (size_t)(32 * dt + l31) * 64 + 16 * kk + 8 * half);
      wx[kk] = *(const h16x8*)(WRG + (size_t)(64 + 32 * dt + l31) * 64 + 16 * kk + 8 * half);
    }
    f32x16 ra[2], rx[2];
#pragma unroll
    for (int ti = 0; ti < 2; ++ti) {
#pragma unroll
      for (int r = 0; r < 16; ++r) { ra[ti][r] = 0.f; rx[ti][r] = 0.f; }
#pragma unroll
      for (int kk = 0; kk < 4; ++kk) {
        const h16x8 af = *(LDS h16x8*)(lds + (32 * ti + l31) * CROW + (n * 64 + 16 * kk + 8 * half) * 2);
        ra[ti] = mfma16(af, wa[kk], ra[ti]);
        rx[ti] = mfma16(af, wx[kk], rx[ti]);
      }
    }
    const int ch = n * 64 + 32 * dt + l31;
    const float ba = p.in[12][ch], bx = p.in[14][ch], lam = p.in[15][ch];
    const float c8 = -8.f * log1pf(__expf(-lam));
#pragma unroll
    for (int ti = 0; ti < 2; ++ti)
#pragma unroll
      for (int r = 0; r < 16; ++r) {
        const int tk = 32 * ti + (r & 3) + 8 * (r >> 2) + 4 * half;
        const float cv = (float)*(LDS h16*)(lds + tk * CROW + ch * 2);
        const float rr = sigmoid_f(ra[ti][r] + ba), ii = sigmoid_f(rx[ti][r] + bx);
        const float la = c8 * rr;
        ra[ti][r] = __expf(la);
        const float x2 = 2.f * la;
        const float om = -x2 * fmaf(x2 * 0.5f, fmaf(x2 * (1.f / 3.f), fmaf(x2 * 0.25f, fmaf(x2, 0.2f, 1.f), 1.f), 1.f), 1.f);
        rx[ti][r] = __builtin_amdgcn_sqrtf(om) * (ii * cv);
      }
    float P[8], Hs[8];
#pragma unroll
    for (int sg = 0; sg < 8; ++sg) {
      const int ti = sg >> 2, q = sg & 3;
      float pp = 1.f, hh = 0.f;
#pragma unroll
      for (int i = 0; i < 4; ++i) { const float a = ra[ti][4 * q + i], bb = rx[ti][4 * q + i]; hh = fmaf(a, hh, bb); pp *= a; }
      P[sg] = pp; Hs[sg] = hh;
    }
    float carry = 0.f, prod = 1.f;
    if (MODE == 1) carry = ((LDS float*)(lds + RNN_CARRY))[ch];
    float cin[8];
#pragma unroll
    for (int sg = 0; sg < 8; ++sg)
#pragma unroll
      for (int ow = 0; ow < 2; ++ow) {
        const float tmp = fmaf(P[sg], carry, Hs[sg]);
        const float tp = P[sg] * prod;
        if (half == ow) cin[sg] = carry;
        const auto swc = __builtin_amdgcn_permlane32_swap(__float_as_uint(tmp), __float_as_uint(tmp), false, false);
        const auto swp = __builtin_amdgcn_permlane32_swap(__float_as_uint(tp), __float_as_uint(tp), false, false);
        carry = __uint_as_float(swc[ow]); prod = __uint_as_float(swp[ow]);
      }
    if (MODE == 0) {
      if (half == 0) { float* ag = AGG + ((size_t)(b * 128 + cr) * 512 + ch) * 2; ag[0] = prod; ag[1] = carry; }
    } else {
#pragma unroll
      for (int sg = 0; sg < 8; ++sg) {
        const int ti = sg >> 2, q = sg & 3;
        float hh = cin[sg];
#pragma unroll
        for (int i = 0; i < 4; ++i) {
          hh = fmaf(ra[ti][4 * q + i], hh, rx[ti][4 * q + i]);
          LDS h16* xp = (LDS h16*)(lds + RNN_XG + (32 * ti + 8 * q + 4 * half + i) * CROW + ch * 2);
          *xp = (h16)(hh * gelu_tanh_f((float)*xp));
        }
      }
    }
  }
  __syncthreads();
  if (MODE == 1) {
    h16* Y = (h16*)(p.ws + WS_H) + ((size_t)b * SEQ + cr * 64) * DM + 512;
#pragma unroll
    for (int i = 0; i < 8; ++i) { const int c = tid + NTHR * i, row = c >> 6, cc = c & 63; *(h16x8*)(Y + (size_t)row * DM + cc * 8) = *(LDS h16x8*)(lds + RNN_XG + row * CROW + cc * 16); }
    __syncthreads();
  }
}

constexpr int IDX_NB = 256, IDX_CAP = 128;
constexpr int IL_HIST = 0, IL_CS = 65536, IL_CK = IL_CS + 64 * IDX_CAP * 4, IL_KI = IL_CK + 64 * IDX_CAP * 2, IL_KISZ = 128 * LROW, IL_ST = IL_KI + 2 * IL_KISZ;
static_assert(IL_ST + 4096 <= LDS_BYTES, "indexer LDS map");

DEVI f32x4 mfma16s(h16x8 a, h16x8 b, f32x4 c) { return __builtin_amdgcn_mfma_f32_16x16x32_f16(a, b, c, 0, 0, 0); }
DEVI void idx_score(LDS unsigned char* kit, int kh, int l15, int g4, const h16x8 (&qf)[8][2], const float (&wq)[8], f32x4 (&sc)[4]) {
  h16x8 kf[4][2];
#pragma unroll
  for (int kt = 0; kt < 4; ++kt)
#pragma unroll
    for (int ks = 0; ks < 2; ++ks) kf[kt][ks] = *(LDS h16x8*)(kit + (64 * kh + 16 * kt + l15) * LROW + (4 * ks + g4) * 16);
#pragma unroll
  for (int kt = 0; kt < 4; ++kt) sc[kt] = (f32x4){0.f, 0.f, 0.f, 0.f};
  f32x4 accA[4], accB[4];
#define IDX_MM(ACC, h) _Pragma("unroll") for (int kt = 0; kt < 4; ++kt) { ACC[kt] = mfma16s(kf[kt][0], qf[h][0], (f32x4){0.f, 0.f, 0.f, 0.f}); ACC[kt] = mfma16s(kf[kt][1], qf[h][1], ACC[kt]); }
#define IDX_RS(ACC, h) _Pragma("unroll") for (int kt = 0; kt < 4; ++kt) _Pragma("unroll") for (int r = 0; r < 4; ++r) sc[kt][r] = __builtin_fmaf(wq[h], __int_as_float(max(__float_as_int(ACC[kt][r]), 0)), sc[kt][r]);
  IDX_MM(accA, 0)
  IDX_MM(accB, 1) IDX_RS(accA, 0)
  IDX_MM(accA, 2) IDX_RS(accB, 1)
  IDX_MM(accB, 3) IDX_RS(accA, 2)
  IDX_MM(accA, 4) IDX_RS(accB, 3)
  IDX_MM(accB, 5) IDX_RS(accA, 4)
  IDX_MM(accA, 6) IDX_RS(accB, 5)
  IDX_MM(accB, 7) IDX_RS(accA, 6)
  IDX_RS(accB, 7)
#undef IDX_MM
#undef IDX_RS
}

template <int MODE>
DEVI void idx_pass(LDS unsigned char* lds, const h16* KIb, int N, int stride, int qg, int kh,
                   const h16* QIrow0, const float* WIrow0, float qinv, float qoff, int bstar, h16* scbase) {
  const int tid = launder((int)threadIdx.x), lane = tid & 63, l15 = lane & 15, g4 = lane >> 4;
  const int q = 16 * qg + l15;
  h16x8 qf[8][2]; float wq[8];
  {
    const h16* QI = QIrow0 + (size_t)q * 512;
#pragma unroll
    for (int h = 0; h < 8; ++h)
#pragma unroll
      for (int ks = 0; ks < 2; ++ks) qf[h][ks] = *(const h16x8*)(QI + h * 64 + 32 * ks + 8 * g4);
    const float* WI = WIrow0 + (size_t)q * 8;
#pragma unroll
    for (int h = 0; h < 8; ++h) wq[h] = WI[h];
#pragma unroll
    for (int h = 0; h < 8; ++h) { asm volatile("" : "+v"(qf[h][0])); asm volatile("" : "+v"(qf[h][1])); asm volatile("" : "+v"(wq[h])); }
  }
  LDS unsigned* hist = (LDS unsigned*)(lds + IL_HIST);
  LDS unsigned* st = (LDS unsigned*)(lds + IL_ST);
  const int nst = (N + 127) >> 7;
  const int lr = tid >> 3, lc = tid & 7;
  h16x8 r0, r1;
  r0 = *(const h16x8*)(KIb + (size_t)lr * 64 + lc * 8); r1 = *(const h16x8*)(KIb + (size_t)(lr + 64) * 64 + lc * 8);
  *(LDS h16x8*)(lds + IL_KI + lr * LROW + lc * 16) = r0; *(LDS h16x8*)(lds + IL_KI + (lr + 64) * LROW + lc * 16) = r1;
  __syncthreads();
  float vmin = INFINITY, vmax = -INFINITY;
  int cur = 0;
  for (int s = 0; s < nst; s += stride) {
    const int nx = s + stride;
    { const int nxc = nx < nst ? nx : s;
      r0 = *(const h16x8*)(KIb + (size_t)(128 * nxc + lr) * 64 + lc * 8); r1 = *(const h16x8*)(KIb + (size_t)(128 * nxc + lr + 64) * 64 + lc * 8); }
    const bool active = 128 * s + 64 * kh < N;
    f32x4 sc[4];
    if (active) {
      idx_score(lds + IL_KI + cur * IL_KISZ, kh, l15, g4, qf, wq, sc);
#pragma unroll
      for (int kt = 0; kt < 4; ++kt) asm volatile("" : "+v"(sc[kt]));
    }
    {
      *(LDS h16x8*)(lds + IL_KI + (cur ^ 1) * IL_KISZ + lr * LROW + lc * 16) = r0;
      *(LDS h16x8*)(lds + IL_KI + (cur ^ 1) * IL_KISZ + (lr + 64) * LROW + lc * 16) = r1;
    }
    if (active) {
      if (MODE == 0) {
#pragma unroll
        for (int kt = 0; kt < 4; ++kt)
#pragma unroll
          for (int r = 0; r < 4; ++r) { vmin = fminf(vmin, sc[kt][r]); vmax = fmaxf(vmax, sc[kt][r]); }
      } else if (MODE == 1) {
        h16* scp = scbase + ((size_t)((s * 2 + kh) * 4) * 1024 + q * 16 + 4 * g4);
#pragma unroll
        for (int kt = 0; kt < 4; ++kt) {
          const h16x4 hv = pack4(sc[kt][0], sc[kt][1], sc[kt][2], sc[kt][3]);
          *(h16x4*)(scp + kt * 1024) = hv;
#pragma unroll
          for (int r = 0; r < 4; ++r) {
            const float xb = fminf(fmaxf(__builtin_fmaf((float)hv[r], qinv, qoff), 0.f), (float)(IDX_NB - 1));
            const int bin = (int)xb;
            __hip_atomic_fetch_add(&hist[bin * 64 + q], 1u, __ATOMIC_RELAXED, __HIP_MEMORY_SCOPE_WORKGROUP);
          }
        }
      }
    }
    __syncthreads();
    cur ^= 1;
  }
  if (MODE == 0) {
    __hip_atomic_fetch_min(&st[q], fkey(vmin), __ATOMIC_RELAXED, __HIP_MEMORY_SCOPE_WORKGROUP);
    __hip_atomic_fetch_max(&st[64 + q], fkey(vmax), __ATOMIC_RELAXED, __HIP_MEMORY_SCOPE_WORKGROUP);
  }
}

DEVI int idx_bin(float sv, float qinv, float qoff) { return (int)fminf(fmaxf(__builtin_fmaf(sv, qinv, qoff), 0.f), (float)(IDX_NB - 1)); }
DEVI float idx_bin_lower_bound(int target, float qinv, float qoff) {
  if (target <= 0) return -INFINITY;
  if (target > IDX_NB - 1) return INFINITY;
  unsigned lo = 0x03FFu, hi = 0xFC00u;
  auto val = [](unsigned k) { const unsigned short hbits = (unsigned short)((k & 0x8000u) ? (k & 0x7FFFu) : (~k & 0xFFFFu)); return (float)__builtin_bit_cast(h16, hbits); };
  if (idx_bin(val(hi), qinv, qoff) < target) return INFINITY;
  while (lo < hi) { const unsigned mid = (lo + hi) >> 1; if (idx_bin(val(mid), qinv, qoff) >= target) hi = mid; else lo = mid + 1; }
  return val(lo);
}
DEVI void idx_stream_step(LDS unsigned char* lds, LDS unsigned* st, const unsigned long long (&cur)[4], int s, int kh, int q, int lane, int g4, h16 thi, h16 tlo) {
  unsigned nib = 0u, cnb = 0u;
#pragma unroll
  for (int kt = 3; kt >= 0; --kt) {
    const h16x4 hv = __builtin_bit_cast(h16x4, cur[kt]);
#pragma unroll
    for (int r = 3; r >= 0; --r) {
      const unsigned long long ms = __builtin_amdgcn_ballot_w64(hv[r] >= thi);
      asm("v_addc_co_u32_e64 %0, vcc, %0, %0, %1" : "+v"(nib) : "s"(ms) : "vcc");
      const unsigned long long mc = __builtin_amdgcn_ballot_w64(hv[r] >= tlo);
      asm("v_addc_co_u32_e64 %0, vcc, %0, %0, %1" : "+v"(cnb) : "s"(mc) : "vcc");
    }
  }
  unsigned cm = cnb & ~nib;
  if (__builtin_amdgcn_ballot_w64(cm != 0u) != 0ull) {
    while (cm != 0u) {
      const int e = __builtin_ctz(cm); cm &= cm - 1u;
      const int kt = e >> 2, r = e & 3;
      const unsigned long long w = kt == 0 ? cur[0] : (kt == 1 ? cur[1] : (kt == 2 ? cur[2] : cur[3]));
      const unsigned hb = (unsigned)(w >> (16 * r)) & 0xFFFFu;
      const unsigned sk = (hb & 0x8000u) ? (~hb & 0xFFFFu) : (hb | 0x8000u);
      const unsigned key = (unsigned)(128 * s + 64 * kh + 16 * kt + 4 * g4 + r);
      const unsigned pos = __hip_atomic_fetch_add(&st[128 + q], 1u, __ATOMIC_RELAXED, __HIP_MEMORY_SCOPE_WORKGROUP);
      if (pos < (unsigned)IDX_CAP) ((LDS unsigned*)(lds + IL_CS))[q * IDX_CAP + pos] = (sk << 16) | (0xFFFFu - key);
    }
  }
  const auto sw = __builtin_amdgcn_permlane32_swap(nib, nib, false, false);
  const unsigned oth = sw[1];
  if (lane < 32) {
#pragma unroll
    for (int T = 0; T < 2; ++T) {
      const unsigned b0 = ((nib >> (8 * T)) & 15u) | (((oth >> (8 * T)) & 15u) << 4);
      const unsigned b1 = ((nib >> (8 * T + 4)) & 15u) | (((oth >> (8 * T + 4)) & 15u) << 4);
      ((LDS unsigned short*)(lds + IL_HIST))[q * 512 + (4 * s + 2 * kh + T) * 2 + (g4 & 1)] = (unsigned short)(b0 | (b1 << 8));
    }
  }
}
DEVI void idx_stream(LDS unsigned char* lds, int N, int qg, int kh, float thi_f, float tlo_f, const h16* scbase) {
  const int tid = launder((int)threadIdx.x), lane = tid & 63, l15 = lane & 15, g4 = lane >> 4;
  const int q = 16 * qg + l15;
  const h16 thi = (h16)thi_f, tlo = (h16)tlo_f;
  LDS unsigned* st = (LDS unsigned*)(lds + IL_ST);
  const int nv = (N - 64 * kh + 127) >> 7;
  const unsigned long long* scp = (const unsigned long long*)(scbase + ((size_t)(kh * 4) * 1024 + q * 16 + 4 * g4));
#define IDX_LD(dst, s_) do { const int sc_ = (s_) < nv ? (s_) : nv - 1; _Pragma("unroll") for (int kt = 0; kt < 4; ++kt) dst[kt] = __hip_atomic_load(scp + (size_t)sc_ * 2048 + kt * 256, __ATOMIC_RELAXED, __HIP_MEMORY_SCOPE_AGENT); } while (0)
  unsigned long long b0[4], b1[4], b2[4], b3[4];
  IDX_LD(b0, 0); IDX_LD(b1, 1); IDX_LD(b2, 2); IDX_LD(b3, 3);
  for (int s = 0; s < nv; s += 4) {
    idx_stream_step(lds, st, b0, s, kh, q, lane, g4, thi, tlo); IDX_LD(b0, s + 4);
    if (s + 1 < nv) idx_stream_step(lds, st, b1, s + 1, kh, q, lane, g4, thi, tlo);
    IDX_LD(b1, s + 5);
    if (s + 2 < nv) idx_stream_step(lds, st, b2, s + 2, kh, q, lane, g4, thi, tlo);
    IDX_LD(b2, s + 6);
    if (s + 3 < nv) idx_stream_step(lds, st, b3, s + 3, kh, q, lane, g4, thi, tlo);
    IDX_LD(b3, s + 7);
  }
#undef IDX_LD
}

DEVI void idx_item(PRef p, LDS unsigned char* lds, int b, int c) {
  const int tid = launder((int)threadIdx.x), lane = tid & 63, wave = wave_id(tid), l31 = lane & 31, half = lane >> 5;
  const int N = 64 * (c + 1);
  unsigned* MASK = (unsigned*)(p.ws + WS_MASK) + ((size_t)b * SEQ + 64 * c) * 256;
  if (N <= 256) {
    const int wpr = N >> 5;
    for (int i = tid; i < 64 * wpr; i += NTHR) MASK[(size_t)(i / wpr) * 256 + (i % wpr)] = 0xFFFFFFFFu;
    return;
  }
  const int qg = wave & 3, kh = wave >> 2, l15 = lane & 15, q = 16 * qg + l15;
  const h16* QIrow0 = (const h16*)(p.ws + WS_QI) + ((size_t)b * SEQ + 64 * c) * 512;
  const float* WIrow0 = (const float*)(p.ws + WS_WI) + ((size_t)b * SEQ + 64 * c) * 8;
  const h16* KIb = (const h16*)(p.ws + WS_KI) + (size_t)b * SEQ * 64;
  h16* scbase;
  {
    const int j = (c < 64) ? c : 127 - c;
    const size_t pre = 8192ull * (size_t)(128 * j - (j * (j - 1)) / 2);
    scbase = (h16*)(p.ws + (b == 0 ? WS_H : WS_MIX + (size_t)(b - 1) * SC_BATCH_BYTES) + pre);
  }
  LDS unsigned* st = (LDS unsigned*)(lds + IL_ST);
  LDS float* stf = (LDS float*)(lds + IL_ST);
  if (tid < 64) { st[tid] = 0xFFFFFFFFu; st[64 + tid] = 0u; st[128 + tid] = 0u; }
  __syncthreads();
  const int nst = (N + 127) >> 7;
  const int stride = nst >= 16 ? 8 : (nst >= 8 ? 4 : (nst >= 4 ? 2 : 1));
  idx_pass<0>(lds, KIb, N, stride, qg, kh, QIrow0, WIrow0, 0.f, 0.f, 0, scbase);
  __syncthreads();
  if (tid < 64) {
    const float lo = fkey_inv(st[tid]), hi = fkey_inv(st[64 + tid]);
    float d = hi - lo; if (!(d > 1e-20f)) d = 1.f;
    const float inv = (float)IDX_NB / (1.5f * d);
    stf[192 + tid] = inv; stf[256 + tid] = -(lo - 0.25f * d) * inv;
  }
  for (int i = tid; i < 16384; i += NTHR) ((LDS unsigned*)(lds + IL_HIST))[i] = 0u;
  __syncthreads();
  const float qinv = stf[192 + q], qoff = stf[256 + q];
  idx_pass<1>(lds, KIb, N, 1, qg, kh, QIrow0, WIrow0, qinv, qoff, 0, scbase);
  {
    LDS unsigned* hist = (LDS unsigned*)(lds + IL_HIST);
    for (int qq = wave; qq < 64; qq += 8) {
      unsigned hb[4];
#pragma unroll
      for (int j = 0; j < 4; ++j) hb[j] = hist[(4 * lane + j) * 64 + qq];
      const unsigned mine = hb[0] + hb[1] + hb[2] + hb[3];
      unsigned suf = mine;
#pragma unroll
      for (int o = 1; o < 64; o <<= 1) { const unsigned v = (unsigned)__shfl_down((int)suf, o); if (lane + o < 64) suf += v; }
      unsigned cum = suf - mine;
      if (cum < 256u && suf >= 256u) {
#pragma unroll
        for (int j = 3; j >= 0; --j) {
          if (cum < 256u && cum + hb[j] >= 256u) { st[320 + qq] = (unsigned)(4 * lane + j); st[384 + qq] = 256u - cum; }
          cum += hb[j];
        }
      }
    }
  }
  __syncthreads();
  if (tid < 64) {
    const int bs = (int)st[320 + tid]; const float qi_ = stf[192 + tid], qo_ = stf[256 + tid];
    stf[448 + tid] = idx_bin_lower_bound(bs + 1, qi_, qo_);
    stf[512 + tid] = idx_bin_lower_bound(bs, qi_, qo_);
  }
  __syncthreads();
  const float thi = stf[448 + q], tlo = stf[512 + q];
  asm volatile("s_waitcnt vmcnt(0)" ::: "memory");
  idx_stream(lds, N, qg, kh, thi, tlo, scbase);
  __syncthreads();
  for (int qq = wave; qq < 64; qq += 8) {
    const int nc = min((int)st[128 + qq], IDX_CAP); const unsigned need = st[384 + qq];
    LDS unsigned* cs = (LDS unsigned*)(lds + IL_CS) + qq * IDX_CAP;
    const unsigned c1 = lane < nc ? cs[lane] : 0u, c2 = 64 + lane < nc ? cs[64 + lane] : 0u;
    unsigned r1 = 0u, r2 = 0u;
    const int n1 = nc < 64 ? nc : 64;
    for (int j = 0; j < n1; ++j) { const unsigned cj = (unsigned)__builtin_amdgcn_readlane((int)c1, j); r1 += cj > c1 ? 1u : 0u; r2 += cj > c2 ? 1u : 0u; }
    for (int j = 64; j < nc; ++j) { const unsigned cj = (unsigned)__builtin_amdgcn_readlane((int)c2, j - 64); r1 += cj > c1 ? 1u : 0u; r2 += cj > c2 ? 1u : 0u; }
#pragma unroll
    for (int h2 = 0; h2 < 2; ++h2) {
      const unsigned cv = h2 ? c2 : c1, rk = h2 ? r2 : r1;
      if (64 * h2 + lane < nc && rk < need) {
        const unsigned kv = 0xFFFFu - (cv & 0xFFFFu), kl = kv & 31u;
        const unsigned bit = 16u * ((kl >> 2) & 1u) + (kl & 3u) + 4u * (kl >> 3);
        __hip_atomic_fetch_or((LDS unsigned*)(lds + IL_HIST) + qq * 256 + (kv >> 5), 1u << bit, __ATOMIC_RELAXED, __HIP_MEMORY_SCOPE_WORKGROUP);
      }
    }
  }
  __syncthreads();
  {
    const int cpr = N >> 6;
    for (int i = tid; i < 64 * cpr; i += NTHR) {
      const int row = i / cpr, cc = i % cpr;
      *(u32x2*)(MASK + (size_t)row * 256 + 2 * cc) = *(LDS u32x2*)(lds + IL_HIST + row * 1024 + cc * 8);
    }
  }
  __syncthreads();
}

DEVI void phase3(PRef p, LDS unsigned char* lds) {
  const int G = gridDim.x;
  for (int it = blockIdx.x; it < 512; it += G) rnn_item<0>(p, lds, it >> 7, it & 127);
  for (int it = blockIdx.x; it < 256; it += G) {
    const int b = it >> 6, j = it & 63;
#pragma unroll 1
    for (int w2 = 0; w2 < 2; ++w2) idx_item(p, lds, b, w2 ? j : 127 - j);
  }
}

DEVI float max3f(float a, float b, float c) { float r; asm("v_max3_f32 %0, %1, %2, %3" : "=v"(r) : "v"(a), "v"(b), "v"(c)); return r; }
DEVI unsigned pk_rtz(float a, float b) { return __builtin_bit_cast(unsigned, __builtin_amdgcn_cvt_pkrtz(a, b)); }
DEVI void attn_seed(f32x16 (&s)[2], u32x2 mw, int half, float mref) {
  const unsigned nm0 = ~(mw[0] >> (16 * half)), nm1 = ~(mw[1] >> (16 * half));
  const unsigned negm = __float_as_uint(-mref);
#pragma unroll
  for (int r = 0; r < 16; ++r) {
    unsigned e0 = (unsigned)__builtin_amdgcn_sbfe((int)nm0, r, 1), e1 = (unsigned)__builtin_amdgcn_sbfe((int)nm1, r, 1);
    asm volatile("" : "+v"(e0), "+v"(e1));
    s[0][r] = __uint_as_float((e0 & 0xFF800000u) | (~e0 & negm));
    s[1][r] = __uint_as_float((e1 & 0xFF800000u) | (~e1 & negm));
  }
}
DEVI void attn_tile(LDS unsigned char* Kt, LDS unsigned char* Vt, const h16x8 (&qf)[4], f32x16 (&s)[2], u32x2 mwn, int l31, int half, f32x16 (&o)[2], float& mref, float& l, bool& init) {
  h16x8 kf[2][4];
#pragma unroll
  for (int ri = 0; ri < 2; ++ri)
#pragma unroll
    for (int kk = 0; kk < 4; ++kk) kf[ri][kk] = *(LDS h16x8*)(Kt + (32 * ri + l31) * LROW + (2 * kk + half) * 16);
  __builtin_amdgcn_sched_barrier(0);
#pragma unroll
  for (int kk = 0; kk < 4; ++kk)
#pragma unroll
    for (int ri = 0; ri < 2; ++ri) s[ri] = mfma16(kf[ri][kk], qf[kk], s[ri]);
  h16x8 vf[2][4];
#pragma unroll
  for (int di = 0; di < 2; ++di)
#pragma unroll
    for (int s4 = 0; s4 < 4; ++s4) vf[di][s4] = *(LDS h16x8*)(Vt + (32 * di + l31) * LROW + (2 * s4 + half) * 16);
  __builtin_amdgcn_sched_barrier(0);
  asm volatile("s_nop 15\n\ts_nop 7" : "+v"(s[0]), "+v"(s[1]));
  float mx = max3f(s[0][0], s[1][0], s[0][1]), mx2 = max3f(s[1][1], s[0][2], s[1][2]);
#pragma unroll
  for (int r = 3; r < 15; r += 2) { mx = max3f(mx, s[0][r], s[1][r]); mx2 = max3f(mx2, s[0][r + 1], s[1][r + 1]); }
  mx = max3f(mx, s[0][15], s[1][15]);
  mx = max3f(mx, mx2, mx2);
  { const auto sw = __builtin_amdgcn_permlane32_swap(__float_as_uint(mx), __float_as_uint(mx), false, false);
    mx = fmaxf(__uint_as_float(sw[0]), __uint_as_float(sw[1])); }
  const bool first = (!init) && (mx > -INFINITY);
  const bool resc = first || (mx > 8.f);
  if (__any(resc)) {
    init = init || first;
    const float delta = resc ? mx : 0.f;
    const float alpha = __builtin_amdgcn_exp2f(-delta);
#pragma unroll
    for (int r = 0; r < 16; ++r) { s[0][r] -= delta; s[1][r] -= delta; o[0][r] *= alpha; o[1][r] *= alpha; }
    l *= alpha; mref += delta;
  }
  float ls = 0.f;
#pragma unroll
  for (int r = 0; r < 16; ++r) {
    s[0][r] = __builtin_amdgcn_exp2f(s[0][r]); s[1][r] = __builtin_amdgcn_exp2f(s[1][r]);
    ls += s[0][r] + s[1][r];
  }
  l += ls;
  h16x8 pf[4];
#pragma unroll
  for (int s4 = 0; s4 < 4; ++s4) {
    u32x4 w;
#pragma unroll
    for (int e = 0; e < 4; ++e) w[e] = pk_rtz(s[s4 >> 1][8 * (s4 & 1) + 2 * e], s[s4 >> 1][8 * (s4 & 1) + 2 * e + 1]);
    pf[s4] = __builtin_bit_cast(h16x8, w);
  }
  __builtin_amdgcn_sched_barrier(0);
  {
    const unsigned nm0 = ~(mwn[0] >> (16 * half)), nm1 = ~(mwn[1] >> (16 * half));
    const unsigned negm = __float_as_uint(-mref);
#pragma unroll
    for (int i = 0; i < 8; ++i) {
      const int di = i >> 2, s4 = i & 3;
      o[di] = mfma16(vf[di][s4], pf[s4], o[di]);
#pragma unroll
      for (int r = 2 * i; r < 2 * i + 2; ++r) {
        unsigned e0 = (unsigned)__builtin_amdgcn_sbfe((int)nm0, r, 1), e1 = (unsigned)__builtin_amdgcn_sbfe((int)nm1, r, 1);
        asm volatile("" : "+v"(e0), "+v"(e1));
        s[0][r] = __uint_as_float((e0 & 0xFF800000u) | (~e0 & negm));
        s[1][r] = __uint_as_float((e1 & 0xFF800000u) | (~e1 & negm));
      }
    }
#pragma unroll
    for (int i = 0; i < 8; ++i) { __builtin_amdgcn_sched_group_barrier(0x008, 1, 0); __builtin_amdgcn_sched_group_barrier(0x002, 8, 0); }
  }
}

DEVI void attn_unit(PRef p, LDS unsigned char* lds, int b, int head, int qb) {
  const int tid = launder((int)threadIdx.x), lane = tid & 63, wave = wave_id(tid), l31 = lane & 31, half = lane >> 5;
  const int q0 = qb * 256 + wave * 32, cw = q0 >> 6, NS = qb + 1;
  const size_t tok = (size_t)b * SEQ + q0 + l31;
  h16x8 qf[4];
  {
    const h16* Q = (const h16*)(p.ws + WS_Q) + tok * 512 + head * 64;
#pragma unroll
    for (int kk = 0; kk < 4; ++kk) qf[kk] = *(const h16x8*)(Q + 16 * kk + 8 * half);
  }
  const unsigned* mrow = (const unsigned*)(p.ws + WS_MASK) + tok * 256;
  constexpr int TP = 2 * 64 * LROW, ABUF = 4 * TP;
  static_assert(2 * ABUF <= LDS_BYTES - 16, "attention LDS");
  const h16* ksrc[4]; const h16* vsrc[4]; int kdst[4], vdst[4];
#pragma unroll
  for (int i = 0; i < 4; ++i) {
    const int id = tid + NTHR * i;
    const int row = id >> 3, lc = id & 7;
    ksrc[i] = (const h16*)(p.ws + WS_K) + ((size_t)b * SEQ + row) * 512 + head * 64 + lc * 8;
    kdst[i] = (row >> 6) * TP + (row & 63) * LROW + lc * 16;
    const int d = id >> 5, c = id & 31;
    vsrc[i] = (const h16*)(p.ws + WS_VT) + ((size_t)(b * 8 + head) * 64 + d) * 8192 + c * 8;
    vdst[i] = (c >> 3) * TP + 64 * LROW + d * LROW + (c & 7) * 16;
  }
  h16x8 rkA[4], rvA[4], rkB[4], rvB[4];
#pragma unroll
  for (int i = 0; i < 4; ++i) { rkA[i] = *(const h16x8*)ksrc[i]; rvA[i] = *(const h16x8*)vsrc[i]; }
#pragma unroll
  for (int i = 0; i < 4; ++i) { *(LDS h16x8*)(lds + kdst[i]) = rkA[i]; *(LDS h16x8*)(lds + vdst[i]) = rvA[i]; }
  {
    const int s1 = NS > 1 ? 1 : 0;
#pragma unroll
    for (int i = 0; i < 4; ++i) { rkA[i] = *(const h16x8*)(ksrc[i] + (size_t)s1 * 256 * 512); rvA[i] = *(const h16x8*)(vsrc[i] + s1 * 256); }
  }
  u32x4 mA0 = *(const u32x4*)mrow, mA1 = *(const u32x4*)(mrow + 4), mB0, mB1;
  __syncthreads();
  f32x16 o[2];
#pragma unroll
  for (int r = 0; r < 16; ++r) { o[0][r] = 0.f; o[1][r] = 0.f; }
  float mref = 0.f, l = 0.f; bool init = false;
  f32x16 sd[2];
  { u32x2 m2; m2[0] = mA0[0]; m2[1] = mA0[1]; attn_seed(sd, m2, half, mref); }
#define ATT_TILE(s, t, W0, W1) if (4 * (s) + (t) <= cw) { u32x2 m2; m2[0] = W0; m2[1] = W1; attn_tile(bb + (t) * TP, bb + (t) * TP + 64 * LROW, qf, sd, m2, l31, half, o, mref, l, init); }
#define ATT_STEP(s, RKC, RVC, RKN, RVN, MC0, MC1, MN0, MN1) { \
    { const int sp = (s) + 2 < NS ? (s) + 2 : NS - 1; _Pragma("unroll") for (int i = 0; i < 4; ++i) { RKN[i] = *(const h16x8*)(ksrc[i] + (size_t)sp * 256 * 512); RVN[i] = *(const h16x8*)(vsrc[i] + sp * 256); } } \
    { const int sm = (s) + 1 < NS ? (s) + 1 : NS - 1; MN0 = *(const u32x4*)(mrow + 8 * sm); MN1 = *(const u32x4*)(mrow + 8 * sm + 4); } \
    { LDS unsigned char* bb = lds + ((s) & 1) * ABUF; \
      ATT_TILE(s, 0, MC0[2], MC0[3]) ATT_TILE(s, 1, MC1[0], MC1[1]) ATT_TILE(s, 2, MC1[2], MC1[3]) ATT_TILE(s, 3, MN0[0], MN0[1]) } \
    { LDS unsigned char* nb = lds + (((s) + 1) & 1) * ABUF; _Pragma("unroll") for (int i = 0; i < 4; ++i) { *(LDS h16x8*)(nb + kdst[i]) = RKC[i]; *(LDS h16x8*)(nb + vdst[i]) = RVC[i]; } } \
    __syncthreads(); }
  for (int s = 0; s < NS; s += 2) {
    ATT_STEP(s, rkA, rvA, rkB, rvB, mA0, mA1, mB0, mB1)
    if (s + 1 < NS) ATT_STEP(s + 1, rkB, rvB, rkA, rvA, mB0, mB1, mA0, mA1)
  }
#undef ATT_STEP
#undef ATT_TILE
  const float inv = 1.f / (l + __shfl_xor(l, 32));
  h16* Y = (h16*)(p.ws + WS_H) + tok * DM + head * 64;
#pragma unroll
  for (int di = 0; di < 2; ++di)
#pragma unroll
    for (int q = 0; q < 4; ++q)
      *(h16x4*)(Y + 32 * di + 8 * q + 4 * half) = pack4(o[di][4 * q] * inv, o[di][4 * q + 1] * inv, o[di][4 * q + 2] * inv, o[di][4 * q + 3] * inv);
}

DEVI void phase4(PRef p, LDS unsigned char* lds) {
  const int G = gridDim.x;
  for (int it = blockIdx.x; it < 512; it += G) { const int c = it & 127; rnn_item<1>(p, lds, it >> 7, (it & 256) ? 127 - c : c); }
  for (int it = blockIdx.x; it < 512; it += G) {
    const int bh = it >> 4, j = it & 15;
#pragma unroll 1
    for (int w2 = 0; w2 < 2; ++w2) attn_unit(p, lds, bh >> 3, bh & 7, w2 ? j : 31 - j);
  }
}

struct EpiPlain {
  h16* dst; int ld;
  DEVI void operator()(const f32x4 (&acc)[2][2][4][2], const g8::Unit& u, int wr, int wc, int fr, int fq) const {
#pragma unroll
    for (int ai = 0; ai < 2; ++ai)
#pragma unroll
      for (int m = 0; m < 4; ++m) {
        const int r = u.pm * 256 + 128 * ai + 64 * wr + 16 * m + fr;
        if (r < u.cnt) {
          h16* d = dst + (size_t)(u.off + r) * ld + u.pn * 256 + 32 * wc + 8 * fq;
#pragma unroll
          for (int bj = 0; bj < 2; ++bj)
            { const f32x4 v0 = acc[ai][bj][m][0], v1 = acc[ai][bj][m][1]; h16x8 w; w[0] = (h16)v0[0]; w[1] = (h16)v0[1]; w[2] = (h16)v0[2]; w[3] = (h16)v0[3]; w[4] = (h16)v1[0]; w[5] = (h16)v1[1]; w[6] = (h16)v1[2]; w[7] = (h16)v1[3]; *(h16x8*)(d + 128 * bj) = w; }
        }
      }
  }
};
DEVI void phase5(PRef p, LDS unsigned char* lds) {
  g8::DenseOrder S{(const h16*)(p.ws + WS_H), (const h16*)(p.ws + WS_WOUT), DM, 128, 4, (int)gridDim.x, (int)blockIdx.x};
  EpiPlain E{(h16*)(p.ws + WS_MIX), DM};
  g8::gemm_phase(lds, DM, S, E);
}

constexpr int P6_TROW = 2064, P6_THI = 0, P6_TLO = 32 * P6_TROW, P6_PART = 0, P6_LGT = 8 * 48 * 32 * 4, P6_MOD = 2 * 32 * P6_TROW;
constexpr int P6_BIAS = P6_MOD + 3 * 4096, P6_TOK = P6_BIAS + 160, P6_LCNT = P6_TOK + 128 * 6 * 4, P6_LBASE = P6_LCNT + 128;
static_assert(P6_LBASE + 128 <= LDS_BYTES - 16 && P6_LGT + 32 * 36 * 4 <= P6_MOD, "phase 6 LDS map");
DEVI void phase6(PRef p, LDS unsigned char* lds) {
  const int tid = launder((int)threadIdx.x), lane = tid & 63, wave = wave_id(tid), l15 = lane & 15, g4 = lane >> 4;
  const int b = blockIdx.x >> 6;
  LDS float* mv = (LDS float*)(lds + P6_MOD);
  LDS float* rbias = (LDS float*)(lds + P6_BIAS);
  LDS unsigned* tokrec = (LDS unsigned*)(lds + P6_TOK);
  LDS unsigned* lcnt = (LDS unsigned*)(lds + P6_LCNT);
  LDS unsigned* lbase = (LDS unsigned*)(lds + P6_LBASE);
  mod_to_lds(p, b, 2, mv); mod_to_lds(p, b, 3, mv + 1024); mod_to_lds(p, b, 4, mv + 2048);
  if (tid < 4) rbias[tid] = p.in[18][tid];
  else if (tid < 36) rbias[tid] = p.in[20][tid - 4];
  if (tid < 32) lcnt[tid] = 0u;
  __syncthreads();
  for (int k = tid; k < 1024; k += NTHR) { mv[k] *= p.in[5][k]; mv[2048 + k] = p.in[6][k] * (mv[2048 + k] + 1.f); }
  __syncthreads();
  const float* x = p.in[0]; const h16* MIX = (const h16*)(p.ws + WS_MIX); h16* X1h = (h16*)(p.ws + WS_MIX); h16* H2 = (h16*)(p.ws + WS_H);
  const h16* WRH = (const h16*)(p.ws + WS_WRH); const h16* WRL = (const h16*)(p.ws + WS_WRL);
  const size_t tok0 = (size_t)blockIdx.x * 128;
  h16x8 bh[3][4], bl[3][4];
#pragma unroll
  for (int ct = 0; ct < 3; ++ct)
#pragma unroll
    for (int kk = 0; kk < 4; ++kk) {
      const int kof = 32 * (4 * wave + kk) + 8 * g4;
      bh[ct][kk] = *(const h16x8*)(WRH + (size_t)(16 * ct + l15) * 1024 + kof); bl[ct][kk] = *(const h16x8*)(WRL + (size_t)(16 * ct + l15) * 1024 + kof);
    }
  f32x4 xa[4]; h16x4 ma[4];
#pragma unroll
  for (int j = 0; j < 4; ++j) { xa[j] = *(const f32x4*)(x + (tok0 + 4 * wave) * DM + 256 * j + 4 * lane); ma[j] = *(const h16x4*)(MIX + (tok0 + 4 * wave) * DM + 256 * j + 4 * lane); }
#pragma unroll 1
  for (int rd = 0; rd < 4; ++rd) {
    {
      const size_t tokb = tok0 + 32 * rd + 4 * wave;
#define P6_LOAD(XV, MH, T) do { _Pragma("unroll") for (int j = 0; j < 4; ++j) { XV[j] = *(const f32x4*)(x + (T) * DM + 256 * j + 4 * lane); MH[j] = *(const h16x4*)(MIX + (T) * DM + 256 * j + 4 * lane); } } while (0)
#define P6_ROW(XV, MH, I) do { \
        const int tr = 4 * wave + (I); const size_t tok = tokb + (I); \
        f32x4 mx[4]; float ssm = 0.f; \
        _Pragma("unroll") for (int j = 0; j < 4; ++j) _Pragma("unroll") for (int e = 0; e < 4; ++e) { mx[j][e] = (float)MH[j][e]; ssm += mx[j][e] * mx[j][e]; } \
        const float rsm = 1.0f / sqrtf(wave_sum(ssm) * (1.f / 1024.f) + 1e-6f); \
        float ss1 = 0.f; \
        _Pragma("unroll") for (int j = 0; j < 4; ++j) { \
          const f32x4 v = XV[j] + *(LDS f32x4*)(mv + 256 * j + 4 * lane) * (mx[j] * rsm); \
          XV[j] = v; \
          *(h16x4*)(X1h + tok * DM + 256 * j + 4 * lane) = pack4(v[0], v[1], v[2], v[3]); \
          ss1 += v[0] * v[0] + v[1] * v[1] + v[2] * v[2] + v[3] * v[3]; \
        } \
        const float rs1 = 1.0f / sqrtf(wave_sum(ss1) * (1.f / 1024.f) + 1e-6f); \
        _Pragma("unroll") for (int j = 0; j < 4; ++j) { \
          const f32x4 h2 = XV[j] * rs1 * *(LDS f32x4*)(mv + 2048 + 256 * j + 4 * lane) + *(LDS f32x4*)(mv + 1024 + 256 * j + 4 * lane); \
          const h16x4 hi = pack4(h2[0], h2[1], h2[2], h2[3]); \
          const h16x4 lo = pack4(h2[0] - (float)hi[0], h2[1] - (float)hi[1], h2[2] - (float)hi[2], h2[3] - (float)hi[3]); \
          *(h16x4*)(H2 + tok * DM + 256 * j + 4 * lane) = hi; \
          *(LDS h16x4*)(lds + P6_THI + tr * P6_TROW + (256 * j + 4 * lane) * 2) = hi; \
          *(LDS h16x4*)(lds + P6_TLO + tr * P6_TROW + (256 * j + 4 * lane) * 2) = lo; \
        } } while (0)
      f32x4 xb[4]; h16x4 mb[4];
      P6_LOAD(xb, mb, tokb + 1); __builtin_amdgcn_sched_barrier(0); P6_ROW(xa, ma, 0);
      P6_LOAD(xa, ma, tokb + 2); __builtin_amdgcn_sched_barrier(0); P6_ROW(xb, mb, 1);
      P6_LOAD(xb, mb, tokb + 3); __builtin_amdgcn_sched_barrier(0); P6_ROW(xa, ma, 2);
      { const size_t tn = rd < 3 ? tokb + 32 : tokb; P6_LOAD(xa, ma, tn); } __builtin_amdgcn_sched_barrier(0); P6_ROW(xb, mb, 3);
    }
    __syncthreads();
    f32x4 acc[2][3];
#pragma unroll
    for (int tt = 0; tt < 2; ++tt)
#pragma unroll
      for (int ct = 0; ct < 3; ++ct) acc[tt][ct] = (f32x4){0.f, 0.f, 0.f, 0.f};
#pragma unroll
    for (int kk = 0; kk < 4; ++kk) {
      const int kof = 32 * (4 * wave + kk) + 8 * g4;
      h16x8 ah[2], al[2];
#pragma unroll
      for (int tt = 0; tt < 2; ++tt) {
        ah[tt] = *(LDS h16x8*)(lds + P6_THI + (16 * tt + l15) * P6_TROW + kof * 2);
        al[tt] = *(LDS h16x8*)(lds + P6_TLO + (16 * tt + l15) * P6_TROW + kof * 2);
      }
#pragma unroll
      for (int ct = 0; ct < 3; ++ct) {
#pragma unroll
        for (int tt = 0; tt < 2; ++tt) {
          acc[tt][ct] = mfma16s(ah[tt], bh[ct][kk], acc[tt][ct]);
          acc[tt][ct] = mfma16s(ah[tt], bl[ct][kk], acc[tt][ct]);
          acc[tt][ct] = mfma16s(al[tt], bh[ct][kk], acc[tt][ct]);
        }
      }
    }
    __syncthreads();
#pragma unroll
    for (int tt = 0; tt < 2; ++tt)
#pragma unroll
      for (int ct = 0; ct < 3; ++ct)
        *(LDS f32x4*)(lds + P6_PART + (((wave * 48 + 16 * ct + l15) * 32) + 16 * tt + 4 * g4) * 4) = acc[tt][ct];
    __syncthreads();
    for (int idx = tid; idx < 36 * 32; idx += NTHR) {
      const int col = idx >> 5, tk = idx & 31;
      float s = 0.f;
#pragma unroll
      for (int w = 0; w < 8; ++w) s += *(LDS float*)(lds + P6_PART + ((w * 48 + col) * 32 + tk) * 4);
      *(LDS float*)(lds + P6_LGT + (tk * 36 + col) * 4) = s;
    }
    __syncthreads();
    if (tid < 32) {
      LDS float* lg = (LDS float*)(lds + P6_LGT) + 36 * tid;
      float gl[4];
#pragma unroll
      for (int g = 0; g < 4; ++g) gl[g] = lg[g] + rbias[g];
      int gi = 0; float gm = gl[0];
#pragma unroll
      for (int g = 1; g < 4; ++g) if (gl[g] > gm) { gm = gl[g]; gi = g; }
      float gs = 0.f;
#pragma unroll
      for (int g = 0; g < 4; ++g) gs += __expf(gl[g] - gm);
      const float pg = 1.f / gs;
      int e1 = 0, e2 = 0; float l1 = -INFINITY, l2 = -INFINITY;
#pragma unroll
      for (int e = 0; e < 8; ++e) {
        const float v = lg[4 + 8 * gi + e] + rbias[4 + 8 * gi + e];
        if (v > l1) { l2 = l1; e2 = e1; l1 = v; e1 = e; }
        else if (v > l2) { l2 = v; e2 = e; }
      }
      const float x2 = __expf(l2 - l1);
      const float w1 = pg / (1.f + x2), w2 = pg * x2 / (1.f + x2);
      const unsigned E1 = (unsigned)(gi * 8 + e1), E2 = (unsigned)(gi * 8 + e2);
      const unsigned lp1 = __hip_atomic_fetch_add(&lcnt[E1], 1u, __ATOMIC_RELAXED, __HIP_MEMORY_SCOPE_WORKGROUP);
      const unsigned lp2 = __hip_atomic_fetch_add(&lcnt[E2], 1u, __ATOMIC_RELAXED, __HIP_MEMORY_SCOPE_WORKGROUP);
      LDS unsigned* tr = tokrec + (32 * rd + tid) * 6;
      tr[0] = E1; tr[1] = lp1; tr[2] = E2; tr[3] = lp2; tr[4] = __float_as_uint(w1); tr[5] = __float_as_uint(w2);
    }
    __syncthreads();
  }
  if (tid < 32) lbase[tid] = atomicAdd((unsigned*)(p.ws + WS_CNT) + tid, lcnt[tid]);
  __syncthreads();
  if (tid < 128) {
    unsigned* LIST = (unsigned*)(p.ws + WS_LIST); float* LISTW = (float*)(p.ws + WS_LISTW); u32x4* ROUTE = (u32x4*)(p.ws + WS_ROUTE);
    const unsigned tok = (unsigned)(tok0 + tid);
    LDS unsigned* tr = tokrec + tid * 6;
    const unsigned E1 = tr[0], E2 = tr[2], p1 = lbase[E1] + tr[1], p2 = lbase[E2] + tr[3];
    LIST[(size_t)E1 * 32768 + p1] = tok; LISTW[(size_t)E1 * 32768 + p1] = __uint_as_float(tr[4]);
    LIST[(size_t)E2 * 32768 + p2] = tok; LISTW[(size_t)E2 * 32768 + p2] = __uint_as_float(tr[5]);
    u32x4 rt; rt[0] = E1; rt[1] = p1; rt[2] = E2; rt[3] = p2;
    ROUTE[tok] = rt;
  }
}

template <bool GATHER_> struct MoeOrder {
  static constexpr bool GATHER = GATHER_;
  unsigned char* ws; int ntn, K, G, c;
  int pre, cnl, offx;
  DEVI void init() {
    const int lane = threadIdx.x & 63;
    const int cn0 = lane < 32 ? (int)((const unsigned*)(ws + WS_CNT))[lane] : 0;
    int pt = ((cn0 + 255) >> 8) * ntn, po = cn0;
#pragma unroll
    for (int d = 1; d < 32; d <<= 1) { const int a = __shfl_up(pt, d), b = __shfl_up(po, d); if (lane >= d) { pt += a; po += b; } }
    pre = lane < 32 ? pt : 0x7fffffff; cnl = cn0; offx = po - cn0;
  }
  DEVI bool next(int i, g8::Unit& u) const {
    const int itg = i * G + (c & 7) * (G >> 3) + (c >> 3);
    const int e = __builtin_popcountll(__builtin_amdgcn_ballot_w64(pre <= itg));
    if (e >= 32) return false;
    const int cn = __builtin_amdgcn_readlane(cnl, e), off = __builtin_amdgcn_readlane(offx, e);
    const int it = itg - (__builtin_amdgcn_readlane(pre, e) - ((cn + 255) >> 8) * ntn);
    u.e = e; u.pm = it / ntn; u.pn = it % ntn; u.cnt = cn; u.off = off;
    const int tid = threadIdx.x;
    if (GATHER_) {
      const unsigned* list = (const unsigned*)(ws + WS_LIST) + (size_t)e * 32768;
      u.A = (const char*)(ws + WS_H);
      u.B = (const char*)((const h16*)(ws + WS_WGU) + ((size_t)e * 512 + u.pn * 256) * DM);
#pragma unroll
      for (int h = 0; h < 2; ++h)
#pragma unroll
        for (int i2 = 0; i2 < 2; ++i2) {
          int R, C; g8::stage_rc(tid * 16 + i2 * 8192, R, C);
          const int row = u.pm * 256 + 128 * h + R;
          const unsigned t = list[row < cn ? row : cn - 1];
          u.va[h][i2] = (t * (unsigned)DM + (unsigned)C) * 2u;
        }
    } else {
      u.A = (const char*)((const h16*)(ws + WS_ACT) + ((size_t)off + u.pm * 256) * 256);
      u.B = (const char*)((const h16*)(ws + WS_WDN) + ((size_t)e * 1024 + u.pn * 256) * 256);
      u.va[0][0] = u.va[0][1] = u.va[1][0] = u.va[1][1] = 0u;
    }
    return true;
  }
};
struct EpiAct {
  unsigned char* ws;
  DEVI void operator()(const f32x4 (&acc)[2][2][4][2], const g8::Unit& u, int wr, int wc, int fr, int fq) const {
    const float* lw = (const float*)(ws + WS_LISTW) + (size_t)u.e * 32768; h16* act = (h16*)(ws + WS_ACT);
    const int r0 = u.pm * 256 + 64 * wr + fr;
    float w8[2][4];
#pragma unroll
    for (int ai = 0; ai < 2; ++ai)
#pragma unroll
      for (int m = 0; m < 4; ++m) { const int r = r0 + 128 * ai + 16 * m; w8[ai][m] = lw[r < u.cnt ? r : u.cnt - 1]; }
    __builtin_amdgcn_sched_barrier(0);
#pragma unroll
    for (int ai = 0; ai < 2; ++ai)
#pragma unroll
      for (int m = 0; m < 4; ++m) asm volatile("" : "+v"(w8[ai][m]));
#pragma unroll
    for (int ai = 0; ai < 2; ++ai)
#pragma unroll
      for (int m = 0; m < 4; ++m) {
        const int r = r0 + 128 * ai + 16 * m;
        if (r < u.cnt) {
          const float w = w8[ai][m];
#pragma unroll
          for (int bj = 0; bj < 2; ++bj) {
            const f32x4 g = acc[ai][bj][m][0], up = acc[ai][bj][m][1];
            float v[4];
#pragma unroll
            for (int e = 0; e < 4; ++e) v[e] = g[e] * __builtin_amdgcn_rcpf(1.f + __expf(-g[e])) * up[e] * w;
            *(h16x4*)(act + (size_t)(u.off + r) * 256 + 16 * (8 * u.pn + 4 * bj + wc) + 4 * fq) = pack4(v[0], v[1], v[2], v[3]);
          }
        }
      }
  }
};
struct EpiYp {
  h16* dst;
  DEVI void operator()(const f32x4 (&acc)[2][2][4][2], const g8::Unit& u, int wr, int wc, int fr, int fq) const {
#pragma unroll
    for (int ai = 0; ai < 2; ++ai)
#pragma unroll
      for (int m = 0; m < 4; ++m) {
        const int r = u.pm * 256 + 128 * ai + 64 * wr + 16 * m + fr;
        if (r < u.cnt) {
          h16* d = dst + (size_t)(u.off + r) * DM + u.pn * 256 + 32 * wc + 8 * fq;
#pragma unroll
          for (int bj = 0; bj < 2; ++bj)
            { const f32x4 v0 = acc[ai][bj][m][0], v1 = acc[ai][bj][m][1]; h16x8 w; w[0] = (h16)v0[0]; w[1] = (h16)v0[1]; w[2] = (h16)v0[2]; w[3] = (h16)v0[3]; w[4] = (h16)v1[0]; w[5] = (h16)v1[1]; w[6] = (h16)v1[2]; w[7] = (h16)v1[3]; *(h16x8*)(d + 128 * bj) = w; }
        }
      }
  }
};
DEVI void phase7(PRef p, LDS unsigned char* lds) {
  MoeOrder<true> S{p.ws, 2, DM, (int)gridDim.x, (int)blockIdx.x, 0, 0, 0};
  S.init();
  EpiAct E{p.ws};
  g8::gemm_phase(lds, DM, S, E);
}
DEVI void phase8(PRef p, LDS unsigned char* lds) {
  MoeOrder<false> S{p.ws, 4, 256, (int)gridDim.x, (int)blockIdx.x, 0, 0, 0};
  S.init();
  EpiYp E{(h16*)(p.ws + WS_YP)};
  g8::gemm_phase(lds, 256, S, E);
}

DEVI void phase9(PRef p, LDS unsigned char* lds) {
  const int tid = launder((int)threadIdx.x), lane = tid & 63, wave = wave_id(tid), G = gridDim.x;
  const int b = blockIdx.x & 3, bi = blockIdx.x >> 2, nbk = G >> 2;
  LDS unsigned* offs = (LDS unsigned*)lds;
  if (tid == 0) { const unsigned* cnt = (const unsigned*)(p.ws + WS_CNT); unsigned o = 0; for (int e = 0; e < 32; ++e) { offs[e] = o; o += cnt[e]; } }
  __syncthreads();
  LDS float* mv = (LDS float*)(lds + 256);
  mod_to_lds(p, b, 5, mv);
  __syncthreads();
  f32x4 A3[4];
#pragma unroll
  for (int j = 0; j < 4; ++j) { const int k = 256 * j + 4 * lane; A3[j] = *(LDS f32x4*)(mv + k) * *(const f32x4*)(p.in[7] + k); }
  const h16* YP = (const h16*)(p.ws + WS_YP); const u32x4* ROUTE = (const u32x4*)(p.ws + WS_ROUTE); float* out = p.out; const h16* X1h = (const h16*)(p.ws + WS_MIX);
  const int rstep = nbk * 8, r_first = bi * 8 + wave;
  const int nrow = (SEQ - r_first + rstep - 1) / rstep;
  unsigned R0 = 0u, R1 = 0u;
  if (lane < nrow) { const u32x4 rt = ROUTE[(size_t)b * SEQ + r_first + rstep * lane]; R0 = offs[rt[0]] + rt[1]; R1 = offs[rt[2]] + rt[3]; }
  h16x4 ya[4], yc[4]; f32x4 xv[4];
  {
    const size_t tok = (size_t)b * SEQ + r_first; const size_t r0 = __builtin_amdgcn_readlane(R0, 0), r1 = __builtin_amdgcn_readlane(R1, 0);
#pragma unroll
    for (int j = 0; j < 4; ++j) { ya[j] = *(const h16x4*)(YP + r0 * DM + 256 * j + 4 * lane); yc[j] = *(const h16x4*)(YP + r1 * DM + 256 * j + 4 * lane); { const h16x4 xh = *(const h16x4*)(X1h + tok * DM + 256 * j + 4 * lane); xv[j] = (f32x4){(float)xh[0], (float)xh[1], (float)xh[2], (float)xh[3]}; } }
  }
  for (int i = 0; i < nrow; ++i) {
    const size_t tok = (size_t)b * SEQ + r_first + rstep * i;
    h16x4 na[4], nc[4]; f32x4 nx[4];
    if (i + 1 < nrow) {
      const size_t r0 = __builtin_amdgcn_readlane(R0, i + 1), r1 = __builtin_amdgcn_readlane(R1, i + 1);
#pragma unroll
      for (int j = 0; j < 4; ++j) { na[j] = *(const h16x4*)(YP + r0 * DM + 256 * j + 4 * lane); nc[j] = *(const h16x4*)(YP + r1 * DM + 256 * j + 4 * lane); { const h16x4 xh = *(const h16x4*)(X1h + (tok + rstep) * DM + 256 * j + 4 * lane); nx[j] = (f32x4){(float)xh[0], (float)xh[1], (float)xh[2], (float)xh[3]}; } }
    }
    f32x4 y[4]; float ss = 0.f;
#pragma unroll
    for (int j = 0; j < 4; ++j)
#pragma unroll
      for (int e = 0; e < 4; ++e) { y[j][e] = (float)ya[j][e] + (float)yc[j][e]; ss += y[j][e] * y[j][e]; }
    const float rs = 1.0f / sqrtf(wave_sum(ss) * (1.f / 1024.f) + 1e-6f);
#pragma unroll
    for (int j = 0; j < 4; ++j) *(f32x4*)(out + tok * DM + 256 * j + 4 * lane) = xv[j] + A3[j] * (y[j] * rs);
    if (i + 1 < nrow) {
#pragma unroll
      for (int j = 0; j < 4; ++j) { ya[j] = na[j]; yc[j] = nc[j]; xv[j] = nx[j]; }
    }
  }
}

#define XB_TMO      128
#define XB_XCNT(j)  (256  + 64 * (j))
#define XB_XSUB(j)  (1280 + 64 * (j))
#define XB_XGEN(j)  (2304 + 64 * (j))
#define XB_TOP      3328
#define XB_TOPGEN   3392
#define XB_SPIN_CAP (1u << 22)
DEVI unsigned xb_ld(unsigned* p)              { return __hip_atomic_load(p, __ATOMIC_RELAXED, __HIP_MEMORY_SCOPE_AGENT); }
DEVI unsigned xb_add(unsigned* p, unsigned v) { return __hip_atomic_fetch_add(p, v, __ATOMIC_RELAXED, __HIP_MEMORY_SCOPE_AGENT); }
DEVI unsigned xb_xcc_id() { return (unsigned)__builtin_amdgcn_s_getreg((3 << 11) | 20) & 0xFu; }
#define XB_SPIN(cond, bar) do { unsigned _sp = 0; while (cond) { __builtin_amdgcn_s_sleep(1); \
    if ((++_sp & 255u) == 0u) { if (xb_ld(&(bar)[XB_TMO])) break; if (_sp > XB_SPIN_CAP) { atomicAdd(&(bar)[XB_TMO], 1u); break; } } } } while (0)
struct XcdBarrier { unsigned* bar; unsigned x; volatile LDS unsigned* st; };
DEVI XcdBarrier xcd_barrier_post(unsigned* bar, volatile LDS unsigned* st) {
  XcdBarrier b; b.bar = bar; b.x = xb_xcc_id(); b.st = st;
  if (threadIdx.x == 0) (void)xb_add(&bar[XB_XCNT(b.x)], 1u);
  return b;
}
DEVI void xcd_barrier_complete(unsigned* bar, unsigned x, unsigned& nloc, unsigned& nx) {
  const unsigned G = gridDim.x * gridDim.y * gridDim.z;
  unsigned sum, cnt, mine, sp = 0u;
  for (;;) {
    sum = 0u; cnt = 0u; mine = 0u;
#pragma unroll
    for (unsigned j = 0; j < 16; ++j) { const unsigned c = xb_ld(&bar[XB_XCNT(j)]); sum += c; cnt += (c > 0u) ? 1u : 0u; mine = (j == x) ? c : mine; }
    if (sum == G) break;
    __builtin_amdgcn_s_sleep(1);
    if ((++sp & 255u) == 0u) { if (xb_ld(&bar[XB_TMO])) break; if (sp > XB_SPIN_CAP) { atomicAdd(&bar[XB_TMO], 1u); break; } }
  }
  nloc = mine > 0u ? mine : 1u; nx = cnt > 0u ? cnt : 1u;
}
DEVI void xcd_barrier(const XcdBarrier& b) {
  asm volatile("s_waitcnt vmcnt(0)" ::: "memory");
  __syncthreads();
  if (threadIdx.x == 0) {
    unsigned* bar = b.bar;
    __builtin_amdgcn_s_waitcnt(0);
    unsigned nloc = b.st[0], nx = b.st[1];
    if (nloc == 0u) { xcd_barrier_complete(bar, b.x, nloc, nx); b.st[0] = nloc; b.st[1] = nx; }
    const unsigned old = xb_add(&bar[XB_XSUB(b.x)], 1u);
    const unsigned gen = old / nloc;
    if (old + 1u == (gen + 1u) * nloc) {
      __builtin_amdgcn_fence(__ATOMIC_RELEASE, "agent");
      asm volatile("s_waitcnt vmcnt(0)" ::: "memory");
      const unsigned og = xb_add(&bar[XB_TOP], 1u);
      const unsigned tg = og / nx;
      if (og + 1u == (tg + 1u) * nx) xb_add(&bar[XB_TOPGEN], 1u);
      else XB_SPIN(xb_ld(&bar[XB_TOPGEN]) == tg, bar);
      __builtin_amdgcn_fence(__ATOMIC_ACQUIRE, "agent");
      xb_add(&bar[XB_XGEN(b.x)], 1u);
      asm volatile("s_waitcnt vmcnt(0)" ::: "memory");
    } else {
      XB_SPIN(xb_ld(&bar[XB_XGEN(b.x)]) == gen, bar);
      __builtin_amdgcn_fence(__ATOMIC_ACQUIRE, "agent");
      asm volatile("s_waitcnt vmcnt(0)" ::: "memory");
    }
  }
  __syncthreads();
}

__global__ void __launch_bounds__(NTHR) fwd_kernel(Params p) {
  extern __shared__ __attribute__((aligned(16))) unsigned char smem[];
  LDS unsigned char* lds = (LDS unsigned char*)smem;
  const int lo = p.ph_lo, hi = p.ph_hi;
  volatile LDS unsigned* bst = (volatile LDS unsigned*)(lds + LDS_BYTES - 16);
  if (threadIdx.x < 4) bst[threadIdx.x] = 0u;
  __syncthreads();
  (void)xcd_barrier_post((unsigned*)(p.ws + WS_BAR), bst);
#ifndef REPEAT_PHASE
#define REPEAT_PHASE -1
#endif
#define GRID_SYNC(k) do { { XcdBarrier xb_; xb_.bar = (unsigned*)(get_params()->ws + WS_BAR); xb_.x = xb_xcc_id(); xb_.st = (volatile LDS unsigned*)(lds + LDS_BYTES - 16); xcd_barrier(xb_); } } while (0)
#define RUN_PHASE(k, fn) if (lo <= (k) && (k) < hi) { fn(*get_params(), lds); if ((k) == REPEAT_PHASE) { GRID_SYNC(k); fn(*get_params(), lds); } if ((k) + 1 < hi) GRID_SYNC(k); }
  RUN_PHASE(0, phase0)
  RUN_PHASE(1, phase1)
  RUN_PHASE(2, phase2)
  RUN_PHASE(3, phase3)
  RUN_PHASE(4, phase4)
  RUN_PHASE(5, phase5)
  RUN_PHASE(6, phase6)
  RUN_PHASE(7, phase7)
  RUN_PHASE(8, phase8)
  RUN_PHASE(9, phase9)
#undef GRID_SYNC
#undef RUN_PHASE
}

extern "C" void kernel_launch(void* const* d_in, const int* in_sizes, int n_in, void* d_out, int out_size, void* d_ws, size_t ws_size, hipStream_t stream) {
  static int grid = 0;
  if (grid == 0) {
    if (n_in != 24 || out_size != NTOK * DM || ws_size < WS_END) { fprintf(stderr, "kernel_launch: unexpected problem (n_in %d out %d ws %zu)\n", n_in, out_size, ws_size); grid = -1; return; }
    (void)hipFuncSetAttribute((const void*)fwd_kernel, hipFuncAttributeMaxDynamicSharedMemorySize, LDS_BYTES);
    int dev = 0, cus = 0, per_cu = 0;
    (void)hipGetDevice(&dev);
    (void)hipDeviceGetAttribute(&cus, hipDeviceAttributeMultiprocessorCount, dev);
    (void)hipOccupancyMaxActiveBlocksPerMultiprocessor(&per_cu, (const void*)fwd_kernel, NTHR, LDS_BYTES);
    if (per_cu < 1 || cus < 256) fprintf(stderr, "kernel_launch: occupancy %d blocks/CU on %d CUs\n", per_cu, cus);
    grid = 256;
  }
  if (grid < 0) return;
  (void)hipMemsetAsync((char*)d_ws + WS_CNT, 0, CTL_ZERO_BYTES, stream);
  Params p{};
  for (int i = 0; i < 24; ++i) p.in[i] = (const float*)d_in[i];
  p.out = (float*)d_out; p.ws = (unsigned char*)d_ws;
#if N_LAUNCH_MODE == 1
  p.ph_lo = 0; p.ph_hi = NPHASE;
  void* args[] = {&p};
  hipError_t e = hipLaunchCooperativeKernel((const void*)fwd_kernel, dim3(grid), dim3(NTHR), args, LDS_BYTES, stream);
  if (e != hipSuccess) fprintf(stderr, "cooperative launch failed: %s\n", hipGetErrorString(e));
#else
  for (int ph = 0; ph < NPHASE; ++ph) {
    p.ph_lo = ph; p.ph_hi = ph + 1;
    hipLaunchKernelGGL(fwd_kernel, dim3(grid), dim3(NTHR), LDS_BYTES, stream, p);
  }
#endif
}
```

```cpp
#include <hip/hip_runtime.h>
#include <cstdio>
#include <cstdint>

#ifndef N_LAUNCH_MODE
#define N_LAUNCH_MODE 1
#endif

#define DEVI __device__ __forceinline__
#define LDS __attribute__((address_space(3)))

typedef _Float16 h16;
typedef _Float16 h16x4 __attribute__((ext_vector_type(4)));
typedef _Float16 h16x8 __attribute__((ext_vector_type(8)));
typedef float f32x4 __attribute__((ext_vector_type(4)));
typedef float f32x16 __attribute__((ext_vector_type(16)));
typedef unsigned u32x2 __attribute__((ext_vector_type(2)));
typedef unsigned u32x4 __attribute__((ext_vector_type(4)));
typedef unsigned long long u64;

constexpr int NBATCH = 4, SEQ = 8192, NTOK = NBATCH * SEQ, DM = 1024;
constexpr int NTHR = 512;
constexpr int NPHASE = 10;
constexpr int LDS_BYTES = 163840;

constexpr size_t MiB = 1ull << 20;
constexpr size_t WS_CNT = 0;
constexpr size_t CTL_ZERO_BYTES = 20480;
constexpr size_t WS_BAR = 4096;
constexpr size_t WS_MODP = 64 * 1024;
constexpr size_t WS_ROPE = 1 * MiB;
constexpr size_t WS_WIN = 3 * MiB;
constexpr size_t WS_WOUT = 10 * MiB;
constexpr size_t WS_WGU = 12 * MiB;
constexpr size_t WS_WDN = 44 * MiB;
constexpr size_t WS_WRG = 60 * MiB;
constexpr size_t WS_WRH = 60 * MiB + 512 * 1024;
constexpr size_t WS_WRL = 60 * MiB + 640 * 1024;
constexpr size_t WS_AGG = 61 * MiB;
constexpr size_t WS_ROUTE = 63 * MiB;
constexpr size_t WS_LIST = 64 * MiB;
constexpr size_t WS_LISTW = 68 * MiB;
constexpr size_t WS_WI = 72 * MiB;
constexpr size_t WS_KI = 73 * MiB;
constexpr size_t WS_MASK = 77 * MiB;
constexpr size_t WS_H = 109 * MiB;
constexpr size_t WS_Q = 173 * MiB;
constexpr size_t WS_K = 205 * MiB;
constexpr size_t WS_VT = 237 * MiB;
constexpr size_t WS_QI = 269 * MiB;
constexpr size_t WS_XR = 301 * MiB;
constexpr size_t WS_XG = 333 * MiB;
constexpr size_t WS_MIX = 365 * MiB;
constexpr size_t WS_ACT = 429 * MiB;
constexpr size_t WS_YP = 173 * MiB;
constexpr size_t WS_END = 510 * MiB;
constexpr size_t SC_BATCH_BYTES = 8192ull * 6176ull;
static_assert(SC_BATCH_BYTES <= 64 * MiB && WS_MIX + 3 * SC_BATCH_BYTES <= WS_END, "score slots");

struct Params { const float* in[24]; float* out; unsigned char* ws; int ph_lo, ph_hi; };
typedef const __attribute__((address_space(4))) Params& PRef;
typedef const __attribute__((address_space(4))) Params* PPtr;

__device__ const double ROPE_REV[32] = {
  1.59154943091895345608e-01, 1.19349370211248861917e-01, 8.94994016088910132600e-02, 6.71150830052272551196e-02,
  5.03292121044870352509e-02, 3.77415847174197710556e-02, 2.83021958306233986646e-02, 2.12236527647776604399e-02,
  1.59154943091895338669e-02, 1.19349370211248861917e-02, 8.94994016088910236684e-03, 6.71150830052272533849e-03,
  5.03292121044870369856e-03, 3.77415847174197719230e-03, 2.83021958306233986646e-03, 2.12236527647776621747e-03,
  1.59154943091895356017e-03, 1.19349370211248848907e-03, 8.94994016088910236684e-04, 6.71150830052272598901e-04,
  5.03292121044870326488e-04, 3.77415847174197740914e-04, 2.83021958306233954120e-04, 2.12236527647776605484e-04,
  1.59154943091895350596e-04, 1.19349370211248862459e-04, 8.94994016088910182474e-05, 6.71150830052272544691e-05,
  5.03292121044870353593e-05, 3.77415847174197768019e-05, 2.83021958306233960897e-05, 2.12236527647776591931e-05};

DEVI int launder(int x) { asm volatile("" : "+v"(x)); return x; }
DEVI PPtr get_params() { PPtr k = (PPtr)__builtin_amdgcn_kernarg_segment_ptr(); asm volatile("" : "+s"(k)); return k; }
DEVI int wave_id(int tid) { return __builtin_amdgcn_readfirstlane(tid >> 6); }
DEVI f32x16 mfma16(h16x8 a, h16x8 b, f32x16 c) { return __builtin_amdgcn_mfma_f32_32x32x16_f16(a, b, c, 0, 0, 0); }
template <int CTRL> DEVI float dpp_add(float v) { return v + __int_as_float(__builtin_amdgcn_update_dpp(0, __float_as_int(v), CTRL, 0xf, 0xf, true)); }
DEVI float wave_sum(float v) {
  v = dpp_add<0xB1>(v); v = dpp_add<0x4E>(v); v = dpp_add<0x141>(v); v = dpp_add<0x140>(v);
  { const auto sw = __builtin_amdgcn_permlane16_swap(__float_as_uint(v), __float_as_uint(v), false, false); v = __uint_as_float(sw[0]) + __uint_as_float(sw[1]); }
  { const auto sw = __builtin_amdgcn_permlane32_swap(__float_as_uint(v), __float_as_uint(v), false, false); v = __uint_as_float(sw[0]) + __uint_as_float(sw[1]); }
  return v;
}
DEVI float sigmoid_f(float x) { return __builtin_amdgcn_rcpf(1.f + __expf(-x)); }
DEVI float silu_f(float x) { return x * __builtin_amdgcn_rcpf(1.f + __expf(-x)); }
DEVI float gelu_tanh_f(float x) {
  const float z = x * __builtin_fmaf(x * x, -2.f * 1.4426950408889634f * 0.7978845608028654f * 0.044715f, -2.f * 1.4426950408889634f * 0.7978845608028654f);
  return x * __builtin_amdgcn_rcpf(1.f + __builtin_amdgcn_exp2f(z));
}
DEVI unsigned fkey(float f) { unsigned u = __float_as_uint(f); return (u & 0x80000000u) ? ~u : (u | 0x80000000u); }
DEVI float fkey_inv(unsigned k) { unsigned u = (k & 0x80000000u) ? (k & 0x7fffffffu) : ~k; return __uint_as_float(u); }
DEVI int vt_perm(int pos) { return (pos & ~12) | ((pos & 4) << 1) | ((pos & 8) >> 1); }

DEVI void mod_to_lds(PRef p, int b, int chunk, LDS float* dst) {
  const float* mp = (const float*)(p.ws + WS_MODP);
  for (int k = threadIdx.x; k < 1024; k += NTHR) {
    const int j = chunk * 1024 + k;
    float v[8];
#pragma unroll
    for (int ks = 0; ks < 8; ++ks) v[ks] = mp[(size_t)(ks * 4 + b) * 6144 + j];
    float s = p.in[3][j];
#pragma unroll
    for (int ks = 0; ks < 8; ++ks) s += v[ks];
    dst[k] = s;
  }
}

constexpr int LROW = 144;

namespace g8 {
constexpr int BM = 256, BK = 64, HALF = 128, HTB = HALF * BK * 2, STAGE_BYTES = 8 * HTB;
DEVI int lds_byte(int r, int c) { const int st = (r >> 4) * 2 + (c >> 5), rr = r & 15, cc = c & 31, ob = rr * 64 + cc * 2; return st * 1024 + (ob ^ (((ob >> 9) & 1) << 5)); }
DEVI void stage_rc(int b, int& R, int& C) { const int st = b / 1024, sb = b % 1024, swz = sb ^ (((sb >> 9) & 1) << 5); R = (st >> 1) * 16 + swz / 64; C = (st & 1) * 32 + (swz % 64) / 2; }
struct Unit { const char* A; unsigned va[2][2]; const char* B; int pm, pn, e, cnt, off, half; };
DEVI void glds16(const char* src, LDS unsigned char* dst) { __builtin_amdgcn_global_load_lds((const unsigned*)src, (LDS unsigned*)dst, 16, 0, 0); }

DEVI void dense_va(unsigned (&va)[2][2], int K) {
  const int tid = threadIdx.x;
#pragma unroll
  for (int h = 0; h < 2; ++h)
#pragma unroll
    for (int i = 0; i < 2; ++i) { int R, C; stage_rc(tid * 16 + i * 8192, R, C); va[h][i] = (unsigned)((128 * h + R) * K + C) * 2u; }
}
template <class Sched, class Epi>
DEVI void gemm_phase(LDS unsigned char* lds, int K, const Sched& S, const Epi& E) {
  const int tid = launder((int)threadIdx.x), wid = wave_id(tid), lane = tid & 63, wr = wid >> 2, wc = wid & 3, fr = lane & 15, fq = lane >> 4;
  const int nt = launder(K) / BK;
  unsigned vb[2];
#pragma unroll
  for (int i = 0; i < 2; ++i) { int R, C; stage_rc(tid * 16 + i * 8192, R, C); vb[i] = (unsigned)(R * K + C) * 2u; }
  const size_t kstep = (size_t)(BK * 2), hstep = (size_t)HALF * K * 2;
  const unsigned ldsw = (unsigned)wid * 1024u;
  const int aoff = lds_byte(wr * 64 + fr, fq * 8), boff = lds_byte(wc * 32 + fr, fq * 8);
#define G8_SA(b, h) (((b) * 2 + (h)) * HTB)
#define G8_SB(b, h) ((4 + (b) * 2 + (h)) * HTB)
#define G8_STAGE(bufoff, gbase, v) do { glds16((gbase) + (v)[0], lds + (bufoff) + ldsw); glds16((gbase) + (v)[1], lds + (bufoff) + ldsw + 8192); } while (0)
#define G8_STAGEA(bufoff, gbase, h) do { glds16((gbase) + G8_VAC(h, 0), lds + (bufoff) + ldsw); glds16((gbase) + G8_VAC(h, 1), lds + (bufoff) + ldsw + 8192); } while (0)
#define G8_LDA(dst, b, h) do { _Pragma("unroll") for (int m = 0; m < 4; ++m) _Pragma("unroll") for (int k = 0; k < 2; ++k) dst[m][k] = *(const LDS h16x8*)(lds + G8_SA(b, h) + aoff + m * 2048 + k * 1024); } while (0)
#define G8_LDB(dst, b, h) do { _Pragma("unroll") for (int n = 0; n < 2; ++n) _Pragma("unroll") for (int k = 0; k < 2; ++k) dst[n][k] = *(const LDS h16x8*)(lds + G8_SB(b, h) + boff + n * 2048 + k * 1024); } while (0)
#define G8_MMA(ai, bj, At, Bt) do { if (!Sched::HALF || dohalf[bj]) { __builtin_amdgcn_s_setprio(1); _Pragma("unroll") for (int m = 0; m < 4; ++m) _Pragma("unroll") for (int n = 0; n < 2; ++n) _Pragma("unroll") for (int k = 0; k < 2; ++k) \
        acc[ai][bj][m][n] = __builtin_amdgcn_mfma_f32_16x16x32_f16(Bt[n][k], At[m][k], acc[ai][bj][m][n], 0, 0, 0); __builtin_amdgcn_s_setprio(0); } } while (0)
#define G8_WAIT_V(n) asm volatile("s_waitcnt vmcnt(" #n ")" ::: "memory")
#define G8_WAIT_L(n) asm volatile("s_waitcnt lgkmcnt(" #n ")" ::: "memory")
#define G8_BAR __builtin_amdgcn_s_barrier()
#define G8_SCHED __builtin_amdgcn_sched_barrier(0)
  Unit cur, nxt; int ui = 0;
  if (!S.next(0, cur)) return;
  unsigned vd[2][2];
  if (!Sched::GATHER) dense_va(vd, K);
#define G8_VAC(h, i) (Sched::GATHER ? cur.va[h][i] : vd[h][i])
#define G8_VAN(h, i) (Sched::GATHER ? nxt.va[h][i] : vd[h][i])
  f32x4 acc[2][2][4][2];
#pragma unroll
  for (int a = 0; a < 2; ++a)
#pragma unroll
    for (int b = 0; b < 2; ++b)
#pragma unroll
      for (int m = 0; m < 4; ++m)
#pragma unroll
        for (int n = 0; n < 2; ++n) acc[a][b][m][n] = (f32x4){0.f, 0.f, 0.f, 0.f};
  h16x8 At[4][2], B0[2][2], B1[2][2];
  const char* cA = cur.A; const char* cB = cur.B;
  G8_STAGE(G8_SB(0, 0), cB, vb); G8_STAGE(G8_SB(0, 1), cB + hstep, vb); G8_STAGEA(G8_SA(0, 0), cA, 0); G8_STAGEA(G8_SA(0, 1), cA, 1);
  if (wr == 1) G8_BAR;
  G8_WAIT_V(2); G8_BAR;
  G8_STAGE(G8_SB(1, 0), cB + kstep, vb); G8_STAGEA(G8_SA(1, 0), cA + kstep, 0); G8_STAGE(G8_SB(1, 1), cB + hstep + kstep, vb);
  G8_WAIT_V(6); G8_BAR;
  for (;;) {
    const bool has_next = S.next(ui + 1, nxt);
    if (!has_next) nxt = cur;
    const bool dohalf[2] = {!Sched::HALF || cur.half != 2, !Sched::HALF || cur.half != 1};
    const char* nA = nxt.A; const char* nB = nxt.B;
#pragma unroll 1
    for (int t = 0; t < nt; t += 2) {
      const bool last = (t == nt - 2);
      const char* a1 = cA + (size_t)(t + 1) * kstep;
      const char* a2 = last ? nA : cA + (size_t)(t + 2) * kstep; const char* b2 = last ? nB : cB + (size_t)(t + 2) * kstep;
      const char* a3 = a2 + kstep; const char* b3 = b2 + kstep;
#define G8_STAGE2(bufoff, gbase, h) do { glds16((gbase) + (last ? G8_VAN(h, 0) : G8_VAC(h, 0)), lds + (bufoff) + ldsw); glds16((gbase) + (last ? G8_VAN(h, 1) : G8_VAC(h, 1)), lds + (bufoff) + ldsw + 8192); } while (0)
      G8_LDB(B0, 0, 0); G8_LDB(B1, 0, 1); G8_SCHED; G8_LDA(At, 0, 0); G8_STAGEA(G8_SA(1, 1), a1, 1);
      G8_WAIT_V(8); G8_WAIT_L(0); G8_BAR; G8_MMA(0, 0, At, B0); G8_MMA(0, 1, At, B1); G8_BAR; G8_SCHED;
      G8_LDA(At, 0, 1); G8_STAGE(G8_SB(0, 0), b2, vb); G8_STAGE(G8_SB(0, 1), b2 + hstep, vb); G8_STAGE2(G8_SA(0, 0), a2, 0);
      G8_WAIT_V(8); G8_WAIT_L(0); G8_BAR; G8_MMA(1, 0, At, B0); G8_MMA(1, 1, At, B1); G8_BAR; G8_SCHED;
      G8_LDB(B0, 1, 0); G8_LDB(B1, 1, 1); G8_SCHED; G8_LDA(At, 1, 0); G8_STAGE2(G8_SA(0, 1), a2, 1);
      G8_WAIT_V(8); G8_WAIT_L(0); G8_BAR; G8_MMA(0, 0, At, B0); G8_MMA(0, 1, At, B1); G8_BAR; G8_SCHED;
      G8_LDA(At, 1, 1); G8_STAGE(G8_SB(1, 0), b3, vb); G8_STAGE(G8_SB(1, 1), b3 + hstep, vb); G8_STAGE2(G8_SA(1, 0), a3, 0);
      G8_WAIT_V(8); G8_WAIT_L(0); G8_BAR; G8_MMA(1, 0, At, B0); G8_MMA(1, 1, At, B1); G8_BAR; G8_SCHED;
    }
#undef G8_STAGE2
    if (wr == 0) G8_BAR;
    E(acc, cur, wr, wc, fr, fq);
    if (!has_next) break;
#pragma unroll
    for (int a = 0; a < 2; ++a)
#pragma unroll
      for (int b = 0; b < 2; ++b)
#pragma unroll
        for (int m = 0; m < 4; ++m)
#pragma unroll
          for (int n = 0; n < 2; ++n) acc[a][b][m][n] = (f32x4){0.f, 0.f, 0.f, 0.f};
    cur = nxt; cA = nA; cB = nB; ++ui;
    if (wr == 1) G8_BAR;
  }
  G8_WAIT_V(0);
  G8_BAR;
#undef G8_SA
#undef G8_STAGEA
#undef G8_VAC
#undef G8_VAN
#undef G8_SB
#undef G8_STAGE
#undef G8_LDA
#undef G8_LDB
#undef G8_MMA
#undef G8_WAIT_V
#undef G8_WAIT_L
#undef G8_BAR
#undef G8_SCHED
}
struct DenseOrder {
  static constexpr bool GATHER = false, HALF = false;
  const h16* A; const h16* Bt; int K, nM, nN, G, c;
  DEVI bool next(int i, Unit& u) const {
    const int nwg = nM * nN; const long L = (long)i * G + c; if (L >= nwg) return false;
    int wgid = (int)L; { const int q = nwg / 8, r = nwg % 8, xcd = wgid % 8, off = wgid / 8; wgid = (xcd < r ? xcd * (q + 1) : r * (q + 1) + (xcd - r) * q) + off; }
    const int nig = 8 * nN, gid = wgid / nig, fm = gid * 8, gsz = (nM - fm) < 8 ? (nM - fm) : 8;
    u.pm = fm + ((wgid % nig) % gsz); u.pn = (wgid % nig) / gsz; u.e = 0; u.cnt = 0x7fffffff; u.off = 0; u.half = 0;
    u.A = (const char*)(A + (size_t)u.pm * 256 * K); u.B = (const char*)(Bt + (size_t)u.pn * 256 * K);
    u.va[0][0] = u.va[0][1] = u.va[1][0] = u.va[1][1] = 0u;
    return true;
  }
};
}


DEVI h16x4 pack4(float a, float b, float c, float d) { h16x4 v; v[0] = (h16)a; v[1] = (h16)b; v[2] = (h16)c; v[3] = (h16)d; return v; }

template <class F>
DEVI void transpose_item(const float* src, int N, int kb, int nb, h16* dst, int ldd, F drow, LDS float* scr, int lane, float scale = 1.f) {
#pragma unroll 8
  for (int i = 0; i < 32; ++i) {
    const int kk = 2 * i + (lane >> 5), n = nb * 32 + (lane & 31);
    scr[kk * 33 + (lane & 31)] = (n < N) ? src[(size_t)(kb * 64 + kk) * N + n] : 0.f;
  }
  asm volatile("s_waitcnt lgkmcnt(0)" ::: "memory");
  const int c = lane & 7;
#pragma unroll
  for (int j = 0; j < 4; ++j) {
    const int nl = (lane >> 3) + 8 * j, n = nb * 32 + nl;
    h16x8 v;
#pragma unroll
    for (int e = 0; e < 8; ++e) v[e] = (h16)(scr[(c * 8 + e) * 33 + nl] * scale);
    if (n < N) *(h16x8*)(dst + (size_t)drow(n) * ldd + kb * 64 + c * 8) = v;
  }
  asm volatile("s_waitcnt lgkmcnt(0)" ::: "memory");
}

constexpr int TI_IN = 16 * 99, TI_RG = 32, TI_EARLY = TI_IN + TI_RG, TI_OUT = 16 * 32, TI_G = 32 * 128, TI_U = 32 * 128, TI_D = 32 * 128, TI_ALL = TI_EARLY + TI_OUT + TI_G + TI_U + TI_D;
DEVI void transpose_any(PRef p, int it, LDS float* scr, int lane) {
  int r = it;
  if (r < TI_IN) {
    transpose_item(p.in[8], 3144, r / 99, r % 99, (h16*)(p.ws + WS_WIN), 1024,
                   [](int n) { const int dl = n < 2112 ? n : (n < 2120 ? 3136 + (n - 2112) : (n < 2632 ? 2112 + (n - 2120) : 2624 + (n - 2632)));
                                 const int d = dl & 63, sx = (dl >> 6) & 3;
                                 return (dl & ~255) + 128 * (d >> 5) + 32 * sx + 16 * ((d >> 2) & 1) + 4 * ((d >> 3) & 3) + (d & 3); }, scr, lane);
    return;
  }
  r -= TI_IN;
  if (r < TI_RG) {
    if (r < 16) transpose_item(p.in[11] + (size_t)(r >> 1) * 4096, 64, 0, r & 1, (h16*)(p.ws + WS_WRG) + (size_t)(r >> 1) * 128 * 64, 64, [](int n) { return n; }, scr, lane, -1.4426950408889634f);
    else transpose_item(p.in[13] + (size_t)((r - 16) >> 1) * 4096, 64, 0, r & 1, (h16*)(p.ws + WS_WRG) + (size_t)((r - 16) >> 1) * 128 * 64, 64, [](int n) { return 64 + n; }, scr, lane, -1.4426950408889634f);
    return;
  }
  r -= TI_RG;
  if (r < TI_OUT) { transpose_item(p.in[16], 1024, r / 32, r % 32, (h16*)(p.ws + WS_WOUT), 1024, [](int n) { return (n & ~31) + 16 * ((n >> 2) & 1) + 4 * ((n >> 3) & 3) + (n & 3); }, scr, lane); return; }
  r -= TI_OUT;
  if (r < TI_G) { const int e = r >> 7, q = r & 127;
    transpose_item(p.in[21] + (size_t)e * 1024 * 256, 256, q >> 3, q & 7, (h16*)(p.ws + WS_WGU) + (size_t)e * 512 * 1024, 1024, [](int f) { return (f >> 4) * 32 + (f & 15); }, scr, lane); return; }
  r -= TI_G;
  if (r < TI_U) { const int e = r >> 7, q = r & 127;
    transpose_item(p.in[22] + (size_t)e * 1024 * 256, 256, q >> 3, q & 7, (h16*)(p.ws + WS_WGU) + (size_t)e * 512 * 1024, 1024, [](int f) { return (f >> 4) * 32 + 16 + (f & 15); }, scr, lane); return; }
  r -= TI_U;
  { const int e = r >> 7, q = r & 127;
    transpose_item(p.in[23] + (size_t)e * 256 * 1024, 1024, q >> 5, q & 31, (h16*)(p.ws + WS_WDN) + (size_t)e * 1024 * 256, 256, [](int n) { return (n & ~31) + 16 * ((n >> 2) & 1) + 4 * ((n >> 3) & 3) + (n & 3); }, scr, lane); }
}

DEVI void phase0(PRef p, LDS unsigned char* lds) {
  const int tid = launder((int)threadIdx.x), lane = tid & 63, wave = wave_id(tid), G = gridDim.x;
  const int gw = blockIdx.x * 8 + wave, NW = G * 8;
  {
    const float* c = p.in[1]; const float* wada = p.in[2]; float* mp = (float*)(p.ws + WS_MODP);
    for (int u = gw; u < 96 * 8; u += NW) {
      const int cgp = u % 96, ks = u / 96, j = cgp * 64 + lane;
      float a0 = 0.f, a1 = 0.f, a2 = 0.f, a3 = 0.f;
      {
        float w[128];
#pragma unroll
        for (int u = 0; u < 128; ++u) w[u] = wada[(size_t)(ks * 128 + u) * 6144 + j];
        int sv[8];
#pragma unroll
        for (int i = 0; i < 8; ++i) sv[i] = __float_as_int(silu_f(c[(i >> 1) * 1024 + ks * 128 + 64 * (i & 1) + lane]));
#pragma unroll
        for (int u = 0; u < 128; ++u) {
          a0 = fmaf(__int_as_float(__builtin_amdgcn_readlane(sv[0 + (u >> 6)], u & 63)), w[u], a0); a1 = fmaf(__int_as_float(__builtin_amdgcn_readlane(sv[2 + (u >> 6)], u & 63)), w[u], a1);
          a2 = fmaf(__int_as_float(__builtin_amdgcn_readlane(sv[4 + (u >> 6)], u & 63)), w[u], a2); a3 = fmaf(__int_as_float(__builtin_amdgcn_readlane(sv[6 + (u >> 6)], u & 63)), w[u], a3);
        }
      }
      mp[(size_t)(ks * 4 + 0) * 6144 + j] = a0; mp[(size_t)(ks * 4 + 1) * 6144 + j] = a1;
      mp[(size_t)(ks * 4 + 2) * 6144 + j] = a2; mp[(size_t)(ks * 4 + 3) * 6144 + j] = a3;
    }
  }
}

DEVI void phase1(PRef p, LDS unsigned char* lds) {
  const int tid = launder((int)threadIdx.x), lane = tid & 63, wave = wave_id(tid), G = gridDim.x;
  { const int gw = blockIdx.x * 8 + wave, NW = G * 8;
  {
    LDS float* scr = (LDS float*)lds + wave * (64 * 33);
    for (int it = gw; it < TI_EARLY; it += NW) transpose_any(p, it, scr, lane);
  }
  {
    h16* wrh = (h16*)(p.ws + WS_WRH); h16* wrl = (h16*)(p.ws + WS_WRL);
    for (int i = blockIdx.x * NTHR + tid; i < 48 * 1024; i += G * NTHR) {
      const int col = i >> 10, k = i & 1023;
      const float w = (col < 4) ? p.in[17][k * 4 + col] : (col < 36 ? p.in[19][k * 32 + (col - 4)] : 0.f);
      const h16 hi = (h16)w;
      wrh[i] = hi; wrl[i] = (h16)(w - (float)hi);
    }
    float* ct = (float*)(p.ws + WS_ROPE); float* st = ct + 8192 * 32;
    for (int i = blockIdx.x * NTHR + tid; i < 8192 * 32; i += G * NTHR) {
      const int pos = i >> 5, f = i & 31;
      const double rev = (double)pos * ROPE_REV[f];
      const float fr = (float)(rev - __builtin_rint(rev));
      ct[i] = __builtin_amdgcn_cosf(fr); st[i] = __builtin_amdgcn_sinf(fr);
    }
  }
  }
  __syncthreads();
  const int b = blockIdx.x & 3, bi = blockIdx.x >> 2, nbk = G >> 2;
  LDS float* mv = (LDS float*)lds;
  mod_to_lds(p, b, 0, mv); mod_to_lds(p, b, 1, mv + 1024);
  __syncthreads();
  f32x4 A[4], SH[4];
#pragma unroll
  for (int j = 0; j < 4; ++j) {
    const int k = 256 * j + 4 * lane;
    const f32x4 g = *(const f32x4*)(p.in[4] + k);
    A[j] = g * (*(LDS f32x4*)(mv + 1024 + k) + 1.f);
    SH[j] = *(LDS f32x4*)(mv + k);
  }
  const float* x = p.in[0]; h16* H = (h16*)(p.ws + WS_H);
  f32x4 vn[4];
  {
    const size_t tok = (size_t)b * SEQ + bi * 8 + wave;
#pragma unroll
    for (int j = 0; j < 4; ++j) vn[j] = *(const f32x4*)(x + tok * DM + 256 * j + 4 * lane);
  }
  for (int r = bi * 8 + wave; r < SEQ; r += nbk * 8) {
    const size_t tok = (size_t)b * SEQ + r;
    f32x4 v[4]; float ss = 0.f;
#pragma unroll
    for (int j = 0; j < 4; ++j) { v[j] = vn[j]; ss += v[j][0] * v[j][0] + v[j][1] * v[j][1] + v[j][2] * v[j][2] + v[j][3] * v[j][3]; }
    {
      const size_t tn = r + nbk * 8 < SEQ ? tok + nbk * 8 : tok;
#pragma unroll
      for (int j = 0; j < 4; ++j) vn[j] = *(const f32x4*)(x + tn * DM + 256 * j + 4 * lane);
    }
    const float rstd = 1.0f / sqrtf(wave_sum(ss) * (1.f / 1024.f) + 1e-6f);
#pragma unroll
    for (int j = 0; j < 4; ++j) {
      const f32x4 y = v[j] * rstd * A[j] + SH[j];
      *(h16x4*)(H + tok * DM + 256 * j + 4 * lane) = pack4(y[0], y[1], y[2], y[3]);
    }
  }
}

DEVI h16x8 pack8(const f32x4& a, const f32x4& b) { h16x8 w; w[0] = (h16)a[0]; w[1] = (h16)a[1]; w[2] = (h16)a[2]; w[3] = (h16)a[3]; w[4] = (h16)b[0]; w[5] = (h16)b[1]; w[6] = (h16)b[2]; w[7] = (h16)b[3]; return w; }
struct EpiInProj {
  unsigned char* ws; LDS unsigned char* lds;
  DEVI void operator()(const f32x4 (&acc)[2][2][4][2], const g8::Unit& u, int wr, int wc, int fr, int fq) const {
    const float* cosT = (const float*)(ws + WS_ROPE); const float* sinT = cosT + 8192 * 32;
    const int g = 4 * u.pn + wc;
    if (g > 49) return;
    const int d0 = 8 * fq;
    const int tok0 = u.pm * 256 + 64 * wr + fr;
    if (g < 16 || (g >= 24 && g <= 32)) {
      float scl; h16* dst; int ld;
      if (g < 8) { scl = 0.125f * 1.4426950408889634f; dst = (h16*)(ws + WS_Q) + g * 64; ld = 512; }
      else if (g < 16) { scl = 1.f; dst = (h16*)(ws + WS_K) + (g - 8) * 64; ld = 512; }
      else if (g < 32) { scl = 0.125f; dst = (h16*)(ws + WS_QI) + (g - 24) * 64; ld = 512; }
      else { scl = 1.f; dst = (h16*)(ws + WS_KI); ld = 64; }
#pragma unroll
      for (int ai = 0; ai < 2; ++ai) {
        f32x4 ca[4], cb[4], sa[4], sb[4];
#pragma unroll
        for (int m = 0; m < 4; ++m) {
          const int pos = (tok0 + 128 * ai + 16 * m) & 8191;
          ca[m] = *(const f32x4*)(cosT + pos * 32 + d0); cb[m] = *(const f32x4*)(cosT + pos * 32 + d0 + 4);
          sa[m] = *(const f32x4*)(sinT + pos * 32 + d0); sb[m] = *(const f32x4*)(sinT + pos * 32 + d0 + 4);
        }
        __builtin_amdgcn_sched_barrier(0);
#pragma unroll
        for (int m = 0; m < 4; ++m) {
          const int tok = tok0 + 128 * ai + 16 * m;
          const f32x4 xa = acc[ai][0][m][0], xb = acc[ai][0][m][1], ya = acc[ai][1][m][0], yb = acc[ai][1][m][1];
          h16* o = dst + (size_t)tok * ld;
          *(h16x8*)(o + d0) = pack8((xa * ca[m] - ya * sa[m]) * scl, (xb * cb[m] - yb * sb[m]) * scl);
          *(h16x8*)(o + 32 + d0) = pack8((ya * ca[m] + xa * sa[m]) * scl, (yb * cb[m] + xb * sb[m]) * scl);
        }
      }
    } else if (g < 24) {
      LDS unsigned char* tl = lds + g8::STAGE_BYTES + (wr * 4 + wc) * 2048;
      const int tp = vt_perm(fr), ln = fr + 16 * fq;
#pragma unroll
      for (int ai = 0; ai < 2; ++ai)
#pragma unroll
        for (int m = 0; m < 4; ++m) {
          const int tb = u.pm * 256 + 128 * ai + 64 * wr + 16 * m;
          const int b = tb >> 13, pb = tb & 8191;
          const f32x4 xa = acc[ai][0][m][0], xb = acc[ai][0][m][1], ya = acc[ai][1][m][0], yb = acc[ai][1][m][1];
#pragma unroll
          for (int e = 0; e < 4; ++e) {
            *(LDS h16*)(tl + (d0 + e) * 32 + tp * 2) = (h16)xa[e]; *(LDS h16*)(tl + (d0 + 4 + e) * 32 + tp * 2) = (h16)xb[e];
            *(LDS h16*)(tl + (32 + d0 + e) * 32 + tp * 2) = (h16)ya[e]; *(LDS h16*)(tl + (36 + d0 + e) * 32 + tp * 2) = (h16)yb[e];
          }
          const h16x8 r0 = *(LDS h16x8*)(tl + ln * 32), r1 = *(LDS h16x8*)(tl + ln * 32 + 16);
          h16* vt = (h16*)(ws + WS_VT) + ((size_t)(b * 8 + (g - 16)) * 64 + ln) * 8192 + pb;
          *(h16x8*)vt = r0; *(h16x8*)(vt + 8) = r1;
        }
    } else if (g < 49) {
      h16* dst = (g < 41) ? (h16*)(ws + WS_XR) + (g - 33) * 64 : (h16*)(ws + WS_XG) + (g - 41) * 64;
#pragma unroll
      for (int ai = 0; ai < 2; ++ai)
#pragma unroll
        for (int m = 0; m < 4; ++m) {
          h16* o = dst + (size_t)(tok0 + 128 * ai + 16 * m) * 512;
          *(h16x8*)(o + d0) = pack8(acc[ai][0][m][0], acc[ai][0][m][1]);
          *(h16x8*)(o + 32 + d0) = pack8(acc[ai][1][m][0], acc[ai][1][m][1]);
        }
    } else if (fq == 0) {
      const float sc = 0.35355339059327373f;
#pragma unroll
      for (int ai = 0; ai < 2; ++ai)
#pragma unroll
        for (int m = 0; m < 4; ++m) {
          float* wi = (float*)(ws + WS_WI) + (size_t)(tok0 + 128 * ai + 16 * m) * 8;
          *(f32x4*)wi = acc[ai][0][m][0] * sc; *(f32x4*)(wi + 4) = acc[ai][0][m][1] * sc;
        }
    }
  }
};

DEVI void phase2(PRef p, LDS unsigned char* lds) {
  g8::DenseOrder S{(const h16*)(p.ws + WS_H), (const h16*)(p.ws + WS_WIN), DM, 128, 13, (int)gridDim.x, (int)blockIdx.x};
  EpiInProj E{p.ws, lds};
  g8::gemm_phase(lds, DM, S, E);
  {
    const int tid = launder((int)threadIdx.x), lane = tid & 63, wave = wave_id(tid);
    LDS float* scr = (LDS float*)lds + wave * (64 * 33);
    const bool light = blockIdx.x >= 128;
    const int wv = (int)(blockIdx.x & 127) * 8 + wave;
    constexpr int NDEF = TI_ALL - TI_EARLY;
    for (int base = 0; base < NDEF; base += 3072) {
      if (light) {
#pragma unroll 1
        for (int k = 0; k < 2; ++k) { const int it = base + 2 * wv + k; if (it < NDEF) transpose_any(p, TI_EARLY + it, scr, lane); }
      } else { const int it = base + 2048 + wv; if (it < NDEF) transpose_any(p, TI_EARLY + it, scr, lane); }
    }
  }
}

constexpr int CROW = 1040;
constexpr int RNN_XG = 64 * CROW;
constexpr int RNN_CARRY = 2 * 64 * CROW;
DEVI void rnn_load_x(PRef p, int b, int cr, h16x8 (&xin)[11]) {
  const int tid = threadIdx.x, chg = tid & 63, tg = tid >> 6, pos0 = cr * 64 + 8 * tg;
  const h16* XR = (const h16*)(p.ws + WS_XR);
#pragma unroll
  for (int i = 0; i < 11; ++i) {
    const int pos = pos0 + i - 3;
    const h16x8 v = *(const h16x8*)(XR + ((size_t)b * SEQ + (pos >= 0 ? pos : 0)) * 512 + chg * 8);
#pragma unroll
    for (int e = 0; e < 8; ++e) xin[i][e] = pos >= 0 ? v[e] : (h16)0.f;
  }
}
DEVI void rnn_load_w(PRef p, float (&cw)[4][8], float (&cb)[8]) {
  const int chg = threadIdx.x & 63;
#pragma unroll
  for (int e = 0; e < 8; ++e) {
    cb[e] = p.in[10][chg * 8 + e];
#pragma unroll
    for (int j = 0; j < 4; ++j) cw[j][e] = p.in[9][j * 512 + chg * 8 + e];
  }
}
template <int MODE>
DEVI void rnn_item(PRef p, LDS unsigned char* lds, int b, int cr, const h16x8 (&xin)[11], const float (&cw)[4][8], const float (&cb)[8]) {
  const int tid = launder((int)threadIdx.x), lane = tid & 63, wave = wave_id(tid), l31 = lane & 31, half = lane >> 5;
  {
    const int chg = tid & 63, tg = tid >> 6;
#pragma unroll
    for (int tt = 0; tt < 8; ++tt) {
      h16x8 o;
#pragma unroll
      for (int e = 0; e < 8; ++e) {
        float v = cb[e];
#pragma unroll
        for (int j = 0; j < 4; ++j) v = fmaf(cw[j][e], (float)xin[tt + j][e], v);
        o[e] = (h16)v;
      }
      *(LDS h16x8*)(lds + (8 * tg + tt) * CROW + chg * 16) = o;
    }
  }
  if (MODE == 1) {
    const float2* ag = (const float2*)(p.ws + WS_AGG) + (size_t)b * 128 * 512 + tid;
    float carry = 0.f; int c2 = 0;
    for (; c2 + 8 <= cr; c2 += 8) {
      float2 v[8];
#pragma unroll
      for (int u = 0; u < 8; ++u) v[u] = ag[(size_t)(c2 + u) * 512];
#pragma unroll
      for (int u = 0; u < 8; ++u) carry = fmaf(v[u].x, carry, v[u].y);
    }
    for (; c2 < cr; ++c2) { const float2 v = ag[(size_t)c2 * 512]; carry = fmaf(v.x, carry, v.y); }
    ((LDS float*)(lds + RNN_CARRY))[tid] = carry;
  }
  if (MODE == 1) {
    const h16* XG = (const h16*)(p.ws + WS_XG) + ((size_t)b * SEQ + cr * 64) * 512;
#pragma unroll
    for (int i = 0; i < 8; ++i) { const int c = tid + NTHR * i, row = c >> 6, cc = c & 63; *(LDS h16x8*)(lds + RNN_XG + row * CROW + cc * 16) = *(const h16x8*)(XG + (size_t)row * 512 + cc * 8); }
  }
  __syncthreads();
  const int n = wave;
  const h16* WRG = (const h16*)(p.ws + WS_WRG) + (size_t)n * 128 * 64;
  float* AGG = (float*)(p.ws + WS_AGG);
#pragma unroll 1
  for (int dt = 0; dt < 2; ++dt) {
    h16x8 wa[4], wx[4];
#pragma unroll
    for (int kk = 0; kk < 4; ++kk) {
      wa[kk] = *(const h16x8*)(WRG + (size_t)(32 * dt + l31) * 64 + 16 * kk + 8 * half);
      wx[kk] = *(const h16x8*)(WRG + (size_t)(64 + 32 * dt + l31) * 64 + 16 * kk + 8 * half);
    }
    f32x16 ra[2], rx[2];
#pragma unroll
    for (int ti = 0; ti < 2; ++ti) {
#pragma unroll
      for (int r = 0; r < 16; ++r) { ra[ti][r] = 0.f; rx[ti][r] = 0.f; }
#pragma unroll
      for (int kk = 0; kk < 4; ++kk) {
        const h16x8 af = *(LDS h16x8*)(lds + (32 * ti + l31) * CROW + (n * 64 + 16 * kk + 8 * half) * 2);
        ra[ti] = mfma16(af, wa[kk], ra[ti]);
        rx[ti] = mfma16(af, wx[kk], rx[ti]);
      }
    }
    const int ch = n * 64 + 32 * dt + l31;
    const float ba = -1.4426950408889634f * p.in[12][ch], bx = -1.4426950408889634f * p.in[14][ch], lam = p.in[15][ch];
    const float c8l = -8.f * 1.4426950408889634f * log1pf(__expf(-lam));
#pragma unroll
    for (int ti = 0; ti < 2; ++ti)
#pragma unroll
      for (int r = 0; r < 16; ++r) {
        const int tk = 32 * ti + (r & 3) + 8 * (r >> 2) + 4 * half;
        const float cv = (float)*(LDS h16*)(lds + tk * CROW + ch * 2);
        const float rr = __builtin_amdgcn_rcpf(1.f + __builtin_amdgcn_exp2f(ra[ti][r] + ba)), ii = __builtin_amdgcn_rcpf(1.f + __builtin_amdgcn_exp2f(rx[ti][r] + bx));
        const float a = __builtin_amdgcn_exp2f(c8l * rr);
        ra[ti][r] = a;
        rx[ti][r] = __builtin_amdgcn_sqrtf(__builtin_fmaf(-a, a, 1.f)) * (ii * cv);
      }
    float P[8], Hs[8];
#pragma unroll
    for (int sg = 0; sg < 8; ++sg) {
      const int ti = sg >> 2, q = sg & 3;
      float pp = 1.f, hh = 0.f;
#pragma unroll
      for (int i = 0; i < 4; ++i) { const float a = ra[ti][4 * q + i], bb = rx[ti][4 * q + i]; hh = fmaf(a, hh, bb); pp *= a; }
      P[sg] = pp; Hs[sg] = hh;
    }
    float carry = 0.f, prod = 1.f;
    if (MODE == 1) carry = ((LDS float*)(lds + RNN_CARRY))[ch];
    float cin[8];
#pragma unroll
    for (int sg = 0; sg < 8; ++sg)
#pragma unroll
      for (int ow = 0; ow < 2; ++ow) {
        const float tmp = fmaf(P[sg], carry, Hs[sg]);
        const float tp = P[sg] * prod;
        if (half == ow) cin[sg] = carry;
        const auto swc = __builtin_amdgcn_permlane32_swap(__float_as_uint(tmp), __float_as_uint(tmp), false, false);
        const auto swp = __builtin_amdgcn_permlane32_swap(__float_as_uint(tp), __float_as_uint(tp), false, false);
        carry = __uint_as_float(swc[ow]); prod = __uint_as_float(swp[ow]);
      }
    if (MODE == 0) {
      if (half == 0) { float* ag = AGG + ((size_t)(b * 128 + cr) * 512 + ch) * 2; ag[0] = prod; ag[1] = carry; }
    } else {
#pragma unroll
      for (int sg = 0; sg < 8; ++sg) {
        const int ti = sg >> 2, q = sg & 3;
        float hh = cin[sg];
#pragma unroll
        for (int i = 0; i < 4; ++i) {
          hh = fmaf(ra[ti][4 * q + i], hh, rx[ti][4 * q + i]);
          LDS h16* xp = (LDS h16*)(lds + RNN_XG + (32 * ti + 8 * q + 4 * half + i) * CROW + ch * 2);
          *xp = (h16)(hh * gelu_tanh_f((float)*xp));
        }
      }
    }
  }
  __syncthreads();
  if (MODE == 1) {
    h16* Y = (h16*)(p.ws + WS_H) + ((size_t)b * SEQ + cr * 64) * DM + 512;
#pragma unroll
    for (int i = 0; i < 8; ++i) { const int c = tid + NTHR * i, row = c >> 6, cc = c & 63; *(h16x8*)(Y + (size_t)row * DM + cc * 8) = *(LDS h16x8*)(lds + RNN_XG + row * CROW + cc * 16); }
    __syncthreads();
  }
}

constexpr int IDX_NB = 256, IDX_CAP = 128;
constexpr int IL_HIST = 0, IL_CS = 65536, IL_CK = IL_CS + 64 * IDX_CAP * 4, IL_KI = IL_CK + 64 * IDX_CAP * 2, IL_KISZ = 128 * LROW, IL_ST = IL_KI + 2 * IL_KISZ;
static_assert(IL_ST + 4096 <= LDS_BYTES, "indexer LDS map");

DEVI f32x4 mfma16s(h16x8 a, h16x8 b, f32x4 c) { return __builtin_amdgcn_mfma_f32_16x16x32_f16(a, b, c, 0, 0, 0); }
DEVI unsigned pk_rtz(float a, float b) { return __builtin_bit_cast(unsigned, __builtin_amdgcn_cvt_pkrtz(a, b)); }
DEVI int idx_bin(float sv, float qinv, float qoff) { return (int)__builtin_amdgcn_fmed3f(__builtin_fmaf(sv, qinv, qoff), 0.f, (float)(IDX_NB - 1)); }
DEVI void idx_score(LDS unsigned char* kit, int kh, int l15, int g4, const h16x8 (&qf)[8][2], const float (&wq)[8], f32x4 (&sc)[4]) {
  h16x8 kf[4][2];
#pragma unroll
  for (int kt = 0; kt < 4; ++kt)
#pragma unroll
    for (int ks = 0; ks < 2; ++ks) kf[kt][ks] = *(LDS h16x8*)(kit + (64 * kh + 16 * kt + l15) * LROW + (4 * ks + g4) * 16);
#pragma unroll
  for (int kt = 0; kt < 4; ++kt) sc[kt] = (f32x4){0.f, 0.f, 0.f, 0.f};
  f32x4 accA[4], accB[4];
#define IDX_MM(ACC, h) __builtin_amdgcn_s_setprio(1); _Pragma("unroll") for (int kt = 0; kt < 4; ++kt) { ACC[kt] = mfma16s(kf[kt][0], qf[h][0], (f32x4){0.f, 0.f, 0.f, 0.f}); ACC[kt] = mfma16s(kf[kt][1], qf[h][1], ACC[kt]); } __builtin_amdgcn_s_setprio(0);
#define IDX_RS(ACC, h) _Pragma("unroll") for (int kt = 0; kt < 4; ++kt) _Pragma("unroll") for (int r = 0; r < 4; ++r) { const float rl_ = __int_as_float(max(__float_as_int(ACC[kt][r]), 0)); asm("v_fmac_f32 %0, %1, %2" : "+v"(sc[kt][r]) : "v"(wq[h]), "v"(rl_)); }
  IDX_MM(accA, 0) IDX_MM(accB, 1) IDX_RS(accA, 0) IDX_RS(accB, 1)
  IDX_MM(accA, 2) IDX_MM(accB, 3) IDX_RS(accA, 2) IDX_RS(accB, 3)
  IDX_MM(accA, 4) IDX_MM(accB, 5) IDX_RS(accA, 4) IDX_RS(accB, 5)
  IDX_MM(accA, 6) IDX_MM(accB, 7) IDX_RS(accA, 6) IDX_RS(accB, 7)
#undef IDX_MM
#undef IDX_RS
}

template <int MODE>
DEVI void idx_pass(LDS unsigned char* lds, const h16* KIb, int N, int stride, int qg, int kh,
                   const h16* QIrow0, const float* WIrow0, float qinv, float qoff, int bstar, h16* scbase) {
  const int tid = launder((int)threadIdx.x), lane = tid & 63, l15 = lane & 15, g4 = lane >> 4;
  const int q = 16 * qg + l15;
  h16x8 qf[8][2]; float wq[8];
  {
    const h16* QI = QIrow0 + (size_t)q * 512;
#pragma unroll
    for (int h = 0; h < 8; ++h)
#pragma unroll
      for (int ks = 0; ks < 2; ++ks) qf[h][ks] = *(const h16x8*)(QI + h * 64 + 32 * ks + 8 * g4);
    const float* WI = WIrow0 + (size_t)q * 8;
#pragma unroll
    for (int h = 0; h < 8; ++h) wq[h] = WI[h];
#pragma unroll
    for (int h = 0; h < 8; ++h) { asm volatile("" : "+v"(qf[h][0])); asm volatile("" : "+v"(qf[h][1])); asm volatile("" : "+v"(wq[h])); }
  }
  LDS unsigned* hist = (LDS unsigned*)(lds + IL_HIST);
  LDS unsigned* st = (LDS unsigned*)(lds + IL_ST);
  const int nst = (N + 127) >> 7;
  const int lr = tid >> 3, lc = tid & 7;
  h16x8 r0, r1;
  r0 = *(const h16x8*)(KIb + (size_t)lr * 64 + lc * 8); r1 = *(const h16x8*)(KIb + (size_t)(lr + 64) * 64 + lc * 8);
  *(LDS h16x8*)(lds + IL_KI + lr * LROW + lc * 16) = r0; *(LDS h16x8*)(lds + IL_KI + (lr + 64) * LROW + lc * 16) = r1;
  __syncthreads();
  float vmin = INFINITY, vmax = -INFINITY;
  int cur = 0;
  for (int s = 0; s < nst; s += stride) {
    const int nx = s + stride;
    { const int nxc = nx < nst ? nx : s;
      r0 = *(const h16x8*)(KIb + (size_t)(128 * nxc + lr) * 64 + lc * 8); r1 = *(const h16x8*)(KIb + (size_t)(128 * nxc + lr + 64) * 64 + lc * 8); }
    const bool active = 128 * s + 64 * kh < N;
    f32x4 sc[4];
    if (active) {
      idx_score(lds + IL_KI + cur * IL_KISZ, kh, l15, g4, qf, wq, sc);
#pragma unroll
      for (int kt = 0; kt < 4; ++kt) asm volatile("" : "+v"(sc[kt]));
    }
    {
      *(LDS h16x8*)(lds + IL_KI + (cur ^ 1) * IL_KISZ + lr * LROW + lc * 16) = r0;
      *(LDS h16x8*)(lds + IL_KI + (cur ^ 1) * IL_KISZ + (lr + 64) * LROW + lc * 16) = r1;
    }
    if (active) {
      if (MODE == 0) {
#pragma unroll
        for (int kt = 0; kt < 4; ++kt)
#pragma unroll
          for (int r = 0; r < 4; ++r) { vmin = fminf(vmin, sc[kt][r]); vmax = fmaxf(vmax, sc[kt][r]); }
      } else if (MODE == 1) {
        h16* scp = scbase + ((size_t)((s * 2 + kh) * 4) * 1024 + q * 16 + 4 * g4);
#pragma unroll
        for (int kt = 0; kt < 4; ++kt) {
          u32x2 pw; pw[0] = pk_rtz(sc[kt][0], sc[kt][1]); pw[1] = pk_rtz(sc[kt][2], sc[kt][3]);
          *(u32x2*)(scp + kt * 1024) = pw;
          const h16x4 hv = __builtin_bit_cast(h16x4, pw);
#pragma unroll
          for (int r = 0; r < 4; ++r) {
            const int bin = idx_bin((float)hv[r], qinv, qoff);
            __hip_atomic_fetch_add(&hist[bin * 64 + q], 1u, __ATOMIC_RELAXED, __HIP_MEMORY_SCOPE_WORKGROUP);
          }
        }
      }
    }
    __syncthreads();
    cur ^= 1;
  }
  if (MODE == 0) {
    __hip_atomic_fetch_min(&st[q], fkey(vmin), __ATOMIC_RELAXED, __HIP_MEMORY_SCOPE_WORKGROUP);
    __hip_atomic_fetch_max(&st[64 + q], fkey(vmax), __ATOMIC_RELAXED, __HIP_MEMORY_SCOPE_WORKGROUP);
  }
}

DEVI float idx_bin_lower_bound(int target, float qinv, float qoff) {
  if (target <= 0) return -INFINITY;
  if (target > IDX_NB - 1) return INFINITY;
  unsigned lo = 0x03FFu, hi = 0xFC00u;
  auto val = [](unsigned k) { const unsigned short hbits = (unsigned short)((k & 0x8000u) ? (k & 0x7FFFu) : (~k & 0xFFFFu)); return (float)__builtin_bit_cast(h16, hbits); };
  if (idx_bin(val(hi), qinv, qoff) < target) return INFINITY;
  while (lo < hi) { const unsigned mid = (lo + hi) >> 1; if (idx_bin(val(mid), qinv, qoff) >= target) hi = mid; else lo = mid + 1; }
  return val(lo);
}
DEVI void idx_stream_step(LDS unsigned char* lds, LDS unsigned* st, const unsigned long long (&cur)[4], int s, int kh, int qg, int q, int lane, int g4, h16 thi, h16 tlo) {
  unsigned cm = 0u; int vlo = 0, vhi = 0;
#pragma unroll
  for (int kt = 3; kt >= 0; --kt) {
    const h16x4 hv = __builtin_bit_cast(h16x4, cur[kt]);
#pragma unroll
    for (int r = 3; r >= 0; --r) {
      const unsigned long long ms = __builtin_amdgcn_ballot_w64(hv[r] >= thi);
      const unsigned long long mc = __builtin_amdgcn_ballot_w64(hv[r] >= tlo) & ~ms;
      asm("v_addc_co_u32_e64 %0, vcc, %0, %0, %1" : "+v"(cm) : "s"(mc) : "vcc");
      asm("v_writelane_b32 %0, %1, %2" : "+v"(vlo) : "s"((unsigned)ms), "n"(4 * kt + r)); asm("v_writelane_b32 %0, %1, %2" : "+v"(vhi) : "s"((unsigned)(ms >> 32)), "n"(4 * kt + r));
    }
  }
  if (__builtin_amdgcn_ballot_w64(cm != 0u) != 0ull) {
    while (cm != 0u) {
      const int e = __builtin_ctz(cm); cm &= cm - 1u;
      const int kt = e >> 2, r = e & 3;
      const unsigned long long w = kt == 0 ? cur[0] : (kt == 1 ? cur[1] : (kt == 2 ? cur[2] : cur[3]));
      const unsigned hb = (unsigned)(w >> (16 * r)) & 0xFFFFu;
      const unsigned sk = (hb & 0x8000u) ? (~hb & 0xFFFFu) : (hb | 0x8000u);
      const unsigned key = (unsigned)(128 * s + 64 * kh + 16 * kt + 4 * g4 + r);
      const unsigned pos = __hip_atomic_fetch_add(&st[128 + q], 1u, __ATOMIC_RELAXED, __HIP_MEMORY_SCOPE_WORKGROUP);
      if (pos < (unsigned)IDX_CAP) ((LDS unsigned*)(lds + IL_CS))[q * IDX_CAP + pos] = (sk << 16) | (0xFFFFu - key);
    }
  }
  if (lane < 16) {
    const int kt = lane >> 2, r = lane & 3;
    LDS unsigned short* d = (LDS unsigned short*)(lds + IL_HIST + ((((2 * s + kh) * 2 + (qg >> 1)) * 32 + (kt >> 1) * 16 + r + 8 * (kt & 1)) * 8) + (qg & 1) * 2);
    d[0] = (unsigned short)vlo; d[2] = (unsigned short)((unsigned)vlo >> 16); d[16] = (unsigned short)vhi; d[18] = (unsigned short)((unsigned)vhi >> 16);
  }
}
DEVI void idx_stream(LDS unsigned char* lds, int N, int qg, int kh, float thi_f, float tlo_f, const h16* scbase) {
  const int tid = launder((int)threadIdx.x), lane = tid & 63, l15 = lane & 15, g4 = lane >> 4;
  const int q = 16 * qg + l15;
  const h16 thi = (h16)thi_f, tlo = (h16)tlo_f;
  LDS unsigned* st = (LDS unsigned*)(lds + IL_ST);
  const int nv = (N - 64 * kh + 127) >> 7;
  const unsigned long long* scp = (const unsigned long long*)(scbase + ((size_t)(kh * 4) * 1024 + q * 16 + 4 * g4));
#define IDX_LD(dst, s_) do { const int sc_ = (s_) < nv ? (s_) : nv - 1; _Pragma("unroll") for (int kt = 0; kt < 4; ++kt) dst[kt] = __hip_atomic_load(scp + (size_t)sc_ * 2048 + kt * 256, __ATOMIC_RELAXED, __HIP_MEMORY_SCOPE_AGENT); } while (0)
  unsigned long long b0[4], b1[4], b2[4], b3[4];
  IDX_LD(b0, 0); IDX_LD(b1, 1); IDX_LD(b2, 2); IDX_LD(b3, 3);
  for (int s = 0; s < nv; s += 4) {
    idx_stream_step(lds, st, b0, s, kh, qg, q, lane, g4, thi, tlo); IDX_LD(b0, s + 4);
    if (s + 1 < nv) idx_stream_step(lds, st, b1, s + 1, kh, qg, q, lane, g4, thi, tlo);
    IDX_LD(b1, s + 5);
    if (s + 2 < nv) idx_stream_step(lds, st, b2, s + 2, kh, qg, q, lane, g4, thi, tlo);
    IDX_LD(b2, s + 6);
    if (s + 3 < nv) idx_stream_step(lds, st, b3, s + 3, kh, qg, q, lane, g4, thi, tlo);
    IDX_LD(b3, s + 7);
  }
#undef IDX_LD
}

DEVI void idx_item(PRef p, LDS unsigned char* lds, int b, int c) {
  const int tid = launder((int)threadIdx.x), lane = tid & 63, wave = wave_id(tid), l31 = lane & 31, half = lane >> 5;
  const int N = 64 * (c + 1);
  u64* MASKT = (u64*)(p.ws + WS_MASK) + ((size_t)(b * 256 + 2 * c) * 128) * 32;
  if (N <= 256) {
    for (int i = tid; i < (N >> 6) * 64; i += NTHR) MASKT[(size_t)((i >> 5) & 1) * 128 * 32 + (i >> 6) * 32 + (i & 31)] = ~0ull;
    return;
  }
  const int qg = wave & 3, kh = wave >> 2, l15 = lane & 15, q = 16 * qg + l15;
  const h16* QIrow0 = (const h16*)(p.ws + WS_QI) + ((size_t)b * SEQ + 64 * c) * 512;
  const float* WIrow0 = (const float*)(p.ws + WS_WI) + ((size_t)b * SEQ + 64 * c) * 8;
  const h16* KIb = (const h16*)(p.ws + WS_KI) + (size_t)b * SEQ * 64;
  h16* scbase;
  {
    const int j = (c < 64) ? c : 127 - c;
    const size_t pre = 8192ull * (size_t)(128 * j - (j * (j - 1)) / 2);
    scbase = (h16*)(p.ws + (b == 0 ? WS_H : WS_MIX + (size_t)(b - 1) * SC_BATCH_BYTES) + pre);
  }
  LDS unsigned* st = (LDS unsigned*)(lds + IL_ST);
  LDS float* stf = (LDS float*)(lds + IL_ST);
  if (tid < 64) { st[tid] = 0xFFFFFFFFu; st[64 + tid] = 0u; st[128 + tid] = 0u; }
  __syncthreads();
  const int nst = (N + 127) >> 7;
  const int stride = nst >= 32 ? 16 : (nst >= 16 ? 8 : (nst >= 8 ? 4 : (nst >= 4 ? 2 : 1)));
  idx_pass<0>(lds, KIb, N, stride, qg, kh, QIrow0, WIrow0, 0.f, 0.f, 0, scbase);
  __syncthreads();
  if (tid < 64) {
    const float lo = fkey_inv(st[tid]), hi = fkey_inv(st[64 + tid]);
    float d = hi - lo; if (!(d > 1e-20f)) d = 1.f;
    const float inv = (float)IDX_NB / (1.5f * d);
    stf[192 + tid] = inv; stf[256 + tid] = -(lo - 0.25f * d) * inv;
  }
  for (int i = tid; i < 4096; i += NTHR) ((LDS u32x4*)(lds + IL_HIST))[i] = (u32x4){0u, 0u, 0u, 0u};
  __syncthreads();
  const float qinv = stf[192 + q], qoff = stf[256 + q];
  idx_pass<1>(lds, KIb, N, 1, qg, kh, QIrow0, WIrow0, qinv, qoff, 0, scbase);
  {
    LDS unsigned* hist = (LDS unsigned*)(lds + IL_HIST);
    LDS unsigned* part = (LDS unsigned*)(lds + IL_CS);
    unsigned sum = 0u;
#pragma unroll 8
    for (int k = 0; k < 32; ++k) sum += hist[(32 * wave + k) * 64 + lane];
    part[wave * 64 + lane] = sum;
    __syncthreads();
    unsigned above = 0u;
    for (int w2 = wave + 1; w2 < 8; ++w2) above += part[w2 * 64 + lane];
    if (above < 256u && above + sum >= 256u) {
      unsigned cum = above;
      for (int k = 31; k >= 0; --k) {
        const unsigned h = hist[(32 * wave + k) * 64 + lane];
        if (cum < 256u && cum + h >= 256u) { st[320 + lane] = (unsigned)(32 * wave + k); st[384 + lane] = 256u - cum; }
        cum += h;
      }
    }
  }
  __syncthreads();
  if (tid < 128) {
    const int qq = tid & 63, bs = (int)st[320 + qq]; const float qi_ = stf[192 + qq], qo_ = stf[256 + qq];
    if (tid < 64) stf[448 + qq] = idx_bin_lower_bound(bs + 1, qi_, qo_);
    else stf[512 + qq] = idx_bin_lower_bound(bs, qi_, qo_);
  }
  __syncthreads();
  const float thi = stf[448 + q], tlo = stf[512 + q];
  asm volatile("s_waitcnt vmcnt(0)" ::: "memory");
  idx_stream(lds, N, qg, kh, thi, tlo, scbase);
  __syncthreads();
  for (int qq = wave; qq < 64; qq += 8) {
    const int nc = min((int)st[128 + qq], IDX_CAP); const unsigned need = st[384 + qq];
    LDS unsigned* cs = (LDS unsigned*)(lds + IL_CS) + qq * IDX_CAP;
    const unsigned c1 = lane < nc ? cs[lane] : 0u, c2 = 64 + lane < nc ? cs[64 + lane] : 0u;
    unsigned r1 = 0u, r2 = 0u;
    const int n1 = nc < 64 ? nc : 64;
    for (int j = 0; j < n1; ++j) { const unsigned cj = (unsigned)__builtin_amdgcn_readlane((int)c1, j); r1 += cj > c1 ? 1u : 0u; r2 += cj > c2 ? 1u : 0u; }
    for (int j = 64; j < nc; ++j) { const unsigned cj = (unsigned)__builtin_amdgcn_readlane((int)c2, j - 64); r1 += cj > c1 ? 1u : 0u; r2 += cj > c2 ? 1u : 0u; }
#pragma unroll
    for (int h2 = 0; h2 < 2; ++h2) {
      const unsigned cv = h2 ? c2 : c1, rk = h2 ? r2 : r1;
      if (64 * h2 + lane < nc && rk < need) {
        const unsigned kv = 0xFFFFu - (cv & 0xFFFFu), k32 = kv & 31u;
        const unsigned wi = ((((kv >> 6) * 2u + ((unsigned)qq >> 5)) * 32u + ((kv >> 5) & 1u) * 16u + (k32 & 3u) + 4u * (k32 >> 3)) * 2u) + ((k32 >> 2) & 1u);
        __hip_atomic_fetch_or((LDS unsigned*)(lds + IL_HIST) + wi, 1u << (qq & 31), __ATOMIC_RELAXED, __HIP_MEMORY_SCOPE_WORKGROUP);
      }
    }
  }
  __syncthreads();
  {
    for (int i = tid; i < (N >> 6) * 32; i += NTHR) {
      const int t = i >> 5, q32l = (i >> 4) & 1, ch = i & 15;
      *(u32x4*)((unsigned char*)(MASKT + (size_t)q32l * 128 * 32 + t * 32) + ch * 16) = *(LDS u32x4*)(lds + IL_HIST + ((t * 2 + q32l) * 32) * 8 + ch * 16);
    }
  }
  __syncthreads();
}

DEVI void phase3(PRef p, LDS unsigned char* lds) {
  const int G = gridDim.x;
  {
    float cw[4][8], cb[8]; rnn_load_w(p, cw, cb);
    h16x8 xin[11]; rnn_load_x(p, blockIdx.x >> 7, blockIdx.x & 127, xin);
    for (int it = blockIdx.x; it < 512; it += G) {
      const int nx = it + G < 512 ? it + G : it;
      h16x8 xn[11]; rnn_load_x(p, nx >> 7, nx & 127, xn);
      rnn_item<0>(p, lds, it >> 7, it & 127, xin, cw, cb);
#pragma unroll
      for (int i = 0; i < 11; ++i) xin[i] = xn[i];
    }
  }
  for (int it = blockIdx.x; it < 256; it += G) {
    const int b = it >> 6, j = it & 63;
#pragma unroll 1
    for (int w2 = 0; w2 < 2; ++w2) idx_item(p, lds, b, w2 ? j : 127 - j);
  }
}

DEVI float max3f(float a, float b, float c) { float r; asm("v_max3_f32 %0, %1, %2, %3" : "=v"(r) : "v"(a), "v"(b), "v"(c)); return r; }
typedef const u64 __attribute__((address_space(4)))* MaskPtr;
DEVI void attn_seed(f32x16 (&s)[2], MaskPtr mk, float mref) {
  const float negm = -mref;
#pragma unroll
  for (int ri = 0; ri < 2; ++ri)
#pragma unroll
    for (int r = 0; r < 16; ++r) s[ri][r] = __builtin_amdgcn_inverse_ballot_w64(mk[ri * 16 + r]) ? negm : -INFINITY;
}
DEVI void attn_tile(LDS unsigned char* Kt, LDS unsigned char* Vt, const h16x8 (&qf)[4], f32x16 (&s)[2], MaskPtr mkc, int l31, int half, f32x16 (&o)[2], float& mref, float& l, bool& init) {
  __builtin_amdgcn_s_setprio(1);
  h16x8 kf[2][4];
#pragma unroll
  for (int ri = 0; ri < 2; ++ri)
#pragma unroll
    for (int kk = 0; kk < 4; ++kk) kf[ri][kk] = *(LDS h16x8*)(Kt + (32 * ri + l31) * LROW + (2 * kk + half) * 16);
  __builtin_amdgcn_sched_barrier(0);
#pragma unroll
  for (int kk = 0; kk < 4; ++kk)
#pragma unroll
    for (int ri = 0; ri < 2; ++ri) s[ri] = mfma16(kf[ri][kk], qf[kk], s[ri]);
  h16x8 vf[2][4];
#pragma unroll
  for (int di = 0; di < 2; ++di)
#pragma unroll
    for (int s4 = 0; s4 < 4; ++s4) vf[di][s4] = *(LDS h16x8*)(Vt + (32 * di + l31) * LROW + (2 * s4 + half) * 16);
  __builtin_amdgcn_s_setprio(0);
  u64 mkn[32];
#define ATT_LOAD_MKN() do { typedef u64 u64x8_ __attribute__((ext_vector_type(8))); \
    const volatile u64x8_ __attribute__((address_space(4)))* vp_ = (const volatile u64x8_ __attribute__((address_space(4)))*)(mkc + 32); \
    _Pragma("unroll") for (int g_ = 0; g_ < 4; ++g_) { const u64x8_ w_ = vp_[g_]; _Pragma("unroll") for (int e_ = 0; e_ < 8; ++e_) mkn[8 * g_ + e_] = w_[e_]; } } while (0)
  ATT_LOAD_MKN();
  __builtin_amdgcn_sched_barrier(0);
  float ls;
  bool full = __any(!init);
  if (!full) {
    float a0, a1;
    s[0][0] = __builtin_amdgcn_exp2f(s[0][0]); s[1][0] = __builtin_amdgcn_exp2f(s[1][0]);
    a0 = s[0][0]; a1 = s[1][0];
#pragma unroll
    for (int r = 1; r < 16; ++r) {
      s[0][r] = __builtin_amdgcn_exp2f(s[0][r]); s[1][r] = __builtin_amdgcn_exp2f(s[1][r]);
      a0 += s[0][r]; asm("" : "+v"(a0));
      a1 += s[1][r]; asm("" : "+v"(a1));
    }
    a0 += a1;
    ls = a0;
    if (__any(!(a0 <= 32768.f))) {
      attn_seed(s, mkc, mref);
#pragma unroll
      for (int ri = 0; ri < 2; ++ri)
#pragma unroll
        for (int kk = 0; kk < 4; ++kk) kf[ri][kk] = *(LDS h16x8*)(Kt + (32 * ri + l31) * LROW + (2 * kk + half) * 16);
#pragma unroll
      for (int kk = 0; kk < 4; ++kk)
#pragma unroll
        for (int ri = 0; ri < 2; ++ri) s[ri] = mfma16(kf[ri][kk], qf[kk], s[ri]);
#pragma unroll
      for (int di = 0; di < 2; ++di)
#pragma unroll
        for (int s4 = 0; s4 < 4; ++s4) vf[di][s4] = *(LDS h16x8*)(Vt + (32 * di + l31) * LROW + (2 * s4 + half) * 16);
      ATT_LOAD_MKN();
      full = true;
    }
  }
  if (full) {
    asm volatile("s_nop 15\n\ts_nop 7" : "+v"(s[0]), "+v"(s[1]));
    float mx = max3f(s[0][0], s[1][0], s[0][1]), mx2 = max3f(s[1][1], s[0][2], s[1][2]);
#pragma unroll
    for (int r = 3; r < 15; r += 2) { mx = max3f(mx, s[0][r], s[1][r]); mx2 = max3f(mx2, s[0][r + 1], s[1][r + 1]); }
    mx = max3f(mx, s[0][15], s[1][15]);
    mx = max3f(mx, mx2, mx2);
    { const auto sw = __builtin_amdgcn_permlane32_swap(__float_as_uint(mx), __float_as_uint(mx), false, false);
      mx = fmaxf(__uint_as_float(sw[0]), __uint_as_float(sw[1])); }
    const bool first = (!init) && (mx > -INFINITY);
    const bool resc = first || (mx > 8.f);
    if (__any(resc)) {
      init = init || first;
      const float delta = resc ? mx : 0.f;
      const float alpha = __builtin_amdgcn_exp2f(-delta);
#pragma unroll
      for (int r = 0; r < 16; ++r) { s[0][r] -= delta; s[1][r] -= delta; o[0][r] *= alpha; o[1][r] *= alpha; }
      l *= alpha; mref += delta;
    }
    float a0 = 0.f;
#pragma unroll
    for (int r = 0; r < 16; ++r) {
      s[0][r] = __builtin_amdgcn_exp2f(s[0][r]); s[1][r] = __builtin_amdgcn_exp2f(s[1][r]);
      a0 += s[0][r] + s[1][r];
    }
    ls = a0;
  }
  l += ls;
  h16x8 pf[4];
#pragma unroll
  for (int s4 = 0; s4 < 4; ++s4) {
    u32x4 w;
#pragma unroll
    for (int e = 0; e < 4; ++e) w[e] = pk_rtz(s[s4 >> 1][8 * (s4 & 1) + 2 * e], s[s4 >> 1][8 * (s4 & 1) + 2 * e + 1]);
    pf[s4] = __builtin_bit_cast(h16x8, w);
  }
  __builtin_amdgcn_sched_barrier(0);
  {
    const float negm = -mref;
#pragma unroll
    for (int i = 0; i < 8; ++i) {
      const int di = i >> 2, s4 = i & 3;
      o[di] = mfma16(vf[di][s4], pf[s4], o[di]);
#pragma unroll
      for (int r = 2 * i; r < 2 * i + 2; ++r) {
        s[0][r] = __builtin_amdgcn_inverse_ballot_w64(mkn[r]) ? negm : -INFINITY;
        s[1][r] = __builtin_amdgcn_inverse_ballot_w64(mkn[16 + r]) ? negm : -INFINITY;
      }
    }
#pragma unroll
    for (int i = 0; i < 8; ++i) { __builtin_amdgcn_sched_group_barrier(0x008, 1, 0); __builtin_amdgcn_sched_group_barrier(0x002, 4, 0); }
  }
}

#undef ATT_LOAD_MKN
DEVI void attn_unit(PRef p, LDS unsigned char* lds, int b, int head, int qb) {
  const int tid = launder((int)threadIdx.x), lane = tid & 63, wave = wave_id(tid), l31 = lane & 31, half = lane >> 5;
  const int q0 = qb * 256 + wave * 32, cw = q0 >> 6, NS = qb + 1;
  const size_t tok = (size_t)b * SEQ + q0 + l31;
  h16x8 qf[4];
  {
    const h16* Q = (const h16*)(p.ws + WS_Q) + tok * 512 + head * 64;
#pragma unroll
    for (int kk = 0; kk < 4; ++kk) qf[kk] = *(const h16x8*)(Q + 16 * kk + 8 * half);
  }
  MaskPtr mk0 = (MaskPtr)(p.ws + WS_MASK) + ((size_t)(b * 256 + qb * 8 + wave) * 128) * 32;
  constexpr int TP = 2 * 64 * LROW, ABUF = 4 * TP;
  static_assert(2 * ABUF <= LDS_BYTES - 16, "attention LDS");
  const h16* ksrc[4]; const h16* vsrc[4]; int kdst[4], vdst[4];
#pragma unroll
  for (int i = 0; i < 4; ++i) {
    const int id = tid + NTHR * i;
    const int row = id >> 3, lc = id & 7;
    ksrc[i] = (const h16*)(p.ws + WS_K) + ((size_t)b * SEQ + row) * 512 + head * 64 + lc * 8;
    kdst[i] = (row >> 6) * TP + (row & 63) * LROW + lc * 16;
    const int d = id >> 5, c = id & 31;
    vsrc[i] = (const h16*)(p.ws + WS_VT) + ((size_t)(b * 8 + head) * 64 + d) * 8192 + c * 8;
    vdst[i] = (c >> 3) * TP + 64 * LROW + d * LROW + (c & 7) * 16;
  }
  h16x8 rk[4], rv[4];
#pragma unroll
  for (int i = 0; i < 4; ++i) { rk[i] = *(const h16x8*)ksrc[i]; rv[i] = *(const h16x8*)vsrc[i]; }
#pragma unroll
  for (int i = 0; i < 4; ++i) { *(LDS h16x8*)(lds + kdst[i]) = rk[i]; *(LDS h16x8*)(lds + vdst[i]) = rv[i]; }
  __syncthreads();
  f32x16 o[2];
#pragma unroll
  for (int r = 0; r < 16; ++r) { o[0][r] = 0.f; o[1][r] = 0.f; }
  float mref = 0.f, l = 0.f; bool init = false;
  f32x16 sd[2];
  attn_seed(sd, mk0, mref);
#define ATT_TILE(s, t) if (4 * (s) + (t) <= cw) attn_tile(bb + (t) * TP, bb + (t) * TP + 64 * LROW, qf, sd, mk0 + 32 * (4 * (s) + (t)), l31, half, o, mref, l, init);
#define ATT_STEP(s) { \
    { const int sp = (s) + 1 < NS ? (s) + 1 : NS - 1; _Pragma("unroll") for (int i = 0; i < 4; ++i) { rk[i] = *(const h16x8*)(ksrc[i] + (size_t)sp * 256 * 512); rv[i] = *(const h16x8*)(vsrc[i] + sp * 256); } } \
    { LDS unsigned char* bb = lds + ((s) & 1) * ABUF; ATT_TILE(s, 0) ATT_TILE(s, 1) ATT_TILE(s, 2) ATT_TILE(s, 3) } \
    { LDS unsigned char* nb = lds + (((s) + 1) & 1) * ABUF; _Pragma("unroll") for (int i = 0; i < 4; ++i) { *(LDS h16x8*)(nb + kdst[i]) = rk[i]; *(LDS h16x8*)(nb + vdst[i]) = rv[i]; } } \
    __syncthreads(); }
#pragma unroll 1
  for (int s = 0; s < NS; ++s) ATT_STEP(s)
#undef ATT_STEP
#undef ATT_TILE
  const float inv = 1.f / (l + __shfl_xor(l, 32));
  h16* Y = (h16*)(p.ws + WS_H) + tok * DM + head * 64;
#pragma unroll
  for (int di = 0; di < 2; ++di)
#pragma unroll
    for (int q = 0; q < 4; ++q)
      *(h16x4*)(Y + 32 * di + 8 * q + 4 * half) = pack4(o[di][4 * q] * inv, o[di][4 * q + 1] * inv, o[di][4 * q + 2] * inv, o[di][4 * q + 3] * inv);
}

DEVI void phase4(PRef p, LDS unsigned char* lds) {
  const int G = gridDim.x;
  {
    float cw[4][8], cb[8]; rnn_load_w(p, cw, cb);
    auto chunk = [](int it) { const int c = it & 127; return (it & 256) ? 127 - c : c; };
    h16x8 xin[11]; rnn_load_x(p, blockIdx.x >> 7, chunk(blockIdx.x), xin);
    for (int it = blockIdx.x; it < 512; it += G) {
      const int nx = it + G < 512 ? it + G : it;
      h16x8 xn[11]; rnn_load_x(p, nx >> 7, chunk(nx), xn);
      rnn_item<1>(p, lds, it >> 7, chunk(it), xin, cw, cb);
#pragma unroll
      for (int i = 0; i < 11; ++i) xin[i] = xn[i];
    }
  }
  for (int it = blockIdx.x; it < 512; it += G) {
    const int bh = it >> 4, j = it & 15;
#pragma unroll 1
    for (int w2 = 0; w2 < 2; ++w2) attn_unit(p, lds, bh >> 3, bh & 7, w2 ? j : 31 - j);
  }
}

struct EpiPlain {
  h16* dst; int ld;
  DEVI void operator()(const f32x4 (&acc)[2][2][4][2], const g8::Unit& u, int wr, int wc, int fr, int fq) const {
#pragma unroll
    for (int ai = 0; ai < 2; ++ai)
#pragma unroll
      for (int m = 0; m < 4; ++m) {
        const int r = u.pm * 256 + 128 * ai + 64 * wr + 16 * m + fr;
        if (r < u.cnt) {
          h16* d = dst + (size_t)(u.off + r) * ld + u.pn * 256 + 32 * wc + 8 * fq;
#pragma unroll
          for (int bj = 0; bj < 2; ++bj)
            { const f32x4 v0 = acc[ai][bj][m][0], v1 = acc[ai][bj][m][1]; h16x8 w; w[0] = (h16)v0[0]; w[1] = (h16)v0[1]; w[2] = (h16)v0[2]; w[3] = (h16)v0[3]; w[4] = (h16)v1[0]; w[5] = (h16)v1[1]; w[6] = (h16)v1[2]; w[7] = (h16)v1[3]; *(h16x8*)(d + 128 * bj) = w; }
        }
      }
  }
};
DEVI void phase5(PRef p, LDS unsigned char* lds) {
  g8::DenseOrder S{(const h16*)(p.ws + WS_H), (const h16*)(p.ws + WS_WOUT), DM, 128, 4, (int)gridDim.x, (int)blockIdx.x};
  EpiPlain E{(h16*)(p.ws + WS_MIX), DM};
  g8::gemm_phase(lds, DM, S, E);
}

constexpr int P6_TROW = 2064, P6_THI = 0, P6_TLO = 32 * P6_TROW, P6_PART = 0, P6_LGT = 8 * 48 * 32 * 4, P6_MOD = 2 * 32 * P6_TROW;
constexpr int P6_BIAS = P6_MOD + 3 * 4096, P6_TOK = P6_BIAS + 160, P6_LCNT = P6_TOK + 128 * 6 * 4, P6_LBASE = P6_LCNT + 128;
static_assert(P6_LBASE + 128 <= LDS_BYTES - 16 && P6_LGT + 32 * 36 * 4 <= P6_MOD, "phase 6 LDS map");
#define LDS_BARRIER() asm volatile("s_waitcnt lgkmcnt(0)\n\ts_barrier" ::: "memory")
DEVI void phase6(PRef p, LDS unsigned char* lds) {
  const int tid = launder((int)threadIdx.x), lane = tid & 63, wave = wave_id(tid), l15 = lane & 15, g4 = lane >> 4;
  const int b = blockIdx.x >> 6;
  LDS float* mv = (LDS float*)(lds + P6_MOD);
  LDS float* rbias = (LDS float*)(lds + P6_BIAS);
  LDS unsigned* tokrec = (LDS unsigned*)(lds + P6_TOK);
  LDS unsigned* lcnt = (LDS unsigned*)(lds + P6_LCNT);
  LDS unsigned* lbase = (LDS unsigned*)(lds + P6_LBASE);
  const float* x = p.in[0]; const h16* MIX = (const h16*)(p.ws + WS_MIX); h16* X1h = (h16*)(p.ws + WS_MIX); h16* H2 = (h16*)(p.ws + WS_H);
  const h16* WRH = (const h16*)(p.ws + WS_WRH); const h16* WRL = (const h16*)(p.ws + WS_WRL);
  const size_t tok0 = (size_t)blockIdx.x * 128;
  h16x8 bh[3][4], bl[3][4];
#pragma unroll
  for (int ct = 0; ct < 3; ++ct)
#pragma unroll
    for (int kk = 0; kk < 4; ++kk) {
      const int kof = 32 * (4 * wave + kk) + 8 * g4;
      bh[ct][kk] = *(const h16x8*)(WRH + (size_t)(16 * ct + l15) * 1024 + kof); bl[ct][kk] = *(const h16x8*)(WRL + (size_t)(16 * ct + l15) * 1024 + kof);
    }
  f32x4 xa[4]; h16x4 ma[4];
#pragma unroll
  for (int j = 0; j < 4; ++j) { xa[j] = *(const f32x4*)(x + (tok0 + 4 * wave) * DM + 256 * j + 4 * lane); ma[j] = *(const h16x4*)(MIX + (tok0 + 4 * wave) * DM + 256 * j + 4 * lane); }
  float w5[2], w6[2];
#pragma unroll
  for (int i = 0; i < 2; ++i) { w5[i] = p.in[5][tid + NTHR * i]; w6[i] = p.in[6][tid + NTHR * i]; }
  mod_to_lds(p, b, 2, mv); mod_to_lds(p, b, 3, mv + 1024); mod_to_lds(p, b, 4, mv + 2048);
  if (tid < 4) rbias[tid] = p.in[18][tid];
  else if (tid < 36) rbias[tid] = p.in[20][tid - 4];
  if (tid < 32) lcnt[tid] = 0u;
  __syncthreads();
#pragma unroll
  for (int i = 0; i < 2; ++i) { const int k = tid + NTHR * i; mv[k] *= w5[i]; mv[2048 + k] = w6[i] * (mv[2048 + k] + 1.f); }
  __syncthreads();
#pragma unroll 1
  for (int rd = 0; rd < 4; ++rd) {
    {
      const size_t tokb = tok0 + 32 * rd + 4 * wave;
#define P6_LOAD(XV, MH, T) do { _Pragma("unroll") for (int j = 0; j < 4; ++j) { XV[j] = *(const f32x4*)(x + (T) * DM + 256 * j + 4 * lane); MH[j] = *(const h16x4*)(MIX + (T) * DM + 256 * j + 4 * lane); } } while (0)
#define P6_ROW(XV, MH, I) do { \
        const int tr = 4 * wave + (I); const size_t tok = tokb + (I); \
        f32x4 mx[4]; float ssm = 0.f; \
        _Pragma("unroll") for (int j = 0; j < 4; ++j) _Pragma("unroll") for (int e = 0; e < 4; ++e) { mx[j][e] = (float)MH[j][e]; ssm += mx[j][e] * mx[j][e]; } \
        const float rsm = 1.0f / sqrtf(wave_sum(ssm) * (1.f / 1024.f) + 1e-6f); \
        float ss1 = 0.f; \
        _Pragma("unroll") for (int j = 0; j < 4; ++j) { \
          const f32x4 v = XV[j] + *(LDS f32x4*)(mv + 256 * j + 4 * lane) * (mx[j] * rsm); \
          XV[j] = v; \
          *(h16x4*)(X1h + tok * DM + 256 * j + 4 * lane) = pack4(v[0], v[1], v[2], v[3]); \
          ss1 += v[0] * v[0] + v[1] * v[1] + v[2] * v[2] + v[3] * v[3]; \
        } \
        const float rs1 = 1.0f / sqrtf(wave_sum(ss1) * (1.f / 1024.f) + 1e-6f); \
        _Pragma("unroll") for (int j = 0; j < 4; ++j) { \
          const f32x4 h2 = XV[j] * rs1 * *(LDS f32x4*)(mv + 2048 + 256 * j + 4 * lane) + *(LDS f32x4*)(mv + 1024 + 256 * j + 4 * lane); \
          const h16x4 hi = pack4(h2[0], h2[1], h2[2], h2[3]); \
          const h16x4 lo = pack4(h2[0] - (float)hi[0], h2[1] - (float)hi[1], h2[2] - (float)hi[2], h2[3] - (float)hi[3]); \
          *(h16x4*)(H2 + tok * DM + 256 * j + 4 * lane) = hi; \
          *(LDS h16x4*)(lds + P6_THI + tr * P6_TROW + (256 * j + 4 * lane) * 2) = hi; \
          *(LDS h16x4*)(lds + P6_TLO + tr * P6_TROW + (256 * j + 4 * lane) * 2) = lo; \
        } } while (0)
      f32x4 xb[4]; h16x4 mb[4];
      P6_LOAD(xb, mb, tokb + 1); __builtin_amdgcn_sched_barrier(0); P6_ROW(xa, ma, 0);
      P6_LOAD(xa, ma, tokb + 2); __builtin_amdgcn_sched_barrier(0); P6_ROW(xb, mb, 1);
      P6_LOAD(xb, mb, tokb + 3); __builtin_amdgcn_sched_barrier(0); P6_ROW(xa, ma, 2);
      { const size_t tn = rd < 3 ? tokb + 32 : tokb; P6_LOAD(xa, ma, tn); } __builtin_amdgcn_sched_barrier(0); P6_ROW(xb, mb, 3);
    }
    LDS_BARRIER();
    f32x4 acc[2][3];
#pragma unroll
    for (int tt = 0; tt < 2; ++tt)
#pragma unroll
      for (int ct = 0; ct < 3; ++ct) acc[tt][ct] = (f32x4){0.f, 0.f, 0.f, 0.f};
#pragma unroll
    for (int kk = 0; kk < 4; ++kk) {
      const int kof = 32 * (4 * wave + kk) + 8 * g4;
      h16x8 ah[2], al[2];
#pragma unroll
      for (int tt = 0; tt < 2; ++tt) {
        ah[tt] = *(LDS h16x8*)(lds + P6_THI + (16 * tt + l15) * P6_TROW + kof * 2);
        al[tt] = *(LDS h16x8*)(lds + P6_TLO + (16 * tt + l15) * P6_TROW + kof * 2);
      }
#pragma unroll
      for (int ct = 0; ct < 3; ++ct) {
#pragma unroll
        for (int tt = 0; tt < 2; ++tt) {
          acc[tt][ct] = mfma16s(ah[tt], bh[ct][kk], acc[tt][ct]);
          acc[tt][ct] = mfma16s(ah[tt], bl[ct][kk], acc[tt][ct]);
          acc[tt][ct] = mfma16s(al[tt], bh[ct][kk], acc[tt][ct]);
        }
      }
    }
    LDS_BARRIER();
#pragma unroll
    for (int tt = 0; tt < 2; ++tt)
#pragma unroll
      for (int ct = 0; ct < 3; ++ct)
        *(LDS f32x4*)(lds + P6_PART + (((wave * 48 + 16 * ct + l15) * 32) + 16 * tt + 4 * g4) * 4) = acc[tt][ct];
    LDS_BARRIER();
    for (int idx = tid; idx < 36 * 32; idx += NTHR) {
      const int col = idx >> 5, tk = idx & 31;
      float s = 0.f;
#pragma unroll
      for (int w = 0; w < 8; ++w) s += *(LDS float*)(lds + P6_PART + ((w * 48 + col) * 32 + tk) * 4);
      *(LDS float*)(lds + P6_LGT + (tk * 36 + col) * 4) = s;
    }
    LDS_BARRIER();
    if (tid < 32) {
      LDS float* lg = (LDS float*)(lds + P6_LGT) + 36 * tid;
      float gl[4];
#pragma unroll
      for (int g = 0; g < 4; ++g) gl[g] = lg[g] + rbias[g];
      int gi = 0; float gm = gl[0];
#pragma unroll
      for (int g = 1; g < 4; ++g) if (gl[g] > gm) { gm = gl[g]; gi = g; }
      float gs = 0.f;
#pragma unroll
      for (int g = 0; g < 4; ++g) gs += __expf(gl[g] - gm);
      const float pg = 1.f / gs;
      int e1 = 0, e2 = 0; float l1 = -INFINITY, l2 = -INFINITY;
#pragma unroll
      for (int e = 0; e < 8; ++e) {
        const float v = lg[4 + 8 * gi + e] + rbias[4 + 8 * gi + e];
        if (v > l1) { l2 = l1; e2 = e1; l1 = v; e1 = e; }
        else if (v > l2) { l2 = v; e2 = e; }
      }
      const float x2 = __expf(l2 - l1);
      const float w1 = pg / (1.f + x2), w2 = pg * x2 / (1.f + x2);
      const unsigned E1 = (unsigned)(gi * 8 + e1), E2 = (unsigned)(gi * 8 + e2);
      const unsigned lp1 = __hip_atomic_fetch_add(&lcnt[E1], 1u, __ATOMIC_RELAXED, __HIP_MEMORY_SCOPE_WORKGROUP);
      const unsigned lp2 = __hip_atomic_fetch_add(&lcnt[E2], 1u, __ATOMIC_RELAXED, __HIP_MEMORY_SCOPE_WORKGROUP);
      LDS unsigned* tr = tokrec + (32 * rd + tid) * 6;
      tr[0] = E1; tr[1] = lp1; tr[2] = E2; tr[3] = lp2; tr[4] = __float_as_uint(w1); tr[5] = __float_as_uint(w2);
    }
    LDS_BARRIER();
  }
  if (tid < 32) lbase[tid] = atomicAdd((unsigned*)(p.ws + WS_CNT) + tid, lcnt[tid]);
  __syncthreads();
  if (tid < 128) {
    unsigned* LIST = (unsigned*)(p.ws + WS_LIST); float* LISTW = (float*)(p.ws + WS_LISTW); u32x4* ROUTE = (u32x4*)(p.ws + WS_ROUTE);
    const unsigned tok = (unsigned)(tok0 + tid);
    LDS unsigned* tr = tokrec + tid * 6;
    const unsigned E1 = tr[0], E2 = tr[2], p1 = lbase[E1] + tr[1], p2 = lbase[E2] + tr[3];
    LIST[(size_t)E1 * 32768 + p1] = tok; LISTW[(size_t)E1 * 32768 + p1] = __uint_as_float(tr[4]);
    LIST[(size_t)E2 * 32768 + p2] = tok; LISTW[(size_t)E2 * 32768 + p2] = __uint_as_float(tr[5]);
    u32x4 rt; rt[0] = E1; rt[1] = p1; rt[2] = E2; rt[3] = p2;
    ROUTE[tok] = rt;
  }
}

template <bool GATHER_> struct MoeOrder {
  static constexpr bool GATHER = GATHER_, HALF = GATHER_;
  unsigned char* ws; int ntn, K, G, c;
  int pre, cnl, offx, preb;
  DEVI void init() {
    const int lane = threadIdx.x & 63;
    const int cn0 = lane < 32 ? (int)((const unsigned*)(ws + WS_CNT))[lane] : 0;
    int pt = (HALF ? (cn0 >> 8) : ((cn0 + 255) >> 8)) * ntn, po = cn0, pb = (HALF && (cn0 & 255)) ? 2 * ntn : 0;
#pragma unroll
    for (int d = 1; d < 32; d <<= 1) { const int a = __shfl_up(pt, d), b = __shfl_up(po, d), cb = __shfl_up(pb, d); if (lane >= d) { pt += a; po += b; pb += cb; } }
    pre = lane < 32 ? pt : 0x7fffffff; cnl = cn0; offx = po - cn0; preb = lane < 32 ? pb : 0x7fffffff;
  }
  DEVI bool next(int i, g8::Unit& u) const {
    const int itg = i * G + (c & 7) * (G >> 3) + (c >> 3);
    int e = __builtin_popcountll(__builtin_amdgcn_ballot_w64(pre <= itg));
    int cn, off, it;
    u.half = 0;
    if (e >= 32) {
      if (!HALF) return false;
      const int j = itg - __builtin_amdgcn_readlane(pre, 31);
      e = __builtin_popcountll(__builtin_amdgcn_ballot_w64(preb <= j));
      if (e >= 32) return false;
      cn = __builtin_amdgcn_readlane(cnl, e); off = __builtin_amdgcn_readlane(offx, e);
      const int k = j - (__builtin_amdgcn_readlane(preb, e) - 2 * ntn);
      it = (cn >> 8) * ntn + (k >> 1); u.half = 1 + (k & 1);
    } else {
      cn = __builtin_amdgcn_readlane(cnl, e); off = __builtin_amdgcn_readlane(offx, e);
      it = itg - (__builtin_amdgcn_readlane(pre, e) - (HALF ? (cn >> 8) : ((cn + 255) >> 8)) * ntn);
    }
    u.e = e; u.pm = it / ntn; u.pn = it % ntn; u.cnt = cn; u.off = off;
    const int tid = threadIdx.x;
    if (GATHER_) {
      const unsigned* list = (const unsigned*)(ws + WS_LIST) + (size_t)e * 32768;
      u.A = (const char*)(ws + WS_H);
      u.B = (const char*)((const h16*)(ws + WS_WGU) + ((size_t)e * 512 + u.pn * 256) * DM);
#pragma unroll
      for (int h = 0; h < 2; ++h)
#pragma unroll
        for (int i2 = 0; i2 < 2; ++i2) {
          int R, C; g8::stage_rc(tid * 16 + i2 * 8192, R, C);
          const int row = u.pm * 256 + 128 * h + R;
          const unsigned t = list[row < cn ? row : cn - 1];
          u.va[h][i2] = (t * (unsigned)DM + (unsigned)C) * 2u;
        }
    } else {
      u.A = (const char*)((const h16*)(ws + WS_ACT) + ((size_t)off + u.pm * 256) * 256);
      u.B = (const char*)((const h16*)(ws + WS_WDN) + ((size_t)e * 1024 + u.pn * 256) * 256);
      u.va[0][0] = u.va[0][1] = u.va[1][0] = u.va[1][1] = 0u;
    }
    return true;
  }
};
struct EpiAct {
  unsigned char* ws;
  DEVI void operator()(const f32x4 (&acc)[2][2][4][2], const g8::Unit& u, int wr, int wc, int fr, int fq) const {
    const float* lw = (const float*)(ws + WS_LISTW) + (size_t)u.e * 32768; h16* act = (h16*)(ws + WS_ACT);
    const int r0 = u.pm * 256 + 64 * wr + fr;
    float w8[2][4];
#pragma unroll
    for (int ai = 0; ai < 2; ++ai)
#pragma unroll
      for (int m = 0; m < 4; ++m) { const int r = r0 + 128 * ai + 16 * m; w8[ai][m] = lw[r < u.cnt ? r : u.cnt - 1]; }
    __builtin_amdgcn_sched_barrier(0);
#pragma unroll
    for (int ai = 0; ai < 2; ++ai)
#pragma unroll
      for (int m = 0; m < 4; ++m) asm volatile("" : "+v"(w8[ai][m]));
#pragma unroll
    for (int ai = 0; ai < 2; ++ai)
#pragma unroll
      for (int m = 0; m < 4; ++m) {
        const int r = r0 + 128 * ai + 16 * m;
        if (r < u.cnt) {
          const float w = w8[ai][m];
#pragma unroll
          for (int bj = 0; bj < 2; ++bj) {
            if (u.half == 2 - bj) continue;
            const f32x4 g = acc[ai][bj][m][0], up = acc[ai][bj][m][1];
            float v[4];
#pragma unroll
            for (int e = 0; e < 4; ++e) v[e] = g[e] * __builtin_amdgcn_rcpf(1.f + __expf(-g[e])) * up[e] * w;
            *(h16x4*)(act + (size_t)(u.off + r) * 256 + 16 * (8 * u.pn + 4 * bj + wc) + 4 * fq) = pack4(v[0], v[1], v[2], v[3]);
          }
        }
      }
  }
};
struct EpiYp {
  h16* dst;
  DEVI void operator()(const f32x4 (&acc)[2][2][4][2], const g8::Unit& u, int wr, int wc, int fr, int fq) const {
#pragma unroll
    for (int ai = 0; ai < 2; ++ai)
#pragma unroll
      for (int m = 0; m < 4; ++m) {
        const int r = u.pm * 256 + 128 * ai + 64 * wr + 16 * m + fr;
        if (r < u.cnt) {
          h16* d = dst + (size_t)(u.off + r) * DM + u.pn * 256 + 32 * wc + 8 * fq;
#pragma unroll
          for (int bj = 0; bj < 2; ++bj)
            { const f32x4 v0 = acc[ai][bj][m][0], v1 = acc[ai][bj][m][1]; h16x8 w; w[0] = (h16)v0[0]; w[1] = (h16)v0[1]; w[2] = (h16)v0[2]; w[3] = (h16)v0[3]; w[4] = (h16)v1[0]; w[5] = (h16)v1[1]; w[6] = (h16)v1[2]; w[7] = (h16)v1[3]; *(h16x8*)(d + 128 * bj) = w; }
        }
      }
  }
};
DEVI void phase7(PRef p, LDS unsigned char* lds) {
  MoeOrder<true> S{p.ws, 2, DM, (int)gridDim.x, (int)blockIdx.x, 0, 0, 0, 0};
  S.init();
  EpiAct E{p.ws};
  g8::gemm_phase(lds, DM, S, E);
}
DEVI void phase8(PRef p, LDS unsigned char* lds) {
  MoeOrder<false> S{p.ws, 4, 256, (int)gridDim.x, (int)blockIdx.x, 0, 0, 0, 0};
  S.init();
  EpiYp E{(h16*)(p.ws + WS_YP)};
  g8::gemm_phase(lds, 256, S, E);
}

DEVI void phase9(PRef p, LDS unsigned char* lds) {
  const int tid = launder((int)threadIdx.x), lane = tid & 63, wave = wave_id(tid), G = gridDim.x;
  const int b = blockIdx.x & 3, bi = blockIdx.x >> 2, nbk = G >> 2;
  const h16* YP = (const h16*)(p.ws + WS_YP); const u32x4* ROUTE = (const u32x4*)(p.ws + WS_ROUTE); float* out = p.out; const h16* X1h = (const h16*)(p.ws + WS_MIX);
  const int rstep = nbk * 8, r_first = bi * 8 + wave;
  const int nrow = (SEQ - r_first + rstep - 1) / rstep;
  u32x4 rt = (u32x4){0u, 0u, 0u, 0u};
  if (lane < nrow) rt = ROUTE[(size_t)b * SEQ + r_first + rstep * lane];
  int offl;
  {
    const int cn0 = lane < 32 ? (int)((const unsigned*)(p.ws + WS_CNT))[lane] : 0;
    int po = cn0;
#pragma unroll
    for (int d = 1; d < 32; d <<= 1) { const int a = __shfl_up(po, d); if (lane >= d) po += a; }
    offl = po - cn0;
  }
  LDS float* mv = (LDS float*)(lds + 256);
  mod_to_lds(p, b, 5, mv);
  __syncthreads();
  f32x4 A3[4];
#pragma unroll
  for (int j = 0; j < 4; ++j) { const int k = 256 * j + 4 * lane; A3[j] = *(LDS f32x4*)(mv + k) * *(const f32x4*)(p.in[7] + k); }
  const unsigned R0 = (unsigned)__shfl(offl, (int)(rt[0] & 31u)) + rt[1], R1 = (unsigned)__shfl(offl, (int)(rt[2] & 31u)) + rt[3];
  h16x4 ya[4], yc[4]; f32x4 xv[4];
  {
    const size_t tok = (size_t)b * SEQ + r_first; const size_t r0 = __builtin_amdgcn_readlane(R0, 0), r1 = __builtin_amdgcn_readlane(R1, 0);
#pragma unroll
    for (int j = 0; j < 4; ++j) { ya[j] = *(const h16x4*)(YP + r0 * DM + 256 * j + 4 * lane); yc[j] = *(const h16x4*)(YP + r1 * DM + 256 * j + 4 * lane); { const h16x4 xh = *(const h16x4*)(X1h + tok * DM + 256 * j + 4 * lane); xv[j] = (f32x4){(float)xh[0], (float)xh[1], (float)xh[2], (float)xh[3]}; } }
  }
  for (int i = 0; i < nrow; ++i) {
    const size_t tok = (size_t)b * SEQ + r_first + rstep * i;
    h16x4 na[4], nc[4], nxh[4];
    {
      const int in_ = i + 1 < nrow ? i + 1 : i;
      const size_t r0 = __builtin_amdgcn_readlane(R0, in_), r1 = __builtin_amdgcn_readlane(R1, in_), tn = (size_t)b * SEQ + r_first + rstep * in_;
#pragma unroll
      for (int j = 0; j < 4; ++j) { na[j] = *(const h16x4*)(YP + r0 * DM + 256 * j + 4 * lane); nc[j] = *(const h16x4*)(YP + r1 * DM + 256 * j + 4 * lane); nxh[j] = *(const h16x4*)(X1h + tn * DM + 256 * j + 4 * lane); }
    }
    f32x4 y[4]; float ss = 0.f;
#pragma unroll
    for (int j = 0; j < 4; ++j)
#pragma unroll
      for (int e = 0; e < 4; ++e) { y[j][e] = (float)ya[j][e] + (float)yc[j][e]; ss += y[j][e] * y[j][e]; }
    const float rs = 1.0f / sqrtf(wave_sum(ss) * (1.f / 1024.f) + 1e-6f);
#pragma unroll
    for (int j = 0; j < 4; ++j) *(f32x4*)(out + tok * DM + 256 * j + 4 * lane) = xv[j] + A3[j] * (y[j] * rs);
#pragma unroll
    for (int j = 0; j < 4; ++j) { ya[j] = na[j]; yc[j] = nc[j]; xv[j] = (f32x4){(float)nxh[j][0], (float)nxh[j][1], (float)nxh[j][2], (float)nxh[j][3]}; }
  }
}

#define XB_TMO      128
#define XB_XCNT(j)  (256  + 64 * (j))
#define XB_XSUB(j)  (1280 + 64 * (j))
#define XB_XGEN(j)  (2304 + 64 * (j))
#define XB_TOP      3328
#define XB_TOPGEN   3392
#define XB_SPIN_CAP (1u << 22)
DEVI unsigned xb_ld(unsigned* p)              { return __hip_atomic_load(p, __ATOMIC_RELAXED, __HIP_MEMORY_SCOPE_AGENT); }
DEVI unsigned xb_add(unsigned* p, unsigned v) { return __hip_atomic_fetch_add(p, v, __ATOMIC_RELAXED, __HIP_MEMORY_SCOPE_AGENT); }
DEVI unsigned xb_xcc_id() { return (unsigned)__builtin_amdgcn_s_getreg((3 << 11) | 20) & 0xFu; }
#define XB_SPIN(cond, bar) do { unsigned _sp = 0; while (cond) { __builtin_amdgcn_s_sleep(1); \
    if ((++_sp & 255u) == 0u) { if (xb_ld(&(bar)[XB_TMO])) break; if (_sp > XB_SPIN_CAP) { atomicAdd(&(bar)[XB_TMO], 1u); break; } } } } while (0)
struct XcdBarrier { unsigned* bar; unsigned x; volatile LDS unsigned* st; };
DEVI XcdBarrier xcd_barrier_post(unsigned* bar, volatile LDS unsigned* st) {
  XcdBarrier b; b.bar = bar; b.x = xb_xcc_id(); b.st = st;
  if (threadIdx.x == 0) (void)xb_add(&bar[XB_XCNT(b.x)], 1u);
  return b;
}
DEVI void xcd_barrier_complete(unsigned* bar, unsigned x, unsigned& nloc, unsigned& nx) {
  const unsigned G = gridDim.x * gridDim.y * gridDim.z;
  unsigned sum, cnt, mine, sp = 0u;
  for (;;) {
    sum = 0u; cnt = 0u; mine = 0u;
#pragma unroll
    for (unsigned j = 0; j < 16; ++j) { const unsigned c = xb_ld(&bar[XB_XCNT(j)]); sum += c; cnt += (c > 0u) ? 1u : 0u; mine = (j == x) ? c : mine; }
    if (sum == G) break;
    __builtin_amdgcn_s_sleep(1);
    if ((++sp & 255u) == 0u) { if (xb_ld(&bar[XB_TMO])) break; if (sp > XB_SPIN_CAP) { atomicAdd(&bar[XB_TMO], 1u); break; } }
  }
  nloc = mine > 0u ? mine : 1u; nx = cnt > 0u ? cnt : 1u;
}
DEVI void xcd_barrier(const XcdBarrier& b) {
  asm volatile("s_waitcnt vmcnt(0)" ::: "memory");
  __syncthreads();
  if (threadIdx.x == 0) {
    unsigned* bar = b.bar;
    __builtin_amdgcn_s_waitcnt(0);
    unsigned nloc = b.st[0], nx = b.st[1];
    if (nloc == 0u) { xcd_barrier_complete(bar, b.x, nloc, nx); b.st[0] = nloc; b.st[1] = nx; }
    const unsigned old = xb_add(&bar[XB_XSUB(b.x)], 1u);
    const unsigned gen = old / nloc;
    if (old + 1u == (gen + 1u) * nloc) {
      __builtin_amdgcn_fence(__ATOMIC_RELEASE, "agent");
      asm volatile("s_waitcnt vmcnt(0)" ::: "memory");
      const unsigned og = xb_add(&bar[XB_TOP], 1u);
      const unsigned tg = og / nx;
      if (og + 1u == (tg + 1u) * nx) xb_add(&bar[XB_TOPGEN], 1u);
      else XB_SPIN(xb_ld(&bar[XB_TOPGEN]) == tg, bar);
      __builtin_amdgcn_fence(__ATOMIC_ACQUIRE, "agent");
      xb_add(&bar[XB_XGEN(b.x)], 1u);
      asm volatile("s_waitcnt vmcnt(0)" ::: "memory");
    } else {
      XB_SPIN(xb_ld(&bar[XB_XGEN(b.x)]) == gen, bar);
      __builtin_amdgcn_fence(__ATOMIC_ACQUIRE, "agent");
      asm volatile("s_waitcnt vmcnt(0)" ::: "memory");
    }
  }
  __syncthreads();
}

__global__ void __launch_bounds__(NTHR) fwd_kernel(Params p) {
  extern __shared__ __attribute__((aligned(16))) unsigned char smem[];
  LDS unsigned char* lds = (LDS unsigned char*)smem;
  const int lo = p.ph_lo, hi = p.ph_hi;
  volatile LDS unsigned* bst = (volatile LDS unsigned*)(lds + LDS_BYTES - 16);
  if (threadIdx.x < 4) bst[threadIdx.x] = 0u;
  __syncthreads();
  (void)xcd_barrier_post((unsigned*)(p.ws + WS_BAR), bst);
#ifndef REPEAT_PHASE
#define REPEAT_PHASE -1
#endif
#define GRID_SYNC(k) do { { XcdBarrier xb_; xb_.bar = (unsigned*)(get_params()->ws + WS_BAR); xb_.x = xb_xcc_id(); xb_.st = (volatile LDS unsigned*)(lds + LDS_BYTES - 16); xcd_barrier(xb_); } } while (0)
#define RUN_PHASE(k, fn) if (lo <= (k) && (k) < hi) { fn(*get_params(), lds); if ((k) == REPEAT_PHASE) { GRID_SYNC(k); fn(*get_params(), lds); } if ((k) + 1 < hi) GRID_SYNC(k); }
  RUN_PHASE(0, phase0)
  RUN_PHASE(1, phase1)
  RUN_PHASE(2, phase2)
  RUN_PHASE(3, phase3)
  RUN_PHASE(4, phase4)
  RUN_PHASE(5, phase5)
  RUN_PHASE(6, phase6)
  RUN_PHASE(7, phase7)
  RUN_PHASE(8, phase8)
  RUN_PHASE(9, phase9)
#undef GRID_SYNC
#undef RUN_PHASE
}

extern "C" void kernel_launch(void* const* d_in, const int* in_sizes, int n_in, void* d_out, int out_size, void* d_ws, size_t ws_size, hipStream_t stream) {
  static int grid = 0;
  if (grid == 0) {
    if (n_in != 24 || out_size != NTOK * DM || ws_size < WS_END) { fprintf(stderr, "kernel_launch: unexpected problem (n_in %d out %d ws %zu)\n", n_in, out_size, ws_size); grid = -1; return; }
    (void)hipFuncSetAttribute((const void*)fwd_kernel, hipFuncAttributeMaxDynamicSharedMemorySize, LDS_BYTES);
    int dev = 0, cus = 0, per_cu = 0;
    (void)hipGetDevice(&dev);
    (void)hipDeviceGetAttribute(&cus, hipDeviceAttributeMultiprocessorCount, dev);
    (void)hipOccupancyMaxActiveBlocksPerMultiprocessor(&per_cu, (const void*)fwd_kernel, NTHR, LDS_BYTES);
    if (per_cu < 1 || cus < 256) fprintf(stderr, "kernel_launch: occupancy %d blocks/CU on %d CUs\n", per_cu, cus);
    grid = 256;
  }
  if (grid < 0) return;
  (void)hipMemsetAsync((char*)d_ws + WS_CNT, 0, CTL_ZERO_BYTES, stream);
  Params p{};
  for (int i = 0; i < 24; ++i) p.in[i] = (const float*)d_in[i];
  p.out = (float*)d_out; p.ws = (unsigned char*)d_ws;
#if N_LAUNCH_MODE == 1
  p.ph_lo = 0; p.ph_hi = NPHASE;
  void* args[] = {&p};
  hipError_t e = hipLaunchCooperativeKernel((const void*)fwd_kernel, dim3(grid), dim3(NTHR), args, LDS_BYTES, stream);
  if (e != hipSuccess) fprintf(stderr, "cooperative launch failed: %s\n", hipGetErrorString(e));
#else
  for (int ph = 0; ph < NPHASE; ++ph) {
    p.ph_lo = ph; p.ph_hi = ph + 1;
    hipLaunchKernelGGL(fwd_kernel, dim3(grid), dim3(NTHR), LDS_BYTES, stream, p);
  }
#endif
}
```
